# Optimizing an MI355X kernel written in HIP

```python
import jax, jax.numpy as jnp
from jax import lax
import numpy as np

D_MODEL = 1024
BATCH = 2
SEQ = 8192
DEPTH = 2

GRID_W = 64
CTX_LEN = 256

HEAD = 64
D_RWKV = D_MODEL // 2
H_RWKV = D_RWKV // HEAD
D_CONV = D_MODEL // 4
D_FOUR = D_MODEL - D_RWKV - D_CONV
FOUR_GROUP = 64
G_FOUR = D_FOUR // FOUR_GROUP
LORA_W = 64
LORA_A = 64
LORA_G = 128
D_RWKV_IN = 3 * D_RWKV + 2 * LORA_W + 2 * LORA_A + LORA_G
RWKV_SPLITS = (D_RWKV, 2 * D_RWKV, 3 * D_RWKV, 3 * D_RWKV + LORA_W, 3 * D_RWKV + 2 * LORA_W,
               3 * D_RWKV + 2 * LORA_W + LORA_A, 3 * D_RWKV + 2 * LORA_W + 2 * LORA_A)
D_IN = D_RWKV_IN + 3 * D_CONV + D_FOUR
CONV_W = 3
N_GROUPS = 4
EXPERTS_PER_GROUP = 8
N_EXPERTS = N_GROUPS * EXPERTS_PER_GROUP
TOP_K = 2
D_EXPERT = D_MODEL // 2
MOE_BLOCK = 128
RMS_EPS = 1e-6
GN_EPS = 64e-5

kernel_name = "hybrid_rwkv7_shortconv_fourier_hmoe_dit"


def rmsnorm(x, gain):
    xf = x.astype(jnp.float32)
    y = xf * lax.rsqrt(jnp.mean(xf * xf, axis=-1, keepdims=True) + RMS_EPS)
    return (y * gain).astype(x.dtype)


def to_heads(t):
    return t.reshape(t.shape[0], t.shape[1], H_RWKV, HEAD)


def grid_shift(z):
    b, length, ch = z.shape
    rows = length // GRID_W
    zg = z.reshape(b, rows, GRID_W, ch // 4, 4)
    left = jnp.pad(zg[:, :, :-1, :, 0], ((0, 0), (0, 0), (1, 0), (0, 0)))
    right = jnp.pad(zg[:, :, 1:, :, 1], ((0, 0), (0, 0), (0, 1), (0, 0)))
    up = jnp.pad(zg[:, :-1, :, :, 2], ((0, 0), (1, 0), (0, 0), (0, 0)))
    down = jnp.pad(zg[:, 1:, :, :, 3], ((0, 0), (0, 1), (0, 0), (0, 0)))
    return jnp.stack([left, right, up, down], axis=-1).reshape(b, length, ch)


def seq_shift(z):
    b, length, ch = z.shape
    zs = z.reshape(b, length, ch // 2, 2)
    prev = jnp.pad(zs[:, :-1, :, 0], ((0, 0), (1, 0), (0, 0)))
    nxt = jnp.pad(zs[:, 1:, :, 1], ((0, 0), (0, 1), (0, 0)))
    return jnp.stack([prev, nxt], axis=-1).reshape(b, length, ch)


def rwkv_streams(z, decay_w0, decay_w2, iclr_a0, iclr_a2, gate_g2, k_k, k_a):
    zf = z.astype(jnp.float32)
    r, k, v, lw_f, lw_b, la_f, la_b, lg = jnp.split(zf, RWKV_SPLITS, axis=-1)
    g = jax.nn.sigmoid(lg) @ gate_g2
    kk = to_heads(k * k_k)
    kk = kk / jnp.maximum(jnp.sqrt(jnp.sum(kk * kk, axis=-1, keepdims=True)), 1e-12)
    per_dir = []
    for dn, (lw, la) in enumerate(((lw_f, la_f), (lw_b, la_b))):
        w_log = -jax.nn.softplus(-(decay_w0[dn] + jnp.tanh(lw) @ decay_w2[dn])) - 0.5
        decay = jnp.exp(-jnp.exp(w_log))
        a = jax.nn.sigmoid(iclr_a0[dn] + la @ iclr_a2[dn])
        k_dir = k * (1.0 + (a - 1.0) * k_a)
        per_dir.append((to_heads(decay), to_heads(k_dir), to_heads(a)))
    return to_heads(r), to_heads(v), kk, g, per_dir


def wkv7_scan(s0, r, decay, k, v, kk, a, reverse, readout):
    def step(s, inp):
        r_t, d_t, k_t, v_t, kk_t, a_t = inp
        s_kk = jnp.einsum('bhvk,bhk->bhv', s, kk_t)
        s = (s * d_t[:, :, None, :]
             - s_kk[..., None] * (kk_t * a_t)[:, :, None, :]
             + v_t[..., None] * k_t[:, :, None, :])
        y_t = jnp.einsum('bhvk,bhk->bhv', s, r_t) if readout else None
        return s, y_t
    xs = tuple(jnp.swapaxes(t, 0, 1) for t in (r, decay, k, v, kk, a))
    s, y = lax.scan(step, s0, xs, reverse=reverse)
    return s, (jnp.swapaxes(y, 0, 1) if readout else None)


def rwkv_readout(ys, r, k_dirs, v, g, r_k, gn_w, gn_b):
    b, length = r.shape[0], r.shape[1]
    y = ys[0] + ys[1]
    mu = jnp.mean(y, axis=-1, keepdims=True)
    var = jnp.mean(jnp.square(y - mu), axis=-1, keepdims=True)
    yn = ((y - mu) * lax.rsqrt(var + GN_EPS)).reshape(b, length, D_RWKV) * gn_w + gn_b
    bonus = (jnp.sum(r * k_dirs[0] * r_k, axis=-1, keepdims=True) * v
             + jnp.sum(r * k_dirs[1] * r_k, axis=-1, keepdims=True) * v)
    return (yn + bonus.reshape(b, length, D_RWKV)) * g


def gated_short_conv(p, conv_w, conv_gain):
    bg, cg, h = jnp.split(p, 3, axis=-1)
    z = cg * h
    prev = jnp.pad(z[:, :-1], ((0, 0), (1, 0), (0, 0)))
    nxt = jnp.pad(z[:, 1:], ((0, 0), (0, 1), (0, 0)))
    y = bg * (conv_w[0] * prev + conv_w[1] * z + conv_w[2] * nxt)
    return rmsnorm(y, conv_gain)


def fourier_mix(p, four_gain):
    b, length, _ = p.shape
    f = p.astype(jnp.float32).reshape(b, length, G_FOUR, FOUR_GROUP)
    y = jnp.fft.fft2(f, axes=(1, 3), norm='ortho').real.reshape(b, length, D_FOUR)
    return rmsnorm(y.astype(p.dtype), four_gain)


def assemble(p, o_rwkv, conv_w, conv_gain, four_gain, w_out):
    cut1, cut2 = D_RWKV_IN, D_RWKV_IN + 3 * D_CONV
    conv_o = gated_short_conv(p[..., cut1:cut2], conv_w, conv_gain)
    four_o = fourier_mix(p[..., cut2:], four_gain)
    return jnp.concatenate([o_rwkv.astype(p.dtype), conv_o, four_o], axis=-1) @ w_out


def token_mixers(hx, hc, w_in, mu_shift, decay_w0, decay_w2, iclr_a0, iclr_a2, gate_g2, k_k, k_a, r_k,
                 gn_w, gn_b, conv_w, conv_gain, four_gain, w_out, need_ctx):
    px = hx @ w_in
    pc = hc @ w_in
    zx = px[..., :D_RWKV_IN]
    zx = zx + (grid_shift(zx) - zx) * mu_shift
    zc = pc[..., :D_RWKV_IN]
    zc = zc + (seq_shift(zc) - zc) * mu_shift
    rx, vx, kkx, gx, dx = rwkv_streams(zx, decay_w0, decay_w2, iclr_a0, iclr_a2, gate_g2, k_k, k_a)
    rc, vc, kkc, gc, dc = rwkv_streams(zc, decay_w0, decay_w2, iclr_a0, iclr_a2, gate_g2, k_k, k_a)
    s0 = jnp.zeros((hx.shape[0], H_RWKV, HEAD, HEAD), jnp.float32)
    ys_x, ys_c = [], []
    for dn in range(2):
        rev = dn == 1
        dec_c, k_c, a_c = dc[dn]
        s_ctx, y_c = wkv7_scan(s0, rc, dec_c, k_c, vc, kkc, a_c, rev, need_ctx)
        dec_x, k_x, a_x = dx[dn]
        _, y_x = wkv7_scan(s_ctx, rx, dec_x, k_x, vx, kkx, a_x, rev, True)
        ys_x.append(y_x)
        ys_c.append(y_c)
    ox = rwkv_readout(ys_x, rx, [d[1] for d in dx], vx, gx, r_k, gn_w, gn_b)
    out_x = assemble(px, ox, conv_w, conv_gain, four_gain, w_out)
    if not need_ctx:
        return out_x, None
    oc = rwkv_readout(ys_c, rc, [d[1] for d in dc], vc, gc, r_k, gn_w, gn_b)
    out_c = assemble(pc, oc, conv_w, conv_gain, four_gain, w_out)
    return out_x, out_c


def hier_moe(h, router_g_w, router_g_b, router_e_w, router_e_b, exp_gate, exp_up, exp_down):
    n, d = h.shape
    hf = h.astype(jnp.float32)
    pg = jax.nn.softmax(hf @ router_g_w.astype(jnp.float32) + router_g_b, axis=-1)
    pg_top, grp = lax.top_k(pg, 1)
    le = (hf @ router_e_w.astype(jnp.float32) + router_e_b).reshape(n, N_GROUPS, EXPERTS_PER_GROUP)
    le_g = jnp.take_along_axis(le, grp[:, :, None], axis=1)[:, 0]
    top_l, top_i = lax.top_k(le_g, TOP_K)
    gates = pg_top * jax.nn.softmax(top_l, axis=-1)
    eid = grp * EXPERTS_PER_GROUP + top_i
    m = n * TOP_K
    flat_e = eid.reshape(m)
    flat_t = jnp.repeat(jnp.arange(n, dtype=jnp.int32), TOP_K)
    flat_w = gates.reshape(m)
    order = jnp.argsort(flat_e)
    se = flat_e[order]
    counts = jnp.bincount(flat_e, length=N_EXPERTS)
    start = jnp.cumsum(counts) - counts
    pcounts = (counts + MOE_BLOCK - 1) // MOE_BLOCK * MOE_BLOCK
    pend = jnp.cumsum(pcounts)
    pstart = pend - pcounts
    dest = pstart[se] + jnp.arange(m, dtype=jnp.int32) - start[se]
    n_blocks = -(-m // MOE_BLOCK) + N_EXPERTS
    cap = n_blocks * MOE_BLOCK
    buf_t = jnp.full((cap,), n, jnp.int32).at[dest].set(flat_t[order])
    buf_w = jnp.zeros((cap,), jnp.float32).at[dest].set(flat_w[order])
    block_e = jnp.minimum(jnp.searchsorted(pend, jnp.arange(n_blocks) * MOE_BLOCK, side='right'),
                          N_EXPERTS - 1)
    h_pad = jnp.concatenate([h, jnp.zeros((1, d), h.dtype)], axis=0)
    xb = h_pad[buf_t].reshape(n_blocks, MOE_BLOCK, d)

    def expert_block(args):
        xblk, e = args
        return (jax.nn.silu(xblk @ exp_gate[e]) * (xblk @ exp_up[e])) @ exp_down[e]

    yb = lax.map(expert_block, (xb, block_e)).reshape(cap, d)
    out = jnp.zeros((n + 1, d), jnp.float32).at[buf_t].add(yb.astype(jnp.float32) * buf_w[:, None])
    return out[:n].astype(h.dtype)


def setup_inputs(seed: int = 0) -> dict:
    key = jax.random.key(seed)
    k = jax.random.split(key, 32)
    f32 = jnp.float32
    L, D = DEPTH, D_MODEL

    def nrm(i, shape, s):
        return jax.random.normal(k[i], shape, f32) * s

    return {
        "x": nrm(0, (BATCH, SEQ, D), 1.0),
        "c": nrm(1, (BATCH, D), 1.0),
        "ctx": nrm(2, (BATCH, CTX_LEN, D), 1.0),
        "c_ctx": nrm(3, (D,), 1.0),
        "ada_w": nrm(4, (L, D, 6 * D), 0.5 * D ** -0.5),
        "ada_b": nrm(5, (L, 6 * D), 0.02),
        "norm1_g": 1.0 + nrm(6, (L, D), 0.05),
        "norm2_g": 1.0 + nrm(7, (L, D), 0.05),
        "w_in": nrm(8, (L, D, D_IN), D ** -0.5),
        "mu_shift": jax.random.uniform(k[9], (L, D_RWKV_IN), f32),
        "decay_w0": jax.random.uniform(k[10], (L, 2, D_RWKV), f32, -6.0, -1.0),
        "decay_w2": nrm(11, (L, 2, LORA_W, D_RWKV), 0.5 * LORA_W ** -0.5),
        "iclr_a0": nrm(12, (L, 2, D_RWKV), 0.1),
        "iclr_a2": nrm(13, (L, 2, LORA_A, D_RWKV), 0.5 * LORA_A ** -0.5),
        "gate_g2": nrm(14, (L, LORA_G, D_RWKV), LORA_G ** -0.5),
        "k_k": 0.85 + nrm(15, (L, D_RWKV), 0.05),
        "k_a": 1.0 + nrm(16, (L, D_RWKV), 0.05),
        "r_k": nrm(17, (L, H_RWKV, HEAD), 0.1),
        "gn_w": 1.0 + nrm(18, (L, D_RWKV), 0.05),
        "gn_b": nrm(19, (L, D_RWKV), 0.02),
        "conv_w": nrm(20, (L, CONV_W, D_CONV), 0.5),
        "conv_gain": 1.0 + nrm(21, (L, D_CONV), 0.05),
        "four_gain": 1.0 + nrm(22, (L, D_FOUR), 0.05),
        "w_out": nrm(23, (L, D, D), D ** -0.5),
        "router_g_w": nrm(24, (L, D, N_GROUPS), D ** -0.5),
        "router_g_b": nrm(25, (L, N_GROUPS), 0.01),
        "router_e_w": nrm(26, (L, D, N_EXPERTS), D ** -0.5),
        "router_e_b": nrm(27, (L, N_EXPERTS), 0.01),
        "exp_gate": nrm(28, (L, N_EXPERTS, D, D_EXPERT), D ** -0.5),
        "exp_up": nrm(29, (L, N_EXPERTS, D, D_EXPERT), D ** -0.5),
        "exp_down": nrm(30, (L, N_EXPERTS, D_EXPERT, D), D_EXPERT ** -0.5),
        "final_g": 1.0 + nrm(31, (D,), 0.05),
    }


def reference(x, c, ctx, c_ctx, ada_w, ada_b, norm1_g, norm2_g, w_in, mu_shift, decay_w0, decay_w2,
              iclr_a0, iclr_a2, gate_g2, k_k, k_a, r_k, gn_w, gn_b, conv_w, conv_gain, four_gain, w_out,
              router_g_w, router_g_b, router_e_w, router_e_b, exp_gate, exp_up, exp_down, final_g):
    bsz, seq, d = x.shape
    n_lat = bsz * seq
    for l in range(DEPTH):
        last = l == DEPTH - 1
        mod_x = jax.nn.silu(c) @ ada_w[l] + ada_b[l]
        mod_c = jax.nn.silu(c_ctx) @ ada_w[l] + ada_b[l]
        sh1x, sc1x, g1x, sh2x, sc2x, g2x = jnp.split(mod_x[:, None, :], 6, axis=-1)
        sh1c, sc1c, g1c, sh2c, sc2c, g2c = jnp.split(mod_c, 6)
        hx = rmsnorm(x, norm1_g[l]) * (1.0 + sc1x) + sh1x
        hc = rmsnorm(ctx, norm1_g[l]) * (1.0 + sc1c) + sh1c
        mx, mc = token_mixers(hx, hc, w_in[l], mu_shift[l], decay_w0[l], decay_w2[l], iclr_a0[l], iclr_a2[l],
                              gate_g2[l], k_k[l], k_a[l], r_k[l], gn_w[l], gn_b[l], conv_w[l], conv_gain[l],
                              four_gain[l], w_out[l], not last)
        x = x + g1x * mx
        hx = rmsnorm(x, norm2_g[l]) * (1.0 + sc2x) + sh2x
        moe_args = (router_g_w[l], router_g_b[l], router_e_w[l], router_e_b[l], exp_gate[l], exp_up[l], exp_down[l])
        if last:
            x = x + g2x * hier_moe(hx.reshape(n_lat, d), *moe_args).reshape(x.shape)
        else:
            ctx = ctx + g1c * mc
            hc = rmsnorm(ctx, norm2_g[l]) * (1.0 + sc2c) + sh2c
            y = hier_moe(jnp.concatenate([hx.reshape(n_lat, d), hc.reshape(-1, d)], axis=0), *moe_args)
            x = x + g2x * y[:n_lat].reshape(x.shape)
            ctx = ctx + g2c * y[n_lat:].reshape(ctx.shape)
    return rmsnorm(x, final_g)
```

```cpp
#include <hip/hip_runtime.h>
#include <hip/hip_cooperative_groups.h>
#include <cstdio>
#include <cstdint>
namespace cg = cooperative_groups;
#ifndef USE_CG_SYNC
#define USE_CG_SYNC 1
#endif
namespace pg8 {
#define PG8_LAS __attribute__((address_space(3)))
typedef unsigned short bf16_t;
typedef short bf16x8 __attribute__((ext_vector_type(8)));
typedef float f32x4 __attribute__((ext_vector_type(4)));
typedef unsigned u32x4 __attribute__((ext_vector_type(4)));
constexpr int BM = 256, BK = 64, HALF = 128, HTB = HALF * BK * 2  , STAGE_BYTES = 8 * HTB, NXCD = 8, WGM = 8;

__host__ __device__ __forceinline__ int lds_byte(int r, int c) { const int st = (r >> 4) * 2 + (c >> 5), rr = r & 15, cc = c & 31, ob = rr * 64 + cc * 2; return st * 1024 + (ob ^ (((ob >> 9) & 1) << 5)); }
__host__ __device__ __forceinline__ void stage_rc(int b, int& R, int& C) { const int st = b / 1024, sb = b % 1024, swz = sb ^ (((sb >> 9) & 1) << 5); R = (st >> 1) * 16 + swz / 64; C = (st & 1) * 32 + (swz % 64) / 2; }
__host__ __device__ __forceinline__ int perm32(int rho) { const int n = rho >> 4, i = rho & 15; return 8 * (i >> 2) + 4 * n + (i & 3); }

struct Unit { int pm, pn; };
struct Gemm { const bf16_t* A; const bf16_t* Bt; int M, N, K; };

struct StaticOrder {
    int nM, nN, nwg, G, c;
    __host__ __device__ void init(int M, int N, int G_, int c_) { nM = M / BM; nN = N / BM; nwg = nM * nN; G = G_; c = c_; }
    __host__ __device__ bool next(int i, Unit& u) const {
        const long L = (long)i * G + c; if (L >= nwg) return false;
        int wgid = (int)L; { const int q = nwg / NXCD, r = nwg % NXCD, xcd = wgid % NXCD, off = wgid / NXCD; wgid = (xcd < r ? xcd * (q + 1) : r * (q + 1) + (xcd - r) * q) + off; }
        const int nig = WGM * nN, gid = wgid / nig, fm = gid * WGM, gsz = (nM - fm) < WGM ? (nM - fm) : WGM;
        u.pm = fm + ((wgid % nig) % gsz); u.pn = (wgid % nig) / gsz; return true;
    }
    __device__ __forceinline__ void a_ready(const Unit&) const {}
    __device__ __forceinline__ void done(const Unit&) const {}
};

__device__ __forceinline__ unsigned cvt_pk_bf16(float lo, float hi) { unsigned r; asm volatile("v_cvt_pk_bf16_f32 %0, %1, %2" : "=v"(r) : "v"(lo), "v"(hi)); return r; }
typedef float f32x2 __attribute__((ext_vector_type(2)));
template <class Epi, class Sched, bool ALIGN_EPI = false, bool SP2 = false>
__device__ __forceinline__ void gemm_phase(PG8_LAS unsigned char* lds, const Gemm g, const Sched& S, const Epi& E) {
    int tid = threadIdx.x; asm volatile("" : "+v"(tid));
    const int wid = __builtin_amdgcn_readfirstlane(tid >> 6), lane = tid & 63, wr = wid >> 2, wc = wid & 3, fr = lane & 15, fq = lane >> 4;
    const int K = g.K, nt = K / BK;
    unsigned voffA[2], voffB[2];
#pragma unroll
    for (int i = 0; i < 2; ++i) { int R, C; stage_rc(tid * 16 + i * 8192, R, C); const int Rb = Epi::PERM ? ((R & ~31) + perm32(R & 31)) : R;
        voffA[i] = (unsigned)(R * K + C) * 2u; voffB[i] = (unsigned)(Rb * K + C) * 2u; }
    const size_t kstep = (size_t)(BK * 2);
    const size_t hstep = (size_t)HALF * K * 2;
    const size_t tstep = 2 * hstep;
    const unsigned ldsw = (unsigned)wid * 1024u;
    const int aoff = lds_byte(wr * 64 + fr, fq * 8), boff = lds_byte(wc * 32 + fr, fq * 8);
#define PG8_SA(b, h) (((b) * 2 + (h)) * HTB)
#define PG8_SB(b, h) ((4 + (b) * 2 + (h)) * HTB)
#define PG8_STAGE(bufoff, gbase, voff) do { _Pragma("unroll") for (int _i = 0; _i < 2; ++_i) \
        __builtin_amdgcn_global_load_lds((const unsigned*)((const char*)(gbase) + (voff)[_i]), (PG8_LAS unsigned*)(lds + (bufoff) + ldsw + _i * 8192), 16, 0, 0); } while (0)
#define PG8_LDA(dst, b, h) do { _Pragma("unroll") for (int m = 0; m < 4; ++m) _Pragma("unroll") for (int k = 0; k < 2; ++k) dst[m][k] = *(const PG8_LAS bf16x8*)(lds + PG8_SA(b, h) + aoff + m * 2048 + k * 1024); } while (0)
#define PG8_LDB(dst, b, h) do { _Pragma("unroll") for (int n = 0; n < 2; ++n) _Pragma("unroll") for (int k = 0; k < 2; ++k) dst[n][k] = *(const PG8_LAS bf16x8*)(lds + PG8_SB(b, h) + boff + n * 2048 + k * 1024); } while (0)
#define PG8_MMA(ai, bj, At, Bt) do { __builtin_amdgcn_s_setprio(1); _Pragma("unroll") for (int m = 0; m < 4; ++m) _Pragma("unroll") for (int n = 0; n < 2; ++n) _Pragma("unroll") for (int k = 0; k < 2; ++k) \
        acc[ai][bj][m][n] = __builtin_amdgcn_mfma_f32_16x16x32_bf16(Bt[n][k], At[m][k], acc[ai][bj][m][n], 0, 0, 0); __builtin_amdgcn_s_setprio(0); } while (0)
#define PG8_WAIT_V(n) asm volatile("s_waitcnt vmcnt(" #n ")" ::: "memory")
#define PG8_WAIT_L(n) asm volatile("s_waitcnt lgkmcnt(" #n ")" ::: "memory")
#define PG8_BAR __builtin_amdgcn_s_barrier()
#define PG8_SCHED __builtin_amdgcn_sched_barrier(0)
    Unit cur, nxt; int ui = 0;
    if (!S.next(0, cur)) return;
    f32x4 acc[2][2][4][2];
#pragma unroll
    for (int a = 0; a < 2; ++a)
#pragma unroll
        for (int b = 0; b < 2; ++b)
#pragma unroll
            for (int m = 0; m < 4; ++m)
#pragma unroll
                for (int n = 0; n < 2; ++n) acc[a][b][m][n] = (f32x4){0.f, 0.f, 0.f, 0.f};
    bf16x8 At[4][2], B0[2][2], B1[2][2];
    const char* cA = (const char*)g.A + (size_t)cur.pm * tstep; const char* cB = (const char*)g.Bt + (size_t)cur.pn * tstep;
    S.a_ready(cur);
    if constexpr (SP2) {
        PG8_STAGE(PG8_SB(0, 0), cB, voffB); PG8_STAGE(PG8_SB(0, 1), cB + hstep, voffB); PG8_STAGE(PG8_SA(0, 0), cA, voffA); PG8_STAGE(PG8_SA(0, 1), cA + hstep, voffA);
        if (wr == 1) PG8_BAR;
        PG8_WAIT_V(2); PG8_BAR;
        PG8_STAGE(PG8_SB(1, 0), cB + kstep, voffB); PG8_STAGE(PG8_SA(1, 0), cA + kstep, voffA); PG8_STAGE(PG8_SB(1, 1), cB + hstep + kstep, voffB);
        PG8_WAIT_V(6); PG8_BAR;
    } else {
        PG8_STAGE(PG8_SB(0, 0), cB, voffB); PG8_STAGE(PG8_SA(0, 0), cA, voffA); PG8_STAGE(PG8_SB(0, 1), cB + hstep, voffB); PG8_STAGE(PG8_SA(0, 1), cA + hstep, voffA);
        if (wr == 1) PG8_BAR;
        PG8_WAIT_V(4); PG8_BAR;
        PG8_STAGE(PG8_SB(1, 0), cB + kstep, voffB); PG8_STAGE(PG8_SA(1, 0), cA + kstep, voffA); PG8_STAGE(PG8_SB(1, 1), cB + hstep + kstep, voffB);
        PG8_WAIT_V(6); PG8_BAR;
    }
    for (;;) {
        const bool has_next = S.next(ui + 1, nxt);
        const char* nA = has_next ? (const char*)g.A + (size_t)nxt.pm * tstep : cA; const char* nB = has_next ? (const char*)g.Bt + (size_t)nxt.pn * tstep : cB;
        for (int t = 0; t < nt; t += 2) {
            const bool last = (t == nt - 2);
            const char* a1 = cA + (size_t)(t + 1) * kstep;
            const char* a2 = last ? nA : cA + (size_t)(t + 2) * kstep; const char* b2 = last ? nB : cB + (size_t)(t + 2) * kstep;
            const char* a3 = a2 + kstep; const char* b3 = b2 + kstep;
            if (last && has_next) S.a_ready(nxt);
            if constexpr (SP2) {
            PG8_LDB(B0, 0, 0); PG8_LDB(B1, 0, 1); PG8_SCHED; PG8_LDA(At, 0, 0); PG8_STAGE(PG8_SA(1, 1), a1 + hstep, voffA);
            PG8_WAIT_V(8); PG8_WAIT_L(0); PG8_BAR; PG8_MMA(0, 0, At, B0); PG8_MMA(0, 1, At, B1); PG8_BAR; PG8_SCHED;
            PG8_LDA(At, 0, 1); PG8_STAGE(PG8_SB(0, 0), b2, voffB); PG8_STAGE(PG8_SB(0, 1), b2 + hstep, voffB); PG8_STAGE(PG8_SA(0, 0), a2, voffA);
            PG8_WAIT_V(8); PG8_WAIT_L(0); PG8_BAR; PG8_MMA(1, 0, At, B0); PG8_MMA(1, 1, At, B1); PG8_BAR; PG8_SCHED;
            PG8_LDB(B0, 1, 0); PG8_LDB(B1, 1, 1); PG8_SCHED; PG8_LDA(At, 1, 0); PG8_STAGE(PG8_SA(0, 1), a2 + hstep, voffA);
            PG8_WAIT_V(8); PG8_WAIT_L(0); PG8_BAR; PG8_MMA(0, 0, At, B0); PG8_MMA(0, 1, At, B1); PG8_BAR; PG8_SCHED;
            PG8_LDA(At, 1, 1); PG8_STAGE(PG8_SB(1, 0), b3, voffB); PG8_STAGE(PG8_SB(1, 1), b3 + hstep, voffB); PG8_STAGE(PG8_SA(1, 0), a3, voffA);
            PG8_WAIT_V(8); PG8_WAIT_L(0); PG8_BAR; PG8_MMA(1, 0, At, B0); PG8_MMA(1, 1, At, B1); PG8_BAR; PG8_SCHED;
            } else {
            PG8_LDB(B0, 0, 0); PG8_SCHED; PG8_LDA(At, 0, 0); PG8_STAGE(PG8_SA(1, 1), a1 + hstep, voffA);
            PG8_WAIT_L(8); PG8_BAR; PG8_WAIT_L(0); PG8_MMA(0, 0, At, B0); PG8_BAR; PG8_SCHED;
            PG8_LDB(B1, 0, 1); PG8_STAGE(PG8_SB(0, 0), b2, voffB);
            PG8_BAR; PG8_WAIT_L(0); PG8_MMA(0, 1, At, B1); PG8_BAR;
            PG8_LDA(At, 0, 1); PG8_STAGE(PG8_SA(0, 0), a2, voffA);
            PG8_BAR; PG8_WAIT_L(0); PG8_MMA(1, 0, At, B0); PG8_BAR; PG8_SCHED;
            PG8_STAGE(PG8_SB(0, 1), b2 + hstep, voffB);
            PG8_WAIT_V(6); PG8_BAR; PG8_MMA(1, 1, At, B1); PG8_BAR;
            PG8_LDB(B0, 1, 0); PG8_SCHED; PG8_LDA(At, 1, 0); PG8_STAGE(PG8_SA(0, 1), a2 + hstep, voffA);
            PG8_WAIT_L(8); PG8_BAR; PG8_WAIT_L(0); PG8_MMA(0, 0, At, B0); PG8_BAR; PG8_SCHED;
            PG8_LDB(B1, 1, 1); PG8_STAGE(PG8_SB(1, 0), b3, voffB);
            PG8_BAR; PG8_WAIT_L(0); PG8_MMA(0, 1, At, B1); PG8_BAR;
            PG8_LDA(At, 1, 1); PG8_STAGE(PG8_SA(1, 0), a3, voffA);
            PG8_BAR; PG8_WAIT_L(0); PG8_MMA(1, 0, At, B0); PG8_BAR; PG8_SCHED;
            PG8_STAGE(PG8_SB(1, 1), b3 + hstep, voffB);
            PG8_WAIT_V(6); PG8_BAR; PG8_MMA(1, 1, At, B1); PG8_BAR;
            }
        }
        if constexpr (ALIGN_EPI) { if (wr == 0) PG8_BAR; }
        if constexpr (!Epi::AFTER_DRAIN) { E(acc, cur, wr, wc, fr, fq); S.done(cur); }
        if (!has_next) break;
#pragma unroll
        for (int a = 0; a < 2; ++a)
#pragma unroll
            for (int b = 0; b < 2; ++b)
#pragma unroll
                for (int m = 0; m < 4; ++m)
#pragma unroll
                    for (int n = 0; n < 2; ++n) acc[a][b][m][n] = (f32x4){0.f, 0.f, 0.f, 0.f};
        cur = nxt; cA = nA; cB = nB; ++ui;
        if constexpr (ALIGN_EPI) { if (wr == 1) PG8_BAR; }
    }
    PG8_WAIT_V(0);
    if constexpr (!ALIGN_EPI) { if (wr == 0) PG8_BAR; }
    PG8_BAR;
    if constexpr (Epi::AFTER_DRAIN) { E.fused(acc, cur, wr, wc, fr, fq, lds, wid, lane); S.done(cur); }
#undef PG8_SA
#undef PG8_SB
#undef PG8_STAGE
#undef PG8_LDA
#undef PG8_LDB
#undef PG8_MMA
#undef PG8_WAIT_V
#undef PG8_WAIT_L
#undef PG8_BAR
#undef PG8_SCHED
}
}
#define LAS __attribute__((address_space(3)))
typedef unsigned short bf16;
typedef float f32x4 __attribute__((ext_vector_type(4)));
typedef short bf16x8 __attribute__((ext_vector_type(8)));
typedef unsigned u32x4 __attribute__((ext_vector_type(4)));
typedef unsigned u32x2 __attribute__((ext_vector_type(2)));

constexpr int D = 1024, NBATCH = 2, SEQ = 8192, CTXL = 256, DEPTH = 2;
constexpr int NLAT = NBATCH * SEQ, NCTX = NBATCH * CTXL, NROW = NLAT + NCTX;
constexpr int DR = 512, DIN = 2944, NP = 3328, ZW = 1920, NHEAD = 8;
constexpr int COL_CONV = 1920, COL_FC = 2688, COL_FS = 2944;
constexpr int STRW = 5120;
constexpr int NEXP = 32, DEXP = 512;
constexpr int MOE_MAXTILES = 168;
constexpr float RMS_EPS = 1e-6f, GN_EPS = 64e-5f;

enum { I_X = 0, I_C, I_CTX, I_CCTX, I_ADAW, I_ADAB, I_N1G, I_N2G, I_WIN, I_MU, I_DW0, I_DW2, I_IA0, I_IA2, I_GG2, I_KK, I_KA, I_RK, I_GNW, I_GNB,
       I_CONVW, I_CONVG, I_FOURG, I_WOUT, I_RGW, I_RGB, I_REW, I_REB, I_EG, I_EU, I_ED, I_FG, N_IN };

constexpr size_t MiB = 1u << 20;
constexpr size_t WS_CTL = 0, CTL_ZERO_BYTES = 1 * MiB;
constexpr size_t WS_MODP = 1 * MiB;
constexpr size_t WS_MODF = 1 * MiB + 1280 * 1024;
constexpr size_t WS_WIN_T = 3 * MiB;
constexpr size_t WS_WOUT_T = 16 * MiB;
constexpr size_t WS_WGU_T = 20 * MiB;
constexpr size_t WS_WD_T = 84 * MiB;
constexpr size_t WS_X = 116 * MiB;
constexpr size_t WS_H = 182 * MiB;
constexpr size_t WS_ZS = 215 * MiB;
constexpr size_t WS_P = 277 * MiB;
constexpr size_t WS_STR = 277 * MiB;
constexpr size_t WS_Y = 442 * MiB;
constexpr size_t WS_GT = 475 * MiB;
constexpr size_t WS_ROUTE = 491 * MiB;
constexpr size_t WS_XS = 215 * MiB;
constexpr size_t WS_ACT = 299 * MiB;
constexpr size_t WS_END = 492 * MiB;
constexpr size_t RT_E = 0, RT_POS = 1 * 33792 * 4, RT_GATE = 2 * 33792 * 4, RT_SLOT = 3 * 33792 * 4, RT_TILE = 4 * 33792 * 4, RT_NT = RT_TILE + 1024;

constexpr int CW_BAR = 4096;
constexpr int CW_CNT = 8192;

constexpr int NWAVES = 8, NTHR = 512;
constexpr int RING_BYTES = 131072, LDSCTL_OFF = RING_BYTES, MISC_OFF = LDSCTL_OFF + 320, LDS_BYTES = 147456;

struct Params { const float* in[N_IN]; float* out; unsigned char* ws; };

__device__ __forceinline__ float bf2f(unsigned h) { return __uint_as_float(h << 16); }
__device__ __forceinline__ unsigned f2bf(float f) { unsigned u = __float_as_uint(f); return (u + 0x7fffu + ((u >> 16) & 1u)) >> 16; }
__device__ __forceinline__ unsigned pk2(float lo, float hi) { return f2bf(lo) | (f2bf(hi) << 16); }
__device__ __forceinline__ float wave_sum(float v) {
#pragma unroll
    for (int o = 1; o < 64; o <<= 1) v += __shfl_xor(v, o);
    return v;
}
__device__ __forceinline__ float sigmoidf_(float x) { return 1.f / (1.f + __expf(-x)); }
#define LDS_WAIT() asm volatile("s_waitcnt lgkmcnt(0)" ::: "memory")
#define VM_WAIT() asm volatile("s_waitcnt vmcnt(0)" ::: "memory")

struct Frame {
    LAS unsigned char* lds;
    int tid, lane, wave, vcu, G, gw, NGW;
    float* out; unsigned char* ws;
};
__device__ __forceinline__ const float* inptr(int i) {
    const volatile unsigned long long __attribute__((address_space(4)))* ka = (const volatile unsigned long long __attribute__((address_space(4)))*)__builtin_amdgcn_kernarg_segment_ptr();
    return (const float*)ka[i];
}
__device__ __forceinline__ unsigned char* opaque(unsigned char* p) { asm volatile("" : "+s"(p)); return p; }
__device__ __forceinline__ Frame phase_frame(const Frame& F0) { Frame F = F0; asm volatile("" : "+v"(F.tid)); F.lane = F.tid & 63; F.ws = opaque(F0.ws);
    asm volatile("" : "+s"(F.G), "+s"(F.vcu)); F.gw = F.vcu * NWAVES + F.wave; F.NGW = F.G * NWAVES; return F; }
__device__ __forceinline__ int modrow(int row) { return row < NLAT ? (row >> 13) : 2; }
#define XB_TMO      128
#define XB_XCNT(j)  (256  + 64 * (j))
#define XB_XSUB(j)  (1280 + 64 * (j))
#define XB_XGEN(j)  (2304 + 64 * (j))
#define XB_TOP      3328
#define XB_TOPGEN   3392
#define XCD_BAR_WORDS 3456
#define XB_SPIN_CAP (1u << 18)

__device__ __forceinline__ unsigned xb_ld(unsigned* p)              { return __hip_atomic_load(p, __ATOMIC_RELAXED, __HIP_MEMORY_SCOPE_AGENT); }
__device__ __forceinline__ unsigned xb_add(unsigned* p, unsigned v) { return __hip_atomic_fetch_add(p, v, __ATOMIC_RELAXED, __HIP_MEMORY_SCOPE_AGENT); }
__device__ __forceinline__ unsigned xb_xcc_id() { return (unsigned)__builtin_amdgcn_s_getreg((3 << 11) | 20) & 0xFu; }
#define XB_SPIN(cond, bar) do { unsigned _sp = 0; while (cond) { __builtin_amdgcn_s_sleep(1); \
    if ((++_sp & 255u) == 0u) { if (xb_ld(&(bar)[XB_TMO])) break; if (_sp > XB_SPIN_CAP) { atomicAdd(&(bar)[XB_TMO], 1u); break; } } } } while (0)

struct XcdBarrier {
    unsigned* bar; unsigned x;
    volatile LAS unsigned* st;
};

__device__ __forceinline__ XcdBarrier xcd_barrier_post(unsigned* bar, volatile LAS unsigned* st) {
    XcdBarrier b; b.bar = bar; b.x = xb_xcc_id(); b.st = st;
    if (threadIdx.x == 0) (void)xb_add(&bar[XB_XCNT(b.x)], 1u);
    return b;
}
__device__ __forceinline__ void xcd_barrier_complete(unsigned* bar, unsigned x, unsigned& nloc, unsigned& nx) {
    const unsigned G = gridDim.x * gridDim.y * gridDim.z;
    unsigned sum, cnt, mine, sp = 0u;
    for (;;) {
        sum = 0u; cnt = 0u; mine = 0u;
#pragma nounroll
        for (unsigned j = 0; j < 16; ++j) { const unsigned c = xb_ld(&bar[XB_XCNT(j)]); sum += c; cnt += (c > 0u) ? 1u : 0u; mine = (j == x) ? c : mine; }
        if (sum == G) break;
        __builtin_amdgcn_s_sleep(1);
        if ((++sp & 255u) == 0u) { if (xb_ld(&bar[XB_TMO])) break; if (sp > XB_SPIN_CAP) { atomicAdd(&bar[XB_TMO], 1u); break; } }
    }
    nloc = mine > 0u ? mine : 1u; nx = cnt > 0u ? cnt : 1u;
}

__device__ __forceinline__ void xcd_barrier(const XcdBarrier& b) {
    asm volatile("s_waitcnt vmcnt(0)" ::: "memory");
    __syncthreads();
    if (threadIdx.x == 0) {
        unsigned* bar = b.bar;
        asm volatile("" : "+s"(bar));
        __builtin_amdgcn_s_waitcnt(0);
        unsigned nloc = b.st[0], nx = b.st[1];
        if (nloc == 0u) { xcd_barrier_complete(bar, b.x, nloc, nx); b.st[0] = nloc; b.st[1] = nx; }
        const unsigned old = xb_add(&bar[XB_XSUB(b.x)], 1u);
        const unsigned gen = old / nloc;
        if (old + 1u == (gen + 1u) * nloc) {
            __builtin_amdgcn_fence(__ATOMIC_RELEASE, "agent");
            asm volatile("s_waitcnt vmcnt(0)" ::: "memory");
            const unsigned og = xb_add(&bar[XB_TOP], 1u);
            const unsigned tg = og / nx;
            if (og + 1u == (tg + 1u) * nx) xb_add(&bar[XB_TOPGEN], 1u);
            else XB_SPIN(xb_ld(&bar[XB_TOPGEN]) == tg, bar);
            __builtin_amdgcn_fence(__ATOMIC_ACQUIRE, "agent");
            xb_add(&bar[XB_XGEN(b.x)], 1u);
            asm volatile("s_waitcnt vmcnt(0)" ::: "memory");
        } else {
            XB_SPIN(xb_ld(&bar[XB_XGEN(b.x)]) == gen, bar);
            __builtin_amdgcn_fence(__ATOMIC_ACQUIRE, "agent");
            asm volatile("s_waitcnt vmcnt(0)" ::: "memory");
        }
    }
    __syncthreads();
}
template <class RowMap>
__device__ __forceinline__ void transpose_item(const float* W, int ldw, int k0, int n0, bf16* WT, int ldt, RowMap rm, LAS float* scr, int lane) {
#pragma unroll 8
    for (int i = 0; i < 32; ++i) { const int kk = 2 * i + (lane >> 5); scr[kk * 33 + (lane & 31)] = W[(size_t)(k0 + kk) * ldw + n0 + (lane & 31)]; }
    LDS_WAIT(); asm volatile("" ::: "memory");
    const int c = lane & 7;
#pragma unroll
    for (int j = 0; j < 4; ++j) { const int n = (lane >> 3) + 8 * j; const LAS float* s = scr + (8 * c) * 33 + n;
        u32x4 o; o.x = pk2(s[0 * 33], s[1 * 33]); o.y = pk2(s[2 * 33], s[3 * 33]); o.z = pk2(s[4 * 33], s[5 * 33]); o.w = pk2(s[6 * 33], s[7 * 33]);
        *(u32x4*)(WT + (size_t)rm(n0 + n) * ldt + k0 + 8 * c) = o; }
    LDS_WAIT(); asm volatile("" ::: "memory");
}
struct RmId { int off; __device__ __forceinline__ int operator()(int n) const { return off + n; } };
struct RmGU { int off; __device__ __forceinline__ int operator()(int n) const { return off + ((n >> 2) << 3) + (n & 3); } };

__device__ __forceinline__ void p0_prologue(const Frame& F0) {
    const Frame F = phase_frame(F0); unsigned char* const ws = F.ws;
    LAS float* scr = (LAS float*)(F.lds + F.wave * 16384);
    LAS float* ctab = (LAS float*)(F.lds + 8 * 16384);
    if (F.tid < 64) ctab[F.tid] = cosf((float)F.tid * (6.283185307179586f / 64.f));
    __syncthreads();
    bf16* win_t = (bf16*)(ws + WS_WIN_T); bf16* wout_t = (bf16*)(ws + WS_WOUT_T);
    constexpr int I_WIN_L = 16 * 84, I_WOUT_L = 16 * 32, I_FOLD_L = 4 * 64, I_MOD_L = 96 * 8;
    constexpr int NIT = 2 * (I_WIN_L + I_WOUT_L + I_FOLD_L + I_MOD_L);
    const float* p_win = inptr(I_WIN); const float* p_wout = inptr(I_WOUT); const float* p_c = inptr(I_C); const float* p_cctx = inptr(I_CCTX); const float* p_adaw = inptr(I_ADAW);
    for (int it = F.gw; it < NIT; it += F.NGW) {
        int r = it; const int l = r & 1; r >>= 1;
        if (r < I_WIN_L) { const int kb = r / 84, nb = r % 84;
            transpose_item(p_win + (size_t)l * D * DIN, DIN, kb * 64, nb * 32, win_t + (size_t)l * NP * D, D, RmId{0}, scr, F.lane); continue; }
        r -= I_WIN_L;
        if (r < I_WOUT_L) { const int kb = r / 32, nb = r % 32;
            transpose_item(p_wout + (size_t)l * D * D, D, kb * 64, nb * 32, wout_t + (size_t)l * D * D, D, RmId{0}, scr, F.lane); continue; }
        r -= I_WOUT_L;
        if (r < I_FOLD_L) {
            const int g = r >> 6, k0 = (r & 63) * 16; const float* W = p_win + (size_t)l * D * DIN;
#pragma unroll
            for (int kk = 0; kk < 16; ++kk) scr[kk * 64 + F.lane] = W[(size_t)(k0 + kk) * DIN + 2688 + g * 64 + F.lane];
            LDS_WAIT(); asm volatile("" ::: "memory");
            float ac[16], as[16];
#pragma unroll
            for (int kk = 0; kk < 16; ++kk) { ac[kk] = 0.f; as[kk] = 0.f; }
            for (int c = 0; c < 64; ++c) { const int idx = (c * F.lane) & 63; const float cc = ctab[idx], ss = ctab[(idx - 16) & 63];
#pragma unroll
                for (int kk = 0; kk < 16; ++kk) { const float w = scr[kk * 64 + c]; ac[kk] += w * cc; as[kk] += w * ss; } }
            bf16* oc = win_t + (size_t)l * NP * D + (size_t)(COL_FC + g * 64 + F.lane) * D + k0;
            bf16* os = win_t + (size_t)l * NP * D + (size_t)(COL_FS + g * 64 + F.lane) * D + k0;
            u32x4 a, b;
            a.x = pk2(ac[0], ac[1]); a.y = pk2(ac[2], ac[3]); a.z = pk2(ac[4], ac[5]); a.w = pk2(ac[6], ac[7]);
            b.x = pk2(ac[8], ac[9]); b.y = pk2(ac[10], ac[11]); b.z = pk2(ac[12], ac[13]); b.w = pk2(ac[14], ac[15]);
            *(u32x4*)oc = a; *(u32x4*)(oc + 8) = b;
            a.x = pk2(as[0], as[1]); a.y = pk2(as[2], as[3]); a.z = pk2(as[4], as[5]); a.w = pk2(as[6], as[7]);
            b.x = pk2(as[8], as[9]); b.y = pk2(as[10], as[11]); b.z = pk2(as[12], as[13]); b.w = pk2(as[14], as[15]);
            *(u32x4*)os = a; *(u32x4*)(os + 8) = b;
            LDS_WAIT(); asm volatile("" ::: "memory");
            continue; }
        r -= I_FOLD_L;
        {
            const int cb = r >> 3, ks = r & 7;
#pragma unroll
            for (int q = 0; q < 2; ++q) { const int k = ks * 128 + q * 64 + F.lane;
                const float c0 = p_c[k], c1 = p_c[D + k], c2 = p_cctx[k];
                scr[0 * 128 + q * 64 + F.lane] = c0 * sigmoidf_(c0); scr[1 * 128 + q * 64 + F.lane] = c1 * sigmoidf_(c1); scr[2 * 128 + q * 64 + F.lane] = c2 * sigmoidf_(c2); }
            LDS_WAIT(); asm volatile("" ::: "memory");
            const float* W = p_adaw + (size_t)l * D * 6144 + (size_t)(ks * 128) * 6144 + cb * 64 + F.lane;
            float a0 = 0.f, a1 = 0.f, a2 = 0.f;
#pragma unroll 8
            for (int kk = 0; kk < 128; ++kk) { const float w = W[(size_t)kk * 6144]; a0 += scr[kk] * w; a1 += scr[128 + kk] * w; a2 += scr[256 + kk] * w; }
            float* mp = (float*)(ws + WS_MODP) + (size_t)((l * 8 + ks) * 3) * 6144 + cb * 64 + F.lane;
            mp[0] = a0; mp[6144] = a1; mp[2 * 6144] = a2;
            LDS_WAIT(); asm volatile("" ::: "memory");
        }
    }
}

__device__ __forceinline__ void mod_to_lds(const Frame& F0, int l, int p, LAS float* dst, bool from_partials) {
    const Frame F = phase_frame(F0); unsigned char* const ws = F.ws;
    const float* adab = inptr(I_ADAB);
    for (int idx = F.tid; idx < 3 * 1024; idx += NTHR) { const int r = idx >> 10, n = idx & 1023;
        float v;
        if (from_partials) { v = adab[l * 6144 + p * 1024 + n]; const float* mp = (const float*)(ws + WS_MODP) + (size_t)(l * 8 * 3 + r) * 6144 + p * 1024 + n;
#pragma unroll
            for (int ks = 0; ks < 8; ++ks) v += mp[(size_t)ks * 3 * 6144]; }
        else v = ((const float*)(ws + WS_MODF))[(size_t)(l * 3 + r) * 6144 + p * 1024 + n];
        dst[idx] = v; }
}
__device__ __forceinline__ void mod_finalize(const Frame& F0) {
    const Frame F = phase_frame(F0); unsigned char* const ws = F.ws;
    const float* adab = inptr(I_ADAB);
    for (int idx = F.vcu * NTHR + F.tid; idx < 2 * 3 * 6144; idx += F.G * NTHR) { const int l = idx / (3 * 6144), rem = idx % (3 * 6144), r = rem / 6144, n = rem % 6144;
        float v = adab[l * 6144 + n]; const float* mp = (const float*)(ws + WS_MODP) + (size_t)(l * 8 * 3 + r) * 6144 + n;
#pragma unroll
        for (int ks = 0; ks < 8; ++ks) v += mp[(size_t)ks * 3 * 6144];
        ((float*)(ws + WS_MODF))[idx] = v; }
}


__device__ __forceinline__ void norm_mod_row(f32x4 (&v)[4], const float* gain, const LAS float* sc, const LAS float* sh, bf16* orow, int lane) {
    float s = 0.f;
#pragma unroll
    for (int j = 0; j < 4; ++j) s += (v[j].x * v[j].x + v[j].y * v[j].y) + (v[j].z * v[j].z + v[j].w * v[j].w);
    const float rs = rsqrtf(wave_sum(s) * (1.f / D) + RMS_EPS);
#pragma unroll
    for (int j = 0; j < 4; ++j) { const int c = 4 * lane + 256 * j; const f32x4 g = *(const f32x4*)(gain + c); const f32x4 a = *(const LAS f32x4*)(sc + c), b = *(const LAS f32x4*)(sh + c);
        v[j] = (v[j] * rs) * g * (a + 1.f) + b;
        u32x2 w; w.x = pk2(v[j].x, v[j].y); w.y = pk2(v[j].z, v[j].w); *(u32x2*)(orow + c) = w; }
}

__device__ __forceinline__ void p0b_norm1(const Frame& F0) {
    const Frame F = phase_frame(F0); unsigned char* const ws = F.ws;
    LAS float* msh = (LAS float*)F.lds; LAS float* msc = msh + 3072;
    mod_to_lds(F, 0, 0, msh, true); mod_to_lds(F, 0, 1, msc, true); __syncthreads();
    mod_finalize(F);
    bf16* H = (bf16*)(ws + WS_H); const float* xin = inptr(I_X); const float* cin = inptr(I_CTX); const float* n1g = inptr(I_N1G);
    for (int row = F.gw; row < NROW; row += F.NGW) { const float* xr = row < NLAT ? xin + (size_t)row * D : cin + (size_t)(row - NLAT) * D; f32x4 v[4];
#pragma unroll
        for (int j = 0; j < 4; ++j) v[j] = *(const f32x4*)(xr + 4 * F.lane + 256 * j);
        const int mr = modrow(row);
        norm_mod_row(v, n1g, msc + mr * 1024, msh + mr * 1024, H + (size_t)row * D, F.lane); }
}
__device__ __forceinline__ void unpack8(const u32x4 w, float (&o)[8]) {
    o[0] = bf2f(w.x & 0xffffu); o[1] = bf2f(w.x >> 16); o[2] = bf2f(w.y & 0xffffu); o[3] = bf2f(w.y >> 16);
    o[4] = bf2f(w.z & 0xffffu); o[5] = bf2f(w.z >> 16); o[6] = bf2f(w.w & 0xffffu); o[7] = bf2f(w.w >> 16);
}
__device__ __forceinline__ void unpack4(const u32x2 w, float (&o)[4]) { o[0] = bf2f(w.x & 0xffffu); o[1] = bf2f(w.x >> 16); o[2] = bf2f(w.y & 0xffffu); o[3] = bf2f(w.y >> 16); }

__device__ __forceinline__ void shift_pass(const Frame& F0, int l) {
    const Frame F = phase_frame(F0); unsigned char* const ws = F.ws;
    const bf16* P = (const bf16*)(ws + WS_P); bf16* Zs = (bf16*)(ws + WS_ZS); const float* mu = inptr(I_MU) + l * ZW;
    const int total = NROW * 240;
    for (int idx = F.vcu * NTHR + F.tid; idx < total; idx += F.G * NTHR) {
        const int row = idx / 240, ck = idx % 240; const bf16* pr = P + (size_t)row * NP + ck * 8;
        const u32x4 zero = {0u, 0u, 0u, 0u};
        float z[8], n0[8], n1[8], n2[8], n3[8], o[8];
        unpack8(*(const u32x4*)pr, z);
        if (row < NLAT) { const int t = row & (SEQ - 1), gr = t >> 6, gc = t & 63;
            unpack8(gc > 0 ? *(const u32x4*)(pr - NP) : zero, n0); unpack8(gc < 63 ? *(const u32x4*)(pr + NP) : zero, n1);
            unpack8(gr > 0 ? *(const u32x4*)(pr - 64 * NP) : zero, n2); unpack8(gr < 127 ? *(const u32x4*)(pr + 64 * NP) : zero, n3);
        } else { const int tc = (row - NLAT) & (CTXL - 1);
            unpack8(tc > 0 ? *(const u32x4*)(pr - NP) : zero, n0); unpack8(tc < CTXL - 1 ? *(const u32x4*)(pr + NP) : zero, n1);
#pragma unroll
            for (int j = 0; j < 8; ++j) { n2[j] = n0[j]; n3[j] = n1[j]; }
        }
        const f32x4 m0 = *(const f32x4*)(mu + ck * 8), m1 = *(const f32x4*)(mu + ck * 8 + 4);
        const float m[8] = {m0.x, m0.y, m0.z, m0.w, m1.x, m1.y, m1.z, m1.w};
#pragma unroll
        for (int j = 0; j < 8; ++j) { const float nb = (j & 3) == 0 ? n0[j] : (j & 3) == 1 ? n1[j] : (j & 3) == 2 ? n2[j] : n3[j]; o[j] = z[j] + (nb - z[j]) * m[j]; }
        u32x4 w; w.x = pk2(o[0], o[1]); w.y = pk2(o[2], o[3]); w.z = pk2(o[4], o[5]); w.w = pk2(o[6], o[7]);
        *(u32x4*)(Zs + (size_t)row * ZW + ck * 8) = w;
    }
}

__device__ __forceinline__ void conv_pass(const Frame& F0, int l, int nrows) {
    const Frame F = phase_frame(F0); unsigned char* const ws = F.ws;
    const bf16* P = (const bf16*)(ws + WS_P); bf16* MA = (bf16*)(ws + WS_H);
    const float* cw = inptr(I_CONVW) + l * 3 * 256; const int c = 4 * F.lane;
    const f32x4 w0 = *(const f32x4*)(cw + c), w1 = *(const f32x4*)(cw + 256 + c), w2 = *(const f32x4*)(cw + 512 + c), gn = *(const f32x4*)(inptr(I_CONVG) + l * 256 + c);
    for (int row = F.gw; row < nrows; row += F.NGW) {
        int t, L; if (row < NLAT) { t = row & (SEQ - 1); L = SEQ; } else { t = (row - NLAT) & (CTXL - 1); L = CTXL; }
        const bf16* pr = P + (size_t)row * NP + COL_CONV + c;
        float bg[4], cg[4], hh[4], cp[4], hp[4], cn[4], hn[4]; const u32x2 zero = {0u, 0u};
        unpack4(*(const u32x2*)pr, bg); unpack4(*(const u32x2*)(pr + 256), cg); unpack4(*(const u32x2*)(pr + 512), hh);
        unpack4(t > 0 ? *(const u32x2*)(pr - NP + 256) : zero, cp); unpack4(t > 0 ? *(const u32x2*)(pr - NP + 512) : zero, hp);
        unpack4(t < L - 1 ? *(const u32x2*)(pr + NP + 256) : zero, cn); unpack4(t < L - 1 ? *(const u32x2*)(pr + NP + 512) : zero, hn);
        const float W0[4] = {w0.x, w0.y, w0.z, w0.w}, W1[4] = {w1.x, w1.y, w1.z, w1.w}, W2[4] = {w2.x, w2.y, w2.z, w2.w}, GN[4] = {gn.x, gn.y, gn.z, gn.w};
        float y[4], s = 0.f;
#pragma unroll
        for (int j = 0; j < 4; ++j) { y[j] = bg[j] * (W0[j] * (cp[j] * hp[j]) + W1[j] * (cg[j] * hh[j]) + W2[j] * (cn[j] * hn[j])); s += y[j] * y[j]; }
        const float rs = rsqrtf(wave_sum(s) * (1.f / 256.f) + RMS_EPS);
        u32x2 o; o.x = pk2(y[0] * rs * GN[0], y[1] * rs * GN[1]); o.y = pk2(y[2] * rs * GN[2], y[3] * rs * GN[3]);
        *(u32x2*)(MA + (size_t)row * D + 512 + c) = o;
    }
}

#define MFMA16(a, b, c) __builtin_amdgcn_mfma_f32_16x16x32_bf16((a), (b), (c), 0, 0, 0)

__device__ __forceinline__ void fftA_item(const Frame& F0, int item) {
    const Frame F = phase_frame(F0); unsigned char* const ws = F.ws;
    const int half = item & 1, t2 = (item >> 1) & 63, b = item >> 7;
    const bf16* P = (const bf16*)(ws + WS_P); bf16* GT = (bf16*)(ws + WS_GT);
    LAS bf16* Bs = (LAS bf16*)F.lds;
    const int lane = F.lane, w = F.wave, fr = lane & 15, fq = lane >> 4;
    __syncthreads();
#pragma unroll
    for (int i = 0; i < 8; ++i) { const int cidx = F.tid + NTHR * i, krow = cidx >> 4, ch8 = cidx & 15, ri = krow >> 7, t1 = krow & 127;
        const u32x4 v = *(const u32x4*)(P + (size_t)(b * SEQ + t1 * 64 + t2) * NP + COL_FC + ri * 256 + half * 128 + ch8 * 8);
        LAS bf16* d = Bs + (ch8 * 8) * 264 + krow;
        d[0 * 264] = (bf16)(v.x & 0xffffu); d[1 * 264] = (bf16)(v.x >> 16); d[2 * 264] = (bf16)(v.y & 0xffffu); d[3 * 264] = (bf16)(v.y >> 16);
        d[4 * 264] = (bf16)(v.z & 0xffffu); d[5 * 264] = (bf16)(v.z >> 16); d[6 * 264] = (bf16)(v.w & 0xffffu); d[7 * 264] = (bf16)(v.w >> 16); }
    __syncthreads();
    f32x4 acc[2][8];
#pragma unroll
    for (int a = 0; a < 2; ++a)
#pragma unroll
        for (int n = 0; n < 8; ++n) acc[a][n] = (f32x4){0.f, 0.f, 0.f, 0.f};
    int t1p_a = 16 * w + fr;
    asm volatile("" : "+v"(t1p_a));
#pragma unroll
    for (int ks = 0; ks < 8; ++ks) {
        bf16x8 ar, ai;
#pragma unroll
        for (int j = 0; j < 8; ++j) { const int k = ks * 32 + 8 * fq + j, ri = k >> 7, t1 = k & 127; const int idx = (t1 * t1p_a) & 127;
            float sn, cs; __sincosf((float)idx * (6.283185307179586f / 128.f), &sn, &cs);
            const float vr = ri == 0 ? cs : -sn, vi = ri == 0 ? -sn : -cs;
            ar[j] = (short)f2bf(vr); ai[j] = (short)f2bf(vi); }
#pragma unroll
        for (int nt = 0; nt < 8; ++nt) { const bf16x8 bfr = *(const LAS bf16x8*)(Bs + (nt * 16 + fr) * 264 + ks * 32 + 8 * fq);
            acc[0][nt] = MFMA16(ar, bfr, acc[0][nt]); acc[1][nt] = MFMA16(ai, bfr, acc[1][nt]); }
    }
#pragma unroll
    for (int reg = 0; reg < 4; ++reg) { const int t1p = 16 * w + 4 * fq + reg; float st, ct; __sincosf((float)(t2 * t1p) * (6.283185307179586f / 8192.f), &st, &ct);
        bf16* g = GT + ((size_t)((b * 128 + t1p) * 64 + t2) * 2) * 256 + half * 128 + fr;
#pragma unroll
        for (int nt = 0; nt < 8; ++nt) { const float gr = acc[0][nt][reg], gi = acc[1][nt][reg];
            g[nt * 16] = (bf16)f2bf(gr * ct + gi * st); g[256 + nt * 16] = (bf16)f2bf(gi * ct - gr * st); } }
}

template <int NKC, int NDIV, class SrcRow, class OutRow>
__device__ __forceinline__ void dft64_item(const Frame& F0, int l, int m0, float sgn, float scale, SrcRow src, OutRow orow) {
    const Frame F = phase_frame(F0); unsigned char* const ws = F.ws;
    LAS bf16* Bs = (LAS bf16*)F.lds;
    LAS float* red = (LAS float*)(F.lds + 256 * 136 * 2);
    const int lane = F.lane, w = F.wave, fr = lane & 15, fq = lane >> 4;
    int fr_a = fr; asm volatile("" : "+v"(fr_a));
    f32x4 acc[4][2];
#pragma unroll
    for (int a = 0; a < 4; ++a) { acc[a][0] = (f32x4){0.f, 0.f, 0.f, 0.f}; acc[a][1] = (f32x4){0.f, 0.f, 0.f, 0.f}; }
    for (int kc = 0; kc < NKC; ++kc) {
        __syncthreads();
#pragma unroll
        for (int i = 0; i < 8; ++i) { const int cidx = F.tid + NTHR * i, krow = cidx >> 5, ch8 = cidx & 31;
            const u32x4 v = *(const u32x4*)(src(kc * 64 + (krow >> 1), krow & 1) + ch8 * 8);
            LAS bf16* d = Bs + (ch8 * 8) * 136 + krow;
            d[0 * 136] = (bf16)(v.x & 0xffffu); d[1 * 136] = (bf16)(v.x >> 16); d[2 * 136] = (bf16)(v.y & 0xffffu); d[3 * 136] = (bf16)(v.y >> 16);
            d[4 * 136] = (bf16)(v.z & 0xffffu); d[5 * 136] = (bf16)(v.z >> 16); d[6 * 136] = (bf16)(v.w & 0xffffu); d[7 * 136] = (bf16)(v.w >> 16); }
        __syncthreads();
#pragma unroll
        for (int ks = 0; ks < 4; ++ks) {
            const bf16x8 b0 = *(const LAS bf16x8*)(Bs + ((2 * w) * 16 + fr) * 136 + ks * 32 + 8 * fq);
            const bf16x8 b1 = *(const LAS bf16x8*)(Bs + ((2 * w + 1) * 16 + fr) * 136 + ks * 32 + 8 * fq);
#pragma unroll
            for (int mt = 0; mt < 4; ++mt) { const int mrow = m0 + mt * 16 + fr_a; bf16x8 a;
#pragma unroll
                for (int j = 0; j < 8; ++j) { const int k = ks * 32 + 8 * fq + j, tl = k >> 1, ri = k & 1; const int idx = ((kc * 64 + tl) * mrow) & (NDIV - 1);
                    float sn, cs; __sincosf((float)idx * (6.283185307179586f / (float)NDIV), &sn, &cs);
                    a[j] = (short)f2bf(ri == 0 ? cs : sgn * sn); }
                acc[mt][0] = MFMA16(a, b0, acc[mt][0]); acc[mt][1] = MFMA16(a, b1, acc[mt][1]); }
        }
    }
#pragma unroll
    for (int mt = 0; mt < 4; ++mt)
#pragma unroll
        for (int reg = 0; reg < 4; ++reg) { const float a = acc[mt][0][reg] * scale, b = acc[mt][1][reg] * scale; acc[mt][0][reg] = a; acc[mt][1][reg] = b;
            float s = a * a + b * b; s += __shfl_xor(s, 1); s += __shfl_xor(s, 2); s += __shfl_xor(s, 4); s += __shfl_xor(s, 8);
            if (fr == 0) red[w * 64 + mt * 16 + 4 * fq + reg] = s; }
    __syncthreads();
    bf16* MA = (bf16*)(ws + WS_H); const float* fg = inptr(I_FOURG) + l * 256;
    const float g0 = fg[(2 * w) * 16 + fr], g1 = fg[(2 * w + 1) * 16 + fr];
#pragma unroll
    for (int mt = 0; mt < 4; ++mt)
#pragma unroll
        for (int reg = 0; reg < 4; ++reg) { const int ml = mt * 16 + 4 * fq + reg; float tot = 0.f;
#pragma unroll
            for (int ww = 0; ww < 8; ++ww) tot += red[ww * 64 + ml];
            const float rs = rsqrtf(tot * (1.f / 256.f) + RMS_EPS);
            bf16* o = MA + (size_t)orow(m0 + ml) * D + 768 + fr;
            o[(2 * w) * 16] = (bf16)f2bf(acc[mt][0][reg] * rs * g0); o[(2 * w + 1) * 16] = (bf16)f2bf(acc[mt][1][reg] * rs * g1); }
    __syncthreads();
}

__device__ __forceinline__ void prep_item(const Frame& F0, int l, int item) {
    const Frame F = phase_frame(F0); unsigned char* const ws = F.ws;
    const bf16* Zs = (const bf16*)(ws + WS_ZS); bf16* STR = (bf16*)(ws + WS_STR);
    LAS float* lin = (LAS float*)F.lds;
    const int row0 = item * 16, c = F.tid;
    __syncthreads();
#pragma unroll
    for (int i = 0; i < 12; ++i) { const int idx = F.tid + NTHR * i, t = idx / 384, ci = idx % 384;
        float v = bf2f(Zs[(size_t)(row0 + t) * ZW + 1536 + ci]);
        if (ci < 128) v = tanhf(v); else if (ci >= 256) v = sigmoidf_(v);
        lin[idx] = v; }
    __syncthreads();
    float aw0[16], aw1[16], aa0[16], aa1[16], ag[16];
#pragma unroll
    for (int t = 0; t < 16; ++t) { aw0[t] = 0.f; aw1[t] = 0.f; aa0[t] = 0.f; aa1[t] = 0.f; ag[t] = 0.f; }
    const float* dw2 = inptr(I_DW2) + (size_t)l * 2 * 64 * DR + c; const float* ia2 = inptr(I_IA2) + (size_t)l * 2 * 64 * DR + c; const float* gg2 = inptr(I_GG2) + (size_t)l * 128 * DR + c;
    for (int j = 0; j < 64; j += 4) {
        float w0[4], w1[4], a0[4], a1[4];
#pragma unroll
        for (int q = 0; q < 4; ++q) { w0[q] = dw2[(size_t)(j + q) * DR]; w1[q] = dw2[(size_t)(64 + j + q) * DR]; a0[q] = ia2[(size_t)(j + q) * DR]; a1[q] = ia2[(size_t)(64 + j + q) * DR]; }
#pragma unroll
        for (int t = 0; t < 16; ++t) { const f32x4 x0 = *(const LAS f32x4*)(lin + t * 384 + j), x1 = *(const LAS f32x4*)(lin + t * 384 + 64 + j),
                                                   x2 = *(const LAS f32x4*)(lin + t * 384 + 128 + j), x3 = *(const LAS f32x4*)(lin + t * 384 + 192 + j);
            aw0[t] += x0.x * w0[0] + x0.y * w0[1] + x0.z * w0[2] + x0.w * w0[3];
            aw1[t] += x1.x * w1[0] + x1.y * w1[1] + x1.z * w1[2] + x1.w * w1[3];
            aa0[t] += x2.x * a0[0] + x2.y * a0[1] + x2.z * a0[2] + x2.w * a0[3];
            aa1[t] += x3.x * a1[0] + x3.y * a1[1] + x3.z * a1[2] + x3.w * a1[3]; }
    }
    for (int j = 0; j < 128; j += 4) {
        float g[4];
#pragma unroll
        for (int q = 0; q < 4; ++q) g[q] = gg2[(size_t)(j + q) * DR];
#pragma unroll
        for (int t = 0; t < 16; ++t) { const f32x4 x = *(const LAS f32x4*)(lin + t * 384 + 256 + j); ag[t] += x.x * g[0] + x.y * g[1] + x.z * g[2] + x.w * g[3]; }
    }
    const float kkw = inptr(I_KK)[l * DR + c], kaw = inptr(I_KA)[l * DR + c];
    const float d00 = inptr(I_DW0)[(l * 2 + 0) * DR + c], d01 = inptr(I_DW0)[(l * 2 + 1) * DR + c], i00 = inptr(I_IA0)[(l * 2 + 0) * DR + c], i01 = inptr(I_IA0)[(l * 2 + 1) * DR + c];
#pragma unroll
    for (int t = 0; t < 16; ++t) { const size_t row = row0 + t; const bf16* zr = Zs + row * ZW; bf16* o = STR + row * STRW + c;
        const float r = bf2f(zr[c]), k = bf2f(zr[512 + c]), v = bf2f(zr[1024 + c]);
        const float kv = k * kkw; const float nrm = sqrtf(wave_sum(kv * kv)); const float kk = kv / fmaxf(nrm, 1e-12f);
        o[0] = (bf16)f2bf(r); o[512] = (bf16)f2bf(v); o[1024] = (bf16)f2bf(kk); o[1536] = (bf16)f2bf(ag[t]);
#pragma unroll
        for (int dn = 0; dn < 2; ++dn) { const float xw = (dn ? d01 : d00) + (dn ? aw1[t] : aw0[t]);
            const float ew = sigmoidf_(xw) * 0.6065306597126334f;
            const float eps = -expm1f(-ew);
            const float a = sigmoidf_((dn ? i01 : i00) + (dn ? aa1[t] : aa0[t]));
            const float kd = k * (1.f + (a - 1.f) * kaw), bb = kk * a;
            o[2048 + dn * 1536] = (bf16)f2bf(eps); o[2048 + dn * 1536 + 512] = (bf16)f2bf(kd); o[2048 + dn * 1536 + 1024] = (bf16)f2bf(bb); }
    }
}

__device__ __forceinline__ int scan_rowof(int s, int dir, int b) { if (s < CTXL) { const int tc = dir ? (CTXL - 1 - s) : s; return NLAT + b * CTXL + tc; } const int tt = s - CTXL; const int t = dir ? (SEQ - 1 - tt) : tt; return b * SEQ + t; }
__device__ __forceinline__ void scan_item(const Frame& F0, int item, bool need_ctx) {
    const Frame F = phase_frame(F0); unsigned char* const ws = F.ws;
    const int dir = item & 1, h = (item >> 1) & 7, b = item >> 4;
    const bf16* STR = (const bf16*)(ws + WS_STR); bf16* Y = (bf16*)(ws + WS_Y) + (size_t)dir * NROW * DR;
    const int lane = F.lane, kq = lane & 7, vrow = 8 * F.wave + (lane >> 3);
    float S[8];
#pragma unroll
    for (int j = 0; j < 8; ++j) S[j] = 0.f;
    const int co = h * 64 + kq * 8;
    constexpr int NSTEP = CTXL + SEQ;
#define rowof(s) scan_rowof((s), dir, b)
    for (int s0 = 0; s0 < NSTEP; s0 += 4) {
        u32x4 qkk[4], qe[4], qkd[4], qb[4], qr[4]; unsigned qv[4];
#pragma unroll
        for (int u = 0; u < 4; ++u) { const bf16* base = STR + (size_t)rowof(s0 + u) * STRW;
            qr[u] = *(const u32x4*)(base + co); qkk[u] = *(const u32x4*)(base + 1024 + co);
            qe[u] = *(const u32x4*)(base + 2048 + dir * 1536 + co); qkd[u] = *(const u32x4*)(base + 2048 + dir * 1536 + 512 + co); qb[u] = *(const u32x4*)(base + 2048 + dir * 1536 + 1024 + co);
            qv[u] = base[512 + h * 64 + vrow]; }
#pragma unroll
        for (int u = 0; u < 4; ++u) { float kk[8], e[8], kd[8], bb[8], r[8];
            unpack8(qkk[u], kk); unpack8(qe[u], e); unpack8(qkd[u], kd); unpack8(qb[u], bb); unpack8(qr[u], r);
            const float vv = bf2f(qv[u]);
            float sk = 0.f;
#pragma unroll
            for (int j = 0; j < 8; ++j) sk += S[j] * kk[j];
            sk += __shfl_xor(sk, 1); sk += __shfl_xor(sk, 2); sk += __shfl_xor(sk, 4);
            float y = 0.f;
#pragma unroll
            for (int j = 0; j < 8; ++j) { S[j] = S[j] * (1.f - e[j]) - sk * bb[j] + vv * kd[j]; y += S[j] * r[j]; }
            y += __shfl_xor(y, 1); y += __shfl_xor(y, 2); y += __shfl_xor(y, 4);
            const int s = s0 + u;
            if (kq == 0 && (s >= CTXL || need_ctx)) Y[(size_t)rowof(s) * DR + h * 64 + vrow] = (bf16)f2bf(y); }
    }
#undef rowof
}

__device__ __forceinline__ void readout_pass(const Frame& F0, int l, int nrows) {
    const Frame F = phase_frame(F0); unsigned char* const ws = F.ws;
    const bf16* STR = (const bf16*)(ws + WS_STR); const bf16* Y0 = (const bf16*)(ws + WS_Y); const bf16* Y1 = Y0 + (size_t)NROW * DR; bf16* MA = (bf16*)(ws + WS_H);
    const int lane = F.lane; const float* gnw = inptr(I_GNW) + l * DR; const float* gnb = inptr(I_GNB) + l * DR; const float* rkp = inptr(I_RK) + l * DR;
    for (int row = F.gw; row < nrows; row += F.NGW) { const bf16* sr = STR + (size_t)row * STRW;
#pragma unroll
        for (int h = 0; h < 8; ++h) { const int c = h * 64 + lane;
            const float y = bf2f(Y0[(size_t)row * DR + c]) + bf2f(Y1[(size_t)row * DR + c]);
            const float mu = wave_sum(y) * (1.f / 64.f); const float dv = y - mu; const float var = wave_sum(dv * dv) * (1.f / 64.f);
            const float yn = dv * rsqrtf(var + GN_EPS) * gnw[c] + gnb[c];
            const float r = bf2f(sr[c]), v = bf2f(sr[512 + c]), g = bf2f(sr[1536 + c]), k0 = bf2f(sr[2048 + 512 + c]), k1 = bf2f(sr[2048 + 1536 + 512 + c]);
            const float rk = rkp[c];
            const float bonus = wave_sum(r * (k0 + k1) * rk) * v;
            MA[(size_t)row * D + c] = (bf16)f2bf((yn + bonus) * g); }
    }
}
namespace pg8 {
struct EpiStoreBf16 {
    static constexpr bool PERM = true, AFTER_DRAIN = false;
    bf16_t* O; int ldc; int pn_mask;
    __device__ __forceinline__ void operator()(const f32x4 (&acc)[2][2][4][2], const Unit& u, int wr, int wc, int fr, int fq) const {
        const int row0 = u.pm * BM + wr * 64 + fr; const int col0 = (u.pn & pn_mask) * BM + wc * 32 + 8 * fq;
#pragma unroll
        for (int ai = 0; ai < 2; ++ai)
#pragma unroll
            for (int m = 0; m < 4; ++m) { bf16_t* rowp = O + (size_t)(row0 + ai * HALF + m * 16) * ldc + col0;
#pragma unroll
                for (int bj = 0; bj < 2; ++bj) { const f32x4 v0 = acc[ai][bj][m][0], v1 = acc[ai][bj][m][1];
                    u32x4 w; w.x = cvt_pk_bf16(v0[0], v0[1]); w.y = cvt_pk_bf16(v0[2], v0[3]); w.z = cvt_pk_bf16(v1[0], v1[1]); w.w = cvt_pk_bf16(v1[2], v1[3]);
                    *(u32x4*)(rowp + bj * HALF) = w; } }
    }
};
struct EpiSwiGLU {
    static constexpr bool PERM = true, AFTER_DRAIN = false;
    bf16_t* O;
    __device__ __forceinline__ void operator()(const f32x4 (&acc)[2][2][4][2], const Unit& u, int wr, int wc, int fr, int fq) const {
        const int row0 = u.pm * BM + wr * 64 + fr; const int col0 = ((u.pn & 3) * BM + wc * 32 + 8 * fq) >> 1;
#pragma unroll
        for (int ai = 0; ai < 2; ++ai)
#pragma unroll
            for (int m = 0; m < 4; ++m) { bf16_t* rowp = O + (size_t)(row0 + ai * HALF + m * 16) * 512 + col0;
#pragma unroll
                for (int bj = 0; bj < 2; ++bj) { const f32x4 g = acc[ai][bj][m][0], up = acc[ai][bj][m][1]; float a[4];
#pragma unroll
                    for (int i = 0; i < 4; ++i) a[i] = g[i] / (1.f + __expf(-g[i])) * up[i];
                    unsigned long long w = (unsigned long long)cvt_pk_bf16(a[0], a[1]) | ((unsigned long long)cvt_pk_bf16(a[2], a[3]) << 32);
                    *(unsigned long long*)(rowp + bj * (HALF / 2)) = w; } }
    }
};
struct EpiResidual {
    static constexpr bool PERM = false, AFTER_DRAIN = false;
    const float* xlat; const float* xctx;
    float* out; const float* g1;
    __device__ __forceinline__ void operator()(const f32x4 (&acc)[2][2][4][2], const Unit& u, int wr, int wc, int fr, int fq) const {
        const int rowt = u.pm * BM; const int mr = rowt < 16384 ? (rowt >> 13) : 2;
        const float* base = rowt < 16384 ? xlat + (size_t)rowt * 1024 : xctx + (size_t)(rowt - 16384) * 1024;
        const int col0 = u.pn * BM + wc * 32 + 4 * fq;
        f32x4 gv[2][2];
#pragma unroll
        for (int bj = 0; bj < 2; ++bj)
#pragma unroll
            for (int n = 0; n < 2; ++n) gv[bj][n] = *(const f32x4*)(g1 + (size_t)mr * 6144 + col0 + bj * HALF + n * 16);
#pragma unroll
        for (int ai = 0; ai < 2; ++ai)
#pragma unroll
            for (int m = 0; m < 4; ++m) { const int rl = ai * HALF + wr * 64 + m * 16 + fr;
#pragma unroll
                for (int bj = 0; bj < 2; ++bj)
#pragma unroll
                    for (int n = 0; n < 2; ++n) { const size_t off = (size_t)rl * 1024 + col0 + bj * HALF + n * 16;
                        const f32x4 xo = *(const f32x4*)(base + off);
                        *(f32x4*)(out + (size_t)rowt * 1024 + off) = xo + gv[bj][n] * acc[ai][bj][m][n]; } }
    }
};
struct MoeOrder {
    const int* tile_e; int ntiles, G, c;
    __device__ bool next(int i, Unit& u) const { const long L = (long)i * G + c; if (L >= 4L * ntiles) return false; const int pm = (int)(L >> 2); u.pm = pm; u.pn = tile_e[pm] * 4 + (int)(L & 3); return true; }
    __device__ __forceinline__ void a_ready(const Unit&) const {}
    __device__ __forceinline__ void done(const Unit&) const {}
};
}

__device__ __forceinline__ void expert_convert(const Frame& F0, int l) {
    const Frame F = phase_frame(F0); unsigned char* const ws = F.ws;
    LAS float* scr = (LAS float*)(F.lds + F.wave * 16384);
    bf16* wgu = (bf16*)(ws + WS_WGU_T); bf16* wd = (bf16*)(ws + WS_WD_T);
    constexpr int I_G = 16 * 16, I_D = 8 * 32;
    constexpr int NIT = NEXP * (2 * I_G + I_D);
    const float* p_eg = inptr(I_EG); const float* p_eu = inptr(I_EU); const float* p_ed = inptr(I_ED);
    for (int it = F.gw; it < NIT; it += F.NGW) { const int e = it / (2 * I_G + I_D); int r = it % (2 * I_G + I_D);
        if (r < I_G) { transpose_item(p_eg + ((size_t)l * NEXP + e) * D * DEXP, DEXP, (r >> 4) * 64, (r & 15) * 32, wgu, D, RmGU{e * 1024}, scr, F.lane); continue; } r -= I_G;
        if (r < I_G) { transpose_item(p_eu + ((size_t)l * NEXP + e) * D * DEXP, DEXP, (r >> 4) * 64, (r & 15) * 32, wgu, D, RmGU{e * 1024 + 4}, scr, F.lane); continue; } r -= I_G;
        transpose_item(p_ed + ((size_t)l * NEXP + e) * DEXP * D, D, (r >> 5) * 64, (r & 31) * 32, wd, DEXP, RmId{e * 1024}, scr, F.lane);
    }
}

__device__ __forceinline__ void router_pass(const Frame& F0, int l, int nrows) {
    const Frame F = phase_frame(F0); unsigned char* const ws = F.ws;
    LAS float* msh = (LAS float*)F.lds; LAS float* msc = msh + 3072;
    __syncthreads();
    mod_to_lds(F, l, 3, msh, false); mod_to_lds(F, l, 4, msc, false); __syncthreads();
    const float* X = (const float*)(ws + WS_X); bf16* H = (bf16*)(ws + WS_H);
    const float* rgw = inptr(I_RGW) + (size_t)l * D * 4; const float* rew = inptr(I_REW) + (size_t)l * D * NEXP;
    const float* rgb = inptr(I_RGB) + l * 4; const float* reb = inptr(I_REB) + l * NEXP;
    int* rt_e = (int*)(ws + WS_ROUTE + RT_E); int* rt_pos = (int*)(ws + WS_ROUTE + RT_POS); float* rt_gate = (float*)(ws + WS_ROUTE + RT_GATE);
    unsigned* cnt = (unsigned*)(ws + WS_CTL) + CW_CNT + 64 * l;
    const int lane = F.lane; const float* n2g = inptr(I_N2G) + l * D;
    for (int row = F.gw; row < nrows; row += F.NGW) {
        f32x4 v[4];
#pragma unroll
        for (int j = 0; j < 4; ++j) v[j] = *(const f32x4*)(X + (size_t)row * D + 4 * lane + 256 * j);
        const int mr = modrow(row);
        norm_mod_row(v, n2g, msc + mr * 1024, msh + mr * 1024, H + (size_t)row * D, lane);
        float lg[4], le[32];
#pragma unroll
        for (int g = 0; g < 4; ++g) lg[g] = 0.f;
#pragma unroll
        for (int e = 0; e < 32; ++e) le[e] = 0.f;
#pragma unroll
        for (int j = 0; j < 4; ++j) { const float hv[4] = {v[j].x, v[j].y, v[j].z, v[j].w};
#pragma unroll
            for (int i = 0; i < 4; ++i) { const int k = 4 * lane + 256 * j + i; const f32x4 wg = *(const f32x4*)(rgw + (size_t)k * 4);
                lg[0] += hv[i] * wg.x; lg[1] += hv[i] * wg.y; lg[2] += hv[i] * wg.z; lg[3] += hv[i] * wg.w;
#pragma unroll
                for (int q = 0; q < 8; ++q) { const f32x4 we = *(const f32x4*)(rew + (size_t)k * 32 + 4 * q);
                    le[4 * q] += hv[i] * we.x; le[4 * q + 1] += hv[i] * we.y; le[4 * q + 2] += hv[i] * we.z; le[4 * q + 3] += hv[i] * we.w; } } }
#pragma unroll
        for (int g = 0; g < 4; ++g) lg[g] = wave_sum(lg[g]) + rgb[g];
#pragma unroll
        for (int e = 0; e < 32; ++e) le[e] = wave_sum(le[e]) + reb[e];
        int grp = 0; float mx = lg[0];
#pragma unroll
        for (int g = 1; g < 4; ++g) if (lg[g] > mx) { mx = lg[g]; grp = g; }
        float den = 0.f;
#pragma unroll
        for (int g = 0; g < 4; ++g) den += __expf(lg[g] - mx);
        const float pg_top = 1.f / den;
        float sel[8];
#pragma unroll
        for (int q = 0; q < 8; ++q) sel[q] = grp == 0 ? le[q] : grp == 1 ? le[8 + q] : grp == 2 ? le[16 + q] : le[24 + q];
        int i0 = 0; float l0 = sel[0];
#pragma unroll
        for (int q = 1; q < 8; ++q) if (sel[q] > l0) { l0 = sel[q]; i0 = q; }
        int i1 = -1; float l1 = -3.0e38f;
#pragma unroll
        for (int q = 0; q < 8; ++q) if (q != i0 && sel[q] > l1) { l1 = sel[q]; i1 = q; }
        const float e1 = __expf(l1 - l0); const float w0 = pg_top / (1.f + e1), w1 = pg_top * e1 / (1.f + e1);
        if (lane == 0) { const int ea = grp * 8 + i0, eb = grp * 8 + i1;
            const unsigned pa = atomicAdd(cnt + ea, 1u), pb = atomicAdd(cnt + eb, 1u);
            rt_e[2 * row] = ea; rt_e[2 * row + 1] = eb; rt_pos[2 * row] = (int)pa; rt_pos[2 * row + 1] = (int)pb; rt_gate[2 * row] = w0; rt_gate[2 * row + 1] = w1; }
    }
}

__device__ __forceinline__ void gather_pass(const Frame& F0, int l, int nrows) {
    const Frame F = phase_frame(F0); unsigned char* const ws = F.ws;
    LAS int* off = (LAS int*)F.lds;
    const unsigned* cnt = (const unsigned*)(ws + WS_CTL) + CW_CNT + 64 * l;
    int* tile_e = (int*)(ws + WS_ROUTE + RT_TILE); int* ntl = (int*)(ws + WS_ROUTE + RT_NT);
    __syncthreads();
    if (F.tid == 0) { int o = 0;
#pragma nounroll
        for (int e = 0; e < NEXP; ++e) { const int c = (int)__hip_atomic_load(cnt + e, __ATOMIC_RELAXED, __HIP_MEMORY_SCOPE_AGENT); const int nt = (c + 255) >> 8; off[e] = o;
            if (blockIdx.x == 0) {
#pragma nounroll
                for (int t = 0; t < nt; ++t) tile_e[(o >> 8) + t] = e; }
            o += nt << 8; }
        if (blockIdx.x == 0) ntl[0] = o >> 8; }
    __syncthreads();
    const int* rt_e = (const int*)(ws + WS_ROUTE + RT_E); const int* rt_pos = (const int*)(ws + WS_ROUTE + RT_POS); int* rt_slot = (int*)(ws + WS_ROUTE + RT_SLOT);
    const bf16* H = (const bf16*)(ws + WS_H); bf16* Xs = (bf16*)(ws + WS_XS);
    for (int it = F.gw; it < 2 * nrows; it += F.NGW) { const int row = it >> 1; const int slot = off[rt_e[it]] + rt_pos[it];
        if (F.lane == 0) rt_slot[it] = slot;
        const u32x4* s = (const u32x4*)(H + (size_t)row * D); u32x4* d = (u32x4*)(Xs + (size_t)slot * D);
        d[F.lane] = s[F.lane]; d[64 + F.lane] = s[64 + F.lane]; }
}

__device__ __forceinline__ void combine_pass(const Frame& F0, int l, int nrows) {
    const Frame F = phase_frame(F0); unsigned char* const ws = F.ws;
    LAS float* mg2 = (LAS float*)F.lds; LAS float* msh = mg2 + 3072; LAS float* msc = msh + 3072;
    const bool last = (l == DEPTH - 1);
    __syncthreads();
    mod_to_lds(F, l, 5, mg2, false); if (!last) { mod_to_lds(F, l + 1, 0, msh, false); mod_to_lds(F, l + 1, 1, msc, false); }
    __syncthreads();
    float* X = (float*)(ws + WS_X); bf16* H = (bf16*)(ws + WS_H); const bf16* Ys = (const bf16*)(ws + WS_XS);
    const int* rt_slot = (const int*)(ws + WS_ROUTE + RT_SLOT); const float* rt_gate = (const float*)(ws + WS_ROUTE + RT_GATE);
    const int lane = F.lane; const float* n1g = inptr(I_N1G) + (last ? 0 : (l + 1) * D); const float* fgp = inptr(I_FG);
    for (int row = F.gw; row < nrows; row += F.NGW) { const int s0 = rt_slot[2 * row], s1 = rt_slot[2 * row + 1]; const float w0 = rt_gate[2 * row], w1 = rt_gate[2 * row + 1];
        const int mr = modrow(row); f32x4 v[4];
#pragma unroll
        for (int j = 0; j < 4; ++j) { const int c = 4 * lane + 256 * j; float a[4], b[4];
            unpack4(*(const u32x2*)(Ys + (size_t)s0 * D + c), a); unpack4(*(const u32x2*)(Ys + (size_t)s1 * D + c), b);
            const f32x4 g2 = *(const LAS f32x4*)(mg2 + mr * 1024 + c); const f32x4 xo = *(const f32x4*)(X + (size_t)row * D + c);
            f32x4 y; y.x = w0 * a[0] + w1 * b[0]; y.y = w0 * a[1] + w1 * b[1]; y.z = w0 * a[2] + w1 * b[2]; y.w = w0 * a[3] + w1 * b[3];
            v[j] = xo + g2 * y; }
        if (!last) {
#pragma unroll
            for (int j = 0; j < 4; ++j) *(f32x4*)(X + (size_t)row * D + 4 * lane + 256 * j) = v[j];
            norm_mod_row(v, n1g, msc + mr * 1024, msh + mr * 1024, H + (size_t)row * D, lane);
        } else { float s = 0.f;
#pragma unroll
            for (int j = 0; j < 4; ++j) s += (v[j].x * v[j].x + v[j].y * v[j].y) + (v[j].z * v[j].z + v[j].w * v[j].w);
            const float rs = rsqrtf(wave_sum(s) * (1.f / D) + RMS_EPS);
#pragma unroll
            for (int j = 0; j < 4; ++j) { const int c = 4 * lane + 256 * j; const f32x4 g = *(const f32x4*)(fgp + c); *(f32x4*)(F.out + (size_t)row * D + c) = v[j] * rs * g; } }
    }
}
__global__ void __launch_bounds__(NTHR, 2) fwd_megakernel(Params prm) {
    extern __shared__ __attribute__((aligned(16))) unsigned char lds_raw[];
    Frame F;
    F.lds = (LAS unsigned char*)lds_raw;
    F.tid = threadIdx.x; F.lane = F.tid & 63; F.wave = __builtin_amdgcn_readfirstlane(F.tid >> 6);
    F.G = gridDim.x; { const int bx = blockIdx.x; F.vcu = (F.G % 8 == 0) ? (bx % 8) * (F.G / 8) + bx / 8 : bx; }
    F.gw = F.vcu * NWAVES + F.wave; F.NGW = F.G * NWAVES;
    F.out = prm.out; F.ws = prm.ws;
    for (int u = F.tid; u < (LDS_BYTES - LDSCTL_OFF) / 4; u += NTHR) ((LAS unsigned*)(F.lds + LDSCTL_OFF))[u] = 0u;
    __syncthreads();
    (void)xcd_barrier_post((unsigned*)(F.ws + WS_CTL) + CW_BAR, (volatile LAS unsigned*)(F.lds + MISC_OFF) + 8);
#define GRID_BAR() do { XcdBarrier bar_; bar_.bar = (unsigned*)(opaque(F.ws) + WS_CTL) + CW_BAR; bar_.x = xb_xcc_id(); bar_.st = (volatile LAS unsigned*)(F.lds + MISC_OFF) + 8; xcd_barrier(bar_); } while (0)

#ifndef PHMASK
#define PHMASK 0xffff
#endif
#define PH(k) ((PHMASK >> (k)) & 1)
    if (PH(0)) p0_prologue(F);
#if USE_CG_SYNC
    cg::this_grid().sync();
#else
    GRID_BAR();
#endif
    if (PH(1)) p0b_norm1(F);
    GRID_BAR();

    for (int l = 0; l < DEPTH; ++l) {
        const bool need_ctx = (l == 0); const int nrows = need_ctx ? NROW : NLAT;
#define WSO Fp.ws
        if (PH(2)) {
            const Frame Fp = phase_frame(F); unsigned char* const ws = WSO; bf16* Hb = (bf16*)(ws + WS_H); bf16* Pb = (bf16*)(ws + WS_P);
            pg8::Gemm g{Hb, (const bf16*)(ws + WS_WIN_T) + (size_t)l * NP * D, NROW, NP, D}; pg8::StaticOrder S; S.init(NROW, NP, Fp.G, (int)blockIdx.x);
            pg8::EpiStoreBf16 E{Pb, NP, 0xffff};
            pg8::gemm_phase<pg8::EpiStoreBf16, pg8::StaticOrder, true, true>(F.lds, g, S, E);
        }
        GRID_BAR();
        {
            const Frame Fp = phase_frame(F); unsigned char* const ws = WSO; bf16* Pb = (bf16*)(ws + WS_P);
            if (PH(3)) for (int it = blockIdx.x; it < 256; it += F.G) fftA_item(F, it);
            if (PH(4) && need_ctx) for (int it = blockIdx.x; it < 8; it += F.G) { const int b = it >> 2, m0 = (it & 3) * 64;
                const bf16* src0 = Pb + (size_t)(NLAT + b * CTXL) * NP + COL_FC;
                dft64_item<4, 256>(F, l, m0, -1.f, 1.f / 128.f, [=](int t, int ri) { return src0 + (size_t)t * NP + ri * 256; }, [=](int m) { return NLAT + b * CTXL + m; }); }
            if (PH(5)) { shift_pass(F, l);
            conv_pass(F, l, nrows); }
        }
        GRID_BAR();
        {
            const Frame Fp = phase_frame(F); unsigned char* const ws = WSO;
            if (PH(6)) for (int it = blockIdx.x; it < 256; it += F.G) { const int b = it >> 7, t1p = it & 127;
                const bf16* src0 = (const bf16*)(ws + WS_GT) + (size_t)(b * 128 + t1p) * 64 * 512;
                dft64_item<1, 64>(F, l, 0, 1.f, 0.0013810679320049757f, [=](int t, int ri) { return src0 + (size_t)t * 512 + ri * 256; }, [=](int m) { return b * SEQ + t1p + 128 * m; }); }
            if (PH(7)) for (int it = blockIdx.x; it < NROW / 16; it += F.G) prep_item(F, l, it);
        }
        GRID_BAR();
        if (PH(8)) for (int it = blockIdx.x; it < 32; it += F.G) scan_item(F, it, need_ctx);
        GRID_BAR();
        if (PH(9)) readout_pass(F, l, nrows);
        GRID_BAR();
        if (PH(10)) {
            const Frame Fp = phase_frame(F); unsigned char* const ws = WSO; bf16* Hb = (bf16*)(ws + WS_H);
            pg8::Gemm g{Hb, (const bf16*)(ws + WS_WOUT_T) + (size_t)l * D * D, nrows, D, D}; pg8::StaticOrder S; S.init(nrows, D, Fp.G, (int)blockIdx.x);
            const float* X = (const float*)(ws + WS_X);
            pg8::EpiResidual E{l == 0 ? inptr(I_X) : X, l == 0 ? inptr(I_CTX) : X + (size_t)NLAT * D, (float*)(ws + WS_X), (const float*)(ws + WS_MODF) + (size_t)l * 3 * 6144 + 2 * 1024};
            pg8::gemm_phase<pg8::EpiResidual, pg8::StaticOrder, true, true>(F.lds, g, S, E);
        }
        GRID_BAR();
        if (PH(11)) expert_convert(F, l);
        if (PH(12)) router_pass(F, l, nrows);
        GRID_BAR();
        if (PH(13)) gather_pass(F, l, nrows);
        GRID_BAR();
        if (PH(14)) {
            const Frame Fp = phase_frame(F); unsigned char* const ws = WSO;
            const int* tile_e = (const int*)(ws + WS_ROUTE + RT_TILE); const int ntiles = *(const int*)(ws + WS_ROUTE + RT_NT);
            pg8::MoeOrder S{tile_e, ntiles, Fp.G, (int)blockIdx.x};
            {   pg8::Gemm g{(const bf16*)(ws + WS_XS), (const bf16*)(ws + WS_WGU_T), 0, 0, D};
                pg8::EpiSwiGLU E{(bf16*)(ws + WS_ACT)};
                pg8::gemm_phase<pg8::EpiSwiGLU, pg8::MoeOrder, true, true>(F.lds, g, S, E); }
            GRID_BAR();
            {   pg8::Gemm g{(const bf16*)(ws + WS_ACT), (const bf16*)(ws + WS_WD_T), 0, 0, DEXP};
                pg8::EpiStoreBf16 E{(bf16*)(ws + WS_XS), D, 3};
                pg8::gemm_phase<pg8::EpiStoreBf16, pg8::MoeOrder, true, true>(F.lds, g, S, E); }
        }
        GRID_BAR();
        if (PH(15)) combine_pass(F, l, nrows);
        if (l + 1 < DEPTH) GRID_BAR();
    }
}

extern "C" void kernel_launch(void* const* d_in, const int* in_sizes, int n_in, void* d_out, int out_size, void* d_ws, size_t ws_size, hipStream_t stream) {
    static int grid = 0;
    if (grid == 0) {
        if (n_in != N_IN || in_sizes[0] != NLAT * D || out_size != NLAT * D || ws_size < WS_END) {
            fprintf(stderr, "kernel_launch: unexpected shapes (n_in %d in0 %d out %d ws %zu)\n", n_in, n_in > 0 ? in_sizes[0] : -1, out_size, ws_size); grid = -1; return; }
        int dev = 0, cus = 0, per_cu = 0;
        hipGetDevice(&dev); hipDeviceGetAttribute(&cus, hipDeviceAttributeMultiprocessorCount, dev);
        hipFuncSetAttribute((const void*)fwd_megakernel, hipFuncAttributeMaxDynamicSharedMemorySize, LDS_BYTES);
        hipOccupancyMaxActiveBlocksPerMultiprocessor(&per_cu, (const void*)fwd_megakernel, NTHR, LDS_BYTES);
        if (per_cu < 1) { fprintf(stderr, "kernel_launch: occupancy query says %d blocks per CU\n", per_cu); per_cu = 1; }
        (void)hipGetLastError();
        grid = cus * per_cu;
    }
    if (grid < 0) return;
    hipMemsetAsync((char*)d_ws + WS_CTL, 0, CTL_ZERO_BYTES, stream);
    Params p{};
    for (int i = 0; i < N_IN; ++i) p.in[i] = (const float*)d_in[i];
    p.out = (float*)d_out; p.ws = (unsigned char*)d_ws;
    void* args[] = {&p};
    hipError_t e = hipLaunchCooperativeKernel((const void*)fwd_megakernel, dim3(grid), dim3(NTHR), args, LDS_BYTES, stream);
    if (e != hipSuccess) fprintf(stderr, "kernel_launch: cooperative launch failed: %s (grid %d)\n", hipGetErrorString(e), grid);
}
```

```cpp
#include <hip/hip_runtime.h>
#include <hip/hip_cooperative_groups.h>
#include <cstdio>
#include <cstdint>
namespace cg = cooperative_groups;
#ifndef USE_CG_SYNC
#define USE_CG_SYNC 1
#endif
namespace pg8 {
#define PG8_LAS __attribute__((address_space(3)))
typedef unsigned short bf16_t;
typedef short bf16x8 __attribute__((ext_vector_type(8)));
typedef float f32x4 __attribute__((ext_vector_type(4)));
typedef unsigned u32x4 __attribute__((ext_vector_type(4)));
constexpr int BM = 256, BK = 64, HALF = 128, HTB = HALF * BK * 2  , STAGE_BYTES = 8 * HTB, NXCD = 8, WGM = 8;

__host__ __device__ __forceinline__ int lds_byte(int r, int c) { const int st = (r >> 4) * 2 + (c >> 5), rr = r & 15, cc = c & 31, ob = rr * 64 + cc * 2; return st * 1024 + (ob ^ (((ob >> 9) & 1) << 5)); }
__host__ __device__ __forceinline__ void stage_rc(int b, int& R, int& C) { const int st = b / 1024, sb = b % 1024, swz = sb ^ (((sb >> 9) & 1) << 5); R = (st >> 1) * 16 + swz / 64; C = (st & 1) * 32 + (swz % 64) / 2; }
__host__ __device__ __forceinline__ int perm32(int rho) { const int n = rho >> 4, i = rho & 15; return 8 * (i >> 2) + 4 * n + (i & 3); }

struct Unit { int pm, pn; };
struct Gemm { const bf16_t* A; const bf16_t* Bt; int M, N, K; };

struct StaticOrder {
    int nM, nN, nwg, G, c;
    __host__ __device__ void init(int M, int N, int G_, int c_) { nM = M / BM; nN = N / BM; nwg = nM * nN; G = G_; c = c_; }
    __host__ __device__ bool next(int i, Unit& u) const {
        const long L = (long)i * G + c; if (L >= nwg) return false;
        int wgid = (int)L; { const int q = nwg / NXCD, r = nwg % NXCD, xcd = wgid % NXCD, off = wgid / NXCD; wgid = (xcd < r ? xcd * (q + 1) : r * (q + 1) + (xcd - r) * q) + off; }
        const int nig = WGM * nN, gid = wgid / nig, fm = gid * WGM, gsz = (nM - fm) < WGM ? (nM - fm) : WGM;
        u.pm = fm + ((wgid % nig) % gsz); u.pn = (wgid % nig) / gsz; return true;
    }
    __device__ __forceinline__ void a_ready(const Unit&) const {}
    __device__ __forceinline__ void done(const Unit&) const {}
};

__device__ __forceinline__ unsigned cvt_pk_bf16(float lo, float hi) { unsigned r; asm volatile("v_cvt_pk_bf16_f32 %0, %1, %2" : "=v"(r) : "v"(lo), "v"(hi)); return r; }
typedef float f32x2 __attribute__((ext_vector_type(2)));
template <class Epi, class Sched, bool ALIGN_EPI = false, bool SP2 = false>
__device__ __forceinline__ void gemm_phase(PG8_LAS unsigned char* lds, const Gemm g, const Sched& S, const Epi& E) {
    int tid = threadIdx.x; asm volatile("" : "+v"(tid));
    const int wid = __builtin_amdgcn_readfirstlane(tid >> 6), lane = tid & 63, wr = wid >> 2, wc = wid & 3, fr = lane & 15, fq = lane >> 4;
    const int K = g.K, nt = K / BK;
    unsigned voffA[2], voffB[2];
#pragma unroll
    for (int i = 0; i < 2; ++i) { int R, C; stage_rc(tid * 16 + i * 8192, R, C); const int Rb = Epi::PERM ? ((R & ~31) + perm32(R & 31)) : R;
        voffA[i] = (unsigned)(R * K + C) * 2u; voffB[i] = (unsigned)(Rb * K + C) * 2u; }
    const size_t kstep = (size_t)(BK * 2);
    const size_t hstep = (size_t)HALF * K * 2;
    const size_t tstep = 2 * hstep;
    const unsigned ldsw = (unsigned)wid * 1024u;
    const int aoff = lds_byte(wr * 64 + fr, fq * 8), boff = lds_byte(wc * 32 + fr, fq * 8);
#define PG8_SA(b, h) (((b) * 2 + (h)) * HTB)
#define PG8_SB(b, h) ((4 + (b) * 2 + (h)) * HTB)
#define PG8_STAGE(bufoff, gbase, voff) do { _Pragma("unroll") for (int _i = 0; _i < 2; ++_i) \
        __builtin_amdgcn_global_load_lds((const unsigned*)((const char*)(gbase) + (voff)[_i]), (PG8_LAS unsigned*)(lds + (bufoff) + ldsw + _i * 8192), 16, 0, 0); } while (0)
#define PG8_LDA(dst, b, h) do { _Pragma("unroll") for (int m = 0; m < 4; ++m) _Pragma("unroll") for (int k = 0; k < 2; ++k) dst[m][k] = *(const PG8_LAS bf16x8*)(lds + PG8_SA(b, h) + aoff + m * 2048 + k * 1024); } while (0)
#define PG8_LDB(dst, b, h) do { _Pragma("unroll") for (int n = 0; n < 2; ++n) _Pragma("unroll") for (int k = 0; k < 2; ++k) dst[n][k] = *(const PG8_LAS bf16x8*)(lds + PG8_SB(b, h) + boff + n * 2048 + k * 1024); } while (0)
#define PG8_MMA(ai, bj, At, Bt) do { __builtin_amdgcn_s_setprio(1); _Pragma("unroll") for (int m = 0; m < 4; ++m) _Pragma("unroll") for (int n = 0; n < 2; ++n) _Pragma("unroll") for (int k = 0; k < 2; ++k) \
        acc[ai][bj][m][n] = __builtin_amdgcn_mfma_f32_16x16x32_bf16(Bt[n][k], At[m][k], acc[ai][bj][m][n], 0, 0, 0); __builtin_amdgcn_s_setprio(0); } while (0)
#define PG8_WAIT_V(n) asm volatile("s_waitcnt vmcnt(" #n ")" ::: "memory")
#define PG8_WAIT_L(n) asm volatile("s_waitcnt lgkmcnt(" #n ")" ::: "memory")
#define PG8_BAR __builtin_amdgcn_s_barrier()
#define PG8_SCHED __builtin_amdgcn_sched_barrier(0)
    Unit cur, nxt; int ui = 0;
    if (!S.next(0, cur)) return;
    f32x4 acc[2][2][4][2];
#pragma unroll
    for (int a = 0; a < 2; ++a)
#pragma unroll
        for (int b = 0; b < 2; ++b)
#pragma unroll
            for (int m = 0; m < 4; ++m)
#pragma unroll
                for (int n = 0; n < 2; ++n) acc[a][b][m][n] = (f32x4){0.f, 0.f, 0.f, 0.f};
    bf16x8 At[4][2], B0[2][2], B1[2][2];
    const char* cA = (const char*)g.A + (size_t)cur.pm * tstep; const char* cB = (const char*)g.Bt + (size_t)cur.pn * tstep;
    S.a_ready(cur);
    if constexpr (SP2) {
        PG8_STAGE(PG8_SB(0, 0), cB, voffB); PG8_STAGE(PG8_SB(0, 1), cB + hstep, voffB); PG8_STAGE(PG8_SA(0, 0), cA, voffA); PG8_STAGE(PG8_SA(0, 1), cA + hstep, voffA);
        if (wr == 1) PG8_BAR;
        PG8_WAIT_V(2); PG8_BAR;
        PG8_STAGE(PG8_SB(1, 0), cB + kstep, voffB); PG8_STAGE(PG8_SA(1, 0), cA + kstep, voffA); PG8_STAGE(PG8_SB(1, 1), cB + hstep + kstep, voffB);
        PG8_WAIT_V(6); PG8_BAR;
    } else {
        PG8_STAGE(PG8_SB(0, 0), cB, voffB); PG8_STAGE(PG8_SA(0, 0), cA, voffA); PG8_STAGE(PG8_SB(0, 1), cB + hstep, voffB); PG8_STAGE(PG8_SA(0, 1), cA + hstep, voffA);
        if (wr == 1) PG8_BAR;
        PG8_WAIT_V(4); PG8_BAR;
        PG8_STAGE(PG8_SB(1, 0), cB + kstep, voffB); PG8_STAGE(PG8_SA(1, 0), cA + kstep, voffA); PG8_STAGE(PG8_SB(1, 1), cB + hstep + kstep, voffB);
        PG8_WAIT_V(6); PG8_BAR;
    }
    for (;;) {
        const bool has_next = S.next(ui + 1, nxt);
        const char* nA = has_next ? (const char*)g.A + (size_t)nxt.pm * tstep : cA; const char* nB = has_next ? (const char*)g.Bt + (size_t)nxt.pn * tstep : cB;
        for (int t = 0; t < nt; t += 2) {
            const bool last = (t == nt - 2);
            const char* a1 = cA + (size_t)(t + 1) * kstep;
            const char* a2 = last ? nA : cA + (size_t)(t + 2) * kstep; const char* b2 = last ? nB : cB + (size_t)(t + 2) * kstep;
            const char* a3 = a2 + kstep; const char* b3 = b2 + kstep;
            if (last && has_next) S.a_ready(nxt);
            if constexpr (SP2) {
            PG8_LDB(B0, 0, 0); PG8_LDB(B1, 0, 1); PG8_SCHED; PG8_LDA(At, 0, 0); PG8_STAGE(PG8_SA(1, 1), a1 + hstep, voffA);
            PG8_WAIT_V(8); PG8_WAIT_L(0); PG8_BAR; PG8_MMA(0, 0, At, B0); PG8_MMA(0, 1, At, B1); PG8_BAR; PG8_SCHED;
            PG8_LDA(At, 0, 1); PG8_STAGE(PG8_SB(0, 0), b2, voffB); PG8_STAGE(PG8_SB(0, 1), b2 + hstep, voffB); PG8_STAGE(PG8_SA(0, 0), a2, voffA);
            PG8_WAIT_V(8); PG8_WAIT_L(0); PG8_BAR; PG8_MMA(1, 0, At, B0); PG8_MMA(1, 1, At, B1); PG8_BAR; PG8_SCHED;
            PG8_LDB(B0, 1, 0); PG8_LDB(B1, 1, 1); PG8_SCHED; PG8_LDA(At, 1, 0); PG8_STAGE(PG8_SA(0, 1), a2 + hstep, voffA);
            PG8_WAIT_V(8); PG8_WAIT_L(0); PG8_BAR; PG8_MMA(0, 0, At, B0); PG8_MMA(0, 1, At, B1); PG8_BAR; PG8_SCHED;
            PG8_LDA(At, 1, 1); PG8_STAGE(PG8_SB(1, 0), b3, voffB); PG8_STAGE(PG8_SB(1, 1), b3 + hstep, voffB); PG8_STAGE(PG8_SA(1, 0), a3, voffA);
            PG8_WAIT_V(8); PG8_WAIT_L(0); PG8_BAR; PG8_MMA(1, 0, At, B0); PG8_MMA(1, 1, At, B1); PG8_BAR; PG8_SCHED;
            } else {
            PG8_LDB(B0, 0, 0); PG8_SCHED; PG8_LDA(At, 0, 0); PG8_STAGE(PG8_SA(1, 1), a1 + hstep, voffA);
            PG8_WAIT_L(8); PG8_BAR; PG8_WAIT_L(0); PG8_MMA(0, 0, At, B0); PG8_BAR; PG8_SCHED;
            PG8_LDB(B1, 0, 1); PG8_STAGE(PG8_SB(0, 0), b2, voffB);
            PG8_BAR; PG8_WAIT_L(0); PG8_MMA(0, 1, At, B1); PG8_BAR;
            PG8_LDA(At, 0, 1); PG8_STAGE(PG8_SA(0, 0), a2, voffA);
            PG8_BAR; PG8_WAIT_L(0); PG8_MMA(1, 0, At, B0); PG8_BAR; PG8_SCHED;
            PG8_STAGE(PG8_SB(0, 1), b2 + hstep, voffB);
            PG8_WAIT_V(6); PG8_BAR; PG8_MMA(1, 1, At, B1); PG8_BAR;
            PG8_LDB(B0, 1, 0); PG8_SCHED; PG8_LDA(At, 1, 0); PG8_STAGE(PG8_SA(0, 1), a2 + hstep, voffA);
            PG8_WAIT_L(8); PG8_BAR; PG8_WAIT_L(0); PG8_MMA(0, 0, At, B0); PG8_BAR; PG8_SCHED;
            PG8_LDB(B1, 1, 1); PG8_STAGE(PG8_SB(1, 0), b3, voffB);
            PG8_BAR; PG8_WAIT_L(0); PG8_MMA(0, 1, At, B1); PG8_BAR;
            PG8_LDA(At, 1, 1); PG8_STAGE(PG8_SA(1, 0), a3, voffA);
            PG8_BAR; PG8_WAIT_L(0); PG8_MMA(1, 0, At, B0); PG8_BAR; PG8_SCHED;
            PG8_STAGE(PG8_SB(1, 1), b3 + hstep, voffB);
            PG8_WAIT_V(6); PG8_BAR; PG8_MMA(1, 1, At, B1); PG8_BAR;
            }
        }
        if constexpr (ALIGN_EPI) { if (wr == 0) PG8_BAR; }
        if constexpr (!Epi::AFTER_DRAIN) { E(acc, cur, wr, wc, fr, fq); S.done(cur); }
        if (!has_next) break;
#pragma unroll
        for (int a = 0; a < 2; ++a)
#pragma unroll
            for (int b = 0; b < 2; ++b)
#pragma unroll
                for (int m = 0; m < 4; ++m)
#pragma unroll
                    for (int n = 0; n < 2; ++n) acc[a][b][m][n] = (f32x4){0.f, 0.f, 0.f, 0.f};
        cur = nxt; cA = nA; cB = nB; ++ui;
        if constexpr (ALIGN_EPI) { if (wr == 1) PG8_BAR; }
    }
    PG8_WAIT_V(0);
    if constexpr (!ALIGN_EPI) { if (wr == 0) PG8_BAR; }
    PG8_BAR;
    if constexpr (Epi::AFTER_DRAIN) { E.fused(acc, cur, wr, wc, fr, fq, lds, wid, lane); S.done(cur); }
#undef PG8_SA
#undef PG8_SB
#undef PG8_STAGE
#undef PG8_LDA
#undef PG8_LDB
#undef PG8_MMA
#undef PG8_WAIT_V
#undef PG8_WAIT_L
#undef PG8_BAR
#undef PG8_SCHED
}
}
#define LAS __attribute__((address_space(3)))
typedef unsigned short bf16;
typedef float f32x4 __attribute__((ext_vector_type(4)));
typedef short bf16x8 __attribute__((ext_vector_type(8)));
typedef unsigned u32x4 __attribute__((ext_vector_type(4)));
typedef unsigned u32x2 __attribute__((ext_vector_type(2)));

constexpr int D = 1024, NBATCH = 2, SEQ = 8192, CTXL = 256, DEPTH = 2;
constexpr int NLAT = NBATCH * SEQ, NCTX = NBATCH * CTXL, NROW = NLAT + NCTX;
constexpr int DR = 512, DIN = 2944, NP = 3328, ZW = 1920, NHEAD = 8;
constexpr int COL_CONV = 1920, COL_FC = 2688, COL_FS = 2944;
constexpr int STRW = 5120;
constexpr int NEXP = 32, DEXP = 512;
constexpr int MOE_MAXTILES = 168;
constexpr float RMS_EPS = 1e-6f, GN_EPS = 64e-5f;

enum { I_X = 0, I_C, I_CTX, I_CCTX, I_ADAW, I_ADAB, I_N1G, I_N2G, I_WIN, I_MU, I_DW0, I_DW2, I_IA0, I_IA2, I_GG2, I_KK, I_KA, I_RK, I_GNW, I_GNB,
       I_CONVW, I_CONVG, I_FOURG, I_WOUT, I_RGW, I_RGB, I_REW, I_REB, I_EG, I_EU, I_ED, I_FG, N_IN };

constexpr size_t MiB = 1u << 20;
constexpr size_t WS_CTL = 0, CTL_ZERO_BYTES = 1 * MiB;
constexpr size_t WS_MODP = 1 * MiB;
constexpr size_t WS_MODF = 1 * MiB + 1280 * 1024;
constexpr size_t WS_WIN_T = 3 * MiB;
constexpr size_t WS_WOUT_T = 16 * MiB;
constexpr size_t WS_WGU_T = 20 * MiB;
constexpr size_t WS_WD_T = 84 * MiB;
constexpr size_t WS_X = 116 * MiB;
constexpr size_t WS_H = 182 * MiB;
constexpr size_t WS_ZS = 215 * MiB;
constexpr size_t WS_P = 277 * MiB;
constexpr size_t WS_STR = 277 * MiB;
constexpr size_t WS_Y = 442 * MiB;
constexpr size_t WS_GT = 475 * MiB;
constexpr size_t WS_ROUTE = 491 * MiB;
constexpr size_t WS_XS = 215 * MiB;
constexpr size_t WS_ACT = 299 * MiB;
constexpr size_t WS_END = 516 * MiB;
constexpr size_t RT_E = 0, RT_POS = 1 * 33792 * 4, RT_GATE = 2 * 33792 * 4, RT_SLOT = 3 * 33792 * 4, RT_TILE = 4 * 33792 * 4, RT_NT = RT_TILE + 1024;

constexpr int CW_BAR = 4096;
constexpr int CW_CNT = 8192;

constexpr int NWAVES = 8, NTHR = 512;
constexpr int RING_BYTES = 131072, LDSCTL_OFF = 143360, MISC_OFF = LDSCTL_OFF + 320, LDS_BYTES = 147456;

struct Params { const float* in[N_IN]; float* out; unsigned char* ws; };

__device__ __forceinline__ float bf2f(unsigned h) { return __uint_as_float(h << 16); }
__device__ __forceinline__ unsigned f2bf(float f) { unsigned u = __float_as_uint(f); return (u + 0x7fffu + ((u >> 16) & 1u)) >> 16; }
__device__ __forceinline__ unsigned pk2(float lo, float hi) { return f2bf(lo) | (f2bf(hi) << 16); }
__device__ __forceinline__ float wave_sum(float v) {
#pragma unroll
    for (int o = 1; o < 64; o <<= 1) v += __shfl_xor(v, o);
    return v;
}
__device__ __forceinline__ float sigmoidf_(float x) { return 1.f / (1.f + __expf(-x)); }
#define LDS_WAIT() asm volatile("s_waitcnt lgkmcnt(0)" ::: "memory")
#define VM_WAIT() asm volatile("s_waitcnt vmcnt(0)" ::: "memory")

struct Frame {
    LAS unsigned char* lds;
    int tid, lane, wave, vcu, G, gw, NGW;
    float* out; unsigned char* ws;
};
__device__ __forceinline__ const float* inptr(int i) {
    const volatile unsigned long long __attribute__((address_space(4)))* ka = (const volatile unsigned long long __attribute__((address_space(4)))*)__builtin_amdgcn_kernarg_segment_ptr();
    return (const float*)ka[i];
}
__device__ __forceinline__ unsigned char* opaque(unsigned char* p) { asm volatile("" : "+s"(p)); return p; }
__device__ __forceinline__ Frame phase_frame(const Frame& F0) { Frame F = F0; asm volatile("" : "+v"(F.tid)); F.lane = F.tid & 63; F.ws = opaque(F0.ws);
    asm volatile("" : "+s"(F.G), "+s"(F.vcu)); F.gw = F.vcu * NWAVES + F.wave; F.NGW = F.G * NWAVES; return F; }
__device__ __forceinline__ int modrow(int row) { return row < NLAT ? (row >> 13) : 2; }
#define XB_TMO      128
#define XB_XCNT(j)  (256  + 64 * (j))
#define XB_XSUB(j)  (1280 + 64 * (j))
#define XB_XGEN(j)  (2304 + 64 * (j))
#define XB_TOP      3328
#define XB_TOPGEN   3392
#define XCD_BAR_WORDS 3456
#define XB_SPIN_CAP (1u << 18)

__device__ __forceinline__ unsigned xb_ld(unsigned* p)              { return __hip_atomic_load(p, __ATOMIC_RELAXED, __HIP_MEMORY_SCOPE_AGENT); }
__device__ __forceinline__ unsigned xb_add(unsigned* p, unsigned v) { return __hip_atomic_fetch_add(p, v, __ATOMIC_RELAXED, __HIP_MEMORY_SCOPE_AGENT); }
__device__ __forceinline__ unsigned xb_xcc_id() { return (unsigned)__builtin_amdgcn_s_getreg((3 << 11) | 20) & 0xFu; }
#define XB_SPIN(cond, bar) do { unsigned _sp = 0; while (cond) { __builtin_amdgcn_s_sleep(1); \
    if ((++_sp & 255u) == 0u) { if (xb_ld(&(bar)[XB_TMO])) break; if (_sp > XB_SPIN_CAP) { atomicAdd(&(bar)[XB_TMO], 1u); break; } } } } while (0)

struct XcdBarrier {
    unsigned* bar; unsigned x;
    volatile LAS unsigned* st;
};

__device__ __forceinline__ XcdBarrier xcd_barrier_post(unsigned* bar, volatile LAS unsigned* st) {
    XcdBarrier b; b.bar = bar; b.x = xb_xcc_id(); b.st = st;
    if (threadIdx.x == 0) (void)xb_add(&bar[XB_XCNT(b.x)], 1u);
    return b;
}
__device__ __forceinline__ void xcd_barrier_complete(unsigned* bar, unsigned x, unsigned& nloc, unsigned& nx) {
    const unsigned G = gridDim.x * gridDim.y * gridDim.z;
    unsigned sum, cnt, mine, sp = 0u;
    for (;;) {
        sum = 0u; cnt = 0u; mine = 0u;
#pragma nounroll
        for (unsigned j = 0; j < 16; ++j) { const unsigned c = xb_ld(&bar[XB_XCNT(j)]); sum += c; cnt += (c > 0u) ? 1u : 0u; mine = (j == x) ? c : mine; }
        if (sum == G) break;
        __builtin_amdgcn_s_sleep(1);
        if ((++sp & 255u) == 0u) { if (xb_ld(&bar[XB_TMO])) break; if (sp > XB_SPIN_CAP) { atomicAdd(&bar[XB_TMO], 1u); break; } }
    }
    nloc = mine > 0u ? mine : 1u; nx = cnt > 0u ? cnt : 1u;
}

__device__ __forceinline__ void xcd_barrier(const XcdBarrier& b) {
    asm volatile("s_waitcnt vmcnt(0)" ::: "memory");
    __syncthreads();
    if (threadIdx.x == 0) {
        unsigned* bar = b.bar;
        asm volatile("" : "+s"(bar));
        __builtin_amdgcn_s_waitcnt(0);
        unsigned nloc = b.st[0], nx = b.st[1];
        if (nloc == 0u) { xcd_barrier_complete(bar, b.x, nloc, nx); b.st[0] = nloc; b.st[1] = nx; }
        const unsigned old = xb_add(&bar[XB_XSUB(b.x)], 1u);
        const unsigned gen = old / nloc;
        if (old + 1u == (gen + 1u) * nloc) {
            __builtin_amdgcn_fence(__ATOMIC_RELEASE, "agent");
            asm volatile("s_waitcnt vmcnt(0)" ::: "memory");
            const unsigned og = xb_add(&bar[XB_TOP], 1u);
            const unsigned tg = og / nx;
            if (og + 1u == (tg + 1u) * nx) xb_add(&bar[XB_TOPGEN], 1u);
            else XB_SPIN(xb_ld(&bar[XB_TOPGEN]) == tg, bar);
            __builtin_amdgcn_fence(__ATOMIC_ACQUIRE, "agent");
            xb_add(&bar[XB_XGEN(b.x)], 1u);
            asm volatile("s_waitcnt vmcnt(0)" ::: "memory");
        } else {
            XB_SPIN(xb_ld(&bar[XB_XGEN(b.x)]) == gen, bar);
            __builtin_amdgcn_fence(__ATOMIC_ACQUIRE, "agent");
            asm volatile("s_waitcnt vmcnt(0)" ::: "memory");
        }
    }
    __syncthreads();
}
template <class RowMap>
__device__ __forceinline__ void transpose_item(const float* W, int ldw, int k0, int n0, bf16* WT, int ldt, RowMap rm, LAS float* scr, int lane) {
#pragma unroll 8
    for (int i = 0; i < 32; ++i) { const int kk = 2 * i + (lane >> 5); scr[kk * 33 + (lane & 31)] = W[(size_t)(k0 + kk) * ldw + n0 + (lane & 31)]; }
    LDS_WAIT(); asm volatile("" ::: "memory");
    const int c = lane & 7;
#pragma unroll
    for (int j = 0; j < 4; ++j) { const int n = (lane >> 3) + 8 * j; const LAS float* s = scr + (8 * c) * 33 + n;
        u32x4 o; o.x = pk2(s[0 * 33], s[1 * 33]); o.y = pk2(s[2 * 33], s[3 * 33]); o.z = pk2(s[4 * 33], s[5 * 33]); o.w = pk2(s[6 * 33], s[7 * 33]);
        *(u32x4*)(WT + (size_t)rm(n0 + n) * ldt + k0 + 8 * c) = o; }
    LDS_WAIT(); asm volatile("" ::: "memory");
}
struct RmId { int off; __device__ __forceinline__ int operator()(int n) const { return off + n; } };
struct RmGU { int off; __device__ __forceinline__ int operator()(int n) const { return off + ((n >> 2) << 3) + (n & 3); } };

__device__ __forceinline__ void p0_prologue(const Frame& F0) {
    const Frame F = phase_frame(F0); unsigned char* const ws = F.ws;
    LAS float* scr = (LAS float*)(F.lds + F.wave * 16384);
    LAS float* ctab = (LAS float*)(F.lds + 8 * 16384);
    if (F.tid < 64) ctab[F.tid] = cosf((float)F.tid * (6.283185307179586f / 64.f));
    __syncthreads();
    bf16* win_t = (bf16*)(ws + WS_WIN_T); bf16* wout_t = (bf16*)(ws + WS_WOUT_T);
    constexpr int I_WIN_L = 16 * 84, I_WOUT_L = 16 * 32, I_FOLD_L = 4 * 64, I_MOD_L = 96 * 8;
    constexpr int NIT = 2 * (I_WIN_L + I_WOUT_L + I_FOLD_L + I_MOD_L);
    const float* p_win = inptr(I_WIN); const float* p_wout = inptr(I_WOUT); const float* p_c = inptr(I_C); const float* p_cctx = inptr(I_CCTX); const float* p_adaw = inptr(I_ADAW);
    for (int it = F.gw; it < NIT; it += F.NGW) {
        int r = it; const int l = r & 1; r >>= 1;
        if (r < I_WIN_L) { const int kb = r / 84, nb = r % 84;
            transpose_item(p_win + (size_t)l * D * DIN, DIN, kb * 64, nb * 32, win_t + (size_t)l * NP * D, D, RmId{0}, scr, F.lane); continue; }
        r -= I_WIN_L;
        if (r < I_WOUT_L) { const int kb = r / 32, nb = r % 32;
            transpose_item(p_wout + (size_t)l * D * D, D, kb * 64, nb * 32, wout_t + (size_t)l * D * D, D, RmId{0}, scr, F.lane); continue; }
        r -= I_WOUT_L;
        if (r < I_FOLD_L) {
            const int g = r >> 6, k0 = (r & 63) * 16; const float* W = p_win + (size_t)l * D * DIN;
#pragma unroll
            for (int kk = 0; kk < 16; ++kk) scr[kk * 64 + F.lane] = W[(size_t)(k0 + kk) * DIN + 2688 + g * 64 + F.lane];
            LDS_WAIT(); asm volatile("" ::: "memory");
            float ac[16], as[16];
#pragma unroll
            for (int kk = 0; kk < 16; ++kk) { ac[kk] = 0.f; as[kk] = 0.f; }
            for (int c = 0; c < 64; ++c) { const int idx = (c * F.lane) & 63; const float cc = ctab[idx], ss = ctab[(idx - 16) & 63];
#pragma unroll
                for (int kk = 0; kk < 16; ++kk) { const float w = scr[kk * 64 + c]; ac[kk] += w * cc; as[kk] += w * ss; } }
            bf16* oc = win_t + (size_t)l * NP * D + (size_t)(COL_FC + g * 64 + F.lane) * D + k0;
            bf16* os = win_t + (size_t)l * NP * D + (size_t)(COL_FS + g * 64 + F.lane) * D + k0;
            u32x4 a, b;
            a.x = pk2(ac[0], ac[1]); a.y = pk2(ac[2], ac[3]); a.z = pk2(ac[4], ac[5]); a.w = pk2(ac[6], ac[7]);
            b.x = pk2(ac[8], ac[9]); b.y = pk2(ac[10], ac[11]); b.z = pk2(ac[12], ac[13]); b.w = pk2(ac[14], ac[15]);
            *(u32x4*)oc = a; *(u32x4*)(oc + 8) = b;
            a.x = pk2(as[0], as[1]); a.y = pk2(as[2], as[3]); a.z = pk2(as[4], as[5]); a.w = pk2(as[6], as[7]);
            b.x = pk2(as[8], as[9]); b.y = pk2(as[10], as[11]); b.z = pk2(as[12], as[13]); b.w = pk2(as[14], as[15]);
            *(u32x4*)os = a; *(u32x4*)(os + 8) = b;
            LDS_WAIT(); asm volatile("" ::: "memory");
            continue; }
        r -= I_FOLD_L;
        {
            const int cb = r >> 3, ks = r & 7;
#pragma unroll
            for (int q = 0; q < 2; ++q) { const int k = ks * 128 + q * 64 + F.lane;
                const float c0 = p_c[k], c1 = p_c[D + k], c2 = p_cctx[k];
                scr[0 * 128 + q * 64 + F.lane] = c0 * sigmoidf_(c0); scr[1 * 128 + q * 64 + F.lane] = c1 * sigmoidf_(c1); scr[2 * 128 + q * 64 + F.lane] = c2 * sigmoidf_(c2); }
            LDS_WAIT(); asm volatile("" ::: "memory");
            const float* W = p_adaw + (size_t)l * D * 6144 + (size_t)(ks * 128) * 6144 + cb * 64 + F.lane;
            float a0 = 0.f, a1 = 0.f, a2 = 0.f;
#pragma unroll 8
            for (int kk = 0; kk < 128; ++kk) { const float w = W[(size_t)kk * 6144]; a0 += scr[kk] * w; a1 += scr[128 + kk] * w; a2 += scr[256 + kk] * w; }
            float* mp = (float*)(ws + WS_MODP) + (size_t)((l * 8 + ks) * 3) * 6144 + cb * 64 + F.lane;
            mp[0] = a0; mp[6144] = a1; mp[2 * 6144] = a2;
            LDS_WAIT(); asm volatile("" ::: "memory");
        }
    }
}

__device__ __forceinline__ void mod_to_lds(const Frame& F0, int l, int p, LAS float* dst, bool from_partials) {
    const Frame F = phase_frame(F0); unsigned char* const ws = F.ws;
    const float* adab = inptr(I_ADAB);
    for (int idx = F.tid; idx < 3 * 1024; idx += NTHR) { const int r = idx >> 10, n = idx & 1023;
        float v;
        if (from_partials) { v = adab[l * 6144 + p * 1024 + n]; const float* mp = (const float*)(ws + WS_MODP) + (size_t)(l * 8 * 3 + r) * 6144 + p * 1024 + n;
#pragma unroll
            for (int ks = 0; ks < 8; ++ks) v += mp[(size_t)ks * 3 * 6144]; }
        else v = ((const float*)(ws + WS_MODF))[(size_t)(l * 3 + r) * 6144 + p * 1024 + n];
        dst[idx] = v; }
}
__device__ __forceinline__ void mod_finalize(const Frame& F0) {
    const Frame F = phase_frame(F0); unsigned char* const ws = F.ws;
    const float* adab = inptr(I_ADAB);
    for (int idx = F.vcu * NTHR + F.tid; idx < 2 * 3 * 6144; idx += F.G * NTHR) { const int l = idx / (3 * 6144), rem = idx % (3 * 6144), r = rem / 6144, n = rem % 6144;
        float v = adab[l * 6144 + n]; const float* mp = (const float*)(ws + WS_MODP) + (size_t)(l * 8 * 3 + r) * 6144 + n;
#pragma unroll
        for (int ks = 0; ks < 8; ++ks) v += mp[(size_t)ks * 3 * 6144];
        ((float*)(ws + WS_MODF))[idx] = v; }
}


__device__ __forceinline__ void norm_mod_row(f32x4 (&v)[4], const float* gain, const LAS float* sc, const LAS float* sh, bf16* orow, int lane) {
    float s = 0.f;
#pragma unroll
    for (int j = 0; j < 4; ++j) s += (v[j].x * v[j].x + v[j].y * v[j].y) + (v[j].z * v[j].z + v[j].w * v[j].w);
    const float rs = rsqrtf(wave_sum(s) * (1.f / D) + RMS_EPS);
#pragma unroll
    for (int j = 0; j < 4; ++j) { const int c = 4 * lane + 256 * j; const f32x4 g = *(const f32x4*)(gain + c); const f32x4 a = *(const LAS f32x4*)(sc + c), b = *(const LAS f32x4*)(sh + c);
        v[j] = (v[j] * rs) * g * (a + 1.f) + b;
        u32x2 w; w.x = pk2(v[j].x, v[j].y); w.y = pk2(v[j].z, v[j].w); *(u32x2*)(orow + c) = w; }
}

__device__ __forceinline__ void p0b_norm1(const Frame& F0) {
    const Frame F = phase_frame(F0); unsigned char* const ws = F.ws;
    LAS float* msh = (LAS float*)F.lds; LAS float* msc = msh + 3072;
    mod_to_lds(F, 0, 0, msh, true); mod_to_lds(F, 0, 1, msc, true); __syncthreads();
    mod_finalize(F);
    bf16* H = (bf16*)(ws + WS_H); const float* xin = inptr(I_X); const float* cin = inptr(I_CTX); const float* n1g = inptr(I_N1G);
    for (int row = F.gw; row < NROW; row += F.NGW) { const float* xr = row < NLAT ? xin + (size_t)row * D : cin + (size_t)(row - NLAT) * D; f32x4 v[4];
#pragma unroll
        for (int j = 0; j < 4; ++j) v[j] = *(const f32x4*)(xr + 4 * F.lane + 256 * j);
        const int mr = modrow(row);
        norm_mod_row(v, n1g, msc + mr * 1024, msh + mr * 1024, H + (size_t)row * D, F.lane); }
}
__device__ __forceinline__ void unpack8(const u32x4 w, float (&o)[8]) {
    o[0] = bf2f(w.x & 0xffffu); o[1] = bf2f(w.x >> 16); o[2] = bf2f(w.y & 0xffffu); o[3] = bf2f(w.y >> 16);
    o[4] = bf2f(w.z & 0xffffu); o[5] = bf2f(w.z >> 16); o[6] = bf2f(w.w & 0xffffu); o[7] = bf2f(w.w >> 16);
}
__device__ __forceinline__ void unpack4(const u32x2 w, float (&o)[4]) { o[0] = bf2f(w.x & 0xffffu); o[1] = bf2f(w.x >> 16); o[2] = bf2f(w.y & 0xffffu); o[3] = bf2f(w.y >> 16); }

__device__ __forceinline__ void shift_pass(const Frame& F0, int l) {
    const Frame F = phase_frame(F0); unsigned char* const ws = F.ws;
    const bf16* P = (const bf16*)(ws + WS_P); bf16* Zs = (bf16*)(ws + WS_ZS); const float* mu = inptr(I_MU) + l * ZW;
    const int total = NROW * 240;
    for (int idx = F.vcu * NTHR + F.tid; idx < total; idx += F.G * NTHR) {
        const int row = idx / 240, ck = idx % 240; const bf16* pr = P + (size_t)row * NP + ck * 8;
        const u32x4 zero = {0u, 0u, 0u, 0u};
        float z[8], n0[8], n1[8], n2[8], n3[8], o[8];
        unpack8(*(const u32x4*)pr, z);
        if (row < NLAT) { const int t = row & (SEQ - 1), gr = t >> 6, gc = t & 63;
            unpack8(gc > 0 ? *(const u32x4*)(pr - NP) : zero, n0); unpack8(gc < 63 ? *(const u32x4*)(pr + NP) : zero, n1);
            unpack8(gr > 0 ? *(const u32x4*)(pr - 64 * NP) : zero, n2); unpack8(gr < 127 ? *(const u32x4*)(pr + 64 * NP) : zero, n3);
        } else { const int tc = (row - NLAT) & (CTXL - 1);
            unpack8(tc > 0 ? *(const u32x4*)(pr - NP) : zero, n0); unpack8(tc < CTXL - 1 ? *(const u32x4*)(pr + NP) : zero, n1);
#pragma unroll
            for (int j = 0; j < 8; ++j) { n2[j] = n0[j]; n3[j] = n1[j]; }
        }
        const f32x4 m0 = *(const f32x4*)(mu + ck * 8), m1 = *(const f32x4*)(mu + ck * 8 + 4);
        const float m[8] = {m0.x, m0.y, m0.z, m0.w, m1.x, m1.y, m1.z, m1.w};
#pragma unroll
        for (int j = 0; j < 8; ++j) { const float nb = (j & 3) == 0 ? n0[j] : (j & 3) == 1 ? n1[j] : (j & 3) == 2 ? n2[j] : n3[j]; o[j] = z[j] + (nb - z[j]) * m[j]; }
        u32x4 w; w.x = pk2(o[0], o[1]); w.y = pk2(o[2], o[3]); w.z = pk2(o[4], o[5]); w.w = pk2(o[6], o[7]);
        *(u32x4*)(Zs + (size_t)row * ZW + ck * 8) = w;
    }
}

__device__ __forceinline__ void conv_pass(const Frame& F0, int l, int nrows) {
    const Frame F = phase_frame(F0); unsigned char* const ws = F.ws;
    const bf16* P = (const bf16*)(ws + WS_P); bf16* MA = (bf16*)(ws + WS_H);
    const float* cw = inptr(I_CONVW) + l * 3 * 256; const int c = 4 * F.lane;
    const f32x4 w0 = *(const f32x4*)(cw + c), w1 = *(const f32x4*)(cw + 256 + c), w2 = *(const f32x4*)(cw + 512 + c), gn = *(const f32x4*)(inptr(I_CONVG) + l * 256 + c);
    for (int row = F.gw; row < nrows; row += F.NGW) {
        int t, L; if (row < NLAT) { t = row & (SEQ - 1); L = SEQ; } else { t = (row - NLAT) & (CTXL - 1); L = CTXL; }
        const bf16* pr = P + (size_t)row * NP + COL_CONV + c;
        float bg[4], cg[4], hh[4], cp[4], hp[4], cn[4], hn[4]; const u32x2 zero = {0u, 0u};
        unpack4(*(const u32x2*)pr, bg); unpack4(*(const u32x2*)(pr + 256), cg); unpack4(*(const u32x2*)(pr + 512), hh);
        unpack4(t > 0 ? *(const u32x2*)(pr - NP + 256) : zero, cp); unpack4(t > 0 ? *(const u32x2*)(pr - NP + 512) : zero, hp);
        unpack4(t < L - 1 ? *(const u32x2*)(pr + NP + 256) : zero, cn); unpack4(t < L - 1 ? *(const u32x2*)(pr + NP + 512) : zero, hn);
        const float W0[4] = {w0.x, w0.y, w0.z, w0.w}, W1[4] = {w1.x, w1.y, w1.z, w1.w}, W2[4] = {w2.x, w2.y, w2.z, w2.w}, GN[4] = {gn.x, gn.y, gn.z, gn.w};
        float y[4], s = 0.f;
#pragma unroll
        for (int j = 0; j < 4; ++j) { y[j] = bg[j] * (W0[j] * (cp[j] * hp[j]) + W1[j] * (cg[j] * hh[j]) + W2[j] * (cn[j] * hn[j])); s += y[j] * y[j]; }
        const float rs = rsqrtf(wave_sum(s) * (1.f / 256.f) + RMS_EPS);
        u32x2 o; o.x = pk2(y[0] * rs * GN[0], y[1] * rs * GN[1]); o.y = pk2(y[2] * rs * GN[2], y[3] * rs * GN[3]);
        *(u32x2*)(MA + (size_t)row * D + 512 + c) = o;
    }
}

#define MFMA16(a, b, c) __builtin_amdgcn_mfma_f32_16x16x32_bf16((a), (b), (c), 0, 0, 0)

__device__ __forceinline__ void fftA_item(const Frame& F0, int item) {
    const Frame F = phase_frame(F0); unsigned char* const ws = F.ws;
    const int half = item & 1, t2 = (item >> 1) & 63, b = item >> 7;
    const bf16* P = (const bf16*)(ws + WS_P); bf16* GT = (bf16*)(ws + WS_GT);
    LAS bf16* Bs = (LAS bf16*)F.lds;
    const int lane = F.lane, w = F.wave, fr = lane & 15, fq = lane >> 4;
    __syncthreads();
#pragma unroll
    for (int i = 0; i < 8; ++i) { const int cidx = F.tid + NTHR * i, krow = cidx >> 4, ch8 = cidx & 15, ri = krow >> 7, t1 = krow & 127;
        const u32x4 v = *(const u32x4*)(P + (size_t)(b * SEQ + t1 * 64 + t2) * NP + COL_FC + ri * 256 + half * 128 + ch8 * 8);
        LAS bf16* d = Bs + (ch8 * 8) * 264 + krow;
        d[0 * 264] = (bf16)(v.x & 0xffffu); d[1 * 264] = (bf16)(v.x >> 16); d[2 * 264] = (bf16)(v.y & 0xffffu); d[3 * 264] = (bf16)(v.y >> 16);
        d[4 * 264] = (bf16)(v.z & 0xffffu); d[5 * 264] = (bf16)(v.z >> 16); d[6 * 264] = (bf16)(v.w & 0xffffu); d[7 * 264] = (bf16)(v.w >> 16); }
    __syncthreads();
    f32x4 acc[2][8];
#pragma unroll
    for (int a = 0; a < 2; ++a)
#pragma unroll
        for (int n = 0; n < 8; ++n) acc[a][n] = (f32x4){0.f, 0.f, 0.f, 0.f};
    int t1p_a = 16 * w + fr;
    asm volatile("" : "+v"(t1p_a));
#pragma unroll
    for (int ks = 0; ks < 8; ++ks) {
        bf16x8 ar, ai;
#pragma unroll
        for (int j = 0; j < 8; ++j) { const int k = ks * 32 + 8 * fq + j, ri = k >> 7, t1 = k & 127; const int idx = (t1 * t1p_a) & 127;
            float sn, cs; __sincosf((float)idx * (6.283185307179586f / 128.f), &sn, &cs);
            const float vr = ri == 0 ? cs : -sn, vi = ri == 0 ? -sn : -cs;
            ar[j] = (short)f2bf(vr); ai[j] = (short)f2bf(vi); }
#pragma unroll
        for (int nt = 0; nt < 8; ++nt) { const bf16x8 bfr = *(const LAS bf16x8*)(Bs + (nt * 16 + fr) * 264 + ks * 32 + 8 * fq);
            acc[0][nt] = MFMA16(ar, bfr, acc[0][nt]); acc[1][nt] = MFMA16(ai, bfr, acc[1][nt]); }
    }
#pragma unroll
    for (int reg = 0; reg < 4; ++reg) { const int t1p = 16 * w + 4 * fq + reg; float st, ct; __sincosf((float)(t2 * t1p) * (6.283185307179586f / 8192.f), &st, &ct);
        bf16* g = GT + ((size_t)((b * 128 + t1p) * 64 + t2) * 2) * 256 + half * 128 + fr;
#pragma unroll
        for (int nt = 0; nt < 8; ++nt) { const float gr = acc[0][nt][reg], gi = acc[1][nt][reg];
            g[nt * 16] = (bf16)f2bf(gr * ct + gi * st); g[256 + nt * 16] = (bf16)f2bf(gi * ct - gr * st); } }
}

template <int NKC, int NDIV, class SrcRow, class OutRow>
__device__ __forceinline__ void dft64_item(const Frame& F0, int l, int m0, float sgn, float scale, SrcRow src, OutRow orow) {
    const Frame F = phase_frame(F0); unsigned char* const ws = F.ws;
    LAS bf16* Bs = (LAS bf16*)F.lds;
    LAS float* red = (LAS float*)(F.lds + 256 * 136 * 2);
    const int lane = F.lane, w = F.wave, fr = lane & 15, fq = lane >> 4;
    int fr_a = fr; asm volatile("" : "+v"(fr_a));
    f32x4 acc[4][2];
#pragma unroll
    for (int a = 0; a < 4; ++a) { acc[a][0] = (f32x4){0.f, 0.f, 0.f, 0.f}; acc[a][1] = (f32x4){0.f, 0.f, 0.f, 0.f}; }
    for (int kc = 0; kc < NKC; ++kc) {
        __syncthreads();
#pragma unroll
        for (int i = 0; i < 8; ++i) { const int cidx = F.tid + NTHR * i, krow = cidx >> 5, ch8 = cidx & 31;
            const u32x4 v = *(const u32x4*)(src(kc * 64 + (krow >> 1), krow & 1) + ch8 * 8);
            LAS bf16* d = Bs + (ch8 * 8) * 136 + krow;
            d[0 * 136] = (bf16)(v.x & 0xffffu); d[1 * 136] = (bf16)(v.x >> 16); d[2 * 136] = (bf16)(v.y & 0xffffu); d[3 * 136] = (bf16)(v.y >> 16);
            d[4 * 136] = (bf16)(v.z & 0xffffu); d[5 * 136] = (bf16)(v.z >> 16); d[6 * 136] = (bf16)(v.w & 0xffffu); d[7 * 136] = (bf16)(v.w >> 16); }
        __syncthreads();
#pragma unroll
        for (int ks = 0; ks < 4; ++ks) {
            const bf16x8 b0 = *(const LAS bf16x8*)(Bs + ((2 * w) * 16 + fr) * 136 + ks * 32 + 8 * fq);
            const bf16x8 b1 = *(const LAS bf16x8*)(Bs + ((2 * w + 1) * 16 + fr) * 136 + ks * 32 + 8 * fq);
#pragma unroll
            for (int mt = 0; mt < 4; ++mt) { const int mrow = m0 + mt * 16 + fr_a; bf16x8 a;
#pragma unroll
                for (int j = 0; j < 8; ++j) { const int k = ks * 32 + 8 * fq + j, tl = k >> 1, ri = k & 1; const int idx = ((kc * 64 + tl) * mrow) & (NDIV - 1);
                    float sn, cs; __sincosf((float)idx * (6.283185307179586f / (float)NDIV), &sn, &cs);
                    a[j] = (short)f2bf(ri == 0 ? cs : sgn * sn); }
                acc[mt][0] = MFMA16(a, b0, acc[mt][0]); acc[mt][1] = MFMA16(a, b1, acc[mt][1]); }
        }
    }
#pragma unroll
    for (int mt = 0; mt < 4; ++mt)
#pragma unroll
        for (int reg = 0; reg < 4; ++reg) { const float a = acc[mt][0][reg] * scale, b = acc[mt][1][reg] * scale; acc[mt][0][reg] = a; acc[mt][1][reg] = b;
            float s = a * a + b * b; s += __shfl_xor(s, 1); s += __shfl_xor(s, 2); s += __shfl_xor(s, 4); s += __shfl_xor(s, 8);
            if (fr == 0) red[w * 64 + mt * 16 + 4 * fq + reg] = s; }
    __syncthreads();
    bf16* MA = (bf16*)(ws + WS_H); const float* fg = inptr(I_FOURG) + l * 256;
    const float g0 = fg[(2 * w) * 16 + fr], g1 = fg[(2 * w + 1) * 16 + fr];
#pragma unroll
    for (int mt = 0; mt < 4; ++mt)
#pragma unroll
        for (int reg = 0; reg < 4; ++reg) { const int ml = mt * 16 + 4 * fq + reg; float tot = 0.f;
#pragma unroll
            for (int ww = 0; ww < 8; ++ww) tot += red[ww * 64 + ml];
            const float rs = rsqrtf(tot * (1.f / 256.f) + RMS_EPS);
            bf16* o = MA + (size_t)orow(m0 + ml) * D + 768 + fr;
            o[(2 * w) * 16] = (bf16)f2bf(acc[mt][0][reg] * rs * g0); o[(2 * w + 1) * 16] = (bf16)f2bf(acc[mt][1][reg] * rs * g1); }
    __syncthreads();
}

__device__ __forceinline__ void prep_item(const Frame& F0, int l, int item) {
    const Frame F = phase_frame(F0); unsigned char* const ws = F.ws;
    const bf16* Zs = (const bf16*)(ws + WS_ZS); bf16* STR = (bf16*)(ws + WS_STR);
    LAS float* lin = (LAS float*)F.lds;
    const int row0 = item * 16, c = F.tid;
    __syncthreads();
#pragma unroll
    for (int i = 0; i < 12; ++i) { const int idx = F.tid + NTHR * i, t = idx / 384, ci = idx % 384;
        float v = bf2f(Zs[(size_t)(row0 + t) * ZW + 1536 + ci]);
        if (ci < 128) v = tanhf(v); else if (ci >= 256) v = sigmoidf_(v);
        lin[idx] = v; }
    __syncthreads();
    float aw0[16], aw1[16], aa0[16], aa1[16], ag[16];
#pragma unroll
    for (int t = 0; t < 16; ++t) { aw0[t] = 0.f; aw1[t] = 0.f; aa0[t] = 0.f; aa1[t] = 0.f; ag[t] = 0.f; }
    const float* dw2 = inptr(I_DW2) + (size_t)l * 2 * 64 * DR + c; const float* ia2 = inptr(I_IA2) + (size_t)l * 2 * 64 * DR + c; const float* gg2 = inptr(I_GG2) + (size_t)l * 128 * DR + c;
    for (int j = 0; j < 64; j += 4) {
        float w0[4], w1[4], a0[4], a1[4];
#pragma unroll
        for (int q = 0; q < 4; ++q) { w0[q] = dw2[(size_t)(j + q) * DR]; w1[q] = dw2[(size_t)(64 + j + q) * DR]; a0[q] = ia2[(size_t)(j + q) * DR]; a1[q] = ia2[(size_t)(64 + j + q) * DR]; }
#pragma unroll
        for (int t = 0; t < 16; ++t) { const f32x4 x0 = *(const LAS f32x4*)(lin + t * 384 + j), x1 = *(const LAS f32x4*)(lin + t * 384 + 64 + j),
                                                   x2 = *(const LAS f32x4*)(lin + t * 384 + 128 + j), x3 = *(const LAS f32x4*)(lin + t * 384 + 192 + j);
            aw0[t] += x0.x * w0[0] + x0.y * w0[1] + x0.z * w0[2] + x0.w * w0[3];
            aw1[t] += x1.x * w1[0] + x1.y * w1[1] + x1.z * w1[2] + x1.w * w1[3];
            aa0[t] += x2.x * a0[0] + x2.y * a0[1] + x2.z * a0[2] + x2.w * a0[3];
            aa1[t] += x3.x * a1[0] + x3.y * a1[1] + x3.z * a1[2] + x3.w * a1[3]; }
    }
    for (int j = 0; j < 128; j += 4) {
        float g[4];
#pragma unroll
        for (int q = 0; q < 4; ++q) g[q] = gg2[(size_t)(j + q) * DR];
#pragma unroll
        for (int t = 0; t < 16; ++t) { const f32x4 x = *(const LAS f32x4*)(lin + t * 384 + 256 + j); ag[t] += x.x * g[0] + x.y * g[1] + x.z * g[2] + x.w * g[3]; }
    }
    const float kkw = inptr(I_KK)[l * DR + c], kaw = inptr(I_KA)[l * DR + c];
    const float d00 = inptr(I_DW0)[(l * 2 + 0) * DR + c], d01 = inptr(I_DW0)[(l * 2 + 1) * DR + c], i00 = inptr(I_IA0)[(l * 2 + 0) * DR + c], i01 = inptr(I_IA0)[(l * 2 + 1) * DR + c];
#pragma unroll
    for (int t = 0; t < 16; ++t) { const size_t row = row0 + t; const bf16* zr = Zs + row * ZW; bf16* o = STR + row * STRW + c;
        const float r = bf2f(zr[c]), k = bf2f(zr[512 + c]), v = bf2f(zr[1024 + c]);
        const float kv = k * kkw; const float nrm = sqrtf(wave_sum(kv * kv)); const float kk = kv / fmaxf(nrm, 1e-12f);
        o[0] = (bf16)f2bf(r); o[512] = (bf16)f2bf(v); o[1024] = (bf16)f2bf(kk); o[1536] = (bf16)f2bf(ag[t]);
#pragma unroll
        for (int dn = 0; dn < 2; ++dn) { const float xw = (dn ? d01 : d00) + (dn ? aw1[t] : aw0[t]);
            const float ew = sigmoidf_(xw) * 0.6065306597126334f;
            const float eps = -expm1f(-ew);
            const float a = sigmoidf_((dn ? i01 : i00) + (dn ? aa1[t] : aa0[t]));
            const float kd = k * (1.f + (a - 1.f) * kaw), bb = kk * a;
            o[2048 + dn * 1536] = (bf16)f2bf(eps); o[2048 + dn * 1536 + 512] = (bf16)f2bf(kd); o[2048 + dn * 1536 + 1024] = (bf16)f2bf(bb); }
    }
}

__device__ __forceinline__ int scan_rowof(int s, int dir, int b) { if (s < CTXL) { const int tc = dir ? (CTXL - 1 - s) : s; return NLAT + b * CTXL + tc; } const int tt = s - CTXL; const int t = dir ? (SEQ - 1 - tt) : tt; return b * SEQ + t; }
__device__ __forceinline__ void scan_item(const Frame& F0, int item, bool need_ctx) {
    const Frame F = phase_frame(F0); unsigned char* const ws = F.ws;
    const int dir = item & 1, h = (item >> 1) & 7, b = item >> 4;
    const bf16* STR = (const bf16*)(ws + WS_STR); bf16* Y = (bf16*)(ws + WS_Y) + (size_t)dir * NROW * DR;
    const int lane = F.lane, kq = lane & 7, vrow = 8 * F.wave + (lane >> 3);
    float S[8];
#pragma unroll
    for (int j = 0; j < 8; ++j) S[j] = 0.f;
    const int co = h * 64 + kq * 8;
    constexpr int NSTEP = CTXL + SEQ;
#define rowof(s) scan_rowof((s), dir, b)
    for (int s0 = 0; s0 < NSTEP; s0 += 4) {
        u32x4 qkk[4], qe[4], qkd[4], qb[4], qr[4]; unsigned qv[4];
#pragma unroll
        for (int u = 0; u < 4; ++u) { const bf16* base = STR + (size_t)rowof(s0 + u) * STRW;
            qr[u] = *(const u32x4*)(base + co); qkk[u] = *(const u32x4*)(base + 1024 + co);
            qe[u] = *(const u32x4*)(base + 2048 + dir * 1536 + co); qkd[u] = *(const u32x4*)(base + 2048 + dir * 1536 + 512 + co); qb[u] = *(const u32x4*)(base + 2048 + dir * 1536 + 1024 + co);
            qv[u] = base[512 + h * 64 + vrow]; }
#pragma unroll
        for (int u = 0; u < 4; ++u) { float kk[8], e[8], kd[8], bb[8], r[8];
            unpack8(qkk[u], kk); unpack8(qe[u], e); unpack8(qkd[u], kd); unpack8(qb[u], bb); unpack8(qr[u], r);
            const float vv = bf2f(qv[u]);
            float sk = 0.f;
#pragma unroll
            for (int j = 0; j < 8; ++j) sk += S[j] * kk[j];
            sk += __shfl_xor(sk, 1); sk += __shfl_xor(sk, 2); sk += __shfl_xor(sk, 4);
            float y = 0.f;
#pragma unroll
            for (int j = 0; j < 8; ++j) { S[j] = S[j] * (1.f - e[j]) - sk * bb[j] + vv * kd[j]; y += S[j] * r[j]; }
            y += __shfl_xor(y, 1); y += __shfl_xor(y, 2); y += __shfl_xor(y, 4);
            const int s = s0 + u;
            if (kq == 0 && (s >= CTXL || need_ctx)) Y[(size_t)rowof(s) * DR + h * 64 + vrow] = (bf16)f2bf(y); }
    }
#undef rowof
}

__device__ __forceinline__ void readout_pass(const Frame& F0, int l, int nrows) {
    const Frame F = phase_frame(F0); unsigned char* const ws = F.ws;
    const bf16* STR = (const bf16*)(ws + WS_STR); const bf16* Y0 = (const bf16*)(ws + WS_Y); const bf16* Y1 = Y0 + (size_t)NROW * DR; bf16* MA = (bf16*)(ws + WS_H);
    const int lane = F.lane; const float* gnw = inptr(I_GNW) + l * DR; const float* gnb = inptr(I_GNB) + l * DR; const float* rkp = inptr(I_RK) + l * DR;
    for (int row = F.gw; row < nrows; row += F.NGW) { const bf16* sr = STR + (size_t)row * STRW;
#pragma unroll
        for (int h = 0; h < 8; ++h) { const int c = h * 64 + lane;
            const float y = bf2f(Y0[(size_t)row * DR + c]) + bf2f(Y1[(size_t)row * DR + c]);
            const float mu = wave_sum(y) * (1.f / 64.f); const float dv = y - mu; const float var = wave_sum(dv * dv) * (1.f / 64.f);
            const float yn = dv * rsqrtf(var + GN_EPS) * gnw[c] + gnb[c];
            const float r = bf2f(sr[c]), v = bf2f(sr[512 + c]), g = bf2f(sr[1536 + c]), k0 = bf2f(sr[2048 + 512 + c]), k1 = bf2f(sr[2048 + 1536 + 512 + c]);
            const float rk = rkp[c];
            const float bonus = wave_sum(r * (k0 + k1) * rk) * v;
            MA[(size_t)row * D + c] = (bf16)f2bf((yn + bonus) * g); }
    }
}
constexpr int BLOB = 14592, SEGCH = 264, NSEG = 2;
constexpr size_t WS_BLOB1 = 20 * MiB, WS_BLOB2 = 492 * MiB, WS_SCANST = 2 * MiB + 512 * 1024;
__device__ __forceinline__ unsigned char* blob_ptr(unsigned char* ws, int scan, int ci) {
    return scan < 26 ? ws + WS_BLOB1 + ((size_t)scan * SEGCH + ci) * BLOB : ws + WS_BLOB2 + ((size_t)(scan - 26) * SEGCH + ci) * BLOB;
}
typedef short s16x4 __attribute__((ext_vector_type(4)));
__device__ __forceinline__ bf16x8 frag_lo(u32x2 x) { u32x4 t = {x.x, x.y, 0u, 0u}; return __builtin_bit_cast(bf16x8, t); }
__device__ __forceinline__ bf16x8 frag_c(const f32x4& a) { u32x4 t = {pk2(a[0], a[1]), pk2(a[2], a[3]), 0u, 0u}; return __builtin_bit_cast(bf16x8, t); }

__device__ __forceinline__ void pre_item(const Frame& F, unsigned char* ws, int scan, int cs, unsigned char* blob) {
    const int dir = scan & 1, h = (scan >> 1) & 7, b = scan >> 4; const int lane = F.lane, fr = lane & 15, fq = lane >> 4;
    LAS unsigned char* L = F.lds + F.wave * 17408;
    LAS bf16* TK = (LAS bf16*)L; LAS bf16* TR = TK + 1024; LAS bf16* TKt = TR + 1024; LAS bf16* TB = TKt + 1024;
    LAS bf16* KTt = TB + 1024; LAS bf16* RTt = KTt + 1024; LAS bf16* Vt = RTt + 1024;
    LAS float* AKB = (LAS float*)(Vt + 1024);
    LAS bf16* AKK = (LAS bf16*)(AKB + 256); LAS bf16* ARK = AKK + 256; LAS bf16* ARB = ARK + 256; LAS bf16* TT = ARB + 256;
    const bf16* STR = (const bf16*)(ws + WS_STR);
    float kh[16], bh[16];
    float pc;
    {   float r_[16], v_[16], kk_[16], lp_[16], kd_[16], bb_[16];
#pragma unroll
        for (int t = 0; t < 16; ++t) { const bf16* base = STR + (size_t)scan_rowof(16 * cs + t, dir, b) * STRW + h * 64 + lane;
            r_[t] = bf2f(base[0]); v_[t] = bf2f(base[512]); kk_[t] = bf2f(base[1024]);
            lp_[t] = bf2f(base[2048 + dir * 1536]); kd_[t] = bf2f(base[2048 + dir * 1536 + 512]); bb_[t] = bf2f(base[2048 + dir * 1536 + 1024]); }
        float lp = 0.f; u32x4 kt4[2], rt4[2], v4[2];
        unsigned ktp[8], rtp[8], vp[8];
#pragma unroll
        for (int t = 0; t < 16; ++t) { const float pm1 = __expf(lp); lp += __logf(1.f - lp_[t]); lp_[t] = lp; const float p = __expf(lp), ip = __expf(-lp);
            const float kt = kk_[t] * pm1, ktl = kd_[t] * ip, btl = bb_[t] * ip, rt = r_[t] * p;
            TK[t * 64 + lane] = (bf16)f2bf(kt); TR[t * 64 + lane] = (bf16)f2bf(rt); TKt[t * 64 + lane] = (bf16)f2bf(ktl); TB[t * 64 + lane] = (bf16)f2bf(btl);
            if (t & 1) { ktp[t >> 1] |= f2bf(kt) << 16; rtp[t >> 1] |= f2bf(rt) << 16; vp[t >> 1] |= f2bf(v_[t]) << 16; }
            else { ktp[t >> 1] = f2bf(kt); rtp[t >> 1] = f2bf(rt); vp[t >> 1] = f2bf(v_[t]); } }
        kt4[0] = (u32x4){ktp[0], ktp[1], ktp[2], ktp[3]}; kt4[1] = (u32x4){ktp[4], ktp[5], ktp[6], ktp[7]};
        rt4[0] = (u32x4){rtp[0], rtp[1], rtp[2], rtp[3]}; rt4[1] = (u32x4){rtp[4], rtp[5], rtp[6], rtp[7]};
        v4[0] = (u32x4){vp[0], vp[1], vp[2], vp[3]}; v4[1] = (u32x4){vp[4], vp[5], vp[6], vp[7]};
        *(LAS u32x4*)(KTt + lane * 16) = kt4[0]; *(LAS u32x4*)(KTt + lane * 16 + 8) = kt4[1];
        *(LAS u32x4*)(RTt + lane * 16) = rt4[0]; *(LAS u32x4*)(RTt + lane * 16 + 8) = rt4[1];
        *(LAS u32x4*)(Vt + lane * 16) = v4[0]; *(LAS u32x4*)(Vt + lane * 16 + 8) = v4[1];
        pc = __expf(lp);
#pragma unroll
        for (int t = 0; t < 16; ++t) { const float e = __expf(lp - lp_[t]); kh[t] = kd_[t] * e; bh[t] = bb_[t] * e; }
    }
    LDS_WAIT(); asm volatile("" ::: "memory");
    {   f32x4 akb = {0.f, 0.f, 0.f, 0.f}, akk = akb, ark = akb, arb = akb;
#pragma unroll
        for (int s = 0; s < 2; ++s) { const int o = fr * 64 + 32 * s + 8 * fq;
            const bf16x8 fk = *(const LAS bf16x8*)(TK + o), frr = *(const LAS bf16x8*)(TR + o), fkt = *(const LAS bf16x8*)(TKt + o), fb = *(const LAS bf16x8*)(TB + o);
            akb = MFMA16(fk, fb, akb); akk = MFMA16(fk, fkt, akk); ark = MFMA16(frr, fkt, ark); arb = MFMA16(frr, fb, arb); }
#pragma unroll
        for (int reg = 0; reg < 4; ++reg) { const int t = 4 * fq + reg; const bool lo = fr < t, le = fr <= t;
            AKB[t * 16 + fr] = lo ? akb[reg] : 0.f; AKK[t * 16 + fr] = (bf16)f2bf(lo ? akk[reg] : 0.f);
            ARK[t * 16 + fr] = (bf16)f2bf(le ? ark[reg] : 0.f); ARB[t * 16 + fr] = (bf16)f2bf(le ? arb[reg] : 0.f); }
    }
    LDS_WAIT(); asm volatile("" ::: "memory");
    {   float col[16];
#pragma unroll
        for (int t = 0; t < 16; ++t) { float s_ = (t == fr) ? 1.f : 0.f;
            if (t > 0) { const f32x4 n0 = *(const LAS f32x4*)(AKB + t * 16), n1 = *(const LAS f32x4*)(AKB + t * 16 + 4), n2 = *(const LAS f32x4*)(AKB + t * 16 + 8), n3 = *(const LAS f32x4*)(AKB + t * 16 + 12);
                const float nn[16] = {n0[0], n0[1], n0[2], n0[3], n1[0], n1[1], n1[2], n1[3], n2[0], n2[1], n2[2], n2[3], n3[0], n3[1], n3[2], n3[3]};
#pragma unroll
                for (int i = 0; i < 16; ++i) if (i < t) s_ -= nn[i] * col[i]; }
            col[t] = s_; TT[t * 16 + fr] = (bf16)f2bf(s_); }
    }
    LDS_WAIT(); asm volatile("" ::: "memory");
    f32x4 Wc[4], Rqc[4], U0c[4], Y0c[4];
    {   const bf16x8 aT = frag_lo(*(const LAS u32x2*)(TT + fr * 16 + 4 * fq)), aKK = frag_lo(*(const LAS u32x2*)(AKK + fr * 16 + 4 * fq)), aRK = frag_lo(*(const LAS u32x2*)(ARK + fr * 16 + 4 * fq));
        u32x2 nb = *(const LAS u32x2*)(ARB + fr * 16 + 4 * fq); nb.x ^= 0x80008000u; nb.y ^= 0x80008000u; const bf16x8 aRBn = frag_lo(nb);
        const f32x4 z4 = {0.f, 0.f, 0.f, 0.f};
#pragma unroll
        for (int nt = 0; nt < 4; ++nt) { const int o = (16 * nt + fr) * 16 + 4 * fq;
            const bf16x8 bK = frag_lo(*(const LAS u32x2*)(KTt + o)), bV = frag_lo(*(const LAS u32x2*)(Vt + o));
            float ri[4]; unpack4(*(const LAS u32x2*)(RTt + o), ri);
            Wc[nt] = MFMA16(aT, bK, z4); const f32x4 Zn = MFMA16(aKK, bV, z4);
            U0c[nt] = MFMA16(aT, frag_c(Zn), z4);
            Rqc[nt] = MFMA16(aRBn, frag_c(Wc[nt]), ((f32x4){ri[0], ri[1], ri[2], ri[3]}));
            Y0c[nt] = MFMA16(aRK, bV, z4); Y0c[nt] = MFMA16(aRBn, frag_c(U0c[nt]), Y0c[nt]); }
    }
    LDS_WAIT(); asm volatile("" ::: "memory");
#pragma unroll
    for (int nt = 0; nt < 4; ++nt) { const u32x2 vv = *(const LAS u32x2*)(Vt + (16 * nt + fr) * 16 + 4 * fq);
        *(u32x2*)(blob + 8448 + nt * 1536 + 1024 + lane * 8) = vv;
        u32x2 u0 = {pk2(U0c[nt][0], U0c[nt][1]), pk2(U0c[nt][2], U0c[nt][3])}, y0 = {pk2(Y0c[nt][0], Y0c[nt][1]), pk2(Y0c[nt][2], Y0c[nt][3])};
        *(u32x2*)(blob + 8448 + nt * 1536 + lane * 8) = u0; *(u32x2*)(blob + 8448 + nt * 1536 + 512 + lane * 8) = y0; }
    *(float*)(blob + 8192 + lane * 4) = pc;
    LAS bf16* WT = TK; LAS bf16* RQT = TR; LAS bf16* BHt = TKt; LAS bf16* KHt = TB;
#pragma unroll
    for (int nt = 0; nt < 4; ++nt)
#pragma unroll
        for (int reg = 0; reg < 4; ++reg) { WT[(4 * fq + reg) * 64 + 16 * nt + fr] = (bf16)f2bf(Wc[nt][reg]); RQT[(4 * fq + reg) * 64 + 16 * nt + fr] = (bf16)f2bf(Rqc[nt][reg]); }
    {   u32x4 a, c, d, e;
        a = (u32x4){pk2(bh[0], bh[1]), pk2(bh[2], bh[3]), pk2(bh[4], bh[5]), pk2(bh[6], bh[7])}; c = (u32x4){pk2(bh[8], bh[9]), pk2(bh[10], bh[11]), pk2(bh[12], bh[13]), pk2(bh[14], bh[15])};
        d = (u32x4){pk2(kh[0], kh[1]), pk2(kh[2], kh[3]), pk2(kh[4], kh[5]), pk2(kh[6], kh[7])}; e = (u32x4){pk2(kh[8], kh[9]), pk2(kh[10], kh[11]), pk2(kh[12], kh[13]), pk2(kh[14], kh[15])};
        *(LAS u32x4*)(BHt + lane * 16) = a; *(LAS u32x4*)(BHt + lane * 16 + 8) = c; *(LAS u32x4*)(KHt + lane * 16) = d; *(LAS u32x4*)(KHt + lane * 16 + 8) = e; }
    LDS_WAIT(); asm volatile("" ::: "memory");
#pragma unroll
    for (int s = 0; s < 2; ++s) { const int o = fr * 64 + 32 * s + 4 * fq;
        const u32x2 w0 = *(const LAS u32x2*)(WT + o), w1 = *(const LAS u32x2*)(WT + o + 16), q0 = *(const LAS u32x2*)(RQT + o), q1 = *(const LAS u32x2*)(RQT + o + 16);
        *(u32x4*)(blob + (0 * 2 + s) * 1024 + lane * 16) = (u32x4){w0.x, w0.y, w1.x, w1.y};
        *(u32x4*)(blob + (1 * 2 + s) * 1024 + lane * 16) = (u32x4){q0.x, q0.y, q1.x, q1.y}; }
#pragma unroll
    for (int mt = 0; mt < 4; ++mt) { const int o = (16 * mt + fr) * 16 + 4 * fq; const u32x2 bb = *(const LAS u32x2*)(BHt + o), kk = *(const LAS u32x2*)(KHt + o);
        *(u32x4*)(blob + 4096 + mt * 1024 + lane * 16) = (u32x4){bb.x ^ 0x80008000u, bb.y ^ 0x80008000u, kk.x, kk.y}; }
    LDS_WAIT(); asm volatile("" ::: "memory");
}

__device__ __forceinline__ void pre_phase(const Frame& F0, int seg) {
    const Frame F = phase_frame(F0); unsigned char* const ws = F.ws;
    for (int it = F.gw; it < 32 * SEGCH; it += F.NGW) { const int scan = it & 31, ci = it >> 5; pre_item(F, ws, scan, seg * SEGCH + ci, blob_ptr(ws, scan, ci)); }
}

struct SeqRegs { bf16x8 a1[4], a2[4]; f32x4 pc[4]; u32x2 u0, y0, vv; };
__device__ __forceinline__ void seq_load(SeqRegs& R, const unsigned char* blob, int vb, int lane, int fq) {
#pragma unroll
    for (int i = 0; i < 4; ++i) { R.a1[i] = *(const bf16x8*)(blob + i * 1024 + lane * 16); R.a2[i] = *(const bf16x8*)(blob + 4096 + i * 1024 + lane * 16);
        R.pc[i] = *(const f32x4*)(blob + 8192 + (16 * i + 4 * fq) * 4); }
    const unsigned char* pv = blob + 8448 + vb * 1536 + lane * 8;
    R.u0 = *(const u32x2*)pv; R.y0 = *(const u32x2*)(pv + 512); R.vv = *(const u32x2*)(pv + 1024);
}
__device__ __forceinline__ void seq_step(const SeqRegs& R, f32x4 (&M)[4], bf16* Y, int cs, int dir, int b, int ycol, int fq, bool store_y) {
    const f32x4 z4 = {0.f, 0.f, 0.f, 0.f};
    const u32x4 t0 = {pk2(M[0][0], M[0][1]), pk2(M[0][2], M[0][3]), pk2(M[1][0], M[1][1]), pk2(M[1][2], M[1][3])};
    const u32x4 t1 = {pk2(M[2][0], M[2][1]), pk2(M[2][2], M[2][3]), pk2(M[3][0], M[3][1]), pk2(M[3][2], M[3][3])};
    const bf16x8 b0 = __builtin_bit_cast(bf16x8, t0), b1 = __builtin_bit_cast(bf16x8, t1);
    f32x4 X0 = MFMA16(R.a1[0], b0, z4); X0 = MFMA16(R.a1[1], b1, X0);
    f32x4 X1 = MFMA16(R.a1[2], b0, z4); X1 = MFMA16(R.a1[3], b1, X1);
    float u0[4], y0[4]; unpack4(R.u0, u0); unpack4(R.y0, y0);
    const float U[4] = {X0[0] + u0[0], X0[1] + u0[1], X0[2] + u0[2], X0[3] + u0[3]};
    if (store_y) {
#pragma unroll
        for (int reg = 0; reg < 4; ++reg) Y[(size_t)scan_rowof(16 * cs + 4 * fq + reg, dir, b) * DR + ycol] = (bf16)f2bf(X1[reg] + y0[reg]); }
    const u32x4 tb = {pk2(U[0], U[1]), pk2(U[2], U[3]), R.vv.x, R.vv.y}; const bf16x8 bB = __builtin_bit_cast(bf16x8, tb);
#pragma unroll
    for (int mt = 0; mt < 4; ++mt) M[mt] = MFMA16(R.a2[mt], bB, R.pc[mt] * M[mt]);
}
__device__ __forceinline__ void seq_item(const Frame& F0, int item, int seg, bool need_ctx) {
    const Frame F = phase_frame(F0); unsigned char* const ws = F.ws;
    const int scan = item >> 2, vb = item & 3, dir = scan & 1, h = (scan >> 1) & 7, b = scan >> 4; const int lane = F.lane, fr = lane & 15, fq = lane >> 4;
    bf16* Y = (bf16*)(ws + WS_Y) + (size_t)dir * NROW * DR; const int ycol = h * 64 + 16 * vb + fr;
    float* st = (float*)(ws + WS_SCANST) + (size_t)item * 1024 + lane * 4;
    f32x4 M[4];
#pragma unroll
    for (int mt = 0; mt < 4; ++mt) M[mt] = seg == 0 ? (f32x4){0.f, 0.f, 0.f, 0.f} : *(const f32x4*)(st + mt * 256);
    const unsigned char* blob = blob_ptr(ws, scan, 0);
    SeqRegs Ra, Rb, Rc;
    seq_load(Ra, blob, vb, lane, fq); seq_load(Rb, blob + BLOB, vb, lane, fq);
    for (int ci = 0; ci < SEGCH; ci += 3) {
        const int cs = seg * SEGCH + ci;
        seq_load(Rc, blob + (size_t)(ci + 2 < SEGCH ? ci + 2 : SEGCH - 1) * BLOB, vb, lane, fq);
        seq_step(Ra, M, Y, cs, dir, b, ycol, fq, need_ctx || cs >= 16);
        seq_load(Ra, blob + (size_t)(ci + 3 < SEGCH ? ci + 3 : SEGCH - 1) * BLOB, vb, lane, fq);
        seq_step(Rb, M, Y, cs + 1, dir, b, ycol, fq, need_ctx || cs + 1 >= 16);
        seq_load(Rb, blob + (size_t)(ci + 4 < SEGCH ? ci + 4 : SEGCH - 1) * BLOB, vb, lane, fq);
        seq_step(Rc, M, Y, cs + 2, dir, b, ycol, fq, need_ctx || cs + 2 >= 16);
    }
    if (seg + 1 < NSEG) {
#pragma unroll
        for (int mt = 0; mt < 4; ++mt) *(f32x4*)(st + mt * 256) = M[mt]; }
}
namespace pg8 {
struct EpiStoreBf16 {
    static constexpr bool PERM = true, AFTER_DRAIN = false;
    bf16_t* O; int ldc; int pn_mask;
    __device__ __forceinline__ void operator()(const f32x4 (&acc)[2][2][4][2], const Unit& u, int wr, int wc, int fr, int fq) const {
        const int row0 = u.pm * BM + wr * 64 + fr; const int col0 = (u.pn & pn_mask) * BM + wc * 32 + 8 * fq;
#pragma unroll
        for (int ai = 0; ai < 2; ++ai)
#pragma unroll
            for (int m = 0; m < 4; ++m) { bf16_t* rowp = O + (size_t)(row0 + ai * HALF + m * 16) * ldc + col0;
#pragma unroll
                for (int bj = 0; bj < 2; ++bj) { const f32x4 v0 = acc[ai][bj][m][0], v1 = acc[ai][bj][m][1];
                    u32x4 w; w.x = cvt_pk_bf16(v0[0], v0[1]); w.y = cvt_pk_bf16(v0[2], v0[3]); w.z = cvt_pk_bf16(v1[0], v1[1]); w.w = cvt_pk_bf16(v1[2], v1[3]);
                    *(u32x4*)(rowp + bj * HALF) = w; } }
    }
};
struct EpiSwiGLU {
    static constexpr bool PERM = true, AFTER_DRAIN = false;
    bf16_t* O;
    __device__ __forceinline__ void operator()(const f32x4 (&acc)[2][2][4][2], const Unit& u, int wr, int wc, int fr, int fq) const {
        const int row0 = u.pm * BM + wr * 64 + fr; const int col0 = ((u.pn & 3) * BM + wc * 32 + 8 * fq) >> 1;
#pragma unroll
        for (int ai = 0; ai < 2; ++ai)
#pragma unroll
            for (int m = 0; m < 4; ++m) { bf16_t* rowp = O + (size_t)(row0 + ai * HALF + m * 16) * 512 + col0;
#pragma unroll
                for (int bj = 0; bj < 2; ++bj) { const f32x4 g = acc[ai][bj][m][0], up = acc[ai][bj][m][1]; float a[4];
#pragma unroll
                    for (int i = 0; i < 4; ++i) a[i] = g[i] / (1.f + __expf(-g[i])) * up[i];
                    unsigned long long w = (unsigned long long)cvt_pk_bf16(a[0], a[1]) | ((unsigned long long)cvt_pk_bf16(a[2], a[3]) << 32);
                    *(unsigned long long*)(rowp + bj * (HALF / 2)) = w; } }
    }
};
struct EpiResidual {
    static constexpr bool PERM = false, AFTER_DRAIN = false;
    const float* xlat; const float* xctx;
    float* out; const float* g1;
    __device__ __forceinline__ void operator()(const f32x4 (&acc)[2][2][4][2], const Unit& u, int wr, int wc, int fr, int fq) const {
        const int rowt = u.pm * BM; const int mr = rowt < 16384 ? (rowt >> 13) : 2;
        const float* base = rowt < 16384 ? xlat + (size_t)rowt * 1024 : xctx + (size_t)(rowt - 16384) * 1024;
        const int col0 = u.pn * BM + wc * 32 + 4 * fq;
        f32x4 gv[2][2];
#pragma unroll
        for (int bj = 0; bj < 2; ++bj)
#pragma unroll
            for (int n = 0; n < 2; ++n) gv[bj][n] = *(const f32x4*)(g1 + (size_t)mr * 6144 + col0 + bj * HALF + n * 16);
#pragma unroll
        for (int ai = 0; ai < 2; ++ai)
#pragma unroll
            for (int m = 0; m < 4; ++m) { const int rl = ai * HALF + wr * 64 + m * 16 + fr;
#pragma unroll
                for (int bj = 0; bj < 2; ++bj)
#pragma unroll
                    for (int n = 0; n < 2; ++n) { const size_t off = (size_t)rl * 1024 + col0 + bj * HALF + n * 16;
                        const f32x4 xo = *(const f32x4*)(base + off);
                        *(f32x4*)(out + (size_t)rowt * 1024 + off) = xo + gv[bj][n] * acc[ai][bj][m][n]; } }
    }
};
struct MoeOrder {
    const int* tile_e; int ntiles, G, c;
    __device__ bool next(int i, Unit& u) const { const long L = (long)i * G + c; if (L >= 4L * ntiles) return false; const int pm = (int)(L >> 2); u.pm = pm; u.pn = tile_e[pm] * 4 + (int)(L & 3); return true; }
    __device__ __forceinline__ void a_ready(const Unit&) const {}
    __device__ __forceinline__ void done(const Unit&) const {}
};
}

__device__ __forceinline__ void expert_convert(const Frame& F0, int l) {
    const Frame F = phase_frame(F0); unsigned char* const ws = F.ws;
    LAS float* scr = (LAS float*)(F.lds + F.wave * 16384);
    bf16* wgu = (bf16*)(ws + WS_WGU_T); bf16* wd = (bf16*)(ws + WS_WD_T);
    constexpr int I_G = 16 * 16, I_D = 8 * 32;
    constexpr int NIT = NEXP * (2 * I_G + I_D);
    const float* p_eg = inptr(I_EG); const float* p_eu = inptr(I_EU); const float* p_ed = inptr(I_ED);
    for (int it = F.gw; it < NIT; it += F.NGW) { const int e = it / (2 * I_G + I_D); int r = it % (2 * I_G + I_D);
        if (r < I_G) { transpose_item(p_eg + ((size_t)l * NEXP + e) * D * DEXP, DEXP, (r >> 4) * 64, (r & 15) * 32, wgu, D, RmGU{e * 1024}, scr, F.lane); continue; } r -= I_G;
        if (r < I_G) { transpose_item(p_eu + ((size_t)l * NEXP + e) * D * DEXP, DEXP, (r >> 4) * 64, (r & 15) * 32, wgu, D, RmGU{e * 1024 + 4}, scr, F.lane); continue; } r -= I_G;
        transpose_item(p_ed + ((size_t)l * NEXP + e) * DEXP * D, D, (r >> 5) * 64, (r & 31) * 32, wd, DEXP, RmId{e * 1024}, scr, F.lane);
    }
}

__device__ __forceinline__ void router_pass(const Frame& F0, int l, int nrows) {
    const Frame F = phase_frame(F0); unsigned char* const ws = F.ws;
    LAS float* msh = (LAS float*)F.lds; LAS float* msc = msh + 3072; LAS float* hrow = msc + 3072;
    LAS float* lgs = hrow + 8 * 1024;
    __syncthreads();
    mod_to_lds(F, l, 3, msh, false); mod_to_lds(F, l, 4, msc, false); __syncthreads();
    const float* X = (const float*)(ws + WS_X); bf16* H = (bf16*)(ws + WS_H);
    const float* rgw = inptr(I_RGW) + (size_t)l * D * 4; const float* rew = inptr(I_REW) + (size_t)l * D * NEXP;
    const float* rgb = inptr(I_RGB) + l * 4; const float* reb = inptr(I_REB) + l * NEXP;
    int* rt_e = (int*)(ws + WS_ROUTE + RT_E); int* rt_pos = (int*)(ws + WS_ROUTE + RT_POS); float* rt_gate = (float*)(ws + WS_ROUTE + RT_GATE);
    unsigned* cnt = (unsigned*)(ws + WS_CTL) + CW_CNT + 64 * l;
    const int lane = F.lane, w = F.wave; const float* n2g = inptr(I_N2G) + l * D;
    float wr[5][16];
#pragma unroll
    for (int j = 0; j < 4; ++j)
#pragma unroll
        for (int i = 0; i < 4; ++i) { const int k = 4 * lane + 256 * j + i;
#pragma unroll
            for (int q = 0; q < 4; ++q) wr[q][4 * j + i] = rew[(size_t)k * 32 + w + 8 * q];
            wr[4][4 * j + i] = w < 4 ? rgw[(size_t)k * 4 + w] : 0.f; }
    const int ngroups = nrows >> 3;
    for (int gi = F.vcu; gi < ngroups; gi += F.G) { const int row = gi * 8 + w;
        {   f32x4 v[4];
#pragma unroll
            for (int j = 0; j < 4; ++j) v[j] = *(const f32x4*)(X + (size_t)row * D + 4 * lane + 256 * j);
            const int mr = modrow(row);
            norm_mod_row(v, n2g, msc + mr * 1024, msh + mr * 1024, H + (size_t)row * D, lane);
#pragma unroll
            for (int j = 0; j < 4; ++j) *(LAS f32x4*)(hrow + w * 1024 + 4 * lane + 256 * j) = v[j]; }
        __syncthreads();
#pragma unroll 2
        for (int r = 0; r < 8; ++r) { float a[5] = {0.f, 0.f, 0.f, 0.f, 0.f};
#pragma unroll
            for (int j = 0; j < 4; ++j) { const f32x4 hv = *(const LAS f32x4*)(hrow + r * 1024 + 4 * lane + 256 * j);
#pragma unroll
                for (int q = 0; q < 5; ++q) a[q] += hv.x * wr[q][4 * j] + hv.y * wr[q][4 * j + 1] + hv.z * wr[q][4 * j + 2] + hv.w * wr[q][4 * j + 3]; }
#pragma unroll
            for (int q = 0; q < 5; ++q) a[q] = wave_sum(a[q]);
            if (lane == 0) {
#pragma unroll
                for (int q = 0; q < 4; ++q) lgs[r * 40 + 4 + w + 8 * q] = a[q] + reb[w + 8 * q];
                if (w < 4) lgs[r * 40 + w] = a[4] + rgb[w]; } }
        __syncthreads();
        if (F.tid < 8) { const int rr = gi * 8 + F.tid; const LAS float* lp = lgs + F.tid * 40;
            int grp = 0; float mx = lp[0];
#pragma unroll
            for (int g = 1; g < 4; ++g) if (lp[g] > mx) { mx = lp[g]; grp = g; }
            float den = 0.f;
#pragma unroll
            for (int g = 0; g < 4; ++g) den += __expf(lp[g] - mx);
            const float pg_top = 1.f / den; const LAS float* sel = lp + 4 + grp * 8;
            int i0 = 0; float l0 = sel[0];
#pragma unroll
            for (int q = 1; q < 8; ++q) if (sel[q] > l0) { l0 = sel[q]; i0 = q; }
            int i1 = -1; float l1 = -3.0e38f;
#pragma unroll
            for (int q = 0; q < 8; ++q) if (q != i0 && sel[q] > l1) { l1 = sel[q]; i1 = q; }
            const float e1 = __expf(l1 - l0); const float w0 = pg_top / (1.f + e1), w1 = pg_top * e1 / (1.f + e1);
            const int ea = grp * 8 + i0, eb = grp * 8 + i1;
            const unsigned pa = atomicAdd(cnt + ea, 1u), pb = atomicAdd(cnt + eb, 1u);
            rt_e[2 * rr] = ea; rt_e[2 * rr + 1] = eb; rt_pos[2 * rr] = (int)pa; rt_pos[2 * rr + 1] = (int)pb; rt_gate[2 * rr] = w0; rt_gate[2 * rr + 1] = w1; }
    }
}

__device__ __forceinline__ void gather_pass(const Frame& F0, int l, int nrows) {
    const Frame F = phase_frame(F0); unsigned char* const ws = F.ws;
    LAS int* off = (LAS int*)F.lds;
    const unsigned* cnt = (const unsigned*)(ws + WS_CTL) + CW_CNT + 64 * l;
    int* tile_e = (int*)(ws + WS_ROUTE + RT_TILE); int* ntl = (int*)(ws + WS_ROUTE + RT_NT);
    __syncthreads();
    if (F.tid == 0) { int o = 0;
#pragma nounroll
        for (int e = 0; e < NEXP; ++e) { const int c = (int)__hip_atomic_load(cnt + e, __ATOMIC_RELAXED, __HIP_MEMORY_SCOPE_AGENT); const int nt = (c + 255) >> 8; off[e] = o;
            if (blockIdx.x == 0) {
#pragma nounroll
                for (int t = 0; t < nt; ++t) tile_e[(o >> 8) + t] = e; }
            o += nt << 8; }
        if (blockIdx.x == 0) ntl[0] = o >> 8; }
    __syncthreads();
    const int* rt_e = (const int*)(ws + WS_ROUTE + RT_E); const int* rt_pos = (const int*)(ws + WS_ROUTE + RT_POS); int* rt_slot = (int*)(ws + WS_ROUTE + RT_SLOT);
    const bf16* H = (const bf16*)(ws + WS_H); bf16* Xs = (bf16*)(ws + WS_XS);
    for (int it = F.gw; it < 2 * nrows; it += F.NGW) { const int row = it >> 1; const int slot = off[rt_e[it]] + rt_pos[it];
        if (F.lane == 0) rt_slot[it] = slot;
        const u32x4* s = (const u32x4*)(H + (size_t)row * D); u32x4* d = (u32x4*)(Xs + (size_t)slot * D);
        d[F.lane] = s[F.lane]; d[64 + F.lane] = s[64 + F.lane]; }
}

__device__ __forceinline__ void combine_pass(const Frame& F0, int l, int nrows) {
    const Frame F = phase_frame(F0); unsigned char* const ws = F.ws;
    LAS float* mg2 = (LAS float*)F.lds; LAS float* msh = mg2 + 3072; LAS float* msc = msh + 3072;
    const bool last = (l == DEPTH - 1);
    __syncthreads();
    mod_to_lds(F, l, 5, mg2, false); if (!last) { mod_to_lds(F, l + 1, 0, msh, false); mod_to_lds(F, l + 1, 1, msc, false); }
    __syncthreads();
    float* X = (float*)(ws + WS_X); bf16* H = (bf16*)(ws + WS_H); const bf16* Ys = (const bf16*)(ws + WS_XS);
    const int* rt_slot = (const int*)(ws + WS_ROUTE + RT_SLOT); const float* rt_gate = (const float*)(ws + WS_ROUTE + RT_GATE);
    const int lane = F.lane; const float* n1g = inptr(I_N1G) + (last ? 0 : (l + 1) * D); const float* fgp = inptr(I_FG);
    for (int row = F.gw; row < nrows; row += F.NGW) { const int s0 = rt_slot[2 * row], s1 = rt_slot[2 * row + 1]; const float w0 = rt_gate[2 * row], w1 = rt_gate[2 * row + 1];
        const int mr = modrow(row); f32x4 v[4];
#pragma unroll
        for (int j = 0; j < 4; ++j) { const int c = 4 * lane + 256 * j; float a[4], b[4];
            unpack4(*(const u32x2*)(Ys + (size_t)s0 * D + c), a); unpack4(*(const u32x2*)(Ys + (size_t)s1 * D + c), b);
            const f32x4 g2 = *(const LAS f32x4*)(mg2 + mr * 1024 + c); const f32x4 xo = *(const f32x4*)(X + (size_t)row * D + c);
            f32x4 y; y.x = w0 * a[0] + w1 * b[0]; y.y = w0 * a[1] + w1 * b[1]; y.z = w0 * a[2] + w1 * b[2]; y.w = w0 * a[3] + w1 * b[3];
            v[j] = xo + g2 * y; }
        if (!last) {
#pragma unroll
            for (int j = 0; j < 4; ++j) *(f32x4*)(X + (size_t)row * D + 4 * lane + 256 * j) = v[j];
            norm_mod_row(v, n1g, msc + mr * 1024, msh + mr * 1024, H + (size_t)row * D, lane);
        } else { float s = 0.f;
#pragma unroll
            for (int j = 0; j < 4; ++j) s += (v[j].x * v[j].x + v[j].y * v[j].y) + (v[j].z * v[j].z + v[j].w * v[j].w);
            const float rs = rsqrtf(wave_sum(s) * (1.f / D) + RMS_EPS);
#pragma unroll
            for (int j = 0; j < 4; ++j) { const int c = 4 * lane + 256 * j; const f32x4 g = *(const f32x4*)(fgp + c); *(f32x4*)(F.out + (size_t)row * D + c) = v[j] * rs * g; } }
    }
}
__global__ void __launch_bounds__(NTHR, 2) fwd_megakernel(Params prm) {
    extern __shared__ __attribute__((aligned(16))) unsigned char lds_raw[];
    Frame F;
    F.lds = (LAS unsigned char*)lds_raw;
    F.tid = threadIdx.x; F.lane = F.tid & 63; F.wave = __builtin_amdgcn_readfirstlane(F.tid >> 6);
    F.G = gridDim.x; { const int bx = blockIdx.x; F.vcu = (F.G % 8 == 0) ? (bx % 8) * (F.G / 8) + bx / 8 : bx; }
    F.gw = F.vcu * NWAVES + F.wave; F.NGW = F.G * NWAVES;
    F.out = prm.out; F.ws = prm.ws;
    for (int u = F.tid; u < (LDS_BYTES - LDSCTL_OFF) / 4; u += NTHR) ((LAS unsigned*)(F.lds + LDSCTL_OFF))[u] = 0u;
    __syncthreads();
    (void)xcd_barrier_post((unsigned*)(F.ws + WS_CTL) + CW_BAR, (volatile LAS unsigned*)(F.lds + MISC_OFF) + 8);
#define GRID_BAR() do { XcdBarrier bar_; bar_.bar = (unsigned*)(opaque(F.ws) + WS_CTL) + CW_BAR; bar_.x = xb_xcc_id(); bar_.st = (volatile LAS unsigned*)(F.lds + MISC_OFF) + 8; xcd_barrier(bar_); } while (0)

#ifndef PHMASK
#define PHMASK 0xffff
#endif
#define PH(k) ((PHMASK >> (k)) & 1)
    if (PH(0)) p0_prologue(F);
#if USE_CG_SYNC
    cg::this_grid().sync();
#else
    GRID_BAR();
#endif
    if (PH(1)) p0b_norm1(F);
    GRID_BAR();

    for (int l = 0; l < DEPTH; ++l) {
        const bool need_ctx = (l == 0); const int nrows = need_ctx ? NROW : NLAT;
#define WSO Fp.ws
        if (PH(2)) {
            const Frame Fp = phase_frame(F); unsigned char* const ws = WSO; bf16* Hb = (bf16*)(ws + WS_H); bf16* Pb = (bf16*)(ws + WS_P);
            pg8::Gemm g{Hb, (const bf16*)(ws + WS_WIN_T) + (size_t)l * NP * D, NROW, NP, D}; pg8::StaticOrder S; S.init(NROW, NP, Fp.G, (int)blockIdx.x);
            pg8::EpiStoreBf16 E{Pb, NP, 0xffff};
            pg8::gemm_phase<pg8::EpiStoreBf16, pg8::StaticOrder, true, true>(F.lds, g, S, E);
        }
        GRID_BAR();
        {
            const Frame Fp = phase_frame(F); unsigned char* const ws = WSO; bf16* Pb = (bf16*)(ws + WS_P);
            if (PH(3)) for (int it = blockIdx.x; it < 256; it += F.G) fftA_item(F, it);
            if (PH(4) && need_ctx) for (int it = blockIdx.x; it < 8; it += F.G) { const int b = it >> 2, m0 = (it & 3) * 64;
                const bf16* src0 = Pb + (size_t)(NLAT + b * CTXL) * NP + COL_FC;
                dft64_item<4, 256>(F, l, m0, -1.f, 1.f / 128.f, [=](int t, int ri) { return src0 + (size_t)t * NP + ri * 256; }, [=](int m) { return NLAT + b * CTXL + m; }); }
            if (PH(5)) { shift_pass(F, l);
            conv_pass(F, l, nrows); }
        }
        GRID_BAR();
        {
            const Frame Fp = phase_frame(F); unsigned char* const ws = WSO;
            if (PH(6)) for (int it = blockIdx.x; it < 256; it += F.G) { const int b = it >> 7, t1p = it & 127;
                const bf16* src0 = (const bf16*)(ws + WS_GT) + (size_t)(b * 128 + t1p) * 64 * 512;
                dft64_item<1, 64>(F, l, 0, 1.f, 0.0013810679320049757f, [=](int t, int ri) { return src0 + (size_t)t * 512 + ri * 256; }, [=](int m) { return b * SEQ + t1p + 128 * m; }); }
            if (PH(7)) for (int it = blockIdx.x; it < NROW / 16; it += F.G) prep_item(F, l, it);
        }
        GRID_BAR();
        for (int seg = 0; seg < NSEG; ++seg) {
            pre_phase(F, seg);
            GRID_BAR();
            if (F.wave == 0) for (int it = blockIdx.x; it < 128; it += F.G) seq_item(F, it, seg, need_ctx);
            GRID_BAR();
        }
        if (PH(9)) readout_pass(F, l, nrows);
        GRID_BAR();
        if (PH(10)) {
            const Frame Fp = phase_frame(F); unsigned char* const ws = WSO; bf16* Hb = (bf16*)(ws + WS_H);
            pg8::Gemm g{Hb, (const bf16*)(ws + WS_WOUT_T) + (size_t)l * D * D, nrows, D, D}; pg8::StaticOrder S; S.init(nrows, D, Fp.G, (int)blockIdx.x);
            const float* X = (const float*)(ws + WS_X);
            pg8::EpiResidual E{l == 0 ? inptr(I_X) : X, l == 0 ? inptr(I_CTX) : X + (size_t)NLAT * D, (float*)(ws + WS_X), (const float*)(ws + WS_MODF) + (size_t)l * 3 * 6144 + 2 * 1024};
            pg8::gemm_phase<pg8::EpiResidual, pg8::StaticOrder, true, true>(F.lds, g, S, E);
        }
        GRID_BAR();
        if (PH(11)) expert_convert(F, l);
        if (PH(12)) router_pass(F, l, nrows);
        GRID_BAR();
        if (PH(13)) gather_pass(F, l, nrows);
        GRID_BAR();
        if (PH(14)) {
            const Frame Fp = phase_frame(F); unsigned char* const ws = WSO;
            const int* tile_e = (const int*)(ws + WS_ROUTE + RT_TILE); const int ntiles = *(const int*)(ws + WS_ROUTE + RT_NT);
            pg8::MoeOrder S{tile_e, ntiles, Fp.G, (int)blockIdx.x};
            {   pg8::Gemm g{(const bf16*)(ws + WS_XS), (const bf16*)(ws + WS_WGU_T), 0, 0, D};
                pg8::EpiSwiGLU E{(bf16*)(ws + WS_ACT)};
                pg8::gemm_phase<pg8::EpiSwiGLU, pg8::MoeOrder, true, true>(F.lds, g, S, E); }
            GRID_BAR();
            {   pg8::Gemm g{(const bf16*)(ws + WS_ACT), (const bf16*)(ws + WS_WD_T), 0, 0, DEXP};
                pg8::EpiStoreBf16 E{(bf16*)(ws + WS_XS), D, 3};
                pg8::gemm_phase<pg8::EpiStoreBf16, pg8::MoeOrder, true, true>(F.lds, g, S, E); }
        }
        GRID_BAR();
        if (PH(15)) combine_pass(F, l, nrows);
        if (l + 1 < DEPTH) GRID_BAR();
    }
}

extern "C" void kernel_launch(void* const* d_in, const int* in_sizes, int n_in, void* d_out, int out_size, void* d_ws, size_t ws_size, hipStream_t stream) {
    static int grid = 0;
    if (grid == 0) {
        if (n_in != N_IN || in_sizes[0] != NLAT * D || out_size != NLAT * D || ws_size < WS_END) {
            fprintf(stderr, "kernel_launch: unexpected shapes (n_in %d in0 %d out %d ws %zu)\n", n_in, n_in > 0 ? in_sizes[0] : -1, out_size, ws_size); grid = -1; return; }
        int dev = 0, cus = 0, per_cu = 0;
        hipGetDevice(&dev); hipDeviceGetAttribute(&cus, hipDeviceAttributeMultiprocessorCount, dev);
        hipFuncSetAttribute((const void*)fwd_megakernel, hipFuncAttributeMaxDynamicSharedMemorySize, LDS_BYTES);
        hipOccupancyMaxActiveBlocksPerMultiprocessor(&per_cu, (const void*)fwd_megakernel, NTHR, LDS_BYTES);
        if (per_cu < 1) { fprintf(stderr, "kernel_launch: occupancy query says %d blocks per CU\n", per_cu); per_cu = 1; }
        (void)hipGetLastError();
        grid = cus * per_cu;
    }
    if (grid < 0) return;
    hipMemsetAsync((char*)d_ws + WS_CTL, 0, CTL_ZERO_BYTES, stream);
    Params p{};
    for (int i = 0; i < N_IN; ++i) p.in[i] = (const float*)d_in[i];
    p.out = (float*)d_out; p.ws = (unsigned char*)d_ws;
    void* args[] = {&p};
    hipError_t e = hipLaunchCooperativeKernel((const void*)fwd_megakernel, dim3(grid), dim3(NTHR), args, LDS_BYTES, stream);
    if (e != hipSuccess) fprintf(stderr, "kernel_launch: cooperative launch failed: %s (grid %d)\n", hipGetErrorString(e), grid);
}
```

```cpp
#include <hip/hip_runtime.h>
#include <hip/hip_cooperative_groups.h>
#include <cstdio>
#include <cstdint>
namespace cg = cooperative_groups;
#ifndef USE_CG_SYNC
#define USE_CG_SYNC 1
#endif
#define SEQ_PROBE 0
#ifndef PROBE_MASK
#define PROBE_MASK 0
#endif
namespace pg8 {
#define PG8_LAS __attribute__((address_space(3)))
typedef unsigned short bf16_t;
typedef short bf16x8 __attribute__((ext_vector_type(8)));
typedef float f32x4 __attribute__((ext_vector_type(4)));
typedef unsigned u32x4 __attribute__((ext_vector_type(4)));
constexpr int BM = 256, BK = 64, HALF = 128, HTB = HALF * BK * 2  , STAGE_BYTES = 8 * HTB, NXCD = 8, WGM = 8;

__host__ __device__ __forceinline__ int lds_byte(int r, int c) { const int st = (r >> 4) * 2 + (c >> 5), rr = r & 15, cc = c & 31, ob = rr * 64 + cc * 2; return st * 1024 + (ob ^ (((ob >> 9) & 1) << 5)); }
__host__ __device__ __forceinline__ void stage_rc(int b, int& R, int& C) { const int st = b / 1024, sb = b % 1024, swz = sb ^ (((sb >> 9) & 1) << 5); R = (st >> 1) * 16 + swz / 64; C = (st & 1) * 32 + (swz % 64) / 2; }
__host__ __device__ __forceinline__ int perm32(int rho) { const int n = rho >> 4, i = rho & 15; return 8 * (i >> 2) + 4 * n + (i & 3); }

struct Unit { int pm, pn; };
struct Gemm { const bf16_t* A; const bf16_t* Bt; int M, N, K; };

struct StaticOrder {
    int nM, nN, nwg, G, c;
    __host__ __device__ void init(int M, int N, int G_, int c_) { nM = M / BM; nN = N / BM; nwg = nM * nN; G = G_; c = c_; }
    __host__ __device__ bool next(int i, Unit& u) const {
        const long L = (long)i * G + c; if (L >= nwg) return false;
        int wgid = (int)L; { const int q = nwg / NXCD, r = nwg % NXCD, xcd = wgid % NXCD, off = wgid / NXCD; wgid = (xcd < r ? xcd * (q + 1) : r * (q + 1) + (xcd - r) * q) + off; }
        const int nig = WGM * nN, gid = wgid / nig, fm = gid * WGM, gsz = (nM - fm) < WGM ? (nM - fm) : WGM;
        u.pm = fm + ((wgid % nig) % gsz); u.pn = (wgid % nig) / gsz; return true;
    }
    __device__ __forceinline__ void a_ready(const Unit&) const {}
    __device__ __forceinline__ void done(const Unit&) const {}
};

__device__ __forceinline__ unsigned cvt_pk_bf16(float lo, float hi) { unsigned r; asm volatile("v_cvt_pk_bf16_f32 %0, %1, %2" : "=v"(r) : "v"(lo), "v"(hi)); return r; }
typedef float f32x2 __attribute__((ext_vector_type(2)));
template <class Epi, class Sched, bool ALIGN_EPI = false, bool SP2 = false>
__device__ __forceinline__ void gemm_phase(PG8_LAS unsigned char* lds, const Gemm g, const Sched& S, const Epi& E) {
    int tid = threadIdx.x; asm volatile("" : "+v"(tid));
    const int wid = __builtin_amdgcn_readfirstlane(tid >> 6), lane = tid & 63, wr = wid >> 2, wc = wid & 3, fr = lane & 15, fq = lane >> 4;
    const int K = g.K, nt = K / BK;
    unsigned voffA[2], voffB[2];
#pragma unroll
    for (int i = 0; i < 2; ++i) { int R, C; stage_rc(tid * 16 + i * 8192, R, C); const int Rb = Epi::PERM ? ((R & ~31) + perm32(R & 31)) : R;
        voffA[i] = (unsigned)(R * K + C) * 2u; voffB[i] = (unsigned)(Rb * K + C) * 2u; }
    const size_t kstep = (size_t)(BK * 2);
    const size_t hstep = (size_t)HALF * K * 2;
    const size_t tstep = 2 * hstep;
    const unsigned ldsw = (unsigned)wid * 1024u;
    const int aoff = lds_byte(wr * 64 + fr, fq * 8), boff = lds_byte(wc * 32 + fr, fq * 8);
#define PG8_SA(b, h) (((b) * 2 + (h)) * HTB)
#define PG8_SB(b, h) ((4 + (b) * 2 + (h)) * HTB)
#define PG8_STAGE(bufoff, gbase, voff) do { _Pragma("unroll") for (int _i = 0; _i < 2; ++_i) \
        __builtin_amdgcn_global_load_lds((const unsigned*)((const char*)(gbase) + (voff)[_i]), (PG8_LAS unsigned*)(lds + (bufoff) + ldsw + _i * 8192), 16, 0, 0); } while (0)
#define PG8_LDA(dst, b, h) do { _Pragma("unroll") for (int m = 0; m < 4; ++m) _Pragma("unroll") for (int k = 0; k < 2; ++k) dst[m][k] = *(const PG8_LAS bf16x8*)(lds + PG8_SA(b, h) + aoff + m * 2048 + k * 1024); } while (0)
#define PG8_LDB(dst, b, h) do { _Pragma("unroll") for (int n = 0; n < 2; ++n) _Pragma("unroll") for (int k = 0; k < 2; ++k) dst[n][k] = *(const PG8_LAS bf16x8*)(lds + PG8_SB(b, h) + boff + n * 2048 + k * 1024); } while (0)
#define PG8_MMA(ai, bj, At, Bt) do { __builtin_amdgcn_s_setprio(1); _Pragma("unroll") for (int m = 0; m < 4; ++m) _Pragma("unroll") for (int n = 0; n < 2; ++n) _Pragma("unroll") for (int k = 0; k < 2; ++k) \
        acc[ai][bj][m][n] = __builtin_amdgcn_mfma_f32_16x16x32_bf16(Bt[n][k], At[m][k], acc[ai][bj][m][n], 0, 0, 0); __builtin_amdgcn_s_setprio(0); } while (0)
#define PG8_WAIT_V(n) asm volatile("s_waitcnt vmcnt(" #n ")" ::: "memory")
#define PG8_WAIT_L(n) asm volatile("s_waitcnt lgkmcnt(" #n ")" ::: "memory")
#define PG8_BAR __builtin_amdgcn_s_barrier()
#define PG8_SCHED __builtin_amdgcn_sched_barrier(0)
    Unit cur, nxt; int ui = 0;
    if (!S.next(0, cur)) return;
    f32x4 acc[2][2][4][2];
#pragma unroll
    for (int a = 0; a < 2; ++a)
#pragma unroll
        for (int b = 0; b < 2; ++b)
#pragma unroll
            for (int m = 0; m < 4; ++m)
#pragma unroll
                for (int n = 0; n < 2; ++n) acc[a][b][m][n] = (f32x4){0.f, 0.f, 0.f, 0.f};
    bf16x8 At[4][2], B0[2][2], B1[2][2];
    const char* cA = (const char*)g.A + (size_t)cur.pm * tstep; const char* cB = (const char*)g.Bt + (size_t)cur.pn * tstep;
    S.a_ready(cur);
    if constexpr (SP2) {
        PG8_STAGE(PG8_SB(0, 0), cB, voffB); PG8_STAGE(PG8_SB(0, 1), cB + hstep, voffB); PG8_STAGE(PG8_SA(0, 0), cA, voffA); PG8_STAGE(PG8_SA(0, 1), cA + hstep, voffA);
        if (wr == 1) PG8_BAR;
        PG8_WAIT_V(2); PG8_BAR;
        PG8_STAGE(PG8_SB(1, 0), cB + kstep, voffB); PG8_STAGE(PG8_SA(1, 0), cA + kstep, voffA); PG8_STAGE(PG8_SB(1, 1), cB + hstep + kstep, voffB);
        PG8_WAIT_V(6); PG8_BAR;
    } else {
        PG8_STAGE(PG8_SB(0, 0), cB, voffB); PG8_STAGE(PG8_SA(0, 0), cA, voffA); PG8_STAGE(PG8_SB(0, 1), cB + hstep, voffB); PG8_STAGE(PG8_SA(0, 1), cA + hstep, voffA);
        if (wr == 1) PG8_BAR;
        PG8_WAIT_V(4); PG8_BAR;
        PG8_STAGE(PG8_SB(1, 0), cB + kstep, voffB); PG8_STAGE(PG8_SA(1, 0), cA + kstep, voffA); PG8_STAGE(PG8_SB(1, 1), cB + hstep + kstep, voffB);
        PG8_WAIT_V(6); PG8_BAR;
    }
    for (;;) {
        const bool has_next = S.next(ui + 1, nxt);
        const char* nA = has_next ? (const char*)g.A + (size_t)nxt.pm * tstep : cA; const char* nB = has_next ? (const char*)g.Bt + (size_t)nxt.pn * tstep : cB;
        for (int t = 0; t < nt; t += 2) {
            const bool last = (t == nt - 2);
            const char* a1 = cA + (size_t)(t + 1) * kstep;
            const char* a2 = last ? nA : cA + (size_t)(t + 2) * kstep; const char* b2 = last ? nB : cB + (size_t)(t + 2) * kstep;
            const char* a3 = a2 + kstep; const char* b3 = b2 + kstep;
            if (last && has_next) S.a_ready(nxt);
            if constexpr (SP2) {
            PG8_LDB(B0, 0, 0); PG8_LDB(B1, 0, 1); PG8_SCHED; PG8_LDA(At, 0, 0); PG8_STAGE(PG8_SA(1, 1), a1 + hstep, voffA);
            PG8_WAIT_V(8); PG8_WAIT_L(0); PG8_BAR; PG8_MMA(0, 0, At, B0); PG8_MMA(0, 1, At, B1); PG8_BAR; PG8_SCHED;
            PG8_LDA(At, 0, 1); PG8_STAGE(PG8_SB(0, 0), b2, voffB); PG8_STAGE(PG8_SB(0, 1), b2 + hstep, voffB); PG8_STAGE(PG8_SA(0, 0), a2, voffA);
            PG8_WAIT_V(8); PG8_WAIT_L(0); PG8_BAR; PG8_MMA(1, 0, At, B0); PG8_MMA(1, 1, At, B1); PG8_BAR; PG8_SCHED;
            PG8_LDB(B0, 1, 0); PG8_LDB(B1, 1, 1); PG8_SCHED; PG8_LDA(At, 1, 0); PG8_STAGE(PG8_SA(0, 1), a2 + hstep, voffA);
            PG8_WAIT_V(8); PG8_WAIT_L(0); PG8_BAR; PG8_MMA(0, 0, At, B0); PG8_MMA(0, 1, At, B1); PG8_BAR; PG8_SCHED;
            PG8_LDA(At, 1, 1); PG8_STAGE(PG8_SB(1, 0), b3, voffB); PG8_STAGE(PG8_SB(1, 1), b3 + hstep, voffB); PG8_STAGE(PG8_SA(1, 0), a3, voffA);
            PG8_WAIT_V(8); PG8_WAIT_L(0); PG8_BAR; PG8_MMA(1, 0, At, B0); PG8_MMA(1, 1, At, B1); PG8_BAR; PG8_SCHED;
            } else {
            PG8_LDB(B0, 0, 0); PG8_SCHED; PG8_LDA(At, 0, 0); PG8_STAGE(PG8_SA(1, 1), a1 + hstep, voffA);
            PG8_WAIT_L(8); PG8_BAR; PG8_WAIT_L(0); PG8_MMA(0, 0, At, B0); PG8_BAR; PG8_SCHED;
            PG8_LDB(B1, 0, 1); PG8_STAGE(PG8_SB(0, 0), b2, voffB);
            PG8_BAR; PG8_WAIT_L(0); PG8_MMA(0, 1, At, B1); PG8_BAR;
            PG8_LDA(At, 0, 1); PG8_STAGE(PG8_SA(0, 0), a2, voffA);
            PG8_BAR; PG8_WAIT_L(0); PG8_MMA(1, 0, At, B0); PG8_BAR; PG8_SCHED;
            PG8_STAGE(PG8_SB(0, 1), b2 + hstep, voffB);
            PG8_WAIT_V(6); PG8_BAR; PG8_MMA(1, 1, At, B1); PG8_BAR;
            PG8_LDB(B0, 1, 0); PG8_SCHED; PG8_LDA(At, 1, 0); PG8_STAGE(PG8_SA(0, 1), a2 + hstep, voffA);
            PG8_WAIT_L(8); PG8_BAR; PG8_WAIT_L(0); PG8_MMA(0, 0, At, B0); PG8_BAR; PG8_SCHED;
            PG8_LDB(B1, 1, 1); PG8_STAGE(PG8_SB(1, 0), b3, voffB);
            PG8_BAR; PG8_WAIT_L(0); PG8_MMA(0, 1, At, B1); PG8_BAR;
            PG8_LDA(At, 1, 1); PG8_STAGE(PG8_SA(1, 0), a3, voffA);
            PG8_BAR; PG8_WAIT_L(0); PG8_MMA(1, 0, At, B0); PG8_BAR; PG8_SCHED;
            PG8_STAGE(PG8_SB(1, 1), b3 + hstep, voffB);
            PG8_WAIT_V(6); PG8_BAR; PG8_MMA(1, 1, At, B1); PG8_BAR;
            }
        }
        if constexpr (ALIGN_EPI) { if (wr == 0) PG8_BAR; }
        if constexpr (!Epi::AFTER_DRAIN) { E(acc, cur, wr, wc, fr, fq); S.done(cur); }
        if (!has_next) break;
#pragma unroll
        for (int a = 0; a < 2; ++a)
#pragma unroll
            for (int b = 0; b < 2; ++b)
#pragma unroll
                for (int m = 0; m < 4; ++m)
#pragma unroll
                    for (int n = 0; n < 2; ++n) acc[a][b][m][n] = (f32x4){0.f, 0.f, 0.f, 0.f};
        cur = nxt; cA = nA; cB = nB; ++ui;
        if constexpr (ALIGN_EPI) { if (wr == 1) PG8_BAR; }
    }
    PG8_WAIT_V(0);
    if constexpr (!ALIGN_EPI) { if (wr == 0) PG8_BAR; }
    PG8_BAR;
    if constexpr (Epi::AFTER_DRAIN) { E.fused(acc, cur, wr, wc, fr, fq, lds, wid, lane); S.done(cur); }
#undef PG8_SA
#undef PG8_SB
#undef PG8_STAGE
#undef PG8_LDA
#undef PG8_LDB
#undef PG8_MMA
#undef PG8_WAIT_V
#undef PG8_WAIT_L
#undef PG8_BAR
#undef PG8_SCHED
}
}
#define LAS __attribute__((address_space(3)))
typedef unsigned short bf16;
typedef float f32x4 __attribute__((ext_vector_type(4)));
typedef short bf16x8 __attribute__((ext_vector_type(8)));
typedef unsigned u32x4 __attribute__((ext_vector_type(4)));
typedef unsigned u32x2 __attribute__((ext_vector_type(2)));

constexpr int D = 1024, NBATCH = 2, SEQ = 8192, CTXL = 256, DEPTH = 2;
constexpr int NLAT = NBATCH * SEQ, NCTX = NBATCH * CTXL, NROW = NLAT + NCTX;
constexpr int DR = 512, DIN = 2944, NP = 3328, ZW = 1920, NHEAD = 8;
constexpr int COL_CONV = 1920, COL_FC = 2688, COL_FS = 2944;
constexpr int STRW = 5120;
constexpr int NEXP = 32, DEXP = 512;
constexpr int MOE_MAXTILES = 168;
constexpr float RMS_EPS = 1e-6f, GN_EPS = 64e-5f;

enum { I_X = 0, I_C, I_CTX, I_CCTX, I_ADAW, I_ADAB, I_N1G, I_N2G, I_WIN, I_MU, I_DW0, I_DW2, I_IA0, I_IA2, I_GG2, I_KK, I_KA, I_RK, I_GNW, I_GNB,
       I_CONVW, I_CONVG, I_FOURG, I_WOUT, I_RGW, I_RGB, I_REW, I_REB, I_EG, I_EU, I_ED, I_FG, N_IN };

constexpr size_t MiB = 1u << 20;
constexpr size_t WS_CTL = 0, CTL_ZERO_BYTES = 64 * 1024;
constexpr size_t WS_MODP = 1 * MiB;
constexpr size_t WS_MODF = 1 * MiB + 1280 * 1024;
constexpr size_t WS_WIN_T = 3 * MiB;
constexpr size_t WS_WOUT_T = 16 * MiB;
constexpr size_t WS_WGU_T = 20 * MiB;
constexpr size_t WS_WD_T = 84 * MiB;
constexpr size_t WS_X = 116 * MiB;
constexpr size_t WS_H = 182 * MiB;
constexpr size_t WS_ZS = 215 * MiB;
constexpr size_t WS_P = 277 * MiB;
constexpr size_t WS_STR = 277 * MiB;
constexpr size_t WS_Y = 442 * MiB;
constexpr size_t WS_GT = 475 * MiB;
constexpr size_t WS_ROUTE = 491 * MiB;
constexpr size_t WS_XS = 215 * MiB;
constexpr size_t WS_ACT = 299 * MiB;
constexpr size_t WS_END = 530 * MiB;
constexpr size_t RT_E = 0, RT_POS = 1 * 33792 * 4, RT_GATE = 2 * 33792 * 4, RT_SLOT = 3 * 33792 * 4, RT_TILE = 4 * 33792 * 4, RT_NT = RT_TILE + 1024;

constexpr int CW_BAR = 4096;
constexpr int CW_CNT = 8192;

constexpr int NWAVES = 8, NTHR = 512;
constexpr int RING_BYTES = 131072, LDSCTL_OFF = 143360, MISC_OFF = LDSCTL_OFF + 320, LDS_BYTES = 147456;

struct Params { const float* in[N_IN]; float* out; unsigned char* ws; };

__device__ __forceinline__ float bf2f(unsigned h) { return __uint_as_float(h << 16); }
typedef __bf16 hwbf2 __attribute__((ext_vector_type(2)));
typedef float f32x2 __attribute__((ext_vector_type(2)));
__device__ __forceinline__ unsigned pk2(float lo, float hi) { const f32x2 x = {lo, hi}; const hwbf2 r = __builtin_convertvector(x, hwbf2); return __builtin_bit_cast(unsigned, r); }
__device__ __forceinline__ unsigned f2bf(float f) { return pk2(f, 0.f) & 0xffffu; }
__device__ __forceinline__ float wave_sum(float v) {
#pragma unroll
    for (int o = 1; o < 64; o <<= 1) v += __shfl_xor(v, o);
    return v;
}
__device__ __forceinline__ float sigmoidf_(float x) { return 1.f / (1.f + __expf(-x)); }
#define LDS_WAIT() asm volatile("s_waitcnt lgkmcnt(0)" ::: "memory")
#define VM_WAIT() asm volatile("s_waitcnt vmcnt(0)" ::: "memory")

struct Frame {
    LAS unsigned char* lds;
    int tid, lane, wave, vcu, G, gw, NGW;
    float* out; unsigned char* ws;
};
__device__ __forceinline__ const float* inptr(int i) {
    const volatile unsigned long long __attribute__((address_space(4)))* ka = (const volatile unsigned long long __attribute__((address_space(4)))*)__builtin_amdgcn_kernarg_segment_ptr();
    return (const float*)ka[i];
}
__device__ __forceinline__ unsigned char* opaque(unsigned char* p) { asm volatile("" : "+s"(p)); return p; }
__device__ __forceinline__ Frame phase_frame(const Frame& F0) { Frame F = F0; asm volatile("" : "+v"(F.tid)); F.lane = F.tid & 63; F.ws = opaque(F0.ws);
    asm volatile("" : "+s"(F.G), "+s"(F.vcu)); F.gw = F.vcu * NWAVES + F.wave; F.NGW = F.G * NWAVES; return F; }
__device__ __forceinline__ int modrow(int row) { return row < NLAT ? (row >> 13) : 2; }
#define XB_TMO      128
#define XB_XCNT(j)  (256  + 64 * (j))
#define XB_XSUB(j)  (1280 + 64 * (j))
#define XB_XGEN(j)  (2304 + 64 * (j))
#define XB_TOP      3328
#define XB_TOPGEN   3392
#define XCD_BAR_WORDS 3456
#define XB_SPIN_CAP (1u << 18)

__device__ __forceinline__ unsigned xb_ld(unsigned* p)              { return __hip_atomic_load(p, __ATOMIC_RELAXED, __HIP_MEMORY_SCOPE_AGENT); }
__device__ __forceinline__ unsigned xb_add(unsigned* p, unsigned v) { return __hip_atomic_fetch_add(p, v, __ATOMIC_RELAXED, __HIP_MEMORY_SCOPE_AGENT); }
__device__ __forceinline__ unsigned xb_xcc_id() { return (unsigned)__builtin_amdgcn_s_getreg((3 << 11) | 20) & 0xFu; }
#define XB_SPIN(cond, bar) do { unsigned _sp = 0; while (cond) { __builtin_amdgcn_s_sleep(1); \
    if ((++_sp & 255u) == 0u) { if (xb_ld(&(bar)[XB_TMO])) break; if (_sp > XB_SPIN_CAP) { atomicAdd(&(bar)[XB_TMO], 1u); break; } } } } while (0)

struct XcdBarrier {
    unsigned* bar; unsigned x;
    volatile LAS unsigned* st;
};

__device__ __forceinline__ XcdBarrier xcd_barrier_post(unsigned* bar, volatile LAS unsigned* st) {
    XcdBarrier b; b.bar = bar; b.x = xb_xcc_id(); b.st = st;
    if (threadIdx.x == 0) (void)xb_add(&bar[XB_XCNT(b.x)], 1u);
    return b;
}
__device__ __forceinline__ void xcd_barrier_complete(unsigned* bar, unsigned x, unsigned& nloc, unsigned& nx) {
    const unsigned G = gridDim.x * gridDim.y * gridDim.z;
    unsigned sum, cnt, mine, sp = 0u;
    for (;;) {
        sum = 0u; cnt = 0u; mine = 0u;
#pragma nounroll
        for (unsigned j = 0; j < 16; ++j) { const unsigned c = xb_ld(&bar[XB_XCNT(j)]); sum += c; cnt += (c > 0u) ? 1u : 0u; mine = (j == x) ? c : mine; }
        if (sum == G) break;
        __builtin_amdgcn_s_sleep(1);
        if ((++sp & 255u) == 0u) { if (xb_ld(&bar[XB_TMO])) break; if (sp > XB_SPIN_CAP) { atomicAdd(&bar[XB_TMO], 1u); break; } }
    }
    nloc = mine > 0u ? mine : 1u; nx = cnt > 0u ? cnt : 1u;
}

__device__ __forceinline__ void xcd_barrier(const XcdBarrier& b) {
    asm volatile("s_waitcnt vmcnt(0)" ::: "memory");
    __syncthreads();
    if (threadIdx.x == 0) {
        unsigned* bar = b.bar;
        asm volatile("" : "+s"(bar));
        __builtin_amdgcn_s_waitcnt(0);
        unsigned nloc = b.st[0], nx = b.st[1];
        if (nloc == 0u) { xcd_barrier_complete(bar, b.x, nloc, nx); b.st[0] = nloc; b.st[1] = nx; }
        const unsigned old = xb_add(&bar[XB_XSUB(b.x)], 1u);
        const unsigned gen = old / nloc;
        if (old + 1u == (gen + 1u) * nloc) {
            __builtin_amdgcn_fence(__ATOMIC_RELEASE, "agent");
            asm volatile("s_waitcnt vmcnt(0)" ::: "memory");
            const unsigned og = xb_add(&bar[XB_TOP], 1u);
            const unsigned tg = og / nx;
            if (og + 1u == (tg + 1u) * nx) xb_add(&bar[XB_TOPGEN], 1u);
            else XB_SPIN(xb_ld(&bar[XB_TOPGEN]) == tg, bar);
            __builtin_amdgcn_fence(__ATOMIC_ACQUIRE, "agent");
            xb_add(&bar[XB_XGEN(b.x)], 1u);
            asm volatile("s_waitcnt vmcnt(0)" ::: "memory");
        } else {
            XB_SPIN(xb_ld(&bar[XB_XGEN(b.x)]) == gen, bar);
            __builtin_amdgcn_fence(__ATOMIC_ACQUIRE, "agent");
            asm volatile("s_waitcnt vmcnt(0)" ::: "memory");
        }
    }
    __syncthreads();
}
template <class RowMap>
__device__ __forceinline__ void transpose_item(const float* W, int ldw, int k0, int n0, bf16* WT, int ldt, RowMap rm, LAS float* scr, int lane) {
    (void)scr;
    const int nq = lane & 7, kg = lane >> 3; const float* src = W + (size_t)(k0 + 8 * kg) * ldw + n0 + 4 * nq;
    f32x4 v[8];
#pragma unroll
    for (int i = 0; i < 8; ++i) v[i] = *(const f32x4*)(src + (size_t)i * ldw);
#pragma unroll
    for (int j = 0; j < 4; ++j) { u32x4 o = {pk2(v[0][j], v[1][j]), pk2(v[2][j], v[3][j]), pk2(v[4][j], v[5][j]), pk2(v[6][j], v[7][j])};
        *(u32x4*)(WT + (size_t)rm(n0 + 4 * nq + j) * ldt + k0 + 8 * kg) = o; }
}
struct RmId { int off; __device__ __forceinline__ int operator()(int n) const { return off + n; } };
struct RmGU { int off; __device__ __forceinline__ int operator()(int n) const { return off + ((n >> 2) << 3) + (n & 3); } };

__device__ __forceinline__ void p0_prologue(const Frame& F0) {
    const Frame F = phase_frame(F0); unsigned char* const ws = F.ws;
    LAS float* scr = (LAS float*)(F.lds + F.wave * 16384);
    LAS float* ctab = (LAS float*)(F.lds + 8 * 16384);
    if (F.tid < 64) ctab[F.tid] = cosf((float)F.tid * (6.283185307179586f / 64.f));
    __syncthreads();
    bf16* win_t = (bf16*)(ws + WS_WIN_T); bf16* wout_t = (bf16*)(ws + WS_WOUT_T);
    constexpr int I_WIN_L = 16 * 84, I_WOUT_L = 16 * 32, I_FOLD_L = 4 * 64, I_MOD_L = 96 * 8;
    constexpr int NIT = 2 * (I_WIN_L + I_WOUT_L + I_FOLD_L + I_MOD_L);
    const float* p_win = inptr(I_WIN); const float* p_wout = inptr(I_WOUT); const float* p_c = inptr(I_C); const float* p_cctx = inptr(I_CCTX); const float* p_adaw = inptr(I_ADAW);
    {
        bf16* wl = (bf16*)(ws + 64 * 1024); const float* dw2 = inptr(I_DW2); const float* ia2 = inptr(I_IA2); const float* gg2 = inptr(I_GG2);
        for (int idx = F.vcu * NTHR + F.tid; idx < 2 * 384 * 512; idx += F.G * NTHR) { const int c = idx & 511, k = (idx >> 9) % 384, l = idx / (384 * 512);
            float v;
            if (k < 128) v = dw2[((size_t)(l * 2 + (k >> 6)) * 64 + (k & 63)) * DR + c];
            else if (k < 256) v = ia2[((size_t)(l * 2 + ((k - 128) >> 6)) * 64 + (k & 63)) * DR + c];
            else v = gg2[((size_t)l * 128 + (k - 256)) * DR + c];
            wl[((size_t)l * 512 + c) * 384 + k] = (bf16)f2bf(v); } }
    for (int it = F.gw; it < NIT; it += F.NGW) {
        int r = it; const int l = r & 1; r >>= 1;
        if (r < I_WIN_L) { const int kb = r / 84, nb = r % 84;
            transpose_item(p_win + (size_t)l * D * DIN, DIN, kb * 64, nb * 32, win_t + (size_t)l * NP * D, D, RmId{0}, scr, F.lane); continue; }
        r -= I_WIN_L;
        if (r < I_WOUT_L) { const int kb = r / 32, nb = r % 32;
            transpose_item(p_wout + (size_t)l * D * D, D, kb * 64, nb * 32, wout_t + (size_t)l * D * D, D, RmId{0}, scr, F.lane); continue; }
        r -= I_WOUT_L;
        if (r < I_FOLD_L) {
            const int g = r >> 6, k0 = (r & 63) * 16; const float* W = p_win + (size_t)l * D * DIN;
#pragma unroll
            for (int kk = 0; kk < 16; ++kk) scr[kk * 64 + F.lane] = W[(size_t)(k0 + kk) * DIN + 2688 + g * 64 + F.lane];
            LDS_WAIT(); asm volatile("" ::: "memory");
            float ac[16], as[16];
#pragma unroll
            for (int kk = 0; kk < 16; ++kk) { ac[kk] = 0.f; as[kk] = 0.f; }
            for (int c = 0; c < 64; ++c) { const int idx = (c * F.lane) & 63; const float cc = ctab[idx], ss = ctab[(idx - 16) & 63];
#pragma unroll
                for (int kk = 0; kk < 16; ++kk) { const float w = scr[kk * 64 + c]; ac[kk] += w * cc; as[kk] += w * ss; } }
            bf16* oc = win_t + (size_t)l * NP * D + (size_t)(COL_FC + g * 64 + F.lane) * D + k0;
            bf16* os = win_t + (size_t)l * NP * D + (size_t)(COL_FS + g * 64 + F.lane) * D + k0;
            u32x4 a, b;
            a.x = pk2(ac[0], ac[1]); a.y = pk2(ac[2], ac[3]); a.z = pk2(ac[4], ac[5]); a.w = pk2(ac[6], ac[7]);
            b.x = pk2(ac[8], ac[9]); b.y = pk2(ac[10], ac[11]); b.z = pk2(ac[12], ac[13]); b.w = pk2(ac[14], ac[15]);
            *(u32x4*)oc = a; *(u32x4*)(oc + 8) = b;
            a.x = pk2(as[0], as[1]); a.y = pk2(as[2], as[3]); a.z = pk2(as[4], as[5]); a.w = pk2(as[6], as[7]);
            b.x = pk2(as[8], as[9]); b.y = pk2(as[10], as[11]); b.z = pk2(as[12], as[13]); b.w = pk2(as[14], as[15]);
            *(u32x4*)os = a; *(u32x4*)(os + 8) = b;
            LDS_WAIT(); asm volatile("" ::: "memory");
            continue; }
        r -= I_FOLD_L;
        {
            const int cb = r >> 3, ks = r & 7;
#pragma unroll
            for (int q = 0; q < 2; ++q) { const int k = ks * 128 + q * 64 + F.lane;
                const float c0 = p_c[k], c1 = p_c[D + k], c2 = p_cctx[k];
                scr[0 * 128 + q * 64 + F.lane] = c0 * sigmoidf_(c0); scr[1 * 128 + q * 64 + F.lane] = c1 * sigmoidf_(c1); scr[2 * 128 + q * 64 + F.lane] = c2 * sigmoidf_(c2); }
            LDS_WAIT(); asm volatile("" ::: "memory");
            const float* W = p_adaw + (size_t)l * D * 6144 + (size_t)(ks * 128) * 6144 + cb * 64 + F.lane;
            float a0 = 0.f, a1 = 0.f, a2 = 0.f;
#pragma unroll 8
            for (int kk = 0; kk < 128; ++kk) { const float w = W[(size_t)kk * 6144]; a0 += scr[kk] * w; a1 += scr[128 + kk] * w; a2 += scr[256 + kk] * w; }
            float* mp = (float*)(ws + WS_MODP) + (size_t)((l * 8 + ks) * 3) * 6144 + cb * 64 + F.lane;
            mp[0] = a0; mp[6144] = a1; mp[2 * 6144] = a2;
            LDS_WAIT(); asm volatile("" ::: "memory");
        }
    }
}

__device__ __forceinline__ void mod_to_lds(const Frame& F0, int l, int p, LAS float* dst, bool from_partials) {
    const Frame F = phase_frame(F0); unsigned char* const ws = F.ws;
    const float* adab = inptr(I_ADAB);
    for (int idx = F.tid; idx < 3 * 1024; idx += NTHR) { const int r = idx >> 10, n = idx & 1023;
        float v;
        if (from_partials) { v = adab[l * 6144 + p * 1024 + n]; const float* mp = (const float*)(ws + WS_MODP) + (size_t)(l * 8 * 3 + r) * 6144 + p * 1024 + n;
#pragma unroll
            for (int ks = 0; ks < 8; ++ks) v += mp[(size_t)ks * 3 * 6144]; }
        else v = ((const float*)(ws + WS_MODF))[(size_t)(l * 3 + r) * 6144 + p * 1024 + n];
        dst[idx] = v; }
}
__device__ __forceinline__ void mod_finalize(const Frame& F0) {
    const Frame F = phase_frame(F0); unsigned char* const ws = F.ws;
    const float* adab = inptr(I_ADAB);
    for (int idx = F.vcu * NTHR + F.tid; idx < 2 * 3 * 6144; idx += F.G * NTHR) { const int l = idx / (3 * 6144), rem = idx % (3 * 6144), r = rem / 6144, n = rem % 6144;
        float v = adab[l * 6144 + n]; const float* mp = (const float*)(ws + WS_MODP) + (size_t)(l * 8 * 3 + r) * 6144 + n;
#pragma unroll
        for (int ks = 0; ks < 8; ++ks) v += mp[(size_t)ks * 3 * 6144];
        ((float*)(ws + WS_MODF))[idx] = v; }
}


__device__ __forceinline__ void norm_mod_row(f32x4 (&v)[4], const float* gain, const LAS float* sc, const LAS float* sh, bf16* orow, int lane) {
    float s = 0.f;
#pragma unroll
    for (int j = 0; j < 4; ++j) s += (v[j].x * v[j].x + v[j].y * v[j].y) + (v[j].z * v[j].z + v[j].w * v[j].w);
    const float rs = rsqrtf(wave_sum(s) * (1.f / D) + RMS_EPS);
#pragma unroll
    for (int j = 0; j < 4; ++j) { const int c = 4 * lane + 256 * j; const f32x4 g = *(const f32x4*)(gain + c); const f32x4 a = *(const LAS f32x4*)(sc + c), b = *(const LAS f32x4*)(sh + c);
        v[j] = (v[j] * rs) * g * (a + 1.f) + b;
        u32x2 w; w.x = pk2(v[j].x, v[j].y); w.y = pk2(v[j].z, v[j].w); *(u32x2*)(orow + c) = w; }
}

__device__ __forceinline__ void p0b_norm1(const Frame& F0) {
    const Frame F = phase_frame(F0); unsigned char* const ws = F.ws;
    LAS float* msh = (LAS float*)F.lds; LAS float* msc = msh + 3072;
    mod_to_lds(F, 0, 0, msh, true); mod_to_lds(F, 0, 1, msc, true); __syncthreads();
    mod_finalize(F);
    bf16* H = (bf16*)(ws + WS_H); const float* xin = inptr(I_X); const float* cin = inptr(I_CTX); const float* n1g = inptr(I_N1G);
    for (int row = F.gw; row < NROW; row += F.NGW) { const float* xr = row < NLAT ? xin + (size_t)row * D : cin + (size_t)(row - NLAT) * D; f32x4 v[4];
#pragma unroll
        for (int j = 0; j < 4; ++j) v[j] = *(const f32x4*)(xr + 4 * F.lane + 256 * j);
        const int mr = modrow(row);
        norm_mod_row(v, n1g, msc + mr * 1024, msh + mr * 1024, H + (size_t)row * D, F.lane); }
}
__device__ __forceinline__ void unpack8(const u32x4 w, float (&o)[8]) {
    o[0] = bf2f(w.x & 0xffffu); o[1] = bf2f(w.x >> 16); o[2] = bf2f(w.y & 0xffffu); o[3] = bf2f(w.y >> 16);
    o[4] = bf2f(w.z & 0xffffu); o[5] = bf2f(w.z >> 16); o[6] = bf2f(w.w & 0xffffu); o[7] = bf2f(w.w >> 16);
}
__device__ __forceinline__ void unpack4(const u32x2 w, float (&o)[4]) { o[0] = bf2f(w.x & 0xffffu); o[1] = bf2f(w.x >> 16); o[2] = bf2f(w.y & 0xffffu); o[3] = bf2f(w.y >> 16); }

__device__ __forceinline__ void shift_pass(const Frame& F0, int l) {
    const Frame F = phase_frame(F0); unsigned char* const ws = F.ws;
    const bf16* P = (const bf16*)(ws + WS_P); bf16* Zs = (bf16*)(ws + WS_ZS); const float* mu = inptr(I_MU) + l * ZW;
    const int total = NROW * 240;
    for (int idx = F.vcu * NTHR + F.tid; idx < total; idx += F.G * NTHR) {
        const int row = idx / 240, ck = idx % 240; const bf16* pr = P + (size_t)row * NP + ck * 8;
        const u32x4 zero = {0u, 0u, 0u, 0u};
        float z[8], n0[8], n1[8], n2[8], n3[8], o[8];
        unpack8(*(const u32x4*)pr, z);
        if (row < NLAT) { const int t = row & (SEQ - 1), gr = t >> 6, gc = t & 63;
            unpack8(gc > 0 ? *(const u32x4*)(pr - NP) : zero, n0); unpack8(gc < 63 ? *(const u32x4*)(pr + NP) : zero, n1);
            unpack8(gr > 0 ? *(const u32x4*)(pr - 64 * NP) : zero, n2); unpack8(gr < 127 ? *(const u32x4*)(pr + 64 * NP) : zero, n3);
        } else { const int tc = (row - NLAT) & (CTXL - 1);
            unpack8(tc > 0 ? *(const u32x4*)(pr - NP) : zero, n0); unpack8(tc < CTXL - 1 ? *(const u32x4*)(pr + NP) : zero, n1);
#pragma unroll
            for (int j = 0; j < 8; ++j) { n2[j] = n0[j]; n3[j] = n1[j]; }
        }
        const f32x4 m0 = *(const f32x4*)(mu + ck * 8), m1 = *(const f32x4*)(mu + ck * 8 + 4);
        const float m[8] = {m0.x, m0.y, m0.z, m0.w, m1.x, m1.y, m1.z, m1.w};
#pragma unroll
        for (int j = 0; j < 8; ++j) { const float nb = (j & 3) == 0 ? n0[j] : (j & 3) == 1 ? n1[j] : (j & 3) == 2 ? n2[j] : n3[j]; o[j] = z[j] + (nb - z[j]) * m[j]; }
        u32x4 w; w.x = pk2(o[0], o[1]); w.y = pk2(o[2], o[3]); w.z = pk2(o[4], o[5]); w.w = pk2(o[6], o[7]);
        *(u32x4*)(Zs + (size_t)row * ZW + ck * 8) = w;
    }
}

__device__ __forceinline__ void conv_pass(const Frame& F0, int l, int nrows) {
    const Frame F = phase_frame(F0); unsigned char* const ws = F.ws;
    const bf16* P = (const bf16*)(ws + WS_P); bf16* MA = (bf16*)(ws + WS_H);
    const float* cw = inptr(I_CONVW) + l * 3 * 256; const int c = 4 * F.lane;
    const f32x4 w0 = *(const f32x4*)(cw + c), w1 = *(const f32x4*)(cw + 256 + c), w2 = *(const f32x4*)(cw + 512 + c), gn = *(const f32x4*)(inptr(I_CONVG) + l * 256 + c);
    for (int row = F.gw; row < nrows; row += F.NGW) {
        int t, L; if (row < NLAT) { t = row & (SEQ - 1); L = SEQ; } else { t = (row - NLAT) & (CTXL - 1); L = CTXL; }
        const bf16* pr = P + (size_t)row * NP + COL_CONV + c;
        float bg[4], cg[4], hh[4], cp[4], hp[4], cn[4], hn[4]; const u32x2 zero = {0u, 0u};
        unpack4(*(const u32x2*)pr, bg); unpack4(*(const u32x2*)(pr + 256), cg); unpack4(*(const u32x2*)(pr + 512), hh);
        unpack4(t > 0 ? *(const u32x2*)(pr - NP + 256) : zero, cp); unpack4(t > 0 ? *(const u32x2*)(pr - NP + 512) : zero, hp);
        unpack4(t < L - 1 ? *(const u32x2*)(pr + NP + 256) : zero, cn); unpack4(t < L - 1 ? *(const u32x2*)(pr + NP + 512) : zero, hn);
        const float W0[4] = {w0.x, w0.y, w0.z, w0.w}, W1[4] = {w1.x, w1.y, w1.z, w1.w}, W2[4] = {w2.x, w2.y, w2.z, w2.w}, GN[4] = {gn.x, gn.y, gn.z, gn.w};
        float y[4], s = 0.f;
#pragma unroll
        for (int j = 0; j < 4; ++j) { y[j] = bg[j] * (W0[j] * (cp[j] * hp[j]) + W1[j] * (cg[j] * hh[j]) + W2[j] * (cn[j] * hn[j])); s += y[j] * y[j]; }
        const float rs = rsqrtf(wave_sum(s) * (1.f / 256.f) + RMS_EPS);
        u32x2 o; o.x = pk2(y[0] * rs * GN[0], y[1] * rs * GN[1]); o.y = pk2(y[2] * rs * GN[2], y[3] * rs * GN[3]);
        *(u32x2*)(MA + (size_t)row * D + 512 + c) = o;
    }
}

#define MFMA16(a, b, c) __builtin_amdgcn_mfma_f32_16x16x32_bf16((a), (b), (c), 0, 0, 0)

__device__ __forceinline__ void fftA_item(const Frame& F0, int item) {
    const Frame F = phase_frame(F0); unsigned char* const ws = F.ws;
    const int half = item & 1, t2 = (item >> 1) & 63, b = item >> 7;
    const bf16* P = (const bf16*)(ws + WS_P); bf16* GT = (bf16*)(ws + WS_GT);
    LAS bf16* Bs = (LAS bf16*)F.lds;
    const int lane = F.lane, w = F.wave, fr = lane & 15, fq = lane >> 4;
    __syncthreads();
#pragma unroll
    for (int i = 0; i < 8; ++i) { const int cidx = F.tid + NTHR * i, krow = cidx >> 4, ch8 = cidx & 15, ri = krow >> 7, t1 = krow & 127;
        const u32x4 v = *(const u32x4*)(P + (size_t)(b * SEQ + t1 * 64 + t2) * NP + COL_FC + ri * 256 + half * 128 + ch8 * 8);
        LAS bf16* d = Bs + (ch8 * 8) * 264 + krow;
        d[0 * 264] = (bf16)(v.x & 0xffffu); d[1 * 264] = (bf16)(v.x >> 16); d[2 * 264] = (bf16)(v.y & 0xffffu); d[3 * 264] = (bf16)(v.y >> 16);
        d[4 * 264] = (bf16)(v.z & 0xffffu); d[5 * 264] = (bf16)(v.z >> 16); d[6 * 264] = (bf16)(v.w & 0xffffu); d[7 * 264] = (bf16)(v.w >> 16); }
    __syncthreads();
    f32x4 acc[2][8];
#pragma unroll
    for (int a = 0; a < 2; ++a)
#pragma unroll
        for (int n = 0; n < 8; ++n) acc[a][n] = (f32x4){0.f, 0.f, 0.f, 0.f};
    int t1p_a = 16 * w + fr;
    asm volatile("" : "+v"(t1p_a));
#pragma unroll
    for (int ks = 0; ks < 8; ++ks) {
        bf16x8 ar, ai;
#pragma unroll
        for (int j = 0; j < 8; ++j) { const int k = ks * 32 + 8 * fq + j, ri = k >> 7, t1 = k & 127; const int idx = (t1 * t1p_a) & 127;
            float sn, cs; __sincosf((float)idx * (6.283185307179586f / 128.f), &sn, &cs);
            const float vr = ri == 0 ? cs : -sn, vi = ri == 0 ? -sn : -cs;
            ar[j] = (short)f2bf(vr); ai[j] = (short)f2bf(vi); }
#pragma unroll
        for (int nt = 0; nt < 8; ++nt) { const bf16x8 bfr = *(const LAS bf16x8*)(Bs + (nt * 16 + fr) * 264 + ks * 32 + 8 * fq);
            acc[0][nt] = MFMA16(ar, bfr, acc[0][nt]); acc[1][nt] = MFMA16(ai, bfr, acc[1][nt]); }
    }
#pragma unroll
    for (int reg = 0; reg < 4; ++reg) { const int t1p = 16 * w + 4 * fq + reg; float st, ct; __sincosf((float)(t2 * t1p) * (6.283185307179586f / 8192.f), &st, &ct);
        bf16* g = GT + ((size_t)((b * 128 + t1p) * 64 + t2) * 2) * 256 + half * 128 + fr;
#pragma unroll
        for (int nt = 0; nt < 8; ++nt) { const float gr = acc[0][nt][reg], gi = acc[1][nt][reg];
            g[nt * 16] = (bf16)f2bf(gr * ct + gi * st); g[256 + nt * 16] = (bf16)f2bf(gi * ct - gr * st); } }
}

template <int NKC, int NDIV, class SrcRow, class OutRow>
__device__ __forceinline__ void dft64_item(const Frame& F0, int l, int m0, float sgn, float scale, SrcRow src, OutRow orow) {
    const Frame F = phase_frame(F0); unsigned char* const ws = F.ws;
    LAS bf16* Bs = (LAS bf16*)F.lds;
    LAS float* red = (LAS float*)(F.lds + 256 * 136 * 2);
    const int lane = F.lane, w = F.wave, fr = lane & 15, fq = lane >> 4;
    int fr_a = fr; asm volatile("" : "+v"(fr_a));
    f32x4 acc[4][2];
#pragma unroll
    for (int a = 0; a < 4; ++a) { acc[a][0] = (f32x4){0.f, 0.f, 0.f, 0.f}; acc[a][1] = (f32x4){0.f, 0.f, 0.f, 0.f}; }
    for (int kc = 0; kc < NKC; ++kc) {
        __syncthreads();
#pragma unroll
        for (int i = 0; i < 8; ++i) { const int cidx = F.tid + NTHR * i, krow = cidx >> 5, ch8 = cidx & 31;
            const u32x4 v = *(const u32x4*)(src(kc * 64 + (krow >> 1), krow & 1) + ch8 * 8);
            LAS bf16* d = Bs + (ch8 * 8) * 136 + krow;
            d[0 * 136] = (bf16)(v.x & 0xffffu); d[1 * 136] = (bf16)(v.x >> 16); d[2 * 136] = (bf16)(v.y & 0xffffu); d[3 * 136] = (bf16)(v.y >> 16);
            d[4 * 136] = (bf16)(v.z & 0xffffu); d[5 * 136] = (bf16)(v.z >> 16); d[6 * 136] = (bf16)(v.w & 0xffffu); d[7 * 136] = (bf16)(v.w >> 16); }
        __syncthreads();
#pragma unroll
        for (int ks = 0; ks < 4; ++ks) {
            const bf16x8 b0 = *(const LAS bf16x8*)(Bs + ((2 * w) * 16 + fr) * 136 + ks * 32 + 8 * fq);
            const bf16x8 b1 = *(const LAS bf16x8*)(Bs + ((2 * w + 1) * 16 + fr) * 136 + ks * 32 + 8 * fq);
#pragma unroll
            for (int mt = 0; mt < 4; ++mt) { const int mrow = m0 + mt * 16 + fr_a; bf16x8 a;
#pragma unroll
                for (int j = 0; j < 8; ++j) { const int k = ks * 32 + 8 * fq + j, tl = k >> 1, ri = k & 1; const int idx = ((kc * 64 + tl) * mrow) & (NDIV - 1);
                    float sn, cs; __sincosf((float)idx * (6.283185307179586f / (float)NDIV), &sn, &cs);
                    a[j] = (short)f2bf(ri == 0 ? cs : sgn * sn); }
                acc[mt][0] = MFMA16(a, b0, acc[mt][0]); acc[mt][1] = MFMA16(a, b1, acc[mt][1]); }
        }
    }
#pragma unroll
    for (int mt = 0; mt < 4; ++mt)
#pragma unroll
        for (int reg = 0; reg < 4; ++reg) { const float a = acc[mt][0][reg] * scale, b = acc[mt][1][reg] * scale; acc[mt][0][reg] = a; acc[mt][1][reg] = b;
            float s = a * a + b * b; s += __shfl_xor(s, 1); s += __shfl_xor(s, 2); s += __shfl_xor(s, 4); s += __shfl_xor(s, 8);
            if (fr == 0) red[w * 64 + mt * 16 + 4 * fq + reg] = s; }
    __syncthreads();
    bf16* MA = (bf16*)(ws + WS_H); const float* fg = inptr(I_FOURG) + l * 256;
    const float g0 = fg[(2 * w) * 16 + fr], g1 = fg[(2 * w + 1) * 16 + fr];
#pragma unroll
    for (int mt = 0; mt < 4; ++mt)
#pragma unroll
        for (int reg = 0; reg < 4; ++reg) { const int ml = mt * 16 + 4 * fq + reg; float tot = 0.f;
#pragma unroll
            for (int ww = 0; ww < 8; ++ww) tot += red[ww * 64 + ml];
            const float rs = rsqrtf(tot * (1.f / 256.f) + RMS_EPS);
            bf16* o = MA + (size_t)orow(m0 + ml) * D + 768 + fr;
            o[(2 * w) * 16] = (bf16)f2bf(acc[mt][0][reg] * rs * g0); o[(2 * w + 1) * 16] = (bf16)f2bf(acc[mt][1][reg] * rs * g1); }
    __syncthreads();
}

constexpr size_t WS_LORA = 64 * 1024;
constexpr int LINP = 392;
__device__ __forceinline__ void prep_item(const Frame& F0, int l, int item) {
    const Frame F = phase_frame(F0); unsigned char* const ws = F.ws;
    const bf16* Zs = (const bf16*)(ws + WS_ZS); bf16* STR = (bf16*)(ws + WS_STR);
    LAS bf16* lin = (LAS bf16*)F.lds;
    const int row0 = item * 16, lane = F.lane, fr = lane & 15, fq = lane >> 4, w = F.wave;
    __syncthreads();
    for (int idx = F.tid; idx < 16 * 48; idx += NTHR) { const int t = idx / 48, c8 = idx % 48;
        float v[8]; unpack8(*(const u32x4*)(Zs + (size_t)(row0 + t) * ZW + 1536 + c8 * 8), v);
        if (c8 < 16) {
#pragma unroll
            for (int j = 0; j < 8; ++j) v[j] = tanhf(v[j]); }
        else if (c8 >= 32) {
#pragma unroll
            for (int j = 0; j < 8; ++j) v[j] = sigmoidf_(v[j]); }
        u32x4 o = {pk2(v[0], v[1]), pk2(v[2], v[3]), pk2(v[4], v[5]), pk2(v[6], v[7])};
        *(LAS u32x4*)(lin + t * LINP + c8 * 8) = o; }
    __syncthreads();
    f32x4 acc[5][4];
#pragma unroll
    for (int q = 0; q < 5; ++q)
#pragma unroll
        for (int nt = 0; nt < 4; ++nt) acc[q][nt] = (f32x4){0.f, 0.f, 0.f, 0.f};
    const bf16* WL = (const bf16*)(ws + WS_LORA) + (size_t)l * 512 * 384 + (size_t)(64 * w + fr) * 384 + 8 * fq;
#pragma unroll
    for (int ks = 0; ks < 12; ++ks) { const int q = ks < 8 ? (ks >> 1) : 4;
        const bf16x8 xf = *(const LAS bf16x8*)(lin + fr * LINP + ks * 32 + 8 * fq);
#pragma unroll
        for (int nt = 0; nt < 4; ++nt) { const bf16x8 wf = *(const bf16x8*)(WL + (size_t)nt * 16 * 384 + ks * 32); acc[q][nt] = MFMA16(wf, xf, acc[q][nt]); } }
    const size_t row = row0 + fr; const bf16* zr = Zs + row * ZW; bf16* o = STR + row * STRW;
    const float* kkp = inptr(I_KK) + l * DR; const float* kap = inptr(I_KA) + l * DR; const float* dw0 = inptr(I_DW0) + l * 2 * DR; const float* ia0 = inptr(I_IA0) + l * 2 * DR;
    float zk[4][4], kv[4][4]; float ss = 0.f;
#pragma unroll
    for (int nt = 0; nt < 4; ++nt) { const int c0 = 64 * w + 16 * nt + 4 * fq; unpack4(*(const u32x2*)(zr + 512 + c0), zk[nt]); const f32x4 kw = *(const f32x4*)(kkp + c0);
#pragma unroll
        for (int i = 0; i < 4; ++i) { kv[nt][i] = zk[nt][i] * kw[i]; ss += kv[nt][i] * kv[nt][i]; } }
    ss += __shfl_xor(ss, 16); ss += __shfl_xor(ss, 32);
    const float inv = 1.f / fmaxf(sqrtf(ss), 1e-12f);
#pragma unroll
    for (int nt = 0; nt < 4; ++nt) { const int c0 = 64 * w + 16 * nt + 4 * fq;
        *(u32x2*)(o + c0) = *(const u32x2*)(zr + c0);
        *(u32x2*)(o + 512 + c0) = *(const u32x2*)(zr + 1024 + c0);
        float kk[4];
#pragma unroll
        for (int i = 0; i < 4; ++i) kk[i] = kv[nt][i] * inv;
        *(u32x2*)(o + 1024 + c0) = (u32x2){pk2(kk[0], kk[1]), pk2(kk[2], kk[3])};
        *(u32x2*)(o + 1536 + c0) = (u32x2){pk2(acc[4][nt][0], acc[4][nt][1]), pk2(acc[4][nt][2], acc[4][nt][3])};
        const f32x4 ka = *(const f32x4*)(kap + c0);
#pragma unroll
        for (int dn = 0; dn < 2; ++dn) { const f32x4 d0 = *(const f32x4*)(dw0 + dn * DR + c0), i0 = *(const f32x4*)(ia0 + dn * DR + c0); float ep[4], kd[4], bb[4];
#pragma unroll
            for (int i = 0; i < 4; ++i) { const float ew = sigmoidf_(d0[i] + acc[dn][nt][i]) * 0.6065306597126334f; ep[i] = -expm1f(-ew);
                const float a = sigmoidf_(i0[i] + acc[2 + dn][nt][i]); kd[i] = zk[nt][i] * (1.f + (a - 1.f) * ka[i]); bb[i] = kk[i] * a; }
            *(u32x2*)(o + 2048 + dn * 1536 + c0) = (u32x2){pk2(ep[0], ep[1]), pk2(ep[2], ep[3])};
            *(u32x2*)(o + 2048 + dn * 1536 + 512 + c0) = (u32x2){pk2(kd[0], kd[1]), pk2(kd[2], kd[3])};
            *(u32x2*)(o + 2048 + dn * 1536 + 1024 + c0) = (u32x2){pk2(bb[0], bb[1]), pk2(bb[2], bb[3])}; } }
}

__device__ __forceinline__ int scan_rowof(int s, int dir, int b) { if (s < CTXL) { const int tc = dir ? (CTXL - 1 - s) : s; return NLAT + b * CTXL + tc; } const int tt = s - CTXL; const int t = dir ? (SEQ - 1 - tt) : tt; return b * SEQ + t; }
__device__ __forceinline__ void scan_item(const Frame& F0, int item, bool need_ctx) {
    const Frame F = phase_frame(F0); unsigned char* const ws = F.ws;
    const int dir = item & 1, h = (item >> 1) & 7, b = item >> 4;
    const bf16* STR = (const bf16*)(ws + WS_STR); bf16* Y = (bf16*)(ws + WS_Y) + (size_t)dir * NROW * DR;
    const int lane = F.lane, kq = lane & 7, vrow = 8 * F.wave + (lane >> 3);
    float S[8];
#pragma unroll
    for (int j = 0; j < 8; ++j) S[j] = 0.f;
    const int co = h * 64 + kq * 8;
    constexpr int NSTEP = CTXL + SEQ;
#define rowof(s) scan_rowof((s), dir, b)
    for (int s0 = 0; s0 < NSTEP; s0 += 4) {
        u32x4 qkk[4], qe[4], qkd[4], qb[4], qr[4]; unsigned qv[4];
#pragma unroll
        for (int u = 0; u < 4; ++u) { const bf16* base = STR + (size_t)rowof(s0 + u) * STRW;
            qr[u] = *(const u32x4*)(base + co); qkk[u] = *(const u32x4*)(base + 1024 + co);
            qe[u] = *(const u32x4*)(base + 2048 + dir * 1536 + co); qkd[u] = *(const u32x4*)(base + 2048 + dir * 1536 + 512 + co); qb[u] = *(const u32x4*)(base + 2048 + dir * 1536 + 1024 + co);
            qv[u] = base[512 + h * 64 + vrow]; }
#pragma unroll
        for (int u = 0; u < 4; ++u) { float kk[8], e[8], kd[8], bb[8], r[8];
            unpack8(qkk[u], kk); unpack8(qe[u], e); unpack8(qkd[u], kd); unpack8(qb[u], bb); unpack8(qr[u], r);
            const float vv = bf2f(qv[u]);
            float sk = 0.f;
#pragma unroll
            for (int j = 0; j < 8; ++j) sk += S[j] * kk[j];
            sk += __shfl_xor(sk, 1); sk += __shfl_xor(sk, 2); sk += __shfl_xor(sk, 4);
            float y = 0.f;
#pragma unroll
            for (int j = 0; j < 8; ++j) { S[j] = S[j] * (1.f - e[j]) - sk * bb[j] + vv * kd[j]; y += S[j] * r[j]; }
            y += __shfl_xor(y, 1); y += __shfl_xor(y, 2); y += __shfl_xor(y, 4);
            const int s = s0 + u;
            if (kq == 0 && (s >= CTXL || need_ctx)) Y[(size_t)rowof(s) * DR + h * 64 + vrow] = (bf16)f2bf(y); }
    }
#undef rowof
}

__device__ __forceinline__ void readout_pass(const Frame& F0, int l, int nrows) {
    const Frame F = phase_frame(F0); unsigned char* const ws = F.ws;
    const bf16* STR = (const bf16*)(ws + WS_STR); const bf16* Y0 = (const bf16*)(ws + WS_Y); const bf16* Y1 = Y0 + (size_t)NROW * DR; bf16* MA = (bf16*)(ws + WS_H);
    const int lane = F.lane; const float* gnw = inptr(I_GNW) + l * DR; const float* gnb = inptr(I_GNB) + l * DR; const float* rkp = inptr(I_RK) + l * DR;
    for (int row = F.gw; row < nrows; row += F.NGW) { const bf16* sr = STR + (size_t)row * STRW;
#pragma unroll
        for (int h = 0; h < 8; ++h) { const int c = h * 64 + lane;
            const float y = bf2f(Y0[(size_t)row * DR + c]) + bf2f(Y1[(size_t)row * DR + c]);
            const float mu = wave_sum(y) * (1.f / 64.f); const float dv = y - mu; const float var = wave_sum(dv * dv) * (1.f / 64.f);
            const float yn = dv * rsqrtf(var + GN_EPS) * gnw[c] + gnb[c];
            const float r = bf2f(sr[c]), v = bf2f(sr[512 + c]), g = bf2f(sr[1536 + c]), k0 = bf2f(sr[2048 + 512 + c]), k1 = bf2f(sr[2048 + 1536 + 512 + c]);
            const float rk = rkp[c];
            const float bonus = wave_sum(r * (k0 + k1) * rk) * v;
            MA[(size_t)row * D + c] = (bf16)f2bf((yn + bonus) * g); }
    }
}
constexpr int BLOB = 16384, SEGCH = 264, NSEG = 2, BLOB_R1_SCANS = 23;
constexpr size_t WS_BLOB1 = 20 * MiB, WS_BLOB2 = 492 * MiB, WS_SCANST = WS_GT;
__device__ __forceinline__ unsigned char* blob_ptr(unsigned char* ws, int scan, int ci) {
    return scan < BLOB_R1_SCANS ? ws + WS_BLOB1 + ((size_t)scan * SEGCH + ci) * BLOB : ws + WS_BLOB2 + ((size_t)(scan - BLOB_R1_SCANS) * SEGCH + ci) * BLOB;
}
typedef short s16x4 __attribute__((ext_vector_type(4)));
__device__ __forceinline__ bf16x8 frag_lo(u32x2 x) { u32x4 t = {x.x, x.y, 0u, 0u}; return __builtin_bit_cast(bf16x8, t); }
__device__ __forceinline__ bf16x8 frag_c(const f32x4& a) { u32x4 t = {pk2(a[0], a[1]), pk2(a[2], a[3]), 0u, 0u}; return __builtin_bit_cast(bf16x8, t); }

__device__ __forceinline__ void pre_item(const Frame& F, unsigned char* ws, int scan, int cs, unsigned char* blob) {
    const int dir = scan & 1, h = (scan >> 1) & 7, b = scan >> 4; const int lane = F.lane, fr = lane & 15, fq = lane >> 4;
    LAS unsigned char* L = F.lds + F.wave * 17408;
    LAS bf16* TK = (LAS bf16*)L; LAS bf16* TR = TK + 1024; LAS bf16* TKt = TR + 1024; LAS bf16* TB = TKt + 1024;
    LAS bf16* KTt = TB + 1024; LAS bf16* RTt = KTt + 1024; LAS bf16* Vt = RTt + 1024;
    LAS float* AKB = (LAS float*)(Vt + 1024);
    LAS bf16* AKK = (LAS bf16*)(AKB + 256); LAS bf16* ARK = AKK + 256; LAS bf16* ARB = ARK + 256; LAS bf16* TT = ARB + 256;
    const bf16* STR = (const bf16*)(ws + WS_STR);
    float kh[16], bh[16];
    float pc;
    {   float r_[16], v_[16], kk_[16], lp_[16], kd_[16], bb_[16];
#pragma unroll
        for (int t = 0; t < 16; ++t) { const bf16* base = STR + (size_t)scan_rowof(16 * cs + t, dir, b) * STRW + h * 64 + lane;
            r_[t] = bf2f(base[0]); v_[t] = bf2f(base[512]); kk_[t] = bf2f(base[1024]);
            lp_[t] = bf2f(base[2048 + dir * 1536]); kd_[t] = bf2f(base[2048 + dir * 1536 + 512]); bb_[t] = bf2f(base[2048 + dir * 1536 + 1024]); }
        float lp = 0.f; u32x4 kt4[2], rt4[2], v4[2];
        unsigned ktp[8], rtp[8], vp[8];
#pragma unroll
        for (int t = 0; t < 16; ++t) { const float pm1 = __expf(lp); lp += __logf(1.f - lp_[t]); lp_[t] = lp; const float p = __expf(lp), ip = __expf(-lp);
            const float kt = kk_[t] * pm1, ktl = kd_[t] * ip, btl = bb_[t] * ip, rt = r_[t] * p;
            TK[t * 64 + lane] = (bf16)f2bf(kt); TR[t * 64 + lane] = (bf16)f2bf(rt); TKt[t * 64 + lane] = (bf16)f2bf(ktl); TB[t * 64 + lane] = (bf16)f2bf(btl);
            if (t & 1) { ktp[t >> 1] |= f2bf(kt) << 16; rtp[t >> 1] |= f2bf(rt) << 16; vp[t >> 1] |= f2bf(v_[t]) << 16; }
            else { ktp[t >> 1] = f2bf(kt); rtp[t >> 1] = f2bf(rt); vp[t >> 1] = f2bf(v_[t]); } }
        kt4[0] = (u32x4){ktp[0], ktp[1], ktp[2], ktp[3]}; kt4[1] = (u32x4){ktp[4], ktp[5], ktp[6], ktp[7]};
        rt4[0] = (u32x4){rtp[0], rtp[1], rtp[2], rtp[3]}; rt4[1] = (u32x4){rtp[4], rtp[5], rtp[6], rtp[7]};
        v4[0] = (u32x4){vp[0], vp[1], vp[2], vp[3]}; v4[1] = (u32x4){vp[4], vp[5], vp[6], vp[7]};
        *(LAS u32x4*)(KTt + lane * 16) = kt4[0]; *(LAS u32x4*)(KTt + lane * 16 + 8) = kt4[1];
        *(LAS u32x4*)(RTt + lane * 16) = rt4[0]; *(LAS u32x4*)(RTt + lane * 16 + 8) = rt4[1];
        *(LAS u32x4*)(Vt + lane * 16) = v4[0]; *(LAS u32x4*)(Vt + lane * 16 + 8) = v4[1];
        pc = __expf(lp);
#pragma unroll
        for (int t = 0; t < 16; ++t) { const float e = __expf(lp - lp_[t]); kh[t] = kd_[t] * e; bh[t] = bb_[t] * e; }
    }
    LDS_WAIT(); asm volatile("" ::: "memory");
    {   f32x4 akb = {0.f, 0.f, 0.f, 0.f}, akk = akb, ark = akb, arb = akb;
#pragma unroll
        for (int s = 0; s < 2; ++s) { const int o = fr * 64 + 32 * s + 8 * fq;
            const bf16x8 fk = *(const LAS bf16x8*)(TK + o), frr = *(const LAS bf16x8*)(TR + o), fkt = *(const LAS bf16x8*)(TKt + o), fb = *(const LAS bf16x8*)(TB + o);
            akb = MFMA16(fk, fb, akb); akk = MFMA16(fk, fkt, akk); ark = MFMA16(frr, fkt, ark); arb = MFMA16(frr, fb, arb); }
#pragma unroll
        for (int reg = 0; reg < 4; ++reg) { const int t = 4 * fq + reg; const bool lo = fr < t, le = fr <= t;
            AKB[t * 16 + fr] = lo ? akb[reg] : 0.f; AKK[t * 16 + fr] = (bf16)f2bf(lo ? akk[reg] : 0.f);
            ARK[t * 16 + fr] = (bf16)f2bf(le ? ark[reg] : 0.f); ARB[t * 16 + fr] = (bf16)f2bf(le ? arb[reg] : 0.f); }
    }
    LDS_WAIT(); asm volatile("" ::: "memory");
    {   float col[16];
#pragma unroll
        for (int t = 0; t < 16; ++t) { float s_ = (t == fr) ? 1.f : 0.f;
            if (t > 0) { const f32x4 n0 = *(const LAS f32x4*)(AKB + t * 16), n1 = *(const LAS f32x4*)(AKB + t * 16 + 4), n2 = *(const LAS f32x4*)(AKB + t * 16 + 8), n3 = *(const LAS f32x4*)(AKB + t * 16 + 12);
                const float nn[16] = {n0[0], n0[1], n0[2], n0[3], n1[0], n1[1], n1[2], n1[3], n2[0], n2[1], n2[2], n2[3], n3[0], n3[1], n3[2], n3[3]};
#pragma unroll
                for (int i = 0; i < 16; ++i) if (i < t) s_ -= nn[i] * col[i]; }
            col[t] = s_; TT[t * 16 + fr] = (bf16)f2bf(s_); }
    }
    LDS_WAIT(); asm volatile("" ::: "memory");
    f32x4 Wc[4], Rqc[4], U0c[4], Y0c[4];
    {   const bf16x8 aT = frag_lo(*(const LAS u32x2*)(TT + fr * 16 + 4 * fq)), aKK = frag_lo(*(const LAS u32x2*)(AKK + fr * 16 + 4 * fq)), aRK = frag_lo(*(const LAS u32x2*)(ARK + fr * 16 + 4 * fq));
        u32x2 nb = *(const LAS u32x2*)(ARB + fr * 16 + 4 * fq); nb.x ^= 0x80008000u; nb.y ^= 0x80008000u; const bf16x8 aRBn = frag_lo(nb);
        const f32x4 z4 = {0.f, 0.f, 0.f, 0.f};
#pragma unroll
        for (int nt = 0; nt < 4; ++nt) { const int o = (16 * nt + fr) * 16 + 4 * fq;
            const bf16x8 bK = frag_lo(*(const LAS u32x2*)(KTt + o)), bV = frag_lo(*(const LAS u32x2*)(Vt + o));
            float ri[4]; unpack4(*(const LAS u32x2*)(RTt + o), ri);
            Wc[nt] = MFMA16(aT, bK, z4); const f32x4 Zn = MFMA16(aKK, bV, z4);
            U0c[nt] = MFMA16(aT, frag_c(Zn), z4);
            Rqc[nt] = MFMA16(aRBn, frag_c(Wc[nt]), ((f32x4){ri[0], ri[1], ri[2], ri[3]}));
            Y0c[nt] = MFMA16(aRK, bV, z4); Y0c[nt] = MFMA16(aRBn, frag_c(U0c[nt]), Y0c[nt]); }
    }
    LDS_WAIT(); asm volatile("" ::: "memory");
#pragma unroll
    for (int nt = 0; nt < 4; ++nt) { const u32x2 vv = *(const LAS u32x2*)(Vt + (16 * nt + fr) * 16 + 4 * fq);
        *(u32x2*)(blob + 8192 + nt * 2048 + 1024 + lane * 8) = vv;
        u32x2 u0 = {pk2(U0c[nt][0], U0c[nt][1]), pk2(U0c[nt][2], U0c[nt][3])}, y0 = {pk2(Y0c[nt][0], Y0c[nt][1]), pk2(Y0c[nt][2], Y0c[nt][3])};
        *(u32x2*)(blob + 8192 + nt * 2048 + lane * 8) = u0; *(u32x2*)(blob + 8192 + nt * 2048 + 512 + lane * 8) = y0;
        *(float*)(blob + 8192 + nt * 2048 + 1536 + lane * 4) = pc; }
    LAS bf16* WT = TK; LAS bf16* RQT = TR; LAS bf16* BHt = TKt; LAS bf16* KHt = TB;
#pragma unroll
    for (int nt = 0; nt < 4; ++nt)
#pragma unroll
        for (int reg = 0; reg < 4; ++reg) { WT[(4 * fq + reg) * 64 + 16 * nt + fr] = (bf16)f2bf(Wc[nt][reg]); RQT[(4 * fq + reg) * 64 + 16 * nt + fr] = (bf16)f2bf(Rqc[nt][reg]); }
    {   u32x4 a, c, d, e;
        a = (u32x4){pk2(bh[0], bh[1]), pk2(bh[2], bh[3]), pk2(bh[4], bh[5]), pk2(bh[6], bh[7])}; c = (u32x4){pk2(bh[8], bh[9]), pk2(bh[10], bh[11]), pk2(bh[12], bh[13]), pk2(bh[14], bh[15])};
        d = (u32x4){pk2(kh[0], kh[1]), pk2(kh[2], kh[3]), pk2(kh[4], kh[5]), pk2(kh[6], kh[7])}; e = (u32x4){pk2(kh[8], kh[9]), pk2(kh[10], kh[11]), pk2(kh[12], kh[13]), pk2(kh[14], kh[15])};
        *(LAS u32x4*)(BHt + lane * 16) = a; *(LAS u32x4*)(BHt + lane * 16 + 8) = c; *(LAS u32x4*)(KHt + lane * 16) = d; *(LAS u32x4*)(KHt + lane * 16 + 8) = e; }
    LDS_WAIT(); asm volatile("" ::: "memory");
#pragma unroll
    for (int s = 0; s < 2; ++s) { const int o = fr * 64 + 32 * s + 4 * fq;
        const u32x2 w0 = *(const LAS u32x2*)(WT + o), w1 = *(const LAS u32x2*)(WT + o + 16), q0 = *(const LAS u32x2*)(RQT + o), q1 = *(const LAS u32x2*)(RQT + o + 16);
        *(u32x4*)(blob + (0 * 2 + s) * 1024 + lane * 16) = (u32x4){w0.x, w0.y, w1.x, w1.y};
        *(u32x4*)(blob + (1 * 2 + s) * 1024 + lane * 16) = (u32x4){q0.x, q0.y, q1.x, q1.y}; }
#pragma unroll
    for (int mt = 0; mt < 4; ++mt) { const int o = (16 * mt + fr) * 16 + 4 * fq; const u32x2 bb = *(const LAS u32x2*)(BHt + o), kk = *(const LAS u32x2*)(KHt + o);
        *(u32x4*)(blob + 4096 + mt * 1024 + lane * 16) = (u32x4){bb.x ^ 0x80008000u, bb.y ^ 0x80008000u, kk.x, kk.y}; }
    LDS_WAIT(); asm volatile("" ::: "memory");
}

__device__ __forceinline__ void pre_phase(const Frame& F0, int seg) {
    const Frame F = phase_frame(F0); unsigned char* const ws = F.ws;
    for (int it = F.gw; it < 32 * SEGCH; it += F.NGW) { const int scan = it & 31, ci = it >> 5; pre_item(F, ws, scan, seg * SEGCH + ci, blob_ptr(ws, scan, ci)); }
}

constexpr int SQ_SLOT = 10240, SQ_R = 12, SQ_D = 8;
template <int MODE>
__device__ __forceinline__ void seq_item(const Frame& F0, int item, int seg, bool need_ctx) {
    const Frame F = phase_frame(F0); unsigned char* const ws = F.ws;
    const int scan = item >> 2, vb = item & 3, dir = scan & 1, h = (scan >> 1) & 7, b = scan >> 4; const int lane = F.lane, fr = lane & 15, fq = lane >> 4, w = F.wave;
    const unsigned char* blob = blob_ptr(ws, scan, 0);
    LAS unsigned char* ring = F.lds;
    __syncthreads();
    const int p0 = 2 * (w - 1);
    const unsigned goff0 = (p0 < 8 ? p0 * 1024 : 8192 + vb * 2048 + (p0 - 8) * 1024) + lane * 16, goff1 = (p0 + 1 < 8 ? (p0 + 1) * 1024 : 8192 + vb * 2048 + (p0 + 1 - 8) * 1024) + lane * 16;
#define SQ_ISSUE(c) do { const unsigned char* g_ = blob + (size_t)(c) * BLOB; LAS unsigned char* s_ = ring + ((c) % SQ_R) * SQ_SLOT + p0 * 1024; \
        __builtin_amdgcn_global_load_lds((const unsigned*)(g_ + goff0), (LAS unsigned*)(s_), 16, 0, 0); \
        __builtin_amdgcn_global_load_lds((const unsigned*)(g_ + goff1), (LAS unsigned*)(s_ + 1024), 16, 0, 0); } while (0)
    const bool loader = (w >= 1 && w <= 5) && MODE != 2;
    if (loader) { for (int c = 0; c < SQ_D; ++c) SQ_ISSUE(c); }
    bf16* Y = (bf16*)(ws + WS_Y) + (size_t)dir * NROW * DR + h * 64 + 16 * vb + fr;
    float* st = (float*)(ws + WS_SCANST) + (size_t)item * 1024 + lane * 4;
    f32x4 M[4];
#pragma unroll
    for (int mt = 0; mt < 4; ++mt) M[mt] = (seg == 0 || w != 0) ? (f32x4){0.f, 0.f, 0.f, 0.f} : *(const f32x4*)(st + mt * 256);
    const f32x4 z4 = {0.f, 0.f, 0.f, 0.f};
    struct SQ { bf16x8 a1[4], a2[4]; f32x4 pc[4]; u32x2 u0, y0, vv; };
#define SQ_READ(R, c) do { const LAS unsigned char* sl_ = ring + ((c) % SQ_R) * SQ_SLOT; _Pragma("unroll") for (int i = 0; i < 4; ++i) { \
        R.a1[i] = *(const LAS bf16x8*)(sl_ + i * 1024 + lane * 16); R.a2[i] = *(const LAS bf16x8*)(sl_ + 4096 + i * 1024 + lane * 16); \
        R.pc[i] = *(const LAS f32x4*)(sl_ + 8192 + 1536 + (16 * i + 4 * fq) * 4); } \
        R.u0 = *(const LAS u32x2*)(sl_ + 8192 + lane * 8); R.y0 = *(const LAS u32x2*)(sl_ + 8192 + 512 + lane * 8); R.vv = *(const LAS u32x2*)(sl_ + 8192 + 1024 + lane * 8); } while (0)
    const long ystep = dir ? -(long)DR : (long)DR;
#define SQ_STEP(R, c) do { const int cs_ = seg * SEGCH + (c); \
        const u32x4 t0 = {pk2(M[0][0], M[0][1]), pk2(M[0][2], M[0][3]), pk2(M[1][0], M[1][1]), pk2(M[1][2], M[1][3])}; \
        const u32x4 t1 = {pk2(M[2][0], M[2][1]), pk2(M[2][2], M[2][3]), pk2(M[3][0], M[3][1]), pk2(M[3][2], M[3][3])}; \
        const bf16x8 b0 = __builtin_bit_cast(bf16x8, t0), b1 = __builtin_bit_cast(bf16x8, t1); \
        f32x4 X0 = MFMA16(R.a1[0], b0, z4); X0 = MFMA16(R.a1[1], b1, X0); \
        f32x4 X1 = MFMA16(R.a1[2], b0, z4); X1 = MFMA16(R.a1[3], b1, X1); \
        float u0[4], y0[4]; unpack4(R.u0, u0); unpack4(R.y0, y0); \
        if (MODE == 0 && (need_ctx || cs_ >= 16)) { bf16* yp = Y + (size_t)scan_rowof(16 * cs_ + 4 * fq, dir, b) * DR; \
            yp[0] = (bf16)f2bf(X1[0] + y0[0]); yp[ystep] = (bf16)f2bf(X1[1] + y0[1]); yp[2 * ystep] = (bf16)f2bf(X1[2] + y0[2]); yp[3 * ystep] = (bf16)f2bf(X1[3] + y0[3]); } \
        const u32x4 tb = {pk2(X0[0] + u0[0], X0[1] + u0[1]), pk2(X0[2] + u0[2], X0[3] + u0[3]), R.vv.x, R.vv.y}; const bf16x8 bB = __builtin_bit_cast(bf16x8, tb); \
        _Pragma("unroll") for (int mt = 0; mt < 4; ++mt) M[mt] = MFMA16(R.a2[mt], bB, R.pc[mt] * M[mt]); } while (0)
#define SQ_LOADER(c) do { if (loader) { if ((c) + SQ_D < SEGCH) { SQ_ISSUE((c) + SQ_D); asm volatile("s_waitcnt vmcnt(14)" ::: "memory"); } else asm volatile("s_waitcnt vmcnt(0)" ::: "memory"); } \
        __builtin_amdgcn_s_barrier(); asm volatile("" ::: "memory"); } while (0)
    SQ Ra, Rb;
    SQ_LOADER(0);
    if (w == 0 && MODE != 1) SQ_READ(Ra, 0);
    for (int c = 0; c < SEGCH; c += 2) {
        SQ_LOADER(c + 1);
        if (w == 0 && MODE != 1) { SQ_STEP(Ra, c); SQ_READ(Rb, c + 1); }
        if (c + 2 < SEGCH) SQ_LOADER(c + 2);
        if (w == 0 && MODE != 1) { SQ_STEP(Rb, c + 1); if (c + 2 < SEGCH) SQ_READ(Ra, c + 2); }
    }
#undef SQ_READ
#undef SQ_STEP
#undef SQ_LOADER
#undef SQ_ISSUE
    if (MODE == 2 && w == 0 && M[0][0] + M[1][1] + M[2][2] + M[3][3] == 12345.678f) st[0] = M[0][0];
    if (MODE == 0 && w == 0 && seg + 1 < NSEG) {
#pragma unroll
        for (int mt = 0; mt < 4; ++mt) *(f32x4*)(st + mt * 256) = M[mt]; }
    __syncthreads();
}

__device__ __forceinline__ void warm_pass(const Frame& F0, int seg) {
    const Frame F = phase_frame(F0); unsigned char* const ws = F.ws;
    const int hb = blockIdx.x - 128;
    if (hb < 0) return;
    const int x = hb & 7, j = hb >> 3;
    const int nw = 16 * NWAVES, me = j * NWAVES + F.wave; unsigned acc = 0u;
    for (int it = me; it < SEGCH * 64; it += 4 * nw) {
        u32x4 v[4];
#pragma unroll
        for (int u = 0; u < 4; ++u) { const int i2 = it + u * nw; const int ci = i2 >> 6, q = (i2 >> 4) & 3, p = i2 & 15;
            v[u] = (i2 < SEGCH * 64) ? *(const u32x4*)(blob_ptr(ws, x + 8 * q, ci) + p * 1024 + F.lane * 16) : (u32x4){0u, 0u, 0u, 0u}; }
#pragma unroll
        for (int u = 0; u < 4; ++u) acc ^= v[u].x ^ v[u].y ^ v[u].z ^ v[u].w;
    }
    asm volatile("" :: "v"(acc));
}
namespace pg8 {
struct EpiStoreBf16 {
    static constexpr bool PERM = true, AFTER_DRAIN = false;
    bf16_t* O; int ldc; int pn_mask;
    __device__ __forceinline__ void operator()(const f32x4 (&acc)[2][2][4][2], const Unit& u, int wr, int wc, int fr, int fq) const {
        const int row0 = u.pm * BM + wr * 64 + fr; const int col0 = (u.pn & pn_mask) * BM + wc * 32 + 8 * fq;
#pragma unroll
        for (int ai = 0; ai < 2; ++ai)
#pragma unroll
            for (int m = 0; m < 4; ++m) { bf16_t* rowp = O + (size_t)(row0 + ai * HALF + m * 16) * ldc + col0;
#pragma unroll
                for (int bj = 0; bj < 2; ++bj) { const f32x4 v0 = acc[ai][bj][m][0], v1 = acc[ai][bj][m][1];
                    u32x4 w; w.x = cvt_pk_bf16(v0[0], v0[1]); w.y = cvt_pk_bf16(v0[2], v0[3]); w.z = cvt_pk_bf16(v1[0], v1[1]); w.w = cvt_pk_bf16(v1[2], v1[3]);
                    *(u32x4*)(rowp + bj * HALF) = w; } }
    }
};
struct EpiSwiGLU {
    static constexpr bool PERM = true, AFTER_DRAIN = false;
    bf16_t* O;
    __device__ __forceinline__ void operator()(const f32x4 (&acc)[2][2][4][2], const Unit& u, int wr, int wc, int fr, int fq) const {
        const int row0 = u.pm * BM + wr * 64 + fr; const int col0 = ((u.pn & 3) * BM + wc * 32 + 8 * fq) >> 1;
#pragma unroll
        for (int ai = 0; ai < 2; ++ai)
#pragma unroll
            for (int m = 0; m < 4; ++m) { bf16_t* rowp = O + (size_t)(row0 + ai * HALF + m * 16) * 512 + col0;
#pragma unroll
                for (int bj = 0; bj < 2; ++bj) { const f32x4 g = acc[ai][bj][m][0], up = acc[ai][bj][m][1]; float a[4];
#pragma unroll
                    for (int i = 0; i < 4; ++i) a[i] = g[i] / (1.f + __expf(-g[i])) * up[i];
                    unsigned long long w = (unsigned long long)cvt_pk_bf16(a[0], a[1]) | ((unsigned long long)cvt_pk_bf16(a[2], a[3]) << 32);
                    *(unsigned long long*)(rowp + bj * (HALF / 2)) = w; } }
    }
};
struct EpiResidual {
    static constexpr bool PERM = false, AFTER_DRAIN = false;
    const float* xlat; const float* xctx;
    float* out; const float* g1;
    __device__ __forceinline__ void operator()(const f32x4 (&acc)[2][2][4][2], const Unit& u, int wr, int wc, int fr, int fq) const {
        const int rowt = u.pm * BM; const int mr = rowt < 16384 ? (rowt >> 13) : 2;
        const float* base = rowt < 16384 ? xlat + (size_t)rowt * 1024 : xctx + (size_t)(rowt - 16384) * 1024;
        const int col0 = u.pn * BM + wc * 32 + 4 * fq;
        f32x4 gv[2][2];
#pragma unroll
        for (int bj = 0; bj < 2; ++bj)
#pragma unroll
            for (int n = 0; n < 2; ++n) gv[bj][n] = *(const f32x4*)(g1 + (size_t)mr * 6144 + col0 + bj * HALF + n * 16);
#pragma unroll
        for (int ai = 0; ai < 2; ++ai)
#pragma unroll
            for (int m = 0; m < 4; ++m) { const int rl = ai * HALF + wr * 64 + m * 16 + fr;
#pragma unroll
                for (int bj = 0; bj < 2; ++bj)
#pragma unroll
                    for (int n = 0; n < 2; ++n) { const size_t off = (size_t)rl * 1024 + col0 + bj * HALF + n * 16;
                        const f32x4 xo = *(const f32x4*)(base + off);
                        *(f32x4*)(out + (size_t)rowt * 1024 + off) = xo + gv[bj][n] * acc[ai][bj][m][n]; } }
    }
};
struct MoeOrder {
    const int* tile_e; int ntiles, G, c;
    __device__ bool next(int i, Unit& u) const { const long L = (long)i * G + c; if (L >= 4L * ntiles) return false; const int pm = (int)(L >> 2); u.pm = pm; u.pn = tile_e[pm] * 4 + (int)(L & 3); return true; }
    __device__ __forceinline__ void a_ready(const Unit&) const {}
    __device__ __forceinline__ void done(const Unit&) const {}
};
}

__device__ __forceinline__ void expert_convert(const Frame& F0, int l) {
    const Frame F = phase_frame(F0); unsigned char* const ws = F.ws;
    LAS float* scr = (LAS float*)(F.lds + F.wave * 16384);
    bf16* wgu = (bf16*)(ws + WS_WGU_T); bf16* wd = (bf16*)(ws + WS_WD_T);
    constexpr int I_G = 16 * 16, I_D = 8 * 32;
    constexpr int NIT = NEXP * (2 * I_G + I_D);
    const float* p_eg = inptr(I_EG); const float* p_eu = inptr(I_EU); const float* p_ed = inptr(I_ED);
    for (int it = F.gw; it < NIT; it += F.NGW) { const int e = it / (2 * I_G + I_D); int r = it % (2 * I_G + I_D);
        if (r < I_G) { transpose_item(p_eg + ((size_t)l * NEXP + e) * D * DEXP, DEXP, (r >> 4) * 64, (r & 15) * 32, wgu, D, RmGU{e * 1024}, scr, F.lane); continue; } r -= I_G;
        if (r < I_G) { transpose_item(p_eu + ((size_t)l * NEXP + e) * D * DEXP, DEXP, (r >> 4) * 64, (r & 15) * 32, wgu, D, RmGU{e * 1024 + 4}, scr, F.lane); continue; } r -= I_G;
        transpose_item(p_ed + ((size_t)l * NEXP + e) * DEXP * D, D, (r >> 5) * 64, (r & 31) * 32, wd, DEXP, RmId{e * 1024}, scr, F.lane);
    }
}

__device__ __forceinline__ void router_pass(const Frame& F0, int l, int nrows) {
    const Frame F = phase_frame(F0); unsigned char* const ws = F.ws;
    LAS float* msh = (LAS float*)F.lds; LAS float* msc = msh + 3072; LAS float* hrow = msc + 3072;
    LAS float* lgs = hrow + 8 * 1024;
    __syncthreads();
    mod_to_lds(F, l, 3, msh, false); mod_to_lds(F, l, 4, msc, false); __syncthreads();
    const float* X = (const float*)(ws + WS_X); bf16* H = (bf16*)(ws + WS_H);
    const float* rgw = inptr(I_RGW) + (size_t)l * D * 4; const float* rew = inptr(I_REW) + (size_t)l * D * NEXP;
    const float* rgb = inptr(I_RGB) + l * 4; const float* reb = inptr(I_REB) + l * NEXP;
    int* rt_e = (int*)(ws + WS_ROUTE + RT_E); int* rt_pos = (int*)(ws + WS_ROUTE + RT_POS); float* rt_gate = (float*)(ws + WS_ROUTE + RT_GATE);
    unsigned* cnt = (unsigned*)(ws + WS_CTL) + CW_CNT + 64 * l;
    const int lane = F.lane, w = F.wave; const float* n2g = inptr(I_N2G) + l * D;
    float wr[5][16];
#pragma unroll
    for (int j = 0; j < 4; ++j)
#pragma unroll
        for (int i = 0; i < 4; ++i) { const int k = 4 * lane + 256 * j + i;
#pragma unroll
            for (int q = 0; q < 4; ++q) wr[q][4 * j + i] = rew[(size_t)k * 32 + w + 8 * q];
            wr[4][4 * j + i] = w < 4 ? rgw[(size_t)k * 4 + w] : 0.f; }
    const int ngroups = nrows >> 3;
    for (int gi = F.vcu; gi < ngroups; gi += F.G) { const int row = gi * 8 + w;
        {   f32x4 v[4];
#pragma unroll
            for (int j = 0; j < 4; ++j) v[j] = *(const f32x4*)(X + (size_t)row * D + 4 * lane + 256 * j);
            const int mr = modrow(row);
            norm_mod_row(v, n2g, msc + mr * 1024, msh + mr * 1024, H + (size_t)row * D, lane);
#pragma unroll
            for (int j = 0; j < 4; ++j) *(LAS f32x4*)(hrow + w * 1024 + 4 * lane + 256 * j) = v[j]; }
        __syncthreads();
#pragma unroll 2
        for (int r = 0; r < 8; ++r) { float a[5] = {0.f, 0.f, 0.f, 0.f, 0.f};
#pragma unroll
            for (int j = 0; j < 4; ++j) { const f32x4 hv = *(const LAS f32x4*)(hrow + r * 1024 + 4 * lane + 256 * j);
#pragma unroll
                for (int q = 0; q < 5; ++q) a[q] += hv.x * wr[q][4 * j] + hv.y * wr[q][4 * j + 1] + hv.z * wr[q][4 * j + 2] + hv.w * wr[q][4 * j + 3]; }
#pragma unroll
            for (int q = 0; q < 5; ++q) a[q] = wave_sum(a[q]);
            if (lane == 0) {
#pragma unroll
                for (int q = 0; q < 4; ++q) lgs[r * 40 + 4 + w + 8 * q] = a[q] + reb[w + 8 * q];
                if (w < 4) lgs[r * 40 + w] = a[4] + rgb[w]; } }
        __syncthreads();
        if (F.tid < 8) { const int rr = gi * 8 + F.tid; const LAS float* lp = lgs + F.tid * 40;
            int grp = 0; float mx = lp[0];
#pragma unroll
            for (int g = 1; g < 4; ++g) if (lp[g] > mx) { mx = lp[g]; grp = g; }
            float den = 0.f;
#pragma unroll
            for (int g = 0; g < 4; ++g) den += __expf(lp[g] - mx);
            const float pg_top = 1.f / den; const LAS float* sel = lp + 4 + grp * 8;
            int i0 = 0; float l0 = sel[0];
#pragma unroll
            for (int q = 1; q < 8; ++q) if (sel[q] > l0) { l0 = sel[q]; i0 = q; }
            int i1 = -1; float l1 = -3.0e38f;
#pragma unroll
            for (int q = 0; q < 8; ++q) if (q != i0 && sel[q] > l1) { l1 = sel[q]; i1 = q; }
            const float e1 = __expf(l1 - l0); const float w0 = pg_top / (1.f + e1), w1 = pg_top * e1 / (1.f + e1);
            const int ea = grp * 8 + i0, eb = grp * 8 + i1;
            const unsigned pa = atomicAdd(cnt + ea, 1u), pb = atomicAdd(cnt + eb, 1u);
            rt_e[2 * rr] = ea; rt_e[2 * rr + 1] = eb; rt_pos[2 * rr] = (int)pa; rt_pos[2 * rr + 1] = (int)pb; rt_gate[2 * rr] = w0; rt_gate[2 * rr + 1] = w1; }
    }
}

__device__ __forceinline__ void gather_pass(const Frame& F0, int l, int nrows) {
    const Frame F = phase_frame(F0); unsigned char* const ws = F.ws;
    LAS int* off = (LAS int*)F.lds;
    const unsigned* cnt = (const unsigned*)(ws + WS_CTL) + CW_CNT + 64 * l;
    int* tile_e = (int*)(ws + WS_ROUTE + RT_TILE); int* ntl = (int*)(ws + WS_ROUTE + RT_NT);
    __syncthreads();
    if (F.tid == 0) { int o = 0;
#pragma nounroll
        for (int e = 0; e < NEXP; ++e) { const int c = (int)__hip_atomic_load(cnt + e, __ATOMIC_RELAXED, __HIP_MEMORY_SCOPE_AGENT); const int nt = (c + 255) >> 8; off[e] = o;
            if (blockIdx.x == 0) {
#pragma nounroll
                for (int t = 0; t < nt; ++t) tile_e[(o >> 8) + t] = e; }
            o += nt << 8; }
        if (blockIdx.x == 0) ntl[0] = o >> 8; }
    __syncthreads();
    const int* rt_e = (const int*)(ws + WS_ROUTE + RT_E); const int* rt_pos = (const int*)(ws + WS_ROUTE + RT_POS); int* rt_slot = (int*)(ws + WS_ROUTE + RT_SLOT);
    const bf16* H = (const bf16*)(ws + WS_H); bf16* Xs = (bf16*)(ws + WS_XS);
    for (int it = F.gw; it < 2 * nrows; it += F.NGW) { const int row = it >> 1; const int slot = off[rt_e[it]] + rt_pos[it];
        if (F.lane == 0) rt_slot[it] = slot;
        const u32x4* s = (const u32x4*)(H + (size_t)row * D); u32x4* d = (u32x4*)(Xs + (size_t)slot * D);
        d[F.lane] = s[F.lane]; d[64 + F.lane] = s[64 + F.lane]; }
}

__device__ __forceinline__ void combine_pass(const Frame& F0, int l, int nrows) {
    const Frame F = phase_frame(F0); unsigned char* const ws = F.ws;
    LAS float* mg2 = (LAS float*)F.lds; LAS float* msh = mg2 + 3072; LAS float* msc = msh + 3072;
    const bool last = (l == DEPTH - 1);
    __syncthreads();
    mod_to_lds(F, l, 5, mg2, false); if (!last) { mod_to_lds(F, l + 1, 0, msh, false); mod_to_lds(F, l + 1, 1, msc, false); }
    __syncthreads();
    float* X = (float*)(ws + WS_X); bf16* H = (bf16*)(ws + WS_H); const bf16* Ys = (const bf16*)(ws + WS_XS);
    const int* rt_slot = (const int*)(ws + WS_ROUTE + RT_SLOT); const float* rt_gate = (const float*)(ws + WS_ROUTE + RT_GATE);
    const int lane = F.lane; const float* n1g = inptr(I_N1G) + (last ? 0 : (l + 1) * D); const float* fgp = inptr(I_FG);
    for (int row = F.gw; row < nrows; row += F.NGW) { const int s0 = rt_slot[2 * row], s1 = rt_slot[2 * row + 1]; const float w0 = rt_gate[2 * row], w1 = rt_gate[2 * row + 1];
        const int mr = modrow(row); f32x4 v[4];
#pragma unroll
        for (int j = 0; j < 4; ++j) { const int c = 4 * lane + 256 * j; float a[4], b[4];
            unpack4(*(const u32x2*)(Ys + (size_t)s0 * D + c), a); unpack4(*(const u32x2*)(Ys + (size_t)s1 * D + c), b);
            const f32x4 g2 = *(const LAS f32x4*)(mg2 + mr * 1024 + c); const f32x4 xo = *(const f32x4*)(X + (size_t)row * D + c);
            f32x4 y; y.x = w0 * a[0] + w1 * b[0]; y.y = w0 * a[1] + w1 * b[1]; y.z = w0 * a[2] + w1 * b[2]; y.w = w0 * a[3] + w1 * b[3];
            v[j] = xo + g2 * y; }
        if (!last) {
#pragma unroll
            for (int j = 0; j < 4; ++j) *(f32x4*)(X + (size_t)row * D + 4 * lane + 256 * j) = v[j];
            norm_mod_row(v, n1g, msc + mr * 1024, msh + mr * 1024, H + (size_t)row * D, lane);
        } else { float s = 0.f;
#pragma unroll
            for (int j = 0; j < 4; ++j) s += (v[j].x * v[j].x + v[j].y * v[j].y) + (v[j].z * v[j].z + v[j].w * v[j].w);
            const float rs = rsqrtf(wave_sum(s) * (1.f / D) + RMS_EPS);
#pragma unroll
            for (int j = 0; j < 4; ++j) { const int c = 4 * lane + 256 * j; const f32x4 g = *(const f32x4*)(fgp + c); *(f32x4*)(F.out + (size_t)row * D + c) = v[j] * rs * g; } }
    }
}
__global__ void __launch_bounds__(NTHR, 2) fwd_megakernel(Params prm) {
    extern __shared__ __attribute__((aligned(16))) unsigned char lds_raw[];
    Frame F;
    F.lds = (LAS unsigned char*)lds_raw;
    F.tid = threadIdx.x; F.lane = F.tid & 63; F.wave = __builtin_amdgcn_readfirstlane(F.tid >> 6);
    F.G = gridDim.x; { const int bx = blockIdx.x; F.vcu = (F.G % 8 == 0) ? (bx % 8) * (F.G / 8) + bx / 8 : bx; }
    F.gw = F.vcu * NWAVES + F.wave; F.NGW = F.G * NWAVES;
    F.out = prm.out; F.ws = prm.ws;
    for (int u = F.tid; u < (LDS_BYTES - LDSCTL_OFF) / 4; u += NTHR) ((LAS unsigned*)(F.lds + LDSCTL_OFF))[u] = 0u;
    __syncthreads();
    (void)xcd_barrier_post((unsigned*)(F.ws + WS_CTL) + CW_BAR, (volatile LAS unsigned*)(F.lds + MISC_OFF) + 8);
#define GRID_BAR() do { XcdBarrier bar_; bar_.bar = (unsigned*)(opaque(F.ws) + WS_CTL) + CW_BAR; bar_.x = xb_xcc_id(); bar_.st = (volatile LAS unsigned*)(F.lds + MISC_OFF) + 8; xcd_barrier(bar_); } while (0)

#ifndef PHMASK
#define PHMASK 0xffff
#endif
#define PH(k) ((PHMASK >> (k)) & 1)
#ifndef PROBE_MASK
#define PROBE_MASK 0
#endif
#define REP(k) _Pragma("nounroll") for (int rep_ = 0; rep_ < ((PROBE_MASK >> (k)) & 1) + 1; ++rep_)
    if (PH(0)) p0_prologue(F);
#if USE_CG_SYNC
    cg::this_grid().sync();
#else
    GRID_BAR();
#endif
    if (PH(1)) p0b_norm1(F);
    GRID_BAR();

    for (int l = 0; l < DEPTH; ++l) {
        const bool need_ctx = (l == 0); const int nrows = need_ctx ? NROW : NLAT;
#define WSO Fp.ws
        if (PH(2)) {
            const Frame Fp = phase_frame(F); unsigned char* const ws = WSO; bf16* Hb = (bf16*)(ws + WS_H); bf16* Pb = (bf16*)(ws + WS_P);
            pg8::Gemm g{Hb, (const bf16*)(ws + WS_WIN_T) + (size_t)l * NP * D, NROW, NP, D}; pg8::StaticOrder S; S.init(NROW, NP, Fp.G, (int)blockIdx.x);
            pg8::EpiStoreBf16 E{Pb, NP, 0xffff};
            pg8::gemm_phase<pg8::EpiStoreBf16, pg8::StaticOrder, true, true>(F.lds, g, S, E);
        }
        GRID_BAR();
        {
            const Frame Fp = phase_frame(F); unsigned char* const ws = WSO; bf16* Pb = (bf16*)(ws + WS_P);
            if (PH(3)) for (int it = blockIdx.x; it < 256; it += F.G) fftA_item(F, it);
            if (PH(4) && need_ctx) for (int it = blockIdx.x; it < 8; it += F.G) { const int b = it >> 2, m0 = (it & 3) * 64;
                const bf16* src0 = Pb + (size_t)(NLAT + b * CTXL) * NP + COL_FC;
                dft64_item<4, 256>(F, l, m0, -1.f, 1.f / 128.f, [=](int t, int ri) { return src0 + (size_t)t * NP + ri * 256; }, [=](int m) { return NLAT + b * CTXL + m; }); }
            if (PH(5)) { shift_pass(F, l);
            conv_pass(F, l, nrows); }
        }
        GRID_BAR();
        {
            const Frame Fp = phase_frame(F); unsigned char* const ws = WSO;
            if (PH(6)) for (int it = blockIdx.x; it < 256; it += F.G) { const int b = it >> 7, t1p = it & 127;
                const bf16* src0 = (const bf16*)(ws + WS_GT) + (size_t)(b * 128 + t1p) * 64 * 512;
                dft64_item<1, 64>(F, l, 0, 1.f, 0.0013810679320049757f, [=](int t, int ri) { return src0 + (size_t)t * 512 + ri * 256; }, [=](int m) { return b * SEQ + t1p + 128 * m; }); }
            if (PH(7)) for (int it = blockIdx.x; it < NROW / 16; it += F.G) prep_item(F, l, it);
        }
        GRID_BAR();
        for (int seg = 0; seg < NSEG; ++seg) {
            pre_phase(F, seg);
            GRID_BAR();
            if (F.G == 256 && blockIdx.x >= 128) warm_pass(F, seg);
            REP(6) for (int it = blockIdx.x; it < 128; it += F.G) { const int x_ = it & 7, j_ = it >> 3; seq_item<0>(F, ((x_ + 8 * (j_ >> 2)) << 2) | (j_ & 3), seg, need_ctx);
#if SEQ_PROBE
                seq_item<SEQ_PROBE>(F, ((x_ + 8 * (j_ >> 2)) << 2) | (j_ & 3), seg, need_ctx);
#endif
            }
            GRID_BAR();
        }
        if (PH(9)) readout_pass(F, l, nrows);
        GRID_BAR();
        if (PH(10)) {
            const Frame Fp = phase_frame(F); unsigned char* const ws = WSO; bf16* Hb = (bf16*)(ws + WS_H);
            pg8::Gemm g{Hb, (const bf16*)(ws + WS_WOUT_T) + (size_t)l * D * D, nrows, D, D}; pg8::StaticOrder S; S.init(nrows, D, Fp.G, (int)blockIdx.x);
            const float* X = (const float*)(ws + WS_X);
            pg8::EpiResidual E{l == 0 ? inptr(I_X) : X, l == 0 ? inptr(I_CTX) : X + (size_t)NLAT * D, (float*)(ws + WS_X), (const float*)(ws + WS_MODF) + (size_t)l * 3 * 6144 + 2 * 1024};
            pg8::gemm_phase<pg8::EpiResidual, pg8::StaticOrder, true, true>(F.lds, g, S, E);
        }
        GRID_BAR();
        if (PH(11)) expert_convert(F, l);
        if (PH(12)) router_pass(F, l, nrows);
        GRID_BAR();
        if (PH(13)) gather_pass(F, l, nrows);
        GRID_BAR();
        if (PH(14)) {
            const Frame Fp = phase_frame(F); unsigned char* const ws = WSO;
            const int* tile_e = (const int*)(ws + WS_ROUTE + RT_TILE); const int ntiles = *(const int*)(ws + WS_ROUTE + RT_NT);
            pg8::MoeOrder S{tile_e, ntiles, Fp.G, (int)blockIdx.x};
            {   pg8::Gemm g{(const bf16*)(ws + WS_XS), (const bf16*)(ws + WS_WGU_T), 0, 0, D};
                pg8::EpiSwiGLU E{(bf16*)(ws + WS_ACT)};
                pg8::gemm_phase<pg8::EpiSwiGLU, pg8::MoeOrder, true, true>(F.lds, g, S, E); }
            GRID_BAR();
            {   pg8::Gemm g{(const bf16*)(ws + WS_ACT), (const bf16*)(ws + WS_WD_T), 0, 0, DEXP};
                pg8::EpiStoreBf16 E{(bf16*)(ws + WS_XS), D, 3};
                pg8::gemm_phase<pg8::EpiStoreBf16, pg8::MoeOrder, true, true>(F.lds, g, S, E); }
        }
        GRID_BAR();
        if (PH(15)) combine_pass(F, l, nrows);
        if (l + 1 < DEPTH) GRID_BAR();
    }
}

extern "C" void kernel_launch(void* const* d_in, const int* in_sizes, int n_in, void* d_out, int out_size, void* d_ws, size_t ws_size, hipStream_t stream) {
    static int grid = 0;
    if (grid == 0) {
        if (n_in != N_IN || in_sizes[0] != NLAT * D || out_size != NLAT * D || ws_size < WS_END) {
            fprintf(stderr, "kernel_launch: unexpected shapes (n_in %d in0 %d out %d ws %zu)\n", n_in, n_in > 0 ? in_sizes[0] : -1, out_size, ws_size); grid = -1; return; }
        int dev = 0, cus = 0, per_cu = 0;
        hipGetDevice(&dev); hipDeviceGetAttribute(&cus, hipDeviceAttributeMultiprocessorCount, dev);
        hipFuncSetAttribute((const void*)fwd_megakernel, hipFuncAttributeMaxDynamicSharedMemorySize, LDS_BYTES);
        hipOccupancyMaxActiveBlocksPerMultiprocessor(&per_cu, (const void*)fwd_megakernel, NTHR, LDS_BYTES);
        if (per_cu < 1) { fprintf(stderr, "kernel_launch: occupancy query says %d blocks per CU\n", per_cu); per_cu = 1; }
        (void)hipGetLastError();
        grid = cus * per_cu;
    }
    if (grid < 0) return;
    hipMemsetAsync((char*)d_ws + WS_CTL, 0, CTL_ZERO_BYTES, stream);
    Params p{};
    for (int i = 0; i < N_IN; ++i) p.in[i] = (const float*)d_in[i];
    p.out = (float*)d_out; p.ws = (unsigned char*)d_ws;
    void* args[] = {&p};
    hipError_t e = hipLaunchCooperativeKernel((const void*)fwd_megakernel, dim3(grid), dim3(NTHR), args, LDS_BYTES, stream);
    if (e != hipSuccess) fprintf(stderr, "kernel_launch: cooperative launch failed: %s (grid %d)\n", hipGetErrorString(e), grid);
}
```

```cpp
#include <hip/hip_runtime.h>
#include <hip/hip_cooperative_groups.h>
#include <cstdio>
#include <cstdint>
namespace cg = cooperative_groups;
#ifndef USE_CG_SYNC
#define USE_CG_SYNC 1
#endif
#define SEQ_PROBE 0
#define PRE_PROBE 0
#ifndef PROBE_MASK
#define PROBE_MASK 0
#endif
namespace pg8 {
#define PG8_LAS __attribute__((address_space(3)))
typedef unsigned short bf16_t;
typedef short bf16x8 __attribute__((ext_vector_type(8)));
typedef float f32x4 __attribute__((ext_vector_type(4)));
typedef unsigned u32x4 __attribute__((ext_vector_type(4)));
constexpr int BM = 256, BK = 64, HALF = 128, HTB = HALF * BK * 2  , STAGE_BYTES = 8 * HTB, NXCD = 8, WGM = 8;

__host__ __device__ __forceinline__ int lds_byte(int r, int c) { const int st = (r >> 4) * 2 + (c >> 5), rr = r & 15, cc = c & 31, ob = rr * 64 + cc * 2; return st * 1024 + (ob ^ (((ob >> 9) & 1) << 5)); }
__host__ __device__ __forceinline__ void stage_rc(int b, int& R, int& C) { const int st = b / 1024, sb = b % 1024, swz = sb ^ (((sb >> 9) & 1) << 5); R = (st >> 1) * 16 + swz / 64; C = (st & 1) * 32 + (swz % 64) / 2; }
__host__ __device__ __forceinline__ int perm32(int rho) { const int n = rho >> 4, i = rho & 15; return 8 * (i >> 2) + 4 * n + (i & 3); }

struct Unit { int pm, pn; };
struct Gemm { const bf16_t* A; const bf16_t* Bt; int M, N, K; };

struct StaticOrder {
    int nM, nN, nwg, G, c;
    __host__ __device__ void init(int M, int N, int G_, int c_) { nM = M / BM; nN = N / BM; nwg = nM * nN; G = G_; c = c_; }
    __host__ __device__ bool next(int i, Unit& u) const {
        const long L = (long)i * G + c; if (L >= nwg) return false;
        int wgid = (int)L; { const int q = nwg / NXCD, r = nwg % NXCD, xcd = wgid % NXCD, off = wgid / NXCD; wgid = (xcd < r ? xcd * (q + 1) : r * (q + 1) + (xcd - r) * q) + off; }
        const int nig = WGM * nN, gid = wgid / nig, fm = gid * WGM, gsz = (nM - fm) < WGM ? (nM - fm) : WGM;
        u.pm = fm + ((wgid % nig) % gsz); u.pn = (wgid % nig) / gsz; return true;
    }
    __device__ __forceinline__ void a_ready(const Unit&) const {}
    __device__ __forceinline__ void done(const Unit&) const {}
};

__device__ __forceinline__ unsigned cvt_pk_bf16(float lo, float hi) { unsigned r; asm volatile("v_cvt_pk_bf16_f32 %0, %1, %2" : "=v"(r) : "v"(lo), "v"(hi)); return r; }
typedef float f32x2 __attribute__((ext_vector_type(2)));
template <class Epi, class Sched, bool ALIGN_EPI = false, bool SP2 = false>
__device__ __forceinline__ void gemm_phase(PG8_LAS unsigned char* lds, const Gemm g, const Sched& S, const Epi& E) {
    int tid = threadIdx.x; asm volatile("" : "+v"(tid));
    const int wid = __builtin_amdgcn_readfirstlane(tid >> 6), lane = tid & 63, wr = wid >> 2, wc = wid & 3, fr = lane & 15, fq = lane >> 4;
    const int K = g.K, nt = K / BK;
    unsigned voffA[2], voffB[2];
#pragma unroll
    for (int i = 0; i < 2; ++i) { int R, C; stage_rc(tid * 16 + i * 8192, R, C); const int Rb = Epi::PERM ? ((R & ~31) + perm32(R & 31)) : R;
        voffA[i] = (unsigned)(R * K + C) * 2u; voffB[i] = (unsigned)(Rb * K + C) * 2u; }
    const size_t kstep = (size_t)(BK * 2);
    const size_t hstep = (size_t)HALF * K * 2;
    const size_t tstep = 2 * hstep;
    const unsigned ldsw = (unsigned)wid * 1024u;
    const int aoff = lds_byte(wr * 64 + fr, fq * 8), boff = lds_byte(wc * 32 + fr, fq * 8);
#define PG8_SA(b, h) (((b) * 2 + (h)) * HTB)
#define PG8_SB(b, h) ((4 + (b) * 2 + (h)) * HTB)
#define PG8_STAGE(bufoff, gbase, voff) do { _Pragma("unroll") for (int _i = 0; _i < 2; ++_i) \
        __builtin_amdgcn_global_load_lds((const unsigned*)((const char*)(gbase) + (voff)[_i]), (PG8_LAS unsigned*)(lds + (bufoff) + ldsw + _i * 8192), 16, 0, 0); } while (0)
#define PG8_LDA(dst, b, h) do { _Pragma("unroll") for (int m = 0; m < 4; ++m) _Pragma("unroll") for (int k = 0; k < 2; ++k) dst[m][k] = *(const PG8_LAS bf16x8*)(lds + PG8_SA(b, h) + aoff + m * 2048 + k * 1024); } while (0)
#define PG8_LDB(dst, b, h) do { _Pragma("unroll") for (int n = 0; n < 2; ++n) _Pragma("unroll") for (int k = 0; k < 2; ++k) dst[n][k] = *(const PG8_LAS bf16x8*)(lds + PG8_SB(b, h) + boff + n * 2048 + k * 1024); } while (0)
#define PG8_MMA(ai, bj, At, Bt) do { __builtin_amdgcn_s_setprio(1); _Pragma("unroll") for (int m = 0; m < 4; ++m) _Pragma("unroll") for (int n = 0; n < 2; ++n) _Pragma("unroll") for (int k = 0; k < 2; ++k) \
        acc[ai][bj][m][n] = __builtin_amdgcn_mfma_f32_16x16x32_bf16(Bt[n][k], At[m][k], acc[ai][bj][m][n], 0, 0, 0); __builtin_amdgcn_s_setprio(0); } while (0)
#define PG8_WAIT_V(n) asm volatile("s_waitcnt vmcnt(" #n ")" ::: "memory")
#define PG8_WAIT_L(n) asm volatile("s_waitcnt lgkmcnt(" #n ")" ::: "memory")
#define PG8_BAR __builtin_amdgcn_s_barrier()
#define PG8_SCHED __builtin_amdgcn_sched_barrier(0)
    Unit cur, nxt; int ui = 0;
    if (!S.next(0, cur)) return;
    f32x4 acc[2][2][4][2];
#pragma unroll
    for (int a = 0; a < 2; ++a)
#pragma unroll
        for (int b = 0; b < 2; ++b)
#pragma unroll
            for (int m = 0; m < 4; ++m)
#pragma unroll
                for (int n = 0; n < 2; ++n) acc[a][b][m][n] = (f32x4){0.f, 0.f, 0.f, 0.f};
    bf16x8 At[4][2], B0[2][2], B1[2][2];
    const char* cA = (const char*)g.A + (size_t)cur.pm * tstep; const char* cB = (const char*)g.Bt + (size_t)cur.pn * tstep;
    S.a_ready(cur);
    if constexpr (SP2) {
        PG8_STAGE(PG8_SB(0, 0), cB, voffB); PG8_STAGE(PG8_SB(0, 1), cB + hstep, voffB); PG8_STAGE(PG8_SA(0, 0), cA, voffA); PG8_STAGE(PG8_SA(0, 1), cA + hstep, voffA);
        if (wr == 1) PG8_BAR;
        PG8_WAIT_V(2); PG8_BAR;
        PG8_STAGE(PG8_SB(1, 0), cB + kstep, voffB); PG8_STAGE(PG8_SA(1, 0), cA + kstep, voffA); PG8_STAGE(PG8_SB(1, 1), cB + hstep + kstep, voffB);
        PG8_WAIT_V(6); PG8_BAR;
    } else {
        PG8_STAGE(PG8_SB(0, 0), cB, voffB); PG8_STAGE(PG8_SA(0, 0), cA, voffA); PG8_STAGE(PG8_SB(0, 1), cB + hstep, voffB); PG8_STAGE(PG8_SA(0, 1), cA + hstep, voffA);
        if (wr == 1) PG8_BAR;
        PG8_WAIT_V(4); PG8_BAR;
        PG8_STAGE(PG8_SB(1, 0), cB + kstep, voffB); PG8_STAGE(PG8_SA(1, 0), cA + kstep, voffA); PG8_STAGE(PG8_SB(1, 1), cB + hstep + kstep, voffB);
        PG8_WAIT_V(6); PG8_BAR;
    }
    for (;;) {
        const bool has_next = S.next(ui + 1, nxt);
        const char* nA = has_next ? (const char*)g.A + (size_t)nxt.pm * tstep : cA; const char* nB = has_next ? (const char*)g.Bt + (size_t)nxt.pn * tstep : cB;
        for (int t = 0; t < nt; t += 2) {
            const bool last = (t == nt - 2);
            const char* a1 = cA + (size_t)(t + 1) * kstep;
            const char* a2 = last ? nA : cA + (size_t)(t + 2) * kstep; const char* b2 = last ? nB : cB + (size_t)(t + 2) * kstep;
            const char* a3 = a2 + kstep; const char* b3 = b2 + kstep;
            if (last && has_next) S.a_ready(nxt);
            if constexpr (SP2) {
            PG8_LDB(B0, 0, 0); PG8_LDB(B1, 0, 1); PG8_SCHED; PG8_LDA(At, 0, 0); PG8_STAGE(PG8_SA(1, 1), a1 + hstep, voffA);
            PG8_WAIT_V(8); PG8_WAIT_L(0); PG8_BAR; PG8_MMA(0, 0, At, B0); PG8_MMA(0, 1, At, B1); PG8_BAR; PG8_SCHED;
            PG8_LDA(At, 0, 1); PG8_STAGE(PG8_SB(0, 0), b2, voffB); PG8_STAGE(PG8_SB(0, 1), b2 + hstep, voffB); PG8_STAGE(PG8_SA(0, 0), a2, voffA);
            PG8_WAIT_V(8); PG8_WAIT_L(0); PG8_BAR; PG8_MMA(1, 0, At, B0); PG8_MMA(1, 1, At, B1); PG8_BAR; PG8_SCHED;
            PG8_LDB(B0, 1, 0); PG8_LDB(B1, 1, 1); PG8_SCHED; PG8_LDA(At, 1, 0); PG8_STAGE(PG8_SA(0, 1), a2 + hstep, voffA);
            PG8_WAIT_V(8); PG8_WAIT_L(0); PG8_BAR; PG8_MMA(0, 0, At, B0); PG8_MMA(0, 1, At, B1); PG8_BAR; PG8_SCHED;
            PG8_LDA(At, 1, 1); PG8_STAGE(PG8_SB(1, 0), b3, voffB); PG8_STAGE(PG8_SB(1, 1), b3 + hstep, voffB); PG8_STAGE(PG8_SA(1, 0), a3, voffA);
            PG8_WAIT_V(8); PG8_WAIT_L(0); PG8_BAR; PG8_MMA(1, 0, At, B0); PG8_MMA(1, 1, At, B1); PG8_BAR; PG8_SCHED;
            } else {
            PG8_LDB(B0, 0, 0); PG8_SCHED; PG8_LDA(At, 0, 0); PG8_STAGE(PG8_SA(1, 1), a1 + hstep, voffA);
            PG8_WAIT_L(8); PG8_BAR; PG8_WAIT_L(0); PG8_MMA(0, 0, At, B0); PG8_BAR; PG8_SCHED;
            PG8_LDB(B1, 0, 1); PG8_STAGE(PG8_SB(0, 0), b2, voffB);
            PG8_BAR; PG8_WAIT_L(0); PG8_MMA(0, 1, At, B1); PG8_BAR;
            PG8_LDA(At, 0, 1); PG8_STAGE(PG8_SA(0, 0), a2, voffA);
            PG8_BAR; PG8_WAIT_L(0); PG8_MMA(1, 0, At, B0); PG8_BAR; PG8_SCHED;
            PG8_STAGE(PG8_SB(0, 1), b2 + hstep, voffB);
            PG8_WAIT_V(6); PG8_BAR; PG8_MMA(1, 1, At, B1); PG8_BAR;
            PG8_LDB(B0, 1, 0); PG8_SCHED; PG8_LDA(At, 1, 0); PG8_STAGE(PG8_SA(0, 1), a2 + hstep, voffA);
            PG8_WAIT_L(8); PG8_BAR; PG8_WAIT_L(0); PG8_MMA(0, 0, At, B0); PG8_BAR; PG8_SCHED;
            PG8_LDB(B1, 1, 1); PG8_STAGE(PG8_SB(1, 0), b3, voffB);
            PG8_BAR; PG8_WAIT_L(0); PG8_MMA(0, 1, At, B1); PG8_BAR;
            PG8_LDA(At, 1, 1); PG8_STAGE(PG8_SA(1, 0), a3, voffA);
            PG8_BAR; PG8_WAIT_L(0); PG8_MMA(1, 0, At, B0); PG8_BAR; PG8_SCHED;
            PG8_STAGE(PG8_SB(1, 1), b3 + hstep, voffB);
            PG8_WAIT_V(6); PG8_BAR; PG8_MMA(1, 1, At, B1); PG8_BAR;
            }
        }
        if constexpr (ALIGN_EPI) { if (wr == 0) PG8_BAR; }
        if constexpr (!Epi::AFTER_DRAIN) { E(acc, cur, wr, wc, fr, fq); S.done(cur); }
        if (!has_next) break;
#pragma unroll
        for (int a = 0; a < 2; ++a)
#pragma unroll
            for (int b = 0; b < 2; ++b)
#pragma unroll
                for (int m = 0; m < 4; ++m)
#pragma unroll
                    for (int n = 0; n < 2; ++n) acc[a][b][m][n] = (f32x4){0.f, 0.f, 0.f, 0.f};
        cur = nxt; cA = nA; cB = nB; ++ui;
        if constexpr (ALIGN_EPI) { if (wr == 1) PG8_BAR; }
    }
    PG8_WAIT_V(0);
    if constexpr (!ALIGN_EPI) { if (wr == 0) PG8_BAR; }
    PG8_BAR;
    if constexpr (Epi::AFTER_DRAIN) { E.fused(acc, cur, wr, wc, fr, fq, lds, wid, lane); S.done(cur); }
#undef PG8_SA
#undef PG8_SB
#undef PG8_STAGE
#undef PG8_LDA
#undef PG8_LDB
#undef PG8_MMA
#undef PG8_WAIT_V
#undef PG8_WAIT_L
#undef PG8_BAR
#undef PG8_SCHED
}
}
#define LAS __attribute__((address_space(3)))
typedef unsigned short bf16;
typedef float f32x4 __attribute__((ext_vector_type(4)));
typedef short bf16x8 __attribute__((ext_vector_type(8)));
typedef unsigned u32x4 __attribute__((ext_vector_type(4)));
typedef unsigned u32x2 __attribute__((ext_vector_type(2)));

constexpr int D = 1024, NBATCH = 2, SEQ = 8192, CTXL = 256, DEPTH = 2;
constexpr int NLAT = NBATCH * SEQ, NCTX = NBATCH * CTXL, NROW = NLAT + NCTX;
constexpr int DR = 512, DIN = 2944, NP = 3328, ZW = 1920, NHEAD = 8;
constexpr int COL_CONV = 1920, COL_FC = 2688, COL_FS = 2944;
constexpr int STRW = 5120;
constexpr int NEXP = 32, DEXP = 512;
constexpr int MOE_MAXTILES = 168;
constexpr float RMS_EPS = 1e-6f, GN_EPS = 64e-5f;

enum { I_X = 0, I_C, I_CTX, I_CCTX, I_ADAW, I_ADAB, I_N1G, I_N2G, I_WIN, I_MU, I_DW0, I_DW2, I_IA0, I_IA2, I_GG2, I_KK, I_KA, I_RK, I_GNW, I_GNB,
       I_CONVW, I_CONVG, I_FOURG, I_WOUT, I_RGW, I_RGB, I_REW, I_REB, I_EG, I_EU, I_ED, I_FG, N_IN };

constexpr size_t MiB = 1u << 20;
constexpr size_t WS_CTL = 0, CTL_ZERO_BYTES = 64 * 1024;
constexpr size_t WS_MODP = 1 * MiB;
constexpr size_t WS_MODF = 1 * MiB + 1280 * 1024;
constexpr size_t WS_WIN_T = 3 * MiB;
constexpr size_t WS_WOUT_T = 16 * MiB;
constexpr size_t WS_WGU_T = 20 * MiB;
constexpr size_t WS_WD_T = 84 * MiB;
constexpr size_t WS_X = 116 * MiB;
constexpr size_t WS_H = 182 * MiB;
constexpr size_t WS_ZS = 215 * MiB;
constexpr size_t WS_P = 277 * MiB;
constexpr size_t WS_STR = 277 * MiB;
constexpr size_t WS_Y = 442 * MiB;
constexpr size_t WS_GT = 475 * MiB;
constexpr size_t WS_ROUTE = 491 * MiB;
constexpr size_t WS_XS = 215 * MiB;
constexpr size_t WS_ACT = 299 * MiB;
constexpr size_t WS_END = 530 * MiB;
constexpr size_t RT_E = 0, RT_POS = 1 * 33792 * 4, RT_GATE = 2 * 33792 * 4, RT_SLOT = 3 * 33792 * 4, RT_TILE = 4 * 33792 * 4, RT_NT = RT_TILE + 1024;

constexpr int CW_BAR = 4096;
constexpr int CW_CNT = 8192;

constexpr int NWAVES = 8, NTHR = 512;
constexpr int RING_BYTES = 131072, LDSCTL_OFF = 143360, MISC_OFF = LDSCTL_OFF + 320, LDS_BYTES = 147456;

struct Params { const float* in[N_IN]; float* out; unsigned char* ws; };

__device__ __forceinline__ float bf2f(unsigned h) { return __uint_as_float(h << 16); }
typedef __bf16 hwbf2 __attribute__((ext_vector_type(2)));
typedef float f32x2 __attribute__((ext_vector_type(2)));
__device__ __forceinline__ unsigned pk2(float lo, float hi) { const f32x2 x = {lo, hi}; const hwbf2 r = __builtin_convertvector(x, hwbf2); return __builtin_bit_cast(unsigned, r); }
__device__ __forceinline__ unsigned f2bf(float f) { return pk2(f, 0.f) & 0xffffu; }
__device__ __forceinline__ float wave_sum(float v) {
#pragma unroll
    for (int o = 1; o < 64; o <<= 1) v += __shfl_xor(v, o);
    return v;
}
__device__ __forceinline__ float sigmoidf_(float x) { return 1.f / (1.f + __expf(-x)); }
#define LDS_WAIT() asm volatile("s_waitcnt lgkmcnt(0)" ::: "memory")
#define VM_WAIT() asm volatile("s_waitcnt vmcnt(0)" ::: "memory")

struct Frame {
    LAS unsigned char* lds;
    int tid, lane, wave, vcu, G, gw, NGW;
    float* out; unsigned char* ws;
};
__device__ __forceinline__ const float* inptr(int i) {
    const volatile unsigned long long __attribute__((address_space(4)))* ka = (const volatile unsigned long long __attribute__((address_space(4)))*)__builtin_amdgcn_kernarg_segment_ptr();
    return (const float*)ka[i];
}
__device__ __forceinline__ unsigned char* opaque(unsigned char* p) { asm volatile("" : "+s"(p)); return p; }
__device__ __forceinline__ Frame phase_frame(const Frame& F0) { Frame F = F0; asm volatile("" : "+v"(F.tid)); F.lane = F.tid & 63; F.ws = opaque(F0.ws);
    asm volatile("" : "+s"(F.G), "+s"(F.vcu)); F.gw = F.vcu * NWAVES + F.wave; F.NGW = F.G * NWAVES; return F; }
__device__ __forceinline__ int modrow(int row) { return row < NLAT ? (row >> 13) : 2; }
#define XB_TMO      128
#define XB_XCNT(j)  (256  + 64 * (j))
#define XB_XSUB(j)  (1280 + 64 * (j))
#define XB_XGEN(j)  (2304 + 64 * (j))
#define XB_TOP      3328
#define XB_TOPGEN   3392
#define XCD_BAR_WORDS 3456
#define XB_SPIN_CAP (1u << 18)

__device__ __forceinline__ unsigned xb_ld(unsigned* p)              { return __hip_atomic_load(p, __ATOMIC_RELAXED, __HIP_MEMORY_SCOPE_AGENT); }
__device__ __forceinline__ unsigned xb_add(unsigned* p, unsigned v) { return __hip_atomic_fetch_add(p, v, __ATOMIC_RELAXED, __HIP_MEMORY_SCOPE_AGENT); }
__device__ __forceinline__ unsigned xb_xcc_id() { return (unsigned)__builtin_amdgcn_s_getreg((3 << 11) | 20) & 0xFu; }
#define XB_SPIN(cond, bar) do { unsigned _sp = 0; while (cond) { __builtin_amdgcn_s_sleep(1); \
    if ((++_sp & 255u) == 0u) { if (xb_ld(&(bar)[XB_TMO])) break; if (_sp > XB_SPIN_CAP) { atomicAdd(&(bar)[XB_TMO], 1u); break; } } } } while (0)

struct XcdBarrier {
    unsigned* bar; unsigned x;
    volatile LAS unsigned* st;
};

__device__ __forceinline__ XcdBarrier xcd_barrier_post(unsigned* bar, volatile LAS unsigned* st) {
    XcdBarrier b; b.bar = bar; b.x = xb_xcc_id(); b.st = st;
    if (threadIdx.x == 0) (void)xb_add(&bar[XB_XCNT(b.x)], 1u);
    return b;
}
__device__ __forceinline__ void xcd_barrier_complete(unsigned* bar, unsigned x, unsigned& nloc, unsigned& nx) {
    const unsigned G = gridDim.x * gridDim.y * gridDim.z;
    unsigned sum, cnt, mine, sp = 0u;
    for (;;) {
        sum = 0u; cnt = 0u; mine = 0u;
#pragma nounroll
        for (unsigned j = 0; j < 16; ++j) { const unsigned c = xb_ld(&bar[XB_XCNT(j)]); sum += c; cnt += (c > 0u) ? 1u : 0u; mine = (j == x) ? c : mine; }
        if (sum == G) break;
        __builtin_amdgcn_s_sleep(1);
        if ((++sp & 255u) == 0u) { if (xb_ld(&bar[XB_TMO])) break; if (sp > XB_SPIN_CAP) { atomicAdd(&bar[XB_TMO], 1u); break; } }
    }
    nloc = mine > 0u ? mine : 1u; nx = cnt > 0u ? cnt : 1u;
}

__device__ __forceinline__ void xcd_barrier(const XcdBarrier& b) {
    asm volatile("s_waitcnt vmcnt(0)" ::: "memory");
    __syncthreads();
    if (threadIdx.x == 0) {
        unsigned* bar = b.bar;
        asm volatile("" : "+s"(bar));
        __builtin_amdgcn_s_waitcnt(0);
        unsigned nloc = b.st[0], nx = b.st[1];
        if (nloc == 0u) { xcd_barrier_complete(bar, b.x, nloc, nx); b.st[0] = nloc; b.st[1] = nx; }
        const unsigned old = xb_add(&bar[XB_XSUB(b.x)], 1u);
        const unsigned gen = old / nloc;
        if (old + 1u == (gen + 1u) * nloc) {
            __builtin_amdgcn_fence(__ATOMIC_RELEASE, "agent");
            asm volatile("s_waitcnt vmcnt(0)" ::: "memory");
            const unsigned og = xb_add(&bar[XB_TOP], 1u);
            const unsigned tg = og / nx;
            if (og + 1u == (tg + 1u) * nx) xb_add(&bar[XB_TOPGEN], 1u);
            else XB_SPIN(xb_ld(&bar[XB_TOPGEN]) == tg, bar);
            __builtin_amdgcn_fence(__ATOMIC_ACQUIRE, "agent");
            xb_add(&bar[XB_XGEN(b.x)], 1u);
            asm volatile("s_waitcnt vmcnt(0)" ::: "memory");
        } else {
            XB_SPIN(xb_ld(&bar[XB_XGEN(b.x)]) == gen, bar);
            __builtin_amdgcn_fence(__ATOMIC_ACQUIRE, "agent");
            asm volatile("s_waitcnt vmcnt(0)" ::: "memory");
        }
    }
    __syncthreads();
}
template <class RowMap>
__device__ __forceinline__ void transpose_item(const float* W, int ldw, int k0, int n0, bf16* WT, int ldt, RowMap rm, LAS float* scr, int lane) {
    (void)scr;
    const int nq = lane & 7, kg = lane >> 3; const float* src = W + (size_t)(k0 + 8 * kg) * ldw + n0 + 4 * nq;
    f32x4 v[8];
#pragma unroll
    for (int i = 0; i < 8; ++i) v[i] = *(const f32x4*)(src + (size_t)i * ldw);
#pragma unroll
    for (int j = 0; j < 4; ++j) { u32x4 o = {pk2(v[0][j], v[1][j]), pk2(v[2][j], v[3][j]), pk2(v[4][j], v[5][j]), pk2(v[6][j], v[7][j])};
        *(u32x4*)(WT + (size_t)rm(n0 + 4 * nq + j) * ldt + k0 + 8 * kg) = o; }
}
struct RmId { int off; __device__ __forceinline__ int operator()(int n) const { return off + n; } };
struct RmGU { int off; __device__ __forceinline__ int operator()(int n) const { return off + ((n >> 2) << 3) + (n & 3); } };

__device__ __forceinline__ void p0_prologue(const Frame& F0) {
    const Frame F = phase_frame(F0); unsigned char* const ws = F.ws;
    LAS float* scr = (LAS float*)(F.lds + F.wave * 16384);
    LAS float* ctab = (LAS float*)(F.lds + 8 * 16384);
    if (F.tid < 64) ctab[F.tid] = cosf((float)F.tid * (6.283185307179586f / 64.f));
    __syncthreads();
    bf16* win_t = (bf16*)(ws + WS_WIN_T); bf16* wout_t = (bf16*)(ws + WS_WOUT_T);
    constexpr int I_WIN_L = 16 * 84, I_WOUT_L = 16 * 32, I_FOLD_L = 4 * 64, I_MOD_L = 96 * 8;
    constexpr int NIT = 2 * (I_WIN_L + I_WOUT_L + I_FOLD_L + I_MOD_L);
    const float* p_win = inptr(I_WIN); const float* p_wout = inptr(I_WOUT); const float* p_c = inptr(I_C); const float* p_cctx = inptr(I_CCTX); const float* p_adaw = inptr(I_ADAW);
    {
        bf16* wl = (bf16*)(ws + 64 * 1024); const float* dw2 = inptr(I_DW2); const float* ia2 = inptr(I_IA2); const float* gg2 = inptr(I_GG2);
        for (int idx = F.vcu * NTHR + F.tid; idx < 2 * 384 * 512; idx += F.G * NTHR) { const int c = idx & 511, k = (idx >> 9) % 384, l = idx / (384 * 512);
            float v;
            if (k < 128) v = dw2[((size_t)(l * 2 + (k >> 6)) * 64 + (k & 63)) * DR + c];
            else if (k < 256) v = ia2[((size_t)(l * 2 + ((k - 128) >> 6)) * 64 + (k & 63)) * DR + c];
            else v = gg2[((size_t)l * 128 + (k - 256)) * DR + c];
            wl[((size_t)l * 512 + c) * 384 + k] = (bf16)f2bf(v); } }
    for (int it = F.gw; it < NIT; it += F.NGW) {
        int r = it; const int l = r & 1; r >>= 1;
        if (r < I_WIN_L) { const int kb = r / 84, nb = r % 84;
            transpose_item(p_win + (size_t)l * D * DIN, DIN, kb * 64, nb * 32, win_t + (size_t)l * NP * D, D, RmId{0}, scr, F.lane); continue; }
        r -= I_WIN_L;
        if (r < I_WOUT_L) { const int kb = r / 32, nb = r % 32;
            transpose_item(p_wout + (size_t)l * D * D, D, kb * 64, nb * 32, wout_t + (size_t)l * D * D, D, RmId{0}, scr, F.lane); continue; }
        r -= I_WOUT_L;
        if (r < I_FOLD_L) {
            const int g = r >> 6, k0 = (r & 63) * 16; const float* W = p_win + (size_t)l * D * DIN;
#pragma unroll
            for (int kk = 0; kk < 16; ++kk) scr[kk * 64 + F.lane] = W[(size_t)(k0 + kk) * DIN + 2688 + g * 64 + F.lane];
            LDS_WAIT(); asm volatile("" ::: "memory");
            float ac[16], as[16];
#pragma unroll
            for (int kk = 0; kk < 16; ++kk) { ac[kk] = 0.f; as[kk] = 0.f; }
            for (int c = 0; c < 64; ++c) { const int idx = (c * F.lane) & 63; const float cc = ctab[idx], ss = ctab[(idx - 16) & 63];
#pragma unroll
                for (int kk = 0; kk < 16; ++kk) { const float w = scr[kk * 64 + c]; ac[kk] += w * cc; as[kk] += w * ss; } }
            bf16* oc = win_t + (size_t)l * NP * D + (size_t)(COL_FC + g * 64 + F.lane) * D + k0;
            bf16* os = win_t + (size_t)l * NP * D + (size_t)(COL_FS + g * 64 + F.lane) * D + k0;
            u32x4 a, b;
            a.x = pk2(ac[0], ac[1]); a.y = pk2(ac[2], ac[3]); a.z = pk2(ac[4], ac[5]); a.w = pk2(ac[6], ac[7]);
            b.x = pk2(ac[8], ac[9]); b.y = pk2(ac[10], ac[11]); b.z = pk2(ac[12], ac[13]); b.w = pk2(ac[14], ac[15]);
            *(u32x4*)oc = a; *(u32x4*)(oc + 8) = b;
            a.x = pk2(as[0], as[1]); a.y = pk2(as[2], as[3]); a.z = pk2(as[4], as[5]); a.w = pk2(as[6], as[7]);
            b.x = pk2(as[8], as[9]); b.y = pk2(as[10], as[11]); b.z = pk2(as[12], as[13]); b.w = pk2(as[14], as[15]);
            *(u32x4*)os = a; *(u32x4*)(os + 8) = b;
            LDS_WAIT(); asm volatile("" ::: "memory");
            continue; }
        r -= I_FOLD_L;
        {
            const int cb = r >> 3, ks = r & 7;
#pragma unroll
            for (int q = 0; q < 2; ++q) { const int k = ks * 128 + q * 64 + F.lane;
                const float c0 = p_c[k], c1 = p_c[D + k], c2 = p_cctx[k];
                scr[0 * 128 + q * 64 + F.lane] = c0 * sigmoidf_(c0); scr[1 * 128 + q * 64 + F.lane] = c1 * sigmoidf_(c1); scr[2 * 128 + q * 64 + F.lane] = c2 * sigmoidf_(c2); }
            LDS_WAIT(); asm volatile("" ::: "memory");
            const float* W = p_adaw + (size_t)l * D * 6144 + (size_t)(ks * 128) * 6144 + cb * 64 + F.lane;
            float a0 = 0.f, a1 = 0.f, a2 = 0.f;
#pragma unroll 8
            for (int kk = 0; kk < 128; ++kk) { const float w = W[(size_t)kk * 6144]; a0 += scr[kk] * w; a1 += scr[128 + kk] * w; a2 += scr[256 + kk] * w; }
            float* mp = (float*)(ws + WS_MODP) + (size_t)((l * 8 + ks) * 3) * 6144 + cb * 64 + F.lane;
            mp[0] = a0; mp[6144] = a1; mp[2 * 6144] = a2;
            LDS_WAIT(); asm volatile("" ::: "memory");
        }
    }
}

__device__ __forceinline__ void mod_to_lds(const Frame& F0, int l, int p, LAS float* dst, bool from_partials) {
    const Frame F = phase_frame(F0); unsigned char* const ws = F.ws;
    const float* adab = inptr(I_ADAB);
    for (int idx = F.tid; idx < 3 * 1024; idx += NTHR) { const int r = idx >> 10, n = idx & 1023;
        float v;
        if (from_partials) { v = adab[l * 6144 + p * 1024 + n]; const float* mp = (const float*)(ws + WS_MODP) + (size_t)(l * 8 * 3 + r) * 6144 + p * 1024 + n;
#pragma unroll
            for (int ks = 0; ks < 8; ++ks) v += mp[(size_t)ks * 3 * 6144]; }
        else v = ((const float*)(ws + WS_MODF))[(size_t)(l * 3 + r) * 6144 + p * 1024 + n];
        dst[idx] = v; }
}
__device__ __forceinline__ void mod_finalize(const Frame& F0) {
    const Frame F = phase_frame(F0); unsigned char* const ws = F.ws;
    const float* adab = inptr(I_ADAB);
    for (int idx = F.vcu * NTHR + F.tid; idx < 2 * 3 * 6144; idx += F.G * NTHR) { const int l = idx / (3 * 6144), rem = idx % (3 * 6144), r = rem / 6144, n = rem % 6144;
        float v = adab[l * 6144 + n]; const float* mp = (const float*)(ws + WS_MODP) + (size_t)(l * 8 * 3 + r) * 6144 + n;
#pragma unroll
        for (int ks = 0; ks < 8; ++ks) v += mp[(size_t)ks * 3 * 6144];
        ((float*)(ws + WS_MODF))[idx] = v; }
}


__device__ __forceinline__ void norm_mod_row(f32x4 (&v)[4], const float* gain, const LAS float* sc, const LAS float* sh, bf16* orow, int lane) {
    float s = 0.f;
#pragma unroll
    for (int j = 0; j < 4; ++j) s += (v[j].x * v[j].x + v[j].y * v[j].y) + (v[j].z * v[j].z + v[j].w * v[j].w);
    const float rs = rsqrtf(wave_sum(s) * (1.f / D) + RMS_EPS);
#pragma unroll
    for (int j = 0; j < 4; ++j) { const int c = 4 * lane + 256 * j; const f32x4 g = *(const f32x4*)(gain + c); const f32x4 a = *(const LAS f32x4*)(sc + c), b = *(const LAS f32x4*)(sh + c);
        v[j] = (v[j] * rs) * g * (a + 1.f) + b;
        u32x2 w; w.x = pk2(v[j].x, v[j].y); w.y = pk2(v[j].z, v[j].w); *(u32x2*)(orow + c) = w; }
}

__device__ __forceinline__ void p0b_norm1(const Frame& F0) {
    const Frame F = phase_frame(F0); unsigned char* const ws = F.ws;
    LAS float* msh = (LAS float*)F.lds; LAS float* msc = msh + 3072;
    mod_to_lds(F, 0, 0, msh, true); mod_to_lds(F, 0, 1, msc, true); __syncthreads();
    mod_finalize(F);
    bf16* H = (bf16*)(ws + WS_H); const float* xin = inptr(I_X); const float* cin = inptr(I_CTX); const float* n1g = inptr(I_N1G);
    for (int row = F.gw; row < NROW; row += F.NGW) { const float* xr = row < NLAT ? xin + (size_t)row * D : cin + (size_t)(row - NLAT) * D; f32x4 v[4];
#pragma unroll
        for (int j = 0; j < 4; ++j) v[j] = *(const f32x4*)(xr + 4 * F.lane + 256 * j);
        const int mr = modrow(row);
        norm_mod_row(v, n1g, msc + mr * 1024, msh + mr * 1024, H + (size_t)row * D, F.lane); }
}
__device__ __forceinline__ void unpack8(const u32x4 w, float (&o)[8]) {
    o[0] = bf2f(w.x & 0xffffu); o[1] = bf2f(w.x >> 16); o[2] = bf2f(w.y & 0xffffu); o[3] = bf2f(w.y >> 16);
    o[4] = bf2f(w.z & 0xffffu); o[5] = bf2f(w.z >> 16); o[6] = bf2f(w.w & 0xffffu); o[7] = bf2f(w.w >> 16);
}
__device__ __forceinline__ void unpack4(const u32x2 w, float (&o)[4]) { o[0] = bf2f(w.x & 0xffffu); o[1] = bf2f(w.x >> 16); o[2] = bf2f(w.y & 0xffffu); o[3] = bf2f(w.y >> 16); }

__device__ __forceinline__ void shift_pass(const Frame& F0, int l) {
    const Frame F = phase_frame(F0); unsigned char* const ws = F.ws;
    const bf16* P = (const bf16*)(ws + WS_P); bf16* Zs = (bf16*)(ws + WS_ZS); const float* mu = inptr(I_MU) + l * ZW;
    const int total = NROW * 240;
    for (int idx = F.vcu * NTHR + F.tid; idx < total; idx += F.G * NTHR) {
        const int row = idx / 240, ck = idx % 240; const bf16* pr = P + (size_t)row * NP + ck * 8;
        const u32x4 zero = {0u, 0u, 0u, 0u};
        float z[8], n0[8], n1[8], n2[8], n3[8], o[8];
        unpack8(*(const u32x4*)pr, z);
        if (row < NLAT) { const int t = row & (SEQ - 1), gr = t >> 6, gc = t & 63;
            unpack8(gc > 0 ? *(const u32x4*)(pr - NP) : zero, n0); unpack8(gc < 63 ? *(const u32x4*)(pr + NP) : zero, n1);
            unpack8(gr > 0 ? *(const u32x4*)(pr - 64 * NP) : zero, n2); unpack8(gr < 127 ? *(const u32x4*)(pr + 64 * NP) : zero, n3);
        } else { const int tc = (row - NLAT) & (CTXL - 1);
            unpack8(tc > 0 ? *(const u32x4*)(pr - NP) : zero, n0); unpack8(tc < CTXL - 1 ? *(const u32x4*)(pr + NP) : zero, n1);
#pragma unroll
            for (int j = 0; j < 8; ++j) { n2[j] = n0[j]; n3[j] = n1[j]; }
        }
        const f32x4 m0 = *(const f32x4*)(mu + ck * 8), m1 = *(const f32x4*)(mu + ck * 8 + 4);
        const float m[8] = {m0.x, m0.y, m0.z, m0.w, m1.x, m1.y, m1.z, m1.w};
#pragma unroll
        for (int j = 0; j < 8; ++j) { const float nb = (j & 3) == 0 ? n0[j] : (j & 3) == 1 ? n1[j] : (j & 3) == 2 ? n2[j] : n3[j]; o[j] = z[j] + (nb - z[j]) * m[j]; }
        u32x4 w; w.x = pk2(o[0], o[1]); w.y = pk2(o[2], o[3]); w.z = pk2(o[4], o[5]); w.w = pk2(o[6], o[7]);
        *(u32x4*)(Zs + (size_t)row * ZW + ck * 8) = w;
    }
}

__device__ __forceinline__ void conv_pass(const Frame& F0, int l, int nrows) {
    const Frame F = phase_frame(F0); unsigned char* const ws = F.ws;
    const bf16* P = (const bf16*)(ws + WS_P); bf16* MA = (bf16*)(ws + WS_H);
    const float* cw = inptr(I_CONVW) + l * 3 * 256; const int c = 4 * F.lane;
    const f32x4 w0 = *(const f32x4*)(cw + c), w1 = *(const f32x4*)(cw + 256 + c), w2 = *(const f32x4*)(cw + 512 + c), gn = *(const f32x4*)(inptr(I_CONVG) + l * 256 + c);
    for (int row = F.gw; row < nrows; row += F.NGW) {
        int t, L; if (row < NLAT) { t = row & (SEQ - 1); L = SEQ; } else { t = (row - NLAT) & (CTXL - 1); L = CTXL; }
        const bf16* pr = P + (size_t)row * NP + COL_CONV + c;
        float bg[4], cg[4], hh[4], cp[4], hp[4], cn[4], hn[4]; const u32x2 zero = {0u, 0u};
        unpack4(*(const u32x2*)pr, bg); unpack4(*(const u32x2*)(pr + 256), cg); unpack4(*(const u32x2*)(pr + 512), hh);
        unpack4(t > 0 ? *(const u32x2*)(pr - NP + 256) : zero, cp); unpack4(t > 0 ? *(const u32x2*)(pr - NP + 512) : zero, hp);
        unpack4(t < L - 1 ? *(const u32x2*)(pr + NP + 256) : zero, cn); unpack4(t < L - 1 ? *(const u32x2*)(pr + NP + 512) : zero, hn);
        const float W0[4] = {w0.x, w0.y, w0.z, w0.w}, W1[4] = {w1.x, w1.y, w1.z, w1.w}, W2[4] = {w2.x, w2.y, w2.z, w2.w}, GN[4] = {gn.x, gn.y, gn.z, gn.w};
        float y[4], s = 0.f;
#pragma unroll
        for (int j = 0; j < 4; ++j) { y[j] = bg[j] * (W0[j] * (cp[j] * hp[j]) + W1[j] * (cg[j] * hh[j]) + W2[j] * (cn[j] * hn[j])); s += y[j] * y[j]; }
        const float rs = rsqrtf(wave_sum(s) * (1.f / 256.f) + RMS_EPS);
        u32x2 o; o.x = pk2(y[0] * rs * GN[0], y[1] * rs * GN[1]); o.y = pk2(y[2] * rs * GN[2], y[3] * rs * GN[3]);
        *(u32x2*)(MA + (size_t)row * D + 512 + c) = o;
    }
}

__device__ __forceinline__ void sincos_turns(float x, float& s, float& c) { s = __builtin_amdgcn_sinf(x); c = __builtin_amdgcn_cosf(x); }
#define MFMA16(a, b, c) __builtin_amdgcn_mfma_f32_16x16x32_bf16((a), (b), (c), 0, 0, 0)

__device__ __forceinline__ void fftA_item(const Frame& F0, int item) {
    const Frame F = phase_frame(F0); unsigned char* const ws = F.ws;
    const int half = item & 1, t2 = (item >> 1) & 63, b = item >> 7;
    const bf16* P = (const bf16*)(ws + WS_P); bf16* GT = (bf16*)(ws + WS_GT);
    LAS bf16* Bs = (LAS bf16*)F.lds;
    const int lane = F.lane, w = F.wave, fr = lane & 15, fq = lane >> 4;
    __syncthreads();
#pragma unroll
    for (int i = 0; i < 8; ++i) { const int cidx = F.tid + NTHR * i, krow = cidx >> 4, ch8 = cidx & 15, ri = krow >> 7, t1 = krow & 127;
        const u32x4 v = *(const u32x4*)(P + (size_t)(b * SEQ + t1 * 64 + t2) * NP + COL_FC + ri * 256 + half * 128 + ch8 * 8);
        LAS bf16* d = Bs + (ch8 * 8) * 264 + krow;
        d[0 * 264] = (bf16)(v.x & 0xffffu); d[1 * 264] = (bf16)(v.x >> 16); d[2 * 264] = (bf16)(v.y & 0xffffu); d[3 * 264] = (bf16)(v.y >> 16);
        d[4 * 264] = (bf16)(v.z & 0xffffu); d[5 * 264] = (bf16)(v.z >> 16); d[6 * 264] = (bf16)(v.w & 0xffffu); d[7 * 264] = (bf16)(v.w >> 16); }
    __syncthreads();
    f32x4 acc[2][8];
#pragma unroll
    for (int a = 0; a < 2; ++a)
#pragma unroll
        for (int n = 0; n < 8; ++n) acc[a][n] = (f32x4){0.f, 0.f, 0.f, 0.f};
    int t1p_a = 16 * w + fr;
    asm volatile("" : "+v"(t1p_a));
#pragma unroll
    for (int ks = 0; ks < 8; ++ks) {
        bf16x8 ar, ai;
#pragma unroll
        for (int j = 0; j < 8; ++j) { const int k = ks * 32 + 8 * fq + j, ri = k >> 7, t1 = k & 127; const int idx = (t1 * t1p_a) & 127;
            float sn, cs; sincos_turns((float)idx * (1.f / 128.f), sn, cs);
            const float vr = ri == 0 ? cs : -sn, vi = ri == 0 ? -sn : -cs;
            ar[j] = (short)f2bf(vr); ai[j] = (short)f2bf(vi); }
#pragma unroll
        for (int nt = 0; nt < 8; ++nt) { const bf16x8 bfr = *(const LAS bf16x8*)(Bs + (nt * 16 + fr) * 264 + ks * 32 + 8 * fq);
            acc[0][nt] = MFMA16(ar, bfr, acc[0][nt]); acc[1][nt] = MFMA16(ai, bfr, acc[1][nt]); }
    }
#pragma unroll
    for (int reg = 0; reg < 4; ++reg) { const int t1p = 16 * w + 4 * fq + reg; float st, ct; sincos_turns((float)(t2 * t1p) * (1.f / 8192.f), st, ct);
        bf16* g = GT + ((size_t)((b * 128 + t1p) * 64 + t2) * 2) * 256 + half * 128 + fr;
#pragma unroll
        for (int nt = 0; nt < 8; ++nt) { const float gr = acc[0][nt][reg], gi = acc[1][nt][reg];
            g[nt * 16] = (bf16)f2bf(gr * ct + gi * st); g[256 + nt * 16] = (bf16)f2bf(gi * ct - gr * st); } }
}

template <int NKC, int NDIV, class SrcRow, class OutRow>
__device__ __forceinline__ void dft64_item(const Frame& F0, int l, int m0, float sgn, float scale, SrcRow src, OutRow orow) {
    const Frame F = phase_frame(F0); unsigned char* const ws = F.ws;
    LAS bf16* Bs = (LAS bf16*)F.lds;
    LAS float* red = (LAS float*)(F.lds + 256 * 136 * 2);
    const int lane = F.lane, w = F.wave, fr = lane & 15, fq = lane >> 4;
    int fr_a = fr; asm volatile("" : "+v"(fr_a));
    f32x4 acc[4][2];
#pragma unroll
    for (int a = 0; a < 4; ++a) { acc[a][0] = (f32x4){0.f, 0.f, 0.f, 0.f}; acc[a][1] = (f32x4){0.f, 0.f, 0.f, 0.f}; }
    for (int kc = 0; kc < NKC; ++kc) {
        __syncthreads();
#pragma unroll
        for (int i = 0; i < 8; ++i) { const int cidx = F.tid + NTHR * i, krow = cidx >> 5, ch8 = cidx & 31;
            const u32x4 v = *(const u32x4*)(src(kc * 64 + (krow >> 1), krow & 1) + ch8 * 8);
            LAS bf16* d = Bs + (ch8 * 8) * 136 + krow;
            d[0 * 136] = (bf16)(v.x & 0xffffu); d[1 * 136] = (bf16)(v.x >> 16); d[2 * 136] = (bf16)(v.y & 0xffffu); d[3 * 136] = (bf16)(v.y >> 16);
            d[4 * 136] = (bf16)(v.z & 0xffffu); d[5 * 136] = (bf16)(v.z >> 16); d[6 * 136] = (bf16)(v.w & 0xffffu); d[7 * 136] = (bf16)(v.w >> 16); }
        __syncthreads();
#pragma unroll
        for (int ks = 0; ks < 4; ++ks) {
            const bf16x8 b0 = *(const LAS bf16x8*)(Bs + ((2 * w) * 16 + fr) * 136 + ks * 32 + 8 * fq);
            const bf16x8 b1 = *(const LAS bf16x8*)(Bs + ((2 * w + 1) * 16 + fr) * 136 + ks * 32 + 8 * fq);
#pragma unroll
            for (int mt = 0; mt < 4; ++mt) { const int mrow = m0 + mt * 16 + fr_a; bf16x8 a;
#pragma unroll
                for (int j = 0; j < 8; ++j) { const int k = ks * 32 + 8 * fq + j, tl = k >> 1, ri = k & 1; const int idx = ((kc * 64 + tl) * mrow) & (NDIV - 1);
                    float sn, cs; sincos_turns((float)idx * (1.f / (float)NDIV), sn, cs);
                    a[j] = (short)f2bf(ri == 0 ? cs : sgn * sn); }
                acc[mt][0] = MFMA16(a, b0, acc[mt][0]); acc[mt][1] = MFMA16(a, b1, acc[mt][1]); }
        }
    }
#pragma unroll
    for (int mt = 0; mt < 4; ++mt)
#pragma unroll
        for (int reg = 0; reg < 4; ++reg) { const float a = acc[mt][0][reg] * scale, b = acc[mt][1][reg] * scale; acc[mt][0][reg] = a; acc[mt][1][reg] = b;
            float s = a * a + b * b; s += __shfl_xor(s, 1); s += __shfl_xor(s, 2); s += __shfl_xor(s, 4); s += __shfl_xor(s, 8);
            if (fr == 0) red[w * 64 + mt * 16 + 4 * fq + reg] = s; }
    __syncthreads();
    bf16* MA = (bf16*)(ws + WS_H); const float* fg = inptr(I_FOURG) + l * 256;
    const float g0 = fg[(2 * w) * 16 + fr], g1 = fg[(2 * w + 1) * 16 + fr];
#pragma unroll
    for (int mt = 0; mt < 4; ++mt)
#pragma unroll
        for (int reg = 0; reg < 4; ++reg) { const int ml = mt * 16 + 4 * fq + reg; float tot = 0.f;
#pragma unroll
            for (int ww = 0; ww < 8; ++ww) tot += red[ww * 64 + ml];
            const float rs = rsqrtf(tot * (1.f / 256.f) + RMS_EPS);
            bf16* o = MA + (size_t)orow(m0 + ml) * D + 768 + fr;
            o[(2 * w) * 16] = (bf16)f2bf(acc[mt][0][reg] * rs * g0); o[(2 * w + 1) * 16] = (bf16)f2bf(acc[mt][1][reg] * rs * g1); }
    __syncthreads();
}

constexpr size_t WS_LORA = 64 * 1024;
constexpr int LINP = 392;
__device__ __forceinline__ void prep_item(const Frame& F0, int l, int item) {
    const Frame F = phase_frame(F0); unsigned char* const ws = F.ws;
    const bf16* Zs = (const bf16*)(ws + WS_ZS); bf16* STR = (bf16*)(ws + WS_STR);
    LAS bf16* lin = (LAS bf16*)F.lds;
    const int row0 = item * 16, lane = F.lane, fr = lane & 15, fq = lane >> 4, w = F.wave;
    __syncthreads();
    for (int idx = F.tid; idx < 16 * 48; idx += NTHR) { const int t = idx / 48, c8 = idx % 48;
        float v[8]; unpack8(*(const u32x4*)(Zs + (size_t)(row0 + t) * ZW + 1536 + c8 * 8), v);
        if (c8 < 16) {
#pragma unroll
            for (int j = 0; j < 8; ++j) v[j] = tanhf(v[j]); }
        else if (c8 >= 32) {
#pragma unroll
            for (int j = 0; j < 8; ++j) v[j] = sigmoidf_(v[j]); }
        u32x4 o = {pk2(v[0], v[1]), pk2(v[2], v[3]), pk2(v[4], v[5]), pk2(v[6], v[7])};
        *(LAS u32x4*)(lin + t * LINP + c8 * 8) = o; }
    __syncthreads();
    f32x4 acc[5][4];
#pragma unroll
    for (int q = 0; q < 5; ++q)
#pragma unroll
        for (int nt = 0; nt < 4; ++nt) acc[q][nt] = (f32x4){0.f, 0.f, 0.f, 0.f};
    const bf16* WL = (const bf16*)(ws + WS_LORA) + (size_t)l * 512 * 384 + (size_t)(64 * w + fr) * 384 + 8 * fq;
#pragma unroll
    for (int ks = 0; ks < 12; ++ks) { const int q = ks < 8 ? (ks >> 1) : 4;
        const bf16x8 xf = *(const LAS bf16x8*)(lin + fr * LINP + ks * 32 + 8 * fq);
#pragma unroll
        for (int nt = 0; nt < 4; ++nt) { const bf16x8 wf = *(const bf16x8*)(WL + (size_t)nt * 16 * 384 + ks * 32); acc[q][nt] = MFMA16(wf, xf, acc[q][nt]); } }
    const size_t row = row0 + fr; const bf16* zr = Zs + row * ZW; bf16* o = STR + ((size_t)item * 8 + w) * 10240 + fr * 64;
    const float* kkp = inptr(I_KK) + l * DR; const float* kap = inptr(I_KA) + l * DR; const float* dw0 = inptr(I_DW0) + l * 2 * DR; const float* ia0 = inptr(I_IA0) + l * 2 * DR;
    float zk[4][4], kv[4][4]; float ss = 0.f;
#pragma unroll
    for (int nt = 0; nt < 4; ++nt) { const int c0 = 64 * w + 16 * nt + 4 * fq; unpack4(*(const u32x2*)(zr + 512 + c0), zk[nt]); const f32x4 kw = *(const f32x4*)(kkp + c0);
#pragma unroll
        for (int i = 0; i < 4; ++i) { kv[nt][i] = zk[nt][i] * kw[i]; ss += kv[nt][i] * kv[nt][i]; } }
    ss += __shfl_xor(ss, 16); ss += __shfl_xor(ss, 32);
    const float inv = 1.f / fmaxf(sqrtf(ss), 1e-12f);
#pragma unroll
    for (int nt = 0; nt < 4; ++nt) { const int c0 = 64 * w + 16 * nt + 4 * fq, cl = 16 * nt + 4 * fq;
        *(u32x2*)(o + cl) = *(const u32x2*)(zr + c0);
        *(u32x2*)(o + 1024 + cl) = *(const u32x2*)(zr + 1024 + c0);
        float kk[4];
#pragma unroll
        for (int i = 0; i < 4; ++i) kk[i] = kv[nt][i] * inv;
        *(u32x2*)(o + 2048 + cl) = (u32x2){pk2(kk[0], kk[1]), pk2(kk[2], kk[3])};
        *(u32x2*)(o + 3072 + cl) = (u32x2){pk2(acc[4][nt][0], acc[4][nt][1]), pk2(acc[4][nt][2], acc[4][nt][3])};
        const f32x4 ka = *(const f32x4*)(kap + c0);
#pragma unroll
        for (int dn = 0; dn < 2; ++dn) { const f32x4 d0 = *(const f32x4*)(dw0 + dn * DR + c0), i0 = *(const f32x4*)(ia0 + dn * DR + c0); float ep[4], kd[4], bb[4];
#pragma unroll
            for (int i = 0; i < 4; ++i) { const float ew = sigmoidf_(d0[i] + acc[dn][nt][i]) * 0.6065306597126334f; ep[i] = -expm1f(-ew);
                const float a = sigmoidf_(i0[i] + acc[2 + dn][nt][i]); kd[i] = zk[nt][i] * (1.f + (a - 1.f) * ka[i]); bb[i] = kk[i] * a; }
            *(u32x2*)(o + (4 + 3 * dn) * 1024 + cl) = (u32x2){pk2(ep[0], ep[1]), pk2(ep[2], ep[3])};
            *(u32x2*)(o + (5 + 3 * dn) * 1024 + cl) = (u32x2){pk2(kd[0], kd[1]), pk2(kd[2], kd[3])};
            *(u32x2*)(o + (6 + 3 * dn) * 1024 + cl) = (u32x2){pk2(bb[0], bb[1]), pk2(bb[2], bb[3])}; } }
}

__device__ __forceinline__ int scan_rowof(int s, int dir, int b) { if (s < CTXL) { const int tc = dir ? (CTXL - 1 - s) : s; return NLAT + b * CTXL + tc; } const int tt = s - CTXL; const int t = dir ? (SEQ - 1 - tt) : tt; return b * SEQ + t; }
__device__ __forceinline__ void scan_item(const Frame& F0, int item, bool need_ctx) {
    const Frame F = phase_frame(F0); unsigned char* const ws = F.ws;
    const int dir = item & 1, h = (item >> 1) & 7, b = item >> 4;
    const bf16* STR = (const bf16*)(ws + WS_STR); bf16* Y = (bf16*)(ws + WS_Y) + (size_t)dir * NROW * DR;
    const int lane = F.lane, kq = lane & 7, vrow = 8 * F.wave + (lane >> 3);
    float S[8];
#pragma unroll
    for (int j = 0; j < 8; ++j) S[j] = 0.f;
    const int co = h * 64 + kq * 8;
    constexpr int NSTEP = CTXL + SEQ;
#define rowof(s) scan_rowof((s), dir, b)
    for (int s0 = 0; s0 < NSTEP; s0 += 4) {
        u32x4 qkk[4], qe[4], qkd[4], qb[4], qr[4]; unsigned qv[4];
#pragma unroll
        for (int u = 0; u < 4; ++u) { const bf16* base = STR + (size_t)rowof(s0 + u) * STRW;
            qr[u] = *(const u32x4*)(base + co); qkk[u] = *(const u32x4*)(base + 1024 + co);
            qe[u] = *(const u32x4*)(base + 2048 + dir * 1536 + co); qkd[u] = *(const u32x4*)(base + 2048 + dir * 1536 + 512 + co); qb[u] = *(const u32x4*)(base + 2048 + dir * 1536 + 1024 + co);
            qv[u] = base[512 + h * 64 + vrow]; }
#pragma unroll
        for (int u = 0; u < 4; ++u) { float kk[8], e[8], kd[8], bb[8], r[8];
            unpack8(qkk[u], kk); unpack8(qe[u], e); unpack8(qkd[u], kd); unpack8(qb[u], bb); unpack8(qr[u], r);
            const float vv = bf2f(qv[u]);
            float sk = 0.f;
#pragma unroll
            for (int j = 0; j < 8; ++j) sk += S[j] * kk[j];
            sk += __shfl_xor(sk, 1); sk += __shfl_xor(sk, 2); sk += __shfl_xor(sk, 4);
            float y = 0.f;
#pragma unroll
            for (int j = 0; j < 8; ++j) { S[j] = S[j] * (1.f - e[j]) - sk * bb[j] + vv * kd[j]; y += S[j] * r[j]; }
            y += __shfl_xor(y, 1); y += __shfl_xor(y, 2); y += __shfl_xor(y, 4);
            const int s = s0 + u;
            if (kq == 0 && (s >= CTXL || need_ctx)) Y[(size_t)rowof(s) * DR + h * 64 + vrow] = (bf16)f2bf(y); }
    }
#undef rowof
}

__device__ __forceinline__ void readout_pass(const Frame& F0, int l, int nrows) {
    const Frame F = phase_frame(F0); unsigned char* const ws = F.ws;
    const bf16* STR = (const bf16*)(ws + WS_STR); const bf16* Y0 = (const bf16*)(ws + WS_Y); const bf16* Y1 = Y0 + (size_t)NROW * DR; bf16* MA = (bf16*)(ws + WS_H);
    const int lane = F.lane, c = 8 * lane;
    float gw[8], gb[8], rk[8];
    {   const float* gnw = inptr(I_GNW) + l * DR + c; const float* gnb = inptr(I_GNB) + l * DR + c; const float* rkp = inptr(I_RK) + l * DR + c;
        const f32x4 a0 = *(const f32x4*)gnw, a1 = *(const f32x4*)(gnw + 4), b0 = *(const f32x4*)gnb, b1 = *(const f32x4*)(gnb + 4), r0 = *(const f32x4*)rkp, r1 = *(const f32x4*)(rkp + 4);
#pragma unroll
        for (int i = 0; i < 4; ++i) { gw[i] = a0[i]; gw[4 + i] = a1[i]; gb[i] = b0[i]; gb[4 + i] = b1[i]; rk[i] = r0[i]; rk[4 + i] = r1[i]; } }
    for (int row = F.gw; row < nrows; row += F.NGW) { const bf16* sr = STR + ((size_t)(row >> 4) * 8 + (lane >> 3)) * 10240 + (row & 15) * 64 + (lane & 7) * 8;
        float ya[8], yb[8], r[8], v[8], g[8], k0[8], k1[8];
        unpack8(*(const u32x4*)(Y0 + (size_t)row * DR + c), ya); unpack8(*(const u32x4*)(Y1 + (size_t)row * DR + c), yb);
        unpack8(*(const u32x4*)sr, r); unpack8(*(const u32x4*)(sr + 1024), v); unpack8(*(const u32x4*)(sr + 3072), g);
        unpack8(*(const u32x4*)(sr + 5 * 1024), k0); unpack8(*(const u32x4*)(sr + 8 * 1024), k1);
        float s1 = 0.f, s2 = 0.f, sb = 0.f;
#pragma unroll
        for (int i = 0; i < 8; ++i) { ya[i] += yb[i]; s1 += ya[i]; s2 += ya[i] * ya[i]; sb += r[i] * (k0[i] + k1[i]) * rk[i]; }
#pragma unroll
        for (int o = 1; o < 8; o <<= 1) { s1 += __shfl_xor(s1, o); s2 += __shfl_xor(s2, o); sb += __shfl_xor(sb, o); }
        const float mu = s1 * (1.f / 64.f); const float var = fmaxf(s2 * (1.f / 64.f) - mu * mu, 0.f); const float rs = rsqrtf(var + GN_EPS);
        float o8[8];
#pragma unroll
        for (int i = 0; i < 8; ++i) o8[i] = ((ya[i] - mu) * rs * gw[i] + gb[i] + sb * v[i]) * g[i];
        *(u32x4*)(MA + (size_t)row * D + c) = (u32x4){pk2(o8[0], o8[1]), pk2(o8[2], o8[3]), pk2(o8[4], o8[5]), pk2(o8[6], o8[7])};
    }
}
constexpr int BLOB = 16384, SEGCH = 264, NSEG = 2, BLOB_R1_SCANS = 23;
constexpr size_t WS_BLOB1 = 20 * MiB, WS_BLOB2 = 492 * MiB, WS_SCANST = WS_GT;
__device__ __forceinline__ unsigned char* blob_ptr(unsigned char* ws, int scan, int ci) {
    return scan < BLOB_R1_SCANS ? ws + WS_BLOB1 + ((size_t)scan * SEGCH + ci) * BLOB : ws + WS_BLOB2 + ((size_t)(scan - BLOB_R1_SCANS) * SEGCH + ci) * BLOB;
}
typedef short s16x4 __attribute__((ext_vector_type(4)));
__device__ __forceinline__ bf16x8 frag_lo(u32x2 x) { u32x4 t = {x.x, x.y, 0u, 0u}; return __builtin_bit_cast(bf16x8, t); }
__device__ __forceinline__ bf16x8 frag_c(const f32x4& a) { u32x4 t = {pk2(a[0], a[1]), pk2(a[2], a[3]), 0u, 0u}; return __builtin_bit_cast(bf16x8, t); }

struct PreRegs { u32x4 q[12]; };
__device__ __forceinline__ void pre_load(PreRegs& R, unsigned char* ws, int scan, int cs, int lane) {
    const int dir = scan & 1, h = (scan >> 1) & 7, b = scan >> 4; const int rfirst = scan_rowof(16 * cs, dir, b);
    const bf16* blk = (const bf16*)(ws + WS_STR) + ((size_t)(rfirst >> 4) * 8 + h) * 10240 + lane * 8;
    const int so[6] = {0, 1, 2, 4 + 3 * dir, 5 + 3 * dir, 6 + 3 * dir};
#pragma unroll
    for (int i = 0; i < 6; ++i) { R.q[2 * i] = *(const u32x4*)(blk + so[i] * 1024); R.q[2 * i + 1] = *(const u32x4*)(blk + so[i] * 1024 + 512); }
}
template <int PM>
__device__ __forceinline__ void pre_item(const Frame& F, unsigned char* ws, int scan, int cs, unsigned char* blob, PreRegs& PR, int nscan, int ncs) {
    const int dir = scan & 1, h = (scan >> 1) & 7, b = scan >> 4; const int lane = F.lane, fr = lane & 15, fq = lane >> 4;
    LAS unsigned char* L = F.lds + F.wave * 17408;
    LAS bf16* TK = (LAS bf16*)L; LAS bf16* TR = TK + 1024; LAS bf16* TKt = TR + 1024; LAS bf16* TB = TKt + 1024;
    LAS bf16* KTt = TB + 1024; LAS bf16* RTt = KTt + 1024; LAS bf16* Vt = RTt + 1024;
    LAS float* AKB = (LAS float*)(Vt + 1024);
    LAS bf16* AKK = (LAS bf16*)(AKB + 256); LAS bf16* ARK = AKK + 256; LAS bf16* ARB = ARK + 256; LAS bf16* TT = ARB + 256;
    float kh[16], bh[16];
    float pc;
    {   float r_[16], v_[16], kk_[16], lp_[16], kd_[16], bb_[16];
        LAS bf16* stg = TK;
#pragma unroll
        for (int i = 0; i < 6; ++i) { *(LAS u32x4*)(stg + i * 1024 + lane * 8) = PR.q[2 * i]; *(LAS u32x4*)(stg + i * 1024 + 512 + lane * 8) = PR.q[2 * i + 1]; }
        LDS_WAIT(); asm volatile("" ::: "memory");
        if (nscan >= 0) pre_load(PR, ws, nscan, ncs, lane);
#pragma unroll
        for (int t = 0; t < 16; ++t) { const int tm = (dir ? 15 - t : t) * 64 + lane;
            r_[t] = bf2f(stg[tm]); v_[t] = bf2f(stg[1024 + tm]); kk_[t] = bf2f(stg[2048 + tm]); lp_[t] = bf2f(stg[3072 + tm]); kd_[t] = bf2f(stg[4096 + tm]); bb_[t] = bf2f(stg[5120 + tm]); }
        LDS_WAIT(); asm volatile("" ::: "memory");
        float lp = 0.f; u32x4 kt4[2], rt4[2], v4[2];
        unsigned ktp[8], rtp[8], vp[8];
#pragma unroll
        for (int t = 0; t < 16; ++t) { const float pm1 = __expf(lp); lp += __logf(1.f - lp_[t]); lp_[t] = lp; const float p = __expf(lp), ip = __expf(-lp);
            const float kt = kk_[t] * pm1, ktl = kd_[t] * ip, btl = bb_[t] * ip, rt = r_[t] * p;
            TK[t * 64 + lane] = (bf16)f2bf(kt); TR[t * 64 + lane] = (bf16)f2bf(rt); TKt[t * 64 + lane] = (bf16)f2bf(ktl); TB[t * 64 + lane] = (bf16)f2bf(btl);
            if (t & 1) { ktp[t >> 1] |= f2bf(kt) << 16; rtp[t >> 1] |= f2bf(rt) << 16; vp[t >> 1] |= f2bf(v_[t]) << 16; }
            else { ktp[t >> 1] = f2bf(kt); rtp[t >> 1] = f2bf(rt); vp[t >> 1] = f2bf(v_[t]); } }
        kt4[0] = (u32x4){ktp[0], ktp[1], ktp[2], ktp[3]}; kt4[1] = (u32x4){ktp[4], ktp[5], ktp[6], ktp[7]};
        rt4[0] = (u32x4){rtp[0], rtp[1], rtp[2], rtp[3]}; rt4[1] = (u32x4){rtp[4], rtp[5], rtp[6], rtp[7]};
        v4[0] = (u32x4){vp[0], vp[1], vp[2], vp[3]}; v4[1] = (u32x4){vp[4], vp[5], vp[6], vp[7]};
        *(LAS u32x4*)(KTt + lane * 16) = kt4[0]; *(LAS u32x4*)(KTt + lane * 16 + 8) = kt4[1];
        *(LAS u32x4*)(RTt + lane * 16) = rt4[0]; *(LAS u32x4*)(RTt + lane * 16 + 8) = rt4[1];
        *(LAS u32x4*)(Vt + lane * 16) = v4[0]; *(LAS u32x4*)(Vt + lane * 16 + 8) = v4[1];
        pc = __expf(lp);
#pragma unroll
        for (int t = 0; t < 16; ++t) { const float e = __expf(lp - lp_[t]); kh[t] = kd_[t] * e; bh[t] = bb_[t] * e; }
    }
    LDS_WAIT(); asm volatile("" ::: "memory");
    {   f32x4 akb = {0.f, 0.f, 0.f, 0.f}, akk = akb, ark = akb, arb = akb;
#pragma unroll
        for (int s = 0; s < 2; ++s) { const int o = fr * 64 + 32 * s + 8 * fq;
            const bf16x8 fk = *(const LAS bf16x8*)(TK + o), frr = *(const LAS bf16x8*)(TR + o), fkt = *(const LAS bf16x8*)(TKt + o), fb = *(const LAS bf16x8*)(TB + o);
            akb = MFMA16(fk, fb, akb); akk = MFMA16(fk, fkt, akk); ark = MFMA16(frr, fkt, ark); arb = MFMA16(frr, fb, arb); }
#pragma unroll
        for (int reg = 0; reg < 4; ++reg) { const int t = 4 * fq + reg; const bool lo = fr < t, le = fr <= t;
            AKB[t * 16 + fr] = lo ? akb[reg] : 0.f; AKK[t * 16 + fr] = (bf16)f2bf(lo ? akk[reg] : 0.f);
            ARK[t * 16 + fr] = (bf16)f2bf(le ? ark[reg] : 0.f); ARB[t * 16 + fr] = (bf16)f2bf(le ? arb[reg] : 0.f); }
    }
    LDS_WAIT(); asm volatile("" ::: "memory");
    {   float col[16];
#pragma unroll
        for (int t = 0; t < 16; ++t) { float s_ = (t == fr) ? 1.f : 0.f;
            if (t > 0) { const f32x4 n0 = *(const LAS f32x4*)(AKB + t * 16), n1 = *(const LAS f32x4*)(AKB + t * 16 + 4), n2 = *(const LAS f32x4*)(AKB + t * 16 + 8), n3 = *(const LAS f32x4*)(AKB + t * 16 + 12);
                const float nn[16] = {n0[0], n0[1], n0[2], n0[3], n1[0], n1[1], n1[2], n1[3], n2[0], n2[1], n2[2], n2[3], n3[0], n3[1], n3[2], n3[3]};
#pragma unroll
                for (int i = 0; i < 16; ++i) if (i < t) s_ -= nn[i] * col[i]; }
            col[t] = s_; TT[t * 16 + fr] = (bf16)f2bf(s_); }
    }
    LDS_WAIT(); asm volatile("" ::: "memory");
    f32x4 Wc[4], Rqc[4], U0c[4], Y0c[4];
    {   const bf16x8 aT = frag_lo(*(const LAS u32x2*)(TT + fr * 16 + 4 * fq)), aKK = frag_lo(*(const LAS u32x2*)(AKK + fr * 16 + 4 * fq)), aRK = frag_lo(*(const LAS u32x2*)(ARK + fr * 16 + 4 * fq));
        u32x2 nb = *(const LAS u32x2*)(ARB + fr * 16 + 4 * fq); nb.x ^= 0x80008000u; nb.y ^= 0x80008000u; const bf16x8 aRBn = frag_lo(nb);
        const f32x4 z4 = {0.f, 0.f, 0.f, 0.f};
#pragma unroll
        for (int nt = 0; nt < 4; ++nt) { const int o = (16 * nt + fr) * 16 + 4 * fq;
            const bf16x8 bK = frag_lo(*(const LAS u32x2*)(KTt + o)), bV = frag_lo(*(const LAS u32x2*)(Vt + o));
            float ri[4]; unpack4(*(const LAS u32x2*)(RTt + o), ri);
            Wc[nt] = MFMA16(aT, bK, z4); const f32x4 Zn = MFMA16(aKK, bV, z4);
            U0c[nt] = MFMA16(aT, frag_c(Zn), z4);
            Rqc[nt] = MFMA16(aRBn, frag_c(Wc[nt]), ((f32x4){ri[0], ri[1], ri[2], ri[3]}));
            Y0c[nt] = MFMA16(aRK, bV, z4); Y0c[nt] = MFMA16(aRBn, frag_c(U0c[nt]), Y0c[nt]); }
    }
    LDS_WAIT(); asm volatile("" ::: "memory");

#pragma unroll
    for (int nt = 0; nt < 4; ++nt) { const u32x2 vv = *(const LAS u32x2*)(Vt + (16 * nt + fr) * 16 + 4 * fq);
        *(u32x2*)(blob + 8192 + nt * 2048 + 1024 + lane * 8) = vv;
        u32x2 u0 = {pk2(U0c[nt][0], U0c[nt][1]), pk2(U0c[nt][2], U0c[nt][3])}, y0 = {pk2(Y0c[nt][0], Y0c[nt][1]), pk2(Y0c[nt][2], Y0c[nt][3])};
        *(u32x2*)(blob + 8192 + nt * 2048 + lane * 8) = u0; *(u32x2*)(blob + 8192 + nt * 2048 + 512 + lane * 8) = y0;
        *(float*)(blob + 8192 + nt * 2048 + 1536 + lane * 4) = pc; }
    LAS bf16* WT = TK; LAS bf16* RQT = TR; LAS bf16* BHt = TKt; LAS bf16* KHt = TB;
#pragma unroll
    for (int nt = 0; nt < 4; ++nt)
#pragma unroll
        for (int reg = 0; reg < 4; ++reg) { WT[(4 * fq + reg) * 64 + 16 * nt + fr] = (bf16)f2bf(Wc[nt][reg]); RQT[(4 * fq + reg) * 64 + 16 * nt + fr] = (bf16)f2bf(Rqc[nt][reg]); }
    {   u32x4 a, c, d, e;
        a = (u32x4){pk2(bh[0], bh[1]), pk2(bh[2], bh[3]), pk2(bh[4], bh[5]), pk2(bh[6], bh[7])}; c = (u32x4){pk2(bh[8], bh[9]), pk2(bh[10], bh[11]), pk2(bh[12], bh[13]), pk2(bh[14], bh[15])};
        d = (u32x4){pk2(kh[0], kh[1]), pk2(kh[2], kh[3]), pk2(kh[4], kh[5]), pk2(kh[6], kh[7])}; e = (u32x4){pk2(kh[8], kh[9]), pk2(kh[10], kh[11]), pk2(kh[12], kh[13]), pk2(kh[14], kh[15])};
        *(LAS u32x4*)(BHt + lane * 16) = a; *(LAS u32x4*)(BHt + lane * 16 + 8) = c; *(LAS u32x4*)(KHt + lane * 16) = d; *(LAS u32x4*)(KHt + lane * 16 + 8) = e; }
    LDS_WAIT(); asm volatile("" ::: "memory");
#pragma unroll
    for (int s = 0; s < 2; ++s) { const int o = fr * 64 + 32 * s + 4 * fq;
        const u32x2 w0 = *(const LAS u32x2*)(WT + o), w1 = *(const LAS u32x2*)(WT + o + 16), q0 = *(const LAS u32x2*)(RQT + o), q1 = *(const LAS u32x2*)(RQT + o + 16);
        *(u32x4*)(blob + (0 * 2 + s) * 1024 + lane * 16) = (u32x4){w0.x, w0.y, w1.x, w1.y};
        *(u32x4*)(blob + (1 * 2 + s) * 1024 + lane * 16) = (u32x4){q0.x, q0.y, q1.x, q1.y}; }
#pragma unroll
    for (int mt = 0; mt < 4; ++mt) { const int o = (16 * mt + fr) * 16 + 4 * fq; const u32x2 bb = *(const LAS u32x2*)(BHt + o), kk = *(const LAS u32x2*)(KHt + o);
        *(u32x4*)(blob + 4096 + mt * 1024 + lane * 16) = (u32x4){bb.x ^ 0x80008000u, bb.y ^ 0x80008000u, kk.x, kk.y}; }
    LDS_WAIT(); asm volatile("" ::: "memory");
}

__device__ __forceinline__ void pre_phase(const Frame& F0, int seg) {
    const Frame F = phase_frame(F0); unsigned char* const ws = F.ws;
    PreRegs R;
    int it = F.gw; if (it >= 32 * SEGCH) return;
    pre_load(R, ws, it & 31, seg * SEGCH + (it >> 5), F.lane);
    for (; it < 32 * SEGCH; it += F.NGW) { const int nx = it + F.NGW; const bool hn = nx < 32 * SEGCH;
        pre_item<0>(F, ws, it & 31, seg * SEGCH + (it >> 5), blob_ptr(ws, it & 31, it >> 5), R, hn ? (nx & 31) : -1, seg * SEGCH + (nx >> 5)); }
}

constexpr int SQ_SLOT = 10240, SQ_R = 12, SQ_D = 8;
template <int MODE>
__device__ __forceinline__ void seq_item(const Frame& F0, int item, int seg, bool need_ctx) {
    const Frame F = phase_frame(F0); unsigned char* const ws = F.ws;
    const int scan = item >> 2, vb = item & 3, dir = scan & 1, h = (scan >> 1) & 7, b = scan >> 4; const int lane = F.lane, fr = lane & 15, fq = lane >> 4, w = F.wave;
    const unsigned char* blob = blob_ptr(ws, scan, 0);
    LAS unsigned char* ring = F.lds;
    __syncthreads();
    const int p0 = 2 * (w - 1);
    const unsigned goff0 = (p0 < 8 ? p0 * 1024 : 8192 + vb * 2048 + (p0 - 8) * 1024) + lane * 16, goff1 = (p0 + 1 < 8 ? (p0 + 1) * 1024 : 8192 + vb * 2048 + (p0 + 1 - 8) * 1024) + lane * 16;
#define SQ_ISSUE(c) do { const unsigned char* g_ = blob + (size_t)(c) * BLOB; LAS unsigned char* s_ = ring + ((c) % SQ_R) * SQ_SLOT + p0 * 1024; \
        __builtin_amdgcn_global_load_lds((const unsigned*)(g_ + goff0), (LAS unsigned*)(s_), 16, 0, 0); \
        __builtin_amdgcn_global_load_lds((const unsigned*)(g_ + goff1), (LAS unsigned*)(s_ + 1024), 16, 0, 0); } while (0)
    const bool loader = (w >= 1 && w <= 5) && MODE != 2;
    if (loader) { for (int c = 0; c < SQ_D; ++c) SQ_ISSUE(c); }
    bf16* Y = (bf16*)(ws + WS_Y) + (size_t)dir * NROW * DR + h * 64 + 16 * vb + fr;
    float* st = (float*)(ws + WS_SCANST) + (size_t)item * 1024 + lane * 4;
    f32x4 M[4];
#pragma unroll
    for (int mt = 0; mt < 4; ++mt) M[mt] = (seg == 0 || w != 0) ? (f32x4){0.f, 0.f, 0.f, 0.f} : *(const f32x4*)(st + mt * 256);
    const f32x4 z4 = {0.f, 0.f, 0.f, 0.f};
    struct SQ { bf16x8 a1[4], a2[4]; f32x4 pc[4]; u32x2 u0, y0, vv; };
#define SQ_READ(R, c) do { const LAS unsigned char* sl_ = ring + ((c) % SQ_R) * SQ_SLOT; _Pragma("unroll") for (int i = 0; i < 4; ++i) { \
        R.a1[i] = *(const LAS bf16x8*)(sl_ + i * 1024 + lane * 16); R.a2[i] = *(const LAS bf16x8*)(sl_ + 4096 + i * 1024 + lane * 16); \
        R.pc[i] = *(const LAS f32x4*)(sl_ + 8192 + 1536 + (16 * i + 4 * fq) * 4); } \
        R.u0 = *(const LAS u32x2*)(sl_ + 8192 + lane * 8); R.y0 = *(const LAS u32x2*)(sl_ + 8192 + 512 + lane * 8); R.vv = *(const LAS u32x2*)(sl_ + 8192 + 1024 + lane * 8); } while (0)
    const long ystep = dir ? -(long)DR : (long)DR;
#define SQ_STEP(R, c) do { const int cs_ = seg * SEGCH + (c); \
        const u32x4 t0 = {pk2(M[0][0], M[0][1]), pk2(M[0][2], M[0][3]), pk2(M[1][0], M[1][1]), pk2(M[1][2], M[1][3])}; \
        const u32x4 t1 = {pk2(M[2][0], M[2][1]), pk2(M[2][2], M[2][3]), pk2(M[3][0], M[3][1]), pk2(M[3][2], M[3][3])}; \
        const bf16x8 b0 = __builtin_bit_cast(bf16x8, t0), b1 = __builtin_bit_cast(bf16x8, t1); \
        f32x4 X0 = MFMA16(R.a1[0], b0, z4); X0 = MFMA16(R.a1[1], b1, X0); \
        f32x4 X1 = MFMA16(R.a1[2], b0, z4); X1 = MFMA16(R.a1[3], b1, X1); \
        float u0[4], y0[4]; unpack4(R.u0, u0); unpack4(R.y0, y0); \
        if (MODE == 0 && (need_ctx || cs_ >= 16)) { bf16* yp = Y + (size_t)scan_rowof(16 * cs_ + 4 * fq, dir, b) * DR; \
            yp[0] = (bf16)f2bf(X1[0] + y0[0]); yp[ystep] = (bf16)f2bf(X1[1] + y0[1]); yp[2 * ystep] = (bf16)f2bf(X1[2] + y0[2]); yp[3 * ystep] = (bf16)f2bf(X1[3] + y0[3]); } \
        const u32x4 tb = {pk2(X0[0] + u0[0], X0[1] + u0[1]), pk2(X0[2] + u0[2], X0[3] + u0[3]), R.vv.x, R.vv.y}; const bf16x8 bB = __builtin_bit_cast(bf16x8, tb); \
        _Pragma("unroll") for (int mt = 0; mt < 4; ++mt) M[mt] = MFMA16(R.a2[mt], bB, R.pc[mt] * M[mt]); } while (0)
#define SQ_LOADER(c) do { if (loader) { if ((c) + SQ_D < SEGCH) { SQ_ISSUE((c) + SQ_D); asm volatile("s_waitcnt vmcnt(14)" ::: "memory"); } else asm volatile("s_waitcnt vmcnt(0)" ::: "memory"); } \
        __builtin_amdgcn_s_barrier(); asm volatile("" ::: "memory"); } while (0)
    SQ Ra, Rb;
    SQ_LOADER(0);
    if (w == 0 && MODE != 1) SQ_READ(Ra, 0);
    for (int c = 0; c < SEGCH; c += 2) {
        SQ_LOADER(c + 1);
        if (w == 0 && MODE != 1) { SQ_STEP(Ra, c); SQ_READ(Rb, c + 1); }
        if (c + 2 < SEGCH) SQ_LOADER(c + 2);
        if (w == 0 && MODE != 1) { SQ_STEP(Rb, c + 1); if (c + 2 < SEGCH) SQ_READ(Ra, c + 2); }
    }
#undef SQ_READ
#undef SQ_STEP
#undef SQ_LOADER
#undef SQ_ISSUE
    if (MODE >= 2 && w == 0 && M[0][0] + M[1][1] + M[2][2] + M[3][3] == 12345.678f) st[0] = M[0][0];
    if (MODE == 0 && w == 0 && seg + 1 < NSEG) {
#pragma unroll
        for (int mt = 0; mt < 4; ++mt) *(f32x4*)(st + mt * 256) = M[mt]; }
    __syncthreads();
}

__device__ __forceinline__ void warm_pass(const Frame& F0, int seg) {
    const Frame F = phase_frame(F0); unsigned char* const ws = F.ws;
    const int hb = blockIdx.x - 128;
    if (hb < 0) return;
    const int x = hb & 7, j = hb >> 3;
    const int nw = 16 * NWAVES, me = j * NWAVES + F.wave; unsigned acc = 0u;
    for (int it = me; it < SEGCH * 64; it += 4 * nw) {
        u32x4 v[4];
#pragma unroll
        for (int u = 0; u < 4; ++u) { const int i2 = it + u * nw; const int ci = i2 >> 6, q = (i2 >> 4) & 3, p = i2 & 15;
            v[u] = (i2 < SEGCH * 64) ? *(const u32x4*)(blob_ptr(ws, x + 8 * q, ci) + p * 1024 + F.lane * 16) : (u32x4){0u, 0u, 0u, 0u}; }
#pragma unroll
        for (int u = 0; u < 4; ++u) acc ^= v[u].x ^ v[u].y ^ v[u].z ^ v[u].w;
    }
    asm volatile("" :: "v"(acc));
}
namespace pg8 {
struct EpiStoreBf16 {
    static constexpr bool PERM = true, AFTER_DRAIN = false;
    bf16_t* O; int ldc; int pn_mask;
    __device__ __forceinline__ void operator()(const f32x4 (&acc)[2][2][4][2], const Unit& u, int wr, int wc, int fr, int fq) const {
        const int row0 = u.pm * BM + wr * 64 + fr; const int col0 = (u.pn & pn_mask) * BM + wc * 32 + 8 * fq;
#pragma unroll
        for (int ai = 0; ai < 2; ++ai)
#pragma unroll
            for (int m = 0; m < 4; ++m) { bf16_t* rowp = O + (size_t)(row0 + ai * HALF + m * 16) * ldc + col0;
#pragma unroll
                for (int bj = 0; bj < 2; ++bj) { const f32x4 v0 = acc[ai][bj][m][0], v1 = acc[ai][bj][m][1];
                    u32x4 w; w.x = cvt_pk_bf16(v0[0], v0[1]); w.y = cvt_pk_bf16(v0[2], v0[3]); w.z = cvt_pk_bf16(v1[0], v1[1]); w.w = cvt_pk_bf16(v1[2], v1[3]);
                    *(u32x4*)(rowp + bj * HALF) = w; } }
    }
};
struct EpiSwiGLU {
    static constexpr bool PERM = true, AFTER_DRAIN = false;
    bf16_t* O;
    __device__ __forceinline__ void operator()(const f32x4 (&acc)[2][2][4][2], const Unit& u, int wr, int wc, int fr, int fq) const {
        const int row0 = u.pm * BM + wr * 64 + fr; const int col0 = ((u.pn & 3) * BM + wc * 32 + 8 * fq) >> 1;
#pragma unroll
        for (int ai = 0; ai < 2; ++ai)
#pragma unroll
            for (int m = 0; m < 4; ++m) { bf16_t* rowp = O + (size_t)(row0 + ai * HALF + m * 16) * 512 + col0;
#pragma unroll
                for (int bj = 0; bj < 2; ++bj) { const f32x4 g = acc[ai][bj][m][0], up = acc[ai][bj][m][1]; float a[4];
#pragma unroll
                    for (int i = 0; i < 4; ++i) a[i] = g[i] / (1.f + __expf(-g[i])) * up[i];
                    unsigned long long w = (unsigned long long)cvt_pk_bf16(a[0], a[1]) | ((unsigned long long)cvt_pk_bf16(a[2], a[3]) << 32);
                    *(unsigned long long*)(rowp + bj * (HALF / 2)) = w; } }
    }
};
struct EpiResidual {
    static constexpr bool PERM = false, AFTER_DRAIN = false;
    const float* xlat; const float* xctx;
    float* out; const float* g1;
    __device__ __forceinline__ void operator()(const f32x4 (&acc)[2][2][4][2], const Unit& u, int wr, int wc, int fr, int fq) const {
        const int rowt = u.pm * BM; const int mr = rowt < 16384 ? (rowt >> 13) : 2;
        const float* base = rowt < 16384 ? xlat + (size_t)rowt * 1024 : xctx + (size_t)(rowt - 16384) * 1024;
        const int col0 = u.pn * BM + wc * 32 + 4 * fq;
        f32x4 gv[2][2];
#pragma unroll
        for (int bj = 0; bj < 2; ++bj)
#pragma unroll
            for (int n = 0; n < 2; ++n) gv[bj][n] = *(const f32x4*)(g1 + (size_t)mr * 6144 + col0 + bj * HALF + n * 16);
#pragma unroll
        for (int ai = 0; ai < 2; ++ai)
#pragma unroll
            for (int m = 0; m < 4; ++m) { const int rl = ai * HALF + wr * 64 + m * 16 + fr;
#pragma unroll
                for (int bj = 0; bj < 2; ++bj)
#pragma unroll
                    for (int n = 0; n < 2; ++n) { const size_t off = (size_t)rl * 1024 + col0 + bj * HALF + n * 16;
                        const f32x4 xo = *(const f32x4*)(base + off);
                        *(f32x4*)(out + (size_t)rowt * 1024 + off) = xo + gv[bj][n] * acc[ai][bj][m][n]; } }
    }
};
struct MoeOrder {
    const int* tile_e; int ntiles, G, c;
    __device__ bool next(int i, Unit& u) const { const long L = (long)i * G + c; if (L >= 4L * ntiles) return false; const int pm = (int)(L >> 2); u.pm = pm; u.pn = tile_e[pm] * 4 + (int)(L & 3); return true; }
    __device__ __forceinline__ void a_ready(const Unit&) const {}
    __device__ __forceinline__ void done(const Unit&) const {}
};
}

__device__ __forceinline__ void expert_convert(const Frame& F0, int l) {
    const Frame F = phase_frame(F0); unsigned char* const ws = F.ws;
    LAS float* scr = (LAS float*)(F.lds + F.wave * 16384);
    bf16* wgu = (bf16*)(ws + WS_WGU_T); bf16* wd = (bf16*)(ws + WS_WD_T);
    constexpr int I_G = 16 * 16, I_D = 8 * 32;
    constexpr int NIT = NEXP * (2 * I_G + I_D);
    const float* p_eg = inptr(I_EG); const float* p_eu = inptr(I_EU); const float* p_ed = inptr(I_ED);
    for (int it = F.gw; it < NIT; it += F.NGW) { const int e = it / (2 * I_G + I_D); int r = it % (2 * I_G + I_D);
        if (r < I_G) { transpose_item(p_eg + ((size_t)l * NEXP + e) * D * DEXP, DEXP, (r >> 4) * 64, (r & 15) * 32, wgu, D, RmGU{e * 1024}, scr, F.lane); continue; } r -= I_G;
        if (r < I_G) { transpose_item(p_eu + ((size_t)l * NEXP + e) * D * DEXP, DEXP, (r >> 4) * 64, (r & 15) * 32, wgu, D, RmGU{e * 1024 + 4}, scr, F.lane); continue; } r -= I_G;
        transpose_item(p_ed + ((size_t)l * NEXP + e) * DEXP * D, D, (r >> 5) * 64, (r & 31) * 32, wd, DEXP, RmId{e * 1024}, scr, F.lane);
    }
}

__device__ __forceinline__ void router_pass(const Frame& F0, int l, int nrows) {
    const Frame F = phase_frame(F0); unsigned char* const ws = F.ws;
    constexpr int HP = 1028;
    LAS float* msh = (LAS float*)F.lds; LAS float* msc = msh + 3072; LAS float* hrow = msc + 3072;
    LAS float* part = hrow + 16 * HP;
    LAS float* lgs = part + 8 * 16 * 48;
    __syncthreads();
    mod_to_lds(F, l, 3, msh, false); mod_to_lds(F, l, 4, msc, false); __syncthreads();
    const float* X = (const float*)(ws + WS_X); bf16* H = (bf16*)(ws + WS_H);
    const float* rgw = inptr(I_RGW) + (size_t)l * D * 4; const float* rew = inptr(I_REW) + (size_t)l * D * NEXP;
    const float* rgb = inptr(I_RGB) + l * 4; const float* reb = inptr(I_REB) + l * NEXP;
    int* rt_e = (int*)(ws + WS_ROUTE + RT_E); int* rt_pos = (int*)(ws + WS_ROUTE + RT_POS); float* rt_gate = (float*)(ws + WS_ROUTE + RT_GATE);
    unsigned* cnt = (unsigned*)(ws + WS_CTL) + CW_CNT + 64 * l;
    const int lane = F.lane, w = F.wave, fr = lane & 15, fq = lane >> 4; const float* n2g = inptr(I_N2G) + l * D;
    float bw[32][3];
#pragma unroll
    for (int ks = 0; ks < 32; ++ks) { const int k = 128 * w + 4 * ks + fq;
        bw[ks][0] = rew[(size_t)k * 32 + fr]; bw[ks][1] = rew[(size_t)k * 32 + 16 + fr]; bw[ks][2] = fr < 4 ? rgw[(size_t)k * 4 + fr] : 0.f; }
    const int ntiles = nrows >> 4;
    for (int gi = F.vcu; gi < ntiles; gi += F.G) {
#pragma unroll
        for (int rr = 0; rr < 2; ++rr) { const int r = 2 * w + rr, row = gi * 16 + r; f32x4 v[4];
#pragma unroll
            for (int j = 0; j < 4; ++j) v[j] = *(const f32x4*)(X + (size_t)row * D + 4 * lane + 256 * j);
            const int mr = modrow(row);
            norm_mod_row(v, n2g, msc + mr * 1024, msh + mr * 1024, H + (size_t)row * D, lane);
#pragma unroll
            for (int j = 0; j < 4; ++j) *(LAS f32x4*)(hrow + r * HP + 4 * lane + 256 * j) = v[j]; }
        __syncthreads();
        {   f32x4 acc[3] = {{0.f, 0.f, 0.f, 0.f}, {0.f, 0.f, 0.f, 0.f}, {0.f, 0.f, 0.f, 0.f}};
#pragma unroll
            for (int ks = 0; ks < 32; ++ks) { const float a = hrow[fr * HP + 128 * w + 4 * ks + fq];
#pragma unroll
                for (int nt = 0; nt < 3; ++nt) acc[nt] = __builtin_amdgcn_mfma_f32_16x16x4f32(a, bw[ks][nt], acc[nt], 0, 0, 0); }
#pragma unroll
            for (int nt = 0; nt < 3; ++nt)
#pragma unroll
                for (int reg = 0; reg < 4; ++reg) part[(w * 16 + 4 * fq + reg) * 48 + 16 * nt + fr] = acc[nt][reg]; }
        __syncthreads();
        for (int idx = F.tid; idx < 16 * 36; idx += NTHR) { const int r = idx / 36, n = idx % 36; float s_ = 0.f;
#pragma unroll
            for (int ww = 0; ww < 8; ++ww) s_ += part[(ww * 16 + r) * 48 + n];
            if (n < 32) lgs[r * 40 + 4 + n] = s_ + reb[n]; else lgs[r * 40 + n - 32] = s_ + rgb[n - 32]; }
        __syncthreads();
        if (F.tid < 16) { const int rr = gi * 16 + F.tid; const LAS float* lp = lgs + F.tid * 40;
            int grp = 0; float mx = lp[0];
#pragma unroll
            for (int g = 1; g < 4; ++g) if (lp[g] > mx) { mx = lp[g]; grp = g; }
            float den = 0.f;
#pragma unroll
            for (int g = 0; g < 4; ++g) den += __expf(lp[g] - mx);
            const float pg_top = 1.f / den; const LAS float* sel = lp + 4 + grp * 8;
            int i0 = 0; float l0 = sel[0];
#pragma unroll
            for (int q = 1; q < 8; ++q) if (sel[q] > l0) { l0 = sel[q]; i0 = q; }
            int i1 = -1; float l1 = -3.0e38f;
#pragma unroll
            for (int q = 0; q < 8; ++q) if (q != i0 && sel[q] > l1) { l1 = sel[q]; i1 = q; }
            const float e1 = __expf(l1 - l0); const float w0 = pg_top / (1.f + e1), w1 = pg_top * e1 / (1.f + e1);
            const int ea = grp * 8 + i0, eb = grp * 8 + i1;
            const unsigned pa = atomicAdd(cnt + ea, 1u), pb = atomicAdd(cnt + eb, 1u);
            rt_e[2 * rr] = ea; rt_e[2 * rr + 1] = eb; rt_pos[2 * rr] = (int)pa; rt_pos[2 * rr + 1] = (int)pb; rt_gate[2 * rr] = w0; rt_gate[2 * rr + 1] = w1; }
    }
}

__device__ __forceinline__ void gather_pass(const Frame& F0, int l, int nrows) {
    const Frame F = phase_frame(F0); unsigned char* const ws = F.ws;
    LAS int* off = (LAS int*)F.lds;
    const unsigned* cnt = (const unsigned*)(ws + WS_CTL) + CW_CNT + 64 * l;
    int* tile_e = (int*)(ws + WS_ROUTE + RT_TILE); int* ntl = (int*)(ws + WS_ROUTE + RT_NT);
    __syncthreads();
    if (F.tid == 0) { int o = 0;
#pragma nounroll
        for (int e = 0; e < NEXP; ++e) { const int c = (int)__hip_atomic_load(cnt + e, __ATOMIC_RELAXED, __HIP_MEMORY_SCOPE_AGENT); const int nt = (c + 255) >> 8; off[e] = o;
            if (blockIdx.x == 0) {
#pragma nounroll
                for (int t = 0; t < nt; ++t) tile_e[(o >> 8) + t] = e; }
            o += nt << 8; }
        if (blockIdx.x == 0) ntl[0] = o >> 8; }
    __syncthreads();
    const int* rt_e = (const int*)(ws + WS_ROUTE + RT_E); const int* rt_pos = (const int*)(ws + WS_ROUTE + RT_POS); int* rt_slot = (int*)(ws + WS_ROUTE + RT_SLOT);
    const bf16* H = (const bf16*)(ws + WS_H); bf16* Xs = (bf16*)(ws + WS_XS);
    for (int it0 = F.gw * 4; it0 < 2 * nrows; it0 += F.NGW * 4) { int slot[4]; u32x4 a[4], b2[4];
#pragma unroll
        for (int u = 0; u < 4; ++u) { const int it = it0 + u; slot[u] = it < 2 * nrows ? off[rt_e[it]] + rt_pos[it] : -1; }
#pragma unroll
        for (int u = 0; u < 4; ++u) if (slot[u] >= 0) { const u32x4* s = (const u32x4*)(H + (size_t)((it0 + u) >> 1) * D); a[u] = s[F.lane]; b2[u] = s[64 + F.lane]; }
#pragma unroll
        for (int u = 0; u < 4; ++u) if (slot[u] >= 0) { if (F.lane == 0) rt_slot[it0 + u] = slot[u]; u32x4* d = (u32x4*)(Xs + (size_t)slot[u] * D); d[F.lane] = a[u]; d[64 + F.lane] = b2[u]; }
    }
}

__device__ __forceinline__ void combine_pass(const Frame& F0, int l, int nrows) {
    const Frame F = phase_frame(F0); unsigned char* const ws = F.ws;
    LAS float* mg2 = (LAS float*)F.lds; LAS float* msh = mg2 + 3072; LAS float* msc = msh + 3072;
    const bool last = (l == DEPTH - 1);
    __syncthreads();
    mod_to_lds(F, l, 5, mg2, false); if (!last) { mod_to_lds(F, l + 1, 0, msh, false); mod_to_lds(F, l + 1, 1, msc, false); }
    __syncthreads();
    float* X = (float*)(ws + WS_X); bf16* H = (bf16*)(ws + WS_H); const bf16* Ys = (const bf16*)(ws + WS_XS);
    const int* rt_slot = (const int*)(ws + WS_ROUTE + RT_SLOT); const float* rt_gate = (const float*)(ws + WS_ROUTE + RT_GATE);
    const int lane = F.lane; const float* n1g = inptr(I_N1G) + (last ? 0 : (l + 1) * D); const float* fgp = inptr(I_FG);
    for (int row = F.gw; row < nrows; row += F.NGW) { const int s0 = rt_slot[2 * row], s1 = rt_slot[2 * row + 1]; const float w0 = rt_gate[2 * row], w1 = rt_gate[2 * row + 1];
        const int mr = modrow(row); f32x4 v[4];
#pragma unroll
        for (int j = 0; j < 4; ++j) { const int c = 4 * lane + 256 * j; float a[4], b[4];
            unpack4(*(const u32x2*)(Ys + (size_t)s0 * D + c), a); unpack4(*(const u32x2*)(Ys + (size_t)s1 * D + c), b);
            const f32x4 g2 = *(const LAS f32x4*)(mg2 + mr * 1024 + c); const f32x4 xo = *(const f32x4*)(X + (size_t)row * D + c);
            f32x4 y; y.x = w0 * a[0] + w1 * b[0]; y.y = w0 * a[1] + w1 * b[1]; y.z = w0 * a[2] + w1 * b[2]; y.w = w0 * a[3] + w1 * b[3];
            v[j] = xo + g2 * y; }
        if (!last) {
#pragma unroll
            for (int j = 0; j < 4; ++j) *(f32x4*)(X + (size_t)row * D + 4 * lane + 256 * j) = v[j];
            norm_mod_row(v, n1g, msc + mr * 1024, msh + mr * 1024, H + (size_t)row * D, lane);
        } else { float s = 0.f;
#pragma unroll
            for (int j = 0; j < 4; ++j) s += (v[j].x * v[j].x + v[j].y * v[j].y) + (v[j].z * v[j].z + v[j].w * v[j].w);
            const float rs = rsqrtf(wave_sum(s) * (1.f / D) + RMS_EPS);
#pragma unroll
            for (int j = 0; j < 4; ++j) { const int c = 4 * lane + 256 * j; const f32x4 g = *(const f32x4*)(fgp + c); *(f32x4*)(F.out + (size_t)row * D + c) = v[j] * rs * g; } }
    }
}
__global__ void __launch_bounds__(NTHR, 2) fwd_megakernel(Params prm) {
    extern __shared__ __attribute__((aligned(16))) unsigned char lds_raw[];
    Frame F;
    F.lds = (LAS unsigned char*)lds_raw;
    F.tid = threadIdx.x; F.lane = F.tid & 63; F.wave = __builtin_amdgcn_readfirstlane(F.tid >> 6);
    F.G = gridDim.x; { const int bx = blockIdx.x; F.vcu = (F.G % 8 == 0) ? (bx % 8) * (F.G / 8) + bx / 8 : bx; }
    F.gw = F.vcu * NWAVES + F.wave; F.NGW = F.G * NWAVES;
    F.out = prm.out; F.ws = prm.ws;
    for (int u = F.tid; u < (LDS_BYTES - LDSCTL_OFF) / 4; u += NTHR) ((LAS unsigned*)(F.lds + LDSCTL_OFF))[u] = 0u;
    __syncthreads();
    (void)xcd_barrier_post((unsigned*)(F.ws + WS_CTL) + CW_BAR, (volatile LAS unsigned*)(F.lds + MISC_OFF) + 8);
#define GRID_BAR() do { XcdBarrier bar_; bar_.bar = (unsigned*)(opaque(F.ws) + WS_CTL) + CW_BAR; bar_.x = xb_xcc_id(); bar_.st = (volatile LAS unsigned*)(F.lds + MISC_OFF) + 8; xcd_barrier(bar_); } while (0)

#ifndef PHMASK
#define PHMASK 0xffff
#endif
#define PH(k) ((PHMASK >> (k)) & 1)
#ifndef PROBE_MASK
#define PROBE_MASK 0
#endif
#define REP(k) _Pragma("nounroll") for (int rep_ = 0; rep_ < ((PROBE_MASK >> (k)) & 1) + 1; ++rep_)
    if (PH(0)) p0_prologue(F);
#if USE_CG_SYNC
    cg::this_grid().sync();
#else
    GRID_BAR();
#endif
    if (PH(1)) p0b_norm1(F);
    GRID_BAR();

    for (int l = 0; l < DEPTH; ++l) {
        const bool need_ctx = (l == 0); const int nrows = need_ctx ? NROW : NLAT;
#define WSO Fp.ws
        REP(2) {
            const Frame Fp = phase_frame(F); unsigned char* const ws = WSO; bf16* Hb = (bf16*)(ws + WS_H); bf16* Pb = (bf16*)(ws + WS_P);
            pg8::Gemm g{Hb, (const bf16*)(ws + WS_WIN_T) + (size_t)l * NP * D, NROW, NP, D}; pg8::StaticOrder S; S.init(NROW, NP, Fp.G, (int)blockIdx.x);
            pg8::EpiStoreBf16 E{Pb, NP, 0xffff};
            pg8::gemm_phase<pg8::EpiStoreBf16, pg8::StaticOrder, true, true>(F.lds, g, S, E);
        }
        GRID_BAR();
        {
            const Frame Fp = phase_frame(F); unsigned char* const ws = WSO; bf16* Pb = (bf16*)(ws + WS_P);
            REP(14) for (int it = blockIdx.x; it < 256; it += F.G) fftA_item(F, it);
            if (PH(4) && need_ctx) for (int it = blockIdx.x; it < 8; it += F.G) { const int b = it >> 2, m0 = (it & 3) * 64;
                const bf16* src0 = Pb + (size_t)(NLAT + b * CTXL) * NP + COL_FC;
                dft64_item<4, 256>(F, l, m0, -1.f, 1.f / 128.f, [=](int t, int ri) { return src0 + (size_t)t * NP + ri * 256; }, [=](int m) { return NLAT + b * CTXL + m; }); }
            REP(15) shift_pass(F, l);
            REP(16) conv_pass(F, l, nrows);
        }
        GRID_BAR();
        {
            const Frame Fp = phase_frame(F); unsigned char* const ws = WSO;
            REP(11) for (int it = blockIdx.x; it < 256; it += F.G) { const int b = it >> 7, t1p = it & 127;
                const bf16* src0 = (const bf16*)(ws + WS_GT) + (size_t)(b * 128 + t1p) * 64 * 512;
                dft64_item<1, 64>(F, l, 0, 1.f, 0.0013810679320049757f, [=](int t, int ri) { return src0 + (size_t)t * 512 + ri * 256; }, [=](int m) { return b * SEQ + t1p + 128 * m; }); }
            for (int it = blockIdx.x; it < (NROW / 16) * (((PROBE_MASK >> 4) & 1) + 1); it += F.G) prep_item(F, l, it % (NROW / 16));
        }
        GRID_BAR();
        for (int seg = 0; seg < NSEG; ++seg) {
            REP(5) pre_phase(F, seg);
            GRID_BAR();
            if (F.G == 256 && blockIdx.x >= 128) warm_pass(F, seg);
            REP(6) for (int it = blockIdx.x; it < 128; it += F.G) { const int x_ = it & 7, j_ = it >> 3; seq_item<0>(F, ((x_ + 8 * (j_ >> 2)) << 2) | (j_ & 3), seg, need_ctx);
#if SEQ_PROBE
                seq_item<SEQ_PROBE>(F, ((x_ + 8 * (j_ >> 2)) << 2) | (j_ & 3), seg, need_ctx);
#endif
            }
            GRID_BAR();
        }
        REP(7) readout_pass(F, l, nrows);
        GRID_BAR();
        REP(8) if (l == 0 || rep_ == 0) {
            const Frame Fp = phase_frame(F); unsigned char* const ws = WSO; bf16* Hb = (bf16*)(ws + WS_H);
            pg8::Gemm g{Hb, (const bf16*)(ws + WS_WOUT_T) + (size_t)l * D * D, nrows, D, D}; pg8::StaticOrder S; S.init(nrows, D, Fp.G, (int)blockIdx.x);
            const float* X = (const float*)(ws + WS_X);
            pg8::EpiResidual E{l == 0 ? inptr(I_X) : X, l == 0 ? inptr(I_CTX) : X + (size_t)NLAT * D, (float*)(ws + WS_X), (const float*)(ws + WS_MODF) + (size_t)l * 3 * 6144 + 2 * 1024};
            pg8::gemm_phase<pg8::EpiResidual, pg8::StaticOrder, true, true>(F.lds, g, S, E);
        }
        GRID_BAR();
        REP(9) expert_convert(F, l);
        if (PH(12)) router_pass(F, l, nrows);
        GRID_BAR();
        REP(10) gather_pass(F, l, nrows);
        GRID_BAR();
        if (PH(14)) {
            const Frame Fp = phase_frame(F); unsigned char* const ws = WSO;
            const int* tile_e = (const int*)(ws + WS_ROUTE + RT_TILE); const int ntiles = *(const int*)(ws + WS_ROUTE + RT_NT);
            pg8::MoeOrder S{tile_e, ntiles, Fp.G, (int)blockIdx.x};
            REP(12) {   pg8::Gemm g{(const bf16*)(ws + WS_XS), (const bf16*)(ws + WS_WGU_T), 0, 0, D};
                pg8::EpiSwiGLU E{(bf16*)(ws + WS_ACT)};
                pg8::gemm_phase<pg8::EpiSwiGLU, pg8::MoeOrder, true, true>(F.lds, g, S, E); }
            GRID_BAR();
            REP(13) {   pg8::Gemm g{(const bf16*)(ws + WS_ACT), (const bf16*)(ws + WS_WD_T), 0, 0, DEXP};
                pg8::EpiStoreBf16 E{(bf16*)(ws + WS_XS), D, 3};
                pg8::gemm_phase<pg8::EpiStoreBf16, pg8::MoeOrder, true, true>(F.lds, g, S, E); }
        }
        GRID_BAR();
        if (PH(15)) combine_pass(F, l, nrows);
        if (l + 1 < DEPTH) GRID_BAR();
    }
}

extern "C" void kernel_launch(void* const* d_in, const int* in_sizes, int n_in, void* d_out, int out_size, void* d_ws, size_t ws_size, hipStream_t stream) {
    static int grid = 0;
    if (grid == 0) {
        if (n_in != N_IN || in_sizes[0] != NLAT * D || out_size != NLAT * D || ws_size < WS_END) {
            fprintf(stderr, "kernel_launch: unexpected shapes (n_in %d in0 %d out %d ws %zu)\n", n_in, n_in > 0 ? in_sizes[0] : -1, out_size, ws_size); grid = -1; return; }
        int dev = 0, cus = 0, per_cu = 0;
        hipGetDevice(&dev); hipDeviceGetAttribute(&cus, hipDeviceAttributeMultiprocessorCount, dev);
        hipFuncSetAttribute((const void*)fwd_megakernel, hipFuncAttributeMaxDynamicSharedMemorySize, LDS_BYTES);
        hipOccupancyMaxActiveBlocksPerMultiprocessor(&per_cu, (const void*)fwd_megakernel, NTHR, LDS_BYTES);
        if (per_cu < 1) { fprintf(stderr, "kernel_launch: occupancy query says %d blocks per CU\n", per_cu); per_cu = 1; }
        (void)hipGetLastError();
        grid = cus * per_cu;
    }
    if (grid < 0) return;
    hipMemsetAsync((char*)d_ws + WS_CTL, 0, CTL_ZERO_BYTES, stream);
    Params p{};
    for (int i = 0; i < N_IN; ++i) p.in[i] = (const float*)d_in[i];
    p.out = (float*)d_out; p.ws = (unsigned char*)d_ws;
    void* args[] = {&p};
    hipError_t e = hipLaunchCooperativeKernel((const void*)fwd_megakernel, dim3(grid), dim3(NTHR), args, LDS_BYTES, stream);
    if (e != hipSuccess) fprintf(stderr, "kernel_launch: cooperative launch failed: %s (grid %d)\n", hipGetErrorString(e), grid);
}
```

```cpp
#include <hip/hip_runtime.h>
#include <hip/hip_cooperative_groups.h>
#include <cstdio>
#include <cstdint>
namespace cg = cooperative_groups;
#ifndef USE_CG_SYNC
#define USE_CG_SYNC 0
#endif
#define SEQ_PROBE 0
#define PRE_PROBE 0
#ifndef PROBE_MASK
#define PROBE_MASK 0
#endif
namespace pg8 {
#define PG8_LAS __attribute__((address_space(3)))
typedef unsigned short bf16_t;
typedef short bf16x8 __attribute__((ext_vector_type(8)));
typedef float f32x4 __attribute__((ext_vector_type(4)));
typedef unsigned u32x4 __attribute__((ext_vector_type(4)));
constexpr int BM = 256, BK = 64, HALF = 128, HTB = HALF * BK * 2  , STAGE_BYTES = 8 * HTB, NXCD = 8, WGM = 8;

__host__ __device__ __forceinline__ int lds_byte(int r, int c) { const int st = (r >> 4) * 2 + (c >> 5), rr = r & 15, cc = c & 31, ob = rr * 64 + cc * 2; return st * 1024 + (ob ^ (((ob >> 9) & 1) << 5)); }
__host__ __device__ __forceinline__ void stage_rc(int b, int& R, int& C) { const int st = b / 1024, sb = b % 1024, swz = sb ^ (((sb >> 9) & 1) << 5); R = (st >> 1) * 16 + swz / 64; C = (st & 1) * 32 + (swz % 64) / 2; }
__host__ __device__ __forceinline__ int perm32(int rho) { const int n = rho >> 4, i = rho & 15; return 8 * (i >> 2) + 4 * n + (i & 3); }

struct Unit { int pm, pn; };
struct Gemm { const bf16_t* A; const bf16_t* Bt; int M, N, K; };

struct StaticOrder {
    int nM, nN, nwg, G, c;
    __host__ __device__ void init(int M, int N, int G_, int c_) { nM = M / BM; nN = N / BM; nwg = nM * nN; G = G_; c = c_; }
    __host__ __device__ bool next(int i, Unit& u) const {
        const long L = (long)i * G + c; if (L >= nwg) return false;
        int wgid = (int)L; { const int q = nwg / NXCD, r = nwg % NXCD, xcd = wgid % NXCD, off = wgid / NXCD; wgid = (xcd < r ? xcd * (q + 1) : r * (q + 1) + (xcd - r) * q) + off; }
        const int nig = WGM * nN, gid = wgid / nig, fm = gid * WGM, gsz = (nM - fm) < WGM ? (nM - fm) : WGM;
        u.pm = fm + ((wgid % nig) % gsz); u.pn = (wgid % nig) / gsz; return true;
    }
    __device__ __forceinline__ void a_ready(const Unit&) const {}
    __device__ __forceinline__ void done(const Unit&) const {}
};

__device__ __forceinline__ unsigned cvt_pk_bf16(float lo, float hi) { unsigned r; asm volatile("v_cvt_pk_bf16_f32 %0, %1, %2" : "=v"(r) : "v"(lo), "v"(hi)); return r; }
typedef float f32x2 __attribute__((ext_vector_type(2)));
template <class Epi, class Sched, bool ALIGN_EPI = false, bool SP2 = false>
__device__ __forceinline__ void gemm_phase(PG8_LAS unsigned char* lds, const Gemm g, const Sched& S, const Epi& E) {
    int tid = threadIdx.x; asm volatile("" : "+v"(tid));
    const int wid = __builtin_amdgcn_readfirstlane(tid >> 6), lane = tid & 63, wr = wid >> 2, wc = wid & 3, fr = lane & 15, fq = lane >> 4;
    const int K = g.K, nt = K / BK;
    unsigned voffA[2], voffB[2];
#pragma unroll
    for (int i = 0; i < 2; ++i) { int R, C; stage_rc(tid * 16 + i * 8192, R, C); const int Rb = Epi::PERM ? ((R & ~31) + perm32(R & 31)) : R;
        voffA[i] = (unsigned)(R * K + C) * 2u; voffB[i] = (unsigned)(Rb * K + C) * 2u; }
    const size_t kstep = (size_t)(BK * 2);
    const size_t hstep = (size_t)HALF * K * 2;
    const size_t tstep = 2 * hstep;
    const unsigned ldsw = (unsigned)wid * 1024u;
    const int aoff = lds_byte(wr * 64 + fr, fq * 8), boff = lds_byte(wc * 32 + fr, fq * 8);
#define PG8_SA(b, h) (((b) * 2 + (h)) * HTB)
#define PG8_SB(b, h) ((4 + (b) * 2 + (h)) * HTB)
#define PG8_STAGE(bufoff, gbase, voff) do { _Pragma("unroll") for (int _i = 0; _i < 2; ++_i) \
        __builtin_amdgcn_global_load_lds((const unsigned*)((const char*)(gbase) + (voff)[_i]), (PG8_LAS unsigned*)(lds + (bufoff) + ldsw + _i * 8192), 16, 0, 0); } while (0)
#define PG8_LDA(dst, b, h) do { _Pragma("unroll") for (int m = 0; m < 4; ++m) _Pragma("unroll") for (int k = 0; k < 2; ++k) dst[m][k] = *(const PG8_LAS bf16x8*)(lds + PG8_SA(b, h) + aoff + m * 2048 + k * 1024); } while (0)
#define PG8_LDB(dst, b, h) do { _Pragma("unroll") for (int n = 0; n < 2; ++n) _Pragma("unroll") for (int k = 0; k < 2; ++k) dst[n][k] = *(const PG8_LAS bf16x8*)(lds + PG8_SB(b, h) + boff + n * 2048 + k * 1024); } while (0)
#define PG8_MMA(ai, bj, At, Bt) do { __builtin_amdgcn_s_setprio(1); _Pragma("unroll") for (int m = 0; m < 4; ++m) _Pragma("unroll") for (int n = 0; n < 2; ++n) _Pragma("unroll") for (int k = 0; k < 2; ++k) \
        acc[ai][bj][m][n] = __builtin_amdgcn_mfma_f32_16x16x32_bf16(Bt[n][k], At[m][k], acc[ai][bj][m][n], 0, 0, 0); __builtin_amdgcn_s_setprio(0); } while (0)
#define PG8_WAIT_V(n) asm volatile("s_waitcnt vmcnt(" #n ")" ::: "memory")
#define PG8_WAIT_L(n) asm volatile("s_waitcnt lgkmcnt(" #n ")" ::: "memory")
#define PG8_BAR __builtin_amdgcn_s_barrier()
#define PG8_SCHED __builtin_amdgcn_sched_barrier(0)
    Unit cur, nxt; int ui = 0;
    if (!S.next(0, cur)) return;
    f32x4 acc[2][2][4][2];
#pragma unroll
    for (int a = 0; a < 2; ++a)
#pragma unroll
        for (int b = 0; b < 2; ++b)
#pragma unroll
            for (int m = 0; m < 4; ++m)
#pragma unroll
                for (int n = 0; n < 2; ++n) acc[a][b][m][n] = (f32x4){0.f, 0.f, 0.f, 0.f};
    bf16x8 At[4][2], B0[2][2], B1[2][2];
    const char* cA = (const char*)g.A + (size_t)cur.pm * tstep; const char* cB = (const char*)g.Bt + (size_t)cur.pn * tstep;
    S.a_ready(cur);
    if constexpr (SP2) {
        PG8_STAGE(PG8_SB(0, 0), cB, voffB); PG8_STAGE(PG8_SB(0, 1), cB + hstep, voffB); PG8_STAGE(PG8_SA(0, 0), cA, voffA); PG8_STAGE(PG8_SA(0, 1), cA + hstep, voffA);
        if (wr == 1) PG8_BAR;
        PG8_WAIT_V(2); PG8_BAR;
        PG8_STAGE(PG8_SB(1, 0), cB + kstep, voffB); PG8_STAGE(PG8_SA(1, 0), cA + kstep, voffA); PG8_STAGE(PG8_SB(1, 1), cB + hstep + kstep, voffB);
        PG8_WAIT_V(6); PG8_BAR;
    } else {
        PG8_STAGE(PG8_SB(0, 0), cB, voffB); PG8_STAGE(PG8_SA(0, 0), cA, voffA); PG8_STAGE(PG8_SB(0, 1), cB + hstep, voffB); PG8_STAGE(PG8_SA(0, 1), cA + hstep, voffA);
        if (wr == 1) PG8_BAR;
        PG8_WAIT_V(4); PG8_BAR;
        PG8_STAGE(PG8_SB(1, 0), cB + kstep, voffB); PG8_STAGE(PG8_SA(1, 0), cA + kstep, voffA); PG8_STAGE(PG8_SB(1, 1), cB + hstep + kstep, voffB);
        PG8_WAIT_V(6); PG8_BAR;
    }
    for (;;) {
        const bool has_next = S.next(ui + 1, nxt);
        const char* nA = has_next ? (const char*)g.A + (size_t)nxt.pm * tstep : cA; const char* nB = has_next ? (const char*)g.Bt + (size_t)nxt.pn * tstep : cB;
        for (int t = 0; t < nt; t += 2) {
            const bool last = (t == nt - 2);
            const char* a1 = cA + (size_t)(t + 1) * kstep;
            const char* a2 = last ? nA : cA + (size_t)(t + 2) * kstep; const char* b2 = last ? nB : cB + (size_t)(t + 2) * kstep;
            const char* a3 = a2 + kstep; const char* b3 = b2 + kstep;
            if (last && has_next) S.a_ready(nxt);
            if constexpr (SP2) {
            PG8_LDB(B0, 0, 0); PG8_LDB(B1, 0, 1); PG8_SCHED; PG8_LDA(At, 0, 0); PG8_STAGE(PG8_SA(1, 1), a1 + hstep, voffA);
            PG8_WAIT_V(8); PG8_WAIT_L(0); PG8_BAR; PG8_MMA(0, 0, At, B0); PG8_MMA(0, 1, At, B1); PG8_BAR; PG8_SCHED;
            PG8_LDA(At, 0, 1); PG8_STAGE(PG8_SB(0, 0), b2, voffB); PG8_STAGE(PG8_SB(0, 1), b2 + hstep, voffB); PG8_STAGE(PG8_SA(0, 0), a2, voffA);
            PG8_WAIT_V(8); PG8_WAIT_L(0); PG8_BAR; PG8_MMA(1, 0, At, B0); PG8_MMA(1, 1, At, B1); PG8_BAR; PG8_SCHED;
            PG8_LDB(B0, 1, 0); PG8_LDB(B1, 1, 1); PG8_SCHED; PG8_LDA(At, 1, 0); PG8_STAGE(PG8_SA(0, 1), a2 + hstep, voffA);
            PG8_WAIT_V(8); PG8_WAIT_L(0); PG8_BAR; PG8_MMA(0, 0, At, B0); PG8_MMA(0, 1, At, B1); PG8_BAR; PG8_SCHED;
            PG8_LDA(At, 1, 1); PG8_STAGE(PG8_SB(1, 0), b3, voffB); PG8_STAGE(PG8_SB(1, 1), b3 + hstep, voffB); PG8_STAGE(PG8_SA(1, 0), a3, voffA);
            PG8_WAIT_V(8); PG8_WAIT_L(0); PG8_BAR; PG8_MMA(1, 0, At, B0); PG8_MMA(1, 1, At, B1); PG8_BAR; PG8_SCHED;
            } else {
            PG8_LDB(B0, 0, 0); PG8_SCHED; PG8_LDA(At, 0, 0); PG8_STAGE(PG8_SA(1, 1), a1 + hstep, voffA);
            PG8_WAIT_L(8); PG8_BAR; PG8_WAIT_L(0); PG8_MMA(0, 0, At, B0); PG8_BAR; PG8_SCHED;
            PG8_LDB(B1, 0, 1); PG8_STAGE(PG8_SB(0, 0), b2, voffB);
            PG8_BAR; PG8_WAIT_L(0); PG8_MMA(0, 1, At, B1); PG8_BAR;
            PG8_LDA(At, 0, 1); PG8_STAGE(PG8_SA(0, 0), a2, voffA);
            PG8_BAR; PG8_WAIT_L(0); PG8_MMA(1, 0, At, B0); PG8_BAR; PG8_SCHED;
            PG8_STAGE(PG8_SB(0, 1), b2 + hstep, voffB);
            PG8_WAIT_V(6); PG8_BAR; PG8_MMA(1, 1, At, B1); PG8_BAR;
            PG8_LDB(B0, 1, 0); PG8_SCHED; PG8_LDA(At, 1, 0); PG8_STAGE(PG8_SA(0, 1), a2 + hstep, voffA);
            PG8_WAIT_L(8); PG8_BAR; PG8_WAIT_L(0); PG8_MMA(0, 0, At, B0); PG8_BAR; PG8_SCHED;
            PG8_LDB(B1, 1, 1); PG8_STAGE(PG8_SB(1, 0), b3, voffB);
            PG8_BAR; PG8_WAIT_L(0); PG8_MMA(0, 1, At, B1); PG8_BAR;
            PG8_LDA(At, 1, 1); PG8_STAGE(PG8_SA(1, 0), a3, voffA);
            PG8_BAR; PG8_WAIT_L(0); PG8_MMA(1, 0, At, B0); PG8_BAR; PG8_SCHED;
            PG8_STAGE(PG8_SB(1, 1), b3 + hstep, voffB);
            PG8_WAIT_V(6); PG8_BAR; PG8_MMA(1, 1, At, B1); PG8_BAR;
            }
        }
        if constexpr (ALIGN_EPI) { if (wr == 0) PG8_BAR; }
        if constexpr (!Epi::AFTER_DRAIN) { E(acc, cur, wr, wc, fr, fq); S.done(cur); }
        if (!has_next) break;
#pragma unroll
        for (int a = 0; a < 2; ++a)
#pragma unroll
            for (int b = 0; b < 2; ++b)
#pragma unroll
                for (int m = 0; m < 4; ++m)
#pragma unroll
                    for (int n = 0; n < 2; ++n) acc[a][b][m][n] = (f32x4){0.f, 0.f, 0.f, 0.f};
        cur = nxt; cA = nA; cB = nB; ++ui;
        if constexpr (ALIGN_EPI) { if (wr == 1) PG8_BAR; }
    }
    PG8_WAIT_V(0);
    if constexpr (!ALIGN_EPI) { if (wr == 0) PG8_BAR; }
    PG8_BAR;
    if constexpr (Epi::AFTER_DRAIN) { E.fused(acc, cur, wr, wc, fr, fq, lds, wid, lane); S.done(cur); }
#undef PG8_SA
#undef PG8_SB
#undef PG8_STAGE
#undef PG8_LDA
#undef PG8_LDB
#undef PG8_MMA
#undef PG8_WAIT_V
#undef PG8_WAIT_L
#undef PG8_BAR
#undef PG8_SCHED
}
}
#define LAS __attribute__((address_space(3)))
typedef unsigned short bf16;
typedef float f32x4 __attribute__((ext_vector_type(4)));
typedef short bf16x8 __attribute__((ext_vector_type(8)));
typedef unsigned u32x4 __attribute__((ext_vector_type(4)));
typedef unsigned u32x2 __attribute__((ext_vector_type(2)));

constexpr int D = 1024, NBATCH = 2, SEQ = 8192, CTXL = 256, DEPTH = 2;
constexpr int NLAT = NBATCH * SEQ, NCTX = NBATCH * CTXL, NROW = NLAT + NCTX;
constexpr int DR = 512, DIN = 2944, NP = 3328, ZW = 1920, NHEAD = 8;
constexpr int COL_CONV = 1920, COL_FC = 2688, COL_FS = 2944;
constexpr int STRW = 5120;
constexpr int NEXP = 32, DEXP = 512;
constexpr int MOE_MAXTILES = 168;
constexpr float RMS_EPS = 1e-6f, GN_EPS = 64e-5f;

enum { I_X = 0, I_C, I_CTX, I_CCTX, I_ADAW, I_ADAB, I_N1G, I_N2G, I_WIN, I_MU, I_DW0, I_DW2, I_IA0, I_IA2, I_GG2, I_KK, I_KA, I_RK, I_GNW, I_GNB,
       I_CONVW, I_CONVG, I_FOURG, I_WOUT, I_RGW, I_RGB, I_REW, I_REB, I_EG, I_EU, I_ED, I_FG, N_IN };

constexpr size_t MiB = 1u << 20;
constexpr size_t WS_CTL = 0, CTL_ZERO_BYTES = 64 * 1024;
constexpr size_t WS_MODP = 1 * MiB;
constexpr size_t WS_MODF = 1 * MiB + 1280 * 1024;
constexpr size_t WS_WIN_T = 3 * MiB;
constexpr size_t WS_WOUT_T = 16 * MiB;
constexpr size_t WS_WGU_T = 20 * MiB;
constexpr size_t WS_WD_T = 84 * MiB;
constexpr size_t WS_X = 116 * MiB;
constexpr size_t WS_H = 182 * MiB;
constexpr size_t WS_ZS = 215 * MiB;
constexpr size_t WS_P = 277 * MiB;
constexpr size_t WS_STR = 277 * MiB;
constexpr size_t WS_Y = 442 * MiB;
constexpr size_t WS_GT = 475 * MiB;
constexpr size_t WS_ROUTE = 491 * MiB;
constexpr size_t WS_XS = 215 * MiB;
constexpr size_t WS_ACT = 299 * MiB;
constexpr size_t WS_END = 530 * MiB;
constexpr size_t RT_E = 0, RT_POS = 1 * 33792 * 4, RT_GATE = 2 * 33792 * 4, RT_SLOT = 3 * 33792 * 4, RT_TILE = 4 * 33792 * 4, RT_NT = RT_TILE + 1024;

constexpr int CW_BAR = 4096;
constexpr int CW_CNT = 8192;

constexpr int NWAVES = 8, NTHR = 512;
constexpr int RING_BYTES = 131072, LDSCTL_OFF = 143360, MISC_OFF = LDSCTL_OFF + 320, LDS_BYTES = 147456;

struct Params { const float* in[N_IN]; float* out; unsigned char* ws; };

__device__ __forceinline__ float bf2f(unsigned h) { return __uint_as_float(h << 16); }
typedef __bf16 hwbf2 __attribute__((ext_vector_type(2)));
typedef float f32x2 __attribute__((ext_vector_type(2)));
__device__ __forceinline__ unsigned pk2(float lo, float hi) { const f32x2 x = {lo, hi}; const hwbf2 r = __builtin_convertvector(x, hwbf2); return __builtin_bit_cast(unsigned, r); }
__device__ __forceinline__ unsigned f2bf(float f) { return pk2(f, 0.f) & 0xffffu; }
__device__ __forceinline__ float wave_sum(float v) {
#pragma unroll
    for (int o = 1; o < 64; o <<= 1) v += __shfl_xor(v, o);
    return v;
}
__device__ __forceinline__ float sigmoidf_(float x) { return 1.f / (1.f + __expf(-x)); }
#define LDS_WAIT() asm volatile("s_waitcnt lgkmcnt(0)" ::: "memory")
#define VM_WAIT() asm volatile("s_waitcnt vmcnt(0)" ::: "memory")

struct Frame {
    LAS unsigned char* lds;
    int tid, lane, wave, vcu, G, gw, NGW;
    float* out; unsigned char* ws;
};
#if defined(__HIP_DEVICE_COMPILE__)
#define ASSUME_GLOBAL(p) do { __builtin_assume(!__builtin_amdgcn_is_shared(p)); __builtin_assume(!__builtin_amdgcn_is_private(p)); } while (0)
#else
#define ASSUME_GLOBAL(p) do { } while (0)
#endif
__device__ __forceinline__ const float* inptr(int i) {
    const volatile unsigned long long __attribute__((address_space(4)))* ka = (const volatile unsigned long long __attribute__((address_space(4)))*)__builtin_amdgcn_kernarg_segment_ptr();
    return (const float*)(const __attribute__((address_space(1))) float*)ka[i];
}
__device__ __forceinline__ unsigned char* opaque(unsigned char* p) { unsigned long z = 0; asm volatile("" : "+s"(z)); return p + z; }
__device__ __forceinline__ Frame phase_frame(const Frame& F0) { Frame F = F0; asm volatile("" : "+v"(F.tid)); F.lane = F.tid & 63; F.ws = opaque(F0.ws);
    asm volatile("" : "+s"(F.G), "+s"(F.vcu)); F.gw = F.vcu * NWAVES + F.wave; F.NGW = F.G * NWAVES; return F; }
__device__ __forceinline__ int modrow(int row) { return row < NLAT ? (row >> 13) : 2; }
#define XB_TMO      128
#define XB_XCNT(j)  (256  + 64 * (j))
#define XB_XSUB(j)  (1280 + 64 * (j))
#define XB_XGEN(j)  (2304 + 64 * (j))
#define XB_TOP      3328
#define XB_TOPGEN   3392
#define XCD_BAR_WORDS 3456
#define XB_SPIN_CAP (1u << 18)

__device__ __forceinline__ unsigned xb_ld(unsigned* p)              { return __hip_atomic_load(p, __ATOMIC_RELAXED, __HIP_MEMORY_SCOPE_AGENT); }
__device__ __forceinline__ unsigned xb_add(unsigned* p, unsigned v) { return __hip_atomic_fetch_add(p, v, __ATOMIC_RELAXED, __HIP_MEMORY_SCOPE_AGENT); }
__device__ __forceinline__ unsigned xb_xcc_id() { return (unsigned)__builtin_amdgcn_s_getreg((3 << 11) | 20) & 0xFu; }
#define XB_SPIN(cond, bar) do { unsigned _sp = 0; while (cond) { __builtin_amdgcn_s_sleep(1); \
    if ((++_sp & 255u) == 0u) { if (xb_ld(&(bar)[XB_TMO])) break; if (_sp > XB_SPIN_CAP) { atomicAdd(&(bar)[XB_TMO], 1u); break; } } } } while (0)

struct XcdBarrier {
    unsigned* bar; unsigned x;
    volatile LAS unsigned* st;
};

__device__ __forceinline__ XcdBarrier xcd_barrier_post(unsigned* bar, volatile LAS unsigned* st) {
    XcdBarrier b; b.bar = bar; b.x = xb_xcc_id(); b.st = st;
    if (threadIdx.x == 0) (void)xb_add(&bar[XB_XCNT(b.x)], 1u);
    return b;
}
__device__ __forceinline__ void xcd_barrier_complete(unsigned* bar, unsigned x, unsigned& nloc, unsigned& nx) {
    const unsigned G = gridDim.x * gridDim.y * gridDim.z;
    unsigned sum, cnt, mine, sp = 0u;
    for (;;) {
        sum = 0u; cnt = 0u; mine = 0u;
#pragma nounroll
        for (unsigned j = 0; j < 16; ++j) { const unsigned c = xb_ld(&bar[XB_XCNT(j)]); sum += c; cnt += (c > 0u) ? 1u : 0u; mine = (j == x) ? c : mine; }
        if (sum == G) break;
        __builtin_amdgcn_s_sleep(1);
        if ((++sp & 255u) == 0u) { if (xb_ld(&bar[XB_TMO])) break; if (sp > XB_SPIN_CAP) { atomicAdd(&bar[XB_TMO], 1u); break; } }
    }
    nloc = mine > 0u ? mine : 1u; nx = cnt > 0u ? cnt : 1u;
}

__device__ __forceinline__ void xcd_barrier(const XcdBarrier& b) {
    asm volatile("s_waitcnt vmcnt(0)" ::: "memory");
    __syncthreads();
    if (threadIdx.x == 0) {
        unsigned* bar = b.bar;
        asm volatile("" : "+s"(bar));
        __builtin_amdgcn_s_waitcnt(0);
        unsigned nloc = b.st[0], nx = b.st[1];
        if (nloc == 0u) { xcd_barrier_complete(bar, b.x, nloc, nx); b.st[0] = nloc; b.st[1] = nx; }
        const unsigned old = xb_add(&bar[XB_XSUB(b.x)], 1u);
        const unsigned gen = old / nloc;
        if (old + 1u == (gen + 1u) * nloc) {
            __builtin_amdgcn_fence(__ATOMIC_RELEASE, "agent");
            asm volatile("s_waitcnt vmcnt(0)" ::: "memory");
            const unsigned og = xb_add(&bar[XB_TOP], 1u);
            const unsigned tg = og / nx;
            if (og + 1u == (tg + 1u) * nx) xb_add(&bar[XB_TOPGEN], 1u);
            else XB_SPIN(xb_ld(&bar[XB_TOPGEN]) == tg, bar);
            __builtin_amdgcn_fence(__ATOMIC_ACQUIRE, "agent");
            xb_add(&bar[XB_XGEN(b.x)], 1u);
            asm volatile("s_waitcnt vmcnt(0)" ::: "memory");
        } else {
            XB_SPIN(xb_ld(&bar[XB_XGEN(b.x)]) == gen, bar);
            __builtin_amdgcn_fence(__ATOMIC_ACQUIRE, "agent");
            asm volatile("s_waitcnt vmcnt(0)" ::: "memory");
        }
    }
    __syncthreads();
}
template <class RowMap>
__device__ __forceinline__ void transpose_item(const float* W, int ldw, int k0, int n0, bf16* WT, int ldt, RowMap rm, LAS float* scr, int lane) {
    (void)scr;
    const int nq = lane & 7, kg = lane >> 3; const float* src = W + (size_t)(k0 + 8 * kg) * ldw + n0 + 4 * nq;
    f32x4 v[8];
#pragma unroll
    for (int i = 0; i < 8; ++i) v[i] = *(const f32x4*)(src + (size_t)i * ldw);
#pragma unroll
    for (int j = 0; j < 4; ++j) { u32x4 o = {pk2(v[0][j], v[1][j]), pk2(v[2][j], v[3][j]), pk2(v[4][j], v[5][j]), pk2(v[6][j], v[7][j])};
        *(u32x4*)(WT + (size_t)rm(n0 + 4 * nq + j) * ldt + k0 + 8 * kg) = o; }
}
struct RmId { int off; __device__ __forceinline__ int operator()(int n) const { return off + n; } };
struct RmGU { int off; __device__ __forceinline__ int operator()(int n) const { return off + ((n >> 2) << 3) + (n & 3); } };

__device__ __forceinline__ void p0_prologue(const Frame& F0) {
    const Frame F = phase_frame(F0); unsigned char* const ws = F.ws;
    LAS float* scr = (LAS float*)(F.lds + F.wave * 16384);
    LAS float* ctab = (LAS float*)(F.lds + 8 * 16384);
    if (F.tid < 64) ctab[F.tid] = cosf((float)F.tid * (6.283185307179586f / 64.f));
    __syncthreads();
    bf16* win_t = (bf16*)(ws + WS_WIN_T); bf16* wout_t = (bf16*)(ws + WS_WOUT_T);
    constexpr int I_WIN_L = 16 * 84, I_WOUT_L = 16 * 32, I_FOLD_L = 4 * 64, I_MOD_L = 96 * 8;
    constexpr int NIT = 2 * (I_WIN_L + I_WOUT_L + I_FOLD_L + I_MOD_L);
    const float* p_win = inptr(I_WIN); const float* p_wout = inptr(I_WOUT); const float* p_c = inptr(I_C); const float* p_cctx = inptr(I_CCTX); const float* p_adaw = inptr(I_ADAW);
    {
        bf16* wl = (bf16*)(ws + 64 * 1024); const float* dw2 = inptr(I_DW2); const float* ia2 = inptr(I_IA2); const float* gg2 = inptr(I_GG2);
        for (int idx = F.vcu * NTHR + F.tid; idx < 2 * 384 * 512; idx += F.G * NTHR) { const int c = idx & 511, k = (idx >> 9) % 384, l = idx / (384 * 512);
            float v;
            if (k < 128) v = dw2[((size_t)(l * 2 + (k >> 6)) * 64 + (k & 63)) * DR + c];
            else if (k < 256) v = ia2[((size_t)(l * 2 + ((k - 128) >> 6)) * 64 + (k & 63)) * DR + c];
            else v = gg2[((size_t)l * 128 + (k - 256)) * DR + c];
            wl[((size_t)l * 512 + c) * 384 + k] = (bf16)f2bf(v); } }
    for (int it = F.gw; it < NIT; it += F.NGW) {
        int r = it; const int l = r & 1; r >>= 1;
        if (r < I_WIN_L) { const int kb = r / 84, nb = r % 84;
            transpose_item(p_win + (size_t)l * D * DIN, DIN, kb * 64, nb * 32, win_t + (size_t)l * NP * D, D, RmId{0}, scr, F.lane); continue; }
        r -= I_WIN_L;
        if (r < I_WOUT_L) { const int kb = r / 32, nb = r % 32;
            transpose_item(p_wout + (size_t)l * D * D, D, kb * 64, nb * 32, wout_t + (size_t)l * D * D, D, RmId{0}, scr, F.lane); continue; }
        r -= I_WOUT_L;
        if (r < I_FOLD_L) {
            const int g = r >> 6, k0 = (r & 63) * 16; const float* W = p_win + (size_t)l * D * DIN;
#pragma unroll
            for (int kk = 0; kk < 16; ++kk) scr[kk * 64 + F.lane] = W[(size_t)(k0 + kk) * DIN + 2688 + g * 64 + F.lane];
            LDS_WAIT(); asm volatile("" ::: "memory");
            float ac[16], as[16];
#pragma unroll
            for (int kk = 0; kk < 16; ++kk) { ac[kk] = 0.f; as[kk] = 0.f; }
            for (int c = 0; c < 64; ++c) { const int idx = (c * F.lane) & 63; const float cc = ctab[idx], ss = ctab[(idx - 16) & 63];
#pragma unroll
                for (int kk = 0; kk < 16; ++kk) { const float w = scr[kk * 64 + c]; ac[kk] += w * cc; as[kk] += w * ss; } }
            bf16* oc = win_t + (size_t)l * NP * D + (size_t)(COL_FC + g * 64 + F.lane) * D + k0;
            bf16* os = win_t + (size_t)l * NP * D + (size_t)(COL_FS + g * 64 + F.lane) * D + k0;
            u32x4 a, b;
            a.x = pk2(ac[0], ac[1]); a.y = pk2(ac[2], ac[3]); a.z = pk2(ac[4], ac[5]); a.w = pk2(ac[6], ac[7]);
            b.x = pk2(ac[8], ac[9]); b.y = pk2(ac[10], ac[11]); b.z = pk2(ac[12], ac[13]); b.w = pk2(ac[14], ac[15]);
            *(u32x4*)oc = a; *(u32x4*)(oc + 8) = b;
            a.x = pk2(as[0], as[1]); a.y = pk2(as[2], as[3]); a.z = pk2(as[4], as[5]); a.w = pk2(as[6], as[7]);
            b.x = pk2(as[8], as[9]); b.y = pk2(as[10], as[11]); b.z = pk2(as[12], as[13]); b.w = pk2(as[14], as[15]);
            *(u32x4*)os = a; *(u32x4*)(os + 8) = b;
            LDS_WAIT(); asm volatile("" ::: "memory");
            continue; }
        r -= I_FOLD_L;
        {
            const int cb = r >> 3, ks = r & 7;
#pragma unroll
            for (int q = 0; q < 2; ++q) { const int k = ks * 128 + q * 64 + F.lane;
                const float c0 = p_c[k], c1 = p_c[D + k], c2 = p_cctx[k];
                scr[0 * 128 + q * 64 + F.lane] = c0 * sigmoidf_(c0); scr[1 * 128 + q * 64 + F.lane] = c1 * sigmoidf_(c1); scr[2 * 128 + q * 64 + F.lane] = c2 * sigmoidf_(c2); }
            LDS_WAIT(); asm volatile("" ::: "memory");
            const float* W = p_adaw + (size_t)l * D * 6144 + (size_t)(ks * 128) * 6144 + cb * 64 + F.lane;
            float a0 = 0.f, a1 = 0.f, a2 = 0.f;
#pragma unroll 8
            for (int kk = 0; kk < 128; ++kk) { const float w = W[(size_t)kk * 6144]; a0 += scr[kk] * w; a1 += scr[128 + kk] * w; a2 += scr[256 + kk] * w; }
            float* mp = (float*)(ws + WS_MODP) + (size_t)((l * 8 + ks) * 3) * 6144 + cb * 64 + F.lane;
            mp[0] = a0; mp[6144] = a1; mp[2 * 6144] = a2;
            LDS_WAIT(); asm volatile("" ::: "memory");
        }
    }
}

__device__ __forceinline__ void mod_to_lds(const Frame& F0, int l, int p, LAS float* dst, bool from_partials) {
    const Frame F = phase_frame(F0); unsigned char* const ws = F.ws;
    const float* adab = inptr(I_ADAB);
    for (int idx = F.tid; idx < 3 * 1024; idx += NTHR) { const int r = idx >> 10, n = idx & 1023;
        float v;
        if (from_partials) { v = adab[l * 6144 + p * 1024 + n]; const float* mp = (const float*)(ws + WS_MODP) + (size_t)(l * 8 * 3 + r) * 6144 + p * 1024 + n;
#pragma unroll
            for (int ks = 0; ks < 8; ++ks) v += mp[(size_t)ks * 3 * 6144]; }
        else v = ((const float*)(ws + WS_MODF))[(size_t)(l * 3 + r) * 6144 + p * 1024 + n];
        dst[idx] = v; }
}
__device__ __forceinline__ void mod_finalize(const Frame& F0) {
    const Frame F = phase_frame(F0); unsigned char* const ws = F.ws;
    const float* adab = inptr(I_ADAB);
    for (int idx = F.vcu * NTHR + F.tid; idx < 2 * 3 * 6144; idx += F.G * NTHR) { const int l = idx / (3 * 6144), rem = idx % (3 * 6144), r = rem / 6144, n = rem % 6144;
        float v = adab[l * 6144 + n]; const float* mp = (const float*)(ws + WS_MODP) + (size_t)(l * 8 * 3 + r) * 6144 + n;
#pragma unroll
        for (int ks = 0; ks < 8; ++ks) v += mp[(size_t)ks * 3 * 6144];
        ((float*)(ws + WS_MODF))[idx] = v; }
}


__device__ __forceinline__ void norm_mod_row(f32x4 (&v)[4], const float* gain, const LAS float* sc, const LAS float* sh, bf16* orow, int lane) {
    float s = 0.f;
#pragma unroll
    for (int j = 0; j < 4; ++j) s += (v[j].x * v[j].x + v[j].y * v[j].y) + (v[j].z * v[j].z + v[j].w * v[j].w);
    const float rs = rsqrtf(wave_sum(s) * (1.f / D) + RMS_EPS);
#pragma unroll
    for (int j = 0; j < 4; ++j) { const int c = 4 * lane + 256 * j; const f32x4 g = *(const f32x4*)(gain + c); const f32x4 a = *(const LAS f32x4*)(sc + c), b = *(const LAS f32x4*)(sh + c);
        v[j] = (v[j] * rs) * g * (a + 1.f) + b;
        u32x2 w; w.x = pk2(v[j].x, v[j].y); w.y = pk2(v[j].z, v[j].w); *(u32x2*)(orow + c) = w; }
}

__device__ __forceinline__ void p0b_norm1(const Frame& F0) {
    const Frame F = phase_frame(F0); unsigned char* const ws = F.ws;
    LAS float* msh = (LAS float*)F.lds; LAS float* msc = msh + 3072;
    mod_to_lds(F, 0, 0, msh, true); mod_to_lds(F, 0, 1, msc, true); __syncthreads();
    mod_finalize(F);
    bf16* H = (bf16*)(ws + WS_H); const float* xin = inptr(I_X); const float* cin = inptr(I_CTX); const float* n1g = inptr(I_N1G);
    for (int row0 = F.gw; row0 < NROW; row0 += 2 * F.NGW) { f32x4 v[2][4]; bool ok[2];
#pragma unroll
        for (int u = 0; u < 2; ++u) { const int row = row0 + u * F.NGW; ok[u] = row < NROW; if (ok[u]) { const float* xr = row < NLAT ? xin + (size_t)row * D : cin + (size_t)(row - NLAT) * D;
#pragma unroll
            for (int j = 0; j < 4; ++j) v[u][j] = *(const f32x4*)(xr + 4 * F.lane + 256 * j); } }
#pragma unroll
        for (int u = 0; u < 2; ++u) if (ok[u]) { const int row = row0 + u * F.NGW; const int mr = modrow(row);
            norm_mod_row(v[u], n1g, msc + mr * 1024, msh + mr * 1024, H + (size_t)row * D, F.lane); } }
}
__device__ __forceinline__ void unpack8(const u32x4 w, float (&o)[8]) {
    o[0] = bf2f(w.x & 0xffffu); o[1] = bf2f(w.x >> 16); o[2] = bf2f(w.y & 0xffffu); o[3] = bf2f(w.y >> 16);
    o[4] = bf2f(w.z & 0xffffu); o[5] = bf2f(w.z >> 16); o[6] = bf2f(w.w & 0xffffu); o[7] = bf2f(w.w >> 16);
}
__device__ __forceinline__ void unpack4(const u32x2 w, float (&o)[4]) { o[0] = bf2f(w.x & 0xffffu); o[1] = bf2f(w.x >> 16); o[2] = bf2f(w.y & 0xffffu); o[3] = bf2f(w.y >> 16); }

__device__ __forceinline__ void shift_pass(const Frame& F0, int l) {
    const Frame F = phase_frame(F0); unsigned char* const ws = F.ws;
    const bf16* P = (const bf16*)(ws + WS_P); bf16* Zs = (bf16*)(ws + WS_ZS); const float* mu = inptr(I_MU) + l * ZW;
    const int total = NROW * 240;
    for (int idx = F.vcu * NTHR + F.tid; idx < total; idx += F.G * NTHR) {
        const int row = idx / 240, ck = idx % 240; const bf16* pr = P + (size_t)row * NP + ck * 8;
        const u32x4 zero = {0u, 0u, 0u, 0u};
        float z[8], n0[8], n1[8], n2[8], n3[8], o[8];
        unpack8(*(const u32x4*)pr, z);
        if (row < NLAT) { const int t = row & (SEQ - 1), gr = t >> 6, gc = t & 63;
            unpack8(gc > 0 ? *(const u32x4*)(pr - NP) : zero, n0); unpack8(gc < 63 ? *(const u32x4*)(pr + NP) : zero, n1);
            unpack8(gr > 0 ? *(const u32x4*)(pr - 64 * NP) : zero, n2); unpack8(gr < 127 ? *(const u32x4*)(pr + 64 * NP) : zero, n3);
        } else { const int tc = (row - NLAT) & (CTXL - 1);
            unpack8(tc > 0 ? *(const u32x4*)(pr - NP) : zero, n0); unpack8(tc < CTXL - 1 ? *(const u32x4*)(pr + NP) : zero, n1);
#pragma unroll
            for (int j = 0; j < 8; ++j) { n2[j] = n0[j]; n3[j] = n1[j]; }
        }
        const f32x4 m0 = *(const f32x4*)(mu + ck * 8), m1 = *(const f32x4*)(mu + ck * 8 + 4);
        const float m[8] = {m0.x, m0.y, m0.z, m0.w, m1.x, m1.y, m1.z, m1.w};
#pragma unroll
        for (int j = 0; j < 8; ++j) { const float nb = (j & 3) == 0 ? n0[j] : (j & 3) == 1 ? n1[j] : (j & 3) == 2 ? n2[j] : n3[j]; o[j] = z[j] + (nb - z[j]) * m[j]; }
        u32x4 w; w.x = pk2(o[0], o[1]); w.y = pk2(o[2], o[3]); w.z = pk2(o[4], o[5]); w.w = pk2(o[6], o[7]);
        *(u32x4*)(Zs + (size_t)row * ZW + ck * 8) = w;
    }
}

__device__ __forceinline__ void conv_pass(const Frame& F0, int l, int nrows) {
    const Frame F = phase_frame(F0); unsigned char* const ws = F.ws;
    const bf16* P = (const bf16*)(ws + WS_P); bf16* MA = (bf16*)(ws + WS_H);
    const float* cw = inptr(I_CONVW) + l * 3 * 256; const int c = 4 * F.lane;
    const f32x4 w0 = *(const f32x4*)(cw + c), w1 = *(const f32x4*)(cw + 256 + c), w2 = *(const f32x4*)(cw + 512 + c), gn = *(const f32x4*)(inptr(I_CONVG) + l * 256 + c);
    for (int row0 = F.gw; row0 < nrows; row0 += 2 * F.NGW) {
        u32x2 q[2][7]; bool ok[2]; const u32x2 zero = {0u, 0u};
#pragma unroll
        for (int u = 0; u < 2; ++u) { const int row = row0 + u * F.NGW; ok[u] = row < nrows; if (ok[u]) {
            int t, L; if (row < NLAT) { t = row & (SEQ - 1); L = SEQ; } else { t = (row - NLAT) & (CTXL - 1); L = CTXL; }
            const bf16* pr = P + (size_t)row * NP + COL_CONV + c;
            q[u][0] = *(const u32x2*)pr; q[u][1] = *(const u32x2*)(pr + 256); q[u][2] = *(const u32x2*)(pr + 512);
            q[u][3] = t > 0 ? *(const u32x2*)(pr - NP + 256) : zero; q[u][4] = t > 0 ? *(const u32x2*)(pr - NP + 512) : zero;
            q[u][5] = t < L - 1 ? *(const u32x2*)(pr + NP + 256) : zero; q[u][6] = t < L - 1 ? *(const u32x2*)(pr + NP + 512) : zero; } }
#pragma unroll
        for (int u = 0; u < 2; ++u) if (ok[u]) { const int row = row0 + u * F.NGW;
            float bg[4], cg[4], hh[4], cp[4], hp[4], cn[4], hn[4];
            unpack4(q[u][0], bg); unpack4(q[u][1], cg); unpack4(q[u][2], hh); unpack4(q[u][3], cp); unpack4(q[u][4], hp); unpack4(q[u][5], cn); unpack4(q[u][6], hn);
            const float W0[4] = {w0.x, w0.y, w0.z, w0.w}, W1[4] = {w1.x, w1.y, w1.z, w1.w}, W2[4] = {w2.x, w2.y, w2.z, w2.w}, GN[4] = {gn.x, gn.y, gn.z, gn.w};
            float y[4], s = 0.f;
#pragma unroll
            for (int j = 0; j < 4; ++j) { y[j] = bg[j] * (W0[j] * (cp[j] * hp[j]) + W1[j] * (cg[j] * hh[j]) + W2[j] * (cn[j] * hn[j])); s += y[j] * y[j]; }
            const float rs = rsqrtf(wave_sum(s) * (1.f / 256.f) + RMS_EPS);
            u32x2 o; o.x = pk2(y[0] * rs * GN[0], y[1] * rs * GN[1]); o.y = pk2(y[2] * rs * GN[2], y[3] * rs * GN[3]);
            *(u32x2*)(MA + (size_t)row * D + 512 + c) = o; }
    }
}

__device__ __forceinline__ void sincos_turns(float x, float& s, float& c) { s = __builtin_amdgcn_sinf(x); c = __builtin_amdgcn_cosf(x); }
#define MFMA16(a, b, c) __builtin_amdgcn_mfma_f32_16x16x32_bf16((a), (b), (c), 0, 0, 0)

__device__ __forceinline__ void fftA_item(const Frame& F0, int item) {
    const Frame F = phase_frame(F0); unsigned char* const ws = F.ws;
    const int half = item & 1, t2 = (item >> 1) & 63, b = item >> 7;
    const bf16* P = (const bf16*)(ws + WS_P); bf16* GT = (bf16*)(ws + WS_GT);
    LAS bf16* Bs = (LAS bf16*)F.lds;
    const int lane = F.lane, w = F.wave, fr = lane & 15, fq = lane >> 4;
    __syncthreads();
#pragma unroll
    for (int i = 0; i < 8; ++i) { const int cidx = F.tid + NTHR * i, krow = cidx >> 4, ch8 = cidx & 15, ri = krow >> 7, t1 = krow & 127;
        const u32x4 v = *(const u32x4*)(P + (size_t)(b * SEQ + t1 * 64 + t2) * NP + COL_FC + ri * 256 + half * 128 + ch8 * 8);
        LAS bf16* d = Bs + (ch8 * 8) * 264 + krow;
        d[0 * 264] = (bf16)(v.x & 0xffffu); d[1 * 264] = (bf16)(v.x >> 16); d[2 * 264] = (bf16)(v.y & 0xffffu); d[3 * 264] = (bf16)(v.y >> 16);
        d[4 * 264] = (bf16)(v.z & 0xffffu); d[5 * 264] = (bf16)(v.z >> 16); d[6 * 264] = (bf16)(v.w & 0xffffu); d[7 * 264] = (bf16)(v.w >> 16); }
    __syncthreads();
    f32x4 acc[2][8];
#pragma unroll
    for (int a = 0; a < 2; ++a)
#pragma unroll
        for (int n = 0; n < 8; ++n) acc[a][n] = (f32x4){0.f, 0.f, 0.f, 0.f};
    int t1p_a = 16 * w + fr;
    asm volatile("" : "+v"(t1p_a));
#pragma unroll
    for (int ks = 0; ks < 8; ++ks) {
        bf16x8 ar, ai;
#pragma unroll
        for (int j = 0; j < 8; ++j) { const int k = ks * 32 + 8 * fq + j, ri = k >> 7, t1 = k & 127; const int idx = (t1 * t1p_a) & 127;
            float sn, cs; sincos_turns((float)idx * (1.f / 128.f), sn, cs);
            const float vr = ri == 0 ? cs : -sn, vi = ri == 0 ? -sn : -cs;
            ar[j] = (short)f2bf(vr); ai[j] = (short)f2bf(vi); }
#pragma unroll
        for (int nt = 0; nt < 8; ++nt) { const bf16x8 bfr = *(const LAS bf16x8*)(Bs + (nt * 16 + fr) * 264 + ks * 32 + 8 * fq);
            acc[0][nt] = MFMA16(ar, bfr, acc[0][nt]); acc[1][nt] = MFMA16(ai, bfr, acc[1][nt]); }
    }
#pragma unroll
    for (int reg = 0; reg < 4; ++reg) { const int t1p = 16 * w + 4 * fq + reg; float st, ct; sincos_turns((float)(t2 * t1p) * (1.f / 8192.f), st, ct);
        bf16* g = GT + ((size_t)((b * 128 + t1p) * 64 + t2) * 2) * 256 + half * 128 + fr;
#pragma unroll
        for (int nt = 0; nt < 8; ++nt) { const float gr = acc[0][nt][reg], gi = acc[1][nt][reg];
            g[nt * 16] = (bf16)f2bf(gr * ct + gi * st); g[256 + nt * 16] = (bf16)f2bf(gi * ct - gr * st); } }
}

template <int NKC, int NDIV, class SrcRow, class OutRow>
__device__ __forceinline__ void dft64_item(const Frame& F0, int l, int m0, float sgn, float scale, SrcRow src, OutRow orow) {
    const Frame F = phase_frame(F0); unsigned char* const ws = F.ws;
    LAS bf16* Bs = (LAS bf16*)F.lds;
    LAS float* red = (LAS float*)(F.lds + 256 * 136 * 2);
    const int lane = F.lane, w = F.wave, fr = lane & 15, fq = lane >> 4;
    int fr_a = fr; asm volatile("" : "+v"(fr_a));
    f32x4 acc[4][2];
#pragma unroll
    for (int a = 0; a < 4; ++a) { acc[a][0] = (f32x4){0.f, 0.f, 0.f, 0.f}; acc[a][1] = (f32x4){0.f, 0.f, 0.f, 0.f}; }
    for (int kc = 0; kc < NKC; ++kc) {
        __syncthreads();
#pragma unroll
        for (int i = 0; i < 8; ++i) { const int cidx = F.tid + NTHR * i, krow = cidx >> 5, ch8 = cidx & 31;
            const u32x4 v = *(const u32x4*)(src(kc * 64 + (krow >> 1), krow & 1) + ch8 * 8);
            LAS bf16* d = Bs + (ch8 * 8) * 136 + krow;
            d[0 * 136] = (bf16)(v.x & 0xffffu); d[1 * 136] = (bf16)(v.x >> 16); d[2 * 136] = (bf16)(v.y & 0xffffu); d[3 * 136] = (bf16)(v.y >> 16);
            d[4 * 136] = (bf16)(v.z & 0xffffu); d[5 * 136] = (bf16)(v.z >> 16); d[6 * 136] = (bf16)(v.w & 0xffffu); d[7 * 136] = (bf16)(v.w >> 16); }
        __syncthreads();
#pragma unroll
        for (int ks = 0; ks < 4; ++ks) {
            const bf16x8 b0 = *(const LAS bf16x8*)(Bs + ((2 * w) * 16 + fr) * 136 + ks * 32 + 8 * fq);
            const bf16x8 b1 = *(const LAS bf16x8*)(Bs + ((2 * w + 1) * 16 + fr) * 136 + ks * 32 + 8 * fq);
#pragma unroll
            for (int mt = 0; mt < 4; ++mt) { const int mrow = m0 + mt * 16 + fr_a; bf16x8 a;
#pragma unroll
                for (int j = 0; j < 8; ++j) { const int k = ks * 32 + 8 * fq + j, tl = k >> 1, ri = k & 1; const int idx = ((kc * 64 + tl) * mrow) & (NDIV - 1);
                    float sn, cs; sincos_turns((float)idx * (1.f / (float)NDIV), sn, cs);
                    a[j] = (short)f2bf(ri == 0 ? cs : sgn * sn); }
                acc[mt][0] = MFMA16(a, b0, acc[mt][0]); acc[mt][1] = MFMA16(a, b1, acc[mt][1]); }
        }
    }
#pragma unroll
    for (int mt = 0; mt < 4; ++mt)
#pragma unroll
        for (int reg = 0; reg < 4; ++reg) { const float a = acc[mt][0][reg] * scale, b = acc[mt][1][reg] * scale; acc[mt][0][reg] = a; acc[mt][1][reg] = b;
            float s = a * a + b * b; s += __shfl_xor(s, 1); s += __shfl_xor(s, 2); s += __shfl_xor(s, 4); s += __shfl_xor(s, 8);
            if (fr == 0) red[w * 64 + mt * 16 + 4 * fq + reg] = s; }
    __syncthreads();
    bf16* MA = (bf16*)(ws + WS_H); const float* fg = inptr(I_FOURG) + l * 256;
    const float g0 = fg[(2 * w) * 16 + fr], g1 = fg[(2 * w + 1) * 16 + fr];
#pragma unroll
    for (int mt = 0; mt < 4; ++mt)
#pragma unroll
        for (int reg = 0; reg < 4; ++reg) { const int ml = mt * 16 + 4 * fq + reg; float tot = 0.f;
#pragma unroll
            for (int ww = 0; ww < 8; ++ww) tot += red[ww * 64 + ml];
            const float rs = rsqrtf(tot * (1.f / 256.f) + RMS_EPS);
            bf16* o = MA + (size_t)orow(m0 + ml) * D + 768 + fr;
            o[(2 * w) * 16] = (bf16)f2bf(acc[mt][0][reg] * rs * g0); o[(2 * w + 1) * 16] = (bf16)f2bf(acc[mt][1][reg] * rs * g1); }
    __syncthreads();
}

constexpr size_t WS_LORA = 64 * 1024;
constexpr int LINP = 392;
__device__ __forceinline__ void prep_item(const Frame& F0, int l, int item) {
    const Frame F = phase_frame(F0); unsigned char* const ws = F.ws;
    const bf16* Zs = (const bf16*)(ws + WS_ZS); bf16* STR = (bf16*)(ws + WS_STR);
    LAS bf16* lin = (LAS bf16*)F.lds;
    const int row0 = item * 16, lane = F.lane, fr = lane & 15, fq = lane >> 4, w = F.wave;
    __syncthreads();
    for (int idx = F.tid; idx < 16 * 48; idx += NTHR) { const int t = idx / 48, c8 = idx % 48;
        float v[8]; unpack8(*(const u32x4*)(Zs + (size_t)(row0 + t) * ZW + 1536 + c8 * 8), v);
        if (c8 < 16) {
#pragma unroll
            for (int j = 0; j < 8; ++j) v[j] = tanhf(v[j]); }
        else if (c8 >= 32) {
#pragma unroll
            for (int j = 0; j < 8; ++j) v[j] = sigmoidf_(v[j]); }
        u32x4 o = {pk2(v[0], v[1]), pk2(v[2], v[3]), pk2(v[4], v[5]), pk2(v[6], v[7])};
        *(LAS u32x4*)(lin + t * LINP + c8 * 8) = o; }
    __syncthreads();
    f32x4 acc[5][4];
#pragma unroll
    for (int q = 0; q < 5; ++q)
#pragma unroll
        for (int nt = 0; nt < 4; ++nt) acc[q][nt] = (f32x4){0.f, 0.f, 0.f, 0.f};
    const bf16* WL = (const bf16*)(ws + WS_LORA) + (size_t)l * 512 * 384 + (size_t)(64 * w + fr) * 384 + 8 * fq;
#pragma unroll
    for (int ks = 0; ks < 12; ++ks) { const int q = ks < 8 ? (ks >> 1) : 4;
        const bf16x8 xf = *(const LAS bf16x8*)(lin + fr * LINP + ks * 32 + 8 * fq);
#pragma unroll
        for (int nt = 0; nt < 4; ++nt) { const bf16x8 wf = *(const bf16x8*)(WL + (size_t)nt * 16 * 384 + ks * 32); acc[q][nt] = MFMA16(wf, xf, acc[q][nt]); } }
    const size_t row = row0 + fr; const bf16* zr = Zs + row * ZW;
    bf16* ob = STR + ((size_t)item * 8 + w) * 10240 + lane * 8;
    LAS bf16* stile = (LAS bf16*)(F.lds + 16384) + w * 2 * 1024;
    const float* kkp = inptr(I_KK) + l * DR; const float* kap = inptr(I_KA) + l * DR; const float* dw0 = inptr(I_DW0) + l * 2 * DR; const float* ia0 = inptr(I_IA0) + l * 2 * DR;
    u32x2 zrr[4], zvv[4]; float zk[4][4], kv[4][4]; float ss = 0.f;
#pragma unroll
    for (int nt = 0; nt < 4; ++nt) { const int c0 = 64 * w + 16 * nt + 4 * fq; zrr[nt] = *(const u32x2*)(zr + c0); zvv[nt] = *(const u32x2*)(zr + 1024 + c0);
        unpack4(*(const u32x2*)(zr + 512 + c0), zk[nt]); const f32x4 kw = *(const f32x4*)(kkp + c0);
#pragma unroll
        for (int i = 0; i < 4; ++i) { kv[nt][i] = zk[nt][i] * kw[i]; ss += kv[nt][i] * kv[nt][i]; } }
    ss += __shfl_xor(ss, 16); ss += __shfl_xor(ss, 32);
    const float inv = __builtin_amdgcn_rcpf(fmaxf(sqrtf(ss), 1e-12f));
    u32x2 S[10][4];
#pragma unroll
    for (int nt = 0; nt < 4; ++nt) { const int c0 = 64 * w + 16 * nt + 4 * fq;
        S[0][nt] = zrr[nt]; S[1][nt] = zvv[nt];
        float kk[4];
#pragma unroll
        for (int i = 0; i < 4; ++i) kk[i] = kv[nt][i] * inv;
        S[2][nt] = (u32x2){pk2(kk[0], kk[1]), pk2(kk[2], kk[3])};
        S[3][nt] = (u32x2){pk2(acc[4][nt][0], acc[4][nt][1]), pk2(acc[4][nt][2], acc[4][nt][3])};
        const f32x4 ka = *(const f32x4*)(kap + c0);
#pragma unroll
        for (int dn = 0; dn < 2; ++dn) { const f32x4 d0 = *(const f32x4*)(dw0 + dn * DR + c0), i0 = *(const f32x4*)(ia0 + dn * DR + c0); float ep[4], kd[4], bb[4];
#pragma unroll
            for (int i = 0; i < 4; ++i) { const float ew = __builtin_amdgcn_rcpf(1.f + __expf(-(d0[i] + acc[dn][nt][i]))) * 0.6065306597126334f;
                ep[i] = ew * (1.f + ew * (-0.5f + ew * (0.16666667f + ew * (-0.041666668f + ew * 0.0083333338f))));
                const float a = __builtin_amdgcn_rcpf(1.f + __expf(-(i0[i] + acc[2 + dn][nt][i]))); kd[i] = zk[nt][i] * (1.f + (a - 1.f) * ka[i]); bb[i] = kk[i] * a; }
            S[4 + 3 * dn][nt] = (u32x2){pk2(ep[0], ep[1]), pk2(ep[2], ep[3])}; S[5 + 3 * dn][nt] = (u32x2){pk2(kd[0], kd[1]), pk2(kd[2], kd[3])}; S[6 + 3 * dn][nt] = (u32x2){pk2(bb[0], bb[1]), pk2(bb[2], bb[3])}; } }
#pragma unroll
    for (int s = 0; s < 10; ++s) { LAS bf16* tl = stile + (s & 1) * 1024;
#pragma unroll
        for (int nt = 0; nt < 4; ++nt) *(LAS u32x2*)(tl + fr * 64 + 16 * nt + 4 * fq) = S[s][nt];
        LDS_WAIT(); asm volatile("" ::: "memory");
        const u32x4 o0 = *(const LAS u32x4*)(tl + lane * 8), o1 = *(const LAS u32x4*)(tl + 512 + lane * 8);
        *(u32x4*)(ob + s * 1024) = o0; *(u32x4*)(ob + s * 1024 + 512) = o1; }
    LDS_WAIT(); asm volatile("" ::: "memory");
}

__device__ __forceinline__ int scan_rowof(int s, int dir, int b) { if (s < CTXL) { const int tc = dir ? (CTXL - 1 - s) : s; return NLAT + b * CTXL + tc; } const int tt = s - CTXL; const int t = dir ? (SEQ - 1 - tt) : tt; return b * SEQ + t; }
__device__ __forceinline__ void scan_item(const Frame& F0, int item, bool need_ctx) {
    const Frame F = phase_frame(F0); unsigned char* const ws = F.ws;
    const int dir = item & 1, h = (item >> 1) & 7, b = item >> 4;
    const bf16* STR = (const bf16*)(ws + WS_STR); bf16* Y = (bf16*)(ws + WS_Y) + (size_t)dir * NROW * DR;
    const int lane = F.lane, kq = lane & 7, vrow = 8 * F.wave + (lane >> 3);
    float S[8];
#pragma unroll
    for (int j = 0; j < 8; ++j) S[j] = 0.f;
    const int co = h * 64 + kq * 8;
    constexpr int NSTEP = CTXL + SEQ;
#define rowof(s) scan_rowof((s), dir, b)
    for (int s0 = 0; s0 < NSTEP; s0 += 4) {
        u32x4 qkk[4], qe[4], qkd[4], qb[4], qr[4]; unsigned qv[4];
#pragma unroll
        for (int u = 0; u < 4; ++u) { const bf16* base = STR + (size_t)rowof(s0 + u) * STRW;
            qr[u] = *(const u32x4*)(base + co); qkk[u] = *(const u32x4*)(base + 1024 + co);
            qe[u] = *(const u32x4*)(base + 2048 + dir * 1536 + co); qkd[u] = *(const u32x4*)(base + 2048 + dir * 1536 + 512 + co); qb[u] = *(const u32x4*)(base + 2048 + dir * 1536 + 1024 + co);
            qv[u] = base[512 + h * 64 + vrow]; }
#pragma unroll
        for (int u = 0; u < 4; ++u) { float kk[8], e[8], kd[8], bb[8], r[8];
            unpack8(qkk[u], kk); unpack8(qe[u], e); unpack8(qkd[u], kd); unpack8(qb[u], bb); unpack8(qr[u], r);
            const float vv = bf2f(qv[u]);
            float sk = 0.f;
#pragma unroll
            for (int j = 0; j < 8; ++j) sk += S[j] * kk[j];
            sk += __shfl_xor(sk, 1); sk += __shfl_xor(sk, 2); sk += __shfl_xor(sk, 4);
            float y = 0.f;
#pragma unroll
            for (int j = 0; j < 8; ++j) { S[j] = S[j] * (1.f - e[j]) - sk * bb[j] + vv * kd[j]; y += S[j] * r[j]; }
            y += __shfl_xor(y, 1); y += __shfl_xor(y, 2); y += __shfl_xor(y, 4);
            const int s = s0 + u;
            if (kq == 0 && (s >= CTXL || need_ctx)) Y[(size_t)rowof(s) * DR + h * 64 + vrow] = (bf16)f2bf(y); }
    }
#undef rowof
}

__device__ __forceinline__ void readout_pass(const Frame& F0, int l, int nrows) {
    const Frame F = phase_frame(F0); unsigned char* const ws = F.ws;
    const bf16* STR = (const bf16*)(ws + WS_STR); const bf16* Y0 = (const bf16*)(ws + WS_Y); const bf16* Y1 = Y0 + (size_t)NROW * DR; bf16* MA = (bf16*)(ws + WS_H);
    const int lane = F.lane, c = 8 * lane;
    float gw[8], gb[8], rk[8];
    {   const float* gnw = inptr(I_GNW) + l * DR + c; const float* gnb = inptr(I_GNB) + l * DR + c; const float* rkp = inptr(I_RK) + l * DR + c;
        const f32x4 a0 = *(const f32x4*)gnw, a1 = *(const f32x4*)(gnw + 4), b0 = *(const f32x4*)gnb, b1 = *(const f32x4*)(gnb + 4), r0 = *(const f32x4*)rkp, r1 = *(const f32x4*)(rkp + 4);
#pragma unroll
        for (int i = 0; i < 4; ++i) { gw[i] = a0[i]; gw[4 + i] = a1[i]; gb[i] = b0[i]; gb[4 + i] = b1[i]; rk[i] = r0[i]; rk[4 + i] = r1[i]; } }
    for (int row0 = F.gw; row0 < nrows; row0 += 2 * F.NGW) {
        u32x4 q[2][7]; bool ok[2];
#pragma unroll
        for (int u = 0; u < 2; ++u) { const int row = row0 + u * F.NGW; ok[u] = row < nrows; if (ok[u]) {
            const bf16* sr = STR + ((size_t)(row >> 4) * 8 + (lane >> 3)) * 10240 + (row & 15) * 64 + (lane & 7) * 8;
            q[u][0] = *(const u32x4*)(Y0 + (size_t)row * DR + c); q[u][1] = *(const u32x4*)(Y1 + (size_t)row * DR + c);
            q[u][2] = *(const u32x4*)sr; q[u][3] = *(const u32x4*)(sr + 1024); q[u][4] = *(const u32x4*)(sr + 3072); q[u][5] = *(const u32x4*)(sr + 5 * 1024); q[u][6] = *(const u32x4*)(sr + 8 * 1024); } }
#pragma unroll
        for (int u = 0; u < 2; ++u) if (ok[u]) { const int row = row0 + u * F.NGW;
            float ya[8], yb[8], r[8], v[8], g[8], k0[8], k1[8];
            unpack8(q[u][0], ya); unpack8(q[u][1], yb); unpack8(q[u][2], r); unpack8(q[u][3], v); unpack8(q[u][4], g); unpack8(q[u][5], k0); unpack8(q[u][6], k1);
            float s1 = 0.f, s2 = 0.f, sb = 0.f;
#pragma unroll
            for (int i = 0; i < 8; ++i) { ya[i] += yb[i]; s1 += ya[i]; s2 += ya[i] * ya[i]; sb += r[i] * (k0[i] + k1[i]) * rk[i]; }
#pragma unroll
            for (int o = 1; o < 8; o <<= 1) { s1 += __shfl_xor(s1, o); s2 += __shfl_xor(s2, o); sb += __shfl_xor(sb, o); }
            const float mu = s1 * (1.f / 64.f); const float var = fmaxf(s2 * (1.f / 64.f) - mu * mu, 0.f); const float rs = rsqrtf(var + GN_EPS);
            float o8[8];
#pragma unroll
            for (int i = 0; i < 8; ++i) o8[i] = ((ya[i] - mu) * rs * gw[i] + gb[i] + sb * v[i]) * g[i];
            *(u32x4*)(MA + (size_t)row * D + c) = (u32x4){pk2(o8[0], o8[1]), pk2(o8[2], o8[3]), pk2(o8[4], o8[5]), pk2(o8[6], o8[7])}; }
    }
}
constexpr int BLOB = 16384, SEGCH = 264, NSEG = 2, BLOB_R1_SCANS = 23;
constexpr size_t WS_BLOB1 = 20 * MiB, WS_BLOB2 = 492 * MiB, WS_SCANST = WS_GT;
__device__ __forceinline__ unsigned char* blob_ptr(unsigned char* ws, int scan, int ci) {
    return scan < BLOB_R1_SCANS ? ws + WS_BLOB1 + ((size_t)scan * SEGCH + ci) * BLOB : ws + WS_BLOB2 + ((size_t)(scan - BLOB_R1_SCANS) * SEGCH + ci) * BLOB;
}
typedef short s16x4 __attribute__((ext_vector_type(4)));
__device__ __forceinline__ bf16x8 frag_lo(u32x2 x) { u32x4 t = {x.x, x.y, 0u, 0u}; return __builtin_bit_cast(bf16x8, t); }
__device__ __forceinline__ bf16x8 frag_c(const f32x4& a) { u32x4 t = {pk2(a[0], a[1]), pk2(a[2], a[3]), 0u, 0u}; return __builtin_bit_cast(bf16x8, t); }

struct PreRegs { u32x4 q[12]; };
__device__ __forceinline__ void pre_load(PreRegs& R, unsigned char* ws, int scan, int cs, int lane) {
    const int dir = scan & 1, h = (scan >> 1) & 7, b = scan >> 4; const int rfirst = scan_rowof(16 * cs, dir, b);
    const bf16* blk = (const bf16*)(ws + WS_STR) + ((size_t)(rfirst >> 4) * 8 + h) * 10240 + lane * 8;
    const int so[6] = {0, 1, 2, 4 + 3 * dir, 5 + 3 * dir, 6 + 3 * dir};
#pragma unroll
    for (int i = 0; i < 6; ++i) { R.q[2 * i] = *(const u32x4*)(blk + so[i] * 1024); R.q[2 * i + 1] = *(const u32x4*)(blk + so[i] * 1024 + 512); }
}
template <int PM>
__device__ __forceinline__ void pre_item(const Frame& F, unsigned char* ws, int scan, int cs, unsigned char* blob, PreRegs& PR, int nscan, int ncs) {
    const int dir = scan & 1, h = (scan >> 1) & 7, b = scan >> 4; const int lane = F.lane, fr = lane & 15, fq = lane >> 4;
    LAS unsigned char* L = F.lds + F.wave * 17408;
    LAS bf16* TK = (LAS bf16*)L; LAS bf16* TR = TK + 1024; LAS bf16* TKt = TR + 1024; LAS bf16* TB = TKt + 1024;
    LAS bf16* KTt = TB + 1024; LAS bf16* RTt = KTt + 1024; LAS bf16* Vt = RTt + 1024;
    LAS float* AKB = (LAS float*)(Vt + 1024);
    LAS bf16* AKK = (LAS bf16*)(AKB + 256); LAS bf16* ARK = AKK + 256; LAS bf16* ARB = ARK + 256; LAS bf16* TT = ARB + 256;
    float kh[16], bh[16];
    float pc;
    {   float r_[16], v_[16], kk_[16], lp_[16], kd_[16], bb_[16];
        LAS bf16* stg = TK;
#pragma unroll
        for (int i = 0; i < 6; ++i) { *(LAS u32x4*)(stg + i * 1024 + lane * 8) = PR.q[2 * i]; *(LAS u32x4*)(stg + i * 1024 + 512 + lane * 8) = PR.q[2 * i + 1]; }
        LDS_WAIT(); asm volatile("" ::: "memory");
        if (nscan >= 0) pre_load(PR, ws, nscan, ncs, lane);
#pragma unroll
        for (int t = 0; t < 16; ++t) { const int tm = (dir ? 15 - t : t) * 64 + lane;
            r_[t] = bf2f(stg[tm]); v_[t] = bf2f(stg[1024 + tm]); kk_[t] = bf2f(stg[2048 + tm]); lp_[t] = bf2f(stg[3072 + tm]); kd_[t] = bf2f(stg[4096 + tm]); bb_[t] = bf2f(stg[5120 + tm]); }
        LDS_WAIT(); asm volatile("" ::: "memory");
        float lp = 0.f; u32x4 kt4[2], rt4[2], v4[2];
        unsigned ktp[8], rtp[8], vp[8];
#pragma unroll
        for (int t = 0; t < 16; ++t) { const float pm1 = __expf(lp); lp += __logf(1.f - lp_[t]); lp_[t] = lp; const float p = __expf(lp), ip = __expf(-lp);
            const float kt = kk_[t] * pm1, ktl = kd_[t] * ip, btl = bb_[t] * ip, rt = r_[t] * p;
            TK[t * 64 + lane] = (bf16)f2bf(kt); TR[t * 64 + lane] = (bf16)f2bf(rt); TKt[t * 64 + lane] = (bf16)f2bf(ktl); TB[t * 64 + lane] = (bf16)f2bf(btl);
            if (t & 1) { ktp[t >> 1] |= f2bf(kt) << 16; rtp[t >> 1] |= f2bf(rt) << 16; vp[t >> 1] |= f2bf(v_[t]) << 16; }
            else { ktp[t >> 1] = f2bf(kt); rtp[t >> 1] = f2bf(rt); vp[t >> 1] = f2bf(v_[t]); } }
        kt4[0] = (u32x4){ktp[0], ktp[1], ktp[2], ktp[3]}; kt4[1] = (u32x4){ktp[4], ktp[5], ktp[6], ktp[7]};
        rt4[0] = (u32x4){rtp[0], rtp[1], rtp[2], rtp[3]}; rt4[1] = (u32x4){rtp[4], rtp[5], rtp[6], rtp[7]};
        v4[0] = (u32x4){vp[0], vp[1], vp[2], vp[3]}; v4[1] = (u32x4){vp[4], vp[5], vp[6], vp[7]};
        *(LAS u32x4*)(KTt + lane * 16) = kt4[0]; *(LAS u32x4*)(KTt + lane * 16 + 8) = kt4[1];
        *(LAS u32x4*)(RTt + lane * 16) = rt4[0]; *(LAS u32x4*)(RTt + lane * 16 + 8) = rt4[1];
        *(LAS u32x4*)(Vt + lane * 16) = v4[0]; *(LAS u32x4*)(Vt + lane * 16 + 8) = v4[1];
        pc = __expf(lp);
#pragma unroll
        for (int t = 0; t < 16; ++t) { const float e = __expf(lp - lp_[t]); kh[t] = kd_[t] * e; bh[t] = bb_[t] * e; }
    }
    LDS_WAIT(); asm volatile("" ::: "memory");
    {   f32x4 akb = {0.f, 0.f, 0.f, 0.f}, akk = akb, ark = akb, arb = akb;
#pragma unroll
        for (int s = 0; s < 2; ++s) { const int o = fr * 64 + 32 * s + 8 * fq;
            const bf16x8 fk = *(const LAS bf16x8*)(TK + o), frr = *(const LAS bf16x8*)(TR + o), fkt = *(const LAS bf16x8*)(TKt + o), fb = *(const LAS bf16x8*)(TB + o);
            akb = MFMA16(fk, fb, akb); akk = MFMA16(fk, fkt, akk); ark = MFMA16(frr, fkt, ark); arb = MFMA16(frr, fb, arb); }
#pragma unroll
        for (int reg = 0; reg < 4; ++reg) { const int t = 4 * fq + reg; const bool lo = fr < t, le = fr <= t;
            AKB[t * 16 + fr] = lo ? akb[reg] : 0.f; AKK[t * 16 + fr] = (bf16)f2bf(lo ? akk[reg] : 0.f);
            ARK[t * 16 + fr] = (bf16)f2bf(le ? ark[reg] : 0.f); ARB[t * 16 + fr] = (bf16)f2bf(le ? arb[reg] : 0.f); }
    }
    LDS_WAIT(); asm volatile("" ::: "memory");
    {   float col[16];
#pragma unroll
        for (int t = 0; t < 16; ++t) { float s_ = (t == fr) ? 1.f : 0.f;
            if (t > 0) { const f32x4 n0 = *(const LAS f32x4*)(AKB + t * 16), n1 = *(const LAS f32x4*)(AKB + t * 16 + 4), n2 = *(const LAS f32x4*)(AKB + t * 16 + 8), n3 = *(const LAS f32x4*)(AKB + t * 16 + 12);
                const float nn[16] = {n0[0], n0[1], n0[2], n0[3], n1[0], n1[1], n1[2], n1[3], n2[0], n2[1], n2[2], n2[3], n3[0], n3[1], n3[2], n3[3]};
#pragma unroll
                for (int i = 0; i < 16; ++i) if (i < t) s_ -= nn[i] * col[i]; }
            col[t] = s_; TT[t * 16 + fr] = (bf16)f2bf(s_); }
    }
    LDS_WAIT(); asm volatile("" ::: "memory");
    f32x4 Wc[4], Rqc[4], U0c[4], Y0c[4];
    {   const bf16x8 aT = frag_lo(*(const LAS u32x2*)(TT + fr * 16 + 4 * fq)), aKK = frag_lo(*(const LAS u32x2*)(AKK + fr * 16 + 4 * fq)), aRK = frag_lo(*(const LAS u32x2*)(ARK + fr * 16 + 4 * fq));
        u32x2 nb = *(const LAS u32x2*)(ARB + fr * 16 + 4 * fq); nb.x ^= 0x80008000u; nb.y ^= 0x80008000u; const bf16x8 aRBn = frag_lo(nb);
        const f32x4 z4 = {0.f, 0.f, 0.f, 0.f};
#pragma unroll
        for (int nt = 0; nt < 4; ++nt) { const int o = (16 * nt + fr) * 16 + 4 * fq;
            const bf16x8 bK = frag_lo(*(const LAS u32x2*)(KTt + o)), bV = frag_lo(*(const LAS u32x2*)(Vt + o));
            float ri[4]; unpack4(*(const LAS u32x2*)(RTt + o), ri);
            Wc[nt] = MFMA16(aT, bK, z4); const f32x4 Zn = MFMA16(aKK, bV, z4);
            U0c[nt] = MFMA16(aT, frag_c(Zn), z4);
            Rqc[nt] = MFMA16(aRBn, frag_c(Wc[nt]), ((f32x4){ri[0], ri[1], ri[2], ri[3]}));
            Y0c[nt] = MFMA16(aRK, bV, z4); Y0c[nt] = MFMA16(aRBn, frag_c(U0c[nt]), Y0c[nt]); }
    }
    LDS_WAIT(); asm volatile("" ::: "memory");

#pragma unroll
    for (int nt = 0; nt < 4; ++nt) { const u32x2 vv = *(const LAS u32x2*)(Vt + (16 * nt + fr) * 16 + 4 * fq);
        *(u32x2*)(blob + 8192 + nt * 2048 + 1024 + lane * 8) = vv;
        u32x2 u0 = {pk2(U0c[nt][0], U0c[nt][1]), pk2(U0c[nt][2], U0c[nt][3])}, y0 = {pk2(Y0c[nt][0], Y0c[nt][1]), pk2(Y0c[nt][2], Y0c[nt][3])};
        *(u32x2*)(blob + 8192 + nt * 2048 + lane * 8) = u0; *(u32x2*)(blob + 8192 + nt * 2048 + 512 + lane * 8) = y0;
        *(float*)(blob + 8192 + nt * 2048 + 1536 + lane * 4) = pc; }
    LAS bf16* WT = TK; LAS bf16* RQT = TR; LAS bf16* BHt = TKt; LAS bf16* KHt = TB;
#pragma unroll
    for (int nt = 0; nt < 4; ++nt)
#pragma unroll
        for (int reg = 0; reg < 4; ++reg) { WT[(4 * fq + reg) * 64 + 16 * nt + fr] = (bf16)f2bf(Wc[nt][reg]); RQT[(4 * fq + reg) * 64 + 16 * nt + fr] = (bf16)f2bf(Rqc[nt][reg]); }
    {   u32x4 a, c, d, e;
        a = (u32x4){pk2(bh[0], bh[1]), pk2(bh[2], bh[3]), pk2(bh[4], bh[5]), pk2(bh[6], bh[7])}; c = (u32x4){pk2(bh[8], bh[9]), pk2(bh[10], bh[11]), pk2(bh[12], bh[13]), pk2(bh[14], bh[15])};
        d = (u32x4){pk2(kh[0], kh[1]), pk2(kh[2], kh[3]), pk2(kh[4], kh[5]), pk2(kh[6], kh[7])}; e = (u32x4){pk2(kh[8], kh[9]), pk2(kh[10], kh[11]), pk2(kh[12], kh[13]), pk2(kh[14], kh[15])};
        *(LAS u32x4*)(BHt + lane * 16) = a; *(LAS u32x4*)(BHt + lane * 16 + 8) = c; *(LAS u32x4*)(KHt + lane * 16) = d; *(LAS u32x4*)(KHt + lane * 16 + 8) = e; }
    LDS_WAIT(); asm volatile("" ::: "memory");
#pragma unroll
    for (int s = 0; s < 2; ++s) { const int o = fr * 64 + 32 * s + 4 * fq;
        const u32x2 w0 = *(const LAS u32x2*)(WT + o), w1 = *(const LAS u32x2*)(WT + o + 16), q0 = *(const LAS u32x2*)(RQT + o), q1 = *(const LAS u32x2*)(RQT + o + 16);
        *(u32x4*)(blob + (0 * 2 + s) * 1024 + lane * 16) = (u32x4){w0.x, w0.y, w1.x, w1.y};
        *(u32x4*)(blob + (1 * 2 + s) * 1024 + lane * 16) = (u32x4){q0.x, q0.y, q1.x, q1.y}; }
#pragma unroll
    for (int mt = 0; mt < 4; ++mt) { const int o = (16 * mt + fr) * 16 + 4 * fq; const u32x2 bb = *(const LAS u32x2*)(BHt + o), kk = *(const LAS u32x2*)(KHt + o);
        *(u32x4*)(blob + 4096 + mt * 1024 + lane * 16) = (u32x4){bb.x ^ 0x80008000u, bb.y ^ 0x80008000u, kk.x, kk.y}; }
    LDS_WAIT(); asm volatile("" ::: "memory");
}

__device__ __forceinline__ void pre_phase(const Frame& F0, int seg) {
    const Frame F = phase_frame(F0); unsigned char* const ws = F.ws;
    PreRegs R;
    int it = F.gw; if (it >= 32 * SEGCH) return;
    pre_load(R, ws, it & 31, seg * SEGCH + (it >> 5), F.lane);
    for (; it < 32 * SEGCH; it += F.NGW) { const int nx = it + F.NGW; const bool hn = nx < 32 * SEGCH;
        pre_item<0>(F, ws, it & 31, seg * SEGCH + (it >> 5), blob_ptr(ws, it & 31, it >> 5), R, hn ? (nx & 31) : -1, seg * SEGCH + (nx >> 5)); }
}

constexpr int SQ_SLOT = 10240, SQ_R = 12, SQ_D = 8;
template <int MODE>
__device__ __forceinline__ void seq_item(const Frame& F0, int item, int seg, bool need_ctx) {
    const Frame F = phase_frame(F0); unsigned char* const ws = F.ws;
    const int scan = item >> 2, vb = item & 3, dir = scan & 1, h = (scan >> 1) & 7, b = scan >> 4; const int lane = F.lane, fr = lane & 15, fq = lane >> 4, w = F.wave;
    const unsigned char* blob = blob_ptr(ws, scan, 0);
    LAS unsigned char* ring = F.lds;
    __syncthreads();
    const int p0 = 2 * (w - 1);
    const unsigned goff0 = (p0 < 8 ? p0 * 1024 : 8192 + vb * 2048 + (p0 - 8) * 1024) + lane * 16, goff1 = (p0 + 1 < 8 ? (p0 + 1) * 1024 : 8192 + vb * 2048 + (p0 + 1 - 8) * 1024) + lane * 16;
#define SQ_ISSUE(c) do { const unsigned char* g_ = blob + (size_t)(c) * BLOB; LAS unsigned char* s_ = ring + ((c) % SQ_R) * SQ_SLOT + p0 * 1024; \
        __builtin_amdgcn_global_load_lds((const unsigned*)(g_ + goff0), (LAS unsigned*)(s_), 16, 0, 0); \
        __builtin_amdgcn_global_load_lds((const unsigned*)(g_ + goff1), (LAS unsigned*)(s_ + 1024), 16, 0, 0); } while (0)
    const bool loader = (w >= 1 && w <= 5) && MODE != 2;
    if (loader) { for (int c = 0; c < SQ_D; ++c) SQ_ISSUE(c); }
    bf16* Y = (bf16*)(ws + WS_Y) + (size_t)dir * NROW * DR + h * 64 + 16 * vb + fr;
    float* st = (float*)(ws + WS_SCANST) + (size_t)item * 1024 + lane * 4;
    f32x4 M[4];
#pragma unroll
    for (int mt = 0; mt < 4; ++mt) M[mt] = (seg == 0 || w != 0) ? (f32x4){0.f, 0.f, 0.f, 0.f} : *(const f32x4*)(st + mt * 256);
    const f32x4 z4 = {0.f, 0.f, 0.f, 0.f};
    struct SQ { bf16x8 a1[4], a2[4]; f32x4 pc[4]; u32x2 u0, y0, vv; };
#define SQ_READ(R, c) do { const LAS unsigned char* sl_ = ring + ((c) % SQ_R) * SQ_SLOT; _Pragma("unroll") for (int i = 0; i < 4; ++i) { \
        R.a1[i] = *(const LAS bf16x8*)(sl_ + i * 1024 + lane * 16); R.a2[i] = *(const LAS bf16x8*)(sl_ + 4096 + i * 1024 + lane * 16); \
        R.pc[i] = *(const LAS f32x4*)(sl_ + 8192 + 1536 + (16 * i + 4 * fq) * 4); } \
        R.u0 = *(const LAS u32x2*)(sl_ + 8192 + lane * 8); R.y0 = *(const LAS u32x2*)(sl_ + 8192 + 512 + lane * 8); R.vv = *(const LAS u32x2*)(sl_ + 8192 + 1024 + lane * 8); } while (0)
    const long ystep = dir ? -(long)DR : (long)DR;
#define SQ_STEP(R, c) do { const int cs_ = seg * SEGCH + (c); \
        const u32x4 t0 = {pk2(M[0][0], M[0][1]), pk2(M[0][2], M[0][3]), pk2(M[1][0], M[1][1]), pk2(M[1][2], M[1][3])}; \
        const u32x4 t1 = {pk2(M[2][0], M[2][1]), pk2(M[2][2], M[2][3]), pk2(M[3][0], M[3][1]), pk2(M[3][2], M[3][3])}; \
        const bf16x8 b0 = __builtin_bit_cast(bf16x8, t0), b1 = __builtin_bit_cast(bf16x8, t1); \
        f32x4 X0 = MFMA16(R.a1[0], b0, z4); X0 = MFMA16(R.a1[1], b1, X0); \
        f32x4 X1 = MFMA16(R.a1[2], b0, z4); X1 = MFMA16(R.a1[3], b1, X1); \
        float u0[4], y0[4]; unpack4(R.u0, u0); unpack4(R.y0, y0); \
        if (MODE == 0 && (need_ctx || cs_ >= 16)) { bf16* yp = Y + (size_t)scan_rowof(16 * cs_ + 4 * fq, dir, b) * DR; \
            yp[0] = (bf16)f2bf(X1[0] + y0[0]); yp[ystep] = (bf16)f2bf(X1[1] + y0[1]); yp[2 * ystep] = (bf16)f2bf(X1[2] + y0[2]); yp[3 * ystep] = (bf16)f2bf(X1[3] + y0[3]); } \
        const u32x4 tb = {pk2(X0[0] + u0[0], X0[1] + u0[1]), pk2(X0[2] + u0[2], X0[3] + u0[3]), R.vv.x, R.vv.y}; const bf16x8 bB = __builtin_bit_cast(bf16x8, tb); \
        _Pragma("unroll") for (int mt = 0; mt < 4; ++mt) M[mt] = MFMA16(R.a2[mt], bB, R.pc[mt] * M[mt]); } while (0)
#define SQ_LOADER(c) do { if (loader) { if ((c) + SQ_D < SEGCH) { SQ_ISSUE((c) + SQ_D); asm volatile("s_waitcnt vmcnt(14)" ::: "memory"); } else asm volatile("s_waitcnt vmcnt(0)" ::: "memory"); } \
        __builtin_amdgcn_s_barrier(); asm volatile("" ::: "memory"); } while (0)
    SQ Ra, Rb;
    SQ_LOADER(0);
    if (w == 0 && MODE != 1) SQ_READ(Ra, 0);
    for (int c = 0; c < SEGCH; c += 2) {
        SQ_LOADER(c + 1);
        if (w == 0 && MODE != 1) { SQ_STEP(Ra, c); SQ_READ(Rb, c + 1); }
        if (c + 2 < SEGCH) SQ_LOADER(c + 2);
        if (w == 0 && MODE != 1) { SQ_STEP(Rb, c + 1); if (c + 2 < SEGCH) SQ_READ(Ra, c + 2); }
    }
#undef SQ_READ
#undef SQ_STEP
#undef SQ_LOADER
#undef SQ_ISSUE
    if (MODE >= 2 && w == 0 && M[0][0] + M[1][1] + M[2][2] + M[3][3] == 12345.678f) st[0] = M[0][0];
    if (MODE == 0 && w == 0 && seg + 1 < NSEG) {
#pragma unroll
        for (int mt = 0; mt < 4; ++mt) *(f32x4*)(st + mt * 256) = M[mt]; }
    __syncthreads();
}

__device__ __forceinline__ void warm_pass(const Frame& F0, int seg) {
    const Frame F = phase_frame(F0); unsigned char* const ws = F.ws;
    const int hb = blockIdx.x - 128;
    if (hb < 0) return;
    const int x = hb & 7, j = hb >> 3;
    const int nw = 16 * NWAVES, me = j * NWAVES + F.wave; unsigned acc = 0u;
    for (int it = me; it < SEGCH * 64; it += 4 * nw) {
        u32x4 v[4];
#pragma unroll
        for (int u = 0; u < 4; ++u) { const int i2 = it + u * nw; const int ci = i2 >> 6, q = (i2 >> 4) & 3, p = i2 & 15;
            v[u] = (i2 < SEGCH * 64) ? *(const u32x4*)(blob_ptr(ws, x + 8 * q, ci) + p * 1024 + F.lane * 16) : (u32x4){0u, 0u, 0u, 0u}; }
#pragma unroll
        for (int u = 0; u < 4; ++u) acc ^= v[u].x ^ v[u].y ^ v[u].z ^ v[u].w;
    }
    asm volatile("" :: "v"(acc));
}
namespace pg8 {
struct EpiStoreBf16 {
    static constexpr bool PERM = true, AFTER_DRAIN = false;
    bf16_t* O; int ldc; int pn_mask;
    __device__ __forceinline__ void operator()(const f32x4 (&acc)[2][2][4][2], const Unit& u, int wr, int wc, int fr, int fq) const {
        const int row0 = u.pm * BM + wr * 64 + fr; const int col0 = (u.pn & pn_mask) * BM + wc * 32 + 8 * fq;
#pragma unroll
        for (int ai = 0; ai < 2; ++ai)
#pragma unroll
            for (int m = 0; m < 4; ++m) { bf16_t* rowp = O + (size_t)(row0 + ai * HALF + m * 16) * ldc + col0;
#pragma unroll
                for (int bj = 0; bj < 2; ++bj) { const f32x4 v0 = acc[ai][bj][m][0], v1 = acc[ai][bj][m][1];
                    u32x4 w; w.x = cvt_pk_bf16(v0[0], v0[1]); w.y = cvt_pk_bf16(v0[2], v0[3]); w.z = cvt_pk_bf16(v1[0], v1[1]); w.w = cvt_pk_bf16(v1[2], v1[3]);
                    *(u32x4*)(rowp + bj * HALF) = w; } }
    }
};
struct EpiSwiGLU {
    static constexpr bool PERM = true, AFTER_DRAIN = false;
    bf16_t* O;
    __device__ __forceinline__ void operator()(const f32x4 (&acc)[2][2][4][2], const Unit& u, int wr, int wc, int fr, int fq) const {
        const int row0 = u.pm * BM + wr * 64 + fr; const int col0 = ((u.pn & 3) * BM + wc * 32 + 8 * fq) >> 1;
#pragma unroll
        for (int ai = 0; ai < 2; ++ai)
#pragma unroll
            for (int m = 0; m < 4; ++m) { bf16_t* rowp = O + (size_t)(row0 + ai * HALF + m * 16) * 512 + col0;
#pragma unroll
                for (int bj = 0; bj < 2; ++bj) { const f32x4 g = acc[ai][bj][m][0], up = acc[ai][bj][m][1]; float a[4];
#pragma unroll
                    for (int i = 0; i < 4; ++i) a[i] = g[i] / (1.f + __expf(-g[i])) * up[i];
                    unsigned long long w = (unsigned long long)cvt_pk_bf16(a[0], a[1]) | ((unsigned long long)cvt_pk_bf16(a[2], a[3]) << 32);
                    *(unsigned long long*)(rowp + bj * (HALF / 2)) = w; } }
    }
};
struct EpiResidual {
    static constexpr bool PERM = false, AFTER_DRAIN = false;
    const float* xlat; const float* xctx;
    float* out; const float* g1;
    __device__ __forceinline__ void operator()(const f32x4 (&acc)[2][2][4][2], const Unit& u, int wr, int wc, int fr, int fq) const {
        const int rowt = u.pm * BM; const int mr = rowt < 16384 ? (rowt >> 13) : 2;
        const float* base = rowt < 16384 ? xlat + (size_t)rowt * 1024 : xctx + (size_t)(rowt - 16384) * 1024;
        const int col0 = u.pn * BM + wc * 32 + 4 * fq;
        f32x4 gv[2][2];
#pragma unroll
        for (int bj = 0; bj < 2; ++bj)
#pragma unroll
            for (int n = 0; n < 2; ++n) gv[bj][n] = *(const f32x4*)(g1 + (size_t)mr * 6144 + col0 + bj * HALF + n * 16);
#pragma unroll
        for (int ai = 0; ai < 2; ++ai)
#pragma unroll
            for (int m = 0; m < 4; ++m) { const int rl = ai * HALF + wr * 64 + m * 16 + fr;
#pragma unroll
                for (int bj = 0; bj < 2; ++bj)
#pragma unroll
                    for (int n = 0; n < 2; ++n) { const size_t off = (size_t)rl * 1024 + col0 + bj * HALF + n * 16;
                        const f32x4 xo = *(const f32x4*)(base + off);
                        *(f32x4*)(out + (size_t)rowt * 1024 + off) = xo + gv[bj][n] * acc[ai][bj][m][n]; } }
    }
};
struct MoeOrder {
    const int* tile_e; int ntiles, G, c;
    __device__ bool next(int i, Unit& u) const { const long L = (long)i * G + c; if (L >= 4L * ntiles) return false; const int pm = (int)(L >> 2); u.pm = pm; u.pn = tile_e[pm] * 4 + (int)(L & 3); return true; }
    __device__ __forceinline__ void a_ready(const Unit&) const {}
    __device__ __forceinline__ void done(const Unit&) const {}
};
}

__device__ __forceinline__ void expert_convert(const Frame& F0, int l) {
    const Frame F = phase_frame(F0); unsigned char* const ws = F.ws;
    LAS float* scr = (LAS float*)(F.lds + F.wave * 16384);
    bf16* wgu = (bf16*)(ws + WS_WGU_T); bf16* wd = (bf16*)(ws + WS_WD_T);
    constexpr int I_G = 16 * 16, I_D = 8 * 32;
    constexpr int NIT = NEXP * (2 * I_G + I_D);
    const float* p_eg = inptr(I_EG); const float* p_eu = inptr(I_EU); const float* p_ed = inptr(I_ED);
    for (int it = F.gw; it < NIT; it += F.NGW) { const int e = it / (2 * I_G + I_D); int r = it % (2 * I_G + I_D);
        if (r < I_G) { transpose_item(p_eg + ((size_t)l * NEXP + e) * D * DEXP, DEXP, (r >> 4) * 64, (r & 15) * 32, wgu, D, RmGU{e * 1024}, scr, F.lane); continue; } r -= I_G;
        if (r < I_G) { transpose_item(p_eu + ((size_t)l * NEXP + e) * D * DEXP, DEXP, (r >> 4) * 64, (r & 15) * 32, wgu, D, RmGU{e * 1024 + 4}, scr, F.lane); continue; } r -= I_G;
        transpose_item(p_ed + ((size_t)l * NEXP + e) * DEXP * D, D, (r >> 5) * 64, (r & 31) * 32, wd, DEXP, RmId{e * 1024}, scr, F.lane);
    }
}

__device__ __forceinline__ void router_pass(const Frame& F0, int l, int nrows) {
    const Frame F = phase_frame(F0); unsigned char* const ws = F.ws;
    constexpr int HP = 1028;
    LAS float* msh = (LAS float*)F.lds; LAS float* msc = msh + 3072; LAS float* hrow = msc + 3072;
    LAS float* part = hrow + 16 * HP;
    LAS float* lgs = part + 8 * 16 * 48;
    __syncthreads();
    mod_to_lds(F, l, 3, msh, false); mod_to_lds(F, l, 4, msc, false); __syncthreads();
    const float* X = (const float*)(ws + WS_X); bf16* H = (bf16*)(ws + WS_H);
    const float* rgw = inptr(I_RGW) + (size_t)l * D * 4; const float* rew = inptr(I_REW) + (size_t)l * D * NEXP;
    const float* rgb = inptr(I_RGB) + l * 4; const float* reb = inptr(I_REB) + l * NEXP;
    int* rt_e = (int*)(ws + WS_ROUTE + RT_E); int* rt_pos = (int*)(ws + WS_ROUTE + RT_POS); float* rt_gate = (float*)(ws + WS_ROUTE + RT_GATE);
    unsigned* cnt = (unsigned*)(ws + WS_CTL) + CW_CNT + 64 * l;
    const int lane = F.lane, w = F.wave, fr = lane & 15, fq = lane >> 4; const float* n2g = inptr(I_N2G) + l * D;
    float bw[32][3];
#pragma unroll
    for (int ks = 0; ks < 32; ++ks) { const int k = 128 * w + 4 * ks + fq;
        bw[ks][0] = rew[(size_t)k * 32 + fr]; bw[ks][1] = rew[(size_t)k * 32 + 16 + fr]; bw[ks][2] = fr < 4 ? rgw[(size_t)k * 4 + fr] : 0.f; }
    const int ntiles = nrows >> 4;
    for (int gi = F.vcu; gi < ntiles; gi += F.G) {
#pragma unroll
        for (int rr = 0; rr < 2; ++rr) { const int r = 2 * w + rr, row = gi * 16 + r; f32x4 v[4];
#pragma unroll
            for (int j = 0; j < 4; ++j) v[j] = *(const f32x4*)(X + (size_t)row * D + 4 * lane + 256 * j);
            const int mr = modrow(row);
            norm_mod_row(v, n2g, msc + mr * 1024, msh + mr * 1024, H + (size_t)row * D, lane);
#pragma unroll
            for (int j = 0; j < 4; ++j) *(LAS f32x4*)(hrow + r * HP + 4 * lane + 256 * j) = v[j]; }
        __syncthreads();
        {   f32x4 acc[3] = {{0.f, 0.f, 0.f, 0.f}, {0.f, 0.f, 0.f, 0.f}, {0.f, 0.f, 0.f, 0.f}};
#pragma unroll
            for (int ks = 0; ks < 32; ++ks) { const float a = hrow[fr * HP + 128 * w + 4 * ks + fq];
#pragma unroll
                for (int nt = 0; nt < 3; ++nt) acc[nt] = __builtin_amdgcn_mfma_f32_16x16x4f32(a, bw[ks][nt], acc[nt], 0, 0, 0); }
#pragma unroll
            for (int nt = 0; nt < 3; ++nt)
#pragma unroll
                for (int reg = 0; reg < 4; ++reg) part[(w * 16 + 4 * fq + reg) * 48 + 16 * nt + fr] = acc[nt][reg]; }
        __syncthreads();
        for (int idx = F.tid; idx < 16 * 36; idx += NTHR) { const int r = idx / 36, n = idx % 36; float s_ = 0.f;
#pragma unroll
            for (int ww = 0; ww < 8; ++ww) s_ += part[(ww * 16 + r) * 48 + n];
            if (n < 32) lgs[r * 40 + 4 + n] = s_ + reb[n]; else lgs[r * 40 + n - 32] = s_ + rgb[n - 32]; }
        __syncthreads();
        if (F.tid < 16) { const int rr = gi * 16 + F.tid; const LAS float* lp = lgs + F.tid * 40;
            int grp = 0; float mx = lp[0];
#pragma unroll
            for (int g = 1; g < 4; ++g) if (lp[g] > mx) { mx = lp[g]; grp = g; }
            float den = 0.f;
#pragma unroll
            for (int g = 0; g < 4; ++g) den += __expf(lp[g] - mx);
            const float pg_top = 1.f / den; const LAS float* sel = lp + 4 + grp * 8;
            int i0 = 0; float l0 = sel[0];
#pragma unroll
            for (int q = 1; q < 8; ++q) if (sel[q] > l0) { l0 = sel[q]; i0 = q; }
            int i1 = -1; float l1 = -3.0e38f;
#pragma unroll
            for (int q = 0; q < 8; ++q) if (q != i0 && sel[q] > l1) { l1 = sel[q]; i1 = q; }
            const float e1 = __expf(l1 - l0); const float w0 = pg_top / (1.f + e1), w1 = pg_top * e1 / (1.f + e1);
            const int ea = grp * 8 + i0, eb = grp * 8 + i1;
            const unsigned pa = atomicAdd(cnt + ea, 1u), pb = atomicAdd(cnt + eb, 1u);
            rt_e[2 * rr] = ea; rt_e[2 * rr + 1] = eb; rt_pos[2 * rr] = (int)pa; rt_pos[2 * rr + 1] = (int)pb; rt_gate[2 * rr] = w0; rt_gate[2 * rr + 1] = w1; }
    }
}

__device__ __forceinline__ void gather_pass(const Frame& F0, int l, int nrows) {
    const Frame F = phase_frame(F0); unsigned char* const ws = F.ws;
    LAS int* off = (LAS int*)F.lds;
    const unsigned* cnt = (const unsigned*)(ws + WS_CTL) + CW_CNT + 64 * l;
    int* tile_e = (int*)(ws + WS_ROUTE + RT_TILE); int* ntl = (int*)(ws + WS_ROUTE + RT_NT);
    __syncthreads();
    if (F.tid == 0) { int o = 0;
#pragma nounroll
        for (int e = 0; e < NEXP; ++e) { const int c = (int)__hip_atomic_load(cnt + e, __ATOMIC_RELAXED, __HIP_MEMORY_SCOPE_AGENT); const int nt = (c + 255) >> 8; off[e] = o;
            if (blockIdx.x == 0) {
#pragma nounroll
                for (int t = 0; t < nt; ++t) tile_e[(o >> 8) + t] = e; }
            o += nt << 8; }
        if (blockIdx.x == 0) ntl[0] = o >> 8; }
    __syncthreads();
    const int* rt_e = (const int*)(ws + WS_ROUTE + RT_E); const int* rt_pos = (const int*)(ws + WS_ROUTE + RT_POS); int* rt_slot = (int*)(ws + WS_ROUTE + RT_SLOT);
    const bf16* H = (const bf16*)(ws + WS_H); bf16* Xs = (bf16*)(ws + WS_XS);
    for (int it0 = F.gw * 4; it0 < 2 * nrows; it0 += F.NGW * 4) { int slot[4]; u32x4 a[4], b2[4];
#pragma unroll
        for (int u = 0; u < 4; ++u) { const int it = it0 + u; slot[u] = it < 2 * nrows ? off[rt_e[it]] + rt_pos[it] : -1; }
#pragma unroll
        for (int u = 0; u < 4; ++u) if (slot[u] >= 0) { const u32x4* s = (const u32x4*)(H + (size_t)((it0 + u) >> 1) * D); a[u] = s[F.lane]; b2[u] = s[64 + F.lane]; }
#pragma unroll
        for (int u = 0; u < 4; ++u) if (slot[u] >= 0) { if (F.lane == 0) rt_slot[it0 + u] = slot[u]; u32x4* d = (u32x4*)(Xs + (size_t)slot[u] * D); d[F.lane] = a[u]; d[64 + F.lane] = b2[u]; }
    }
}

__device__ __forceinline__ void combine_pass(const Frame& F0, int l, int nrows) {
    const Frame F = phase_frame(F0); unsigned char* const ws = F.ws;
    LAS float* mg2 = (LAS float*)F.lds; LAS float* msh = mg2 + 3072; LAS float* msc = msh + 3072;
    const bool last = (l == DEPTH - 1);
    __syncthreads();
    mod_to_lds(F, l, 5, mg2, false); if (!last) { mod_to_lds(F, l + 1, 0, msh, false); mod_to_lds(F, l + 1, 1, msc, false); }
    __syncthreads();
    float* X = (float*)(ws + WS_X); bf16* H = (bf16*)(ws + WS_H); const bf16* Ys = (const bf16*)(ws + WS_XS);
    const int* rt_slot = (const int*)(ws + WS_ROUTE + RT_SLOT); const float* rt_gate = (const float*)(ws + WS_ROUTE + RT_GATE);
    const int lane = F.lane; const float* n1g = inptr(I_N1G) + (last ? 0 : (l + 1) * D); const float* fgp = inptr(I_FG);
    for (int row0 = F.gw; row0 < nrows; row0 += 2 * F.NGW) {
        int s0[2], s1[2]; float w0[2], w1[2]; bool ok[2]; u32x2 ya[2][4], yb[2][4]; f32x4 xo[2][4];
#pragma unroll
        for (int u = 0; u < 2; ++u) { const int row = row0 + u * F.NGW; ok[u] = row < nrows; if (ok[u]) { s0[u] = rt_slot[2 * row]; s1[u] = rt_slot[2 * row + 1]; w0[u] = rt_gate[2 * row]; w1[u] = rt_gate[2 * row + 1]; } }
#pragma unroll
        for (int u = 0; u < 2; ++u) if (ok[u]) { const int row = row0 + u * F.NGW;
#pragma unroll
            for (int j = 0; j < 4; ++j) { const int c = 4 * lane + 256 * j; ya[u][j] = *(const u32x2*)(Ys + (size_t)s0[u] * D + c); yb[u][j] = *(const u32x2*)(Ys + (size_t)s1[u] * D + c); xo[u][j] = *(const f32x4*)(X + (size_t)row * D + c); } }
#pragma unroll
        for (int u = 0; u < 2; ++u) if (ok[u]) { const int row = row0 + u * F.NGW; const int mr = modrow(row); f32x4 v[4];
#pragma unroll
            for (int j = 0; j < 4; ++j) { const int c = 4 * lane + 256 * j; float a[4], b[4]; unpack4(ya[u][j], a); unpack4(yb[u][j], b);
                const f32x4 g2 = *(const LAS f32x4*)(mg2 + mr * 1024 + c);
                f32x4 y; y.x = w0[u] * a[0] + w1[u] * b[0]; y.y = w0[u] * a[1] + w1[u] * b[1]; y.z = w0[u] * a[2] + w1[u] * b[2]; y.w = w0[u] * a[3] + w1[u] * b[3];
                v[j] = xo[u][j] + g2 * y; }
            if (!last) {
#pragma unroll
                for (int j = 0; j < 4; ++j) *(f32x4*)(X + (size_t)row * D + 4 * lane + 256 * j) = v[j];
                norm_mod_row(v, n1g, msc + mr * 1024, msh + mr * 1024, H + (size_t)row * D, lane);
            } else { float s = 0.f;
#pragma unroll
                for (int j = 0; j < 4; ++j) s += (v[j].x * v[j].x + v[j].y * v[j].y) + (v[j].z * v[j].z + v[j].w * v[j].w);
                const float rs = rsqrtf(wave_sum(s) * (1.f / D) + RMS_EPS);
#pragma unroll
                for (int j = 0; j < 4; ++j) { const int c = 4 * lane + 256 * j; const f32x4 g = *(const f32x4*)(fgp + c); *(f32x4*)(F.out + (size_t)row * D + c) = v[j] * rs * g; } } }
    }
}
__global__ void __launch_bounds__(NTHR, 2) fwd_megakernel(Params prm) {
    extern __shared__ __attribute__((aligned(16))) unsigned char lds_raw[];
    Frame F;
    F.lds = (LAS unsigned char*)lds_raw;
    F.tid = threadIdx.x; F.lane = F.tid & 63; F.wave = __builtin_amdgcn_readfirstlane(F.tid >> 6);
    F.G = gridDim.x; { const int bx = blockIdx.x; F.vcu = (F.G % 8 == 0) ? (bx % 8) * (F.G / 8) + bx / 8 : bx; }
    F.gw = F.vcu * NWAVES + F.wave; F.NGW = F.G * NWAVES;
    F.out = prm.out; F.ws = prm.ws;
    for (int u = F.tid; u < (LDS_BYTES - LDSCTL_OFF) / 4; u += NTHR) ((LAS unsigned*)(F.lds + LDSCTL_OFF))[u] = 0u;
    __syncthreads();
    (void)xcd_barrier_post((unsigned*)(F.ws + WS_CTL) + CW_BAR, (volatile LAS unsigned*)(F.lds + MISC_OFF) + 8);
#define GRID_BAR() do { XcdBarrier bar_; bar_.bar = (unsigned*)(opaque(F.ws) + WS_CTL) + CW_BAR; bar_.x = xb_xcc_id(); bar_.st = (volatile LAS unsigned*)(F.lds + MISC_OFF) + 8; xcd_barrier(bar_); } while (0)

#ifndef PHMASK
#define PHMASK 0xffff
#endif
#define PH(k) ((PHMASK >> (k)) & 1)
#ifndef PROBE_MASK
#define PROBE_MASK 0
#endif
#define REP(k) _Pragma("nounroll") for (int rep_ = 0; rep_ < ((PROBE_MASK >> (k)) & 1) + 1; ++rep_)
    if (PH(0)) p0_prologue(F);
#if USE_CG_SYNC
    cg::this_grid().sync();
#else
    GRID_BAR();
#endif
    if (PH(1)) p0b_norm1(F);
    GRID_BAR();

    for (int l = 0; l < DEPTH; ++l) {
        const bool need_ctx = (l == 0); const int nrows = need_ctx ? NROW : NLAT;
#define WSO Fp.ws
        REP(2) {
            const Frame Fp = phase_frame(F); unsigned char* const ws = WSO; bf16* Hb = (bf16*)(ws + WS_H); bf16* Pb = (bf16*)(ws + WS_P);
            pg8::Gemm g{Hb, (const bf16*)(ws + WS_WIN_T) + (size_t)l * NP * D, NROW, NP, D}; pg8::StaticOrder S; S.init(NROW, NP, Fp.G, (int)blockIdx.x);
            pg8::EpiStoreBf16 E{Pb, NP, 0xffff};
            pg8::gemm_phase<pg8::EpiStoreBf16, pg8::StaticOrder, true, true>(F.lds, g, S, E);
        }
        GRID_BAR();
        {
            const Frame Fp = phase_frame(F); unsigned char* const ws = WSO; bf16* Pb = (bf16*)(ws + WS_P);
            REP(14) for (int it = blockIdx.x; it < 256; it += F.G) fftA_item(F, it);
            if (PH(4) && need_ctx) for (int it = blockIdx.x; it < 8; it += F.G) { const int b = it >> 2, m0 = (it & 3) * 64;
                const bf16* src0 = Pb + (size_t)(NLAT + b * CTXL) * NP + COL_FC;
                dft64_item<4, 256>(F, l, m0, -1.f, 1.f / 128.f, [=](int t, int ri) { return src0 + (size_t)t * NP + ri * 256; }, [=](int m) { return NLAT + b * CTXL + m; }); }
            REP(15) shift_pass(F, l);
            REP(16) conv_pass(F, l, nrows);
        }
        GRID_BAR();
        {
            const Frame Fp = phase_frame(F); unsigned char* const ws = WSO;
            REP(11) for (int it = blockIdx.x; it < 256; it += F.G) { const int b = it >> 7, t1p = it & 127;
                const bf16* src0 = (const bf16*)(ws + WS_GT) + (size_t)(b * 128 + t1p) * 64 * 512;
                dft64_item<1, 64>(F, l, 0, 1.f, 0.0013810679320049757f, [=](int t, int ri) { return src0 + (size_t)t * 512 + ri * 256; }, [=](int m) { return b * SEQ + t1p + 128 * m; }); }
            for (int it = blockIdx.x; it < (NROW / 16) * (((PROBE_MASK >> 4) & 1) + 1); it += F.G) prep_item(F, l, it % (NROW / 16));
        }
        GRID_BAR();
        for (int seg = 0; seg < NSEG; ++seg) {
            REP(5) pre_phase(F, seg);
            GRID_BAR();
            if (F.G == 256 && blockIdx.x >= 128) warm_pass(F, seg);
            REP(6) for (int it = blockIdx.x; it < 128; it += F.G) { const int x_ = it & 7, j_ = it >> 3; seq_item<0>(F, ((x_ + 8 * (j_ >> 2)) << 2) | (j_ & 3), seg, need_ctx);
#if SEQ_PROBE
                seq_item<SEQ_PROBE>(F, ((x_ + 8 * (j_ >> 2)) << 2) | (j_ & 3), seg, need_ctx);
#endif
            }
            GRID_BAR();
        }
        REP(7) readout_pass(F, l, nrows);
        GRID_BAR();
        REP(8) if (l == 0 || rep_ == 0) {
            const Frame Fp = phase_frame(F); unsigned char* const ws = WSO; bf16* Hb = (bf16*)(ws + WS_H);
            pg8::Gemm g{Hb, (const bf16*)(ws + WS_WOUT_T) + (size_t)l * D * D, nrows, D, D}; pg8::StaticOrder S; S.init(nrows, D, Fp.G, (int)blockIdx.x);
            const float* X = (const float*)(ws + WS_X);
            pg8::EpiResidual E{l == 0 ? inptr(I_X) : X, l == 0 ? inptr(I_CTX) : X + (size_t)NLAT * D, (float*)(ws + WS_X), (const float*)(ws + WS_MODF) + (size_t)l * 3 * 6144 + 2 * 1024};
            pg8::gemm_phase<pg8::EpiResidual, pg8::StaticOrder, true, true>(F.lds, g, S, E);
        }
        GRID_BAR();
        REP(9) expert_convert(F, l);
        if (PH(12)) router_pass(F, l, nrows);
        GRID_BAR();
        REP(10) gather_pass(F, l, nrows);
        GRID_BAR();
        if (PH(14)) {
            const Frame Fp = phase_frame(F); unsigned char* const ws = WSO;
            const int* tile_e = (const int*)(ws + WS_ROUTE + RT_TILE); const int ntiles = *(const int*)(ws + WS_ROUTE + RT_NT);
            pg8::MoeOrder S{tile_e, ntiles, Fp.G, (int)blockIdx.x};
            REP(12) {   pg8::Gemm g{(const bf16*)(ws + WS_XS), (const bf16*)(ws + WS_WGU_T), 0, 0, D};
                pg8::EpiSwiGLU E{(bf16*)(ws + WS_ACT)};
                pg8::gemm_phase<pg8::EpiSwiGLU, pg8::MoeOrder, true, true>(F.lds, g, S, E); }
            GRID_BAR();
            REP(13) {   pg8::Gemm g{(const bf16*)(ws + WS_ACT), (const bf16*)(ws + WS_WD_T), 0, 0, DEXP};
                pg8::EpiStoreBf16 E{(bf16*)(ws + WS_XS), D, 3};
                pg8::gemm_phase<pg8::EpiStoreBf16, pg8::MoeOrder, true, true>(F.lds, g, S, E); }
        }
        GRID_BAR();
        if (PH(15)) combine_pass(F, l, nrows);
        if (l + 1 < DEPTH) GRID_BAR();
    }
}

extern "C" void kernel_launch(void* const* d_in, const int* in_sizes, int n_in, void* d_out, int out_size, void* d_ws, size_t ws_size, hipStream_t stream) {
    static int grid = 0;
    if (grid == 0) {
        if (n_in != N_IN || in_sizes[0] != NLAT * D || out_size != NLAT * D || ws_size < WS_END) {
            fprintf(stderr, "kernel_launch: unexpected shapes (n_in %d in0 %d out %d ws %zu)\n", n_in, n_in > 0 ? in_sizes[0] : -1, out_size, ws_size); grid = -1; return; }
        int dev = 0, cus = 0, per_cu = 0;
        hipGetDevice(&dev); hipDeviceGetAttribute(&cus, hipDeviceAttributeMultiprocessorCount, dev);
        hipFuncSetAttribute((const void*)fwd_megakernel, hipFuncAttributeMaxDynamicSharedMemorySize, LDS_BYTES);
        hipOccupancyMaxActiveBlocksPerMultiprocessor(&per_cu, (const void*)fwd_megakernel, NTHR, LDS_BYTES);
        if (per_cu < 1) { fprintf(stderr, "kernel_launch: occupancy query says %d blocks per CU\n", per_cu); per_cu = 1; }
        (void)hipGetLastError();
        grid = cus * per_cu;
    }
    if (grid < 0) return;
    hipMemsetAsync((char*)d_ws + WS_CTL, 0, CTL_ZERO_BYTES, stream);
    Params p{};
    for (int i = 0; i < N_IN; ++i) p.in[i] = (const float*)d_in[i];
    p.out = (float*)d_out; p.ws = (unsigned char*)d_ws;
    void* args[] = {&p};
    hipError_t e = hipLaunchCooperativeKernel((const void*)fwd_megakernel, dim3(grid), dim3(NTHR), args, LDS_BYTES, stream);
    if (e != hipSuccess) fprintf(stderr, "kernel_launch: cooperative launch failed: %s (grid %d)\n", hipGetErrorString(e), grid);
}
```

```cpp
#include <hip/hip_runtime.h>
#include <hip/hip_cooperative_groups.h>
#include <cstdio>
#include <cstdint>
namespace cg = cooperative_groups;
#ifndef USE_CG_SYNC
#define USE_CG_SYNC 0
#endif
#define SEQ_PROBE 0
#define SEQ_PROBE_PRE 0
#define PRE_PROBE 0
#define BAR_PROBE 0
#define PREP_PROBE 0
#ifndef PROBE_MASK
#define PROBE_MASK 0
#endif
namespace pg8 {
#define PG8_LAS __attribute__((address_space(3)))
typedef unsigned short bf16_t;
typedef short bf16x8 __attribute__((ext_vector_type(8)));
typedef float f32x4 __attribute__((ext_vector_type(4)));
typedef unsigned u32x4 __attribute__((ext_vector_type(4)));
constexpr int BM = 256, BK = 64, HALF = 128, HTB = HALF * BK * 2  , STAGE_BYTES = 8 * HTB, NXCD = 8, WGM = 8;

__host__ __device__ __forceinline__ int lds_byte(int r, int c) { const int st = (r >> 4) * 2 + (c >> 5), rr = r & 15, cc = c & 31, ob = rr * 64 + cc * 2; return st * 1024 + (ob ^ (((ob >> 9) & 1) << 5)); }
__host__ __device__ __forceinline__ void stage_rc(int b, int& R, int& C) { const int st = b / 1024, sb = b % 1024, swz = sb ^ (((sb >> 9) & 1) << 5); R = (st >> 1) * 16 + swz / 64; C = (st & 1) * 32 + (swz % 64) / 2; }
__host__ __device__ __forceinline__ int perm32(int rho) { const int n = rho >> 4, i = rho & 15; return 8 * (i >> 2) + 4 * n + (i & 3); }

struct Unit { int pm, pn; };
struct Gemm { const bf16_t* A; const bf16_t* Bt; int M, N, K; };

struct StaticOrder {
    int nM, nN, nwg, G, c;
    __host__ __device__ void init(int M, int N, int G_, int c_) { nM = M / BM; nN = N / BM; nwg = nM * nN; G = G_; c = c_; }
    __host__ __device__ bool next(int i, Unit& u) const {
        const long L = (long)i * G + c; if (L >= nwg) return false;
        int wgid = (int)L; { const int q = nwg / NXCD, r = nwg % NXCD, xcd = wgid % NXCD, off = wgid / NXCD; wgid = (xcd < r ? xcd * (q + 1) : r * (q + 1) + (xcd - r) * q) + off; }
        const int nig = WGM * nN, gid = wgid / nig, fm = gid * WGM, gsz = (nM - fm) < WGM ? (nM - fm) : WGM;
        u.pm = fm + ((wgid % nig) % gsz); u.pn = (wgid % nig) / gsz; return true;
    }
    __device__ __forceinline__ void a_ready(const Unit&) const {}
    __device__ __forceinline__ void done(const Unit&) const {}
};

__device__ __forceinline__ unsigned cvt_pk_bf16(float lo, float hi) { unsigned r; asm volatile("v_cvt_pk_bf16_f32 %0, %1, %2" : "=v"(r) : "v"(lo), "v"(hi)); return r; }
typedef float f32x2 __attribute__((ext_vector_type(2)));
template <class Epi, class Sched, bool ALIGN_EPI = false, bool SP2 = false>
__device__ __forceinline__ void gemm_phase(PG8_LAS unsigned char* lds, const Gemm g, const Sched& S, const Epi& E) {
    int tid = threadIdx.x; asm volatile("" : "+v"(tid));
    const int wid = __builtin_amdgcn_readfirstlane(tid >> 6), lane = tid & 63, wr = wid >> 2, wc = wid & 3, fr = lane & 15, fq = lane >> 4;
    const int K = g.K, nt = K / BK;
    unsigned voffA[2], voffB[2];
#pragma unroll
    for (int i = 0; i < 2; ++i) { int R, C; stage_rc(tid * 16 + i * 8192, R, C); const int Rb = Epi::PERM ? ((R & ~31) + perm32(R & 31)) : R;
        voffA[i] = (unsigned)(R * K + C) * 2u; voffB[i] = (unsigned)(Rb * K + C) * 2u; }
    const size_t kstep = (size_t)(BK * 2);
    const size_t hstep = (size_t)HALF * K * 2;
    const size_t tstep = 2 * hstep;
    const unsigned ldsw = (unsigned)wid * 1024u;
    const int aoff = lds_byte(wr * 64 + fr, fq * 8), boff = lds_byte(wc * 32 + fr, fq * 8);
#define PG8_SA(b, h) (((b) * 2 + (h)) * HTB)
#define PG8_SB(b, h) ((4 + (b) * 2 + (h)) * HTB)
#define PG8_STAGE(bufoff, gbase, voff) do { _Pragma("unroll") for (int _i = 0; _i < 2; ++_i) \
        __builtin_amdgcn_global_load_lds((const unsigned*)((const char*)(gbase) + (voff)[_i]), (PG8_LAS unsigned*)(lds + (bufoff) + ldsw + _i * 8192), 16, 0, 0); } while (0)
#define PG8_LDA(dst, b, h) do { _Pragma("unroll") for (int m = 0; m < 4; ++m) _Pragma("unroll") for (int k = 0; k < 2; ++k) dst[m][k] = *(const PG8_LAS bf16x8*)(lds + PG8_SA(b, h) + aoff + m * 2048 + k * 1024); } while (0)
#define PG8_LDB(dst, b, h) do { _Pragma("unroll") for (int n = 0; n < 2; ++n) _Pragma("unroll") for (int k = 0; k < 2; ++k) dst[n][k] = *(const PG8_LAS bf16x8*)(lds + PG8_SB(b, h) + boff + n * 2048 + k * 1024); } while (0)
#define PG8_MMA(ai, bj, At, Bt) do { __builtin_amdgcn_s_setprio(1); _Pragma("unroll") for (int m = 0; m < 4; ++m) _Pragma("unroll") for (int n = 0; n < 2; ++n) _Pragma("unroll") for (int k = 0; k < 2; ++k) \
        acc[ai][bj][m][n] = __builtin_amdgcn_mfma_f32_16x16x32_bf16(Bt[n][k], At[m][k], acc[ai][bj][m][n], 0, 0, 0); __builtin_amdgcn_s_setprio(0); } while (0)
#define PG8_WAIT_V(n) asm volatile("s_waitcnt vmcnt(" #n ")" ::: "memory")
#define PG8_WAIT_L(n) asm volatile("s_waitcnt lgkmcnt(" #n ")" ::: "memory")
#define PG8_BAR __builtin_amdgcn_s_barrier()
#define PG8_SCHED __builtin_amdgcn_sched_barrier(0)
    Unit cur, nxt; int ui = 0;
    if (!S.next(0, cur)) return;
    f32x4 acc[2][2][4][2];
#pragma unroll
    for (int a = 0; a < 2; ++a)
#pragma unroll
        for (int b = 0; b < 2; ++b)
#pragma unroll
            for (int m = 0; m < 4; ++m)
#pragma unroll
                for (int n = 0; n < 2; ++n) acc[a][b][m][n] = (f32x4){0.f, 0.f, 0.f, 0.f};
    bf16x8 At[4][2], B0[2][2], B1[2][2];
    const char* cA = (const char*)g.A + (size_t)cur.pm * tstep; const char* cB = (const char*)g.Bt + (size_t)cur.pn * tstep;
    S.a_ready(cur);
    if constexpr (SP2) {
        PG8_STAGE(PG8_SB(0, 0), cB, voffB); PG8_STAGE(PG8_SB(0, 1), cB + hstep, voffB); PG8_STAGE(PG8_SA(0, 0), cA, voffA); PG8_STAGE(PG8_SA(0, 1), cA + hstep, voffA);
        if (wr == 1) PG8_BAR;
        PG8_WAIT_V(2); PG8_BAR;
        PG8_STAGE(PG8_SB(1, 0), cB + kstep, voffB); PG8_STAGE(PG8_SA(1, 0), cA + kstep, voffA); PG8_STAGE(PG8_SB(1, 1), cB + hstep + kstep, voffB);
        PG8_WAIT_V(6); PG8_BAR;
    } else {
        PG8_STAGE(PG8_SB(0, 0), cB, voffB); PG8_STAGE(PG8_SA(0, 0), cA, voffA); PG8_STAGE(PG8_SB(0, 1), cB + hstep, voffB); PG8_STAGE(PG8_SA(0, 1), cA + hstep, voffA);
        if (wr == 1) PG8_BAR;
        PG8_WAIT_V(4); PG8_BAR;
        PG8_STAGE(PG8_SB(1, 0), cB + kstep, voffB); PG8_STAGE(PG8_SA(1, 0), cA + kstep, voffA); PG8_STAGE(PG8_SB(1, 1), cB + hstep + kstep, voffB);
        PG8_WAIT_V(6); PG8_BAR;
    }
    for (;;) {
        const bool has_next = S.next(ui + 1, nxt);
        const char* nA = has_next ? (const char*)g.A + (size_t)nxt.pm * tstep : cA; const char* nB = has_next ? (const char*)g.Bt + (size_t)nxt.pn * tstep : cB;
        for (int t = 0; t < nt; t += 2) {
            const bool last = (t == nt - 2);
            const char* a1 = cA + (size_t)(t + 1) * kstep;
            const char* a2 = last ? nA : cA + (size_t)(t + 2) * kstep; const char* b2 = last ? nB : cB + (size_t)(t + 2) * kstep;
            const char* a3 = a2 + kstep; const char* b3 = b2 + kstep;
            if (last && has_next) S.a_ready(nxt);
            if constexpr (SP2) {
            PG8_LDB(B0, 0, 0); PG8_LDB(B1, 0, 1); PG8_SCHED; PG8_LDA(At, 0, 0); PG8_STAGE(PG8_SA(1, 1), a1 + hstep, voffA);
            PG8_WAIT_V(8); PG8_WAIT_L(0); PG8_BAR; PG8_MMA(0, 0, At, B0); PG8_MMA(0, 1, At, B1); PG8_BAR; PG8_SCHED;
            PG8_LDA(At, 0, 1); PG8_STAGE(PG8_SB(0, 0), b2, voffB); PG8_STAGE(PG8_SB(0, 1), b2 + hstep, voffB); PG8_STAGE(PG8_SA(0, 0), a2, voffA);
            PG8_WAIT_V(8); PG8_WAIT_L(0); PG8_BAR; PG8_MMA(1, 0, At, B0); PG8_MMA(1, 1, At, B1); PG8_BAR; PG8_SCHED;
            PG8_LDB(B0, 1, 0); PG8_LDB(B1, 1, 1); PG8_SCHED; PG8_LDA(At, 1, 0); PG8_STAGE(PG8_SA(0, 1), a2 + hstep, voffA);
            PG8_WAIT_V(8); PG8_WAIT_L(0); PG8_BAR; PG8_MMA(0, 0, At, B0); PG8_MMA(0, 1, At, B1); PG8_BAR; PG8_SCHED;
            PG8_LDA(At, 1, 1); PG8_STAGE(PG8_SB(1, 0), b3, voffB); PG8_STAGE(PG8_SB(1, 1), b3 + hstep, voffB); PG8_STAGE(PG8_SA(1, 0), a3, voffA);
            PG8_WAIT_V(8); PG8_WAIT_L(0); PG8_BAR; PG8_MMA(1, 0, At, B0); PG8_MMA(1, 1, At, B1); PG8_BAR; PG8_SCHED;
            } else {
            PG8_LDB(B0, 0, 0); PG8_SCHED; PG8_LDA(At, 0, 0); PG8_STAGE(PG8_SA(1, 1), a1 + hstep, voffA);
            PG8_WAIT_L(8); PG8_BAR; PG8_WAIT_L(0); PG8_MMA(0, 0, At, B0); PG8_BAR; PG8_SCHED;
            PG8_LDB(B1, 0, 1); PG8_STAGE(PG8_SB(0, 0), b2, voffB);
            PG8_BAR; PG8_WAIT_L(0); PG8_MMA(0, 1, At, B1); PG8_BAR;
            PG8_LDA(At, 0, 1); PG8_STAGE(PG8_SA(0, 0), a2, voffA);
            PG8_BAR; PG8_WAIT_L(0); PG8_MMA(1, 0, At, B0); PG8_BAR; PG8_SCHED;
            PG8_STAGE(PG8_SB(0, 1), b2 + hstep, voffB);
            PG8_WAIT_V(6); PG8_BAR; PG8_MMA(1, 1, At, B1); PG8_BAR;
            PG8_LDB(B0, 1, 0); PG8_SCHED; PG8_LDA(At, 1, 0); PG8_STAGE(PG8_SA(0, 1), a2 + hstep, voffA);
            PG8_WAIT_L(8); PG8_BAR; PG8_WAIT_L(0); PG8_MMA(0, 0, At, B0); PG8_BAR; PG8_SCHED;
            PG8_LDB(B1, 1, 1); PG8_STAGE(PG8_SB(1, 0), b3, voffB);
            PG8_BAR; PG8_WAIT_L(0); PG8_MMA(0, 1, At, B1); PG8_BAR;
            PG8_LDA(At, 1, 1); PG8_STAGE(PG8_SA(1, 0), a3, voffA);
            PG8_BAR; PG8_WAIT_L(0); PG8_MMA(1, 0, At, B0); PG8_BAR; PG8_SCHED;
            PG8_STAGE(PG8_SB(1, 1), b3 + hstep, voffB);
            PG8_WAIT_V(6); PG8_BAR; PG8_MMA(1, 1, At, B1); PG8_BAR;
            }
        }
        if constexpr (ALIGN_EPI) { if (wr == 0) PG8_BAR; }
        if constexpr (!Epi::AFTER_DRAIN) { E(acc, cur, wr, wc, fr, fq); S.done(cur); }
        if (!has_next) break;
#pragma unroll
        for (int a = 0; a < 2; ++a)
#pragma unroll
            for (int b = 0; b < 2; ++b)
#pragma unroll
                for (int m = 0; m < 4; ++m)
#pragma unroll
                    for (int n = 0; n < 2; ++n) acc[a][b][m][n] = (f32x4){0.f, 0.f, 0.f, 0.f};
        cur = nxt; cA = nA; cB = nB; ++ui;
        if constexpr (ALIGN_EPI) { if (wr == 1) PG8_BAR; }
    }
    PG8_WAIT_V(0);
    if constexpr (!ALIGN_EPI) { if (wr == 0) PG8_BAR; }
    PG8_BAR;
    if constexpr (Epi::AFTER_DRAIN) { E.fused(acc, cur, wr, wc, fr, fq, lds, wid, lane); S.done(cur); }
#undef PG8_SA
#undef PG8_SB
#undef PG8_STAGE
#undef PG8_LDA
#undef PG8_LDB
#undef PG8_MMA
#undef PG8_WAIT_V
#undef PG8_WAIT_L
#undef PG8_BAR
#undef PG8_SCHED
}
}
#define LAS __attribute__((address_space(3)))
typedef unsigned short bf16;
typedef float f32x4 __attribute__((ext_vector_type(4)));
typedef short bf16x8 __attribute__((ext_vector_type(8)));
typedef unsigned u32x4 __attribute__((ext_vector_type(4)));
typedef unsigned u32x2 __attribute__((ext_vector_type(2)));

constexpr int D = 1024, NBATCH = 2, SEQ = 8192, CTXL = 256, DEPTH = 2;
constexpr int NLAT = NBATCH * SEQ, NCTX = NBATCH * CTXL, NROW = NLAT + NCTX;
constexpr int DR = 512, DIN = 2944, NP = 3328, ZW = 1920, NHEAD = 8;
constexpr int COL_CONV = 1920, COL_FC = 2688, COL_FS = 2944;
constexpr int STRW = 5120;
constexpr int NEXP = 32, DEXP = 512;
constexpr int MOE_MAXTILES = 168;
constexpr float RMS_EPS = 1e-6f, GN_EPS = 64e-5f;

enum { I_X = 0, I_C, I_CTX, I_CCTX, I_ADAW, I_ADAB, I_N1G, I_N2G, I_WIN, I_MU, I_DW0, I_DW2, I_IA0, I_IA2, I_GG2, I_KK, I_KA, I_RK, I_GNW, I_GNB,
       I_CONVW, I_CONVG, I_FOURG, I_WOUT, I_RGW, I_RGB, I_REW, I_REB, I_EG, I_EU, I_ED, I_FG, N_IN };

constexpr size_t MiB = 1u << 20;
constexpr size_t WS_CTL = 0, CTL_ZERO_BYTES = 64 * 1024;
constexpr size_t WS_MODP = 1 * MiB;
constexpr size_t WS_MODF = 1 * MiB + 1280 * 1024;
constexpr size_t WS_WIN_T = 3 * MiB;
constexpr size_t WS_WOUT_T = 16 * MiB;
constexpr size_t WS_WGU_T = 20 * MiB;
constexpr size_t WS_WD_T = 84 * MiB;
constexpr size_t WS_X = 116 * MiB;
constexpr size_t WS_H = 182 * MiB;
constexpr size_t WS_ZS = 215 * MiB;
constexpr size_t WS_P = 277 * MiB;
constexpr size_t WS_STR = 277 * MiB;
constexpr size_t WS_Y = 442 * MiB;
constexpr size_t WS_GT = 475 * MiB;
constexpr size_t WS_ROUTE = 491 * MiB;
constexpr size_t WS_XS = 215 * MiB;
constexpr size_t WS_ACT = 299 * MiB;
constexpr size_t WS_END = 530 * MiB;
constexpr size_t RT_E = 0, RT_POS = 1 * 33792 * 4, RT_GATE = 2 * 33792 * 4, RT_SLOT = 3 * 33792 * 4, RT_TILE = 4 * 33792 * 4, RT_NT = RT_TILE + 1024;

constexpr int CW_BAR = 4096;
constexpr int CW_CNT = 8192;

constexpr int NWAVES = 8, NTHR = 512;
constexpr int RING_BYTES = 131072, LDSCTL_OFF = 143360, MISC_OFF = LDSCTL_OFF + 320, LDS_BYTES = 147456;

struct Params { const float* in[N_IN]; float* out; unsigned char* ws; };

__device__ __forceinline__ float bf2f(unsigned h) { return __uint_as_float(h << 16); }
typedef __bf16 hwbf2 __attribute__((ext_vector_type(2)));
typedef float f32x2 __attribute__((ext_vector_type(2)));
__device__ __forceinline__ unsigned pk2(float lo, float hi) { const f32x2 x = {lo, hi}; const hwbf2 r = __builtin_convertvector(x, hwbf2); return __builtin_bit_cast(unsigned, r); }
__device__ __forceinline__ unsigned f2bf(float f) { return pk2(f, 0.f) & 0xffffu; }
__device__ __forceinline__ float wave_sum(float v) {
#pragma unroll
    for (int o = 1; o < 64; o <<= 1) v += __shfl_xor(v, o);
    return v;
}
__device__ __forceinline__ float sigmoidf_(float x) { return 1.f / (1.f + __expf(-x)); }
#define LDS_WAIT() asm volatile("s_waitcnt lgkmcnt(0)" ::: "memory")
#define VM_WAIT() asm volatile("s_waitcnt vmcnt(0)" ::: "memory")

struct Frame {
    LAS unsigned char* lds;
    int tid, lane, wave, vcu, G, gw, NGW;
    float* out; unsigned char* ws;
};
#if defined(__HIP_DEVICE_COMPILE__)
#define ASSUME_GLOBAL(p) do { __builtin_assume(!__builtin_amdgcn_is_shared(p)); __builtin_assume(!__builtin_amdgcn_is_private(p)); } while (0)
#else
#define ASSUME_GLOBAL(p) do { } while (0)
#endif
__device__ __forceinline__ const float* inptr(int i) {
    const volatile unsigned long long __attribute__((address_space(4)))* ka = (const volatile unsigned long long __attribute__((address_space(4)))*)__builtin_amdgcn_kernarg_segment_ptr();
    return (const float*)(const __attribute__((address_space(1))) float*)ka[i];
}
__device__ __forceinline__ unsigned char* opaque(unsigned char* p) { unsigned long z = 0; asm volatile("" : "+s"(z)); return p + z; }
__device__ __forceinline__ Frame phase_frame(const Frame& F0) { Frame F = F0; asm volatile("" : "+v"(F.tid)); F.lane = F.tid & 63; F.ws = opaque(F0.ws);
    asm volatile("" : "+s"(F.G), "+s"(F.vcu)); F.gw = F.vcu * NWAVES + F.wave; F.NGW = F.G * NWAVES; return F; }
__device__ __forceinline__ int modrow(int row) { return row < NLAT ? (row >> 13) : 2; }
#define XB_TMO      128
#define XB_XCNT(j)  (256  + 64 * (j))
#define XB_XSUB(j)  (1280 + 64 * (j))
#define XB_XGEN(j)  (2304 + 64 * (j))
#define XB_TOP      3328
#define XB_TOPGEN   3392
#define XCD_BAR_WORDS 3456
#define XB_SPIN_CAP (1u << 18)

__device__ __forceinline__ unsigned xb_ld(unsigned* p)              { return __hip_atomic_load(p, __ATOMIC_RELAXED, __HIP_MEMORY_SCOPE_AGENT); }
__device__ __forceinline__ unsigned xb_add(unsigned* p, unsigned v) { return __hip_atomic_fetch_add(p, v, __ATOMIC_RELAXED, __HIP_MEMORY_SCOPE_AGENT); }
__device__ __forceinline__ unsigned xb_xcc_id() { return (unsigned)__builtin_amdgcn_s_getreg((3 << 11) | 20) & 0xFu; }
#define XB_SPIN(cond, bar) do { unsigned _sp = 0; while (cond) { __builtin_amdgcn_s_sleep(1); \
    if ((++_sp & 255u) == 0u) { if (xb_ld(&(bar)[XB_TMO])) break; if (_sp > XB_SPIN_CAP) { atomicAdd(&(bar)[XB_TMO], 1u); break; } } } } while (0)

struct XcdBarrier {
    unsigned* bar; unsigned x;
    volatile LAS unsigned* st;
};

__device__ __forceinline__ XcdBarrier xcd_barrier_post(unsigned* bar, volatile LAS unsigned* st) {
    XcdBarrier b; b.bar = bar; b.x = xb_xcc_id(); b.st = st;
    if (threadIdx.x == 0) (void)xb_add(&bar[XB_XCNT(b.x)], 1u);
    return b;
}
__device__ __forceinline__ void xcd_barrier_complete(unsigned* bar, unsigned x, unsigned& nloc, unsigned& nx) {
    const unsigned G = gridDim.x * gridDim.y * gridDim.z;
    unsigned sum, cnt, mine, sp = 0u;
    for (;;) {
        sum = 0u; cnt = 0u; mine = 0u;
#pragma nounroll
        for (unsigned j = 0; j < 16; ++j) { const unsigned c = xb_ld(&bar[XB_XCNT(j)]); sum += c; cnt += (c > 0u) ? 1u : 0u; mine = (j == x) ? c : mine; }
        if (sum == G) break;
        __builtin_amdgcn_s_sleep(1);
        if ((++sp & 255u) == 0u) { if (xb_ld(&bar[XB_TMO])) break; if (sp > XB_SPIN_CAP) { atomicAdd(&bar[XB_TMO], 1u); break; } }
    }
    nloc = mine > 0u ? mine : 1u; nx = cnt > 0u ? cnt : 1u;
}

__device__ __forceinline__ void xcd_barrier(const XcdBarrier& b) {
    asm volatile("s_waitcnt vmcnt(0)" ::: "memory");
    __syncthreads();
    if (threadIdx.x == 0) {
        unsigned* bar = b.bar;
        asm volatile("" : "+s"(bar));
        __builtin_amdgcn_s_waitcnt(0);
        unsigned nloc = b.st[0], nx = b.st[1];
        if (nloc == 0u) { xcd_barrier_complete(bar, b.x, nloc, nx); b.st[0] = nloc; b.st[1] = nx; }
        const unsigned old = xb_add(&bar[XB_XSUB(b.x)], 1u);
        const unsigned gen = old / nloc;
        if (old + 1u == (gen + 1u) * nloc) {
            __builtin_amdgcn_fence(__ATOMIC_RELEASE, "agent");
            asm volatile("s_waitcnt vmcnt(0)" ::: "memory");
            const unsigned og = xb_add(&bar[XB_TOP], 1u);
            const unsigned tg = og / nx;
            if (og + 1u == (tg + 1u) * nx) xb_add(&bar[XB_TOPGEN], 1u);
            else XB_SPIN(xb_ld(&bar[XB_TOPGEN]) == tg, bar);
            __builtin_amdgcn_fence(__ATOMIC_ACQUIRE, "agent");
            xb_add(&bar[XB_XGEN(b.x)], 1u);
            asm volatile("s_waitcnt vmcnt(0)" ::: "memory");
        } else {
            XB_SPIN(xb_ld(&bar[XB_XGEN(b.x)]) == gen, bar);
            __builtin_amdgcn_fence(__ATOMIC_ACQUIRE, "agent");
            asm volatile("s_waitcnt vmcnt(0)" ::: "memory");
        }
    }
    __syncthreads();
}
template <class RowMap>
__device__ __forceinline__ void transpose_item(const float* W, int ldw, int k0, int n0, bf16* WT, int ldt, RowMap rm, LAS float* scr, int lane) {
    (void)scr;
    const int nq = lane & 7, kg = lane >> 3; const float* src = W + (size_t)(k0 + 8 * kg) * ldw + n0 + 4 * nq;
    f32x4 v[8];
#pragma unroll
    for (int i = 0; i < 8; ++i) v[i] = *(const f32x4*)(src + (size_t)i * ldw);
#pragma unroll
    for (int j = 0; j < 4; ++j) { u32x4 o = {pk2(v[0][j], v[1][j]), pk2(v[2][j], v[3][j]), pk2(v[4][j], v[5][j]), pk2(v[6][j], v[7][j])};
        *(u32x4*)(WT + (size_t)rm(n0 + 4 * nq + j) * ldt + k0 + 8 * kg) = o; }
}
struct RmId { int off; __device__ __forceinline__ int operator()(int n) const { return off + n; } };
struct RmGU { int off; __device__ __forceinline__ int operator()(int n) const { return off + ((n >> 2) << 3) + (n & 3); } };

__device__ __forceinline__ void p0_prologue(const Frame& F0) {
    const Frame F = phase_frame(F0); unsigned char* const ws = F.ws;
    LAS float* scr = (LAS float*)(F.lds + F.wave * 16384);
    LAS float* ctab = (LAS float*)(F.lds + 8 * 16384);
    if (F.tid < 64) ctab[F.tid] = cosf((float)F.tid * (6.283185307179586f / 64.f));
    __syncthreads();
    bf16* win_t = (bf16*)(ws + WS_WIN_T); bf16* wout_t = (bf16*)(ws + WS_WOUT_T);
    constexpr int I_WIN_L = 16 * 84, I_WOUT_L = 16 * 32, I_FOLD_L = 4 * 64, I_MOD_L = 96 * 8;
    constexpr int NIT = 2 * (I_WIN_L + I_WOUT_L + I_FOLD_L + I_MOD_L);
    const float* p_win = inptr(I_WIN); const float* p_wout = inptr(I_WOUT); const float* p_c = inptr(I_C); const float* p_cctx = inptr(I_CCTX); const float* p_adaw = inptr(I_ADAW);
    {
        bf16* wl = (bf16*)(ws + 64 * 1024); const float* dw2 = inptr(I_DW2); const float* ia2 = inptr(I_IA2); const float* gg2 = inptr(I_GG2);
        for (int idx = F.vcu * NTHR + F.tid; idx < 2 * 384 * 512; idx += F.G * NTHR) { const int c = idx & 511, k = (idx >> 9) % 384, l = idx / (384 * 512);
            float v;
            if (k < 128) v = dw2[((size_t)(l * 2 + (k >> 6)) * 64 + (k & 63)) * DR + c];
            else if (k < 256) v = ia2[((size_t)(l * 2 + ((k - 128) >> 6)) * 64 + (k & 63)) * DR + c];
            else v = gg2[((size_t)l * 128 + (k - 256)) * DR + c];
            wl[((size_t)l * 512 + c) * 384 + k] = (bf16)f2bf(v); } }
    for (int it = F.gw; it < NIT; it += F.NGW) {
        int r = it; const int l = r & 1; r >>= 1;
        if (r < I_WIN_L) { const int kb = r / 84, nb = r % 84;
            transpose_item(p_win + (size_t)l * D * DIN, DIN, kb * 64, nb * 32, win_t + (size_t)l * NP * D, D, RmId{0}, scr, F.lane); continue; }
        r -= I_WIN_L;
        if (r < I_WOUT_L) { const int kb = r / 32, nb = r % 32;
            transpose_item(p_wout + (size_t)l * D * D, D, kb * 64, nb * 32, wout_t + (size_t)l * D * D, D, RmId{0}, scr, F.lane); continue; }
        r -= I_WOUT_L;
        if (r < I_FOLD_L) {
            const int g = r >> 6, k0 = (r & 63) * 16; const float* W = p_win + (size_t)l * D * DIN;
#pragma unroll
            for (int kk = 0; kk < 16; ++kk) scr[kk * 64 + F.lane] = W[(size_t)(k0 + kk) * DIN + 2688 + g * 64 + F.lane];
            LDS_WAIT(); asm volatile("" ::: "memory");
            float ac[16], as[16];
#pragma unroll
            for (int kk = 0; kk < 16; ++kk) { ac[kk] = 0.f; as[kk] = 0.f; }
            for (int c = 0; c < 64; ++c) { const int idx = (c * F.lane) & 63; const float cc = ctab[idx], ss = ctab[(idx - 16) & 63];
#pragma unroll
                for (int kk = 0; kk < 16; ++kk) { const float w = scr[kk * 64 + c]; ac[kk] += w * cc; as[kk] += w * ss; } }
            bf16* oc = win_t + (size_t)l * NP * D + (size_t)(COL_FC + g * 64 + F.lane) * D + k0;
            bf16* os = win_t + (size_t)l * NP * D + (size_t)(COL_FS + g * 64 + F.lane) * D + k0;
            u32x4 a, b;
            a.x = pk2(ac[0], ac[1]); a.y = pk2(ac[2], ac[3]); a.z = pk2(ac[4], ac[5]); a.w = pk2(ac[6], ac[7]);
            b.x = pk2(ac[8], ac[9]); b.y = pk2(ac[10], ac[11]); b.z = pk2(ac[12], ac[13]); b.w = pk2(ac[14], ac[15]);
            *(u32x4*)oc = a; *(u32x4*)(oc + 8) = b;
            a.x = pk2(as[0], as[1]); a.y = pk2(as[2], as[3]); a.z = pk2(as[4], as[5]); a.w = pk2(as[6], as[7]);
            b.x = pk2(as[8], as[9]); b.y = pk2(as[10], as[11]); b.z = pk2(as[12], as[13]); b.w = pk2(as[14], as[15]);
            *(u32x4*)os = a; *(u32x4*)(os + 8) = b;
            LDS_WAIT(); asm volatile("" ::: "memory");
            continue; }
        r -= I_FOLD_L;
        {
            const int cb = r >> 3, ks = r & 7;
#pragma unroll
            for (int q = 0; q < 2; ++q) { const int k = ks * 128 + q * 64 + F.lane;
                const float c0 = p_c[k], c1 = p_c[D + k], c2 = p_cctx[k];
                scr[0 * 128 + q * 64 + F.lane] = c0 * sigmoidf_(c0); scr[1 * 128 + q * 64 + F.lane] = c1 * sigmoidf_(c1); scr[2 * 128 + q * 64 + F.lane] = c2 * sigmoidf_(c2); }
            LDS_WAIT(); asm volatile("" ::: "memory");
            const float* W = p_adaw + (size_t)l * D * 6144 + (size_t)(ks * 128) * 6144 + cb * 64 + F.lane;
            float a0 = 0.f, a1 = 0.f, a2 = 0.f;
#pragma unroll 8
            for (int kk = 0; kk < 128; ++kk) { const float w = W[(size_t)kk * 6144]; a0 += scr[kk] * w; a1 += scr[128 + kk] * w; a2 += scr[256 + kk] * w; }
            float* mp = (float*)(ws + WS_MODP) + (size_t)((l * 8 + ks) * 3) * 6144 + cb * 64 + F.lane;
            mp[0] = a0; mp[6144] = a1; mp[2 * 6144] = a2;
            LDS_WAIT(); asm volatile("" ::: "memory");
        }
    }
}

__device__ __forceinline__ void mod_to_lds(const Frame& F0, int l, int p, LAS float* dst, bool from_partials) {
    const Frame F = phase_frame(F0); unsigned char* const ws = F.ws;
    const float* adab = inptr(I_ADAB);
    for (int idx = F.tid; idx < 3 * 1024; idx += NTHR) { const int r = idx >> 10, n = idx & 1023;
        float v;
        if (from_partials) { v = adab[l * 6144 + p * 1024 + n]; const float* mp = (const float*)(ws + WS_MODP) + (size_t)(l * 8 * 3 + r) * 6144 + p * 1024 + n;
#pragma unroll
            for (int ks = 0; ks < 8; ++ks) v += mp[(size_t)ks * 3 * 6144]; }
        else v = ((const float*)(ws + WS_MODF))[(size_t)(l * 3 + r) * 6144 + p * 1024 + n];
        dst[idx] = v; }
}
__device__ __forceinline__ void mod_finalize(const Frame& F0) {
    const Frame F = phase_frame(F0); unsigned char* const ws = F.ws;
    const float* adab = inptr(I_ADAB);
    for (int idx = F.vcu * NTHR + F.tid; idx < 2 * 3 * 6144; idx += F.G * NTHR) { const int l = idx / (3 * 6144), rem = idx % (3 * 6144), r = rem / 6144, n = rem % 6144;
        float v = adab[l * 6144 + n]; const float* mp = (const float*)(ws + WS_MODP) + (size_t)(l * 8 * 3 + r) * 6144 + n;
#pragma unroll
        for (int ks = 0; ks < 8; ++ks) v += mp[(size_t)ks * 3 * 6144];
        ((float*)(ws + WS_MODF))[idx] = v; }
}


__device__ __forceinline__ void norm_mod_row(f32x4 (&v)[4], const float* gain, const LAS float* sc, const LAS float* sh, bf16* orow, int lane) {
    float s = 0.f;
#pragma unroll
    for (int j = 0; j < 4; ++j) s += (v[j].x * v[j].x + v[j].y * v[j].y) + (v[j].z * v[j].z + v[j].w * v[j].w);
    const float rs = rsqrtf(wave_sum(s) * (1.f / D) + RMS_EPS);
#pragma unroll
    for (int j = 0; j < 4; ++j) { const int c = 4 * lane + 256 * j; const f32x4 g = *(const f32x4*)(gain + c); const f32x4 a = *(const LAS f32x4*)(sc + c), b = *(const LAS f32x4*)(sh + c);
        v[j] = (v[j] * rs) * g * (a + 1.f) + b;
        u32x2 w; w.x = pk2(v[j].x, v[j].y); w.y = pk2(v[j].z, v[j].w); *(u32x2*)(orow + c) = w; }
}

__device__ __forceinline__ void p0b_norm1(const Frame& F0) {
    const Frame F = phase_frame(F0); unsigned char* const ws = F.ws;
    LAS float* msh = (LAS float*)F.lds; LAS float* msc = msh + 3072;
    mod_to_lds(F, 0, 0, msh, true); mod_to_lds(F, 0, 1, msc, true); __syncthreads();
    mod_finalize(F);
    bf16* H = (bf16*)(ws + WS_H); const float* xin = inptr(I_X); const float* cin = inptr(I_CTX); const float* n1g = inptr(I_N1G);
    for (int row0 = F.gw; row0 < NROW; row0 += 2 * F.NGW) { f32x4 v[2][4]; bool ok[2];
#pragma unroll
        for (int u = 0; u < 2; ++u) { const int row = row0 + u * F.NGW; ok[u] = row < NROW; if (ok[u]) { const float* xr = row < NLAT ? xin + (size_t)row * D : cin + (size_t)(row - NLAT) * D;
#pragma unroll
            for (int j = 0; j < 4; ++j) v[u][j] = *(const f32x4*)(xr + 4 * F.lane + 256 * j); } }
#pragma unroll
        for (int u = 0; u < 2; ++u) if (ok[u]) { const int row = row0 + u * F.NGW; const int mr = modrow(row);
            norm_mod_row(v[u], n1g, msc + mr * 1024, msh + mr * 1024, H + (size_t)row * D, F.lane); } }
}
__device__ __forceinline__ void unpack8(const u32x4 w, float (&o)[8]) {
    o[0] = bf2f(w.x & 0xffffu); o[1] = bf2f(w.x >> 16); o[2] = bf2f(w.y & 0xffffu); o[3] = bf2f(w.y >> 16);
    o[4] = bf2f(w.z & 0xffffu); o[5] = bf2f(w.z >> 16); o[6] = bf2f(w.w & 0xffffu); o[7] = bf2f(w.w >> 16);
}
__device__ __forceinline__ void unpack4(const u32x2 w, float (&o)[4]) { o[0] = bf2f(w.x & 0xffffu); o[1] = bf2f(w.x >> 16); o[2] = bf2f(w.y & 0xffffu); o[3] = bf2f(w.y >> 16); }

__device__ __forceinline__ void shift_pass(const Frame& F0, int l) {
    const Frame F = phase_frame(F0); unsigned char* const ws = F.ws;
    const bf16* P = (const bf16*)(ws + WS_P); bf16* Zs = (bf16*)(ws + WS_ZS); const float* mu = inptr(I_MU) + l * ZW;
    const int total = NROW * 240;
    for (int idx = F.vcu * NTHR + F.tid; idx < total; idx += F.G * NTHR) {
        const int row = idx / 240, ck = idx % 240; const bf16* pr = P + (size_t)row * NP + ck * 8;
        const u32x4 zero = {0u, 0u, 0u, 0u};
        float z[8], n0[8], n1[8], n2[8], n3[8], o[8];
        unpack8(*(const u32x4*)pr, z);
        if (row < NLAT) { const int t = row & (SEQ - 1), gr = t >> 6, gc = t & 63;
            unpack8(gc > 0 ? *(const u32x4*)(pr - NP) : zero, n0); unpack8(gc < 63 ? *(const u32x4*)(pr + NP) : zero, n1);
            unpack8(gr > 0 ? *(const u32x4*)(pr - 64 * NP) : zero, n2); unpack8(gr < 127 ? *(const u32x4*)(pr + 64 * NP) : zero, n3);
        } else { const int tc = (row - NLAT) & (CTXL - 1);
            unpack8(tc > 0 ? *(const u32x4*)(pr - NP) : zero, n0); unpack8(tc < CTXL - 1 ? *(const u32x4*)(pr + NP) : zero, n1);
#pragma unroll
            for (int j = 0; j < 8; ++j) { n2[j] = n0[j]; n3[j] = n1[j]; }
        }
        const f32x4 m0 = *(const f32x4*)(mu + ck * 8), m1 = *(const f32x4*)(mu + ck * 8 + 4);
        const float m[8] = {m0.x, m0.y, m0.z, m0.w, m1.x, m1.y, m1.z, m1.w};
#pragma unroll
        for (int j = 0; j < 8; ++j) { const float nb = (j & 3) == 0 ? n0[j] : (j & 3) == 1 ? n1[j] : (j & 3) == 2 ? n2[j] : n3[j]; o[j] = z[j] + (nb - z[j]) * m[j]; }
        u32x4 w; w.x = pk2(o[0], o[1]); w.y = pk2(o[2], o[3]); w.z = pk2(o[4], o[5]); w.w = pk2(o[6], o[7]);
        *(u32x4*)(Zs + (size_t)row * ZW + ck * 8) = w;
    }
}

__device__ __forceinline__ void conv_pass(const Frame& F0, int l, int nrows) {
    const Frame F = phase_frame(F0); unsigned char* const ws = F.ws;
    const bf16* P = (const bf16*)(ws + WS_P); bf16* MA = (bf16*)(ws + WS_H);
    const float* cw = inptr(I_CONVW) + l * 3 * 256; const int c = 4 * F.lane;
    const f32x4 w0 = *(const f32x4*)(cw + c), w1 = *(const f32x4*)(cw + 256 + c), w2 = *(const f32x4*)(cw + 512 + c), gn = *(const f32x4*)(inptr(I_CONVG) + l * 256 + c);
    for (int row0 = F.gw; row0 < nrows; row0 += 2 * F.NGW) {
        u32x2 q[2][7]; bool ok[2]; const u32x2 zero = {0u, 0u};
#pragma unroll
        for (int u = 0; u < 2; ++u) { const int row = row0 + u * F.NGW; ok[u] = row < nrows; if (ok[u]) {
            int t, L; if (row < NLAT) { t = row & (SEQ - 1); L = SEQ; } else { t = (row - NLAT) & (CTXL - 1); L = CTXL; }
            const bf16* pr = P + (size_t)row * NP + COL_CONV + c;
            q[u][0] = *(const u32x2*)pr; q[u][1] = *(const u32x2*)(pr + 256); q[u][2] = *(const u32x2*)(pr + 512);
            q[u][3] = t > 0 ? *(const u32x2*)(pr - NP + 256) : zero; q[u][4] = t > 0 ? *(const u32x2*)(pr - NP + 512) : zero;
            q[u][5] = t < L - 1 ? *(const u32x2*)(pr + NP + 256) : zero; q[u][6] = t < L - 1 ? *(const u32x2*)(pr + NP + 512) : zero; } }
#pragma unroll
        for (int u = 0; u < 2; ++u) if (ok[u]) { const int row = row0 + u * F.NGW;
            float bg[4], cg[4], hh[4], cp[4], hp[4], cn[4], hn[4];
            unpack4(q[u][0], bg); unpack4(q[u][1], cg); unpack4(q[u][2], hh); unpack4(q[u][3], cp); unpack4(q[u][4], hp); unpack4(q[u][5], cn); unpack4(q[u][6], hn);
            const float W0[4] = {w0.x, w0.y, w0.z, w0.w}, W1[4] = {w1.x, w1.y, w1.z, w1.w}, W2[4] = {w2.x, w2.y, w2.z, w2.w}, GN[4] = {gn.x, gn.y, gn.z, gn.w};
            float y[4], s = 0.f;
#pragma unroll
            for (int j = 0; j < 4; ++j) { y[j] = bg[j] * (W0[j] * (cp[j] * hp[j]) + W1[j] * (cg[j] * hh[j]) + W2[j] * (cn[j] * hn[j])); s += y[j] * y[j]; }
            const float rs = rsqrtf(wave_sum(s) * (1.f / 256.f) + RMS_EPS);
            u32x2 o; o.x = pk2(y[0] * rs * GN[0], y[1] * rs * GN[1]); o.y = pk2(y[2] * rs * GN[2], y[3] * rs * GN[3]);
            *(u32x2*)(MA + (size_t)row * D + 512 + c) = o; }
    }
}

__device__ __forceinline__ void sincos_turns(float x, float& s, float& c) { s = __builtin_amdgcn_sinf(x); c = __builtin_amdgcn_cosf(x); }
#define MFMA16(a, b, c) __builtin_amdgcn_mfma_f32_16x16x32_bf16((a), (b), (c), 0, 0, 0)

__device__ __forceinline__ void fftA_item(const Frame& F0, int item) {
    const Frame F = phase_frame(F0); unsigned char* const ws = F.ws;
    const int half = item & 1, t2 = (item >> 1) & 63, b = item >> 7;
    const bf16* P = (const bf16*)(ws + WS_P); bf16* GT = (bf16*)(ws + WS_GT);
    LAS bf16* Bs = (LAS bf16*)F.lds;
    const int lane = F.lane, w = F.wave, fr = lane & 15, fq = lane >> 4;
    __syncthreads();
#pragma unroll
    for (int i = 0; i < 8; ++i) { const int cidx = F.tid + NTHR * i, krow = cidx >> 4, ch8 = cidx & 15, ri = krow >> 7, t1 = krow & 127;
        const u32x4 v = *(const u32x4*)(P + (size_t)(b * SEQ + t1 * 64 + t2) * NP + COL_FC + ri * 256 + half * 128 + ch8 * 8);
        LAS bf16* d = Bs + (ch8 * 8) * 264 + krow;
        d[0 * 264] = (bf16)(v.x & 0xffffu); d[1 * 264] = (bf16)(v.x >> 16); d[2 * 264] = (bf16)(v.y & 0xffffu); d[3 * 264] = (bf16)(v.y >> 16);
        d[4 * 264] = (bf16)(v.z & 0xffffu); d[5 * 264] = (bf16)(v.z >> 16); d[6 * 264] = (bf16)(v.w & 0xffffu); d[7 * 264] = (bf16)(v.w >> 16); }
    __syncthreads();
    f32x4 acc[2][8];
#pragma unroll
    for (int a = 0; a < 2; ++a)
#pragma unroll
        for (int n = 0; n < 8; ++n) acc[a][n] = (f32x4){0.f, 0.f, 0.f, 0.f};
    int t1p_a = 16 * w + fr;
    asm volatile("" : "+v"(t1p_a));
#pragma unroll
    for (int ks = 0; ks < 8; ++ks) {
        bf16x8 ar, ai;
#pragma unroll
        for (int j = 0; j < 8; ++j) { const int k = ks * 32 + 8 * fq + j, ri = k >> 7, t1 = k & 127; const int idx = (t1 * t1p_a) & 127;
            float sn, cs; sincos_turns((float)idx * (1.f / 128.f), sn, cs);
            const float vr = ri == 0 ? cs : -sn, vi = ri == 0 ? -sn : -cs;
            ar[j] = (short)f2bf(vr); ai[j] = (short)f2bf(vi); }
#pragma unroll
        for (int nt = 0; nt < 8; ++nt) { const bf16x8 bfr = *(const LAS bf16x8*)(Bs + (nt * 16 + fr) * 264 + ks * 32 + 8 * fq);
            acc[0][nt] = MFMA16(ar, bfr, acc[0][nt]); acc[1][nt] = MFMA16(ai, bfr, acc[1][nt]); }
    }
#pragma unroll
    for (int reg = 0; reg < 4; ++reg) { const int t1p = 16 * w + 4 * fq + reg; float st, ct; sincos_turns((float)(t2 * t1p) * (1.f / 8192.f), st, ct);
        bf16* g = GT + ((size_t)((b * 128 + t1p) * 64 + t2) * 2) * 256 + half * 128 + fr;
#pragma unroll
        for (int nt = 0; nt < 8; ++nt) { const float gr = acc[0][nt][reg], gi = acc[1][nt][reg];
            g[nt * 16] = (bf16)f2bf(gr * ct + gi * st); g[256 + nt * 16] = (bf16)f2bf(gi * ct - gr * st); } }
}

template <int NKC, int NDIV, class SrcRow, class OutRow>
__device__ __forceinline__ void dft64_item(const Frame& F0, int l, int m0, float sgn, float scale, SrcRow src, OutRow orow) {
    const Frame F = phase_frame(F0); unsigned char* const ws = F.ws;
    LAS bf16* Bs = (LAS bf16*)F.lds;
    LAS float* red = (LAS float*)(F.lds + 256 * 136 * 2);
    const int lane = F.lane, w = F.wave, fr = lane & 15, fq = lane >> 4;
    int fr_a = fr; asm volatile("" : "+v"(fr_a));
    f32x4 acc[4][2];
#pragma unroll
    for (int a = 0; a < 4; ++a) { acc[a][0] = (f32x4){0.f, 0.f, 0.f, 0.f}; acc[a][1] = (f32x4){0.f, 0.f, 0.f, 0.f}; }
    for (int kc = 0; kc < NKC; ++kc) {
        __syncthreads();
#pragma unroll
        for (int i = 0; i < 8; ++i) { const int cidx = F.tid + NTHR * i, krow = cidx >> 5, ch8 = cidx & 31;
            const u32x4 v = *(const u32x4*)(src(kc * 64 + (krow >> 1), krow & 1) + ch8 * 8);
            LAS bf16* d = Bs + (ch8 * 8) * 136 + krow;
            d[0 * 136] = (bf16)(v.x & 0xffffu); d[1 * 136] = (bf16)(v.x >> 16); d[2 * 136] = (bf16)(v.y & 0xffffu); d[3 * 136] = (bf16)(v.y >> 16);
            d[4 * 136] = (bf16)(v.z & 0xffffu); d[5 * 136] = (bf16)(v.z >> 16); d[6 * 136] = (bf16)(v.w & 0xffffu); d[7 * 136] = (bf16)(v.w >> 16); }
        __syncthreads();
#pragma unroll
        for (int ks = 0; ks < 4; ++ks) {
            const bf16x8 b0 = *(const LAS bf16x8*)(Bs + ((2 * w) * 16 + fr) * 136 + ks * 32 + 8 * fq);
            const bf16x8 b1 = *(const LAS bf16x8*)(Bs + ((2 * w + 1) * 16 + fr) * 136 + ks * 32 + 8 * fq);
#pragma unroll
            for (int mt = 0; mt < 4; ++mt) { const int mrow = m0 + mt * 16 + fr_a; bf16x8 a;
#pragma unroll
                for (int j = 0; j < 8; ++j) { const int k = ks * 32 + 8 * fq + j, tl = k >> 1, ri = k & 1; const int idx = ((kc * 64 + tl) * mrow) & (NDIV - 1);
                    float sn, cs; sincos_turns((float)idx * (1.f / (float)NDIV), sn, cs);
                    a[j] = (short)f2bf(ri == 0 ? cs : sgn * sn); }
                acc[mt][0] = MFMA16(a, b0, acc[mt][0]); acc[mt][1] = MFMA16(a, b1, acc[mt][1]); }
        }
    }
#pragma unroll
    for (int mt = 0; mt < 4; ++mt)
#pragma unroll
        for (int reg = 0; reg < 4; ++reg) { const float a = acc[mt][0][reg] * scale, b = acc[mt][1][reg] * scale; acc[mt][0][reg] = a; acc[mt][1][reg] = b;
            float s = a * a + b * b; s += __shfl_xor(s, 1); s += __shfl_xor(s, 2); s += __shfl_xor(s, 4); s += __shfl_xor(s, 8);
            if (fr == 0) red[w * 64 + mt * 16 + 4 * fq + reg] = s; }
    __syncthreads();
    bf16* MA = (bf16*)(ws + WS_H); const float* fg = inptr(I_FOURG) + l * 256;
    const float g0 = fg[(2 * w) * 16 + fr], g1 = fg[(2 * w + 1) * 16 + fr];
#pragma unroll
    for (int mt = 0; mt < 4; ++mt)
#pragma unroll
        for (int reg = 0; reg < 4; ++reg) { const int ml = mt * 16 + 4 * fq + reg; float tot = 0.f;
#pragma unroll
            for (int ww = 0; ww < 8; ++ww) tot += red[ww * 64 + ml];
            const float rs = rsqrtf(tot * (1.f / 256.f) + RMS_EPS);
            bf16* o = MA + (size_t)orow(m0 + ml) * D + 768 + fr;
            o[(2 * w) * 16] = (bf16)f2bf(acc[mt][0][reg] * rs * g0); o[(2 * w + 1) * 16] = (bf16)f2bf(acc[mt][1][reg] * rs * g1); }
    __syncthreads();
}

constexpr size_t WS_LORA = 64 * 1024;
constexpr int LINP = 392;
__device__ __forceinline__ float fast_sigmoid(float x) { return __builtin_amdgcn_rcpf(1.f + __expf(-x)); }
__device__ __forceinline__ float fast_tanh(float x) { return 1.f - 2.f * __builtin_amdgcn_rcpf(1.f + __expf(2.f * x)); }
__device__ __forceinline__ void prep_phase(const Frame& F0, int l) {
    const Frame F = phase_frame(F0); unsigned char* const ws = F.ws;
    const bf16* Zs = (const bf16*)(ws + WS_ZS); bf16* STR = (bf16*)(ws + WS_STR);
    LAS bf16* lin = (LAS bf16*)F.lds;
    LAS float* ssum = (LAS float*)(F.lds + 12544);
    LAS bf16* tiles = (LAS bf16*)(F.lds + 13312);
    const int lane = F.lane, fr = lane & 15, fq = lane >> 4, w = F.wave, tid = F.tid;
    const int nitems = (NROW / 16) * 2;
    int it = blockIdx.x; if (it >= nitems) return;
    int hh = -1, head = 0, cb = 0;
    bf16x8 wf[12][2];
    const float* kkp = inptr(I_KK) + l * DR; const float* kap = inptr(I_KA) + l * DR; const float* dw0 = inptr(I_DW0) + l * 2 * DR; const float* ia0 = inptr(I_IA0) + l * 2 * DR;
    u32x4 pz[2];
#define PREP_LOAD(item_) do { const int row0_ = ((item_) >> 1) * 16; \
        pz[0] = *(const u32x4*)(Zs + (size_t)(row0_ + tid / 48) * ZW + 1536 + (tid % 48) * 8); \
        if (tid < 256) pz[1] = *(const u32x4*)(Zs + (size_t)(row0_ + (tid + 512) / 48) * ZW + 1536 + ((tid + 512) % 48) * 8); } while (0)
    PREP_LOAD(it);
    for (; it < nitems; it += F.G) {
        const int tile = it >> 1;
        if ((it & 1) != hh) {
            hh = it & 1; head = 4 * hh + (w >> 1); cb = 64 * head + 32 * (w & 1);
            const bf16* WL = (const bf16*)(ws + WS_LORA) + (size_t)l * 512 * 384 + (size_t)(cb + fr) * 384 + 8 * fq;
#pragma unroll
            for (int ks = 0; ks < 12; ++ks)
#pragma unroll
                for (int nt = 0; nt < 2; ++nt) wf[ks][nt] = *(const bf16x8*)(WL + (size_t)nt * 16 * 384 + ks * 32);
        }
        __syncthreads();
        {   float v[8]; unpack8(pz[0], v); const int c8 = tid % 48;
            if (c8 < 16) {
#pragma unroll
                for (int j = 0; j < 8; ++j) v[j] = fast_tanh(v[j]); }
            else if (c8 >= 32) {
#pragma unroll
                for (int j = 0; j < 8; ++j) v[j] = fast_sigmoid(v[j]); }
            *(LAS u32x4*)(lin + (tid / 48) * LINP + c8 * 8) = (u32x4){pk2(v[0], v[1]), pk2(v[2], v[3]), pk2(v[4], v[5]), pk2(v[6], v[7])};
            if (tid < 256) { unpack8(pz[1], v); const int c9 = (tid + 512) % 48;
                if (c9 < 16) {
#pragma unroll
                    for (int j = 0; j < 8; ++j) v[j] = fast_tanh(v[j]); }
                else if (c9 >= 32) {
#pragma unroll
                    for (int j = 0; j < 8; ++j) v[j] = fast_sigmoid(v[j]); }
                *(LAS u32x4*)(lin + ((tid + 512) / 48) * LINP + c9 * 8) = (u32x4){pk2(v[0], v[1]), pk2(v[2], v[3]), pk2(v[4], v[5]), pk2(v[6], v[7])}; } }
        u32x2 zr2[2], zk2[2], zv2[2];
        {   const bf16* zr_ = Zs + (size_t)(tile * 16 + fr) * ZW + cb + 4 * fq;
#pragma unroll
            for (int nt = 0; nt < 2; ++nt) { zr2[nt] = *(const u32x2*)(zr_ + 16 * nt); zk2[nt] = *(const u32x2*)(zr_ + 512 + 16 * nt); zv2[nt] = *(const u32x2*)(zr_ + 1024 + 16 * nt); } }
        if (it + F.G < nitems) PREP_LOAD(it + F.G);
        __syncthreads();
        f32x4 kkw[2], kaw[2], d0w[2][2], i0w[2][2];
#pragma unroll
        for (int nt = 0; nt < 2; ++nt) { const int c0 = cb + 16 * nt + 4 * fq; kkw[nt] = *(const f32x4*)(kkp + c0); kaw[nt] = *(const f32x4*)(kap + c0);
#pragma unroll
            for (int dn = 0; dn < 2; ++dn) { d0w[dn][nt] = *(const f32x4*)(dw0 + dn * DR + c0); i0w[dn][nt] = *(const f32x4*)(ia0 + dn * DR + c0); } }
        f32x4 acc[5][2];
#pragma unroll
        for (int q = 0; q < 5; ++q) { acc[q][0] = (f32x4){0.f, 0.f, 0.f, 0.f}; acc[q][1] = (f32x4){0.f, 0.f, 0.f, 0.f}; }
#pragma unroll
        for (int ks = 0; ks < 12; ++ks) { const int q = ks < 8 ? (ks >> 1) : 4; const bf16x8 xf = *(const LAS bf16x8*)(lin + fr * LINP + ks * 32 + 8 * fq);
            acc[q][0] = MFMA16(wf[ks][0], xf, acc[q][0]); acc[q][1] = MFMA16(wf[ks][1], xf, acc[q][1]); }
        float zk[2][4], kv[2][4]; float ss = 0.f;
#pragma unroll
        for (int nt = 0; nt < 2; ++nt) { unpack4(zk2[nt], zk[nt]);
#pragma unroll
            for (int i = 0; i < 4; ++i) { kv[nt][i] = zk[nt][i] * kkw[nt][i]; ss += kv[nt][i] * kv[nt][i]; } }
        ss += __shfl_xor(ss, 16); ss += __shfl_xor(ss, 32);
        if (fq == 0) ssum[w * 16 + fr] = ss;
        __syncthreads();
        const float inv = __builtin_amdgcn_rcpf(fmaxf(sqrtf(ssum[w * 16 + fr] + ssum[(w ^ 1) * 16 + fr]), 1e-12f));
        LAS bf16* th = tiles + (w >> 1) * 10 * 1024 + fr * 64 + 32 * (w & 1) + 4 * fq;
#pragma unroll
        for (int nt = 0; nt < 2; ++nt) { LAS bf16* t0 = th + 16 * nt;
            *(LAS u32x2*)(t0) = zr2[nt]; *(LAS u32x2*)(t0 + 1024) = zv2[nt];
            float kk[4];
#pragma unroll
            for (int i = 0; i < 4; ++i) kk[i] = kv[nt][i] * inv;
            *(LAS u32x2*)(t0 + 2 * 1024) = (u32x2){pk2(kk[0], kk[1]), pk2(kk[2], kk[3])};
            *(LAS u32x2*)(t0 + 3 * 1024) = (u32x2){pk2(acc[4][nt][0], acc[4][nt][1]), pk2(acc[4][nt][2], acc[4][nt][3])};
#pragma unroll
            for (int dn = 0; dn < 2; ++dn) { float ep[4], kd[4], bb[4];
#pragma unroll
                for (int i = 0; i < 4; ++i) { const float ew = fast_sigmoid(d0w[dn][nt][i] + acc[dn][nt][i]) * 0.6065306597126334f;
                    ep[i] = ew * (1.f + ew * (-0.5f + ew * (0.16666667f + ew * (-0.041666668f + ew * 0.0083333338f))));
                    const float a = fast_sigmoid(i0w[dn][nt][i] + acc[2 + dn][nt][i]); kd[i] = zk[nt][i] * (1.f + (a - 1.f) * kaw[nt][i]); bb[i] = kk[i] * a; }
                *(LAS u32x2*)(t0 + (4 + 3 * dn) * 1024) = (u32x2){pk2(ep[0], ep[1]), pk2(ep[2], ep[3])};
                *(LAS u32x2*)(t0 + (5 + 3 * dn) * 1024) = (u32x2){pk2(kd[0], kd[1]), pk2(kd[2], kd[3])};
                *(LAS u32x2*)(t0 + (6 + 3 * dn) * 1024) = (u32x2){pk2(bb[0], bb[1]), pk2(bb[2], bb[3])}; } }
        __syncthreads();
        {   const LAS bf16* src = tiles + (w >> 1) * 10 * 1024 + 8 * (w & 1) * 64 + lane * 8; bf16* dst = STR + ((size_t)tile * 8 + head) * 10240 + 8 * (w & 1) * 64 + lane * 8;
#pragma unroll
            for (int s = 0; s < 10; ++s) *(u32x4*)(dst + s * 1024) = *(const LAS u32x4*)(src + s * 1024); }
    }
#undef PREP_LOAD
}

__device__ __forceinline__ int scan_rowof(int s, int dir, int b) { if (s < CTXL) { const int tc = dir ? (CTXL - 1 - s) : s; return NLAT + b * CTXL + tc; } const int tt = s - CTXL; const int t = dir ? (SEQ - 1 - tt) : tt; return b * SEQ + t; }
__device__ __forceinline__ void scan_item(const Frame& F0, int item, bool need_ctx) {
    const Frame F = phase_frame(F0); unsigned char* const ws = F.ws;
    const int dir = item & 1, h = (item >> 1) & 7, b = item >> 4;
    const bf16* STR = (const bf16*)(ws + WS_STR); bf16* Y = (bf16*)(ws + WS_Y) + (size_t)dir * NROW * DR;
    const int lane = F.lane, kq = lane & 7, vrow = 8 * F.wave + (lane >> 3);
    float S[8];
#pragma unroll
    for (int j = 0; j < 8; ++j) S[j] = 0.f;
    const int co = h * 64 + kq * 8;
    constexpr int NSTEP = CTXL + SEQ;
#define rowof(s) scan_rowof((s), dir, b)
    for (int s0 = 0; s0 < NSTEP; s0 += 4) {
        u32x4 qkk[4], qe[4], qkd[4], qb[4], qr[4]; unsigned qv[4];
#pragma unroll
        for (int u = 0; u < 4; ++u) { const bf16* base = STR + (size_t)rowof(s0 + u) * STRW;
            qr[u] = *(const u32x4*)(base + co); qkk[u] = *(const u32x4*)(base + 1024 + co);
            qe[u] = *(const u32x4*)(base + 2048 + dir * 1536 + co); qkd[u] = *(const u32x4*)(base + 2048 + dir * 1536 + 512 + co); qb[u] = *(const u32x4*)(base + 2048 + dir * 1536 + 1024 + co);
            qv[u] = base[512 + h * 64 + vrow]; }
#pragma unroll
        for (int u = 0; u < 4; ++u) { float kk[8], e[8], kd[8], bb[8], r[8];
            unpack8(qkk[u], kk); unpack8(qe[u], e); unpack8(qkd[u], kd); unpack8(qb[u], bb); unpack8(qr[u], r);
            const float vv = bf2f(qv[u]);
            float sk = 0.f;
#pragma unroll
            for (int j = 0; j < 8; ++j) sk += S[j] * kk[j];
            sk += __shfl_xor(sk, 1); sk += __shfl_xor(sk, 2); sk += __shfl_xor(sk, 4);
            float y = 0.f;
#pragma unroll
            for (int j = 0; j < 8; ++j) { S[j] = S[j] * (1.f - e[j]) - sk * bb[j] + vv * kd[j]; y += S[j] * r[j]; }
            y += __shfl_xor(y, 1); y += __shfl_xor(y, 2); y += __shfl_xor(y, 4);
            const int s = s0 + u;
            if (kq == 0 && (s >= CTXL || need_ctx)) Y[(size_t)rowof(s) * DR + h * 64 + vrow] = (bf16)f2bf(y); }
    }
#undef rowof
}

__device__ __forceinline__ void readout_pass(const Frame& F0, int l, int nrows) {
    const Frame F = phase_frame(F0); unsigned char* const ws = F.ws;
    const bf16* STR = (const bf16*)(ws + WS_STR); const bf16* Y0 = (const bf16*)(ws + WS_Y); const bf16* Y1 = Y0 + (size_t)NROW * DR; bf16* MA = (bf16*)(ws + WS_H);
    const int lane = F.lane, c = 8 * lane;
    float gw[8], gb[8], rk[8];
    {   const float* gnw = inptr(I_GNW) + l * DR + c; const float* gnb = inptr(I_GNB) + l * DR + c; const float* rkp = inptr(I_RK) + l * DR + c;
        const f32x4 a0 = *(const f32x4*)gnw, a1 = *(const f32x4*)(gnw + 4), b0 = *(const f32x4*)gnb, b1 = *(const f32x4*)(gnb + 4), r0 = *(const f32x4*)rkp, r1 = *(const f32x4*)(rkp + 4);
#pragma unroll
        for (int i = 0; i < 4; ++i) { gw[i] = a0[i]; gw[4 + i] = a1[i]; gb[i] = b0[i]; gb[4 + i] = b1[i]; rk[i] = r0[i]; rk[4 + i] = r1[i]; } }
    for (int row0 = F.gw; row0 < nrows; row0 += 2 * F.NGW) {
        u32x4 q[2][7]; bool ok[2];
#pragma unroll
        for (int u = 0; u < 2; ++u) { const int row = row0 + u * F.NGW; ok[u] = row < nrows; if (ok[u]) {
            const bf16* sr = STR + ((size_t)(row >> 4) * 8 + (lane >> 3)) * 10240 + (row & 15) * 64 + (lane & 7) * 8;
            q[u][0] = *(const u32x4*)(Y0 + (size_t)row * DR + c); q[u][1] = *(const u32x4*)(Y1 + (size_t)row * DR + c);
            q[u][2] = *(const u32x4*)sr; q[u][3] = *(const u32x4*)(sr + 1024); q[u][4] = *(const u32x4*)(sr + 3072); q[u][5] = *(const u32x4*)(sr + 5 * 1024); q[u][6] = *(const u32x4*)(sr + 8 * 1024); } }
#pragma unroll
        for (int u = 0; u < 2; ++u) if (ok[u]) { const int row = row0 + u * F.NGW;
            float ya[8], yb[8], r[8], v[8], g[8], k0[8], k1[8];
            unpack8(q[u][0], ya); unpack8(q[u][1], yb); unpack8(q[u][2], r); unpack8(q[u][3], v); unpack8(q[u][4], g); unpack8(q[u][5], k0); unpack8(q[u][6], k1);
            float s1 = 0.f, s2 = 0.f, sb = 0.f;
#pragma unroll
            for (int i = 0; i < 8; ++i) { ya[i] += yb[i]; s1 += ya[i]; s2 += ya[i] * ya[i]; sb += r[i] * (k0[i] + k1[i]) * rk[i]; }
#pragma unroll
            for (int o = 1; o < 8; o <<= 1) { s1 += __shfl_xor(s1, o); s2 += __shfl_xor(s2, o); sb += __shfl_xor(sb, o); }
            const float mu = s1 * (1.f / 64.f); const float var = fmaxf(s2 * (1.f / 64.f) - mu * mu, 0.f); const float rs = rsqrtf(var + GN_EPS);
            float o8[8];
#pragma unroll
            for (int i = 0; i < 8; ++i) o8[i] = ((ya[i] - mu) * rs * gw[i] + gb[i] + sb * v[i]) * g[i];
            *(u32x4*)(MA + (size_t)row * D + c) = (u32x4){pk2(o8[0], o8[1]), pk2(o8[2], o8[3]), pk2(o8[4], o8[5]), pk2(o8[6], o8[7])}; }
    }
}
constexpr int BLOB = 16384, SEGCH = 264, NSEG = 2, BLOB_R1_SCANS = 23;
constexpr size_t WS_BLOB1 = 20 * MiB, WS_BLOB2 = 492 * MiB, WS_SCANST = WS_GT;
__device__ __forceinline__ unsigned char* blob_ptr(unsigned char* ws, int scan, int ci) {
    return scan < BLOB_R1_SCANS ? ws + WS_BLOB1 + ((size_t)scan * SEGCH + ci) * BLOB : ws + WS_BLOB2 + ((size_t)(scan - BLOB_R1_SCANS) * SEGCH + ci) * BLOB;
}
typedef short s16x4 __attribute__((ext_vector_type(4)));
__device__ __forceinline__ bf16x8 frag_lo(u32x2 x) { u32x4 t = {x.x, x.y, 0u, 0u}; return __builtin_bit_cast(bf16x8, t); }
__device__ __forceinline__ bf16x8 frag_c(const f32x4& a) { u32x4 t = {pk2(a[0], a[1]), pk2(a[2], a[3]), 0u, 0u}; return __builtin_bit_cast(bf16x8, t); }

struct PreRegs { u32x4 q[12]; };
__device__ __forceinline__ void pre_load(PreRegs& R, unsigned char* ws, int scan, int cs, int lane) {
    const int dir = scan & 1, h = (scan >> 1) & 7, b = scan >> 4; const int rfirst = scan_rowof(16 * cs, dir, b);
    const bf16* blk = (const bf16*)(ws + WS_STR) + ((size_t)(rfirst >> 4) * 8 + h) * 10240 + lane * 8;
    const int so[6] = {0, 1, 2, 4 + 3 * dir, 5 + 3 * dir, 6 + 3 * dir};
#pragma unroll
    for (int i = 0; i < 6; ++i) { R.q[2 * i] = *(const u32x4*)(blk + so[i] * 1024); R.q[2 * i + 1] = *(const u32x4*)(blk + so[i] * 1024 + 512); }
}
template <int PM>
__device__ __forceinline__ void pre_item(const Frame& F, unsigned char* ws, int scan, int cs, unsigned char* blob, PreRegs& PR, int nscan, int ncs) {
    const int dir = scan & 1, h = (scan >> 1) & 7, b = scan >> 4; const int lane = F.lane, fr = lane & 15, fq = lane >> 4;
    LAS unsigned char* L = F.lds + F.wave * 17408;
    LAS bf16* TK = (LAS bf16*)L; LAS bf16* TR = TK + 1024; LAS bf16* TKt = TR + 1024; LAS bf16* TB = TKt + 1024;
    LAS bf16* KTt = TB + 1024; LAS bf16* RTt = KTt + 1024; LAS bf16* Vt = RTt + 1024;
    LAS float* AKB = (LAS float*)(Vt + 1024);
    LAS bf16* AKK = (LAS bf16*)(AKB + 256); LAS bf16* ARK = AKK + 256; LAS bf16* ARB = ARK + 256; LAS bf16* TT = ARB + 256;
    float kh[16], bh[16];
    float pc;
    {   float r_[16], v_[16], kk_[16], lp_[16], kd_[16], bb_[16];
        LAS bf16* stg = TK;
#pragma unroll
        for (int i = 0; i < 6; ++i) { *(LAS u32x4*)(stg + i * 1024 + lane * 8) = PR.q[2 * i]; *(LAS u32x4*)(stg + i * 1024 + 512 + lane * 8) = PR.q[2 * i + 1]; }
        LDS_WAIT(); asm volatile("" ::: "memory");
        if (nscan >= 0) pre_load(PR, ws, nscan, ncs, lane);
#pragma unroll
        for (int t = 0; t < 16; ++t) { const int tm = (dir ? 15 - t : t) * 64 + lane;
            r_[t] = bf2f(stg[tm]); v_[t] = bf2f(stg[1024 + tm]); kk_[t] = bf2f(stg[2048 + tm]); lp_[t] = bf2f(stg[3072 + tm]); kd_[t] = bf2f(stg[4096 + tm]); bb_[t] = bf2f(stg[5120 + tm]); }
        LDS_WAIT(); asm volatile("" ::: "memory");
        float lp = 0.f; u32x4 kt4[2], rt4[2], v4[2];
        unsigned ktp[8], rtp[8], vp[8];
#pragma unroll
        for (int t = 0; t < 16; ++t) { const float pm1 = __expf(lp); lp += __logf(1.f - lp_[t]); lp_[t] = lp; const float p = __expf(lp), ip = __expf(-lp);
            const float kt = kk_[t] * pm1, ktl = kd_[t] * ip, btl = bb_[t] * ip, rt = r_[t] * p;
            TK[t * 64 + lane] = (bf16)f2bf(kt); TR[t * 64 + lane] = (bf16)f2bf(rt); TKt[t * 64 + lane] = (bf16)f2bf(ktl); TB[t * 64 + lane] = (bf16)f2bf(btl);
            if (t & 1) { ktp[t >> 1] |= f2bf(kt) << 16; rtp[t >> 1] |= f2bf(rt) << 16; vp[t >> 1] |= f2bf(v_[t]) << 16; }
            else { ktp[t >> 1] = f2bf(kt); rtp[t >> 1] = f2bf(rt); vp[t >> 1] = f2bf(v_[t]); } }
        kt4[0] = (u32x4){ktp[0], ktp[1], ktp[2], ktp[3]}; kt4[1] = (u32x4){ktp[4], ktp[5], ktp[6], ktp[7]};
        rt4[0] = (u32x4){rtp[0], rtp[1], rtp[2], rtp[3]}; rt4[1] = (u32x4){rtp[4], rtp[5], rtp[6], rtp[7]};
        v4[0] = (u32x4){vp[0], vp[1], vp[2], vp[3]}; v4[1] = (u32x4){vp[4], vp[5], vp[6], vp[7]};
        *(LAS u32x4*)(KTt + lane * 16) = kt4[0]; *(LAS u32x4*)(KTt + lane * 16 + 8) = kt4[1];
        *(LAS u32x4*)(RTt + lane * 16) = rt4[0]; *(LAS u32x4*)(RTt + lane * 16 + 8) = rt4[1];
        *(LAS u32x4*)(Vt + lane * 16) = v4[0]; *(LAS u32x4*)(Vt + lane * 16 + 8) = v4[1];
        pc = __expf(lp);
#pragma unroll
        for (int t = 0; t < 16; ++t) { const float e = __expf(lp - lp_[t]); kh[t] = kd_[t] * e; bh[t] = bb_[t] * e; }
    }
    LDS_WAIT(); asm volatile("" ::: "memory");
    {   f32x4 akb = {0.f, 0.f, 0.f, 0.f}, akk = akb, ark = akb, arb = akb;
#pragma unroll
        for (int s = 0; s < 2; ++s) { const int o = fr * 64 + 32 * s + 8 * fq;
            const bf16x8 fk = *(const LAS bf16x8*)(TK + o), frr = *(const LAS bf16x8*)(TR + o), fkt = *(const LAS bf16x8*)(TKt + o), fb = *(const LAS bf16x8*)(TB + o);
            akb = MFMA16(fk, fb, akb); akk = MFMA16(fk, fkt, akk); ark = MFMA16(frr, fkt, ark); arb = MFMA16(frr, fb, arb); }
#pragma unroll
        for (int reg = 0; reg < 4; ++reg) { const int t = 4 * fq + reg; const bool lo = fr < t, le = fr <= t;
            AKB[t * 16 + fr] = lo ? akb[reg] : 0.f; AKK[t * 16 + fr] = (bf16)f2bf(lo ? akk[reg] : 0.f);
            ARK[t * 16 + fr] = (bf16)f2bf(le ? ark[reg] : 0.f); ARB[t * 16 + fr] = (bf16)f2bf(le ? arb[reg] : 0.f); }
    }
    LDS_WAIT(); asm volatile("" ::: "memory");
    {   float col[16];
#pragma unroll
        for (int t = 0; t < 16; ++t) { float s_ = (t == fr) ? 1.f : 0.f;
            if (t > 0) { const f32x4 n0 = *(const LAS f32x4*)(AKB + t * 16), n1 = *(const LAS f32x4*)(AKB + t * 16 + 4), n2 = *(const LAS f32x4*)(AKB + t * 16 + 8), n3 = *(const LAS f32x4*)(AKB + t * 16 + 12);
                const float nn[16] = {n0[0], n0[1], n0[2], n0[3], n1[0], n1[1], n1[2], n1[3], n2[0], n2[1], n2[2], n2[3], n3[0], n3[1], n3[2], n3[3]};
#pragma unroll
                for (int i = 0; i < 16; ++i) if (i < t) s_ -= nn[i] * col[i]; }
            col[t] = s_; TT[t * 16 + fr] = (bf16)f2bf(s_); }
    }
    LDS_WAIT(); asm volatile("" ::: "memory");
    f32x4 Wc[4], Rqc[4], U0c[4], Y0c[4];
    {   const bf16x8 aT = frag_lo(*(const LAS u32x2*)(TT + fr * 16 + 4 * fq)), aKK = frag_lo(*(const LAS u32x2*)(AKK + fr * 16 + 4 * fq)), aRK = frag_lo(*(const LAS u32x2*)(ARK + fr * 16 + 4 * fq));
        u32x2 nb = *(const LAS u32x2*)(ARB + fr * 16 + 4 * fq); nb.x ^= 0x80008000u; nb.y ^= 0x80008000u; const bf16x8 aRBn = frag_lo(nb);
        const f32x4 z4 = {0.f, 0.f, 0.f, 0.f};
#pragma unroll
        for (int nt = 0; nt < 4; ++nt) { const int o = (16 * nt + fr) * 16 + 4 * fq;
            const bf16x8 bK = frag_lo(*(const LAS u32x2*)(KTt + o)), bV = frag_lo(*(const LAS u32x2*)(Vt + o));
            float ri[4]; unpack4(*(const LAS u32x2*)(RTt + o), ri);
            Wc[nt] = MFMA16(aT, bK, z4); const f32x4 Zn = MFMA16(aKK, bV, z4);
            U0c[nt] = MFMA16(aT, frag_c(Zn), z4);
            Rqc[nt] = MFMA16(aRBn, frag_c(Wc[nt]), ((f32x4){ri[0], ri[1], ri[2], ri[3]}));
            Y0c[nt] = MFMA16(aRK, bV, z4); Y0c[nt] = MFMA16(aRBn, frag_c(U0c[nt]), Y0c[nt]); }
    }
    LDS_WAIT(); asm volatile("" ::: "memory");

#pragma unroll
    for (int nt = 0; nt < 4; ++nt) { const u32x2 vv = *(const LAS u32x2*)(Vt + (16 * nt + fr) * 16 + 4 * fq);
        *(u32x2*)(blob + 8192 + nt * 2048 + 1024 + lane * 8) = vv;
        u32x2 u0 = {pk2(U0c[nt][0], U0c[nt][1]), pk2(U0c[nt][2], U0c[nt][3])}, y0 = {pk2(Y0c[nt][0], Y0c[nt][1]), pk2(Y0c[nt][2], Y0c[nt][3])};
        *(u32x2*)(blob + 8192 + nt * 2048 + lane * 8) = u0; *(u32x2*)(blob + 8192 + nt * 2048 + 512 + lane * 8) = y0;
        *(float*)(blob + 8192 + nt * 2048 + 1536 + lane * 4) = pc; }
    LAS bf16* WT = TK; LAS bf16* RQT = TR; LAS bf16* BHt = TKt; LAS bf16* KHt = TB;
#pragma unroll
    for (int nt = 0; nt < 4; ++nt)
#pragma unroll
        for (int reg = 0; reg < 4; ++reg) { WT[(4 * fq + reg) * 64 + 16 * nt + fr] = (bf16)f2bf(Wc[nt][reg]); RQT[(4 * fq + reg) * 64 + 16 * nt + fr] = (bf16)f2bf(Rqc[nt][reg]); }
    {   u32x4 a, c, d, e;
        a = (u32x4){pk2(bh[0], bh[1]), pk2(bh[2], bh[3]), pk2(bh[4], bh[5]), pk2(bh[6], bh[7])}; c = (u32x4){pk2(bh[8], bh[9]), pk2(bh[10], bh[11]), pk2(bh[12], bh[13]), pk2(bh[14], bh[15])};
        d = (u32x4){pk2(kh[0], kh[1]), pk2(kh[2], kh[3]), pk2(kh[4], kh[5]), pk2(kh[6], kh[7])}; e = (u32x4){pk2(kh[8], kh[9]), pk2(kh[10], kh[11]), pk2(kh[12], kh[13]), pk2(kh[14], kh[15])};
        *(LAS u32x4*)(BHt + lane * 16) = a; *(LAS u32x4*)(BHt + lane * 16 + 8) = c; *(LAS u32x4*)(KHt + lane * 16) = d; *(LAS u32x4*)(KHt + lane * 16 + 8) = e; }
    LDS_WAIT(); asm volatile("" ::: "memory");
#pragma unroll
    for (int s = 0; s < 2; ++s) { const int o = fr * 64 + 32 * s + 4 * fq;
        const u32x2 w0 = *(const LAS u32x2*)(WT + o), w1 = *(const LAS u32x2*)(WT + o + 16), q0 = *(const LAS u32x2*)(RQT + o), q1 = *(const LAS u32x2*)(RQT + o + 16);
        *(u32x4*)(blob + (0 * 2 + s) * 1024 + lane * 16) = (u32x4){w0.x, w0.y, w1.x, w1.y};
        *(u32x4*)(blob + (1 * 2 + s) * 1024 + lane * 16) = (u32x4){q0.x, q0.y, q1.x, q1.y}; }
#pragma unroll
    for (int mt = 0; mt < 4; ++mt) { const int o = (16 * mt + fr) * 16 + 4 * fq; const u32x2 bb = *(const LAS u32x2*)(BHt + o), kk = *(const LAS u32x2*)(KHt + o);
        *(u32x4*)(blob + 4096 + mt * 1024 + lane * 16) = (u32x4){bb.x ^ 0x80008000u, bb.y ^ 0x80008000u, kk.x, kk.y}; }
    LDS_WAIT(); asm volatile("" ::: "memory");
}

__device__ __forceinline__ void pre_phase(const Frame& F0, int seg) {
    const Frame F = phase_frame(F0); unsigned char* const ws = F.ws;
    PreRegs R;
    int it = F.gw; if (it >= 32 * SEGCH) return;
    pre_load(R, ws, it & 31, seg * SEGCH + (it >> 5), F.lane);
    for (; it < 32 * SEGCH; it += F.NGW) { const int nx = it + F.NGW; const bool hn = nx < 32 * SEGCH;
        pre_item<0>(F, ws, it & 31, seg * SEGCH + (it >> 5), blob_ptr(ws, it & 31, it >> 5), R, hn ? (nx & 31) : -1, seg * SEGCH + (nx >> 5)); }
}

constexpr int SQ_SLOT = 10240, SQ_R = 12, SQ_D = 8;
template <int MODE>
__device__ __forceinline__ void seq_item(const Frame& F0, int item, int seg, bool need_ctx) {
    const Frame F = phase_frame(F0); unsigned char* const ws = F.ws;
    const int scan = item >> 2, vb = item & 3, dir = scan & 1, h = (scan >> 1) & 7, b = scan >> 4; const int lane = F.lane, fr = lane & 15, fq = lane >> 4, w = F.wave;
    const unsigned char* blob = blob_ptr(ws, scan, 0);
    LAS unsigned char* ring = F.lds;
    __syncthreads();
    const int p0 = 2 * (w - 1);
    const unsigned goff0 = (p0 < 8 ? p0 * 1024 : 8192 + vb * 2048 + (p0 - 8) * 1024) + lane * 16, goff1 = (p0 + 1 < 8 ? (p0 + 1) * 1024 : 8192 + vb * 2048 + (p0 + 1 - 8) * 1024) + lane * 16;
#define SQ_ISSUE(c) do { const unsigned char* g_ = blob + (size_t)(c) * BLOB; LAS unsigned char* s_ = ring + ((c) % SQ_R) * SQ_SLOT + p0 * 1024; \
        __builtin_amdgcn_global_load_lds((const unsigned*)(g_ + goff0), (LAS unsigned*)(s_), 16, 0, 0); \
        __builtin_amdgcn_global_load_lds((const unsigned*)(g_ + goff1), (LAS unsigned*)(s_ + 1024), 16, 0, 0); } while (0)
    const bool loader = (w >= 1 && w <= 5) && MODE != 2;
    if (loader) { for (int c = 0; c < SQ_D; ++c) SQ_ISSUE(c); }
    bf16* Y = (bf16*)(ws + WS_Y) + (size_t)dir * NROW * DR + h * 64 + 16 * vb + fr;
    float* st = (float*)(ws + WS_SCANST) + (size_t)item * 1024 + lane * 4;
    f32x4 M[4];
#pragma unroll
    for (int mt = 0; mt < 4; ++mt) M[mt] = (seg == 0 || w != 0) ? (f32x4){0.f, 0.f, 0.f, 0.f} : *(const f32x4*)(st + mt * 256);
    const f32x4 z4 = {0.f, 0.f, 0.f, 0.f};
    struct SQ { bf16x8 a1[4], a2[4]; f32x4 pc[4]; u32x2 u0, y0, vv; };
#define SQ_READ(R, c) do { const LAS unsigned char* sl_ = ring + ((c) % SQ_R) * SQ_SLOT; _Pragma("unroll") for (int i = 0; i < 4; ++i) { \
        R.a1[i] = *(const LAS bf16x8*)(sl_ + i * 1024 + lane * 16); R.a2[i] = *(const LAS bf16x8*)(sl_ + 4096 + i * 1024 + lane * 16); \
        R.pc[i] = *(const LAS f32x4*)(sl_ + 8192 + 1536 + (16 * i + 4 * fq) * 4); } \
        R.u0 = *(const LAS u32x2*)(sl_ + 8192 + lane * 8); R.y0 = *(const LAS u32x2*)(sl_ + 8192 + 512 + lane * 8); R.vv = *(const LAS u32x2*)(sl_ + 8192 + 1024 + lane * 8); } while (0)
    const long ystep = dir ? -(long)DR : (long)DR;
#define SQ_STEP(R, c) do { const int cs_ = seg * SEGCH + (c); \
        const u32x4 t0 = {pk2(M[0][0], M[0][1]), pk2(M[0][2], M[0][3]), pk2(M[1][0], M[1][1]), pk2(M[1][2], M[1][3])}; \
        const u32x4 t1 = {pk2(M[2][0], M[2][1]), pk2(M[2][2], M[2][3]), pk2(M[3][0], M[3][1]), pk2(M[3][2], M[3][3])}; \
        const bf16x8 b0 = __builtin_bit_cast(bf16x8, t0), b1 = __builtin_bit_cast(bf16x8, t1); \
        f32x4 X0 = MFMA16(R.a1[0], b0, z4); X0 = MFMA16(R.a1[1], b1, X0); \
        f32x4 X1 = MFMA16(R.a1[2], b0, z4); X1 = MFMA16(R.a1[3], b1, X1); \
        float u0[4], y0[4]; unpack4(R.u0, u0); unpack4(R.y0, y0); \
        if (MODE == 0 && (need_ctx || cs_ >= 16)) { bf16* yp = Y + (size_t)scan_rowof(16 * cs_ + 4 * fq, dir, b) * DR; \
            yp[0] = (bf16)f2bf(X1[0] + y0[0]); yp[ystep] = (bf16)f2bf(X1[1] + y0[1]); yp[2 * ystep] = (bf16)f2bf(X1[2] + y0[2]); yp[3 * ystep] = (bf16)f2bf(X1[3] + y0[3]); } \
        const u32x4 tb = {pk2(X0[0] + u0[0], X0[1] + u0[1]), pk2(X0[2] + u0[2], X0[3] + u0[3]), R.vv.x, R.vv.y}; const bf16x8 bB = __builtin_bit_cast(bf16x8, tb); \
        _Pragma("unroll") for (int mt = 0; mt < 4; ++mt) M[mt] = MFMA16(R.a2[mt], bB, R.pc[mt] * M[mt]); } while (0)
#define SQ_LOADER(c) do { if (loader) { if ((c) + SQ_D < SEGCH) { SQ_ISSUE((c) + SQ_D); asm volatile("s_waitcnt vmcnt(12)" ::: "memory"); } else asm volatile("s_waitcnt vmcnt(0)" ::: "memory"); } \
        __builtin_amdgcn_s_barrier(); asm volatile("" ::: "memory"); } while (0)
    SQ Ra, Rb, Rc;
    SQ_LOADER(0);
    if (w == 0 && MODE != 1) { SQ_READ(Ra, 0); SQ_READ(Rb, 1); }
    for (int c = 0; c < SEGCH; c += 3) {
        SQ_LOADER(c + 1);
        if (w == 0 && MODE != 1) { SQ_STEP(Ra, c); if (c + 2 < SEGCH) SQ_READ(Rc, c + 2); }
        SQ_LOADER(c + 2);
        if (w == 0 && MODE != 1) { SQ_STEP(Rb, c + 1); if (c + 3 < SEGCH) SQ_READ(Ra, c + 3); }
        if (c + 3 < SEGCH) SQ_LOADER(c + 3);
        if (w == 0 && MODE != 1) { SQ_STEP(Rc, c + 2); if (c + 4 < SEGCH) SQ_READ(Rb, c + 4); }
    }
#undef SQ_READ
#undef SQ_STEP
#undef SQ_LOADER
#undef SQ_ISSUE
    if (MODE >= 2 && w == 0 && M[0][0] + M[1][1] + M[2][2] + M[3][3] == 12345.678f) st[0] = M[0][0];
    if (MODE == 0 && w == 0 && seg + 1 < NSEG) {
#pragma unroll
        for (int mt = 0; mt < 4; ++mt) *(f32x4*)(st + mt * 256) = M[mt]; }
    __syncthreads();
}

__device__ __forceinline__ void warm_pass(const Frame& F0, int seg) {
    const Frame F = phase_frame(F0); unsigned char* const ws = F.ws;
    const int hb = blockIdx.x - 128;
    if (hb < 0) return;
    const int x = hb & 7, j = hb >> 3;
    const int nw = 16 * NWAVES, me = j * NWAVES + F.wave; unsigned acc = 0u;
    for (int it = me; it < SEGCH * 64; it += 4 * nw) {
        u32x4 v[4];
#pragma unroll
        for (int u = 0; u < 4; ++u) { const int i2 = it + u * nw; const int ci = i2 >> 6, q = (i2 >> 4) & 3, p = i2 & 15;
            v[u] = (i2 < SEGCH * 64) ? *(const u32x4*)(blob_ptr(ws, x + 8 * q, ci) + p * 1024 + F.lane * 16) : (u32x4){0u, 0u, 0u, 0u}; }
#pragma unroll
        for (int u = 0; u < 4; ++u) acc ^= v[u].x ^ v[u].y ^ v[u].z ^ v[u].w;
    }
    asm volatile("" :: "v"(acc));
}
namespace pg8 {
struct EpiStoreBf16 {
    static constexpr bool PERM = true, AFTER_DRAIN = false;
    bf16_t* O; int ldc; int pn_mask;
    __device__ __forceinline__ void operator()(const f32x4 (&acc)[2][2][4][2], const Unit& u, int wr, int wc, int fr, int fq) const {
        const int row0 = u.pm * BM + wr * 64 + fr; const int col0 = (u.pn & pn_mask) * BM + wc * 32 + 8 * fq;
#pragma unroll
        for (int ai = 0; ai < 2; ++ai)
#pragma unroll
            for (int m = 0; m < 4; ++m) { bf16_t* rowp = O + (size_t)(row0 + ai * HALF + m * 16) * ldc + col0;
#pragma unroll
                for (int bj = 0; bj < 2; ++bj) { const f32x4 v0 = acc[ai][bj][m][0], v1 = acc[ai][bj][m][1];
                    u32x4 w; w.x = cvt_pk_bf16(v0[0], v0[1]); w.y = cvt_pk_bf16(v0[2], v0[3]); w.z = cvt_pk_bf16(v1[0], v1[1]); w.w = cvt_pk_bf16(v1[2], v1[3]);
                    *(u32x4*)(rowp + bj * HALF) = w; } }
    }
};
struct EpiSwiGLU {
    static constexpr bool PERM = true, AFTER_DRAIN = false;
    bf16_t* O;
    __device__ __forceinline__ void operator()(const f32x4 (&acc)[2][2][4][2], const Unit& u, int wr, int wc, int fr, int fq) const {
        const int row0 = u.pm * BM + wr * 64 + fr; const int col0 = ((u.pn & 3) * BM + wc * 32 + 8 * fq) >> 1;
#pragma unroll
        for (int ai = 0; ai < 2; ++ai)
#pragma unroll
            for (int m = 0; m < 4; ++m) { bf16_t* rowp = O + (size_t)(row0 + ai * HALF + m * 16) * 512 + col0;
#pragma unroll
                for (int bj = 0; bj < 2; ++bj) { const f32x4 g = acc[ai][bj][m][0], up = acc[ai][bj][m][1]; float a[4];
#pragma unroll
                    for (int i = 0; i < 4; ++i) a[i] = g[i] / (1.f + __expf(-g[i])) * up[i];
                    unsigned long long w = (unsigned long long)cvt_pk_bf16(a[0], a[1]) | ((unsigned long long)cvt_pk_bf16(a[2], a[3]) << 32);
                    *(unsigned long long*)(rowp + bj * (HALF / 2)) = w; } }
    }
};
struct EpiResidual {
    static constexpr bool PERM = false, AFTER_DRAIN = false;
    const float* xlat; const float* xctx;
    float* out; const float* g1;
    __device__ __forceinline__ void operator()(const f32x4 (&acc)[2][2][4][2], const Unit& u, int wr, int wc, int fr, int fq) const {
        const int rowt = u.pm * BM; const int mr = rowt < 16384 ? (rowt >> 13) : 2;
        const float* base = rowt < 16384 ? xlat + (size_t)rowt * 1024 : xctx + (size_t)(rowt - 16384) * 1024;
        const int col0 = u.pn * BM + wc * 32 + 4 * fq;
        f32x4 gv[2][2];
#pragma unroll
        for (int bj = 0; bj < 2; ++bj)
#pragma unroll
            for (int n = 0; n < 2; ++n) gv[bj][n] = *(const f32x4*)(g1 + (size_t)mr * 6144 + col0 + bj * HALF + n * 16);
#pragma unroll
        for (int ai = 0; ai < 2; ++ai)
#pragma unroll
            for (int m = 0; m < 4; ++m) { const int rl = ai * HALF + wr * 64 + m * 16 + fr;
#pragma unroll
                for (int bj = 0; bj < 2; ++bj)
#pragma unroll
                    for (int n = 0; n < 2; ++n) { const size_t off = (size_t)rl * 1024 + col0 + bj * HALF + n * 16;
                        const f32x4 xo = *(const f32x4*)(base + off);
                        *(f32x4*)(out + (size_t)rowt * 1024 + off) = xo + gv[bj][n] * acc[ai][bj][m][n]; } }
    }
};
struct MoeOrder {
    const int* tile_e; int ntiles, G, c;
    __device__ bool next(int i, Unit& u) const { const long L = (long)i * G + c; if (L >= 4L * ntiles) return false; const int pm = (int)(L >> 2); u.pm = pm; u.pn = tile_e[pm] * 4 + (int)(L & 3); return true; }
    __device__ __forceinline__ void a_ready(const Unit&) const {}
    __device__ __forceinline__ void done(const Unit&) const {}
};
}

__device__ __forceinline__ void expert_convert(const Frame& F0, int l, int b_lo) {
    const Frame F = phase_frame(F0); unsigned char* const ws = F.ws;
    if ((int)blockIdx.x < b_lo) return;
    const int nwv = (F.G - b_lo) * NWAVES, myw = ((int)blockIdx.x - b_lo) * NWAVES + F.wave;
    LAS float* scr = (LAS float*)(F.lds + F.wave * 16384);
    bf16* wgu = (bf16*)(ws + WS_WGU_T); bf16* wd = (bf16*)(ws + WS_WD_T);
    constexpr int I_G = 16 * 16, I_D = 8 * 32;
    constexpr int NIT = NEXP * (2 * I_G + I_D);
    const float* p_eg = inptr(I_EG); const float* p_eu = inptr(I_EU); const float* p_ed = inptr(I_ED);
    for (int it = myw; it < NIT; it += nwv) { const int e = it / (2 * I_G + I_D); int r = it % (2 * I_G + I_D);
        if (r < I_G) { transpose_item(p_eg + ((size_t)l * NEXP + e) * D * DEXP, DEXP, (r >> 4) * 64, (r & 15) * 32, wgu, D, RmGU{e * 1024}, scr, F.lane); continue; } r -= I_G;
        if (r < I_G) { transpose_item(p_eu + ((size_t)l * NEXP + e) * D * DEXP, DEXP, (r >> 4) * 64, (r & 15) * 32, wgu, D, RmGU{e * 1024 + 4}, scr, F.lane); continue; } r -= I_G;
        transpose_item(p_ed + ((size_t)l * NEXP + e) * DEXP * D, D, (r >> 5) * 64, (r & 31) * 32, wd, DEXP, RmId{e * 1024}, scr, F.lane);
    }
}

__device__ __forceinline__ void router_pass(const Frame& F0, int l, int nrows) {
    const Frame F = phase_frame(F0); unsigned char* const ws = F.ws;
    constexpr int HP = 1028;
    LAS float* msh = (LAS float*)F.lds; LAS float* msc = msh + 3072; LAS float* hrow = msc + 3072;
    LAS float* part = hrow + 16 * HP;
    LAS float* lgs = part + 8 * 16 * 48;
    __syncthreads();
    mod_to_lds(F, l, 3, msh, false); mod_to_lds(F, l, 4, msc, false); __syncthreads();
    const float* X = (const float*)(ws + WS_X); bf16* H = (bf16*)(ws + WS_H);
    const float* rgw = inptr(I_RGW) + (size_t)l * D * 4; const float* rew = inptr(I_REW) + (size_t)l * D * NEXP;
    const float* rgb = inptr(I_RGB) + l * 4; const float* reb = inptr(I_REB) + l * NEXP;
    int* rt_e = (int*)(ws + WS_ROUTE + RT_E); int* rt_pos = (int*)(ws + WS_ROUTE + RT_POS); float* rt_gate = (float*)(ws + WS_ROUTE + RT_GATE);
    unsigned* cnt = (unsigned*)(ws + WS_CTL) + CW_CNT + 64 * l;
    const int lane = F.lane, w = F.wave, fr = lane & 15, fq = lane >> 4; const float* n2g = inptr(I_N2G) + l * D;
    float bw[32][3];
#pragma unroll
    for (int ks = 0; ks < 32; ++ks) { const int k = 128 * w + 4 * ks + fq;
        bw[ks][0] = rew[(size_t)k * 32 + fr]; bw[ks][1] = rew[(size_t)k * 32 + 16 + fr]; bw[ks][2] = fr < 4 ? rgw[(size_t)k * 4 + fr] : 0.f; }
    const int ntiles = nrows >> 4;
    for (int gi = F.vcu; gi < ntiles; gi += F.G) {
#pragma unroll
        for (int rr = 0; rr < 2; ++rr) { const int r = 2 * w + rr, row = gi * 16 + r; f32x4 v[4];
#pragma unroll
            for (int j = 0; j < 4; ++j) v[j] = *(const f32x4*)(X + (size_t)row * D + 4 * lane + 256 * j);
            const int mr = modrow(row);
            norm_mod_row(v, n2g, msc + mr * 1024, msh + mr * 1024, H + (size_t)row * D, lane);
#pragma unroll
            for (int j = 0; j < 4; ++j) *(LAS f32x4*)(hrow + r * HP + 4 * lane + 256 * j) = v[j]; }
        __syncthreads();
        {   f32x4 acc[3] = {{0.f, 0.f, 0.f, 0.f}, {0.f, 0.f, 0.f, 0.f}, {0.f, 0.f, 0.f, 0.f}};
#pragma unroll
            for (int ks = 0; ks < 32; ++ks) { const float a = hrow[fr * HP + 128 * w + 4 * ks + fq];
#pragma unroll
                for (int nt = 0; nt < 3; ++nt) acc[nt] = __builtin_amdgcn_mfma_f32_16x16x4f32(a, bw[ks][nt], acc[nt], 0, 0, 0); }
#pragma unroll
            for (int nt = 0; nt < 3; ++nt)
#pragma unroll
                for (int reg = 0; reg < 4; ++reg) part[(w * 16 + 4 * fq + reg) * 48 + 16 * nt + fr] = acc[nt][reg]; }
        __syncthreads();
        for (int idx = F.tid; idx < 16 * 36; idx += NTHR) { const int r = idx / 36, n = idx % 36; float s_ = 0.f;
#pragma unroll
            for (int ww = 0; ww < 8; ++ww) s_ += part[(ww * 16 + r) * 48 + n];
            if (n < 32) lgs[r * 40 + 4 + n] = s_ + reb[n]; else lgs[r * 40 + n - 32] = s_ + rgb[n - 32]; }
        __syncthreads();
        if (F.tid < 16) { const int rr = gi * 16 + F.tid; const LAS float* lp = lgs + F.tid * 40;
            int grp = 0; float mx = lp[0];
#pragma unroll
            for (int g = 1; g < 4; ++g) if (lp[g] > mx) { mx = lp[g]; grp = g; }
            float den = 0.f;
#pragma unroll
            for (int g = 0; g < 4; ++g) den += __expf(lp[g] - mx);
            const float pg_top = 1.f / den; const LAS float* sel = lp + 4 + grp * 8;
            int i0 = 0; float l0 = sel[0];
#pragma unroll
            for (int q = 1; q < 8; ++q) if (sel[q] > l0) { l0 = sel[q]; i0 = q; }
            int i1 = -1; float l1 = -3.0e38f;
#pragma unroll
            for (int q = 0; q < 8; ++q) if (q != i0 && sel[q] > l1) { l1 = sel[q]; i1 = q; }
            const float e1 = __expf(l1 - l0); const float w0 = pg_top / (1.f + e1), w1 = pg_top * e1 / (1.f + e1);
            const int ea = grp * 8 + i0, eb = grp * 8 + i1;
            const unsigned pa = atomicAdd(cnt + ea, 1u), pb = atomicAdd(cnt + eb, 1u);
            rt_e[2 * rr] = ea; rt_e[2 * rr + 1] = eb; rt_pos[2 * rr] = (int)pa; rt_pos[2 * rr + 1] = (int)pb; rt_gate[2 * rr] = w0; rt_gate[2 * rr + 1] = w1; }
    }
}

__device__ __forceinline__ void gather_pass(const Frame& F0, int l, int nrows) {
    const Frame F = phase_frame(F0); unsigned char* const ws = F.ws;
    LAS int* off = (LAS int*)F.lds;
    const unsigned* cnt = (const unsigned*)(ws + WS_CTL) + CW_CNT + 64 * l;
    int* tile_e = (int*)(ws + WS_ROUTE + RT_TILE); int* ntl = (int*)(ws + WS_ROUTE + RT_NT);
    __syncthreads();
    if (F.tid == 0) { int o = 0;
#pragma nounroll
        for (int e = 0; e < NEXP; ++e) { const int c = (int)__hip_atomic_load(cnt + e, __ATOMIC_RELAXED, __HIP_MEMORY_SCOPE_AGENT); const int nt = (c + 255) >> 8; off[e] = o;
            if (blockIdx.x == 0) {
#pragma nounroll
                for (int t = 0; t < nt; ++t) tile_e[(o >> 8) + t] = e; }
            o += nt << 8; }
        if (blockIdx.x == 0) ntl[0] = o >> 8; }
    __syncthreads();
    const int* rt_e = (const int*)(ws + WS_ROUTE + RT_E); const int* rt_pos = (const int*)(ws + WS_ROUTE + RT_POS); int* rt_slot = (int*)(ws + WS_ROUTE + RT_SLOT);
    const bf16* H = (const bf16*)(ws + WS_H); bf16* Xs = (bf16*)(ws + WS_XS);
    for (int it0 = F.gw * 4; it0 < 2 * nrows; it0 += F.NGW * 4) { int slot[4]; u32x4 a[4], b2[4];
#pragma unroll
        for (int u = 0; u < 4; ++u) { const int it = it0 + u; slot[u] = it < 2 * nrows ? off[rt_e[it]] + rt_pos[it] : -1; }
#pragma unroll
        for (int u = 0; u < 4; ++u) if (slot[u] >= 0) { const u32x4* s = (const u32x4*)(H + (size_t)((it0 + u) >> 1) * D); a[u] = s[F.lane]; b2[u] = s[64 + F.lane]; }
#pragma unroll
        for (int u = 0; u < 4; ++u) if (slot[u] >= 0) { if (F.lane == 0) rt_slot[it0 + u] = slot[u]; u32x4* d = (u32x4*)(Xs + (size_t)slot[u] * D); d[F.lane] = a[u]; d[64 + F.lane] = b2[u]; }
    }
}

__device__ __forceinline__ void combine_pass(const Frame& F0, int l, int nrows) {
    const Frame F = phase_frame(F0); unsigned char* const ws = F.ws;
    LAS float* mg2 = (LAS float*)F.lds; LAS float* msh = mg2 + 3072; LAS float* msc = msh + 3072;
    const bool last = (l == DEPTH - 1);
    __syncthreads();
    mod_to_lds(F, l, 5, mg2, false); if (!last) { mod_to_lds(F, l + 1, 0, msh, false); mod_to_lds(F, l + 1, 1, msc, false); }
    __syncthreads();
    float* X = (float*)(ws + WS_X); bf16* H = (bf16*)(ws + WS_H); const bf16* Ys = (const bf16*)(ws + WS_XS);
    const int* rt_slot = (const int*)(ws + WS_ROUTE + RT_SLOT); const float* rt_gate = (const float*)(ws + WS_ROUTE + RT_GATE);
    const int lane = F.lane; const float* n1g = inptr(I_N1G) + (last ? 0 : (l + 1) * D); const float* fgp = inptr(I_FG);
    for (int row0 = F.gw; row0 < nrows; row0 += 2 * F.NGW) {
        int s0[2], s1[2]; float w0[2], w1[2]; bool ok[2]; u32x2 ya[2][4], yb[2][4]; f32x4 xo[2][4];
#pragma unroll
        for (int u = 0; u < 2; ++u) { const int row = row0 + u * F.NGW; ok[u] = row < nrows; if (ok[u]) { s0[u] = rt_slot[2 * row]; s1[u] = rt_slot[2 * row + 1]; w0[u] = rt_gate[2 * row]; w1[u] = rt_gate[2 * row + 1]; } }
#pragma unroll
        for (int u = 0; u < 2; ++u) if (ok[u]) { const int row = row0 + u * F.NGW;
#pragma unroll
            for (int j = 0; j < 4; ++j) { const int c = 4 * lane + 256 * j; ya[u][j] = *(const u32x2*)(Ys + (size_t)s0[u] * D + c); yb[u][j] = *(const u32x2*)(Ys + (size_t)s1[u] * D + c); xo[u][j] = *(const f32x4*)(X + (size_t)row * D + c); } }
#pragma unroll
        for (int u = 0; u < 2; ++u) if (ok[u]) { const int row = row0 + u * F.NGW; const int mr = modrow(row); f32x4 v[4];
#pragma unroll
            for (int j = 0; j < 4; ++j) { const int c = 4 * lane + 256 * j; float a[4], b[4]; unpack4(ya[u][j], a); unpack4(yb[u][j], b);
                const f32x4 g2 = *(const LAS f32x4*)(mg2 + mr * 1024 + c);
                f32x4 y; y.x = w0[u] * a[0] + w1[u] * b[0]; y.y = w0[u] * a[1] + w1[u] * b[1]; y.z = w0[u] * a[2] + w1[u] * b[2]; y.w = w0[u] * a[3] + w1[u] * b[3];
                v[j] = xo[u][j] + g2 * y; }
            if (!last) {
#pragma unroll
                for (int j = 0; j < 4; ++j) *(f32x4*)(X + (size_t)row * D + 4 * lane + 256 * j) = v[j];
                norm_mod_row(v, n1g, msc + mr * 1024, msh + mr * 1024, H + (size_t)row * D, lane);
            } else { float s = 0.f;
#pragma unroll
                for (int j = 0; j < 4; ++j) s += (v[j].x * v[j].x + v[j].y * v[j].y) + (v[j].z * v[j].z + v[j].w * v[j].w);
                const float rs = rsqrtf(wave_sum(s) * (1.f / D) + RMS_EPS);
#pragma unroll
                for (int j = 0; j < 4; ++j) { const int c = 4 * lane + 256 * j; const f32x4 g = *(const f32x4*)(fgp + c); *(f32x4*)(F.out + (size_t)row * D + c) = v[j] * rs * g; } } }
    }
}
__global__ void __launch_bounds__(NTHR, 2) fwd_megakernel(Params prm) {
    extern __shared__ __attribute__((aligned(16))) unsigned char lds_raw[];
    Frame F;
    F.lds = (LAS unsigned char*)lds_raw;
    F.tid = threadIdx.x; F.lane = F.tid & 63; F.wave = __builtin_amdgcn_readfirstlane(F.tid >> 6);
    F.G = gridDim.x; { const int bx = blockIdx.x; F.vcu = (F.G % 8 == 0) ? (bx % 8) * (F.G / 8) + bx / 8 : bx; }
    F.gw = F.vcu * NWAVES + F.wave; F.NGW = F.G * NWAVES;
    F.out = prm.out; F.ws = prm.ws;
    for (int u = F.tid; u < (LDS_BYTES - LDSCTL_OFF) / 4; u += NTHR) ((LAS unsigned*)(F.lds + LDSCTL_OFF))[u] = 0u;
    __syncthreads();
    (void)xcd_barrier_post((unsigned*)(F.ws + WS_CTL) + CW_BAR, (volatile LAS unsigned*)(F.lds + MISC_OFF) + 8);
#define GRID_BAR() do { XcdBarrier bar_; bar_.bar = (unsigned*)(opaque(F.ws) + WS_CTL) + CW_BAR; bar_.x = xb_xcc_id(); bar_.st = (volatile LAS unsigned*)(F.lds + MISC_OFF) + 8; xcd_barrier(bar_); } while (0)

#ifndef PHMASK
#define PHMASK 0xffff
#endif
#define PH(k) ((PHMASK >> (k)) & 1)
#ifndef PROBE_MASK
#define PROBE_MASK 0
#endif
#define REP(k) _Pragma("nounroll") for (int rep_ = 0; rep_ < ((PROBE_MASK >> (k)) & 1) + 1; ++rep_)
    if (PH(0)) p0_prologue(F);
#if USE_CG_SYNC
    cg::this_grid().sync();
#else
    GRID_BAR();
#endif
    if (PH(1)) p0b_norm1(F);
    GRID_BAR();

#if BAR_PROBE
    for (int i_ = 0; i_ < 20; ++i_) GRID_BAR();
#endif
    for (int l = 0; l < DEPTH; ++l) {
        const bool need_ctx = (l == 0); const int nrows = need_ctx ? NROW : NLAT;
#define WSO Fp.ws
        REP(2) {
            const Frame Fp = phase_frame(F); unsigned char* const ws = WSO; bf16* Hb = (bf16*)(ws + WS_H); bf16* Pb = (bf16*)(ws + WS_P);
            pg8::Gemm g{Hb, (const bf16*)(ws + WS_WIN_T) + (size_t)l * NP * D, NROW, NP, D}; pg8::StaticOrder S; S.init(NROW, NP, Fp.G, (int)blockIdx.x);
            pg8::EpiStoreBf16 E{Pb, NP, 0xffff};
            pg8::gemm_phase<pg8::EpiStoreBf16, pg8::StaticOrder, true, true>(F.lds, g, S, E);
        }
        GRID_BAR();
        {
            const Frame Fp = phase_frame(F); unsigned char* const ws = WSO; bf16* Pb = (bf16*)(ws + WS_P);
            REP(14) for (int it = blockIdx.x; it < 256; it += F.G) fftA_item(F, it);
            if (PH(4) && need_ctx) for (int it = blockIdx.x; it < 8; it += F.G) { const int b = it >> 2, m0 = (it & 3) * 64;
                const bf16* src0 = Pb + (size_t)(NLAT + b * CTXL) * NP + COL_FC;
                dft64_item<4, 256>(F, l, m0, -1.f, 1.f / 128.f, [=](int t, int ri) { return src0 + (size_t)t * NP + ri * 256; }, [=](int m) { return NLAT + b * CTXL + m; }); }
            REP(15) shift_pass(F, l);
            REP(16) conv_pass(F, l, nrows);
        }
        GRID_BAR();
        {
            const Frame Fp = phase_frame(F); unsigned char* const ws = WSO;
            REP(11) for (int it = blockIdx.x; it < 256; it += F.G) { const int b = it >> 7, t1p = it & 127;
                const bf16* src0 = (const bf16*)(ws + WS_GT) + (size_t)(b * 128 + t1p) * 64 * 512;
                dft64_item<1, 64>(F, l, 0, 1.f, 0.0013810679320049757f, [=](int t, int ri) { return src0 + (size_t)t * 512 + ri * 256; }, [=](int m) { return b * SEQ + t1p + 128 * m; }); }
            REP(4) prep_phase(F, l);
        }
        GRID_BAR();
        for (int seg = 0; seg < NSEG; ++seg) {
            REP(5) pre_phase(F, seg);
            GRID_BAR();
            REP(6) for (int it = blockIdx.x; it < 128; it += F.G) { const int x_ = it & 7, j_ = it >> 3;
#if SEQ_PROBE_PRE
                seq_item<SEQ_PROBE_PRE>(F, ((x_ + 8 * (j_ >> 2)) << 2) | (j_ & 3), seg, need_ctx);
#endif
                seq_item<0>(F, ((x_ + 8 * (j_ >> 2)) << 2) | (j_ & 3), seg, need_ctx);
#if SEQ_PROBE
                seq_item<SEQ_PROBE>(F, ((x_ + 8 * (j_ >> 2)) << 2) | (j_ & 3), seg, need_ctx);
#endif
            }
            GRID_BAR();
        }
        REP(7) readout_pass(F, l, nrows);
        GRID_BAR();
        REP(8) if (l == 0 || rep_ == 0) {
            const Frame Fp = phase_frame(F); unsigned char* const ws = WSO; bf16* Hb = (bf16*)(ws + WS_H);
            pg8::Gemm g{Hb, (const bf16*)(ws + WS_WOUT_T) + (size_t)l * D * D, nrows, D, D}; pg8::StaticOrder S; S.init(nrows, D, Fp.G, (int)blockIdx.x);
            const float* X = (const float*)(ws + WS_X);
            pg8::EpiResidual E{l == 0 ? inptr(I_X) : X, l == 0 ? inptr(I_CTX) : X + (size_t)NLAT * D, (float*)(ws + WS_X), (const float*)(ws + WS_MODF) + (size_t)l * 3 * 6144 + 2 * 1024};
            pg8::gemm_phase<pg8::EpiResidual, pg8::StaticOrder, true, true>(F.lds, g, S, E);
        }
        expert_convert(F, l, (nrows / 256) * 4 > F.G ? (nrows / 256) * 4 - F.G : 0);
        GRID_BAR();
        if (PH(12)) router_pass(F, l, nrows);
        GRID_BAR();
        REP(10) gather_pass(F, l, nrows);
        GRID_BAR();
        if (PH(14)) {
            const Frame Fp = phase_frame(F); unsigned char* const ws = WSO;
            const int* tile_e = (const int*)(ws + WS_ROUTE + RT_TILE); const int ntiles = *(const int*)(ws + WS_ROUTE + RT_NT);
            pg8::MoeOrder S{tile_e, ntiles, Fp.G, (int)blockIdx.x};
            REP(12) {   pg8::Gemm g{(const bf16*)(ws + WS_XS), (const bf16*)(ws + WS_WGU_T), 0, 0, D};
                pg8::EpiSwiGLU E{(bf16*)(ws + WS_ACT)};
                pg8::gemm_phase<pg8::EpiSwiGLU, pg8::MoeOrder, true, true>(F.lds, g, S, E); }
            GRID_BAR();
            REP(13) {   pg8::Gemm g{(const bf16*)(ws + WS_ACT), (const bf16*)(ws + WS_WD_T), 0, 0, DEXP};
                pg8::EpiStoreBf16 E{(bf16*)(ws + WS_XS), D, 3};
                pg8::gemm_phase<pg8::EpiStoreBf16, pg8::MoeOrder, true, true>(F.lds, g, S, E); }
        }
        GRID_BAR();
        if (PH(15)) combine_pass(F, l, nrows);
        if (l + 1 < DEPTH) GRID_BAR();
    }
}

extern "C" void kernel_launch(void* const* d_in, const int* in_sizes, int n_in, void* d_out, int out_size, void* d_ws, size_t ws_size, hipStream_t stream) {
    static int grid = 0;
    if (grid == 0) {
        if (n_in != N_IN || in_sizes[0] != NLAT * D || out_size != NLAT * D || ws_size < WS_END) {
            fprintf(stderr, "kernel_launch: unexpected shapes (n_in %d in0 %d out %d ws %zu)\n", n_in, n_in > 0 ? in_sizes[0] : -1, out_size, ws_size); grid = -1; return; }
        int dev = 0, cus = 0, per_cu = 0;
        hipGetDevice(&dev); hipDeviceGetAttribute(&cus, hipDeviceAttributeMultiprocessorCount, dev);
        hipFuncSetAttribute((const void*)fwd_megakernel, hipFuncAttributeMaxDynamicSharedMemorySize, LDS_BYTES);
        hipOccupancyMaxActiveBlocksPerMultiprocessor(&per_cu, (const void*)fwd_megakernel, NTHR, LDS_BYTES);
        if (per_cu < 1) { fprintf(stderr, "kernel_launch: occupancy query says %d blocks per CU\n", per_cu); per_cu = 1; }
        (void)hipGetLastError();
        grid = cus * per_cu;
    }
    if (grid < 0) return;
    hipMemsetAsync((char*)d_ws + WS_CTL, 0, CTL_ZERO_BYTES, stream);
    Params p{};
    for (int i = 0; i < N_IN; ++i) p.in[i] = (const float*)d_in[i];
    p.out = (float*)d_out; p.ws = (unsigned char*)d_ws;
    void* args[] = {&p};
    hipError_t e = hipLaunchCooperativeKernel((const void*)fwd_megakernel, dim3(grid), dim3(NTHR), args, LDS_BYTES, stream);
    if (e != hipSuccess) fprintf(stderr, "kernel_launch: cooperative launch failed: %s (grid %d)\n", hipGetErrorString(e), grid);
}
```

```cpp
#include <hip/hip_runtime.h>
#include <hip/hip_cooperative_groups.h>
#include <cstdio>
#include <cstdint>
namespace cg = cooperative_groups;
#ifndef USE_CG_SYNC
#define USE_CG_SYNC 0
#endif
#define SEQ_PROBE 0
#define SEQ_PROBE_PRE 0
#define PRE_PROBE 0
#define BAR_PROBE 0
#define RC_PROBE 0
#define PREP_PROBE 0
#ifndef PROBE_MASK
#define PROBE_MASK 0
#endif
namespace pg8 {
#define PG8_LAS __attribute__((address_space(3)))
typedef unsigned short bf16_t;
typedef short bf16x8 __attribute__((ext_vector_type(8)));
typedef float f32x4 __attribute__((ext_vector_type(4)));
typedef unsigned u32x4 __attribute__((ext_vector_type(4)));
constexpr int BM = 256, BK = 64, HALF = 128, HTB = HALF * BK * 2  , STAGE_BYTES = 8 * HTB, NXCD = 8, WGM = 8;

__host__ __device__ __forceinline__ int lds_byte(int r, int c) { const int st = (r >> 4) * 2 + (c >> 5), rr = r & 15, cc = c & 31, ob = rr * 64 + cc * 2; return st * 1024 + (ob ^ (((ob >> 9) & 1) << 5)); }
__host__ __device__ __forceinline__ void stage_rc(int b, int& R, int& C) { const int st = b / 1024, sb = b % 1024, swz = sb ^ (((sb >> 9) & 1) << 5); R = (st >> 1) * 16 + swz / 64; C = (st & 1) * 32 + (swz % 64) / 2; }
__host__ __device__ __forceinline__ int perm32(int rho) { const int n = rho >> 4, i = rho & 15; return 8 * (i >> 2) + 4 * n + (i & 3); }

struct Unit { int pm, pn; };
struct Gemm { const bf16_t* A; const bf16_t* Bt; int M, N, K; };

struct StaticOrder {
    int nM, nN, nwg, G, c;
    __host__ __device__ void init(int M, int N, int G_, int c_) { nM = M / BM; nN = N / BM; nwg = nM * nN; G = G_; c = c_; }
    __host__ __device__ bool next(int i, Unit& u) const {
        const long L = (long)i * G + c; if (L >= nwg) return false;
        int wgid = (int)L; { const int q = nwg / NXCD, r = nwg % NXCD, xcd = wgid % NXCD, off = wgid / NXCD; wgid = (xcd < r ? xcd * (q + 1) : r * (q + 1) + (xcd - r) * q) + off; }
        const int nig = WGM * nN, gid = wgid / nig, fm = gid * WGM, gsz = (nM - fm) < WGM ? (nM - fm) : WGM;
        u.pm = fm + ((wgid % nig) % gsz); u.pn = (wgid % nig) / gsz; return true;
    }
    __device__ __forceinline__ void a_ready(const Unit&) const {}
    __device__ __forceinline__ void done(const Unit&) const {}
};

__device__ __forceinline__ unsigned cvt_pk_bf16(float lo, float hi) { unsigned r; asm volatile("v_cvt_pk_bf16_f32 %0, %1, %2" : "=v"(r) : "v"(lo), "v"(hi)); return r; }
typedef float f32x2 __attribute__((ext_vector_type(2)));
template <class Epi, class Sched, bool ALIGN_EPI = false, bool SP2 = false>
__device__ __forceinline__ void gemm_phase(PG8_LAS unsigned char* lds, const Gemm g, const Sched& S, const Epi& E) {
    int tid = threadIdx.x; asm volatile("" : "+v"(tid));
    const int wid = __builtin_amdgcn_readfirstlane(tid >> 6), lane = tid & 63, wr = wid >> 2, wc = wid & 3, fr = lane & 15, fq = lane >> 4;
    const int K = g.K, nt = K / BK;
    unsigned voffA[2], voffB[2];
#pragma unroll
    for (int i = 0; i < 2; ++i) { int R, C; stage_rc(tid * 16 + i * 8192, R, C); const int Rb = Epi::PERM ? ((R & ~31) + perm32(R & 31)) : R;
        voffA[i] = (unsigned)(R * K + C) * 2u; voffB[i] = (unsigned)(Rb * K + C) * 2u; }
    const size_t kstep = (size_t)(BK * 2);
    const size_t hstep = (size_t)HALF * K * 2;
    const size_t tstep = 2 * hstep;
    const unsigned ldsw = (unsigned)wid * 1024u;
    const int aoff = lds_byte(wr * 64 + fr, fq * 8), boff = lds_byte(wc * 32 + fr, fq * 8);
#define PG8_SA(b, h) (((b) * 2 + (h)) * HTB)
#define PG8_SB(b, h) ((4 + (b) * 2 + (h)) * HTB)
#define PG8_STAGE(bufoff, gbase, voff) do { _Pragma("unroll") for (int _i = 0; _i < 2; ++_i) \
        __builtin_amdgcn_global_load_lds((const unsigned*)((const char*)(gbase) + (voff)[_i]), (PG8_LAS unsigned*)(lds + (bufoff) + ldsw + _i * 8192), 16, 0, 0); } while (0)
#define PG8_LDA(dst, b, h) do { _Pragma("unroll") for (int m = 0; m < 4; ++m) _Pragma("unroll") for (int k = 0; k < 2; ++k) dst[m][k] = *(const PG8_LAS bf16x8*)(lds + PG8_SA(b, h) + aoff + m * 2048 + k * 1024); } while (0)
#define PG8_LDB(dst, b, h) do { _Pragma("unroll") for (int n = 0; n < 2; ++n) _Pragma("unroll") for (int k = 0; k < 2; ++k) dst[n][k] = *(const PG8_LAS bf16x8*)(lds + PG8_SB(b, h) + boff + n * 2048 + k * 1024); } while (0)
#define PG8_MMA(ai, bj, At, Bt) do { __builtin_amdgcn_s_setprio(1); _Pragma("unroll") for (int m = 0; m < 4; ++m) _Pragma("unroll") for (int n = 0; n < 2; ++n) _Pragma("unroll") for (int k = 0; k < 2; ++k) \
        acc[ai][bj][m][n] = __builtin_amdgcn_mfma_f32_16x16x32_bf16(Bt[n][k], At[m][k], acc[ai][bj][m][n], 0, 0, 0); __builtin_amdgcn_s_setprio(0); } while (0)
#define PG8_WAIT_V(n) asm volatile("s_waitcnt vmcnt(" #n ")" ::: "memory")
#define PG8_WAIT_L(n) asm volatile("s_waitcnt lgkmcnt(" #n ")" ::: "memory")
#define PG8_BAR __builtin_amdgcn_s_barrier()
#define PG8_SCHED __builtin_amdgcn_sched_barrier(0)
    Unit cur, nxt; int ui = 0;
    if (!S.next(0, cur)) return;
    f32x4 acc[2][2][4][2];
#pragma unroll
    for (int a = 0; a < 2; ++a)
#pragma unroll
        for (int b = 0; b < 2; ++b)
#pragma unroll
            for (int m = 0; m < 4; ++m)
#pragma unroll
                for (int n = 0; n < 2; ++n) acc[a][b][m][n] = (f32x4){0.f, 0.f, 0.f, 0.f};
    bf16x8 At[4][2], B0[2][2], B1[2][2];
    const char* cA = (const char*)g.A + (size_t)cur.pm * tstep; const char* cB = (const char*)g.Bt + (size_t)cur.pn * tstep;
    S.a_ready(cur);
    if constexpr (SP2) {
        PG8_STAGE(PG8_SB(0, 0), cB, voffB); PG8_STAGE(PG8_SB(0, 1), cB + hstep, voffB); PG8_STAGE(PG8_SA(0, 0), cA, voffA); PG8_STAGE(PG8_SA(0, 1), cA + hstep, voffA);
        if (wr == 1) PG8_BAR;
        PG8_WAIT_V(2); PG8_BAR;
        PG8_STAGE(PG8_SB(1, 0), cB + kstep, voffB); PG8_STAGE(PG8_SA(1, 0), cA + kstep, voffA); PG8_STAGE(PG8_SB(1, 1), cB + hstep + kstep, voffB);
        PG8_WAIT_V(6); PG8_BAR;
    } else {
        PG8_STAGE(PG8_SB(0, 0), cB, voffB); PG8_STAGE(PG8_SA(0, 0), cA, voffA); PG8_STAGE(PG8_SB(0, 1), cB + hstep, voffB); PG8_STAGE(PG8_SA(0, 1), cA + hstep, voffA);
        if (wr == 1) PG8_BAR;
        PG8_WAIT_V(4); PG8_BAR;
        PG8_STAGE(PG8_SB(1, 0), cB + kstep, voffB); PG8_STAGE(PG8_SA(1, 0), cA + kstep, voffA); PG8_STAGE(PG8_SB(1, 1), cB + hstep + kstep, voffB);
        PG8_WAIT_V(6); PG8_BAR;
    }
    for (;;) {
        const bool has_next = S.next(ui + 1, nxt);
        const char* nA = has_next ? (const char*)g.A + (size_t)nxt.pm * tstep : cA; const char* nB = has_next ? (const char*)g.Bt + (size_t)nxt.pn * tstep : cB;
        for (int t = 0; t < nt; t += 2) {
            const bool last = (t == nt - 2);
            const char* a1 = cA + (size_t)(t + 1) * kstep;
            const char* a2 = last ? nA : cA + (size_t)(t + 2) * kstep; const char* b2 = last ? nB : cB + (size_t)(t + 2) * kstep;
            const char* a3 = a2 + kstep; const char* b3 = b2 + kstep;
            if (last && has_next) S.a_ready(nxt);
            if constexpr (SP2) {
            PG8_LDB(B0, 0, 0); PG8_LDB(B1, 0, 1); PG8_SCHED; PG8_LDA(At, 0, 0); PG8_STAGE(PG8_SA(1, 1), a1 + hstep, voffA);
            PG8_WAIT_V(8); PG8_WAIT_L(0); PG8_BAR; PG8_MMA(0, 0, At, B0); PG8_MMA(0, 1, At, B1); PG8_BAR; PG8_SCHED;
            PG8_LDA(At, 0, 1); PG8_STAGE(PG8_SB(0, 0), b2, voffB); PG8_STAGE(PG8_SB(0, 1), b2 + hstep, voffB); PG8_STAGE(PG8_SA(0, 0), a2, voffA);
            PG8_WAIT_V(8); PG8_WAIT_L(0); PG8_BAR; PG8_MMA(1, 0, At, B0); PG8_MMA(1, 1, At, B1); PG8_BAR; PG8_SCHED;
            PG8_LDB(B0, 1, 0); PG8_LDB(B1, 1, 1); PG8_SCHED; PG8_LDA(At, 1, 0); PG8_STAGE(PG8_SA(0, 1), a2 + hstep, voffA);
            PG8_WAIT_V(8); PG8_WAIT_L(0); PG8_BAR; PG8_MMA(0, 0, At, B0); PG8_MMA(0, 1, At, B1); PG8_BAR; PG8_SCHED;
            PG8_LDA(At, 1, 1); PG8_STAGE(PG8_SB(1, 0), b3, voffB); PG8_STAGE(PG8_SB(1, 1), b3 + hstep, voffB); PG8_STAGE(PG8_SA(1, 0), a3, voffA);
            PG8_WAIT_V(8); PG8_WAIT_L(0); PG8_BAR; PG8_MMA(1, 0, At, B0); PG8_MMA(1, 1, At, B1); PG8_BAR; PG8_SCHED;
            } else {
            PG8_LDB(B0, 0, 0); PG8_SCHED; PG8_LDA(At, 0, 0); PG8_STAGE(PG8_SA(1, 1), a1 + hstep, voffA);
            PG8_WAIT_L(8); PG8_BAR; PG8_WAIT_L(0); PG8_MMA(0, 0, At, B0); PG8_BAR; PG8_SCHED;
            PG8_LDB(B1, 0, 1); PG8_STAGE(PG8_SB(0, 0), b2, voffB);
            PG8_BAR; PG8_WAIT_L(0); PG8_MMA(0, 1, At, B1); PG8_BAR;
            PG8_LDA(At, 0, 1); PG8_STAGE(PG8_SA(0, 0), a2, voffA);
            PG8_BAR; PG8_WAIT_L(0); PG8_MMA(1, 0, At, B0); PG8_BAR; PG8_SCHED;
            PG8_STAGE(PG8_SB(0, 1), b2 + hstep, voffB);
            PG8_WAIT_V(6); PG8_BAR; PG8_MMA(1, 1, At, B1); PG8_BAR;
            PG8_LDB(B0, 1, 0); PG8_SCHED; PG8_LDA(At, 1, 0); PG8_STAGE(PG8_SA(0, 1), a2 + hstep, voffA);
            PG8_WAIT_L(8); PG8_BAR; PG8_WAIT_L(0); PG8_MMA(0, 0, At, B0); PG8_BAR; PG8_SCHED;
            PG8_LDB(B1, 1, 1); PG8_STAGE(PG8_SB(1, 0), b3, voffB);
            PG8_BAR; PG8_WAIT_L(0); PG8_MMA(0, 1, At, B1); PG8_BAR;
            PG8_LDA(At, 1, 1); PG8_STAGE(PG8_SA(1, 0), a3, voffA);
            PG8_BAR; PG8_WAIT_L(0); PG8_MMA(1, 0, At, B0); PG8_BAR; PG8_SCHED;
            PG8_STAGE(PG8_SB(1, 1), b3 + hstep, voffB);
            PG8_WAIT_V(6); PG8_BAR; PG8_MMA(1, 1, At, B1); PG8_BAR;
            }
        }
        if constexpr (ALIGN_EPI) { if (wr == 0) PG8_BAR; }
        if constexpr (!Epi::AFTER_DRAIN) { E(acc, cur, wr, wc, fr, fq); S.done(cur); }
        if (!has_next) break;
#pragma unroll
        for (int a = 0; a < 2; ++a)
#pragma unroll
            for (int b = 0; b < 2; ++b)
#pragma unroll
                for (int m = 0; m < 4; ++m)
#pragma unroll
                    for (int n = 0; n < 2; ++n) acc[a][b][m][n] = (f32x4){0.f, 0.f, 0.f, 0.f};
        cur = nxt; cA = nA; cB = nB; ++ui;
        if constexpr (ALIGN_EPI) { if (wr == 1) PG8_BAR; }
    }
    PG8_WAIT_V(0);
    if constexpr (!ALIGN_EPI) { if (wr == 0) PG8_BAR; }
    PG8_BAR;
    if constexpr (Epi::AFTER_DRAIN) { E.fused(acc, cur, wr, wc, fr, fq, lds, wid, lane); S.done(cur); }
#undef PG8_SA
#undef PG8_SB
#undef PG8_STAGE
#undef PG8_LDA
#undef PG8_LDB
#undef PG8_MMA
#undef PG8_WAIT_V
#undef PG8_WAIT_L
#undef PG8_BAR
#undef PG8_SCHED
}
}
#define LAS __attribute__((address_space(3)))
typedef unsigned short bf16;
typedef float f32x4 __attribute__((ext_vector_type(4)));
typedef short bf16x8 __attribute__((ext_vector_type(8)));
typedef unsigned u32x4 __attribute__((ext_vector_type(4)));
typedef unsigned u32x2 __attribute__((ext_vector_type(2)));

constexpr int D = 1024, NBATCH = 2, SEQ = 8192, CTXL = 256, DEPTH = 2;
constexpr int NLAT = NBATCH * SEQ, NCTX = NBATCH * CTXL, NROW = NLAT + NCTX;
constexpr int DR = 512, DIN = 2944, NP = 3328, ZW = 1920, NHEAD = 8;
constexpr int COL_CONV = 1920, COL_FC = 2688, COL_FS = 2944;
constexpr int STRW = 5120;
constexpr int NEXP = 32, DEXP = 512;
constexpr int MOE_MAXTILES = 168;
constexpr float RMS_EPS = 1e-6f, GN_EPS = 64e-5f;

enum { I_X = 0, I_C, I_CTX, I_CCTX, I_ADAW, I_ADAB, I_N1G, I_N2G, I_WIN, I_MU, I_DW0, I_DW2, I_IA0, I_IA2, I_GG2, I_KK, I_KA, I_RK, I_GNW, I_GNB,
       I_CONVW, I_CONVG, I_FOURG, I_WOUT, I_RGW, I_RGB, I_REW, I_REB, I_EG, I_EU, I_ED, I_FG, N_IN };

constexpr size_t MiB = 1u << 20;
constexpr size_t WS_CTL = 0, CTL_ZERO_BYTES = 64 * 1024;
constexpr size_t WS_MODP = 1 * MiB;
constexpr size_t WS_MODF = 1 * MiB + 1280 * 1024;
constexpr size_t WS_WIN_T = 3 * MiB;
constexpr size_t WS_WOUT_T = 16 * MiB;
constexpr size_t WS_WGU_T = 20 * MiB;
constexpr size_t WS_WD_T = 84 * MiB;
constexpr size_t WS_X = 116 * MiB;
constexpr size_t WS_H = 182 * MiB;
constexpr size_t WS_ZS = 215 * MiB;
constexpr size_t WS_P = 277 * MiB;
constexpr size_t WS_STR = 277 * MiB;
constexpr size_t WS_Y = 442 * MiB;
constexpr size_t WS_GT = 475 * MiB;
constexpr size_t WS_ROUTE = 491 * MiB;
constexpr size_t WS_XS = 215 * MiB;
constexpr size_t WS_ACT = 299 * MiB;
constexpr size_t WS_END = 530 * MiB;
constexpr size_t RT_E = 0, RT_POS = 1 * 33792 * 4, RT_GATE = 2 * 33792 * 4, RT_SLOT = 3 * 33792 * 4, RT_TILE = 4 * 33792 * 4, RT_NT = RT_TILE + 1024;

constexpr int CW_BAR = 4096;
constexpr int CW_CNT = 8192;

constexpr int NWAVES = 8, NTHR = 512;
constexpr int RING_BYTES = 131072, LDSCTL_OFF = 143360, MISC_OFF = LDSCTL_OFF + 320, LDS_BYTES = 147456;

struct Params { const float* in[N_IN]; float* out; unsigned char* ws; };

__device__ __forceinline__ float bf2f(unsigned h) { return __uint_as_float(h << 16); }
typedef __bf16 hwbf2 __attribute__((ext_vector_type(2)));
typedef float f32x2 __attribute__((ext_vector_type(2)));
__device__ __forceinline__ unsigned pk2(float lo, float hi) { const f32x2 x = {lo, hi}; const hwbf2 r = __builtin_convertvector(x, hwbf2); return __builtin_bit_cast(unsigned, r); }
__device__ __forceinline__ unsigned f2bf(float f) { return pk2(f, 0.f) & 0xffffu; }
__device__ __forceinline__ float wave_sum(float v) {
#pragma unroll
    for (int o = 1; o < 64; o <<= 1) v += __shfl_xor(v, o);
    return v;
}
__device__ __forceinline__ float sigmoidf_(float x) { return 1.f / (1.f + __expf(-x)); }
#define LDS_WAIT() asm volatile("s_waitcnt lgkmcnt(0)" ::: "memory")
#define VM_WAIT() asm volatile("s_waitcnt vmcnt(0)" ::: "memory")

struct Frame {
    LAS unsigned char* lds;
    int tid, lane, wave, vcu, G, gw, NGW;
    float* out; unsigned char* ws;
};
#if defined(__HIP_DEVICE_COMPILE__)
#define ASSUME_GLOBAL(p) do { __builtin_assume(!__builtin_amdgcn_is_shared(p)); __builtin_assume(!__builtin_amdgcn_is_private(p)); } while (0)
#else
#define ASSUME_GLOBAL(p) do { } while (0)
#endif
__device__ __forceinline__ const float* inptr(int i) {
    const volatile unsigned long long __attribute__((address_space(4)))* ka = (const volatile unsigned long long __attribute__((address_space(4)))*)__builtin_amdgcn_kernarg_segment_ptr();
    return (const float*)(const __attribute__((address_space(1))) float*)ka[i];
}
__device__ __forceinline__ unsigned char* opaque(unsigned char* p) { unsigned long z = 0; asm volatile("" : "+s"(z)); return p + z; }
__device__ __forceinline__ Frame phase_frame(const Frame& F0) { Frame F = F0; asm volatile("" : "+v"(F.tid)); F.lane = F.tid & 63; F.ws = opaque(F0.ws);
    asm volatile("" : "+s"(F.G), "+s"(F.vcu)); F.gw = F.vcu * NWAVES + F.wave; F.NGW = F.G * NWAVES; return F; }
__device__ __forceinline__ int modrow(int row) { return row < NLAT ? (row >> 13) : 2; }
#define XB_TMO      128
#define XB_XCNT(j)  (256  + 64 * (j))
#define XB_XSUB(j)  (1280 + 64 * (j))
#define XB_XGEN(j)  (2304 + 64 * (j))
#define XB_TOP      3328
#define XB_TOPGEN   3392
#define XCD_BAR_WORDS 3456
#define XB_SPIN_CAP (1u << 18)

__device__ __forceinline__ unsigned xb_ld(unsigned* p)              { return __hip_atomic_load(p, __ATOMIC_RELAXED, __HIP_MEMORY_SCOPE_AGENT); }
__device__ __forceinline__ unsigned xb_add(unsigned* p, unsigned v) { return __hip_atomic_fetch_add(p, v, __ATOMIC_RELAXED, __HIP_MEMORY_SCOPE_AGENT); }
__device__ __forceinline__ unsigned xb_xcc_id() { return (unsigned)__builtin_amdgcn_s_getreg((3 << 11) | 20) & 0xFu; }
#define XB_SPIN(cond, bar) do { unsigned _sp = 0; while (cond) { __builtin_amdgcn_s_sleep(1); \
    if ((++_sp & 255u) == 0u) { if (xb_ld(&(bar)[XB_TMO])) break; if (_sp > XB_SPIN_CAP) { atomicAdd(&(bar)[XB_TMO], 1u); break; } } } } while (0)

struct XcdBarrier {
    unsigned* bar; unsigned x;
    volatile LAS unsigned* st;
};

__device__ __forceinline__ XcdBarrier xcd_barrier_post(unsigned* bar, volatile LAS unsigned* st) {
    XcdBarrier b; b.bar = bar; b.x = xb_xcc_id(); b.st = st;
    if (threadIdx.x == 0) (void)xb_add(&bar[XB_XCNT(b.x)], 1u);
    return b;
}
__device__ __forceinline__ void xcd_barrier_complete(unsigned* bar, unsigned x, unsigned& nloc, unsigned& nx) {
    const unsigned G = gridDim.x * gridDim.y * gridDim.z;
    unsigned sum, cnt, mine, sp = 0u;
    for (;;) {
        sum = 0u; cnt = 0u; mine = 0u;
#pragma nounroll
        for (unsigned j = 0; j < 16; ++j) { const unsigned c = xb_ld(&bar[XB_XCNT(j)]); sum += c; cnt += (c > 0u) ? 1u : 0u; mine = (j == x) ? c : mine; }
        if (sum == G) break;
        __builtin_amdgcn_s_sleep(1);
        if ((++sp & 255u) == 0u) { if (xb_ld(&bar[XB_TMO])) break; if (sp > XB_SPIN_CAP) { atomicAdd(&bar[XB_TMO], 1u); break; } }
    }
    nloc = mine > 0u ? mine : 1u; nx = cnt > 0u ? cnt : 1u;
}

__device__ __forceinline__ void xcd_barrier(const XcdBarrier& b) {
    asm volatile("s_waitcnt vmcnt(0)" ::: "memory");
    __syncthreads();
    if (threadIdx.x == 0) {
        unsigned* bar = b.bar;
        asm volatile("" : "+s"(bar));
        __builtin_amdgcn_s_waitcnt(0);
        unsigned nloc = b.st[0], nx = b.st[1];
        if (nloc == 0u) { xcd_barrier_complete(bar, b.x, nloc, nx); b.st[0] = nloc; b.st[1] = nx; }
        const unsigned old = xb_add(&bar[XB_XSUB(b.x)], 1u);
        const unsigned gen = old / nloc;
        if (old + 1u == (gen + 1u) * nloc) {
            __builtin_amdgcn_fence(__ATOMIC_RELEASE, "agent");
            asm volatile("s_waitcnt vmcnt(0)" ::: "memory");
            const unsigned og = xb_add(&bar[XB_TOP], 1u);
            const unsigned tg = og / nx;
            if (og + 1u == (tg + 1u) * nx) xb_add(&bar[XB_TOPGEN], 1u);
            else XB_SPIN(xb_ld(&bar[XB_TOPGEN]) == tg, bar);
            __builtin_amdgcn_fence(__ATOMIC_ACQUIRE, "agent");
            xb_add(&bar[XB_XGEN(b.x)], 1u);
            asm volatile("s_waitcnt vmcnt(0)" ::: "memory");
        } else {
            XB_SPIN(xb_ld(&bar[XB_XGEN(b.x)]) == gen, bar);
            __builtin_amdgcn_fence(__ATOMIC_ACQUIRE, "agent");
            asm volatile("s_waitcnt vmcnt(0)" ::: "memory");
        }
    }
    __syncthreads();
}
template <class RowMap>
__device__ __forceinline__ void transpose_item(const float* W, int ldw, int k0, int n0, bf16* WT, int ldt, RowMap rm, LAS float* scr, int lane) {
    (void)scr;
    const int nq = lane & 7, kg = lane >> 3; const float* src = W + (size_t)(k0 + 8 * kg) * ldw + n0 + 4 * nq;
    f32x4 v[8];
#pragma unroll
    for (int i = 0; i < 8; ++i) v[i] = *(const f32x4*)(src + (size_t)i * ldw);
#pragma unroll
    for (int j = 0; j < 4; ++j) { u32x4 o = {pk2(v[0][j], v[1][j]), pk2(v[2][j], v[3][j]), pk2(v[4][j], v[5][j]), pk2(v[6][j], v[7][j])};
        *(u32x4*)(WT + (size_t)rm(n0 + 4 * nq + j) * ldt + k0 + 8 * kg) = o; }
}
struct RmId { int off; __device__ __forceinline__ int operator()(int n) const { return off + n; } };
struct RmGU { int off; __device__ __forceinline__ int operator()(int n) const { return off + ((n >> 2) << 3) + (n & 3); } };

__device__ __forceinline__ void p0_prologue(const Frame& F0) {
    const Frame F = phase_frame(F0); unsigned char* const ws = F.ws;
    LAS float* scr = (LAS float*)(F.lds + F.wave * 16384);
    LAS float* ctab = (LAS float*)(F.lds + 8 * 16384);
    if (F.tid < 64) ctab[F.tid] = cosf((float)F.tid * (6.283185307179586f / 64.f));
    __syncthreads();
    bf16* win_t = (bf16*)(ws + WS_WIN_T); bf16* wout_t = (bf16*)(ws + WS_WOUT_T);
    constexpr int I_WIN_L = 16 * 84, I_WOUT_L = 16 * 32, I_FOLD_L = 4 * 64, I_MOD_L = 96 * 8;
    constexpr int NIT = 2 * (I_WIN_L + I_WOUT_L + I_FOLD_L + I_MOD_L);
    const float* p_win = inptr(I_WIN); const float* p_wout = inptr(I_WOUT); const float* p_c = inptr(I_C); const float* p_cctx = inptr(I_CCTX); const float* p_adaw = inptr(I_ADAW);
    {
        bf16* wl = (bf16*)(ws + 64 * 1024); const float* dw2 = inptr(I_DW2); const float* ia2 = inptr(I_IA2); const float* gg2 = inptr(I_GG2);
        for (int idx = F.vcu * NTHR + F.tid; idx < 2 * 384 * 512; idx += F.G * NTHR) { const int c = idx & 511, k = (idx >> 9) % 384, l = idx / (384 * 512);
            float v;
            if (k < 128) v = dw2[((size_t)(l * 2 + (k >> 6)) * 64 + (k & 63)) * DR + c];
            else if (k < 256) v = ia2[((size_t)(l * 2 + ((k - 128) >> 6)) * 64 + (k & 63)) * DR + c];
            else v = gg2[((size_t)l * 128 + (k - 256)) * DR + c];
            wl[((size_t)l * 512 + c) * 384 + k] = (bf16)f2bf(v); } }
    for (int it = F.gw; it < NIT; it += F.NGW) {
        int r = it; const int l = r & 1; r >>= 1;
        if (r < I_WIN_L) { const int kb = r / 84, nb = r % 84;
            transpose_item(p_win + (size_t)l * D * DIN, DIN, kb * 64, nb * 32, win_t + (size_t)l * NP * D, D, RmId{0}, scr, F.lane); continue; }
        r -= I_WIN_L;
        if (r < I_WOUT_L) { const int kb = r / 32, nb = r % 32;
            transpose_item(p_wout + (size_t)l * D * D, D, kb * 64, nb * 32, wout_t + (size_t)l * D * D, D, RmId{0}, scr, F.lane); continue; }
        r -= I_WOUT_L;
        if (r < I_FOLD_L) {
            const int g = r >> 6, k0 = (r & 63) * 16; const float* W = p_win + (size_t)l * D * DIN;
#pragma unroll
            for (int kk = 0; kk < 16; ++kk) scr[kk * 64 + F.lane] = W[(size_t)(k0 + kk) * DIN + 2688 + g * 64 + F.lane];
            LDS_WAIT(); asm volatile("" ::: "memory");
            float ac[16], as[16];
#pragma unroll
            for (int kk = 0; kk < 16; ++kk) { ac[kk] = 0.f; as[kk] = 0.f; }
            for (int c = 0; c < 64; ++c) { const int idx = (c * F.lane) & 63; const float cc = ctab[idx], ss = ctab[(idx - 16) & 63];
#pragma unroll
                for (int kk = 0; kk < 16; ++kk) { const float w = scr[kk * 64 + c]; ac[kk] += w * cc; as[kk] += w * ss; } }
            bf16* oc = win_t + (size_t)l * NP * D + (size_t)(COL_FC + g * 64 + F.lane) * D + k0;
            bf16* os = win_t + (size_t)l * NP * D + (size_t)(COL_FS + g * 64 + F.lane) * D + k0;
            u32x4 a, b;
            a.x = pk2(ac[0], ac[1]); a.y = pk2(ac[2], ac[3]); a.z = pk2(ac[4], ac[5]); a.w = pk2(ac[6], ac[7]);
            b.x = pk2(ac[8], ac[9]); b.y = pk2(ac[10], ac[11]); b.z = pk2(ac[12], ac[13]); b.w = pk2(ac[14], ac[15]);
            *(u32x4*)oc = a; *(u32x4*)(oc + 8) = b;
            a.x = pk2(as[0], as[1]); a.y = pk2(as[2], as[3]); a.z = pk2(as[4], as[5]); a.w = pk2(as[6], as[7]);
            b.x = pk2(as[8], as[9]); b.y = pk2(as[10], as[11]); b.z = pk2(as[12], as[13]); b.w = pk2(as[14], as[15]);
            *(u32x4*)os = a; *(u32x4*)(os + 8) = b;
            LDS_WAIT(); asm volatile("" ::: "memory");
            continue; }
        r -= I_FOLD_L;
        {
            const int cb = r >> 3, ks = r & 7;
#pragma unroll
            for (int q = 0; q < 2; ++q) { const int k = ks * 128 + q * 64 + F.lane;
                const float c0 = p_c[k], c1 = p_c[D + k], c2 = p_cctx[k];
                scr[0 * 128 + q * 64 + F.lane] = c0 * sigmoidf_(c0); scr[1 * 128 + q * 64 + F.lane] = c1 * sigmoidf_(c1); scr[2 * 128 + q * 64 + F.lane] = c2 * sigmoidf_(c2); }
            LDS_WAIT(); asm volatile("" ::: "memory");
            const float* W = p_adaw + (size_t)l * D * 6144 + (size_t)(ks * 128) * 6144 + cb * 64 + F.lane;
            float a0 = 0.f, a1 = 0.f, a2 = 0.f;
#pragma unroll 8
            for (int kk = 0; kk < 128; ++kk) { const float w = W[(size_t)kk * 6144]; a0 += scr[kk] * w; a1 += scr[128 + kk] * w; a2 += scr[256 + kk] * w; }
            float* mp = (float*)(ws + WS_MODP) + (size_t)((l * 8 + ks) * 3) * 6144 + cb * 64 + F.lane;
            mp[0] = a0; mp[6144] = a1; mp[2 * 6144] = a2;
            LDS_WAIT(); asm volatile("" ::: "memory");
        }
    }
}

__device__ __forceinline__ void mod_to_lds(const Frame& F0, int l, int p, LAS float* dst, bool from_partials) {
    const Frame F = phase_frame(F0); unsigned char* const ws = F.ws;
    const float* adab = inptr(I_ADAB);
    for (int idx = F.tid; idx < 3 * 1024; idx += NTHR) { const int r = idx >> 10, n = idx & 1023;
        float v;
        if (from_partials) { v = adab[l * 6144 + p * 1024 + n]; const float* mp = (const float*)(ws + WS_MODP) + (size_t)(l * 8 * 3 + r) * 6144 + p * 1024 + n;
#pragma unroll
            for (int ks = 0; ks < 8; ++ks) v += mp[(size_t)ks * 3 * 6144]; }
        else v = ((const float*)(ws + WS_MODF))[(size_t)(l * 3 + r) * 6144 + p * 1024 + n];
        dst[idx] = v; }
}
__device__ __forceinline__ void mod_finalize(const Frame& F0) {
    const Frame F = phase_frame(F0); unsigned char* const ws = F.ws;
    const float* adab = inptr(I_ADAB);
    for (int idx = F.vcu * NTHR + F.tid; idx < 2 * 3 * 6144; idx += F.G * NTHR) { const int l = idx / (3 * 6144), rem = idx % (3 * 6144), r = rem / 6144, n = rem % 6144;
        float v = adab[l * 6144 + n]; const float* mp = (const float*)(ws + WS_MODP) + (size_t)(l * 8 * 3 + r) * 6144 + n;
#pragma unroll
        for (int ks = 0; ks < 8; ++ks) v += mp[(size_t)ks * 3 * 6144];
        ((float*)(ws + WS_MODF))[idx] = v; }
}


__device__ __forceinline__ void norm_mod_row(f32x4 (&v)[4], const float* gain, const LAS float* sc, const LAS float* sh, bf16* orow, int lane) {
    float s = 0.f;
#pragma unroll
    for (int j = 0; j < 4; ++j) s += (v[j].x * v[j].x + v[j].y * v[j].y) + (v[j].z * v[j].z + v[j].w * v[j].w);
    const float rs = rsqrtf(wave_sum(s) * (1.f / D) + RMS_EPS);
#pragma unroll
    for (int j = 0; j < 4; ++j) { const int c = 4 * lane + 256 * j; const f32x4 g = *(const f32x4*)(gain + c); const f32x4 a = *(const LAS f32x4*)(sc + c), b = *(const LAS f32x4*)(sh + c);
        v[j] = (v[j] * rs) * g * (a + 1.f) + b;
        u32x2 w; w.x = pk2(v[j].x, v[j].y); w.y = pk2(v[j].z, v[j].w); *(u32x2*)(orow + c) = w; }
}

__device__ __forceinline__ void p0b_norm1(const Frame& F0) {
    const Frame F = phase_frame(F0); unsigned char* const ws = F.ws;
    LAS float* msh = (LAS float*)F.lds; LAS float* msc = msh + 3072;
    mod_to_lds(F, 0, 0, msh, true); mod_to_lds(F, 0, 1, msc, true); __syncthreads();
    mod_finalize(F);
    bf16* H = (bf16*)(ws + WS_H); const float* xin = inptr(I_X); const float* cin = inptr(I_CTX); const float* n1g = inptr(I_N1G);
    for (int row0 = F.gw; row0 < NROW; row0 += 2 * F.NGW) { f32x4 v[2][4]; bool ok[2];
#pragma unroll
        for (int u = 0; u < 2; ++u) { const int row = row0 + u * F.NGW; ok[u] = row < NROW; if (ok[u]) { const float* xr = row < NLAT ? xin + (size_t)row * D : cin + (size_t)(row - NLAT) * D;
#pragma unroll
            for (int j = 0; j < 4; ++j) v[u][j] = *(const f32x4*)(xr + 4 * F.lane + 256 * j); } }
#pragma unroll
        for (int u = 0; u < 2; ++u) if (ok[u]) { const int row = row0 + u * F.NGW; const int mr = modrow(row);
            norm_mod_row(v[u], n1g, msc + mr * 1024, msh + mr * 1024, H + (size_t)row * D, F.lane); } }
}
__device__ __forceinline__ void unpack8(const u32x4 w, float (&o)[8]) {
    o[0] = bf2f(w.x & 0xffffu); o[1] = bf2f(w.x >> 16); o[2] = bf2f(w.y & 0xffffu); o[3] = bf2f(w.y >> 16);
    o[4] = bf2f(w.z & 0xffffu); o[5] = bf2f(w.z >> 16); o[6] = bf2f(w.w & 0xffffu); o[7] = bf2f(w.w >> 16);
}
__device__ __forceinline__ void unpack4(const u32x2 w, float (&o)[4]) { o[0] = bf2f(w.x & 0xffffu); o[1] = bf2f(w.x >> 16); o[2] = bf2f(w.y & 0xffffu); o[3] = bf2f(w.y >> 16); }

__device__ __forceinline__ void shift_pass(const Frame& F0, int l) {
    const Frame F = phase_frame(F0); unsigned char* const ws = F.ws;
    const bf16* P = (const bf16*)(ws + WS_P); bf16* Zs = (bf16*)(ws + WS_ZS); const float* mu = inptr(I_MU) + l * ZW;
    const int total = NROW * 240;
    for (int idx = F.vcu * NTHR + F.tid; idx < total; idx += F.G * NTHR) {
        const int row = idx / 240, ck = idx % 240; const bf16* pr = P + (size_t)row * NP + ck * 8;
        const u32x4 zero = {0u, 0u, 0u, 0u};
        float z[8], n0[8], n1[8], n2[8], n3[8], o[8];
        unpack8(*(const u32x4*)pr, z);
        if (row < NLAT) { const int t = row & (SEQ - 1), gr = t >> 6, gc = t & 63;
            unpack8(gc > 0 ? *(const u32x4*)(pr - NP) : zero, n0); unpack8(gc < 63 ? *(const u32x4*)(pr + NP) : zero, n1);
            unpack8(gr > 0 ? *(const u32x4*)(pr - 64 * NP) : zero, n2); unpack8(gr < 127 ? *(const u32x4*)(pr + 64 * NP) : zero, n3);
        } else { const int tc = (row - NLAT) & (CTXL - 1);
            unpack8(tc > 0 ? *(const u32x4*)(pr - NP) : zero, n0); unpack8(tc < CTXL - 1 ? *(const u32x4*)(pr + NP) : zero, n1);
#pragma unroll
            for (int j = 0; j < 8; ++j) { n2[j] = n0[j]; n3[j] = n1[j]; }
        }
        const f32x4 m0 = *(const f32x4*)(mu + ck * 8), m1 = *(const f32x4*)(mu + ck * 8 + 4);
        const float m[8] = {m0.x, m0.y, m0.z, m0.w, m1.x, m1.y, m1.z, m1.w};
#pragma unroll
        for (int j = 0; j < 8; ++j) { const float nb = (j & 3) == 0 ? n0[j] : (j & 3) == 1 ? n1[j] : (j & 3) == 2 ? n2[j] : n3[j]; o[j] = z[j] + (nb - z[j]) * m[j]; }
        u32x4 w; w.x = pk2(o[0], o[1]); w.y = pk2(o[2], o[3]); w.z = pk2(o[4], o[5]); w.w = pk2(o[6], o[7]);
        *(u32x4*)(Zs + (size_t)row * ZW + ck * 8) = w;
    }
}

__device__ __forceinline__ void conv_pass(const Frame& F0, int l, int nrows) {
    const Frame F = phase_frame(F0); unsigned char* const ws = F.ws;
    const bf16* P = (const bf16*)(ws + WS_P); bf16* MA = (bf16*)(ws + WS_H);
    const float* cw = inptr(I_CONVW) + l * 3 * 256; const int c = 4 * F.lane;
    const f32x4 w0 = *(const f32x4*)(cw + c), w1 = *(const f32x4*)(cw + 256 + c), w2 = *(const f32x4*)(cw + 512 + c), gn = *(const f32x4*)(inptr(I_CONVG) + l * 256 + c);
    for (int row0 = F.gw; row0 < nrows; row0 += 2 * F.NGW) {
        u32x2 q[2][7]; bool ok[2]; const u32x2 zero = {0u, 0u};
#pragma unroll
        for (int u = 0; u < 2; ++u) { const int row = row0 + u * F.NGW; ok[u] = row < nrows; if (ok[u]) {
            int t, L; if (row < NLAT) { t = row & (SEQ - 1); L = SEQ; } else { t = (row - NLAT) & (CTXL - 1); L = CTXL; }
            const bf16* pr = P + (size_t)row * NP + COL_CONV + c;
            q[u][0] = *(const u32x2*)pr; q[u][1] = *(const u32x2*)(pr + 256); q[u][2] = *(const u32x2*)(pr + 512);
            q[u][3] = t > 0 ? *(const u32x2*)(pr - NP + 256) : zero; q[u][4] = t > 0 ? *(const u32x2*)(pr - NP + 512) : zero;
            q[u][5] = t < L - 1 ? *(const u32x2*)(pr + NP + 256) : zero; q[u][6] = t < L - 1 ? *(const u32x2*)(pr + NP + 512) : zero; } }
#pragma unroll
        for (int u = 0; u < 2; ++u) if (ok[u]) { const int row = row0 + u * F.NGW;
            float bg[4], cg[4], hh[4], cp[4], hp[4], cn[4], hn[4];
            unpack4(q[u][0], bg); unpack4(q[u][1], cg); unpack4(q[u][2], hh); unpack4(q[u][3], cp); unpack4(q[u][4], hp); unpack4(q[u][5], cn); unpack4(q[u][6], hn);
            const float W0[4] = {w0.x, w0.y, w0.z, w0.w}, W1[4] = {w1.x, w1.y, w1.z, w1.w}, W2[4] = {w2.x, w2.y, w2.z, w2.w}, GN[4] = {gn.x, gn.y, gn.z, gn.w};
            float y[4], s = 0.f;
#pragma unroll
            for (int j = 0; j < 4; ++j) { y[j] = bg[j] * (W0[j] * (cp[j] * hp[j]) + W1[j] * (cg[j] * hh[j]) + W2[j] * (cn[j] * hn[j])); s += y[j] * y[j]; }
            const float rs = rsqrtf(wave_sum(s) * (1.f / 256.f) + RMS_EPS);
            u32x2 o; o.x = pk2(y[0] * rs * GN[0], y[1] * rs * GN[1]); o.y = pk2(y[2] * rs * GN[2], y[3] * rs * GN[3]);
            *(u32x2*)(MA + (size_t)row * D + 512 + c) = o; }
    }
}

__device__ __forceinline__ void sincos_turns(float x, float& s, float& c) { s = __builtin_amdgcn_sinf(x); c = __builtin_amdgcn_cosf(x); }
#define MFMA16(a, b, c) __builtin_amdgcn_mfma_f32_16x16x32_bf16((a), (b), (c), 0, 0, 0)

__device__ __forceinline__ void fftA_item(const Frame& F0, int item) {
    const Frame F = phase_frame(F0); unsigned char* const ws = F.ws;
    const int half = item & 1, t2 = (item >> 1) & 63, b = item >> 7;
    const bf16* P = (const bf16*)(ws + WS_P); bf16* GT = (bf16*)(ws + WS_GT);
    LAS bf16* Bs = (LAS bf16*)F.lds;
    const int lane = F.lane, w = F.wave, fr = lane & 15, fq = lane >> 4;
    __syncthreads();
#pragma unroll
    for (int i = 0; i < 8; ++i) { const int cidx = F.tid + NTHR * i, krow = cidx >> 4, ch8 = cidx & 15, ri = krow >> 7, t1 = krow & 127;
        const u32x4 v = *(const u32x4*)(P + (size_t)(b * SEQ + t1 * 64 + t2) * NP + COL_FC + ri * 256 + half * 128 + ch8 * 8);
        LAS bf16* d = Bs + (ch8 * 8) * 264 + krow;
        d[0 * 264] = (bf16)(v.x & 0xffffu); d[1 * 264] = (bf16)(v.x >> 16); d[2 * 264] = (bf16)(v.y & 0xffffu); d[3 * 264] = (bf16)(v.y >> 16);
        d[4 * 264] = (bf16)(v.z & 0xffffu); d[5 * 264] = (bf16)(v.z >> 16); d[6 * 264] = (bf16)(v.w & 0xffffu); d[7 * 264] = (bf16)(v.w >> 16); }
    __syncthreads();
    f32x4 acc[2][8];
#pragma unroll
    for (int a = 0; a < 2; ++a)
#pragma unroll
        for (int n = 0; n < 8; ++n) acc[a][n] = (f32x4){0.f, 0.f, 0.f, 0.f};
    int t1p_a = 16 * w + fr;
    asm volatile("" : "+v"(t1p_a));
#pragma unroll
    for (int ks = 0; ks < 8; ++ks) {
        bf16x8 ar, ai;
#pragma unroll
        for (int j = 0; j < 8; ++j) { const int k = ks * 32 + 8 * fq + j, ri = k >> 7, t1 = k & 127; const int idx = (t1 * t1p_a) & 127;
            float sn, cs; sincos_turns((float)idx * (1.f / 128.f), sn, cs);
            const float vr = ri == 0 ? cs : -sn, vi = ri == 0 ? -sn : -cs;
            ar[j] = (short)f2bf(vr); ai[j] = (short)f2bf(vi); }
#pragma unroll
        for (int nt = 0; nt < 8; ++nt) { const bf16x8 bfr = *(const LAS bf16x8*)(Bs + (nt * 16 + fr) * 264 + ks * 32 + 8 * fq);
            acc[0][nt] = MFMA16(ar, bfr, acc[0][nt]); acc[1][nt] = MFMA16(ai, bfr, acc[1][nt]); }
    }
#pragma unroll
    for (int reg = 0; reg < 4; ++reg) { const int t1p = 16 * w + 4 * fq + reg; float st, ct; sincos_turns((float)(t2 * t1p) * (1.f / 8192.f), st, ct);
        bf16* g = GT + ((size_t)((b * 128 + t1p) * 64 + t2) * 2) * 256 + half * 128 + fr;
#pragma unroll
        for (int nt = 0; nt < 8; ++nt) { const float gr = acc[0][nt][reg], gi = acc[1][nt][reg];
            g[nt * 16] = (bf16)f2bf(gr * ct + gi * st); g[256 + nt * 16] = (bf16)f2bf(gi * ct - gr * st); } }
}

template <int NKC, int NDIV, class SrcRow, class OutRow>
__device__ __forceinline__ void dft64_item(const Frame& F0, int l, int m0, float sgn, float scale, SrcRow src, OutRow orow) {
    const Frame F = phase_frame(F0); unsigned char* const ws = F.ws;
    LAS bf16* Bs = (LAS bf16*)F.lds;
    LAS float* red = (LAS float*)(F.lds + 256 * 136 * 2);
    const int lane = F.lane, w = F.wave, fr = lane & 15, fq = lane >> 4;
    int fr_a = fr; asm volatile("" : "+v"(fr_a));
    f32x4 acc[4][2];
#pragma unroll
    for (int a = 0; a < 4; ++a) { acc[a][0] = (f32x4){0.f, 0.f, 0.f, 0.f}; acc[a][1] = (f32x4){0.f, 0.f, 0.f, 0.f}; }
    for (int kc = 0; kc < NKC; ++kc) {
        __syncthreads();
#pragma unroll
        for (int i = 0; i < 8; ++i) { const int cidx = F.tid + NTHR * i, krow = cidx >> 5, ch8 = cidx & 31;
            const u32x4 v = *(const u32x4*)(src(kc * 64 + (krow >> 1), krow & 1) + ch8 * 8);
            LAS bf16* d = Bs + (ch8 * 8) * 136 + krow;
            d[0 * 136] = (bf16)(v.x & 0xffffu); d[1 * 136] = (bf16)(v.x >> 16); d[2 * 136] = (bf16)(v.y & 0xffffu); d[3 * 136] = (bf16)(v.y >> 16);
            d[4 * 136] = (bf16)(v.z & 0xffffu); d[5 * 136] = (bf16)(v.z >> 16); d[6 * 136] = (bf16)(v.w & 0xffffu); d[7 * 136] = (bf16)(v.w >> 16); }
        __syncthreads();
#pragma unroll
        for (int ks = 0; ks < 4; ++ks) {
            const bf16x8 b0 = *(const LAS bf16x8*)(Bs + ((2 * w) * 16 + fr) * 136 + ks * 32 + 8 * fq);
            const bf16x8 b1 = *(const LAS bf16x8*)(Bs + ((2 * w + 1) * 16 + fr) * 136 + ks * 32 + 8 * fq);
#pragma unroll
            for (int mt = 0; mt < 4; ++mt) { const int mrow = m0 + mt * 16 + fr_a; bf16x8 a;
#pragma unroll
                for (int j = 0; j < 8; ++j) { const int k = ks * 32 + 8 * fq + j, tl = k >> 1, ri = k & 1; const int idx = ((kc * 64 + tl) * mrow) & (NDIV - 1);
                    float sn, cs; sincos_turns((float)idx * (1.f / (float)NDIV), sn, cs);
                    a[j] = (short)f2bf(ri == 0 ? cs : sgn * sn); }
                acc[mt][0] = MFMA16(a, b0, acc[mt][0]); acc[mt][1] = MFMA16(a, b1, acc[mt][1]); }
        }
    }
#pragma unroll
    for (int mt = 0; mt < 4; ++mt)
#pragma unroll
        for (int reg = 0; reg < 4; ++reg) { const float a = acc[mt][0][reg] * scale, b = acc[mt][1][reg] * scale; acc[mt][0][reg] = a; acc[mt][1][reg] = b;
            float s = a * a + b * b; s += __shfl_xor(s, 1); s += __shfl_xor(s, 2); s += __shfl_xor(s, 4); s += __shfl_xor(s, 8);
            if (fr == 0) red[w * 64 + mt * 16 + 4 * fq + reg] = s; }
    __syncthreads();
    bf16* MA = (bf16*)(ws + WS_H); const float* fg = inptr(I_FOURG) + l * 256;
    const float g0 = fg[(2 * w) * 16 + fr], g1 = fg[(2 * w + 1) * 16 + fr];
#pragma unroll
    for (int mt = 0; mt < 4; ++mt)
#pragma unroll
        for (int reg = 0; reg < 4; ++reg) { const int ml = mt * 16 + 4 * fq + reg; float tot = 0.f;
#pragma unroll
            for (int ww = 0; ww < 8; ++ww) tot += red[ww * 64 + ml];
            const float rs = rsqrtf(tot * (1.f / 256.f) + RMS_EPS);
            bf16* o = MA + (size_t)orow(m0 + ml) * D + 768 + fr;
            o[(2 * w) * 16] = (bf16)f2bf(acc[mt][0][reg] * rs * g0); o[(2 * w + 1) * 16] = (bf16)f2bf(acc[mt][1][reg] * rs * g1); }
    __syncthreads();
}

constexpr size_t WS_LORA = 64 * 1024;
constexpr int LINP = 392;
__device__ __forceinline__ float fast_sigmoid(float x) { return __builtin_amdgcn_rcpf(1.f + __expf(-x)); }
__device__ __forceinline__ float fast_tanh(float x) { return 1.f - 2.f * __builtin_amdgcn_rcpf(1.f + __expf(2.f * x)); }
__device__ __forceinline__ void prep_phase(const Frame& F0, int l) {
    const Frame F = phase_frame(F0); unsigned char* const ws = F.ws;
    const bf16* Zs = (const bf16*)(ws + WS_ZS); bf16* STR = (bf16*)(ws + WS_STR);
    LAS bf16* lin = (LAS bf16*)F.lds;
    LAS float* ssum = (LAS float*)(F.lds + 12544);
    LAS bf16* tiles = (LAS bf16*)(F.lds + 13312);
    const int lane = F.lane, fr = lane & 15, fq = lane >> 4, w = F.wave, tid = F.tid;
    const int nitems = (NROW / 16) * 2;
    int it = blockIdx.x; if (it >= nitems) return;
    int hh = -1, head = 0, cb = 0;
    bf16x8 wf[12][2];
    const float* kkp = inptr(I_KK) + l * DR; const float* kap = inptr(I_KA) + l * DR; const float* dw0 = inptr(I_DW0) + l * 2 * DR; const float* ia0 = inptr(I_IA0) + l * 2 * DR;
    u32x4 pz[2];
#define PREP_LOAD(item_) do { const int row0_ = ((item_) >> 1) * 16; \
        pz[0] = *(const u32x4*)(Zs + (size_t)(row0_ + tid / 48) * ZW + 1536 + (tid % 48) * 8); \
        if (tid < 256) pz[1] = *(const u32x4*)(Zs + (size_t)(row0_ + (tid + 512) / 48) * ZW + 1536 + ((tid + 512) % 48) * 8); } while (0)
    PREP_LOAD(it);
    for (; it < nitems; it += F.G) {
        const int tile = it >> 1;
        if ((it & 1) != hh) {
            hh = it & 1; head = 4 * hh + (w >> 1); cb = 64 * head + 32 * (w & 1);
            const bf16* WL = (const bf16*)(ws + WS_LORA) + (size_t)l * 512 * 384 + (size_t)(cb + fr) * 384 + 8 * fq;
#pragma unroll
            for (int ks = 0; ks < 12; ++ks)
#pragma unroll
                for (int nt = 0; nt < 2; ++nt) wf[ks][nt] = *(const bf16x8*)(WL + (size_t)nt * 16 * 384 + ks * 32);
        }
        __syncthreads();
        {   float v[8]; unpack8(pz[0], v); const int c8 = tid % 48;
            if (c8 < 16) {
#pragma unroll
                for (int j = 0; j < 8; ++j) v[j] = fast_tanh(v[j]); }
            else if (c8 >= 32) {
#pragma unroll
                for (int j = 0; j < 8; ++j) v[j] = fast_sigmoid(v[j]); }
            *(LAS u32x4*)(lin + (tid / 48) * LINP + c8 * 8) = (u32x4){pk2(v[0], v[1]), pk2(v[2], v[3]), pk2(v[4], v[5]), pk2(v[6], v[7])};
            if (tid < 256) { unpack8(pz[1], v); const int c9 = (tid + 512) % 48;
                if (c9 < 16) {
#pragma unroll
                    for (int j = 0; j < 8; ++j) v[j] = fast_tanh(v[j]); }
                else if (c9 >= 32) {
#pragma unroll
                    for (int j = 0; j < 8; ++j) v[j] = fast_sigmoid(v[j]); }
                *(LAS u32x4*)(lin + ((tid + 512) / 48) * LINP + c9 * 8) = (u32x4){pk2(v[0], v[1]), pk2(v[2], v[3]), pk2(v[4], v[5]), pk2(v[6], v[7])}; } }
        u32x2 zr2[2], zk2[2], zv2[2];
        {   const bf16* zr_ = Zs + (size_t)(tile * 16 + fr) * ZW + cb + 4 * fq;
#pragma unroll
            for (int nt = 0; nt < 2; ++nt) { zr2[nt] = *(const u32x2*)(zr_ + 16 * nt); zk2[nt] = *(const u32x2*)(zr_ + 512 + 16 * nt); zv2[nt] = *(const u32x2*)(zr_ + 1024 + 16 * nt); } }
        if (it + F.G < nitems) PREP_LOAD(it + F.G);
        __syncthreads();
        f32x4 kkw[2], kaw[2], d0w[2][2], i0w[2][2];
#pragma unroll
        for (int nt = 0; nt < 2; ++nt) { const int c0 = cb + 16 * nt + 4 * fq; kkw[nt] = *(const f32x4*)(kkp + c0); kaw[nt] = *(const f32x4*)(kap + c0);
#pragma unroll
            for (int dn = 0; dn < 2; ++dn) { d0w[dn][nt] = *(const f32x4*)(dw0 + dn * DR + c0); i0w[dn][nt] = *(const f32x4*)(ia0 + dn * DR + c0); } }
        f32x4 acc[5][2];
#pragma unroll
        for (int q = 0; q < 5; ++q) { acc[q][0] = (f32x4){0.f, 0.f, 0.f, 0.f}; acc[q][1] = (f32x4){0.f, 0.f, 0.f, 0.f}; }
#pragma unroll
        for (int ks = 0; ks < 12; ++ks) { const int q = ks < 8 ? (ks >> 1) : 4; const bf16x8 xf = *(const LAS bf16x8*)(lin + fr * LINP + ks * 32 + 8 * fq);
            acc[q][0] = MFMA16(wf[ks][0], xf, acc[q][0]); acc[q][1] = MFMA16(wf[ks][1], xf, acc[q][1]); }
        float zk[2][4], kv[2][4]; float ss = 0.f;
#pragma unroll
        for (int nt = 0; nt < 2; ++nt) { unpack4(zk2[nt], zk[nt]);
#pragma unroll
            for (int i = 0; i < 4; ++i) { kv[nt][i] = zk[nt][i] * kkw[nt][i]; ss += kv[nt][i] * kv[nt][i]; } }
        ss += __shfl_xor(ss, 16); ss += __shfl_xor(ss, 32);
        if (fq == 0) ssum[w * 16 + fr] = ss;
        __syncthreads();
        const float inv = __builtin_amdgcn_rcpf(fmaxf(sqrtf(ssum[w * 16 + fr] + ssum[(w ^ 1) * 16 + fr]), 1e-12f));
        LAS bf16* th = tiles + (w >> 1) * 10 * 1024 + fr * 64 + 32 * (w & 1) + 4 * fq;
#pragma unroll
        for (int nt = 0; nt < 2; ++nt) { LAS bf16* t0 = th + 16 * nt;
            *(LAS u32x2*)(t0) = zr2[nt]; *(LAS u32x2*)(t0 + 1024) = zv2[nt];
            float kk[4];
#pragma unroll
            for (int i = 0; i < 4; ++i) kk[i] = kv[nt][i] * inv;
            *(LAS u32x2*)(t0 + 2 * 1024) = (u32x2){pk2(kk[0], kk[1]), pk2(kk[2], kk[3])};
            *(LAS u32x2*)(t0 + 3 * 1024) = (u32x2){pk2(acc[4][nt][0], acc[4][nt][1]), pk2(acc[4][nt][2], acc[4][nt][3])};
#pragma unroll
            for (int dn = 0; dn < 2; ++dn) { float ep[4], kd[4], bb[4];
#pragma unroll
                for (int i = 0; i < 4; ++i) { const float ew = fast_sigmoid(d0w[dn][nt][i] + acc[dn][nt][i]) * 0.6065306597126334f;
                    ep[i] = ew * (1.f + ew * (-0.5f + ew * (0.16666667f + ew * (-0.041666668f + ew * 0.0083333338f))));
                    const float a = fast_sigmoid(i0w[dn][nt][i] + acc[2 + dn][nt][i]); kd[i] = zk[nt][i] * (1.f + (a - 1.f) * kaw[nt][i]); bb[i] = kk[i] * a; }
                *(LAS u32x2*)(t0 + (4 + 3 * dn) * 1024) = (u32x2){pk2(ep[0], ep[1]), pk2(ep[2], ep[3])};
                *(LAS u32x2*)(t0 + (5 + 3 * dn) * 1024) = (u32x2){pk2(kd[0], kd[1]), pk2(kd[2], kd[3])};
                *(LAS u32x2*)(t0 + (6 + 3 * dn) * 1024) = (u32x2){pk2(bb[0], bb[1]), pk2(bb[2], bb[3])}; } }
        __syncthreads();
        {   const LAS bf16* src = tiles + (w >> 1) * 10 * 1024 + 8 * (w & 1) * 64 + lane * 8; bf16* dst = STR + ((size_t)tile * 8 + head) * 10240 + 8 * (w & 1) * 64 + lane * 8;
#pragma unroll
            for (int s = 0; s < 10; ++s) *(u32x4*)(dst + s * 1024) = *(const LAS u32x4*)(src + s * 1024); }
    }
#undef PREP_LOAD
}

__device__ __forceinline__ int scan_rowof(int s, int dir, int b) { if (s < CTXL) { const int tc = dir ? (CTXL - 1 - s) : s; return NLAT + b * CTXL + tc; } const int tt = s - CTXL; const int t = dir ? (SEQ - 1 - tt) : tt; return b * SEQ + t; }
__device__ __forceinline__ void scan_item(const Frame& F0, int item, bool need_ctx) {
    const Frame F = phase_frame(F0); unsigned char* const ws = F.ws;
    const int dir = item & 1, h = (item >> 1) & 7, b = item >> 4;
    const bf16* STR = (const bf16*)(ws + WS_STR); bf16* Y = (bf16*)(ws + WS_Y) + (size_t)dir * NROW * DR;
    const int lane = F.lane, kq = lane & 7, vrow = 8 * F.wave + (lane >> 3);
    float S[8];
#pragma unroll
    for (int j = 0; j < 8; ++j) S[j] = 0.f;
    const int co = h * 64 + kq * 8;
    constexpr int NSTEP = CTXL + SEQ;
#define rowof(s) scan_rowof((s), dir, b)
    for (int s0 = 0; s0 < NSTEP; s0 += 4) {
        u32x4 qkk[4], qe[4], qkd[4], qb[4], qr[4]; unsigned qv[4];
#pragma unroll
        for (int u = 0; u < 4; ++u) { const bf16* base = STR + (size_t)rowof(s0 + u) * STRW;
            qr[u] = *(const u32x4*)(base + co); qkk[u] = *(const u32x4*)(base + 1024 + co);
            qe[u] = *(const u32x4*)(base + 2048 + dir * 1536 + co); qkd[u] = *(const u32x4*)(base + 2048 + dir * 1536 + 512 + co); qb[u] = *(const u32x4*)(base + 2048 + dir * 1536 + 1024 + co);
            qv[u] = base[512 + h * 64 + vrow]; }
#pragma unroll
        for (int u = 0; u < 4; ++u) { float kk[8], e[8], kd[8], bb[8], r[8];
            unpack8(qkk[u], kk); unpack8(qe[u], e); unpack8(qkd[u], kd); unpack8(qb[u], bb); unpack8(qr[u], r);
            const float vv = bf2f(qv[u]);
            float sk = 0.f;
#pragma unroll
            for (int j = 0; j < 8; ++j) sk += S[j] * kk[j];
            sk += __shfl_xor(sk, 1); sk += __shfl_xor(sk, 2); sk += __shfl_xor(sk, 4);
            float y = 0.f;
#pragma unroll
            for (int j = 0; j < 8; ++j) { S[j] = S[j] * (1.f - e[j]) - sk * bb[j] + vv * kd[j]; y += S[j] * r[j]; }
            y += __shfl_xor(y, 1); y += __shfl_xor(y, 2); y += __shfl_xor(y, 4);
            const int s = s0 + u;
            if (kq == 0 && (s >= CTXL || need_ctx)) Y[(size_t)rowof(s) * DR + h * 64 + vrow] = (bf16)f2bf(y); }
    }
#undef rowof
}

__device__ __forceinline__ void readout_pass(const Frame& F0, int l, int nrows) {
    const Frame F = phase_frame(F0); unsigned char* const ws = F.ws;
    const bf16* STR = (const bf16*)(ws + WS_STR); const bf16* Y0 = (const bf16*)(ws + WS_Y); const bf16* Y1 = Y0 + (size_t)NROW * DR; bf16* MA = (bf16*)(ws + WS_H);
    const int lane = F.lane, c = 8 * lane;
    float gw[8], gb[8], rk[8];
    {   const float* gnw = inptr(I_GNW) + l * DR + c; const float* gnb = inptr(I_GNB) + l * DR + c; const float* rkp = inptr(I_RK) + l * DR + c;
        const f32x4 a0 = *(const f32x4*)gnw, a1 = *(const f32x4*)(gnw + 4), b0 = *(const f32x4*)gnb, b1 = *(const f32x4*)(gnb + 4), r0 = *(const f32x4*)rkp, r1 = *(const f32x4*)(rkp + 4);
#pragma unroll
        for (int i = 0; i < 4; ++i) { gw[i] = a0[i]; gw[4 + i] = a1[i]; gb[i] = b0[i]; gb[4 + i] = b1[i]; rk[i] = r0[i]; rk[4 + i] = r1[i]; } }
    for (int row0 = F.gw; row0 < nrows; row0 += 2 * F.NGW) {
        u32x4 q[2][7]; bool ok[2];
#pragma unroll
        for (int u = 0; u < 2; ++u) { const int row = row0 + u * F.NGW; ok[u] = row < nrows; if (ok[u]) {
            const bf16* sr = STR + ((size_t)(row >> 4) * 8 + (lane >> 3)) * 10240 + (row & 15) * 64 + (lane & 7) * 8;
            q[u][0] = *(const u32x4*)(Y0 + (size_t)row * DR + c); q[u][1] = *(const u32x4*)(Y1 + (size_t)row * DR + c);
            q[u][2] = *(const u32x4*)sr; q[u][3] = *(const u32x4*)(sr + 1024); q[u][4] = *(const u32x4*)(sr + 3072); q[u][5] = *(const u32x4*)(sr + 5 * 1024); q[u][6] = *(const u32x4*)(sr + 8 * 1024); } }
#pragma unroll
        for (int u = 0; u < 2; ++u) if (ok[u]) { const int row = row0 + u * F.NGW;
            float ya[8], yb[8], r[8], v[8], g[8], k0[8], k1[8];
            unpack8(q[u][0], ya); unpack8(q[u][1], yb); unpack8(q[u][2], r); unpack8(q[u][3], v); unpack8(q[u][4], g); unpack8(q[u][5], k0); unpack8(q[u][6], k1);
            float s1 = 0.f, s2 = 0.f, sb = 0.f;
#pragma unroll
            for (int i = 0; i < 8; ++i) { ya[i] += yb[i]; s1 += ya[i]; s2 += ya[i] * ya[i]; sb += r[i] * (k0[i] + k1[i]) * rk[i]; }
#pragma unroll
            for (int o = 1; o < 8; o <<= 1) { s1 += __shfl_xor(s1, o); s2 += __shfl_xor(s2, o); sb += __shfl_xor(sb, o); }
            const float mu = s1 * (1.f / 64.f); const float var = fmaxf(s2 * (1.f / 64.f) - mu * mu, 0.f); const float rs = rsqrtf(var + GN_EPS);
            float o8[8];
#pragma unroll
            for (int i = 0; i < 8; ++i) o8[i] = ((ya[i] - mu) * rs * gw[i] + gb[i] + sb * v[i]) * g[i];
            *(u32x4*)(MA + (size_t)row * D + c) = (u32x4){pk2(o8[0], o8[1]), pk2(o8[2], o8[3]), pk2(o8[4], o8[5]), pk2(o8[6], o8[7])}; }
    }
}
constexpr int BLOB = 16384, SEGCH = 264, NSEG = 2, BLOB_R1_SCANS = 23;
constexpr size_t WS_BLOB1 = 20 * MiB, WS_BLOB2 = 492 * MiB, WS_SCANST = 2 * MiB + 512 * 1024;
__device__ __forceinline__ unsigned char* blob_ptr(unsigned char* ws, int scan, int ci) {
    return scan < BLOB_R1_SCANS ? ws + WS_BLOB1 + ((size_t)scan * SEGCH + ci) * BLOB : ws + WS_BLOB2 + ((size_t)(scan - BLOB_R1_SCANS) * SEGCH + ci) * BLOB;
}
typedef short s16x4 __attribute__((ext_vector_type(4)));
__device__ __forceinline__ bf16x8 frag_lo(u32x2 x) { u32x4 t = {x.x, x.y, 0u, 0u}; return __builtin_bit_cast(bf16x8, t); }
__device__ __forceinline__ bf16x8 frag_c(const f32x4& a) { u32x4 t = {pk2(a[0], a[1]), pk2(a[2], a[3]), 0u, 0u}; return __builtin_bit_cast(bf16x8, t); }

struct PreRegs { u32x4 q[12]; };
__device__ __forceinline__ void pre_load(PreRegs& R, unsigned char* ws, int scan, int cs, int lane) {
    const int dir = scan & 1, h = (scan >> 1) & 7, b = scan >> 4; const int rfirst = scan_rowof(16 * cs, dir, b);
    const bf16* blk = (const bf16*)(ws + WS_STR) + ((size_t)(rfirst >> 4) * 8 + h) * 10240 + lane * 8;
    const int so[6] = {0, 1, 2, 4 + 3 * dir, 5 + 3 * dir, 6 + 3 * dir};
#pragma unroll
    for (int i = 0; i < 6; ++i) { R.q[2 * i] = *(const u32x4*)(blk + so[i] * 1024); R.q[2 * i + 1] = *(const u32x4*)(blk + so[i] * 1024 + 512); }
}
template <int PM>
__device__ __forceinline__ void pre_item(const Frame& F, unsigned char* ws, int scan, int cs, unsigned char* blob, PreRegs& PR, int nscan, int ncs) {
    const int dir = scan & 1, h = (scan >> 1) & 7, b = scan >> 4; const int lane = F.lane, fr = lane & 15, fq = lane >> 4;
    LAS unsigned char* L = F.lds + F.wave * 17408;
    LAS bf16* TK = (LAS bf16*)L; LAS bf16* TR = TK + 1024; LAS bf16* TKt = TR + 1024; LAS bf16* TB = TKt + 1024;
    LAS bf16* KTt = TB + 1024; LAS bf16* RTt = KTt + 1024; LAS bf16* Vt = RTt + 1024;
    LAS float* AKB = (LAS float*)(Vt + 1024);
    LAS bf16* AKK = (LAS bf16*)(AKB + 256); LAS bf16* ARK = AKK + 256; LAS bf16* ARB = ARK + 256; LAS bf16* TT = ARB + 256;
    float kh[16], bh[16];
    float pc;
    {   float r_[16], v_[16], kk_[16], lp_[16], kd_[16], bb_[16];
        LAS bf16* stg = TK;
#pragma unroll
        for (int i = 0; i < 6; ++i) { *(LAS u32x4*)(stg + i * 1024 + lane * 8) = PR.q[2 * i]; *(LAS u32x4*)(stg + i * 1024 + 512 + lane * 8) = PR.q[2 * i + 1]; }
        LDS_WAIT(); asm volatile("" ::: "memory");
        if (nscan >= 0) pre_load(PR, ws, nscan, ncs, lane);
#pragma unroll
        for (int t = 0; t < 16; ++t) { const int tm = (dir ? 15 - t : t) * 64 + lane;
            r_[t] = bf2f(stg[tm]); v_[t] = bf2f(stg[1024 + tm]); kk_[t] = bf2f(stg[2048 + tm]); lp_[t] = bf2f(stg[3072 + tm]); kd_[t] = bf2f(stg[4096 + tm]); bb_[t] = bf2f(stg[5120 + tm]); }
        LDS_WAIT(); asm volatile("" ::: "memory");
        float lp = 0.f; u32x4 kt4[2], rt4[2], v4[2];
        unsigned ktp[8], rtp[8], vp[8];
#pragma unroll
        for (int t = 0; t < 16; ++t) { const float pm1 = __expf(lp); lp += __logf(1.f - lp_[t]); lp_[t] = lp; const float p = __expf(lp), ip = __expf(-lp);
            const float kt = kk_[t] * pm1, ktl = kd_[t] * ip, btl = bb_[t] * ip, rt = r_[t] * p;
            TK[t * 64 + lane] = (bf16)f2bf(kt); TR[t * 64 + lane] = (bf16)f2bf(rt); TKt[t * 64 + lane] = (bf16)f2bf(ktl); TB[t * 64 + lane] = (bf16)f2bf(btl);
            if (t & 1) { ktp[t >> 1] |= f2bf(kt) << 16; rtp[t >> 1] |= f2bf(rt) << 16; vp[t >> 1] |= f2bf(v_[t]) << 16; }
            else { ktp[t >> 1] = f2bf(kt); rtp[t >> 1] = f2bf(rt); vp[t >> 1] = f2bf(v_[t]); } }
        kt4[0] = (u32x4){ktp[0], ktp[1], ktp[2], ktp[3]}; kt4[1] = (u32x4){ktp[4], ktp[5], ktp[6], ktp[7]};
        rt4[0] = (u32x4){rtp[0], rtp[1], rtp[2], rtp[3]}; rt4[1] = (u32x4){rtp[4], rtp[5], rtp[6], rtp[7]};
        v4[0] = (u32x4){vp[0], vp[1], vp[2], vp[3]}; v4[1] = (u32x4){vp[4], vp[5], vp[6], vp[7]};
        *(LAS u32x4*)(KTt + lane * 16) = kt4[0]; *(LAS u32x4*)(KTt + lane * 16 + 8) = kt4[1];
        *(LAS u32x4*)(RTt + lane * 16) = rt4[0]; *(LAS u32x4*)(RTt + lane * 16 + 8) = rt4[1];
        *(LAS u32x4*)(Vt + lane * 16) = v4[0]; *(LAS u32x4*)(Vt + lane * 16 + 8) = v4[1];
        pc = __expf(lp);
#pragma unroll
        for (int t = 0; t < 16; ++t) { const float e = __expf(lp - lp_[t]); kh[t] = kd_[t] * e; bh[t] = bb_[t] * e; }
    }
    LDS_WAIT(); asm volatile("" ::: "memory");
    {   f32x4 akb = {0.f, 0.f, 0.f, 0.f}, akk = akb, ark = akb, arb = akb;
#pragma unroll
        for (int s = 0; s < 2; ++s) { const int o = fr * 64 + 32 * s + 8 * fq;
            const bf16x8 fk = *(const LAS bf16x8*)(TK + o), frr = *(const LAS bf16x8*)(TR + o), fkt = *(const LAS bf16x8*)(TKt + o), fb = *(const LAS bf16x8*)(TB + o);
            akb = MFMA16(fk, fb, akb); akk = MFMA16(fk, fkt, akk); ark = MFMA16(frr, fkt, ark); arb = MFMA16(frr, fb, arb); }
#pragma unroll
        for (int reg = 0; reg < 4; ++reg) { const int t = 4 * fq + reg; const bool lo = fr < t, le = fr <= t;
            AKB[t * 16 + fr] = lo ? akb[reg] : 0.f; AKK[t * 16 + fr] = (bf16)f2bf(lo ? akk[reg] : 0.f);
            ARK[t * 16 + fr] = (bf16)f2bf(le ? ark[reg] : 0.f); ARB[t * 16 + fr] = (bf16)f2bf(le ? arb[reg] : 0.f); }
    }
    LDS_WAIT(); asm volatile("" ::: "memory");
    {   float col[16];
#pragma unroll
        for (int t = 0; t < 16; ++t) { float s_ = (t == fr) ? 1.f : 0.f;
            if (t > 0) { const f32x4 n0 = *(const LAS f32x4*)(AKB + t * 16), n1 = *(const LAS f32x4*)(AKB + t * 16 + 4), n2 = *(const LAS f32x4*)(AKB + t * 16 + 8), n3 = *(const LAS f32x4*)(AKB + t * 16 + 12);
                const float nn[16] = {n0[0], n0[1], n0[2], n0[3], n1[0], n1[1], n1[2], n1[3], n2[0], n2[1], n2[2], n2[3], n3[0], n3[1], n3[2], n3[3]};
#pragma unroll
                for (int i = 0; i < 16; ++i) if (i < t) s_ -= nn[i] * col[i]; }
            col[t] = s_; TT[t * 16 + fr] = (bf16)f2bf(s_); }
    }
    LDS_WAIT(); asm volatile("" ::: "memory");
    f32x4 Wc[4], Rqc[4], U0c[4], Y0c[4];
    {   const bf16x8 aT = frag_lo(*(const LAS u32x2*)(TT + fr * 16 + 4 * fq)), aKK = frag_lo(*(const LAS u32x2*)(AKK + fr * 16 + 4 * fq)), aRK = frag_lo(*(const LAS u32x2*)(ARK + fr * 16 + 4 * fq));
        u32x2 nb = *(const LAS u32x2*)(ARB + fr * 16 + 4 * fq); nb.x ^= 0x80008000u; nb.y ^= 0x80008000u; const bf16x8 aRBn = frag_lo(nb);
        const f32x4 z4 = {0.f, 0.f, 0.f, 0.f};
#pragma unroll
        for (int nt = 0; nt < 4; ++nt) { const int o = (16 * nt + fr) * 16 + 4 * fq;
            const bf16x8 bK = frag_lo(*(const LAS u32x2*)(KTt + o)), bV = frag_lo(*(const LAS u32x2*)(Vt + o));
            float ri[4]; unpack4(*(const LAS u32x2*)(RTt + o), ri);
            Wc[nt] = MFMA16(aT, bK, z4); const f32x4 Zn = MFMA16(aKK, bV, z4);
            U0c[nt] = MFMA16(aT, frag_c(Zn), z4);
            Rqc[nt] = MFMA16(aRBn, frag_c(Wc[nt]), ((f32x4){ri[0], ri[1], ri[2], ri[3]}));
            Y0c[nt] = MFMA16(aRK, bV, z4); Y0c[nt] = MFMA16(aRBn, frag_c(U0c[nt]), Y0c[nt]); }
    }
    LDS_WAIT(); asm volatile("" ::: "memory");

#pragma unroll
    for (int nt = 0; nt < 4; ++nt) { const u32x2 vv = *(const LAS u32x2*)(Vt + (16 * nt + fr) * 16 + 4 * fq);
        *(u32x2*)(blob + 8192 + nt * 2048 + 1024 + lane * 8) = vv;
        u32x2 u0 = {pk2(U0c[nt][0], U0c[nt][1]), pk2(U0c[nt][2], U0c[nt][3])}, y0 = {pk2(Y0c[nt][0], Y0c[nt][1]), pk2(Y0c[nt][2], Y0c[nt][3])};
        *(u32x2*)(blob + 8192 + nt * 2048 + lane * 8) = u0; *(u32x2*)(blob + 8192 + nt * 2048 + 512 + lane * 8) = y0;
        *(float*)(blob + 8192 + nt * 2048 + 1536 + lane * 4) = pc; }
    LAS bf16* WT = TK; LAS bf16* RQT = TR; LAS bf16* BHt = TKt; LAS bf16* KHt = TB;
#pragma unroll
    for (int nt = 0; nt < 4; ++nt)
#pragma unroll
        for (int reg = 0; reg < 4; ++reg) { WT[(4 * fq + reg) * 64 + 16 * nt + fr] = (bf16)f2bf(Wc[nt][reg]); RQT[(4 * fq + reg) * 64 + 16 * nt + fr] = (bf16)f2bf(Rqc[nt][reg]); }
    {   u32x4 a, c, d, e;
        a = (u32x4){pk2(bh[0], bh[1]), pk2(bh[2], bh[3]), pk2(bh[4], bh[5]), pk2(bh[6], bh[7])}; c = (u32x4){pk2(bh[8], bh[9]), pk2(bh[10], bh[11]), pk2(bh[12], bh[13]), pk2(bh[14], bh[15])};
        d = (u32x4){pk2(kh[0], kh[1]), pk2(kh[2], kh[3]), pk2(kh[4], kh[5]), pk2(kh[6], kh[7])}; e = (u32x4){pk2(kh[8], kh[9]), pk2(kh[10], kh[11]), pk2(kh[12], kh[13]), pk2(kh[14], kh[15])};
        *(LAS u32x4*)(BHt + lane * 16) = a; *(LAS u32x4*)(BHt + lane * 16 + 8) = c; *(LAS u32x4*)(KHt + lane * 16) = d; *(LAS u32x4*)(KHt + lane * 16 + 8) = e; }
    LDS_WAIT(); asm volatile("" ::: "memory");
#pragma unroll
    for (int s = 0; s < 2; ++s) { const int o = fr * 64 + 32 * s + 4 * fq;
        const u32x2 w0 = *(const LAS u32x2*)(WT + o), w1 = *(const LAS u32x2*)(WT + o + 16), q0 = *(const LAS u32x2*)(RQT + o), q1 = *(const LAS u32x2*)(RQT + o + 16);
        *(u32x4*)(blob + (0 * 2 + s) * 1024 + lane * 16) = (u32x4){w0.x, w0.y, w1.x, w1.y};
        *(u32x4*)(blob + (1 * 2 + s) * 1024 + lane * 16) = (u32x4){q0.x, q0.y, q1.x, q1.y}; }
#pragma unroll
    for (int mt = 0; mt < 4; ++mt) { const int o = (16 * mt + fr) * 16 + 4 * fq; const u32x2 bb = *(const LAS u32x2*)(BHt + o), kk = *(const LAS u32x2*)(KHt + o);
        *(u32x4*)(blob + 4096 + mt * 1024 + lane * 16) = (u32x4){bb.x ^ 0x80008000u, bb.y ^ 0x80008000u, kk.x, kk.y}; }
    LDS_WAIT(); asm volatile("" ::: "memory");
}

__device__ __forceinline__ void pre_phase(const Frame& F0, int seg) {
    const Frame F = phase_frame(F0); unsigned char* const ws = F.ws;
    PreRegs R;
    int it = F.gw; if (it >= 32 * SEGCH) return;
    pre_load(R, ws, it & 31, seg * SEGCH + (it >> 5), F.lane);
    for (; it < 32 * SEGCH; it += F.NGW) { const int nx = it + F.NGW; const bool hn = nx < 32 * SEGCH;
        pre_item<0>(F, ws, it & 31, seg * SEGCH + (it >> 5), blob_ptr(ws, it & 31, it >> 5), R, hn ? (nx & 31) : -1, seg * SEGCH + (nx >> 5)); }
}

constexpr int SQ_SLOT = 10240, SQ_R = 12, SQ_D = 8;
template <int MODE>
__device__ __forceinline__ void seq_item(const Frame& F0, int item, int seg, bool need_ctx) {
    const Frame F = phase_frame(F0); unsigned char* const ws = F.ws;
    const int scan = item >> 2, vb = item & 3, dir = scan & 1, h = (scan >> 1) & 7, b = scan >> 4; const int lane = F.lane, fr = lane & 15, fq = lane >> 4, w = F.wave;
    const unsigned char* blob = blob_ptr(ws, scan, 0);
    LAS unsigned char* ring = F.lds;
    __syncthreads();
    const int p0 = 2 * (w - 1);
    const unsigned goff0 = (p0 < 8 ? p0 * 1024 : 8192 + vb * 2048 + (p0 - 8) * 1024) + lane * 16, goff1 = (p0 + 1 < 8 ? (p0 + 1) * 1024 : 8192 + vb * 2048 + (p0 + 1 - 8) * 1024) + lane * 16;
#define SQ_ISSUE(c) do { const unsigned char* g_ = blob + (size_t)(c) * BLOB; LAS unsigned char* s_ = ring + ((c) % SQ_R) * SQ_SLOT + p0 * 1024; \
        __builtin_amdgcn_global_load_lds((const unsigned*)(g_ + goff0), (LAS unsigned*)(s_), 16, 0, 0); \
        __builtin_amdgcn_global_load_lds((const unsigned*)(g_ + goff1), (LAS unsigned*)(s_ + 1024), 16, 0, 0); } while (0)
    const bool loader = (w >= 1 && w <= 5) && MODE != 2;
    if (loader) { for (int c = 0; c < SQ_D; ++c) SQ_ISSUE(c); }
    bf16* Y = (bf16*)(ws + WS_Y) + (size_t)dir * NROW * DR + h * 64 + 16 * vb + fr;
    float* st = (float*)(ws + WS_SCANST) + (size_t)item * 1024 + lane * 4;
    f32x4 M[4];
#pragma unroll
    for (int mt = 0; mt < 4; ++mt) M[mt] = (seg == 0 || w != 0) ? (f32x4){0.f, 0.f, 0.f, 0.f} : *(const f32x4*)(st + mt * 256);
    const f32x4 z4 = {0.f, 0.f, 0.f, 0.f};
    LAS unsigned char* mb = ring + SQ_R * SQ_SLOT;
    struct SQ { bf16x8 a1[2], a2[4]; f32x4 pc[4]; u32x2 u0, vv; };
#define SQ_READ(R, c) do { const LAS unsigned char* sl_ = ring + ((c) % SQ_R) * SQ_SLOT; _Pragma("unroll") for (int i = 0; i < 4; ++i) { \
        R.a2[i] = *(const LAS bf16x8*)(sl_ + 4096 + i * 1024 + lane * 16); R.pc[i] = *(const LAS f32x4*)(sl_ + 8192 + 1536 + (16 * i + 4 * fq) * 4); } \
        R.a1[0] = *(const LAS bf16x8*)(sl_ + lane * 16); R.a1[1] = *(const LAS bf16x8*)(sl_ + 1024 + lane * 16); \
        R.u0 = *(const LAS u32x2*)(sl_ + 8192 + lane * 8); R.vv = *(const LAS u32x2*)(sl_ + 8192 + 1024 + lane * 8); } while (0)
#define SQ_STEP(R, c, RN, cn) do { \
        if ((cn) < SEGCH) SQ_READ(RN, cn); \
        const u32x4 t0 = {pk2(M[0][0], M[0][1]), pk2(M[0][2], M[0][3]), pk2(M[1][0], M[1][1]), pk2(M[1][2], M[1][3])}; \
        const u32x4 t1 = {pk2(M[2][0], M[2][1]), pk2(M[2][2], M[2][3]), pk2(M[3][0], M[3][1]), pk2(M[3][2], M[3][3])}; \
        *(LAS u32x4*)(mb + ((c) & 1) * 2048 + lane * 16) = t0; *(LAS u32x4*)(mb + ((c) & 1) * 2048 + 1024 + lane * 16) = t1; \
        const bf16x8 b0 = __builtin_bit_cast(bf16x8, t0), b1 = __builtin_bit_cast(bf16x8, t1); \
        f32x4 X0 = MFMA16(R.a1[0], b0, z4); X0 = MFMA16(R.a1[1], b1, X0); \
        float u0[4]; unpack4(R.u0, u0); \
        const u32x4 tb = {pk2(X0[0] + u0[0], X0[1] + u0[1]), pk2(X0[2] + u0[2], X0[3] + u0[3]), R.vv.x, R.vv.y}; const bf16x8 bB = __builtin_bit_cast(bf16x8, tb); \
        _Pragma("unroll") for (int mt = 0; mt < 4; ++mt) M[mt] = MFMA16(R.a2[mt], bB, R.pc[mt] * M[mt]); \
        asm volatile("s_waitcnt lgkmcnt(0)" ::: "memory"); } while (0)
    const long ystep = dir ? -(long)DR : (long)DR;
#define SQ_YSTEP(c) do { const int cs_ = seg * SEGCH + (c); if (MODE == 0 && (need_ctx || cs_ >= 16)) { const LAS unsigned char* sl_ = ring + ((c) % SQ_R) * SQ_SLOT; \
        const bf16x8 q0 = *(const LAS bf16x8*)(sl_ + 2048 + lane * 16), q1 = *(const LAS bf16x8*)(sl_ + 3072 + lane * 16); \
        const bf16x8 b0 = *(const LAS bf16x8*)(mb + ((c) & 1) * 2048 + lane * 16), b1 = *(const LAS bf16x8*)(mb + ((c) & 1) * 2048 + 1024 + lane * 16); \
        float y0[4]; unpack4(*(const LAS u32x2*)(sl_ + 8192 + 512 + lane * 8), y0); \
        f32x4 X1 = MFMA16(q0, b0, z4); X1 = MFMA16(q1, b1, X1); \
        bf16* yp = Y + (size_t)scan_rowof(16 * cs_ + 4 * fq, dir, b) * DR; \
        yp[0] = (bf16)f2bf(X1[0] + y0[0]); yp[ystep] = (bf16)f2bf(X1[1] + y0[1]); yp[2 * ystep] = (bf16)f2bf(X1[2] + y0[2]); yp[3 * ystep] = (bf16)f2bf(X1[3] + y0[3]); \
        asm volatile("s_waitcnt lgkmcnt(0)" ::: "memory"); } } while (0)
#define SQ_LOADER(c) do { if (loader) { __builtin_amdgcn_s_sleep(3); if ((c) + SQ_D < SEGCH) { SQ_ISSUE((c) + SQ_D); asm volatile("s_waitcnt vmcnt(12)" ::: "memory"); } else asm volatile("s_waitcnt vmcnt(0)" ::: "memory"); } \
        __builtin_amdgcn_s_barrier(); asm volatile("" ::: "memory"); } while (0)
    const bool stw = (w == 0 && MODE != 1), yw = (w == 6 && MODE != 1);
    SQ Ra, Rb, Rc;
    SQ_LOADER(0);
    if (stw) { SQ_READ(Ra, 0); SQ_READ(Rb, 1); }
    for (int c = 0; c < SEGCH; c += 3) {
        SQ_LOADER(c + 1);
        if (stw) SQ_STEP(Ra, c, Rc, c + 2);
        if (yw && c > 0) SQ_YSTEP(c - 1);
        SQ_LOADER(c + 2);
        if (stw) SQ_STEP(Rb, c + 1, Ra, c + 3);
        if (yw) SQ_YSTEP(c);
        SQ_LOADER(c + 3);
        if (stw) SQ_STEP(Rc, c + 2, Rb, c + 4);
        if (yw) SQ_YSTEP(c + 1);
    }
    __builtin_amdgcn_s_barrier(); asm volatile("" ::: "memory");
    if (yw) SQ_YSTEP(SEGCH - 1);
#undef SQ_READ
#undef SQ_STEP
#undef SQ_YSTEP
#undef SQ_LOADER
#undef SQ_ISSUE
    if (MODE >= 2 && w == 0 && M[0][0] + M[1][1] + M[2][2] + M[3][3] == 12345.678f) st[0] = M[0][0];
    if (MODE == 0 && w == 0 && seg + 1 < NSEG) {
#pragma unroll
        for (int mt = 0; mt < 4; ++mt) *(f32x4*)(st + mt * 256) = M[mt]; }
    __syncthreads();
}

__device__ __forceinline__ void warm_pass(const Frame& F0, int seg) {
    const Frame F = phase_frame(F0); unsigned char* const ws = F.ws;
    const int hb = blockIdx.x - 128;
    if (hb < 0) return;
    const int x = hb & 7, j = hb >> 3;
    const int nw = 16 * NWAVES, me = j * NWAVES + F.wave; unsigned acc = 0u;
    for (int it = me; it < SEGCH * 64; it += 4 * nw) {
        u32x4 v[4];
#pragma unroll
        for (int u = 0; u < 4; ++u) { const int i2 = it + u * nw; const int ci = i2 >> 6, q = (i2 >> 4) & 3, p = i2 & 15;
            v[u] = (i2 < SEGCH * 64) ? *(const u32x4*)(blob_ptr(ws, x + 8 * q, ci) + p * 1024 + F.lane * 16) : (u32x4){0u, 0u, 0u, 0u}; }
#pragma unroll
        for (int u = 0; u < 4; ++u) acc ^= v[u].x ^ v[u].y ^ v[u].z ^ v[u].w;
    }
    asm volatile("" :: "v"(acc));
}
namespace pg8 {
struct EpiStoreBf16 {
    static constexpr bool PERM = true, AFTER_DRAIN = false;
    bf16_t* O; int ldc; int pn_mask;
    __device__ __forceinline__ void operator()(const f32x4 (&acc)[2][2][4][2], const Unit& u, int wr, int wc, int fr, int fq) const {
        const int row0 = u.pm * BM + wr * 64 + fr; const int col0 = (u.pn & pn_mask) * BM + wc * 32 + 8 * fq;
#pragma unroll
        for (int ai = 0; ai < 2; ++ai)
#pragma unroll
            for (int m = 0; m < 4; ++m) { bf16_t* rowp = O + (size_t)(row0 + ai * HALF + m * 16) * ldc + col0;
#pragma unroll
                for (int bj = 0; bj < 2; ++bj) { const f32x4 v0 = acc[ai][bj][m][0], v1 = acc[ai][bj][m][1];
                    u32x4 w; w.x = cvt_pk_bf16(v0[0], v0[1]); w.y = cvt_pk_bf16(v0[2], v0[3]); w.z = cvt_pk_bf16(v1[0], v1[1]); w.w = cvt_pk_bf16(v1[2], v1[3]);
                    *(u32x4*)(rowp + bj * HALF) = w; } }
    }
};
struct EpiSwiGLU {
    static constexpr bool PERM = true, AFTER_DRAIN = false;
    bf16_t* O;
    __device__ __forceinline__ void operator()(const f32x4 (&acc)[2][2][4][2], const Unit& u, int wr, int wc, int fr, int fq) const {
        const int row0 = u.pm * BM + wr * 64 + fr; const int col0 = ((u.pn & 3) * BM + wc * 32 + 8 * fq) >> 1;
#pragma unroll
        for (int ai = 0; ai < 2; ++ai)
#pragma unroll
            for (int m = 0; m < 4; ++m) { bf16_t* rowp = O + (size_t)(row0 + ai * HALF + m * 16) * 512 + col0;
#pragma unroll
                for (int bj = 0; bj < 2; ++bj) { const f32x4 g = acc[ai][bj][m][0], up = acc[ai][bj][m][1]; float a[4];
#pragma unroll
                    for (int i = 0; i < 4; ++i) a[i] = g[i] / (1.f + __expf(-g[i])) * up[i];
                    unsigned long long w = (unsigned long long)cvt_pk_bf16(a[0], a[1]) | ((unsigned long long)cvt_pk_bf16(a[2], a[3]) << 32);
                    *(unsigned long long*)(rowp + bj * (HALF / 2)) = w; } }
    }
};
struct EpiResidual {
    static constexpr bool PERM = false, AFTER_DRAIN = false;
    const float* xlat; const float* xctx;
    float* out; const float* g1;
    __device__ __forceinline__ void operator()(const f32x4 (&acc)[2][2][4][2], const Unit& u, int wr, int wc, int fr, int fq) const {
        const int rowt = u.pm * BM; const int mr = rowt < 16384 ? (rowt >> 13) : 2;
        const float* base = rowt < 16384 ? xlat + (size_t)rowt * 1024 : xctx + (size_t)(rowt - 16384) * 1024;
        const int col0 = u.pn * BM + wc * 32 + 4 * fq;
        f32x4 gv[2][2];
#pragma unroll
        for (int bj = 0; bj < 2; ++bj)
#pragma unroll
            for (int n = 0; n < 2; ++n) gv[bj][n] = *(const f32x4*)(g1 + (size_t)mr * 6144 + col0 + bj * HALF + n * 16);
#pragma unroll
        for (int ai = 0; ai < 2; ++ai)
#pragma unroll
            for (int m = 0; m < 4; ++m) { const int rl = ai * HALF + wr * 64 + m * 16 + fr;
#pragma unroll
                for (int bj = 0; bj < 2; ++bj)
#pragma unroll
                    for (int n = 0; n < 2; ++n) { const size_t off = (size_t)rl * 1024 + col0 + bj * HALF + n * 16;
                        const f32x4 xo = *(const f32x4*)(base + off);
                        *(f32x4*)(out + (size_t)rowt * 1024 + off) = xo + gv[bj][n] * acc[ai][bj][m][n]; } }
    }
};
struct MoeOrder {
    const int* tile_e; int ntiles, G, c;
    __device__ bool next(int i, Unit& u) const { const long L = (long)i * G + c; if (L >= 4L * ntiles) return false; const int pm = (int)(L >> 2); u.pm = pm; u.pn = tile_e[pm] * 4 + (int)(L & 3); return true; }
    __device__ __forceinline__ void a_ready(const Unit&) const {}
    __device__ __forceinline__ void done(const Unit&) const {}
};
}

__device__ __forceinline__ void expert_convert(const Frame& F0, int l, int b_lo) {
    const Frame F = phase_frame(F0); unsigned char* const ws = F.ws;
    if ((int)blockIdx.x < b_lo) return;
    const int nwv = (F.G - b_lo) * NWAVES, myw = ((int)blockIdx.x - b_lo) * NWAVES + F.wave;
    LAS float* scr = (LAS float*)(F.lds + F.wave * 16384);
    bf16* wgu = (bf16*)(ws + WS_WGU_T); bf16* wd = (bf16*)(ws + WS_WD_T);
    constexpr int I_G = 16 * 16, I_D = 8 * 32;
    constexpr int NIT = NEXP * (2 * I_G + I_D);
    const float* p_eg = inptr(I_EG); const float* p_eu = inptr(I_EU); const float* p_ed = inptr(I_ED);
    for (int it = myw; it < NIT; it += nwv) { const int e = it / (2 * I_G + I_D); int r = it % (2 * I_G + I_D);
        if (r < I_G) { transpose_item(p_eg + ((size_t)l * NEXP + e) * D * DEXP, DEXP, (r >> 4) * 64, (r & 15) * 32, wgu, D, RmGU{e * 1024}, scr, F.lane); continue; } r -= I_G;
        if (r < I_G) { transpose_item(p_eu + ((size_t)l * NEXP + e) * D * DEXP, DEXP, (r >> 4) * 64, (r & 15) * 32, wgu, D, RmGU{e * 1024 + 4}, scr, F.lane); continue; } r -= I_G;
        transpose_item(p_ed + ((size_t)l * NEXP + e) * DEXP * D, D, (r >> 5) * 64, (r & 31) * 32, wd, DEXP, RmId{e * 1024}, scr, F.lane);
    }
}

__device__ __forceinline__ void router_pass(const Frame& F0, int l, int nrows, int cnt_off = 0) {
    const Frame F = phase_frame(F0); unsigned char* const ws = F.ws;
    constexpr int HP = 1028;
    LAS float* msh = (LAS float*)F.lds; LAS float* msc = msh + 3072; LAS float* hrow = msc + 3072;
    LAS float* part = hrow + 16 * HP;
    LAS float* lgs = part + 8 * 16 * 48;
    LAS unsigned* lcnt = (LAS unsigned*)(lgs + 16 * 40);
    if (F0.tid < 64) lcnt[F0.tid] = 0u;
    __syncthreads();
    mod_to_lds(F, l, 3, msh, false); mod_to_lds(F, l, 4, msc, false); __syncthreads();
    const float* X = (const float*)(ws + WS_X); bf16* H = (bf16*)(ws + WS_H);
    const float* rgw = inptr(I_RGW) + (size_t)l * D * 4; const float* rew = inptr(I_REW) + (size_t)l * D * NEXP;
    const float* rgb = inptr(I_RGB) + l * 4; const float* reb = inptr(I_REB) + l * NEXP;
    int* rt_e = (int*)(ws + WS_ROUTE + RT_E); int* rt_pos = (int*)(ws + WS_ROUTE + RT_POS); float* rt_gate = (float*)(ws + WS_ROUTE + RT_GATE);
    unsigned* cnt = (unsigned*)(ws + WS_CTL) + CW_CNT + 64 * l + cnt_off;
    const int lane = F.lane, w = F.wave, fr = lane & 15, fq = lane >> 4; const float* n2g = inptr(I_N2G) + l * D;
    float bw[32][3];
#pragma unroll
    for (int ks = 0; ks < 32; ++ks) { const int k = 128 * w + 4 * ks + fq;
        bw[ks][0] = rew[(size_t)k * 32 + fr]; bw[ks][1] = rew[(size_t)k * 32 + 16 + fr]; bw[ks][2] = fr < 4 ? rgw[(size_t)k * 4 + fr] : 0.f; }
    const int ntiles = nrows >> 4;
    f32x4 pv[2][4];
    if (F.vcu < ntiles) {
#pragma unroll
        for (int rr = 0; rr < 2; ++rr)
#pragma unroll
            for (int j = 0; j < 4; ++j) pv[rr][j] = *(const f32x4*)(X + (size_t)(F.vcu * 16 + 2 * w + rr) * D + 4 * lane + 256 * j); }
    for (int gi = F.vcu; gi < ntiles; gi += F.G) {
#pragma unroll
        for (int rr = 0; rr < 2; ++rr) { const int r = 2 * w + rr, row = gi * 16 + r; f32x4 v[4];
#pragma unroll
            for (int j = 0; j < 4; ++j) v[j] = pv[rr][j];
            const int mr = modrow(row);
            norm_mod_row(v, n2g, msc + mr * 1024, msh + mr * 1024, H + (size_t)row * D, lane);
#pragma unroll
            for (int j = 0; j < 4; ++j) *(LAS f32x4*)(hrow + r * HP + 4 * lane + 256 * j) = v[j]; }
        if (gi + F.G < ntiles) {
#pragma unroll
            for (int rr = 0; rr < 2; ++rr)
#pragma unroll
                for (int j = 0; j < 4; ++j) pv[rr][j] = *(const f32x4*)(X + (size_t)((gi + F.G) * 16 + 2 * w + rr) * D + 4 * lane + 256 * j); }
        __syncthreads();
        {   f32x4 acc[3] = {{0.f, 0.f, 0.f, 0.f}, {0.f, 0.f, 0.f, 0.f}, {0.f, 0.f, 0.f, 0.f}};
#pragma unroll
            for (int ks = 0; ks < 32; ++ks) { const float a = hrow[fr * HP + 128 * w + 4 * ks + fq];
#pragma unroll
                for (int nt = 0; nt < 3; ++nt) acc[nt] = __builtin_amdgcn_mfma_f32_16x16x4f32(a, bw[ks][nt], acc[nt], 0, 0, 0); }
#pragma unroll
            for (int nt = 0; nt < 3; ++nt)
#pragma unroll
                for (int reg = 0; reg < 4; ++reg) part[(w * 16 + 4 * fq + reg) * 48 + 16 * nt + fr] = acc[nt][reg]; }
        __syncthreads();
        for (int idx = F.tid; idx < 16 * 36; idx += NTHR) { const int r = idx / 36, n = idx % 36; float s_ = 0.f;
#pragma unroll
            for (int ww = 0; ww < 8; ++ww) s_ += part[(ww * 16 + r) * 48 + n];
            if (n < 32) lgs[r * 40 + 4 + n] = s_ + reb[n]; else lgs[r * 40 + n - 32] = s_ + rgb[n - 32]; }
        __syncthreads();
        if (F.tid < 16) { const int rr = gi * 16 + F.tid; const LAS float* lp = lgs + F.tid * 40;
            int grp = 0; float mx = lp[0];
#pragma unroll
            for (int g = 1; g < 4; ++g) if (lp[g] > mx) { mx = lp[g]; grp = g; }
            float den = 0.f;
#pragma unroll
            for (int g = 0; g < 4; ++g) den += __expf(lp[g] - mx);
            const float pg_top = 1.f / den; const LAS float* sel = lp + 4 + grp * 8;
            int i0 = 0; float l0 = sel[0];
#pragma unroll
            for (int q = 1; q < 8; ++q) if (sel[q] > l0) { l0 = sel[q]; i0 = q; }
            int i1 = -1; float l1 = -3.0e38f;
#pragma unroll
            for (int q = 0; q < 8; ++q) if (q != i0 && sel[q] > l1) { l1 = sel[q]; i1 = q; }
            const float e1 = __expf(l1 - l0); const float w0 = pg_top / (1.f + e1), w1 = pg_top * e1 / (1.f + e1);
            const int ea = grp * 8 + i0, eb = grp * 8 + i1;
            const unsigned pa = atomicAdd((unsigned*)(lcnt + ea), 1u), pb = atomicAdd((unsigned*)(lcnt + eb), 1u);
            rt_e[2 * rr] = ea; rt_e[2 * rr + 1] = eb; rt_pos[2 * rr] = (int)pa; rt_pos[2 * rr + 1] = (int)pb; rt_gate[2 * rr] = w0; rt_gate[2 * rr + 1] = w1; }
    }
    __syncthreads();
    if (F.tid < 32) lcnt[32 + F.tid] = lcnt[F.tid] ? atomicAdd(cnt + F.tid, lcnt[F.tid]) : 0u;
    __syncthreads();
    if (F.tid < 16) for (int gi = F.vcu; gi < ntiles; gi += F.G) { const int rr = gi * 16 + F.tid;
        rt_pos[2 * rr] += (int)lcnt[32 + rt_e[2 * rr]]; rt_pos[2 * rr + 1] += (int)lcnt[32 + rt_e[2 * rr + 1]]; }
}

__device__ __forceinline__ void gather_pass(const Frame& F0, int l, int nrows) {
    const Frame F = phase_frame(F0); unsigned char* const ws = F.ws;
    LAS int* off = (LAS int*)F.lds;
    const unsigned* cnt = (const unsigned*)(ws + WS_CTL) + CW_CNT + 64 * l;
    int* tile_e = (int*)(ws + WS_ROUTE + RT_TILE); int* ntl = (int*)(ws + WS_ROUTE + RT_NT);
    __syncthreads();
    if (F.tid < NEXP) off[32 + F.tid] = (int)__hip_atomic_load(cnt + F.tid, __ATOMIC_RELAXED, __HIP_MEMORY_SCOPE_AGENT);
    __syncthreads();
    if (F.tid == 0) { int o = 0;
#pragma nounroll
        for (int e = 0; e < NEXP; ++e) { const int c = off[32 + e]; const int nt = (c + 255) >> 8; off[e] = o;
            if (blockIdx.x == 0) {
#pragma nounroll
                for (int t = 0; t < nt; ++t) tile_e[(o >> 8) + t] = e; }
            o += nt << 8; }
        if (blockIdx.x == 0) ntl[0] = o >> 8; }
    __syncthreads();
    const int* rt_e = (const int*)(ws + WS_ROUTE + RT_E); const int* rt_pos = (const int*)(ws + WS_ROUTE + RT_POS); int* rt_slot = (int*)(ws + WS_ROUTE + RT_SLOT);
    const bf16* H = (const bf16*)(ws + WS_H); bf16* Xs = (bf16*)(ws + WS_XS);
    for (int it0 = F.gw * 4; it0 < 2 * nrows; it0 += F.NGW * 4) { int slot[4]; u32x4 a[4], b2[4];
#pragma unroll
        for (int u = 0; u < 4; ++u) { const int it = it0 + u; slot[u] = it < 2 * nrows ? off[rt_e[it]] + rt_pos[it] : -1; }
#pragma unroll
        for (int u = 0; u < 4; ++u) if (slot[u] >= 0) { const u32x4* s = (const u32x4*)(H + (size_t)((it0 + u) >> 1) * D); a[u] = s[F.lane]; b2[u] = s[64 + F.lane]; }
#pragma unroll
        for (int u = 0; u < 4; ++u) if (slot[u] >= 0) { if (F.lane == 0) rt_slot[it0 + u] = slot[u]; u32x4* d = (u32x4*)(Xs + (size_t)slot[u] * D); d[F.lane] = a[u]; d[64 + F.lane] = b2[u]; }
    }
}

template <bool DRY>
__device__ __forceinline__ void combine_pass(const Frame& F0, int l, int nrows) {
    const Frame F = phase_frame(F0); unsigned char* const ws = F.ws;
    LAS float* mg2 = (LAS float*)F.lds; LAS float* msh = mg2 + 3072; LAS float* msc = msh + 3072;
    const bool last = (l == DEPTH - 1);
    __syncthreads();
    mod_to_lds(F, l, 5, mg2, false); if (!last) { mod_to_lds(F, l + 1, 0, msh, false); mod_to_lds(F, l + 1, 1, msc, false); }
    __syncthreads();
    float* X = (float*)(ws + WS_X); bf16* H = (bf16*)(ws + WS_H); const bf16* Ys = (const bf16*)(ws + WS_XS);
    const int* rt_slot = (const int*)(ws + WS_ROUTE + RT_SLOT); const float* rt_gate = (const float*)(ws + WS_ROUTE + RT_GATE);
    const int lane = F.lane; const float* n1g = inptr(I_N1G) + (last ? 0 : (l + 1) * D); const float* fgp = inptr(I_FG);
    for (int row0 = F.gw; row0 < nrows; row0 += 2 * F.NGW) {
        int s0[2], s1[2]; float w0[2], w1[2]; bool ok[2]; u32x2 ya[2][4], yb[2][4]; f32x4 xo[2][4];
#pragma unroll
        for (int u = 0; u < 2; ++u) { const int row = row0 + u * F.NGW; ok[u] = row < nrows; if (ok[u]) { s0[u] = rt_slot[2 * row]; s1[u] = rt_slot[2 * row + 1]; w0[u] = rt_gate[2 * row]; w1[u] = rt_gate[2 * row + 1]; } }
#pragma unroll
        for (int u = 0; u < 2; ++u) if (ok[u]) { const int row = row0 + u * F.NGW;
#pragma unroll
            for (int j = 0; j < 4; ++j) { const int c = 4 * lane + 256 * j; ya[u][j] = *(const u32x2*)(Ys + (size_t)s0[u] * D + c); yb[u][j] = *(const u32x2*)(Ys + (size_t)s1[u] * D + c); xo[u][j] = *(const f32x4*)(X + (size_t)row * D + c); } }
#pragma unroll
        for (int u = 0; u < 2; ++u) if (ok[u]) { const int row = row0 + u * F.NGW; const int mr = modrow(row); f32x4 v[4];
#pragma unroll
            for (int j = 0; j < 4; ++j) { const int c = 4 * lane + 256 * j; float a[4], b[4]; unpack4(ya[u][j], a); unpack4(yb[u][j], b);
                const f32x4 g2 = *(const LAS f32x4*)(mg2 + mr * 1024 + c);
                f32x4 y; y.x = w0[u] * a[0] + w1[u] * b[0]; y.y = w0[u] * a[1] + w1[u] * b[1]; y.z = w0[u] * a[2] + w1[u] * b[2]; y.w = w0[u] * a[3] + w1[u] * b[3];
                v[j] = xo[u][j] + g2 * y; }
            if (DRY) { asm volatile("" :: "v"(v[0].x + v[1].y + v[2].z + v[3].w)); }
            else if (!last) {
#pragma unroll
                for (int j = 0; j < 4; ++j) *(f32x4*)(X + (size_t)row * D + 4 * lane + 256 * j) = v[j];
                norm_mod_row(v, n1g, msc + mr * 1024, msh + mr * 1024, H + (size_t)row * D, lane);
            } else { float s = 0.f;
#pragma unroll
                for (int j = 0; j < 4; ++j) s += (v[j].x * v[j].x + v[j].y * v[j].y) + (v[j].z * v[j].z + v[j].w * v[j].w);
                const float rs = rsqrtf(wave_sum(s) * (1.f / D) + RMS_EPS);
#pragma unroll
                for (int j = 0; j < 4; ++j) { const int c = 4 * lane + 256 * j; const f32x4 g = *(const f32x4*)(fgp + c); *(f32x4*)(F.out + (size_t)row * D + c) = v[j] * rs * g; } } }
    }
}
__global__ void __launch_bounds__(NTHR, 2) fwd_megakernel(Params prm) {
    extern __shared__ __attribute__((aligned(16))) unsigned char lds_raw[];
    Frame F;
    F.lds = (LAS unsigned char*)lds_raw;
    F.tid = threadIdx.x; F.lane = F.tid & 63; F.wave = __builtin_amdgcn_readfirstlane(F.tid >> 6);
    F.G = gridDim.x; { const int bx = blockIdx.x; F.vcu = (F.G % 8 == 0) ? (bx % 8) * (F.G / 8) + bx / 8 : bx; }
    F.gw = F.vcu * NWAVES + F.wave; F.NGW = F.G * NWAVES;
    F.out = prm.out; F.ws = prm.ws;
    for (int u = F.tid; u < (LDS_BYTES - LDSCTL_OFF) / 4; u += NTHR) ((LAS unsigned*)(F.lds + LDSCTL_OFF))[u] = 0u;
    __syncthreads();
    (void)xcd_barrier_post((unsigned*)(F.ws + WS_CTL) + CW_BAR, (volatile LAS unsigned*)(F.lds + MISC_OFF) + 8);
#define GRID_BAR() do { XcdBarrier bar_; bar_.bar = (unsigned*)(opaque(F.ws) + WS_CTL) + CW_BAR; bar_.x = xb_xcc_id(); bar_.st = (volatile LAS unsigned*)(F.lds + MISC_OFF) + 8; xcd_barrier(bar_); } while (0)

#ifndef PHMASK
#define PHMASK 0xffff
#endif
#define PH(k) ((PHMASK >> (k)) & 1)
#ifndef PROBE_MASK
#define PROBE_MASK 0
#endif
#define REP(k) _Pragma("nounroll") for (int rep_ = 0; rep_ < ((PROBE_MASK >> (k)) & 1) + 1; ++rep_)
    if (PH(0)) p0_prologue(F);
#if USE_CG_SYNC
    cg::this_grid().sync();
#else
    GRID_BAR();
#endif
    if (PH(1)) p0b_norm1(F);
    GRID_BAR();

#if BAR_PROBE
    for (int i_ = 0; i_ < 20; ++i_) GRID_BAR();
#endif
    for (int l = 0; l < DEPTH; ++l) {
        const bool need_ctx = (l == 0); const int nrows = need_ctx ? NROW : NLAT;
#define WSO Fp.ws
        REP(2) {
            const Frame Fp = phase_frame(F); unsigned char* const ws = WSO; bf16* Hb = (bf16*)(ws + WS_H); bf16* Pb = (bf16*)(ws + WS_P);
            pg8::Gemm g{Hb, (const bf16*)(ws + WS_WIN_T) + (size_t)l * NP * D, NROW, NP, D}; pg8::StaticOrder S; S.init(NROW, NP, Fp.G, (int)blockIdx.x);
            pg8::EpiStoreBf16 E{Pb, NP, 0xffff};
            pg8::gemm_phase<pg8::EpiStoreBf16, pg8::StaticOrder, true, true>(F.lds, g, S, E);
        }
        GRID_BAR();
        {
            const Frame Fp = phase_frame(F); unsigned char* const ws = WSO; bf16* Pb = (bf16*)(ws + WS_P);
            REP(14) for (int it = blockIdx.x; it < 256; it += F.G) fftA_item(F, it);
            if (PH(4) && need_ctx) for (int it = blockIdx.x; it < 8; it += F.G) { const int b = it >> 2, m0 = (it & 3) * 64;
                const bf16* src0 = Pb + (size_t)(NLAT + b * CTXL) * NP + COL_FC;
                dft64_item<4, 256>(F, l, m0, -1.f, 1.f / 128.f, [=](int t, int ri) { return src0 + (size_t)t * NP + ri * 256; }, [=](int m) { return NLAT + b * CTXL + m; }); }
            REP(15) shift_pass(F, l);
            REP(16) conv_pass(F, l, nrows);
        }
        GRID_BAR();
        {
            const Frame Fp = phase_frame(F); unsigned char* const ws = WSO;
            REP(4) prep_phase(F, l);
        }
        GRID_BAR();
        for (int seg = 0; seg < NSEG; ++seg) {
            REP(5) pre_phase(F, seg);
            GRID_BAR();
            unsigned char* const ws = opaque(F.ws);
            if (seg == 0 && F.G == 256 && blockIdx.x >= 128) for (int it = (int)blockIdx.x - 128; it < 256; it += 128) { const int b = it >> 7, t1p = it & 127;
                const bf16* src0 = (const bf16*)(ws + WS_GT) + (size_t)(b * 128 + t1p) * 64 * 512;
                dft64_item<1, 64>(F, l, 0, 1.f, 0.0013810679320049757f, [=](int t, int ri) { return src0 + (size_t)t * 512 + ri * 256; }, [=](int m) { return b * SEQ + t1p + 128 * m; }); }
            if (seg == 0 && F.G != 256) for (int it = blockIdx.x; it < 256; it += F.G) { const int b = it >> 7, t1p = it & 127;
                const bf16* src0 = (const bf16*)(ws + WS_GT) + (size_t)(b * 128 + t1p) * 64 * 512;
                dft64_item<1, 64>(F, l, 0, 1.f, 0.0013810679320049757f, [=](int t, int ri) { return src0 + (size_t)t * 512 + ri * 256; }, [=](int m) { return b * SEQ + t1p + 128 * m; }); }
            REP(6) for (int it = blockIdx.x; it < 128; it += F.G) { const int x_ = it & 7, j_ = it >> 3;
#if SEQ_PROBE_PRE
                seq_item<SEQ_PROBE_PRE>(F, ((x_ + 8 * (j_ >> 2)) << 2) | (j_ & 3), seg, need_ctx);
#endif
                seq_item<0>(F, ((x_ + 8 * (j_ >> 2)) << 2) | (j_ & 3), seg, need_ctx);
#if SEQ_PROBE
                seq_item<SEQ_PROBE>(F, ((x_ + 8 * (j_ >> 2)) << 2) | (j_ & 3), seg, need_ctx);
#endif
            }
            GRID_BAR();
        }
        REP(7) readout_pass(F, l, nrows);
        GRID_BAR();
        REP(8) if (l == 0 || rep_ == 0) {
            const Frame Fp = phase_frame(F); unsigned char* const ws = WSO; bf16* Hb = (bf16*)(ws + WS_H);
            pg8::Gemm g{Hb, (const bf16*)(ws + WS_WOUT_T) + (size_t)l * D * D, nrows, D, D}; pg8::StaticOrder S; S.init(nrows, D, Fp.G, (int)blockIdx.x);
            const float* X = (const float*)(ws + WS_X);
            pg8::EpiResidual E{l == 0 ? inptr(I_X) : X, l == 0 ? inptr(I_CTX) : X + (size_t)NLAT * D, (float*)(ws + WS_X), (const float*)(ws + WS_MODF) + (size_t)l * 3 * 6144 + 2 * 1024};
            pg8::gemm_phase<pg8::EpiResidual, pg8::StaticOrder, true, true>(F.lds, g, S, E);
        }
        expert_convert(F, l, (nrows / 256) * 4 > F.G ? (nrows / 256) * 4 - F.G : 0);
        GRID_BAR();
        router_pass(F, l, nrows);
#if RC_PROBE == 1
        router_pass(F, l, nrows, 1024);
#endif
        GRID_BAR();
        REP(10) gather_pass(F, l, nrows);
        GRID_BAR();
        if (PH(14)) {
            const Frame Fp = phase_frame(F); unsigned char* const ws = WSO;
            const int* tile_e = (const int*)(ws + WS_ROUTE + RT_TILE); const int ntiles = *(const int*)(ws + WS_ROUTE + RT_NT);
            pg8::MoeOrder S{tile_e, ntiles, Fp.G, (int)blockIdx.x};
            REP(12) {   pg8::Gemm g{(const bf16*)(ws + WS_XS), (const bf16*)(ws + WS_WGU_T), 0, 0, D};
                pg8::EpiSwiGLU E{(bf16*)(ws + WS_ACT)};
                pg8::gemm_phase<pg8::EpiSwiGLU, pg8::MoeOrder, true, true>(F.lds, g, S, E); }
            GRID_BAR();
            REP(13) {   pg8::Gemm g{(const bf16*)(ws + WS_ACT), (const bf16*)(ws + WS_WD_T), 0, 0, DEXP};
                pg8::EpiStoreBf16 E{(bf16*)(ws + WS_XS), D, 3};
                pg8::gemm_phase<pg8::EpiStoreBf16, pg8::MoeOrder, true, true>(F.lds, g, S, E); }
        }
        GRID_BAR();
#if RC_PROBE == 2
        combine_pass<true>(F, l, nrows);
#endif
        combine_pass<false>(F, l, nrows);
        if (l + 1 < DEPTH) GRID_BAR();
    }
}

extern "C" void kernel_launch(void* const* d_in, const int* in_sizes, int n_in, void* d_out, int out_size, void* d_ws, size_t ws_size, hipStream_t stream) {
    static int grid = 0;
    if (grid == 0) {
        if (n_in != N_IN || in_sizes[0] != NLAT * D || out_size != NLAT * D || ws_size < WS_END) {
            fprintf(stderr, "kernel_launch: unexpected shapes (n_in %d in0 %d out %d ws %zu)\n", n_in, n_in > 0 ? in_sizes[0] : -1, out_size, ws_size); grid = -1; return; }
        int dev = 0, cus = 0, per_cu = 0;
        hipGetDevice(&dev); hipDeviceGetAttribute(&cus, hipDeviceAttributeMultiprocessorCount, dev);
        hipFuncSetAttribute((const void*)fwd_megakernel, hipFuncAttributeMaxDynamicSharedMemorySize, LDS_BYTES);
        hipOccupancyMaxActiveBlocksPerMultiprocessor(&per_cu, (const void*)fwd_megakernel, NTHR, LDS_BYTES);
        if (per_cu < 1) { fprintf(stderr, "kernel_launch: occupancy query says %d blocks per CU\n", per_cu); per_cu = 1; }
        (void)hipGetLastError();
        grid = cus * per_cu;
    }
    if (grid < 0) return;
    hipMemsetAsync((char*)d_ws + WS_CTL, 0, CTL_ZERO_BYTES, stream);
    Params p{};
    for (int i = 0; i < N_IN; ++i) p.in[i] = (const float*)d_in[i];
    p.out = (float*)d_out; p.ws = (unsigned char*)d_ws;
    void* args[] = {&p};
    hipError_t e = hipLaunchCooperativeKernel((const void*)fwd_megakernel, dim3(grid), dim3(NTHR), args, LDS_BYTES, stream);
    if (e != hipSuccess) fprintf(stderr, "kernel_launch: cooperative launch failed: %s (grid %d)\n", hipGetErrorString(e), grid);
}
```

```cpp
#include <hip/hip_runtime.h>
#include <hip/hip_cooperative_groups.h>
#include <cstdio>
#include <cstdint>
namespace cg = cooperative_groups;
#ifndef USE_CG_SYNC
#define USE_CG_SYNC 0
#endif
#define SEQ_PROBE 0
#define SEQ_PROBE_PRE 0
#define PRE_PROBE 0
#define BAR_PROBE 0
#define RC_PROBE 0
#define PREP_PROBE 0
#ifndef PROBE_MASK
#define PROBE_MASK 0
#endif
namespace pg8 {
#define PG8_LAS __attribute__((address_space(3)))
typedef unsigned short bf16_t;
typedef short bf16x8 __attribute__((ext_vector_type(8)));
typedef float f32x4 __attribute__((ext_vector_type(4)));
typedef unsigned u32x4 __attribute__((ext_vector_type(4)));
constexpr int BM = 256, BK = 64, HALF = 128, HTB = HALF * BK * 2  , STAGE_BYTES = 8 * HTB, NXCD = 8, WGM = 8;

__host__ __device__ __forceinline__ int lds_byte(int r, int c) { const int st = (r >> 4) * 2 + (c >> 5), rr = r & 15, cc = c & 31, ob = rr * 64 + cc * 2; return st * 1024 + (ob ^ (((ob >> 9) & 1) << 5)); }
__host__ __device__ __forceinline__ void stage_rc(int b, int& R, int& C) { const int st = b / 1024, sb = b % 1024, swz = sb ^ (((sb >> 9) & 1) << 5); R = (st >> 1) * 16 + swz / 64; C = (st & 1) * 32 + (swz % 64) / 2; }
__host__ __device__ __forceinline__ int perm32(int rho) { const int n = rho >> 4, i = rho & 15; return 8 * (i >> 2) + 4 * n + (i & 3); }

struct Unit { int pm, pn; };
struct Gemm { const bf16_t* A; const bf16_t* Bt; int M, N, K; };

struct StaticOrder {
    int nM, nN, nwg, G, c;
    __host__ __device__ void init(int M, int N, int G_, int c_) { nM = M / BM; nN = N / BM; nwg = nM * nN; G = G_; c = c_; }
    __host__ __device__ bool next(int i, Unit& u) const {
        const long L = (long)i * G + c; if (L >= nwg) return false;
        int wgid = (int)L; { const int q = nwg / NXCD, r = nwg % NXCD, xcd = wgid % NXCD, off = wgid / NXCD; wgid = (xcd < r ? xcd * (q + 1) : r * (q + 1) + (xcd - r) * q) + off; }
        const int nig = WGM * nN, gid = wgid / nig, fm = gid * WGM, gsz = (nM - fm) < WGM ? (nM - fm) : WGM;
        u.pm = fm + ((wgid % nig) % gsz); u.pn = (wgid % nig) / gsz; return true;
    }
    __device__ __forceinline__ void a_ready(const Unit&) const {}
    __device__ __forceinline__ void done(const Unit&) const {}
};

__device__ __forceinline__ unsigned cvt_pk_bf16(float lo, float hi) { unsigned r; asm volatile("v_cvt_pk_bf16_f32 %0, %1, %2" : "=v"(r) : "v"(lo), "v"(hi)); return r; }
typedef float f32x2 __attribute__((ext_vector_type(2)));
template <class Epi, class Sched, bool ALIGN_EPI = false, bool SP2 = false>
__device__ __forceinline__ void gemm_phase(PG8_LAS unsigned char* lds, const Gemm g, const Sched& S, const Epi& E) {
    int tid = threadIdx.x; asm volatile("" : "+v"(tid));
    const int wid = __builtin_amdgcn_readfirstlane(tid >> 6), lane = tid & 63, wr = wid >> 2, wc = wid & 3, fr = lane & 15, fq = lane >> 4;
    const int K = g.K, nt = K / BK;
    unsigned voffA[2], voffB[2];
#pragma unroll
    for (int i = 0; i < 2; ++i) { int R, C; stage_rc(tid * 16 + i * 8192, R, C); const int Rb = Epi::PERM ? ((R & ~31) + perm32(R & 31)) : R;
        voffA[i] = (unsigned)(R * K + C) * 2u; voffB[i] = (unsigned)(Rb * K + C) * 2u; }
    const size_t kstep = (size_t)(BK * 2);
    const size_t hstep = (size_t)HALF * K * 2;
    const size_t tstep = 2 * hstep;
    const unsigned ldsw = (unsigned)wid * 1024u;
    const int aoff = lds_byte(wr * 64 + fr, fq * 8), boff = lds_byte(wc * 32 + fr, fq * 8);
#define PG8_SA(b, h) (((b) * 2 + (h)) * HTB)
#define PG8_SB(b, h) ((4 + (b) * 2 + (h)) * HTB)
#define PG8_STAGE(bufoff, gbase, voff) do { _Pragma("unroll") for (int _i = 0; _i < 2; ++_i) \
        __builtin_amdgcn_global_load_lds((const unsigned*)((const char*)(gbase) + (voff)[_i]), (PG8_LAS unsigned*)(lds + (bufoff) + ldsw + _i * 8192), 16, 0, 0); } while (0)
#define PG8_LDA(dst, b, h) do { _Pragma("unroll") for (int m = 0; m < 4; ++m) _Pragma("unroll") for (int k = 0; k < 2; ++k) dst[m][k] = *(const PG8_LAS bf16x8*)(lds + PG8_SA(b, h) + aoff + m * 2048 + k * 1024); } while (0)
#define PG8_LDB(dst, b, h) do { _Pragma("unroll") for (int n = 0; n < 2; ++n) _Pragma("unroll") for (int k = 0; k < 2; ++k) dst[n][k] = *(const PG8_LAS bf16x8*)(lds + PG8_SB(b, h) + boff + n * 2048 + k * 1024); } while (0)
#define PG8_MMA(ai, bj, At, Bt) do { __builtin_amdgcn_s_setprio(1); _Pragma("unroll") for (int m = 0; m < 4; ++m) _Pragma("unroll") for (int n = 0; n < 2; ++n) _Pragma("unroll") for (int k = 0; k < 2; ++k) \
        acc[ai][bj][m][n] = __builtin_amdgcn_mfma_f32_16x16x32_bf16(Bt[n][k], At[m][k], acc[ai][bj][m][n], 0, 0, 0); __builtin_amdgcn_s_setprio(0); } while (0)
#define PG8_WAIT_V(n) asm volatile("s_waitcnt vmcnt(" #n ")" ::: "memory")
#define PG8_WAIT_L(n) asm volatile("s_waitcnt lgkmcnt(" #n ")" ::: "memory")
#define PG8_BAR __builtin_amdgcn_s_barrier()
#define PG8_SCHED __builtin_amdgcn_sched_barrier(0)
    Unit cur, nxt; int ui = 0;
    if (!S.next(0, cur)) return;
    f32x4 acc[2][2][4][2];
#pragma unroll
    for (int a = 0; a < 2; ++a)
#pragma unroll
        for (int b = 0; b < 2; ++b)
#pragma unroll
            for (int m = 0; m < 4; ++m)
#pragma unroll
                for (int n = 0; n < 2; ++n) acc[a][b][m][n] = (f32x4){0.f, 0.f, 0.f, 0.f};
    bf16x8 At[4][2], B0[2][2], B1[2][2];
    const char* cA = (const char*)g.A + (size_t)cur.pm * tstep; const char* cB = (const char*)g.Bt + (size_t)cur.pn * tstep;
    S.a_ready(cur);
    if constexpr (SP2) {
        PG8_STAGE(PG8_SB(0, 0), cB, voffB); PG8_STAGE(PG8_SB(0, 1), cB + hstep, voffB); PG8_STAGE(PG8_SA(0, 0), cA, voffA); PG8_STAGE(PG8_SA(0, 1), cA + hstep, voffA);
        if (wr == 1) PG8_BAR;
        PG8_WAIT_V(2); PG8_BAR;
        PG8_STAGE(PG8_SB(1, 0), cB + kstep, voffB); PG8_STAGE(PG8_SA(1, 0), cA + kstep, voffA); PG8_STAGE(PG8_SB(1, 1), cB + hstep + kstep, voffB);
        PG8_WAIT_V(6); PG8_BAR;
    } else {
        PG8_STAGE(PG8_SB(0, 0), cB, voffB); PG8_STAGE(PG8_SA(0, 0), cA, voffA); PG8_STAGE(PG8_SB(0, 1), cB + hstep, voffB); PG8_STAGE(PG8_SA(0, 1), cA + hstep, voffA);
        if (wr == 1) PG8_BAR;
        PG8_WAIT_V(4); PG8_BAR;
        PG8_STAGE(PG8_SB(1, 0), cB + kstep, voffB); PG8_STAGE(PG8_SA(1, 0), cA + kstep, voffA); PG8_STAGE(PG8_SB(1, 1), cB + hstep + kstep, voffB);
        PG8_WAIT_V(6); PG8_BAR;
    }
    for (;;) {
        const bool has_next = S.next(ui + 1, nxt);
        const char* nA = has_next ? (const char*)g.A + (size_t)nxt.pm * tstep : cA; const char* nB = has_next ? (const char*)g.Bt + (size_t)nxt.pn * tstep : cB;
        for (int t = 0; t < nt; t += 2) {
            const bool last = (t == nt - 2);
            const char* a1 = cA + (size_t)(t + 1) * kstep;
            const char* a2 = last ? nA : cA + (size_t)(t + 2) * kstep; const char* b2 = last ? nB : cB + (size_t)(t + 2) * kstep;
            const char* a3 = a2 + kstep; const char* b3 = b2 + kstep;
            if (last && has_next) S.a_ready(nxt);
            if constexpr (SP2) {
            PG8_LDB(B0, 0, 0); PG8_LDB(B1, 0, 1); PG8_SCHED; PG8_LDA(At, 0, 0); PG8_STAGE(PG8_SA(1, 1), a1 + hstep, voffA);
            PG8_WAIT_V(8); PG8_WAIT_L(0); PG8_BAR; PG8_MMA(0, 0, At, B0); PG8_MMA(0, 1, At, B1); PG8_BAR; PG8_SCHED;
            PG8_LDA(At, 0, 1); PG8_STAGE(PG8_SB(0, 0), b2, voffB); PG8_STAGE(PG8_SB(0, 1), b2 + hstep, voffB); PG8_STAGE(PG8_SA(0, 0), a2, voffA);
            PG8_WAIT_V(8); PG8_WAIT_L(0); PG8_BAR; PG8_MMA(1, 0, At, B0); PG8_MMA(1, 1, At, B1); PG8_BAR; PG8_SCHED;
            PG8_LDB(B0, 1, 0); PG8_LDB(B1, 1, 1); PG8_SCHED; PG8_LDA(At, 1, 0); PG8_STAGE(PG8_SA(0, 1), a2 + hstep, voffA);
            PG8_WAIT_V(8); PG8_WAIT_L(0); PG8_BAR; PG8_MMA(0, 0, At, B0); PG8_MMA(0, 1, At, B1); PG8_BAR; PG8_SCHED;
            PG8_LDA(At, 1, 1); PG8_STAGE(PG8_SB(1, 0), b3, voffB); PG8_STAGE(PG8_SB(1, 1), b3 + hstep, voffB); PG8_STAGE(PG8_SA(1, 0), a3, voffA);
            PG8_WAIT_V(8); PG8_WAIT_L(0); PG8_BAR; PG8_MMA(1, 0, At, B0); PG8_MMA(1, 1, At, B1); PG8_BAR; PG8_SCHED;
            } else {
            PG8_LDB(B0, 0, 0); PG8_SCHED; PG8_LDA(At, 0, 0); PG8_STAGE(PG8_SA(1, 1), a1 + hstep, voffA);
            PG8_WAIT_L(8); PG8_BAR; PG8_WAIT_L(0); PG8_MMA(0, 0, At, B0); PG8_BAR; PG8_SCHED;
            PG8_LDB(B1, 0, 1); PG8_STAGE(PG8_SB(0, 0), b2, voffB);
            PG8_BAR; PG8_WAIT_L(0); PG8_MMA(0, 1, At, B1); PG8_BAR;
            PG8_LDA(At, 0, 1); PG8_STAGE(PG8_SA(0, 0), a2, voffA);
            PG8_BAR; PG8_WAIT_L(0); PG8_MMA(1, 0, At, B0); PG8_BAR; PG8_SCHED;
            PG8_STAGE(PG8_SB(0, 1), b2 + hstep, voffB);
            PG8_WAIT_V(6); PG8_BAR; PG8_MMA(1, 1, At, B1); PG8_BAR;
            PG8_LDB(B0, 1, 0); PG8_SCHED; PG8_LDA(At, 1, 0); PG8_STAGE(PG8_SA(0, 1), a2 + hstep, voffA);
            PG8_WAIT_L(8); PG8_BAR; PG8_WAIT_L(0); PG8_MMA(0, 0, At, B0); PG8_BAR; PG8_SCHED;
            PG8_LDB(B1, 1, 1); PG8_STAGE(PG8_SB(1, 0), b3, voffB);
            PG8_BAR; PG8_WAIT_L(0); PG8_MMA(0, 1, At, B1); PG8_BAR;
            PG8_LDA(At, 1, 1); PG8_STAGE(PG8_SA(1, 0), a3, voffA);
            PG8_BAR; PG8_WAIT_L(0); PG8_MMA(1, 0, At, B0); PG8_BAR; PG8_SCHED;
            PG8_STAGE(PG8_SB(1, 1), b3 + hstep, voffB);
            PG8_WAIT_V(6); PG8_BAR; PG8_MMA(1, 1, At, B1); PG8_BAR;
            }
        }
        if constexpr (ALIGN_EPI) { if (wr == 0) PG8_BAR; }
        if constexpr (!Epi::AFTER_DRAIN) { E(acc, cur, wr, wc, fr, fq); S.done(cur); }
        if (!has_next) break;
#pragma unroll
        for (int a = 0; a < 2; ++a)
#pragma unroll
            for (int b = 0; b < 2; ++b)
#pragma unroll
                for (int m = 0; m < 4; ++m)
#pragma unroll
                    for (int n = 0; n < 2; ++n) acc[a][b][m][n] = (f32x4){0.f, 0.f, 0.f, 0.f};
        cur = nxt; cA = nA; cB = nB; ++ui;
        if constexpr (ALIGN_EPI) { if (wr == 1) PG8_BAR; }
    }
    PG8_WAIT_V(0);
    if constexpr (!ALIGN_EPI) { if (wr == 0) PG8_BAR; }
    PG8_BAR;
    if constexpr (Epi::AFTER_DRAIN) { E.fused(acc, cur, wr, wc, fr, fq, lds, wid, lane); S.done(cur); }
#undef PG8_SA
#undef PG8_SB
#undef PG8_STAGE
#undef PG8_LDA
#undef PG8_LDB
#undef PG8_MMA
#undef PG8_WAIT_V
#undef PG8_WAIT_L
#undef PG8_BAR
#undef PG8_SCHED
}
}
#define LAS __attribute__((address_space(3)))
typedef unsigned short bf16;
typedef float f32x4 __attribute__((ext_vector_type(4)));
typedef short bf16x8 __attribute__((ext_vector_type(8)));
typedef unsigned u32x4 __attribute__((ext_vector_type(4)));
typedef unsigned u32x2 __attribute__((ext_vector_type(2)));

constexpr int D = 1024, NBATCH = 2, SEQ = 8192, CTXL = 256, DEPTH = 2;
constexpr int NLAT = NBATCH * SEQ, NCTX = NBATCH * CTXL, NROW = NLAT + NCTX;
constexpr int DR = 512, DIN = 2944, NP = 3328, ZW = 1920, NHEAD = 8;
constexpr int COL_CONV = 1920, COL_FC = 2688, COL_FS = 2944;
constexpr int STRW = 5120;
constexpr int NEXP = 32, DEXP = 512;
constexpr int MOE_MAXTILES = 168;
constexpr float RMS_EPS = 1e-6f, GN_EPS = 64e-5f;

enum { I_X = 0, I_C, I_CTX, I_CCTX, I_ADAW, I_ADAB, I_N1G, I_N2G, I_WIN, I_MU, I_DW0, I_DW2, I_IA0, I_IA2, I_GG2, I_KK, I_KA, I_RK, I_GNW, I_GNB,
       I_CONVW, I_CONVG, I_FOURG, I_WOUT, I_RGW, I_RGB, I_REW, I_REB, I_EG, I_EU, I_ED, I_FG, N_IN };

constexpr size_t MiB = 1u << 20;
constexpr size_t WS_CTL = 0, CTL_ZERO_BYTES = 64 * 1024;
constexpr size_t WS_MODP = 1 * MiB;
constexpr size_t WS_MODF = 1 * MiB + 1280 * 1024;
constexpr size_t WS_WIN_T = 3 * MiB;
constexpr size_t WS_WOUT_T = 16 * MiB;
constexpr size_t WS_WGU_T = 20 * MiB;
constexpr size_t WS_WD_T = 84 * MiB;
constexpr size_t WS_X = 116 * MiB;
constexpr size_t WS_H = 182 * MiB;
constexpr size_t WS_ZS = 215 * MiB;
constexpr size_t WS_P = 277 * MiB;
constexpr size_t WS_STR = 277 * MiB;
constexpr size_t WS_Y = 442 * MiB;
constexpr size_t WS_GT = 475 * MiB;
constexpr size_t WS_ROUTE = 491 * MiB;
constexpr size_t WS_XS = 215 * MiB;
constexpr size_t WS_ACT = 299 * MiB;
constexpr size_t WS_END = 530 * MiB;
constexpr size_t RT_E = 0, RT_POS = 1 * 33792 * 4, RT_GATE = 2 * 33792 * 4, RT_SLOT = 3 * 33792 * 4, RT_TILE = 4 * 33792 * 4, RT_NT = RT_TILE + 1024;

constexpr int CW_BAR = 4096;
constexpr int CW_CNT = 8192;

constexpr int NWAVES = 8, NTHR = 512;
constexpr int RING_BYTES = 131072, LDSCTL_OFF = 143360, MISC_OFF = LDSCTL_OFF + 320, LDS_BYTES = 147456;

struct Params { const float* in[N_IN]; float* out; unsigned char* ws; };

__device__ __forceinline__ float bf2f(unsigned h) { return __uint_as_float(h << 16); }
typedef __bf16 hwbf2 __attribute__((ext_vector_type(2)));
typedef float f32x2 __attribute__((ext_vector_type(2)));
__device__ __forceinline__ unsigned pk2(float lo, float hi) { const f32x2 x = {lo, hi}; const hwbf2 r = __builtin_convertvector(x, hwbf2); return __builtin_bit_cast(unsigned, r); }
__device__ __forceinline__ unsigned f2bf(float f) { return pk2(f, 0.f) & 0xffffu; }
__device__ __forceinline__ float wave_sum(float v) {
#pragma unroll
    for (int o = 1; o < 64; o <<= 1) v += __shfl_xor(v, o);
    return v;
}
__device__ __forceinline__ float sigmoidf_(float x) { return 1.f / (1.f + __expf(-x)); }
#define LDS_WAIT() asm volatile("s_waitcnt lgkmcnt(0)" ::: "memory")
#define VM_WAIT() asm volatile("s_waitcnt vmcnt(0)" ::: "memory")

struct Frame {
    LAS unsigned char* lds;
    int tid, lane, wave, vcu, G, gw, NGW;
    float* out; unsigned char* ws;
};
#if defined(__HIP_DEVICE_COMPILE__)
#define ASSUME_GLOBAL(p) do { __builtin_assume(!__builtin_amdgcn_is_shared(p)); __builtin_assume(!__builtin_amdgcn_is_private(p)); } while (0)
#else
#define ASSUME_GLOBAL(p) do { } while (0)
#endif
__device__ __forceinline__ const float* inptr(int i) {
    const volatile unsigned long long __attribute__((address_space(4)))* ka = (const volatile unsigned long long __attribute__((address_space(4)))*)__builtin_amdgcn_kernarg_segment_ptr();
    return (const float*)(const __attribute__((address_space(1))) float*)ka[i];
}
__device__ __forceinline__ unsigned char* opaque(unsigned char* p) { unsigned long z = 0; asm volatile("" : "+s"(z)); return p + z; }
__device__ __forceinline__ Frame phase_frame(const Frame& F0) { Frame F = F0; asm volatile("" : "+v"(F.tid)); F.lane = F.tid & 63; F.ws = opaque(F0.ws);
    asm volatile("" : "+s"(F.G), "+s"(F.vcu)); F.gw = F.vcu * NWAVES + F.wave; F.NGW = F.G * NWAVES; return F; }
__device__ __forceinline__ int modrow(int row) { return row < NLAT ? (row >> 13) : 2; }
#define XB_TMO      128
#define XB_XCNT(j)  (256  + 64 * (j))
#define XB_XSUB(j)  (1280 + 64 * (j))
#define XB_XGEN(j)  (2304 + 64 * (j))
#define XB_TOP      3328
#define XB_TOPGEN   3392
#define XCD_BAR_WORDS 3456
#define XB_SPIN_CAP (1u << 18)

__device__ __forceinline__ unsigned xb_ld(unsigned* p)              { return __hip_atomic_load(p, __ATOMIC_RELAXED, __HIP_MEMORY_SCOPE_AGENT); }
__device__ __forceinline__ unsigned xb_add(unsigned* p, unsigned v) { return __hip_atomic_fetch_add(p, v, __ATOMIC_RELAXED, __HIP_MEMORY_SCOPE_AGENT); }
__device__ __forceinline__ unsigned xb_xcc_id() { return (unsigned)__builtin_amdgcn_s_getreg((3 << 11) | 20) & 0xFu; }
#define XB_SPIN(cond, bar) do { unsigned _sp = 0; while (cond) { __builtin_amdgcn_s_sleep(1); \
    if ((++_sp & 255u) == 0u) { if (xb_ld(&(bar)[XB_TMO])) break; if (_sp > XB_SPIN_CAP) { atomicAdd(&(bar)[XB_TMO], 1u); break; } } } } while (0)

struct XcdBarrier {
    unsigned* bar; unsigned x;
    volatile LAS unsigned* st;
};

__device__ __forceinline__ XcdBarrier xcd_barrier_post(unsigned* bar, volatile LAS unsigned* st) {
    XcdBarrier b; b.bar = bar; b.x = xb_xcc_id(); b.st = st;
    if (threadIdx.x == 0) (void)xb_add(&bar[XB_XCNT(b.x)], 1u);
    return b;
}
__device__ __forceinline__ void xcd_barrier_complete(unsigned* bar, unsigned x, unsigned& nloc, unsigned& nx) {
    const unsigned G = gridDim.x * gridDim.y * gridDim.z;
    unsigned sum, cnt, mine, sp = 0u;
    for (;;) {
        sum = 0u; cnt = 0u; mine = 0u;
#pragma nounroll
        for (unsigned j = 0; j < 16; ++j) { const unsigned c = xb_ld(&bar[XB_XCNT(j)]); sum += c; cnt += (c > 0u) ? 1u : 0u; mine = (j == x) ? c : mine; }
        if (sum == G) break;
        __builtin_amdgcn_s_sleep(1);
        if ((++sp & 255u) == 0u) { if (xb_ld(&bar[XB_TMO])) break; if (sp > XB_SPIN_CAP) { atomicAdd(&bar[XB_TMO], 1u); break; } }
    }
    nloc = mine > 0u ? mine : 1u; nx = cnt > 0u ? cnt : 1u;
}

__device__ __forceinline__ void xcd_barrier(const XcdBarrier& b) {
    asm volatile("s_waitcnt vmcnt(0)" ::: "memory");
    __syncthreads();
    if (threadIdx.x == 0) {
        unsigned* bar = b.bar;
        asm volatile("" : "+s"(bar));
        __builtin_amdgcn_s_waitcnt(0);
        unsigned nloc = b.st[0], nx = b.st[1];
        if (nloc == 0u) { xcd_barrier_complete(bar, b.x, nloc, nx); b.st[0] = nloc; b.st[1] = nx; }
        const unsigned old = xb_add(&bar[XB_XSUB(b.x)], 1u);
        const unsigned gen = old / nloc;
        if (old + 1u == (gen + 1u) * nloc) {
            __builtin_amdgcn_fence(__ATOMIC_RELEASE, "agent");
            asm volatile("s_waitcnt vmcnt(0)" ::: "memory");
            const unsigned og = xb_add(&bar[XB_TOP], 1u);
            const unsigned tg = og / nx;
            if (og + 1u == (tg + 1u) * nx) xb_add(&bar[XB_TOPGEN], 1u);
            else XB_SPIN(xb_ld(&bar[XB_TOPGEN]) == tg, bar);
            __builtin_amdgcn_fence(__ATOMIC_ACQUIRE, "agent");
            xb_add(&bar[XB_XGEN(b.x)], 1u);
            asm volatile("s_waitcnt vmcnt(0)" ::: "memory");
        } else {
            XB_SPIN(xb_ld(&bar[XB_XGEN(b.x)]) == gen, bar);
            __builtin_amdgcn_fence(__ATOMIC_ACQUIRE, "agent");
            asm volatile("s_waitcnt vmcnt(0)" ::: "memory");
        }
    }
    __syncthreads();
}
template <class RowMap>
__device__ __forceinline__ void transpose_item(const float* W, int ldw, int k0, int n0, bf16* WT, int ldt, RowMap rm, LAS float* scr, int lane) {
    (void)scr;
    const int nq = lane & 7, kg = lane >> 3; const float* src = W + (size_t)(k0 + 8 * kg) * ldw + n0 + 4 * nq;
    f32x4 v[8];
#pragma unroll
    for (int i = 0; i < 8; ++i) v[i] = *(const f32x4*)(src + (size_t)i * ldw);
#pragma unroll
    for (int j = 0; j < 4; ++j) { u32x4 o = {pk2(v[0][j], v[1][j]), pk2(v[2][j], v[3][j]), pk2(v[4][j], v[5][j]), pk2(v[6][j], v[7][j])};
        *(u32x4*)(WT + (size_t)rm(n0 + 4 * nq + j) * ldt + k0 + 8 * kg) = o; }
}
struct RmId { int off; __device__ __forceinline__ int operator()(int n) const { return off + n; } };
struct RmGU { int off; __device__ __forceinline__ int operator()(int n) const { return off + ((n >> 2) << 3) + (n & 3); } };

__device__ __forceinline__ void p0_prologue(const Frame& F0) {
    const Frame F = phase_frame(F0); unsigned char* const ws = F.ws;
    LAS float* scr = (LAS float*)(F.lds + F.wave * 16384);
    LAS float* ctab = (LAS float*)(F.lds + 8 * 16384);
    if (F.tid < 64) ctab[F.tid] = cosf((float)F.tid * (6.283185307179586f / 64.f));
    __syncthreads();
    bf16* win_t = (bf16*)(ws + WS_WIN_T); bf16* wout_t = (bf16*)(ws + WS_WOUT_T);
    constexpr int I_WIN_L = 16 * 84, I_WOUT_L = 16 * 32, I_FOLD_L = 4 * 64, I_MOD_L = 96 * 8;
    constexpr int NIT = 2 * (I_WIN_L + I_WOUT_L + I_FOLD_L + I_MOD_L);
    const float* p_win = inptr(I_WIN); const float* p_wout = inptr(I_WOUT); const float* p_c = inptr(I_C); const float* p_cctx = inptr(I_CCTX); const float* p_adaw = inptr(I_ADAW);
    {
        bf16* wl = (bf16*)(ws + 64 * 1024); const float* dw2 = inptr(I_DW2); const float* ia2 = inptr(I_IA2); const float* gg2 = inptr(I_GG2);
        for (int idx = F.vcu * NTHR + F.tid; idx < 2 * 384 * 512; idx += F.G * NTHR) { const int c = idx & 511, k = (idx >> 9) % 384, l = idx / (384 * 512);
            float v;
            if (k < 128) v = dw2[((size_t)(l * 2 + (k >> 6)) * 64 + (k & 63)) * DR + c];
            else if (k < 256) v = ia2[((size_t)(l * 2 + ((k - 128) >> 6)) * 64 + (k & 63)) * DR + c];
            else v = gg2[((size_t)l * 128 + (k - 256)) * DR + c];
            wl[((size_t)l * 512 + c) * 384 + k] = (bf16)f2bf(v); } }
    for (int it = F.gw; it < NIT; it += F.NGW) {
        int r = it; const int l = r & 1; r >>= 1;
        if (r < I_WIN_L) { const int kb = r / 84, nb = r % 84;
            transpose_item(p_win + (size_t)l * D * DIN, DIN, kb * 64, nb * 32, win_t + (size_t)l * NP * D, D, RmId{0}, scr, F.lane); continue; }
        r -= I_WIN_L;
        if (r < I_WOUT_L) { const int kb = r / 32, nb = r % 32;
            transpose_item(p_wout + (size_t)l * D * D, D, kb * 64, nb * 32, wout_t + (size_t)l * D * D, D, RmId{0}, scr, F.lane); continue; }
        r -= I_WOUT_L;
        if (r < I_FOLD_L) {
            const int g = r >> 6, k0 = (r & 63) * 16; const float* W = p_win + (size_t)l * D * DIN;
#pragma unroll
            for (int kk = 0; kk < 16; ++kk) scr[kk * 64 + F.lane] = W[(size_t)(k0 + kk) * DIN + 2688 + g * 64 + F.lane];
            LDS_WAIT(); asm volatile("" ::: "memory");
            float ac[16], as[16];
#pragma unroll
            for (int kk = 0; kk < 16; ++kk) { ac[kk] = 0.f; as[kk] = 0.f; }
            for (int c = 0; c < 64; ++c) { const int idx = (c * F.lane) & 63; const float cc = ctab[idx], ss = ctab[(idx - 16) & 63];
#pragma unroll
                for (int kk = 0; kk < 16; ++kk) { const float w = scr[kk * 64 + c]; ac[kk] += w * cc; as[kk] += w * ss; } }
            bf16* oc = win_t + (size_t)l * NP * D + (size_t)(COL_FC + g * 64 + F.lane) * D + k0;
            bf16* os = win_t + (size_t)l * NP * D + (size_t)(COL_FS + g * 64 + F.lane) * D + k0;
            u32x4 a, b;
            a.x = pk2(ac[0], ac[1]); a.y = pk2(ac[2], ac[3]); a.z = pk2(ac[4], ac[5]); a.w = pk2(ac[6], ac[7]);
            b.x = pk2(ac[8], ac[9]); b.y = pk2(ac[10], ac[11]); b.z = pk2(ac[12], ac[13]); b.w = pk2(ac[14], ac[15]);
            *(u32x4*)oc = a; *(u32x4*)(oc + 8) = b;
            a.x = pk2(as[0], as[1]); a.y = pk2(as[2], as[3]); a.z = pk2(as[4], as[5]); a.w = pk2(as[6], as[7]);
            b.x = pk2(as[8], as[9]); b.y = pk2(as[10], as[11]); b.z = pk2(as[12], as[13]); b.w = pk2(as[14], as[15]);
            *(u32x4*)os = a; *(u32x4*)(os + 8) = b;
            LDS_WAIT(); asm volatile("" ::: "memory");
            continue; }
        r -= I_FOLD_L;
        {
            const int cb = r >> 3, ks = r & 7;
#pragma unroll
            for (int q = 0; q < 2; ++q) { const int k = ks * 128 + q * 64 + F.lane;
                const float c0 = p_c[k], c1 = p_c[D + k], c2 = p_cctx[k];
                scr[0 * 128 + q * 64 + F.lane] = c0 * sigmoidf_(c0); scr[1 * 128 + q * 64 + F.lane] = c1 * sigmoidf_(c1); scr[2 * 128 + q * 64 + F.lane] = c2 * sigmoidf_(c2); }
            LDS_WAIT(); asm volatile("" ::: "memory");
            const float* W = p_adaw + (size_t)l * D * 6144 + (size_t)(ks * 128) * 6144 + cb * 64 + F.lane;
            float a0 = 0.f, a1 = 0.f, a2 = 0.f;
#pragma unroll 8
            for (int kk = 0; kk < 128; ++kk) { const float w = W[(size_t)kk * 6144]; a0 += scr[kk] * w; a1 += scr[128 + kk] * w; a2 += scr[256 + kk] * w; }
            float* mp = (float*)(ws + WS_MODP) + (size_t)((l * 8 + ks) * 3) * 6144 + cb * 64 + F.lane;
            mp[0] = a0; mp[6144] = a1; mp[2 * 6144] = a2;
            LDS_WAIT(); asm volatile("" ::: "memory");
        }
    }
}

__device__ __forceinline__ void mod_to_lds(const Frame& F0, int l, int p, LAS float* dst, bool from_partials) {
    const Frame F = phase_frame(F0); unsigned char* const ws = F.ws;
    const float* adab = inptr(I_ADAB);
    for (int idx = F.tid; idx < 3 * 1024; idx += NTHR) { const int r = idx >> 10, n = idx & 1023;
        float v;
        if (from_partials) { v = adab[l * 6144 + p * 1024 + n]; const float* mp = (const float*)(ws + WS_MODP) + (size_t)(l * 8 * 3 + r) * 6144 + p * 1024 + n;
#pragma unroll
            for (int ks = 0; ks < 8; ++ks) v += mp[(size_t)ks * 3 * 6144]; }
        else v = ((const float*)(ws + WS_MODF))[(size_t)(l * 3 + r) * 6144 + p * 1024 + n];
        dst[idx] = v; }
}
__device__ __forceinline__ void mod_finalize(const Frame& F0) {
    const Frame F = phase_frame(F0); unsigned char* const ws = F.ws;
    const float* adab = inptr(I_ADAB);
    for (int idx = F.vcu * NTHR + F.tid; idx < 2 * 3 * 6144; idx += F.G * NTHR) { const int l = idx / (3 * 6144), rem = idx % (3 * 6144), r = rem / 6144, n = rem % 6144;
        float v = adab[l * 6144 + n]; const float* mp = (const float*)(ws + WS_MODP) + (size_t)(l * 8 * 3 + r) * 6144 + n;
#pragma unroll
        for (int ks = 0; ks < 8; ++ks) v += mp[(size_t)ks * 3 * 6144];
        ((float*)(ws + WS_MODF))[idx] = v; }
}


__device__ __forceinline__ void norm_mod_row(f32x4 (&v)[4], const float* gain, const LAS float* sc, const LAS float* sh, bf16* orow, int lane) {
    float s = 0.f;
#pragma unroll
    for (int j = 0; j < 4; ++j) s += (v[j].x * v[j].x + v[j].y * v[j].y) + (v[j].z * v[j].z + v[j].w * v[j].w);
    const float rs = rsqrtf(wave_sum(s) * (1.f / D) + RMS_EPS);
#pragma unroll
    for (int j = 0; j < 4; ++j) { const int c = 4 * lane + 256 * j; const f32x4 g = *(const f32x4*)(gain + c); const f32x4 a = *(const LAS f32x4*)(sc + c), b = *(const LAS f32x4*)(sh + c);
        v[j] = (v[j] * rs) * g * (a + 1.f) + b;
        u32x2 w; w.x = pk2(v[j].x, v[j].y); w.y = pk2(v[j].z, v[j].w); *(u32x2*)(orow + c) = w; }
}

__device__ __forceinline__ void p0b_norm1(const Frame& F0) {
    const Frame F = phase_frame(F0); unsigned char* const ws = F.ws;
    LAS float* msh = (LAS float*)F.lds; LAS float* msc = msh + 3072;
    mod_to_lds(F, 0, 0, msh, true); mod_to_lds(F, 0, 1, msc, true); __syncthreads();
    mod_finalize(F);
    bf16* H = (bf16*)(ws + WS_H); const float* xin = inptr(I_X); const float* cin = inptr(I_CTX); const float* n1g = inptr(I_N1G);
    for (int row0 = F.gw; row0 < NROW; row0 += 2 * F.NGW) { f32x4 v[2][4]; bool ok[2];
#pragma unroll
        for (int u = 0; u < 2; ++u) { const int row = row0 + u * F.NGW; ok[u] = row < NROW; if (ok[u]) { const float* xr = row < NLAT ? xin + (size_t)row * D : cin + (size_t)(row - NLAT) * D;
#pragma unroll
            for (int j = 0; j < 4; ++j) v[u][j] = *(const f32x4*)(xr + 4 * F.lane + 256 * j); } }
#pragma unroll
        for (int u = 0; u < 2; ++u) if (ok[u]) { const int row = row0 + u * F.NGW; const int mr = modrow(row);
            norm_mod_row(v[u], n1g, msc + mr * 1024, msh + mr * 1024, H + (size_t)row * D, F.lane); } }
}
__device__ __forceinline__ void unpack8(const u32x4 w, float (&o)[8]) {
    o[0] = bf2f(w.x & 0xffffu); o[1] = bf2f(w.x >> 16); o[2] = bf2f(w.y & 0xffffu); o[3] = bf2f(w.y >> 16);
    o[4] = bf2f(w.z & 0xffffu); o[5] = bf2f(w.z >> 16); o[6] = bf2f(w.w & 0xffffu); o[7] = bf2f(w.w >> 16);
}
__device__ __forceinline__ void unpack4(const u32x2 w, float (&o)[4]) { o[0] = bf2f(w.x & 0xffffu); o[1] = bf2f(w.x >> 16); o[2] = bf2f(w.y & 0xffffu); o[3] = bf2f(w.y >> 16); }

__device__ __forceinline__ void shift_pass(const Frame& F0, int l) {
    const Frame F = phase_frame(F0); unsigned char* const ws = F.ws;
    const bf16* P = (const bf16*)(ws + WS_P); bf16* Zs = (bf16*)(ws + WS_ZS); const float* mu = inptr(I_MU) + l * ZW;
    const int total = NROW * 240;
    for (int idx = F.vcu * NTHR + F.tid; idx < total; idx += F.G * NTHR) {
        const int row = idx / 240, ck = idx % 240; const bf16* pr = P + (size_t)row * NP + ck * 8;
        const u32x4 zero = {0u, 0u, 0u, 0u};
        float z[8], n0[8], n1[8], n2[8], n3[8], o[8];
        unpack8(*(const u32x4*)pr, z);
        if (row < NLAT) { const int t = row & (SEQ - 1), gr = t >> 6, gc = t & 63;
            unpack8(gc > 0 ? *(const u32x4*)(pr - NP) : zero, n0); unpack8(gc < 63 ? *(const u32x4*)(pr + NP) : zero, n1);
            unpack8(gr > 0 ? *(const u32x4*)(pr - 64 * NP) : zero, n2); unpack8(gr < 127 ? *(const u32x4*)(pr + 64 * NP) : zero, n3);
        } else { const int tc = (row - NLAT) & (CTXL - 1);
            unpack8(tc > 0 ? *(const u32x4*)(pr - NP) : zero, n0); unpack8(tc < CTXL - 1 ? *(const u32x4*)(pr + NP) : zero, n1);
#pragma unroll
            for (int j = 0; j < 8; ++j) { n2[j] = n0[j]; n3[j] = n1[j]; }
        }
        const f32x4 m0 = *(const f32x4*)(mu + ck * 8), m1 = *(const f32x4*)(mu + ck * 8 + 4);
        const float m[8] = {m0.x, m0.y, m0.z, m0.w, m1.x, m1.y, m1.z, m1.w};
#pragma unroll
        for (int j = 0; j < 8; ++j) { const float nb = (j & 3) == 0 ? n0[j] : (j & 3) == 1 ? n1[j] : (j & 3) == 2 ? n2[j] : n3[j]; o[j] = z[j] + (nb - z[j]) * m[j]; }
        u32x4 w; w.x = pk2(o[0], o[1]); w.y = pk2(o[2], o[3]); w.z = pk2(o[4], o[5]); w.w = pk2(o[6], o[7]);
        *(u32x4*)(Zs + (size_t)row * ZW + ck * 8) = w;
    }
}

__device__ __forceinline__ void conv_pass(const Frame& F0, int l, int nrows) {
    const Frame F = phase_frame(F0); unsigned char* const ws = F.ws;
    const bf16* P = (const bf16*)(ws + WS_P); bf16* MA = (bf16*)(ws + WS_H);
    const float* cw = inptr(I_CONVW) + l * 3 * 256; const int c = 4 * F.lane;
    const f32x4 w0 = *(const f32x4*)(cw + c), w1 = *(const f32x4*)(cw + 256 + c), w2 = *(const f32x4*)(cw + 512 + c), gn = *(const f32x4*)(inptr(I_CONVG) + l * 256 + c);
    for (int row0 = F.gw; row0 < nrows; row0 += 2 * F.NGW) {
        u32x2 q[2][7]; bool ok[2]; const u32x2 zero = {0u, 0u};
#pragma unroll
        for (int u = 0; u < 2; ++u) { const int row = row0 + u * F.NGW; ok[u] = row < nrows; if (ok[u]) {
            int t, L; if (row < NLAT) { t = row & (SEQ - 1); L = SEQ; } else { t = (row - NLAT) & (CTXL - 1); L = CTXL; }
            const bf16* pr = P + (size_t)row * NP + COL_CONV + c;
            q[u][0] = *(const u32x2*)pr; q[u][1] = *(const u32x2*)(pr + 256); q[u][2] = *(const u32x2*)(pr + 512);
            q[u][3] = t > 0 ? *(const u32x2*)(pr - NP + 256) : zero; q[u][4] = t > 0 ? *(const u32x2*)(pr - NP + 512) : zero;
            q[u][5] = t < L - 1 ? *(const u32x2*)(pr + NP + 256) : zero; q[u][6] = t < L - 1 ? *(const u32x2*)(pr + NP + 512) : zero; } }
#pragma unroll
        for (int u = 0; u < 2; ++u) if (ok[u]) { const int row = row0 + u * F.NGW;
            float bg[4], cg[4], hh[4], cp[4], hp[4], cn[4], hn[4];
            unpack4(q[u][0], bg); unpack4(q[u][1], cg); unpack4(q[u][2], hh); unpack4(q[u][3], cp); unpack4(q[u][4], hp); unpack4(q[u][5], cn); unpack4(q[u][6], hn);
            const float W0[4] = {w0.x, w0.y, w0.z, w0.w}, W1[4] = {w1.x, w1.y, w1.z, w1.w}, W2[4] = {w2.x, w2.y, w2.z, w2.w}, GN[4] = {gn.x, gn.y, gn.z, gn.w};
            float y[4], s = 0.f;
#pragma unroll
            for (int j = 0; j < 4; ++j) { y[j] = bg[j] * (W0[j] * (cp[j] * hp[j]) + W1[j] * (cg[j] * hh[j]) + W2[j] * (cn[j] * hn[j])); s += y[j] * y[j]; }
            const float rs = rsqrtf(wave_sum(s) * (1.f / 256.f) + RMS_EPS);
            u32x2 o; o.x = pk2(y[0] * rs * GN[0], y[1] * rs * GN[1]); o.y = pk2(y[2] * rs * GN[2], y[3] * rs * GN[3]);
            *(u32x2*)(MA + (size_t)row * D + 512 + c) = o; }
    }
}

__device__ __forceinline__ void sincos_turns(float x, float& s, float& c) { s = __builtin_amdgcn_sinf(x); c = __builtin_amdgcn_cosf(x); }
#define MFMA16(a, b, c) __builtin_amdgcn_mfma_f32_16x16x32_bf16((a), (b), (c), 0, 0, 0)

__device__ __forceinline__ void fftA_item(const Frame& F0, int item) {
    const Frame F = phase_frame(F0); unsigned char* const ws = F.ws;
    const int half = item & 1, t2 = (item >> 1) & 63, b = item >> 7;
    const bf16* P = (const bf16*)(ws + WS_P); bf16* GT = (bf16*)(ws + WS_GT);
    LAS bf16* Bs = (LAS bf16*)F.lds;
    const int lane = F.lane, w = F.wave, fr = lane & 15, fq = lane >> 4;
    __syncthreads();
#pragma unroll
    for (int i = 0; i < 8; ++i) { const int cidx = F.tid + NTHR * i, krow = cidx >> 4, ch8 = cidx & 15, ri = krow >> 7, t1 = krow & 127;
        const u32x4 v = *(const u32x4*)(P + (size_t)(b * SEQ + t1 * 64 + t2) * NP + COL_FC + ri * 256 + half * 128 + ch8 * 8);
        LAS bf16* d = Bs + (ch8 * 8) * 264 + krow;
        d[0 * 264] = (bf16)(v.x & 0xffffu); d[1 * 264] = (bf16)(v.x >> 16); d[2 * 264] = (bf16)(v.y & 0xffffu); d[3 * 264] = (bf16)(v.y >> 16);
        d[4 * 264] = (bf16)(v.z & 0xffffu); d[5 * 264] = (bf16)(v.z >> 16); d[6 * 264] = (bf16)(v.w & 0xffffu); d[7 * 264] = (bf16)(v.w >> 16); }
    __syncthreads();
    f32x4 acc[2][8];
#pragma unroll
    for (int a = 0; a < 2; ++a)
#pragma unroll
        for (int n = 0; n < 8; ++n) acc[a][n] = (f32x4){0.f, 0.f, 0.f, 0.f};
    int t1p_a = 16 * w + fr;
    asm volatile("" : "+v"(t1p_a));
#pragma unroll
    for (int ks = 0; ks < 8; ++ks) {
        bf16x8 ar, ai;
#pragma unroll
        for (int j = 0; j < 8; ++j) { const int k = ks * 32 + 8 * fq + j, ri = k >> 7, t1 = k & 127; const int idx = (t1 * t1p_a) & 127;
            float sn, cs; sincos_turns((float)idx * (1.f / 128.f), sn, cs);
            const float vr = ri == 0 ? cs : -sn, vi = ri == 0 ? -sn : -cs;
            ar[j] = (short)f2bf(vr); ai[j] = (short)f2bf(vi); }
#pragma unroll
        for (int nt = 0; nt < 8; ++nt) { const bf16x8 bfr = *(const LAS bf16x8*)(Bs + (nt * 16 + fr) * 264 + ks * 32 + 8 * fq);
            acc[0][nt] = MFMA16(ar, bfr, acc[0][nt]); acc[1][nt] = MFMA16(ai, bfr, acc[1][nt]); }
    }
#pragma unroll
    for (int reg = 0; reg < 4; ++reg) { const int t1p = 16 * w + 4 * fq + reg; float st, ct; sincos_turns((float)(t2 * t1p) * (1.f / 8192.f), st, ct);
        bf16* g = GT + ((size_t)((b * 128 + t1p) * 64 + t2) * 2) * 256 + half * 128 + fr;
#pragma unroll
        for (int nt = 0; nt < 8; ++nt) { const float gr = acc[0][nt][reg], gi = acc[1][nt][reg];
            g[nt * 16] = (bf16)f2bf(gr * ct + gi * st); g[256 + nt * 16] = (bf16)f2bf(gi * ct - gr * st); } }
}

template <int NKC, int NDIV, class SrcRow, class OutRow>
__device__ __forceinline__ void dft64_item(const Frame& F0, int l, int m0, float sgn, float scale, SrcRow src, OutRow orow) {
    const Frame F = phase_frame(F0); unsigned char* const ws = F.ws;
    LAS bf16* Bs = (LAS bf16*)F.lds;
    LAS float* red = (LAS float*)(F.lds + 256 * 136 * 2);
    const int lane = F.lane, w = F.wave, fr = lane & 15, fq = lane >> 4;
    int fr_a = fr; asm volatile("" : "+v"(fr_a));
    f32x4 acc[4][2];
#pragma unroll
    for (int a = 0; a < 4; ++a) { acc[a][0] = (f32x4){0.f, 0.f, 0.f, 0.f}; acc[a][1] = (f32x4){0.f, 0.f, 0.f, 0.f}; }
    for (int kc = 0; kc < NKC; ++kc) {
        __syncthreads();
#pragma unroll
        for (int i = 0; i < 8; ++i) { const int cidx = F.tid + NTHR * i, krow = cidx >> 5, ch8 = cidx & 31;
            const u32x4 v = *(const u32x4*)(src(kc * 64 + (krow >> 1), krow & 1) + ch8 * 8);
            LAS bf16* d = Bs + (ch8 * 8) * 136 + krow;
            d[0 * 136] = (bf16)(v.x & 0xffffu); d[1 * 136] = (bf16)(v.x >> 16); d[2 * 136] = (bf16)(v.y & 0xffffu); d[3 * 136] = (bf16)(v.y >> 16);
            d[4 * 136] = (bf16)(v.z & 0xffffu); d[5 * 136] = (bf16)(v.z >> 16); d[6 * 136] = (bf16)(v.w & 0xffffu); d[7 * 136] = (bf16)(v.w >> 16); }
        __syncthreads();
#pragma unroll
        for (int ks = 0; ks < 4; ++ks) {
            const bf16x8 b0 = *(const LAS bf16x8*)(Bs + ((2 * w) * 16 + fr) * 136 + ks * 32 + 8 * fq);
            const bf16x8 b1 = *(const LAS bf16x8*)(Bs + ((2 * w + 1) * 16 + fr) * 136 + ks * 32 + 8 * fq);
#pragma unroll
            for (int mt = 0; mt < 4; ++mt) { const int mrow = m0 + mt * 16 + fr_a; bf16x8 a;
#pragma unroll
                for (int j = 0; j < 8; ++j) { const int k = ks * 32 + 8 * fq + j, tl = k >> 1, ri = k & 1; const int idx = ((kc * 64 + tl) * mrow) & (NDIV - 1);
                    float sn, cs; sincos_turns((float)idx * (1.f / (float)NDIV), sn, cs);
                    a[j] = (short)f2bf(ri == 0 ? cs : sgn * sn); }
                acc[mt][0] = MFMA16(a, b0, acc[mt][0]); acc[mt][1] = MFMA16(a, b1, acc[mt][1]); }
        }
    }
#pragma unroll
    for (int mt = 0; mt < 4; ++mt)
#pragma unroll
        for (int reg = 0; reg < 4; ++reg) { const float a = acc[mt][0][reg] * scale, b = acc[mt][1][reg] * scale; acc[mt][0][reg] = a; acc[mt][1][reg] = b;
            float s = a * a + b * b; s += __shfl_xor(s, 1); s += __shfl_xor(s, 2); s += __shfl_xor(s, 4); s += __shfl_xor(s, 8);
            if (fr == 0) red[w * 64 + mt * 16 + 4 * fq + reg] = s; }
    __syncthreads();
    bf16* MA = (bf16*)(ws + WS_H); const float* fg = inptr(I_FOURG) + l * 256;
    const float g0 = fg[(2 * w) * 16 + fr], g1 = fg[(2 * w + 1) * 16 + fr];
#pragma unroll
    for (int mt = 0; mt < 4; ++mt)
#pragma unroll
        for (int reg = 0; reg < 4; ++reg) { const int ml = mt * 16 + 4 * fq + reg; float tot = 0.f;
#pragma unroll
            for (int ww = 0; ww < 8; ++ww) tot += red[ww * 64 + ml];
            const float rs = rsqrtf(tot * (1.f / 256.f) + RMS_EPS);
            bf16* o = MA + (size_t)orow(m0 + ml) * D + 768 + fr;
            o[(2 * w) * 16] = (bf16)f2bf(acc[mt][0][reg] * rs * g0); o[(2 * w + 1) * 16] = (bf16)f2bf(acc[mt][1][reg] * rs * g1); }
    __syncthreads();
}

constexpr size_t WS_LORA = 64 * 1024;
constexpr int LINP = 392;
__device__ __forceinline__ float fast_sigmoid(float x) { return __builtin_amdgcn_rcpf(1.f + __expf(-x)); }
__device__ __forceinline__ float fast_tanh(float x) { return 1.f - 2.f * __builtin_amdgcn_rcpf(1.f + __expf(2.f * x)); }
__device__ __forceinline__ void prep_phase(const Frame& F0, int l) {
    const Frame F = phase_frame(F0); unsigned char* const ws = F.ws;
    const bf16* Zs = (const bf16*)(ws + WS_ZS); bf16* STR = (bf16*)(ws + WS_STR);
    LAS bf16* lin = (LAS bf16*)F.lds;
    LAS float* ssum = (LAS float*)(F.lds + 12544);
    LAS bf16* tiles = (LAS bf16*)(F.lds + 13312);
    const int lane = F.lane, fr = lane & 15, fq = lane >> 4, w = F.wave, tid = F.tid;
    const int nitems = (NROW / 16) * 2;
    int it = blockIdx.x; if (it >= nitems) return;
    int hh = -1, head = 0, cb = 0;
    bf16x8 wf[12][2];
    const float* kkp = inptr(I_KK) + l * DR; const float* kap = inptr(I_KA) + l * DR; const float* dw0 = inptr(I_DW0) + l * 2 * DR; const float* ia0 = inptr(I_IA0) + l * 2 * DR;
    u32x4 pz[2];
#define PREP_LOAD(item_) do { const int row0_ = ((item_) >> 1) * 16; \
        pz[0] = *(const u32x4*)(Zs + (size_t)(row0_ + tid / 48) * ZW + 1536 + (tid % 48) * 8); \
        if (tid < 256) pz[1] = *(const u32x4*)(Zs + (size_t)(row0_ + (tid + 512) / 48) * ZW + 1536 + ((tid + 512) % 48) * 8); } while (0)
    PREP_LOAD(it);
    for (; it < nitems; it += F.G) {
        const int tile = it >> 1;
        if ((it & 1) != hh) {
            hh = it & 1; head = 4 * hh + (w >> 1); cb = 64 * head + 32 * (w & 1);
            const bf16* WL = (const bf16*)(ws + WS_LORA) + (size_t)l * 512 * 384 + (size_t)(cb + fr) * 384 + 8 * fq;
#pragma unroll
            for (int ks = 0; ks < 12; ++ks)
#pragma unroll
                for (int nt = 0; nt < 2; ++nt) wf[ks][nt] = *(const bf16x8*)(WL + (size_t)nt * 16 * 384 + ks * 32);
        }
        __syncthreads();
        {   float v[8]; unpack8(pz[0], v); const int c8 = tid % 48;
            if (c8 < 16) {
#pragma unroll
                for (int j = 0; j < 8; ++j) v[j] = fast_tanh(v[j]); }
            else if (c8 >= 32) {
#pragma unroll
                for (int j = 0; j < 8; ++j) v[j] = fast_sigmoid(v[j]); }
            *(LAS u32x4*)(lin + (tid / 48) * LINP + c8 * 8) = (u32x4){pk2(v[0], v[1]), pk2(v[2], v[3]), pk2(v[4], v[5]), pk2(v[6], v[7])};
            if (tid < 256) { unpack8(pz[1], v); const int c9 = (tid + 512) % 48;
                if (c9 < 16) {
#pragma unroll
                    for (int j = 0; j < 8; ++j) v[j] = fast_tanh(v[j]); }
                else if (c9 >= 32) {
#pragma unroll
                    for (int j = 0; j < 8; ++j) v[j] = fast_sigmoid(v[j]); }
                *(LAS u32x4*)(lin + ((tid + 512) / 48) * LINP + c9 * 8) = (u32x4){pk2(v[0], v[1]), pk2(v[2], v[3]), pk2(v[4], v[5]), pk2(v[6], v[7])}; } }
        u32x2 zr2[2], zk2[2], zv2[2];
        {   const bf16* zr_ = Zs + (size_t)(tile * 16 + fr) * ZW + cb + 4 * fq;
#pragma unroll
            for (int nt = 0; nt < 2; ++nt) { zr2[nt] = *(const u32x2*)(zr_ + 16 * nt); zk2[nt] = *(const u32x2*)(zr_ + 512 + 16 * nt); zv2[nt] = *(const u32x2*)(zr_ + 1024 + 16 * nt); } }
        if (it + F.G < nitems) PREP_LOAD(it + F.G);
        __syncthreads();
        f32x4 kkw[2], kaw[2], d0w[2][2], i0w[2][2];
#pragma unroll
        for (int nt = 0; nt < 2; ++nt) { const int c0 = cb + 16 * nt + 4 * fq; kkw[nt] = *(const f32x4*)(kkp + c0); kaw[nt] = *(const f32x4*)(kap + c0);
#pragma unroll
            for (int dn = 0; dn < 2; ++dn) { d0w[dn][nt] = *(const f32x4*)(dw0 + dn * DR + c0); i0w[dn][nt] = *(const f32x4*)(ia0 + dn * DR + c0); } }
        f32x4 acc[5][2];
#pragma unroll
        for (int q = 0; q < 5; ++q) { acc[q][0] = (f32x4){0.f, 0.f, 0.f, 0.f}; acc[q][1] = (f32x4){0.f, 0.f, 0.f, 0.f}; }
#pragma unroll
        for (int ks = 0; ks < 12; ++ks) { const int q = ks < 8 ? (ks >> 1) : 4; const bf16x8 xf = *(const LAS bf16x8*)(lin + fr * LINP + ks * 32 + 8 * fq);
            acc[q][0] = MFMA16(wf[ks][0], xf, acc[q][0]); acc[q][1] = MFMA16(wf[ks][1], xf, acc[q][1]); }
        float zk[2][4], kv[2][4]; float ss = 0.f;
#pragma unroll
        for (int nt = 0; nt < 2; ++nt) { unpack4(zk2[nt], zk[nt]);
#pragma unroll
            for (int i = 0; i < 4; ++i) { kv[nt][i] = zk[nt][i] * kkw[nt][i]; ss += kv[nt][i] * kv[nt][i]; } }
        ss += __shfl_xor(ss, 16); ss += __shfl_xor(ss, 32);
        if (fq == 0) ssum[w * 16 + fr] = ss;
        __syncthreads();
        const float inv = __builtin_amdgcn_rcpf(fmaxf(sqrtf(ssum[w * 16 + fr] + ssum[(w ^ 1) * 16 + fr]), 1e-12f));
        LAS bf16* th = tiles + (w >> 1) * 10 * 1024 + fr * 64 + 32 * (w & 1) + 4 * fq;
#pragma unroll
        for (int nt = 0; nt < 2; ++nt) { LAS bf16* t0 = th + 16 * nt;
            *(LAS u32x2*)(t0) = zr2[nt]; *(LAS u32x2*)(t0 + 1024) = zv2[nt];
            float kk[4];
#pragma unroll
            for (int i = 0; i < 4; ++i) kk[i] = kv[nt][i] * inv;
            *(LAS u32x2*)(t0 + 2 * 1024) = (u32x2){pk2(kk[0], kk[1]), pk2(kk[2], kk[3])};
            *(LAS u32x2*)(t0 + 3 * 1024) = (u32x2){pk2(acc[4][nt][0], acc[4][nt][1]), pk2(acc[4][nt][2], acc[4][nt][3])};
#pragma unroll
            for (int dn = 0; dn < 2; ++dn) { float ep[4], kd[4], bb[4];
#pragma unroll
                for (int i = 0; i < 4; ++i) { const float ew = fast_sigmoid(d0w[dn][nt][i] + acc[dn][nt][i]) * 0.6065306597126334f;
                    ep[i] = ew * (1.f + ew * (-0.5f + ew * (0.16666667f + ew * (-0.041666668f + ew * 0.0083333338f))));
                    const float a = fast_sigmoid(i0w[dn][nt][i] + acc[2 + dn][nt][i]); kd[i] = zk[nt][i] * (1.f + (a - 1.f) * kaw[nt][i]); bb[i] = kk[i] * a; }
                *(LAS u32x2*)(t0 + (4 + 3 * dn) * 1024) = (u32x2){pk2(ep[0], ep[1]), pk2(ep[2], ep[3])};
                *(LAS u32x2*)(t0 + (5 + 3 * dn) * 1024) = (u32x2){pk2(kd[0], kd[1]), pk2(kd[2], kd[3])};
                *(LAS u32x2*)(t0 + (6 + 3 * dn) * 1024) = (u32x2){pk2(bb[0], bb[1]), pk2(bb[2], bb[3])}; } }
        __syncthreads();
        {   const LAS bf16* src = tiles + (w >> 1) * 10 * 1024 + 8 * (w & 1) * 64 + lane * 8; bf16* dst = STR + ((size_t)tile * 8 + head) * 10240 + 8 * (w & 1) * 64 + lane * 8;
#pragma unroll
            for (int s = 0; s < 10; ++s) *(u32x4*)(dst + s * 1024) = *(const LAS u32x4*)(src + s * 1024); }
    }
#undef PREP_LOAD
}

__device__ __forceinline__ int scan_rowof(int s, int dir, int b) { if (s < CTXL) { const int tc = dir ? (CTXL - 1 - s) : s; return NLAT + b * CTXL + tc; } const int tt = s - CTXL; const int t = dir ? (SEQ - 1 - tt) : tt; return b * SEQ + t; }
__device__ __forceinline__ void scan_item(const Frame& F0, int item, bool need_ctx) {
    const Frame F = phase_frame(F0); unsigned char* const ws = F.ws;
    const int dir = item & 1, h = (item >> 1) & 7, b = item >> 4;
    const bf16* STR = (const bf16*)(ws + WS_STR); bf16* Y = (bf16*)(ws + WS_Y) + (size_t)dir * NROW * DR;
    const int lane = F.lane, kq = lane & 7, vrow = 8 * F.wave + (lane >> 3);
    float S[8];
#pragma unroll
    for (int j = 0; j < 8; ++j) S[j] = 0.f;
    const int co = h * 64 + kq * 8;
    constexpr int NSTEP = CTXL + SEQ;
#define rowof(s) scan_rowof((s), dir, b)
    for (int s0 = 0; s0 < NSTEP; s0 += 4) {
        u32x4 qkk[4], qe[4], qkd[4], qb[4], qr[4]; unsigned qv[4];
#pragma unroll
        for (int u = 0; u < 4; ++u) { const bf16* base = STR + (size_t)rowof(s0 + u) * STRW;
            qr[u] = *(const u32x4*)(base + co); qkk[u] = *(const u32x4*)(base + 1024 + co);
            qe[u] = *(const u32x4*)(base + 2048 + dir * 1536 + co); qkd[u] = *(const u32x4*)(base + 2048 + dir * 1536 + 512 + co); qb[u] = *(const u32x4*)(base + 2048 + dir * 1536 + 1024 + co);
            qv[u] = base[512 + h * 64 + vrow]; }
#pragma unroll
        for (int u = 0; u < 4; ++u) { float kk[8], e[8], kd[8], bb[8], r[8];
            unpack8(qkk[u], kk); unpack8(qe[u], e); unpack8(qkd[u], kd); unpack8(qb[u], bb); unpack8(qr[u], r);
            const float vv = bf2f(qv[u]);
            float sk = 0.f;
#pragma unroll
            for (int j = 0; j < 8; ++j) sk += S[j] * kk[j];
            sk += __shfl_xor(sk, 1); sk += __shfl_xor(sk, 2); sk += __shfl_xor(sk, 4);
            float y = 0.f;
#pragma unroll
            for (int j = 0; j < 8; ++j) { S[j] = S[j] * (1.f - e[j]) - sk * bb[j] + vv * kd[j]; y += S[j] * r[j]; }
            y += __shfl_xor(y, 1); y += __shfl_xor(y, 2); y += __shfl_xor(y, 4);
            const int s = s0 + u;
            if (kq == 0 && (s >= CTXL || need_ctx)) Y[(size_t)rowof(s) * DR + h * 64 + vrow] = (bf16)f2bf(y); }
    }
#undef rowof
}

__device__ __forceinline__ void readout_pass(const Frame& F0, int l, int nrows) {
    const Frame F = phase_frame(F0); unsigned char* const ws = F.ws;
    const bf16* STR = (const bf16*)(ws + WS_STR); const bf16* Y0 = (const bf16*)(ws + WS_Y); const bf16* Y1 = Y0 + (size_t)NROW * DR; bf16* MA = (bf16*)(ws + WS_H);
    const int lane = F.lane, c = 8 * lane;
    float gw[8], gb[8], rk[8];
    {   const float* gnw = inptr(I_GNW) + l * DR + c; const float* gnb = inptr(I_GNB) + l * DR + c; const float* rkp = inptr(I_RK) + l * DR + c;
        const f32x4 a0 = *(const f32x4*)gnw, a1 = *(const f32x4*)(gnw + 4), b0 = *(const f32x4*)gnb, b1 = *(const f32x4*)(gnb + 4), r0 = *(const f32x4*)rkp, r1 = *(const f32x4*)(rkp + 4);
#pragma unroll
        for (int i = 0; i < 4; ++i) { gw[i] = a0[i]; gw[4 + i] = a1[i]; gb[i] = b0[i]; gb[4 + i] = b1[i]; rk[i] = r0[i]; rk[4 + i] = r1[i]; } }
    for (int row0 = F.gw; row0 < nrows; row0 += 2 * F.NGW) {
        u32x4 q[2][7]; bool ok[2];
#pragma unroll
        for (int u = 0; u < 2; ++u) { const int row = row0 + u * F.NGW; ok[u] = row < nrows; if (ok[u]) {
            const bf16* sr = STR + ((size_t)(row >> 4) * 8 + (lane >> 3)) * 10240 + (row & 15) * 64 + (lane & 7) * 8;
            q[u][0] = *(const u32x4*)(Y0 + (size_t)row * DR + c); q[u][1] = *(const u32x4*)(Y1 + (size_t)row * DR + c);
            q[u][2] = *(const u32x4*)sr; q[u][3] = *(const u32x4*)(sr + 1024); q[u][4] = *(const u32x4*)(sr + 3072); q[u][5] = *(const u32x4*)(sr + 5 * 1024); q[u][6] = *(const u32x4*)(sr + 8 * 1024); } }
#pragma unroll
        for (int u = 0; u < 2; ++u) if (ok[u]) { const int row = row0 + u * F.NGW;
            float ya[8], yb[8], r[8], v[8], g[8], k0[8], k1[8];
            unpack8(q[u][0], ya); unpack8(q[u][1], yb); unpack8(q[u][2], r); unpack8(q[u][3], v); unpack8(q[u][4], g); unpack8(q[u][5], k0); unpack8(q[u][6], k1);
            float s1 = 0.f, s2 = 0.f, sb = 0.f;
#pragma unroll
            for (int i = 0; i < 8; ++i) { ya[i] += yb[i]; s1 += ya[i]; s2 += ya[i] * ya[i]; sb += r[i] * (k0[i] + k1[i]) * rk[i]; }
#pragma unroll
            for (int o = 1; o < 8; o <<= 1) { s1 += __shfl_xor(s1, o); s2 += __shfl_xor(s2, o); sb += __shfl_xor(sb, o); }
            const float mu = s1 * (1.f / 64.f); const float var = fmaxf(s2 * (1.f / 64.f) - mu * mu, 0.f); const float rs = rsqrtf(var + GN_EPS);
            float o8[8];
#pragma unroll
            for (int i = 0; i < 8; ++i) o8[i] = ((ya[i] - mu) * rs * gw[i] + gb[i] + sb * v[i]) * g[i];
            *(u32x4*)(MA + (size_t)row * D + c) = (u32x4){pk2(o8[0], o8[1]), pk2(o8[2], o8[3]), pk2(o8[4], o8[5]), pk2(o8[6], o8[7])}; }
    }
}
constexpr int BLOB = 16384, SEGCH = 132, NSEG = 4, BLOB_B1_SCANS = 14;
constexpr size_t WS_BLOBA = 20 * MiB, WS_BLOBB1 = 86 * MiB, WS_BLOBB2 = 492 * MiB;
constexpr size_t WS_SCANST = 2 * MiB + 512 * 1024;
__device__ __forceinline__ unsigned char* blob_ptr(unsigned char* ws, int seg, int scan, int ci) {
    if ((seg & 1) == 0) return ws + WS_BLOBA + ((size_t)scan * SEGCH + ci) * BLOB;
    return scan < BLOB_B1_SCANS ? ws + WS_BLOBB1 + ((size_t)scan * SEGCH + ci) * BLOB : ws + WS_BLOBB2 + ((size_t)(scan - BLOB_B1_SCANS) * SEGCH + ci) * BLOB;
}
typedef short s16x4 __attribute__((ext_vector_type(4)));
__device__ __forceinline__ bf16x8 frag_lo(u32x2 x) { u32x4 t = {x.x, x.y, 0u, 0u}; return __builtin_bit_cast(bf16x8, t); }
__device__ __forceinline__ bf16x8 frag_c(const f32x4& a) { u32x4 t = {pk2(a[0], a[1]), pk2(a[2], a[3]), 0u, 0u}; return __builtin_bit_cast(bf16x8, t); }

struct PreRegs { u32x4 q[12]; };
__device__ __forceinline__ void pre_load(PreRegs& R, unsigned char* ws, int scan, int cs, int lane) {
    const int dir = scan & 1, h = (scan >> 1) & 7, b = scan >> 4; const int rfirst = scan_rowof(16 * cs, dir, b);
    const bf16* blk = (const bf16*)(ws + WS_STR) + ((size_t)(rfirst >> 4) * 8 + h) * 10240 + lane * 8;
    const int so[6] = {0, 1, 2, 4 + 3 * dir, 5 + 3 * dir, 6 + 3 * dir};
#pragma unroll
    for (int i = 0; i < 6; ++i) { R.q[2 * i] = *(const u32x4*)(blk + so[i] * 1024); R.q[2 * i + 1] = *(const u32x4*)(blk + so[i] * 1024 + 512); }
}
template <int PM>
__device__ __forceinline__ void pre_item(const Frame& F, unsigned char* ws, int scan, int cs, unsigned char* blob, PreRegs& PR, int nscan, int ncs) {
    const int dir = scan & 1, h = (scan >> 1) & 7, b = scan >> 4; const int lane = F.lane, fr = lane & 15, fq = lane >> 4;
    LAS unsigned char* L = F.lds + F.wave * 17408;
    LAS bf16* TK = (LAS bf16*)L; LAS bf16* TR = TK + 1024; LAS bf16* TKt = TR + 1024; LAS bf16* TB = TKt + 1024;
    LAS bf16* KTt = TB + 1024; LAS bf16* RTt = KTt + 1024; LAS bf16* Vt = RTt + 1024;
    LAS float* AKB = (LAS float*)(Vt + 1024);
    LAS bf16* AKK = (LAS bf16*)(AKB + 256); LAS bf16* ARK = AKK + 256; LAS bf16* ARB = ARK + 256; LAS bf16* TT = ARB + 256;
    float kh[16], bh[16];
    float pc;
    {   float r_[16], v_[16], kk_[16], lp_[16], kd_[16], bb_[16];
        LAS bf16* stg = TK;
#pragma unroll
        for (int i = 0; i < 6; ++i) { *(LAS u32x4*)(stg + i * 1024 + lane * 8) = PR.q[2 * i]; *(LAS u32x4*)(stg + i * 1024 + 512 + lane * 8) = PR.q[2 * i + 1]; }
        LDS_WAIT(); asm volatile("" ::: "memory");
        if (nscan >= 0) pre_load(PR, ws, nscan, ncs, lane);
#pragma unroll
        for (int t = 0; t < 16; ++t) { const int tm = (dir ? 15 - t : t) * 64 + lane;
            r_[t] = bf2f(stg[tm]); v_[t] = bf2f(stg[1024 + tm]); kk_[t] = bf2f(stg[2048 + tm]); lp_[t] = bf2f(stg[3072 + tm]); kd_[t] = bf2f(stg[4096 + tm]); bb_[t] = bf2f(stg[5120 + tm]); }
        LDS_WAIT(); asm volatile("" ::: "memory");
        float lp = 0.f; u32x4 kt4[2], rt4[2], v4[2];
        unsigned ktp[8], rtp[8], vp[8];
#pragma unroll
        for (int t = 0; t < 16; ++t) { const float pm1 = __expf(lp); lp += __logf(1.f - lp_[t]); lp_[t] = lp; const float p = __expf(lp), ip = __expf(-lp);
            const float kt = kk_[t] * pm1, ktl = kd_[t] * ip, btl = bb_[t] * ip, rt = r_[t] * p;
            TK[t * 64 + lane] = (bf16)f2bf(kt); TR[t * 64 + lane] = (bf16)f2bf(rt); TKt[t * 64 + lane] = (bf16)f2bf(ktl); TB[t * 64 + lane] = (bf16)f2bf(btl);
            if (t & 1) { ktp[t >> 1] |= f2bf(kt) << 16; rtp[t >> 1] |= f2bf(rt) << 16; vp[t >> 1] |= f2bf(v_[t]) << 16; }
            else { ktp[t >> 1] = f2bf(kt); rtp[t >> 1] = f2bf(rt); vp[t >> 1] = f2bf(v_[t]); } }
        kt4[0] = (u32x4){ktp[0], ktp[1], ktp[2], ktp[3]}; kt4[1] = (u32x4){ktp[4], ktp[5], ktp[6], ktp[7]};
        rt4[0] = (u32x4){rtp[0], rtp[1], rtp[2], rtp[3]}; rt4[1] = (u32x4){rtp[4], rtp[5], rtp[6], rtp[7]};
        v4[0] = (u32x4){vp[0], vp[1], vp[2], vp[3]}; v4[1] = (u32x4){vp[4], vp[5], vp[6], vp[7]};
        *(LAS u32x4*)(KTt + lane * 16) = kt4[0]; *(LAS u32x4*)(KTt + lane * 16 + 8) = kt4[1];
        *(LAS u32x4*)(RTt + lane * 16) = rt4[0]; *(LAS u32x4*)(RTt + lane * 16 + 8) = rt4[1];
        *(LAS u32x4*)(Vt + lane * 16) = v4[0]; *(LAS u32x4*)(Vt + lane * 16 + 8) = v4[1];
        pc = __expf(lp);
#pragma unroll
        for (int t = 0; t < 16; ++t) { const float e = __expf(lp - lp_[t]); kh[t] = kd_[t] * e; bh[t] = bb_[t] * e; }
    }
    LDS_WAIT(); asm volatile("" ::: "memory");
    {   f32x4 akb = {0.f, 0.f, 0.f, 0.f}, akk = akb, ark = akb, arb = akb;
#pragma unroll
        for (int s = 0; s < 2; ++s) { const int o = fr * 64 + 32 * s + 8 * fq;
            const bf16x8 fk = *(const LAS bf16x8*)(TK + o), frr = *(const LAS bf16x8*)(TR + o), fkt = *(const LAS bf16x8*)(TKt + o), fb = *(const LAS bf16x8*)(TB + o);
            akb = MFMA16(fk, fb, akb); akk = MFMA16(fk, fkt, akk); ark = MFMA16(frr, fkt, ark); arb = MFMA16(frr, fb, arb); }
#pragma unroll
        for (int reg = 0; reg < 4; ++reg) { const int t = 4 * fq + reg; const bool lo = fr < t, le = fr <= t;
            AKB[t * 16 + fr] = lo ? akb[reg] : 0.f; AKK[t * 16 + fr] = (bf16)f2bf(lo ? akk[reg] : 0.f);
            ARK[t * 16 + fr] = (bf16)f2bf(le ? ark[reg] : 0.f); ARB[t * 16 + fr] = (bf16)f2bf(le ? arb[reg] : 0.f); }
    }
    LDS_WAIT(); asm volatile("" ::: "memory");
    {   float col[16];
#pragma unroll
        for (int t = 0; t < 16; ++t) { float s_ = (t == fr) ? 1.f : 0.f;
            if (t > 0) { const f32x4 n0 = *(const LAS f32x4*)(AKB + t * 16), n1 = *(const LAS f32x4*)(AKB + t * 16 + 4), n2 = *(const LAS f32x4*)(AKB + t * 16 + 8), n3 = *(const LAS f32x4*)(AKB + t * 16 + 12);
                const float nn[16] = {n0[0], n0[1], n0[2], n0[3], n1[0], n1[1], n1[2], n1[3], n2[0], n2[1], n2[2], n2[3], n3[0], n3[1], n3[2], n3[3]};
#pragma unroll
                for (int i = 0; i < 16; ++i) if (i < t) s_ -= nn[i] * col[i]; }
            col[t] = s_; TT[t * 16 + fr] = (bf16)f2bf(s_); }
    }
    LDS_WAIT(); asm volatile("" ::: "memory");
    f32x4 Wc[4], Rqc[4], U0c[4], Y0c[4];
    {   const bf16x8 aT = frag_lo(*(const LAS u32x2*)(TT + fr * 16 + 4 * fq)), aKK = frag_lo(*(const LAS u32x2*)(AKK + fr * 16 + 4 * fq)), aRK = frag_lo(*(const LAS u32x2*)(ARK + fr * 16 + 4 * fq));
        u32x2 nb = *(const LAS u32x2*)(ARB + fr * 16 + 4 * fq); nb.x ^= 0x80008000u; nb.y ^= 0x80008000u; const bf16x8 aRBn = frag_lo(nb);
        const f32x4 z4 = {0.f, 0.f, 0.f, 0.f};
#pragma unroll
        for (int nt = 0; nt < 4; ++nt) { const int o = (16 * nt + fr) * 16 + 4 * fq;
            const bf16x8 bK = frag_lo(*(const LAS u32x2*)(KTt + o)), bV = frag_lo(*(const LAS u32x2*)(Vt + o));
            float ri[4]; unpack4(*(const LAS u32x2*)(RTt + o), ri);
            Wc[nt] = MFMA16(aT, bK, z4); const f32x4 Zn = MFMA16(aKK, bV, z4);
            U0c[nt] = MFMA16(aT, frag_c(Zn), z4);
            Rqc[nt] = MFMA16(aRBn, frag_c(Wc[nt]), ((f32x4){ri[0], ri[1], ri[2], ri[3]}));
            Y0c[nt] = MFMA16(aRK, bV, z4); Y0c[nt] = MFMA16(aRBn, frag_c(U0c[nt]), Y0c[nt]); }
    }
    LDS_WAIT(); asm volatile("" ::: "memory");

#pragma unroll
    for (int nt = 0; nt < 4; ++nt) { const u32x2 vv = *(const LAS u32x2*)(Vt + (16 * nt + fr) * 16 + 4 * fq);
        *(u32x2*)(blob + 8192 + nt * 2048 + 1024 + lane * 8) = vv;
        u32x2 u0 = {pk2(U0c[nt][0], U0c[nt][1]), pk2(U0c[nt][2], U0c[nt][3])}, y0 = {pk2(Y0c[nt][0], Y0c[nt][1]), pk2(Y0c[nt][2], Y0c[nt][3])};
        *(u32x2*)(blob + 8192 + nt * 2048 + lane * 8) = u0; *(u32x2*)(blob + 8192 + nt * 2048 + 512 + lane * 8) = y0;
        *(float*)(blob + 8192 + nt * 2048 + 1536 + lane * 4) = pc; }
    LAS bf16* WT = TK; LAS bf16* RQT = TR; LAS bf16* BHt = TKt; LAS bf16* KHt = TB;
#pragma unroll
    for (int nt = 0; nt < 4; ++nt)
#pragma unroll
        for (int reg = 0; reg < 4; ++reg) { WT[(4 * fq + reg) * 64 + 16 * nt + fr] = (bf16)f2bf(Wc[nt][reg]); RQT[(4 * fq + reg) * 64 + 16 * nt + fr] = (bf16)f2bf(Rqc[nt][reg]); }
    {   u32x4 a, c, d, e;
        a = (u32x4){pk2(bh[0], bh[1]), pk2(bh[2], bh[3]), pk2(bh[4], bh[5]), pk2(bh[6], bh[7])}; c = (u32x4){pk2(bh[8], bh[9]), pk2(bh[10], bh[11]), pk2(bh[12], bh[13]), pk2(bh[14], bh[15])};
        d = (u32x4){pk2(kh[0], kh[1]), pk2(kh[2], kh[3]), pk2(kh[4], kh[5]), pk2(kh[6], kh[7])}; e = (u32x4){pk2(kh[8], kh[9]), pk2(kh[10], kh[11]), pk2(kh[12], kh[13]), pk2(kh[14], kh[15])};
        *(LAS u32x4*)(BHt + lane * 16) = a; *(LAS u32x4*)(BHt + lane * 16 + 8) = c; *(LAS u32x4*)(KHt + lane * 16) = d; *(LAS u32x4*)(KHt + lane * 16 + 8) = e; }
    LDS_WAIT(); asm volatile("" ::: "memory");
#pragma unroll
    for (int s = 0; s < 2; ++s) { const int o = fr * 64 + 32 * s + 4 * fq;
        const u32x2 w0 = *(const LAS u32x2*)(WT + o), w1 = *(const LAS u32x2*)(WT + o + 16), q0 = *(const LAS u32x2*)(RQT + o), q1 = *(const LAS u32x2*)(RQT + o + 16);
        *(u32x4*)(blob + (0 * 2 + s) * 1024 + lane * 16) = (u32x4){w0.x, w0.y, w1.x, w1.y};
        *(u32x4*)(blob + (1 * 2 + s) * 1024 + lane * 16) = (u32x4){q0.x, q0.y, q1.x, q1.y}; }
#pragma unroll
    for (int mt = 0; mt < 4; ++mt) { const int o = (16 * mt + fr) * 16 + 4 * fq; const u32x2 bb = *(const LAS u32x2*)(BHt + o), kk = *(const LAS u32x2*)(KHt + o);
        *(u32x4*)(blob + 4096 + mt * 1024 + lane * 16) = (u32x4){bb.x ^ 0x80008000u, bb.y ^ 0x80008000u, kk.x, kk.y}; }
    LDS_WAIT(); asm volatile("" ::: "memory");
}

__device__ __forceinline__ void pre_phase(const Frame& F0, int seg, int b_lo) {
    const Frame F = phase_frame(F0); unsigned char* const ws = F.ws;
    if ((int)blockIdx.x < b_lo) return;
    const int nwv = (F.G - b_lo) * NWAVES;
    PreRegs R;
    int it = ((int)blockIdx.x - b_lo) * NWAVES + F.wave; if (it >= 32 * SEGCH) return;
    pre_load(R, ws, it & 31, seg * SEGCH + (it >> 5), F.lane);
    for (; it < 32 * SEGCH; it += nwv) { const int nx = it + nwv; const bool hn = nx < 32 * SEGCH;
        pre_item<0>(F, ws, it & 31, seg * SEGCH + (it >> 5), blob_ptr(ws, seg, it & 31, it >> 5), R, hn ? (nx & 31) : -1, seg * SEGCH + (nx >> 5)); }
}

constexpr int SQ_SLOT = 10240, SQ_R = 12, SQ_D = 8;
template <int MODE>
__device__ __forceinline__ void seq_item(const Frame& F0, int item, int seg, bool need_ctx) {
    const Frame F = phase_frame(F0); unsigned char* const ws = F.ws;
    const int scan = item >> 2, vb = item & 3, dir = scan & 1, h = (scan >> 1) & 7, b = scan >> 4; const int lane = F.lane, fr = lane & 15, fq = lane >> 4, w = F.wave;
    const unsigned char* blob = blob_ptr(ws, seg, scan, 0);
    LAS unsigned char* ring = F.lds;
    __syncthreads();
    const int p0 = 2 * (w - 1);
    const unsigned goff0 = (p0 < 8 ? p0 * 1024 : 8192 + vb * 2048 + (p0 - 8) * 1024) + lane * 16, goff1 = (p0 + 1 < 8 ? (p0 + 1) * 1024 : 8192 + vb * 2048 + (p0 + 1 - 8) * 1024) + lane * 16;
#define SQ_ISSUE(c) do { const unsigned char* g_ = blob + (size_t)(c) * BLOB; LAS unsigned char* s_ = ring + ((c) % SQ_R) * SQ_SLOT + p0 * 1024; \
        __builtin_amdgcn_global_load_lds((const unsigned*)(g_ + goff0), (LAS unsigned*)(s_), 16, 0, 0); \
        __builtin_amdgcn_global_load_lds((const unsigned*)(g_ + goff1), (LAS unsigned*)(s_ + 1024), 16, 0, 0); } while (0)
    const bool loader = (w >= 1 && w <= 5) && MODE != 2;
    if (loader) { for (int c = 0; c < SQ_D; ++c) SQ_ISSUE(c); }
    bf16* Y = (bf16*)(ws + WS_Y) + (size_t)dir * NROW * DR + h * 64 + 16 * vb + fr;
    float* st = (float*)(ws + WS_SCANST) + (size_t)item * 1024 + lane * 4;
    f32x4 M[4];
#pragma unroll
    for (int mt = 0; mt < 4; ++mt) M[mt] = (seg == 0 || w != 0) ? (f32x4){0.f, 0.f, 0.f, 0.f} : *(const f32x4*)(st + mt * 256);
    const f32x4 z4 = {0.f, 0.f, 0.f, 0.f};
    LAS unsigned char* mb = ring + SQ_R * SQ_SLOT;
    struct SQ { bf16x8 a1[2], a2[4]; f32x4 pc[4]; u32x2 u0, vv; };
#define SQ_READ(R, c) do { const LAS unsigned char* sl_ = ring + ((c) % SQ_R) * SQ_SLOT; _Pragma("unroll") for (int i = 0; i < 4; ++i) { \
        R.a2[i] = *(const LAS bf16x8*)(sl_ + 4096 + i * 1024 + lane * 16); R.pc[i] = *(const LAS f32x4*)(sl_ + 8192 + 1536 + (16 * i + 4 * fq) * 4); } \
        R.a1[0] = *(const LAS bf16x8*)(sl_ + lane * 16); R.a1[1] = *(const LAS bf16x8*)(sl_ + 1024 + lane * 16); \
        R.u0 = *(const LAS u32x2*)(sl_ + 8192 + lane * 8); R.vv = *(const LAS u32x2*)(sl_ + 8192 + 1024 + lane * 8); } while (0)
#define SQ_STEP(R, c, RN, cn) do { \
        if ((cn) < SEGCH) SQ_READ(RN, cn); \
        const u32x4 t0 = {pk2(M[0][0], M[0][1]), pk2(M[0][2], M[0][3]), pk2(M[1][0], M[1][1]), pk2(M[1][2], M[1][3])}; \
        const u32x4 t1 = {pk2(M[2][0], M[2][1]), pk2(M[2][2], M[2][3]), pk2(M[3][0], M[3][1]), pk2(M[3][2], M[3][3])}; \
        *(LAS u32x4*)(mb + ((c) & 1) * 2048 + lane * 16) = t0; *(LAS u32x4*)(mb + ((c) & 1) * 2048 + 1024 + lane * 16) = t1; \
        const bf16x8 b0 = __builtin_bit_cast(bf16x8, t0), b1 = __builtin_bit_cast(bf16x8, t1); \
        f32x4 X0 = MFMA16(R.a1[0], b0, z4); X0 = MFMA16(R.a1[1], b1, X0); \
        float u0[4]; unpack4(R.u0, u0); \
        const u32x4 tb = {pk2(X0[0] + u0[0], X0[1] + u0[1]), pk2(X0[2] + u0[2], X0[3] + u0[3]), R.vv.x, R.vv.y}; const bf16x8 bB = __builtin_bit_cast(bf16x8, tb); \
        _Pragma("unroll") for (int mt = 0; mt < 4; ++mt) M[mt] = MFMA16(R.a2[mt], bB, R.pc[mt] * M[mt]); \
        asm volatile("s_waitcnt lgkmcnt(0)" ::: "memory"); } while (0)
    const long ystep = dir ? -(long)DR : (long)DR;
#define SQ_YSTEP(c) do { const int cs_ = seg * SEGCH + (c); if (MODE == 0 && (need_ctx || cs_ >= 16)) { const LAS unsigned char* sl_ = ring + ((c) % SQ_R) * SQ_SLOT; \
        const bf16x8 q0 = *(const LAS bf16x8*)(sl_ + 2048 + lane * 16), q1 = *(const LAS bf16x8*)(sl_ + 3072 + lane * 16); \
        const bf16x8 b0 = *(const LAS bf16x8*)(mb + ((c) & 1) * 2048 + lane * 16), b1 = *(const LAS bf16x8*)(mb + ((c) & 1) * 2048 + 1024 + lane * 16); \
        float y0[4]; unpack4(*(const LAS u32x2*)(sl_ + 8192 + 512 + lane * 8), y0); \
        f32x4 X1 = MFMA16(q0, b0, z4); X1 = MFMA16(q1, b1, X1); \
        bf16* yp = Y + (size_t)scan_rowof(16 * cs_ + 4 * fq, dir, b) * DR; \
        yp[0] = (bf16)f2bf(X1[0] + y0[0]); yp[ystep] = (bf16)f2bf(X1[1] + y0[1]); yp[2 * ystep] = (bf16)f2bf(X1[2] + y0[2]); yp[3 * ystep] = (bf16)f2bf(X1[3] + y0[3]); \
        asm volatile("s_waitcnt lgkmcnt(0)" ::: "memory"); } } while (0)
#define SQ_LOADER(c) do { if (loader) { __builtin_amdgcn_s_sleep(3); if ((c) + SQ_D < SEGCH) { SQ_ISSUE((c) + SQ_D); asm volatile("s_waitcnt vmcnt(12)" ::: "memory"); } else asm volatile("s_waitcnt vmcnt(0)" ::: "memory"); } \
        __builtin_amdgcn_s_barrier(); asm volatile("" ::: "memory"); } while (0)
    const bool stw = (w == 0 && MODE != 1), yw = (w == 6 && MODE != 1);
    SQ Ra, Rb, Rc;
    SQ_LOADER(0);
    if (stw) { SQ_READ(Ra, 0); SQ_READ(Rb, 1); }
    for (int c = 0; c < SEGCH; c += 3) {
        SQ_LOADER(c + 1);
        if (stw) SQ_STEP(Ra, c, Rc, c + 2);
        if (yw && c > 0) SQ_YSTEP(c - 1);
        SQ_LOADER(c + 2);
        if (stw) SQ_STEP(Rb, c + 1, Ra, c + 3);
        if (yw) SQ_YSTEP(c);
        SQ_LOADER(c + 3);
        if (stw) SQ_STEP(Rc, c + 2, Rb, c + 4);
        if (yw) SQ_YSTEP(c + 1);
    }
    __builtin_amdgcn_s_barrier(); asm volatile("" ::: "memory");
    if (yw) SQ_YSTEP(SEGCH - 1);
#undef SQ_READ
#undef SQ_STEP
#undef SQ_YSTEP
#undef SQ_LOADER
#undef SQ_ISSUE
    if (MODE >= 2 && w == 0 && M[0][0] + M[1][1] + M[2][2] + M[3][3] == 12345.678f) st[0] = M[0][0];
    if (MODE == 0 && w == 0 && seg + 1 < NSEG) {
#pragma unroll
        for (int mt = 0; mt < 4; ++mt) *(f32x4*)(st + mt * 256) = M[mt]; }
    __syncthreads();
}

namespace pg8 {
struct EpiStoreBf16 {
    static constexpr bool PERM = true, AFTER_DRAIN = false;
    bf16_t* O; int ldc; int pn_mask;
    __device__ __forceinline__ void operator()(const f32x4 (&acc)[2][2][4][2], const Unit& u, int wr, int wc, int fr, int fq) const {
        const int row0 = u.pm * BM + wr * 64 + fr; const int col0 = (u.pn & pn_mask) * BM + wc * 32 + 8 * fq;
#pragma unroll
        for (int ai = 0; ai < 2; ++ai)
#pragma unroll
            for (int m = 0; m < 4; ++m) { bf16_t* rowp = O + (size_t)(row0 + ai * HALF + m * 16) * ldc + col0;
#pragma unroll
                for (int bj = 0; bj < 2; ++bj) { const f32x4 v0 = acc[ai][bj][m][0], v1 = acc[ai][bj][m][1];
                    u32x4 w; w.x = cvt_pk_bf16(v0[0], v0[1]); w.y = cvt_pk_bf16(v0[2], v0[3]); w.z = cvt_pk_bf16(v1[0], v1[1]); w.w = cvt_pk_bf16(v1[2], v1[3]);
                    *(u32x4*)(rowp + bj * HALF) = w; } }
    }
};
struct EpiSwiGLU {
    static constexpr bool PERM = true, AFTER_DRAIN = false;
    bf16_t* O;
    __device__ __forceinline__ void operator()(const f32x4 (&acc)[2][2][4][2], const Unit& u, int wr, int wc, int fr, int fq) const {
        const int row0 = u.pm * BM + wr * 64 + fr; const int col0 = ((u.pn & 3) * BM + wc * 32 + 8 * fq) >> 1;
#pragma unroll
        for (int ai = 0; ai < 2; ++ai)
#pragma unroll
            for (int m = 0; m < 4; ++m) { bf16_t* rowp = O + (size_t)(row0 + ai * HALF + m * 16) * 512 + col0;
#pragma unroll
                for (int bj = 0; bj < 2; ++bj) { const f32x4 g = acc[ai][bj][m][0], up = acc[ai][bj][m][1]; float a[4];
#pragma unroll
                    for (int i = 0; i < 4; ++i) a[i] = g[i] / (1.f + __expf(-g[i])) * up[i];
                    unsigned long long w = (unsigned long long)cvt_pk_bf16(a[0], a[1]) | ((unsigned long long)cvt_pk_bf16(a[2], a[3]) << 32);
                    *(unsigned long long*)(rowp + bj * (HALF / 2)) = w; } }
    }
};
struct EpiResidual {
    static constexpr bool PERM = false, AFTER_DRAIN = false;
    const float* xlat; const float* xctx;
    float* out; const float* g1;
    __device__ __forceinline__ void operator()(const f32x4 (&acc)[2][2][4][2], const Unit& u, int wr, int wc, int fr, int fq) const {
        const int rowt = u.pm * BM; const int mr = rowt < 16384 ? (rowt >> 13) : 2;
        const float* base = rowt < 16384 ? xlat + (size_t)rowt * 1024 : xctx + (size_t)(rowt - 16384) * 1024;
        const int col0 = u.pn * BM + wc * 32 + 4 * fq;
        f32x4 gv[2][2];
#pragma unroll
        for (int bj = 0; bj < 2; ++bj)
#pragma unroll
            for (int n = 0; n < 2; ++n) gv[bj][n] = *(const f32x4*)(g1 + (size_t)mr * 6144 + col0 + bj * HALF + n * 16);
#pragma unroll
        for (int ai = 0; ai < 2; ++ai)
#pragma unroll
            for (int m = 0; m < 4; ++m) { const int rl = ai * HALF + wr * 64 + m * 16 + fr;
#pragma unroll
                for (int bj = 0; bj < 2; ++bj)
#pragma unroll
                    for (int n = 0; n < 2; ++n) { const size_t off = (size_t)rl * 1024 + col0 + bj * HALF + n * 16;
                        const f32x4 xo = *(const f32x4*)(base + off);
                        *(f32x4*)(out + (size_t)rowt * 1024 + off) = xo + gv[bj][n] * acc[ai][bj][m][n]; } }
    }
};
struct MoeOrder {
    const int* tile_e; int ntiles, G, c;
    __device__ bool next(int i, Unit& u) const { const long L = (long)i * G + c; if (L >= 4L * ntiles) return false; const int pm = (int)(L >> 2); u.pm = pm; u.pn = tile_e[pm] * 4 + (int)(L & 3); return true; }
    __device__ __forceinline__ void a_ready(const Unit&) const {}
    __device__ __forceinline__ void done(const Unit&) const {}
};
}

__device__ __forceinline__ void expert_convert(const Frame& F0, int l, int b_lo) {
    const Frame F = phase_frame(F0); unsigned char* const ws = F.ws;
    if ((int)blockIdx.x < b_lo) return;
    const int nwv = (F.G - b_lo) * NWAVES, myw = ((int)blockIdx.x - b_lo) * NWAVES + F.wave;
    LAS float* scr = (LAS float*)(F.lds + F.wave * 16384);
    bf16* wgu = (bf16*)(ws + WS_WGU_T); bf16* wd = (bf16*)(ws + WS_WD_T);
    constexpr int I_G = 16 * 16, I_D = 8 * 32;
    constexpr int NIT = NEXP * (2 * I_G + I_D);
    const float* p_eg = inptr(I_EG); const float* p_eu = inptr(I_EU); const float* p_ed = inptr(I_ED);
    for (int it = myw; it < NIT; it += nwv) { const int e = it / (2 * I_G + I_D); int r = it % (2 * I_G + I_D);
        if (r < I_G) { transpose_item(p_eg + ((size_t)l * NEXP + e) * D * DEXP, DEXP, (r >> 4) * 64, (r & 15) * 32, wgu, D, RmGU{e * 1024}, scr, F.lane); continue; } r -= I_G;
        if (r < I_G) { transpose_item(p_eu + ((size_t)l * NEXP + e) * D * DEXP, DEXP, (r >> 4) * 64, (r & 15) * 32, wgu, D, RmGU{e * 1024 + 4}, scr, F.lane); continue; } r -= I_G;
        transpose_item(p_ed + ((size_t)l * NEXP + e) * DEXP * D, D, (r >> 5) * 64, (r & 31) * 32, wd, DEXP, RmId{e * 1024}, scr, F.lane);
    }
}

__device__ __forceinline__ void router_pass(const Frame& F0, int l, int nrows, int cnt_off = 0) {
    const Frame F = phase_frame(F0); unsigned char* const ws = F.ws;
    constexpr int HP = 1028;
    LAS float* msh = (LAS float*)F.lds; LAS float* msc = msh + 3072; LAS float* hrow = msc + 3072;
    LAS float* part = hrow + 16 * HP;
    LAS float* lgs = part + 8 * 16 * 48;
    LAS unsigned* lcnt = (LAS unsigned*)(lgs + 16 * 40);
    if (F0.tid < 64) lcnt[F0.tid] = 0u;
    __syncthreads();
    mod_to_lds(F, l, 3, msh, false); mod_to_lds(F, l, 4, msc, false); __syncthreads();
    const float* X = (const float*)(ws + WS_X); bf16* H = (bf16*)(ws + WS_H);
    const float* rgw = inptr(I_RGW) + (size_t)l * D * 4; const float* rew = inptr(I_REW) + (size_t)l * D * NEXP;
    const float* rgb = inptr(I_RGB) + l * 4; const float* reb = inptr(I_REB) + l * NEXP;
    int* rt_e = (int*)(ws + WS_ROUTE + RT_E); int* rt_pos = (int*)(ws + WS_ROUTE + RT_POS); float* rt_gate = (float*)(ws + WS_ROUTE + RT_GATE);
    unsigned* cnt = (unsigned*)(ws + WS_CTL) + CW_CNT + 64 * l + cnt_off;
    const int lane = F.lane, w = F.wave, fr = lane & 15, fq = lane >> 4; const float* n2g = inptr(I_N2G) + l * D;
    float bw[32][3];
#pragma unroll
    for (int ks = 0; ks < 32; ++ks) { const int k = 128 * w + 4 * ks + fq;
        bw[ks][0] = rew[(size_t)k * 32 + fr]; bw[ks][1] = rew[(size_t)k * 32 + 16 + fr]; bw[ks][2] = fr < 4 ? rgw[(size_t)k * 4 + fr] : 0.f; }
    const int ntiles = nrows >> 4;
    f32x4 pv[2][4];
    if (F.vcu < ntiles) {
#pragma unroll
        for (int rr = 0; rr < 2; ++rr)
#pragma unroll
            for (int j = 0; j < 4; ++j) pv[rr][j] = *(const f32x4*)(X + (size_t)(F.vcu * 16 + 2 * w + rr) * D + 4 * lane + 256 * j); }
    for (int gi = F.vcu; gi < ntiles; gi += F.G) {
#pragma unroll
        for (int rr = 0; rr < 2; ++rr) { const int r = 2 * w + rr, row = gi * 16 + r; f32x4 v[4];
#pragma unroll
            for (int j = 0; j < 4; ++j) v[j] = pv[rr][j];
            const int mr = modrow(row);
            norm_mod_row(v, n2g, msc + mr * 1024, msh + mr * 1024, H + (size_t)row * D, lane);
#pragma unroll
            for (int j = 0; j < 4; ++j) *(LAS f32x4*)(hrow + r * HP + 4 * lane + 256 * j) = v[j]; }
        if (gi + F.G < ntiles) {
#pragma unroll
            for (int rr = 0; rr < 2; ++rr)
#pragma unroll
                for (int j = 0; j < 4; ++j) pv[rr][j] = *(const f32x4*)(X + (size_t)((gi + F.G) * 16 + 2 * w + rr) * D + 4 * lane + 256 * j); }
        __syncthreads();
        {   f32x4 acc[3] = {{0.f, 0.f, 0.f, 0.f}, {0.f, 0.f, 0.f, 0.f}, {0.f, 0.f, 0.f, 0.f}};
#pragma unroll
            for (int ks = 0; ks < 32; ++ks) { const float a = hrow[fr * HP + 128 * w + 4 * ks + fq];
#pragma unroll
                for (int nt = 0; nt < 3; ++nt) acc[nt] = __builtin_amdgcn_mfma_f32_16x16x4f32(a, bw[ks][nt], acc[nt], 0, 0, 0); }
#pragma unroll
            for (int nt = 0; nt < 3; ++nt)
#pragma unroll
                for (int reg = 0; reg < 4; ++reg) part[(w * 16 + 4 * fq + reg) * 48 + 16 * nt + fr] = acc[nt][reg]; }
        __syncthreads();
        for (int idx = F.tid; idx < 16 * 36; idx += NTHR) { const int r = idx / 36, n = idx % 36; float s_ = 0.f;
#pragma unroll
            for (int ww = 0; ww < 8; ++ww) s_ += part[(ww * 16 + r) * 48 + n];
            if (n < 32) lgs[r * 40 + 4 + n] = s_ + reb[n]; else lgs[r * 40 + n - 32] = s_ + rgb[n - 32]; }
        __syncthreads();
        if (F.tid < 16) { const int rr = gi * 16 + F.tid; const LAS float* lp = lgs + F.tid * 40;
            int grp = 0; float mx = lp[0];
#pragma unroll
            for (int g = 1; g < 4; ++g) if (lp[g] > mx) { mx = lp[g]; grp = g; }
            float den = 0.f;
#pragma unroll
            for (int g = 0; g < 4; ++g) den += __expf(lp[g] - mx);
            const float pg_top = 1.f / den; const LAS float* sel = lp + 4 + grp * 8;
            int i0 = 0; float l0 = sel[0];
#pragma unroll
            for (int q = 1; q < 8; ++q) if (sel[q] > l0) { l0 = sel[q]; i0 = q; }
            int i1 = -1; float l1 = -3.0e38f;
#pragma unroll
            for (int q = 0; q < 8; ++q) if (q != i0 && sel[q] > l1) { l1 = sel[q]; i1 = q; }
            const float e1 = __expf(l1 - l0); const float w0 = pg_top / (1.f + e1), w1 = pg_top * e1 / (1.f + e1);
            const int ea = grp * 8 + i0, eb = grp * 8 + i1;
            const unsigned pa = atomicAdd((unsigned*)(lcnt + ea), 1u), pb = atomicAdd((unsigned*)(lcnt + eb), 1u);
            rt_e[2 * rr] = ea; rt_e[2 * rr + 1] = eb; rt_pos[2 * rr] = (int)pa; rt_pos[2 * rr + 1] = (int)pb; rt_gate[2 * rr] = w0; rt_gate[2 * rr + 1] = w1; }
    }
    __syncthreads();
    if (F.tid < 32) lcnt[32 + F.tid] = lcnt[F.tid] ? atomicAdd(cnt + F.tid, lcnt[F.tid]) : 0u;
    __syncthreads();
    if (F.tid < 16) for (int gi = F.vcu; gi < ntiles; gi += F.G) { const int rr = gi * 16 + F.tid;
        rt_pos[2 * rr] += (int)lcnt[32 + rt_e[2 * rr]]; rt_pos[2 * rr + 1] += (int)lcnt[32 + rt_e[2 * rr + 1]]; }
}

__device__ __forceinline__ void gather_pass(const Frame& F0, int l, int nrows) {
    const Frame F = phase_frame(F0); unsigned char* const ws = F.ws;
    LAS int* off = (LAS int*)F.lds;
    const unsigned* cnt = (const unsigned*)(ws + WS_CTL) + CW_CNT + 64 * l;
    int* tile_e = (int*)(ws + WS_ROUTE + RT_TILE); int* ntl = (int*)(ws + WS_ROUTE + RT_NT);
    __syncthreads();
    if (F.tid < NEXP) off[32 + F.tid] = (int)__hip_atomic_load(cnt + F.tid, __ATOMIC_RELAXED, __HIP_MEMORY_SCOPE_AGENT);
    __syncthreads();
    if (F.tid == 0) { int o = 0;
#pragma nounroll
        for (int e = 0; e < NEXP; ++e) { const int c = off[32 + e]; const int nt = (c + 255) >> 8; off[e] = o;
            if (blockIdx.x == 0) {
#pragma nounroll
                for (int t = 0; t < nt; ++t) tile_e[(o >> 8) + t] = e; }
            o += nt << 8; }
        if (blockIdx.x == 0) ntl[0] = o >> 8; }
    __syncthreads();
    const int* rt_e = (const int*)(ws + WS_ROUTE + RT_E); const int* rt_pos = (const int*)(ws + WS_ROUTE + RT_POS); int* rt_slot = (int*)(ws + WS_ROUTE + RT_SLOT);
    const bf16* H = (const bf16*)(ws + WS_H); bf16* Xs = (bf16*)(ws + WS_XS);
    for (int it0 = F.gw * 4; it0 < 2 * nrows; it0 += F.NGW * 4) { int slot[4]; u32x4 a[4], b2[4];
#pragma unroll
        for (int u = 0; u < 4; ++u) { const int it = it0 + u; slot[u] = it < 2 * nrows ? off[rt_e[it]] + rt_pos[it] : -1; }
#pragma unroll
        for (int u = 0; u < 4; ++u) if (slot[u] >= 0) { const u32x4* s = (const u32x4*)(H + (size_t)((it0 + u) >> 1) * D); a[u] = s[F.lane]; b2[u] = s[64 + F.lane]; }
#pragma unroll
        for (int u = 0; u < 4; ++u) if (slot[u] >= 0) { if (F.lane == 0) rt_slot[it0 + u] = slot[u]; u32x4* d = (u32x4*)(Xs + (size_t)slot[u] * D); d[F.lane] = a[u]; d[64 + F.lane] = b2[u]; }
    }
}

template <bool DRY>
__device__ __forceinline__ void combine_pass(const Frame& F0, int l, int nrows) {
    const Frame F = phase_frame(F0); unsigned char* const ws = F.ws;
    LAS float* mg2 = (LAS float*)F.lds; LAS float* msh = mg2 + 3072; LAS float* msc = msh + 3072;
    const bool last = (l == DEPTH - 1);
    __syncthreads();
    mod_to_lds(F, l, 5, mg2, false); if (!last) { mod_to_lds(F, l + 1, 0, msh, false); mod_to_lds(F, l + 1, 1, msc, false); }
    __syncthreads();
    float* X = (float*)(ws + WS_X); bf16* H = (bf16*)(ws + WS_H); const bf16* Ys = (const bf16*)(ws + WS_XS);
    const int* rt_slot = (const int*)(ws + WS_ROUTE + RT_SLOT); const float* rt_gate = (const float*)(ws + WS_ROUTE + RT_GATE);
    const int lane = F.lane; const float* n1g = inptr(I_N1G) + (last ? 0 : (l + 1) * D); const float* fgp = inptr(I_FG);
    for (int row0 = F.gw; row0 < nrows; row0 += 2 * F.NGW) {
        int s0[2], s1[2]; float w0[2], w1[2]; bool ok[2]; u32x2 ya[2][4], yb[2][4]; f32x4 xo[2][4];
#pragma unroll
        for (int u = 0; u < 2; ++u) { const int row = row0 + u * F.NGW; ok[u] = row < nrows; if (ok[u]) { s0[u] = rt_slot[2 * row]; s1[u] = rt_slot[2 * row + 1]; w0[u] = rt_gate[2 * row]; w1[u] = rt_gate[2 * row + 1]; } }
#pragma unroll
        for (int u = 0; u < 2; ++u) if (ok[u]) { const int row = row0 + u * F.NGW;
#pragma unroll
            for (int j = 0; j < 4; ++j) { const int c = 4 * lane + 256 * j; ya[u][j] = *(const u32x2*)(Ys + (size_t)s0[u] * D + c); yb[u][j] = *(const u32x2*)(Ys + (size_t)s1[u] * D + c); xo[u][j] = *(const f32x4*)(X + (size_t)row * D + c); } }
#pragma unroll
        for (int u = 0; u < 2; ++u) if (ok[u]) { const int row = row0 + u * F.NGW; const int mr = modrow(row); f32x4 v[4];
#pragma unroll
            for (int j = 0; j < 4; ++j) { const int c = 4 * lane + 256 * j; float a[4], b[4]; unpack4(ya[u][j], a); unpack4(yb[u][j], b);
                const f32x4 g2 = *(const LAS f32x4*)(mg2 + mr * 1024 + c);
                f32x4 y; y.x = w0[u] * a[0] + w1[u] * b[0]; y.y = w0[u] * a[1] + w1[u] * b[1]; y.z = w0[u] * a[2] + w1[u] * b[2]; y.w = w0[u] * a[3] + w1[u] * b[3];
                v[j] = xo[u][j] + g2 * y; }
            if (DRY) { asm volatile("" :: "v"(v[0].x + v[1].y + v[2].z + v[3].w)); }
            else if (!last) {
#pragma unroll
                for (int j = 0; j < 4; ++j) *(f32x4*)(X + (size_t)row * D + 4 * lane + 256 * j) = v[j];
                norm_mod_row(v, n1g, msc + mr * 1024, msh + mr * 1024, H + (size_t)row * D, lane);
            } else { float s = 0.f;
#pragma unroll
                for (int j = 0; j < 4; ++j) s += (v[j].x * v[j].x + v[j].y * v[j].y) + (v[j].z * v[j].z + v[j].w * v[j].w);
                const float rs = rsqrtf(wave_sum(s) * (1.f / D) + RMS_EPS);
#pragma unroll
                for (int j = 0; j < 4; ++j) { const int c = 4 * lane + 256 * j; const f32x4 g = *(const f32x4*)(fgp + c); *(f32x4*)(F.out + (size_t)row * D + c) = v[j] * rs * g; } } }
    }
}
__global__ void __launch_bounds__(NTHR, 2) fwd_megakernel(Params prm) {
    extern __shared__ __attribute__((aligned(16))) unsigned char lds_raw[];
    Frame F;
    F.lds = (LAS unsigned char*)lds_raw;
    F.tid = threadIdx.x; F.lane = F.tid & 63; F.wave = __builtin_amdgcn_readfirstlane(F.tid >> 6);
    F.G = gridDim.x; { const int bx = blockIdx.x; F.vcu = (F.G % 8 == 0) ? (bx % 8) * (F.G / 8) + bx / 8 : bx; }
    F.gw = F.vcu * NWAVES + F.wave; F.NGW = F.G * NWAVES;
    F.out = prm.out; F.ws = prm.ws;
    for (int u = F.tid; u < (LDS_BYTES - LDSCTL_OFF) / 4; u += NTHR) ((LAS unsigned*)(F.lds + LDSCTL_OFF))[u] = 0u;
    __syncthreads();
    (void)xcd_barrier_post((unsigned*)(F.ws + WS_CTL) + CW_BAR, (volatile LAS unsigned*)(F.lds + MISC_OFF) + 8);
#define GRID_BAR() do { XcdBarrier bar_; bar_.bar = (unsigned*)(opaque(F.ws) + WS_CTL) + CW_BAR; bar_.x = xb_xcc_id(); bar_.st = (volatile LAS unsigned*)(F.lds + MISC_OFF) + 8; xcd_barrier(bar_); } while (0)

#ifndef PHMASK
#define PHMASK 0xffff
#endif
#define PH(k) ((PHMASK >> (k)) & 1)
#ifndef PROBE_MASK
#define PROBE_MASK 0
#endif
#define REP(k) _Pragma("nounroll") for (int rep_ = 0; rep_ < ((PROBE_MASK >> (k)) & 1) + 1; ++rep_)
    if (PH(0)) p0_prologue(F);
#if USE_CG_SYNC
    cg::this_grid().sync();
#else
    GRID_BAR();
#endif
    if (PH(1)) p0b_norm1(F);
    GRID_BAR();

#if BAR_PROBE
    for (int i_ = 0; i_ < 20; ++i_) GRID_BAR();
#endif
    for (int l = 0; l < DEPTH; ++l) {
        const bool need_ctx = (l == 0); const int nrows = need_ctx ? NROW : NLAT;
#define WSO Fp.ws
        REP(2) {
            const Frame Fp = phase_frame(F); unsigned char* const ws = WSO; bf16* Hb = (bf16*)(ws + WS_H); bf16* Pb = (bf16*)(ws + WS_P);
            pg8::Gemm g{Hb, (const bf16*)(ws + WS_WIN_T) + (size_t)l * NP * D, NROW, NP, D}; pg8::StaticOrder S; S.init(NROW, NP, Fp.G, (int)blockIdx.x);
            pg8::EpiStoreBf16 E{Pb, NP, 0xffff};
            pg8::gemm_phase<pg8::EpiStoreBf16, pg8::StaticOrder, true, true>(F.lds, g, S, E);
        }
        GRID_BAR();
        {
            const Frame Fp = phase_frame(F); unsigned char* const ws = WSO; bf16* Pb = (bf16*)(ws + WS_P);
            REP(14) for (int it = blockIdx.x; it < 256; it += F.G) fftA_item(F, it);
            if (PH(4) && need_ctx) for (int it = blockIdx.x; it < 8; it += F.G) { const int b = it >> 2, m0 = (it & 3) * 64;
                const bf16* src0 = Pb + (size_t)(NLAT + b * CTXL) * NP + COL_FC;
                dft64_item<4, 256>(F, l, m0, -1.f, 1.f / 128.f, [=](int t, int ri) { return src0 + (size_t)t * NP + ri * 256; }, [=](int m) { return NLAT + b * CTXL + m; }); }
            REP(15) shift_pass(F, l);
            REP(16) conv_pass(F, l, nrows);
        }
        GRID_BAR();
        {
            const Frame Fp = phase_frame(F); unsigned char* const ws = WSO;
            REP(4) prep_phase(F, l);
        }
        GRID_BAR();
        for (int seg = -1; seg < NSEG; ++seg) {
            const bool split = (F.G == 256);
            if (seg + 1 < NSEG) pre_phase(F, seg + 1, (seg >= 0 && split) ? 128 : 0);
            if (seg + 1 == NSEG && (!split || blockIdx.x >= 128)) { unsigned char* const ws = opaque(F.ws); int bx_ = (int)blockIdx.x; asm volatile("" : "+s"(bx_));
                const int first_ = split ? bx_ - 128 : bx_, stride_ = split ? 128 : F.G;
                for (int it = first_; it < 256; it += stride_) { const int b = it >> 7, t1p = it & 127;
                    const bf16* src0 = (const bf16*)(ws + WS_GT) + (size_t)(b * 128 + t1p) * 64 * 512;
                    dft64_item<1, 64>(F, l, 0, 1.f, 0.0013810679320049757f, [=](int t, int ri) { return src0 + (size_t)t * 512 + ri * 256; }, [=](int m) { return b * SEQ + t1p + 128 * m; }); } }
            if (seg >= 0) for (int it = blockIdx.x; it < 128; it += F.G) { const int x_ = it & 7, j_ = it >> 3;
                seq_item<0>(F, ((x_ + 8 * (j_ >> 2)) << 2) | (j_ & 3), seg, need_ctx); }
            GRID_BAR();
        }
        REP(7) readout_pass(F, l, nrows);
        GRID_BAR();
        REP(8) if (l == 0 || rep_ == 0) {
            const Frame Fp = phase_frame(F); unsigned char* const ws = WSO; bf16* Hb = (bf16*)(ws + WS_H);
            pg8::Gemm g{Hb, (const bf16*)(ws + WS_WOUT_T) + (size_t)l * D * D, nrows, D, D}; pg8::StaticOrder S; S.init(nrows, D, Fp.G, (int)blockIdx.x);
            const float* X = (const float*)(ws + WS_X);
            pg8::EpiResidual E{l == 0 ? inptr(I_X) : X, l == 0 ? inptr(I_CTX) : X + (size_t)NLAT * D, (float*)(ws + WS_X), (const float*)(ws + WS_MODF) + (size_t)l * 3 * 6144 + 2 * 1024};
            pg8::gemm_phase<pg8::EpiResidual, pg8::StaticOrder, true, true>(F.lds, g, S, E);
        }
        expert_convert(F, l, (nrows / 256) * 4 > F.G ? (nrows / 256) * 4 - F.G : 0);
        GRID_BAR();
        router_pass(F, l, nrows);
#if RC_PROBE == 1
        router_pass(F, l, nrows, 1024);
#endif
        GRID_BAR();
        REP(10) gather_pass(F, l, nrows);
        GRID_BAR();
        if (PH(14)) {
            const Frame Fp = phase_frame(F); unsigned char* const ws = WSO;
            const int* tile_e = (const int*)(ws + WS_ROUTE + RT_TILE); const int ntiles = *(const int*)(ws + WS_ROUTE + RT_NT);
            pg8::MoeOrder S{tile_e, ntiles, Fp.G, (int)blockIdx.x};
            REP(12) {   pg8::Gemm g{(const bf16*)(ws + WS_XS), (const bf16*)(ws + WS_WGU_T), 0, 0, D};
                pg8::EpiSwiGLU E{(bf16*)(ws + WS_ACT)};
                pg8::gemm_phase<pg8::EpiSwiGLU, pg8::MoeOrder, true, true>(F.lds, g, S, E); }
            GRID_BAR();
            REP(13) {   pg8::Gemm g{(const bf16*)(ws + WS_ACT), (const bf16*)(ws + WS_WD_T), 0, 0, DEXP};
                pg8::EpiStoreBf16 E{(bf16*)(ws + WS_XS), D, 3};
                pg8::gemm_phase<pg8::EpiStoreBf16, pg8::MoeOrder, true, true>(F.lds, g, S, E); }
        }
        GRID_BAR();
#if RC_PROBE == 2
        combine_pass<true>(F, l, nrows);
#endif
        combine_pass<false>(F, l, nrows);
        if (l + 1 < DEPTH) GRID_BAR();
    }
}

extern "C" void kernel_launch(void* const* d_in, const int* in_sizes, int n_in, void* d_out, int out_size, void* d_ws, size_t ws_size, hipStream_t stream) {
    static int grid = 0;
    if (grid == 0) {
        if (n_in != N_IN || in_sizes[0] != NLAT * D || out_size != NLAT * D || ws_size < WS_END) {
            fprintf(stderr, "kernel_launch: unexpected shapes (n_in %d in0 %d out %d ws %zu)\n", n_in, n_in > 0 ? in_sizes[0] : -1, out_size, ws_size); grid = -1; return; }
        int dev = 0, cus = 0, per_cu = 0;
        hipGetDevice(&dev); hipDeviceGetAttribute(&cus, hipDeviceAttributeMultiprocessorCount, dev);
        hipFuncSetAttribute((const void*)fwd_megakernel, hipFuncAttributeMaxDynamicSharedMemorySize, LDS_BYTES);
        hipOccupancyMaxActiveBlocksPerMultiprocessor(&per_cu, (const void*)fwd_megakernel, NTHR, LDS_BYTES);
        if (per_cu < 1) { fprintf(stderr, "kernel_launch: occupancy query says %d blocks per CU\n", per_cu); per_cu = 1; }
        (void)hipGetLastError();
        grid = cus * per_cu;
    }
    if (grid < 0) return;
    hipMemsetAsync((char*)d_ws + WS_CTL, 0, CTL_ZERO_BYTES, stream);
    Params p{};
    for (int i = 0; i < N_IN; ++i) p.in[i] = (const float*)d_in[i];
    p.out = (float*)d_out; p.ws = (unsigned char*)d_ws;
    void* args[] = {&p};
    hipError_t e = hipLaunchCooperativeKernel((const void*)fwd_megakernel, dim3(grid), dim3(NTHR), args, LDS_BYTES, stream);
    if (e != hipSuccess) fprintf(stderr, "kernel_launch: cooperative launch failed: %s (grid %d)\n", hipGetErrorString(e), grid);
}
```

```cpp
#include <hip/hip_runtime.h>
#include <hip/hip_cooperative_groups.h>
#include <cstdio>
#include <cstdint>
namespace cg = cooperative_groups;
#define USE_CG_SYNC 0
#define SEQ_PROBE 0
#define SEQ_PROBE_PRE 0
namespace pg8 {
#define PG8_LAS __attribute__((address_space(3)))
typedef unsigned short bf16_t;
typedef short bf16x8 __attribute__((ext_vector_type(8)));
typedef float f32x4 __attribute__((ext_vector_type(4)));
typedef unsigned u32x4 __attribute__((ext_vector_type(4)));
constexpr int BM = 256, BK = 64, HALF = 128, HTB = HALF * BK * 2  , STAGE_BYTES = 8 * HTB, NXCD = 8, WGM = 8;

__host__ __device__ __forceinline__ int lds_byte(int r, int c) { const int st = (r >> 4) * 2 + (c >> 5), rr = r & 15, cc = c & 31, ob = rr * 64 + cc * 2; return st * 1024 + (ob ^ (((ob >> 9) & 1) << 5)); }
__host__ __device__ __forceinline__ void stage_rc(int b, int& R, int& C) { const int st = b / 1024, sb = b % 1024, swz = sb ^ (((sb >> 9) & 1) << 5); R = (st >> 1) * 16 + swz / 64; C = (st & 1) * 32 + (swz % 64) / 2; }
__host__ __device__ __forceinline__ int perm32(int rho) { const int n = rho >> 4, i = rho & 15; return 8 * (i >> 2) + 4 * n + (i & 3); }

struct Unit { int pm, pn; };
struct Gemm { const bf16_t* A; const bf16_t* Bt; int M, N, K; };

struct StaticOrder {
    int nM, nN, nwg, G, c;
    __host__ __device__ void init(int M, int N, int G_, int c_) { nM = M / BM; nN = N / BM; nwg = nM * nN; G = G_; c = c_; }
    __host__ __device__ bool next(int i, Unit& u) const {
        const long L = (long)i * G + c; if (L >= nwg) return false;
        int wgid = (int)L; { const int q = nwg / NXCD, r = nwg % NXCD, xcd = wgid % NXCD, off = wgid / NXCD; wgid = (xcd < r ? xcd * (q + 1) : r * (q + 1) + (xcd - r) * q) + off; }
        const int nig = WGM * nN, gid = wgid / nig, fm = gid * WGM, gsz = (nM - fm) < WGM ? (nM - fm) : WGM;
        u.pm = fm + ((wgid % nig) % gsz); u.pn = (wgid % nig) / gsz; return true;
    }
    __device__ __forceinline__ void a_ready(const Unit&) const {}
    __device__ __forceinline__ void done(const Unit&) const {}
};

__device__ __forceinline__ unsigned cvt_pk_bf16(float lo, float hi) { unsigned r; asm volatile("v_cvt_pk_bf16_f32 %0, %1, %2" : "=v"(r) : "v"(lo), "v"(hi)); return r; }
typedef float f32x2 __attribute__((ext_vector_type(2)));
template <class Epi, class Sched, bool ALIGN_EPI = false, bool SP2 = false>
__device__ __forceinline__ void gemm_phase(PG8_LAS unsigned char* lds, const Gemm g, const Sched& S, const Epi& E) {
    int tid = threadIdx.x; asm volatile("" : "+v"(tid));
    const int wid = __builtin_amdgcn_readfirstlane(tid >> 6), lane = tid & 63, wr = wid >> 2, wc = wid & 3, fr = lane & 15, fq = lane >> 4;
    const int K = g.K, nt = K / BK;
    unsigned voffA[2], voffB[2];
#pragma unroll
    for (int i = 0; i < 2; ++i) { int R, C; stage_rc(tid * 16 + i * 8192, R, C); const int Rb = Epi::PERM ? ((R & ~31) + perm32(R & 31)) : R;
        voffA[i] = (unsigned)(R * K + C) * 2u; voffB[i] = (unsigned)(Rb * K + C) * 2u; }
    const size_t kstep = (size_t)(BK * 2);
    const size_t hstep = (size_t)HALF * K * 2;
    const size_t tstep = 2 * hstep;
    const unsigned ldsw = (unsigned)wid * 1024u;
    const int aoff = lds_byte(wr * 64 + fr, fq * 8), boff = lds_byte(wc * 32 + fr, fq * 8);
#define PG8_SA(b, h) (((b) * 2 + (h)) * HTB)
#define PG8_SB(b, h) ((4 + (b) * 2 + (h)) * HTB)
#define PG8_STAGE(bufoff, gbase, voff) do { _Pragma("unroll") for (int _i = 0; _i < 2; ++_i) \
        __builtin_amdgcn_global_load_lds((const unsigned*)((const char*)(gbase) + (voff)[_i]), (PG8_LAS unsigned*)(lds + (bufoff) + ldsw + _i * 8192), 16, 0, 0); } while (0)
#define PG8_LDA(dst, b, h) do { _Pragma("unroll") for (int m = 0; m < 4; ++m) _Pragma("unroll") for (int k = 0; k < 2; ++k) dst[m][k] = *(const PG8_LAS bf16x8*)(lds + PG8_SA(b, h) + aoff + m * 2048 + k * 1024); } while (0)
#define PG8_LDB(dst, b, h) do { _Pragma("unroll") for (int n = 0; n < 2; ++n) _Pragma("unroll") for (int k = 0; k < 2; ++k) dst[n][k] = *(const PG8_LAS bf16x8*)(lds + PG8_SB(b, h) + boff + n * 2048 + k * 1024); } while (0)
#define PG8_MMA(ai, bj, At, Bt) do { __builtin_amdgcn_s_setprio(1); _Pragma("unroll") for (int m = 0; m < 4; ++m) _Pragma("unroll") for (int n = 0; n < 2; ++n) _Pragma("unroll") for (int k = 0; k < 2; ++k) \
        acc[ai][bj][m][n] = __builtin_amdgcn_mfma_f32_16x16x32_bf16(Bt[n][k], At[m][k], acc[ai][bj][m][n], 0, 0, 0); __builtin_amdgcn_s_setprio(0); } while (0)
#define PG8_WAIT_V(n) asm volatile("s_waitcnt vmcnt(" #n ")" ::: "memory")
#define PG8_WAIT_L(n) asm volatile("s_waitcnt lgkmcnt(" #n ")" ::: "memory")
#define PG8_BAR __builtin_amdgcn_s_barrier()
#define PG8_SCHED __builtin_amdgcn_sched_barrier(0)
    Unit cur, nxt; int ui = 0;
    if (!S.next(0, cur)) return;
    f32x4 acc[2][2][4][2];
#pragma unroll
    for (int a = 0; a < 2; ++a)
#pragma unroll
        for (int b = 0; b < 2; ++b)
#pragma unroll
            for (int m = 0; m < 4; ++m)
#pragma unroll
                for (int n = 0; n < 2; ++n) acc[a][b][m][n] = (f32x4){0.f, 0.f, 0.f, 0.f};
    bf16x8 At[4][2], B0[2][2], B1[2][2];
    const char* cA = (const char*)g.A + (size_t)cur.pm * tstep; const char* cB = (const char*)g.Bt + (size_t)cur.pn * tstep;
    S.a_ready(cur);
    if constexpr (SP2) {
        PG8_STAGE(PG8_SB(0, 0), cB, voffB); PG8_STAGE(PG8_SB(0, 1), cB + hstep, voffB); PG8_STAGE(PG8_SA(0, 0), cA, voffA); PG8_STAGE(PG8_SA(0, 1), cA + hstep, voffA);
        if (wr == 1) PG8_BAR;
        PG8_WAIT_V(2); PG8_BAR;
        PG8_STAGE(PG8_SB(1, 0), cB + kstep, voffB); PG8_STAGE(PG8_SA(1, 0), cA + kstep, voffA); PG8_STAGE(PG8_SB(1, 1), cB + hstep + kstep, voffB);
        PG8_WAIT_V(6); PG8_BAR;
    } else {
        PG8_STAGE(PG8_SB(0, 0), cB, voffB); PG8_STAGE(PG8_SA(0, 0), cA, voffA); PG8_STAGE(PG8_SB(0, 1), cB + hstep, voffB); PG8_STAGE(PG8_SA(0, 1), cA + hstep, voffA);
        if (wr == 1) PG8_BAR;
        PG8_WAIT_V(4); PG8_BAR;
        PG8_STAGE(PG8_SB(1, 0), cB + kstep, voffB); PG8_STAGE(PG8_SA(1, 0), cA + kstep, voffA); PG8_STAGE(PG8_SB(1, 1), cB + hstep + kstep, voffB);
        PG8_WAIT_V(6); PG8_BAR;
    }
    for (;;) {
        const bool has_next = S.next(ui + 1, nxt);
        const char* nA = has_next ? (const char*)g.A + (size_t)nxt.pm * tstep : cA; const char* nB = has_next ? (const char*)g.Bt + (size_t)nxt.pn * tstep : cB;
        for (int t = 0; t < nt; t += 2) {
            const bool last = (t == nt - 2);
            const char* a1 = cA + (size_t)(t + 1) * kstep;
            const char* a2 = last ? nA : cA + (size_t)(t + 2) * kstep; const char* b2 = last ? nB : cB + (size_t)(t + 2) * kstep;
            const char* a3 = a2 + kstep; const char* b3 = b2 + kstep;
            if (last && has_next) S.a_ready(nxt);
            if constexpr (SP2) {
            PG8_LDB(B0, 0, 0); PG8_LDB(B1, 0, 1); PG8_SCHED; PG8_LDA(At, 0, 0); PG8_STAGE(PG8_SA(1, 1), a1 + hstep, voffA);
            PG8_WAIT_V(8); PG8_WAIT_L(0); PG8_BAR; PG8_MMA(0, 0, At, B0); PG8_MMA(0, 1, At, B1); PG8_BAR; PG8_SCHED;
            PG8_LDA(At, 0, 1); PG8_STAGE(PG8_SB(0, 0), b2, voffB); PG8_STAGE(PG8_SB(0, 1), b2 + hstep, voffB); PG8_STAGE(PG8_SA(0, 0), a2, voffA);
            PG8_WAIT_V(8); PG8_WAIT_L(0); PG8_BAR; PG8_MMA(1, 0, At, B0); PG8_MMA(1, 1, At, B1); PG8_BAR; PG8_SCHED;
            PG8_LDB(B0, 1, 0); PG8_LDB(B1, 1, 1); PG8_SCHED; PG8_LDA(At, 1, 0); PG8_STAGE(PG8_SA(0, 1), a2 + hstep, voffA);
            PG8_WAIT_V(8); PG8_WAIT_L(0); PG8_BAR; PG8_MMA(0, 0, At, B0); PG8_MMA(0, 1, At, B1); PG8_BAR; PG8_SCHED;
            PG8_LDA(At, 1, 1); PG8_STAGE(PG8_SB(1, 0), b3, voffB); PG8_STAGE(PG8_SB(1, 1), b3 + hstep, voffB); PG8_STAGE(PG8_SA(1, 0), a3, voffA);
            PG8_WAIT_V(8); PG8_WAIT_L(0); PG8_BAR; PG8_MMA(1, 0, At, B0); PG8_MMA(1, 1, At, B1); PG8_BAR; PG8_SCHED;
            } else {
            PG8_LDB(B0, 0, 0); PG8_SCHED; PG8_LDA(At, 0, 0); PG8_STAGE(PG8_SA(1, 1), a1 + hstep, voffA);
            PG8_WAIT_L(8); PG8_BAR; PG8_WAIT_L(0); PG8_MMA(0, 0, At, B0); PG8_BAR; PG8_SCHED;
            PG8_LDB(B1, 0, 1); PG8_STAGE(PG8_SB(0, 0), b2, voffB);
            PG8_BAR; PG8_WAIT_L(0); PG8_MMA(0, 1, At, B1); PG8_BAR;
            PG8_LDA(At, 0, 1); PG8_STAGE(PG8_SA(0, 0), a2, voffA);
            PG8_BAR; PG8_WAIT_L(0); PG8_MMA(1, 0, At, B0); PG8_BAR; PG8_SCHED;
            PG8_STAGE(PG8_SB(0, 1), b2 + hstep, voffB);
            PG8_WAIT_V(6); PG8_BAR; PG8_MMA(1, 1, At, B1); PG8_BAR;
            PG8_LDB(B0, 1, 0); PG8_SCHED; PG8_LDA(At, 1, 0); PG8_STAGE(PG8_SA(0, 1), a2 + hstep, voffA);
            PG8_WAIT_L(8); PG8_BAR; PG8_WAIT_L(0); PG8_MMA(0, 0, At, B0); PG8_BAR; PG8_SCHED;
            PG8_LDB(B1, 1, 1); PG8_STAGE(PG8_SB(1, 0), b3, voffB);
            PG8_BAR; PG8_WAIT_L(0); PG8_MMA(0, 1, At, B1); PG8_BAR;
            PG8_LDA(At, 1, 1); PG8_STAGE(PG8_SA(1, 0), a3, voffA);
            PG8_BAR; PG8_WAIT_L(0); PG8_MMA(1, 0, At, B0); PG8_BAR; PG8_SCHED;
            PG8_STAGE(PG8_SB(1, 1), b3 + hstep, voffB);
            PG8_WAIT_V(6); PG8_BAR; PG8_MMA(1, 1, At, B1); PG8_BAR;
            }
        }
        if constexpr (ALIGN_EPI) { if (wr == 0) PG8_BAR; }
        if constexpr (!Epi::AFTER_DRAIN) { E(acc, cur, wr, wc, fr, fq); S.done(cur); }
        if (!has_next) break;
#pragma unroll
        for (int a = 0; a < 2; ++a)
#pragma unroll
            for (int b = 0; b < 2; ++b)
#pragma unroll
                for (int m = 0; m < 4; ++m)
#pragma unroll
                    for (int n = 0; n < 2; ++n) acc[a][b][m][n] = (f32x4){0.f, 0.f, 0.f, 0.f};
        cur = nxt; cA = nA; cB = nB; ++ui;
        if constexpr (ALIGN_EPI) { if (wr == 1) PG8_BAR; }
    }
    PG8_WAIT_V(0);
    if constexpr (!ALIGN_EPI) { if (wr == 0) PG8_BAR; }
    PG8_BAR;
    if constexpr (Epi::AFTER_DRAIN) { E.fused(acc, cur, wr, wc, fr, fq, lds, wid, lane); S.done(cur); }
#undef PG8_SA
#undef PG8_SB
#undef PG8_STAGE
#undef PG8_LDA
#undef PG8_LDB
#undef PG8_MMA
#undef PG8_WAIT_V
#undef PG8_WAIT_L
#undef PG8_BAR
#undef PG8_SCHED
}
}
#define LAS __attribute__((address_space(3)))
typedef unsigned short bf16;
typedef float f32x4 __attribute__((ext_vector_type(4)));
typedef short bf16x8 __attribute__((ext_vector_type(8)));
typedef unsigned u32x4 __attribute__((ext_vector_type(4)));
typedef unsigned u32x2 __attribute__((ext_vector_type(2)));

constexpr int D = 1024, NBATCH = 2, SEQ = 8192, CTXL = 256, DEPTH = 2;
constexpr int NLAT = NBATCH * SEQ, NCTX = NBATCH * CTXL, NROW = NLAT + NCTX;
constexpr int DR = 512, DIN = 2944, NP = 3328, ZW = 1920, NHEAD = 8;
constexpr int COL_CONV = 1920, COL_FC = 2688, COL_FS = 2944;
constexpr int STRW = 5120;
constexpr int NEXP = 32, DEXP = 512;
constexpr int MOE_MAXTILES = 168;
constexpr float RMS_EPS = 1e-6f, GN_EPS = 64e-5f;

enum { I_X = 0, I_C, I_CTX, I_CCTX, I_ADAW, I_ADAB, I_N1G, I_N2G, I_WIN, I_MU, I_DW0, I_DW2, I_IA0, I_IA2, I_GG2, I_KK, I_KA, I_RK, I_GNW, I_GNB,
       I_CONVW, I_CONVG, I_FOURG, I_WOUT, I_RGW, I_RGB, I_REW, I_REB, I_EG, I_EU, I_ED, I_FG, N_IN };

constexpr size_t MiB = 1u << 20;
constexpr size_t WS_CTL = 0, CTL_ZERO_BYTES = 64 * 1024;
constexpr size_t WS_MODP = 1 * MiB;
constexpr size_t WS_MODF = 1 * MiB + 1280 * 1024;
constexpr size_t WS_WIN_T = 3 * MiB;
constexpr size_t WS_WOUT_T = 16 * MiB;
constexpr size_t WS_WGU_T = 20 * MiB;
constexpr size_t WS_WD_T = 84 * MiB;
constexpr size_t WS_X = 116 * MiB;
constexpr size_t WS_H = 182 * MiB;
constexpr size_t WS_ZS = 215 * MiB;
constexpr size_t WS_P = 277 * MiB;
constexpr size_t WS_STR = 277 * MiB;
constexpr size_t WS_Y = 442 * MiB;
constexpr size_t WS_GT = 475 * MiB;
constexpr size_t WS_ROUTE = 491 * MiB;
constexpr size_t WS_XS = 215 * MiB;
constexpr size_t WS_ACT = 299 * MiB;
constexpr size_t WS_END = 530 * MiB;
constexpr size_t RT_E = 0, RT_POS = 1 * 33792 * 4, RT_GATE = 2 * 33792 * 4, RT_SLOT = 3 * 33792 * 4, RT_TILE = 4 * 33792 * 4, RT_NT = RT_TILE + 1024;

constexpr int CW_BAR = 4096;
constexpr int CW_CNT = 8192;

constexpr int NWAVES = 8, NTHR = 512;
constexpr int RING_BYTES = 131072, LDSCTL_OFF = 143360, MISC_OFF = LDSCTL_OFF + 320, LDS_BYTES = 147456;

struct Params { const float* in[N_IN]; float* out; unsigned char* ws; };

__device__ __forceinline__ float bf2f(unsigned h) { return __uint_as_float(h << 16); }
typedef __bf16 hwbf2 __attribute__((ext_vector_type(2)));
typedef float f32x2 __attribute__((ext_vector_type(2)));
__device__ __forceinline__ unsigned pk2(float lo, float hi) { const f32x2 x = {lo, hi}; const hwbf2 r = __builtin_convertvector(x, hwbf2); return __builtin_bit_cast(unsigned, r); }
__device__ __forceinline__ unsigned f2bf(float f) { return pk2(f, 0.f) & 0xffffu; }
__device__ __forceinline__ float wave_sum(float v) {
#pragma unroll
    for (int o = 1; o < 64; o <<= 1) v += __shfl_xor(v, o);
    return v;
}
__device__ __forceinline__ float sigmoidf_(float x) { return 1.f / (1.f + __expf(-x)); }
#define LDS_WAIT() asm volatile("s_waitcnt lgkmcnt(0)" ::: "memory")
#define VM_WAIT() asm volatile("s_waitcnt vmcnt(0)" ::: "memory")

struct Frame {
    LAS unsigned char* lds;
    int tid, lane, wave, vcu, G, gw, NGW;
    float* out; unsigned char* ws;
};
#if defined(__HIP_DEVICE_COMPILE__)
#define ASSUME_GLOBAL(p) do { __builtin_assume(!__builtin_amdgcn_is_shared(p)); __builtin_assume(!__builtin_amdgcn_is_private(p)); } while (0)
#else
#define ASSUME_GLOBAL(p) do { } while (0)
#endif
__device__ __forceinline__ const float* inptr(int i) {
    const volatile unsigned long long __attribute__((address_space(4)))* ka = (const volatile unsigned long long __attribute__((address_space(4)))*)__builtin_amdgcn_kernarg_segment_ptr();
    return (const float*)(const __attribute__((address_space(1))) float*)ka[i];
}
__device__ __forceinline__ unsigned char* opaque(unsigned char* p) { unsigned long z = 0; asm volatile("" : "+s"(z)); return p + z; }
__device__ __forceinline__ Frame phase_frame(const Frame& F0) { Frame F = F0; asm volatile("" : "+v"(F.tid)); F.lane = F.tid & 63; F.ws = opaque(F0.ws);
    asm volatile("" : "+s"(F.G), "+s"(F.vcu)); F.gw = F.vcu * NWAVES + F.wave; F.NGW = F.G * NWAVES; return F; }
__device__ __forceinline__ int modrow(int row) { return row < NLAT ? (row >> 13) : 2; }
#define XB_TMO      128
#define XB_XCNT(j)  (256  + 64 * (j))
#define XB_XSUB(j)  (1280 + 64 * (j))
#define XB_XGEN(j)  (2304 + 64 * (j))
#define XB_TOP      3328
#define XB_TOPGEN   3392
#define XCD_BAR_WORDS 3456
#define XB_SPIN_CAP (1u << 18)

__device__ __forceinline__ unsigned xb_ld(unsigned* p)              { return __hip_atomic_load(p, __ATOMIC_RELAXED, __HIP_MEMORY_SCOPE_AGENT); }
__device__ __forceinline__ unsigned xb_add(unsigned* p, unsigned v) { return __hip_atomic_fetch_add(p, v, __ATOMIC_RELAXED, __HIP_MEMORY_SCOPE_AGENT); }
__device__ __forceinline__ unsigned xb_xcc_id() { return (unsigned)__builtin_amdgcn_s_getreg((3 << 11) | 20) & 0xFu; }
#define XB_SPIN(cond, bar) do { unsigned _sp = 0; while (cond) { __builtin_amdgcn_s_sleep(1); \
    if ((++_sp & 255u) == 0u) { if (xb_ld(&(bar)[XB_TMO])) break; if (_sp > XB_SPIN_CAP) { atomicAdd(&(bar)[XB_TMO], 1u); break; } } } } while (0)

struct XcdBarrier {
    unsigned* bar; unsigned x;
    volatile LAS unsigned* st;
};

__device__ __forceinline__ XcdBarrier xcd_barrier_post(unsigned* bar, volatile LAS unsigned* st) {
    XcdBarrier b; b.bar = bar; b.x = xb_xcc_id(); b.st = st;
    if (threadIdx.x == 0) (void)xb_add(&bar[XB_XCNT(b.x)], 1u);
    return b;
}
__device__ __forceinline__ void xcd_barrier_complete(unsigned* bar, unsigned x, unsigned& nloc, unsigned& nx) {
    const unsigned G = gridDim.x * gridDim.y * gridDim.z;
    unsigned sum, cnt, mine, sp = 0u;
    for (;;) {
        sum = 0u; cnt = 0u; mine = 0u;
#pragma nounroll
        for (unsigned j = 0; j < 16; ++j) { const unsigned c = xb_ld(&bar[XB_XCNT(j)]); sum += c; cnt += (c > 0u) ? 1u : 0u; mine = (j == x) ? c : mine; }
        if (sum == G) break;
        __builtin_amdgcn_s_sleep(1);
        if ((++sp & 255u) == 0u) { if (xb_ld(&bar[XB_TMO])) break; if (sp > XB_SPIN_CAP) { atomicAdd(&bar[XB_TMO], 1u); break; } }
    }
    nloc = mine > 0u ? mine : 1u; nx = cnt > 0u ? cnt : 1u;
}

__device__ __forceinline__ void xcd_barrier(const XcdBarrier& b) {
    asm volatile("s_waitcnt vmcnt(0)" ::: "memory");
    __syncthreads();
    if (threadIdx.x == 0) {
        unsigned* bar = b.bar;
        asm volatile("" : "+s"(bar));
        __builtin_amdgcn_s_waitcnt(0);
        unsigned nloc = b.st[0], nx = b.st[1];
        if (nloc == 0u) { xcd_barrier_complete(bar, b.x, nloc, nx); b.st[0] = nloc; b.st[1] = nx; }
        const unsigned old = xb_add(&bar[XB_XSUB(b.x)], 1u);
        const unsigned gen = old / nloc;
        if (old + 1u == (gen + 1u) * nloc) {
            __builtin_amdgcn_fence(__ATOMIC_RELEASE, "agent");
            asm volatile("s_waitcnt vmcnt(0)" ::: "memory");
            const unsigned og = xb_add(&bar[XB_TOP], 1u);
            const unsigned tg = og / nx;
            if (og + 1u == (tg + 1u) * nx) xb_add(&bar[XB_TOPGEN], 1u);
            else XB_SPIN(xb_ld(&bar[XB_TOPGEN]) == tg, bar);
            __builtin_amdgcn_fence(__ATOMIC_ACQUIRE, "agent");
            xb_add(&bar[XB_XGEN(b.x)], 1u);
            asm volatile("s_waitcnt vmcnt(0)" ::: "memory");
        } else {
            XB_SPIN(xb_ld(&bar[XB_XGEN(b.x)]) == gen, bar);
            __builtin_amdgcn_fence(__ATOMIC_ACQUIRE, "agent");
            asm volatile("s_waitcnt vmcnt(0)" ::: "memory");
        }
    }
    __syncthreads();
}
template <class RowMap>
__device__ __forceinline__ void transpose_item(const float* W, int ldw, int k0, int n0, bf16* WT, int ldt, RowMap rm, LAS float* scr, int lane) {
    (void)scr;
    const int nq = lane & 7, kg = lane >> 3; const float* src = W + (size_t)(k0 + 8 * kg) * ldw + n0 + 4 * nq;
    f32x4 v[8];
#pragma unroll
    for (int i = 0; i < 8; ++i) v[i] = *(const f32x4*)(src + (size_t)i * ldw);
#pragma unroll
    for (int j = 0; j < 4; ++j) { u32x4 o = {pk2(v[0][j], v[1][j]), pk2(v[2][j], v[3][j]), pk2(v[4][j], v[5][j]), pk2(v[6][j], v[7][j])};
        *(u32x4*)(WT + (size_t)rm(n0 + 4 * nq + j) * ldt + k0 + 8 * kg) = o; }
}
struct RmId { int off; __device__ __forceinline__ int operator()(int n) const { return off + n; } };
struct RmGU { int off; __device__ __forceinline__ int operator()(int n) const { return off + ((n >> 2) << 3) + (n & 3); } };

__device__ __forceinline__ void p0_prologue(const Frame& F0) {
    const Frame F = phase_frame(F0); unsigned char* const ws = F.ws;
    LAS float* scr = (LAS float*)(F.lds + F.wave * 16384);
    LAS float* ctab = (LAS float*)(F.lds + 8 * 16384);
    if (F.tid < 64) ctab[F.tid] = cosf((float)F.tid * (6.283185307179586f / 64.f));
    __syncthreads();
    bf16* win_t = (bf16*)(ws + WS_WIN_T); bf16* wout_t = (bf16*)(ws + WS_WOUT_T);
    constexpr int I_WIN_L = 16 * 84, I_WOUT_L = 16 * 32, I_FOLD_L = 4 * 64, I_MOD_L = 96 * 8;
    constexpr int NIT = 2 * (I_WIN_L + I_WOUT_L + I_FOLD_L + I_MOD_L);
    const float* p_win = inptr(I_WIN); const float* p_wout = inptr(I_WOUT); const float* p_c = inptr(I_C); const float* p_cctx = inptr(I_CCTX); const float* p_adaw = inptr(I_ADAW);
    {
        bf16* wl = (bf16*)(ws + 64 * 1024); const float* dw2 = inptr(I_DW2); const float* ia2 = inptr(I_IA2); const float* gg2 = inptr(I_GG2);
        for (int idx = F.vcu * NTHR + F.tid; idx < 2 * 384 * 512; idx += F.G * NTHR) { const int c = idx & 511, k = (idx >> 9) % 384, l = idx / (384 * 512);
            float v;
            if (k < 128) v = dw2[((size_t)(l * 2 + (k >> 6)) * 64 + (k & 63)) * DR + c];
            else if (k < 256) v = ia2[((size_t)(l * 2 + ((k - 128) >> 6)) * 64 + (k & 63)) * DR + c];
            else v = gg2[((size_t)l * 128 + (k - 256)) * DR + c];
            wl[((size_t)l * 512 + c) * 384 + k] = (bf16)f2bf(v); } }
    for (int it = F.gw; it < NIT; it += F.NGW) {
        int r = it; const int l = r & 1; r >>= 1;
        if (r < I_WIN_L) { const int kb = r / 84, nb = r % 84;
            transpose_item(p_win + (size_t)l * D * DIN, DIN, kb * 64, nb * 32, win_t + (size_t)l * NP * D, D, RmId{0}, scr, F.lane); continue; }
        r -= I_WIN_L;
        if (r < I_WOUT_L) { const int kb = r / 32, nb = r % 32;
            transpose_item(p_wout + (size_t)l * D * D, D, kb * 64, nb * 32, wout_t + (size_t)l * D * D, D, RmId{0}, scr, F.lane); continue; }
        r -= I_WOUT_L;
        if (r < I_FOLD_L) {
            const int g = r >> 6, k0 = (r & 63) * 16; const float* W = p_win + (size_t)l * D * DIN;
#pragma unroll
            for (int kk = 0; kk < 16; ++kk) scr[kk * 64 + F.lane] = W[(size_t)(k0 + kk) * DIN + 2688 + g * 64 + F.lane];
            LDS_WAIT(); asm volatile("" ::: "memory");
            float ac[16], as[16];
#pragma unroll
            for (int kk = 0; kk < 16; ++kk) { ac[kk] = 0.f; as[kk] = 0.f; }
            for (int c = 0; c < 64; ++c) { const int idx = (c * F.lane) & 63; const float cc = ctab[idx], ss = ctab[(idx - 16) & 63];
#pragma unroll
                for (int kk = 0; kk < 16; ++kk) { const float w = scr[kk * 64 + c]; ac[kk] += w * cc; as[kk] += w * ss; } }
            bf16* oc = win_t + (size_t)l * NP * D + (size_t)(COL_FC + g * 64 + F.lane) * D + k0;
            bf16* os = win_t + (size_t)l * NP * D + (size_t)(COL_FS + g * 64 + F.lane) * D + k0;
            u32x4 a, b;
            a.x = pk2(ac[0], ac[1]); a.y = pk2(ac[2], ac[3]); a.z = pk2(ac[4], ac[5]); a.w = pk2(ac[6], ac[7]);
            b.x = pk2(ac[8], ac[9]); b.y = pk2(ac[10], ac[11]); b.z = pk2(ac[12], ac[13]); b.w = pk2(ac[14], ac[15]);
            *(u32x4*)oc = a; *(u32x4*)(oc + 8) = b;
            a.x = pk2(as[0], as[1]); a.y = pk2(as[2], as[3]); a.z = pk2(as[4], as[5]); a.w = pk2(as[6], as[7]);
            b.x = pk2(as[8], as[9]); b.y = pk2(as[10], as[11]); b.z = pk2(as[12], as[13]); b.w = pk2(as[14], as[15]);
            *(u32x4*)os = a; *(u32x4*)(os + 8) = b;
            LDS_WAIT(); asm volatile("" ::: "memory");
            continue; }
        r -= I_FOLD_L;
        {
            const int cb = r >> 3, ks = r & 7;
#pragma unroll
            for (int q = 0; q < 2; ++q) { const int k = ks * 128 + q * 64 + F.lane;
                const float c0 = p_c[k], c1 = p_c[D + k], c2 = p_cctx[k];
                scr[0 * 128 + q * 64 + F.lane] = c0 * sigmoidf_(c0); scr[1 * 128 + q * 64 + F.lane] = c1 * sigmoidf_(c1); scr[2 * 128 + q * 64 + F.lane] = c2 * sigmoidf_(c2); }
            LDS_WAIT(); asm volatile("" ::: "memory");
            const float* W = p_adaw + (size_t)l * D * 6144 + (size_t)(ks * 128) * 6144 + cb * 64 + F.lane;
            float a0 = 0.f, a1 = 0.f, a2 = 0.f;
#pragma unroll 8
            for (int kk = 0; kk < 128; ++kk) { const float w = W[(size_t)kk * 6144]; a0 += scr[kk] * w; a1 += scr[128 + kk] * w; a2 += scr[256 + kk] * w; }
            float* mp = (float*)(ws + WS_MODP) + (size_t)((l * 8 + ks) * 3) * 6144 + cb * 64 + F.lane;
            mp[0] = a0; mp[6144] = a1; mp[2 * 6144] = a2;
            LDS_WAIT(); asm volatile("" ::: "memory");
        }
    }
}

__device__ __forceinline__ void mod_to_lds(const Frame& F0, int l, int p, LAS float* dst, bool from_partials) {
    const Frame F = phase_frame(F0); unsigned char* const ws = F.ws;
    const float* adab = inptr(I_ADAB);
    for (int idx = F.tid; idx < 3 * 1024; idx += NTHR) { const int r = idx >> 10, n = idx & 1023;
        float v;
        if (from_partials) { v = adab[l * 6144 + p * 1024 + n]; const float* mp = (const float*)(ws + WS_MODP) + (size_t)(l * 8 * 3 + r) * 6144 + p * 1024 + n;
#pragma unroll
            for (int ks = 0; ks < 8; ++ks) v += mp[(size_t)ks * 3 * 6144]; }
        else v = ((const float*)(ws + WS_MODF))[(size_t)(l * 3 + r) * 6144 + p * 1024 + n];
        dst[idx] = v; }
}
__device__ __forceinline__ void mod_finalize(const Frame& F0) {
    const Frame F = phase_frame(F0); unsigned char* const ws = F.ws;
    const float* adab = inptr(I_ADAB);
    for (int idx = F.vcu * NTHR + F.tid; idx < 2 * 3 * 6144; idx += F.G * NTHR) { const int l = idx / (3 * 6144), rem = idx % (3 * 6144), r = rem / 6144, n = rem % 6144;
        float v = adab[l * 6144 + n]; const float* mp = (const float*)(ws + WS_MODP) + (size_t)(l * 8 * 3 + r) * 6144 + n;
#pragma unroll
        for (int ks = 0; ks < 8; ++ks) v += mp[(size_t)ks * 3 * 6144];
        ((float*)(ws + WS_MODF))[idx] = v; }
}


__device__ __forceinline__ void norm_mod_row(f32x4 (&v)[4], const float* gain, const LAS float* sc, const LAS float* sh, bf16* orow, int lane) {
    float s = 0.f;
#pragma unroll
    for (int j = 0; j < 4; ++j) s += (v[j].x * v[j].x + v[j].y * v[j].y) + (v[j].z * v[j].z + v[j].w * v[j].w);
    const float rs = rsqrtf(wave_sum(s) * (1.f / D) + RMS_EPS);
#pragma unroll
    for (int j = 0; j < 4; ++j) { const int c = 4 * lane + 256 * j; const f32x4 g = *(const f32x4*)(gain + c); const f32x4 a = *(const LAS f32x4*)(sc + c), b = *(const LAS f32x4*)(sh + c);
        v[j] = (v[j] * rs) * g * (a + 1.f) + b;
        u32x2 w; w.x = pk2(v[j].x, v[j].y); w.y = pk2(v[j].z, v[j].w); *(u32x2*)(orow + c) = w; }
}

__device__ __forceinline__ void p0b_norm1(const Frame& F0) {
    const Frame F = phase_frame(F0); unsigned char* const ws = F.ws;
    LAS float* msh = (LAS float*)F.lds; LAS float* msc = msh + 3072;
    mod_to_lds(F, 0, 0, msh, true); mod_to_lds(F, 0, 1, msc, true); __syncthreads();
    mod_finalize(F);
    bf16* H = (bf16*)(ws + WS_H); const float* xin = inptr(I_X); const float* cin = inptr(I_CTX); const float* n1g = inptr(I_N1G);
    for (int row0 = F.gw; row0 < NROW; row0 += 2 * F.NGW) { f32x4 v[2][4]; bool ok[2];
#pragma unroll
        for (int u = 0; u < 2; ++u) { const int row = row0 + u * F.NGW; ok[u] = row < NROW; if (ok[u]) { const float* xr = row < NLAT ? xin + (size_t)row * D : cin + (size_t)(row - NLAT) * D;
#pragma unroll
            for (int j = 0; j < 4; ++j) v[u][j] = *(const f32x4*)(xr + 4 * F.lane + 256 * j); } }
#pragma unroll
        for (int u = 0; u < 2; ++u) if (ok[u]) { const int row = row0 + u * F.NGW; const int mr = modrow(row);
            norm_mod_row(v[u], n1g, msc + mr * 1024, msh + mr * 1024, H + (size_t)row * D, F.lane); } }
}
__device__ __forceinline__ void unpack8(const u32x4 w, float (&o)[8]) {
    o[0] = bf2f(w.x & 0xffffu); o[1] = bf2f(w.x >> 16); o[2] = bf2f(w.y & 0xffffu); o[3] = bf2f(w.y >> 16);
    o[4] = bf2f(w.z & 0xffffu); o[5] = bf2f(w.z >> 16); o[6] = bf2f(w.w & 0xffffu); o[7] = bf2f(w.w >> 16);
}
__device__ __forceinline__ void unpack4(const u32x2 w, float (&o)[4]) { o[0] = bf2f(w.x & 0xffffu); o[1] = bf2f(w.x >> 16); o[2] = bf2f(w.y & 0xffffu); o[3] = bf2f(w.y >> 16); }

__device__ __forceinline__ void shift_pass(const Frame& F0, int l) {
    const Frame F = phase_frame(F0); unsigned char* const ws = F.ws;
    const bf16* P = (const bf16*)(ws + WS_P); bf16* Zs = (bf16*)(ws + WS_ZS); const float* mu = inptr(I_MU) + l * ZW;
    const int total = NROW * 240;
    for (int idx = F.vcu * NTHR + F.tid; idx < total; idx += F.G * NTHR) {
        const int row = idx / 240, ck = idx % 240; const bf16* pr = P + (size_t)row * NP + ck * 8;
        const u32x4 zero = {0u, 0u, 0u, 0u};
        float z[8], n0[8], n1[8], n2[8], n3[8], o[8];
        unpack8(*(const u32x4*)pr, z);
        if (row < NLAT) { const int t = row & (SEQ - 1), gr = t >> 6, gc = t & 63;
            unpack8(gc > 0 ? *(const u32x4*)(pr - NP) : zero, n0); unpack8(gc < 63 ? *(const u32x4*)(pr + NP) : zero, n1);
            unpack8(gr > 0 ? *(const u32x4*)(pr - 64 * NP) : zero, n2); unpack8(gr < 127 ? *(const u32x4*)(pr + 64 * NP) : zero, n3);
        } else { const int tc = (row - NLAT) & (CTXL - 1);
            unpack8(tc > 0 ? *(const u32x4*)(pr - NP) : zero, n0); unpack8(tc < CTXL - 1 ? *(const u32x4*)(pr + NP) : zero, n1);
#pragma unroll
            for (int j = 0; j < 8; ++j) { n2[j] = n0[j]; n3[j] = n1[j]; }
        }
        const f32x4 m0 = *(const f32x4*)(mu + ck * 8), m1 = *(const f32x4*)(mu + ck * 8 + 4);
        const float m[8] = {m0.x, m0.y, m0.z, m0.w, m1.x, m1.y, m1.z, m1.w};
#pragma unroll
        for (int j = 0; j < 8; ++j) { const float nb = (j & 3) == 0 ? n0[j] : (j & 3) == 1 ? n1[j] : (j & 3) == 2 ? n2[j] : n3[j]; o[j] = z[j] + (nb - z[j]) * m[j]; }
        u32x4 w; w.x = pk2(o[0], o[1]); w.y = pk2(o[2], o[3]); w.z = pk2(o[4], o[5]); w.w = pk2(o[6], o[7]);
        *(u32x4*)(Zs + (size_t)row * ZW + ck * 8) = w;
    }
}

__device__ __forceinline__ void conv_pass(const Frame& F0, int l, int nrows) {
    const Frame F = phase_frame(F0); unsigned char* const ws = F.ws;
    const bf16* P = (const bf16*)(ws + WS_P); bf16* MA = (bf16*)(ws + WS_H);
    const float* cw = inptr(I_CONVW) + l * 3 * 256; const int c = 4 * F.lane;
    const f32x4 w0 = *(const f32x4*)(cw + c), w1 = *(const f32x4*)(cw + 256 + c), w2 = *(const f32x4*)(cw + 512 + c), gn = *(const f32x4*)(inptr(I_CONVG) + l * 256 + c);
    for (int row0 = F.gw; row0 < nrows; row0 += 2 * F.NGW) {
        u32x2 q[2][7]; bool ok[2]; const u32x2 zero = {0u, 0u};
#pragma unroll
        for (int u = 0; u < 2; ++u) { const int row = row0 + u * F.NGW; ok[u] = row < nrows; if (ok[u]) {
            int t, L; if (row < NLAT) { t = row & (SEQ - 1); L = SEQ; } else { t = (row - NLAT) & (CTXL - 1); L = CTXL; }
            const bf16* pr = P + (size_t)row * NP + COL_CONV + c;
            q[u][0] = *(const u32x2*)pr; q[u][1] = *(const u32x2*)(pr + 256); q[u][2] = *(const u32x2*)(pr + 512);
            q[u][3] = t > 0 ? *(const u32x2*)(pr - NP + 256) : zero; q[u][4] = t > 0 ? *(const u32x2*)(pr - NP + 512) : zero;
            q[u][5] = t < L - 1 ? *(const u32x2*)(pr + NP + 256) : zero; q[u][6] = t < L - 1 ? *(const u32x2*)(pr + NP + 512) : zero; } }
#pragma unroll
        for (int u = 0; u < 2; ++u) if (ok[u]) { const int row = row0 + u * F.NGW;
            float bg[4], cg[4], hh[4], cp[4], hp[4], cn[4], hn[4];
            unpack4(q[u][0], bg); unpack4(q[u][1], cg); unpack4(q[u][2], hh); unpack4(q[u][3], cp); unpack4(q[u][4], hp); unpack4(q[u][5], cn); unpack4(q[u][6], hn);
            const float W0[4] = {w0.x, w0.y, w0.z, w0.w}, W1[4] = {w1.x, w1.y, w1.z, w1.w}, W2[4] = {w2.x, w2.y, w2.z, w2.w}, GN[4] = {gn.x, gn.y, gn.z, gn.w};
            float y[4], s = 0.f;
#pragma unroll
            for (int j = 0; j < 4; ++j) { y[j] = bg[j] * (W0[j] * (cp[j] * hp[j]) + W1[j] * (cg[j] * hh[j]) + W2[j] * (cn[j] * hn[j])); s += y[j] * y[j]; }
            const float rs = rsqrtf(wave_sum(s) * (1.f / 256.f) + RMS_EPS);
            u32x2 o; o.x = pk2(y[0] * rs * GN[0], y[1] * rs * GN[1]); o.y = pk2(y[2] * rs * GN[2], y[3] * rs * GN[3]);
            *(u32x2*)(MA + (size_t)row * D + 512 + c) = o; }
    }
}

__device__ __forceinline__ void sincos_turns(float x, float& s, float& c) { s = __builtin_amdgcn_sinf(x); c = __builtin_amdgcn_cosf(x); }
#define MFMA16(a, b, c) __builtin_amdgcn_mfma_f32_16x16x32_bf16((a), (b), (c), 0, 0, 0)

__device__ __forceinline__ void fftA_item(const Frame& F0, int item) {
    const Frame F = phase_frame(F0); unsigned char* const ws = F.ws;
    const int half = item & 1, t2 = (item >> 1) & 63, b = item >> 7;
    const bf16* P = (const bf16*)(ws + WS_P); bf16* GT = (bf16*)(ws + WS_GT);
    LAS bf16* Bs = (LAS bf16*)F.lds;
    const int lane = F.lane, w = F.wave, fr = lane & 15, fq = lane >> 4;
    __syncthreads();
#pragma unroll
    for (int i = 0; i < 8; ++i) { const int cidx = F.tid + NTHR * i, krow = cidx >> 4, ch8 = cidx & 15, ri = krow >> 7, t1 = krow & 127;
        const u32x4 v = *(const u32x4*)(P + (size_t)(b * SEQ + t1 * 64 + t2) * NP + COL_FC + ri * 256 + half * 128 + ch8 * 8);
        LAS bf16* d = Bs + (ch8 * 8) * 264 + krow;
        d[0 * 264] = (bf16)(v.x & 0xffffu); d[1 * 264] = (bf16)(v.x >> 16); d[2 * 264] = (bf16)(v.y & 0xffffu); d[3 * 264] = (bf16)(v.y >> 16);
        d[4 * 264] = (bf16)(v.z & 0xffffu); d[5 * 264] = (bf16)(v.z >> 16); d[6 * 264] = (bf16)(v.w & 0xffffu); d[7 * 264] = (bf16)(v.w >> 16); }
    __syncthreads();
    f32x4 acc[2][8];
#pragma unroll
    for (int a = 0; a < 2; ++a)
#pragma unroll
        for (int n = 0; n < 8; ++n) acc[a][n] = (f32x4){0.f, 0.f, 0.f, 0.f};
    int t1p_a = 16 * w + fr;
    asm volatile("" : "+v"(t1p_a));
#pragma unroll
    for (int ks = 0; ks < 8; ++ks) {
        bf16x8 ar, ai;
#pragma unroll
        for (int j = 0; j < 8; ++j) { const int k = ks * 32 + 8 * fq + j, ri = k >> 7, t1 = k & 127; const int idx = (t1 * t1p_a) & 127;
            float sn, cs; sincos_turns((float)idx * (1.f / 128.f), sn, cs);
            const float vr = ri == 0 ? cs : -sn, vi = ri == 0 ? -sn : -cs;
            ar[j] = (short)f2bf(vr); ai[j] = (short)f2bf(vi); }
#pragma unroll
        for (int nt = 0; nt < 8; ++nt) { const bf16x8 bfr = *(const LAS bf16x8*)(Bs + (nt * 16 + fr) * 264 + ks * 32 + 8 * fq);
            acc[0][nt] = MFMA16(ar, bfr, acc[0][nt]); acc[1][nt] = MFMA16(ai, bfr, acc[1][nt]); }
    }
#pragma unroll
    for (int reg = 0; reg < 4; ++reg) { const int t1p = 16 * w + 4 * fq + reg; float st, ct; sincos_turns((float)(t2 * t1p) * (1.f / 8192.f), st, ct);
        bf16* g = GT + ((size_t)((b * 128 + t1p) * 64 + t2) * 2) * 256 + half * 128 + fr;
#pragma unroll
        for (int nt = 0; nt < 8; ++nt) { const float gr = acc[0][nt][reg], gi = acc[1][nt][reg];
            g[nt * 16] = (bf16)f2bf(gr * ct + gi * st); g[256 + nt * 16] = (bf16)f2bf(gi * ct - gr * st); } }
}

template <int NKC, int NDIV, class SrcRow, class OutRow>
__device__ __forceinline__ void dft64_item(const Frame& F0, int l, int m0, float sgn, float scale, SrcRow src, OutRow orow) {
    const Frame F = phase_frame(F0); unsigned char* const ws = F.ws;
    LAS bf16* Bs = (LAS bf16*)F.lds;
    LAS float* red = (LAS float*)(F.lds + 256 * 136 * 2);
    const int lane = F.lane, w = F.wave, fr = lane & 15, fq = lane >> 4;
    int fr_a = fr; asm volatile("" : "+v"(fr_a));
    f32x4 acc[4][2];
#pragma unroll
    for (int a = 0; a < 4; ++a) { acc[a][0] = (f32x4){0.f, 0.f, 0.f, 0.f}; acc[a][1] = (f32x4){0.f, 0.f, 0.f, 0.f}; }
    for (int kc = 0; kc < NKC; ++kc) {
        __syncthreads();
#pragma unroll
        for (int i = 0; i < 8; ++i) { const int cidx = F.tid + NTHR * i, krow = cidx >> 5, ch8 = cidx & 31;
            const u32x4 v = *(const u32x4*)(src(kc * 64 + (krow >> 1), krow & 1) + ch8 * 8);
            LAS bf16* d = Bs + (ch8 * 8) * 136 + krow;
            d[0 * 136] = (bf16)(v.x & 0xffffu); d[1 * 136] = (bf16)(v.x >> 16); d[2 * 136] = (bf16)(v.y & 0xffffu); d[3 * 136] = (bf16)(v.y >> 16);
            d[4 * 136] = (bf16)(v.z & 0xffffu); d[5 * 136] = (bf16)(v.z >> 16); d[6 * 136] = (bf16)(v.w & 0xffffu); d[7 * 136] = (bf16)(v.w >> 16); }
        __syncthreads();
#pragma unroll
        for (int ks = 0; ks < 4; ++ks) {
            const bf16x8 b0 = *(const LAS bf16x8*)(Bs + ((2 * w) * 16 + fr) * 136 + ks * 32 + 8 * fq);
            const bf16x8 b1 = *(const LAS bf16x8*)(Bs + ((2 * w + 1) * 16 + fr) * 136 + ks * 32 + 8 * fq);
#pragma unroll
            for (int mt = 0; mt < 4; ++mt) { const int mrow = m0 + mt * 16 + fr_a; bf16x8 a;
#pragma unroll
                for (int j = 0; j < 8; ++j) { const int k = ks * 32 + 8 * fq + j, tl = k >> 1, ri = k & 1; const int idx = ((kc * 64 + tl) * mrow) & (NDIV - 1);
                    float sn, cs; sincos_turns((float)idx * (1.f / (float)NDIV), sn, cs);
                    a[j] = (short)f2bf(ri == 0 ? cs : sgn * sn); }
                acc[mt][0] = MFMA16(a, b0, acc[mt][0]); acc[mt][1] = MFMA16(a, b1, acc[mt][1]); }
        }
    }
#pragma unroll
    for (int mt = 0; mt < 4; ++mt)
#pragma unroll
        for (int reg = 0; reg < 4; ++reg) { const float a = acc[mt][0][reg] * scale, b = acc[mt][1][reg] * scale; acc[mt][0][reg] = a; acc[mt][1][reg] = b;
            float s = a * a + b * b; s += __shfl_xor(s, 1); s += __shfl_xor(s, 2); s += __shfl_xor(s, 4); s += __shfl_xor(s, 8);
            if (fr == 0) red[w * 64 + mt * 16 + 4 * fq + reg] = s; }
    __syncthreads();
    bf16* MA = (bf16*)(ws + WS_H); const float* fg = inptr(I_FOURG) + l * 256;
    const float g0 = fg[(2 * w) * 16 + fr], g1 = fg[(2 * w + 1) * 16 + fr];
#pragma unroll
    for (int mt = 0; mt < 4; ++mt)
#pragma unroll
        for (int reg = 0; reg < 4; ++reg) { const int ml = mt * 16 + 4 * fq + reg; float tot = 0.f;
#pragma unroll
            for (int ww = 0; ww < 8; ++ww) tot += red[ww * 64 + ml];
            const float rs = rsqrtf(tot * (1.f / 256.f) + RMS_EPS);
            bf16* o = MA + (size_t)orow(m0 + ml) * D + 768 + fr;
            o[(2 * w) * 16] = (bf16)f2bf(acc[mt][0][reg] * rs * g0); o[(2 * w + 1) * 16] = (bf16)f2bf(acc[mt][1][reg] * rs * g1); }
    __syncthreads();
}

constexpr size_t WS_LORA = 64 * 1024;
constexpr int LINP = 392;
__device__ __forceinline__ float fast_sigmoid(float x) { return __builtin_amdgcn_rcpf(1.f + __expf(-x)); }
__device__ __forceinline__ float fast_tanh(float x) { return 1.f - 2.f * __builtin_amdgcn_rcpf(1.f + __expf(2.f * x)); }
__device__ __forceinline__ void prep_phase(const Frame& F0, int l) {
    const Frame F = phase_frame(F0); unsigned char* const ws = F.ws;
    const bf16* Zs = (const bf16*)(ws + WS_ZS); bf16* STR = (bf16*)(ws + WS_STR);
    LAS bf16* lin = (LAS bf16*)F.lds;
    LAS float* ssum = (LAS float*)(F.lds + 12544);
    LAS bf16* tiles = (LAS bf16*)(F.lds + 13312);
    const int lane = F.lane, fr = lane & 15, fq = lane >> 4, w = F.wave, tid = F.tid;
    const int nitems = (NROW / 16) * 2;
    int it = blockIdx.x; if (it >= nitems) return;
    int hh = -1, head = 0, cb = 0;
    bf16x8 wf[12][2];
    const float* kkp = inptr(I_KK) + l * DR; const float* kap = inptr(I_KA) + l * DR; const float* dw0 = inptr(I_DW0) + l * 2 * DR; const float* ia0 = inptr(I_IA0) + l * 2 * DR;
    u32x4 pz[2];
#define PREP_LOAD(item_) do { const int row0_ = ((item_) >> 1) * 16; \
        pz[0] = *(const u32x4*)(Zs + (size_t)(row0_ + tid / 48) * ZW + 1536 + (tid % 48) * 8); \
        if (tid < 256) pz[1] = *(const u32x4*)(Zs + (size_t)(row0_ + (tid + 512) / 48) * ZW + 1536 + ((tid + 512) % 48) * 8); } while (0)
    PREP_LOAD(it);
    for (; it < nitems; it += F.G) {
        const int tile = it >> 1;
        if ((it & 1) != hh) {
            hh = it & 1; head = 4 * hh + (w >> 1); cb = 64 * head + 32 * (w & 1);
            const bf16* WL = (const bf16*)(ws + WS_LORA) + (size_t)l * 512 * 384 + (size_t)(cb + fr) * 384 + 8 * fq;
#pragma unroll
            for (int ks = 0; ks < 12; ++ks)
#pragma unroll
                for (int nt = 0; nt < 2; ++nt) wf[ks][nt] = *(const bf16x8*)(WL + (size_t)nt * 16 * 384 + ks * 32);
        }
        __syncthreads();
        {   float v[8]; unpack8(pz[0], v); const int c8 = tid % 48;
            if (c8 < 16) {
#pragma unroll
                for (int j = 0; j < 8; ++j) v[j] = fast_tanh(v[j]); }
            else if (c8 >= 32) {
#pragma unroll
                for (int j = 0; j < 8; ++j) v[j] = fast_sigmoid(v[j]); }
            *(LAS u32x4*)(lin + (tid / 48) * LINP + c8 * 8) = (u32x4){pk2(v[0], v[1]), pk2(v[2], v[3]), pk2(v[4], v[5]), pk2(v[6], v[7])};
            if (tid < 256) { unpack8(pz[1], v); const int c9 = (tid + 512) % 48;
                if (c9 < 16) {
#pragma unroll
                    for (int j = 0; j < 8; ++j) v[j] = fast_tanh(v[j]); }
                else if (c9 >= 32) {
#pragma unroll
                    for (int j = 0; j < 8; ++j) v[j] = fast_sigmoid(v[j]); }
                *(LAS u32x4*)(lin + ((tid + 512) / 48) * LINP + c9 * 8) = (u32x4){pk2(v[0], v[1]), pk2(v[2], v[3]), pk2(v[4], v[5]), pk2(v[6], v[7])}; } }
        u32x2 zr2[2], zk2[2], zv2[2];
        {   const bf16* zr_ = Zs + (size_t)(tile * 16 + fr) * ZW + cb + 4 * fq;
#pragma unroll
            for (int nt = 0; nt < 2; ++nt) { zr2[nt] = *(const u32x2*)(zr_ + 16 * nt); zk2[nt] = *(const u32x2*)(zr_ + 512 + 16 * nt); zv2[nt] = *(const u32x2*)(zr_ + 1024 + 16 * nt); } }
        if (it + F.G < nitems) PREP_LOAD(it + F.G);
        __syncthreads();
        f32x4 kkw[2], kaw[2], d0w[2][2], i0w[2][2];
#pragma unroll
        for (int nt = 0; nt < 2; ++nt) { const int c0 = cb + 16 * nt + 4 * fq; kkw[nt] = *(const f32x4*)(kkp + c0); kaw[nt] = *(const f32x4*)(kap + c0);
#pragma unroll
            for (int dn = 0; dn < 2; ++dn) { d0w[dn][nt] = *(const f32x4*)(dw0 + dn * DR + c0); i0w[dn][nt] = *(const f32x4*)(ia0 + dn * DR + c0); } }
        f32x4 acc[5][2];
#pragma unroll
        for (int q = 0; q < 5; ++q) { acc[q][0] = (f32x4){0.f, 0.f, 0.f, 0.f}; acc[q][1] = (f32x4){0.f, 0.f, 0.f, 0.f}; }
#pragma unroll
        for (int ks = 0; ks < 12; ++ks) { const int q = ks < 8 ? (ks >> 1) : 4; const bf16x8 xf = *(const LAS bf16x8*)(lin + fr * LINP + ks * 32 + 8 * fq);
            acc[q][0] = MFMA16(wf[ks][0], xf, acc[q][0]); acc[q][1] = MFMA16(wf[ks][1], xf, acc[q][1]); }
        float zk[2][4], kv[2][4]; float ss = 0.f;
#pragma unroll
        for (int nt = 0; nt < 2; ++nt) { unpack4(zk2[nt], zk[nt]);
#pragma unroll
            for (int i = 0; i < 4; ++i) { kv[nt][i] = zk[nt][i] * kkw[nt][i]; ss += kv[nt][i] * kv[nt][i]; } }
        ss += __shfl_xor(ss, 16); ss += __shfl_xor(ss, 32);
        if (fq == 0) ssum[w * 16 + fr] = ss;
        __syncthreads();
        const float inv = __builtin_amdgcn_rcpf(fmaxf(sqrtf(ssum[w * 16 + fr] + ssum[(w ^ 1) * 16 + fr]), 1e-12f));
        LAS bf16* th = tiles + (w >> 1) * 10 * 1024 + fr * 64 + 32 * (w & 1) + 4 * fq;
#pragma unroll
        for (int nt = 0; nt < 2; ++nt) { LAS bf16* t0 = th + 16 * nt;
            *(LAS u32x2*)(t0) = zr2[nt]; *(LAS u32x2*)(t0 + 1024) = zv2[nt];
            float kk[4];
#pragma unroll
            for (int i = 0; i < 4; ++i) kk[i] = kv[nt][i] * inv;
            *(LAS u32x2*)(t0 + 2 * 1024) = (u32x2){pk2(kk[0], kk[1]), pk2(kk[2], kk[3])};
            *(LAS u32x2*)(t0 + 3 * 1024) = (u32x2){pk2(acc[4][nt][0], acc[4][nt][1]), pk2(acc[4][nt][2], acc[4][nt][3])};
#pragma unroll
            for (int dn = 0; dn < 2; ++dn) { float ep[4], kd[4], bb[4];
#pragma unroll
                for (int i = 0; i < 4; ++i) { const float ew = fast_sigmoid(d0w[dn][nt][i] + acc[dn][nt][i]) * 0.6065306597126334f;
                    ep[i] = ew * (1.f + ew * (-0.5f + ew * (0.16666667f + ew * (-0.041666668f + ew * 0.0083333338f))));
                    const float a = fast_sigmoid(i0w[dn][nt][i] + acc[2 + dn][nt][i]); kd[i] = zk[nt][i] * (1.f + (a - 1.f) * kaw[nt][i]); bb[i] = kk[i] * a; }
                *(LAS u32x2*)(t0 + (4 + 3 * dn) * 1024) = (u32x2){pk2(ep[0], ep[1]), pk2(ep[2], ep[3])};
                *(LAS u32x2*)(t0 + (5 + 3 * dn) * 1024) = (u32x2){pk2(kd[0], kd[1]), pk2(kd[2], kd[3])};
                *(LAS u32x2*)(t0 + (6 + 3 * dn) * 1024) = (u32x2){pk2(bb[0], bb[1]), pk2(bb[2], bb[3])}; } }
        __syncthreads();
        {   const LAS bf16* src = tiles + (w >> 1) * 10 * 1024 + 8 * (w & 1) * 64 + lane * 8; bf16* dst = STR + ((size_t)tile * 8 + head) * 10240 + 8 * (w & 1) * 64 + lane * 8;
#pragma unroll
            for (int s = 0; s < 10; ++s) *(u32x4*)(dst + s * 1024) = *(const LAS u32x4*)(src + s * 1024); }
    }
#undef PREP_LOAD
}

__device__ __forceinline__ int scan_rowof(int s, int dir, int b) { if (s < CTXL) { const int tc = dir ? (CTXL - 1 - s) : s; return NLAT + b * CTXL + tc; } const int tt = s - CTXL; const int t = dir ? (SEQ - 1 - tt) : tt; return b * SEQ + t; }
__device__ __forceinline__ void readout_pass(const Frame& F0, int l, int nrows) {
    const Frame F = phase_frame(F0); unsigned char* const ws = F.ws;
    const bf16* STR = (const bf16*)(ws + WS_STR); const bf16* Y0 = (const bf16*)(ws + WS_Y); const bf16* Y1 = Y0 + (size_t)NROW * DR; bf16* MA = (bf16*)(ws + WS_H);
    const int lane = F.lane, c = 8 * lane;
    float gw[8], gb[8], rk[8];
    {   const float* gnw = inptr(I_GNW) + l * DR + c; const float* gnb = inptr(I_GNB) + l * DR + c; const float* rkp = inptr(I_RK) + l * DR + c;
        const f32x4 a0 = *(const f32x4*)gnw, a1 = *(const f32x4*)(gnw + 4), b0 = *(const f32x4*)gnb, b1 = *(const f32x4*)(gnb + 4), r0 = *(const f32x4*)rkp, r1 = *(const f32x4*)(rkp + 4);
#pragma unroll
        for (int i = 0; i < 4; ++i) { gw[i] = a0[i]; gw[4 + i] = a1[i]; gb[i] = b0[i]; gb[4 + i] = b1[i]; rk[i] = r0[i]; rk[4 + i] = r1[i]; } }
    for (int row0 = F.gw; row0 < nrows; row0 += 2 * F.NGW) {
        u32x4 q[2][7]; bool ok[2];
#pragma unroll
        for (int u = 0; u < 2; ++u) { const int row = row0 + u * F.NGW; ok[u] = row < nrows; if (ok[u]) {
            const bf16* sr = STR + ((size_t)(row >> 4) * 8 + (lane >> 3)) * 10240 + (row & 15) * 64 + (lane & 7) * 8;
            q[u][0] = *(const u32x4*)(Y0 + (size_t)row * DR + c); q[u][1] = *(const u32x4*)(Y1 + (size_t)row * DR + c);
            q[u][2] = *(const u32x4*)sr; q[u][3] = *(const u32x4*)(sr + 1024); q[u][4] = *(const u32x4*)(sr + 3072); q[u][5] = *(const u32x4*)(sr + 5 * 1024); q[u][6] = *(const u32x4*)(sr + 8 * 1024); } }
#pragma unroll
        for (int u = 0; u < 2; ++u) if (ok[u]) { const int row = row0 + u * F.NGW;
            float ya[8], yb[8], r[8], v[8], g[8], k0[8], k1[8];
            unpack8(q[u][0], ya); unpack8(q[u][1], yb); unpack8(q[u][2], r); unpack8(q[u][3], v); unpack8(q[u][4], g); unpack8(q[u][5], k0); unpack8(q[u][6], k1);
            float s1 = 0.f, s2 = 0.f, sb = 0.f;
#pragma unroll
            for (int i = 0; i < 8; ++i) { ya[i] += yb[i]; s1 += ya[i]; s2 += ya[i] * ya[i]; sb += r[i] * (k0[i] + k1[i]) * rk[i]; }
#pragma unroll
            for (int o = 1; o < 8; o <<= 1) { s1 += __shfl_xor(s1, o); s2 += __shfl_xor(s2, o); sb += __shfl_xor(sb, o); }
            const float mu = s1 * (1.f / 64.f); const float var = fmaxf(s2 * (1.f / 64.f) - mu * mu, 0.f); const float rs = rsqrtf(var + GN_EPS);
            float o8[8];
#pragma unroll
            for (int i = 0; i < 8; ++i) o8[i] = ((ya[i] - mu) * rs * gw[i] + gb[i] + sb * v[i]) * g[i];
            *(u32x4*)(MA + (size_t)row * D + c) = (u32x4){pk2(o8[0], o8[1]), pk2(o8[2], o8[3]), pk2(o8[4], o8[5]), pk2(o8[6], o8[7])}; }
    }
}
constexpr int BLOB = 16384, SEGCH = 132, NSEG = 4, BLOB_B1_SCANS = 14;
constexpr size_t WS_BLOBA = 20 * MiB, WS_BLOBB1 = 86 * MiB, WS_BLOBB2 = 492 * MiB;
constexpr size_t WS_SCANST = 2 * MiB + 512 * 1024;
__device__ __forceinline__ unsigned char* blob_ptr(unsigned char* ws, int seg, int scan, int ci) {
    if ((seg & 1) == 0) return ws + WS_BLOBA + ((size_t)scan * SEGCH + ci) * BLOB;
    return scan < BLOB_B1_SCANS ? ws + WS_BLOBB1 + ((size_t)scan * SEGCH + ci) * BLOB : ws + WS_BLOBB2 + ((size_t)(scan - BLOB_B1_SCANS) * SEGCH + ci) * BLOB;
}
typedef short s16x4 __attribute__((ext_vector_type(4)));
__device__ __forceinline__ bf16x8 frag_lo(u32x2 x) { u32x4 t = {x.x, x.y, 0u, 0u}; return __builtin_bit_cast(bf16x8, t); }
__device__ __forceinline__ bf16x8 frag_c(const f32x4& a) { u32x4 t = {pk2(a[0], a[1]), pk2(a[2], a[3]), 0u, 0u}; return __builtin_bit_cast(bf16x8, t); }

struct PreRegs { u32x4 q[12]; };
__device__ __forceinline__ void pre_load(PreRegs& R, unsigned char* ws, int scan, int cs, int lane) {
    const int dir = scan & 1, h = (scan >> 1) & 7, b = scan >> 4; const int rfirst = scan_rowof(16 * cs, dir, b);
    const bf16* blk = (const bf16*)(ws + WS_STR) + ((size_t)(rfirst >> 4) * 8 + h) * 10240 + lane * 8;
    const int so[6] = {0, 1, 2, 4 + 3 * dir, 5 + 3 * dir, 6 + 3 * dir};
#pragma unroll
    for (int i = 0; i < 6; ++i) { R.q[2 * i] = *(const u32x4*)(blk + so[i] * 1024); R.q[2 * i + 1] = *(const u32x4*)(blk + so[i] * 1024 + 512); }
}
template <int PM>
__device__ __forceinline__ void pre_item(const Frame& F, unsigned char* ws, int scan, int cs, unsigned char* blob, PreRegs& PR, int nscan, int ncs) {
    const int dir = scan & 1, h = (scan >> 1) & 7, b = scan >> 4; const int lane = F.lane, fr = lane & 15, fq = lane >> 4;
    LAS unsigned char* L = F.lds + F.wave * 17408;
    LAS bf16* TK = (LAS bf16*)L; LAS bf16* TR = TK + 1024; LAS bf16* TKt = TR + 1024; LAS bf16* TB = TKt + 1024;
    LAS bf16* KTt = TB + 1024; LAS bf16* RTt = KTt + 1024; LAS bf16* Vt = RTt + 1024;
    LAS float* AKB = (LAS float*)(Vt + 1024);
    LAS bf16* AKK = (LAS bf16*)(AKB + 256); LAS bf16* ARK = AKK + 256; LAS bf16* ARB = ARK + 256; LAS bf16* TT = ARB + 256;
    float kh[16], bh[16];
    float pc;
    {   float r_[16], v_[16], kk_[16], lp_[16], kd_[16], bb_[16];
        LAS bf16* stg = TK;
#pragma unroll
        for (int i = 0; i < 6; ++i) { *(LAS u32x4*)(stg + i * 1024 + lane * 8) = PR.q[2 * i]; *(LAS u32x4*)(stg + i * 1024 + 512 + lane * 8) = PR.q[2 * i + 1]; }
        LDS_WAIT(); asm volatile("" ::: "memory");
        if (nscan >= 0) pre_load(PR, ws, nscan, ncs, lane);
#pragma unroll
        for (int t = 0; t < 16; ++t) { const int tm = (dir ? 15 - t : t) * 64 + lane;
            r_[t] = bf2f(stg[tm]); v_[t] = bf2f(stg[1024 + tm]); kk_[t] = bf2f(stg[2048 + tm]); lp_[t] = bf2f(stg[3072 + tm]); kd_[t] = bf2f(stg[4096 + tm]); bb_[t] = bf2f(stg[5120 + tm]); }
        LDS_WAIT(); asm volatile("" ::: "memory");
        float lp = 0.f; u32x4 kt4[2], rt4[2], v4[2];
        unsigned ktp[8], rtp[8], vp[8];
#pragma unroll
        for (int t = 0; t < 16; ++t) { const float pm1 = __expf(lp); lp += __logf(1.f - lp_[t]); lp_[t] = lp; const float p = __expf(lp), ip = __expf(-lp);
            const float kt = kk_[t] * pm1, ktl = kd_[t] * ip, btl = bb_[t] * ip, rt = r_[t] * p;
            TK[t * 64 + lane] = (bf16)f2bf(kt); TR[t * 64 + lane] = (bf16)f2bf(rt); TKt[t * 64 + lane] = (bf16)f2bf(ktl); TB[t * 64 + lane] = (bf16)f2bf(btl);
            if (t & 1) { ktp[t >> 1] |= f2bf(kt) << 16; rtp[t >> 1] |= f2bf(rt) << 16; vp[t >> 1] |= f2bf(v_[t]) << 16; }
            else { ktp[t >> 1] = f2bf(kt); rtp[t >> 1] = f2bf(rt); vp[t >> 1] = f2bf(v_[t]); } }
        kt4[0] = (u32x4){ktp[0], ktp[1], ktp[2], ktp[3]}; kt4[1] = (u32x4){ktp[4], ktp[5], ktp[6], ktp[7]};
        rt4[0] = (u32x4){rtp[0], rtp[1], rtp[2], rtp[3]}; rt4[1] = (u32x4){rtp[4], rtp[5], rtp[6], rtp[7]};
        v4[0] = (u32x4){vp[0], vp[1], vp[2], vp[3]}; v4[1] = (u32x4){vp[4], vp[5], vp[6], vp[7]};
        *(LAS u32x4*)(KTt + lane * 16) = kt4[0]; *(LAS u32x4*)(KTt + lane * 16 + 8) = kt4[1];
        *(LAS u32x4*)(RTt + lane * 16) = rt4[0]; *(LAS u32x4*)(RTt + lane * 16 + 8) = rt4[1];
        *(LAS u32x4*)(Vt + lane * 16) = v4[0]; *(LAS u32x4*)(Vt + lane * 16 + 8) = v4[1];
        pc = __expf(lp);
#pragma unroll
        for (int t = 0; t < 16; ++t) { const float e = __expf(lp - lp_[t]); kh[t] = kd_[t] * e; bh[t] = bb_[t] * e; }
    }
    LDS_WAIT(); asm volatile("" ::: "memory");
    {   f32x4 akb = {0.f, 0.f, 0.f, 0.f}, akk = akb, ark = akb, arb = akb;
#pragma unroll
        for (int s = 0; s < 2; ++s) { const int o = fr * 64 + 32 * s + 8 * fq;
            const bf16x8 fk = *(const LAS bf16x8*)(TK + o), frr = *(const LAS bf16x8*)(TR + o), fkt = *(const LAS bf16x8*)(TKt + o), fb = *(const LAS bf16x8*)(TB + o);
            akb = MFMA16(fk, fb, akb); akk = MFMA16(fk, fkt, akk); ark = MFMA16(frr, fkt, ark); arb = MFMA16(frr, fb, arb); }
        float nm[4];
#pragma unroll
        for (int reg = 0; reg < 4; ++reg) { const int t = 4 * fq + reg; const bool lo = fr < t, le = fr <= t;
            nm[reg] = lo ? akb[reg] : 0.f; AKK[t * 16 + fr] = (bf16)f2bf(lo ? akk[reg] : 0.f);
            ARK[t * 16 + fr] = (bf16)f2bf(le ? ark[reg] : 0.f); ARB[t * 16 + fr] = (bf16)f2bf(le ? arb[reg] : 0.f); }
        float col[16];
#pragma unroll
        for (int t = 0; t < 16; ++t) { float s_ = (t == fr) ? 1.f : 0.f;
#pragma unroll
            for (int i = 0; i < 16; ++i) if (i < t) { const float n_ti = __builtin_bit_cast(float, __builtin_amdgcn_readlane(__builtin_bit_cast(int, nm[t & 3]), i + 16 * (t >> 2))); s_ -= n_ti * col[i]; }
            col[t] = s_; TT[t * 16 + fr] = (bf16)f2bf(s_); }
    }
    LDS_WAIT(); asm volatile("" ::: "memory");
    f32x4 Wc[4], Rqc[4], U0c[4], Y0c[4];
    {   const bf16x8 aT = frag_lo(*(const LAS u32x2*)(TT + fr * 16 + 4 * fq)), aKK = frag_lo(*(const LAS u32x2*)(AKK + fr * 16 + 4 * fq)), aRK = frag_lo(*(const LAS u32x2*)(ARK + fr * 16 + 4 * fq));
        u32x2 nb = *(const LAS u32x2*)(ARB + fr * 16 + 4 * fq); nb.x ^= 0x80008000u; nb.y ^= 0x80008000u; const bf16x8 aRBn = frag_lo(nb);
        const f32x4 z4 = {0.f, 0.f, 0.f, 0.f};
#pragma unroll
        for (int nt = 0; nt < 4; ++nt) { const int o = (16 * nt + fr) * 16 + 4 * fq;
            const bf16x8 bK = frag_lo(*(const LAS u32x2*)(KTt + o)), bV = frag_lo(*(const LAS u32x2*)(Vt + o));
            float ri[4]; unpack4(*(const LAS u32x2*)(RTt + o), ri);
            Wc[nt] = MFMA16(aT, bK, z4); const f32x4 Zn = MFMA16(aKK, bV, z4);
            U0c[nt] = MFMA16(aT, frag_c(Zn), z4);
            Rqc[nt] = MFMA16(aRBn, frag_c(Wc[nt]), ((f32x4){ri[0], ri[1], ri[2], ri[3]}));
            Y0c[nt] = MFMA16(aRK, bV, z4); Y0c[nt] = MFMA16(aRBn, frag_c(U0c[nt]), Y0c[nt]); }
    }
    LDS_WAIT(); asm volatile("" ::: "memory");

#pragma unroll
    for (int nt = 0; nt < 4; ++nt) { const u32x2 vv = *(const LAS u32x2*)(Vt + (16 * nt + fr) * 16 + 4 * fq);
        *(u32x2*)(blob + 8192 + nt * 2048 + 1024 + lane * 8) = vv;
        u32x2 u0 = {pk2(U0c[nt][0], U0c[nt][1]), pk2(U0c[nt][2], U0c[nt][3])}, y0 = {pk2(Y0c[nt][0], Y0c[nt][1]), pk2(Y0c[nt][2], Y0c[nt][3])};
        *(u32x2*)(blob + 8192 + nt * 2048 + lane * 8) = u0; *(u32x2*)(blob + 8192 + nt * 2048 + 512 + lane * 8) = y0;
        *(float*)(blob + 8192 + nt * 2048 + 1536 + lane * 4) = pc; }
    LAS bf16* WT = TK; LAS bf16* RQT = TR; LAS bf16* BHt = TKt; LAS bf16* KHt = TB;
#pragma unroll
    for (int nt = 0; nt < 4; ++nt)
#pragma unroll
        for (int reg = 0; reg < 4; ++reg) { WT[(4 * fq + reg) * 64 + 16 * nt + fr] = (bf16)f2bf(Wc[nt][reg]); RQT[(4 * fq + reg) * 64 + 16 * nt + fr] = (bf16)f2bf(Rqc[nt][reg]); }
    {   u32x4 a, c, d, e;
        a = (u32x4){pk2(bh[0], bh[1]), pk2(bh[2], bh[3]), pk2(bh[4], bh[5]), pk2(bh[6], bh[7])}; c = (u32x4){pk2(bh[8], bh[9]), pk2(bh[10], bh[11]), pk2(bh[12], bh[13]), pk2(bh[14], bh[15])};
        d = (u32x4){pk2(kh[0], kh[1]), pk2(kh[2], kh[3]), pk2(kh[4], kh[5]), pk2(kh[6], kh[7])}; e = (u32x4){pk2(kh[8], kh[9]), pk2(kh[10], kh[11]), pk2(kh[12], kh[13]), pk2(kh[14], kh[15])};
        *(LAS u32x4*)(BHt + lane * 16) = a; *(LAS u32x4*)(BHt + lane * 16 + 8) = c; *(LAS u32x4*)(KHt + lane * 16) = d; *(LAS u32x4*)(KHt + lane * 16 + 8) = e; }
    LDS_WAIT(); asm volatile("" ::: "memory");
#pragma unroll
    for (int s = 0; s < 2; ++s) { const int o = fr * 64 + 32 * s + 4 * fq;
        const u32x2 w0 = *(const LAS u32x2*)(WT + o), w1 = *(const LAS u32x2*)(WT + o + 16), q0 = *(const LAS u32x2*)(RQT + o), q1 = *(const LAS u32x2*)(RQT + o + 16);
        *(u32x4*)(blob + (0 * 2 + s) * 1024 + lane * 16) = (u32x4){w0.x, w0.y, w1.x, w1.y};
        *(u32x4*)(blob + (1 * 2 + s) * 1024 + lane * 16) = (u32x4){q0.x, q0.y, q1.x, q1.y}; }
#pragma unroll
    for (int mt = 0; mt < 4; ++mt) { const int o = (16 * mt + fr) * 16 + 4 * fq; const u32x2 bb = *(const LAS u32x2*)(BHt + o), kk = *(const LAS u32x2*)(KHt + o);
        *(u32x4*)(blob + 4096 + mt * 1024 + lane * 16) = (u32x4){bb.x ^ 0x80008000u, bb.y ^ 0x80008000u, kk.x, kk.y}; }
    LDS_WAIT(); asm volatile("" ::: "memory");
}

__device__ __forceinline__ void pre_phase(const Frame& F0, int seg, int b_lo) {
    const Frame F = phase_frame(F0); unsigned char* const ws = F.ws;
    if ((int)blockIdx.x < b_lo) return;
    const int nwv = (F.G - b_lo) * NWAVES;
    PreRegs R;
    int it = ((int)blockIdx.x - b_lo) * NWAVES + F.wave; if (it >= 32 * SEGCH) return;
    pre_load(R, ws, it & 31, seg * SEGCH + (it >> 5), F.lane);
    for (; it < 32 * SEGCH; it += nwv) { const int nx = it + nwv; const bool hn = nx < 32 * SEGCH;
        pre_item<0>(F, ws, it & 31, seg * SEGCH + (it >> 5), blob_ptr(ws, seg, it & 31, it >> 5), R, hn ? (nx & 31) : -1, seg * SEGCH + (nx >> 5)); }
}

constexpr int SQ_SLOT = 10240, SQ_R = 12, SQ_D = 8;
template <int MODE>
__device__ __forceinline__ void seq_item(const Frame& F0, int item, int seg, bool need_ctx) {
    const Frame F = phase_frame(F0); unsigned char* const ws = F.ws;
    const int scan = item >> 2, vb = item & 3, dir = scan & 1, h = (scan >> 1) & 7, b = scan >> 4; const int lane = F.lane, fr = lane & 15, fq = lane >> 4, w = F.wave;
    const unsigned char* blob = blob_ptr(ws, seg, scan, 0);
    LAS unsigned char* ring = F.lds;
    __syncthreads();
    const int p0 = 2 * (w - 1);
    const unsigned goff0 = (p0 < 8 ? p0 * 1024 : 8192 + vb * 2048 + (p0 - 8) * 1024) + lane * 16, goff1 = (p0 + 1 < 8 ? (p0 + 1) * 1024 : 8192 + vb * 2048 + (p0 + 1 - 8) * 1024) + lane * 16;
#define SQ_ISSUE(c) do { const unsigned char* g_ = blob + (size_t)(c) * BLOB; LAS unsigned char* s_ = ring + ((c) % SQ_R) * SQ_SLOT + p0 * 1024; \
        __builtin_amdgcn_global_load_lds((const unsigned*)(g_ + goff0), (LAS unsigned*)(s_), 16, 0, 0); \
        __builtin_amdgcn_global_load_lds((const unsigned*)(g_ + goff1), (LAS unsigned*)(s_ + 1024), 16, 0, 0); } while (0)
    const bool loader = (w >= 1 && w <= 5) && MODE != 2;
    if (loader) { for (int c = 0; c < SQ_D; ++c) SQ_ISSUE(c); }
    bf16* Y = (bf16*)(ws + WS_Y) + (size_t)dir * NROW * DR + h * 64 + 16 * vb + fr;
    float* st = (float*)(ws + WS_SCANST) + (size_t)item * 1024 + lane * 4;
    f32x4 M[4];
#pragma unroll
    for (int mt = 0; mt < 4; ++mt) M[mt] = (seg == 0 || w != 0) ? (f32x4){0.f, 0.f, 0.f, 0.f} : *(const f32x4*)(st + mt * 256);
    const f32x4 z4 = {0.f, 0.f, 0.f, 0.f};
    LAS unsigned char* mb = ring + SQ_R * SQ_SLOT;
    struct SQ { bf16x8 a1[2], a2[4]; f32x4 pc[4]; u32x2 u0, vv; };
#define SQ_READ(R, c) do { const LAS unsigned char* sl_ = ring + ((c) % SQ_R) * SQ_SLOT; _Pragma("unroll") for (int i = 0; i < 4; ++i) { \
        R.a2[i] = *(const LAS bf16x8*)(sl_ + 4096 + i * 1024 + lane * 16); R.pc[i] = *(const LAS f32x4*)(sl_ + 8192 + 1536 + (16 * i + 4 * fq) * 4); } \
        R.a1[0] = *(const LAS bf16x8*)(sl_ + lane * 16); R.a1[1] = *(const LAS bf16x8*)(sl_ + 1024 + lane * 16); \
        R.u0 = *(const LAS u32x2*)(sl_ + 8192 + lane * 8); R.vv = *(const LAS u32x2*)(sl_ + 8192 + 1024 + lane * 8); } while (0)
#define SQ_STEP(R, c, RN, cn) do { \
        if ((cn) < SEGCH) SQ_READ(RN, cn); \
        const u32x4 t0 = {pk2(M[0][0], M[0][1]), pk2(M[0][2], M[0][3]), pk2(M[1][0], M[1][1]), pk2(M[1][2], M[1][3])}; \
        const u32x4 t1 = {pk2(M[2][0], M[2][1]), pk2(M[2][2], M[2][3]), pk2(M[3][0], M[3][1]), pk2(M[3][2], M[3][3])}; \
        *(LAS u32x4*)(mb + ((c) & 1) * 2048 + lane * 16) = t0; *(LAS u32x4*)(mb + ((c) & 1) * 2048 + 1024 + lane * 16) = t1; \
        const bf16x8 b0 = __builtin_bit_cast(bf16x8, t0), b1 = __builtin_bit_cast(bf16x8, t1); \
        f32x4 X0 = MFMA16(R.a1[0], b0, z4); X0 = MFMA16(R.a1[1], b1, X0); \
        float u0[4]; unpack4(R.u0, u0); \
        const u32x4 tb = {pk2(X0[0] + u0[0], X0[1] + u0[1]), pk2(X0[2] + u0[2], X0[3] + u0[3]), R.vv.x, R.vv.y}; const bf16x8 bB = __builtin_bit_cast(bf16x8, tb); \
        _Pragma("unroll") for (int mt = 0; mt < 4; ++mt) M[mt] = MFMA16(R.a2[mt], bB, R.pc[mt] * M[mt]); \
        asm volatile("s_waitcnt lgkmcnt(0)" ::: "memory"); } while (0)
    const long ystep = dir ? -(long)DR : (long)DR;
#define SQ_YSTEP(c) do { const int cs_ = seg * SEGCH + (c); if (MODE == 0 && (need_ctx || cs_ >= 16)) { const LAS unsigned char* sl_ = ring + ((c) % SQ_R) * SQ_SLOT; \
        const bf16x8 q0 = *(const LAS bf16x8*)(sl_ + 2048 + lane * 16), q1 = *(const LAS bf16x8*)(sl_ + 3072 + lane * 16); \
        const bf16x8 b0 = *(const LAS bf16x8*)(mb + ((c) & 1) * 2048 + lane * 16), b1 = *(const LAS bf16x8*)(mb + ((c) & 1) * 2048 + 1024 + lane * 16); \
        float y0[4]; unpack4(*(const LAS u32x2*)(sl_ + 8192 + 512 + lane * 8), y0); \
        f32x4 X1 = MFMA16(q0, b0, z4); X1 = MFMA16(q1, b1, X1); \
        bf16* yp = Y + (size_t)scan_rowof(16 * cs_ + 4 * fq, dir, b) * DR; \
        yp[0] = (bf16)f2bf(X1[0] + y0[0]); yp[ystep] = (bf16)f2bf(X1[1] + y0[1]); yp[2 * ystep] = (bf16)f2bf(X1[2] + y0[2]); yp[3 * ystep] = (bf16)f2bf(X1[3] + y0[3]); \
        asm volatile("s_waitcnt lgkmcnt(0)" ::: "memory"); } } while (0)
#define SQ_LOADER(c) do { if (loader) { __builtin_amdgcn_s_sleep(3); if ((c) + SQ_D < SEGCH) { SQ_ISSUE((c) + SQ_D); asm volatile("s_waitcnt vmcnt(12)" ::: "memory"); } else asm volatile("s_waitcnt vmcnt(0)" ::: "memory"); } \
        __builtin_amdgcn_s_barrier(); asm volatile("" ::: "memory"); } while (0)
    const bool stw = (w == 0 && MODE != 1), yw = (w == 6 && MODE != 1);
    SQ Ra, Rb, Rc;
    SQ_LOADER(0);
    if (stw) { SQ_READ(Ra, 0); SQ_READ(Rb, 1); }
    for (int c = 0; c < SEGCH; c += 3) {
        SQ_LOADER(c + 1);
        if (stw) SQ_STEP(Ra, c, Rc, c + 2);
        if (yw && c > 0) SQ_YSTEP(c - 1);
        SQ_LOADER(c + 2);
        if (stw) SQ_STEP(Rb, c + 1, Ra, c + 3);
        if (yw) SQ_YSTEP(c);
        SQ_LOADER(c + 3);
        if (stw) SQ_STEP(Rc, c + 2, Rb, c + 4);
        if (yw) SQ_YSTEP(c + 1);
    }
    __builtin_amdgcn_s_barrier(); asm volatile("" ::: "memory");
    if (yw) SQ_YSTEP(SEGCH - 1);
#undef SQ_READ
#undef SQ_STEP
#undef SQ_YSTEP
#undef SQ_LOADER
#undef SQ_ISSUE
    if (MODE >= 2 && w == 0 && M[0][0] + M[1][1] + M[2][2] + M[3][3] == 12345.678f) st[0] = M[0][0];
    if (MODE == 0 && w == 0 && seg + 1 < NSEG) {
#pragma unroll
        for (int mt = 0; mt < 4; ++mt) *(f32x4*)(st + mt * 256) = M[mt]; }
    __syncthreads();
}

namespace pg8 {
struct EpiStoreBf16 {
    static constexpr bool PERM = true, AFTER_DRAIN = false;
    bf16_t* O; int ldc; int pn_mask;
    __device__ __forceinline__ void operator()(const f32x4 (&acc)[2][2][4][2], const Unit& u, int wr, int wc, int fr, int fq) const {
        const int row0 = u.pm * BM + wr * 64 + fr; const int col0 = (u.pn & pn_mask) * BM + wc * 32 + 8 * fq;
#pragma unroll
        for (int ai = 0; ai < 2; ++ai)
#pragma unroll
            for (int m = 0; m < 4; ++m) { bf16_t* rowp = O + (size_t)(row0 + ai * HALF + m * 16) * ldc + col0;
#pragma unroll
                for (int bj = 0; bj < 2; ++bj) { const f32x4 v0 = acc[ai][bj][m][0], v1 = acc[ai][bj][m][1];
                    u32x4 w; w.x = cvt_pk_bf16(v0[0], v0[1]); w.y = cvt_pk_bf16(v0[2], v0[3]); w.z = cvt_pk_bf16(v1[0], v1[1]); w.w = cvt_pk_bf16(v1[2], v1[3]);
                    *(u32x4*)(rowp + bj * HALF) = w; } }
    }
};
struct EpiSwiGLU {
    static constexpr bool PERM = true, AFTER_DRAIN = false;
    bf16_t* O;
    __device__ __forceinline__ void operator()(const f32x4 (&acc)[2][2][4][2], const Unit& u, int wr, int wc, int fr, int fq) const {
        const int row0 = u.pm * BM + wr * 64 + fr; const int col0 = ((u.pn & 3) * BM + wc * 32 + 8 * fq) >> 1;
#pragma unroll
        for (int ai = 0; ai < 2; ++ai)
#pragma unroll
            for (int m = 0; m < 4; ++m) { bf16_t* rowp = O + (size_t)(row0 + ai * HALF + m * 16) * 512 + col0;
#pragma unroll
                for (int bj = 0; bj < 2; ++bj) { const f32x4 g = acc[ai][bj][m][0], up = acc[ai][bj][m][1]; float a[4];
#pragma unroll
                    for (int i = 0; i < 4; ++i) a[i] = g[i] / (1.f + __expf(-g[i])) * up[i];
                    unsigned long long w = (unsigned long long)cvt_pk_bf16(a[0], a[1]) | ((unsigned long long)cvt_pk_bf16(a[2], a[3]) << 32);
                    *(unsigned long long*)(rowp + bj * (HALF / 2)) = w; } }
    }
};
struct EpiResidual {
    static constexpr bool PERM = false, AFTER_DRAIN = false;
    const float* xlat; const float* xctx;
    float* out; const float* g1;
    __device__ __forceinline__ void operator()(const f32x4 (&acc)[2][2][4][2], const Unit& u, int wr, int wc, int fr, int fq) const {
        const int rowt = u.pm * BM; const int mr = rowt < 16384 ? (rowt >> 13) : 2;
        const float* base = rowt < 16384 ? xlat + (size_t)rowt * 1024 : xctx + (size_t)(rowt - 16384) * 1024;
        const int col0 = u.pn * BM + wc * 32 + 4 * fq;
        f32x4 gv[2][2];
#pragma unroll
        for (int bj = 0; bj < 2; ++bj)
#pragma unroll
            for (int n = 0; n < 2; ++n) gv[bj][n] = *(const f32x4*)(g1 + (size_t)mr * 6144 + col0 + bj * HALF + n * 16);
#pragma unroll
        for (int ai = 0; ai < 2; ++ai)
#pragma unroll
            for (int m = 0; m < 4; ++m) { const int rl = ai * HALF + wr * 64 + m * 16 + fr;
#pragma unroll
                for (int bj = 0; bj < 2; ++bj)
#pragma unroll
                    for (int n = 0; n < 2; ++n) { const size_t off = (size_t)rl * 1024 + col0 + bj * HALF + n * 16;
                        const f32x4 xo = *(const f32x4*)(base + off);
                        *(f32x4*)(out + (size_t)rowt * 1024 + off) = xo + gv[bj][n] * acc[ai][bj][m][n]; } }
    }
};
struct MoeOrder {
    const int* tile_e; int ntiles, G, c;
    __device__ bool next(int i, Unit& u) const { const long L = (long)i * G + c; if (L >= 4L * ntiles) return false; const int pm = (int)(L >> 2); u.pm = pm; u.pn = tile_e[pm] * 4 + (int)(L & 3); return true; }
    __device__ __forceinline__ void a_ready(const Unit&) const {}
    __device__ __forceinline__ void done(const Unit&) const {}
};
}

__device__ __forceinline__ void expert_convert(const Frame& F0, int l, int b_lo) {
    const Frame F = phase_frame(F0); unsigned char* const ws = F.ws;
    if ((int)blockIdx.x < b_lo) return;
    const int nwv = (F.G - b_lo) * NWAVES, myw = ((int)blockIdx.x - b_lo) * NWAVES + F.wave;
    LAS float* scr = (LAS float*)(F.lds + F.wave * 16384);
    bf16* wgu = (bf16*)(ws + WS_WGU_T); bf16* wd = (bf16*)(ws + WS_WD_T);
    constexpr int I_G = 16 * 16, I_D = 8 * 32;
    constexpr int NIT = NEXP * (2 * I_G + I_D);
    const float* p_eg = inptr(I_EG); const float* p_eu = inptr(I_EU); const float* p_ed = inptr(I_ED);
    for (int it = myw; it < NIT; it += nwv) { const int e = it / (2 * I_G + I_D); int r = it % (2 * I_G + I_D);
        if (r < I_G) { transpose_item(p_eg + ((size_t)l * NEXP + e) * D * DEXP, DEXP, (r >> 4) * 64, (r & 15) * 32, wgu, D, RmGU{e * 1024}, scr, F.lane); continue; } r -= I_G;
        if (r < I_G) { transpose_item(p_eu + ((size_t)l * NEXP + e) * D * DEXP, DEXP, (r >> 4) * 64, (r & 15) * 32, wgu, D, RmGU{e * 1024 + 4}, scr, F.lane); continue; } r -= I_G;
        transpose_item(p_ed + ((size_t)l * NEXP + e) * DEXP * D, D, (r >> 5) * 64, (r & 31) * 32, wd, DEXP, RmId{e * 1024}, scr, F.lane);
    }
}

__device__ __forceinline__ void router_pass(const Frame& F0, int l, int nrows, int cnt_off = 0) {
    const Frame F = phase_frame(F0); unsigned char* const ws = F.ws;
    constexpr int HP = 1028;
    LAS float* msh = (LAS float*)F.lds; LAS float* msc = msh + 3072; LAS float* hrow = msc + 3072;
    LAS float* part = hrow + 16 * HP;
    LAS float* lgs = part + 8 * 16 * 48;
    LAS unsigned* lcnt = (LAS unsigned*)(lgs + 16 * 40);
    if (F0.tid < 64) lcnt[F0.tid] = 0u;
    __syncthreads();
    mod_to_lds(F, l, 3, msh, false); mod_to_lds(F, l, 4, msc, false); __syncthreads();
    const float* X = (const float*)(ws + WS_X); bf16* H = (bf16*)(ws + WS_H);
    const float* rgw = inptr(I_RGW) + (size_t)l * D * 4; const float* rew = inptr(I_REW) + (size_t)l * D * NEXP;
    const float* rgb = inptr(I_RGB) + l * 4; const float* reb = inptr(I_REB) + l * NEXP;
    int* rt_e = (int*)(ws + WS_ROUTE + RT_E); int* rt_pos = (int*)(ws + WS_ROUTE + RT_POS); float* rt_gate = (float*)(ws + WS_ROUTE + RT_GATE);
    unsigned* cnt = (unsigned*)(ws + WS_CTL) + CW_CNT + 64 * l + cnt_off;
    const int lane = F.lane, w = F.wave, fr = lane & 15, fq = lane >> 4; const float* n2g = inptr(I_N2G) + l * D;
    float bw[32][3];
#pragma unroll
    for (int ks = 0; ks < 32; ++ks) { const int k = 128 * w + 4 * ks + fq;
        bw[ks][0] = rew[(size_t)k * 32 + fr]; bw[ks][1] = rew[(size_t)k * 32 + 16 + fr]; bw[ks][2] = fr < 4 ? rgw[(size_t)k * 4 + fr] : 0.f; }
    const int ntiles = nrows >> 4;
    f32x4 pv[2][4];
    if (F.vcu < ntiles) {
#pragma unroll
        for (int rr = 0; rr < 2; ++rr)
#pragma unroll
            for (int j = 0; j < 4; ++j) pv[rr][j] = *(const f32x4*)(X + (size_t)(F.vcu * 16 + 2 * w + rr) * D + 4 * lane + 256 * j); }
    for (int gi = F.vcu; gi < ntiles; gi += F.G) {
#pragma unroll
        for (int rr = 0; rr < 2; ++rr) { const int r = 2 * w + rr, row = gi * 16 + r; f32x4 v[4];
#pragma unroll
            for (int j = 0; j < 4; ++j) v[j] = pv[rr][j];
            const int mr = modrow(row);
            norm_mod_row(v, n2g, msc + mr * 1024, msh + mr * 1024, H + (size_t)row * D, lane);
#pragma unroll
            for (int j = 0; j < 4; ++j) *(LAS f32x4*)(hrow + r * HP + 4 * lane + 256 * j) = v[j]; }
        if (gi + F.G < ntiles) {
#pragma unroll
            for (int rr = 0; rr < 2; ++rr)
#pragma unroll
                for (int j = 0; j < 4; ++j) pv[rr][j] = *(const f32x4*)(X + (size_t)((gi + F.G) * 16 + 2 * w + rr) * D + 4 * lane + 256 * j); }
        __syncthreads();
        {   f32x4 acc[3] = {{0.f, 0.f, 0.f, 0.f}, {0.f, 0.f, 0.f, 0.f}, {0.f, 0.f, 0.f, 0.f}};
#pragma unroll
            for (int ks = 0; ks < 32; ++ks) { const float a = hrow[fr * HP + 128 * w + 4 * ks + fq];
#pragma unroll
                for (int nt = 0; nt < 3; ++nt) acc[nt] = __builtin_amdgcn_mfma_f32_16x16x4f32(a, bw[ks][nt], acc[nt], 0, 0, 0); }
#pragma unroll
            for (int nt = 0; nt < 3; ++nt)
#pragma unroll
                for (int reg = 0; reg < 4; ++reg) part[(w * 16 + 4 * fq + reg) * 48 + 16 * nt + fr] = acc[nt][reg]; }
        __syncthreads();
        for (int idx = F.tid; idx < 16 * 36; idx += NTHR) { const int r = idx / 36, n = idx % 36; float s_ = 0.f;
#pragma unroll
            for (int ww = 0; ww < 8; ++ww) s_ += part[(ww * 16 + r) * 48 + n];
            if (n < 32) lgs[r * 40 + 4 + n] = s_ + reb[n]; else lgs[r * 40 + n - 32] = s_ + rgb[n - 32]; }
        __syncthreads();
        if (F.tid < 16) { const int rr = gi * 16 + F.tid; const LAS float* lp = lgs + F.tid * 40;
            int grp = 0; float mx = lp[0];
#pragma unroll
            for (int g = 1; g < 4; ++g) if (lp[g] > mx) { mx = lp[g]; grp = g; }
            float den = 0.f;
#pragma unroll
            for (int g = 0; g < 4; ++g) den += __expf(lp[g] - mx);
            const float pg_top = 1.f / den; const LAS float* sel = lp + 4 + grp * 8;
            int i0 = 0; float l0 = sel[0];
#pragma unroll
            for (int q = 1; q < 8; ++q) if (sel[q] > l0) { l0 = sel[q]; i0 = q; }
            int i1 = -1; float l1 = -3.0e38f;
#pragma unroll
            for (int q = 0; q < 8; ++q) if (q != i0 && sel[q] > l1) { l1 = sel[q]; i1 = q; }
            const float e1 = __expf(l1 - l0); const float w0 = pg_top / (1.f + e1), w1 = pg_top * e1 / (1.f + e1);
            const int ea = grp * 8 + i0, eb = grp * 8 + i1;
            const unsigned pa = atomicAdd((unsigned*)(lcnt + ea), 1u), pb = atomicAdd((unsigned*)(lcnt + eb), 1u);
            rt_e[2 * rr] = ea; rt_e[2 * rr + 1] = eb; rt_pos[2 * rr] = (int)pa; rt_pos[2 * rr + 1] = (int)pb; rt_gate[2 * rr] = w0; rt_gate[2 * rr + 1] = w1; }
    }
    __syncthreads();
    if (F.tid < 32) lcnt[32 + F.tid] = lcnt[F.tid] ? atomicAdd(cnt + F.tid, lcnt[F.tid]) : 0u;
    __syncthreads();
    if (F.tid < 16) for (int gi = F.vcu; gi < ntiles; gi += F.G) { const int rr = gi * 16 + F.tid;
        rt_pos[2 * rr] += (int)lcnt[32 + rt_e[2 * rr]]; rt_pos[2 * rr + 1] += (int)lcnt[32 + rt_e[2 * rr + 1]]; }
}

__device__ __forceinline__ void gather_pass(const Frame& F0, int l, int nrows) {
    const Frame F = phase_frame(F0); unsigned char* const ws = F.ws;
    LAS int* off = (LAS int*)F.lds;
    const unsigned* cnt = (const unsigned*)(ws + WS_CTL) + CW_CNT + 64 * l;
    int* tile_e = (int*)(ws + WS_ROUTE + RT_TILE); int* ntl = (int*)(ws + WS_ROUTE + RT_NT);
    __syncthreads();
    if (F.tid < NEXP) off[32 + F.tid] = (int)__hip_atomic_load(cnt + F.tid, __ATOMIC_RELAXED, __HIP_MEMORY_SCOPE_AGENT);
    __syncthreads();
    if (F.tid == 0) { int o = 0;
#pragma nounroll
        for (int e = 0; e < NEXP; ++e) { const int c = off[32 + e]; const int nt = (c + 255) >> 8; off[e] = o;
            if (blockIdx.x == 0) {
#pragma nounroll
                for (int t = 0; t < nt; ++t) tile_e[(o >> 8) + t] = e; }
            o += nt << 8; }
        if (blockIdx.x == 0) ntl[0] = o >> 8; }
    __syncthreads();
    const int* rt_e = (const int*)(ws + WS_ROUTE + RT_E); const int* rt_pos = (const int*)(ws + WS_ROUTE + RT_POS); int* rt_slot = (int*)(ws + WS_ROUTE + RT_SLOT);
    const bf16* H = (const bf16*)(ws + WS_H); bf16* Xs = (bf16*)(ws + WS_XS);
    for (int it0 = F.gw * 4; it0 < 2 * nrows; it0 += F.NGW * 4) { int slot[4]; u32x4 a[4], b2[4];
#pragma unroll
        for (int u = 0; u < 4; ++u) { const int it = it0 + u; slot[u] = it < 2 * nrows ? off[rt_e[it]] + rt_pos[it] : -1; }
#pragma unroll
        for (int u = 0; u < 4; ++u) if (slot[u] >= 0) { const u32x4* s = (const u32x4*)(H + (size_t)((it0 + u) >> 1) * D); a[u] = s[F.lane]; b2[u] = s[64 + F.lane]; }
#pragma unroll
        for (int u = 0; u < 4; ++u) if (slot[u] >= 0) { if (F.lane == 0) rt_slot[it0 + u] = slot[u]; u32x4* d = (u32x4*)(Xs + (size_t)slot[u] * D); d[F.lane] = a[u]; d[64 + F.lane] = b2[u]; }
    }
}

template <bool DRY>
__device__ __forceinline__ void combine_pass(const Frame& F0, int l, int nrows) {
    const Frame F = phase_frame(F0); unsigned char* const ws = F.ws;
    LAS float* mg2 = (LAS float*)F.lds; LAS float* msh = mg2 + 3072; LAS float* msc = msh + 3072;
    const bool last = (l == DEPTH - 1);
    __syncthreads();
    mod_to_lds(F, l, 5, mg2, false); if (!last) { mod_to_lds(F, l + 1, 0, msh, false); mod_to_lds(F, l + 1, 1, msc, false); }
    __syncthreads();
    float* X = (float*)(ws + WS_X); bf16* H = (bf16*)(ws + WS_H); const bf16* Ys = (const bf16*)(ws + WS_XS);
    const int* rt_slot = (const int*)(ws + WS_ROUTE + RT_SLOT); const float* rt_gate = (const float*)(ws + WS_ROUTE + RT_GATE);
    const int lane = F.lane; const float* n1g = inptr(I_N1G) + (last ? 0 : (l + 1) * D); const float* fgp = inptr(I_FG);
    for (int row0 = F.gw; row0 < nrows; row0 += 2 * F.NGW) {
        int s0[2], s1[2]; float w0[2], w1[2]; bool ok[2]; u32x2 ya[2][4], yb[2][4]; f32x4 xo[2][4];
#pragma unroll
        for (int u = 0; u < 2; ++u) { const int row = row0 + u * F.NGW; ok[u] = row < nrows; if (ok[u]) { s0[u] = rt_slot[2 * row]; s1[u] = rt_slot[2 * row + 1]; w0[u] = rt_gate[2 * row]; w1[u] = rt_gate[2 * row + 1]; } }
#pragma unroll
        for (int u = 0; u < 2; ++u) if (ok[u]) { const int row = row0 + u * F.NGW;
#pragma unroll
            for (int j = 0; j < 4; ++j) { const int c = 4 * lane + 256 * j; ya[u][j] = *(const u32x2*)(Ys + (size_t)s0[u] * D + c); yb[u][j] = *(const u32x2*)(Ys + (size_t)s1[u] * D + c); xo[u][j] = *(const f32x4*)(X + (size_t)row * D + c); } }
#pragma unroll
        for (int u = 0; u < 2; ++u) if (ok[u]) { const int row = row0 + u * F.NGW; const int mr = modrow(row); f32x4 v[4];
#pragma unroll
            for (int j = 0; j < 4; ++j) { const int c = 4 * lane + 256 * j; float a[4], b[4]; unpack4(ya[u][j], a); unpack4(yb[u][j], b);
                const f32x4 g2 = *(const LAS f32x4*)(mg2 + mr * 1024 + c);
                f32x4 y; y.x = w0[u] * a[0] + w1[u] * b[0]; y.y = w0[u] * a[1] + w1[u] * b[1]; y.z = w0[u] * a[2] + w1[u] * b[2]; y.w = w0[u] * a[3] + w1[u] * b[3];
                v[j] = xo[u][j] + g2 * y; }
            if (DRY) { asm volatile("" :: "v"(v[0].x + v[1].y + v[2].z + v[3].w)); }
            else if (!last) {
#pragma unroll
                for (int j = 0; j < 4; ++j) *(f32x4*)(X + (size_t)row * D + 4 * lane + 256 * j) = v[j];
                norm_mod_row(v, n1g, msc + mr * 1024, msh + mr * 1024, H + (size_t)row * D, lane);
            } else { float s = 0.f;
#pragma unroll
                for (int j = 0; j < 4; ++j) s += (v[j].x * v[j].x + v[j].y * v[j].y) + (v[j].z * v[j].z + v[j].w * v[j].w);
                const float rs = rsqrtf(wave_sum(s) * (1.f / D) + RMS_EPS);
#pragma unroll
                for (int j = 0; j < 4; ++j) { const int c = 4 * lane + 256 * j; const f32x4 g = *(const f32x4*)(fgp + c); *(f32x4*)(F.out + (size_t)row * D + c) = v[j] * rs * g; } } }
    }
}
__global__ void __launch_bounds__(NTHR, 2) fwd_megakernel(Params prm) {
    extern __shared__ __attribute__((aligned(16))) unsigned char lds_raw[];
    Frame F;
    F.lds = (LAS unsigned char*)lds_raw;
    F.tid = threadIdx.x; F.lane = F.tid & 63; F.wave = __builtin_amdgcn_readfirstlane(F.tid >> 6);
    F.G = gridDim.x; { const int bx = blockIdx.x; F.vcu = (F.G % 8 == 0) ? (bx % 8) * (F.G / 8) + bx / 8 : bx; }
    F.gw = F.vcu * NWAVES + F.wave; F.NGW = F.G * NWAVES;
    F.out = prm.out; F.ws = prm.ws;
    for (int u = F.tid; u < (LDS_BYTES - LDSCTL_OFF) / 4; u += NTHR) ((LAS unsigned*)(F.lds + LDSCTL_OFF))[u] = 0u;
    __syncthreads();
    (void)xcd_barrier_post((unsigned*)(F.ws + WS_CTL) + CW_BAR, (volatile LAS unsigned*)(F.lds + MISC_OFF) + 8);
#define GRID_BAR() do { XcdBarrier bar_; bar_.bar = (unsigned*)(opaque(F.ws) + WS_CTL) + CW_BAR; bar_.x = xb_xcc_id(); bar_.st = (volatile LAS unsigned*)(F.lds + MISC_OFF) + 8; xcd_barrier(bar_); } while (0)

    p0_prologue(F);
#if USE_CG_SYNC
    cg::this_grid().sync();
#else
    GRID_BAR();
#endif
    p0b_norm1(F);
    GRID_BAR();

    for (int l = 0; l < DEPTH; ++l) {
        const bool need_ctx = (l == 0); const int nrows = need_ctx ? NROW : NLAT;
#define WSO Fp.ws
        {
            const Frame Fp = phase_frame(F); unsigned char* const ws = WSO; bf16* Hb = (bf16*)(ws + WS_H); bf16* Pb = (bf16*)(ws + WS_P);
            pg8::Gemm g{Hb, (const bf16*)(ws + WS_WIN_T) + (size_t)l * NP * D, NROW, NP, D}; pg8::StaticOrder S; S.init(NROW, NP, Fp.G, (int)blockIdx.x);
            pg8::EpiStoreBf16 E{Pb, NP, 0xffff};
            pg8::gemm_phase<pg8::EpiStoreBf16, pg8::StaticOrder, true, true>(F.lds, g, S, E);
        }
        GRID_BAR();
        {
            const Frame Fp = phase_frame(F); unsigned char* const ws = WSO; bf16* Pb = (bf16*)(ws + WS_P);
            for (int it = blockIdx.x; it < 256; it += F.G) fftA_item(F, it);
            if (need_ctx) for (int it = blockIdx.x; it < 8; it += F.G) { const int b = it >> 2, m0 = (it & 3) * 64;
                const bf16* src0 = Pb + (size_t)(NLAT + b * CTXL) * NP + COL_FC;
                dft64_item<4, 256>(F, l, m0, -1.f, 1.f / 128.f, [=](int t, int ri) { return src0 + (size_t)t * NP + ri * 256; }, [=](int m) { return NLAT + b * CTXL + m; }); }
            shift_pass(F, l);
            conv_pass(F, l, nrows);
        }
        GRID_BAR();
        {
            const Frame Fp = phase_frame(F); unsigned char* const ws = WSO;
            prep_phase(F, l);
        }
        GRID_BAR();
        for (int seg = -1; seg < NSEG; ++seg) {
            const bool split = (F.G == 256);
            if (seg + 1 < NSEG) pre_phase(F, seg + 1, (seg >= 0 && split) ? 128 : 0);
            if (seg + 1 == NSEG && (!split || blockIdx.x >= 128)) { unsigned char* const ws = opaque(F.ws); int bx_ = (int)blockIdx.x; asm volatile("" : "+s"(bx_));
                const int first_ = split ? bx_ - 128 : bx_, stride_ = split ? 128 : F.G;
                for (int it = first_; it < 256; it += stride_) { const int b = it >> 7, t1p = it & 127;
                    const bf16* src0 = (const bf16*)(ws + WS_GT) + (size_t)(b * 128 + t1p) * 64 * 512;
                    dft64_item<1, 64>(F, l, 0, 1.f, 0.0013810679320049757f, [=](int t, int ri) { return src0 + (size_t)t * 512 + ri * 256; }, [=](int m) { return b * SEQ + t1p + 128 * m; }); } }
            if (seg >= 0) for (int it = blockIdx.x; it < 128; it += F.G) { const int x_ = it & 7, j_ = it >> 3;
                seq_item<0>(F, ((x_ + 8 * (j_ >> 2)) << 2) | (j_ & 3), seg, need_ctx); }
            GRID_BAR();
        }
        readout_pass(F, l, nrows);
        GRID_BAR();
        const int cv_lo = (nrows / 256) * 4 > F.G ? (nrows / 256) * 4 - F.G : 0;
        if (blockIdx.x & 1) expert_convert(F, l, cv_lo);
        {
            const Frame Fp = phase_frame(F); unsigned char* const ws = WSO; bf16* Hb = (bf16*)(ws + WS_H);
            pg8::Gemm g{Hb, (const bf16*)(ws + WS_WOUT_T) + (size_t)l * D * D, nrows, D, D}; pg8::StaticOrder S; S.init(nrows, D, Fp.G, (int)blockIdx.x);
            const float* X = (const float*)(ws + WS_X);
            pg8::EpiResidual E{l == 0 ? inptr(I_X) : X, l == 0 ? inptr(I_CTX) : X + (size_t)NLAT * D, (float*)(ws + WS_X), (const float*)(ws + WS_MODF) + (size_t)l * 3 * 6144 + 2 * 1024};
            pg8::gemm_phase<pg8::EpiResidual, pg8::StaticOrder, true, true>(F.lds, g, S, E);
        }
        if (!(blockIdx.x & 1)) expert_convert(F, l, cv_lo);
        GRID_BAR();
        router_pass(F, l, nrows);
        GRID_BAR();
        gather_pass(F, l, nrows);
        GRID_BAR();
        {
            const Frame Fp = phase_frame(F); unsigned char* const ws = WSO;
            const int* tile_e = (const int*)(ws + WS_ROUTE + RT_TILE); const int ntiles = *(const int*)(ws + WS_ROUTE + RT_NT);
            pg8::MoeOrder S{tile_e, ntiles, Fp.G, (int)blockIdx.x};
            {   pg8::Gemm g{(const bf16*)(ws + WS_XS), (const bf16*)(ws + WS_WGU_T), 0, 0, D};
                pg8::EpiSwiGLU E{(bf16*)(ws + WS_ACT)};
                pg8::gemm_phase<pg8::EpiSwiGLU, pg8::MoeOrder, true, true>(F.lds, g, S, E); }
            GRID_BAR();
            {   pg8::Gemm g{(const bf16*)(ws + WS_ACT), (const bf16*)(ws + WS_WD_T), 0, 0, DEXP};
                pg8::EpiStoreBf16 E{(bf16*)(ws + WS_XS), D, 3};
                pg8::gemm_phase<pg8::EpiStoreBf16, pg8::MoeOrder, true, true>(F.lds, g, S, E); }
        }
        GRID_BAR();
        combine_pass<false>(F, l, nrows);
        if (l + 1 < DEPTH) GRID_BAR();
    }
}

extern "C" void kernel_launch(void* const* d_in, const int* in_sizes, int n_in, void* d_out, int out_size, void* d_ws, size_t ws_size, hipStream_t stream) {
    static int grid = 0;
    if (grid == 0) {
        if (n_in != N_IN || in_sizes[0] != NLAT * D || out_size != NLAT * D || ws_size < WS_END) {
            fprintf(stderr, "kernel_launch: unexpected shapes (n_in %d in0 %d out %d ws %zu)\n", n_in, n_in > 0 ? in_sizes[0] : -1, out_size, ws_size); grid = -1; return; }
        int dev = 0, cus = 0, per_cu = 0;
        hipGetDevice(&dev); hipDeviceGetAttribute(&cus, hipDeviceAttributeMultiprocessorCount, dev);
        hipFuncSetAttribute((const void*)fwd_megakernel, hipFuncAttributeMaxDynamicSharedMemorySize, LDS_BYTES);
        hipOccupancyMaxActiveBlocksPerMultiprocessor(&per_cu, (const void*)fwd_megakernel, NTHR, LDS_BYTES);
        if (per_cu < 1) { fprintf(stderr, "kernel_launch: occupancy query says %d blocks per CU\n", per_cu); per_cu = 1; }
        (void)hipGetLastError();
        grid = cus * per_cu;
    }
    if (grid < 0) return;
    hipMemsetAsync((char*)d_ws + WS_CTL, 0, CTL_ZERO_BYTES, stream);
    Params p{};
    for (int i = 0; i < N_IN; ++i) p.in[i] = (const float*)d_in[i];
    p.out = (float*)d_out; p.ws = (unsigned char*)d_ws;
    void* args[] = {&p};
    hipError_t e = hipLaunchCooperativeKernel((const void*)fwd_megakernel, dim3(grid), dim3(NTHR), args, LDS_BYTES, stream);
    if (e != hipSuccess) fprintf(stderr, "kernel_launch: cooperative launch failed: %s (grid %d)\n", hipGetErrorString(e), grid);
}
```

```cpp
#include <hip/hip_runtime.h>
#include <hip/hip_cooperative_groups.h>
#include <cstdio>
#include <cstdint>
namespace cg = cooperative_groups;
#define USE_CG_SYNC 0
#define SEQ_PROBE 0
#define SEQ_PROBE_PRE 0
namespace pg8 {
#define PG8_LAS __attribute__((address_space(3)))
typedef unsigned short bf16_t;
typedef short bf16x8 __attribute__((ext_vector_type(8)));
typedef float f32x4 __attribute__((ext_vector_type(4)));
typedef unsigned u32x4 __attribute__((ext_vector_type(4)));
constexpr int BM = 256, BK = 64, HALF = 128, HTB = HALF * BK * 2  , STAGE_BYTES = 8 * HTB, NXCD = 8, WGM = 8;

__host__ __device__ __forceinline__ int lds_byte(int r, int c) { const int st = (r >> 4) * 2 + (c >> 5), rr = r & 15, cc = c & 31, ob = rr * 64 + cc * 2; return st * 1024 + (ob ^ (((ob >> 9) & 1) << 5)); }
__host__ __device__ __forceinline__ void stage_rc(int b, int& R, int& C) { const int st = b / 1024, sb = b % 1024, swz = sb ^ (((sb >> 9) & 1) << 5); R = (st >> 1) * 16 + swz / 64; C = (st & 1) * 32 + (swz % 64) / 2; }
__host__ __device__ __forceinline__ int perm32(int rho) { const int n = rho >> 4, i = rho & 15; return 8 * (i >> 2) + 4 * n + (i & 3); }

struct Unit { int pm, pn; };
struct Gemm { const bf16_t* A; const bf16_t* Bt; int M, N, K; };

struct StaticOrder {
    int nM, nN, nwg, G, c;
    __host__ __device__ void init(int M, int N, int G_, int c_) { nM = M / BM; nN = N / BM; nwg = nM * nN; G = G_; c = c_; }
    __host__ __device__ bool next(int i, Unit& u) const {
        const long L = (long)i * G + c; if (L >= nwg) return false;
        int wgid = (int)L; { const int q = nwg / NXCD, r = nwg % NXCD, xcd = wgid % NXCD, off = wgid / NXCD; wgid = (xcd < r ? xcd * (q + 1) : r * (q + 1) + (xcd - r) * q) + off; }
        const int nig = WGM * nN, gid = wgid / nig, fm = gid * WGM, gsz = (nM - fm) < WGM ? (nM - fm) : WGM;
        u.pm = fm + ((wgid % nig) % gsz); u.pn = (wgid % nig) / gsz; return true;
    }
    __device__ __forceinline__ void a_ready(const Unit&) const {}
    __device__ __forceinline__ void done(const Unit&) const {}
};

__device__ __forceinline__ unsigned cvt_pk_bf16(float lo, float hi) { unsigned r; asm volatile("v_cvt_pk_bf16_f32 %0, %1, %2" : "=v"(r) : "v"(lo), "v"(hi)); return r; }
typedef float f32x2 __attribute__((ext_vector_type(2)));
template <class Epi, class Sched, bool ALIGN_EPI = false, bool SP2 = false>
__device__ __forceinline__ void gemm_phase(PG8_LAS unsigned char* lds, const Gemm g, const Sched& S, const Epi& E) {
    int tid = threadIdx.x; asm volatile("" : "+v"(tid));
    const int wid = __builtin_amdgcn_readfirstlane(tid >> 6), lane = tid & 63, wr = wid >> 2, wc = wid & 3, fr = lane & 15, fq = lane >> 4;
    const int K = g.K, nt = K / BK;
    unsigned voffA[2], voffB[2];
#pragma unroll
    for (int i = 0; i < 2; ++i) { int R, C; stage_rc(tid * 16 + i * 8192, R, C); const int Rb = Epi::PERM ? ((R & ~31) + perm32(R & 31)) : R;
        voffA[i] = (unsigned)(R * K + C) * 2u; voffB[i] = (unsigned)(Rb * K + C) * 2u; }
    const size_t kstep = (size_t)(BK * 2);
    const size_t hstep = (size_t)HALF * K * 2;
    const size_t tstep = 2 * hstep;
    const unsigned ldsw = (unsigned)wid * 1024u;
    const int aoff = lds_byte(wr * 64 + fr, fq * 8), boff = lds_byte(wc * 32 + fr, fq * 8);
#define PG8_SA(b, h) (((b) * 2 + (h)) * HTB)
#define PG8_SB(b, h) ((4 + (b) * 2 + (h)) * HTB)
#define PG8_STAGE(bufoff, gbase, voff) do { _Pragma("unroll") for (int _i = 0; _i < 2; ++_i) \
        __builtin_amdgcn_global_load_lds((const unsigned*)((const char*)(gbase) + (voff)[_i]), (PG8_LAS unsigned*)(lds + (bufoff) + ldsw + _i * 8192), 16, 0, 0); } while (0)
#define PG8_LDA(dst, b, h) do { _Pragma("unroll") for (int m = 0; m < 4; ++m) _Pragma("unroll") for (int k = 0; k < 2; ++k) dst[m][k] = *(const PG8_LAS bf16x8*)(lds + PG8_SA(b, h) + aoff + m * 2048 + k * 1024); } while (0)
#define PG8_LDB(dst, b, h) do { _Pragma("unroll") for (int n = 0; n < 2; ++n) _Pragma("unroll") for (int k = 0; k < 2; ++k) dst[n][k] = *(const PG8_LAS bf16x8*)(lds + PG8_SB(b, h) + boff + n * 2048 + k * 1024); } while (0)
#define PG8_MMA(ai, bj, At, Bt) do { __builtin_amdgcn_s_setprio(1); _Pragma("unroll") for (int m = 0; m < 4; ++m) _Pragma("unroll") for (int n = 0; n < 2; ++n) _Pragma("unroll") for (int k = 0; k < 2; ++k) \
        acc[ai][bj][m][n] = __builtin_amdgcn_mfma_f32_16x16x32_bf16(Bt[n][k], At[m][k], acc[ai][bj][m][n], 0, 0, 0); __builtin_amdgcn_s_setprio(0); } while (0)
#define PG8_WAIT_V(n) asm volatile("s_waitcnt vmcnt(" #n ")" ::: "memory")
#define PG8_WAIT_L(n) asm volatile("s_waitcnt lgkmcnt(" #n ")" ::: "memory")
#define PG8_BAR __builtin_amdgcn_s_barrier()
#define PG8_SCHED __builtin_amdgcn_sched_barrier(0)
    Unit cur, nxt; int ui = 0;
    if (!S.next(0, cur)) return;
    f32x4 acc[2][2][4][2];
#pragma unroll
    for (int a = 0; a < 2; ++a)
#pragma unroll
        for (int b = 0; b < 2; ++b)
#pragma unroll
            for (int m = 0; m < 4; ++m)
#pragma unroll
                for (int n = 0; n < 2; ++n) acc[a][b][m][n] = (f32x4){0.f, 0.f, 0.f, 0.f};
    bf16x8 At[4][2], B0[2][2], B1[2][2];
    const char* cA = (const char*)g.A + (size_t)cur.pm * tstep; const char* cB = (const char*)g.Bt + (size_t)cur.pn * tstep;
    S.a_ready(cur);
    if constexpr (SP2) {
        PG8_STAGE(PG8_SB(0, 0), cB, voffB); PG8_STAGE(PG8_SB(0, 1), cB + hstep, voffB); PG8_STAGE(PG8_SA(0, 0), cA, voffA); PG8_STAGE(PG8_SA(0, 1), cA + hstep, voffA);
        if (wr == 1) PG8_BAR;
        PG8_WAIT_V(2); PG8_BAR;
        PG8_STAGE(PG8_SB(1, 0), cB + kstep, voffB); PG8_STAGE(PG8_SA(1, 0), cA + kstep, voffA); PG8_STAGE(PG8_SB(1, 1), cB + hstep + kstep, voffB);
        PG8_WAIT_V(6); PG8_BAR;
    } else {
        PG8_STAGE(PG8_SB(0, 0), cB, voffB); PG8_STAGE(PG8_SA(0, 0), cA, voffA); PG8_STAGE(PG8_SB(0, 1), cB + hstep, voffB); PG8_STAGE(PG8_SA(0, 1), cA + hstep, voffA);
        if (wr == 1) PG8_BAR;
        PG8_WAIT_V(4); PG8_BAR;
        PG8_STAGE(PG8_SB(1, 0), cB + kstep, voffB); PG8_STAGE(PG8_SA(1, 0), cA + kstep, voffA); PG8_STAGE(PG8_SB(1, 1), cB + hstep + kstep, voffB);
        PG8_WAIT_V(6); PG8_BAR;
    }
    for (;;) {
        const bool has_next = S.next(ui + 1, nxt);
        const char* nA = has_next ? (const char*)g.A + (size_t)nxt.pm * tstep : cA; const char* nB = has_next ? (const char*)g.Bt + (size_t)nxt.pn * tstep : cB;
        for (int t = 0; t < nt; t += 2) {
            const bool last = (t == nt - 2);
            const char* a1 = cA + (size_t)(t + 1) * kstep;
            const char* a2 = last ? nA : cA + (size_t)(t + 2) * kstep; const char* b2 = last ? nB : cB + (size_t)(t + 2) * kstep;
            const char* a3 = a2 + kstep; const char* b3 = b2 + kstep;
            if (last && has_next) S.a_ready(nxt);
            if constexpr (SP2) {
            PG8_LDB(B0, 0, 0); PG8_LDB(B1, 0, 1); PG8_SCHED; PG8_LDA(At, 0, 0); PG8_STAGE(PG8_SA(1, 1), a1 + hstep, voffA);
            PG8_WAIT_V(8); PG8_WAIT_L(0); PG8_BAR; PG8_MMA(0, 0, At, B0); PG8_MMA(0, 1, At, B1); PG8_BAR; PG8_SCHED;
            PG8_LDA(At, 0, 1); PG8_STAGE(PG8_SB(0, 0), b2, voffB); PG8_STAGE(PG8_SB(0, 1), b2 + hstep, voffB); PG8_STAGE(PG8_SA(0, 0), a2, voffA);
            PG8_WAIT_V(8); PG8_WAIT_L(0); PG8_BAR; PG8_MMA(1, 0, At, B0); PG8_MMA(1, 1, At, B1); PG8_BAR; PG8_SCHED;
            PG8_LDB(B0, 1, 0); PG8_LDB(B1, 1, 1); PG8_SCHED; PG8_LDA(At, 1, 0); PG8_STAGE(PG8_SA(0, 1), a2 + hstep, voffA);
            PG8_WAIT_V(8); PG8_WAIT_L(0); PG8_BAR; PG8_MMA(0, 0, At, B0); PG8_MMA(0, 1, At, B1); PG8_BAR; PG8_SCHED;
            PG8_LDA(At, 1, 1); PG8_STAGE(PG8_SB(1, 0), b3, voffB); PG8_STAGE(PG8_SB(1, 1), b3 + hstep, voffB); PG8_STAGE(PG8_SA(1, 0), a3, voffA);
            PG8_WAIT_V(8); PG8_WAIT_L(0); PG8_BAR; PG8_MMA(1, 0, At, B0); PG8_MMA(1, 1, At, B1); PG8_BAR; PG8_SCHED;
            } else {
            PG8_LDB(B0, 0, 0); PG8_SCHED; PG8_LDA(At, 0, 0); PG8_STAGE(PG8_SA(1, 1), a1 + hstep, voffA);
            PG8_WAIT_L(8); PG8_BAR; PG8_WAIT_L(0); PG8_MMA(0, 0, At, B0); PG8_BAR; PG8_SCHED;
            PG8_LDB(B1, 0, 1); PG8_STAGE(PG8_SB(0, 0), b2, voffB);
            PG8_BAR; PG8_WAIT_L(0); PG8_MMA(0, 1, At, B1); PG8_BAR;
            PG8_LDA(At, 0, 1); PG8_STAGE(PG8_SA(0, 0), a2, voffA);
            PG8_BAR; PG8_WAIT_L(0); PG8_MMA(1, 0, At, B0); PG8_BAR; PG8_SCHED;
            PG8_STAGE(PG8_SB(0, 1), b2 + hstep, voffB);
            PG8_WAIT_V(6); PG8_BAR; PG8_MMA(1, 1, At, B1); PG8_BAR;
            PG8_LDB(B0, 1, 0); PG8_SCHED; PG8_LDA(At, 1, 0); PG8_STAGE(PG8_SA(0, 1), a2 + hstep, voffA);
            PG8_WAIT_L(8); PG8_BAR; PG8_WAIT_L(0); PG8_MMA(0, 0, At, B0); PG8_BAR; PG8_SCHED;
            PG8_LDB(B1, 1, 1); PG8_STAGE(PG8_SB(1, 0), b3, voffB);
            PG8_BAR; PG8_WAIT_L(0); PG8_MMA(0, 1, At, B1); PG8_BAR;
            PG8_LDA(At, 1, 1); PG8_STAGE(PG8_SA(1, 0), a3, voffA);
            PG8_BAR; PG8_WAIT_L(0); PG8_MMA(1, 0, At, B0); PG8_BAR; PG8_SCHED;
            PG8_STAGE(PG8_SB(1, 1), b3 + hstep, voffB);
            PG8_WAIT_V(6); PG8_BAR; PG8_MMA(1, 1, At, B1); PG8_BAR;
            }
        }
        if constexpr (ALIGN_EPI) { if (wr == 0) PG8_BAR; }
        if constexpr (!Epi::AFTER_DRAIN) { E(acc, cur, wr, wc, fr, fq); S.done(cur); }
        if (!has_next) break;
#pragma unroll
        for (int a = 0; a < 2; ++a)
#pragma unroll
            for (int b = 0; b < 2; ++b)
#pragma unroll
                for (int m = 0; m < 4; ++m)
#pragma unroll
                    for (int n = 0; n < 2; ++n) acc[a][b][m][n] = (f32x4){0.f, 0.f, 0.f, 0.f};
        cur = nxt; cA = nA; cB = nB; ++ui;
        if constexpr (ALIGN_EPI) { if (wr == 1) PG8_BAR; }
    }
    PG8_WAIT_V(0);
    if constexpr (!ALIGN_EPI) { if (wr == 0) PG8_BAR; }
    PG8_BAR;
    if constexpr (Epi::AFTER_DRAIN) { E.fused(acc, cur, wr, wc, fr, fq, lds, wid, lane); S.done(cur); }
#undef PG8_SA
#undef PG8_SB
#undef PG8_STAGE
#undef PG8_LDA
#undef PG8_LDB
#undef PG8_MMA
#undef PG8_WAIT_V
#undef PG8_WAIT_L
#undef PG8_BAR
#undef PG8_SCHED
}
}
#define LAS __attribute__((address_space(3)))
typedef unsigned short bf16;
typedef float f32x4 __attribute__((ext_vector_type(4)));
typedef short bf16x8 __attribute__((ext_vector_type(8)));
typedef unsigned u32x4 __attribute__((ext_vector_type(4)));
typedef unsigned u32x2 __attribute__((ext_vector_type(2)));

constexpr int D = 1024, NBATCH = 2, SEQ = 8192, CTXL = 256, DEPTH = 2;
constexpr int NLAT = NBATCH * SEQ, NCTX = NBATCH * CTXL, NROW = NLAT + NCTX;
constexpr int DR = 512, DIN = 2944, NP = 3328, ZW = 1920, NHEAD = 8;
constexpr int COL_CONV = 1920, COL_FC = 2688, COL_FS = 2944;
constexpr int STRW = 5120;
constexpr int NEXP = 32, DEXP = 512;
constexpr int MOE_MAXTILES = 168;
constexpr float RMS_EPS = 1e-6f, GN_EPS = 64e-5f;

enum { I_X = 0, I_C, I_CTX, I_CCTX, I_ADAW, I_ADAB, I_N1G, I_N2G, I_WIN, I_MU, I_DW0, I_DW2, I_IA0, I_IA2, I_GG2, I_KK, I_KA, I_RK, I_GNW, I_GNB,
       I_CONVW, I_CONVG, I_FOURG, I_WOUT, I_RGW, I_RGB, I_REW, I_REB, I_EG, I_EU, I_ED, I_FG, N_IN };

constexpr size_t MiB = 1u << 20;
constexpr size_t WS_CTL = 0, CTL_ZERO_BYTES = 64 * 1024;
constexpr size_t WS_MODP = 1 * MiB;
constexpr size_t WS_MODF = 1 * MiB + 1280 * 1024;
constexpr size_t WS_WIN_T = 3 * MiB;
constexpr size_t WS_WOUT_T = 16 * MiB;
constexpr size_t WS_WGU_T = 20 * MiB;
constexpr size_t WS_WD_T = 84 * MiB;
constexpr size_t WS_X = 116 * MiB;
constexpr size_t WS_H = 182 * MiB;
constexpr size_t WS_ZS = 215 * MiB;
constexpr size_t WS_P = 277 * MiB;
constexpr size_t WS_STR = 277 * MiB;
constexpr size_t WS_Y = 442 * MiB;
constexpr size_t WS_GT = 475 * MiB;
constexpr size_t WS_ROUTE = 491 * MiB;
constexpr size_t WS_XS = 215 * MiB;
constexpr size_t WS_ACT = 299 * MiB;
constexpr size_t WS_END = 530 * MiB;
constexpr size_t RT_E = 0, RT_POS = 1 * 33792 * 4, RT_GATE = 2 * 33792 * 4, RT_SLOT = 3 * 33792 * 4, RT_TILE = 4 * 33792 * 4, RT_NT = RT_TILE + 1024;

constexpr int CW_BAR = 4096;
constexpr int CW_CNT = 8192;

constexpr int NWAVES = 8, NTHR = 512;
constexpr int RING_BYTES = 131072, LDSCTL_OFF = 143360, MISC_OFF = LDSCTL_OFF + 320, LDS_BYTES = 147456;

struct Params { const float* in[N_IN]; float* out; unsigned char* ws; };

__device__ __forceinline__ float bf2f(unsigned h) { return __uint_as_float(h << 16); }
typedef __bf16 hwbf2 __attribute__((ext_vector_type(2)));
typedef float f32x2 __attribute__((ext_vector_type(2)));
__device__ __forceinline__ unsigned pk2(float lo, float hi) { const f32x2 x = {lo, hi}; const hwbf2 r = __builtin_convertvector(x, hwbf2); return __builtin_bit_cast(unsigned, r); }
__device__ __forceinline__ unsigned f2bf(float f) { return pk2(f, 0.f) & 0xffffu; }
__device__ __forceinline__ float wave_sum(float v) {
#pragma unroll
    for (int o = 1; o < 64; o <<= 1) v += __shfl_xor(v, o);
    return v;
}
__device__ __forceinline__ float sigmoidf_(float x) { return 1.f / (1.f + __expf(-x)); }
#define LDS_WAIT() asm volatile("s_waitcnt lgkmcnt(0)" ::: "memory")
#define VM_WAIT() asm volatile("s_waitcnt vmcnt(0)" ::: "memory")

struct Frame {
    LAS unsigned char* lds;
    int tid, lane, wave, vcu, G, gw, NGW;
    float* out; unsigned char* ws;
};
#if defined(__HIP_DEVICE_COMPILE__)
#define ASSUME_GLOBAL(p) do { __builtin_assume(!__builtin_amdgcn_is_shared(p)); __builtin_assume(!__builtin_amdgcn_is_private(p)); } while (0)
#else
#define ASSUME_GLOBAL(p) do { } while (0)
#endif
__device__ __forceinline__ const float* inptr(int i) {
    const volatile unsigned long long __attribute__((address_space(4)))* ka = (const volatile unsigned long long __attribute__((address_space(4)))*)__builtin_amdgcn_kernarg_segment_ptr();
    return (const float*)(const __attribute__((address_space(1))) float*)ka[i];
}
__device__ __forceinline__ unsigned char* opaque(unsigned char* p) { unsigned long z = 0; asm volatile("" : "+s"(z)); return p + z; }
__device__ __forceinline__ Frame phase_frame(const Frame& F0) { Frame F = F0; asm volatile("" : "+v"(F.tid)); F.lane = F.tid & 63; F.ws = opaque(F0.ws);
    asm volatile("" : "+s"(F.G), "+s"(F.vcu)); F.gw = F.vcu * NWAVES + F.wave; F.NGW = F.G * NWAVES; return F; }
__device__ __forceinline__ int modrow(int row) { return row < NLAT ? (row >> 13) : 2; }
#define XB_TMO      128
#define XB_XCNT(j)  (256  + 64 * (j))
#define XB_XSUB(j)  (1280 + 64 * (j))
#define XB_XGEN(j)  (2304 + 64 * (j))
#define XB_TOP      3328
#define XB_TOPGEN   3392
#define XCD_BAR_WORDS 3456
#define XB_SPIN_CAP (1u << 18)

__device__ __forceinline__ unsigned xb_ld(unsigned* p)              { return __hip_atomic_load(p, __ATOMIC_RELAXED, __HIP_MEMORY_SCOPE_AGENT); }
__device__ __forceinline__ unsigned xb_add(unsigned* p, unsigned v) { return __hip_atomic_fetch_add(p, v, __ATOMIC_RELAXED, __HIP_MEMORY_SCOPE_AGENT); }
__device__ __forceinline__ unsigned xb_xcc_id() { return (unsigned)__builtin_amdgcn_s_getreg((3 << 11) | 20) & 0xFu; }
#define XB_SPIN(cond, bar) do { unsigned _sp = 0; while (cond) { __builtin_amdgcn_s_sleep(1); \
    if ((++_sp & 255u) == 0u) { if (xb_ld(&(bar)[XB_TMO])) break; if (_sp > XB_SPIN_CAP) { atomicAdd(&(bar)[XB_TMO], 1u); break; } } } } while (0)

struct XcdBarrier {
    unsigned* bar; unsigned x;
    volatile LAS unsigned* st;
};

__device__ __forceinline__ XcdBarrier xcd_barrier_post(unsigned* bar, volatile LAS unsigned* st) {
    XcdBarrier b; b.bar = bar; b.x = xb_xcc_id(); b.st = st;
    if (threadIdx.x == 0) (void)xb_add(&bar[XB_XCNT(b.x)], 1u);
    return b;
}
__device__ __forceinline__ void xcd_barrier_complete(unsigned* bar, unsigned x, unsigned& nloc, unsigned& nx) {
    const unsigned G = gridDim.x * gridDim.y * gridDim.z;
    unsigned sum, cnt, mine, sp = 0u;
    for (;;) {
        sum = 0u; cnt = 0u; mine = 0u;
#pragma nounroll
        for (unsigned j = 0; j < 16; ++j) { const unsigned c = xb_ld(&bar[XB_XCNT(j)]); sum += c; cnt += (c > 0u) ? 1u : 0u; mine = (j == x) ? c : mine; }
        if (sum == G) break;
        __builtin_amdgcn_s_sleep(1);
        if ((++sp & 255u) == 0u) { if (xb_ld(&bar[XB_TMO])) break; if (sp > XB_SPIN_CAP) { atomicAdd(&bar[XB_TMO], 1u); break; } }
    }
    nloc = mine > 0u ? mine : 1u; nx = cnt > 0u ? cnt : 1u;
}

__device__ __forceinline__ void xcd_barrier(const XcdBarrier& b) {
    asm volatile("s_waitcnt vmcnt(0)" ::: "memory");
    __syncthreads();
    if (threadIdx.x == 0) {
        unsigned* bar = b.bar;
        asm volatile("" : "+s"(bar));
        __builtin_amdgcn_s_waitcnt(0);
        unsigned nloc = b.st[0], nx = b.st[1];
        if (nloc == 0u) { xcd_barrier_complete(bar, b.x, nloc, nx); b.st[0] = nloc; b.st[1] = nx; }
        const unsigned old = xb_add(&bar[XB_XSUB(b.x)], 1u);
        const unsigned gen = old / nloc;
        if (old + 1u == (gen + 1u) * nloc) {
            __builtin_amdgcn_fence(__ATOMIC_RELEASE, "agent");
            asm volatile("s_waitcnt vmcnt(0)" ::: "memory");
            const unsigned og = xb_add(&bar[XB_TOP], 1u);
            const unsigned tg = og / nx;
            if (og + 1u == (tg + 1u) * nx) xb_add(&bar[XB_TOPGEN], 1u);
            else XB_SPIN(xb_ld(&bar[XB_TOPGEN]) == tg, bar);
            __builtin_amdgcn_fence(__ATOMIC_ACQUIRE, "agent");
            xb_add(&bar[XB_XGEN(b.x)], 1u);
            asm volatile("s_waitcnt vmcnt(0)" ::: "memory");
        } else {
            XB_SPIN(xb_ld(&bar[XB_XGEN(b.x)]) == gen, bar);
            __builtin_amdgcn_fence(__ATOMIC_ACQUIRE, "agent");
            asm volatile("s_waitcnt vmcnt(0)" ::: "memory");
        }
    }
    __syncthreads();
}
template <class RowMap>
__device__ __forceinline__ void transpose_item(const float* W, int ldw, int k0, int n0, bf16* WT, int ldt, RowMap rm, LAS float* scr, int lane) {
    (void)scr;
    const int nq = lane & 7, kg = lane >> 3; const float* src = W + (size_t)(k0 + 8 * kg) * ldw + n0 + 4 * nq;
    f32x4 v[8];
#pragma unroll
    for (int i = 0; i < 8; ++i) v[i] = *(const f32x4*)(src + (size_t)i * ldw);
#pragma unroll
    for (int j = 0; j < 4; ++j) { u32x4 o = {pk2(v[0][j], v[1][j]), pk2(v[2][j], v[3][j]), pk2(v[4][j], v[5][j]), pk2(v[6][j], v[7][j])};
        *(u32x4*)(WT + (size_t)rm(n0 + 4 * nq + j) * ldt + k0 + 8 * kg) = o; }
}
struct RmId { int off; __device__ __forceinline__ int operator()(int n) const { return off + n; } };
struct RmGU { int off; __device__ __forceinline__ int operator()(int n) const { return off + ((n >> 2) << 3) + (n & 3); } };

__device__ __forceinline__ void p0_prologue(const Frame& F0) {
    const Frame F = phase_frame(F0); unsigned char* const ws = F.ws;
    LAS float* scr = (LAS float*)(F.lds + F.wave * 16384);
    LAS float* ctab = (LAS float*)(F.lds + 8 * 16384);
    if (F.tid < 64) ctab[F.tid] = cosf((float)F.tid * (6.283185307179586f / 64.f));
    __syncthreads();
    bf16* win_t = (bf16*)(ws + WS_WIN_T); bf16* wout_t = (bf16*)(ws + WS_WOUT_T);
    constexpr int I_WIN_L = 16 * 84, I_WOUT_L = 16 * 32, I_FOLD_L = 4 * 64, I_MOD_L = 96 * 8;
    constexpr int NIT = 2 * (I_WIN_L + I_WOUT_L + I_FOLD_L + I_MOD_L);
    const float* p_win = inptr(I_WIN); const float* p_wout = inptr(I_WOUT); const float* p_c = inptr(I_C); const float* p_cctx = inptr(I_CCTX); const float* p_adaw = inptr(I_ADAW);
    {
        bf16* wl = (bf16*)(ws + 64 * 1024); const float* dw2 = inptr(I_DW2); const float* ia2 = inptr(I_IA2); const float* gg2 = inptr(I_GG2);
        for (int idx = F.vcu * NTHR + F.tid; idx < 2 * 384 * 512; idx += F.G * NTHR) { const int c = idx & 511, k = (idx >> 9) % 384, l = idx / (384 * 512);
            float v;
            if (k < 128) v = dw2[((size_t)(l * 2 + (k >> 6)) * 64 + (k & 63)) * DR + c];
            else if (k < 256) v = ia2[((size_t)(l * 2 + ((k - 128) >> 6)) * 64 + (k & 63)) * DR + c];
            else v = gg2[((size_t)l * 128 + (k - 256)) * DR + c];
            wl[((size_t)l * 512 + c) * 384 + k] = (bf16)f2bf(v); } }
    for (int it = F.gw; it < NIT; it += F.NGW) {
        int r = it; const int l = r & 1; r >>= 1;
        if (r < I_WIN_L) { const int kb = r / 84, nb = r % 84;
            transpose_item(p_win + (size_t)l * D * DIN, DIN, kb * 64, nb * 32, win_t + (size_t)l * NP * D, D, RmId{0}, scr, F.lane); continue; }
        r -= I_WIN_L;
        if (r < I_WOUT_L) { const int kb = r / 32, nb = r % 32;
            transpose_item(p_wout + (size_t)l * D * D, D, kb * 64, nb * 32, wout_t + (size_t)l * D * D, D, RmId{0}, scr, F.lane); continue; }
        r -= I_WOUT_L;
        if (r < I_FOLD_L) {
            const int g = r >> 6, k0 = (r & 63) * 16; const float* W = p_win + (size_t)l * D * DIN;
#pragma unroll
            for (int kk = 0; kk < 16; ++kk) scr[kk * 64 + F.lane] = W[(size_t)(k0 + kk) * DIN + 2688 + g * 64 + F.lane];
            LDS_WAIT(); asm volatile("" ::: "memory");
            float ac[16], as[16];
#pragma unroll
            for (int kk = 0; kk < 16; ++kk) { ac[kk] = 0.f; as[kk] = 0.f; }
            for (int c = 0; c < 64; ++c) { const int idx = (c * F.lane) & 63; const float cc = ctab[idx], ss = ctab[(idx - 16) & 63];
#pragma unroll
                for (int kk = 0; kk < 16; ++kk) { const float w = scr[kk * 64 + c]; ac[kk] += w * cc; as[kk] += w * ss; } }
            bf16* oc = win_t + (size_t)l * NP * D + (size_t)(COL_FC + g * 64 + F.lane) * D + k0;
            bf16* os = win_t + (size_t)l * NP * D + (size_t)(COL_FS + g * 64 + F.lane) * D + k0;
            u32x4 a, b;
            a.x = pk2(ac[0], ac[1]); a.y = pk2(ac[2], ac[3]); a.z = pk2(ac[4], ac[5]); a.w = pk2(ac[6], ac[7]);
            b.x = pk2(ac[8], ac[9]); b.y = pk2(ac[10], ac[11]); b.z = pk2(ac[12], ac[13]); b.w = pk2(ac[14], ac[15]);
            *(u32x4*)oc = a; *(u32x4*)(oc + 8) = b;
            a.x = pk2(as[0], as[1]); a.y = pk2(as[2], as[3]); a.z = pk2(as[4], as[5]); a.w = pk2(as[6], as[7]);
            b.x = pk2(as[8], as[9]); b.y = pk2(as[10], as[11]); b.z = pk2(as[12], as[13]); b.w = pk2(as[14], as[15]);
            *(u32x4*)os = a; *(u32x4*)(os + 8) = b;
            LDS_WAIT(); asm volatile("" ::: "memory");
            continue; }
        r -= I_FOLD_L;
        {
            const int cb = r >> 3, ks = r & 7;
#pragma unroll
            for (int q = 0; q < 2; ++q) { const int k = ks * 128 + q * 64 + F.lane;
                const float c0 = p_c[k], c1 = p_c[D + k], c2 = p_cctx[k];
                scr[0 * 128 + q * 64 + F.lane] = c0 * sigmoidf_(c0); scr[1 * 128 + q * 64 + F.lane] = c1 * sigmoidf_(c1); scr[2 * 128 + q * 64 + F.lane] = c2 * sigmoidf_(c2); }
            LDS_WAIT(); asm volatile("" ::: "memory");
            const float* W = p_adaw + (size_t)l * D * 6144 + (size_t)(ks * 128) * 6144 + cb * 64 + F.lane;
            float a0 = 0.f, a1 = 0.f, a2 = 0.f;
#pragma unroll 8
            for (int kk = 0; kk < 128; ++kk) { const float w = W[(size_t)kk * 6144]; a0 += scr[kk] * w; a1 += scr[128 + kk] * w; a2 += scr[256 + kk] * w; }
            float* mp = (float*)(ws + WS_MODP) + (size_t)((l * 8 + ks) * 3) * 6144 + cb * 64 + F.lane;
            mp[0] = a0; mp[6144] = a1; mp[2 * 6144] = a2;
            LDS_WAIT(); asm volatile("" ::: "memory");
        }
    }
}

__device__ __forceinline__ void mod_to_lds(const Frame& F0, int l, int p, LAS float* dst, bool from_partials) {
    const Frame F = phase_frame(F0); unsigned char* const ws = F.ws;
    const float* adab = inptr(I_ADAB);
    for (int idx = F.tid; idx < 3 * 1024; idx += NTHR) { const int r = idx >> 10, n = idx & 1023;
        float v;
        if (from_partials) { v = adab[l * 6144 + p * 1024 + n]; const float* mp = (const float*)(ws + WS_MODP) + (size_t)(l * 8 * 3 + r) * 6144 + p * 1024 + n;
#pragma unroll
            for (int ks = 0; ks < 8; ++ks) v += mp[(size_t)ks * 3 * 6144]; }
        else v = ((const float*)(ws + WS_MODF))[(size_t)(l * 3 + r) * 6144 + p * 1024 + n];
        dst[idx] = v; }
}
__device__ __forceinline__ void mod_finalize(const Frame& F0) {
    const Frame F = phase_frame(F0); unsigned char* const ws = F.ws;
    const float* adab = inptr(I_ADAB);
    for (int idx = F.vcu * NTHR + F.tid; idx < 2 * 3 * 6144; idx += F.G * NTHR) { const int l = idx / (3 * 6144), rem = idx % (3 * 6144), r = rem / 6144, n = rem % 6144;
        float v = adab[l * 6144 + n]; const float* mp = (const float*)(ws + WS_MODP) + (size_t)(l * 8 * 3 + r) * 6144 + n;
#pragma unroll
        for (int ks = 0; ks < 8; ++ks) v += mp[(size_t)ks * 3 * 6144];
        ((float*)(ws + WS_MODF))[idx] = v; }
}


__device__ __forceinline__ void norm_mod_row(f32x4 (&v)[4], const float* gain, const LAS float* sc, const LAS float* sh, bf16* orow, int lane) {
    float s = 0.f;
#pragma unroll
    for (int j = 0; j < 4; ++j) s += (v[j].x * v[j].x + v[j].y * v[j].y) + (v[j].z * v[j].z + v[j].w * v[j].w);
    const float rs = rsqrtf(wave_sum(s) * (1.f / D) + RMS_EPS);
#pragma unroll
    for (int j = 0; j < 4; ++j) { const int c = 4 * lane + 256 * j; const f32x4 g = *(const f32x4*)(gain + c); const f32x4 a = *(const LAS f32x4*)(sc + c), b = *(const LAS f32x4*)(sh + c);
        v[j] = (v[j] * rs) * g * (a + 1.f) + b;
        u32x2 w; w.x = pk2(v[j].x, v[j].y); w.y = pk2(v[j].z, v[j].w); *(u32x2*)(orow + c) = w; }
}

__device__ __forceinline__ void p0b_norm1(const Frame& F0) {
    const Frame F = phase_frame(F0); unsigned char* const ws = F.ws;
    LAS float* msh = (LAS float*)F.lds; LAS float* msc = msh + 3072;
    mod_to_lds(F, 0, 0, msh, true); mod_to_lds(F, 0, 1, msc, true); __syncthreads();
    mod_finalize(F);
    bf16* H = (bf16*)(ws + WS_H); const float* xin = inptr(I_X); const float* cin = inptr(I_CTX); const float* n1g = inptr(I_N1G);
    for (int row0 = F.gw; row0 < NROW; row0 += 2 * F.NGW) { f32x4 v[2][4]; bool ok[2];
#pragma unroll
        for (int u = 0; u < 2; ++u) { const int row = row0 + u * F.NGW; ok[u] = row < NROW; if (ok[u]) { const float* xr = row < NLAT ? xin + (size_t)row * D : cin + (size_t)(row - NLAT) * D;
#pragma unroll
            for (int j = 0; j < 4; ++j) v[u][j] = *(const f32x4*)(xr + 4 * F.lane + 256 * j); } }
#pragma unroll
        for (int u = 0; u < 2; ++u) if (ok[u]) { const int row = row0 + u * F.NGW; const int mr = modrow(row);
            norm_mod_row(v[u], n1g, msc + mr * 1024, msh + mr * 1024, H + (size_t)row * D, F.lane); } }
}
__device__ __forceinline__ void unpack8(const u32x4 w, float (&o)[8]) {
    o[0] = bf2f(w.x & 0xffffu); o[1] = bf2f(w.x >> 16); o[2] = bf2f(w.y & 0xffffu); o[3] = bf2f(w.y >> 16);
    o[4] = bf2f(w.z & 0xffffu); o[5] = bf2f(w.z >> 16); o[6] = bf2f(w.w & 0xffffu); o[7] = bf2f(w.w >> 16);
}
__device__ __forceinline__ void unpack4(const u32x2 w, float (&o)[4]) { o[0] = bf2f(w.x & 0xffffu); o[1] = bf2f(w.x >> 16); o[2] = bf2f(w.y & 0xffffu); o[3] = bf2f(w.y >> 16); }

__device__ __forceinline__ void shift_pass(const Frame& F0, int l) {
    const Frame F = phase_frame(F0); unsigned char* const ws = F.ws;
    const bf16* P = (const bf16*)(ws + WS_P); bf16* Zs = (bf16*)(ws + WS_ZS); const float* mu = inptr(I_MU) + l * ZW;
    const int total = NROW * 240;
    for (int idx = F.vcu * NTHR + F.tid; idx < total; idx += F.G * NTHR) {
        const int row = idx / 240, ck = idx % 240; const bf16* pr = P + (size_t)row * NP + ck * 8;
        const u32x4 zero = {0u, 0u, 0u, 0u};
        float z[8], n0[8], n1[8], n2[8], n3[8], o[8];
        unpack8(*(const u32x4*)pr, z);
        if (row < NLAT) { const int t = row & (SEQ - 1), gr = t >> 6, gc = t & 63;
            unpack8(gc > 0 ? *(const u32x4*)(pr - NP) : zero, n0); unpack8(gc < 63 ? *(const u32x4*)(pr + NP) : zero, n1);
            unpack8(gr > 0 ? *(const u32x4*)(pr - 64 * NP) : zero, n2); unpack8(gr < 127 ? *(const u32x4*)(pr + 64 * NP) : zero, n3);
        } else { const int tc = (row - NLAT) & (CTXL - 1);
            unpack8(tc > 0 ? *(const u32x4*)(pr - NP) : zero, n0); unpack8(tc < CTXL - 1 ? *(const u32x4*)(pr + NP) : zero, n1);
#pragma unroll
            for (int j = 0; j < 8; ++j) { n2[j] = n0[j]; n3[j] = n1[j]; }
        }
        const f32x4 m0 = *(const f32x4*)(mu + ck * 8), m1 = *(const f32x4*)(mu + ck * 8 + 4);
        const float m[8] = {m0.x, m0.y, m0.z, m0.w, m1.x, m1.y, m1.z, m1.w};
#pragma unroll
        for (int j = 0; j < 8; ++j) { const float nb = (j & 3) == 0 ? n0[j] : (j & 3) == 1 ? n1[j] : (j & 3) == 2 ? n2[j] : n3[j]; o[j] = z[j] + (nb - z[j]) * m[j]; }
        u32x4 w; w.x = pk2(o[0], o[1]); w.y = pk2(o[2], o[3]); w.z = pk2(o[4], o[5]); w.w = pk2(o[6], o[7]);
        *(u32x4*)(Zs + (size_t)row * ZW + ck * 8) = w;
    }
}

__device__ __forceinline__ void conv_pass(const Frame& F0, int l, int nrows) {
    const Frame F = phase_frame(F0); unsigned char* const ws = F.ws;
    const bf16* P = (const bf16*)(ws + WS_P); bf16* MA = (bf16*)(ws + WS_H);
    const float* cw = inptr(I_CONVW) + l * 3 * 256; const int c = 4 * F.lane;
    const f32x4 w0 = *(const f32x4*)(cw + c), w1 = *(const f32x4*)(cw + 256 + c), w2 = *(const f32x4*)(cw + 512 + c), gn = *(const f32x4*)(inptr(I_CONVG) + l * 256 + c);
    for (int row0 = F.gw; row0 < nrows; row0 += 2 * F.NGW) {
        u32x2 q[2][7]; bool ok[2]; const u32x2 zero = {0u, 0u};
#pragma unroll
        for (int u = 0; u < 2; ++u) { const int row = row0 + u * F.NGW; ok[u] = row < nrows; if (ok[u]) {
            int t, L; if (row < NLAT) { t = row & (SEQ - 1); L = SEQ; } else { t = (row - NLAT) & (CTXL - 1); L = CTXL; }
            const bf16* pr = P + (size_t)row * NP + COL_CONV + c;
            q[u][0] = *(const u32x2*)pr; q[u][1] = *(const u32x2*)(pr + 256); q[u][2] = *(const u32x2*)(pr + 512);
            q[u][3] = t > 0 ? *(const u32x2*)(pr - NP + 256) : zero; q[u][4] = t > 0 ? *(const u32x2*)(pr - NP + 512) : zero;
            q[u][5] = t < L - 1 ? *(const u32x2*)(pr + NP + 256) : zero; q[u][6] = t < L - 1 ? *(const u32x2*)(pr + NP + 512) : zero; } }
#pragma unroll
        for (int u = 0; u < 2; ++u) if (ok[u]) { const int row = row0 + u * F.NGW;
            float bg[4], cg[4], hh[4], cp[4], hp[4], cn[4], hn[4];
            unpack4(q[u][0], bg); unpack4(q[u][1], cg); unpack4(q[u][2], hh); unpack4(q[u][3], cp); unpack4(q[u][4], hp); unpack4(q[u][5], cn); unpack4(q[u][6], hn);
            const float W0[4] = {w0.x, w0.y, w0.z, w0.w}, W1[4] = {w1.x, w1.y, w1.z, w1.w}, W2[4] = {w2.x, w2.y, w2.z, w2.w}, GN[4] = {gn.x, gn.y, gn.z, gn.w};
            float y[4], s = 0.f;
#pragma unroll
            for (int j = 0; j < 4; ++j) { y[j] = bg[j] * (W0[j] * (cp[j] * hp[j]) + W1[j] * (cg[j] * hh[j]) + W2[j] * (cn[j] * hn[j])); s += y[j] * y[j]; }
            const float rs = rsqrtf(wave_sum(s) * (1.f / 256.f) + RMS_EPS);
            u32x2 o; o.x = pk2(y[0] * rs * GN[0], y[1] * rs * GN[1]); o.y = pk2(y[2] * rs * GN[2], y[3] * rs * GN[3]);
            *(u32x2*)(MA + (size_t)row * D + 512 + c) = o; }
    }
}

__device__ __forceinline__ void sincos_turns(float x, float& s, float& c) { s = __builtin_amdgcn_sinf(x); c = __builtin_amdgcn_cosf(x); }
#define MFMA16(a, b, c) __builtin_amdgcn_mfma_f32_16x16x32_bf16((a), (b), (c), 0, 0, 0)

__device__ __forceinline__ void fftA_item(const Frame& F0, int item) {
    const Frame F = phase_frame(F0); unsigned char* const ws = F.ws;
    const int half = item & 1, t2 = (item >> 1) & 63, b = item >> 7;
    const bf16* P = (const bf16*)(ws + WS_P); bf16* GT = (bf16*)(ws + WS_GT);
    LAS bf16* Bs = (LAS bf16*)F.lds;
    const int lane = F.lane, w = F.wave, fr = lane & 15, fq = lane >> 4;
    __syncthreads();
#pragma unroll
    for (int i = 0; i < 8; ++i) { const int cidx = F.tid + NTHR * i, krow = cidx >> 4, ch8 = cidx & 15, ri = krow >> 7, t1 = krow & 127;
        const u32x4 v = *(const u32x4*)(P + (size_t)(b * SEQ + t1 * 64 + t2) * NP + COL_FC + ri * 256 + half * 128 + ch8 * 8);
        LAS bf16* d = Bs + (ch8 * 8) * 264 + krow;
        d[0 * 264] = (bf16)(v.x & 0xffffu); d[1 * 264] = (bf16)(v.x >> 16); d[2 * 264] = (bf16)(v.y & 0xffffu); d[3 * 264] = (bf16)(v.y >> 16);
        d[4 * 264] = (bf16)(v.z & 0xffffu); d[5 * 264] = (bf16)(v.z >> 16); d[6 * 264] = (bf16)(v.w & 0xffffu); d[7 * 264] = (bf16)(v.w >> 16); }
    __syncthreads();
    f32x4 acc[2][8];
#pragma unroll
    for (int a = 0; a < 2; ++a)
#pragma unroll
        for (int n = 0; n < 8; ++n) acc[a][n] = (f32x4){0.f, 0.f, 0.f, 0.f};
    int t1p_a = 16 * w + fr;
    asm volatile("" : "+v"(t1p_a));
#pragma unroll
    for (int ks = 0; ks < 8; ++ks) {
        bf16x8 ar, ai;
#pragma unroll
        for (int j = 0; j < 8; ++j) { const int k = ks * 32 + 8 * fq + j, ri = k >> 7, t1 = k & 127; const int idx = (t1 * t1p_a) & 127;
            float sn, cs; sincos_turns((float)idx * (1.f / 128.f), sn, cs);
            const float vr = ri == 0 ? cs : -sn, vi = ri == 0 ? -sn : -cs;
            ar[j] = (short)f2bf(vr); ai[j] = (short)f2bf(vi); }
#pragma unroll
        for (int nt = 0; nt < 8; ++nt) { const bf16x8 bfr = *(const LAS bf16x8*)(Bs + (nt * 16 + fr) * 264 + ks * 32 + 8 * fq);
            acc[0][nt] = MFMA16(ar, bfr, acc[0][nt]); acc[1][nt] = MFMA16(ai, bfr, acc[1][nt]); }
    }
#pragma unroll
    for (int reg = 0; reg < 4; ++reg) { const int t1p = 16 * w + 4 * fq + reg; float st, ct; sincos_turns((float)(t2 * t1p) * (1.f / 8192.f), st, ct);
        bf16* g = GT + ((size_t)((b * 128 + t1p) * 64 + t2) * 2) * 256 + half * 128 + fr;
#pragma unroll
        for (int nt = 0; nt < 8; ++nt) { const float gr = acc[0][nt][reg], gi = acc[1][nt][reg];
            g[nt * 16] = (bf16)f2bf(gr * ct + gi * st); g[256 + nt * 16] = (bf16)f2bf(gi * ct - gr * st); } }
}

template <int NKC, int NDIV, class SrcRow, class OutRow>
__device__ __forceinline__ void dft64_item(const Frame& F0, int l, int m0, float sgn, float scale, SrcRow src, OutRow orow) {
    const Frame F = phase_frame(F0); unsigned char* const ws = F.ws;
    LAS bf16* Bs = (LAS bf16*)F.lds;
    LAS float* red = (LAS float*)(F.lds + 256 * 136 * 2);
    const int lane = F.lane, w = F.wave, fr = lane & 15, fq = lane >> 4;
    int fr_a = fr; asm volatile("" : "+v"(fr_a));
    f32x4 acc[4][2];
#pragma unroll
    for (int a = 0; a < 4; ++a) { acc[a][0] = (f32x4){0.f, 0.f, 0.f, 0.f}; acc[a][1] = (f32x4){0.f, 0.f, 0.f, 0.f}; }
    for (int kc = 0; kc < NKC; ++kc) {
        __syncthreads();
#pragma unroll
        for (int i = 0; i < 8; ++i) { const int cidx = F.tid + NTHR * i, krow = cidx >> 5, ch8 = cidx & 31;
            const u32x4 v = *(const u32x4*)(src(kc * 64 + (krow >> 1), krow & 1) + ch8 * 8);
            LAS bf16* d = Bs + (ch8 * 8) * 136 + krow;
            d[0 * 136] = (bf16)(v.x & 0xffffu); d[1 * 136] = (bf16)(v.x >> 16); d[2 * 136] = (bf16)(v.y & 0xffffu); d[3 * 136] = (bf16)(v.y >> 16);
            d[4 * 136] = (bf16)(v.z & 0xffffu); d[5 * 136] = (bf16)(v.z >> 16); d[6 * 136] = (bf16)(v.w & 0xffffu); d[7 * 136] = (bf16)(v.w >> 16); }
        __syncthreads();
#pragma unroll
        for (int ks = 0; ks < 4; ++ks) {
            const bf16x8 b0 = *(const LAS bf16x8*)(Bs + ((2 * w) * 16 + fr) * 136 + ks * 32 + 8 * fq);
            const bf16x8 b1 = *(const LAS bf16x8*)(Bs + ((2 * w + 1) * 16 + fr) * 136 + ks * 32 + 8 * fq);
#pragma unroll
            for (int mt = 0; mt < 4; ++mt) { const int mrow = m0 + mt * 16 + fr_a; bf16x8 a;
#pragma unroll
                for (int j = 0; j < 8; ++j) { const int k = ks * 32 + 8 * fq + j, tl = k >> 1, ri = k & 1; const int idx = ((kc * 64 + tl) * mrow) & (NDIV - 1);
                    float sn, cs; sincos_turns((float)idx * (1.f / (float)NDIV), sn, cs);
                    a[j] = (short)f2bf(ri == 0 ? cs : sgn * sn); }
                acc[mt][0] = MFMA16(a, b0, acc[mt][0]); acc[mt][1] = MFMA16(a, b1, acc[mt][1]); }
        }
    }
#pragma unroll
    for (int mt = 0; mt < 4; ++mt)
#pragma unroll
        for (int reg = 0; reg < 4; ++reg) { const float a = acc[mt][0][reg] * scale, b = acc[mt][1][reg] * scale; acc[mt][0][reg] = a; acc[mt][1][reg] = b;
            float s = a * a + b * b; s += __shfl_xor(s, 1); s += __shfl_xor(s, 2); s += __shfl_xor(s, 4); s += __shfl_xor(s, 8);
            if (fr == 0) red[w * 64 + mt * 16 + 4 * fq + reg] = s; }
    __syncthreads();
    bf16* MA = (bf16*)(ws + WS_H); const float* fg = inptr(I_FOURG) + l * 256;
    const float g0 = fg[(2 * w) * 16 + fr], g1 = fg[(2 * w + 1) * 16 + fr];
#pragma unroll
    for (int mt = 0; mt < 4; ++mt)
#pragma unroll
        for (int reg = 0; reg < 4; ++reg) { const int ml = mt * 16 + 4 * fq + reg; float tot = 0.f;
#pragma unroll
            for (int ww = 0; ww < 8; ++ww) tot += red[ww * 64 + ml];
            const float rs = rsqrtf(tot * (1.f / 256.f) + RMS_EPS);
            bf16* o = MA + (size_t)orow(m0 + ml) * D + 768 + fr;
            o[(2 * w) * 16] = (bf16)f2bf(acc[mt][0][reg] * rs * g0); o[(2 * w + 1) * 16] = (bf16)f2bf(acc[mt][1][reg] * rs * g1); }
    __syncthreads();
}

constexpr size_t WS_LORA = 64 * 1024;
constexpr int LINP = 392;
__device__ __forceinline__ float fast_sigmoid(float x) { return __builtin_amdgcn_rcpf(1.f + __expf(-x)); }
__device__ __forceinline__ float fast_tanh(float x) { return 1.f - 2.f * __builtin_amdgcn_rcpf(1.f + __expf(2.f * x)); }
__device__ __forceinline__ void prep_phase(const Frame& F0, int l) {
    const Frame F = phase_frame(F0); unsigned char* const ws = F.ws;
    const bf16* Zs = (const bf16*)(ws + WS_ZS); bf16* STR = (bf16*)(ws + WS_STR);
    LAS bf16* lin = (LAS bf16*)F.lds;
    LAS float* ssum = (LAS float*)(F.lds + 12544);
    LAS bf16* tiles = (LAS bf16*)(F.lds + 13312);
    const int lane = F.lane, fr = lane & 15, fq = lane >> 4, w = F.wave, tid = F.tid;
    const int nitems = (NROW / 16) * 2;
    int it = blockIdx.x; if (it >= nitems) return;
    int hh = -1, head = 0, cb = 0;
    bf16x8 wf[12][2];
    const float* kkp = inptr(I_KK) + l * DR; const float* kap = inptr(I_KA) + l * DR; const float* dw0 = inptr(I_DW0) + l * 2 * DR; const float* ia0 = inptr(I_IA0) + l * 2 * DR;
    u32x4 pz[2];
#define PREP_LOAD(item_) do { const int row0_ = ((item_) >> 1) * 16; \
        pz[0] = *(const u32x4*)(Zs + (size_t)(row0_ + tid / 48) * ZW + 1536 + (tid % 48) * 8); \
        if (tid < 256) pz[1] = *(const u32x4*)(Zs + (size_t)(row0_ + (tid + 512) / 48) * ZW + 1536 + ((tid + 512) % 48) * 8); } while (0)
    PREP_LOAD(it);
    for (; it < nitems; it += F.G) {
        const int tile = it >> 1;
        if ((it & 1) != hh) {
            hh = it & 1; head = 4 * hh + (w >> 1); cb = 64 * head + 32 * (w & 1);
            const bf16* WL = (const bf16*)(ws + WS_LORA) + (size_t)l * 512 * 384 + (size_t)(cb + fr) * 384 + 8 * fq;
#pragma unroll
            for (int ks = 0; ks < 12; ++ks)
#pragma unroll
                for (int nt = 0; nt < 2; ++nt) wf[ks][nt] = *(const bf16x8*)(WL + (size_t)nt * 16 * 384 + ks * 32);
        }
        __syncthreads();
        {   float v[8]; unpack8(pz[0], v); const int c8 = tid % 48;
            if (c8 < 16) {
#pragma unroll
                for (int j = 0; j < 8; ++j) v[j] = fast_tanh(v[j]); }
            else if (c8 >= 32) {
#pragma unroll
                for (int j = 0; j < 8; ++j) v[j] = fast_sigmoid(v[j]); }
            *(LAS u32x4*)(lin + (tid / 48) * LINP + c8 * 8) = (u32x4){pk2(v[0], v[1]), pk2(v[2], v[3]), pk2(v[4], v[5]), pk2(v[6], v[7])};
            if (tid < 256) { unpack8(pz[1], v); const int c9 = (tid + 512) % 48;
                if (c9 < 16) {
#pragma unroll
                    for (int j = 0; j < 8; ++j) v[j] = fast_tanh(v[j]); }
                else if (c9 >= 32) {
#pragma unroll
                    for (int j = 0; j < 8; ++j) v[j] = fast_sigmoid(v[j]); }
                *(LAS u32x4*)(lin + ((tid + 512) / 48) * LINP + c9 * 8) = (u32x4){pk2(v[0], v[1]), pk2(v[2], v[3]), pk2(v[4], v[5]), pk2(v[6], v[7])}; } }
        u32x2 zr2[2], zk2[2], zv2[2];
        {   const bf16* zr_ = Zs + (size_t)(tile * 16 + fr) * ZW + cb + 4 * fq;
#pragma unroll
            for (int nt = 0; nt < 2; ++nt) { zr2[nt] = *(const u32x2*)(zr_ + 16 * nt); zk2[nt] = *(const u32x2*)(zr_ + 512 + 16 * nt); zv2[nt] = *(const u32x2*)(zr_ + 1024 + 16 * nt); } }
        if (it + F.G < nitems) PREP_LOAD(it + F.G);
        __syncthreads();
        f32x4 kkw[2], kaw[2], d0w[2][2], i0w[2][2];
#pragma unroll
        for (int nt = 0; nt < 2; ++nt) { const int c0 = cb + 16 * nt + 4 * fq; kkw[nt] = *(const f32x4*)(kkp + c0); kaw[nt] = *(const f32x4*)(kap + c0);
#pragma unroll
            for (int dn = 0; dn < 2; ++dn) { d0w[dn][nt] = *(const f32x4*)(dw0 + dn * DR + c0); i0w[dn][nt] = *(const f32x4*)(ia0 + dn * DR + c0); } }
        f32x4 acc[5][2];
#pragma unroll
        for (int q = 0; q < 5; ++q) { acc[q][0] = (f32x4){0.f, 0.f, 0.f, 0.f}; acc[q][1] = (f32x4){0.f, 0.f, 0.f, 0.f}; }
#pragma unroll
        for (int ks = 0; ks < 12; ++ks) { const int q = ks < 8 ? (ks >> 1) : 4; const bf16x8 xf = *(const LAS bf16x8*)(lin + fr * LINP + ks * 32 + 8 * fq);
            acc[q][0] = MFMA16(wf[ks][0], xf, acc[q][0]); acc[q][1] = MFMA16(wf[ks][1], xf, acc[q][1]); }
        float zk[2][4], kv[2][4]; float ss = 0.f;
#pragma unroll
        for (int nt = 0; nt < 2; ++nt) { unpack4(zk2[nt], zk[nt]);
#pragma unroll
            for (int i = 0; i < 4; ++i) { kv[nt][i] = zk[nt][i] * kkw[nt][i]; ss += kv[nt][i] * kv[nt][i]; } }
        ss += __shfl_xor(ss, 16); ss += __shfl_xor(ss, 32);
        if (fq == 0) ssum[w * 16 + fr] = ss;
        __syncthreads();
        const float inv = __builtin_amdgcn_rcpf(fmaxf(sqrtf(ssum[w * 16 + fr] + ssum[(w ^ 1) * 16 + fr]), 1e-12f));
        LAS bf16* th = tiles + (w >> 1) * 10 * 1024 + fr * 64 + 32 * (w & 1) + 4 * fq;
#pragma unroll
        for (int nt = 0; nt < 2; ++nt) { LAS bf16* t0 = th + 16 * nt;
            *(LAS u32x2*)(t0) = zr2[nt]; *(LAS u32x2*)(t0 + 1024) = zv2[nt];
            float kk[4];
#pragma unroll
            for (int i = 0; i < 4; ++i) kk[i] = kv[nt][i] * inv;
            *(LAS u32x2*)(t0 + 2 * 1024) = (u32x2){pk2(kk[0], kk[1]), pk2(kk[2], kk[3])};
            *(LAS u32x2*)(t0 + 3 * 1024) = (u32x2){pk2(acc[4][nt][0], acc[4][nt][1]), pk2(acc[4][nt][2], acc[4][nt][3])};
#pragma unroll
            for (int dn = 0; dn < 2; ++dn) { float ep[4], kd[4], bb[4];
#pragma unroll
                for (int i = 0; i < 4; ++i) { const float ew = fast_sigmoid(d0w[dn][nt][i] + acc[dn][nt][i]) * 0.6065306597126334f;
                    ep[i] = ew * (1.f + ew * (-0.5f + ew * (0.16666667f + ew * (-0.041666668f + ew * 0.0083333338f))));
                    const float a = fast_sigmoid(i0w[dn][nt][i] + acc[2 + dn][nt][i]); kd[i] = zk[nt][i] * (1.f + (a - 1.f) * kaw[nt][i]); bb[i] = kk[i] * a; }
                *(LAS u32x2*)(t0 + (4 + 3 * dn) * 1024) = (u32x2){pk2(ep[0], ep[1]), pk2(ep[2], ep[3])};
                *(LAS u32x2*)(t0 + (5 + 3 * dn) * 1024) = (u32x2){pk2(kd[0], kd[1]), pk2(kd[2], kd[3])};
                *(LAS u32x2*)(t0 + (6 + 3 * dn) * 1024) = (u32x2){pk2(bb[0], bb[1]), pk2(bb[2], bb[3])}; } }
        __syncthreads();
        {   const LAS bf16* src = tiles + (w >> 1) * 10 * 1024 + 8 * (w & 1) * 64 + lane * 8; bf16* dst = STR + ((size_t)tile * 8 + head) * 10240 + 8 * (w & 1) * 64 + lane * 8;
#pragma unroll
            for (int s = 0; s < 10; ++s) *(u32x4*)(dst + s * 1024) = *(const LAS u32x4*)(src + s * 1024); }
    }
#undef PREP_LOAD
}

__device__ __forceinline__ int scan_rowof(int s, int dir, int b) { if (s < CTXL) { const int tc = dir ? (CTXL - 1 - s) : s; return NLAT + b * CTXL + tc; } const int tt = s - CTXL; const int t = dir ? (SEQ - 1 - tt) : tt; return b * SEQ + t; }
__device__ __forceinline__ void readout_pass(const Frame& F0, int l, int nrows) {
    const Frame F = phase_frame(F0); unsigned char* const ws = F.ws;
    const bf16* STR = (const bf16*)(ws + WS_STR); const bf16* Y0 = (const bf16*)(ws + WS_Y); const bf16* Y1 = Y0 + (size_t)NROW * DR; bf16* MA = (bf16*)(ws + WS_H);
    const int lane = F.lane, c = 8 * lane;
    float gw[8], gb[8], rk[8];
    {   const float* gnw = inptr(I_GNW) + l * DR + c; const float* gnb = inptr(I_GNB) + l * DR + c; const float* rkp = inptr(I_RK) + l * DR + c;
        const f32x4 a0 = *(const f32x4*)gnw, a1 = *(const f32x4*)(gnw + 4), b0 = *(const f32x4*)gnb, b1 = *(const f32x4*)(gnb + 4), r0 = *(const f32x4*)rkp, r1 = *(const f32x4*)(rkp + 4);
#pragma unroll
        for (int i = 0; i < 4; ++i) { gw[i] = a0[i]; gw[4 + i] = a1[i]; gb[i] = b0[i]; gb[4 + i] = b1[i]; rk[i] = r0[i]; rk[4 + i] = r1[i]; } }
    for (int row0 = F.gw; row0 < nrows; row0 += 2 * F.NGW) {
        u32x4 q[2][7]; bool ok[2];
#pragma unroll
        for (int u = 0; u < 2; ++u) { const int row = row0 + u * F.NGW; ok[u] = row < nrows; if (ok[u]) {
            const bf16* sr = STR + ((size_t)(row >> 4) * 8 + (lane >> 3)) * 10240 + (row & 15) * 64 + (lane & 7) * 8;
            q[u][0] = *(const u32x4*)(Y0 + (size_t)row * DR + c); q[u][1] = *(const u32x4*)(Y1 + (size_t)row * DR + c);
            q[u][2] = *(const u32x4*)sr; q[u][3] = *(const u32x4*)(sr + 1024); q[u][4] = *(const u32x4*)(sr + 3072); q[u][5] = *(const u32x4*)(sr + 5 * 1024); q[u][6] = *(const u32x4*)(sr + 8 * 1024); } }
#pragma unroll
        for (int u = 0; u < 2; ++u) if (ok[u]) { const int row = row0 + u * F.NGW;
            float ya[8], yb[8], r[8], v[8], g[8], k0[8], k1[8];
            unpack8(q[u][0], ya); unpack8(q[u][1], yb); unpack8(q[u][2], r); unpack8(q[u][3], v); unpack8(q[u][4], g); unpack8(q[u][5], k0); unpack8(q[u][6], k1);
            float s1 = 0.f, s2 = 0.f, sb = 0.f;
#pragma unroll
            for (int i = 0; i < 8; ++i) { ya[i] += yb[i]; s1 += ya[i]; s2 += ya[i] * ya[i]; sb += r[i] * (k0[i] + k1[i]) * rk[i]; }
#pragma unroll
            for (int o = 1; o < 8; o <<= 1) { s1 += __shfl_xor(s1, o); s2 += __shfl_xor(s2, o); sb += __shfl_xor(sb, o); }
            const float mu = s1 * (1.f / 64.f); const float var = fmaxf(s2 * (1.f / 64.f) - mu * mu, 0.f); const float rs = rsqrtf(var + GN_EPS);
            float o8[8];
#pragma unroll
            for (int i = 0; i < 8; ++i) o8[i] = ((ya[i] - mu) * rs * gw[i] + gb[i] + sb * v[i]) * g[i];
            *(u32x4*)(MA + (size_t)row * D + c) = (u32x4){pk2(o8[0], o8[1]), pk2(o8[2], o8[3]), pk2(o8[4], o8[5]), pk2(o8[6], o8[7])}; }
    }
}
constexpr int BLOB = 16384, SEGCH = 132, NSEG = 4, BLOB_B1_SCANS = 14;
constexpr size_t WS_BLOBA = 20 * MiB, WS_BLOBB1 = 86 * MiB, WS_BLOBB2 = 492 * MiB;
constexpr size_t WS_SCANST = 2 * MiB + 512 * 1024;
__device__ __forceinline__ unsigned char* blob_ptr(unsigned char* ws, int seg, int scan, int ci) {
    if ((seg & 1) == 0) return ws + WS_BLOBA + ((size_t)scan * SEGCH + ci) * BLOB;
    return scan < BLOB_B1_SCANS ? ws + WS_BLOBB1 + ((size_t)scan * SEGCH + ci) * BLOB : ws + WS_BLOBB2 + ((size_t)(scan - BLOB_B1_SCANS) * SEGCH + ci) * BLOB;
}
typedef short s16x4 __attribute__((ext_vector_type(4)));
__device__ __forceinline__ bf16x8 frag_lo(u32x2 x) { u32x4 t = {x.x, x.y, 0u, 0u}; return __builtin_bit_cast(bf16x8, t); }
__device__ __forceinline__ bf16x8 frag_c(const f32x4& a) { u32x4 t = {pk2(a[0], a[1]), pk2(a[2], a[3]), 0u, 0u}; return __builtin_bit_cast(bf16x8, t); }

struct PreRegs { u32x4 q[12]; };
__device__ __forceinline__ void pre_load(PreRegs& R, unsigned char* ws, int scan, int cs, int lane) {
    const int dir = scan & 1, h = (scan >> 1) & 7, b = scan >> 4; const int rfirst = scan_rowof(16 * cs, dir, b);
    const bf16* blk = (const bf16*)(ws + WS_STR) + ((size_t)(rfirst >> 4) * 8 + h) * 10240 + lane * 8;
    const int so[6] = {0, 1, 2, 4 + 3 * dir, 5 + 3 * dir, 6 + 3 * dir};
#pragma unroll
    for (int i = 0; i < 6; ++i) { R.q[2 * i] = *(const u32x4*)(blk + so[i] * 1024); R.q[2 * i + 1] = *(const u32x4*)(blk + so[i] * 1024 + 512); }
}
template <int PM>
__device__ __forceinline__ void pre_item(const Frame& F, unsigned char* ws, int scan, int cs, unsigned char* blob, PreRegs& PR, int nscan, int ncs) {
    const int dir = scan & 1, h = (scan >> 1) & 7, b = scan >> 4; const int lane = F.lane, fr = lane & 15, fq = lane >> 4;
    LAS unsigned char* L = F.lds + F.wave * 17408;
    LAS bf16* TK = (LAS bf16*)L; LAS bf16* TR = TK + 1024; LAS bf16* TKt = TR + 1024; LAS bf16* TB = TKt + 1024;
    LAS bf16* KTt = TB + 1024; LAS bf16* RTt = KTt + 1024; LAS bf16* Vt = RTt + 1024;
    LAS float* AKB = (LAS float*)(Vt + 1024);
    LAS bf16* AKK = (LAS bf16*)(AKB + 256); LAS bf16* ARK = AKK + 256; LAS bf16* ARB = ARK + 256; LAS bf16* TT = ARB + 256;
    float kh[16], bh[16];
    float pc;
    {   float r_[16], v_[16], kk_[16], lp_[16], kd_[16], bb_[16];
        LAS bf16* stg = TK;
#pragma unroll
        for (int i = 0; i < 6; ++i) { *(LAS u32x4*)(stg + i * 1024 + lane * 8) = PR.q[2 * i]; *(LAS u32x4*)(stg + i * 1024 + 512 + lane * 8) = PR.q[2 * i + 1]; }
        LDS_WAIT(); asm volatile("" ::: "memory");
        if (nscan >= 0) pre_load(PR, ws, nscan, ncs, lane);
#pragma unroll
        for (int t = 0; t < 16; ++t) { const int tm = (dir ? 15 - t : t) * 64 + lane;
            r_[t] = bf2f(stg[tm]); v_[t] = bf2f(stg[1024 + tm]); kk_[t] = bf2f(stg[2048 + tm]); lp_[t] = bf2f(stg[3072 + tm]); kd_[t] = bf2f(stg[4096 + tm]); bb_[t] = bf2f(stg[5120 + tm]); }
        LDS_WAIT(); asm volatile("" ::: "memory");
        float pp = 1.f; u32x4 kt4[2], rt4[2], v4[2];
        unsigned ktp[8], rtp[8], vp[8];
#pragma unroll
        for (int t = 0; t < 16; ++t) { const float pm1 = pp; pp *= 1.f - lp_[t]; const float p = pp, ip = __builtin_amdgcn_rcpf(pp); lp_[t] = ip;
            const float kt = kk_[t] * pm1, ktl = kd_[t] * ip, btl = bb_[t] * ip, rt = r_[t] * p;
            const unsigned hk = pk2(kt, rt), hb = pk2(ktl, btl);
            TK[t * 64 + lane] = (bf16)(hk & 0xffffu); TR[t * 64 + lane] = (bf16)(hk >> 16); TKt[t * 64 + lane] = (bf16)(hb & 0xffffu); TB[t * 64 + lane] = (bf16)(hb >> 16);
            const unsigned hv = f2bf(v_[t]);
            if (t & 1) { ktp[t >> 1] |= hk << 16; rtp[t >> 1] |= hk & 0xffff0000u; vp[t >> 1] |= hv << 16; }
            else { ktp[t >> 1] = hk & 0xffffu; rtp[t >> 1] = hk >> 16; vp[t >> 1] = hv; } }
        kt4[0] = (u32x4){ktp[0], ktp[1], ktp[2], ktp[3]}; kt4[1] = (u32x4){ktp[4], ktp[5], ktp[6], ktp[7]};
        rt4[0] = (u32x4){rtp[0], rtp[1], rtp[2], rtp[3]}; rt4[1] = (u32x4){rtp[4], rtp[5], rtp[6], rtp[7]};
        v4[0] = (u32x4){vp[0], vp[1], vp[2], vp[3]}; v4[1] = (u32x4){vp[4], vp[5], vp[6], vp[7]};
        *(LAS u32x4*)(KTt + lane * 16) = kt4[0]; *(LAS u32x4*)(KTt + lane * 16 + 8) = kt4[1];
        *(LAS u32x4*)(RTt + lane * 16) = rt4[0]; *(LAS u32x4*)(RTt + lane * 16 + 8) = rt4[1];
        *(LAS u32x4*)(Vt + lane * 16) = v4[0]; *(LAS u32x4*)(Vt + lane * 16 + 8) = v4[1];
        pc = pp;
#pragma unroll
        for (int t = 0; t < 16; ++t) { const float e = pp * lp_[t]; kh[t] = kd_[t] * e; bh[t] = bb_[t] * e; }
    }
    LDS_WAIT(); asm volatile("" ::: "memory");
    {   f32x4 akb = {0.f, 0.f, 0.f, 0.f}, akk = akb, ark = akb, arb = akb;
#pragma unroll
        for (int s = 0; s < 2; ++s) { const int o = fr * 64 + 32 * s + 8 * fq;
            const bf16x8 fk = *(const LAS bf16x8*)(TK + o), frr = *(const LAS bf16x8*)(TR + o), fkt = *(const LAS bf16x8*)(TKt + o), fb = *(const LAS bf16x8*)(TB + o);
            akb = MFMA16(fk, fb, akb); akk = MFMA16(fk, fkt, akk); ark = MFMA16(frr, fkt, ark); arb = MFMA16(frr, fb, arb); }
        float nm[4];
#pragma unroll
        for (int reg = 0; reg < 4; ++reg) { const int t = 4 * fq + reg; const bool lo = fr < t, le = fr <= t;
            nm[reg] = lo ? akb[reg] : 0.f; AKK[t * 16 + fr] = (bf16)f2bf(lo ? akk[reg] : 0.f);
            ARK[t * 16 + fr] = (bf16)f2bf(le ? ark[reg] : 0.f); ARB[t * 16 + fr] = (bf16)f2bf(le ? arb[reg] : 0.f); }
        float col[16];
#pragma unroll
        for (int t = 0; t < 16; ++t) { float s_ = (t == fr) ? 1.f : 0.f;
#pragma unroll
            for (int i = 0; i < 16; ++i) if (i < t) { const float n_ti = __builtin_bit_cast(float, __builtin_amdgcn_readlane(__builtin_bit_cast(int, nm[t & 3]), i + 16 * (t >> 2))); s_ -= n_ti * col[i]; }
            col[t] = s_; TT[t * 16 + fr] = (bf16)f2bf(s_); }
    }
    LDS_WAIT(); asm volatile("" ::: "memory");
    f32x4 WTc[4], RqT[4], U0c[4], Y0c[4];
    {   const bf16x8 aT = frag_lo(*(const LAS u32x2*)(TT + fr * 16 + 4 * fq)), aKK = frag_lo(*(const LAS u32x2*)(AKK + fr * 16 + 4 * fq)), aRK = frag_lo(*(const LAS u32x2*)(ARK + fr * 16 + 4 * fq));
        u32x2 nb = *(const LAS u32x2*)(ARB + fr * 16 + 4 * fq); nb.x ^= 0x80008000u; nb.y ^= 0x80008000u; const bf16x8 aRBn = frag_lo(nb);
        const f32x4 z4 = {0.f, 0.f, 0.f, 0.f};
#pragma unroll
        for (int nt = 0; nt < 4; ++nt) { const int o = (16 * nt + fr) * 16 + 4 * fq;
            const bf16x8 bK = frag_lo(*(const LAS u32x2*)(KTt + o)), bV = frag_lo(*(const LAS u32x2*)(Vt + o));
            float ri[4]; unpack4(*(const LAS u32x2*)(TR + fr * 64 + 16 * nt + 4 * fq), ri);
            const f32x4 Wn = MFMA16(aT, bK, z4); WTc[nt] = MFMA16(bK, aT, z4);
            const f32x4 Zn = MFMA16(aKK, bV, z4);
            U0c[nt] = MFMA16(aT, frag_c(Zn), z4);
            RqT[nt] = MFMA16(frag_c(Wn), aRBn, ((f32x4){ri[0], ri[1], ri[2], ri[3]}));
            Y0c[nt] = MFMA16(aRK, bV, z4); Y0c[nt] = MFMA16(aRBn, frag_c(U0c[nt]), Y0c[nt]); }
    }
    LDS_WAIT(); asm volatile("" ::: "memory");
#pragma unroll
    for (int nt = 0; nt < 4; ++nt) { const u32x2 vv = *(const LAS u32x2*)(Vt + (16 * nt + fr) * 16 + 4 * fq);
        *(u32x2*)(blob + 8192 + nt * 2048 + 1024 + lane * 8) = vv;
        u32x2 u0 = {pk2(U0c[nt][0], U0c[nt][1]), pk2(U0c[nt][2], U0c[nt][3])}, y0 = {pk2(Y0c[nt][0], Y0c[nt][1]), pk2(Y0c[nt][2], Y0c[nt][3])};
        *(u32x2*)(blob + 8192 + nt * 2048 + lane * 8) = u0; *(u32x2*)(blob + 8192 + nt * 2048 + 512 + lane * 8) = y0;
        *(float*)(blob + 8192 + nt * 2048 + 1536 + lane * 4) = pc; }
#pragma unroll
    for (int s = 0; s < 2; ++s) {
        *(u32x4*)(blob + (0 * 2 + s) * 1024 + lane * 16) = (u32x4){pk2(WTc[2 * s][0], WTc[2 * s][1]), pk2(WTc[2 * s][2], WTc[2 * s][3]), pk2(WTc[2 * s + 1][0], WTc[2 * s + 1][1]), pk2(WTc[2 * s + 1][2], WTc[2 * s + 1][3])};
        *(u32x4*)(blob + (1 * 2 + s) * 1024 + lane * 16) = (u32x4){pk2(RqT[2 * s][0], RqT[2 * s][1]), pk2(RqT[2 * s][2], RqT[2 * s][3]), pk2(RqT[2 * s + 1][0], RqT[2 * s + 1][1]), pk2(RqT[2 * s + 1][2], RqT[2 * s + 1][3])}; }
    LAS bf16* BHt = TKt; LAS bf16* KHt = TB;
    {   u32x4 a, c, d, e;
        a = (u32x4){pk2(bh[0], bh[1]), pk2(bh[2], bh[3]), pk2(bh[4], bh[5]), pk2(bh[6], bh[7])}; c = (u32x4){pk2(bh[8], bh[9]), pk2(bh[10], bh[11]), pk2(bh[12], bh[13]), pk2(bh[14], bh[15])};
        d = (u32x4){pk2(kh[0], kh[1]), pk2(kh[2], kh[3]), pk2(kh[4], kh[5]), pk2(kh[6], kh[7])}; e = (u32x4){pk2(kh[8], kh[9]), pk2(kh[10], kh[11]), pk2(kh[12], kh[13]), pk2(kh[14], kh[15])};
        *(LAS u32x4*)(BHt + lane * 16) = a; *(LAS u32x4*)(BHt + lane * 16 + 8) = c; *(LAS u32x4*)(KHt + lane * 16) = d; *(LAS u32x4*)(KHt + lane * 16 + 8) = e; }
    LDS_WAIT(); asm volatile("" ::: "memory");
#pragma unroll
    for (int mt = 0; mt < 4; ++mt) { const int o = (16 * mt + fr) * 16 + 4 * fq; const u32x2 bb = *(const LAS u32x2*)(BHt + o), kk = *(const LAS u32x2*)(KHt + o);
        *(u32x4*)(blob + 4096 + mt * 1024 + lane * 16) = (u32x4){bb.x ^ 0x80008000u, bb.y ^ 0x80008000u, kk.x, kk.y}; }
    LDS_WAIT(); asm volatile("" ::: "memory");
}

__device__ __forceinline__ void pre_phase(const Frame& F0, int seg, int b_lo) {
    const Frame F = phase_frame(F0); unsigned char* const ws = F.ws;
    if ((int)blockIdx.x < b_lo) return;
    const int nwv = (F.G - b_lo) * NWAVES;
    PreRegs R;
    int it = ((int)blockIdx.x - b_lo) * NWAVES + F.wave; if (it >= 32 * SEGCH) return;
    pre_load(R, ws, it & 31, seg * SEGCH + (it >> 5), F.lane);
    for (; it < 32 * SEGCH; it += nwv) { const int nx = it + nwv; const bool hn = nx < 32 * SEGCH;
        pre_item<0>(F, ws, it & 31, seg * SEGCH + (it >> 5), blob_ptr(ws, seg, it & 31, it >> 5), R, hn ? (nx & 31) : -1, seg * SEGCH + (nx >> 5)); }
}

constexpr int SQ_SLOT = 10240, SQ_R = 12, SQ_D = 8;
template <int MODE>
__device__ __forceinline__ void seq_item(const Frame& F0, int item, int seg, bool need_ctx) {
    const Frame F = phase_frame(F0); unsigned char* const ws = F.ws;
    const int scan = item >> 2, vb = item & 3, dir = scan & 1, h = (scan >> 1) & 7, b = scan >> 4; const int lane = F.lane, fr = lane & 15, fq = lane >> 4, w = F.wave;
    const unsigned char* blob = blob_ptr(ws, seg, scan, 0);
    LAS unsigned char* ring = F.lds;
    __syncthreads();
    const int p0 = 2 * (w - 1);
    const unsigned goff0 = (p0 < 8 ? p0 * 1024 : 8192 + vb * 2048 + (p0 - 8) * 1024) + lane * 16, goff1 = (p0 + 1 < 8 ? (p0 + 1) * 1024 : 8192 + vb * 2048 + (p0 + 1 - 8) * 1024) + lane * 16;
#define SQ_ISSUE(c) do { const unsigned char* g_ = blob + (size_t)(c) * BLOB; LAS unsigned char* s_ = ring + ((c) % SQ_R) * SQ_SLOT + p0 * 1024; \
        __builtin_amdgcn_global_load_lds((const unsigned*)(g_ + goff0), (LAS unsigned*)(s_), 16, 0, 0); \
        __builtin_amdgcn_global_load_lds((const unsigned*)(g_ + goff1), (LAS unsigned*)(s_ + 1024), 16, 0, 0); } while (0)
    const bool loader = (w >= 1 && w <= 5) && MODE != 2;
    if (loader) { for (int c = 0; c < SQ_D; ++c) SQ_ISSUE(c); }
    bf16* Y = (bf16*)(ws + WS_Y) + (size_t)dir * NROW * DR + h * 64 + 16 * vb + fr;
    float* st = (float*)(ws + WS_SCANST) + (size_t)item * 1024 + lane * 4;
    f32x4 M[4];
#pragma unroll
    for (int mt = 0; mt < 4; ++mt) M[mt] = (seg == 0 || w != 0) ? (f32x4){0.f, 0.f, 0.f, 0.f} : *(const f32x4*)(st + mt * 256);
    const f32x4 z4 = {0.f, 0.f, 0.f, 0.f};
    LAS unsigned char* mb = ring + SQ_R * SQ_SLOT;
    struct SQ { bf16x8 a1[2], a2[4]; f32x4 pc[4]; u32x2 u0, vv; };
#define SQ_READ(R, c) do { const LAS unsigned char* sl_ = ring + ((c) % SQ_R) * SQ_SLOT; _Pragma("unroll") for (int i = 0; i < 4; ++i) { \
        R.a2[i] = *(const LAS bf16x8*)(sl_ + 4096 + i * 1024 + lane * 16); R.pc[i] = *(const LAS f32x4*)(sl_ + 8192 + 1536 + (16 * i + 4 * fq) * 4); } \
        R.a1[0] = *(const LAS bf16x8*)(sl_ + lane * 16); R.a1[1] = *(const LAS bf16x8*)(sl_ + 1024 + lane * 16); \
        R.u0 = *(const LAS u32x2*)(sl_ + 8192 + lane * 8); R.vv = *(const LAS u32x2*)(sl_ + 8192 + 1024 + lane * 8); } while (0)
#define SQ_STEP(R, c, RN, cn) do { \
        if ((cn) < SEGCH) SQ_READ(RN, cn); \
        const u32x4 t0 = {pk2(M[0][0], M[0][1]), pk2(M[0][2], M[0][3]), pk2(M[1][0], M[1][1]), pk2(M[1][2], M[1][3])}; \
        const u32x4 t1 = {pk2(M[2][0], M[2][1]), pk2(M[2][2], M[2][3]), pk2(M[3][0], M[3][1]), pk2(M[3][2], M[3][3])}; \
        *(LAS u32x4*)(mb + ((c) & 1) * 2048 + lane * 16) = t0; *(LAS u32x4*)(mb + ((c) & 1) * 2048 + 1024 + lane * 16) = t1; \
        const bf16x8 b0 = __builtin_bit_cast(bf16x8, t0), b1 = __builtin_bit_cast(bf16x8, t1); \
        f32x4 X0 = MFMA16(R.a1[0], b0, z4); X0 = MFMA16(R.a1[1], b1, X0); \
        float u0[4]; unpack4(R.u0, u0); \
        const u32x4 tb = {pk2(X0[0] + u0[0], X0[1] + u0[1]), pk2(X0[2] + u0[2], X0[3] + u0[3]), R.vv.x, R.vv.y}; const bf16x8 bB = __builtin_bit_cast(bf16x8, tb); \
        _Pragma("unroll") for (int mt = 0; mt < 4; ++mt) M[mt] = MFMA16(R.a2[mt], bB, R.pc[mt] * M[mt]); \
        asm volatile("s_waitcnt lgkmcnt(0)" ::: "memory"); } while (0)
    const long ystep = dir ? -(long)DR : (long)DR;
#define SQ_YSTEP(c) do { const int cs_ = seg * SEGCH + (c); if (MODE == 0 && (need_ctx || cs_ >= 16)) { const LAS unsigned char* sl_ = ring + ((c) % SQ_R) * SQ_SLOT; \
        const bf16x8 q0 = *(const LAS bf16x8*)(sl_ + 2048 + lane * 16), q1 = *(const LAS bf16x8*)(sl_ + 3072 + lane * 16); \
        const bf16x8 b0 = *(const LAS bf16x8*)(mb + ((c) & 1) * 2048 + lane * 16), b1 = *(const LAS bf16x8*)(mb + ((c) & 1) * 2048 + 1024 + lane * 16); \
        float y0[4]; unpack4(*(const LAS u32x2*)(sl_ + 8192 + 512 + lane * 8), y0); \
        f32x4 X1 = MFMA16(q0, b0, z4); X1 = MFMA16(q1, b1, X1); \
        bf16* yp = Y + (size_t)scan_rowof(16 * cs_ + 4 * fq, dir, b) * DR; \
        yp[0] = (bf16)f2bf(X1[0] + y0[0]); yp[ystep] = (bf16)f2bf(X1[1] + y0[1]); yp[2 * ystep] = (bf16)f2bf(X1[2] + y0[2]); yp[3 * ystep] = (bf16)f2bf(X1[3] + y0[3]); \
        asm volatile("s_waitcnt lgkmcnt(0)" ::: "memory"); } } while (0)
#define SQ_LOADER(c) do { if (loader) { __builtin_amdgcn_s_sleep(3); if ((c) + SQ_D < SEGCH) { SQ_ISSUE((c) + SQ_D); asm volatile("s_waitcnt vmcnt(12)" ::: "memory"); } else asm volatile("s_waitcnt vmcnt(0)" ::: "memory"); } \
        __builtin_amdgcn_s_barrier(); asm volatile("" ::: "memory"); } while (0)
    const bool stw = (w == 0 && MODE != 1), yw = (w == 6 && MODE != 1);
    SQ Ra, Rb, Rc;
    SQ_LOADER(0);
    if (stw) { SQ_READ(Ra, 0); SQ_READ(Rb, 1); }
    for (int c = 0; c < SEGCH; c += 3) {
        SQ_LOADER(c + 1);
        if (stw) SQ_STEP(Ra, c, Rc, c + 2);
        if (yw && c > 0) SQ_YSTEP(c - 1);
        SQ_LOADER(c + 2);
        if (stw) SQ_STEP(Rb, c + 1, Ra, c + 3);
        if (yw) SQ_YSTEP(c);
        SQ_LOADER(c + 3);
        if (stw) SQ_STEP(Rc, c + 2, Rb, c + 4);
        if (yw) SQ_YSTEP(c + 1);
    }
    __builtin_amdgcn_s_barrier(); asm volatile("" ::: "memory");
    if (yw) SQ_YSTEP(SEGCH - 1);
#undef SQ_READ
#undef SQ_STEP
#undef SQ_YSTEP
#undef SQ_LOADER
#undef SQ_ISSUE
    if (MODE >= 2 && w == 0 && M[0][0] + M[1][1] + M[2][2] + M[3][3] == 12345.678f) st[0] = M[0][0];
    if (MODE == 0 && w == 0 && seg + 1 < NSEG) {
#pragma unroll
        for (int mt = 0; mt < 4; ++mt) *(f32x4*)(st + mt * 256) = M[mt]; }
    __syncthreads();
}

namespace pg8 {
struct EpiStoreBf16 {
    static constexpr bool PERM = true, AFTER_DRAIN = false;
    bf16_t* O; int ldc; int pn_mask;
    __device__ __forceinline__ void operator()(const f32x4 (&acc)[2][2][4][2], const Unit& u, int wr, int wc, int fr, int fq) const {
        const int row0 = u.pm * BM + wr * 64 + fr; const int col0 = (u.pn & pn_mask) * BM + wc * 32 + 8 * fq;
#pragma unroll
        for (int ai = 0; ai < 2; ++ai)
#pragma unroll
            for (int m = 0; m < 4; ++m) { bf16_t* rowp = O + (size_t)(row0 + ai * HALF + m * 16) * ldc + col0;
#pragma unroll
                for (int bj = 0; bj < 2; ++bj) { const f32x4 v0 = acc[ai][bj][m][0], v1 = acc[ai][bj][m][1];
                    u32x4 w; w.x = cvt_pk_bf16(v0[0], v0[1]); w.y = cvt_pk_bf16(v0[2], v0[3]); w.z = cvt_pk_bf16(v1[0], v1[1]); w.w = cvt_pk_bf16(v1[2], v1[3]);
                    *(u32x4*)(rowp + bj * HALF) = w; } }
    }
};
struct EpiSwiGLU {
    static constexpr bool PERM = true, AFTER_DRAIN = false;
    bf16_t* O;
    __device__ __forceinline__ void operator()(const f32x4 (&acc)[2][2][4][2], const Unit& u, int wr, int wc, int fr, int fq) const {
        const int row0 = u.pm * BM + wr * 64 + fr; const int col0 = ((u.pn & 3) * BM + wc * 32 + 8 * fq) >> 1;
#pragma unroll
        for (int ai = 0; ai < 2; ++ai)
#pragma unroll
            for (int m = 0; m < 4; ++m) { bf16_t* rowp = O + (size_t)(row0 + ai * HALF + m * 16) * 512 + col0;
#pragma unroll
                for (int bj = 0; bj < 2; ++bj) { const f32x4 g = acc[ai][bj][m][0], up = acc[ai][bj][m][1]; float a[4];
#pragma unroll
                    for (int i = 0; i < 4; ++i) a[i] = g[i] / (1.f + __expf(-g[i])) * up[i];
                    unsigned long long w = (unsigned long long)cvt_pk_bf16(a[0], a[1]) | ((unsigned long long)cvt_pk_bf16(a[2], a[3]) << 32);
                    *(unsigned long long*)(rowp + bj * (HALF / 2)) = w; } }
    }
};
struct EpiResidual {
    static constexpr bool PERM = false, AFTER_DRAIN = false;
    const float* xlat; const float* xctx;
    float* out; const float* g1;
    __device__ __forceinline__ void operator()(const f32x4 (&acc)[2][2][4][2], const Unit& u, int wr, int wc, int fr, int fq) const {
        const int rowt = u.pm * BM; const int mr = rowt < 16384 ? (rowt >> 13) : 2;
        const float* base = rowt < 16384 ? xlat + (size_t)rowt * 1024 : xctx + (size_t)(rowt - 16384) * 1024;
        const int col0 = u.pn * BM + wc * 32 + 4 * fq;
        f32x4 gv[2][2];
#pragma unroll
        for (int bj = 0; bj < 2; ++bj)
#pragma unroll
            for (int n = 0; n < 2; ++n) gv[bj][n] = *(const f32x4*)(g1 + (size_t)mr * 6144 + col0 + bj * HALF + n * 16);
#pragma unroll
        for (int ai = 0; ai < 2; ++ai)
#pragma unroll
            for (int m = 0; m < 4; ++m) { const int rl = ai * HALF + wr * 64 + m * 16 + fr;
#pragma unroll
                for (int bj = 0; bj < 2; ++bj)
#pragma unroll
                    for (int n = 0; n < 2; ++n) { const size_t off = (size_t)rl * 1024 + col0 + bj * HALF + n * 16;
                        const f32x4 xo = *(const f32x4*)(base + off);
                        *(f32x4*)(out + (size_t)rowt * 1024 + off) = xo + gv[bj][n] * acc[ai][bj][m][n]; } }
    }
};
struct MoeOrder {
    const int* tile_e; int ntiles, G, c;
    __device__ bool next(int i, Unit& u) const { const long L = (long)i * G + c; if (L >= 4L * ntiles) return false; const int pm = (int)(L >> 2); u.pm = pm; u.pn = tile_e[pm] * 4 + (int)(L & 3); return true; }
    __device__ __forceinline__ void a_ready(const Unit&) const {}
    __device__ __forceinline__ void done(const Unit&) const {}
};
}

__device__ __forceinline__ void expert_convert(const Frame& F0, int l, int b_lo) {
    const Frame F = phase_frame(F0); unsigned char* const ws = F.ws;
    if ((int)blockIdx.x < b_lo) return;
    const int nwv = (F.G - b_lo) * NWAVES, myw = ((int)blockIdx.x - b_lo) * NWAVES + F.wave;
    LAS float* scr = (LAS float*)(F.lds + F.wave * 16384);
    bf16* wgu = (bf16*)(ws + WS_WGU_T); bf16* wd = (bf16*)(ws + WS_WD_T);
    constexpr int I_G = 16 * 16, I_D = 8 * 32;
    constexpr int NIT = NEXP * (2 * I_G + I_D);
    const float* p_eg = inptr(I_EG); const float* p_eu = inptr(I_EU); const float* p_ed = inptr(I_ED);
    for (int it = myw; it < NIT; it += nwv) { const int e = it / (2 * I_G + I_D); int r = it % (2 * I_G + I_D);
        if (r < I_G) { transpose_item(p_eg + ((size_t)l * NEXP + e) * D * DEXP, DEXP, (r >> 4) * 64, (r & 15) * 32, wgu, D, RmGU{e * 1024}, scr, F.lane); continue; } r -= I_G;
        if (r < I_G) { transpose_item(p_eu + ((size_t)l * NEXP + e) * D * DEXP, DEXP, (r >> 4) * 64, (r & 15) * 32, wgu, D, RmGU{e * 1024 + 4}, scr, F.lane); continue; } r -= I_G;
        transpose_item(p_ed + ((size_t)l * NEXP + e) * DEXP * D, D, (r >> 5) * 64, (r & 31) * 32, wd, DEXP, RmId{e * 1024}, scr, F.lane);
    }
}

__device__ __forceinline__ void router_pass(const Frame& F0, int l, int nrows, int cnt_off = 0) {
    const Frame F = phase_frame(F0); unsigned char* const ws = F.ws;
    constexpr int HP = 1028;
    LAS float* msh = (LAS float*)F.lds; LAS float* msc = msh + 3072; LAS float* hrow = msc + 3072;
    LAS float* part = hrow + 16 * HP;
    LAS float* lgs = part + 8 * 16 * 48;
    LAS unsigned* lcnt = (LAS unsigned*)(lgs + 16 * 40);
    if (F0.tid < 64) lcnt[F0.tid] = 0u;
    __syncthreads();
    mod_to_lds(F, l, 3, msh, false); mod_to_lds(F, l, 4, msc, false); __syncthreads();
    const float* X = (const float*)(ws + WS_X); bf16* H = (bf16*)(ws + WS_H);
    const float* rgw = inptr(I_RGW) + (size_t)l * D * 4; const float* rew = inptr(I_REW) + (size_t)l * D * NEXP;
    const float* rgb = inptr(I_RGB) + l * 4; const float* reb = inptr(I_REB) + l * NEXP;
    int* rt_e = (int*)(ws + WS_ROUTE + RT_E); int* rt_pos = (int*)(ws + WS_ROUTE + RT_POS); float* rt_gate = (float*)(ws + WS_ROUTE + RT_GATE);
    unsigned* cnt = (unsigned*)(ws + WS_CTL) + CW_CNT + 64 * l + cnt_off;
    const int lane = F.lane, w = F.wave, fr = lane & 15, fq = lane >> 4; const float* n2g = inptr(I_N2G) + l * D;
    float bw[32][3];
#pragma unroll
    for (int ks = 0; ks < 32; ++ks) { const int k = 128 * w + 4 * ks + fq;
        bw[ks][0] = rew[(size_t)k * 32 + fr]; bw[ks][1] = rew[(size_t)k * 32 + 16 + fr]; bw[ks][2] = fr < 4 ? rgw[(size_t)k * 4 + fr] : 0.f; }
    const int ntiles = nrows >> 4;
    f32x4 pv[2][4];
    if (F.vcu < ntiles) {
#pragma unroll
        for (int rr = 0; rr < 2; ++rr)
#pragma unroll
            for (int j = 0; j < 4; ++j) pv[rr][j] = *(const f32x4*)(X + (size_t)(F.vcu * 16 + 2 * w + rr) * D + 4 * lane + 256 * j); }
    for (int gi = F.vcu; gi < ntiles; gi += F.G) {
#pragma unroll
        for (int rr = 0; rr < 2; ++rr) { const int r = 2 * w + rr, row = gi * 16 + r; f32x4 v[4];
#pragma unroll
            for (int j = 0; j < 4; ++j) v[j] = pv[rr][j];
            const int mr = modrow(row);
            norm_mod_row(v, n2g, msc + mr * 1024, msh + mr * 1024, H + (size_t)row * D, lane);
#pragma unroll
            for (int j = 0; j < 4; ++j) *(LAS f32x4*)(hrow + r * HP + 4 * lane + 256 * j) = v[j]; }
        if (gi + F.G < ntiles) {
#pragma unroll
            for (int rr = 0; rr < 2; ++rr)
#pragma unroll
                for (int j = 0; j < 4; ++j) pv[rr][j] = *(const f32x4*)(X + (size_t)((gi + F.G) * 16 + 2 * w + rr) * D + 4 * lane + 256 * j); }
        __syncthreads();
        {   f32x4 acc[3] = {{0.f, 0.f, 0.f, 0.f}, {0.f, 0.f, 0.f, 0.f}, {0.f, 0.f, 0.f, 0.f}};
#pragma unroll
            for (int ks = 0; ks < 32; ++ks) { const float a = hrow[fr * HP + 128 * w + 4 * ks + fq];
#pragma unroll
                for (int nt = 0; nt < 3; ++nt) acc[nt] = __builtin_amdgcn_mfma_f32_16x16x4f32(a, bw[ks][nt], acc[nt], 0, 0, 0); }
#pragma unroll
            for (int nt = 0; nt < 3; ++nt)
#pragma unroll
                for (int reg = 0; reg < 4; ++reg) part[(w * 16 + 4 * fq + reg) * 48 + 16 * nt + fr] = acc[nt][reg]; }
        __syncthreads();
        for (int idx = F.tid; idx < 16 * 36; idx += NTHR) { const int r = idx / 36, n = idx % 36; float s_ = 0.f;
#pragma unroll
            for (int ww = 0; ww < 8; ++ww) s_ += part[(ww * 16 + r) * 48 + n];
            if (n < 32) lgs[r * 40 + 4 + n] = s_ + reb[n]; else lgs[r * 40 + n - 32] = s_ + rgb[n - 32]; }
        __syncthreads();
        if (F.tid < 16) { const int rr = gi * 16 + F.tid; const LAS float* lp = lgs + F.tid * 40;
            int grp = 0; float mx = lp[0];
#pragma unroll
            for (int g = 1; g < 4; ++g) if (lp[g] > mx) { mx = lp[g]; grp = g; }
            float den = 0.f;
#pragma unroll
            for (int g = 0; g < 4; ++g) den += __expf(lp[g] - mx);
            const float pg_top = 1.f / den; const LAS float* sel = lp + 4 + grp * 8;
            int i0 = 0; float l0 = sel[0];
#pragma unroll
            for (int q = 1; q < 8; ++q) if (sel[q] > l0) { l0 = sel[q]; i0 = q; }
            int i1 = -1; float l1 = -3.0e38f;
#pragma unroll
            for (int q = 0; q < 8; ++q) if (q != i0 && sel[q] > l1) { l1 = sel[q]; i1 = q; }
            const float e1 = __expf(l1 - l0); const float w0 = pg_top / (1.f + e1), w1 = pg_top * e1 / (1.f + e1);
            const int ea = grp * 8 + i0, eb = grp * 8 + i1;
            const unsigned pa = atomicAdd((unsigned*)(lcnt + ea), 1u), pb = atomicAdd((unsigned*)(lcnt + eb), 1u);
            rt_e[2 * rr] = ea; rt_e[2 * rr + 1] = eb; rt_pos[2 * rr] = (int)pa; rt_pos[2 * rr + 1] = (int)pb; rt_gate[2 * rr] = w0; rt_gate[2 * rr + 1] = w1; }
    }
    __syncthreads();
    if (F.tid < 32) lcnt[32 + F.tid] = lcnt[F.tid] ? atomicAdd(cnt + F.tid, lcnt[F.tid]) : 0u;
    __syncthreads();
    if (F.tid < 16) for (int gi = F.vcu; gi < ntiles; gi += F.G) { const int rr = gi * 16 + F.tid;
        rt_pos[2 * rr] += (int)lcnt[32 + rt_e[2 * rr]]; rt_pos[2 * rr + 1] += (int)lcnt[32 + rt_e[2 * rr + 1]]; }
}

__device__ __forceinline__ void gather_pass(const Frame& F0, int l, int nrows) {
    const Frame F = phase_frame(F0); unsigned char* const ws = F.ws;
    LAS int* off = (LAS int*)F.lds;
    const unsigned* cnt = (const unsigned*)(ws + WS_CTL) + CW_CNT + 64 * l;
    int* tile_e = (int*)(ws + WS_ROUTE + RT_TILE); int* ntl = (int*)(ws + WS_ROUTE + RT_NT);
    __syncthreads();
    if (F.tid < NEXP) off[32 + F.tid] = (int)__hip_atomic_load(cnt + F.tid, __ATOMIC_RELAXED, __HIP_MEMORY_SCOPE_AGENT);
    __syncthreads();
    if (F.tid == 0) { int o = 0;
#pragma nounroll
        for (int e = 0; e < NEXP; ++e) { const int c = off[32 + e]; const int nt = (c + 255) >> 8; off[e] = o;
            if (blockIdx.x == 0) {
#pragma nounroll
                for (int t = 0; t < nt; ++t) tile_e[(o >> 8) + t] = e; }
            o += nt << 8; }
        if (blockIdx.x == 0) ntl[0] = o >> 8; }
    __syncthreads();
    const int* rt_e = (const int*)(ws + WS_ROUTE + RT_E); const int* rt_pos = (const int*)(ws + WS_ROUTE + RT_POS); int* rt_slot = (int*)(ws + WS_ROUTE + RT_SLOT);
    const bf16* H = (const bf16*)(ws + WS_H); bf16* Xs = (bf16*)(ws + WS_XS);
    for (int it0 = F.gw * 4; it0 < 2 * nrows; it0 += F.NGW * 4) { int slot[4]; u32x4 a[4], b2[4];
#pragma unroll
        for (int u = 0; u < 4; ++u) { const int it = it0 + u; slot[u] = it < 2 * nrows ? off[rt_e[it]] + rt_pos[it] : -1; }
#pragma unroll
        for (int u = 0; u < 4; ++u) if (slot[u] >= 0) { const u32x4* s = (const u32x4*)(H + (size_t)((it0 + u) >> 1) * D); a[u] = s[F.lane]; b2[u] = s[64 + F.lane]; }
#pragma unroll
        for (int u = 0; u < 4; ++u) if (slot[u] >= 0) { if (F.lane == 0) rt_slot[it0 + u] = slot[u]; u32x4* d = (u32x4*)(Xs + (size_t)slot[u] * D); d[F.lane] = a[u]; d[64 + F.lane] = b2[u]; }
    }
}

template <bool DRY>
__device__ __forceinline__ void combine_pass(const Frame& F0, int l, int nrows) {
    const Frame F = phase_frame(F0); unsigned char* const ws = F.ws;
    LAS float* mg2 = (LAS float*)F.lds; LAS float* msh = mg2 + 3072; LAS float* msc = msh + 3072;
    const bool last = (l == DEPTH - 1);
    __syncthreads();
    mod_to_lds(F, l, 5, mg2, false); if (!last) { mod_to_lds(F, l + 1, 0, msh, false); mod_to_lds(F, l + 1, 1, msc, false); }
    __syncthreads();
    float* X = (float*)(ws + WS_X); bf16* H = (bf16*)(ws + WS_H); const bf16* Ys = (const bf16*)(ws + WS_XS);
    const int* rt_slot = (const int*)(ws + WS_ROUTE + RT_SLOT); const float* rt_gate = (const float*)(ws + WS_ROUTE + RT_GATE);
    const int lane = F.lane; const float* n1g = inptr(I_N1G) + (last ? 0 : (l + 1) * D); const float* fgp = inptr(I_FG);
    for (int row0 = F.gw; row0 < nrows; row0 += 2 * F.NGW) {
        int s0[2], s1[2]; float w0[2], w1[2]; bool ok[2]; u32x2 ya[2][4], yb[2][4]; f32x4 xo[2][4];
#pragma unroll
        for (int u = 0; u < 2; ++u) { const int row = row0 + u * F.NGW; ok[u] = row < nrows; if (ok[u]) { s0[u] = rt_slot[2 * row]; s1[u] = rt_slot[2 * row + 1]; w0[u] = rt_gate[2 * row]; w1[u] = rt_gate[2 * row + 1]; } }
#pragma unroll
        for (int u = 0; u < 2; ++u) if (ok[u]) { const int row = row0 + u * F.NGW;
#pragma unroll
            for (int j = 0; j < 4; ++j) { const int c = 4 * lane + 256 * j; ya[u][j] = *(const u32x2*)(Ys + (size_t)s0[u] * D + c); yb[u][j] = *(const u32x2*)(Ys + (size_t)s1[u] * D + c); xo[u][j] = *(const f32x4*)(X + (size_t)row * D + c); } }
#pragma unroll
        for (int u = 0; u < 2; ++u) if (ok[u]) { const int row = row0 + u * F.NGW; const int mr = modrow(row); f32x4 v[4];
#pragma unroll
            for (int j = 0; j < 4; ++j) { const int c = 4 * lane + 256 * j; float a[4], b[4]; unpack4(ya[u][j], a); unpack4(yb[u][j], b);
                const f32x4 g2 = *(const LAS f32x4*)(mg2 + mr * 1024 + c);
                f32x4 y; y.x = w0[u] * a[0] + w1[u] * b[0]; y.y = w0[u] * a[1] + w1[u] * b[1]; y.z = w0[u] * a[2] + w1[u] * b[2]; y.w = w0[u] * a[3] + w1[u] * b[3];
                v[j] = xo[u][j] + g2 * y; }
            if (DRY) { asm volatile("" :: "v"(v[0].x + v[1].y + v[2].z + v[3].w)); }
            else if (!last) {
#pragma unroll
                for (int j = 0; j < 4; ++j) *(f32x4*)(X + (size_t)row * D + 4 * lane + 256 * j) = v[j];
                norm_mod_row(v, n1g, msc + mr * 1024, msh + mr * 1024, H + (size_t)row * D, lane);
            } else { float s = 0.f;
#pragma unroll
                for (int j = 0; j < 4; ++j) s += (v[j].x * v[j].x + v[j].y * v[j].y) + (v[j].z * v[j].z + v[j].w * v[j].w);
                const float rs = rsqrtf(wave_sum(s) * (1.f / D) + RMS_EPS);
#pragma unroll
                for (int j = 0; j < 4; ++j) { const int c = 4 * lane + 256 * j; const f32x4 g = *(const f32x4*)(fgp + c); *(f32x4*)(F.out + (size_t)row * D + c) = v[j] * rs * g; } } }
    }
}
__global__ void __launch_bounds__(NTHR, 2) fwd_megakernel(Params prm) {
    extern __shared__ __attribute__((aligned(16))) unsigned char lds_raw[];
    Frame F;
    F.lds = (LAS unsigned char*)lds_raw;
    F.tid = threadIdx.x; F.lane = F.tid & 63; F.wave = __builtin_amdgcn_readfirstlane(F.tid >> 6);
    F.G = gridDim.x; { const int bx = blockIdx.x; F.vcu = (F.G % 8 == 0) ? (bx % 8) * (F.G / 8) + bx / 8 : bx; }
    F.gw = F.vcu * NWAVES + F.wave; F.NGW = F.G * NWAVES;
    F.out = prm.out; F.ws = prm.ws;
    for (int u = F.tid; u < (LDS_BYTES - LDSCTL_OFF) / 4; u += NTHR) ((LAS unsigned*)(F.lds + LDSCTL_OFF))[u] = 0u;
    __syncthreads();
    (void)xcd_barrier_post((unsigned*)(F.ws + WS_CTL) + CW_BAR, (volatile LAS unsigned*)(F.lds + MISC_OFF) + 8);
#define GRID_BAR() do { XcdBarrier bar_; bar_.bar = (unsigned*)(opaque(F.ws) + WS_CTL) + CW_BAR; bar_.x = xb_xcc_id(); bar_.st = (volatile LAS unsigned*)(F.lds + MISC_OFF) + 8; xcd_barrier(bar_); } while (0)

    p0_prologue(F);
#if USE_CG_SYNC
    cg::this_grid().sync();
#else
    GRID_BAR();
#endif
    p0b_norm1(F);
    GRID_BAR();

    for (int l = 0; l < DEPTH; ++l) {
        const bool need_ctx = (l == 0); const int nrows = need_ctx ? NROW : NLAT;
#define WSO Fp.ws
        {
            const Frame Fp = phase_frame(F); unsigned char* const ws = WSO; bf16* Hb = (bf16*)(ws + WS_H); bf16* Pb = (bf16*)(ws + WS_P);
            pg8::Gemm g{Hb, (const bf16*)(ws + WS_WIN_T) + (size_t)l * NP * D, NROW, NP, D}; pg8::StaticOrder S; S.init(NROW, NP, Fp.G, (int)blockIdx.x);
            pg8::EpiStoreBf16 E{Pb, NP, 0xffff};
            pg8::gemm_phase<pg8::EpiStoreBf16, pg8::StaticOrder, true, true>(F.lds, g, S, E);
        }
        GRID_BAR();
        {
            const Frame Fp = phase_frame(F); unsigned char* const ws = WSO; bf16* Pb = (bf16*)(ws + WS_P);
            for (int it = blockIdx.x; it < 256; it += F.G) fftA_item(F, it);
            if (need_ctx) for (int it = blockIdx.x; it < 8; it += F.G) { const int b = it >> 2, m0 = (it & 3) * 64;
                const bf16* src0 = Pb + (size_t)(NLAT + b * CTXL) * NP + COL_FC;
                dft64_item<4, 256>(F, l, m0, -1.f, 1.f / 128.f, [=](int t, int ri) { return src0 + (size_t)t * NP + ri * 256; }, [=](int m) { return NLAT + b * CTXL + m; }); }
            shift_pass(F, l);
            conv_pass(F, l, nrows);
        }
        GRID_BAR();
        {
            const Frame Fp = phase_frame(F); unsigned char* const ws = WSO;
            prep_phase(F, l);
        }
        GRID_BAR();
        for (int seg = -1; seg < NSEG; ++seg) {
            const bool split = (F.G == 256);
            if (seg + 1 < NSEG) pre_phase(F, seg + 1, (seg >= 0 && split) ? 128 : 0);
            if (seg + 1 == NSEG && (!split || blockIdx.x >= 128)) { unsigned char* const ws = opaque(F.ws); int bx_ = (int)blockIdx.x; asm volatile("" : "+s"(bx_));
                const int first_ = split ? bx_ - 128 : bx_, stride_ = split ? 128 : F.G;
                for (int it = first_; it < 256; it += stride_) { const int b = it >> 7, t1p = it & 127;
                    const bf16* src0 = (const bf16*)(ws + WS_GT) + (size_t)(b * 128 + t1p) * 64 * 512;
                    dft64_item<1, 64>(F, l, 0, 1.f, 0.0013810679320049757f, [=](int t, int ri) { return src0 + (size_t)t * 512 + ri * 256; }, [=](int m) { return b * SEQ + t1p + 128 * m; }); } }
            if (seg >= 0) for (int it = blockIdx.x; it < 128; it += F.G) { const int x_ = it & 7, j_ = it >> 3;
                seq_item<0>(F, ((x_ + 8 * (j_ >> 2)) << 2) | (j_ & 3), seg, need_ctx); }
            GRID_BAR();
        }
        readout_pass(F, l, nrows);
        GRID_BAR();
        const int cv_lo = (nrows / 256) * 4 > F.G ? (nrows / 256) * 4 - F.G : 0;
        if (blockIdx.x & 1) expert_convert(F, l, cv_lo);
        {
            const Frame Fp = phase_frame(F); unsigned char* const ws = WSO; bf16* Hb = (bf16*)(ws + WS_H);
            pg8::Gemm g{Hb, (const bf16*)(ws + WS_WOUT_T) + (size_t)l * D * D, nrows, D, D}; pg8::StaticOrder S; S.init(nrows, D, Fp.G, (int)blockIdx.x);
            const float* X = (const float*)(ws + WS_X);
            pg8::EpiResidual E{l == 0 ? inptr(I_X) : X, l == 0 ? inptr(I_CTX) : X + (size_t)NLAT * D, (float*)(ws + WS_X), (const float*)(ws + WS_MODF) + (size_t)l * 3 * 6144 + 2 * 1024};
            pg8::gemm_phase<pg8::EpiResidual, pg8::StaticOrder, true, true>(F.lds, g, S, E);
        }
        if (!(blockIdx.x & 1)) expert_convert(F, l, cv_lo);
        GRID_BAR();
        router_pass(F, l, nrows);
        GRID_BAR();
        gather_pass(F, l, nrows);
        GRID_BAR();
        {
            const Frame Fp = phase_frame(F); unsigned char* const ws = WSO;
            const int* tile_e = (const int*)(ws + WS_ROUTE + RT_TILE); const int ntiles = *(const int*)(ws + WS_ROUTE + RT_NT);
            pg8::MoeOrder S{tile_e, ntiles, Fp.G, (int)blockIdx.x};
            {   pg8::Gemm g{(const bf16*)(ws + WS_XS), (const bf16*)(ws + WS_WGU_T), 0, 0, D};
                pg8::EpiSwiGLU E{(bf16*)(ws + WS_ACT)};
                pg8::gemm_phase<pg8::EpiSwiGLU, pg8::MoeOrder, true, true>(F.lds, g, S, E); }
            GRID_BAR();
            {   pg8::Gemm g{(const bf16*)(ws + WS_ACT), (const bf16*)(ws + WS_WD_T), 0, 0, DEXP};
                pg8::EpiStoreBf16 E{(bf16*)(ws + WS_XS), D, 3};
                pg8::gemm_phase<pg8::EpiStoreBf16, pg8::MoeOrder, true, true>(F.lds, g, S, E); }
        }
        GRID_BAR();
        combine_pass<false>(F, l, nrows);
        if (l + 1 < DEPTH) GRID_BAR();
    }
}

extern "C" void kernel_launch(void* const* d_in, const int* in_sizes, int n_in, void* d_out, int out_size, void* d_ws, size_t ws_size, hipStream_t stream) {
    static int grid = 0;
    if (grid == 0) {
        if (n_in != N_IN || in_sizes[0] != NLAT * D || out_size != NLAT * D || ws_size < WS_END) {
            fprintf(stderr, "kernel_launch: unexpected shapes (n_in %d in0 %d out %d ws %zu)\n", n_in, n_in > 0 ? in_sizes[0] : -1, out_size, ws_size); grid = -1; return; }
        int dev = 0, cus = 0, per_cu = 0;
        hipGetDevice(&dev); hipDeviceGetAttribute(&cus, hipDeviceAttributeMultiprocessorCount, dev);
        hipFuncSetAttribute((const void*)fwd_megakernel, hipFuncAttributeMaxDynamicSharedMemorySize, LDS_BYTES);
        hipOccupancyMaxActiveBlocksPerMultiprocessor(&per_cu, (const void*)fwd_megakernel, NTHR, LDS_BYTES);
        if (per_cu < 1) { fprintf(stderr, "kernel_launch: occupancy query says %d blocks per CU\n", per_cu); per_cu = 1; }
        (void)hipGetLastError();
        grid = cus * per_cu;
    }
    if (grid < 0) return;
    hipMemsetAsync((char*)d_ws + WS_CTL, 0, CTL_ZERO_BYTES, stream);
    Params p{};
    for (int i = 0; i < N_IN; ++i) p.in[i] = (const float*)d_in[i];
    p.out = (float*)d_out; p.ws = (unsigned char*)d_ws;
    void* args[] = {&p};
    hipError_t e = hipLaunchCooperativeKernel((const void*)fwd_megakernel, dim3(grid), dim3(NTHR), args, LDS_BYTES, stream);
    if (e != hipSuccess) fprintf(stderr, "kernel_launch: cooperative launch failed: %s (grid %d)\n", hipGetErrorString(e), grid);
}
```

```cpp
#include <hip/hip_runtime.h>
#include <hip/hip_cooperative_groups.h>
#include <cstdio>
#include <cstdint>
namespace cg = cooperative_groups;
#define USE_CG_SYNC 0
#define SEQ_PROBE 0
#define SEQ_PROBE_PRE 0
namespace pg8 {
#define PG8_LAS __attribute__((address_space(3)))
typedef unsigned short bf16_t;
typedef short bf16x8 __attribute__((ext_vector_type(8)));
typedef float f32x4 __attribute__((ext_vector_type(4)));
typedef unsigned u32x4 __attribute__((ext_vector_type(4)));
constexpr int BM = 256, BK = 64, HALF = 128, HTB = HALF * BK * 2  , STAGE_BYTES = 8 * HTB, NXCD = 8, WGM = 8;

__host__ __device__ __forceinline__ int lds_byte(int r, int c) { const int st = (r >> 4) * 2 + (c >> 5), rr = r & 15, cc = c & 31, ob = rr * 64 + cc * 2; return st * 1024 + (ob ^ (((ob >> 9) & 1) << 5)); }
__host__ __device__ __forceinline__ void stage_rc(int b, int& R, int& C) { const int st = b / 1024, sb = b % 1024, swz = sb ^ (((sb >> 9) & 1) << 5); R = (st >> 1) * 16 + swz / 64; C = (st & 1) * 32 + (swz % 64) / 2; }
__host__ __device__ __forceinline__ int perm32(int rho) { const int n = rho >> 4, i = rho & 15; return 8 * (i >> 2) + 4 * n + (i & 3); }

struct Unit { int pm, pn; };
struct Gemm { const bf16_t* A; const bf16_t* Bt; int M, N, K; };

struct StaticOrder {
    int nM, nN, nwg, G, c;
    __host__ __device__ void init(int M, int N, int G_, int c_) { nM = M / BM; nN = N / BM; nwg = nM * nN; G = G_; c = c_; }
    __host__ __device__ bool next(int i, Unit& u) const {
        const long L = (long)i * G + c; if (L >= nwg) return false;
        int wgid = (int)L; { const int q = nwg / NXCD, r = nwg % NXCD, xcd = wgid % NXCD, off = wgid / NXCD; wgid = (xcd < r ? xcd * (q + 1) : r * (q + 1) + (xcd - r) * q) + off; }
        const int nig = WGM * nN, gid = wgid / nig, fm = gid * WGM, gsz = (nM - fm) < WGM ? (nM - fm) : WGM;
        u.pm = fm + ((wgid % nig) % gsz); u.pn = (wgid % nig) / gsz; return true;
    }
    __device__ __forceinline__ void a_ready(const Unit&) const {}
    __device__ __forceinline__ void done(const Unit&) const {}
};

__device__ __forceinline__ unsigned cvt_pk_bf16(float lo, float hi) { unsigned r; asm volatile("v_cvt_pk_bf16_f32 %0, %1, %2" : "=v"(r) : "v"(lo), "v"(hi)); return r; }
typedef float f32x2 __attribute__((ext_vector_type(2)));
template <class Epi, class Sched, bool ALIGN_EPI = false, bool SP2 = false>
__device__ __forceinline__ void gemm_phase(PG8_LAS unsigned char* lds, const Gemm g, const Sched& S, const Epi& E) {
    int tid = threadIdx.x; asm volatile("" : "+v"(tid));
    const int wid = __builtin_amdgcn_readfirstlane(tid >> 6), lane = tid & 63, wr = wid >> 2, wc = wid & 3, fr = lane & 15, fq = lane >> 4;
    const int K = g.K, nt = K / BK;
    unsigned voffA[2], voffB[2];
#pragma unroll
    for (int i = 0; i < 2; ++i) { int R, C; stage_rc(tid * 16 + i * 8192, R, C); const int Rb = Epi::PERM ? ((R & ~31) + perm32(R & 31)) : R;
        voffA[i] = (unsigned)(R * K + C) * 2u; voffB[i] = (unsigned)(Rb * K + C) * 2u; }
    const size_t kstep = (size_t)(BK * 2);
    const size_t hstep = (size_t)HALF * K * 2;
    const size_t tstep = 2 * hstep;
    const unsigned ldsw = (unsigned)wid * 1024u;
    const int aoff = lds_byte(wr * 64 + fr, fq * 8), boff = lds_byte(wc * 32 + fr, fq * 8);
#define PG8_SA(b, h) (((b) * 2 + (h)) * HTB)
#define PG8_SB(b, h) ((4 + (b) * 2 + (h)) * HTB)
#define PG8_STAGE(bufoff, gbase, voff) do { _Pragma("unroll") for (int _i = 0; _i < 2; ++_i) \
        __builtin_amdgcn_global_load_lds((const unsigned*)((const char*)(gbase) + (voff)[_i]), (PG8_LAS unsigned*)(lds + (bufoff) + ldsw + _i * 8192), 16, 0, 0); } while (0)
#define PG8_LDA(dst, b, h) do { _Pragma("unroll") for (int m = 0; m < 4; ++m) _Pragma("unroll") for (int k = 0; k < 2; ++k) dst[m][k] = *(const PG8_LAS bf16x8*)(lds + PG8_SA(b, h) + aoff + m * 2048 + k * 1024); } while (0)
#define PG8_LDB(dst, b, h) do { _Pragma("unroll") for (int n = 0; n < 2; ++n) _Pragma("unroll") for (int k = 0; k < 2; ++k) dst[n][k] = *(const PG8_LAS bf16x8*)(lds + PG8_SB(b, h) + boff + n * 2048 + k * 1024); } while (0)
#define PG8_MMA(ai, bj, At, Bt) do { __builtin_amdgcn_s_setprio(1); _Pragma("unroll") for (int m = 0; m < 4; ++m) _Pragma("unroll") for (int n = 0; n < 2; ++n) _Pragma("unroll") for (int k = 0; k < 2; ++k) \
        acc[ai][bj][m][n] = __builtin_amdgcn_mfma_f32_16x16x32_bf16(Bt[n][k], At[m][k], acc[ai][bj][m][n], 0, 0, 0); __builtin_amdgcn_s_setprio(0); } while (0)
#define PG8_WAIT_V(n) asm volatile("s_waitcnt vmcnt(" #n ")" ::: "memory")
#define PG8_WAIT_L(n) asm volatile("s_waitcnt lgkmcnt(" #n ")" ::: "memory")
#define PG8_BAR __builtin_amdgcn_s_barrier()
#define PG8_SCHED __builtin_amdgcn_sched_barrier(0)
    Unit cur, nxt; int ui = 0;
    if (!S.next(0, cur)) return;
    f32x4 acc[2][2][4][2];
#pragma unroll
    for (int a = 0; a < 2; ++a)
#pragma unroll
        for (int b = 0; b < 2; ++b)
#pragma unroll
            for (int m = 0; m < 4; ++m)
#pragma unroll
                for (int n = 0; n < 2; ++n) acc[a][b][m][n] = (f32x4){0.f, 0.f, 0.f, 0.f};
    bf16x8 At[4][2], B0[2][2], B1[2][2];
    const char* cA = (const char*)g.A + (size_t)cur.pm * tstep; const char* cB = (const char*)g.Bt + (size_t)cur.pn * tstep;
    S.a_ready(cur);
    if constexpr (SP2) {
        PG8_STAGE(PG8_SB(0, 0), cB, voffB); PG8_STAGE(PG8_SB(0, 1), cB + hstep, voffB); PG8_STAGE(PG8_SA(0, 0), cA, voffA); PG8_STAGE(PG8_SA(0, 1), cA + hstep, voffA);
        if (wr == 1) PG8_BAR;
        PG8_WAIT_V(2); PG8_BAR;
        PG8_STAGE(PG8_SB(1, 0), cB + kstep, voffB); PG8_STAGE(PG8_SA(1, 0), cA + kstep, voffA); PG8_STAGE(PG8_SB(1, 1), cB + hstep + kstep, voffB);
        PG8_WAIT_V(6); PG8_BAR;
    } else {
        PG8_STAGE(PG8_SB(0, 0), cB, voffB); PG8_STAGE(PG8_SA(0, 0), cA, voffA); PG8_STAGE(PG8_SB(0, 1), cB + hstep, voffB); PG8_STAGE(PG8_SA(0, 1), cA + hstep, voffA);
        if (wr == 1) PG8_BAR;
        PG8_WAIT_V(4); PG8_BAR;
        PG8_STAGE(PG8_SB(1, 0), cB + kstep, voffB); PG8_STAGE(PG8_SA(1, 0), cA + kstep, voffA); PG8_STAGE(PG8_SB(1, 1), cB + hstep + kstep, voffB);
        PG8_WAIT_V(6); PG8_BAR;
    }
    for (;;) {
        const bool has_next = S.next(ui + 1, nxt);
        const char* nA = has_next ? (const char*)g.A + (size_t)nxt.pm * tstep : cA; const char* nB = has_next ? (const char*)g.Bt + (size_t)nxt.pn * tstep : cB;
        for (int t = 0; t < nt; t += 2) {
            const bool last = (t == nt - 2);
            const char* a1 = cA + (size_t)(t + 1) * kstep;
            const char* a2 = last ? nA : cA + (size_t)(t + 2) * kstep; const char* b2 = last ? nB : cB + (size_t)(t + 2) * kstep;
            const char* a3 = a2 + kstep; const char* b3 = b2 + kstep;
            if (last && has_next) S.a_ready(nxt);
            if constexpr (SP2) {
            PG8_LDB(B0, 0, 0); PG8_LDB(B1, 0, 1); PG8_SCHED; PG8_LDA(At, 0, 0); PG8_STAGE(PG8_SA(1, 1), a1 + hstep, voffA);
            PG8_WAIT_V(8); PG8_WAIT_L(0); PG8_BAR; PG8_MMA(0, 0, At, B0); PG8_MMA(0, 1, At, B1); PG8_BAR; PG8_SCHED;
            PG8_LDA(At, 0, 1); PG8_STAGE(PG8_SB(0, 0), b2, voffB); PG8_STAGE(PG8_SB(0, 1), b2 + hstep, voffB); PG8_STAGE(PG8_SA(0, 0), a2, voffA);
            PG8_WAIT_V(8); PG8_WAIT_L(0); PG8_BAR; PG8_MMA(1, 0, At, B0); PG8_MMA(1, 1, At, B1); PG8_BAR; PG8_SCHED;
            PG8_LDB(B0, 1, 0); PG8_LDB(B1, 1, 1); PG8_SCHED; PG8_LDA(At, 1, 0); PG8_STAGE(PG8_SA(0, 1), a2 + hstep, voffA);
            PG8_WAIT_V(8); PG8_WAIT_L(0); PG8_BAR; PG8_MMA(0, 0, At, B0); PG8_MMA(0, 1, At, B1); PG8_BAR; PG8_SCHED;
            PG8_LDA(At, 1, 1); PG8_STAGE(PG8_SB(1, 0), b3, voffB); PG8_STAGE(PG8_SB(1, 1), b3 + hstep, voffB); PG8_STAGE(PG8_SA(1, 0), a3, voffA);
            PG8_WAIT_V(8); PG8_WAIT_L(0); PG8_BAR; PG8_MMA(1, 0, At, B0); PG8_MMA(1, 1, At, B1); PG8_BAR; PG8_SCHED;
            } else {
            PG8_LDB(B0, 0, 0); PG8_SCHED; PG8_LDA(At, 0, 0); PG8_STAGE(PG8_SA(1, 1), a1 + hstep, voffA);
            PG8_WAIT_L(8); PG8_BAR; PG8_WAIT_L(0); PG8_MMA(0, 0, At, B0); PG8_BAR; PG8_SCHED;
            PG8_LDB(B1, 0, 1); PG8_STAGE(PG8_SB(0, 0), b2, voffB);
            PG8_BAR; PG8_WAIT_L(0); PG8_MMA(0, 1, At, B1); PG8_BAR;
            PG8_LDA(At, 0, 1); PG8_STAGE(PG8_SA(0, 0), a2, voffA);
            PG8_BAR; PG8_WAIT_L(0); PG8_MMA(1, 0, At, B0); PG8_BAR; PG8_SCHED;
            PG8_STAGE(PG8_SB(0, 1), b2 + hstep, voffB);
            PG8_WAIT_V(6); PG8_BAR; PG8_MMA(1, 1, At, B1); PG8_BAR;
            PG8_LDB(B0, 1, 0); PG8_SCHED; PG8_LDA(At, 1, 0); PG8_STAGE(PG8_SA(0, 1), a2 + hstep, voffA);
            PG8_WAIT_L(8); PG8_BAR; PG8_WAIT_L(0); PG8_MMA(0, 0, At, B0); PG8_BAR; PG8_SCHED;
            PG8_LDB(B1, 1, 1); PG8_STAGE(PG8_SB(1, 0), b3, voffB);
            PG8_BAR; PG8_WAIT_L(0); PG8_MMA(0, 1, At, B1); PG8_BAR;
            PG8_LDA(At, 1, 1); PG8_STAGE(PG8_SA(1, 0), a3, voffA);
            PG8_BAR; PG8_WAIT_L(0); PG8_MMA(1, 0, At, B0); PG8_BAR; PG8_SCHED;
            PG8_STAGE(PG8_SB(1, 1), b3 + hstep, voffB);
            PG8_WAIT_V(6); PG8_BAR; PG8_MMA(1, 1, At, B1); PG8_BAR;
            }
        }
        if constexpr (ALIGN_EPI) { if (wr == 0) PG8_BAR; }
        if constexpr (!Epi::AFTER_DRAIN) { E(acc, cur, wr, wc, fr, fq); S.done(cur); }
        if (!has_next) break;
#pragma unroll
        for (int a = 0; a < 2; ++a)
#pragma unroll
            for (int b = 0; b < 2; ++b)
#pragma unroll
                for (int m = 0; m < 4; ++m)
#pragma unroll
                    for (int n = 0; n < 2; ++n) acc[a][b][m][n] = (f32x4){0.f, 0.f, 0.f, 0.f};
        cur = nxt; cA = nA; cB = nB; ++ui;
        if constexpr (ALIGN_EPI) { if (wr == 1) PG8_BAR; }
    }
    PG8_WAIT_V(0);
    if constexpr (!ALIGN_EPI) { if (wr == 0) PG8_BAR; }
    PG8_BAR;
    if constexpr (Epi::AFTER_DRAIN) { E.fused(acc, cur, wr, wc, fr, fq, lds, wid, lane); S.done(cur); }
#undef PG8_SA
#undef PG8_SB
#undef PG8_STAGE
#undef PG8_LDA
#undef PG8_LDB
#undef PG8_MMA
#undef PG8_WAIT_V
#undef PG8_WAIT_L
#undef PG8_BAR
#undef PG8_SCHED
}
}
#define LAS __attribute__((address_space(3)))
typedef unsigned short bf16;
typedef float f32x4 __attribute__((ext_vector_type(4)));
typedef short bf16x8 __attribute__((ext_vector_type(8)));
typedef unsigned u32x4 __attribute__((ext_vector_type(4)));
typedef unsigned u32x2 __attribute__((ext_vector_type(2)));

constexpr int D = 1024, NBATCH = 2, SEQ = 8192, CTXL = 256, DEPTH = 2;
constexpr int NLAT = NBATCH * SEQ, NCTX = NBATCH * CTXL, NROW = NLAT + NCTX;
constexpr int DR = 512, DIN = 2944, NP = 3328, ZW = 1920, NHEAD = 8;
constexpr int COL_CONV = 1920, COL_FC = 2688, COL_FS = 2944;
constexpr int STRW = 5120;
constexpr int NEXP = 32, DEXP = 512;
constexpr int MOE_MAXTILES = 168;
constexpr float RMS_EPS = 1e-6f, GN_EPS = 64e-5f;

enum { I_X = 0, I_C, I_CTX, I_CCTX, I_ADAW, I_ADAB, I_N1G, I_N2G, I_WIN, I_MU, I_DW0, I_DW2, I_IA0, I_IA2, I_GG2, I_KK, I_KA, I_RK, I_GNW, I_GNB,
       I_CONVW, I_CONVG, I_FOURG, I_WOUT, I_RGW, I_RGB, I_REW, I_REB, I_EG, I_EU, I_ED, I_FG, N_IN };

constexpr size_t MiB = 1u << 20;
constexpr size_t WS_CTL = 0, CTL_ZERO_BYTES = 64 * 1024;
constexpr size_t WS_MODP = 1 * MiB;
constexpr size_t WS_MODF = 1 * MiB + 1280 * 1024;
constexpr size_t WS_WIN_T = 3 * MiB;
constexpr size_t WS_WOUT_T = 16 * MiB;
constexpr size_t WS_WGU_T = 20 * MiB;
constexpr size_t WS_WD_T = 84 * MiB;
constexpr size_t WS_X = 116 * MiB;
constexpr size_t WS_H = 182 * MiB;
constexpr size_t WS_ZS = 215 * MiB;
constexpr size_t WS_P = 277 * MiB;
constexpr size_t WS_STR = 277 * MiB;
constexpr size_t WS_Y = 442 * MiB;
constexpr size_t WS_GT = 475 * MiB;
constexpr size_t WS_ROUTE = 491 * MiB;
constexpr size_t WS_XS = 215 * MiB;
constexpr size_t WS_ACT = 299 * MiB;
constexpr size_t WS_END = 530 * MiB;
constexpr size_t RT_E = 0, RT_POS = 1 * 33792 * 4, RT_GATE = 2 * 33792 * 4, RT_SLOT = 3 * 33792 * 4, RT_TILE = 4 * 33792 * 4, RT_NT = RT_TILE + 1024;

constexpr int CW_BAR = 4096;
constexpr int CW_CNT = 8192;

constexpr int NWAVES = 8, NTHR = 512;
constexpr int RING_BYTES = 131072, LDSCTL_OFF = 143360, MISC_OFF = LDSCTL_OFF + 320, LDS_BYTES = 147456;

struct Params { const float* in[N_IN]; float* out; unsigned char* ws; };

__device__ __forceinline__ float bf2f(unsigned h) { return __uint_as_float(h << 16); }
typedef __bf16 hwbf2 __attribute__((ext_vector_type(2)));
typedef float f32x2 __attribute__((ext_vector_type(2)));
__device__ __forceinline__ unsigned pk2(float lo, float hi) { const f32x2 x = {lo, hi}; const hwbf2 r = __builtin_convertvector(x, hwbf2); return __builtin_bit_cast(unsigned, r); }
__device__ __forceinline__ unsigned f2bf(float f) { return pk2(f, 0.f) & 0xffffu; }
__device__ __forceinline__ float wave_sum(float v) {
#pragma unroll
    for (int o = 1; o < 64; o <<= 1) v += __shfl_xor(v, o);
    return v;
}
__device__ __forceinline__ float sigmoidf_(float x) { return 1.f / (1.f + __expf(-x)); }
#define LDS_WAIT() asm volatile("s_waitcnt lgkmcnt(0)" ::: "memory")
#define VM_WAIT() asm volatile("s_waitcnt vmcnt(0)" ::: "memory")

struct Frame {
    LAS unsigned char* lds;
    int tid, lane, wave, vcu, G, gw, NGW;
    float* out; unsigned char* ws;
};
#if defined(__HIP_DEVICE_COMPILE__)
#define ASSUME_GLOBAL(p) do { __builtin_assume(!__builtin_amdgcn_is_shared(p)); __builtin_assume(!__builtin_amdgcn_is_private(p)); } while (0)
#else
#define ASSUME_GLOBAL(p) do { } while (0)
#endif
__device__ __forceinline__ const float* inptr(int i) {
    const volatile unsigned long long __attribute__((address_space(4)))* ka = (const volatile unsigned long long __attribute__((address_space(4)))*)__builtin_amdgcn_kernarg_segment_ptr();
    return (const float*)(const __attribute__((address_space(1))) float*)ka[i];
}
__device__ __forceinline__ unsigned char* opaque(unsigned char* p) { unsigned long z = 0; asm volatile("" : "+s"(z)); return p + z; }
__device__ __forceinline__ Frame phase_frame(const Frame& F0) { Frame F = F0; asm volatile("" : "+v"(F.tid)); F.lane = F.tid & 63; F.ws = opaque(F0.ws);
    asm volatile("" : "+s"(F.G), "+s"(F.vcu)); F.gw = F.vcu * NWAVES + F.wave; F.NGW = F.G * NWAVES; return F; }
__device__ __forceinline__ int modrow(int row) { return row < NLAT ? (row >> 13) : 2; }
#define XB_TMO      128
#define XB_XCNT(j)  (256  + 64 * (j))
#define XB_XSUB(j)  (1280 + 64 * (j))
#define XB_XGEN(j)  (2304 + 64 * (j))
#define XB_TOP      3328
#define XB_TOPGEN   3392
#define XCD_BAR_WORDS 3456
#define XB_SPIN_CAP (1u << 18)

__device__ __forceinline__ unsigned xb_ld(unsigned* p)              { return __hip_atomic_load(p, __ATOMIC_RELAXED, __HIP_MEMORY_SCOPE_AGENT); }
__device__ __forceinline__ unsigned xb_add(unsigned* p, unsigned v) { return __hip_atomic_fetch_add(p, v, __ATOMIC_RELAXED, __HIP_MEMORY_SCOPE_AGENT); }
__device__ __forceinline__ unsigned xb_xcc_id() { return (unsigned)__builtin_amdgcn_s_getreg((3 << 11) | 20) & 0xFu; }
#define XB_SPIN(cond, bar) do { unsigned _sp = 0; while (cond) { __builtin_amdgcn_s_sleep(1); \
    if ((++_sp & 255u) == 0u) { if (xb_ld(&(bar)[XB_TMO])) break; if (_sp > XB_SPIN_CAP) { atomicAdd(&(bar)[XB_TMO], 1u); break; } } } } while (0)

struct XcdBarrier {
    unsigned* bar; unsigned x;
    volatile LAS unsigned* st;
};

__device__ __forceinline__ XcdBarrier xcd_barrier_post(unsigned* bar, volatile LAS unsigned* st) {
    XcdBarrier b; b.bar = bar; b.x = xb_xcc_id(); b.st = st;
    if (threadIdx.x == 0) (void)xb_add(&bar[XB_XCNT(b.x)], 1u);
    return b;
}
__device__ __forceinline__ void xcd_barrier_complete(unsigned* bar, unsigned x, unsigned& nloc, unsigned& nx) {
    const unsigned G = gridDim.x * gridDim.y * gridDim.z;
    unsigned sum, cnt, mine, sp = 0u;
    for (;;) {
        sum = 0u; cnt = 0u; mine = 0u;
#pragma nounroll
        for (unsigned j = 0; j < 16; ++j) { const unsigned c = xb_ld(&bar[XB_XCNT(j)]); sum += c; cnt += (c > 0u) ? 1u : 0u; mine = (j == x) ? c : mine; }
        if (sum == G) break;
        __builtin_amdgcn_s_sleep(1);
        if ((++sp & 255u) == 0u) { if (xb_ld(&bar[XB_TMO])) break; if (sp > XB_SPIN_CAP) { atomicAdd(&bar[XB_TMO], 1u); break; } }
    }
    nloc = mine > 0u ? mine : 1u; nx = cnt > 0u ? cnt : 1u;
}

__device__ __forceinline__ void xcd_barrier(const XcdBarrier& b) {
    asm volatile("s_waitcnt vmcnt(0)" ::: "memory");
    __syncthreads();
    if (threadIdx.x == 0) {
        unsigned* bar = b.bar;
        asm volatile("" : "+s"(bar));
        __builtin_amdgcn_s_waitcnt(0);
        unsigned nloc = b.st[0], nx = b.st[1];
        if (nloc == 0u) { xcd_barrier_complete(bar, b.x, nloc, nx); b.st[0] = nloc; b.st[1] = nx; }
        const unsigned old = xb_add(&bar[XB_XSUB(b.x)], 1u);
        const unsigned gen = old / nloc;
        if (old + 1u == (gen + 1u) * nloc) {
            __builtin_amdgcn_fence(__ATOMIC_RELEASE, "agent");
            asm volatile("s_waitcnt vmcnt(0)" ::: "memory");
            const unsigned og = xb_add(&bar[XB_TOP], 1u);
            const unsigned tg = og / nx;
            if (og + 1u == (tg + 1u) * nx) xb_add(&bar[XB_TOPGEN], 1u);
            else XB_SPIN(xb_ld(&bar[XB_TOPGEN]) == tg, bar);
            __builtin_amdgcn_fence(__ATOMIC_ACQUIRE, "agent");
            xb_add(&bar[XB_XGEN(b.x)], 1u);
            asm volatile("s_waitcnt vmcnt(0)" ::: "memory");
        } else {
            XB_SPIN(xb_ld(&bar[XB_XGEN(b.x)]) == gen, bar);
            __builtin_amdgcn_fence(__ATOMIC_ACQUIRE, "agent");
            asm volatile("s_waitcnt vmcnt(0)" ::: "memory");
        }
    }
    __syncthreads();
}
template <class RowMap>
__device__ __forceinline__ void transpose_item(const float* W, int ldw, int k0, int n0, bf16* WT, int ldt, RowMap rm, LAS float* scr, int lane) {
    (void)scr;
    const int nq = lane & 7, kg = lane >> 3; const float* src = W + (size_t)(k0 + 8 * kg) * ldw + n0 + 4 * nq;
    f32x4 v[8];
#pragma unroll
    for (int i = 0; i < 8; ++i) v[i] = *(const f32x4*)(src + (size_t)i * ldw);
#pragma unroll
    for (int j = 0; j < 4; ++j) { u32x4 o = {pk2(v[0][j], v[1][j]), pk2(v[2][j], v[3][j]), pk2(v[4][j], v[5][j]), pk2(v[6][j], v[7][j])};
        *(u32x4*)(WT + (size_t)rm(n0 + 4 * nq + j) * ldt + k0 + 8 * kg) = o; }
}
struct RmId { int off; __device__ __forceinline__ int operator()(int n) const { return off + n; } };
struct RmGU { int off; __device__ __forceinline__ int operator()(int n) const { return off + ((n >> 2) << 3) + (n & 3); } };

__device__ __forceinline__ void p0_prologue(const Frame& F0) {
    const Frame F = phase_frame(F0); unsigned char* const ws = F.ws;
    LAS float* scr = (LAS float*)(F.lds + F.wave * 16384);
    LAS float* ctab = (LAS float*)(F.lds + 8 * 16384);
    if (F.tid < 64) ctab[F.tid] = cosf((float)F.tid * (6.283185307179586f / 64.f));
    __syncthreads();
    bf16* win_t = (bf16*)(ws + WS_WIN_T); bf16* wout_t = (bf16*)(ws + WS_WOUT_T);
    constexpr int I_WIN_L = 16 * 84, I_WOUT_L = 16 * 32, I_FOLD_L = 4 * 64, I_MOD_L = 96 * 8;
    constexpr int NIT = 2 * (I_WIN_L + I_WOUT_L + I_FOLD_L + I_MOD_L);
    const float* p_win = inptr(I_WIN); const float* p_wout = inptr(I_WOUT); const float* p_c = inptr(I_C); const float* p_cctx = inptr(I_CCTX); const float* p_adaw = inptr(I_ADAW);
    {
        bf16* wl = (bf16*)(ws + 64 * 1024); const float* dw2 = inptr(I_DW2); const float* ia2 = inptr(I_IA2); const float* gg2 = inptr(I_GG2);
        for (int idx = F.vcu * NTHR + F.tid; idx < 2 * 384 * 512; idx += F.G * NTHR) { const int c = idx & 511, k = (idx >> 9) % 384, l = idx / (384 * 512);
            float v;
            if (k < 128) v = dw2[((size_t)(l * 2 + (k >> 6)) * 64 + (k & 63)) * DR + c];
            else if (k < 256) v = ia2[((size_t)(l * 2 + ((k - 128) >> 6)) * 64 + (k & 63)) * DR + c];
            else v = gg2[((size_t)l * 128 + (k - 256)) * DR + c];
            wl[((size_t)l * 512 + c) * 384 + k] = (bf16)f2bf(v); } }
    for (int it = F.gw; it < NIT; it += F.NGW) {
        int r = it; const int l = r & 1; r >>= 1;
        if (r < I_WIN_L) { const int kb = r / 84, nb = r % 84;
            transpose_item(p_win + (size_t)l * D * DIN, DIN, kb * 64, nb * 32, win_t + (size_t)l * NP * D, D, RmId{0}, scr, F.lane); continue; }
        r -= I_WIN_L;
        if (r < I_WOUT_L) { const int kb = r / 32, nb = r % 32;
            transpose_item(p_wout + (size_t)l * D * D, D, kb * 64, nb * 32, wout_t + (size_t)l * D * D, D, RmId{0}, scr, F.lane); continue; }
        r -= I_WOUT_L;
        if (r < I_FOLD_L) {
            const int g = r >> 6, k0 = (r & 63) * 16; const float* W = p_win + (size_t)l * D * DIN;
#pragma unroll
            for (int kk = 0; kk < 16; ++kk) scr[kk * 64 + F.lane] = W[(size_t)(k0 + kk) * DIN + 2688 + g * 64 + F.lane];
            LDS_WAIT(); asm volatile("" ::: "memory");
            float ac[16], as[16];
#pragma unroll
            for (int kk = 0; kk < 16; ++kk) { ac[kk] = 0.f; as[kk] = 0.f; }
            for (int c = 0; c < 64; ++c) { const int idx = (c * F.lane) & 63; const float cc = ctab[idx], ss = ctab[(idx - 16) & 63];
#pragma unroll
                for (int kk = 0; kk < 16; ++kk) { const float w = scr[kk * 64 + c]; ac[kk] += w * cc; as[kk] += w * ss; } }
            bf16* oc = win_t + (size_t)l * NP * D + (size_t)(COL_FC + g * 64 + F.lane) * D + k0;
            bf16* os = win_t + (size_t)l * NP * D + (size_t)(COL_FS + g * 64 + F.lane) * D + k0;
            u32x4 a, b;
            a.x = pk2(ac[0], ac[1]); a.y = pk2(ac[2], ac[3]); a.z = pk2(ac[4], ac[5]); a.w = pk2(ac[6], ac[7]);
            b.x = pk2(ac[8], ac[9]); b.y = pk2(ac[10], ac[11]); b.z = pk2(ac[12], ac[13]); b.w = pk2(ac[14], ac[15]);
            *(u32x4*)oc = a; *(u32x4*)(oc + 8) = b;
            a.x = pk2(as[0], as[1]); a.y = pk2(as[2], as[3]); a.z = pk2(as[4], as[5]); a.w = pk2(as[6], as[7]);
            b.x = pk2(as[8], as[9]); b.y = pk2(as[10], as[11]); b.z = pk2(as[12], as[13]); b.w = pk2(as[14], as[15]);
            *(u32x4*)os = a; *(u32x4*)(os + 8) = b;
            LDS_WAIT(); asm volatile("" ::: "memory");
            continue; }
        r -= I_FOLD_L;
        {
            const int cb = r >> 3, ks = r & 7;
#pragma unroll
            for (int q = 0; q < 2; ++q) { const int k = ks * 128 + q * 64 + F.lane;
                const float c0 = p_c[k], c1 = p_c[D + k], c2 = p_cctx[k];
                scr[0 * 128 + q * 64 + F.lane] = c0 * sigmoidf_(c0); scr[1 * 128 + q * 64 + F.lane] = c1 * sigmoidf_(c1); scr[2 * 128 + q * 64 + F.lane] = c2 * sigmoidf_(c2); }
            LDS_WAIT(); asm volatile("" ::: "memory");
            const float* W = p_adaw + (size_t)l * D * 6144 + (size_t)(ks * 128) * 6144 + cb * 64 + F.lane;
            float a0 = 0.f, a1 = 0.f, a2 = 0.f;
#pragma unroll 8
            for (int kk = 0; kk < 128; ++kk) { const float w = W[(size_t)kk * 6144]; a0 += scr[kk] * w; a1 += scr[128 + kk] * w; a2 += scr[256 + kk] * w; }
            float* mp = (float*)(ws + WS_MODP) + (size_t)((l * 8 + ks) * 3) * 6144 + cb * 64 + F.lane;
            mp[0] = a0; mp[6144] = a1; mp[2 * 6144] = a2;
            LDS_WAIT(); asm volatile("" ::: "memory");
        }
    }
}

__device__ __forceinline__ void mod_to_lds(const Frame& F0, int l, int p, LAS float* dst, bool from_partials) {
    const Frame F = phase_frame(F0); unsigned char* const ws = F.ws;
    const float* adab = inptr(I_ADAB);
    for (int idx = F.tid; idx < 3 * 1024; idx += NTHR) { const int r = idx >> 10, n = idx & 1023;
        float v;
        if (from_partials) { v = adab[l * 6144 + p * 1024 + n]; const float* mp = (const float*)(ws + WS_MODP) + (size_t)(l * 8 * 3 + r) * 6144 + p * 1024 + n;
#pragma unroll
            for (int ks = 0; ks < 8; ++ks) v += mp[(size_t)ks * 3 * 6144]; }
        else v = ((const float*)(ws + WS_MODF))[(size_t)(l * 3 + r) * 6144 + p * 1024 + n];
        dst[idx] = v; }
}
__device__ __forceinline__ void mod_finalize(const Frame& F0) {
    const Frame F = phase_frame(F0); unsigned char* const ws = F.ws;
    const float* adab = inptr(I_ADAB);
    for (int idx = F.vcu * NTHR + F.tid; idx < 2 * 3 * 6144; idx += F.G * NTHR) { const int l = idx / (3 * 6144), rem = idx % (3 * 6144), r = rem / 6144, n = rem % 6144;
        float v = adab[l * 6144 + n]; const float* mp = (const float*)(ws + WS_MODP) + (size_t)(l * 8 * 3 + r) * 6144 + n;
#pragma unroll
        for (int ks = 0; ks < 8; ++ks) v += mp[(size_t)ks * 3 * 6144];
        ((float*)(ws + WS_MODF))[idx] = v; }
}


__device__ __forceinline__ void norm_mod_row(f32x4 (&v)[4], const float* gain, const LAS float* sc, const LAS float* sh, bf16* orow, int lane) {
    float s = 0.f;
#pragma unroll
    for (int j = 0; j < 4; ++j) s += (v[j].x * v[j].x + v[j].y * v[j].y) + (v[j].z * v[j].z + v[j].w * v[j].w);
    const float rs = rsqrtf(wave_sum(s) * (1.f / D) + RMS_EPS);
#pragma unroll
    for (int j = 0; j < 4; ++j) { const int c = 4 * lane + 256 * j; const f32x4 g = *(const f32x4*)(gain + c); const f32x4 a = *(const LAS f32x4*)(sc + c), b = *(const LAS f32x4*)(sh + c);
        v[j] = (v[j] * rs) * g * (a + 1.f) + b;
        u32x2 w; w.x = pk2(v[j].x, v[j].y); w.y = pk2(v[j].z, v[j].w); *(u32x2*)(orow + c) = w; }
}

__device__ __forceinline__ void p0b_norm1(const Frame& F0) {
    const Frame F = phase_frame(F0); unsigned char* const ws = F.ws;
    LAS float* msh = (LAS float*)F.lds; LAS float* msc = msh + 3072;
    mod_to_lds(F, 0, 0, msh, true); mod_to_lds(F, 0, 1, msc, true); __syncthreads();
    mod_finalize(F);
    bf16* H = (bf16*)(ws + WS_H); const float* xin = inptr(I_X); const float* cin = inptr(I_CTX); const float* n1g = inptr(I_N1G);
    for (int row0 = F.gw; row0 < NROW; row0 += 2 * F.NGW) { f32x4 v[2][4]; bool ok[2];
#pragma unroll
        for (int u = 0; u < 2; ++u) { const int row = row0 + u * F.NGW; ok[u] = row < NROW; if (ok[u]) { const float* xr = row < NLAT ? xin + (size_t)row * D : cin + (size_t)(row - NLAT) * D;
#pragma unroll
            for (int j = 0; j < 4; ++j) v[u][j] = *(const f32x4*)(xr + 4 * F.lane + 256 * j); } }
#pragma unroll
        for (int u = 0; u < 2; ++u) if (ok[u]) { const int row = row0 + u * F.NGW; const int mr = modrow(row);
            norm_mod_row(v[u], n1g, msc + mr * 1024, msh + mr * 1024, H + (size_t)row * D, F.lane); } }
}
__device__ __forceinline__ void unpack8(const u32x4 w, float (&o)[8]) {
    o[0] = bf2f(w.x & 0xffffu); o[1] = bf2f(w.x >> 16); o[2] = bf2f(w.y & 0xffffu); o[3] = bf2f(w.y >> 16);
    o[4] = bf2f(w.z & 0xffffu); o[5] = bf2f(w.z >> 16); o[6] = bf2f(w.w & 0xffffu); o[7] = bf2f(w.w >> 16);
}
__device__ __forceinline__ void unpack4(const u32x2 w, float (&o)[4]) { o[0] = bf2f(w.x & 0xffffu); o[1] = bf2f(w.x >> 16); o[2] = bf2f(w.y & 0xffffu); o[3] = bf2f(w.y >> 16); }

__device__ __forceinline__ void shift_pass(const Frame& F0, int l) {
    const Frame F = phase_frame(F0); unsigned char* const ws = F.ws;
    const bf16* P = (const bf16*)(ws + WS_P); bf16* Zs = (bf16*)(ws + WS_ZS); const float* mu = inptr(I_MU) + l * ZW;
    const int total = NROW * 240;
    for (int idx = F.vcu * NTHR + F.tid; idx < total; idx += F.G * NTHR) {
        const int row = idx / 240, ck = idx % 240; const bf16* pr = P + (size_t)row * NP + ck * 8;
        const u32x4 zero = {0u, 0u, 0u, 0u};
        float z[8], n0[8], n1[8], n2[8], n3[8], o[8];
        unpack8(*(const u32x4*)pr, z);
        if (row < NLAT) { const int t = row & (SEQ - 1), gr = t >> 6, gc = t & 63;
            unpack8(gc > 0 ? *(const u32x4*)(pr - NP) : zero, n0); unpack8(gc < 63 ? *(const u32x4*)(pr + NP) : zero, n1);
            unpack8(gr > 0 ? *(const u32x4*)(pr - 64 * NP) : zero, n2); unpack8(gr < 127 ? *(const u32x4*)(pr + 64 * NP) : zero, n3);
        } else { const int tc = (row - NLAT) & (CTXL - 1);
            unpack8(tc > 0 ? *(const u32x4*)(pr - NP) : zero, n0); unpack8(tc < CTXL - 1 ? *(const u32x4*)(pr + NP) : zero, n1);
#pragma unroll
            for (int j = 0; j < 8; ++j) { n2[j] = n0[j]; n3[j] = n1[j]; }
        }
        const f32x4 m0 = *(const f32x4*)(mu + ck * 8), m1 = *(const f32x4*)(mu + ck * 8 + 4);
        const float m[8] = {m0.x, m0.y, m0.z, m0.w, m1.x, m1.y, m1.z, m1.w};
#pragma unroll
        for (int j = 0; j < 8; ++j) { const float nb = (j & 3) == 0 ? n0[j] : (j & 3) == 1 ? n1[j] : (j & 3) == 2 ? n2[j] : n3[j]; o[j] = z[j] + (nb - z[j]) * m[j]; }
        u32x4 w; w.x = pk2(o[0], o[1]); w.y = pk2(o[2], o[3]); w.z = pk2(o[4], o[5]); w.w = pk2(o[6], o[7]);
        *(u32x4*)(Zs + (size_t)row * ZW + ck * 8) = w;
    }
}

__device__ __forceinline__ void conv_pass(const Frame& F0, int l, int nrows) {
    const Frame F = phase_frame(F0); unsigned char* const ws = F.ws;
    const bf16* P = (const bf16*)(ws + WS_P); bf16* MA = (bf16*)(ws + WS_H);
    const float* cw = inptr(I_CONVW) + l * 3 * 256; const int c = 4 * F.lane;
    const f32x4 w0 = *(const f32x4*)(cw + c), w1 = *(const f32x4*)(cw + 256 + c), w2 = *(const f32x4*)(cw + 512 + c), gn = *(const f32x4*)(inptr(I_CONVG) + l * 256 + c);
    for (int row0 = F.gw; row0 < nrows; row0 += 2 * F.NGW) {
        u32x2 q[2][7]; bool ok[2]; const u32x2 zero = {0u, 0u};
#pragma unroll
        for (int u = 0; u < 2; ++u) { const int row = row0 + u * F.NGW; ok[u] = row < nrows; if (ok[u]) {
            int t, L; if (row < NLAT) { t = row & (SEQ - 1); L = SEQ; } else { t = (row - NLAT) & (CTXL - 1); L = CTXL; }
            const bf16* pr = P + (size_t)row * NP + COL_CONV + c;
            q[u][0] = *(const u32x2*)pr; q[u][1] = *(const u32x2*)(pr + 256); q[u][2] = *(const u32x2*)(pr + 512);
            q[u][3] = t > 0 ? *(const u32x2*)(pr - NP + 256) : zero; q[u][4] = t > 0 ? *(const u32x2*)(pr - NP + 512) : zero;
            q[u][5] = t < L - 1 ? *(const u32x2*)(pr + NP + 256) : zero; q[u][6] = t < L - 1 ? *(const u32x2*)(pr + NP + 512) : zero; } }
#pragma unroll
        for (int u = 0; u < 2; ++u) if (ok[u]) { const int row = row0 + u * F.NGW;
            float bg[4], cg[4], hh[4], cp[4], hp[4], cn[4], hn[4];
            unpack4(q[u][0], bg); unpack4(q[u][1], cg); unpack4(q[u][2], hh); unpack4(q[u][3], cp); unpack4(q[u][4], hp); unpack4(q[u][5], cn); unpack4(q[u][6], hn);
            const float W0[4] = {w0.x, w0.y, w0.z, w0.w}, W1[4] = {w1.x, w1.y, w1.z, w1.w}, W2[4] = {w2.x, w2.y, w2.z, w2.w}, GN[4] = {gn.x, gn.y, gn.z, gn.w};
            float y[4], s = 0.f;
#pragma unroll
            for (int j = 0; j < 4; ++j) { y[j] = bg[j] * (W0[j] * (cp[j] * hp[j]) + W1[j] * (cg[j] * hh[j]) + W2[j] * (cn[j] * hn[j])); s += y[j] * y[j]; }
            const float rs = rsqrtf(wave_sum(s) * (1.f / 256.f) + RMS_EPS);
            u32x2 o; o.x = pk2(y[0] * rs * GN[0], y[1] * rs * GN[1]); o.y = pk2(y[2] * rs * GN[2], y[3] * rs * GN[3]);
            *(u32x2*)(MA + (size_t)row * D + 512 + c) = o; }
    }
}

__device__ __forceinline__ void sincos_turns(float x, float& s, float& c) { s = __builtin_amdgcn_sinf(x); c = __builtin_amdgcn_cosf(x); }
#define MFMA16(a, b, c) __builtin_amdgcn_mfma_f32_16x16x32_bf16((a), (b), (c), 0, 0, 0)

__device__ __forceinline__ void fftA_item(const Frame& F0, int item) {
    const Frame F = phase_frame(F0); unsigned char* const ws = F.ws;
    const int half = item & 1, t2 = (item >> 1) & 63, b = item >> 7;
    const bf16* P = (const bf16*)(ws + WS_P); bf16* GT = (bf16*)(ws + WS_GT);
    LAS bf16* Bs = (LAS bf16*)F.lds;
    const int lane = F.lane, w = F.wave, fr = lane & 15, fq = lane >> 4;
    __syncthreads();
#pragma unroll
    for (int i = 0; i < 8; ++i) { const int cidx = F.tid + NTHR * i, krow = cidx >> 4, ch8 = cidx & 15, ri = krow >> 7, t1 = krow & 127;
        const u32x4 v = *(const u32x4*)(P + (size_t)(b * SEQ + t1 * 64 + t2) * NP + COL_FC + ri * 256 + half * 128 + ch8 * 8);
        LAS bf16* d = Bs + (ch8 * 8) * 264 + krow;
        d[0 * 264] = (bf16)(v.x & 0xffffu); d[1 * 264] = (bf16)(v.x >> 16); d[2 * 264] = (bf16)(v.y & 0xffffu); d[3 * 264] = (bf16)(v.y >> 16);
        d[4 * 264] = (bf16)(v.z & 0xffffu); d[5 * 264] = (bf16)(v.z >> 16); d[6 * 264] = (bf16)(v.w & 0xffffu); d[7 * 264] = (bf16)(v.w >> 16); }
    __syncthreads();
    f32x4 acc[2][8];
#pragma unroll
    for (int a = 0; a < 2; ++a)
#pragma unroll
        for (int n = 0; n < 8; ++n) acc[a][n] = (f32x4){0.f, 0.f, 0.f, 0.f};
    int t1p_a = 16 * w + fr;
    asm volatile("" : "+v"(t1p_a));
#pragma unroll
    for (int ks = 0; ks < 8; ++ks) {
        bf16x8 ar, ai;
#pragma unroll
        for (int j = 0; j < 8; ++j) { const int k = ks * 32 + 8 * fq + j, ri = k >> 7, t1 = k & 127; const int idx = (t1 * t1p_a) & 127;
            float sn, cs; sincos_turns((float)idx * (1.f / 128.f), sn, cs);
            const float vr = ri == 0 ? cs : -sn, vi = ri == 0 ? -sn : -cs;
            ar[j] = (short)f2bf(vr); ai[j] = (short)f2bf(vi); }
#pragma unroll
        for (int nt = 0; nt < 8; ++nt) { const bf16x8 bfr = *(const LAS bf16x8*)(Bs + (nt * 16 + fr) * 264 + ks * 32 + 8 * fq);
            acc[0][nt] = MFMA16(ar, bfr, acc[0][nt]); acc[1][nt] = MFMA16(ai, bfr, acc[1][nt]); }
    }
#pragma unroll
    for (int reg = 0; reg < 4; ++reg) { const int t1p = 16 * w + 4 * fq + reg; float st, ct; sincos_turns((float)(t2 * t1p) * (1.f / 8192.f), st, ct);
        bf16* g = GT + ((size_t)((b * 128 + t1p) * 64 + t2) * 2) * 256 + half * 128 + fr;
#pragma unroll
        for (int nt = 0; nt < 8; ++nt) { const float gr = acc[0][nt][reg], gi = acc[1][nt][reg];
            g[nt * 16] = (bf16)f2bf(gr * ct + gi * st); g[256 + nt * 16] = (bf16)f2bf(gi * ct - gr * st); } }
}

template <int NKC, int NDIV, class SrcRow, class OutRow>
__device__ __forceinline__ void dft64_item(const Frame& F0, int l, int m0, float sgn, float scale, SrcRow src, OutRow orow) {
    const Frame F = phase_frame(F0); unsigned char* const ws = F.ws;
    LAS bf16* Bs = (LAS bf16*)F.lds;
    LAS float* red = (LAS float*)(F.lds + 256 * 136 * 2);
    const int lane = F.lane, w = F.wave, fr = lane & 15, fq = lane >> 4;
    int fr_a = fr; asm volatile("" : "+v"(fr_a));
    f32x4 acc[4][2];
#pragma unroll
    for (int a = 0; a < 4; ++a) { acc[a][0] = (f32x4){0.f, 0.f, 0.f, 0.f}; acc[a][1] = (f32x4){0.f, 0.f, 0.f, 0.f}; }
    for (int kc = 0; kc < NKC; ++kc) {
        __syncthreads();
#pragma unroll
        for (int i = 0; i < 8; ++i) { const int cidx = F.tid + NTHR * i, krow = cidx >> 5, ch8 = cidx & 31;
            const u32x4 v = *(const u32x4*)(src(kc * 64 + (krow >> 1), krow & 1) + ch8 * 8);
            LAS bf16* d = Bs + (ch8 * 8) * 136 + krow;
            d[0 * 136] = (bf16)(v.x & 0xffffu); d[1 * 136] = (bf16)(v.x >> 16); d[2 * 136] = (bf16)(v.y & 0xffffu); d[3 * 136] = (bf16)(v.y >> 16);
            d[4 * 136] = (bf16)(v.z & 0xffffu); d[5 * 136] = (bf16)(v.z >> 16); d[6 * 136] = (bf16)(v.w & 0xffffu); d[7 * 136] = (bf16)(v.w >> 16); }
        __syncthreads();
#pragma unroll
        for (int ks = 0; ks < 4; ++ks) {
            const bf16x8 b0 = *(const LAS bf16x8*)(Bs + ((2 * w) * 16 + fr) * 136 + ks * 32 + 8 * fq);
            const bf16x8 b1 = *(const LAS bf16x8*)(Bs + ((2 * w + 1) * 16 + fr) * 136 + ks * 32 + 8 * fq);
#pragma unroll
            for (int mt = 0; mt < 4; ++mt) { const int mrow = m0 + mt * 16 + fr_a; bf16x8 a;
#pragma unroll
                for (int j = 0; j < 8; ++j) { const int k = ks * 32 + 8 * fq + j, tl = k >> 1, ri = k & 1; const int idx = ((kc * 64 + tl) * mrow) & (NDIV - 1);
                    float sn, cs; sincos_turns((float)idx * (1.f / (float)NDIV), sn, cs);
                    a[j] = (short)f2bf(ri == 0 ? cs : sgn * sn); }
                acc[mt][0] = MFMA16(a, b0, acc[mt][0]); acc[mt][1] = MFMA16(a, b1, acc[mt][1]); }
        }
    }
#pragma unroll
    for (int mt = 0; mt < 4; ++mt)
#pragma unroll
        for (int reg = 0; reg < 4; ++reg) { const float a = acc[mt][0][reg] * scale, b = acc[mt][1][reg] * scale; acc[mt][0][reg] = a; acc[mt][1][reg] = b;
            float s = a * a + b * b; s += __shfl_xor(s, 1); s += __shfl_xor(s, 2); s += __shfl_xor(s, 4); s += __shfl_xor(s, 8);
            if (fr == 0) red[w * 64 + mt * 16 + 4 * fq + reg] = s; }
    __syncthreads();
    bf16* MA = (bf16*)(ws + WS_H); const float* fg = inptr(I_FOURG) + l * 256;
    const float g0 = fg[(2 * w) * 16 + fr], g1 = fg[(2 * w + 1) * 16 + fr];
#pragma unroll
    for (int mt = 0; mt < 4; ++mt)
#pragma unroll
        for (int reg = 0; reg < 4; ++reg) { const int ml = mt * 16 + 4 * fq + reg; float tot = 0.f;
#pragma unroll
            for (int ww = 0; ww < 8; ++ww) tot += red[ww * 64 + ml];
            const float rs = rsqrtf(tot * (1.f / 256.f) + RMS_EPS);
            bf16* o = MA + (size_t)orow(m0 + ml) * D + 768 + fr;
            o[(2 * w) * 16] = (bf16)f2bf(acc[mt][0][reg] * rs * g0); o[(2 * w + 1) * 16] = (bf16)f2bf(acc[mt][1][reg] * rs * g1); }
    __syncthreads();
}

constexpr size_t WS_LORA = 64 * 1024;
constexpr int LINP = 392;
__device__ __forceinline__ float fast_sigmoid(float x) { return __builtin_amdgcn_rcpf(1.f + __expf(-x)); }
__device__ __forceinline__ float fast_tanh(float x) { return 1.f - 2.f * __builtin_amdgcn_rcpf(1.f + __expf(2.f * x)); }
__device__ __forceinline__ void prep_phase(const Frame& F0, int l) {
    const Frame F = phase_frame(F0); unsigned char* const ws = F.ws;
    const bf16* Zs = (const bf16*)(ws + WS_ZS); bf16* STR = (bf16*)(ws + WS_STR);
    LAS bf16* lin = (LAS bf16*)F.lds;
    LAS float* ssum = (LAS float*)(F.lds + 12544);
    LAS bf16* tiles = (LAS bf16*)(F.lds + 13312);
    const int lane = F.lane, fr = lane & 15, fq = lane >> 4, w = F.wave, tid = F.tid;
    const int nitems = (NROW / 16) * 2;
    int it = blockIdx.x; if (it >= nitems) return;
    int hh = -1, head = 0, cb = 0;
    bf16x8 wf[12][2];
    const float* kkp = inptr(I_KK) + l * DR; const float* kap = inptr(I_KA) + l * DR; const float* dw0 = inptr(I_DW0) + l * 2 * DR; const float* ia0 = inptr(I_IA0) + l * 2 * DR;
    u32x4 pz[2];
#define PREP_LOAD(item_) do { const int row0_ = ((item_) >> 1) * 16; \
        pz[0] = *(const u32x4*)(Zs + (size_t)(row0_ + tid / 48) * ZW + 1536 + (tid % 48) * 8); \
        if (tid < 256) pz[1] = *(const u32x4*)(Zs + (size_t)(row0_ + (tid + 512) / 48) * ZW + 1536 + ((tid + 512) % 48) * 8); } while (0)
    PREP_LOAD(it);
    for (; it < nitems; it += F.G) {
        const int tile = it >> 1;
        if ((it & 1) != hh) {
            hh = it & 1; head = 4 * hh + (w >> 1); cb = 64 * head + 32 * (w & 1);
            const bf16* WL = (const bf16*)(ws + WS_LORA) + (size_t)l * 512 * 384 + (size_t)(cb + fr) * 384 + 8 * fq;
#pragma unroll
            for (int ks = 0; ks < 12; ++ks)
#pragma unroll
                for (int nt = 0; nt < 2; ++nt) wf[ks][nt] = *(const bf16x8*)(WL + (size_t)nt * 16 * 384 + ks * 32);
        }
        __syncthreads();
        {   float v[8]; unpack8(pz[0], v); const int c8 = tid % 48;
            if (c8 < 16) {
#pragma unroll
                for (int j = 0; j < 8; ++j) v[j] = fast_tanh(v[j]); }
            else if (c8 >= 32) {
#pragma unroll
                for (int j = 0; j < 8; ++j) v[j] = fast_sigmoid(v[j]); }
            *(LAS u32x4*)(lin + (tid / 48) * LINP + c8 * 8) = (u32x4){pk2(v[0], v[1]), pk2(v[2], v[3]), pk2(v[4], v[5]), pk2(v[6], v[7])};
            if (tid < 256) { unpack8(pz[1], v); const int c9 = (tid + 512) % 48;
                if (c9 < 16) {
#pragma unroll
                    for (int j = 0; j < 8; ++j) v[j] = fast_tanh(v[j]); }
                else if (c9 >= 32) {
#pragma unroll
                    for (int j = 0; j < 8; ++j) v[j] = fast_sigmoid(v[j]); }
                *(LAS u32x4*)(lin + ((tid + 512) / 48) * LINP + c9 * 8) = (u32x4){pk2(v[0], v[1]), pk2(v[2], v[3]), pk2(v[4], v[5]), pk2(v[6], v[7])}; } }
        u32x2 zr2[2], zk2[2], zv2[2];
        {   const bf16* zr_ = Zs + (size_t)(tile * 16 + fr) * ZW + cb + 4 * fq;
#pragma unroll
            for (int nt = 0; nt < 2; ++nt) { zr2[nt] = *(const u32x2*)(zr_ + 16 * nt); zk2[nt] = *(const u32x2*)(zr_ + 512 + 16 * nt); zv2[nt] = *(const u32x2*)(zr_ + 1024 + 16 * nt); } }
        if (it + F.G < nitems) PREP_LOAD(it + F.G);
        __syncthreads();
        f32x4 kkw[2], kaw[2], d0w[2][2], i0w[2][2];
#pragma unroll
        for (int nt = 0; nt < 2; ++nt) { const int c0 = cb + 16 * nt + 4 * fq; kkw[nt] = *(const f32x4*)(kkp + c0); kaw[nt] = *(const f32x4*)(kap + c0);
#pragma unroll
            for (int dn = 0; dn < 2; ++dn) { d0w[dn][nt] = *(const f32x4*)(dw0 + dn * DR + c0); i0w[dn][nt] = *(const f32x4*)(ia0 + dn * DR + c0); } }
        f32x4 acc[5][2];
#pragma unroll
        for (int q = 0; q < 5; ++q) { acc[q][0] = (f32x4){0.f, 0.f, 0.f, 0.f}; acc[q][1] = (f32x4){0.f, 0.f, 0.f, 0.f}; }
#pragma unroll
        for (int ks = 0; ks < 12; ++ks) { const int q = ks < 8 ? (ks >> 1) : 4; const bf16x8 xf = *(const LAS bf16x8*)(lin + fr * LINP + ks * 32 + 8 * fq);
            acc[q][0] = MFMA16(wf[ks][0], xf, acc[q][0]); acc[q][1] = MFMA16(wf[ks][1], xf, acc[q][1]); }
        float zk[2][4], kv[2][4]; float ss = 0.f;
#pragma unroll
        for (int nt = 0; nt < 2; ++nt) { unpack4(zk2[nt], zk[nt]);
#pragma unroll
            for (int i = 0; i < 4; ++i) { kv[nt][i] = zk[nt][i] * kkw[nt][i]; ss += kv[nt][i] * kv[nt][i]; } }
        ss += __shfl_xor(ss, 16); ss += __shfl_xor(ss, 32);
        if (fq == 0) ssum[w * 16 + fr] = ss;
        __syncthreads();
        const float inv = __builtin_amdgcn_rcpf(fmaxf(sqrtf(ssum[w * 16 + fr] + ssum[(w ^ 1) * 16 + fr]), 1e-12f));
        LAS bf16* th = tiles + (w >> 1) * 10 * 1024 + fr * 64 + 32 * (w & 1) + 4 * fq;
#pragma unroll
        for (int nt = 0; nt < 2; ++nt) { LAS bf16* t0 = th + 16 * nt;
            *(LAS u32x2*)(t0) = zr2[nt]; *(LAS u32x2*)(t0 + 1024) = zv2[nt];
            float kk[4];
#pragma unroll
            for (int i = 0; i < 4; ++i) kk[i] = kv[nt][i] * inv;
            *(LAS u32x2*)(t0 + 2 * 1024) = (u32x2){pk2(kk[0], kk[1]), pk2(kk[2], kk[3])};
            *(LAS u32x2*)(t0 + 3 * 1024) = (u32x2){pk2(acc[4][nt][0], acc[4][nt][1]), pk2(acc[4][nt][2], acc[4][nt][3])};
#pragma unroll
            for (int dn = 0; dn < 2; ++dn) { float ep[4], kd[4], bb[4];
#pragma unroll
                for (int i = 0; i < 4; ++i) { const float ew = fast_sigmoid(d0w[dn][nt][i] + acc[dn][nt][i]) * 0.6065306597126334f;
                    ep[i] = ew * (1.f + ew * (-0.5f + ew * (0.16666667f + ew * (-0.041666668f + ew * 0.0083333338f))));
                    const float a = fast_sigmoid(i0w[dn][nt][i] + acc[2 + dn][nt][i]); kd[i] = zk[nt][i] * (1.f + (a - 1.f) * kaw[nt][i]); bb[i] = kk[i] * a; }
                *(LAS u32x2*)(t0 + (4 + 3 * dn) * 1024) = (u32x2){pk2(ep[0], ep[1]), pk2(ep[2], ep[3])};
                *(LAS u32x2*)(t0 + (5 + 3 * dn) * 1024) = (u32x2){pk2(kd[0], kd[1]), pk2(kd[2], kd[3])};
                *(LAS u32x2*)(t0 + (6 + 3 * dn) * 1024) = (u32x2){pk2(bb[0], bb[1]), pk2(bb[2], bb[3])}; } }
        __syncthreads();
        {   const LAS bf16* src = tiles + (w >> 1) * 10 * 1024 + 8 * (w & 1) * 64 + lane * 8; bf16* dst = STR + ((size_t)tile * 8 + head) * 10240 + 8 * (w & 1) * 64 + lane * 8;
#pragma unroll
            for (int s = 0; s < 10; ++s) *(u32x4*)(dst + s * 1024) = *(const LAS u32x4*)(src + s * 1024); }
    }
#undef PREP_LOAD
}

__device__ __forceinline__ int scan_rowof(int s, int dir, int b) { if (s < CTXL) { const int tc = dir ? (CTXL - 1 - s) : s; return NLAT + b * CTXL + tc; } const int tt = s - CTXL; const int t = dir ? (SEQ - 1 - tt) : tt; return b * SEQ + t; }
__device__ __forceinline__ void readout_pass(const Frame& F0, int l, int nrows) {
    const Frame F = phase_frame(F0); unsigned char* const ws = F.ws;
    const bf16* STR = (const bf16*)(ws + WS_STR); const bf16* Y0 = (const bf16*)(ws + WS_Y); const bf16* Y1 = Y0 + (size_t)NROW * DR; bf16* MA = (bf16*)(ws + WS_H);
    const int lane = F.lane, c = 8 * lane;
    float gw[8], gb[8], rk[8];
    {   const float* gnw = inptr(I_GNW) + l * DR + c; const float* gnb = inptr(I_GNB) + l * DR + c; const float* rkp = inptr(I_RK) + l * DR + c;
        const f32x4 a0 = *(const f32x4*)gnw, a1 = *(const f32x4*)(gnw + 4), b0 = *(const f32x4*)gnb, b1 = *(const f32x4*)(gnb + 4), r0 = *(const f32x4*)rkp, r1 = *(const f32x4*)(rkp + 4);
#pragma unroll
        for (int i = 0; i < 4; ++i) { gw[i] = a0[i]; gw[4 + i] = a1[i]; gb[i] = b0[i]; gb[4 + i] = b1[i]; rk[i] = r0[i]; rk[4 + i] = r1[i]; } }
    for (int row0 = F.gw; row0 < nrows; row0 += 2 * F.NGW) {
        u32x4 q[2][7]; bool ok[2];
#pragma unroll
        for (int u = 0; u < 2; ++u) { const int row = row0 + u * F.NGW; ok[u] = row < nrows; if (ok[u]) {
            const bf16* sr = STR + ((size_t)(row >> 4) * 8 + (lane >> 3)) * 10240 + (row & 15) * 64 + (lane & 7) * 8;
            q[u][0] = *(const u32x4*)(Y0 + (size_t)row * DR + c); q[u][1] = *(const u32x4*)(Y1 + (size_t)row * DR + c);
            q[u][2] = *(const u32x4*)sr; q[u][3] = *(const u32x4*)(sr + 1024); q[u][4] = *(const u32x4*)(sr + 3072); q[u][5] = *(const u32x4*)(sr + 5 * 1024); q[u][6] = *(const u32x4*)(sr + 8 * 1024); } }
#pragma unroll
        for (int u = 0; u < 2; ++u) if (ok[u]) { const int row = row0 + u * F.NGW;
            float ya[8], yb[8], r[8], v[8], g[8], k0[8], k1[8];
            unpack8(q[u][0], ya); unpack8(q[u][1], yb); unpack8(q[u][2], r); unpack8(q[u][3], v); unpack8(q[u][4], g); unpack8(q[u][5], k0); unpack8(q[u][6], k1);
            float s1 = 0.f, s2 = 0.f, sb = 0.f;
#pragma unroll
            for (int i = 0; i < 8; ++i) { ya[i] += yb[i]; s1 += ya[i]; s2 += ya[i] * ya[i]; sb += r[i] * (k0[i] + k1[i]) * rk[i]; }
#pragma unroll
            for (int o = 1; o < 8; o <<= 1) { s1 += __shfl_xor(s1, o); s2 += __shfl_xor(s2, o); sb += __shfl_xor(sb, o); }
            const float mu = s1 * (1.f / 64.f); const float var = fmaxf(s2 * (1.f / 64.f) - mu * mu, 0.f); const float rs = rsqrtf(var + GN_EPS);
            float o8[8];
#pragma unroll
            for (int i = 0; i < 8; ++i) o8[i] = ((ya[i] - mu) * rs * gw[i] + gb[i] + sb * v[i]) * g[i];
            *(u32x4*)(MA + (size_t)row * D + c) = (u32x4){pk2(o8[0], o8[1]), pk2(o8[2], o8[3]), pk2(o8[4], o8[5]), pk2(o8[6], o8[7])}; }
    }
}
constexpr int BLOB = 16384, SEGCH = 132, NSEG = 4, BLOB_B1_SCANS = 14;
constexpr size_t WS_BLOBA = 20 * MiB, WS_BLOBB1 = 86 * MiB, WS_BLOBB2 = 492 * MiB;
constexpr size_t WS_SCANST = 2 * MiB + 512 * 1024;
__device__ __forceinline__ unsigned char* blob_ptr(unsigned char* ws, int seg, int scan, int ci) {
    if ((seg & 1) == 0) return ws + WS_BLOBA + ((size_t)scan * SEGCH + ci) * BLOB;
    return scan < BLOB_B1_SCANS ? ws + WS_BLOBB1 + ((size_t)scan * SEGCH + ci) * BLOB : ws + WS_BLOBB2 + ((size_t)(scan - BLOB_B1_SCANS) * SEGCH + ci) * BLOB;
}
typedef short s16x4 __attribute__((ext_vector_type(4)));
__device__ __forceinline__ bf16x8 frag_lo(u32x2 x) { u32x4 t = {x.x, x.y, 0u, 0u}; return __builtin_bit_cast(bf16x8, t); }
__device__ __forceinline__ bf16x8 frag_c(const f32x4& a) { u32x4 t = {pk2(a[0], a[1]), pk2(a[2], a[3]), 0u, 0u}; return __builtin_bit_cast(bf16x8, t); }

struct PreRegs { u32x4 q[12]; };
__device__ __forceinline__ void pre_load(PreRegs& R, unsigned char* ws, int scan, int cs, int lane) {
    const int dir = scan & 1, h = (scan >> 1) & 7, b = scan >> 4; const int rfirst = scan_rowof(16 * cs, dir, b);
    const bf16* blk = (const bf16*)(ws + WS_STR) + ((size_t)(rfirst >> 4) * 8 + h) * 10240 + lane * 8;
    const int so[6] = {0, 1, 2, 4 + 3 * dir, 5 + 3 * dir, 6 + 3 * dir};
#pragma unroll
    for (int i = 0; i < 6; ++i) { R.q[2 * i] = *(const u32x4*)(blk + so[i] * 1024); R.q[2 * i + 1] = *(const u32x4*)(blk + so[i] * 1024 + 512); }
}
template <int PM>
__device__ __forceinline__ void pre_item(const Frame& F, unsigned char* ws, int scan, int cs, unsigned char* blob, PreRegs& PR, int nscan, int ncs) {
    const int dir = scan & 1, h = (scan >> 1) & 7, b = scan >> 4; const int lane = F.lane, fr = lane & 15, fq = lane >> 4;
    LAS unsigned char* L = F.lds + F.wave * 17408;
    LAS bf16* TK = (LAS bf16*)L; LAS bf16* TR = TK + 1024; LAS bf16* TKt = TR + 1024; LAS bf16* TB = TKt + 1024;
    LAS bf16* KTt = TB + 1024; LAS bf16* RTt = KTt + 1024; LAS bf16* Vt = RTt + 1024;
    LAS float* AKB = (LAS float*)(Vt + 1024);
    LAS bf16* AKK = (LAS bf16*)(AKB + 256); LAS bf16* ARK = AKK + 256; LAS bf16* ARB = ARK + 256; LAS bf16* TT = ARB + 256;
    float kh[16], bh[16];
    float pc;
    {   float r_[16], v_[16], kk_[16], lp_[16], kd_[16], bb_[16];
        LAS bf16* stg = TK;
#pragma unroll
        for (int i = 0; i < 6; ++i) { *(LAS u32x4*)(stg + i * 1024 + lane * 8) = PR.q[2 * i]; *(LAS u32x4*)(stg + i * 1024 + 512 + lane * 8) = PR.q[2 * i + 1]; }
        LDS_WAIT(); asm volatile("" ::: "memory");
        if (nscan >= 0) pre_load(PR, ws, nscan, ncs, lane);
#pragma unroll
        for (int t = 0; t < 16; ++t) { const int tm = (dir ? 15 - t : t) * 64 + lane;
            r_[t] = bf2f(stg[tm]); v_[t] = bf2f(stg[1024 + tm]); kk_[t] = bf2f(stg[2048 + tm]); lp_[t] = bf2f(stg[3072 + tm]); kd_[t] = bf2f(stg[4096 + tm]); bb_[t] = bf2f(stg[5120 + tm]); }
        LDS_WAIT(); asm volatile("" ::: "memory");
        float pp = 1.f; u32x4 kt4[2], rt4[2], v4[2];
        unsigned ktp[8], rtp[8], vp[8];
#pragma unroll
        for (int t = 0; t < 16; ++t) { const float pm1 = pp; pp *= 1.f - lp_[t]; const float p = pp, ip = __builtin_amdgcn_rcpf(pp); lp_[t] = ip;
            const float kt = kk_[t] * pm1, ktl = kd_[t] * ip, btl = bb_[t] * ip, rt = r_[t] * p;
            const unsigned hk = pk2(kt, rt), hb = pk2(ktl, btl);
            TK[t * 64 + lane] = (bf16)(hk & 0xffffu); TR[t * 64 + lane] = (bf16)(hk >> 16); TKt[t * 64 + lane] = (bf16)(hb & 0xffffu); TB[t * 64 + lane] = (bf16)(hb >> 16);
            const unsigned hv = f2bf(v_[t]);
            if (t & 1) { ktp[t >> 1] |= hk << 16; rtp[t >> 1] |= hk & 0xffff0000u; vp[t >> 1] |= hv << 16; }
            else { ktp[t >> 1] = hk & 0xffffu; rtp[t >> 1] = hk >> 16; vp[t >> 1] = hv; } }
        kt4[0] = (u32x4){ktp[0], ktp[1], ktp[2], ktp[3]}; kt4[1] = (u32x4){ktp[4], ktp[5], ktp[6], ktp[7]};
        rt4[0] = (u32x4){rtp[0], rtp[1], rtp[2], rtp[3]}; rt4[1] = (u32x4){rtp[4], rtp[5], rtp[6], rtp[7]};
        v4[0] = (u32x4){vp[0], vp[1], vp[2], vp[3]}; v4[1] = (u32x4){vp[4], vp[5], vp[6], vp[7]};
        *(LAS u32x4*)(KTt + lane * 16) = kt4[0]; *(LAS u32x4*)(KTt + lane * 16 + 8) = kt4[1];
        *(LAS u32x4*)(RTt + lane * 16) = rt4[0]; *(LAS u32x4*)(RTt + lane * 16 + 8) = rt4[1];
        *(LAS u32x4*)(Vt + lane * 16) = v4[0]; *(LAS u32x4*)(Vt + lane * 16 + 8) = v4[1];
        pc = pp;
#pragma unroll
        for (int t = 0; t < 16; ++t) { const float e = pp * lp_[t]; kh[t] = kd_[t] * e; bh[t] = bb_[t] * e; }
    }
    LDS_WAIT(); asm volatile("" ::: "memory");
    {   f32x4 akb = {0.f, 0.f, 0.f, 0.f}, akk = akb, ark = akb, arb = akb;
#pragma unroll
        for (int s = 0; s < 2; ++s) { const int o = fr * 64 + 32 * s + 8 * fq;
            const bf16x8 fk = *(const LAS bf16x8*)(TK + o), frr = *(const LAS bf16x8*)(TR + o), fkt = *(const LAS bf16x8*)(TKt + o), fb = *(const LAS bf16x8*)(TB + o);
            akb = MFMA16(fk, fb, akb); akk = MFMA16(fk, fkt, akk); ark = MFMA16(frr, fkt, ark); arb = MFMA16(frr, fb, arb); }
        float nm[4];
#pragma unroll
        for (int reg = 0; reg < 4; ++reg) { const int t = 4 * fq + reg; const bool lo = fr < t, le = fr <= t;
            nm[reg] = lo ? akb[reg] : 0.f; AKK[t * 16 + fr] = (bf16)f2bf(lo ? akk[reg] : 0.f);
            ARK[t * 16 + fr] = (bf16)f2bf(le ? ark[reg] : 0.f); ARB[t * 16 + fr] = (bf16)f2bf(le ? arb[reg] : 0.f); }
        float col[16];
#pragma unroll
        for (int t = 0; t < 16; ++t) { float s_ = (t == fr) ? 1.f : 0.f;
#pragma unroll
            for (int i = 0; i < 16; ++i) if (i < t) { const float n_ti = __builtin_bit_cast(float, __builtin_amdgcn_readlane(__builtin_bit_cast(int, nm[t & 3]), i + 16 * (t >> 2))); s_ -= n_ti * col[i]; }
            col[t] = s_; TT[t * 16 + fr] = (bf16)f2bf(s_); }
    }
    LDS_WAIT(); asm volatile("" ::: "memory");
    f32x4 WTc[4], RqT[4], U0c[4], Y0c[4];
    {   const bf16x8 aT = frag_lo(*(const LAS u32x2*)(TT + fr * 16 + 4 * fq)), aKK = frag_lo(*(const LAS u32x2*)(AKK + fr * 16 + 4 * fq)), aRK = frag_lo(*(const LAS u32x2*)(ARK + fr * 16 + 4 * fq));
        u32x2 nb = *(const LAS u32x2*)(ARB + fr * 16 + 4 * fq); nb.x ^= 0x80008000u; nb.y ^= 0x80008000u; const bf16x8 aRBn = frag_lo(nb);
        const f32x4 z4 = {0.f, 0.f, 0.f, 0.f};
#pragma unroll
        for (int nt = 0; nt < 4; ++nt) { const int o = (16 * nt + fr) * 16 + 4 * fq;
            const bf16x8 bK = frag_lo(*(const LAS u32x2*)(KTt + o)), bV = frag_lo(*(const LAS u32x2*)(Vt + o));
            float ri[4]; unpack4(*(const LAS u32x2*)(TR + fr * 64 + 16 * nt + 4 * fq), ri);
            const f32x4 Wn = MFMA16(aT, bK, z4); WTc[nt] = MFMA16(bK, aT, z4);
            const f32x4 Zn = MFMA16(aKK, bV, z4);
            U0c[nt] = MFMA16(aT, frag_c(Zn), z4);
            RqT[nt] = MFMA16(frag_c(Wn), aRBn, ((f32x4){ri[0], ri[1], ri[2], ri[3]}));
            Y0c[nt] = MFMA16(aRK, bV, z4); Y0c[nt] = MFMA16(aRBn, frag_c(U0c[nt]), Y0c[nt]); }
    }
    LDS_WAIT(); asm volatile("" ::: "memory");
#pragma unroll
    for (int nt = 0; nt < 4; ++nt) { const u32x2 vv = *(const LAS u32x2*)(Vt + (16 * nt + fr) * 16 + 4 * fq);
        *(u32x2*)(blob + 8192 + nt * 2048 + 1024 + lane * 8) = vv;
        u32x2 u0 = {pk2(U0c[nt][0], U0c[nt][1]), pk2(U0c[nt][2], U0c[nt][3])}, y0 = {pk2(Y0c[nt][0], Y0c[nt][1]), pk2(Y0c[nt][2], Y0c[nt][3])};
        *(u32x2*)(blob + 8192 + nt * 2048 + lane * 8) = u0; *(u32x2*)(blob + 8192 + nt * 2048 + 512 + lane * 8) = y0;
        *(float*)(blob + 8192 + nt * 2048 + 1536 + lane * 4) = pc; }
#pragma unroll
    for (int s = 0; s < 2; ++s) {
        *(u32x4*)(blob + (0 * 2 + s) * 1024 + lane * 16) = (u32x4){pk2(WTc[2 * s][0], WTc[2 * s][1]), pk2(WTc[2 * s][2], WTc[2 * s][3]), pk2(WTc[2 * s + 1][0], WTc[2 * s + 1][1]), pk2(WTc[2 * s + 1][2], WTc[2 * s + 1][3])};
        *(u32x4*)(blob + (1 * 2 + s) * 1024 + lane * 16) = (u32x4){pk2(RqT[2 * s][0], RqT[2 * s][1]), pk2(RqT[2 * s][2], RqT[2 * s][3]), pk2(RqT[2 * s + 1][0], RqT[2 * s + 1][1]), pk2(RqT[2 * s + 1][2], RqT[2 * s + 1][3])}; }
    LAS bf16* BHt = TKt; LAS bf16* KHt = TB;
    {   u32x4 a, c, d, e;
        a = (u32x4){pk2(bh[0], bh[1]), pk2(bh[2], bh[3]), pk2(bh[4], bh[5]), pk2(bh[6], bh[7])}; c = (u32x4){pk2(bh[8], bh[9]), pk2(bh[10], bh[11]), pk2(bh[12], bh[13]), pk2(bh[14], bh[15])};
        d = (u32x4){pk2(kh[0], kh[1]), pk2(kh[2], kh[3]), pk2(kh[4], kh[5]), pk2(kh[6], kh[7])}; e = (u32x4){pk2(kh[8], kh[9]), pk2(kh[10], kh[11]), pk2(kh[12], kh[13]), pk2(kh[14], kh[15])};
        *(LAS u32x4*)(BHt + lane * 16) = a; *(LAS u32x4*)(BHt + lane * 16 + 8) = c; *(LAS u32x4*)(KHt + lane * 16) = d; *(LAS u32x4*)(KHt + lane * 16 + 8) = e; }
    LDS_WAIT(); asm volatile("" ::: "memory");
#pragma unroll
    for (int mt = 0; mt < 4; ++mt) { const int o = (16 * mt + fr) * 16 + 4 * fq; const u32x2 bb = *(const LAS u32x2*)(BHt + o), kk = *(const LAS u32x2*)(KHt + o);
        *(u32x4*)(blob + 4096 + mt * 1024 + lane * 16) = (u32x4){bb.x ^ 0x80008000u, bb.y ^ 0x80008000u, kk.x, kk.y}; }
    LDS_WAIT(); asm volatile("" ::: "memory");
}

__device__ __forceinline__ void pre_phase(const Frame& F0, int seg, int b_lo) {
    const Frame F = phase_frame(F0); unsigned char* const ws = F.ws;
    if ((int)blockIdx.x < b_lo) return;
    const int nwv = (F.G - b_lo) * NWAVES;
    PreRegs R;
    int it = ((int)blockIdx.x - b_lo) * NWAVES + F.wave; if (it >= 32 * SEGCH) return;
    pre_load(R, ws, it & 31, seg * SEGCH + (it >> 5), F.lane);
    for (; it < 32 * SEGCH; it += nwv) { const int nx = it + nwv; const bool hn = nx < 32 * SEGCH;
        pre_item<0>(F, ws, it & 31, seg * SEGCH + (it >> 5), blob_ptr(ws, seg, it & 31, it >> 5), R, hn ? (nx & 31) : -1, seg * SEGCH + (nx >> 5)); }
}

constexpr int SQ_SLOT = 10240, SQ_R = 12, SQ_D = 8;
template <int MODE>
__device__ __forceinline__ void seq_item(const Frame& F0, int item, int seg, bool need_ctx) {
    const Frame F = phase_frame(F0); unsigned char* const ws = F.ws;
    const int scan = item >> 2, vb = item & 3, dir = scan & 1, h = (scan >> 1) & 7, b = scan >> 4; const int lane = F.lane, fr = lane & 15, fq = lane >> 4, w = F.wave;
    const unsigned char* blob = blob_ptr(ws, seg, scan, 0);
    LAS unsigned char* ring = F.lds;
    __syncthreads();
    const int p0 = 2 * (w - 1);
    const unsigned goff0 = (p0 < 8 ? p0 * 1024 : 8192 + vb * 2048 + (p0 - 8) * 1024) + lane * 16, goff1 = (p0 + 1 < 8 ? (p0 + 1) * 1024 : 8192 + vb * 2048 + (p0 + 1 - 8) * 1024) + lane * 16;
#define SQ_ISSUE(c) do { const unsigned char* g_ = blob + (size_t)(c) * BLOB; LAS unsigned char* s_ = ring + ((c) % SQ_R) * SQ_SLOT + p0 * 1024; \
        __builtin_amdgcn_global_load_lds((const unsigned*)(g_ + goff0), (LAS unsigned*)(s_), 16, 0, 0); \
        __builtin_amdgcn_global_load_lds((const unsigned*)(g_ + goff1), (LAS unsigned*)(s_ + 1024), 16, 0, 0); } while (0)
    const bool loader = (w >= 1 && w <= 5) && MODE != 2;
    if (loader) { for (int c = 0; c < SQ_D; ++c) SQ_ISSUE(c); }
    bf16* Y = (bf16*)(ws + WS_Y) + (size_t)dir * NROW * DR + h * 64 + 16 * vb + fr;
    float* st = (float*)(ws + WS_SCANST) + (size_t)item * 1024 + lane * 4;
    f32x4 M[4];
#pragma unroll
    for (int mt = 0; mt < 4; ++mt) M[mt] = (seg == 0 || w != 0) ? (f32x4){0.f, 0.f, 0.f, 0.f} : *(const f32x4*)(st + mt * 256);
    const f32x4 z4 = {0.f, 0.f, 0.f, 0.f};
    LAS unsigned char* mb = ring + SQ_R * SQ_SLOT;
    struct SQ { bf16x8 a1[2], a2[4]; f32x4 pc[4]; u32x2 u0, vv; };
#define SQ_READ(R, c) do { const LAS unsigned char* sl_ = ring + ((c) % SQ_R) * SQ_SLOT; _Pragma("unroll") for (int i = 0; i < 4; ++i) { \
        R.a2[i] = *(const LAS bf16x8*)(sl_ + 4096 + i * 1024 + lane * 16); R.pc[i] = *(const LAS f32x4*)(sl_ + 8192 + 1536 + (16 * i + 4 * fq) * 4); } \
        R.a1[0] = *(const LAS bf16x8*)(sl_ + lane * 16); R.a1[1] = *(const LAS bf16x8*)(sl_ + 1024 + lane * 16); \
        R.u0 = *(const LAS u32x2*)(sl_ + 8192 + lane * 8); R.vv = *(const LAS u32x2*)(sl_ + 8192 + 1024 + lane * 8); } while (0)
#define SQ_STEP(R, c, RN, cn) do { \
        if ((cn) < SEGCH) SQ_READ(RN, cn); \
        const u32x4 t0 = {pk2(M[0][0], M[0][1]), pk2(M[0][2], M[0][3]), pk2(M[1][0], M[1][1]), pk2(M[1][2], M[1][3])}; \
        const u32x4 t1 = {pk2(M[2][0], M[2][1]), pk2(M[2][2], M[2][3]), pk2(M[3][0], M[3][1]), pk2(M[3][2], M[3][3])}; \
        *(LAS u32x4*)(mb + ((c) & 1) * 2048 + lane * 16) = t0; *(LAS u32x4*)(mb + ((c) & 1) * 2048 + 1024 + lane * 16) = t1; \
        const bf16x8 b0 = __builtin_bit_cast(bf16x8, t0), b1 = __builtin_bit_cast(bf16x8, t1); \
        f32x4 X0 = MFMA16(R.a1[0], b0, z4); X0 = MFMA16(R.a1[1], b1, X0); \
        float u0[4]; unpack4(R.u0, u0); \
        const u32x4 tb = {pk2(X0[0] + u0[0], X0[1] + u0[1]), pk2(X0[2] + u0[2], X0[3] + u0[3]), R.vv.x, R.vv.y}; const bf16x8 bB = __builtin_bit_cast(bf16x8, tb); \
        _Pragma("unroll") for (int mt = 0; mt < 4; ++mt) M[mt] = MFMA16(R.a2[mt], bB, R.pc[mt] * M[mt]); \
        asm volatile("s_waitcnt lgkmcnt(0)" ::: "memory"); } while (0)
    const long ystep = dir ? -(long)DR : (long)DR;
#define SQ_YSTEP(c) do { const int cs_ = seg * SEGCH + (c); if (MODE == 0 && (need_ctx || cs_ >= 16)) { const LAS unsigned char* sl_ = ring + ((c) % SQ_R) * SQ_SLOT; \
        const bf16x8 q0 = *(const LAS bf16x8*)(sl_ + 2048 + lane * 16), q1 = *(const LAS bf16x8*)(sl_ + 3072 + lane * 16); \
        const bf16x8 b0 = *(const LAS bf16x8*)(mb + ((c) & 1) * 2048 + lane * 16), b1 = *(const LAS bf16x8*)(mb + ((c) & 1) * 2048 + 1024 + lane * 16); \
        float y0[4]; unpack4(*(const LAS u32x2*)(sl_ + 8192 + 512 + lane * 8), y0); \
        f32x4 X1 = MFMA16(q0, b0, z4); X1 = MFMA16(q1, b1, X1); \
        bf16* yp = Y + (size_t)scan_rowof(16 * cs_ + 4 * fq, dir, b) * DR; \
        yp[0] = (bf16)f2bf(X1[0] + y0[0]); yp[ystep] = (bf16)f2bf(X1[1] + y0[1]); yp[2 * ystep] = (bf16)f2bf(X1[2] + y0[2]); yp[3 * ystep] = (bf16)f2bf(X1[3] + y0[3]); \
        asm volatile("s_waitcnt lgkmcnt(0)" ::: "memory"); } } while (0)
#define SQ_LOADER(c) do { if (loader) { __builtin_amdgcn_s_sleep(3); if ((c) + SQ_D < SEGCH) { SQ_ISSUE((c) + SQ_D); asm volatile("s_waitcnt vmcnt(12)" ::: "memory"); } else asm volatile("s_waitcnt vmcnt(0)" ::: "memory"); } \
        __builtin_amdgcn_s_barrier(); asm volatile("" ::: "memory"); } while (0)
    const bool stw = (w == 0 && MODE != 1), yw = (w == 6 && MODE != 1);
    SQ Ra, Rb, Rc;
    SQ_LOADER(0);
    if (stw) { SQ_READ(Ra, 0); SQ_READ(Rb, 1); }
    for (int c = 0; c < SEGCH; c += 3) {
        SQ_LOADER(c + 1);
        if (stw) SQ_STEP(Ra, c, Rc, c + 2);
        if (yw && c > 0) SQ_YSTEP(c - 1);
        SQ_LOADER(c + 2);
        if (stw) SQ_STEP(Rb, c + 1, Ra, c + 3);
        if (yw) SQ_YSTEP(c);
        SQ_LOADER(c + 3);
        if (stw) SQ_STEP(Rc, c + 2, Rb, c + 4);
        if (yw) SQ_YSTEP(c + 1);
    }
    __builtin_amdgcn_s_barrier(); asm volatile("" ::: "memory");
    if (yw) SQ_YSTEP(SEGCH - 1);
#undef SQ_READ
#undef SQ_STEP
#undef SQ_YSTEP
#undef SQ_LOADER
#undef SQ_ISSUE
    if (MODE >= 2 && w == 0 && M[0][0] + M[1][1] + M[2][2] + M[3][3] == 12345.678f) st[0] = M[0][0];
    if (MODE == 0 && w == 0 && seg + 1 < NSEG) {
#pragma unroll
        for (int mt = 0; mt < 4; ++mt) *(f32x4*)(st + mt * 256) = M[mt]; }
    __syncthreads();
}

namespace pg8 {
struct EpiStoreBf16 {
    static constexpr bool PERM = true, AFTER_DRAIN = false;
    bf16_t* O; int ldc; int pn_mask;
    __device__ __forceinline__ void operator()(const f32x4 (&acc)[2][2][4][2], const Unit& u, int wr, int wc, int fr, int fq) const {
        const int row0 = u.pm * BM + wr * 64 + fr; const int col0 = (u.pn & pn_mask) * BM + wc * 32 + 8 * fq;
#pragma unroll
        for (int ai = 0; ai < 2; ++ai)
#pragma unroll
            for (int m = 0; m < 4; ++m) { bf16_t* rowp = O + (size_t)(row0 + ai * HALF + m * 16) * ldc + col0;
#pragma unroll
                for (int bj = 0; bj < 2; ++bj) { const f32x4 v0 = acc[ai][bj][m][0], v1 = acc[ai][bj][m][1];
                    u32x4 w; w.x = cvt_pk_bf16(v0[0], v0[1]); w.y = cvt_pk_bf16(v0[2], v0[3]); w.z = cvt_pk_bf16(v1[0], v1[1]); w.w = cvt_pk_bf16(v1[2], v1[3]);
                    *(u32x4*)(rowp + bj * HALF) = w; } }
    }
};
struct EpiSwiGLU {
    static constexpr bool PERM = true, AFTER_DRAIN = false;
    bf16_t* O;
    __device__ __forceinline__ void operator()(const f32x4 (&acc)[2][2][4][2], const Unit& u, int wr, int wc, int fr, int fq) const {
        const int row0 = u.pm * BM + wr * 64 + fr; const int col0 = ((u.pn & 3) * BM + wc * 32 + 8 * fq) >> 1;
#pragma unroll
        for (int ai = 0; ai < 2; ++ai)
#pragma unroll
            for (int m = 0; m < 4; ++m) { bf16_t* rowp = O + (size_t)(row0 + ai * HALF + m * 16) * 512 + col0;
#pragma unroll
                for (int bj = 0; bj < 2; ++bj) { const f32x4 g = acc[ai][bj][m][0], up = acc[ai][bj][m][1]; float a[4];
#pragma unroll
                    for (int i = 0; i < 4; ++i) a[i] = g[i] / (1.f + __expf(-g[i])) * up[i];
                    unsigned long long w = (unsigned long long)cvt_pk_bf16(a[0], a[1]) | ((unsigned long long)cvt_pk_bf16(a[2], a[3]) << 32);
                    *(unsigned long long*)(rowp + bj * (HALF / 2)) = w; } }
    }
};
template <bool XF32> struct EpiResidual {
    static constexpr bool PERM = false, AFTER_DRAIN = false;
    const void* xlat; const void* xctx;
    bf16_t* out; const float* g1;
    __device__ __forceinline__ void operator()(const f32x4 (&acc)[2][2][4][2], const Unit& u, int wr, int wc, int fr, int fq) const {
        const int rowt = u.pm * BM; const int mr = rowt < 16384 ? (rowt >> 13) : 2;
        const size_t boff = rowt < 16384 ? (size_t)rowt * 1024 : (size_t)(rowt - 16384) * 1024; const void* bp = rowt < 16384 ? xlat : xctx;
        const int col0 = u.pn * BM + wc * 32 + 4 * fq;
        f32x4 gv[2][2];
#pragma unroll
        for (int bj = 0; bj < 2; ++bj)
#pragma unroll
            for (int n = 0; n < 2; ++n) gv[bj][n] = *(const f32x4*)(g1 + (size_t)mr * 6144 + col0 + bj * HALF + n * 16);
#pragma unroll
        for (int ai = 0; ai < 2; ++ai)
#pragma unroll
            for (int m = 0; m < 4; ++m) { const int rl = ai * HALF + wr * 64 + m * 16 + fr;
#pragma unroll
                for (int bj = 0; bj < 2; ++bj)
#pragma unroll
                    for (int n = 0; n < 2; ++n) { const size_t off = (size_t)rl * 1024 + col0 + bj * HALF + n * 16;
                        f32x4 xo;
                        if (XF32) xo = *(const f32x4*)((const float*)bp + boff + off);
                        else { const unsigned long long w_ = *(const unsigned long long*)((const bf16_t*)bp + boff + off); const unsigned lo = (unsigned)w_, hi = (unsigned)(w_ >> 32);
                            xo = (f32x4){__uint_as_float(lo << 16), __uint_as_float(lo & 0xffff0000u), __uint_as_float(hi << 16), __uint_as_float(hi & 0xffff0000u)}; }
                        const f32x4 r = xo + gv[bj][n] * acc[ai][bj][m][n];
                        *(unsigned long long*)(out + (size_t)rowt * 1024 + off) = (unsigned long long)cvt_pk_bf16(r[0], r[1]) | ((unsigned long long)cvt_pk_bf16(r[2], r[3]) << 32); } }
    }
};
struct MoeOrder {
    const int* tile_e; int ntiles, G, c;
    __device__ bool next(int i, Unit& u) const { const long L = (long)i * G + c; if (L >= 4L * ntiles) return false; const int pm = (int)(L >> 2); u.pm = pm; u.pn = tile_e[pm] * 4 + (int)(L & 3); return true; }
    __device__ __forceinline__ void a_ready(const Unit&) const {}
    __device__ __forceinline__ void done(const Unit&) const {}
};
}

__device__ __forceinline__ void expert_convert(const Frame& F0, int l, int b_lo) {
    const Frame F = phase_frame(F0); unsigned char* const ws = F.ws;
    if ((int)blockIdx.x < b_lo) return;
    const int nwv = (F.G - b_lo) * NWAVES, myw = ((int)blockIdx.x - b_lo) * NWAVES + F.wave;
    LAS float* scr = (LAS float*)(F.lds + F.wave * 16384);
    bf16* wgu = (bf16*)(ws + WS_WGU_T); bf16* wd = (bf16*)(ws + WS_WD_T);
    constexpr int I_G = 16 * 16, I_D = 8 * 32;
    constexpr int NIT = NEXP * (2 * I_G + I_D);
    const float* p_eg = inptr(I_EG); const float* p_eu = inptr(I_EU); const float* p_ed = inptr(I_ED);
    for (int it = myw; it < NIT; it += nwv) { const int e = it / (2 * I_G + I_D); int r = it % (2 * I_G + I_D);
        if (r < I_G) { transpose_item(p_eg + ((size_t)l * NEXP + e) * D * DEXP, DEXP, (r >> 4) * 64, (r & 15) * 32, wgu, D, RmGU{e * 1024}, scr, F.lane); continue; } r -= I_G;
        if (r < I_G) { transpose_item(p_eu + ((size_t)l * NEXP + e) * D * DEXP, DEXP, (r >> 4) * 64, (r & 15) * 32, wgu, D, RmGU{e * 1024 + 4}, scr, F.lane); continue; } r -= I_G;
        transpose_item(p_ed + ((size_t)l * NEXP + e) * DEXP * D, D, (r >> 5) * 64, (r & 31) * 32, wd, DEXP, RmId{e * 1024}, scr, F.lane);
    }
}

__device__ __forceinline__ void router_pass(const Frame& F0, int l, int nrows, int cnt_off = 0) {
    const Frame F = phase_frame(F0); unsigned char* const ws = F.ws;
    constexpr int HP = 1028;
    LAS float* msh = (LAS float*)F.lds; LAS float* msc = msh + 3072; LAS float* hrow = msc + 3072;
    LAS float* part = hrow + 16 * HP;
    LAS float* lgs = part + 8 * 16 * 48;
    LAS unsigned* lcnt = (LAS unsigned*)(lgs + 16 * 40);
    if (F0.tid < 64) lcnt[F0.tid] = 0u;
    __syncthreads();
    mod_to_lds(F, l, 3, msh, false); mod_to_lds(F, l, 4, msc, false); __syncthreads();
    const bf16* X = (const bf16*)(ws + WS_X); bf16* H = (bf16*)(ws + WS_H);
    const float* rgw = inptr(I_RGW) + (size_t)l * D * 4; const float* rew = inptr(I_REW) + (size_t)l * D * NEXP;
    const float* rgb = inptr(I_RGB) + l * 4; const float* reb = inptr(I_REB) + l * NEXP;
    int* rt_e = (int*)(ws + WS_ROUTE + RT_E); int* rt_pos = (int*)(ws + WS_ROUTE + RT_POS); float* rt_gate = (float*)(ws + WS_ROUTE + RT_GATE);
    unsigned* cnt = (unsigned*)(ws + WS_CTL) + CW_CNT + 64 * l + cnt_off;
    const int lane = F.lane, w = F.wave, fr = lane & 15, fq = lane >> 4; const float* n2g = inptr(I_N2G) + l * D;
    float bw[32][3];
#pragma unroll
    for (int ks = 0; ks < 32; ++ks) { const int k = 128 * w + 4 * ks + fq;
        bw[ks][0] = rew[(size_t)k * 32 + fr]; bw[ks][1] = rew[(size_t)k * 32 + 16 + fr]; bw[ks][2] = fr < 4 ? rgw[(size_t)k * 4 + fr] : 0.f; }
    const int ntiles = nrows >> 4;
    u32x2 pv[2][4];
    if (F.vcu < ntiles) {
#pragma unroll
        for (int rr = 0; rr < 2; ++rr)
#pragma unroll
            for (int j = 0; j < 4; ++j) pv[rr][j] = *(const u32x2*)(X + (size_t)(F.vcu * 16 + 2 * w + rr) * D + 4 * lane + 256 * j); }
    for (int gi = F.vcu; gi < ntiles; gi += F.G) {
#pragma unroll
        for (int rr = 0; rr < 2; ++rr) { const int r = 2 * w + rr, row = gi * 16 + r; f32x4 v[4];
#pragma unroll
            for (int j = 0; j < 4; ++j) { float t_[4]; unpack4(pv[rr][j], t_); v[j] = (f32x4){t_[0], t_[1], t_[2], t_[3]}; }
            const int mr = modrow(row);
            norm_mod_row(v, n2g, msc + mr * 1024, msh + mr * 1024, H + (size_t)row * D, lane);
#pragma unroll
            for (int j = 0; j < 4; ++j) *(LAS f32x4*)(hrow + r * HP + 4 * lane + 256 * j) = v[j]; }
        if (gi + F.G < ntiles) {
#pragma unroll
            for (int rr = 0; rr < 2; ++rr)
#pragma unroll
                for (int j = 0; j < 4; ++j) pv[rr][j] = *(const u32x2*)(X + (size_t)((gi + F.G) * 16 + 2 * w + rr) * D + 4 * lane + 256 * j); }
        __syncthreads();
        {   f32x4 acc[3] = {{0.f, 0.f, 0.f, 0.f}, {0.f, 0.f, 0.f, 0.f}, {0.f, 0.f, 0.f, 0.f}};
#pragma unroll
            for (int ks = 0; ks < 32; ++ks) { const float a = hrow[fr * HP + 128 * w + 4 * ks + fq];
#pragma unroll
                for (int nt = 0; nt < 3; ++nt) acc[nt] = __builtin_amdgcn_mfma_f32_16x16x4f32(a, bw[ks][nt], acc[nt], 0, 0, 0); }
#pragma unroll
            for (int nt = 0; nt < 3; ++nt)
#pragma unroll
                for (int reg = 0; reg < 4; ++reg) part[(w * 16 + 4 * fq + reg) * 48 + 16 * nt + fr] = acc[nt][reg]; }
        __syncthreads();
        for (int idx = F.tid; idx < 16 * 36; idx += NTHR) { const int r = idx / 36, n = idx % 36; float s_ = 0.f;
#pragma unroll
            for (int ww = 0; ww < 8; ++ww) s_ += part[(ww * 16 + r) * 48 + n];
            if (n < 32) lgs[r * 40 + 4 + n] = s_ + reb[n]; else lgs[r * 40 + n - 32] = s_ + rgb[n - 32]; }
        __syncthreads();
        if (F.tid < 16) { const int rr = gi * 16 + F.tid; const LAS float* lp = lgs + F.tid * 40;
            int grp = 0; float mx = lp[0];
#pragma unroll
            for (int g = 1; g < 4; ++g) if (lp[g] > mx) { mx = lp[g]; grp = g; }
            float den = 0.f;
#pragma unroll
            for (int g = 0; g < 4; ++g) den += __expf(lp[g] - mx);
            const float pg_top = 1.f / den; const LAS float* sel = lp + 4 + grp * 8;
            int i0 = 0; float l0 = sel[0];
#pragma unroll
            for (int q = 1; q < 8; ++q) if (sel[q] > l0) { l0 = sel[q]; i0 = q; }
            int i1 = -1; float l1 = -3.0e38f;
#pragma unroll
            for (int q = 0; q < 8; ++q) if (q != i0 && sel[q] > l1) { l1 = sel[q]; i1 = q; }
            const float e1 = __expf(l1 - l0); const float w0 = pg_top / (1.f + e1), w1 = pg_top * e1 / (1.f + e1);
            const int ea = grp * 8 + i0, eb = grp * 8 + i1;
            const unsigned pa = atomicAdd((unsigned*)(lcnt + ea), 1u), pb = atomicAdd((unsigned*)(lcnt + eb), 1u);
            rt_e[2 * rr] = ea; rt_e[2 * rr + 1] = eb; rt_pos[2 * rr] = (int)pa; rt_pos[2 * rr + 1] = (int)pb; rt_gate[2 * rr] = w0; rt_gate[2 * rr + 1] = w1; }
    }
    __syncthreads();
    if (F.tid < 32) lcnt[32 + F.tid] = lcnt[F.tid] ? atomicAdd(cnt + F.tid, lcnt[F.tid]) : 0u;
    __syncthreads();
    if (F.tid < 16) for (int gi = F.vcu; gi < ntiles; gi += F.G) { const int rr = gi * 16 + F.tid;
        rt_pos[2 * rr] += (int)lcnt[32 + rt_e[2 * rr]]; rt_pos[2 * rr + 1] += (int)lcnt[32 + rt_e[2 * rr + 1]]; }
}

__device__ __forceinline__ void gather_pass(const Frame& F0, int l, int nrows) {
    const Frame F = phase_frame(F0); unsigned char* const ws = F.ws;
    LAS int* off = (LAS int*)F.lds;
    const unsigned* cnt = (const unsigned*)(ws + WS_CTL) + CW_CNT + 64 * l;
    int* tile_e = (int*)(ws + WS_ROUTE + RT_TILE); int* ntl = (int*)(ws + WS_ROUTE + RT_NT);
    __syncthreads();
    if (F.tid < NEXP) off[32 + F.tid] = (int)__hip_atomic_load(cnt + F.tid, __ATOMIC_RELAXED, __HIP_MEMORY_SCOPE_AGENT);
    __syncthreads();
    if (F.tid == 0) { int o = 0;
#pragma nounroll
        for (int e = 0; e < NEXP; ++e) { const int c = off[32 + e]; const int nt = (c + 255) >> 8; off[e] = o;
            if (blockIdx.x == 0) {
#pragma nounroll
                for (int t = 0; t < nt; ++t) tile_e[(o >> 8) + t] = e; }
            o += nt << 8; }
        if (blockIdx.x == 0) ntl[0] = o >> 8; }
    __syncthreads();
    const int* rt_e = (const int*)(ws + WS_ROUTE + RT_E); const int* rt_pos = (const int*)(ws + WS_ROUTE + RT_POS); int* rt_slot = (int*)(ws + WS_ROUTE + RT_SLOT);
    const bf16* H = (const bf16*)(ws + WS_H); bf16* Xs = (bf16*)(ws + WS_XS);
    for (int it0 = F.gw * 4; it0 < 2 * nrows; it0 += F.NGW * 4) { int slot[4]; u32x4 a[4], b2[4];
#pragma unroll
        for (int u = 0; u < 4; ++u) { const int it = it0 + u; slot[u] = it < 2 * nrows ? off[rt_e[it]] + rt_pos[it] : -1; }
#pragma unroll
        for (int u = 0; u < 4; ++u) if (slot[u] >= 0) { const u32x4* s = (const u32x4*)(H + (size_t)((it0 + u) >> 1) * D); a[u] = s[F.lane]; b2[u] = s[64 + F.lane]; }
#pragma unroll
        for (int u = 0; u < 4; ++u) if (slot[u] >= 0) { if (F.lane == 0) rt_slot[it0 + u] = slot[u]; u32x4* d = (u32x4*)(Xs + (size_t)slot[u] * D); d[F.lane] = a[u]; d[64 + F.lane] = b2[u]; }
    }
}

template <bool DRY>
__device__ __forceinline__ void combine_pass(const Frame& F0, int l, int nrows) {
    const Frame F = phase_frame(F0); unsigned char* const ws = F.ws;
    LAS float* mg2 = (LAS float*)F.lds; LAS float* msh = mg2 + 3072; LAS float* msc = msh + 3072;
    const bool last = (l == DEPTH - 1);
    __syncthreads();
    mod_to_lds(F, l, 5, mg2, false); if (!last) { mod_to_lds(F, l + 1, 0, msh, false); mod_to_lds(F, l + 1, 1, msc, false); }
    __syncthreads();
    bf16* X = (bf16*)(ws + WS_X); bf16* H = (bf16*)(ws + WS_H); const bf16* Ys = (const bf16*)(ws + WS_XS);
    const int* rt_slot = (const int*)(ws + WS_ROUTE + RT_SLOT); const float* rt_gate = (const float*)(ws + WS_ROUTE + RT_GATE);
    const int lane = F.lane; const float* n1g = inptr(I_N1G) + (last ? 0 : (l + 1) * D); const float* fgp = inptr(I_FG);
    for (int row0 = F.gw; row0 < nrows; row0 += 2 * F.NGW) {
        int s0[2], s1[2]; float w0[2], w1[2]; bool ok[2]; u32x2 ya[2][4], yb[2][4], xo[2][4];
#pragma unroll
        for (int u = 0; u < 2; ++u) { const int row = row0 + u * F.NGW; ok[u] = row < nrows; if (ok[u]) { s0[u] = rt_slot[2 * row]; s1[u] = rt_slot[2 * row + 1]; w0[u] = rt_gate[2 * row]; w1[u] = rt_gate[2 * row + 1]; } }
#pragma unroll
        for (int u = 0; u < 2; ++u) if (ok[u]) { const int row = row0 + u * F.NGW;
#pragma unroll
            for (int j = 0; j < 4; ++j) { const int c = 4 * lane + 256 * j; ya[u][j] = *(const u32x2*)(Ys + (size_t)s0[u] * D + c); yb[u][j] = *(const u32x2*)(Ys + (size_t)s1[u] * D + c); xo[u][j] = *(const u32x2*)(X + (size_t)row * D + c); } }
#pragma unroll
        for (int u = 0; u < 2; ++u) if (ok[u]) { const int row = row0 + u * F.NGW; const int mr = modrow(row); f32x4 v[4];
#pragma unroll
            for (int j = 0; j < 4; ++j) { const int c = 4 * lane + 256 * j; float a[4], b[4]; unpack4(ya[u][j], a); unpack4(yb[u][j], b);
                const f32x4 g2 = *(const LAS f32x4*)(mg2 + mr * 1024 + c);
                f32x4 y; y.x = w0[u] * a[0] + w1[u] * b[0]; y.y = w0[u] * a[1] + w1[u] * b[1]; y.z = w0[u] * a[2] + w1[u] * b[2]; y.w = w0[u] * a[3] + w1[u] * b[3];
                float x_[4]; unpack4(xo[u][j], x_); v[j] = (f32x4){x_[0], x_[1], x_[2], x_[3]} + g2 * y; }
            if (DRY) { asm volatile("" :: "v"(v[0].x + v[1].y + v[2].z + v[3].w)); }
            else if (!last) {
#pragma unroll
                for (int j = 0; j < 4; ++j) *(u32x2*)(X + (size_t)row * D + 4 * lane + 256 * j) = (u32x2){pk2(v[j].x, v[j].y), pk2(v[j].z, v[j].w)};
                norm_mod_row(v, n1g, msc + mr * 1024, msh + mr * 1024, H + (size_t)row * D, lane);
            } else { float s = 0.f;
#pragma unroll
                for (int j = 0; j < 4; ++j) s += (v[j].x * v[j].x + v[j].y * v[j].y) + (v[j].z * v[j].z + v[j].w * v[j].w);
                const float rs = rsqrtf(wave_sum(s) * (1.f / D) + RMS_EPS);
#pragma unroll
                for (int j = 0; j < 4; ++j) { const int c = 4 * lane + 256 * j; const f32x4 g = *(const f32x4*)(fgp + c); *(f32x4*)(F.out + (size_t)row * D + c) = v[j] * rs * g; } } }
    }
}
__global__ void __launch_bounds__(NTHR, 2) fwd_megakernel(Params prm) {
    extern __shared__ __attribute__((aligned(16))) unsigned char lds_raw[];
    Frame F;
    F.lds = (LAS unsigned char*)lds_raw;
    F.tid = threadIdx.x; F.lane = F.tid & 63; F.wave = __builtin_amdgcn_readfirstlane(F.tid >> 6);
    F.G = gridDim.x; { const int bx = blockIdx.x; F.vcu = (F.G % 8 == 0) ? (bx % 8) * (F.G / 8) + bx / 8 : bx; }
    F.gw = F.vcu * NWAVES + F.wave; F.NGW = F.G * NWAVES;
    F.out = prm.out; F.ws = prm.ws;
    for (int u = F.tid; u < (LDS_BYTES - LDSCTL_OFF) / 4; u += NTHR) ((LAS unsigned*)(F.lds + LDSCTL_OFF))[u] = 0u;
    __syncthreads();
    (void)xcd_barrier_post((unsigned*)(F.ws + WS_CTL) + CW_BAR, (volatile LAS unsigned*)(F.lds + MISC_OFF) + 8);
#define GRID_BAR() do { XcdBarrier bar_; bar_.bar = (unsigned*)(opaque(F.ws) + WS_CTL) + CW_BAR; bar_.x = xb_xcc_id(); bar_.st = (volatile LAS unsigned*)(F.lds + MISC_OFF) + 8; xcd_barrier(bar_); } while (0)

    p0_prologue(F);
#if USE_CG_SYNC
    cg::this_grid().sync();
#else
    GRID_BAR();
#endif
    p0b_norm1(F);
    GRID_BAR();

    for (int l = 0; l < DEPTH; ++l) {
        const bool need_ctx = (l == 0); const int nrows = need_ctx ? NROW : NLAT;
#define WSO Fp.ws
        {
            const Frame Fp = phase_frame(F); unsigned char* const ws = WSO; bf16* Hb = (bf16*)(ws + WS_H); bf16* Pb = (bf16*)(ws + WS_P);
            pg8::Gemm g{Hb, (const bf16*)(ws + WS_WIN_T) + (size_t)l * NP * D, NROW, NP, D}; pg8::StaticOrder S; S.init(NROW, NP, Fp.G, (int)blockIdx.x);
            pg8::EpiStoreBf16 E{Pb, NP, 0xffff};
            pg8::gemm_phase<pg8::EpiStoreBf16, pg8::StaticOrder, true, true>(F.lds, g, S, E);
        }
        GRID_BAR();
        {
            const Frame Fp = phase_frame(F); unsigned char* const ws = WSO; bf16* Pb = (bf16*)(ws + WS_P);
            for (int it = blockIdx.x; it < 256; it += F.G) fftA_item(F, it);
            if (need_ctx) for (int it = blockIdx.x; it < 8; it += F.G) { const int b = it >> 2, m0 = (it & 3) * 64;
                const bf16* src0 = Pb + (size_t)(NLAT + b * CTXL) * NP + COL_FC;
                dft64_item<4, 256>(F, l, m0, -1.f, 1.f / 128.f, [=](int t, int ri) { return src0 + (size_t)t * NP + ri * 256; }, [=](int m) { return NLAT + b * CTXL + m; }); }
            shift_pass(F, l);
            conv_pass(F, l, nrows);
        }
        GRID_BAR();
        {
            const Frame Fp = phase_frame(F); unsigned char* const ws = WSO;
            prep_phase(F, l);
        }
        GRID_BAR();
        for (int seg = -1; seg < NSEG; ++seg) {
            const bool split = (F.G == 256);
            if (seg + 1 < NSEG) pre_phase(F, seg + 1, (seg >= 0 && split) ? 128 : 0);
            if (seg + 1 == NSEG && (!split || blockIdx.x >= 128)) { unsigned char* const ws = opaque(F.ws); int bx_ = (int)blockIdx.x; asm volatile("" : "+s"(bx_));
                const int first_ = split ? bx_ - 128 : bx_, stride_ = split ? 128 : F.G;
                for (int it = first_; it < 256; it += stride_) { const int b = it >> 7, t1p = it & 127;
                    const bf16* src0 = (const bf16*)(ws + WS_GT) + (size_t)(b * 128 + t1p) * 64 * 512;
                    dft64_item<1, 64>(F, l, 0, 1.f, 0.0013810679320049757f, [=](int t, int ri) { return src0 + (size_t)t * 512 + ri * 256; }, [=](int m) { return b * SEQ + t1p + 128 * m; }); } }
            if (seg >= 0) for (int it = blockIdx.x; it < 128; it += F.G) { const int x_ = it & 7, j_ = it >> 3;
                seq_item<0>(F, ((x_ + 8 * (j_ >> 2)) << 2) | (j_ & 3), seg, need_ctx); }
            GRID_BAR();
        }
        readout_pass(F, l, nrows);
        GRID_BAR();
        const int cv_lo = (nrows / 256) * 4 > F.G ? (nrows / 256) * 4 - F.G : 0;
        if (blockIdx.x & 1) expert_convert(F, l, cv_lo);
        {
            const Frame Fp = phase_frame(F); unsigned char* const ws = WSO; bf16* Hb = (bf16*)(ws + WS_H);
            pg8::Gemm g{Hb, (const bf16*)(ws + WS_WOUT_T) + (size_t)l * D * D, nrows, D, D}; pg8::StaticOrder S; S.init(nrows, D, Fp.G, (int)blockIdx.x);
            bf16* X = (bf16*)(ws + WS_X); const float* g1p = (const float*)(ws + WS_MODF) + (size_t)l * 3 * 6144 + 2 * 1024;
            if (l == 0) { pg8::EpiResidual<true> E{inptr(I_X), inptr(I_CTX), X, g1p}; pg8::gemm_phase<pg8::EpiResidual<true>, pg8::StaticOrder, true, true>(F.lds, g, S, E); }
            else { pg8::EpiResidual<false> E{X, X + (size_t)NLAT * D, X, g1p}; pg8::gemm_phase<pg8::EpiResidual<false>, pg8::StaticOrder, true, true>(F.lds, g, S, E); }
        }
        if (!(blockIdx.x & 1)) expert_convert(F, l, cv_lo);
        GRID_BAR();
        router_pass(F, l, nrows);
        GRID_BAR();
        gather_pass(F, l, nrows);
        GRID_BAR();
        {
            const Frame Fp = phase_frame(F); unsigned char* const ws = WSO;
            const int* tile_e = (const int*)(ws + WS_ROUTE + RT_TILE); const int ntiles = *(const int*)(ws + WS_ROUTE + RT_NT);
            pg8::MoeOrder S{tile_e, ntiles, Fp.G, (int)blockIdx.x};
            {   pg8::Gemm g{(const bf16*)(ws + WS_XS), (const bf16*)(ws + WS_WGU_T), 0, 0, D};
                pg8::EpiSwiGLU E{(bf16*)(ws + WS_ACT)};
                pg8::gemm_phase<pg8::EpiSwiGLU, pg8::MoeOrder, true, true>(F.lds, g, S, E); }
            GRID_BAR();
            {   pg8::Gemm g{(const bf16*)(ws + WS_ACT), (const bf16*)(ws + WS_WD_T), 0, 0, DEXP};
                pg8::EpiStoreBf16 E{(bf16*)(ws + WS_XS), D, 3};
                pg8::gemm_phase<pg8::EpiStoreBf16, pg8::MoeOrder, true, true>(F.lds, g, S, E); }
        }
        GRID_BAR();
        combine_pass<false>(F, l, nrows);
        if (l + 1 < DEPTH) GRID_BAR();
    }
}

extern "C" void kernel_launch(void* const* d_in, const int* in_sizes, int n_in, void* d_out, int out_size, void* d_ws, size_t ws_size, hipStream_t stream) {
    static int grid = 0;
    if (grid == 0) {
        if (n_in != N_IN || in_sizes[0] != NLAT * D || out_size != NLAT * D || ws_size < WS_END) {
            fprintf(stderr, "kernel_launch: unexpected shapes (n_in %d in0 %d out %d ws %zu)\n", n_in, n_in > 0 ? in_sizes[0] : -1, out_size, ws_size); grid = -1; return; }
        int dev = 0, cus = 0, per_cu = 0;
        hipGetDevice(&dev); hipDeviceGetAttribute(&cus, hipDeviceAttributeMultiprocessorCount, dev);
        hipFuncSetAttribute((const void*)fwd_megakernel, hipFuncAttributeMaxDynamicSharedMemorySize, LDS_BYTES);
        hipOccupancyMaxActiveBlocksPerMultiprocessor(&per_cu, (const void*)fwd_megakernel, NTHR, LDS_BYTES);
        if (per_cu < 1) { fprintf(stderr, "kernel_launch: occupancy query says %d blocks per CU\n", per_cu); per_cu = 1; }
        (void)hipGetLastError();
        grid = cus * per_cu;
    }
    if (grid < 0) return;
    hipMemsetAsync((char*)d_ws + WS_CTL, 0, CTL_ZERO_BYTES, stream);
    Params p{};
    for (int i = 0; i < N_IN; ++i) p.in[i] = (const float*)d_in[i];
    p.out = (float*)d_out; p.ws = (unsigned char*)d_ws;
    void* args[] = {&p};
    hipError_t e = hipLaunchCooperativeKernel((const void*)fwd_megakernel, dim3(grid), dim3(NTHR), args, LDS_BYTES, stream);
    if (e != hipSuccess) fprintf(stderr, "kernel_launch: cooperative launch failed: %s (grid %d)\n", hipGetErrorString(e), grid);
}
```

```cpp
#include <hip/hip_runtime.h>
#include <hip/hip_cooperative_groups.h>
#include <cstdio>
#include <cstdint>
namespace cg = cooperative_groups;
#define USE_CG_SYNC 0
#define SEQ_PROBE 0
#define SEQ_PROBE_PRE 0
namespace pg8 {
#define PG8_LAS __attribute__((address_space(3)))
typedef unsigned short bf16_t;
typedef short bf16x8 __attribute__((ext_vector_type(8)));
typedef float f32x4 __attribute__((ext_vector_type(4)));
typedef unsigned u32x4 __attribute__((ext_vector_type(4)));
constexpr int BM = 256, BK = 64, HALF = 128, HTB = HALF * BK * 2  , STAGE_BYTES = 8 * HTB, NXCD = 8, WGM = 8;

__host__ __device__ __forceinline__ int lds_byte(int r, int c) { const int st = (r >> 4) * 2 + (c >> 5), rr = r & 15, cc = c & 31, ob = rr * 64 + cc * 2; return st * 1024 + (ob ^ (((ob >> 9) & 1) << 5)); }
__host__ __device__ __forceinline__ void stage_rc(int b, int& R, int& C) { const int st = b / 1024, sb = b % 1024, swz = sb ^ (((sb >> 9) & 1) << 5); R = (st >> 1) * 16 + swz / 64; C = (st & 1) * 32 + (swz % 64) / 2; }
__host__ __device__ __forceinline__ int perm32(int rho) { const int n = rho >> 4, i = rho & 15; return 8 * (i >> 2) + 4 * n + (i & 3); }

struct Unit { int pm, pn, ga; };
struct Gemm { const bf16_t* A; const bf16_t* Bt; int M, N, K; const int* gidx; int gmax; };

struct StaticOrder {
    int nM, nN, nwg, G, c;
    __host__ __device__ void init(int M, int N, int G_, int c_) { nM = M / BM; nN = N / BM; nwg = nM * nN; G = G_; c = c_; }
    __host__ __device__ bool next(int i, Unit& u) const {
        const long L = (long)i * G + c; if (L >= nwg) return false;
        int wgid = (int)L; { const int q = nwg / NXCD, r = nwg % NXCD, xcd = wgid % NXCD, off = wgid / NXCD; wgid = (xcd < r ? xcd * (q + 1) : r * (q + 1) + (xcd - r) * q) + off; }
        const int nig = WGM * nN, gid = wgid / nig, fm = gid * WGM, gsz = (nM - fm) < WGM ? (nM - fm) : WGM;
        u.pm = fm + ((wgid % nig) % gsz); u.pn = (wgid % nig) / gsz; return true;
    }
    __device__ __forceinline__ void a_ready(const Unit&) const {}
    __device__ __forceinline__ void done(const Unit&) const {}
};

__device__ __forceinline__ unsigned cvt_pk_bf16(float lo, float hi) { unsigned r; asm volatile("v_cvt_pk_bf16_f32 %0, %1, %2" : "=v"(r) : "v"(lo), "v"(hi)); return r; }
typedef float f32x2 __attribute__((ext_vector_type(2)));
template <class Epi, class Sched, bool ALIGN_EPI = false, bool SP2 = false, bool GATHER = false>
__device__ __forceinline__ void gemm_phase(PG8_LAS unsigned char* lds, const Gemm g, const Sched& S, const Epi& E) {
    int tid = threadIdx.x; asm volatile("" : "+v"(tid));
    const int wid = __builtin_amdgcn_readfirstlane(tid >> 6), lane = tid & 63, wr = wid >> 2, wc = wid & 3, fr = lane & 15, fq = lane >> 4;
    const int K = g.K, nt = K / BK;
    unsigned voffA[2], voffB[2];
#pragma unroll
    for (int i = 0; i < 2; ++i) { int R, C; stage_rc(tid * 16 + i * 8192, R, C); const int Rb = Epi::PERM ? ((R & ~31) + perm32(R & 31)) : R;
        voffA[i] = (unsigned)(R * K + C) * 2u; voffB[i] = (unsigned)(Rb * K + C) * 2u; }
    static_assert(!GATHER || SP2, "GATHER is implemented for the SP2 loop");
    unsigned gcur[2][2], gnx[2][2];
#define PG8_GOFF(go, u_) do { _Pragma("unroll") for (int h_ = 0; h_ < 2; ++h_) _Pragma("unroll") for (int i_ = 0; i_ < 2; ++i_) { int R_, C_; stage_rc(tid * 16 + i_ * 8192, R_, C_); \
        int ri_ = g.gidx[(u_).ga + h_ * HALF + R_]; ri_ = ri_ < 0 ? 0 : (ri_ > g.gmax ? g.gmax : ri_); go[h_][i_] = (unsigned)ri_ * (unsigned)(K * 2) + (unsigned)C_ * 2u; } } while (0)
    const size_t kstep = (size_t)(BK * 2);
    const size_t hstep = (size_t)HALF * K * 2;
    const size_t tstep = 2 * hstep;
    const unsigned ldsw = (unsigned)wid * 1024u;
    const int aoff = lds_byte(wr * 64 + fr, fq * 8), boff = lds_byte(wc * 32 + fr, fq * 8);
#define PG8_SA(b, h) (((b) * 2 + (h)) * HTB)
#define PG8_SB(b, h) ((4 + (b) * 2 + (h)) * HTB)
#define PG8_STAGE(bufoff, gbase, voff) do { _Pragma("unroll") for (int _i = 0; _i < 2; ++_i) \
        __builtin_amdgcn_global_load_lds((const unsigned*)((const char*)(gbase) + (voff)[_i]), (PG8_LAS unsigned*)(lds + (bufoff) + ldsw + _i * 8192), 16, 0, 0); } while (0)
#define PG8_LDA(dst, b, h) do { _Pragma("unroll") for (int m = 0; m < 4; ++m) _Pragma("unroll") for (int k = 0; k < 2; ++k) dst[m][k] = *(const PG8_LAS bf16x8*)(lds + PG8_SA(b, h) + aoff + m * 2048 + k * 1024); } while (0)
#define PG8_LDB(dst, b, h) do { _Pragma("unroll") for (int n = 0; n < 2; ++n) _Pragma("unroll") for (int k = 0; k < 2; ++k) dst[n][k] = *(const PG8_LAS bf16x8*)(lds + PG8_SB(b, h) + boff + n * 2048 + k * 1024); } while (0)
#define PG8_MMA(ai, bj, At, Bt) do { __builtin_amdgcn_s_setprio(1); _Pragma("unroll") for (int m = 0; m < 4; ++m) _Pragma("unroll") for (int n = 0; n < 2; ++n) _Pragma("unroll") for (int k = 0; k < 2; ++k) \
        acc[ai][bj][m][n] = __builtin_amdgcn_mfma_f32_16x16x32_bf16(Bt[n][k], At[m][k], acc[ai][bj][m][n], 0, 0, 0); __builtin_amdgcn_s_setprio(0); } while (0)
#define PG8_WAIT_V(n) asm volatile("s_waitcnt vmcnt(" #n ")" ::: "memory")
#define PG8_WAIT_L(n) asm volatile("s_waitcnt lgkmcnt(" #n ")" ::: "memory")
#define PG8_BAR __builtin_amdgcn_s_barrier()
#define PG8_SCHED __builtin_amdgcn_sched_barrier(0)
    Unit cur, nxt; int ui = 0;
    if (!S.next(0, cur)) return;
    f32x4 acc[2][2][4][2];
#pragma unroll
    for (int a = 0; a < 2; ++a)
#pragma unroll
        for (int b = 0; b < 2; ++b)
#pragma unroll
            for (int m = 0; m < 4; ++m)
#pragma unroll
                for (int n = 0; n < 2; ++n) acc[a][b][m][n] = (f32x4){0.f, 0.f, 0.f, 0.f};
    bf16x8 At[4][2], B0[2][2], B1[2][2];
    const char* cA = (const char*)g.A + (size_t)cur.pm * tstep; const char* cB = (const char*)g.Bt + (size_t)cur.pn * tstep;
    S.a_ready(cur);
    const char* gA = (const char*)g.A;
    if constexpr (GATHER) PG8_GOFF(gcur, cur);
    if constexpr (SP2) {
        PG8_STAGE(PG8_SB(0, 0), cB, voffB); PG8_STAGE(PG8_SB(0, 1), cB + hstep, voffB);
        if constexpr (GATHER) { PG8_STAGE(PG8_SA(0, 0), gA, gcur[0]); PG8_STAGE(PG8_SA(0, 1), gA, gcur[1]); } else { PG8_STAGE(PG8_SA(0, 0), cA, voffA); PG8_STAGE(PG8_SA(0, 1), cA + hstep, voffA); }
        if (wr == 1) PG8_BAR;
        PG8_WAIT_V(2); PG8_BAR;
        PG8_STAGE(PG8_SB(1, 0), cB + kstep, voffB); if constexpr (GATHER) PG8_STAGE(PG8_SA(1, 0), gA + kstep, gcur[0]); else PG8_STAGE(PG8_SA(1, 0), cA + kstep, voffA); PG8_STAGE(PG8_SB(1, 1), cB + hstep + kstep, voffB);
        PG8_WAIT_V(6); PG8_BAR;
    } else {
        PG8_STAGE(PG8_SB(0, 0), cB, voffB); PG8_STAGE(PG8_SA(0, 0), cA, voffA); PG8_STAGE(PG8_SB(0, 1), cB + hstep, voffB); PG8_STAGE(PG8_SA(0, 1), cA + hstep, voffA);
        if (wr == 1) PG8_BAR;
        PG8_WAIT_V(4); PG8_BAR;
        PG8_STAGE(PG8_SB(1, 0), cB + kstep, voffB); PG8_STAGE(PG8_SA(1, 0), cA + kstep, voffA); PG8_STAGE(PG8_SB(1, 1), cB + hstep + kstep, voffB);
        PG8_WAIT_V(6); PG8_BAR;
    }
    for (;;) {
        const bool has_next = S.next(ui + 1, nxt);
        if constexpr (GATHER) { if (has_next) PG8_GOFF(gnx, nxt); else { gnx[0][0] = gcur[0][0]; gnx[0][1] = gcur[0][1]; gnx[1][0] = gcur[1][0]; gnx[1][1] = gcur[1][1]; } }
        const char* nA = has_next ? (const char*)g.A + (size_t)nxt.pm * tstep : cA; const char* nB = has_next ? (const char*)g.Bt + (size_t)nxt.pn * tstep : cB;
        for (int t = 0; t < nt; t += 2) {
            const bool last = (t == nt - 2);
            const char* a1 = cA + (size_t)(t + 1) * kstep;
            const char* a2 = last ? nA : cA + (size_t)(t + 2) * kstep; const char* b2 = last ? nB : cB + (size_t)(t + 2) * kstep;
            const char* a3 = a2 + kstep; const char* b3 = b2 + kstep;
            if (last && has_next) S.a_ready(nxt);
            unsigned ga0[2], ga1[2]; const char* g1 = gA; const char* g2 = gA; const char* g3 = gA;
            if constexpr (GATHER) { g1 = gA + (size_t)(t + 1) * kstep; g2 = last ? gA : gA + (size_t)(t + 2) * kstep; g3 = g2 + kstep;
                ga0[0] = last ? gnx[0][0] : gcur[0][0]; ga0[1] = last ? gnx[0][1] : gcur[0][1]; ga1[0] = last ? gnx[1][0] : gcur[1][0]; ga1[1] = last ? gnx[1][1] : gcur[1][1]; }
            if constexpr (SP2) {
            PG8_LDB(B0, 0, 0); PG8_LDB(B1, 0, 1); PG8_SCHED; PG8_LDA(At, 0, 0); if constexpr (GATHER) PG8_STAGE(PG8_SA(1, 1), g1, gcur[1]); else PG8_STAGE(PG8_SA(1, 1), a1 + hstep, voffA);
            PG8_WAIT_V(8); PG8_WAIT_L(0); PG8_BAR; PG8_MMA(0, 0, At, B0); PG8_MMA(0, 1, At, B1); PG8_BAR; PG8_SCHED;
            PG8_LDA(At, 0, 1); PG8_STAGE(PG8_SB(0, 0), b2, voffB); PG8_STAGE(PG8_SB(0, 1), b2 + hstep, voffB); if constexpr (GATHER) PG8_STAGE(PG8_SA(0, 0), g2, ga0); else PG8_STAGE(PG8_SA(0, 0), a2, voffA);
            PG8_WAIT_V(8); PG8_WAIT_L(0); PG8_BAR; PG8_MMA(1, 0, At, B0); PG8_MMA(1, 1, At, B1); PG8_BAR; PG8_SCHED;
            PG8_LDB(B0, 1, 0); PG8_LDB(B1, 1, 1); PG8_SCHED; PG8_LDA(At, 1, 0); if constexpr (GATHER) PG8_STAGE(PG8_SA(0, 1), g2, ga1); else PG8_STAGE(PG8_SA(0, 1), a2 + hstep, voffA);
            PG8_WAIT_V(8); PG8_WAIT_L(0); PG8_BAR; PG8_MMA(0, 0, At, B0); PG8_MMA(0, 1, At, B1); PG8_BAR; PG8_SCHED;
            PG8_LDA(At, 1, 1); PG8_STAGE(PG8_SB(1, 0), b3, voffB); PG8_STAGE(PG8_SB(1, 1), b3 + hstep, voffB); if constexpr (GATHER) PG8_STAGE(PG8_SA(1, 0), g3, ga0); else PG8_STAGE(PG8_SA(1, 0), a3, voffA);
            PG8_WAIT_V(8); PG8_WAIT_L(0); PG8_BAR; PG8_MMA(1, 0, At, B0); PG8_MMA(1, 1, At, B1); PG8_BAR; PG8_SCHED;
            } else {
            PG8_LDB(B0, 0, 0); PG8_SCHED; PG8_LDA(At, 0, 0); PG8_STAGE(PG8_SA(1, 1), a1 + hstep, voffA);
            PG8_WAIT_L(8); PG8_BAR; PG8_WAIT_L(0); PG8_MMA(0, 0, At, B0); PG8_BAR; PG8_SCHED;
            PG8_LDB(B1, 0, 1); PG8_STAGE(PG8_SB(0, 0), b2, voffB);
            PG8_BAR; PG8_WAIT_L(0); PG8_MMA(0, 1, At, B1); PG8_BAR;
            PG8_LDA(At, 0, 1); PG8_STAGE(PG8_SA(0, 0), a2, voffA);
            PG8_BAR; PG8_WAIT_L(0); PG8_MMA(1, 0, At, B0); PG8_BAR; PG8_SCHED;
            PG8_STAGE(PG8_SB(0, 1), b2 + hstep, voffB);
            PG8_WAIT_V(6); PG8_BAR; PG8_MMA(1, 1, At, B1); PG8_BAR;
            PG8_LDB(B0, 1, 0); PG8_SCHED; PG8_LDA(At, 1, 0); PG8_STAGE(PG8_SA(0, 1), a2 + hstep, voffA);
            PG8_WAIT_L(8); PG8_BAR; PG8_WAIT_L(0); PG8_MMA(0, 0, At, B0); PG8_BAR; PG8_SCHED;
            PG8_LDB(B1, 1, 1); PG8_STAGE(PG8_SB(1, 0), b3, voffB);
            PG8_BAR; PG8_WAIT_L(0); PG8_MMA(0, 1, At, B1); PG8_BAR;
            PG8_LDA(At, 1, 1); PG8_STAGE(PG8_SA(1, 0), a3, voffA);
            PG8_BAR; PG8_WAIT_L(0); PG8_MMA(1, 0, At, B0); PG8_BAR; PG8_SCHED;
            PG8_STAGE(PG8_SB(1, 1), b3 + hstep, voffB);
            PG8_WAIT_V(6); PG8_BAR; PG8_MMA(1, 1, At, B1); PG8_BAR;
            }
        }
        if constexpr (ALIGN_EPI) { if (wr == 0) PG8_BAR; }
        if constexpr (!Epi::AFTER_DRAIN) { E(acc, cur, wr, wc, fr, fq); S.done(cur); }
        if (!has_next) break;
#pragma unroll
        for (int a = 0; a < 2; ++a)
#pragma unroll
            for (int b = 0; b < 2; ++b)
#pragma unroll
                for (int m = 0; m < 4; ++m)
#pragma unroll
                    for (int n = 0; n < 2; ++n) acc[a][b][m][n] = (f32x4){0.f, 0.f, 0.f, 0.f};
        cur = nxt; cA = nA; cB = nB; ++ui;
        if constexpr (GATHER) { gcur[0][0] = gnx[0][0]; gcur[0][1] = gnx[0][1]; gcur[1][0] = gnx[1][0]; gcur[1][1] = gnx[1][1]; }
        if constexpr (ALIGN_EPI) { if (wr == 1) PG8_BAR; }
    }
    PG8_WAIT_V(0);
    if constexpr (!ALIGN_EPI) { if (wr == 0) PG8_BAR; }
    PG8_BAR;
    if constexpr (Epi::AFTER_DRAIN) { E.fused(acc, cur, wr, wc, fr, fq, lds, wid, lane); S.done(cur); }
#undef PG8_GOFF
#undef PG8_SA
#undef PG8_SB
#undef PG8_STAGE
#undef PG8_LDA
#undef PG8_LDB
#undef PG8_MMA
#undef PG8_WAIT_V
#undef PG8_WAIT_L
#undef PG8_BAR
#undef PG8_SCHED
}
}
#define LAS __attribute__((address_space(3)))
typedef unsigned short bf16;
typedef float f32x4 __attribute__((ext_vector_type(4)));
typedef short bf16x8 __attribute__((ext_vector_type(8)));
typedef unsigned u32x4 __attribute__((ext_vector_type(4)));
typedef unsigned u32x2 __attribute__((ext_vector_type(2)));

constexpr int D = 1024, NBATCH = 2, SEQ = 8192, CTXL = 256, DEPTH = 2;
constexpr int NLAT = NBATCH * SEQ, NCTX = NBATCH * CTXL, NROW = NLAT + NCTX;
constexpr int DR = 512, DIN = 2944, NP = 3328, ZW = 1920, NHEAD = 8;
constexpr int COL_CONV = 1920, COL_FC = 2688, COL_FS = 2944;
constexpr int STRW = 5120;
constexpr int NEXP = 32, DEXP = 512;
constexpr int MOE_MAXTILES = 168;
constexpr float RMS_EPS = 1e-6f, GN_EPS = 64e-5f;

enum { I_X = 0, I_C, I_CTX, I_CCTX, I_ADAW, I_ADAB, I_N1G, I_N2G, I_WIN, I_MU, I_DW0, I_DW2, I_IA0, I_IA2, I_GG2, I_KK, I_KA, I_RK, I_GNW, I_GNB,
       I_CONVW, I_CONVG, I_FOURG, I_WOUT, I_RGW, I_RGB, I_REW, I_REB, I_EG, I_EU, I_ED, I_FG, N_IN };

constexpr size_t MiB = 1u << 20;
constexpr size_t WS_CTL = 0, CTL_ZERO_BYTES = 64 * 1024;
constexpr size_t WS_MODP = 1 * MiB;
constexpr size_t WS_MODF = 1 * MiB + 1280 * 1024;
constexpr size_t WS_WIN_T = 3 * MiB;
constexpr size_t WS_WOUT_T = 16 * MiB;
constexpr size_t WS_WGU_T = 20 * MiB;
constexpr size_t WS_WD_T = 84 * MiB;
constexpr size_t WS_X = 116 * MiB;
constexpr size_t WS_H = 182 * MiB;
constexpr size_t WS_ZS = 215 * MiB;
constexpr size_t WS_P = 277 * MiB;
constexpr size_t WS_STR = 277 * MiB;
constexpr size_t WS_Y = 442 * MiB;
constexpr size_t WS_GT = 475 * MiB;
constexpr size_t WS_ROUTE = 491 * MiB;
constexpr size_t WS_XS = 215 * MiB;
constexpr size_t WS_ACT = 299 * MiB;
constexpr size_t WS_ELIST = 340 * MiB;
constexpr size_t WS_END = 530 * MiB;
constexpr size_t RT_E = 0, RT_POS = 1 * 33792 * 4, RT_GATE = 2 * 33792 * 4, RT_SLOT = 3 * 33792 * 4, RT_TILE = 4 * 33792 * 4, RT_NT = RT_TILE + 1024;

constexpr int CW_BAR = 4096;
constexpr int CW_CNT = 8192;

constexpr int NWAVES = 8, NTHR = 512;
constexpr int RING_BYTES = 131072, LDSCTL_OFF = 143360, MISC_OFF = LDSCTL_OFF + 320, LDS_BYTES = 147456;

struct Params { const float* in[N_IN]; float* out; unsigned char* ws; };

__device__ __forceinline__ float bf2f(unsigned h) { return __uint_as_float(h << 16); }
typedef __bf16 hwbf2 __attribute__((ext_vector_type(2)));
typedef float f32x2 __attribute__((ext_vector_type(2)));
__device__ __forceinline__ unsigned pk2(float lo, float hi) { const f32x2 x = {lo, hi}; const hwbf2 r = __builtin_convertvector(x, hwbf2); return __builtin_bit_cast(unsigned, r); }
__device__ __forceinline__ unsigned f2bf(float f) { return pk2(f, 0.f) & 0xffffu; }
__device__ __forceinline__ float wave_sum(float v) {
#pragma unroll
    for (int o = 1; o < 64; o <<= 1) v += __shfl_xor(v, o);
    return v;
}
__device__ __forceinline__ float sigmoidf_(float x) { return 1.f / (1.f + __expf(-x)); }
#define LDS_WAIT() asm volatile("s_waitcnt lgkmcnt(0)" ::: "memory")
#define VM_WAIT() asm volatile("s_waitcnt vmcnt(0)" ::: "memory")

struct Frame {
    LAS unsigned char* lds;
    int tid, lane, wave, vcu, G, gw, NGW;
    float* out; unsigned char* ws;
};
#if defined(__HIP_DEVICE_COMPILE__)
#define ASSUME_GLOBAL(p) do { __builtin_assume(!__builtin_amdgcn_is_shared(p)); __builtin_assume(!__builtin_amdgcn_is_private(p)); } while (0)
#else
#define ASSUME_GLOBAL(p) do { } while (0)
#endif
__device__ __forceinline__ const float* inptr(int i) {
    const volatile unsigned long long __attribute__((address_space(4)))* ka = (const volatile unsigned long long __attribute__((address_space(4)))*)__builtin_amdgcn_kernarg_segment_ptr();
    return (const float*)(const __attribute__((address_space(1))) float*)ka[i];
}
__device__ __forceinline__ unsigned char* opaque(unsigned char* p) { unsigned long z = 0; asm volatile("" : "+s"(z)); return p + z; }
__device__ __forceinline__ Frame phase_frame(const Frame& F0) { Frame F = F0; asm volatile("" : "+v"(F.tid)); F.lane = F.tid & 63; F.ws = opaque(F0.ws);
    asm volatile("" : "+s"(F.G), "+s"(F.vcu)); F.gw = F.vcu * NWAVES + F.wave; F.NGW = F.G * NWAVES; return F; }
__device__ __forceinline__ int modrow(int row) { return row < NLAT ? (row >> 13) : 2; }
#define XB_TMO      128
#define XB_XCNT(j)  (256  + 64 * (j))
#define XB_XSUB(j)  (1280 + 64 * (j))
#define XB_XGEN(j)  (2304 + 64 * (j))
#define XB_TOP      3328
#define XB_TOPGEN   3392
#define XCD_BAR_WORDS 3456
#define XB_SPIN_CAP (1u << 18)

__device__ __forceinline__ unsigned xb_ld(unsigned* p)              { return __hip_atomic_load(p, __ATOMIC_RELAXED, __HIP_MEMORY_SCOPE_AGENT); }
__device__ __forceinline__ unsigned xb_add(unsigned* p, unsigned v) { return __hip_atomic_fetch_add(p, v, __ATOMIC_RELAXED, __HIP_MEMORY_SCOPE_AGENT); }
__device__ __forceinline__ unsigned xb_xcc_id() { return (unsigned)__builtin_amdgcn_s_getreg((3 << 11) | 20) & 0xFu; }
#define XB_SPIN(cond, bar) do { unsigned _sp = 0; while (cond) { __builtin_amdgcn_s_sleep(1); \
    if ((++_sp & 255u) == 0u) { if (xb_ld(&(bar)[XB_TMO])) break; if (_sp > XB_SPIN_CAP) { atomicAdd(&(bar)[XB_TMO], 1u); break; } } } } while (0)

struct XcdBarrier {
    unsigned* bar; unsigned x;
    volatile LAS unsigned* st;
};

__device__ __forceinline__ XcdBarrier xcd_barrier_post(unsigned* bar, volatile LAS unsigned* st) {
    XcdBarrier b; b.bar = bar; b.x = xb_xcc_id(); b.st = st;
    if (threadIdx.x == 0) (void)xb_add(&bar[XB_XCNT(b.x)], 1u);
    return b;
}
__device__ __forceinline__ void xcd_barrier_complete(unsigned* bar, unsigned x, unsigned& nloc, unsigned& nx) {
    const unsigned G = gridDim.x * gridDim.y * gridDim.z;
    unsigned sum, cnt, mine, sp = 0u;
    for (;;) {
        sum = 0u; cnt = 0u; mine = 0u;
#pragma nounroll
        for (unsigned j = 0; j < 16; ++j) { const unsigned c = xb_ld(&bar[XB_XCNT(j)]); sum += c; cnt += (c > 0u) ? 1u : 0u; mine = (j == x) ? c : mine; }
        if (sum == G) break;
        __builtin_amdgcn_s_sleep(1);
        if ((++sp & 255u) == 0u) { if (xb_ld(&bar[XB_TMO])) break; if (sp > XB_SPIN_CAP) { atomicAdd(&bar[XB_TMO], 1u); break; } }
    }
    nloc = mine > 0u ? mine : 1u; nx = cnt > 0u ? cnt : 1u;
}

__device__ __forceinline__ void xcd_barrier(const XcdBarrier& b) {
    asm volatile("s_waitcnt vmcnt(0)" ::: "memory");
    __syncthreads();
    if (threadIdx.x == 0) {
        unsigned* bar = b.bar;
        asm volatile("" : "+s"(bar));
        __builtin_amdgcn_s_waitcnt(0);
        unsigned nloc = b.st[0], nx = b.st[1];
        if (nloc == 0u) { xcd_barrier_complete(bar, b.x, nloc, nx); b.st[0] = nloc; b.st[1] = nx; }
        const unsigned old = xb_add(&bar[XB_XSUB(b.x)], 1u);
        const unsigned gen = old / nloc;
        if (old + 1u == (gen + 1u) * nloc) {
            __builtin_amdgcn_fence(__ATOMIC_RELEASE, "agent");
            asm volatile("s_waitcnt vmcnt(0)" ::: "memory");
            const unsigned og = xb_add(&bar[XB_TOP], 1u);
            const unsigned tg = og / nx;
            if (og + 1u == (tg + 1u) * nx) xb_add(&bar[XB_TOPGEN], 1u);
            else XB_SPIN(xb_ld(&bar[XB_TOPGEN]) == tg, bar);
            __builtin_amdgcn_fence(__ATOMIC_ACQUIRE, "agent");
            xb_add(&bar[XB_XGEN(b.x)], 1u);
            asm volatile("s_waitcnt vmcnt(0)" ::: "memory");
        } else {
            XB_SPIN(xb_ld(&bar[XB_XGEN(b.x)]) == gen, bar);
            __builtin_amdgcn_fence(__ATOMIC_ACQUIRE, "agent");
            asm volatile("s_waitcnt vmcnt(0)" ::: "memory");
        }
    }
    __syncthreads();
}
template <class RowMap>
__device__ __forceinline__ void transpose_item(const float* W, int ldw, int k0, int n0, bf16* WT, int ldt, RowMap rm, LAS float* scr, int lane) {
    (void)scr;
    const int nq = lane & 7, kg = lane >> 3; const float* src = W + (size_t)(k0 + 8 * kg) * ldw + n0 + 4 * nq;
    f32x4 v[8];
#pragma unroll
    for (int i = 0; i < 8; ++i) v[i] = *(const f32x4*)(src + (size_t)i * ldw);
#pragma unroll
    for (int j = 0; j < 4; ++j) { u32x4 o = {pk2(v[0][j], v[1][j]), pk2(v[2][j], v[3][j]), pk2(v[4][j], v[5][j]), pk2(v[6][j], v[7][j])};
        *(u32x4*)(WT + (size_t)rm(n0 + 4 * nq + j) * ldt + k0 + 8 * kg) = o; }
}
struct RmId { int off; __device__ __forceinline__ int operator()(int n) const { return off + n; } };
struct RmGU { int off; __device__ __forceinline__ int operator()(int n) const { return off + ((n >> 2) << 3) + (n & 3); } };

__device__ __forceinline__ void p0_prologue(const Frame& F0) {
    const Frame F = phase_frame(F0); unsigned char* const ws = F.ws;
    LAS float* scr = (LAS float*)(F.lds + F.wave * 16384);
    LAS float* ctab = (LAS float*)(F.lds + 8 * 16384);
    if (F.tid < 64) ctab[F.tid] = cosf((float)F.tid * (6.283185307179586f / 64.f));
    __syncthreads();
    bf16* win_t = (bf16*)(ws + WS_WIN_T); bf16* wout_t = (bf16*)(ws + WS_WOUT_T);
    constexpr int I_WIN_L = 16 * 84, I_WOUT_L = 16 * 32, I_FOLD_L = 4 * 64, I_MOD_L = 96 * 8;
    constexpr int NIT = 2 * (I_WIN_L + I_WOUT_L + I_FOLD_L + I_MOD_L);
    const float* p_win = inptr(I_WIN); const float* p_wout = inptr(I_WOUT); const float* p_c = inptr(I_C); const float* p_cctx = inptr(I_CCTX); const float* p_adaw = inptr(I_ADAW);
    {
        bf16* wl = (bf16*)(ws + 64 * 1024); const float* dw2 = inptr(I_DW2); const float* ia2 = inptr(I_IA2); const float* gg2 = inptr(I_GG2);
        for (int idx = F.vcu * NTHR + F.tid; idx < 2 * 384 * 512; idx += F.G * NTHR) { const int c = idx & 511, k = (idx >> 9) % 384, l = idx / (384 * 512);
            float v;
            if (k < 128) v = dw2[((size_t)(l * 2 + (k >> 6)) * 64 + (k & 63)) * DR + c];
            else if (k < 256) v = ia2[((size_t)(l * 2 + ((k - 128) >> 6)) * 64 + (k & 63)) * DR + c];
            else v = gg2[((size_t)l * 128 + (k - 256)) * DR + c];
            wl[((size_t)l * 512 + c) * 384 + k] = (bf16)f2bf(v); } }
    for (int it = F.gw; it < NIT; it += F.NGW) {
        int r = it; const int l = r & 1; r >>= 1;
        if (r < I_WIN_L) { const int kb = r / 84, nb = r % 84;
            transpose_item(p_win + (size_t)l * D * DIN, DIN, kb * 64, nb * 32, win_t + (size_t)l * NP * D, D, RmId{0}, scr, F.lane); continue; }
        r -= I_WIN_L;
        if (r < I_WOUT_L) { const int kb = r / 32, nb = r % 32;
            transpose_item(p_wout + (size_t)l * D * D, D, kb * 64, nb * 32, wout_t + (size_t)l * D * D, D, RmId{0}, scr, F.lane); continue; }
        r -= I_WOUT_L;
        if (r < I_FOLD_L) {
            const int g = r >> 6, k0 = (r & 63) * 16; const float* W = p_win + (size_t)l * D * DIN;
#pragma unroll
            for (int kk = 0; kk < 16; ++kk) scr[kk * 64 + F.lane] = W[(size_t)(k0 + kk) * DIN + 2688 + g * 64 + F.lane];
            LDS_WAIT(); asm volatile("" ::: "memory");
            float ac[16], as[16];
#pragma unroll
            for (int kk = 0; kk < 16; ++kk) { ac[kk] = 0.f; as[kk] = 0.f; }
            for (int c = 0; c < 64; ++c) { const int idx = (c * F.lane) & 63; const float cc = ctab[idx], ss = ctab[(idx - 16) & 63];
#pragma unroll
                for (int kk = 0; kk < 16; ++kk) { const float w = scr[kk * 64 + c]; ac[kk] += w * cc; as[kk] += w * ss; } }
            bf16* oc = win_t + (size_t)l * NP * D + (size_t)(COL_FC + g * 64 + F.lane) * D + k0;
            bf16* os = win_t + (size_t)l * NP * D + (size_t)(COL_FS + g * 64 + F.lane) * D + k0;
            u32x4 a, b;
            a.x = pk2(ac[0], ac[1]); a.y = pk2(ac[2], ac[3]); a.z = pk2(ac[4], ac[5]); a.w = pk2(ac[6], ac[7]);
            b.x = pk2(ac[8], ac[9]); b.y = pk2(ac[10], ac[11]); b.z = pk2(ac[12], ac[13]); b.w = pk2(ac[14], ac[15]);
            *(u32x4*)oc = a; *(u32x4*)(oc + 8) = b;
            a.x = pk2(as[0], as[1]); a.y = pk2(as[2], as[3]); a.z = pk2(as[4], as[5]); a.w = pk2(as[6], as[7]);
            b.x = pk2(as[8], as[9]); b.y = pk2(as[10], as[11]); b.z = pk2(as[12], as[13]); b.w = pk2(as[14], as[15]);
            *(u32x4*)os = a; *(u32x4*)(os + 8) = b;
            LDS_WAIT(); asm volatile("" ::: "memory");
            continue; }
        r -= I_FOLD_L;
        {
            const int cb = r >> 3, ks = r & 7;
#pragma unroll
            for (int q = 0; q < 2; ++q) { const int k = ks * 128 + q * 64 + F.lane;
                const float c0 = p_c[k], c1 = p_c[D + k], c2 = p_cctx[k];
                scr[0 * 128 + q * 64 + F.lane] = c0 * sigmoidf_(c0); scr[1 * 128 + q * 64 + F.lane] = c1 * sigmoidf_(c1); scr[2 * 128 + q * 64 + F.lane] = c2 * sigmoidf_(c2); }
            LDS_WAIT(); asm volatile("" ::: "memory");
            const float* W = p_adaw + (size_t)l * D * 6144 + (size_t)(ks * 128) * 6144 + cb * 64 + F.lane;
            float a0 = 0.f, a1 = 0.f, a2 = 0.f;
#pragma unroll 8
            for (int kk = 0; kk < 128; ++kk) { const float w = W[(size_t)kk * 6144]; a0 += scr[kk] * w; a1 += scr[128 + kk] * w; a2 += scr[256 + kk] * w; }
            float* mp = (float*)(ws + WS_MODP) + (size_t)((l * 8 + ks) * 3) * 6144 + cb * 64 + F.lane;
            mp[0] = a0; mp[6144] = a1; mp[2 * 6144] = a2;
            LDS_WAIT(); asm volatile("" ::: "memory");
        }
    }
}

__device__ __forceinline__ void mod_to_lds(const Frame& F0, int l, int p, LAS float* dst, bool from_partials) {
    const Frame F = phase_frame(F0); unsigned char* const ws = F.ws;
    const float* adab = inptr(I_ADAB);
    for (int idx = F.tid; idx < 3 * 1024; idx += NTHR) { const int r = idx >> 10, n = idx & 1023;
        float v;
        if (from_partials) { v = adab[l * 6144 + p * 1024 + n]; const float* mp = (const float*)(ws + WS_MODP) + (size_t)(l * 8 * 3 + r) * 6144 + p * 1024 + n;
#pragma unroll
            for (int ks = 0; ks < 8; ++ks) v += mp[(size_t)ks * 3 * 6144]; }
        else v = ((const float*)(ws + WS_MODF))[(size_t)(l * 3 + r) * 6144 + p * 1024 + n];
        dst[idx] = v; }
}
__device__ __forceinline__ void mod_finalize(const Frame& F0) {
    const Frame F = phase_frame(F0); unsigned char* const ws = F.ws;
    const float* adab = inptr(I_ADAB);
    for (int idx = F.vcu * NTHR + F.tid; idx < 2 * 3 * 6144; idx += F.G * NTHR) { const int l = idx / (3 * 6144), rem = idx % (3 * 6144), r = rem / 6144, n = rem % 6144;
        float v = adab[l * 6144 + n]; const float* mp = (const float*)(ws + WS_MODP) + (size_t)(l * 8 * 3 + r) * 6144 + n;
#pragma unroll
        for (int ks = 0; ks < 8; ++ks) v += mp[(size_t)ks * 3 * 6144];
        ((float*)(ws + WS_MODF))[idx] = v; }
}


__device__ __forceinline__ void norm_mod_row(f32x4 (&v)[4], const float* gain, const LAS float* sc, const LAS float* sh, bf16* orow, int lane) {
    float s = 0.f;
#pragma unroll
    for (int j = 0; j < 4; ++j) s += (v[j].x * v[j].x + v[j].y * v[j].y) + (v[j].z * v[j].z + v[j].w * v[j].w);
    const float rs = rsqrtf(wave_sum(s) * (1.f / D) + RMS_EPS);
#pragma unroll
    for (int j = 0; j < 4; ++j) { const int c = 4 * lane + 256 * j; const f32x4 g = *(const f32x4*)(gain + c); const f32x4 a = *(const LAS f32x4*)(sc + c), b = *(const LAS f32x4*)(sh + c);
        v[j] = (v[j] * rs) * g * (a + 1.f) + b;
        u32x2 w; w.x = pk2(v[j].x, v[j].y); w.y = pk2(v[j].z, v[j].w); *(u32x2*)(orow + c) = w; }
}

__device__ __forceinline__ void p0b_norm1(const Frame& F0) {
    const Frame F = phase_frame(F0); unsigned char* const ws = F.ws;
    LAS float* msh = (LAS float*)F.lds; LAS float* msc = msh + 3072;
    mod_to_lds(F, 0, 0, msh, true); mod_to_lds(F, 0, 1, msc, true); __syncthreads();
    mod_finalize(F);
    bf16* H = (bf16*)(ws + WS_H); const float* xin = inptr(I_X); const float* cin = inptr(I_CTX); const float* n1g = inptr(I_N1G);
    for (int row0 = F.gw; row0 < NROW; row0 += 2 * F.NGW) { f32x4 v[2][4]; bool ok[2];
#pragma unroll
        for (int u = 0; u < 2; ++u) { const int row = row0 + u * F.NGW; ok[u] = row < NROW; if (ok[u]) { const float* xr = row < NLAT ? xin + (size_t)row * D : cin + (size_t)(row - NLAT) * D;
#pragma unroll
            for (int j = 0; j < 4; ++j) v[u][j] = *(const f32x4*)(xr + 4 * F.lane + 256 * j); } }
#pragma unroll
        for (int u = 0; u < 2; ++u) if (ok[u]) { const int row = row0 + u * F.NGW; const int mr = modrow(row);
            norm_mod_row(v[u], n1g, msc + mr * 1024, msh + mr * 1024, H + (size_t)row * D, F.lane); } }
}
__device__ __forceinline__ void unpack8(const u32x4 w, float (&o)[8]) {
    o[0] = bf2f(w.x & 0xffffu); o[1] = bf2f(w.x >> 16); o[2] = bf2f(w.y & 0xffffu); o[3] = bf2f(w.y >> 16);
    o[4] = bf2f(w.z & 0xffffu); o[5] = bf2f(w.z >> 16); o[6] = bf2f(w.w & 0xffffu); o[7] = bf2f(w.w >> 16);
}
__device__ __forceinline__ void unpack4(const u32x2 w, float (&o)[4]) { o[0] = bf2f(w.x & 0xffffu); o[1] = bf2f(w.x >> 16); o[2] = bf2f(w.y & 0xffffu); o[3] = bf2f(w.y >> 16); }

__device__ __forceinline__ void shift_pass(const Frame& F0, int l) {
    const Frame F = phase_frame(F0); unsigned char* const ws = F.ws;
    const bf16* P = (const bf16*)(ws + WS_P); bf16* Zs = (bf16*)(ws + WS_ZS); const float* mu = inptr(I_MU) + l * ZW;
    const int total = NROW * 240;
    for (int idx = F.vcu * NTHR + F.tid; idx < total; idx += F.G * NTHR) {
        const int row = idx / 240, ck = idx % 240; const bf16* pr = P + (size_t)row * NP + ck * 8;
        const u32x4 zero = {0u, 0u, 0u, 0u};
        float z[8], n0[8], n1[8], n2[8], n3[8], o[8];
        unpack8(*(const u32x4*)pr, z);
        if (row < NLAT) { const int t = row & (SEQ - 1), gr = t >> 6, gc = t & 63;
            unpack8(gc > 0 ? *(const u32x4*)(pr - NP) : zero, n0); unpack8(gc < 63 ? *(const u32x4*)(pr + NP) : zero, n1);
            unpack8(gr > 0 ? *(const u32x4*)(pr - 64 * NP) : zero, n2); unpack8(gr < 127 ? *(const u32x4*)(pr + 64 * NP) : zero, n3);
        } else { const int tc = (row - NLAT) & (CTXL - 1);
            unpack8(tc > 0 ? *(const u32x4*)(pr - NP) : zero, n0); unpack8(tc < CTXL - 1 ? *(const u32x4*)(pr + NP) : zero, n1);
#pragma unroll
            for (int j = 0; j < 8; ++j) { n2[j] = n0[j]; n3[j] = n1[j]; }
        }
        const f32x4 m0 = *(const f32x4*)(mu + ck * 8), m1 = *(const f32x4*)(mu + ck * 8 + 4);
        const float m[8] = {m0.x, m0.y, m0.z, m0.w, m1.x, m1.y, m1.z, m1.w};
#pragma unroll
        for (int j = 0; j < 8; ++j) { const float nb = (j & 3) == 0 ? n0[j] : (j & 3) == 1 ? n1[j] : (j & 3) == 2 ? n2[j] : n3[j]; o[j] = z[j] + (nb - z[j]) * m[j]; }
        u32x4 w; w.x = pk2(o[0], o[1]); w.y = pk2(o[2], o[3]); w.z = pk2(o[4], o[5]); w.w = pk2(o[6], o[7]);
        *(u32x4*)(Zs + (size_t)row * ZW + ck * 8) = w;
    }
}

__device__ __forceinline__ void conv_pass(const Frame& F0, int l, int nrows) {
    const Frame F = phase_frame(F0); unsigned char* const ws = F.ws;
    const bf16* P = (const bf16*)(ws + WS_P); bf16* MA = (bf16*)(ws + WS_H);
    const float* cw = inptr(I_CONVW) + l * 3 * 256; const int c = 4 * F.lane;
    const f32x4 w0 = *(const f32x4*)(cw + c), w1 = *(const f32x4*)(cw + 256 + c), w2 = *(const f32x4*)(cw + 512 + c), gn = *(const f32x4*)(inptr(I_CONVG) + l * 256 + c);
    for (int row0 = F.gw; row0 < nrows; row0 += 2 * F.NGW) {
        u32x2 q[2][7]; bool ok[2]; const u32x2 zero = {0u, 0u};
#pragma unroll
        for (int u = 0; u < 2; ++u) { const int row = row0 + u * F.NGW; ok[u] = row < nrows; if (ok[u]) {
            int t, L; if (row < NLAT) { t = row & (SEQ - 1); L = SEQ; } else { t = (row - NLAT) & (CTXL - 1); L = CTXL; }
            const bf16* pr = P + (size_t)row * NP + COL_CONV + c;
            q[u][0] = *(const u32x2*)pr; q[u][1] = *(const u32x2*)(pr + 256); q[u][2] = *(const u32x2*)(pr + 512);
            q[u][3] = t > 0 ? *(const u32x2*)(pr - NP + 256) : zero; q[u][4] = t > 0 ? *(const u32x2*)(pr - NP + 512) : zero;
            q[u][5] = t < L - 1 ? *(const u32x2*)(pr + NP + 256) : zero; q[u][6] = t < L - 1 ? *(const u32x2*)(pr + NP + 512) : zero; } }
#pragma unroll
        for (int u = 0; u < 2; ++u) if (ok[u]) { const int row = row0 + u * F.NGW;
            float bg[4], cg[4], hh[4], cp[4], hp[4], cn[4], hn[4];
            unpack4(q[u][0], bg); unpack4(q[u][1], cg); unpack4(q[u][2], hh); unpack4(q[u][3], cp); unpack4(q[u][4], hp); unpack4(q[u][5], cn); unpack4(q[u][6], hn);
            const float W0[4] = {w0.x, w0.y, w0.z, w0.w}, W1[4] = {w1.x, w1.y, w1.z, w1.w}, W2[4] = {w2.x, w2.y, w2.z, w2.w}, GN[4] = {gn.x, gn.y, gn.z, gn.w};
            float y[4], s = 0.f;
#pragma unroll
            for (int j = 0; j < 4; ++j) { y[j] = bg[j] * (W0[j] * (cp[j] * hp[j]) + W1[j] * (cg[j] * hh[j]) + W2[j] * (cn[j] * hn[j])); s += y[j] * y[j]; }
            const float rs = rsqrtf(wave_sum(s) * (1.f / 256.f) + RMS_EPS);
            u32x2 o; o.x = pk2(y[0] * rs * GN[0], y[1] * rs * GN[1]); o.y = pk2(y[2] * rs * GN[2], y[3] * rs * GN[3]);
            *(u32x2*)(MA + (size_t)row * D + 512 + c) = o; }
    }
}

__device__ __forceinline__ void sincos_turns(float x, float& s, float& c) { s = __builtin_amdgcn_sinf(x); c = __builtin_amdgcn_cosf(x); }
#define MFMA16(a, b, c) __builtin_amdgcn_mfma_f32_16x16x32_bf16((a), (b), (c), 0, 0, 0)

__device__ __forceinline__ void fftA_item(const Frame& F0, int item) {
    const Frame F = phase_frame(F0); unsigned char* const ws = F.ws;
    const int half = item & 1, t2 = (item >> 1) & 63, b = item >> 7;
    const bf16* P = (const bf16*)(ws + WS_P); bf16* GT = (bf16*)(ws + WS_GT);
    LAS bf16* Bs = (LAS bf16*)F.lds;
    const int lane = F.lane, w = F.wave, fr = lane & 15, fq = lane >> 4;
    __syncthreads();
#pragma unroll
    for (int i = 0; i < 8; ++i) { const int cidx = F.tid + NTHR * i, krow = cidx >> 4, ch8 = cidx & 15, ri = krow >> 7, t1 = krow & 127;
        const u32x4 v = *(const u32x4*)(P + (size_t)(b * SEQ + t1 * 64 + t2) * NP + COL_FC + ri * 256 + half * 128 + ch8 * 8);
        LAS bf16* d = Bs + (ch8 * 8) * 264 + krow;
        d[0 * 264] = (bf16)(v.x & 0xffffu); d[1 * 264] = (bf16)(v.x >> 16); d[2 * 264] = (bf16)(v.y & 0xffffu); d[3 * 264] = (bf16)(v.y >> 16);
        d[4 * 264] = (bf16)(v.z & 0xffffu); d[5 * 264] = (bf16)(v.z >> 16); d[6 * 264] = (bf16)(v.w & 0xffffu); d[7 * 264] = (bf16)(v.w >> 16); }
    __syncthreads();
    f32x4 acc[2][8];
#pragma unroll
    for (int a = 0; a < 2; ++a)
#pragma unroll
        for (int n = 0; n < 8; ++n) acc[a][n] = (f32x4){0.f, 0.f, 0.f, 0.f};
    int t1p_a = 16 * w + fr;
    asm volatile("" : "+v"(t1p_a));
#pragma unroll
    for (int ks = 0; ks < 8; ++ks) {
        bf16x8 ar, ai;
#pragma unroll
        for (int j = 0; j < 8; ++j) { const int k = ks * 32 + 8 * fq + j, ri = k >> 7, t1 = k & 127; const int idx = (t1 * t1p_a) & 127;
            float sn, cs; sincos_turns((float)idx * (1.f / 128.f), sn, cs);
            const float vr = ri == 0 ? cs : -sn, vi = ri == 0 ? -sn : -cs;
            ar[j] = (short)f2bf(vr); ai[j] = (short)f2bf(vi); }
#pragma unroll
        for (int nt = 0; nt < 8; ++nt) { const bf16x8 bfr = *(const LAS bf16x8*)(Bs + (nt * 16 + fr) * 264 + ks * 32 + 8 * fq);
            acc[0][nt] = MFMA16(ar, bfr, acc[0][nt]); acc[1][nt] = MFMA16(ai, bfr, acc[1][nt]); }
    }
#pragma unroll
    for (int reg = 0; reg < 4; ++reg) { const int t1p = 16 * w + 4 * fq + reg; float st, ct; sincos_turns((float)(t2 * t1p) * (1.f / 8192.f), st, ct);
        bf16* g = GT + ((size_t)((b * 128 + t1p) * 64 + t2) * 2) * 256 + half * 128 + fr;
#pragma unroll
        for (int nt = 0; nt < 8; ++nt) { const float gr = acc[0][nt][reg], gi = acc[1][nt][reg];
            g[nt * 16] = (bf16)f2bf(gr * ct + gi * st); g[256 + nt * 16] = (bf16)f2bf(gi * ct - gr * st); } }
}

template <int NKC, int NDIV, class SrcRow, class OutRow>
__device__ __forceinline__ void dft64_item(const Frame& F0, int l, int m0, float sgn, float scale, SrcRow src, OutRow orow) {
    const Frame F = phase_frame(F0); unsigned char* const ws = F.ws;
    LAS bf16* Bs = (LAS bf16*)F.lds;
    LAS float* red = (LAS float*)(F.lds + 256 * 136 * 2);
    const int lane = F.lane, w = F.wave, fr = lane & 15, fq = lane >> 4;
    int fr_a = fr; asm volatile("" : "+v"(fr_a));
    f32x4 acc[4][2];
#pragma unroll
    for (int a = 0; a < 4; ++a) { acc[a][0] = (f32x4){0.f, 0.f, 0.f, 0.f}; acc[a][1] = (f32x4){0.f, 0.f, 0.f, 0.f}; }
    for (int kc = 0; kc < NKC; ++kc) {
        __syncthreads();
#pragma unroll
        for (int i = 0; i < 8; ++i) { const int cidx = F.tid + NTHR * i, krow = cidx >> 5, ch8 = cidx & 31;
            const u32x4 v = *(const u32x4*)(src(kc * 64 + (krow >> 1), krow & 1) + ch8 * 8);
            LAS bf16* d = Bs + (ch8 * 8) * 136 + krow;
            d[0 * 136] = (bf16)(v.x & 0xffffu); d[1 * 136] = (bf16)(v.x >> 16); d[2 * 136] = (bf16)(v.y & 0xffffu); d[3 * 136] = (bf16)(v.y >> 16);
            d[4 * 136] = (bf16)(v.z & 0xffffu); d[5 * 136] = (bf16)(v.z >> 16); d[6 * 136] = (bf16)(v.w & 0xffffu); d[7 * 136] = (bf16)(v.w >> 16); }
        __syncthreads();
#pragma unroll
        for (int ks = 0; ks < 4; ++ks) {
            const bf16x8 b0 = *(const LAS bf16x8*)(Bs + ((2 * w) * 16 + fr) * 136 + ks * 32 + 8 * fq);
            const bf16x8 b1 = *(const LAS bf16x8*)(Bs + ((2 * w + 1) * 16 + fr) * 136 + ks * 32 + 8 * fq);
#pragma unroll
            for (int mt = 0; mt < 4; ++mt) { const int mrow = m0 + mt * 16 + fr_a; bf16x8 a;
#pragma unroll
                for (int j = 0; j < 8; ++j) { const int k = ks * 32 + 8 * fq + j, tl = k >> 1, ri = k & 1; const int idx = ((kc * 64 + tl) * mrow) & (NDIV - 1);
                    float sn, cs; sincos_turns((float)idx * (1.f / (float)NDIV), sn, cs);
                    a[j] = (short)f2bf(ri == 0 ? cs : sgn * sn); }
                acc[mt][0] = MFMA16(a, b0, acc[mt][0]); acc[mt][1] = MFMA16(a, b1, acc[mt][1]); }
        }
    }
#pragma unroll
    for (int mt = 0; mt < 4; ++mt)
#pragma unroll
        for (int reg = 0; reg < 4; ++reg) { const float a = acc[mt][0][reg] * scale, b = acc[mt][1][reg] * scale; acc[mt][0][reg] = a; acc[mt][1][reg] = b;
            float s = a * a + b * b; s += __shfl_xor(s, 1); s += __shfl_xor(s, 2); s += __shfl_xor(s, 4); s += __shfl_xor(s, 8);
            if (fr == 0) red[w * 64 + mt * 16 + 4 * fq + reg] = s; }
    __syncthreads();
    bf16* MA = (bf16*)(ws + WS_H); const float* fg = inptr(I_FOURG) + l * 256;
    const float g0 = fg[(2 * w) * 16 + fr], g1 = fg[(2 * w + 1) * 16 + fr];
#pragma unroll
    for (int mt = 0; mt < 4; ++mt)
#pragma unroll
        for (int reg = 0; reg < 4; ++reg) { const int ml = mt * 16 + 4 * fq + reg; float tot = 0.f;
#pragma unroll
            for (int ww = 0; ww < 8; ++ww) tot += red[ww * 64 + ml];
            const float rs = rsqrtf(tot * (1.f / 256.f) + RMS_EPS);
            bf16* o = MA + (size_t)orow(m0 + ml) * D + 768 + fr;
            o[(2 * w) * 16] = (bf16)f2bf(acc[mt][0][reg] * rs * g0); o[(2 * w + 1) * 16] = (bf16)f2bf(acc[mt][1][reg] * rs * g1); }
    __syncthreads();
}

constexpr size_t WS_LORA = 64 * 1024;
constexpr int LINP = 392;
__device__ __forceinline__ float fast_sigmoid(float x) { return __builtin_amdgcn_rcpf(1.f + __expf(-x)); }
__device__ __forceinline__ float fast_tanh(float x) { return 1.f - 2.f * __builtin_amdgcn_rcpf(1.f + __expf(2.f * x)); }
__device__ __forceinline__ void prep_phase(const Frame& F0, int l) {
    const Frame F = phase_frame(F0); unsigned char* const ws = F.ws;
    const bf16* Zs = (const bf16*)(ws + WS_ZS); bf16* STR = (bf16*)(ws + WS_STR);
    LAS bf16* lin = (LAS bf16*)F.lds;
    LAS float* ssum = (LAS float*)(F.lds + 12544);
    LAS bf16* tiles = (LAS bf16*)(F.lds + 13312);
    const int lane = F.lane, fr = lane & 15, fq = lane >> 4, w = F.wave, tid = F.tid;
    const int nitems = (NROW / 16) * 2;
    int it = blockIdx.x; if (it >= nitems) return;
    int hh = -1, head = 0, cb = 0;
    bf16x8 wf[12][2];
    const float* kkp = inptr(I_KK) + l * DR; const float* kap = inptr(I_KA) + l * DR; const float* dw0 = inptr(I_DW0) + l * 2 * DR; const float* ia0 = inptr(I_IA0) + l * 2 * DR;
    u32x4 pz[2];
#define PREP_LOAD(item_) do { const int row0_ = ((item_) >> 1) * 16; \
        pz[0] = *(const u32x4*)(Zs + (size_t)(row0_ + tid / 48) * ZW + 1536 + (tid % 48) * 8); \
        if (tid < 256) pz[1] = *(const u32x4*)(Zs + (size_t)(row0_ + (tid + 512) / 48) * ZW + 1536 + ((tid + 512) % 48) * 8); } while (0)
    PREP_LOAD(it);
    for (; it < nitems; it += F.G) {
        const int tile = it >> 1;
        if ((it & 1) != hh) {
            hh = it & 1; head = 4 * hh + (w >> 1); cb = 64 * head + 32 * (w & 1);
            const bf16* WL = (const bf16*)(ws + WS_LORA) + (size_t)l * 512 * 384 + (size_t)(cb + fr) * 384 + 8 * fq;
#pragma unroll
            for (int ks = 0; ks < 12; ++ks)
#pragma unroll
                for (int nt = 0; nt < 2; ++nt) wf[ks][nt] = *(const bf16x8*)(WL + (size_t)nt * 16 * 384 + ks * 32);
        }
        __syncthreads();
        {   float v[8]; unpack8(pz[0], v); const int c8 = tid % 48;
            if (c8 < 16) {
#pragma unroll
                for (int j = 0; j < 8; ++j) v[j] = fast_tanh(v[j]); }
            else if (c8 >= 32) {
#pragma unroll
                for (int j = 0; j < 8; ++j) v[j] = fast_sigmoid(v[j]); }
            *(LAS u32x4*)(lin + (tid / 48) * LINP + c8 * 8) = (u32x4){pk2(v[0], v[1]), pk2(v[2], v[3]), pk2(v[4], v[5]), pk2(v[6], v[7])};
            if (tid < 256) { unpack8(pz[1], v); const int c9 = (tid + 512) % 48;
                if (c9 < 16) {
#pragma unroll
                    for (int j = 0; j < 8; ++j) v[j] = fast_tanh(v[j]); }
                else if (c9 >= 32) {
#pragma unroll
                    for (int j = 0; j < 8; ++j) v[j] = fast_sigmoid(v[j]); }
                *(LAS u32x4*)(lin + ((tid + 512) / 48) * LINP + c9 * 8) = (u32x4){pk2(v[0], v[1]), pk2(v[2], v[3]), pk2(v[4], v[5]), pk2(v[6], v[7])}; } }
        u32x2 zr2[2], zk2[2], zv2[2];
        {   const bf16* zr_ = Zs + (size_t)(tile * 16 + fr) * ZW + cb + 4 * fq;
#pragma unroll
            for (int nt = 0; nt < 2; ++nt) { zr2[nt] = *(const u32x2*)(zr_ + 16 * nt); zk2[nt] = *(const u32x2*)(zr_ + 512 + 16 * nt); zv2[nt] = *(const u32x2*)(zr_ + 1024 + 16 * nt); } }
        if (it + F.G < nitems) PREP_LOAD(it + F.G);
        __syncthreads();
        f32x4 kkw[2], kaw[2], d0w[2][2], i0w[2][2];
#pragma unroll
        for (int nt = 0; nt < 2; ++nt) { const int c0 = cb + 16 * nt + 4 * fq; kkw[nt] = *(const f32x4*)(kkp + c0); kaw[nt] = *(const f32x4*)(kap + c0);
#pragma unroll
            for (int dn = 0; dn < 2; ++dn) { d0w[dn][nt] = *(const f32x4*)(dw0 + dn * DR + c0); i0w[dn][nt] = *(const f32x4*)(ia0 + dn * DR + c0); } }
        f32x4 acc[5][2];
#pragma unroll
        for (int q = 0; q < 5; ++q) { acc[q][0] = (f32x4){0.f, 0.f, 0.f, 0.f}; acc[q][1] = (f32x4){0.f, 0.f, 0.f, 0.f}; }
#pragma unroll
        for (int ks = 0; ks < 12; ++ks) { const int q = ks < 8 ? (ks >> 1) : 4; const bf16x8 xf = *(const LAS bf16x8*)(lin + fr * LINP + ks * 32 + 8 * fq);
            acc[q][0] = MFMA16(wf[ks][0], xf, acc[q][0]); acc[q][1] = MFMA16(wf[ks][1], xf, acc[q][1]); }
        float zk[2][4], kv[2][4]; float ss = 0.f;
#pragma unroll
        for (int nt = 0; nt < 2; ++nt) { unpack4(zk2[nt], zk[nt]);
#pragma unroll
            for (int i = 0; i < 4; ++i) { kv[nt][i] = zk[nt][i] * kkw[nt][i]; ss += kv[nt][i] * kv[nt][i]; } }
        ss += __shfl_xor(ss, 16); ss += __shfl_xor(ss, 32);
        if (fq == 0) ssum[w * 16 + fr] = ss;
        __syncthreads();
        const float inv = __builtin_amdgcn_rcpf(fmaxf(sqrtf(ssum[w * 16 + fr] + ssum[(w ^ 1) * 16 + fr]), 1e-12f));
        LAS bf16* th = tiles + (w >> 1) * 10 * 1024 + fr * 64 + 32 * (w & 1) + 4 * fq;
#pragma unroll
        for (int nt = 0; nt < 2; ++nt) { LAS bf16* t0 = th + 16 * nt;
            *(LAS u32x2*)(t0) = zr2[nt]; *(LAS u32x2*)(t0 + 1024) = zv2[nt];
            float kk[4];
#pragma unroll
            for (int i = 0; i < 4; ++i) kk[i] = kv[nt][i] * inv;
            *(LAS u32x2*)(t0 + 2 * 1024) = (u32x2){pk2(kk[0], kk[1]), pk2(kk[2], kk[3])};
            *(LAS u32x2*)(t0 + 3 * 1024) = (u32x2){pk2(acc[4][nt][0], acc[4][nt][1]), pk2(acc[4][nt][2], acc[4][nt][3])};
#pragma unroll
            for (int dn = 0; dn < 2; ++dn) { float ep[4], kd[4], bb[4];
#pragma unroll
                for (int i = 0; i < 4; ++i) { const float ew = fast_sigmoid(d0w[dn][nt][i] + acc[dn][nt][i]) * 0.6065306597126334f;
                    ep[i] = ew * (1.f + ew * (-0.5f + ew * (0.16666667f + ew * (-0.041666668f + ew * 0.0083333338f))));
                    const float a = fast_sigmoid(i0w[dn][nt][i] + acc[2 + dn][nt][i]); kd[i] = zk[nt][i] * (1.f + (a - 1.f) * kaw[nt][i]); bb[i] = kk[i] * a; }
                *(LAS u32x2*)(t0 + (4 + 3 * dn) * 1024) = (u32x2){pk2(ep[0], ep[1]), pk2(ep[2], ep[3])};
                *(LAS u32x2*)(t0 + (5 + 3 * dn) * 1024) = (u32x2){pk2(kd[0], kd[1]), pk2(kd[2], kd[3])};
                *(LAS u32x2*)(t0 + (6 + 3 * dn) * 1024) = (u32x2){pk2(bb[0], bb[1]), pk2(bb[2], bb[3])}; } }
        __syncthreads();
        {   const LAS bf16* src = tiles + (w >> 1) * 10 * 1024 + 8 * (w & 1) * 64 + lane * 8; bf16* dst = STR + ((size_t)tile * 8 + head) * 10240 + 8 * (w & 1) * 64 + lane * 8;
#pragma unroll
            for (int s = 0; s < 10; ++s) *(u32x4*)(dst + s * 1024) = *(const LAS u32x4*)(src + s * 1024); }
    }
#undef PREP_LOAD
}

__device__ __forceinline__ int scan_rowof(int s, int dir, int b) { if (s < CTXL) { const int tc = dir ? (CTXL - 1 - s) : s; return NLAT + b * CTXL + tc; } const int tt = s - CTXL; const int t = dir ? (SEQ - 1 - tt) : tt; return b * SEQ + t; }
__device__ __forceinline__ void readout_pass(const Frame& F0, int l, int nrows) {
    const Frame F = phase_frame(F0); unsigned char* const ws = F.ws;
    const bf16* STR = (const bf16*)(ws + WS_STR); const bf16* Y0 = (const bf16*)(ws + WS_Y); const bf16* Y1 = Y0 + (size_t)NROW * DR; bf16* MA = (bf16*)(ws + WS_H);
    const int lane = F.lane, c = 8 * lane;
    float gw[8], gb[8], rk[8];
    {   const float* gnw = inptr(I_GNW) + l * DR + c; const float* gnb = inptr(I_GNB) + l * DR + c; const float* rkp = inptr(I_RK) + l * DR + c;
        const f32x4 a0 = *(const f32x4*)gnw, a1 = *(const f32x4*)(gnw + 4), b0 = *(const f32x4*)gnb, b1 = *(const f32x4*)(gnb + 4), r0 = *(const f32x4*)rkp, r1 = *(const f32x4*)(rkp + 4);
#pragma unroll
        for (int i = 0; i < 4; ++i) { gw[i] = a0[i]; gw[4 + i] = a1[i]; gb[i] = b0[i]; gb[4 + i] = b1[i]; rk[i] = r0[i]; rk[4 + i] = r1[i]; } }
    for (int row0 = F.gw; row0 < nrows; row0 += 2 * F.NGW) {
        u32x4 q[2][7]; bool ok[2];
#pragma unroll
        for (int u = 0; u < 2; ++u) { const int row = row0 + u * F.NGW; ok[u] = row < nrows; if (ok[u]) {
            const bf16* sr = STR + ((size_t)(row >> 4) * 8 + (lane >> 3)) * 10240 + (row & 15) * 64 + (lane & 7) * 8;
            q[u][0] = *(const u32x4*)(Y0 + (size_t)row * DR + c); q[u][1] = *(const u32x4*)(Y1 + (size_t)row * DR + c);
            q[u][2] = *(const u32x4*)sr; q[u][3] = *(const u32x4*)(sr + 1024); q[u][4] = *(const u32x4*)(sr + 3072); q[u][5] = *(const u32x4*)(sr + 5 * 1024); q[u][6] = *(const u32x4*)(sr + 8 * 1024); } }
#pragma unroll
        for (int u = 0; u < 2; ++u) if (ok[u]) { const int row = row0 + u * F.NGW;
            float ya[8], yb[8], r[8], v[8], g[8], k0[8], k1[8];
            unpack8(q[u][0], ya); unpack8(q[u][1], yb); unpack8(q[u][2], r); unpack8(q[u][3], v); unpack8(q[u][4], g); unpack8(q[u][5], k0); unpack8(q[u][6], k1);
            float s1 = 0.f, s2 = 0.f, sb = 0.f;
#pragma unroll
            for (int i = 0; i < 8; ++i) { ya[i] += yb[i]; s1 += ya[i]; s2 += ya[i] * ya[i]; sb += r[i] * (k0[i] + k1[i]) * rk[i]; }
#pragma unroll
            for (int o = 1; o < 8; o <<= 1) { s1 += __shfl_xor(s1, o); s2 += __shfl_xor(s2, o); sb += __shfl_xor(sb, o); }
            const float mu = s1 * (1.f / 64.f); const float var = fmaxf(s2 * (1.f / 64.f) - mu * mu, 0.f); const float rs = rsqrtf(var + GN_EPS);
            float o8[8];
#pragma unroll
            for (int i = 0; i < 8; ++i) o8[i] = ((ya[i] - mu) * rs * gw[i] + gb[i] + sb * v[i]) * g[i];
            *(u32x4*)(MA + (size_t)row * D + c) = (u32x4){pk2(o8[0], o8[1]), pk2(o8[2], o8[3]), pk2(o8[4], o8[5]), pk2(o8[6], o8[7])}; }
    }
}
constexpr int BLOB = 16384, SEGCH = 132, NSEG = 4, BLOB_B1_SCANS = 14;
constexpr size_t WS_BLOBA = 20 * MiB, WS_BLOBB1 = 86 * MiB, WS_BLOBB2 = 492 * MiB;
constexpr size_t WS_SCANST = 2 * MiB + 512 * 1024;
__device__ __forceinline__ unsigned char* blob_ptr(unsigned char* ws, int seg, int scan, int ci) {
    if ((seg & 1) == 0) return ws + WS_BLOBA + ((size_t)scan * SEGCH + ci) * BLOB;
    return scan < BLOB_B1_SCANS ? ws + WS_BLOBB1 + ((size_t)scan * SEGCH + ci) * BLOB : ws + WS_BLOBB2 + ((size_t)(scan - BLOB_B1_SCANS) * SEGCH + ci) * BLOB;
}
typedef short s16x4 __attribute__((ext_vector_type(4)));
__device__ __forceinline__ bf16x8 frag_lo(u32x2 x) { u32x4 t = {x.x, x.y, 0u, 0u}; return __builtin_bit_cast(bf16x8, t); }
__device__ __forceinline__ bf16x8 frag_c(const f32x4& a) { u32x4 t = {pk2(a[0], a[1]), pk2(a[2], a[3]), 0u, 0u}; return __builtin_bit_cast(bf16x8, t); }

struct PreRegs { u32x4 q[12]; };
__device__ __forceinline__ void pre_load(PreRegs& R, unsigned char* ws, int scan, int cs, int lane) {
    const int dir = scan & 1, h = (scan >> 1) & 7, b = scan >> 4; const int rfirst = scan_rowof(16 * cs, dir, b);
    const bf16* blk = (const bf16*)(ws + WS_STR) + ((size_t)(rfirst >> 4) * 8 + h) * 10240 + lane * 8;
    const int so[6] = {0, 1, 2, 4 + 3 * dir, 5 + 3 * dir, 6 + 3 * dir};
#pragma unroll
    for (int i = 0; i < 6; ++i) { R.q[2 * i] = *(const u32x4*)(blk + so[i] * 1024); R.q[2 * i + 1] = *(const u32x4*)(blk + so[i] * 1024 + 512); }
}
template <int PM>
__device__ __forceinline__ void pre_item(const Frame& F, unsigned char* ws, int scan, int cs, unsigned char* blob, PreRegs& PR, int nscan, int ncs) {
    const int dir = scan & 1, h = (scan >> 1) & 7, b = scan >> 4; const int lane = F.lane, fr = lane & 15, fq = lane >> 4;
    LAS unsigned char* L = F.lds + F.wave * 17408;
    LAS bf16* TK = (LAS bf16*)L; LAS bf16* TR = TK + 1024; LAS bf16* TKt = TR + 1024; LAS bf16* TB = TKt + 1024;
    LAS bf16* KTt = TB + 1024; LAS bf16* RTt = KTt + 1024; LAS bf16* Vt = RTt + 1024;
    LAS float* AKB = (LAS float*)(Vt + 1024);
    LAS bf16* AKK = (LAS bf16*)(AKB + 256); LAS bf16* ARK = AKK + 256; LAS bf16* ARB = ARK + 256; LAS bf16* TT = ARB + 256;
    float kh[16], bh[16];
    float pc;
    {   float r_[16], v_[16], kk_[16], lp_[16], kd_[16], bb_[16];
        LAS bf16* stg = TK;
#pragma unroll
        for (int i = 0; i < 6; ++i) { *(LAS u32x4*)(stg + i * 1024 + lane * 8) = PR.q[2 * i]; *(LAS u32x4*)(stg + i * 1024 + 512 + lane * 8) = PR.q[2 * i + 1]; }
        LDS_WAIT(); asm volatile("" ::: "memory");
        if (nscan >= 0) pre_load(PR, ws, nscan, ncs, lane);
#pragma unroll
        for (int t = 0; t < 16; ++t) { const int tm = (dir ? 15 - t : t) * 64 + lane;
            r_[t] = bf2f(stg[tm]); v_[t] = bf2f(stg[1024 + tm]); kk_[t] = bf2f(stg[2048 + tm]); lp_[t] = bf2f(stg[3072 + tm]); kd_[t] = bf2f(stg[4096 + tm]); bb_[t] = bf2f(stg[5120 + tm]); }
        LDS_WAIT(); asm volatile("" ::: "memory");
        float pp = 1.f; u32x4 kt4[2], rt4[2], v4[2];
        unsigned ktp[8], rtp[8], vp[8];
#pragma unroll
        for (int t = 0; t < 16; ++t) { const float pm1 = pp; pp *= 1.f - lp_[t]; const float p = pp, ip = __builtin_amdgcn_rcpf(pp); lp_[t] = ip;
            const float kt = kk_[t] * pm1, ktl = kd_[t] * ip, btl = bb_[t] * ip, rt = r_[t] * p;
            const unsigned hk = pk2(kt, rt), hb = pk2(ktl, btl);
            TK[t * 64 + lane] = (bf16)(hk & 0xffffu); TR[t * 64 + lane] = (bf16)(hk >> 16); TKt[t * 64 + lane] = (bf16)(hb & 0xffffu); TB[t * 64 + lane] = (bf16)(hb >> 16);
            const unsigned hv = f2bf(v_[t]);
            if (t & 1) { ktp[t >> 1] |= hk << 16; rtp[t >> 1] |= hk & 0xffff0000u; vp[t >> 1] |= hv << 16; }
            else { ktp[t >> 1] = hk & 0xffffu; rtp[t >> 1] = hk >> 16; vp[t >> 1] = hv; } }
        kt4[0] = (u32x4){ktp[0], ktp[1], ktp[2], ktp[3]}; kt4[1] = (u32x4){ktp[4], ktp[5], ktp[6], ktp[7]};
        rt4[0] = (u32x4){rtp[0], rtp[1], rtp[2], rtp[3]}; rt4[1] = (u32x4){rtp[4], rtp[5], rtp[6], rtp[7]};
        v4[0] = (u32x4){vp[0], vp[1], vp[2], vp[3]}; v4[1] = (u32x4){vp[4], vp[5], vp[6], vp[7]};
        *(LAS u32x4*)(KTt + lane * 16) = kt4[0]; *(LAS u32x4*)(KTt + lane * 16 + 8) = kt4[1];
        *(LAS u32x4*)(RTt + lane * 16) = rt4[0]; *(LAS u32x4*)(RTt + lane * 16 + 8) = rt4[1];
        *(LAS u32x4*)(Vt + lane * 16) = v4[0]; *(LAS u32x4*)(Vt + lane * 16 + 8) = v4[1];
        pc = pp;
#pragma unroll
        for (int t = 0; t < 16; ++t) { const float e = pp * lp_[t]; kh[t] = kd_[t] * e; bh[t] = bb_[t] * e; }
    }
    LDS_WAIT(); asm volatile("" ::: "memory");
    {   f32x4 akb = {0.f, 0.f, 0.f, 0.f}, akk = akb, ark = akb, arb = akb;
#pragma unroll
        for (int s = 0; s < 2; ++s) { const int o = fr * 64 + 32 * s + 8 * fq;
            const bf16x8 fk = *(const LAS bf16x8*)(TK + o), frr = *(const LAS bf16x8*)(TR + o), fkt = *(const LAS bf16x8*)(TKt + o), fb = *(const LAS bf16x8*)(TB + o);
            akb = MFMA16(fk, fb, akb); akk = MFMA16(fk, fkt, akk); ark = MFMA16(frr, fkt, ark); arb = MFMA16(frr, fb, arb); }
        float nm[4];
#pragma unroll
        for (int reg = 0; reg < 4; ++reg) { const int t = 4 * fq + reg; const bool lo = fr < t, le = fr <= t;
            nm[reg] = lo ? akb[reg] : 0.f; AKK[t * 16 + fr] = (bf16)f2bf(lo ? akk[reg] : 0.f);
            ARK[t * 16 + fr] = (bf16)f2bf(le ? ark[reg] : 0.f); ARB[t * 16 + fr] = (bf16)f2bf(le ? arb[reg] : 0.f); }
        float col[16];
#pragma unroll
        for (int t = 0; t < 16; ++t) { float s_ = (t == fr) ? 1.f : 0.f;
#pragma unroll
            for (int i = 0; i < 16; ++i) if (i < t) { const float n_ti = __builtin_bit_cast(float, __builtin_amdgcn_readlane(__builtin_bit_cast(int, nm[t & 3]), i + 16 * (t >> 2))); s_ -= n_ti * col[i]; }
            col[t] = s_; TT[t * 16 + fr] = (bf16)f2bf(s_); }
    }
    LDS_WAIT(); asm volatile("" ::: "memory");
    f32x4 WTc[4], RqT[4], U0c[4], Y0c[4];
    {   const bf16x8 aT = frag_lo(*(const LAS u32x2*)(TT + fr * 16 + 4 * fq)), aKK = frag_lo(*(const LAS u32x2*)(AKK + fr * 16 + 4 * fq)), aRK = frag_lo(*(const LAS u32x2*)(ARK + fr * 16 + 4 * fq));
        u32x2 nb = *(const LAS u32x2*)(ARB + fr * 16 + 4 * fq); nb.x ^= 0x80008000u; nb.y ^= 0x80008000u; const bf16x8 aRBn = frag_lo(nb);
        const f32x4 z4 = {0.f, 0.f, 0.f, 0.f};
#pragma unroll
        for (int nt = 0; nt < 4; ++nt) { const int o = (16 * nt + fr) * 16 + 4 * fq;
            const bf16x8 bK = frag_lo(*(const LAS u32x2*)(KTt + o)), bV = frag_lo(*(const LAS u32x2*)(Vt + o));
            float ri[4]; unpack4(*(const LAS u32x2*)(TR + fr * 64 + 16 * nt + 4 * fq), ri);
            const f32x4 Wn = MFMA16(aT, bK, z4); WTc[nt] = MFMA16(bK, aT, z4);
            const f32x4 Zn = MFMA16(aKK, bV, z4);
            U0c[nt] = MFMA16(aT, frag_c(Zn), z4);
            RqT[nt] = MFMA16(frag_c(Wn), aRBn, ((f32x4){ri[0], ri[1], ri[2], ri[3]}));
            Y0c[nt] = MFMA16(aRK, bV, z4); Y0c[nt] = MFMA16(aRBn, frag_c(U0c[nt]), Y0c[nt]); }
    }
    LDS_WAIT(); asm volatile("" ::: "memory");
#pragma unroll
    for (int nt = 0; nt < 4; ++nt) { const u32x2 vv = *(const LAS u32x2*)(Vt + (16 * nt + fr) * 16 + 4 * fq);
        *(u32x2*)(blob + 8192 + nt * 2048 + 1024 + lane * 8) = vv;
        u32x2 u0 = {pk2(U0c[nt][0], U0c[nt][1]), pk2(U0c[nt][2], U0c[nt][3])}, y0 = {pk2(Y0c[nt][0], Y0c[nt][1]), pk2(Y0c[nt][2], Y0c[nt][3])};
        *(u32x2*)(blob + 8192 + nt * 2048 + lane * 8) = u0; *(u32x2*)(blob + 8192 + nt * 2048 + 512 + lane * 8) = y0;
        *(float*)(blob + 8192 + nt * 2048 + 1536 + lane * 4) = pc; }
#pragma unroll
    for (int s = 0; s < 2; ++s) {
        *(u32x4*)(blob + (0 * 2 + s) * 1024 + lane * 16) = (u32x4){pk2(WTc[2 * s][0], WTc[2 * s][1]), pk2(WTc[2 * s][2], WTc[2 * s][3]), pk2(WTc[2 * s + 1][0], WTc[2 * s + 1][1]), pk2(WTc[2 * s + 1][2], WTc[2 * s + 1][3])};
        *(u32x4*)(blob + (1 * 2 + s) * 1024 + lane * 16) = (u32x4){pk2(RqT[2 * s][0], RqT[2 * s][1]), pk2(RqT[2 * s][2], RqT[2 * s][3]), pk2(RqT[2 * s + 1][0], RqT[2 * s + 1][1]), pk2(RqT[2 * s + 1][2], RqT[2 * s + 1][3])}; }
    LAS bf16* BHt = TKt; LAS bf16* KHt = TB;
    {   u32x4 a, c, d, e;
        a = (u32x4){pk2(bh[0], bh[1]), pk2(bh[2], bh[3]), pk2(bh[4], bh[5]), pk2(bh[6], bh[7])}; c = (u32x4){pk2(bh[8], bh[9]), pk2(bh[10], bh[11]), pk2(bh[12], bh[13]), pk2(bh[14], bh[15])};
        d = (u32x4){pk2(kh[0], kh[1]), pk2(kh[2], kh[3]), pk2(kh[4], kh[5]), pk2(kh[6], kh[7])}; e = (u32x4){pk2(kh[8], kh[9]), pk2(kh[10], kh[11]), pk2(kh[12], kh[13]), pk2(kh[14], kh[15])};
        *(LAS u32x4*)(BHt + lane * 16) = a; *(LAS u32x4*)(BHt + lane * 16 + 8) = c; *(LAS u32x4*)(KHt + lane * 16) = d; *(LAS u32x4*)(KHt + lane * 16 + 8) = e; }
    LDS_WAIT(); asm volatile("" ::: "memory");
#pragma unroll
    for (int mt = 0; mt < 4; ++mt) { const int o = (16 * mt + fr) * 16 + 4 * fq; const u32x2 bb = *(const LAS u32x2*)(BHt + o), kk = *(const LAS u32x2*)(KHt + o);
        *(u32x4*)(blob + 4096 + mt * 1024 + lane * 16) = (u32x4){bb.x ^ 0x80008000u, bb.y ^ 0x80008000u, kk.x, kk.y}; }
    LDS_WAIT(); asm volatile("" ::: "memory");
}

__device__ __forceinline__ void pre_phase(const Frame& F0, int seg, int b_lo) {
    const Frame F = phase_frame(F0); unsigned char* const ws = F.ws;
    if ((int)blockIdx.x < b_lo) return;
    const int nwv = (F.G - b_lo) * NWAVES;
    PreRegs R;
    int it = ((int)blockIdx.x - b_lo) * NWAVES + F.wave; if (it >= 32 * SEGCH) return;
    pre_load(R, ws, it & 31, seg * SEGCH + (it >> 5), F.lane);
    for (; it < 32 * SEGCH; it += nwv) { const int nx = it + nwv; const bool hn = nx < 32 * SEGCH;
        pre_item<0>(F, ws, it & 31, seg * SEGCH + (it >> 5), blob_ptr(ws, seg, it & 31, it >> 5), R, hn ? (nx & 31) : -1, seg * SEGCH + (nx >> 5)); }
}

constexpr int SQ_SLOT = 10240, SQ_R = 12, SQ_D = 8;
template <int MODE>
__device__ __forceinline__ void seq_item(const Frame& F0, int item, int seg, bool need_ctx) {
    const Frame F = phase_frame(F0); unsigned char* const ws = F.ws;
    const int scan = item >> 2, vb = item & 3, dir = scan & 1, h = (scan >> 1) & 7, b = scan >> 4; const int lane = F.lane, fr = lane & 15, fq = lane >> 4, w = F.wave;
    const unsigned char* blob = blob_ptr(ws, seg, scan, 0);
    LAS unsigned char* ring = F.lds;
    __syncthreads();
    const int p0 = 2 * (w - 1);
    const unsigned goff0 = (p0 < 8 ? p0 * 1024 : 8192 + vb * 2048 + (p0 - 8) * 1024) + lane * 16, goff1 = (p0 + 1 < 8 ? (p0 + 1) * 1024 : 8192 + vb * 2048 + (p0 + 1 - 8) * 1024) + lane * 16;
#define SQ_ISSUE(c) do { const unsigned char* g_ = blob + (size_t)(c) * BLOB; LAS unsigned char* s_ = ring + ((c) % SQ_R) * SQ_SLOT + p0 * 1024; \
        __builtin_amdgcn_global_load_lds((const unsigned*)(g_ + goff0), (LAS unsigned*)(s_), 16, 0, 0); \
        __builtin_amdgcn_global_load_lds((const unsigned*)(g_ + goff1), (LAS unsigned*)(s_ + 1024), 16, 0, 0); } while (0)
    const bool loader = (w >= 1 && w <= 5) && MODE != 2;
    if (loader) { for (int c = 0; c < SQ_D; ++c) SQ_ISSUE(c); }
    bf16* Y = (bf16*)(ws + WS_Y) + (size_t)dir * NROW * DR + h * 64 + 16 * vb + fr;
    float* st = (float*)(ws + WS_SCANST) + (size_t)item * 1024 + lane * 4;
    f32x4 M[4];
#pragma unroll
    for (int mt = 0; mt < 4; ++mt) M[mt] = (seg == 0 || w != 0) ? (f32x4){0.f, 0.f, 0.f, 0.f} : *(const f32x4*)(st + mt * 256);
    const f32x4 z4 = {0.f, 0.f, 0.f, 0.f};
    LAS unsigned char* mb = ring + SQ_R * SQ_SLOT;
    struct SQ { bf16x8 a1[2], a2[4]; f32x4 pc[4]; u32x2 u0, vv; };
#define SQ_READ(R, c) do { const LAS unsigned char* sl_ = ring + ((c) % SQ_R) * SQ_SLOT; _Pragma("unroll") for (int i = 0; i < 4; ++i) { \
        R.a2[i] = *(const LAS bf16x8*)(sl_ + 4096 + i * 1024 + lane * 16); R.pc[i] = *(const LAS f32x4*)(sl_ + 8192 + 1536 + (16 * i + 4 * fq) * 4); } \
        R.a1[0] = *(const LAS bf16x8*)(sl_ + lane * 16); R.a1[1] = *(const LAS bf16x8*)(sl_ + 1024 + lane * 16); \
        R.u0 = *(const LAS u32x2*)(sl_ + 8192 + lane * 8); R.vv = *(const LAS u32x2*)(sl_ + 8192 + 1024 + lane * 8); } while (0)
#define SQ_STEP(R, c, RN, cn) do { \
        if ((cn) < SEGCH) SQ_READ(RN, cn); \
        const u32x4 t0 = {pk2(M[0][0], M[0][1]), pk2(M[0][2], M[0][3]), pk2(M[1][0], M[1][1]), pk2(M[1][2], M[1][3])}; \
        const u32x4 t1 = {pk2(M[2][0], M[2][1]), pk2(M[2][2], M[2][3]), pk2(M[3][0], M[3][1]), pk2(M[3][2], M[3][3])}; \
        *(LAS u32x4*)(mb + ((c) & 1) * 2048 + lane * 16) = t0; *(LAS u32x4*)(mb + ((c) & 1) * 2048 + 1024 + lane * 16) = t1; \
        const bf16x8 b0 = __builtin_bit_cast(bf16x8, t0), b1 = __builtin_bit_cast(bf16x8, t1); \
        f32x4 X0 = MFMA16(R.a1[0], b0, z4); X0 = MFMA16(R.a1[1], b1, X0); \
        float u0[4]; unpack4(R.u0, u0); \
        const u32x4 tb = {pk2(X0[0] + u0[0], X0[1] + u0[1]), pk2(X0[2] + u0[2], X0[3] + u0[3]), R.vv.x, R.vv.y}; const bf16x8 bB = __builtin_bit_cast(bf16x8, tb); \
        _Pragma("unroll") for (int mt = 0; mt < 4; ++mt) M[mt] = MFMA16(R.a2[mt], bB, R.pc[mt] * M[mt]); \
        asm volatile("s_waitcnt lgkmcnt(0)" ::: "memory"); } while (0)
    const long ystep = dir ? -(long)DR : (long)DR;
#define SQ_YSTEP(c) do { const int cs_ = seg * SEGCH + (c); if (MODE == 0 && (need_ctx || cs_ >= 16)) { const LAS unsigned char* sl_ = ring + ((c) % SQ_R) * SQ_SLOT; \
        const bf16x8 q0 = *(const LAS bf16x8*)(sl_ + 2048 + lane * 16), q1 = *(const LAS bf16x8*)(sl_ + 3072 + lane * 16); \
        const bf16x8 b0 = *(const LAS bf16x8*)(mb + ((c) & 1) * 2048 + lane * 16), b1 = *(const LAS bf16x8*)(mb + ((c) & 1) * 2048 + 1024 + lane * 16); \
        float y0[4]; unpack4(*(const LAS u32x2*)(sl_ + 8192 + 512 + lane * 8), y0); \
        f32x4 X1 = MFMA16(q0, b0, z4); X1 = MFMA16(q1, b1, X1); \
        bf16* yp = Y + (size_t)scan_rowof(16 * cs_ + 4 * fq, dir, b) * DR; \
        yp[0] = (bf16)f2bf(X1[0] + y0[0]); yp[ystep] = (bf16)f2bf(X1[1] + y0[1]); yp[2 * ystep] = (bf16)f2bf(X1[2] + y0[2]); yp[3 * ystep] = (bf16)f2bf(X1[3] + y0[3]); \
        asm volatile("s_waitcnt lgkmcnt(0)" ::: "memory"); } } while (0)
#define SQ_LOADER(c) do { if (loader) { __builtin_amdgcn_s_sleep(3); if ((c) + SQ_D < SEGCH) { SQ_ISSUE((c) + SQ_D); asm volatile("s_waitcnt vmcnt(12)" ::: "memory"); } else asm volatile("s_waitcnt vmcnt(0)" ::: "memory"); } \
        __builtin_amdgcn_s_barrier(); asm volatile("" ::: "memory"); } while (0)
    const bool stw = (w == 0 && MODE != 1), yw = (w == 6 && MODE != 1);
    SQ Ra, Rb, Rc;
    SQ_LOADER(0);
    if (stw) { SQ_READ(Ra, 0); SQ_READ(Rb, 1); }
    for (int c = 0; c < SEGCH; c += 3) {
        SQ_LOADER(c + 1);
        if (stw) SQ_STEP(Ra, c, Rc, c + 2);
        if (yw && c > 0) SQ_YSTEP(c - 1);
        SQ_LOADER(c + 2);
        if (stw) SQ_STEP(Rb, c + 1, Ra, c + 3);
        if (yw) SQ_YSTEP(c);
        SQ_LOADER(c + 3);
        if (stw) SQ_STEP(Rc, c + 2, Rb, c + 4);
        if (yw) SQ_YSTEP(c + 1);
    }
    __builtin_amdgcn_s_barrier(); asm volatile("" ::: "memory");
    if (yw) SQ_YSTEP(SEGCH - 1);
#undef SQ_READ
#undef SQ_STEP
#undef SQ_YSTEP
#undef SQ_LOADER
#undef SQ_ISSUE
    if (MODE >= 2 && w == 0 && M[0][0] + M[1][1] + M[2][2] + M[3][3] == 12345.678f) st[0] = M[0][0];
    if (MODE == 0 && w == 0 && seg + 1 < NSEG) {
#pragma unroll
        for (int mt = 0; mt < 4; ++mt) *(f32x4*)(st + mt * 256) = M[mt]; }
    __syncthreads();
}

namespace pg8 {
struct EpiStoreBf16 {
    static constexpr bool PERM = true, AFTER_DRAIN = false;
    bf16_t* O; int ldc; int pn_mask;
    __device__ __forceinline__ void operator()(const f32x4 (&acc)[2][2][4][2], const Unit& u, int wr, int wc, int fr, int fq) const {
        const int row0 = u.pm * BM + wr * 64 + fr; const int col0 = (u.pn & pn_mask) * BM + wc * 32 + 8 * fq;
#pragma unroll
        for (int ai = 0; ai < 2; ++ai)
#pragma unroll
            for (int m = 0; m < 4; ++m) { bf16_t* rowp = O + (size_t)(row0 + ai * HALF + m * 16) * ldc + col0;
#pragma unroll
                for (int bj = 0; bj < 2; ++bj) { const f32x4 v0 = acc[ai][bj][m][0], v1 = acc[ai][bj][m][1];
                    u32x4 w; w.x = cvt_pk_bf16(v0[0], v0[1]); w.y = cvt_pk_bf16(v0[2], v0[3]); w.z = cvt_pk_bf16(v1[0], v1[1]); w.w = cvt_pk_bf16(v1[2], v1[3]);
                    *(u32x4*)(rowp + bj * HALF) = w; } }
    }
};
struct EpiSwiGLU {
    static constexpr bool PERM = true, AFTER_DRAIN = false;
    bf16_t* O;
    __device__ __forceinline__ void operator()(const f32x4 (&acc)[2][2][4][2], const Unit& u, int wr, int wc, int fr, int fq) const {
        const int row0 = u.pm * BM + wr * 64 + fr; const int col0 = ((u.pn & 3) * BM + wc * 32 + 8 * fq) >> 1;
#pragma unroll
        for (int ai = 0; ai < 2; ++ai)
#pragma unroll
            for (int m = 0; m < 4; ++m) { bf16_t* rowp = O + (size_t)(row0 + ai * HALF + m * 16) * 512 + col0;
#pragma unroll
                for (int bj = 0; bj < 2; ++bj) { const f32x4 g = acc[ai][bj][m][0], up = acc[ai][bj][m][1]; float a[4];
#pragma unroll
                    for (int i = 0; i < 4; ++i) a[i] = g[i] / (1.f + __expf(-g[i])) * up[i];
                    unsigned long long w = (unsigned long long)cvt_pk_bf16(a[0], a[1]) | ((unsigned long long)cvt_pk_bf16(a[2], a[3]) << 32);
                    *(unsigned long long*)(rowp + bj * (HALF / 2)) = w; } }
    }
};
template <bool XF32> struct EpiResidual {
    static constexpr bool PERM = false, AFTER_DRAIN = false;
    const void* xlat; const void* xctx;
    bf16_t* out; const float* g1;
    __device__ __forceinline__ void operator()(const f32x4 (&acc)[2][2][4][2], const Unit& u, int wr, int wc, int fr, int fq) const {
        const int rowt = u.pm * BM; const int mr = rowt < 16384 ? (rowt >> 13) : 2;
        const size_t boff = rowt < 16384 ? (size_t)rowt * 1024 : (size_t)(rowt - 16384) * 1024; const void* bp = rowt < 16384 ? xlat : xctx;
        const int col0 = u.pn * BM + wc * 32 + 4 * fq;
        f32x4 gv[2][2];
#pragma unroll
        for (int bj = 0; bj < 2; ++bj)
#pragma unroll
            for (int n = 0; n < 2; ++n) gv[bj][n] = *(const f32x4*)(g1 + (size_t)mr * 6144 + col0 + bj * HALF + n * 16);
#pragma unroll
        for (int ai = 0; ai < 2; ++ai)
#pragma unroll
            for (int m = 0; m < 4; ++m) { const int rl = ai * HALF + wr * 64 + m * 16 + fr;
#pragma unroll
                for (int bj = 0; bj < 2; ++bj)
#pragma unroll
                    for (int n = 0; n < 2; ++n) { const size_t off = (size_t)rl * 1024 + col0 + bj * HALF + n * 16;
                        f32x4 xo;
                        if (XF32) xo = *(const f32x4*)((const float*)bp + boff + off);
                        else { const unsigned long long w_ = *(const unsigned long long*)((const bf16_t*)bp + boff + off); const unsigned lo = (unsigned)w_, hi = (unsigned)(w_ >> 32);
                            xo = (f32x4){__uint_as_float(lo << 16), __uint_as_float(lo & 0xffff0000u), __uint_as_float(hi << 16), __uint_as_float(hi & 0xffff0000u)}; }
                        const f32x4 r = xo + gv[bj][n] * acc[ai][bj][m][n];
                        *(unsigned long long*)(out + (size_t)rowt * 1024 + off) = (unsigned long long)cvt_pk_bf16(r[0], r[1]) | ((unsigned long long)cvt_pk_bf16(r[2], r[3]) << 32); } }
    }
};
struct MoeOrder {
    const PG8_LAS int* tile_e; const PG8_LAS int* tile_t; int ntiles, G, c;
    __device__ bool next(int i, Unit& u) const { const long L = (long)i * G + c; if (L >= 4L * ntiles) return false; const int pm = (int)(L >> 2); const int e = tile_e[pm];
        u.pm = pm; u.pn = e * 4 + (int)(L & 3); u.ga = e * 16896 + tile_t[pm] * 256; return true; }
    __device__ __forceinline__ void a_ready(const Unit&) const {}
    __device__ __forceinline__ void done(const Unit&) const {}
};
}

__device__ __forceinline__ void expert_convert(const Frame& F0, int l, int b_lo) {
    const Frame F = phase_frame(F0); unsigned char* const ws = F.ws;
    if ((int)blockIdx.x < b_lo) return;
    const int nwv = (F.G - b_lo) * NWAVES, myw = ((int)blockIdx.x - b_lo) * NWAVES + F.wave;
    LAS float* scr = (LAS float*)(F.lds + F.wave * 16384);
    bf16* wgu = (bf16*)(ws + WS_WGU_T); bf16* wd = (bf16*)(ws + WS_WD_T);
    constexpr int I_G = 16 * 16, I_D = 8 * 32;
    constexpr int NIT = NEXP * (2 * I_G + I_D);
    const float* p_eg = inptr(I_EG); const float* p_eu = inptr(I_EU); const float* p_ed = inptr(I_ED);
    for (int it = myw; it < NIT; it += nwv) { const int e = it / (2 * I_G + I_D); int r = it % (2 * I_G + I_D);
        if (r < I_G) { transpose_item(p_eg + ((size_t)l * NEXP + e) * D * DEXP, DEXP, (r >> 4) * 64, (r & 15) * 32, wgu, D, RmGU{e * 1024}, scr, F.lane); continue; } r -= I_G;
        if (r < I_G) { transpose_item(p_eu + ((size_t)l * NEXP + e) * D * DEXP, DEXP, (r >> 4) * 64, (r & 15) * 32, wgu, D, RmGU{e * 1024 + 4}, scr, F.lane); continue; } r -= I_G;
        transpose_item(p_ed + ((size_t)l * NEXP + e) * DEXP * D, D, (r >> 5) * 64, (r & 31) * 32, wd, DEXP, RmId{e * 1024}, scr, F.lane);
    }
}

__device__ __forceinline__ void router_pass(const Frame& F0, int l, int nrows, int cnt_off = 0) {
    const Frame F = phase_frame(F0); unsigned char* const ws = F.ws;
    constexpr int HP = 1028;
    LAS float* msh = (LAS float*)F.lds; LAS float* msc = msh + 3072; LAS float* hrow = msc + 3072;
    LAS float* part = hrow + 16 * HP;
    LAS float* lgs = part + 8 * 16 * 48;
    LAS unsigned* lcnt = (LAS unsigned*)(lgs + 16 * 40);
    if (F0.tid < 64) lcnt[F0.tid] = 0u;
    __syncthreads();
    mod_to_lds(F, l, 3, msh, false); mod_to_lds(F, l, 4, msc, false); __syncthreads();
    const bf16* X = (const bf16*)(ws + WS_X); bf16* H = (bf16*)(ws + WS_H);
    const float* rgw = inptr(I_RGW) + (size_t)l * D * 4; const float* rew = inptr(I_REW) + (size_t)l * D * NEXP;
    const float* rgb = inptr(I_RGB) + l * 4; const float* reb = inptr(I_REB) + l * NEXP;
    int* rt_e = (int*)(ws + WS_ROUTE + RT_E); int* rt_pos = (int*)(ws + WS_ROUTE + RT_POS); float* rt_gate = (float*)(ws + WS_ROUTE + RT_GATE);
    unsigned* cnt = (unsigned*)(ws + WS_CTL) + CW_CNT + 64 * l + cnt_off;
    const int lane = F.lane, w = F.wave, fr = lane & 15, fq = lane >> 4; const float* n2g = inptr(I_N2G) + l * D;
    float bw[32][3];
#pragma unroll
    for (int ks = 0; ks < 32; ++ks) { const int k = 128 * w + 4 * ks + fq;
        bw[ks][0] = rew[(size_t)k * 32 + fr]; bw[ks][1] = rew[(size_t)k * 32 + 16 + fr]; bw[ks][2] = fr < 4 ? rgw[(size_t)k * 4 + fr] : 0.f; }
    const int ntiles = nrows >> 4;
    u32x2 pv[2][4];
    if (F.vcu < ntiles) {
#pragma unroll
        for (int rr = 0; rr < 2; ++rr)
#pragma unroll
            for (int j = 0; j < 4; ++j) pv[rr][j] = *(const u32x2*)(X + (size_t)(F.vcu * 16 + 2 * w + rr) * D + 4 * lane + 256 * j); }
    for (int gi = F.vcu; gi < ntiles; gi += F.G) {
#pragma unroll
        for (int rr = 0; rr < 2; ++rr) { const int r = 2 * w + rr, row = gi * 16 + r; f32x4 v[4];
#pragma unroll
            for (int j = 0; j < 4; ++j) { float t_[4]; unpack4(pv[rr][j], t_); v[j] = (f32x4){t_[0], t_[1], t_[2], t_[3]}; }
            const int mr = modrow(row);
            norm_mod_row(v, n2g, msc + mr * 1024, msh + mr * 1024, H + (size_t)row * D, lane);
#pragma unroll
            for (int j = 0; j < 4; ++j) *(LAS f32x4*)(hrow + r * HP + 4 * lane + 256 * j) = v[j]; }
        if (gi + F.G < ntiles) {
#pragma unroll
            for (int rr = 0; rr < 2; ++rr)
#pragma unroll
                for (int j = 0; j < 4; ++j) pv[rr][j] = *(const u32x2*)(X + (size_t)((gi + F.G) * 16 + 2 * w + rr) * D + 4 * lane + 256 * j); }
        __syncthreads();
        {   f32x4 acc[3] = {{0.f, 0.f, 0.f, 0.f}, {0.f, 0.f, 0.f, 0.f}, {0.f, 0.f, 0.f, 0.f}};
#pragma unroll
            for (int ks = 0; ks < 32; ++ks) { const float a = hrow[fr * HP + 128 * w + 4 * ks + fq];
#pragma unroll
                for (int nt = 0; nt < 3; ++nt) acc[nt] = __builtin_amdgcn_mfma_f32_16x16x4f32(a, bw[ks][nt], acc[nt], 0, 0, 0); }
#pragma unroll
            for (int nt = 0; nt < 3; ++nt)
#pragma unroll
                for (int reg = 0; reg < 4; ++reg) part[(w * 16 + 4 * fq + reg) * 48 + 16 * nt + fr] = acc[nt][reg]; }
        __syncthreads();
        for (int idx = F.tid; idx < 16 * 36; idx += NTHR) { const int r = idx / 36, n = idx % 36; float s_ = 0.f;
#pragma unroll
            for (int ww = 0; ww < 8; ++ww) s_ += part[(ww * 16 + r) * 48 + n];
            if (n < 32) lgs[r * 40 + 4 + n] = s_ + reb[n]; else lgs[r * 40 + n - 32] = s_ + rgb[n - 32]; }
        __syncthreads();
        if (F.tid < 16) { const int rr = gi * 16 + F.tid; const LAS float* lp = lgs + F.tid * 40;
            int grp = 0; float mx = lp[0];
#pragma unroll
            for (int g = 1; g < 4; ++g) if (lp[g] > mx) { mx = lp[g]; grp = g; }
            float den = 0.f;
#pragma unroll
            for (int g = 0; g < 4; ++g) den += __expf(lp[g] - mx);
            const float pg_top = 1.f / den; const LAS float* sel = lp + 4 + grp * 8;
            int i0 = 0; float l0 = sel[0];
#pragma unroll
            for (int q = 1; q < 8; ++q) if (sel[q] > l0) { l0 = sel[q]; i0 = q; }
            int i1 = -1; float l1 = -3.0e38f;
#pragma unroll
            for (int q = 0; q < 8; ++q) if (q != i0 && sel[q] > l1) { l1 = sel[q]; i1 = q; }
            const float e1 = __expf(l1 - l0); const float w0 = pg_top / (1.f + e1), w1 = pg_top * e1 / (1.f + e1);
            const int ea = grp * 8 + i0, eb = grp * 8 + i1;
            const unsigned pa = atomicAdd((unsigned*)(lcnt + ea), 1u), pb = atomicAdd((unsigned*)(lcnt + eb), 1u);
            rt_e[2 * rr] = ea; rt_e[2 * rr + 1] = eb; rt_pos[2 * rr] = (int)pa; rt_pos[2 * rr + 1] = (int)pb; rt_gate[2 * rr] = w0; rt_gate[2 * rr + 1] = w1; }
    }
    __syncthreads();
    if (F.tid < 32) lcnt[32 + F.tid] = lcnt[F.tid] ? atomicAdd(cnt + F.tid, lcnt[F.tid]) : 0u;
    __syncthreads();
    int* elist = (int*)(ws + WS_ELIST);
    if (F.tid < 16) for (int gi = F.vcu; gi < ntiles; gi += F.G) { const int rr = gi * 16 + F.tid;
        const int ea = rt_e[2 * rr], eb = rt_e[2 * rr + 1]; const int pa = rt_pos[2 * rr] + (int)lcnt[32 + ea], pb = rt_pos[2 * rr + 1] + (int)lcnt[32 + eb];
        rt_pos[2 * rr] = pa; rt_pos[2 * rr + 1] = pb; elist[(size_t)ea * NROW + pa] = rr; elist[(size_t)eb * NROW + pb] = rr; }
}

constexpr int MOE_MAP_OFF = 131072;
__device__ __forceinline__ void moe_map(const Frame& F0, int l) {
    const Frame F = phase_frame(F0); unsigned char* const ws = F.ws;
    LAS int* mp = (LAS int*)(F.lds + MOE_MAP_OFF);
    const unsigned* cnt = (const unsigned*)(ws + WS_CTL) + CW_CNT + 64 * l;
    __syncthreads();
    if (F.tid < NEXP) mp[32 + F.tid] = (int)__hip_atomic_load(cnt + F.tid, __ATOMIC_RELAXED, __HIP_MEMORY_SCOPE_AGENT);
    __syncthreads();
    if (F.tid == 0) { int o = 0;
#pragma nounroll
        for (int e = 0; e < NEXP; ++e) { const int c = mp[32 + e]; const int nt = (c + 255) >> 8; mp[e] = o;
#pragma nounroll
            for (int t = 0; t < nt; ++t) { mp[128 + (o >> 8) + t] = e; mp[320 + (o >> 8) + t] = t; }
            o += nt << 8; }
        mp[64] = o >> 8; }
    __syncthreads();
}

template <bool DRY>
__device__ __forceinline__ void combine_pass(const Frame& F0, int l, int nrows) {
    const Frame F = phase_frame(F0); unsigned char* const ws = F.ws;
    LAS float* mg2 = (LAS float*)F.lds; LAS float* msh = mg2 + 3072; LAS float* msc = msh + 3072;
    const bool last = (l == DEPTH - 1);
    __syncthreads();
    mod_to_lds(F, l, 5, mg2, false); if (!last) { mod_to_lds(F, l + 1, 0, msh, false); mod_to_lds(F, l + 1, 1, msc, false); }
    __syncthreads();
    bf16* X = (bf16*)(ws + WS_X); bf16* H = (bf16*)(ws + WS_H); const bf16* Ys = (const bf16*)(ws + WS_XS);
    const int* rt_e = (const int*)(ws + WS_ROUTE + RT_E); const int* rt_pos = (const int*)(ws + WS_ROUTE + RT_POS); const float* rt_gate = (const float*)(ws + WS_ROUTE + RT_GATE);
    const LAS int* moff = (const LAS int*)(F.lds + MOE_MAP_OFF);
    const int lane = F.lane; const float* n1g = inptr(I_N1G) + (last ? 0 : (l + 1) * D); const float* fgp = inptr(I_FG);
    for (int row0 = F.gw; row0 < nrows; row0 += 2 * F.NGW) {
        int s0[2], s1[2]; float w0[2], w1[2]; bool ok[2]; u32x2 ya[2][4], yb[2][4], xo[2][4];
#pragma unroll
        for (int u = 0; u < 2; ++u) { const int row = row0 + u * F.NGW; ok[u] = row < nrows; if (ok[u]) { s0[u] = moff[rt_e[2 * row]] + rt_pos[2 * row]; s1[u] = moff[rt_e[2 * row + 1]] + rt_pos[2 * row + 1]; w0[u] = rt_gate[2 * row]; w1[u] = rt_gate[2 * row + 1]; } }
#pragma unroll
        for (int u = 0; u < 2; ++u) if (ok[u]) { const int row = row0 + u * F.NGW;
#pragma unroll
            for (int j = 0; j < 4; ++j) { const int c = 4 * lane + 256 * j; ya[u][j] = *(const u32x2*)(Ys + (size_t)s0[u] * D + c); yb[u][j] = *(const u32x2*)(Ys + (size_t)s1[u] * D + c); xo[u][j] = *(const u32x2*)(X + (size_t)row * D + c); } }
#pragma unroll
        for (int u = 0; u < 2; ++u) if (ok[u]) { const int row = row0 + u * F.NGW; const int mr = modrow(row); f32x4 v[4];
#pragma unroll
            for (int j = 0; j < 4; ++j) { const int c = 4 * lane + 256 * j; float a[4], b[4]; unpack4(ya[u][j], a); unpack4(yb[u][j], b);
                const f32x4 g2 = *(const LAS f32x4*)(mg2 + mr * 1024 + c);
                f32x4 y; y.x = w0[u] * a[0] + w1[u] * b[0]; y.y = w0[u] * a[1] + w1[u] * b[1]; y.z = w0[u] * a[2] + w1[u] * b[2]; y.w = w0[u] * a[3] + w1[u] * b[3];
                float x_[4]; unpack4(xo[u][j], x_); v[j] = (f32x4){x_[0], x_[1], x_[2], x_[3]} + g2 * y; }
            if (DRY) { asm volatile("" :: "v"(v[0].x + v[1].y + v[2].z + v[3].w)); }
            else if (!last) {
#pragma unroll
                for (int j = 0; j < 4; ++j) *(u32x2*)(X + (size_t)row * D + 4 * lane + 256 * j) = (u32x2){pk2(v[j].x, v[j].y), pk2(v[j].z, v[j].w)};
                norm_mod_row(v, n1g, msc + mr * 1024, msh + mr * 1024, H + (size_t)row * D, lane);
            } else { float s = 0.f;
#pragma unroll
                for (int j = 0; j < 4; ++j) s += (v[j].x * v[j].x + v[j].y * v[j].y) + (v[j].z * v[j].z + v[j].w * v[j].w);
                const float rs = rsqrtf(wave_sum(s) * (1.f / D) + RMS_EPS);
#pragma unroll
                for (int j = 0; j < 4; ++j) { const int c = 4 * lane + 256 * j; const f32x4 g = *(const f32x4*)(fgp + c); *(f32x4*)(F.out + (size_t)row * D + c) = v[j] * rs * g; } } }
    }
}
__global__ void __launch_bounds__(NTHR, 2) fwd_megakernel(Params prm) {
    extern __shared__ __attribute__((aligned(16))) unsigned char lds_raw[];
    Frame F;
    F.lds = (LAS unsigned char*)lds_raw;
    F.tid = threadIdx.x; F.lane = F.tid & 63; F.wave = __builtin_amdgcn_readfirstlane(F.tid >> 6);
    F.G = gridDim.x; { const int bx = blockIdx.x; F.vcu = (F.G % 8 == 0) ? (bx % 8) * (F.G / 8) + bx / 8 : bx; }
    F.gw = F.vcu * NWAVES + F.wave; F.NGW = F.G * NWAVES;
    F.out = prm.out; F.ws = prm.ws;
    for (int u = F.tid; u < (LDS_BYTES - LDSCTL_OFF) / 4; u += NTHR) ((LAS unsigned*)(F.lds + LDSCTL_OFF))[u] = 0u;
    __syncthreads();
    (void)xcd_barrier_post((unsigned*)(F.ws + WS_CTL) + CW_BAR, (volatile LAS unsigned*)(F.lds + MISC_OFF) + 8);
#define GRID_BAR() do { XcdBarrier bar_; bar_.bar = (unsigned*)(opaque(F.ws) + WS_CTL) + CW_BAR; bar_.x = xb_xcc_id(); bar_.st = (volatile LAS unsigned*)(F.lds + MISC_OFF) + 8; xcd_barrier(bar_); } while (0)

    p0_prologue(F);
#if USE_CG_SYNC
    cg::this_grid().sync();
#else
    GRID_BAR();
#endif
    p0b_norm1(F);
    GRID_BAR();

    for (int l = 0; l < DEPTH; ++l) {
        const bool need_ctx = (l == 0); const int nrows = need_ctx ? NROW : NLAT;
#define WSO Fp.ws
        {
            const Frame Fp = phase_frame(F); unsigned char* const ws = WSO; bf16* Hb = (bf16*)(ws + WS_H); bf16* Pb = (bf16*)(ws + WS_P);
            pg8::Gemm g{Hb, (const bf16*)(ws + WS_WIN_T) + (size_t)l * NP * D, NROW, NP, D}; pg8::StaticOrder S; S.init(NROW, NP, Fp.G, (int)blockIdx.x);
            pg8::EpiStoreBf16 E{Pb, NP, 0xffff};
            pg8::gemm_phase<pg8::EpiStoreBf16, pg8::StaticOrder, true, true>(F.lds, g, S, E);
        }
        GRID_BAR();
        {
            const Frame Fp = phase_frame(F); unsigned char* const ws = WSO; bf16* Pb = (bf16*)(ws + WS_P);
            for (int it = blockIdx.x; it < 256; it += F.G) fftA_item(F, it);
            if (need_ctx) for (int it = blockIdx.x; it < 8; it += F.G) { const int b = it >> 2, m0 = (it & 3) * 64;
                const bf16* src0 = Pb + (size_t)(NLAT + b * CTXL) * NP + COL_FC;
                dft64_item<4, 256>(F, l, m0, -1.f, 1.f / 128.f, [=](int t, int ri) { return src0 + (size_t)t * NP + ri * 256; }, [=](int m) { return NLAT + b * CTXL + m; }); }
            shift_pass(F, l);
            conv_pass(F, l, nrows);
        }
        GRID_BAR();
        {
            const Frame Fp = phase_frame(F); unsigned char* const ws = WSO;
            prep_phase(F, l);
        }
        GRID_BAR();
        for (int seg = -1; seg < NSEG; ++seg) {
            const bool split = (F.G == 256);
            if (seg + 1 < NSEG) pre_phase(F, seg + 1, (seg >= 0 && split) ? 128 : 0);
            if (seg + 1 == NSEG && (!split || blockIdx.x >= 128)) { unsigned char* const ws = opaque(F.ws); int bx_ = (int)blockIdx.x; asm volatile("" : "+s"(bx_));
                const int first_ = split ? bx_ - 128 : bx_, stride_ = split ? 128 : F.G;
                for (int it = first_; it < 256; it += stride_) { const int b = it >> 7, t1p = it & 127;
                    const bf16* src0 = (const bf16*)(ws + WS_GT) + (size_t)(b * 128 + t1p) * 64 * 512;
                    dft64_item<1, 64>(F, l, 0, 1.f, 0.0013810679320049757f, [=](int t, int ri) { return src0 + (size_t)t * 512 + ri * 256; }, [=](int m) { return b * SEQ + t1p + 128 * m; }); } }
            if (seg >= 0) for (int it = blockIdx.x; it < 128; it += F.G) { const int x_ = it & 7, j_ = it >> 3;
                seq_item<0>(F, ((x_ + 8 * (j_ >> 2)) << 2) | (j_ & 3), seg, need_ctx); }
            GRID_BAR();
        }
        readout_pass(F, l, nrows);
        GRID_BAR();
        const int cv_lo = (nrows / 256) * 4 > F.G ? (nrows / 256) * 4 - F.G : 0;
        if (blockIdx.x & 1) expert_convert(F, l, cv_lo);
        {
            const Frame Fp = phase_frame(F); unsigned char* const ws = WSO; bf16* Hb = (bf16*)(ws + WS_H);
            pg8::Gemm g{Hb, (const bf16*)(ws + WS_WOUT_T) + (size_t)l * D * D, nrows, D, D}; pg8::StaticOrder S; S.init(nrows, D, Fp.G, (int)blockIdx.x);
            bf16* X = (bf16*)(ws + WS_X); const float* g1p = (const float*)(ws + WS_MODF) + (size_t)l * 3 * 6144 + 2 * 1024;
            if (l == 0) { pg8::EpiResidual<true> E{inptr(I_X), inptr(I_CTX), X, g1p}; pg8::gemm_phase<pg8::EpiResidual<true>, pg8::StaticOrder, true, true>(F.lds, g, S, E); }
            else { pg8::EpiResidual<false> E{X, X + (size_t)NLAT * D, X, g1p}; pg8::gemm_phase<pg8::EpiResidual<false>, pg8::StaticOrder, true, true>(F.lds, g, S, E); }
        }
        if (!(blockIdx.x & 1)) expert_convert(F, l, cv_lo);
        GRID_BAR();
        router_pass(F, l, nrows);
        GRID_BAR();
        {
            const Frame Fp = phase_frame(F); unsigned char* const ws = WSO;
            moe_map(F, l);
            const LAS int* mp = (const LAS int*)(F.lds + MOE_MAP_OFF);
            pg8::MoeOrder S{mp + 128, mp + 320, mp[64], Fp.G, (int)blockIdx.x};
            {   pg8::Gemm g{(const bf16*)(ws + WS_H), (const bf16*)(ws + WS_WGU_T), 0, 0, D, (const int*)(ws + WS_ELIST), NROW - 1};
                pg8::EpiSwiGLU E{(bf16*)(ws + WS_ACT)};
                pg8::gemm_phase<pg8::EpiSwiGLU, pg8::MoeOrder, true, true, true>(F.lds, g, S, E); }
            GRID_BAR();
            {   pg8::Gemm g{(const bf16*)(ws + WS_ACT), (const bf16*)(ws + WS_WD_T), 0, 0, DEXP};
                pg8::EpiStoreBf16 E{(bf16*)(ws + WS_XS), D, 3};
                pg8::gemm_phase<pg8::EpiStoreBf16, pg8::MoeOrder, true, true>(F.lds, g, S, E); }
        }
        GRID_BAR();
        combine_pass<false>(F, l, nrows);
        if (l + 1 < DEPTH) GRID_BAR();
    }
}

extern "C" void kernel_launch(void* const* d_in, const int* in_sizes, int n_in, void* d_out, int out_size, void* d_ws, size_t ws_size, hipStream_t stream) {
    static int grid = 0;
    if (grid == 0) {
        if (n_in != N_IN || in_sizes[0] != NLAT * D || out_size != NLAT * D || ws_size < WS_END) {
            fprintf(stderr, "kernel_launch: unexpected shapes (n_in %d in0 %d out %d ws %zu)\n", n_in, n_in > 0 ? in_sizes[0] : -1, out_size, ws_size); grid = -1; return; }
        int dev = 0, cus = 0, per_cu = 0;
        hipGetDevice(&dev); hipDeviceGetAttribute(&cus, hipDeviceAttributeMultiprocessorCount, dev);
        hipFuncSetAttribute((const void*)fwd_megakernel, hipFuncAttributeMaxDynamicSharedMemorySize, LDS_BYTES);
        hipOccupancyMaxActiveBlocksPerMultiprocessor(&per_cu, (const void*)fwd_megakernel, NTHR, LDS_BYTES);
        if (per_cu < 1) { fprintf(stderr, "kernel_launch: occupancy query says %d blocks per CU\n", per_cu); per_cu = 1; }
        (void)hipGetLastError();
        grid = cus * per_cu;
    }
    if (grid < 0) return;
    hipMemsetAsync((char*)d_ws + WS_CTL, 0, CTL_ZERO_BYTES, stream);
    Params p{};
    for (int i = 0; i < N_IN; ++i) p.in[i] = (const float*)d_in[i];
    p.out = (float*)d_out; p.ws = (unsigned char*)d_ws;
    void* args[] = {&p};
    hipError_t e = hipLaunchCooperativeKernel((const void*)fwd_megakernel, dim3(grid), dim3(NTHR), args, LDS_BYTES, stream);
    if (e != hipSuccess) fprintf(stderr, "kernel_launch: cooperative launch failed: %s (grid %d)\n", hipGetErrorString(e), grid);
}
```

```cpp
#include <hip/hip_runtime.h>
#include <hip/hip_cooperative_groups.h>
#include <cstdio>
#include <cstdint>
namespace cg = cooperative_groups;
#define USE_CG_SYNC 0
#define SEQ_PROBE 0
#define SEQ_PROBE_PRE 0
namespace pg8 {
#define PG8_LAS __attribute__((address_space(3)))
typedef unsigned short bf16_t;
typedef short bf16x8 __attribute__((ext_vector_type(8)));
typedef float f32x4 __attribute__((ext_vector_type(4)));
typedef unsigned u32x4 __attribute__((ext_vector_type(4)));
constexpr int BM = 256, BK = 64, HALF = 128, HTB = HALF * BK * 2  , STAGE_BYTES = 8 * HTB, NXCD = 8, WGM = 8;

__host__ __device__ __forceinline__ int lds_byte(int r, int c) { const int st = (r >> 4) * 2 + (c >> 5), rr = r & 15, cc = c & 31, ob = rr * 64 + cc * 2; return st * 1024 + (ob ^ (((ob >> 9) & 1) << 5)); }
__host__ __device__ __forceinline__ void stage_rc(int b, int& R, int& C) { const int st = b / 1024, sb = b % 1024, swz = sb ^ (((sb >> 9) & 1) << 5); R = (st >> 1) * 16 + swz / 64; C = (st & 1) * 32 + (swz % 64) / 2; }
__host__ __device__ __forceinline__ int perm32(int rho) { const int n = rho >> 4, i = rho & 15; return 8 * (i >> 2) + 4 * n + (i & 3); }

struct Unit { int pm, pn, ga; };
struct Gemm { const bf16_t* A; const bf16_t* Bt; int M, N, K; const int* gidx; int gmax; };

struct StaticOrder {
    int nM, nN, nwg, G, c;
    __host__ __device__ void init(int M, int N, int G_, int c_) { nM = M / BM; nN = N / BM; nwg = nM * nN; G = G_; c = c_; }
    __host__ __device__ bool next(int i, Unit& u) const {
        const long L = (long)i * G + c; if (L >= nwg) return false;
        int wgid = (int)L; { const int q = nwg / NXCD, r = nwg % NXCD, xcd = wgid % NXCD, off = wgid / NXCD; wgid = (xcd < r ? xcd * (q + 1) : r * (q + 1) + (xcd - r) * q) + off; }
        const int nig = WGM * nN, gid = wgid / nig, fm = gid * WGM, gsz = (nM - fm) < WGM ? (nM - fm) : WGM;
        u.pm = fm + ((wgid % nig) % gsz); u.pn = (wgid % nig) / gsz; return true;
    }
    __device__ __forceinline__ void a_ready(const Unit&) const {}
    __device__ __forceinline__ void done(const Unit&) const {}
};

__device__ __forceinline__ unsigned cvt_pk_bf16(float lo, float hi) { unsigned r; asm volatile("v_cvt_pk_bf16_f32 %0, %1, %2" : "=v"(r) : "v"(lo), "v"(hi)); return r; }
typedef float f32x2 __attribute__((ext_vector_type(2)));
template <class Epi, class Sched, bool ALIGN_EPI = false, bool SP2 = false, bool GATHER = false>
__device__ __forceinline__ void gemm_phase(PG8_LAS unsigned char* lds, const Gemm g, const Sched& S, const Epi& E) {
    int tid = threadIdx.x; asm volatile("" : "+v"(tid));
    const int wid = __builtin_amdgcn_readfirstlane(tid >> 6), lane = tid & 63, wr = wid >> 2, wc = wid & 3, fr = lane & 15, fq = lane >> 4;
    const int K = g.K, nt = K / BK;
    unsigned voffA[2], voffB[2];
#pragma unroll
    for (int i = 0; i < 2; ++i) { int R, C; stage_rc(tid * 16 + i * 8192, R, C); const int Rb = Epi::PERM ? ((R & ~31) + perm32(R & 31)) : R;
        voffA[i] = (unsigned)(R * K + C) * 2u; voffB[i] = (unsigned)(Rb * K + C) * 2u; }
    static_assert(!GATHER || SP2, "GATHER is implemented for the SP2 loop");
    unsigned gcur[2][2], gnx[2][2];
#define PG8_GOFF(go, u_) do { _Pragma("unroll") for (int h_ = 0; h_ < 2; ++h_) _Pragma("unroll") for (int i_ = 0; i_ < 2; ++i_) { int R_, C_; stage_rc(tid * 16 + i_ * 8192, R_, C_); \
        int ri_ = g.gidx[(u_).ga + h_ * HALF + R_]; ri_ = ri_ < 0 ? 0 : (ri_ > g.gmax ? g.gmax : ri_); go[h_][i_] = (unsigned)ri_ * (unsigned)(K * 2) + (unsigned)C_ * 2u; } } while (0)
    const size_t kstep = (size_t)(BK * 2);
    const size_t hstep = (size_t)HALF * K * 2;
    const size_t tstep = 2 * hstep;
    const unsigned ldsw = (unsigned)wid * 1024u;
    const int aoff = lds_byte(wr * 64 + fr, fq * 8), boff = lds_byte(wc * 32 + fr, fq * 8);
#define PG8_SA(b, h) (((b) * 2 + (h)) * HTB)
#define PG8_SB(b, h) ((4 + (b) * 2 + (h)) * HTB)
#define PG8_STAGE(bufoff, gbase, voff) do { _Pragma("unroll") for (int _i = 0; _i < 2; ++_i) \
        __builtin_amdgcn_global_load_lds((const unsigned*)((const char*)(gbase) + (voff)[_i]), (PG8_LAS unsigned*)(lds + (bufoff) + ldsw + _i * 8192), 16, 0, 0); } while (0)
#define PG8_LDA(dst, b, h) do { _Pragma("unroll") for (int m = 0; m < 4; ++m) _Pragma("unroll") for (int k = 0; k < 2; ++k) dst[m][k] = *(const PG8_LAS bf16x8*)(lds + PG8_SA(b, h) + aoff + m * 2048 + k * 1024); } while (0)
#define PG8_LDB(dst, b, h) do { _Pragma("unroll") for (int n = 0; n < 2; ++n) _Pragma("unroll") for (int k = 0; k < 2; ++k) dst[n][k] = *(const PG8_LAS bf16x8*)(lds + PG8_SB(b, h) + boff + n * 2048 + k * 1024); } while (0)
#define PG8_MMA(ai, bj, At, Bt) do { __builtin_amdgcn_s_setprio(1); _Pragma("unroll") for (int m = 0; m < 4; ++m) _Pragma("unroll") for (int n = 0; n < 2; ++n) _Pragma("unroll") for (int k = 0; k < 2; ++k) \
        acc[ai][bj][m][n] = __builtin_amdgcn_mfma_f32_16x16x32_bf16(Bt[n][k], At[m][k], acc[ai][bj][m][n], 0, 0, 0); __builtin_amdgcn_s_setprio(0); } while (0)
#define PG8_WAIT_V(n) asm volatile("s_waitcnt vmcnt(" #n ")" ::: "memory")
#define PG8_WAIT_L(n) asm volatile("s_waitcnt lgkmcnt(" #n ")" ::: "memory")
#define PG8_BAR __builtin_amdgcn_s_barrier()
#define PG8_SCHED __builtin_amdgcn_sched_barrier(0)
    Unit cur, nxt; int ui = 0;
    if (!S.next(0, cur)) return;
    f32x4 acc[2][2][4][2];
#pragma unroll
    for (int a = 0; a < 2; ++a)
#pragma unroll
        for (int b = 0; b < 2; ++b)
#pragma unroll
            for (int m = 0; m < 4; ++m)
#pragma unroll
                for (int n = 0; n < 2; ++n) acc[a][b][m][n] = (f32x4){0.f, 0.f, 0.f, 0.f};
    bf16x8 At[4][2], B0[2][2], B1[2][2];
    const char* cA = (const char*)g.A + (size_t)cur.pm * tstep; const char* cB = (const char*)g.Bt + (size_t)cur.pn * tstep;
    S.a_ready(cur);
    const char* gA = (const char*)g.A;
    if constexpr (GATHER) PG8_GOFF(gcur, cur);
    if constexpr (SP2) {
        PG8_STAGE(PG8_SB(0, 0), cB, voffB); PG8_STAGE(PG8_SB(0, 1), cB + hstep, voffB);
        if constexpr (GATHER) { PG8_STAGE(PG8_SA(0, 0), gA, gcur[0]); PG8_STAGE(PG8_SA(0, 1), gA, gcur[1]); } else { PG8_STAGE(PG8_SA(0, 0), cA, voffA); PG8_STAGE(PG8_SA(0, 1), cA + hstep, voffA); }
        if (wr == 1) PG8_BAR;
        PG8_WAIT_V(2); PG8_BAR;
        PG8_STAGE(PG8_SB(1, 0), cB + kstep, voffB); if constexpr (GATHER) PG8_STAGE(PG8_SA(1, 0), gA + kstep, gcur[0]); else PG8_STAGE(PG8_SA(1, 0), cA + kstep, voffA); PG8_STAGE(PG8_SB(1, 1), cB + hstep + kstep, voffB);
        PG8_WAIT_V(6); PG8_BAR;
    } else {
        PG8_STAGE(PG8_SB(0, 0), cB, voffB); PG8_STAGE(PG8_SA(0, 0), cA, voffA); PG8_STAGE(PG8_SB(0, 1), cB + hstep, voffB); PG8_STAGE(PG8_SA(0, 1), cA + hstep, voffA);
        if (wr == 1) PG8_BAR;
        PG8_WAIT_V(4); PG8_BAR;
        PG8_STAGE(PG8_SB(1, 0), cB + kstep, voffB); PG8_STAGE(PG8_SA(1, 0), cA + kstep, voffA); PG8_STAGE(PG8_SB(1, 1), cB + hstep + kstep, voffB);
        PG8_WAIT_V(6); PG8_BAR;
    }
    for (;;) {
        const bool has_next = S.next(ui + 1, nxt);
        if constexpr (GATHER) { if (has_next) PG8_GOFF(gnx, nxt); else { gnx[0][0] = gcur[0][0]; gnx[0][1] = gcur[0][1]; gnx[1][0] = gcur[1][0]; gnx[1][1] = gcur[1][1]; } }
        const char* nA = has_next ? (const char*)g.A + (size_t)nxt.pm * tstep : cA; const char* nB = has_next ? (const char*)g.Bt + (size_t)nxt.pn * tstep : cB;
        for (int t = 0; t < nt; t += 2) {
            const bool last = (t == nt - 2);
            const char* a1 = cA + (size_t)(t + 1) * kstep;
            const char* a2 = last ? nA : cA + (size_t)(t + 2) * kstep; const char* b2 = last ? nB : cB + (size_t)(t + 2) * kstep;
            const char* a3 = a2 + kstep; const char* b3 = b2 + kstep;
            if (last && has_next) S.a_ready(nxt);
            unsigned ga0[2], ga1[2]; const char* g1 = gA; const char* g2 = gA; const char* g3 = gA;
            if constexpr (GATHER) { g1 = gA + (size_t)(t + 1) * kstep; g2 = last ? gA : gA + (size_t)(t + 2) * kstep; g3 = g2 + kstep;
                ga0[0] = last ? gnx[0][0] : gcur[0][0]; ga0[1] = last ? gnx[0][1] : gcur[0][1]; ga1[0] = last ? gnx[1][0] : gcur[1][0]; ga1[1] = last ? gnx[1][1] : gcur[1][1]; }
            if constexpr (SP2) {
            PG8_LDB(B0, 0, 0); PG8_LDB(B1, 0, 1); PG8_SCHED; PG8_LDA(At, 0, 0); if constexpr (GATHER) PG8_STAGE(PG8_SA(1, 1), g1, gcur[1]); else PG8_STAGE(PG8_SA(1, 1), a1 + hstep, voffA);
            PG8_WAIT_V(8); PG8_WAIT_L(0); PG8_BAR; PG8_MMA(0, 0, At, B0); PG8_MMA(0, 1, At, B1); PG8_BAR; PG8_SCHED;
            PG8_LDA(At, 0, 1); PG8_STAGE(PG8_SB(0, 0), b2, voffB); PG8_STAGE(PG8_SB(0, 1), b2 + hstep, voffB); if constexpr (GATHER) PG8_STAGE(PG8_SA(0, 0), g2, ga0); else PG8_STAGE(PG8_SA(0, 0), a2, voffA);
            PG8_WAIT_V(8); PG8_WAIT_L(0); PG8_BAR; PG8_MMA(1, 0, At, B0); PG8_MMA(1, 1, At, B1); PG8_BAR; PG8_SCHED;
            PG8_LDB(B0, 1, 0); PG8_LDB(B1, 1, 1); PG8_SCHED; PG8_LDA(At, 1, 0); if constexpr (GATHER) PG8_STAGE(PG8_SA(0, 1), g2, ga1); else PG8_STAGE(PG8_SA(0, 1), a2 + hstep, voffA);
            PG8_WAIT_V(8); PG8_WAIT_L(0); PG8_BAR; PG8_MMA(0, 0, At, B0); PG8_MMA(0, 1, At, B1); PG8_BAR; PG8_SCHED;
            PG8_LDA(At, 1, 1); PG8_STAGE(PG8_SB(1, 0), b3, voffB); PG8_STAGE(PG8_SB(1, 1), b3 + hstep, voffB); if constexpr (GATHER) PG8_STAGE(PG8_SA(1, 0), g3, ga0); else PG8_STAGE(PG8_SA(1, 0), a3, voffA);
            PG8_WAIT_V(8); PG8_WAIT_L(0); PG8_BAR; PG8_MMA(1, 0, At, B0); PG8_MMA(1, 1, At, B1); PG8_BAR; PG8_SCHED;
            } else {
            PG8_LDB(B0, 0, 0); PG8_SCHED; PG8_LDA(At, 0, 0); PG8_STAGE(PG8_SA(1, 1), a1 + hstep, voffA);
            PG8_WAIT_L(8); PG8_BAR; PG8_WAIT_L(0); PG8_MMA(0, 0, At, B0); PG8_BAR; PG8_SCHED;
            PG8_LDB(B1, 0, 1); PG8_STAGE(PG8_SB(0, 0), b2, voffB);
            PG8_BAR; PG8_WAIT_L(0); PG8_MMA(0, 1, At, B1); PG8_BAR;
            PG8_LDA(At, 0, 1); PG8_STAGE(PG8_SA(0, 0), a2, voffA);
            PG8_BAR; PG8_WAIT_L(0); PG8_MMA(1, 0, At, B0); PG8_BAR; PG8_SCHED;
            PG8_STAGE(PG8_SB(0, 1), b2 + hstep, voffB);
            PG8_WAIT_V(6); PG8_BAR; PG8_MMA(1, 1, At, B1); PG8_BAR;
            PG8_LDB(B0, 1, 0); PG8_SCHED; PG8_LDA(At, 1, 0); PG8_STAGE(PG8_SA(0, 1), a2 + hstep, voffA);
            PG8_WAIT_L(8); PG8_BAR; PG8_WAIT_L(0); PG8_MMA(0, 0, At, B0); PG8_BAR; PG8_SCHED;
            PG8_LDB(B1, 1, 1); PG8_STAGE(PG8_SB(1, 0), b3, voffB);
            PG8_BAR; PG8_WAIT_L(0); PG8_MMA(0, 1, At, B1); PG8_BAR;
            PG8_LDA(At, 1, 1); PG8_STAGE(PG8_SA(1, 0), a3, voffA);
            PG8_BAR; PG8_WAIT_L(0); PG8_MMA(1, 0, At, B0); PG8_BAR; PG8_SCHED;
            PG8_STAGE(PG8_SB(1, 1), b3 + hstep, voffB);
            PG8_WAIT_V(6); PG8_BAR; PG8_MMA(1, 1, At, B1); PG8_BAR;
            }
        }
        if constexpr (ALIGN_EPI) { if (wr == 0) PG8_BAR; }
        if constexpr (!Epi::AFTER_DRAIN) { E(acc, cur, wr, wc, fr, fq); S.done(cur); }
        if (!has_next) break;
#pragma unroll
        for (int a = 0; a < 2; ++a)
#pragma unroll
            for (int b = 0; b < 2; ++b)
#pragma unroll
                for (int m = 0; m < 4; ++m)
#pragma unroll
                    for (int n = 0; n < 2; ++n) acc[a][b][m][n] = (f32x4){0.f, 0.f, 0.f, 0.f};
        cur = nxt; cA = nA; cB = nB; ++ui;
        if constexpr (GATHER) { gcur[0][0] = gnx[0][0]; gcur[0][1] = gnx[0][1]; gcur[1][0] = gnx[1][0]; gcur[1][1] = gnx[1][1]; }
        if constexpr (ALIGN_EPI) { if (wr == 1) PG8_BAR; }
    }
    PG8_WAIT_V(0);
    if constexpr (!ALIGN_EPI) { if (wr == 0) PG8_BAR; }
    PG8_BAR;
    if constexpr (Epi::AFTER_DRAIN) { E.fused(acc, cur, wr, wc, fr, fq, lds, wid, lane); S.done(cur); }
#undef PG8_GOFF
#undef PG8_SA
#undef PG8_SB
#undef PG8_STAGE
#undef PG8_LDA
#undef PG8_LDB
#undef PG8_MMA
#undef PG8_WAIT_V
#undef PG8_WAIT_L
#undef PG8_BAR
#undef PG8_SCHED
}
}
#define LAS __attribute__((address_space(3)))
typedef unsigned short bf16;
typedef float f32x4 __attribute__((ext_vector_type(4)));
typedef short bf16x8 __attribute__((ext_vector_type(8)));
typedef unsigned u32x4 __attribute__((ext_vector_type(4)));
typedef unsigned u32x2 __attribute__((ext_vector_type(2)));

constexpr int D = 1024, NBATCH = 2, SEQ = 8192, CTXL = 256, DEPTH = 2;
constexpr int NLAT = NBATCH * SEQ, NCTX = NBATCH * CTXL, NROW = NLAT + NCTX;
constexpr int DR = 512, DIN = 2944, NP = 3328, ZW = 1920, NHEAD = 8;
constexpr int COL_CONV = 1920, COL_FC = 2688, COL_FS = 2944;
constexpr int STRW = 5120;
constexpr int NEXP = 32, DEXP = 512;
constexpr int MOE_MAXTILES = 168;
constexpr float RMS_EPS = 1e-6f, GN_EPS = 64e-5f;

enum { I_X = 0, I_C, I_CTX, I_CCTX, I_ADAW, I_ADAB, I_N1G, I_N2G, I_WIN, I_MU, I_DW0, I_DW2, I_IA0, I_IA2, I_GG2, I_KK, I_KA, I_RK, I_GNW, I_GNB,
       I_CONVW, I_CONVG, I_FOURG, I_WOUT, I_RGW, I_RGB, I_REW, I_REB, I_EG, I_EU, I_ED, I_FG, N_IN };

constexpr size_t MiB = 1u << 20;
constexpr size_t WS_CTL = 0, CTL_ZERO_BYTES = 64 * 1024;
constexpr size_t WS_MODP = 1 * MiB;
constexpr size_t WS_MODF = 1 * MiB + 1280 * 1024;
constexpr size_t WS_WIN_T = 3 * MiB;
constexpr size_t WS_WOUT_T = 16 * MiB;
constexpr size_t WS_WGU_T = 20 * MiB;
constexpr size_t WS_WD_T = 84 * MiB;
constexpr size_t WS_X = 116 * MiB;
constexpr size_t WS_H = 182 * MiB;
constexpr size_t WS_ZS = 215 * MiB;
constexpr size_t WS_P = 277 * MiB;
constexpr size_t WS_STR = 277 * MiB;
constexpr size_t WS_Y = 442 * MiB;
constexpr size_t WS_GT = 475 * MiB;
constexpr size_t WS_ROUTE = 491 * MiB;
constexpr size_t WS_XS = 215 * MiB;
constexpr size_t WS_ACT = 299 * MiB;
constexpr size_t WS_ELIST = 340 * MiB;
constexpr size_t WS_END = 530 * MiB;
constexpr size_t RT_E = 0, RT_POS = 1 * 33792 * 4, RT_GATE = 2 * 33792 * 4, RT_SLOT = 3 * 33792 * 4, RT_TILE = 4 * 33792 * 4, RT_NT = RT_TILE + 1024;

constexpr int CW_BAR = 4096;
constexpr int CW_CNT = 8192;

constexpr int NWAVES = 8, NTHR = 512;
constexpr int RING_BYTES = 131072, LDSCTL_OFF = 143360, MISC_OFF = LDSCTL_OFF + 320, LDS_BYTES = 147456;

struct Params { const float* in[N_IN]; float* out; unsigned char* ws; };

__device__ __forceinline__ float bf2f(unsigned h) { return __uint_as_float(h << 16); }
typedef __bf16 hwbf2 __attribute__((ext_vector_type(2)));
typedef float f32x2 __attribute__((ext_vector_type(2)));
__device__ __forceinline__ unsigned pk2(float lo, float hi) { const f32x2 x = {lo, hi}; const hwbf2 r = __builtin_convertvector(x, hwbf2); return __builtin_bit_cast(unsigned, r); }
__device__ __forceinline__ unsigned f2bf(float f) { return pk2(f, 0.f) & 0xffffu; }
__device__ __forceinline__ float wave_sum(float v) {
#pragma unroll
    for (int o = 1; o < 64; o <<= 1) v += __shfl_xor(v, o);
    return v;
}
__device__ __forceinline__ float sigmoidf_(float x) { return 1.f / (1.f + __expf(-x)); }
#define LDS_WAIT() asm volatile("s_waitcnt lgkmcnt(0)" ::: "memory")
#define VM_WAIT() asm volatile("s_waitcnt vmcnt(0)" ::: "memory")

struct Frame {
    LAS unsigned char* lds;
    int tid, lane, wave, vcu, G, gw, NGW;
    float* out; unsigned char* ws;
};
#if defined(__HIP_DEVICE_COMPILE__)
#define ASSUME_GLOBAL(p) do { __builtin_assume(!__builtin_amdgcn_is_shared(p)); __builtin_assume(!__builtin_amdgcn_is_private(p)); } while (0)
#else
#define ASSUME_GLOBAL(p) do { } while (0)
#endif
__device__ __forceinline__ const float* inptr(int i) {
    const volatile unsigned long long __attribute__((address_space(4)))* ka = (const volatile unsigned long long __attribute__((address_space(4)))*)__builtin_amdgcn_kernarg_segment_ptr();
    return (const float*)(const __attribute__((address_space(1))) float*)ka[i];
}
__device__ __forceinline__ unsigned char* opaque(unsigned char* p) { unsigned long z = 0; asm volatile("" : "+s"(z)); return p + z; }
__device__ __forceinline__ Frame phase_frame(const Frame& F0) { Frame F = F0; asm volatile("" : "+v"(F.tid)); F.lane = F.tid & 63; F.ws = opaque(F0.ws);
    asm volatile("" : "+s"(F.G), "+s"(F.vcu)); F.gw = F.vcu * NWAVES + F.wave; F.NGW = F.G * NWAVES; return F; }
__device__ __forceinline__ int modrow(int row) { return row < NLAT ? (row >> 13) : 2; }
#define XB_TMO      128
#define XB_XCNT(j)  (256  + 64 * (j))
#define XB_XSUB(j)  (1280 + 64 * (j))
#define XB_XGEN(j)  (2304 + 64 * (j))
#define XB_TOP      3328
#define XB_TOPGEN   3392
#define XCD_BAR_WORDS 3456
#define XB_SPIN_CAP (1u << 18)

__device__ __forceinline__ unsigned xb_ld(unsigned* p)              { return __hip_atomic_load(p, __ATOMIC_RELAXED, __HIP_MEMORY_SCOPE_AGENT); }
__device__ __forceinline__ unsigned xb_add(unsigned* p, unsigned v) { return __hip_atomic_fetch_add(p, v, __ATOMIC_RELAXED, __HIP_MEMORY_SCOPE_AGENT); }
__device__ __forceinline__ unsigned xb_xcc_id() { return (unsigned)__builtin_amdgcn_s_getreg((3 << 11) | 20) & 0xFu; }
#define XB_SPIN(cond, bar) do { unsigned _sp = 0; while (cond) { __builtin_amdgcn_s_sleep(1); \
    if ((++_sp & 255u) == 0u) { if (xb_ld(&(bar)[XB_TMO])) break; if (_sp > XB_SPIN_CAP) { atomicAdd(&(bar)[XB_TMO], 1u); break; } } } } while (0)

struct XcdBarrier {
    unsigned* bar; unsigned x;
    volatile LAS unsigned* st;
};

__device__ __forceinline__ XcdBarrier xcd_barrier_post(unsigned* bar, volatile LAS unsigned* st) {
    XcdBarrier b; b.bar = bar; b.x = xb_xcc_id(); b.st = st;
    if (threadIdx.x == 0) (void)xb_add(&bar[XB_XCNT(b.x)], 1u);
    return b;
}
__device__ __forceinline__ void xcd_barrier_complete(unsigned* bar, unsigned x, unsigned& nloc, unsigned& nx) {
    const unsigned G = gridDim.x * gridDim.y * gridDim.z;
    unsigned sum, cnt, mine, sp = 0u;
    for (;;) {
        sum = 0u; cnt = 0u; mine = 0u;
#pragma nounroll
        for (unsigned j = 0; j < 16; ++j) { const unsigned c = xb_ld(&bar[XB_XCNT(j)]); sum += c; cnt += (c > 0u) ? 1u : 0u; mine = (j == x) ? c : mine; }
        if (sum == G) break;
        __builtin_amdgcn_s_sleep(1);
        if ((++sp & 255u) == 0u) { if (xb_ld(&bar[XB_TMO])) break; if (sp > XB_SPIN_CAP) { atomicAdd(&bar[XB_TMO], 1u); break; } }
    }
    nloc = mine > 0u ? mine : 1u; nx = cnt > 0u ? cnt : 1u;
}

__device__ __forceinline__ void xcd_barrier(const XcdBarrier& b) {
    asm volatile("s_waitcnt vmcnt(0)" ::: "memory");
    __syncthreads();
    if (threadIdx.x == 0) {
        unsigned* bar = b.bar;
        asm volatile("" : "+s"(bar));
        __builtin_amdgcn_s_waitcnt(0);
        unsigned nloc = b.st[0], nx = b.st[1];
        if (nloc == 0u) { xcd_barrier_complete(bar, b.x, nloc, nx); b.st[0] = nloc; b.st[1] = nx; }
        const unsigned old = xb_add(&bar[XB_XSUB(b.x)], 1u);
        const unsigned gen = old / nloc;
        if (old + 1u == (gen + 1u) * nloc) {
            __builtin_amdgcn_fence(__ATOMIC_RELEASE, "agent");
            asm volatile("s_waitcnt vmcnt(0)" ::: "memory");
            const unsigned og = xb_add(&bar[XB_TOP], 1u);
            const unsigned tg = og / nx;
            if (og + 1u == (tg + 1u) * nx) xb_add(&bar[XB_TOPGEN], 1u);
            else XB_SPIN(xb_ld(&bar[XB_TOPGEN]) == tg, bar);
            __builtin_amdgcn_fence(__ATOMIC_ACQUIRE, "agent");
            xb_add(&bar[XB_XGEN(b.x)], 1u);
            asm volatile("s_waitcnt vmcnt(0)" ::: "memory");
        } else {
            XB_SPIN(xb_ld(&bar[XB_XGEN(b.x)]) == gen, bar);
            __builtin_amdgcn_fence(__ATOMIC_ACQUIRE, "agent");
            asm volatile("s_waitcnt vmcnt(0)" ::: "memory");
        }
    }
    __syncthreads();
}
template <class RowMap>
__device__ __forceinline__ void transpose_item(const float* W, int ldw, int k0, int n0, bf16* WT, int ldt, RowMap rm, LAS float* scr, int lane) {
    (void)scr;
    const int nq = lane & 7, kg = lane >> 3; const float* src = W + (size_t)(k0 + 8 * kg) * ldw + n0 + 4 * nq;
    f32x4 v[8];
#pragma unroll
    for (int i = 0; i < 8; ++i) v[i] = *(const f32x4*)(src + (size_t)i * ldw);
#pragma unroll
    for (int j = 0; j < 4; ++j) { u32x4 o = {pk2(v[0][j], v[1][j]), pk2(v[2][j], v[3][j]), pk2(v[4][j], v[5][j]), pk2(v[6][j], v[7][j])};
        *(u32x4*)(WT + (size_t)rm(n0 + 4 * nq + j) * ldt + k0 + 8 * kg) = o; }
}
struct RmId { int off; __device__ __forceinline__ int operator()(int n) const { return off + n; } };
struct RmGU { int off; __device__ __forceinline__ int operator()(int n) const { return off + ((n >> 2) << 3) + (n & 3); } };

__device__ __forceinline__ void p0_prologue(const Frame& F0) {
    const Frame F = phase_frame(F0); unsigned char* const ws = F.ws;
    LAS float* scr = (LAS float*)(F.lds + F.wave * 16384);
    LAS float* ctab = (LAS float*)(F.lds + 8 * 16384);
    if (F.tid < 64) ctab[F.tid] = cosf((float)F.tid * (6.283185307179586f / 64.f));
    __syncthreads();
    bf16* win_t = (bf16*)(ws + WS_WIN_T); bf16* wout_t = (bf16*)(ws + WS_WOUT_T);
    constexpr int I_WIN_L = 16 * 84, I_WOUT_L = 16 * 32, I_FOLD_L = 4 * 64, I_MOD_L = 96 * 8;
    constexpr int NIT = 2 * (I_WIN_L + I_WOUT_L + I_FOLD_L + I_MOD_L);
    const float* p_win = inptr(I_WIN); const float* p_wout = inptr(I_WOUT); const float* p_c = inptr(I_C); const float* p_cctx = inptr(I_CCTX); const float* p_adaw = inptr(I_ADAW);
    {
        bf16* wl = (bf16*)(ws + 64 * 1024); const float* dw2 = inptr(I_DW2); const float* ia2 = inptr(I_IA2); const float* gg2 = inptr(I_GG2);
        for (int idx = F.vcu * NTHR + F.tid; idx < 2 * 384 * 512; idx += F.G * NTHR) { const int c = idx & 511, k = (idx >> 9) % 384, l = idx / (384 * 512);
            float v;
            if (k < 128) v = dw2[((size_t)(l * 2 + (k >> 6)) * 64 + (k & 63)) * DR + c];
            else if (k < 256) v = ia2[((size_t)(l * 2 + ((k - 128) >> 6)) * 64 + (k & 63)) * DR + c];
            else v = gg2[((size_t)l * 128 + (k - 256)) * DR + c];
            wl[((size_t)l * 512 + c) * 384 + k] = (bf16)f2bf(v); } }
    for (int it = F.gw; it < NIT; it += F.NGW) {
        int r = it; const int l = r & 1; r >>= 1;
        if (r < I_WIN_L) { const int kb = r / 84, nb = r % 84;
            transpose_item(p_win + (size_t)l * D * DIN, DIN, kb * 64, nb * 32, win_t + (size_t)l * NP * D, D, RmId{0}, scr, F.lane); continue; }
        r -= I_WIN_L;
        if (r < I_WOUT_L) { const int kb = r / 32, nb = r % 32;
            transpose_item(p_wout + (size_t)l * D * D, D, kb * 64, nb * 32, wout_t + (size_t)l * D * D, D, RmId{0}, scr, F.lane); continue; }
        r -= I_WOUT_L;
        if (r < I_FOLD_L) {
            const int g = r >> 6, k0 = (r & 63) * 16; const float* W = p_win + (size_t)l * D * DIN;
#pragma unroll
            for (int kk = 0; kk < 16; ++kk) scr[kk * 64 + F.lane] = W[(size_t)(k0 + kk) * DIN + 2688 + g * 64 + F.lane];
            LDS_WAIT(); asm volatile("" ::: "memory");
            float ac[16], as[16];
#pragma unroll
            for (int kk = 0; kk < 16; ++kk) { ac[kk] = 0.f; as[kk] = 0.f; }
            for (int c = 0; c < 64; ++c) { const int idx = (c * F.lane) & 63; const float cc = ctab[idx], ss = ctab[(idx - 16) & 63];
#pragma unroll
                for (int kk = 0; kk < 16; ++kk) { const float w = scr[kk * 64 + c]; ac[kk] += w * cc; as[kk] += w * ss; } }
            bf16* oc = win_t + (size_t)l * NP * D + (size_t)(COL_FC + g * 64 + F.lane) * D + k0;
            bf16* os = win_t + (size_t)l * NP * D + (size_t)(COL_FS + g * 64 + F.lane) * D + k0;
            u32x4 a, b;
            a.x = pk2(ac[0], ac[1]); a.y = pk2(ac[2], ac[3]); a.z = pk2(ac[4], ac[5]); a.w = pk2(ac[6], ac[7]);
            b.x = pk2(ac[8], ac[9]); b.y = pk2(ac[10], ac[11]); b.z = pk2(ac[12], ac[13]); b.w = pk2(ac[14], ac[15]);
            *(u32x4*)oc = a; *(u32x4*)(oc + 8) = b;
            a.x = pk2(as[0], as[1]); a.y = pk2(as[2], as[3]); a.z = pk2(as[4], as[5]); a.w = pk2(as[6], as[7]);
            b.x = pk2(as[8], as[9]); b.y = pk2(as[10], as[11]); b.z = pk2(as[12], as[13]); b.w = pk2(as[14], as[15]);
            *(u32x4*)os = a; *(u32x4*)(os + 8) = b;
            LDS_WAIT(); asm volatile("" ::: "memory");
            continue; }
        r -= I_FOLD_L;
        {
            const int cb = r >> 3, ks = r & 7;
#pragma unroll
            for (int q = 0; q < 2; ++q) { const int k = ks * 128 + q * 64 + F.lane;
                const float c0 = p_c[k], c1 = p_c[D + k], c2 = p_cctx[k];
                scr[0 * 128 + q * 64 + F.lane] = c0 * sigmoidf_(c0); scr[1 * 128 + q * 64 + F.lane] = c1 * sigmoidf_(c1); scr[2 * 128 + q * 64 + F.lane] = c2 * sigmoidf_(c2); }
            LDS_WAIT(); asm volatile("" ::: "memory");
            const float* W = p_adaw + (size_t)l * D * 6144 + (size_t)(ks * 128) * 6144 + cb * 64 + F.lane;
            float a0 = 0.f, a1 = 0.f, a2 = 0.f;
#pragma unroll 8
            for (int kk = 0; kk < 128; ++kk) { const float w = W[(size_t)kk * 6144]; a0 += scr[kk] * w; a1 += scr[128 + kk] * w; a2 += scr[256 + kk] * w; }
            float* mp = (float*)(ws + WS_MODP) + (size_t)((l * 8 + ks) * 3) * 6144 + cb * 64 + F.lane;
            mp[0] = a0; mp[6144] = a1; mp[2 * 6144] = a2;
            LDS_WAIT(); asm volatile("" ::: "memory");
        }
    }
}

__device__ __forceinline__ void mod_to_lds(const Frame& F0, int l, int p, LAS float* dst, bool from_partials) {
    const Frame F = phase_frame(F0); unsigned char* const ws = F.ws;
    const float* adab = inptr(I_ADAB);
    for (int idx = F.tid; idx < 3 * 1024; idx += NTHR) { const int r = idx >> 10, n = idx & 1023;
        float v;
        if (from_partials) { v = adab[l * 6144 + p * 1024 + n]; const float* mp = (const float*)(ws + WS_MODP) + (size_t)(l * 8 * 3 + r) * 6144 + p * 1024 + n;
#pragma unroll
            for (int ks = 0; ks < 8; ++ks) v += mp[(size_t)ks * 3 * 6144]; }
        else v = ((const float*)(ws + WS_MODF))[(size_t)(l * 3 + r) * 6144 + p * 1024 + n];
        dst[idx] = v; }
}
__device__ __forceinline__ void mod_finalize(const Frame& F0) {
    const Frame F = phase_frame(F0); unsigned char* const ws = F.ws;
    const float* adab = inptr(I_ADAB);
    for (int idx = F.vcu * NTHR + F.tid; idx < 2 * 3 * 6144; idx += F.G * NTHR) { const int l = idx / (3 * 6144), rem = idx % (3 * 6144), r = rem / 6144, n = rem % 6144;
        float v = adab[l * 6144 + n]; const float* mp = (const float*)(ws + WS_MODP) + (size_t)(l * 8 * 3 + r) * 6144 + n;
#pragma unroll
        for (int ks = 0; ks < 8; ++ks) v += mp[(size_t)ks * 3 * 6144];
        ((float*)(ws + WS_MODF))[idx] = v; }
}


__device__ __forceinline__ void norm_mod_row(f32x4 (&v)[4], const float* gain, const LAS float* sc, const LAS float* sh, bf16* orow, int lane) {
    float s = 0.f;
#pragma unroll
    for (int j = 0; j < 4; ++j) s += (v[j].x * v[j].x + v[j].y * v[j].y) + (v[j].z * v[j].z + v[j].w * v[j].w);
    const float rs = rsqrtf(wave_sum(s) * (1.f / D) + RMS_EPS);
#pragma unroll
    for (int j = 0; j < 4; ++j) { const int c = 4 * lane + 256 * j; const f32x4 g = *(const f32x4*)(gain + c); const f32x4 a = *(const LAS f32x4*)(sc + c), b = *(const LAS f32x4*)(sh + c);
        v[j] = (v[j] * rs) * g * (a + 1.f) + b;
        u32x2 w; w.x = pk2(v[j].x, v[j].y); w.y = pk2(v[j].z, v[j].w); *(u32x2*)(orow + c) = w; }
}

__device__ __forceinline__ void p0b_norm1(const Frame& F0) {
    const Frame F = phase_frame(F0); unsigned char* const ws = F.ws;
    LAS float* msh = (LAS float*)F.lds; LAS float* msc = msh + 3072;
    mod_to_lds(F, 0, 0, msh, true); mod_to_lds(F, 0, 1, msc, true); __syncthreads();
    mod_finalize(F);
    bf16* H = (bf16*)(ws + WS_H); const float* xin = inptr(I_X); const float* cin = inptr(I_CTX); const float* n1g = inptr(I_N1G);
    for (int row0 = F.gw; row0 < NROW; row0 += 2 * F.NGW) { f32x4 v[2][4]; bool ok[2];
#pragma unroll
        for (int u = 0; u < 2; ++u) { const int row = row0 + u * F.NGW; ok[u] = row < NROW; if (ok[u]) { const float* xr = row < NLAT ? xin + (size_t)row * D : cin + (size_t)(row - NLAT) * D;
#pragma unroll
            for (int j = 0; j < 4; ++j) v[u][j] = *(const f32x4*)(xr + 4 * F.lane + 256 * j); } }
#pragma unroll
        for (int u = 0; u < 2; ++u) if (ok[u]) { const int row = row0 + u * F.NGW; const int mr = modrow(row);
            norm_mod_row(v[u], n1g, msc + mr * 1024, msh + mr * 1024, H + (size_t)row * D, F.lane); } }
}
__device__ __forceinline__ void unpack8(const u32x4 w, float (&o)[8]) {
    o[0] = bf2f(w.x & 0xffffu); o[1] = bf2f(w.x >> 16); o[2] = bf2f(w.y & 0xffffu); o[3] = bf2f(w.y >> 16);
    o[4] = bf2f(w.z & 0xffffu); o[5] = bf2f(w.z >> 16); o[6] = bf2f(w.w & 0xffffu); o[7] = bf2f(w.w >> 16);
}
__device__ __forceinline__ void unpack4(const u32x2 w, float (&o)[4]) { o[0] = bf2f(w.x & 0xffffu); o[1] = bf2f(w.x >> 16); o[2] = bf2f(w.y & 0xffffu); o[3] = bf2f(w.y >> 16); }

__device__ __forceinline__ void shift_pass(const Frame& F0, int l) {
    const Frame F = phase_frame(F0); unsigned char* const ws = F.ws;
    const bf16* P = (const bf16*)(ws + WS_P); bf16* Zs = (bf16*)(ws + WS_ZS); const float* mu = inptr(I_MU) + l * ZW;
    const int total = NROW * 240;
    for (int idx = F.vcu * NTHR + F.tid; idx < total; idx += F.G * NTHR) {
        const int row = idx / 240, ck = idx % 240; const bf16* pr = P + (size_t)row * NP + ck * 8;
        const u32x4 zero = {0u, 0u, 0u, 0u};
        float z[8], n0[8], n1[8], n2[8], n3[8], o[8];
        unpack8(*(const u32x4*)pr, z);
        if (row < NLAT) { const int t = row & (SEQ - 1), gr = t >> 6, gc = t & 63;
            unpack8(gc > 0 ? *(const u32x4*)(pr - NP) : zero, n0); unpack8(gc < 63 ? *(const u32x4*)(pr + NP) : zero, n1);
            unpack8(gr > 0 ? *(const u32x4*)(pr - 64 * NP) : zero, n2); unpack8(gr < 127 ? *(const u32x4*)(pr + 64 * NP) : zero, n3);
        } else { const int tc = (row - NLAT) & (CTXL - 1);
            unpack8(tc > 0 ? *(const u32x4*)(pr - NP) : zero, n0); unpack8(tc < CTXL - 1 ? *(const u32x4*)(pr + NP) : zero, n1);
#pragma unroll
            for (int j = 0; j < 8; ++j) { n2[j] = n0[j]; n3[j] = n1[j]; }
        }
        const f32x4 m0 = *(const f32x4*)(mu + ck * 8), m1 = *(const f32x4*)(mu + ck * 8 + 4);
        const float m[8] = {m0.x, m0.y, m0.z, m0.w, m1.x, m1.y, m1.z, m1.w};
#pragma unroll
        for (int j = 0; j < 8; ++j) { const float nb = (j & 3) == 0 ? n0[j] : (j & 3) == 1 ? n1[j] : (j & 3) == 2 ? n2[j] : n3[j]; o[j] = z[j] + (nb - z[j]) * m[j]; }
        u32x4 w; w.x = pk2(o[0], o[1]); w.y = pk2(o[2], o[3]); w.z = pk2(o[4], o[5]); w.w = pk2(o[6], o[7]);
        *(u32x4*)(Zs + (size_t)row * ZW + ck * 8) = w;
    }
}

__device__ __forceinline__ void conv_pass(const Frame& F0, int l, int nrows) {
    const Frame F = phase_frame(F0); unsigned char* const ws = F.ws;
    const bf16* P = (const bf16*)(ws + WS_P); bf16* MA = (bf16*)(ws + WS_H);
    const float* cw = inptr(I_CONVW) + l * 3 * 256; const int c = 4 * F.lane;
    const f32x4 w0 = *(const f32x4*)(cw + c), w1 = *(const f32x4*)(cw + 256 + c), w2 = *(const f32x4*)(cw + 512 + c), gn = *(const f32x4*)(inptr(I_CONVG) + l * 256 + c);
    for (int row0 = F.gw; row0 < nrows; row0 += 2 * F.NGW) {
        u32x2 q[2][7]; bool ok[2]; const u32x2 zero = {0u, 0u};
#pragma unroll
        for (int u = 0; u < 2; ++u) { const int row = row0 + u * F.NGW; ok[u] = row < nrows; if (ok[u]) {
            int t, L; if (row < NLAT) { t = row & (SEQ - 1); L = SEQ; } else { t = (row - NLAT) & (CTXL - 1); L = CTXL; }
            const bf16* pr = P + (size_t)row * NP + COL_CONV + c;
            q[u][0] = *(const u32x2*)pr; q[u][1] = *(const u32x2*)(pr + 256); q[u][2] = *(const u32x2*)(pr + 512);
            q[u][3] = t > 0 ? *(const u32x2*)(pr - NP + 256) : zero; q[u][4] = t > 0 ? *(const u32x2*)(pr - NP + 512) : zero;
            q[u][5] = t < L - 1 ? *(const u32x2*)(pr + NP + 256) : zero; q[u][6] = t < L - 1 ? *(const u32x2*)(pr + NP + 512) : zero; } }
#pragma unroll
        for (int u = 0; u < 2; ++u) if (ok[u]) { const int row = row0 + u * F.NGW;
            float bg[4], cg[4], hh[4], cp[4], hp[4], cn[4], hn[4];
            unpack4(q[u][0], bg); unpack4(q[u][1], cg); unpack4(q[u][2], hh); unpack4(q[u][3], cp); unpack4(q[u][4], hp); unpack4(q[u][5], cn); unpack4(q[u][6], hn);
            const float W0[4] = {w0.x, w0.y, w0.z, w0.w}, W1[4] = {w1.x, w1.y, w1.z, w1.w}, W2[4] = {w2.x, w2.y, w2.z, w2.w}, GN[4] = {gn.x, gn.y, gn.z, gn.w};
            float y[4], s = 0.f;
#pragma unroll
            for (int j = 0; j < 4; ++j) { y[j] = bg[j] * (W0[j] * (cp[j] * hp[j]) + W1[j] * (cg[j] * hh[j]) + W2[j] * (cn[j] * hn[j])); s += y[j] * y[j]; }
            const float rs = rsqrtf(wave_sum(s) * (1.f / 256.f) + RMS_EPS);
            u32x2 o; o.x = pk2(y[0] * rs * GN[0], y[1] * rs * GN[1]); o.y = pk2(y[2] * rs * GN[2], y[3] * rs * GN[3]);
            *(u32x2*)(MA + (size_t)row * D + 512 + c) = o; }
    }
}

__device__ __forceinline__ void sincos_turns(float x, float& s, float& c) { s = __builtin_amdgcn_sinf(x); c = __builtin_amdgcn_cosf(x); }
#define MFMA16(a, b, c) __builtin_amdgcn_mfma_f32_16x16x32_bf16((a), (b), (c), 0, 0, 0)

__device__ __forceinline__ void fftA_item(const Frame& F0, int item) {
    const Frame F = phase_frame(F0); unsigned char* const ws = F.ws;
    const int half = item & 1, t2 = (item >> 1) & 63, b = item >> 7;
    const bf16* P = (const bf16*)(ws + WS_P); bf16* GT = (bf16*)(ws + WS_GT);
    LAS bf16* Bs = (LAS bf16*)F.lds;
    const int lane = F.lane, w = F.wave, fr = lane & 15, fq = lane >> 4;
    __syncthreads();
#pragma unroll
    for (int i = 0; i < 8; ++i) { const int cidx = F.tid + NTHR * i, krow = cidx >> 4, ch8 = cidx & 15, ri = krow >> 7, t1 = krow & 127;
        const u32x4 v = *(const u32x4*)(P + (size_t)(b * SEQ + t1 * 64 + t2) * NP + COL_FC + ri * 256 + half * 128 + ch8 * 8);
        LAS bf16* d = Bs + (ch8 * 8) * 264 + krow;
        d[0 * 264] = (bf16)(v.x & 0xffffu); d[1 * 264] = (bf16)(v.x >> 16); d[2 * 264] = (bf16)(v.y & 0xffffu); d[3 * 264] = (bf16)(v.y >> 16);
        d[4 * 264] = (bf16)(v.z & 0xffffu); d[5 * 264] = (bf16)(v.z >> 16); d[6 * 264] = (bf16)(v.w & 0xffffu); d[7 * 264] = (bf16)(v.w >> 16); }
    __syncthreads();
    f32x4 acc[2][8];
#pragma unroll
    for (int a = 0; a < 2; ++a)
#pragma unroll
        for (int n = 0; n < 8; ++n) acc[a][n] = (f32x4){0.f, 0.f, 0.f, 0.f};
    int t1p_a = 16 * w + fr;
    asm volatile("" : "+v"(t1p_a));
#pragma unroll
    for (int ks = 0; ks < 8; ++ks) {
        bf16x8 ar, ai;
#pragma unroll
        for (int j = 0; j < 8; ++j) { const int k = ks * 32 + 8 * fq + j, ri = k >> 7, t1 = k & 127; const int idx = (t1 * t1p_a) & 127;
            float sn, cs; sincos_turns((float)idx * (1.f / 128.f), sn, cs);
            const float vr = ri == 0 ? cs : -sn, vi = ri == 0 ? -sn : -cs;
            ar[j] = (short)f2bf(vr); ai[j] = (short)f2bf(vi); }
#pragma unroll
        for (int nt = 0; nt < 8; ++nt) { const bf16x8 bfr = *(const LAS bf16x8*)(Bs + (nt * 16 + fr) * 264 + ks * 32 + 8 * fq);
            acc[0][nt] = MFMA16(ar, bfr, acc[0][nt]); acc[1][nt] = MFMA16(ai, bfr, acc[1][nt]); }
    }
#pragma unroll
    for (int reg = 0; reg < 4; ++reg) { const int t1p = 16 * w + 4 * fq + reg; float st, ct; sincos_turns((float)(t2 * t1p) * (1.f / 8192.f), st, ct);
        bf16* g = GT + ((size_t)((b * 128 + t1p) * 64 + t2) * 2) * 256 + half * 128 + fr;
#pragma unroll
        for (int nt = 0; nt < 8; ++nt) { const float gr = acc[0][nt][reg], gi = acc[1][nt][reg];
            g[nt * 16] = (bf16)f2bf(gr * ct + gi * st); g[256 + nt * 16] = (bf16)f2bf(gi * ct - gr * st); } }
}

template <int NKC, int NDIV, int MT, class SrcRow, class OutRow>
__device__ __forceinline__ void dft64_item(const Frame& F0, int l, int m0, float sgn, float scale, SrcRow src, OutRow orow) {
    const Frame F = phase_frame(F0); unsigned char* const ws = F.ws;
    LAS bf16* Bs = (LAS bf16*)F.lds;
    LAS float* red = (LAS float*)(F.lds + 256 * 136 * 2);
    const int lane = F.lane, w = F.wave, fr = lane & 15, fq = lane >> 4;
    int fr_a = fr; asm volatile("" : "+v"(fr_a));
    f32x4 acc[MT][2];
#pragma unroll
    for (int a = 0; a < MT; ++a) { acc[a][0] = (f32x4){0.f, 0.f, 0.f, 0.f}; acc[a][1] = (f32x4){0.f, 0.f, 0.f, 0.f}; }
    for (int kc = 0; kc < NKC; ++kc) {
        __syncthreads();
#pragma unroll
        for (int i = 0; i < 8; ++i) { const int cidx = F.tid + NTHR * i, krow = cidx >> 5, ch8 = cidx & 31;
            const u32x4 v = *(const u32x4*)(src(kc * 64 + (krow >> 1), krow & 1) + ch8 * 8);
            LAS bf16* d = Bs + (ch8 * 8) * 136 + krow;
            d[0 * 136] = (bf16)(v.x & 0xffffu); d[1 * 136] = (bf16)(v.x >> 16); d[2 * 136] = (bf16)(v.y & 0xffffu); d[3 * 136] = (bf16)(v.y >> 16);
            d[4 * 136] = (bf16)(v.z & 0xffffu); d[5 * 136] = (bf16)(v.z >> 16); d[6 * 136] = (bf16)(v.w & 0xffffu); d[7 * 136] = (bf16)(v.w >> 16); }
        __syncthreads();
#pragma unroll
        for (int ks = 0; ks < 4; ++ks) {
            const bf16x8 b0 = *(const LAS bf16x8*)(Bs + ((2 * w) * 16 + fr) * 136 + ks * 32 + 8 * fq);
            const bf16x8 b1 = *(const LAS bf16x8*)(Bs + ((2 * w + 1) * 16 + fr) * 136 + ks * 32 + 8 * fq);
#pragma unroll
            for (int mt = 0; mt < MT; ++mt) { const int mrow = m0 + mt * 16 + fr_a; bf16x8 a;
#pragma unroll
                for (int j = 0; j < 8; ++j) { const int k = ks * 32 + 8 * fq + j, tl = k >> 1, ri = k & 1; const int idx = ((kc * 64 + tl) * mrow) & (NDIV - 1);
                    float sn, cs; sincos_turns((float)idx * (1.f / (float)NDIV), sn, cs);
                    a[j] = (short)f2bf(ri == 0 ? cs : sgn * sn); }
                acc[mt][0] = MFMA16(a, b0, acc[mt][0]); acc[mt][1] = MFMA16(a, b1, acc[mt][1]); }
        }
    }
#pragma unroll
    for (int mt = 0; mt < MT; ++mt)
#pragma unroll
        for (int reg = 0; reg < 4; ++reg) { const float a = acc[mt][0][reg] * scale, b = acc[mt][1][reg] * scale; acc[mt][0][reg] = a; acc[mt][1][reg] = b;
            float s = a * a + b * b; s += __shfl_xor(s, 1); s += __shfl_xor(s, 2); s += __shfl_xor(s, 4); s += __shfl_xor(s, 8);
            if (fr == 0) red[w * 64 + mt * 16 + 4 * fq + reg] = s; }
    __syncthreads();
    bf16* MA = (bf16*)(ws + WS_H); const float* fg = inptr(I_FOURG) + l * 256;
    const float g0 = fg[(2 * w) * 16 + fr], g1 = fg[(2 * w + 1) * 16 + fr];
#pragma unroll
    for (int mt = 0; mt < MT; ++mt)
#pragma unroll
        for (int reg = 0; reg < 4; ++reg) { const int ml = mt * 16 + 4 * fq + reg; float tot = 0.f;
#pragma unroll
            for (int ww = 0; ww < 8; ++ww) tot += red[ww * 64 + ml];
            const float rs = rsqrtf(tot * (1.f / 256.f) + RMS_EPS);
            bf16* o = MA + (size_t)orow(m0 + ml) * D + 768 + fr;
            o[(2 * w) * 16] = (bf16)f2bf(acc[mt][0][reg] * rs * g0); o[(2 * w + 1) * 16] = (bf16)f2bf(acc[mt][1][reg] * rs * g1); }
    __syncthreads();
}

constexpr size_t WS_LORA = 64 * 1024;
constexpr int LINP = 392;
__device__ __forceinline__ float fast_sigmoid(float x) { return __builtin_amdgcn_rcpf(1.f + __expf(-x)); }
__device__ __forceinline__ float fast_tanh(float x) { return 1.f - 2.f * __builtin_amdgcn_rcpf(1.f + __expf(2.f * x)); }
__device__ __forceinline__ void prep_phase(const Frame& F0, int l) {
    const Frame F = phase_frame(F0); unsigned char* const ws = F.ws;
    const bf16* Zs = (const bf16*)(ws + WS_ZS); bf16* STR = (bf16*)(ws + WS_STR);
    LAS bf16* lin = (LAS bf16*)F.lds;
    LAS float* ssum = (LAS float*)(F.lds + 12544);
    LAS bf16* tiles = (LAS bf16*)(F.lds + 13312);
    const int lane = F.lane, fr = lane & 15, fq = lane >> 4, w = F.wave, tid = F.tid;
    const int nitems = (NROW / 16) * 2;
    int it = blockIdx.x; if (it >= nitems) return;
    int hh = -1, head = 0, cb = 0;
    bf16x8 wf[12][2];
    const float* kkp = inptr(I_KK) + l * DR; const float* kap = inptr(I_KA) + l * DR; const float* dw0 = inptr(I_DW0) + l * 2 * DR; const float* ia0 = inptr(I_IA0) + l * 2 * DR;
    u32x4 pz[2];
#define PREP_LOAD(item_) do { const int row0_ = ((item_) >> 1) * 16; \
        pz[0] = *(const u32x4*)(Zs + (size_t)(row0_ + tid / 48) * ZW + 1536 + (tid % 48) * 8); \
        if (tid < 256) pz[1] = *(const u32x4*)(Zs + (size_t)(row0_ + (tid + 512) / 48) * ZW + 1536 + ((tid + 512) % 48) * 8); } while (0)
    PREP_LOAD(it);
    for (; it < nitems; it += F.G) {
        const int tile = it >> 1;
        if ((it & 1) != hh) {
            hh = it & 1; head = 4 * hh + (w >> 1); cb = 64 * head + 32 * (w & 1);
            const bf16* WL = (const bf16*)(ws + WS_LORA) + (size_t)l * 512 * 384 + (size_t)(cb + fr) * 384 + 8 * fq;
#pragma unroll
            for (int ks = 0; ks < 12; ++ks)
#pragma unroll
                for (int nt = 0; nt < 2; ++nt) wf[ks][nt] = *(const bf16x8*)(WL + (size_t)nt * 16 * 384 + ks * 32);
        }
        __syncthreads();
        {   float v[8]; unpack8(pz[0], v); const int c8 = tid % 48;
            if (c8 < 16) {
#pragma unroll
                for (int j = 0; j < 8; ++j) v[j] = fast_tanh(v[j]); }
            else if (c8 >= 32) {
#pragma unroll
                for (int j = 0; j < 8; ++j) v[j] = fast_sigmoid(v[j]); }
            *(LAS u32x4*)(lin + (tid / 48) * LINP + c8 * 8) = (u32x4){pk2(v[0], v[1]), pk2(v[2], v[3]), pk2(v[4], v[5]), pk2(v[6], v[7])};
            if (tid < 256) { unpack8(pz[1], v); const int c9 = (tid + 512) % 48;
                if (c9 < 16) {
#pragma unroll
                    for (int j = 0; j < 8; ++j) v[j] = fast_tanh(v[j]); }
                else if (c9 >= 32) {
#pragma unroll
                    for (int j = 0; j < 8; ++j) v[j] = fast_sigmoid(v[j]); }
                *(LAS u32x4*)(lin + ((tid + 512) / 48) * LINP + c9 * 8) = (u32x4){pk2(v[0], v[1]), pk2(v[2], v[3]), pk2(v[4], v[5]), pk2(v[6], v[7])}; } }
        u32x2 zr2[2], zk2[2], zv2[2];
        {   const bf16* zr_ = Zs + (size_t)(tile * 16 + fr) * ZW + cb + 4 * fq;
#pragma unroll
            for (int nt = 0; nt < 2; ++nt) { zr2[nt] = *(const u32x2*)(zr_ + 16 * nt); zk2[nt] = *(const u32x2*)(zr_ + 512 + 16 * nt); zv2[nt] = *(const u32x2*)(zr_ + 1024 + 16 * nt); } }
        if (it + F.G < nitems) PREP_LOAD(it + F.G);
        __syncthreads();
        f32x4 kkw[2], kaw[2], d0w[2][2], i0w[2][2];
#pragma unroll
        for (int nt = 0; nt < 2; ++nt) { const int c0 = cb + 16 * nt + 4 * fq; kkw[nt] = *(const f32x4*)(kkp + c0); kaw[nt] = *(const f32x4*)(kap + c0);
#pragma unroll
            for (int dn = 0; dn < 2; ++dn) { d0w[dn][nt] = *(const f32x4*)(dw0 + dn * DR + c0); i0w[dn][nt] = *(const f32x4*)(ia0 + dn * DR + c0); } }
        f32x4 acc[5][2];
#pragma unroll
        for (int q = 0; q < 5; ++q) { acc[q][0] = (f32x4){0.f, 0.f, 0.f, 0.f}; acc[q][1] = (f32x4){0.f, 0.f, 0.f, 0.f}; }
#pragma unroll
        for (int ks = 0; ks < 12; ++ks) { const int q = ks < 8 ? (ks >> 1) : 4; const bf16x8 xf = *(const LAS bf16x8*)(lin + fr * LINP + ks * 32 + 8 * fq);
            acc[q][0] = MFMA16(wf[ks][0], xf, acc[q][0]); acc[q][1] = MFMA16(wf[ks][1], xf, acc[q][1]); }
        float zk[2][4], kv[2][4]; float ss = 0.f;
#pragma unroll
        for (int nt = 0; nt < 2; ++nt) { unpack4(zk2[nt], zk[nt]);
#pragma unroll
            for (int i = 0; i < 4; ++i) { kv[nt][i] = zk[nt][i] * kkw[nt][i]; ss += kv[nt][i] * kv[nt][i]; } }
        ss += __shfl_xor(ss, 16); ss += __shfl_xor(ss, 32);
        if (fq == 0) ssum[w * 16 + fr] = ss;
        __syncthreads();
        const float inv = __builtin_amdgcn_rcpf(fmaxf(sqrtf(ssum[w * 16 + fr] + ssum[(w ^ 1) * 16 + fr]), 1e-12f));
        LAS bf16* th = tiles + (w >> 1) * 10 * 1024 + fr * 64 + 32 * (w & 1) + 4 * fq;
#pragma unroll
        for (int nt = 0; nt < 2; ++nt) { LAS bf16* t0 = th + 16 * nt;
            *(LAS u32x2*)(t0) = zr2[nt]; *(LAS u32x2*)(t0 + 1024) = zv2[nt];
            float kk[4];
#pragma unroll
            for (int i = 0; i < 4; ++i) kk[i] = kv[nt][i] * inv;
            *(LAS u32x2*)(t0 + 2 * 1024) = (u32x2){pk2(kk[0], kk[1]), pk2(kk[2], kk[3])};
            *(LAS u32x2*)(t0 + 3 * 1024) = (u32x2){pk2(acc[4][nt][0], acc[4][nt][1]), pk2(acc[4][nt][2], acc[4][nt][3])};
#pragma unroll
            for (int dn = 0; dn < 2; ++dn) { float ep[4], kd[4], bb[4];
#pragma unroll
                for (int i = 0; i < 4; ++i) { const float ew = fast_sigmoid(d0w[dn][nt][i] + acc[dn][nt][i]) * 0.6065306597126334f;
                    ep[i] = ew * (1.f + ew * (-0.5f + ew * (0.16666667f + ew * (-0.041666668f + ew * 0.0083333338f))));
                    const float a = fast_sigmoid(i0w[dn][nt][i] + acc[2 + dn][nt][i]); kd[i] = zk[nt][i] * (1.f + (a - 1.f) * kaw[nt][i]); bb[i] = kk[i] * a; }
                *(LAS u32x2*)(t0 + (4 + 3 * dn) * 1024) = (u32x2){pk2(ep[0], ep[1]), pk2(ep[2], ep[3])};
                *(LAS u32x2*)(t0 + (5 + 3 * dn) * 1024) = (u32x2){pk2(kd[0], kd[1]), pk2(kd[2], kd[3])};
                *(LAS u32x2*)(t0 + (6 + 3 * dn) * 1024) = (u32x2){pk2(bb[0], bb[1]), pk2(bb[2], bb[3])}; } }
        __syncthreads();
        {   const LAS bf16* src = tiles + (w >> 1) * 10 * 1024 + 8 * (w & 1) * 64 + lane * 8; bf16* dst = STR + ((size_t)tile * 8 + head) * 10240 + 8 * (w & 1) * 64 + lane * 8;
#pragma unroll
            for (int s = 0; s < 10; ++s) *(u32x4*)(dst + s * 1024) = *(const LAS u32x4*)(src + s * 1024); }
    }
#undef PREP_LOAD
}

__device__ __forceinline__ int scan_rowof(int s, int dir, int b) { if (s < CTXL) { const int tc = dir ? (CTXL - 1 - s) : s; return NLAT + b * CTXL + tc; } const int tt = s - CTXL; const int t = dir ? (SEQ - 1 - tt) : tt; return b * SEQ + t; }
__device__ __forceinline__ void readout_pass(const Frame& F0, int l, int nrows) {
    const Frame F = phase_frame(F0); unsigned char* const ws = F.ws;
    const bf16* STR = (const bf16*)(ws + WS_STR); const bf16* Y0 = (const bf16*)(ws + WS_Y); const bf16* Y1 = Y0 + (size_t)NROW * DR; bf16* MA = (bf16*)(ws + WS_H);
    const int lane = F.lane, c = 8 * lane;
    float gw[8], gb[8], rk[8];
    {   const float* gnw = inptr(I_GNW) + l * DR + c; const float* gnb = inptr(I_GNB) + l * DR + c; const float* rkp = inptr(I_RK) + l * DR + c;
        const f32x4 a0 = *(const f32x4*)gnw, a1 = *(const f32x4*)(gnw + 4), b0 = *(const f32x4*)gnb, b1 = *(const f32x4*)(gnb + 4), r0 = *(const f32x4*)rkp, r1 = *(const f32x4*)(rkp + 4);
#pragma unroll
        for (int i = 0; i < 4; ++i) { gw[i] = a0[i]; gw[4 + i] = a1[i]; gb[i] = b0[i]; gb[4 + i] = b1[i]; rk[i] = r0[i]; rk[4 + i] = r1[i]; } }
    for (int row0 = F.gw; row0 < nrows; row0 += 2 * F.NGW) {
        u32x4 q[2][7]; bool ok[2];
#pragma unroll
        for (int u = 0; u < 2; ++u) { const int row = row0 + u * F.NGW; ok[u] = row < nrows; if (ok[u]) {
            const bf16* sr = STR + ((size_t)(row >> 4) * 8 + (lane >> 3)) * 10240 + (row & 15) * 64 + (lane & 7) * 8;
            q[u][0] = *(const u32x4*)(Y0 + (size_t)row * DR + c); q[u][1] = *(const u32x4*)(Y1 + (size_t)row * DR + c);
            q[u][2] = *(const u32x4*)sr; q[u][3] = *(const u32x4*)(sr + 1024); q[u][4] = *(const u32x4*)(sr + 3072); q[u][5] = *(const u32x4*)(sr + 5 * 1024); q[u][6] = *(const u32x4*)(sr + 8 * 1024); } }
#pragma unroll
        for (int u = 0; u < 2; ++u) if (ok[u]) { const int row = row0 + u * F.NGW;
            float ya[8], yb[8], r[8], v[8], g[8], k0[8], k1[8];
            unpack8(q[u][0], ya); unpack8(q[u][1], yb); unpack8(q[u][2], r); unpack8(q[u][3], v); unpack8(q[u][4], g); unpack8(q[u][5], k0); unpack8(q[u][6], k1);
            float s1 = 0.f, s2 = 0.f, sb = 0.f;
#pragma unroll
            for (int i = 0; i < 8; ++i) { ya[i] += yb[i]; s1 += ya[i]; s2 += ya[i] * ya[i]; sb += r[i] * (k0[i] + k1[i]) * rk[i]; }
#pragma unroll
            for (int o = 1; o < 8; o <<= 1) { s1 += __shfl_xor(s1, o); s2 += __shfl_xor(s2, o); sb += __shfl_xor(sb, o); }
            const float mu = s1 * (1.f / 64.f); const float var = fmaxf(s2 * (1.f / 64.f) - mu * mu, 0.f); const float rs = rsqrtf(var + GN_EPS);
            float o8[8];
#pragma unroll
            for (int i = 0; i < 8; ++i) o8[i] = ((ya[i] - mu) * rs * gw[i] + gb[i] + sb * v[i]) * g[i];
            *(u32x4*)(MA + (size_t)row * D + c) = (u32x4){pk2(o8[0], o8[1]), pk2(o8[2], o8[3]), pk2(o8[4], o8[5]), pk2(o8[6], o8[7])}; }
    }
}
constexpr int BLOB = 16384, SEGCH = 132, NSEG = 4, BLOB_B1_SCANS = 14;
constexpr size_t WS_BLOBA = 20 * MiB, WS_BLOBB1 = 86 * MiB, WS_BLOBB2 = 492 * MiB;
constexpr size_t WS_SCANST = 2 * MiB + 512 * 1024;
__device__ __forceinline__ unsigned char* blob_ptr(unsigned char* ws, int seg, int scan, int ci) {
    if ((seg & 1) == 0) return ws + WS_BLOBA + ((size_t)scan * SEGCH + ci) * BLOB;
    return scan < BLOB_B1_SCANS ? ws + WS_BLOBB1 + ((size_t)scan * SEGCH + ci) * BLOB : ws + WS_BLOBB2 + ((size_t)(scan - BLOB_B1_SCANS) * SEGCH + ci) * BLOB;
}
typedef short s16x4 __attribute__((ext_vector_type(4)));
__device__ __forceinline__ bf16x8 frag_lo(u32x2 x) { u32x4 t = {x.x, x.y, 0u, 0u}; return __builtin_bit_cast(bf16x8, t); }
__device__ __forceinline__ bf16x8 frag_c(const f32x4& a) { u32x4 t = {pk2(a[0], a[1]), pk2(a[2], a[3]), 0u, 0u}; return __builtin_bit_cast(bf16x8, t); }

struct PreRegs { u32x4 q[12]; };
__device__ __forceinline__ void pre_load(PreRegs& R, unsigned char* ws, int scan, int cs, int lane) {
    const int dir = scan & 1, h = (scan >> 1) & 7, b = scan >> 4; const int rfirst = scan_rowof(16 * cs, dir, b);
    const bf16* blk = (const bf16*)(ws + WS_STR) + ((size_t)(rfirst >> 4) * 8 + h) * 10240 + lane * 8;
    const int so[6] = {0, 1, 2, 4 + 3 * dir, 5 + 3 * dir, 6 + 3 * dir};
#pragma unroll
    for (int i = 0; i < 6; ++i) { R.q[2 * i] = *(const u32x4*)(blk + so[i] * 1024); R.q[2 * i + 1] = *(const u32x4*)(blk + so[i] * 1024 + 512); }
}
template <int PM>
__device__ __forceinline__ void pre_item(const Frame& F, unsigned char* ws, int scan, int cs, unsigned char* blob, PreRegs& PR, int nscan, int ncs) {
    const int dir = scan & 1, h = (scan >> 1) & 7, b = scan >> 4; const int lane = F.lane, fr = lane & 15, fq = lane >> 4;
    LAS unsigned char* L = F.lds + F.wave * 17408;
    LAS bf16* TK = (LAS bf16*)L; LAS bf16* TR = TK + 1024; LAS bf16* TKt = TR + 1024; LAS bf16* TB = TKt + 1024;
    LAS bf16* KTt = TB + 1024; LAS bf16* RTt = KTt + 1024; LAS bf16* Vt = RTt + 1024;
    LAS float* AKB = (LAS float*)(Vt + 1024);
    LAS bf16* AKK = (LAS bf16*)(AKB + 256); LAS bf16* ARK = AKK + 256; LAS bf16* ARB = ARK + 256; LAS bf16* TT = ARB + 256;
    float kh[16], bh[16];
    float pc;
    {   float r_[16], v_[16], kk_[16], lp_[16], kd_[16], bb_[16];
        LAS bf16* stg = TK;
#pragma unroll
        for (int i = 0; i < 6; ++i) { *(LAS u32x4*)(stg + i * 1024 + lane * 8) = PR.q[2 * i]; *(LAS u32x4*)(stg + i * 1024 + 512 + lane * 8) = PR.q[2 * i + 1]; }
        LDS_WAIT(); asm volatile("" ::: "memory");
        if (nscan >= 0) pre_load(PR, ws, nscan, ncs, lane);
#pragma unroll
        for (int t = 0; t < 16; ++t) { const int tm = (dir ? 15 - t : t) * 64 + lane;
            r_[t] = bf2f(stg[tm]); v_[t] = bf2f(stg[1024 + tm]); kk_[t] = bf2f(stg[2048 + tm]); lp_[t] = bf2f(stg[3072 + tm]); kd_[t] = bf2f(stg[4096 + tm]); bb_[t] = bf2f(stg[5120 + tm]); }
        LDS_WAIT(); asm volatile("" ::: "memory");
        float pp = 1.f; u32x4 kt4[2], rt4[2], v4[2];
        unsigned ktp[8], rtp[8], vp[8];
#pragma unroll
        for (int t = 0; t < 16; ++t) { const float pm1 = pp; pp *= 1.f - lp_[t]; const float p = pp, ip = __builtin_amdgcn_rcpf(pp); lp_[t] = ip;
            const float kt = kk_[t] * pm1, ktl = kd_[t] * ip, btl = bb_[t] * ip, rt = r_[t] * p;
            const unsigned hk = pk2(kt, rt), hb = pk2(ktl, btl);
            TK[t * 64 + lane] = (bf16)(hk & 0xffffu); TR[t * 64 + lane] = (bf16)(hk >> 16); TKt[t * 64 + lane] = (bf16)(hb & 0xffffu); TB[t * 64 + lane] = (bf16)(hb >> 16);
            const unsigned hv = f2bf(v_[t]);
            if (t & 1) { ktp[t >> 1] |= hk << 16; rtp[t >> 1] |= hk & 0xffff0000u; vp[t >> 1] |= hv << 16; }
            else { ktp[t >> 1] = hk & 0xffffu; rtp[t >> 1] = hk >> 16; vp[t >> 1] = hv; } }
        kt4[0] = (u32x4){ktp[0], ktp[1], ktp[2], ktp[3]}; kt4[1] = (u32x4){ktp[4], ktp[5], ktp[6], ktp[7]};
        rt4[0] = (u32x4){rtp[0], rtp[1], rtp[2], rtp[3]}; rt4[1] = (u32x4){rtp[4], rtp[5], rtp[6], rtp[7]};
        v4[0] = (u32x4){vp[0], vp[1], vp[2], vp[3]}; v4[1] = (u32x4){vp[4], vp[5], vp[6], vp[7]};
        *(LAS u32x4*)(KTt + lane * 16) = kt4[0]; *(LAS u32x4*)(KTt + lane * 16 + 8) = kt4[1];
        *(LAS u32x4*)(RTt + lane * 16) = rt4[0]; *(LAS u32x4*)(RTt + lane * 16 + 8) = rt4[1];
        *(LAS u32x4*)(Vt + lane * 16) = v4[0]; *(LAS u32x4*)(Vt + lane * 16 + 8) = v4[1];
        pc = pp;
#pragma unroll
        for (int t = 0; t < 16; ++t) { const float e = pp * lp_[t]; kh[t] = kd_[t] * e; bh[t] = bb_[t] * e; }
    }
    LDS_WAIT(); asm volatile("" ::: "memory");
    {   f32x4 akb = {0.f, 0.f, 0.f, 0.f}, akk = akb, ark = akb, arb = akb;
#pragma unroll
        for (int s = 0; s < 2; ++s) { const int o = fr * 64 + 32 * s + 8 * fq;
            const bf16x8 fk = *(const LAS bf16x8*)(TK + o), frr = *(const LAS bf16x8*)(TR + o), fkt = *(const LAS bf16x8*)(TKt + o), fb = *(const LAS bf16x8*)(TB + o);
            akb = MFMA16(fk, fb, akb); akk = MFMA16(fk, fkt, akk); ark = MFMA16(frr, fkt, ark); arb = MFMA16(frr, fb, arb); }
        float nm[4];
#pragma unroll
        for (int reg = 0; reg < 4; ++reg) { const int t = 4 * fq + reg; const bool lo = fr < t, le = fr <= t;
            nm[reg] = lo ? akb[reg] : 0.f; AKK[t * 16 + fr] = (bf16)f2bf(lo ? akk[reg] : 0.f);
            ARK[t * 16 + fr] = (bf16)f2bf(le ? ark[reg] : 0.f); ARB[t * 16 + fr] = (bf16)f2bf(le ? arb[reg] : 0.f); }
        float col[16];
#pragma unroll
        for (int t = 0; t < 16; ++t) { float s_ = (t == fr) ? 1.f : 0.f;
#pragma unroll
            for (int i = 0; i < 16; ++i) if (i < t) { const float n_ti = __builtin_bit_cast(float, __builtin_amdgcn_readlane(__builtin_bit_cast(int, nm[t & 3]), i + 16 * (t >> 2))); s_ -= n_ti * col[i]; }
            col[t] = s_; TT[t * 16 + fr] = (bf16)f2bf(s_); }
    }
    LDS_WAIT(); asm volatile("" ::: "memory");
    f32x4 WTc[4], RqT[4], U0c[4], Y0c[4];
    {   const bf16x8 aT = frag_lo(*(const LAS u32x2*)(TT + fr * 16 + 4 * fq)), aKK = frag_lo(*(const LAS u32x2*)(AKK + fr * 16 + 4 * fq)), aRK = frag_lo(*(const LAS u32x2*)(ARK + fr * 16 + 4 * fq));
        u32x2 nb = *(const LAS u32x2*)(ARB + fr * 16 + 4 * fq); nb.x ^= 0x80008000u; nb.y ^= 0x80008000u; const bf16x8 aRBn = frag_lo(nb);
        const f32x4 z4 = {0.f, 0.f, 0.f, 0.f};
#pragma unroll
        for (int nt = 0; nt < 4; ++nt) { const int o = (16 * nt + fr) * 16 + 4 * fq;
            const bf16x8 bK = frag_lo(*(const LAS u32x2*)(KTt + o)), bV = frag_lo(*(const LAS u32x2*)(Vt + o));
            float ri[4]; unpack4(*(const LAS u32x2*)(TR + fr * 64 + 16 * nt + 4 * fq), ri);
            const f32x4 Wn = MFMA16(aT, bK, z4); WTc[nt] = MFMA16(bK, aT, z4);
            const f32x4 Zn = MFMA16(aKK, bV, z4);
            U0c[nt] = MFMA16(aT, frag_c(Zn), z4);
            RqT[nt] = MFMA16(frag_c(Wn), aRBn, ((f32x4){ri[0], ri[1], ri[2], ri[3]}));
            Y0c[nt] = MFMA16(aRK, bV, z4); Y0c[nt] = MFMA16(aRBn, frag_c(U0c[nt]), Y0c[nt]); }
    }
    LDS_WAIT(); asm volatile("" ::: "memory");
#pragma unroll
    for (int nt = 0; nt < 4; ++nt) { const u32x2 vv = *(const LAS u32x2*)(Vt + (16 * nt + fr) * 16 + 4 * fq);
        *(u32x2*)(blob + 8192 + nt * 2048 + 1024 + lane * 8) = vv;
        u32x2 u0 = {pk2(U0c[nt][0], U0c[nt][1]), pk2(U0c[nt][2], U0c[nt][3])}, y0 = {pk2(Y0c[nt][0], Y0c[nt][1]), pk2(Y0c[nt][2], Y0c[nt][3])};
        *(u32x2*)(blob + 8192 + nt * 2048 + lane * 8) = u0; *(u32x2*)(blob + 8192 + nt * 2048 + 512 + lane * 8) = y0;
        *(float*)(blob + 8192 + nt * 2048 + 1536 + lane * 4) = pc; }
#pragma unroll
    for (int s = 0; s < 2; ++s) {
        *(u32x4*)(blob + (0 * 2 + s) * 1024 + lane * 16) = (u32x4){pk2(WTc[2 * s][0], WTc[2 * s][1]), pk2(WTc[2 * s][2], WTc[2 * s][3]), pk2(WTc[2 * s + 1][0], WTc[2 * s + 1][1]), pk2(WTc[2 * s + 1][2], WTc[2 * s + 1][3])};
        *(u32x4*)(blob + (1 * 2 + s) * 1024 + lane * 16) = (u32x4){pk2(RqT[2 * s][0], RqT[2 * s][1]), pk2(RqT[2 * s][2], RqT[2 * s][3]), pk2(RqT[2 * s + 1][0], RqT[2 * s + 1][1]), pk2(RqT[2 * s + 1][2], RqT[2 * s + 1][3])}; }
    LAS bf16* BHt = TKt; LAS bf16* KHt = TB;
    {   u32x4 a, c, d, e;
        a = (u32x4){pk2(bh[0], bh[1]), pk2(bh[2], bh[3]), pk2(bh[4], bh[5]), pk2(bh[6], bh[7])}; c = (u32x4){pk2(bh[8], bh[9]), pk2(bh[10], bh[11]), pk2(bh[12], bh[13]), pk2(bh[14], bh[15])};
        d = (u32x4){pk2(kh[0], kh[1]), pk2(kh[2], kh[3]), pk2(kh[4], kh[5]), pk2(kh[6], kh[7])}; e = (u32x4){pk2(kh[8], kh[9]), pk2(kh[10], kh[11]), pk2(kh[12], kh[13]), pk2(kh[14], kh[15])};
        *(LAS u32x4*)(BHt + lane * 16) = a; *(LAS u32x4*)(BHt + lane * 16 + 8) = c; *(LAS u32x4*)(KHt + lane * 16) = d; *(LAS u32x4*)(KHt + lane * 16 + 8) = e; }
    LDS_WAIT(); asm volatile("" ::: "memory");
#pragma unroll
    for (int mt = 0; mt < 4; ++mt) { const int o = (16 * mt + fr) * 16 + 4 * fq; const u32x2 bb = *(const LAS u32x2*)(BHt + o), kk = *(const LAS u32x2*)(KHt + o);
        *(u32x4*)(blob + 4096 + mt * 1024 + lane * 16) = (u32x4){bb.x ^ 0x80008000u, bb.y ^ 0x80008000u, kk.x, kk.y}; }
    LDS_WAIT(); asm volatile("" ::: "memory");
}

__device__ __forceinline__ void pre_phase(const Frame& F0, int seg, int b_lo) {
    const Frame F = phase_frame(F0); unsigned char* const ws = F.ws;
    if ((int)blockIdx.x < b_lo) return;
    const int nwv = (F.G - b_lo) * NWAVES;
    PreRegs R;
    int it = ((int)blockIdx.x - b_lo) * NWAVES + F.wave; if (it >= 32 * SEGCH) return;
    pre_load(R, ws, it & 31, seg * SEGCH + (it >> 5), F.lane);
    for (; it < 32 * SEGCH; it += nwv) { const int nx = it + nwv; const bool hn = nx < 32 * SEGCH;
        pre_item<0>(F, ws, it & 31, seg * SEGCH + (it >> 5), blob_ptr(ws, seg, it & 31, it >> 5), R, hn ? (nx & 31) : -1, seg * SEGCH + (nx >> 5)); }
}

constexpr int SQ_SLOT = 10240, SQ_R = 12, SQ_D = 8;
template <int MODE>
__device__ __forceinline__ void seq_item(const Frame& F0, int item, int seg, bool need_ctx) {
    const Frame F = phase_frame(F0); unsigned char* const ws = F.ws;
    const int scan = item >> 2, vb = item & 3, dir = scan & 1, h = (scan >> 1) & 7, b = scan >> 4; const int lane = F.lane, fr = lane & 15, fq = lane >> 4, w = F.wave;
    const unsigned char* blob = blob_ptr(ws, seg, scan, 0);
    LAS unsigned char* ring = F.lds;
    __syncthreads();
    const int p0 = 2 * (w - 1);
    const unsigned goff0 = (p0 < 8 ? p0 * 1024 : 8192 + vb * 2048 + (p0 - 8) * 1024) + lane * 16, goff1 = (p0 + 1 < 8 ? (p0 + 1) * 1024 : 8192 + vb * 2048 + (p0 + 1 - 8) * 1024) + lane * 16;
#define SQ_ISSUE(c) do { const unsigned char* g_ = blob + (size_t)(c) * BLOB; LAS unsigned char* s_ = ring + ((c) % SQ_R) * SQ_SLOT + p0 * 1024; \
        __builtin_amdgcn_global_load_lds((const unsigned*)(g_ + goff0), (LAS unsigned*)(s_), 16, 0, 0); \
        __builtin_amdgcn_global_load_lds((const unsigned*)(g_ + goff1), (LAS unsigned*)(s_ + 1024), 16, 0, 0); } while (0)
    const bool loader = (w >= 1 && w <= 5) && MODE != 2;
    if (loader) { for (int c = 0; c < SQ_D; ++c) SQ_ISSUE(c); }
    bf16* Y = (bf16*)(ws + WS_Y) + (size_t)dir * NROW * DR + h * 64 + 16 * vb + fr;
    float* st = (float*)(ws + WS_SCANST) + (size_t)item * 1024 + lane * 4;
    f32x4 M[4];
#pragma unroll
    for (int mt = 0; mt < 4; ++mt) M[mt] = (seg == 0 || w != 0) ? (f32x4){0.f, 0.f, 0.f, 0.f} : *(const f32x4*)(st + mt * 256);
    const f32x4 z4 = {0.f, 0.f, 0.f, 0.f};
    LAS unsigned char* mb = ring + SQ_R * SQ_SLOT;
    struct SQ { bf16x8 a1[2], a2[4]; f32x4 pc[4]; u32x2 u0, vv; };
#define SQ_READ(R, c) do { const LAS unsigned char* sl_ = ring + ((c) % SQ_R) * SQ_SLOT; _Pragma("unroll") for (int i = 0; i < 4; ++i) { \
        R.a2[i] = *(const LAS bf16x8*)(sl_ + 4096 + i * 1024 + lane * 16); R.pc[i] = *(const LAS f32x4*)(sl_ + 8192 + 1536 + (16 * i + 4 * fq) * 4); } \
        R.a1[0] = *(const LAS bf16x8*)(sl_ + lane * 16); R.a1[1] = *(const LAS bf16x8*)(sl_ + 1024 + lane * 16); \
        R.u0 = *(const LAS u32x2*)(sl_ + 8192 + lane * 8); R.vv = *(const LAS u32x2*)(sl_ + 8192 + 1024 + lane * 8); } while (0)
#define SQ_STEP(R, c, RN, cn) do { \
        if ((cn) < SEGCH) SQ_READ(RN, cn); \
        const u32x4 t0 = {pk2(M[0][0], M[0][1]), pk2(M[0][2], M[0][3]), pk2(M[1][0], M[1][1]), pk2(M[1][2], M[1][3])}; \
        const u32x4 t1 = {pk2(M[2][0], M[2][1]), pk2(M[2][2], M[2][3]), pk2(M[3][0], M[3][1]), pk2(M[3][2], M[3][3])}; \
        *(LAS u32x4*)(mb + ((c) & 1) * 2048 + lane * 16) = t0; *(LAS u32x4*)(mb + ((c) & 1) * 2048 + 1024 + lane * 16) = t1; \
        const bf16x8 b0 = __builtin_bit_cast(bf16x8, t0), b1 = __builtin_bit_cast(bf16x8, t1); \
        f32x4 X0 = MFMA16(R.a1[0], b0, z4); X0 = MFMA16(R.a1[1], b1, X0); \
        float u0[4]; unpack4(R.u0, u0); \
        const u32x4 tb = {pk2(X0[0] + u0[0], X0[1] + u0[1]), pk2(X0[2] + u0[2], X0[3] + u0[3]), R.vv.x, R.vv.y}; const bf16x8 bB = __builtin_bit_cast(bf16x8, tb); \
        _Pragma("unroll") for (int mt = 0; mt < 4; ++mt) M[mt] = MFMA16(R.a2[mt], bB, R.pc[mt] * M[mt]); \
        asm volatile("s_waitcnt lgkmcnt(0)" ::: "memory"); } while (0)
    const long ystep = dir ? -(long)DR : (long)DR;
#define SQ_YSTEP(c) do { const int cs_ = seg * SEGCH + (c); if (MODE == 0 && (need_ctx || cs_ >= 16)) { const LAS unsigned char* sl_ = ring + ((c) % SQ_R) * SQ_SLOT; \
        const bf16x8 q0 = *(const LAS bf16x8*)(sl_ + 2048 + lane * 16), q1 = *(const LAS bf16x8*)(sl_ + 3072 + lane * 16); \
        const bf16x8 b0 = *(const LAS bf16x8*)(mb + ((c) & 1) * 2048 + lane * 16), b1 = *(const LAS bf16x8*)(mb + ((c) & 1) * 2048 + 1024 + lane * 16); \
        float y0[4]; unpack4(*(const LAS u32x2*)(sl_ + 8192 + 512 + lane * 8), y0); \
        f32x4 X1 = MFMA16(q0, b0, z4); X1 = MFMA16(q1, b1, X1); \
        bf16* yp = Y + (size_t)scan_rowof(16 * cs_ + 4 * fq, dir, b) * DR; \
        yp[0] = (bf16)f2bf(X1[0] + y0[0]); yp[ystep] = (bf16)f2bf(X1[1] + y0[1]); yp[2 * ystep] = (bf16)f2bf(X1[2] + y0[2]); yp[3 * ystep] = (bf16)f2bf(X1[3] + y0[3]); \
        asm volatile("s_waitcnt lgkmcnt(0)" ::: "memory"); } } while (0)
#define SQ_LOADER(c) do { if (loader) { __builtin_amdgcn_s_sleep(3); if ((c) + SQ_D < SEGCH) { SQ_ISSUE((c) + SQ_D); asm volatile("s_waitcnt vmcnt(12)" ::: "memory"); } else asm volatile("s_waitcnt vmcnt(0)" ::: "memory"); } \
        __builtin_amdgcn_s_barrier(); asm volatile("" ::: "memory"); } while (0)
    const bool stw = (w == 0 && MODE != 1), yw = (w == 6 && MODE != 1);
    SQ Ra, Rb, Rc;
    SQ_LOADER(0);
    if (stw) { SQ_READ(Ra, 0); SQ_READ(Rb, 1); }
    for (int c = 0; c < SEGCH; c += 3) {
        SQ_LOADER(c + 1);
        if (stw) SQ_STEP(Ra, c, Rc, c + 2);
        if (yw && c > 0) SQ_YSTEP(c - 1);
        SQ_LOADER(c + 2);
        if (stw) SQ_STEP(Rb, c + 1, Ra, c + 3);
        if (yw) SQ_YSTEP(c);
        SQ_LOADER(c + 3);
        if (stw) SQ_STEP(Rc, c + 2, Rb, c + 4);
        if (yw) SQ_YSTEP(c + 1);
    }
    __builtin_amdgcn_s_barrier(); asm volatile("" ::: "memory");
    if (yw) SQ_YSTEP(SEGCH - 1);
#undef SQ_READ
#undef SQ_STEP
#undef SQ_YSTEP
#undef SQ_LOADER
#undef SQ_ISSUE
    if (MODE >= 2 && w == 0 && M[0][0] + M[1][1] + M[2][2] + M[3][3] == 12345.678f) st[0] = M[0][0];
    if (MODE == 0 && w == 0 && seg + 1 < NSEG) {
#pragma unroll
        for (int mt = 0; mt < 4; ++mt) *(f32x4*)(st + mt * 256) = M[mt]; }
    __syncthreads();
}

namespace pg8 {
struct EpiStoreBf16 {
    static constexpr bool PERM = true, AFTER_DRAIN = false;
    bf16_t* O; int ldc; int pn_mask;
    __device__ __forceinline__ void operator()(const f32x4 (&acc)[2][2][4][2], const Unit& u, int wr, int wc, int fr, int fq) const {
        const int row0 = u.pm * BM + wr * 64 + fr; const int col0 = (u.pn & pn_mask) * BM + wc * 32 + 8 * fq;
#pragma unroll
        for (int ai = 0; ai < 2; ++ai)
#pragma unroll
            for (int m = 0; m < 4; ++m) { bf16_t* rowp = O + (size_t)(row0 + ai * HALF + m * 16) * ldc + col0;
#pragma unroll
                for (int bj = 0; bj < 2; ++bj) { const f32x4 v0 = acc[ai][bj][m][0], v1 = acc[ai][bj][m][1];
                    u32x4 w; w.x = cvt_pk_bf16(v0[0], v0[1]); w.y = cvt_pk_bf16(v0[2], v0[3]); w.z = cvt_pk_bf16(v1[0], v1[1]); w.w = cvt_pk_bf16(v1[2], v1[3]);
                    *(u32x4*)(rowp + bj * HALF) = w; } }
    }
};
struct EpiSwiGLU {
    static constexpr bool PERM = true, AFTER_DRAIN = false;
    bf16_t* O;
    __device__ __forceinline__ void operator()(const f32x4 (&acc)[2][2][4][2], const Unit& u, int wr, int wc, int fr, int fq) const {
        const int row0 = u.pm * BM + wr * 64 + fr; const int col0 = ((u.pn & 3) * BM + wc * 32 + 8 * fq) >> 1;
#pragma unroll
        for (int ai = 0; ai < 2; ++ai)
#pragma unroll
            for (int m = 0; m < 4; ++m) { bf16_t* rowp = O + (size_t)(row0 + ai * HALF + m * 16) * 512 + col0;
#pragma unroll
                for (int bj = 0; bj < 2; ++bj) { const f32x4 g = acc[ai][bj][m][0], up = acc[ai][bj][m][1]; float a[4];
#pragma unroll
                    for (int i = 0; i < 4; ++i) a[i] = g[i] / (1.f + __expf(-g[i])) * up[i];
                    unsigned long long w = (unsigned long long)cvt_pk_bf16(a[0], a[1]) | ((unsigned long long)cvt_pk_bf16(a[2], a[3]) << 32);
                    *(unsigned long long*)(rowp + bj * (HALF / 2)) = w; } }
    }
};
template <bool XF32> struct EpiResidual {
    static constexpr bool PERM = false, AFTER_DRAIN = false;
    const void* xlat; const void* xctx;
    bf16_t* out; const float* g1;
    __device__ __forceinline__ void operator()(const f32x4 (&acc)[2][2][4][2], const Unit& u, int wr, int wc, int fr, int fq) const {
        const int rowt = u.pm * BM; const int mr = rowt < 16384 ? (rowt >> 13) : 2;
        const size_t boff = rowt < 16384 ? (size_t)rowt * 1024 : (size_t)(rowt - 16384) * 1024; const void* bp = rowt < 16384 ? xlat : xctx;
        const int col0 = u.pn * BM + wc * 32 + 4 * fq;
        f32x4 gv[2][2];
#pragma unroll
        for (int bj = 0; bj < 2; ++bj)
#pragma unroll
            for (int n = 0; n < 2; ++n) gv[bj][n] = *(const f32x4*)(g1 + (size_t)mr * 6144 + col0 + bj * HALF + n * 16);
#pragma unroll
        for (int ai = 0; ai < 2; ++ai)
#pragma unroll
            for (int m = 0; m < 4; ++m) { const int rl = ai * HALF + wr * 64 + m * 16 + fr;
#pragma unroll
                for (int bj = 0; bj < 2; ++bj)
#pragma unroll
                    for (int n = 0; n < 2; ++n) { const size_t off = (size_t)rl * 1024 + col0 + bj * HALF + n * 16;
                        f32x4 xo;
                        if (XF32) xo = *(const f32x4*)((const float*)bp + boff + off);
                        else { const unsigned long long w_ = *(const unsigned long long*)((const bf16_t*)bp + boff + off); const unsigned lo = (unsigned)w_, hi = (unsigned)(w_ >> 32);
                            xo = (f32x4){__uint_as_float(lo << 16), __uint_as_float(lo & 0xffff0000u), __uint_as_float(hi << 16), __uint_as_float(hi & 0xffff0000u)}; }
                        const f32x4 r = xo + gv[bj][n] * acc[ai][bj][m][n];
                        *(unsigned long long*)(out + (size_t)rowt * 1024 + off) = (unsigned long long)cvt_pk_bf16(r[0], r[1]) | ((unsigned long long)cvt_pk_bf16(r[2], r[3]) << 32); } }
    }
};
struct MoeOrder {
    const PG8_LAS int* tile_e; const PG8_LAS int* tile_t; int ntiles, G, c;
    __device__ bool next(int i, Unit& u) const { const long L = (long)i * G + c; if (L >= 4L * ntiles) return false; const int pm = (int)(L >> 2); const int e = tile_e[pm];
        u.pm = pm; u.pn = e * 4 + (int)(L & 3); u.ga = e * 16896 + tile_t[pm] * 256; return true; }
    __device__ __forceinline__ void a_ready(const Unit&) const {}
    __device__ __forceinline__ void done(const Unit&) const {}
};
}

__device__ __forceinline__ void expert_convert(const Frame& F0, int l, int b_lo) {
    const Frame F = phase_frame(F0); unsigned char* const ws = F.ws;
    if ((int)blockIdx.x < b_lo) return;
    const int nwv = (F.G - b_lo) * NWAVES, myw = ((int)blockIdx.x - b_lo) * NWAVES + F.wave;
    LAS float* scr = (LAS float*)(F.lds + F.wave * 16384);
    bf16* wgu = (bf16*)(ws + WS_WGU_T); bf16* wd = (bf16*)(ws + WS_WD_T);
    constexpr int I_G = 16 * 16, I_D = 8 * 32;
    constexpr int NIT = NEXP * (2 * I_G + I_D);
    const float* p_eg = inptr(I_EG); const float* p_eu = inptr(I_EU); const float* p_ed = inptr(I_ED);
    for (int it = myw; it < NIT; it += nwv) { const int e = it / (2 * I_G + I_D); int r = it % (2 * I_G + I_D);
        if (r < I_G) { transpose_item(p_eg + ((size_t)l * NEXP + e) * D * DEXP, DEXP, (r >> 4) * 64, (r & 15) * 32, wgu, D, RmGU{e * 1024}, scr, F.lane); continue; } r -= I_G;
        if (r < I_G) { transpose_item(p_eu + ((size_t)l * NEXP + e) * D * DEXP, DEXP, (r >> 4) * 64, (r & 15) * 32, wgu, D, RmGU{e * 1024 + 4}, scr, F.lane); continue; } r -= I_G;
        transpose_item(p_ed + ((size_t)l * NEXP + e) * DEXP * D, D, (r >> 5) * 64, (r & 31) * 32, wd, DEXP, RmId{e * 1024}, scr, F.lane);
    }
}

__device__ __forceinline__ void router_pass(const Frame& F0, int l, int nrows, int cnt_off = 0) {
    const Frame F = phase_frame(F0); unsigned char* const ws = F.ws;
    constexpr int HP = 1028;
    LAS float* msh = (LAS float*)F.lds; LAS float* msc = msh + 3072; LAS float* hrow = msc + 3072;
    LAS float* part = hrow + 16 * HP;
    LAS float* lgs = part + 8 * 16 * 48;
    LAS unsigned* lcnt = (LAS unsigned*)(lgs + 16 * 40);
    if (F0.tid < 64) lcnt[F0.tid] = 0u;
    __syncthreads();
    mod_to_lds(F, l, 3, msh, false); mod_to_lds(F, l, 4, msc, false); __syncthreads();
    const bf16* X = (const bf16*)(ws + WS_X); bf16* H = (bf16*)(ws + WS_H);
    const float* rgw = inptr(I_RGW) + (size_t)l * D * 4; const float* rew = inptr(I_REW) + (size_t)l * D * NEXP;
    const float* rgb = inptr(I_RGB) + l * 4; const float* reb = inptr(I_REB) + l * NEXP;
    int* rt_e = (int*)(ws + WS_ROUTE + RT_E); int* rt_pos = (int*)(ws + WS_ROUTE + RT_POS); float* rt_gate = (float*)(ws + WS_ROUTE + RT_GATE);
    unsigned* cnt = (unsigned*)(ws + WS_CTL) + CW_CNT + 64 * l + cnt_off;
    const int lane = F.lane, w = F.wave, fr = lane & 15, fq = lane >> 4; const float* n2g = inptr(I_N2G) + l * D;
    float bw[32][3];
#pragma unroll
    for (int ks = 0; ks < 32; ++ks) { const int k = 128 * w + 4 * ks + fq;
        bw[ks][0] = rew[(size_t)k * 32 + fr]; bw[ks][1] = rew[(size_t)k * 32 + 16 + fr]; bw[ks][2] = fr < 4 ? rgw[(size_t)k * 4 + fr] : 0.f; }
    const int ntiles = nrows >> 4;
    u32x2 pv[2][4];
    if (F.vcu < ntiles) {
#pragma unroll
        for (int rr = 0; rr < 2; ++rr)
#pragma unroll
            for (int j = 0; j < 4; ++j) pv[rr][j] = *(const u32x2*)(X + (size_t)(F.vcu * 16 + 2 * w + rr) * D + 4 * lane + 256 * j); }
    for (int gi = F.vcu; gi < ntiles; gi += F.G) {
#pragma unroll
        for (int rr = 0; rr < 2; ++rr) { const int r = 2 * w + rr, row = gi * 16 + r; f32x4 v[4];
#pragma unroll
            for (int j = 0; j < 4; ++j) { float t_[4]; unpack4(pv[rr][j], t_); v[j] = (f32x4){t_[0], t_[1], t_[2], t_[3]}; }
            const int mr = modrow(row);
            norm_mod_row(v, n2g, msc + mr * 1024, msh + mr * 1024, H + (size_t)row * D, lane);
#pragma unroll
            for (int j = 0; j < 4; ++j) *(LAS f32x4*)(hrow + r * HP + 4 * lane + 256 * j) = v[j]; }
        if (gi + F.G < ntiles) {
#pragma unroll
            for (int rr = 0; rr < 2; ++rr)
#pragma unroll
                for (int j = 0; j < 4; ++j) pv[rr][j] = *(const u32x2*)(X + (size_t)((gi + F.G) * 16 + 2 * w + rr) * D + 4 * lane + 256 * j); }
        __syncthreads();
        {   f32x4 acc[3] = {{0.f, 0.f, 0.f, 0.f}, {0.f, 0.f, 0.f, 0.f}, {0.f, 0.f, 0.f, 0.f}};
#pragma unroll
            for (int ks = 0; ks < 32; ++ks) { const float a = hrow[fr * HP + 128 * w + 4 * ks + fq];
#pragma unroll
                for (int nt = 0; nt < 3; ++nt) acc[nt] = __builtin_amdgcn_mfma_f32_16x16x4f32(a, bw[ks][nt], acc[nt], 0, 0, 0); }
#pragma unroll
            for (int nt = 0; nt < 3; ++nt)
#pragma unroll
                for (int reg = 0; reg < 4; ++reg) part[(w * 16 + 4 * fq + reg) * 48 + 16 * nt + fr] = acc[nt][reg]; }
        __syncthreads();
        for (int idx = F.tid; idx < 16 * 36; idx += NTHR) { const int r = idx / 36, n = idx % 36; float s_ = 0.f;
#pragma unroll
            for (int ww = 0; ww < 8; ++ww) s_ += part[(ww * 16 + r) * 48 + n];
            if (n < 32) lgs[r * 40 + 4 + n] = s_ + reb[n]; else lgs[r * 40 + n - 32] = s_ + rgb[n - 32]; }
        __syncthreads();
        if (F.tid < 16) { const int rr = gi * 16 + F.tid; const LAS float* lp = lgs + F.tid * 40;
            int grp = 0; float mx = lp[0];
#pragma unroll
            for (int g = 1; g < 4; ++g) if (lp[g] > mx) { mx = lp[g]; grp = g; }
            float den = 0.f;
#pragma unroll
            for (int g = 0; g < 4; ++g) den += __expf(lp[g] - mx);
            const float pg_top = 1.f / den; const LAS float* sel = lp + 4 + grp * 8;
            int i0 = 0; float l0 = sel[0];
#pragma unroll
            for (int q = 1; q < 8; ++q) if (sel[q] > l0) { l0 = sel[q]; i0 = q; }
            int i1 = -1; float l1 = -3.0e38f;
#pragma unroll
            for (int q = 0; q < 8; ++q) if (q != i0 && sel[q] > l1) { l1 = sel[q]; i1 = q; }
            const float e1 = __expf(l1 - l0); const float w0 = pg_top / (1.f + e1), w1 = pg_top * e1 / (1.f + e1);
            const int ea = grp * 8 + i0, eb = grp * 8 + i1;
            const unsigned pa = atomicAdd((unsigned*)(lcnt + ea), 1u), pb = atomicAdd((unsigned*)(lcnt + eb), 1u);
            rt_e[2 * rr] = ea; rt_e[2 * rr + 1] = eb; rt_pos[2 * rr] = (int)pa; rt_pos[2 * rr + 1] = (int)pb; rt_gate[2 * rr] = w0; rt_gate[2 * rr + 1] = w1; }
    }
    __syncthreads();
    if (F.tid < 32) lcnt[32 + F.tid] = lcnt[F.tid] ? atomicAdd(cnt + F.tid, lcnt[F.tid]) : 0u;
    __syncthreads();
    int* elist = (int*)(ws + WS_ELIST);
    if (F.tid < 16) for (int gi = F.vcu; gi < ntiles; gi += F.G) { const int rr = gi * 16 + F.tid;
        const int ea = rt_e[2 * rr], eb = rt_e[2 * rr + 1]; const int pa = rt_pos[2 * rr] + (int)lcnt[32 + ea], pb = rt_pos[2 * rr + 1] + (int)lcnt[32 + eb];
        rt_pos[2 * rr] = pa; rt_pos[2 * rr + 1] = pb; elist[(size_t)ea * NROW + pa] = rr; elist[(size_t)eb * NROW + pb] = rr; }
}

constexpr int MOE_MAP_OFF = 131072;
__device__ __forceinline__ void moe_map(const Frame& F0, int l) {
    const Frame F = phase_frame(F0); unsigned char* const ws = F.ws;
    LAS int* mp = (LAS int*)(F.lds + MOE_MAP_OFF);
    const unsigned* cnt = (const unsigned*)(ws + WS_CTL) + CW_CNT + 64 * l;
    __syncthreads();
    if (F.tid < NEXP) mp[32 + F.tid] = (int)__hip_atomic_load(cnt + F.tid, __ATOMIC_RELAXED, __HIP_MEMORY_SCOPE_AGENT);
    __syncthreads();
    if (F.tid == 0) { int o = 0;
#pragma nounroll
        for (int e = 0; e < NEXP; ++e) { const int c = mp[32 + e]; const int nt = (c + 255) >> 8; mp[e] = o;
#pragma nounroll
            for (int t = 0; t < nt; ++t) { mp[128 + (o >> 8) + t] = e; mp[320 + (o >> 8) + t] = t; }
            o += nt << 8; }
        mp[64] = o >> 8; }
    __syncthreads();
}

template <bool DRY>
__device__ __forceinline__ void combine_pass(const Frame& F0, int l, int nrows) {
    const Frame F = phase_frame(F0); unsigned char* const ws = F.ws;
    LAS float* mg2 = (LAS float*)F.lds; LAS float* msh = mg2 + 3072; LAS float* msc = msh + 3072;
    const bool last = (l == DEPTH - 1);
    __syncthreads();
    mod_to_lds(F, l, 5, mg2, false); if (!last) { mod_to_lds(F, l + 1, 0, msh, false); mod_to_lds(F, l + 1, 1, msc, false); }
    __syncthreads();
    bf16* X = (bf16*)(ws + WS_X); bf16* H = (bf16*)(ws + WS_H); const bf16* Ys = (const bf16*)(ws + WS_XS);
    const int* rt_e = (const int*)(ws + WS_ROUTE + RT_E); const int* rt_pos = (const int*)(ws + WS_ROUTE + RT_POS); const float* rt_gate = (const float*)(ws + WS_ROUTE + RT_GATE);
    const LAS int* moff = (const LAS int*)(F.lds + MOE_MAP_OFF);
    const int lane = F.lane; const float* n1g = inptr(I_N1G) + (last ? 0 : (l + 1) * D); const float* fgp = inptr(I_FG);
    for (int row0 = F.gw; row0 < nrows; row0 += 2 * F.NGW) {
        int s0[2], s1[2]; float w0[2], w1[2]; bool ok[2]; u32x2 ya[2][4], yb[2][4], xo[2][4];
#pragma unroll
        for (int u = 0; u < 2; ++u) { const int row = row0 + u * F.NGW; ok[u] = row < nrows; if (ok[u]) { s0[u] = moff[rt_e[2 * row]] + rt_pos[2 * row]; s1[u] = moff[rt_e[2 * row + 1]] + rt_pos[2 * row + 1]; w0[u] = rt_gate[2 * row]; w1[u] = rt_gate[2 * row + 1]; } }
#pragma unroll
        for (int u = 0; u < 2; ++u) if (ok[u]) { const int row = row0 + u * F.NGW;
#pragma unroll
            for (int j = 0; j < 4; ++j) { const int c = 4 * lane + 256 * j; ya[u][j] = *(const u32x2*)(Ys + (size_t)s0[u] * D + c); yb[u][j] = *(const u32x2*)(Ys + (size_t)s1[u] * D + c); xo[u][j] = *(const u32x2*)(X + (size_t)row * D + c); } }
#pragma unroll
        for (int u = 0; u < 2; ++u) if (ok[u]) { const int row = row0 + u * F.NGW; const int mr = modrow(row); f32x4 v[4];
#pragma unroll
            for (int j = 0; j < 4; ++j) { const int c = 4 * lane + 256 * j; float a[4], b[4]; unpack4(ya[u][j], a); unpack4(yb[u][j], b);
                const f32x4 g2 = *(const LAS f32x4*)(mg2 + mr * 1024 + c);
                f32x4 y; y.x = w0[u] * a[0] + w1[u] * b[0]; y.y = w0[u] * a[1] + w1[u] * b[1]; y.z = w0[u] * a[2] + w1[u] * b[2]; y.w = w0[u] * a[3] + w1[u] * b[3];
                float x_[4]; unpack4(xo[u][j], x_); v[j] = (f32x4){x_[0], x_[1], x_[2], x_[3]} + g2 * y; }
            if (DRY) { asm volatile("" :: "v"(v[0].x + v[1].y + v[2].z + v[3].w)); }
            else if (!last) {
#pragma unroll
                for (int j = 0; j < 4; ++j) *(u32x2*)(X + (size_t)row * D + 4 * lane + 256 * j) = (u32x2){pk2(v[j].x, v[j].y), pk2(v[j].z, v[j].w)};
                norm_mod_row(v, n1g, msc + mr * 1024, msh + mr * 1024, H + (size_t)row * D, lane);
            } else { float s = 0.f;
#pragma unroll
                for (int j = 0; j < 4; ++j) s += (v[j].x * v[j].x + v[j].y * v[j].y) + (v[j].z * v[j].z + v[j].w * v[j].w);
                const float rs = rsqrtf(wave_sum(s) * (1.f / D) + RMS_EPS);
#pragma unroll
                for (int j = 0; j < 4; ++j) { const int c = 4 * lane + 256 * j; const f32x4 g = *(const f32x4*)(fgp + c); *(f32x4*)(F.out + (size_t)row * D + c) = v[j] * rs * g; } } }
    }
}
__global__ void __launch_bounds__(NTHR, 2) fwd_megakernel(Params prm) {
    extern __shared__ __attribute__((aligned(16))) unsigned char lds_raw[];
    Frame F;
    F.lds = (LAS unsigned char*)lds_raw;
    F.tid = threadIdx.x; F.lane = F.tid & 63; F.wave = __builtin_amdgcn_readfirstlane(F.tid >> 6);
    F.G = gridDim.x; { const int bx = blockIdx.x; F.vcu = (F.G % 8 == 0) ? (bx % 8) * (F.G / 8) + bx / 8 : bx; }
    F.gw = F.vcu * NWAVES + F.wave; F.NGW = F.G * NWAVES;
    F.out = prm.out; F.ws = prm.ws;
    for (int u = F.tid; u < (LDS_BYTES - LDSCTL_OFF) / 4; u += NTHR) ((LAS unsigned*)(F.lds + LDSCTL_OFF))[u] = 0u;
    __syncthreads();
    (void)xcd_barrier_post((unsigned*)(F.ws + WS_CTL) + CW_BAR, (volatile LAS unsigned*)(F.lds + MISC_OFF) + 8);
#define GRID_BAR() do { XcdBarrier bar_; bar_.bar = (unsigned*)(opaque(F.ws) + WS_CTL) + CW_BAR; bar_.x = xb_xcc_id(); bar_.st = (volatile LAS unsigned*)(F.lds + MISC_OFF) + 8; xcd_barrier(bar_); } while (0)

    p0_prologue(F);
#if USE_CG_SYNC
    cg::this_grid().sync();
#else
    GRID_BAR();
#endif
    p0b_norm1(F);
    GRID_BAR();

    for (int l = 0; l < DEPTH; ++l) {
        const bool need_ctx = (l == 0); const int nrows = need_ctx ? NROW : NLAT;
#define WSO Fp.ws
        {
            const Frame Fp = phase_frame(F); unsigned char* const ws = WSO; bf16* Hb = (bf16*)(ws + WS_H); bf16* Pb = (bf16*)(ws + WS_P);
            pg8::Gemm g{Hb, (const bf16*)(ws + WS_WIN_T) + (size_t)l * NP * D, NROW, NP, D}; pg8::StaticOrder S; S.init(NROW, NP, Fp.G, (int)blockIdx.x);
            pg8::EpiStoreBf16 E{Pb, NP, 0xffff};
            pg8::gemm_phase<pg8::EpiStoreBf16, pg8::StaticOrder, true, true>(F.lds, g, S, E);
        }
        GRID_BAR();
        {
            const Frame Fp = phase_frame(F); unsigned char* const ws = WSO; bf16* Pb = (bf16*)(ws + WS_P);
            for (int it = blockIdx.x; it < 256; it += F.G) fftA_item(F, it);
            if (need_ctx) for (int it = (int)blockIdx.x - (F.G >= 64 ? F.G - 32 : 0); it >= 0 && it < 32; it += F.G) { const int b = it >> 4, m0 = (it & 15) * 16;
                const bf16* src0 = Pb + (size_t)(NLAT + b * CTXL) * NP + COL_FC;
                dft64_item<4, 256, 1>(F, l, m0, -1.f, 1.f / 128.f, [=](int t, int ri) { return src0 + (size_t)t * NP + ri * 256; }, [=](int m) { return NLAT + b * CTXL + m; }); }
            shift_pass(F, l);
            conv_pass(F, l, nrows);
        }
        GRID_BAR();
        {
            const Frame Fp = phase_frame(F); unsigned char* const ws = WSO;
            prep_phase(F, l);
        }
        GRID_BAR();
        for (int seg = -1; seg < NSEG; ++seg) {
            const bool split = (F.G == 256);
            if (seg + 1 < NSEG) pre_phase(F, seg + 1, (seg >= 0 && split) ? 128 : 0);
            if (seg + 1 == NSEG && (!split || blockIdx.x >= 128)) { unsigned char* const ws = opaque(F.ws); int bx_ = (int)blockIdx.x; asm volatile("" : "+s"(bx_));
                const int first_ = split ? bx_ - 128 : bx_, stride_ = split ? 128 : F.G;
                for (int it = first_; it < 256; it += stride_) { const int b = it >> 7, t1p = it & 127;
                    const bf16* src0 = (const bf16*)(ws + WS_GT) + (size_t)(b * 128 + t1p) * 64 * 512;
                    dft64_item<1, 64, 4>(F, l, 0, 1.f, 0.0013810679320049757f, [=](int t, int ri) { return src0 + (size_t)t * 512 + ri * 256; }, [=](int m) { return b * SEQ + t1p + 128 * m; }); } }
            if (seg >= 0) for (int it = blockIdx.x; it < 128; it += F.G) { const int x_ = it & 7, j_ = it >> 3;
                seq_item<0>(F, ((x_ + 8 * (j_ >> 2)) << 2) | (j_ & 3), seg, need_ctx); }
            GRID_BAR();
        }
        readout_pass(F, l, nrows);
        GRID_BAR();
        const int cv_lo = (nrows / 256) * 4 > F.G ? (nrows / 256) * 4 - F.G : 0;
        if (blockIdx.x & 1) expert_convert(F, l, cv_lo);
        {
            const Frame Fp = phase_frame(F); unsigned char* const ws = WSO; bf16* Hb = (bf16*)(ws + WS_H);
            pg8::Gemm g{Hb, (const bf16*)(ws + WS_WOUT_T) + (size_t)l * D * D, nrows, D, D}; pg8::StaticOrder S; S.init(nrows, D, Fp.G, (int)blockIdx.x);
            bf16* X = (bf16*)(ws + WS_X); const float* g1p = (const float*)(ws + WS_MODF) + (size_t)l * 3 * 6144 + 2 * 1024;
            if (l == 0) { pg8::EpiResidual<true> E{inptr(I_X), inptr(I_CTX), X, g1p}; pg8::gemm_phase<pg8::EpiResidual<true>, pg8::StaticOrder, true, true>(F.lds, g, S, E); }
            else { pg8::EpiResidual<false> E{X, X + (size_t)NLAT * D, X, g1p}; pg8::gemm_phase<pg8::EpiResidual<false>, pg8::StaticOrder, true, true>(F.lds, g, S, E); }
        }
        if (!(blockIdx.x & 1)) expert_convert(F, l, cv_lo);
        GRID_BAR();
        router_pass(F, l, nrows);
        GRID_BAR();
        {
            const Frame Fp = phase_frame(F); unsigned char* const ws = WSO;
            moe_map(F, l);
            const LAS int* mp = (const LAS int*)(F.lds + MOE_MAP_OFF);
            pg8::MoeOrder S{mp + 128, mp + 320, mp[64], Fp.G, (int)blockIdx.x};
            {   pg8::Gemm g{(const bf16*)(ws + WS_H), (const bf16*)(ws + WS_WGU_T), 0, 0, D, (const int*)(ws + WS_ELIST), NROW - 1};
                pg8::EpiSwiGLU E{(bf16*)(ws + WS_ACT)};
                pg8::gemm_phase<pg8::EpiSwiGLU, pg8::MoeOrder, true, true, true>(F.lds, g, S, E); }
            GRID_BAR();
            {   pg8::Gemm g{(const bf16*)(ws + WS_ACT), (const bf16*)(ws + WS_WD_T), 0, 0, DEXP};
                pg8::EpiStoreBf16 E{(bf16*)(ws + WS_XS), D, 3};
                pg8::gemm_phase<pg8::EpiStoreBf16, pg8::MoeOrder, true, true>(F.lds, g, S, E); }
        }
        GRID_BAR();
        combine_pass<false>(F, l, nrows);
        if (l + 1 < DEPTH) GRID_BAR();
    }
}

extern "C" void kernel_launch(void* const* d_in, const int* in_sizes, int n_in, void* d_out, int out_size, void* d_ws, size_t ws_size, hipStream_t stream) {
    static int grid = 0;
    if (grid == 0) {
        if (n_in != N_IN || in_sizes[0] != NLAT * D || out_size != NLAT * D || ws_size < WS_END) {
            fprintf(stderr, "kernel_launch: unexpected shapes (n_in %d in0 %d out %d ws %zu)\n", n_in, n_in > 0 ? in_sizes[0] : -1, out_size, ws_size); grid = -1; return; }
        int dev = 0, cus = 0, per_cu = 0;
        hipGetDevice(&dev); hipDeviceGetAttribute(&cus, hipDeviceAttributeMultiprocessorCount, dev);
        hipFuncSetAttribute((const void*)fwd_megakernel, hipFuncAttributeMaxDynamicSharedMemorySize, LDS_BYTES);
        hipOccupancyMaxActiveBlocksPerMultiprocessor(&per_cu, (const void*)fwd_megakernel, NTHR, LDS_BYTES);
        if (per_cu < 1) { fprintf(stderr, "kernel_launch: occupancy query says %d blocks per CU\n", per_cu); per_cu = 1; }
        (void)hipGetLastError();
        grid = cus * per_cu;
    }
    if (grid < 0) return;
    hipMemsetAsync((char*)d_ws + WS_CTL, 0, CTL_ZERO_BYTES, stream);
    Params p{};
    for (int i = 0; i < N_IN; ++i) p.in[i] = (const float*)d_in[i];
    p.out = (float*)d_out; p.ws = (unsigned char*)d_ws;
    void* args[] = {&p};
    hipError_t e = hipLaunchCooperativeKernel((const void*)fwd_megakernel, dim3(grid), dim3(NTHR), args, LDS_BYTES, stream);
    if (e != hipSuccess) fprintf(stderr, "kernel_launch: cooperative launch failed: %s (grid %d)\n", hipGetErrorString(e), grid);
}
```

```cpp
#include <hip/hip_runtime.h>
#include <hip/hip_cooperative_groups.h>
#include <cstdio>
#include <cstdint>
namespace cg = cooperative_groups;
#define USE_CG_SYNC 0
#define SEQ_PROBE 0
#define SEQ_PROBE_PRE 0
namespace pg8 {
#define PG8_LAS __attribute__((address_space(3)))
typedef unsigned short bf16_t;
typedef short bf16x8 __attribute__((ext_vector_type(8)));
typedef float f32x4 __attribute__((ext_vector_type(4)));
typedef unsigned u32x4 __attribute__((ext_vector_type(4)));
constexpr int BM = 256, BK = 64, HALF = 128, HTB = HALF * BK * 2  , STAGE_BYTES = 8 * HTB, NXCD = 8, WGM = 8;

__host__ __device__ __forceinline__ int lds_byte(int r, int c) { const int st = (r >> 4) * 2 + (c >> 5), rr = r & 15, cc = c & 31, ob = rr * 64 + cc * 2; return st * 1024 + (ob ^ (((ob >> 9) & 1) << 5)); }
__host__ __device__ __forceinline__ void stage_rc(int b, int& R, int& C) { const int st = b / 1024, sb = b % 1024, swz = sb ^ (((sb >> 9) & 1) << 5); R = (st >> 1) * 16 + swz / 64; C = (st & 1) * 32 + (swz % 64) / 2; }
__host__ __device__ __forceinline__ int perm32(int rho) { const int n = rho >> 4, i = rho & 15; return 8 * (i >> 2) + 4 * n + (i & 3); }

struct Unit { int pm, pn, ga; };
struct Gemm { const bf16_t* A; const bf16_t* Bt; int M, N, K; const int* gidx; int gmax; };

struct StaticOrder {
    int nM, nN, nwg, G, c;
    __host__ __device__ void init(int M, int N, int G_, int c_) { nM = M / BM; nN = N / BM; nwg = nM * nN; G = G_; c = c_; }
    __host__ __device__ bool next(int i, Unit& u) const {
        const long L = (long)i * G + c; if (L >= nwg) return false;
        int wgid = (int)L; { const int q = nwg / NXCD, r = nwg % NXCD, xcd = wgid % NXCD, off = wgid / NXCD; wgid = (xcd < r ? xcd * (q + 1) : r * (q + 1) + (xcd - r) * q) + off; }
        const int nig = WGM * nN, gid = wgid / nig, fm = gid * WGM, gsz = (nM - fm) < WGM ? (nM - fm) : WGM;
        u.pm = fm + ((wgid % nig) % gsz); u.pn = (wgid % nig) / gsz; return true;
    }
    __device__ __forceinline__ void a_ready(const Unit&) const {}
    __device__ __forceinline__ void done(const Unit&) const {}
};

__device__ __forceinline__ unsigned cvt_pk_bf16(float lo, float hi) { unsigned r; asm volatile("v_cvt_pk_bf16_f32 %0, %1, %2" : "=v"(r) : "v"(lo), "v"(hi)); return r; }
typedef float f32x2 __attribute__((ext_vector_type(2)));
template <class Epi, class Sched, bool ALIGN_EPI = false, bool SP2 = false, bool GATHER = false>
__device__ __forceinline__ void gemm_phase(PG8_LAS unsigned char* lds, const Gemm g, const Sched& S, const Epi& E) {
    int tid = threadIdx.x; asm volatile("" : "+v"(tid));
    const int wid = __builtin_amdgcn_readfirstlane(tid >> 6), lane = tid & 63, wr = wid >> 2, wc = wid & 3, fr = lane & 15, fq = lane >> 4;
    const int K = g.K, nt = K / BK;
    unsigned voffA[2], voffB[2];
#pragma unroll
    for (int i = 0; i < 2; ++i) { int R, C; stage_rc(tid * 16 + i * 8192, R, C); const int Rb = Epi::PERM ? ((R & ~31) + perm32(R & 31)) : R;
        voffA[i] = (unsigned)(R * K + C) * 2u; voffB[i] = (unsigned)(Rb * K + C) * 2u; }
    static_assert(!GATHER || SP2, "GATHER is implemented for the SP2 loop");
    unsigned gcur[2][2], gnx[2][2];
#define PG8_GOFF(go, u_) do { _Pragma("unroll") for (int h_ = 0; h_ < 2; ++h_) _Pragma("unroll") for (int i_ = 0; i_ < 2; ++i_) { int R_, C_; stage_rc(tid * 16 + i_ * 8192, R_, C_); \
        int ri_ = g.gidx[(u_).ga + h_ * HALF + R_]; ri_ = ri_ < 0 ? 0 : (ri_ > g.gmax ? g.gmax : ri_); go[h_][i_] = (unsigned)ri_ * (unsigned)(K * 2) + (unsigned)C_ * 2u; } } while (0)
    const size_t kstep = (size_t)(BK * 2);
    const size_t hstep = (size_t)HALF * K * 2;
    const size_t tstep = 2 * hstep;
    const unsigned ldsw = (unsigned)wid * 1024u;
    const int aoff = lds_byte(wr * 64 + fr, fq * 8), boff = lds_byte(wc * 32 + fr, fq * 8);
#define PG8_SA(b, h) (((b) * 2 + (h)) * HTB)
#define PG8_SB(b, h) ((4 + (b) * 2 + (h)) * HTB)
#define PG8_STAGE(bufoff, gbase, voff) do { _Pragma("unroll") for (int _i = 0; _i < 2; ++_i) \
        __builtin_amdgcn_global_load_lds((const unsigned*)((const char*)(gbase) + (voff)[_i]), (PG8_LAS unsigned*)(lds + (bufoff) + ldsw + _i * 8192), 16, 0, 0); } while (0)
#define PG8_LDA(dst, b, h) do { _Pragma("unroll") for (int m = 0; m < 4; ++m) _Pragma("unroll") for (int k = 0; k < 2; ++k) dst[m][k] = *(const PG8_LAS bf16x8*)(lds + PG8_SA(b, h) + aoff + m * 2048 + k * 1024); } while (0)
#define PG8_LDB(dst, b, h) do { _Pragma("unroll") for (int n = 0; n < 2; ++n) _Pragma("unroll") for (int k = 0; k < 2; ++k) dst[n][k] = *(const PG8_LAS bf16x8*)(lds + PG8_SB(b, h) + boff + n * 2048 + k * 1024); } while (0)
#define PG8_MMA(ai, bj, At, Bt) do { __builtin_amdgcn_s_setprio(1); _Pragma("unroll") for (int m = 0; m < 4; ++m) _Pragma("unroll") for (int n = 0; n < 2; ++n) _Pragma("unroll") for (int k = 0; k < 2; ++k) \
        acc[ai][bj][m][n] = __builtin_amdgcn_mfma_f32_16x16x32_bf16(Bt[n][k], At[m][k], acc[ai][bj][m][n], 0, 0, 0); __builtin_amdgcn_s_setprio(0); } while (0)
#define PG8_WAIT_V(n) asm volatile("s_waitcnt vmcnt(" #n ")" ::: "memory")
#define PG8_WAIT_L(n) asm volatile("s_waitcnt lgkmcnt(" #n ")" ::: "memory")
#define PG8_BAR __builtin_amdgcn_s_barrier()
#define PG8_SCHED __builtin_amdgcn_sched_barrier(0)
    Unit cur, nxt; int ui = 0;
    if (!S.next(0, cur)) return;
    f32x4 acc[2][2][4][2];
#pragma unroll
    for (int a = 0; a < 2; ++a)
#pragma unroll
        for (int b = 0; b < 2; ++b)
#pragma unroll
            for (int m = 0; m < 4; ++m)
#pragma unroll
                for (int n = 0; n < 2; ++n) acc[a][b][m][n] = (f32x4){0.f, 0.f, 0.f, 0.f};
    bf16x8 At[4][2], B0[2][2], B1[2][2];
    const char* cA = (const char*)g.A + (size_t)cur.pm * tstep; const char* cB = (const char*)g.Bt + (size_t)cur.pn * tstep;
    S.a_ready(cur);
    const char* gA = (const char*)g.A;
    if constexpr (GATHER) PG8_GOFF(gcur, cur);
    if constexpr (SP2) {
        PG8_STAGE(PG8_SB(0, 0), cB, voffB); PG8_STAGE(PG8_SB(0, 1), cB + hstep, voffB);
        if constexpr (GATHER) { PG8_STAGE(PG8_SA(0, 0), gA, gcur[0]); PG8_STAGE(PG8_SA(0, 1), gA, gcur[1]); } else { PG8_STAGE(PG8_SA(0, 0), cA, voffA); PG8_STAGE(PG8_SA(0, 1), cA + hstep, voffA); }
        if (wr == 1) PG8_BAR;
        PG8_WAIT_V(2); PG8_BAR;
        PG8_STAGE(PG8_SB(1, 0), cB + kstep, voffB); if constexpr (GATHER) PG8_STAGE(PG8_SA(1, 0), gA + kstep, gcur[0]); else PG8_STAGE(PG8_SA(1, 0), cA + kstep, voffA); PG8_STAGE(PG8_SB(1, 1), cB + hstep + kstep, voffB);
        PG8_WAIT_V(6); PG8_BAR;
    } else {
        PG8_STAGE(PG8_SB(0, 0), cB, voffB); PG8_STAGE(PG8_SA(0, 0), cA, voffA); PG8_STAGE(PG8_SB(0, 1), cB + hstep, voffB); PG8_STAGE(PG8_SA(0, 1), cA + hstep, voffA);
        if (wr == 1) PG8_BAR;
        PG8_WAIT_V(4); PG8_BAR;
        PG8_STAGE(PG8_SB(1, 0), cB + kstep, voffB); PG8_STAGE(PG8_SA(1, 0), cA + kstep, voffA); PG8_STAGE(PG8_SB(1, 1), cB + hstep + kstep, voffB);
        PG8_WAIT_V(6); PG8_BAR;
    }
    for (;;) {
        const bool has_next = S.next(ui + 1, nxt);
        if constexpr (GATHER) { if (has_next) PG8_GOFF(gnx, nxt); else { gnx[0][0] = gcur[0][0]; gnx[0][1] = gcur[0][1]; gnx[1][0] = gcur[1][0]; gnx[1][1] = gcur[1][1]; } }
        const char* nA = has_next ? (const char*)g.A + (size_t)nxt.pm * tstep : cA; const char* nB = has_next ? (const char*)g.Bt + (size_t)nxt.pn * tstep : cB;
        for (int t = 0; t < nt; t += 2) {
            const bool last = (t == nt - 2);
            const char* a1 = cA + (size_t)(t + 1) * kstep;
            const char* a2 = last ? nA : cA + (size_t)(t + 2) * kstep; const char* b2 = last ? nB : cB + (size_t)(t + 2) * kstep;
            const char* a3 = a2 + kstep; const char* b3 = b2 + kstep;
            if (last && has_next) S.a_ready(nxt);
            unsigned ga0[2], ga1[2]; const char* g1 = gA; const char* g2 = gA; const char* g3 = gA;
            if constexpr (GATHER) { g1 = gA + (size_t)(t + 1) * kstep; g2 = last ? gA : gA + (size_t)(t + 2) * kstep; g3 = g2 + kstep;
                ga0[0] = last ? gnx[0][0] : gcur[0][0]; ga0[1] = last ? gnx[0][1] : gcur[0][1]; ga1[0] = last ? gnx[1][0] : gcur[1][0]; ga1[1] = last ? gnx[1][1] : gcur[1][1]; }
            if constexpr (SP2) {
            PG8_LDB(B0, 0, 0); PG8_LDB(B1, 0, 1); PG8_SCHED; PG8_LDA(At, 0, 0); if constexpr (GATHER) PG8_STAGE(PG8_SA(1, 1), g1, gcur[1]); else PG8_STAGE(PG8_SA(1, 1), a1 + hstep, voffA);
            PG8_WAIT_V(8); PG8_WAIT_L(0); PG8_BAR; PG8_MMA(0, 0, At, B0); PG8_MMA(0, 1, At, B1); PG8_BAR; PG8_SCHED;
            PG8_LDA(At, 0, 1); PG8_STAGE(PG8_SB(0, 0), b2, voffB); PG8_STAGE(PG8_SB(0, 1), b2 + hstep, voffB); if constexpr (GATHER) PG8_STAGE(PG8_SA(0, 0), g2, ga0); else PG8_STAGE(PG8_SA(0, 0), a2, voffA);
            PG8_WAIT_V(8); PG8_WAIT_L(0); PG8_BAR; PG8_MMA(1, 0, At, B0); PG8_MMA(1, 1, At, B1); PG8_BAR; PG8_SCHED;
            PG8_LDB(B0, 1, 0); PG8_LDB(B1, 1, 1); PG8_SCHED; PG8_LDA(At, 1, 0); if constexpr (GATHER) PG8_STAGE(PG8_SA(0, 1), g2, ga1); else PG8_STAGE(PG8_SA(0, 1), a2 + hstep, voffA);
            PG8_WAIT_V(8); PG8_WAIT_L(0); PG8_BAR; PG8_MMA(0, 0, At, B0); PG8_MMA(0, 1, At, B1); PG8_BAR; PG8_SCHED;
            PG8_LDA(At, 1, 1); PG8_STAGE(PG8_SB(1, 0), b3, voffB); PG8_STAGE(PG8_SB(1, 1), b3 + hstep, voffB); if constexpr (GATHER) PG8_STAGE(PG8_SA(1, 0), g3, ga0); else PG8_STAGE(PG8_SA(1, 0), a3, voffA);
            PG8_WAIT_V(8); PG8_WAIT_L(0); PG8_BAR; PG8_MMA(1, 0, At, B0); PG8_MMA(1, 1, At, B1); PG8_BAR; PG8_SCHED;
            } else {
            PG8_LDB(B0, 0, 0); PG8_SCHED; PG8_LDA(At, 0, 0); PG8_STAGE(PG8_SA(1, 1), a1 + hstep, voffA);
            PG8_WAIT_L(8); PG8_BAR; PG8_WAIT_L(0); PG8_MMA(0, 0, At, B0); PG8_BAR; PG8_SCHED;
            PG8_LDB(B1, 0, 1); PG8_STAGE(PG8_SB(0, 0), b2, voffB);
            PG8_BAR; PG8_WAIT_L(0); PG8_MMA(0, 1, At, B1); PG8_BAR;
            PG8_LDA(At, 0, 1); PG8_STAGE(PG8_SA(0, 0), a2, voffA);
            PG8_BAR; PG8_WAIT_L(0); PG8_MMA(1, 0, At, B0); PG8_BAR; PG8_SCHED;
            PG8_STAGE(PG8_SB(0, 1), b2 + hstep, voffB);
            PG8_WAIT_V(6); PG8_BAR; PG8_MMA(1, 1, At, B1); PG8_BAR;
            PG8_LDB(B0, 1, 0); PG8_SCHED; PG8_LDA(At, 1, 0); PG8_STAGE(PG8_SA(0, 1), a2 + hstep, voffA);
            PG8_WAIT_L(8); PG8_BAR; PG8_WAIT_L(0); PG8_MMA(0, 0, At, B0); PG8_BAR; PG8_SCHED;
            PG8_LDB(B1, 1, 1); PG8_STAGE(PG8_SB(1, 0), b3, voffB);
            PG8_BAR; PG8_WAIT_L(0); PG8_MMA(0, 1, At, B1); PG8_BAR;
            PG8_LDA(At, 1, 1); PG8_STAGE(PG8_SA(1, 0), a3, voffA);
            PG8_BAR; PG8_WAIT_L(0); PG8_MMA(1, 0, At, B0); PG8_BAR; PG8_SCHED;
            PG8_STAGE(PG8_SB(1, 1), b3 + hstep, voffB);
            PG8_WAIT_V(6); PG8_BAR; PG8_MMA(1, 1, At, B1); PG8_BAR;
            }
        }
        if constexpr (ALIGN_EPI) { if (wr == 0) PG8_BAR; }
        if constexpr (!Epi::AFTER_DRAIN) { E(acc, cur, wr, wc, fr, fq); S.done(cur); }
        if (!has_next) break;
#pragma unroll
        for (int a = 0; a < 2; ++a)
#pragma unroll
            for (int b = 0; b < 2; ++b)
#pragma unroll
                for (int m = 0; m < 4; ++m)
#pragma unroll
                    for (int n = 0; n < 2; ++n) acc[a][b][m][n] = (f32x4){0.f, 0.f, 0.f, 0.f};
        cur = nxt; cA = nA; cB = nB; ++ui;
        if constexpr (GATHER) { gcur[0][0] = gnx[0][0]; gcur[0][1] = gnx[0][1]; gcur[1][0] = gnx[1][0]; gcur[1][1] = gnx[1][1]; }
        if constexpr (ALIGN_EPI) { if (wr == 1) PG8_BAR; }
    }
    PG8_WAIT_V(0);
    if constexpr (!ALIGN_EPI) { if (wr == 0) PG8_BAR; }
    PG8_BAR;
    if constexpr (Epi::AFTER_DRAIN) { E.fused(acc, cur, wr, wc, fr, fq, lds, wid, lane); S.done(cur); }
#undef PG8_GOFF
#undef PG8_SA
#undef PG8_SB
#undef PG8_STAGE
#undef PG8_LDA
#undef PG8_LDB
#undef PG8_MMA
#undef PG8_WAIT_V
#undef PG8_WAIT_L
#undef PG8_BAR
#undef PG8_SCHED
}
}
#define LAS __attribute__((address_space(3)))
typedef unsigned short bf16;
typedef float f32x4 __attribute__((ext_vector_type(4)));
typedef short bf16x8 __attribute__((ext_vector_type(8)));
typedef unsigned u32x4 __attribute__((ext_vector_type(4)));
typedef unsigned u32x2 __attribute__((ext_vector_type(2)));

constexpr int D = 1024, NBATCH = 2, SEQ = 8192, CTXL = 256, DEPTH = 2;
constexpr int NLAT = NBATCH * SEQ, NCTX = NBATCH * CTXL, NROW = NLAT + NCTX;
constexpr int DR = 512, DIN = 2944, NP = 3328, ZW = 1920, NHEAD = 8;
constexpr int COL_CONV = 1920, COL_FC = 2688, COL_FS = 2944;
constexpr int STRW = 5120;
constexpr int NEXP = 32, DEXP = 512;
constexpr int MOE_MAXTILES = 168;
constexpr float RMS_EPS = 1e-6f, GN_EPS = 64e-5f;

enum { I_X = 0, I_C, I_CTX, I_CCTX, I_ADAW, I_ADAB, I_N1G, I_N2G, I_WIN, I_MU, I_DW0, I_DW2, I_IA0, I_IA2, I_GG2, I_KK, I_KA, I_RK, I_GNW, I_GNB,
       I_CONVW, I_CONVG, I_FOURG, I_WOUT, I_RGW, I_RGB, I_REW, I_REB, I_EG, I_EU, I_ED, I_FG, N_IN };

constexpr size_t MiB = 1u << 20;
constexpr size_t WS_CTL = 0, CTL_ZERO_BYTES = 64 * 1024;
constexpr size_t WS_MODP = 1 * MiB;
constexpr size_t WS_MODF = 1 * MiB + 1280 * 1024;
constexpr size_t WS_WIN_T = 3 * MiB;
constexpr size_t WS_WOUT_T = 16 * MiB;
constexpr size_t WS_WGU_T = 20 * MiB;
constexpr size_t WS_WD_T = 84 * MiB;
constexpr size_t WS_X = 116 * MiB;
constexpr size_t WS_H = 182 * MiB;
constexpr size_t WS_ZS = 215 * MiB;
constexpr size_t WS_P = 277 * MiB;
constexpr size_t WS_STR = 277 * MiB;
constexpr size_t WS_Y = 442 * MiB;
constexpr size_t WS_GT = 475 * MiB;
constexpr size_t WS_ROUTE = 491 * MiB;
constexpr size_t WS_XS = 215 * MiB;
constexpr size_t WS_ACT = 299 * MiB;
constexpr size_t WS_ELIST = 340 * MiB;
constexpr size_t WS_END = 530 * MiB;
constexpr size_t RT_E = 0, RT_POS = 1 * 33792 * 4, RT_GATE = 2 * 33792 * 4, RT_SLOT = 3 * 33792 * 4, RT_TILE = 4 * 33792 * 4, RT_NT = RT_TILE + 1024;

constexpr int CW_BAR = 4096;
constexpr int CW_CNT = 8192;

constexpr int NWAVES = 8, NTHR = 512;
constexpr int RING_BYTES = 131072, LDSCTL_OFF = 143360, MISC_OFF = LDSCTL_OFF + 320, LDS_BYTES = 147456;

struct Params { const float* in[N_IN]; float* out; unsigned char* ws; };

__device__ __forceinline__ float bf2f(unsigned h) { return __uint_as_float(h << 16); }
typedef __bf16 hwbf2 __attribute__((ext_vector_type(2)));
typedef float f32x2 __attribute__((ext_vector_type(2)));
__device__ __forceinline__ unsigned pk2(float lo, float hi) { const f32x2 x = {lo, hi}; const hwbf2 r = __builtin_convertvector(x, hwbf2); return __builtin_bit_cast(unsigned, r); }
__device__ __forceinline__ unsigned f2bf(float f) { return pk2(f, 0.f) & 0xffffu; }
__device__ __forceinline__ float wave_sum(float v) {
#pragma unroll
    for (int o = 1; o < 64; o <<= 1) v += __shfl_xor(v, o);
    return v;
}
__device__ __forceinline__ float sigmoidf_(float x) { return 1.f / (1.f + __expf(-x)); }
#define LDS_WAIT() asm volatile("s_waitcnt lgkmcnt(0)" ::: "memory")
#define VM_WAIT() asm volatile("s_waitcnt vmcnt(0)" ::: "memory")

struct Frame {
    LAS unsigned char* lds;
    int tid, lane, wave, vcu, G, gw, NGW;
    float* out; unsigned char* ws;
};
#if defined(__HIP_DEVICE_COMPILE__)
#define ASSUME_GLOBAL(p) do { __builtin_assume(!__builtin_amdgcn_is_shared(p)); __builtin_assume(!__builtin_amdgcn_is_private(p)); } while (0)
#else
#define ASSUME_GLOBAL(p) do { } while (0)
#endif
__device__ __forceinline__ const float* inptr(int i) {
    const volatile unsigned long long __attribute__((address_space(4)))* ka = (const volatile unsigned long long __attribute__((address_space(4)))*)__builtin_amdgcn_kernarg_segment_ptr();
    return (const float*)(const __attribute__((address_space(1))) float*)ka[i];
}
__device__ __forceinline__ unsigned char* opaque(unsigned char* p) { unsigned long z = 0; asm volatile("" : "+s"(z)); return p + z; }
__device__ __forceinline__ Frame phase_frame(const Frame& F0) { Frame F = F0; asm volatile("" : "+v"(F.tid)); F.lane = F.tid & 63; F.ws = opaque(F0.ws);
    asm volatile("" : "+s"(F.G), "+s"(F.vcu)); F.gw = F.vcu * NWAVES + F.wave; F.NGW = F.G * NWAVES; return F; }
__device__ __forceinline__ int modrow(int row) { return row < NLAT ? (row >> 13) : 2; }
#define XB_TMO      128
#define XB_XCNT(j)  (256  + 64 * (j))
#define XB_XSUB(j)  (1280 + 64 * (j))
#define XB_XGEN(j)  (2304 + 64 * (j))
#define XB_TOP      3328
#define XB_TOPGEN   3392
#define XCD_BAR_WORDS 3456
#define XB_SPIN_CAP (1u << 18)

__device__ __forceinline__ unsigned xb_ld(unsigned* p)              { return __hip_atomic_load(p, __ATOMIC_RELAXED, __HIP_MEMORY_SCOPE_AGENT); }
__device__ __forceinline__ unsigned xb_add(unsigned* p, unsigned v) { return __hip_atomic_fetch_add(p, v, __ATOMIC_RELAXED, __HIP_MEMORY_SCOPE_AGENT); }
__device__ __forceinline__ unsigned xb_xcc_id() { return (unsigned)__builtin_amdgcn_s_getreg((3 << 11) | 20) & 0xFu; }
#define XB_SPIN(cond, bar) do { unsigned _sp = 0; while (cond) { __builtin_amdgcn_s_sleep(1); \
    if ((++_sp & 255u) == 0u) { if (xb_ld(&(bar)[XB_TMO])) break; if (_sp > XB_SPIN_CAP) { atomicAdd(&(bar)[XB_TMO], 1u); break; } } } } while (0)

struct XcdBarrier {
    unsigned* bar; unsigned x;
    volatile LAS unsigned* st;
};

__device__ __forceinline__ XcdBarrier xcd_barrier_post(unsigned* bar, volatile LAS unsigned* st) {
    XcdBarrier b; b.bar = bar; b.x = xb_xcc_id(); b.st = st;
    if (threadIdx.x == 0) (void)xb_add(&bar[XB_XCNT(b.x)], 1u);
    return b;
}
__device__ __forceinline__ void xcd_barrier_complete(unsigned* bar, unsigned x, unsigned& nloc, unsigned& nx) {
    const unsigned G = gridDim.x * gridDim.y * gridDim.z;
    unsigned sum, cnt, mine, sp = 0u;
    for (;;) {
        sum = 0u; cnt = 0u; mine = 0u;
#pragma nounroll
        for (unsigned j = 0; j < 16; ++j) { const unsigned c = xb_ld(&bar[XB_XCNT(j)]); sum += c; cnt += (c > 0u) ? 1u : 0u; mine = (j == x) ? c : mine; }
        if (sum == G) break;
        __builtin_amdgcn_s_sleep(1);
        if ((++sp & 255u) == 0u) { if (xb_ld(&bar[XB_TMO])) break; if (sp > XB_SPIN_CAP) { atomicAdd(&bar[XB_TMO], 1u); break; } }
    }
    nloc = mine > 0u ? mine : 1u; nx = cnt > 0u ? cnt : 1u;
}

__device__ __forceinline__ void xcd_barrier(const XcdBarrier& b) {
    asm volatile("s_waitcnt vmcnt(0)" ::: "memory");
    __syncthreads();
    if (threadIdx.x == 0) {
        unsigned* bar = b.bar;
        asm volatile("" : "+s"(bar));
        __builtin_amdgcn_s_waitcnt(0);
        unsigned nloc = b.st[0], nx = b.st[1];
        if (nloc == 0u) { xcd_barrier_complete(bar, b.x, nloc, nx); b.st[0] = nloc; b.st[1] = nx; }
        const unsigned old = xb_add(&bar[XB_XSUB(b.x)], 1u);
        const unsigned gen = old / nloc;
        if (old + 1u == (gen + 1u) * nloc) {
            __builtin_amdgcn_fence(__ATOMIC_RELEASE, "agent");
            asm volatile("s_waitcnt vmcnt(0)" ::: "memory");
            const unsigned og = xb_add(&bar[XB_TOP], 1u);
            const unsigned tg = og / nx;
            if (og + 1u == (tg + 1u) * nx) xb_add(&bar[XB_TOPGEN], 1u);
            else XB_SPIN(xb_ld(&bar[XB_TOPGEN]) == tg, bar);
            __builtin_amdgcn_fence(__ATOMIC_ACQUIRE, "agent");
            xb_add(&bar[XB_XGEN(b.x)], 1u);
            asm volatile("s_waitcnt vmcnt(0)" ::: "memory");
        } else {
            XB_SPIN(xb_ld(&bar[XB_XGEN(b.x)]) == gen, bar);
            __builtin_amdgcn_fence(__ATOMIC_ACQUIRE, "agent");
            asm volatile("s_waitcnt vmcnt(0)" ::: "memory");
        }
    }
    __syncthreads();
}
template <class RowMap>
__device__ __forceinline__ void transpose_item(const float* W, int ldw, int k0, int n0, bf16* WT, int ldt, RowMap rm, LAS float* scr, int lane) {
    (void)scr;
    const int nq = lane & 7, kg = lane >> 3; const float* src = W + (size_t)(k0 + 8 * kg) * ldw + n0 + 4 * nq;
    f32x4 v[8];
#pragma unroll
    for (int i = 0; i < 8; ++i) v[i] = *(const f32x4*)(src + (size_t)i * ldw);
#pragma unroll
    for (int j = 0; j < 4; ++j) { u32x4 o = {pk2(v[0][j], v[1][j]), pk2(v[2][j], v[3][j]), pk2(v[4][j], v[5][j]), pk2(v[6][j], v[7][j])};
        *(u32x4*)(WT + (size_t)rm(n0 + 4 * nq + j) * ldt + k0 + 8 * kg) = o; }
}
struct RmId { int off; __device__ __forceinline__ int operator()(int n) const { return off + n; } };
struct RmGU { int off; __device__ __forceinline__ int operator()(int n) const { return off + ((n >> 2) << 3) + (n & 3); } };

__device__ __forceinline__ void p0_prologue(const Frame& F0) {
    const Frame F = phase_frame(F0); unsigned char* const ws = F.ws;
    LAS float* scr = (LAS float*)(F.lds + F.wave * 16384);
    LAS float* ctab = (LAS float*)(F.lds + 8 * 16384);
    if (F.tid < 64) ctab[F.tid] = cosf((float)F.tid * (6.283185307179586f / 64.f));
    __syncthreads();
    bf16* win_t = (bf16*)(ws + WS_WIN_T); bf16* wout_t = (bf16*)(ws + WS_WOUT_T);
    constexpr int I_WIN_L = 16 * 84, I_WOUT_L = 16 * 32, I_FOLD_L = 4 * 64, I_MOD_L = 96 * 8;
    constexpr int NIT = 2 * (I_WIN_L + I_WOUT_L + I_FOLD_L + I_MOD_L);
    const float* p_win = inptr(I_WIN); const float* p_wout = inptr(I_WOUT); const float* p_c = inptr(I_C); const float* p_cctx = inptr(I_CCTX); const float* p_adaw = inptr(I_ADAW);
    {
        bf16* wl = (bf16*)(ws + 64 * 1024); const float* dw2 = inptr(I_DW2); const float* ia2 = inptr(I_IA2); const float* gg2 = inptr(I_GG2);
        for (int idx = F.vcu * NTHR + F.tid; idx < 2 * 384 * 512; idx += F.G * NTHR) { const int c = idx & 511, k = (idx >> 9) % 384, l = idx / (384 * 512);
            float v;
            if (k < 128) v = dw2[((size_t)(l * 2 + (k >> 6)) * 64 + (k & 63)) * DR + c];
            else if (k < 256) v = ia2[((size_t)(l * 2 + ((k - 128) >> 6)) * 64 + (k & 63)) * DR + c];
            else v = gg2[((size_t)l * 128 + (k - 256)) * DR + c];
            wl[((size_t)l * 512 + c) * 384 + k] = (bf16)f2bf(v); } }
    for (int it = F.gw; it < NIT; it += F.NGW) {
        int r = it; const int l = r & 1; r >>= 1;
        if (r < I_WIN_L) { const int kb = r / 84, nb = r % 84;
            transpose_item(p_win + (size_t)l * D * DIN, DIN, kb * 64, nb * 32, win_t + (size_t)l * NP * D, D, RmId{0}, scr, F.lane); continue; }
        r -= I_WIN_L;
        if (r < I_WOUT_L) { const int kb = r / 32, nb = r % 32;
            transpose_item(p_wout + (size_t)l * D * D, D, kb * 64, nb * 32, wout_t + (size_t)l * D * D, D, RmId{0}, scr, F.lane); continue; }
        r -= I_WOUT_L;
        if (r < I_FOLD_L) {
            const int g = r >> 6, k0 = (r & 63) * 16; const float* W = p_win + (size_t)l * D * DIN;
#pragma unroll
            for (int kk = 0; kk < 16; ++kk) scr[kk * 64 + F.lane] = W[(size_t)(k0 + kk) * DIN + 2688 + g * 64 + F.lane];
            LDS_WAIT(); asm volatile("" ::: "memory");
            float ac[16], as[16];
#pragma unroll
            for (int kk = 0; kk < 16; ++kk) { ac[kk] = 0.f; as[kk] = 0.f; }
            for (int c = 0; c < 64; ++c) { const int idx = (c * F.lane) & 63; const float cc = ctab[idx], ss = ctab[(idx - 16) & 63];
#pragma unroll
                for (int kk = 0; kk < 16; ++kk) { const float w = scr[kk * 64 + c]; ac[kk] += w * cc; as[kk] += w * ss; } }
            bf16* oc = win_t + (size_t)l * NP * D + (size_t)(COL_FC + g * 64 + F.lane) * D + k0;
            bf16* os = win_t + (size_t)l * NP * D + (size_t)(COL_FS + g * 64 + F.lane) * D + k0;
            u32x4 a, b;
            a.x = pk2(ac[0], ac[1]); a.y = pk2(ac[2], ac[3]); a.z = pk2(ac[4], ac[5]); a.w = pk2(ac[6], ac[7]);
            b.x = pk2(ac[8], ac[9]); b.y = pk2(ac[10], ac[11]); b.z = pk2(ac[12], ac[13]); b.w = pk2(ac[14], ac[15]);
            *(u32x4*)oc = a; *(u32x4*)(oc + 8) = b;
            a.x = pk2(as[0], as[1]); a.y = pk2(as[2], as[3]); a.z = pk2(as[4], as[5]); a.w = pk2(as[6], as[7]);
            b.x = pk2(as[8], as[9]); b.y = pk2(as[10], as[11]); b.z = pk2(as[12], as[13]); b.w = pk2(as[14], as[15]);
            *(u32x4*)os = a; *(u32x4*)(os + 8) = b;
            LDS_WAIT(); asm volatile("" ::: "memory");
            continue; }
        r -= I_FOLD_L;
        {
            const int cb = r >> 3, ks = r & 7;
#pragma unroll
            for (int q = 0; q < 2; ++q) { const int k = ks * 128 + q * 64 + F.lane;
                const float c0 = p_c[k], c1 = p_c[D + k], c2 = p_cctx[k];
                scr[0 * 128 + q * 64 + F.lane] = c0 * sigmoidf_(c0); scr[1 * 128 + q * 64 + F.lane] = c1 * sigmoidf_(c1); scr[2 * 128 + q * 64 + F.lane] = c2 * sigmoidf_(c2); }
            LDS_WAIT(); asm volatile("" ::: "memory");
            const float* W = p_adaw + (size_t)l * D * 6144 + (size_t)(ks * 128) * 6144 + cb * 64 + F.lane;
            float a0 = 0.f, a1 = 0.f, a2 = 0.f;
#pragma unroll 8
            for (int kk = 0; kk < 128; ++kk) { const float w = W[(size_t)kk * 6144]; a0 += scr[kk] * w; a1 += scr[128 + kk] * w; a2 += scr[256 + kk] * w; }
            float* mp = (float*)(ws + WS_MODP) + (size_t)((l * 8 + ks) * 3) * 6144 + cb * 64 + F.lane;
            mp[0] = a0; mp[6144] = a1; mp[2 * 6144] = a2;
            LDS_WAIT(); asm volatile("" ::: "memory");
        }
    }
}

__device__ __forceinline__ void mod_to_lds(const Frame& F0, int l, int p, LAS float* dst, bool from_partials) {
    const Frame F = phase_frame(F0); unsigned char* const ws = F.ws;
    const float* adab = inptr(I_ADAB);
    for (int idx = F.tid; idx < 3 * 1024; idx += NTHR) { const int r = idx >> 10, n = idx & 1023;
        float v;
        if (from_partials) { v = adab[l * 6144 + p * 1024 + n]; const float* mp = (const float*)(ws + WS_MODP) + (size_t)(l * 8 * 3 + r) * 6144 + p * 1024 + n;
#pragma unroll
            for (int ks = 0; ks < 8; ++ks) v += mp[(size_t)ks * 3 * 6144]; }
        else v = ((const float*)(ws + WS_MODF))[(size_t)(l * 3 + r) * 6144 + p * 1024 + n];
        dst[idx] = v; }
}
__device__ __forceinline__ void mod_finalize(const Frame& F0) {
    const Frame F = phase_frame(F0); unsigned char* const ws = F.ws;
    const float* adab = inptr(I_ADAB);
    for (int idx = F.vcu * NTHR + F.tid; idx < 2 * 3 * 6144; idx += F.G * NTHR) { const int l = idx / (3 * 6144), rem = idx % (3 * 6144), r = rem / 6144, n = rem % 6144;
        float v = adab[l * 6144 + n]; const float* mp = (const float*)(ws + WS_MODP) + (size_t)(l * 8 * 3 + r) * 6144 + n;
#pragma unroll
        for (int ks = 0; ks < 8; ++ks) v += mp[(size_t)ks * 3 * 6144];
        ((float*)(ws + WS_MODF))[idx] = v; }
}


__device__ __forceinline__ void norm_mod_row(f32x4 (&v)[4], const float* gain, const LAS float* sc, const LAS float* sh, bf16* orow, int lane) {
    float s = 0.f;
#pragma unroll
    for (int j = 0; j < 4; ++j) s += (v[j].x * v[j].x + v[j].y * v[j].y) + (v[j].z * v[j].z + v[j].w * v[j].w);
    const float rs = rsqrtf(wave_sum(s) * (1.f / D) + RMS_EPS);
#pragma unroll
    for (int j = 0; j < 4; ++j) { const int c = 4 * lane + 256 * j; const f32x4 g = *(const f32x4*)(gain + c); const f32x4 a = *(const LAS f32x4*)(sc + c), b = *(const LAS f32x4*)(sh + c);
        v[j] = (v[j] * rs) * g * (a + 1.f) + b;
        u32x2 w; w.x = pk2(v[j].x, v[j].y); w.y = pk2(v[j].z, v[j].w); *(u32x2*)(orow + c) = w; }
}

__device__ __forceinline__ void p0b_norm1(const Frame& F0) {
    const Frame F = phase_frame(F0); unsigned char* const ws = F.ws;
    LAS float* msh = (LAS float*)F.lds; LAS float* msc = msh + 3072;
    mod_to_lds(F, 0, 0, msh, true); mod_to_lds(F, 0, 1, msc, true); __syncthreads();
    mod_finalize(F);
    bf16* H = (bf16*)(ws + WS_H); const float* xin = inptr(I_X); const float* cin = inptr(I_CTX); const float* n1g = inptr(I_N1G);
    for (int row0 = F.gw; row0 < NROW; row0 += 2 * F.NGW) { f32x4 v[2][4]; bool ok[2];
#pragma unroll
        for (int u = 0; u < 2; ++u) { const int row = row0 + u * F.NGW; ok[u] = row < NROW; if (ok[u]) { const float* xr = row < NLAT ? xin + (size_t)row * D : cin + (size_t)(row - NLAT) * D;
#pragma unroll
            for (int j = 0; j < 4; ++j) v[u][j] = *(const f32x4*)(xr + 4 * F.lane + 256 * j); } }
#pragma unroll
        for (int u = 0; u < 2; ++u) if (ok[u]) { const int row = row0 + u * F.NGW; const int mr = modrow(row);
            norm_mod_row(v[u], n1g, msc + mr * 1024, msh + mr * 1024, H + (size_t)row * D, F.lane); } }
}
__device__ __forceinline__ void unpack8(const u32x4 w, float (&o)[8]) {
    o[0] = bf2f(w.x & 0xffffu); o[1] = bf2f(w.x >> 16); o[2] = bf2f(w.y & 0xffffu); o[3] = bf2f(w.y >> 16);
    o[4] = bf2f(w.z & 0xffffu); o[5] = bf2f(w.z >> 16); o[6] = bf2f(w.w & 0xffffu); o[7] = bf2f(w.w >> 16);
}
__device__ __forceinline__ void unpack4(const u32x2 w, float (&o)[4]) { o[0] = bf2f(w.x & 0xffffu); o[1] = bf2f(w.x >> 16); o[2] = bf2f(w.y & 0xffffu); o[3] = bf2f(w.y >> 16); }

__device__ __forceinline__ void shift_pass(const Frame& F0, int l) {
    const Frame F = phase_frame(F0); unsigned char* const ws = F.ws;
    const bf16* P = (const bf16*)(ws + WS_P); bf16* Zs = (bf16*)(ws + WS_ZS); const float* mu = inptr(I_MU) + l * ZW;
    const int total = NROW * 240;
    for (int idx = F.vcu * NTHR + F.tid; idx < total; idx += F.G * NTHR) {
        const int row = idx / 240, ck = idx % 240; const bf16* pr = P + (size_t)row * NP + ck * 8;
        const u32x4 zero = {0u, 0u, 0u, 0u};
        float z[8], n0[8], n1[8], n2[8], n3[8], o[8];
        unpack8(*(const u32x4*)pr, z);
        if (row < NLAT) { const int t = row & (SEQ - 1), gr = t >> 6, gc = t & 63;
            unpack8(gc > 0 ? *(const u32x4*)(pr - NP) : zero, n0); unpack8(gc < 63 ? *(const u32x4*)(pr + NP) : zero, n1);
            unpack8(gr > 0 ? *(const u32x4*)(pr - 64 * NP) : zero, n2); unpack8(gr < 127 ? *(const u32x4*)(pr + 64 * NP) : zero, n3);
        } else { const int tc = (row - NLAT) & (CTXL - 1);
            unpack8(tc > 0 ? *(const u32x4*)(pr - NP) : zero, n0); unpack8(tc < CTXL - 1 ? *(const u32x4*)(pr + NP) : zero, n1);
#pragma unroll
            for (int j = 0; j < 8; ++j) { n2[j] = n0[j]; n3[j] = n1[j]; }
        }
        const f32x4 m0 = *(const f32x4*)(mu + ck * 8), m1 = *(const f32x4*)(mu + ck * 8 + 4);
        const float m[8] = {m0.x, m0.y, m0.z, m0.w, m1.x, m1.y, m1.z, m1.w};
#pragma unroll
        for (int j = 0; j < 8; ++j) { const float nb = (j & 3) == 0 ? n0[j] : (j & 3) == 1 ? n1[j] : (j & 3) == 2 ? n2[j] : n3[j]; o[j] = z[j] + (nb - z[j]) * m[j]; }
        u32x4 w; w.x = pk2(o[0], o[1]); w.y = pk2(o[2], o[3]); w.z = pk2(o[4], o[5]); w.w = pk2(o[6], o[7]);
        *(u32x4*)(Zs + (size_t)row * ZW + ck * 8) = w;
    }
}

__device__ __forceinline__ void conv_pass(const Frame& F0, int l, int nrows) {
    const Frame F = phase_frame(F0); unsigned char* const ws = F.ws;
    const bf16* P = (const bf16*)(ws + WS_P); bf16* MA = (bf16*)(ws + WS_H);
    const float* cw = inptr(I_CONVW) + l * 3 * 256; const int c = 4 * F.lane;
    const f32x4 w0 = *(const f32x4*)(cw + c), w1 = *(const f32x4*)(cw + 256 + c), w2 = *(const f32x4*)(cw + 512 + c), gn = *(const f32x4*)(inptr(I_CONVG) + l * 256 + c);
    for (int row0 = F.gw; row0 < nrows; row0 += 2 * F.NGW) {
        u32x2 q[2][7]; bool ok[2]; const u32x2 zero = {0u, 0u};
#pragma unroll
        for (int u = 0; u < 2; ++u) { const int row = row0 + u * F.NGW; ok[u] = row < nrows; if (ok[u]) {
            int t, L; if (row < NLAT) { t = row & (SEQ - 1); L = SEQ; } else { t = (row - NLAT) & (CTXL - 1); L = CTXL; }
            const bf16* pr = P + (size_t)row * NP + COL_CONV + c;
            q[u][0] = *(const u32x2*)pr; q[u][1] = *(const u32x2*)(pr + 256); q[u][2] = *(const u32x2*)(pr + 512);
            q[u][3] = t > 0 ? *(const u32x2*)(pr - NP + 256) : zero; q[u][4] = t > 0 ? *(const u32x2*)(pr - NP + 512) : zero;
            q[u][5] = t < L - 1 ? *(const u32x2*)(pr + NP + 256) : zero; q[u][6] = t < L - 1 ? *(const u32x2*)(pr + NP + 512) : zero; } }
#pragma unroll
        for (int u = 0; u < 2; ++u) if (ok[u]) { const int row = row0 + u * F.NGW;
            float bg[4], cg[4], hh[4], cp[4], hp[4], cn[4], hn[4];
            unpack4(q[u][0], bg); unpack4(q[u][1], cg); unpack4(q[u][2], hh); unpack4(q[u][3], cp); unpack4(q[u][4], hp); unpack4(q[u][5], cn); unpack4(q[u][6], hn);
            const float W0[4] = {w0.x, w0.y, w0.z, w0.w}, W1[4] = {w1.x, w1.y, w1.z, w1.w}, W2[4] = {w2.x, w2.y, w2.z, w2.w}, GN[4] = {gn.x, gn.y, gn.z, gn.w};
            float y[4], s = 0.f;
#pragma unroll
            for (int j = 0; j < 4; ++j) { y[j] = bg[j] * (W0[j] * (cp[j] * hp[j]) + W1[j] * (cg[j] * hh[j]) + W2[j] * (cn[j] * hn[j])); s += y[j] * y[j]; }
            const float rs = rsqrtf(wave_sum(s) * (1.f / 256.f) + RMS_EPS);
            u32x2 o; o.x = pk2(y[0] * rs * GN[0], y[1] * rs * GN[1]); o.y = pk2(y[2] * rs * GN[2], y[3] * rs * GN[3]);
            *(u32x2*)(MA + (size_t)row * D + 512 + c) = o; }
    }
}

__device__ __forceinline__ void sincos_turns(float x, float& s, float& c) { s = __builtin_amdgcn_sinf(x); c = __builtin_amdgcn_cosf(x); }
#define MFMA16(a, b, c) __builtin_amdgcn_mfma_f32_16x16x32_bf16((a), (b), (c), 0, 0, 0)

__device__ __forceinline__ void fftA_item(const Frame& F0, int item) {
    const Frame F = phase_frame(F0); unsigned char* const ws = F.ws;
    const int half = item & 1, t2 = (item >> 1) & 63, b = item >> 7;
    const bf16* P = (const bf16*)(ws + WS_P); bf16* GT = (bf16*)(ws + WS_GT);
    LAS bf16* Bs = (LAS bf16*)F.lds;
    const int lane = F.lane, w = F.wave, fr = lane & 15, fq = lane >> 4;
    __syncthreads();
#pragma unroll
    for (int i = 0; i < 8; ++i) { const int cidx = F.tid + NTHR * i, krow = cidx >> 4, ch8 = cidx & 15, ri = krow >> 7, t1 = krow & 127;
        const u32x4 v = *(const u32x4*)(P + (size_t)(b * SEQ + t1 * 64 + t2) * NP + COL_FC + ri * 256 + half * 128 + ch8 * 8);
        LAS bf16* d = Bs + (ch8 * 8) * 264 + krow;
        d[0 * 264] = (bf16)(v.x & 0xffffu); d[1 * 264] = (bf16)(v.x >> 16); d[2 * 264] = (bf16)(v.y & 0xffffu); d[3 * 264] = (bf16)(v.y >> 16);
        d[4 * 264] = (bf16)(v.z & 0xffffu); d[5 * 264] = (bf16)(v.z >> 16); d[6 * 264] = (bf16)(v.w & 0xffffu); d[7 * 264] = (bf16)(v.w >> 16); }
    __syncthreads();
    f32x4 acc[2][8];
#pragma unroll
    for (int a = 0; a < 2; ++a)
#pragma unroll
        for (int n = 0; n < 8; ++n) acc[a][n] = (f32x4){0.f, 0.f, 0.f, 0.f};
    int t1p_a = 16 * w + fr;
    asm volatile("" : "+v"(t1p_a));
#pragma unroll
    for (int ks = 0; ks < 8; ++ks) {
        bf16x8 ar, ai;
#pragma unroll
        for (int j = 0; j < 8; ++j) { const int k = ks * 32 + 8 * fq + j, ri = k >> 7, t1 = k & 127; const int idx = (t1 * t1p_a) & 127;
            float sn, cs; sincos_turns((float)idx * (1.f / 128.f), sn, cs);
            const float vr = ri == 0 ? cs : -sn, vi = ri == 0 ? -sn : -cs;
            ar[j] = (short)f2bf(vr); ai[j] = (short)f2bf(vi); }
#pragma unroll
        for (int nt = 0; nt < 8; ++nt) { const bf16x8 bfr = *(const LAS bf16x8*)(Bs + (nt * 16 + fr) * 264 + ks * 32 + 8 * fq);
            acc[0][nt] = MFMA16(ar, bfr, acc[0][nt]); acc[1][nt] = MFMA16(ai, bfr, acc[1][nt]); }
    }
#pragma unroll
    for (int reg = 0; reg < 4; ++reg) { const int t1p = 16 * w + 4 * fq + reg; float st, ct; sincos_turns((float)(t2 * t1p) * (1.f / 8192.f), st, ct);
        bf16* g = GT + ((size_t)((b * 128 + t1p) * 64 + t2) * 2) * 256 + half * 128 + fr;
#pragma unroll
        for (int nt = 0; nt < 8; ++nt) { const float gr = acc[0][nt][reg], gi = acc[1][nt][reg];
            g[nt * 16] = (bf16)f2bf(gr * ct + gi * st); g[256 + nt * 16] = (bf16)f2bf(gi * ct - gr * st); } }
}

template <int NKC, int NDIV, int MT, class SrcRow, class OutRow>
__device__ __forceinline__ void dft64_item(const Frame& F0, int l, int m0, float sgn, float scale, SrcRow src, OutRow orow) {
    const Frame F = phase_frame(F0); unsigned char* const ws = F.ws;
    LAS bf16* Bs = (LAS bf16*)F.lds;
    LAS float* red = (LAS float*)(F.lds + 256 * 136 * 2);
    const int lane = F.lane, w = F.wave, fr = lane & 15, fq = lane >> 4;
    int fr_a = fr; asm volatile("" : "+v"(fr_a));
    f32x4 acc[MT][2];
#pragma unroll
    for (int a = 0; a < MT; ++a) { acc[a][0] = (f32x4){0.f, 0.f, 0.f, 0.f}; acc[a][1] = (f32x4){0.f, 0.f, 0.f, 0.f}; }
    for (int kc = 0; kc < NKC; ++kc) {
        __syncthreads();
#pragma unroll
        for (int i = 0; i < 8; ++i) { const int cidx = F.tid + NTHR * i, krow = cidx >> 5, ch8 = cidx & 31;
            const u32x4 v = *(const u32x4*)(src(kc * 64 + (krow >> 1), krow & 1) + ch8 * 8);
            LAS bf16* d = Bs + (ch8 * 8) * 136 + krow;
            d[0 * 136] = (bf16)(v.x & 0xffffu); d[1 * 136] = (bf16)(v.x >> 16); d[2 * 136] = (bf16)(v.y & 0xffffu); d[3 * 136] = (bf16)(v.y >> 16);
            d[4 * 136] = (bf16)(v.z & 0xffffu); d[5 * 136] = (bf16)(v.z >> 16); d[6 * 136] = (bf16)(v.w & 0xffffu); d[7 * 136] = (bf16)(v.w >> 16); }
        __syncthreads();
#pragma unroll
        for (int ks = 0; ks < 4; ++ks) {
            const bf16x8 b0 = *(const LAS bf16x8*)(Bs + ((2 * w) * 16 + fr) * 136 + ks * 32 + 8 * fq);
            const bf16x8 b1 = *(const LAS bf16x8*)(Bs + ((2 * w + 1) * 16 + fr) * 136 + ks * 32 + 8 * fq);
#pragma unroll
            for (int mt = 0; mt < MT; ++mt) { const int mrow = m0 + mt * 16 + fr_a; bf16x8 a;
#pragma unroll
                for (int j = 0; j < 8; ++j) { const int k = ks * 32 + 8 * fq + j, tl = k >> 1, ri = k & 1; const int idx = ((kc * 64 + tl) * mrow) & (NDIV - 1);
                    float sn, cs; sincos_turns((float)idx * (1.f / (float)NDIV), sn, cs);
                    a[j] = (short)f2bf(ri == 0 ? cs : sgn * sn); }
                acc[mt][0] = MFMA16(a, b0, acc[mt][0]); acc[mt][1] = MFMA16(a, b1, acc[mt][1]); }
        }
    }
#pragma unroll
    for (int mt = 0; mt < MT; ++mt)
#pragma unroll
        for (int reg = 0; reg < 4; ++reg) { const float a = acc[mt][0][reg] * scale, b = acc[mt][1][reg] * scale; acc[mt][0][reg] = a; acc[mt][1][reg] = b;
            float s = a * a + b * b; s += __shfl_xor(s, 1); s += __shfl_xor(s, 2); s += __shfl_xor(s, 4); s += __shfl_xor(s, 8);
            if (fr == 0) red[w * 64 + mt * 16 + 4 * fq + reg] = s; }
    __syncthreads();
    bf16* MA = (bf16*)(ws + WS_H); const float* fg = inptr(I_FOURG) + l * 256;
    const float g0 = fg[(2 * w) * 16 + fr], g1 = fg[(2 * w + 1) * 16 + fr];
#pragma unroll
    for (int mt = 0; mt < MT; ++mt)
#pragma unroll
        for (int reg = 0; reg < 4; ++reg) { const int ml = mt * 16 + 4 * fq + reg; float tot = 0.f;
#pragma unroll
            for (int ww = 0; ww < 8; ++ww) tot += red[ww * 64 + ml];
            const float rs = rsqrtf(tot * (1.f / 256.f) + RMS_EPS);
            bf16* o = MA + (size_t)orow(m0 + ml) * D + 768 + fr;
            o[(2 * w) * 16] = (bf16)f2bf(acc[mt][0][reg] * rs * g0); o[(2 * w + 1) * 16] = (bf16)f2bf(acc[mt][1][reg] * rs * g1); }
    __syncthreads();
}

constexpr size_t WS_LORA = 64 * 1024;
constexpr int LINP = 392;
__device__ __forceinline__ float fast_sigmoid(float x) { return __builtin_amdgcn_rcpf(1.f + __expf(-x)); }
__device__ __forceinline__ float fast_tanh(float x) { return 1.f - 2.f * __builtin_amdgcn_rcpf(1.f + __expf(2.f * x)); }
__device__ __forceinline__ void prep_phase(const Frame& F0, int l) {
    const Frame F = phase_frame(F0); unsigned char* const ws = F.ws;
    const bf16* Zs = (const bf16*)(ws + WS_ZS); bf16* STR = (bf16*)(ws + WS_STR);
    LAS bf16* lin = (LAS bf16*)F.lds;
    LAS float* ssum = (LAS float*)(F.lds + 12544);
    LAS bf16* tiles = (LAS bf16*)(F.lds + 13312);
    const int lane = F.lane, fr = lane & 15, fq = lane >> 4, w = F.wave, tid = F.tid;
    const int nitems = (NROW / 16) * 2;
    int it = blockIdx.x; if (it >= nitems) return;
    int hh = -1, head = 0, cb = 0;
    bf16x8 wf[12][2];
    const float* kkp = inptr(I_KK) + l * DR; const float* kap = inptr(I_KA) + l * DR; const float* dw0 = inptr(I_DW0) + l * 2 * DR; const float* ia0 = inptr(I_IA0) + l * 2 * DR;
    u32x4 pz[2];
#define PREP_LOAD(item_) do { const int row0_ = ((item_) >> 1) * 16; \
        pz[0] = *(const u32x4*)(Zs + (size_t)(row0_ + tid / 48) * ZW + 1536 + (tid % 48) * 8); \
        if (tid < 256) pz[1] = *(const u32x4*)(Zs + (size_t)(row0_ + (tid + 512) / 48) * ZW + 1536 + ((tid + 512) % 48) * 8); } while (0)
    PREP_LOAD(it);
    for (; it < nitems; it += F.G) {
        const int tile = it >> 1;
        if ((it & 1) != hh) {
            hh = it & 1; head = 4 * hh + (w >> 1); cb = 64 * head + 32 * (w & 1);
            const bf16* WL = (const bf16*)(ws + WS_LORA) + (size_t)l * 512 * 384 + (size_t)(cb + fr) * 384 + 8 * fq;
#pragma unroll
            for (int ks = 0; ks < 12; ++ks)
#pragma unroll
                for (int nt = 0; nt < 2; ++nt) wf[ks][nt] = *(const bf16x8*)(WL + (size_t)nt * 16 * 384 + ks * 32);
        }
        __syncthreads();
        {   float v[8]; unpack8(pz[0], v); const int c8 = tid % 48;
            if (c8 < 16) {
#pragma unroll
                for (int j = 0; j < 8; ++j) v[j] = fast_tanh(v[j]); }
            else if (c8 >= 32) {
#pragma unroll
                for (int j = 0; j < 8; ++j) v[j] = fast_sigmoid(v[j]); }
            *(LAS u32x4*)(lin + (tid / 48) * LINP + c8 * 8) = (u32x4){pk2(v[0], v[1]), pk2(v[2], v[3]), pk2(v[4], v[5]), pk2(v[6], v[7])};
            if (tid < 256) { unpack8(pz[1], v); const int c9 = (tid + 512) % 48;
                if (c9 < 16) {
#pragma unroll
                    for (int j = 0; j < 8; ++j) v[j] = fast_tanh(v[j]); }
                else if (c9 >= 32) {
#pragma unroll
                    for (int j = 0; j < 8; ++j) v[j] = fast_sigmoid(v[j]); }
                *(LAS u32x4*)(lin + ((tid + 512) / 48) * LINP + c9 * 8) = (u32x4){pk2(v[0], v[1]), pk2(v[2], v[3]), pk2(v[4], v[5]), pk2(v[6], v[7])}; } }
        u32x2 zr2[2], zk2[2], zv2[2];
        {   const bf16* zr_ = Zs + (size_t)(tile * 16 + fr) * ZW + cb + 4 * fq;
#pragma unroll
            for (int nt = 0; nt < 2; ++nt) { zr2[nt] = *(const u32x2*)(zr_ + 16 * nt); zk2[nt] = *(const u32x2*)(zr_ + 512 + 16 * nt); zv2[nt] = *(const u32x2*)(zr_ + 1024 + 16 * nt); } }
        if (it + F.G < nitems) PREP_LOAD(it + F.G);
        __syncthreads();
        f32x4 kkw[2], kaw[2], d0w[2][2], i0w[2][2];
#pragma unroll
        for (int nt = 0; nt < 2; ++nt) { const int c0 = cb + 16 * nt + 4 * fq; kkw[nt] = *(const f32x4*)(kkp + c0); kaw[nt] = *(const f32x4*)(kap + c0);
#pragma unroll
            for (int dn = 0; dn < 2; ++dn) { d0w[dn][nt] = *(const f32x4*)(dw0 + dn * DR + c0); i0w[dn][nt] = *(const f32x4*)(ia0 + dn * DR + c0); } }
        f32x4 acc[5][2];
#pragma unroll
        for (int q = 0; q < 5; ++q) { acc[q][0] = (f32x4){0.f, 0.f, 0.f, 0.f}; acc[q][1] = (f32x4){0.f, 0.f, 0.f, 0.f}; }
#pragma unroll
        for (int ks = 0; ks < 12; ++ks) { const int q = ks < 8 ? (ks >> 1) : 4; const bf16x8 xf = *(const LAS bf16x8*)(lin + fr * LINP + ks * 32 + 8 * fq);
            acc[q][0] = MFMA16(wf[ks][0], xf, acc[q][0]); acc[q][1] = MFMA16(wf[ks][1], xf, acc[q][1]); }
        float zk[2][4], kv[2][4]; float ss = 0.f;
#pragma unroll
        for (int nt = 0; nt < 2; ++nt) { unpack4(zk2[nt], zk[nt]);
#pragma unroll
            for (int i = 0; i < 4; ++i) { kv[nt][i] = zk[nt][i] * kkw[nt][i]; ss += kv[nt][i] * kv[nt][i]; } }
        ss += __shfl_xor(ss, 16); ss += __shfl_xor(ss, 32);
        if (fq == 0) ssum[w * 16 + fr] = ss;
        __syncthreads();
        const float inv = __builtin_amdgcn_rcpf(fmaxf(sqrtf(ssum[w * 16 + fr] + ssum[(w ^ 1) * 16 + fr]), 1e-12f));
        LAS bf16* th = tiles + (w >> 1) * 10 * 1024 + fr * 64 + 32 * (w & 1) + 4 * fq;
#pragma unroll
        for (int nt = 0; nt < 2; ++nt) { LAS bf16* t0 = th + 16 * nt;
            *(LAS u32x2*)(t0) = zr2[nt]; *(LAS u32x2*)(t0 + 1024) = zv2[nt];
            float kk[4];
#pragma unroll
            for (int i = 0; i < 4; ++i) kk[i] = kv[nt][i] * inv;
            *(LAS u32x2*)(t0 + 2 * 1024) = (u32x2){pk2(kk[0], kk[1]), pk2(kk[2], kk[3])};
            *(LAS u32x2*)(t0 + 3 * 1024) = (u32x2){pk2(acc[4][nt][0], acc[4][nt][1]), pk2(acc[4][nt][2], acc[4][nt][3])};
#pragma unroll
            for (int dn = 0; dn < 2; ++dn) { float ep[4], kd[4], bb[4];
#pragma unroll
                for (int i = 0; i < 4; ++i) { const float ew = fast_sigmoid(d0w[dn][nt][i] + acc[dn][nt][i]) * 0.6065306597126334f;
                    ep[i] = ew * (1.f + ew * (-0.5f + ew * (0.16666667f + ew * (-0.041666668f + ew * 0.0083333338f))));
                    const float a = fast_sigmoid(i0w[dn][nt][i] + acc[2 + dn][nt][i]); kd[i] = zk[nt][i] * (1.f + (a - 1.f) * kaw[nt][i]); bb[i] = kk[i] * a; }
                *(LAS u32x2*)(t0 + (4 + 3 * dn) * 1024) = (u32x2){pk2(ep[0], ep[1]), pk2(ep[2], ep[3])};
                *(LAS u32x2*)(t0 + (5 + 3 * dn) * 1024) = (u32x2){pk2(kd[0], kd[1]), pk2(kd[2], kd[3])};
                *(LAS u32x2*)(t0 + (6 + 3 * dn) * 1024) = (u32x2){pk2(bb[0], bb[1]), pk2(bb[2], bb[3])}; } }
        __syncthreads();
        {   const LAS bf16* src = tiles + (w >> 1) * 10 * 1024 + 8 * (w & 1) * 64 + lane * 8; bf16* dst = STR + ((size_t)tile * 8 + head) * 10240 + 8 * (w & 1) * 64 + lane * 8;
#pragma unroll
            for (int s = 0; s < 10; ++s) *(u32x4*)(dst + s * 1024) = *(const LAS u32x4*)(src + s * 1024); }
    }
#undef PREP_LOAD
}

__device__ __forceinline__ int scan_rowof(int s, int dir, int b) { if (s < CTXL) { const int tc = dir ? (CTXL - 1 - s) : s; return NLAT + b * CTXL + tc; } const int tt = s - CTXL; const int t = dir ? (SEQ - 1 - tt) : tt; return b * SEQ + t; }
__device__ __forceinline__ void readout_pass(const Frame& F0, int l, int nrows) {
    const Frame F = phase_frame(F0); unsigned char* const ws = F.ws;
    const bf16* STR = (const bf16*)(ws + WS_STR); const bf16* Y0 = (const bf16*)(ws + WS_Y); const bf16* Y1 = Y0 + (size_t)NROW * DR; bf16* MA = (bf16*)(ws + WS_H);
    const int lane = F.lane, c = 8 * lane;
    float gw[8], gb[8], rk[8];
    {   const float* gnw = inptr(I_GNW) + l * DR + c; const float* gnb = inptr(I_GNB) + l * DR + c; const float* rkp = inptr(I_RK) + l * DR + c;
        const f32x4 a0 = *(const f32x4*)gnw, a1 = *(const f32x4*)(gnw + 4), b0 = *(const f32x4*)gnb, b1 = *(const f32x4*)(gnb + 4), r0 = *(const f32x4*)rkp, r1 = *(const f32x4*)(rkp + 4);
#pragma unroll
        for (int i = 0; i < 4; ++i) { gw[i] = a0[i]; gw[4 + i] = a1[i]; gb[i] = b0[i]; gb[4 + i] = b1[i]; rk[i] = r0[i]; rk[4 + i] = r1[i]; } }
    for (int row0 = F.gw; row0 < nrows; row0 += 2 * F.NGW) {
        u32x4 q[2][7]; bool ok[2];
#pragma unroll
        for (int u = 0; u < 2; ++u) { const int row = row0 + u * F.NGW; ok[u] = row < nrows; if (ok[u]) {
            const bf16* sr = STR + ((size_t)(row >> 4) * 8 + (lane >> 3)) * 10240 + (row & 15) * 64 + (lane & 7) * 8;
            q[u][0] = *(const u32x4*)(Y0 + (size_t)row * DR + c); q[u][1] = *(const u32x4*)(Y1 + (size_t)row * DR + c);
            q[u][2] = *(const u32x4*)sr; q[u][3] = *(const u32x4*)(sr + 1024); q[u][4] = *(const u32x4*)(sr + 3072); q[u][5] = *(const u32x4*)(sr + 5 * 1024); q[u][6] = *(const u32x4*)(sr + 8 * 1024); } }
#pragma unroll
        for (int u = 0; u < 2; ++u) if (ok[u]) { const int row = row0 + u * F.NGW;
            float ya[8], yb[8], r[8], v[8], g[8], k0[8], k1[8];
            unpack8(q[u][0], ya); unpack8(q[u][1], yb); unpack8(q[u][2], r); unpack8(q[u][3], v); unpack8(q[u][4], g); unpack8(q[u][5], k0); unpack8(q[u][6], k1);
            float s1 = 0.f, s2 = 0.f, sb = 0.f;
#pragma unroll
            for (int i = 0; i < 8; ++i) { ya[i] += yb[i]; s1 += ya[i]; s2 += ya[i] * ya[i]; sb += r[i] * (k0[i] + k1[i]) * rk[i]; }
#pragma unroll
            for (int o = 1; o < 8; o <<= 1) { s1 += __shfl_xor(s1, o); s2 += __shfl_xor(s2, o); sb += __shfl_xor(sb, o); }
            const float mu = s1 * (1.f / 64.f); const float var = fmaxf(s2 * (1.f / 64.f) - mu * mu, 0.f); const float rs = rsqrtf(var + GN_EPS);
            float o8[8];
#pragma unroll
            for (int i = 0; i < 8; ++i) o8[i] = ((ya[i] - mu) * rs * gw[i] + gb[i] + sb * v[i]) * g[i];
            *(u32x4*)(MA + (size_t)row * D + c) = (u32x4){pk2(o8[0], o8[1]), pk2(o8[2], o8[3]), pk2(o8[4], o8[5]), pk2(o8[6], o8[7])}; }
    }
}
constexpr int BLOB = 16384, SEGCH = 132, NSEG = 4, BLOB_B1_SCANS = 14;
constexpr size_t WS_BLOBA = 20 * MiB, WS_BLOBB1 = 86 * MiB, WS_BLOBB2 = 492 * MiB;
constexpr size_t WS_SCANST = 2 * MiB + 512 * 1024;
__device__ __forceinline__ unsigned char* blob_ptr(unsigned char* ws, int seg, int scan, int ci) {
    if ((seg & 1) == 0) return ws + WS_BLOBA + ((size_t)scan * SEGCH + ci) * BLOB;
    return scan < BLOB_B1_SCANS ? ws + WS_BLOBB1 + ((size_t)scan * SEGCH + ci) * BLOB : ws + WS_BLOBB2 + ((size_t)(scan - BLOB_B1_SCANS) * SEGCH + ci) * BLOB;
}
typedef short s16x4 __attribute__((ext_vector_type(4)));
__device__ __forceinline__ bf16x8 frag_lo(u32x2 x) { u32x4 t = {x.x, x.y, 0u, 0u}; return __builtin_bit_cast(bf16x8, t); }
__device__ __forceinline__ bf16x8 frag_c(const f32x4& a) { u32x4 t = {pk2(a[0], a[1]), pk2(a[2], a[3]), 0u, 0u}; return __builtin_bit_cast(bf16x8, t); }

struct PreRegs { u32x4 q[12]; };
__device__ __forceinline__ void pre_load(PreRegs& R, unsigned char* ws, int scan, int cs, int lane) {
    const int dir = scan & 1, h = (scan >> 1) & 7, b = scan >> 4; const int rfirst = scan_rowof(16 * cs, dir, b);
    const bf16* blk = (const bf16*)(ws + WS_STR) + ((size_t)(rfirst >> 4) * 8 + h) * 10240 + lane * 8;
    const int so[6] = {0, 1, 2, 4 + 3 * dir, 5 + 3 * dir, 6 + 3 * dir};
#pragma unroll
    for (int i = 0; i < 6; ++i) { R.q[2 * i] = *(const u32x4*)(blk + so[i] * 1024); R.q[2 * i + 1] = *(const u32x4*)(blk + so[i] * 1024 + 512); }
}
template <int PM>
__device__ __forceinline__ void pre_item(const Frame& F, unsigned char* ws, int scan, int cs, unsigned char* blob, PreRegs& PR, int nscan, int ncs) {
    const int dir = scan & 1, h = (scan >> 1) & 7, b = scan >> 4; const int lane = F.lane, fr = lane & 15, fq = lane >> 4;
    LAS unsigned char* L = F.lds + F.wave * 17408;
    LAS bf16* TK = (LAS bf16*)L; LAS bf16* TR = TK + 1024; LAS bf16* TKt = TR + 1024; LAS bf16* TB = TKt + 1024;
    LAS bf16* KTt = TB + 1024; LAS bf16* RTt = KTt + 1024; LAS bf16* Vt = RTt + 1024;
    LAS float* AKB = (LAS float*)(Vt + 1024);
    LAS bf16* AKK = (LAS bf16*)(AKB + 256); LAS bf16* ARK = AKK + 256; LAS bf16* ARB = ARK + 256; LAS bf16* TT = ARB + 256;
    float kh[16], bh[16];
    float pc;
    {   float r_[16], v_[16], kk_[16], lp_[16], kd_[16], bb_[16];
        LAS bf16* stg = TK;
#pragma unroll
        for (int i = 0; i < 6; ++i) { *(LAS u32x4*)(stg + i * 1024 + lane * 8) = PR.q[2 * i]; *(LAS u32x4*)(stg + i * 1024 + 512 + lane * 8) = PR.q[2 * i + 1]; }
        LDS_WAIT(); asm volatile("" ::: "memory");
        if (nscan >= 0) pre_load(PR, ws, nscan, ncs, lane);
#pragma unroll
        for (int t = 0; t < 16; ++t) { const int tm = (dir ? 15 - t : t) * 64 + lane;
            r_[t] = bf2f(stg[tm]); v_[t] = bf2f(stg[1024 + tm]); kk_[t] = bf2f(stg[2048 + tm]); lp_[t] = bf2f(stg[3072 + tm]); kd_[t] = bf2f(stg[4096 + tm]); bb_[t] = bf2f(stg[5120 + tm]); }
        LDS_WAIT(); asm volatile("" ::: "memory");
        float pp = 1.f; u32x4 kt4[2], rt4[2], v4[2];
        unsigned ktp[8], rtp[8], vp[8];
#pragma unroll
        for (int t = 0; t < 16; ++t) { const float pm1 = pp; pp *= 1.f - lp_[t]; const float p = pp, ip = __builtin_amdgcn_rcpf(pp); lp_[t] = ip;
            const float kt = kk_[t] * pm1, ktl = kd_[t] * ip, btl = bb_[t] * ip, rt = r_[t] * p;
            const unsigned hk = pk2(kt, rt), hb = pk2(ktl, btl);
            TK[t * 64 + lane] = (bf16)(hk & 0xffffu); TR[t * 64 + lane] = (bf16)(hk >> 16); TKt[t * 64 + lane] = (bf16)(hb & 0xffffu); TB[t * 64 + lane] = (bf16)(hb >> 16);
            const unsigned hv = f2bf(v_[t]);
            if (t & 1) { ktp[t >> 1] |= hk << 16; rtp[t >> 1] |= hk & 0xffff0000u; vp[t >> 1] |= hv << 16; }
            else { ktp[t >> 1] = hk & 0xffffu; rtp[t >> 1] = hk >> 16; vp[t >> 1] = hv; } }
        kt4[0] = (u32x4){ktp[0], ktp[1], ktp[2], ktp[3]}; kt4[1] = (u32x4){ktp[4], ktp[5], ktp[6], ktp[7]};
        rt4[0] = (u32x4){rtp[0], rtp[1], rtp[2], rtp[3]}; rt4[1] = (u32x4){rtp[4], rtp[5], rtp[6], rtp[7]};
        v4[0] = (u32x4){vp[0], vp[1], vp[2], vp[3]}; v4[1] = (u32x4){vp[4], vp[5], vp[6], vp[7]};
        *(LAS u32x4*)(KTt + lane * 16) = kt4[0]; *(LAS u32x4*)(KTt + lane * 16 + 8) = kt4[1];
        *(LAS u32x4*)(RTt + lane * 16) = rt4[0]; *(LAS u32x4*)(RTt + lane * 16 + 8) = rt4[1];
        *(LAS u32x4*)(Vt + lane * 16) = v4[0]; *(LAS u32x4*)(Vt + lane * 16 + 8) = v4[1];
        pc = pp;
#pragma unroll
        for (int t = 0; t < 16; ++t) { const float e = pp * lp_[t]; kh[t] = kd_[t] * e; bh[t] = bb_[t] * e; }
    }
    LDS_WAIT(); asm volatile("" ::: "memory");
    {   f32x4 akb = {0.f, 0.f, 0.f, 0.f}, akk = akb, ark = akb, arb = akb;
#pragma unroll
        for (int s = 0; s < 2; ++s) { const int o = fr * 64 + 32 * s + 8 * fq;
            const bf16x8 fk = *(const LAS bf16x8*)(TK + o), frr = *(const LAS bf16x8*)(TR + o), fkt = *(const LAS bf16x8*)(TKt + o), fb = *(const LAS bf16x8*)(TB + o);
            akb = MFMA16(fk, fb, akb); akk = MFMA16(fk, fkt, akk); ark = MFMA16(frr, fkt, ark); arb = MFMA16(frr, fb, arb); }
        float nm[4];
#pragma unroll
        for (int reg = 0; reg < 4; ++reg) { const int t = 4 * fq + reg; const bool lo = fr < t, le = fr <= t;
            nm[reg] = lo ? akb[reg] : 0.f; AKK[t * 16 + fr] = (bf16)f2bf(lo ? akk[reg] : 0.f);
            ARK[t * 16 + fr] = (bf16)f2bf(le ? ark[reg] : 0.f); ARB[t * 16 + fr] = (bf16)f2bf(le ? arb[reg] : 0.f); }
        float col[16];
#pragma unroll
        for (int t = 0; t < 16; ++t) { float s_ = (t == fr) ? 1.f : 0.f;
#pragma unroll
            for (int i = 0; i < 16; ++i) if (i < t) { const float n_ti = __builtin_bit_cast(float, __builtin_amdgcn_readlane(__builtin_bit_cast(int, nm[t & 3]), i + 16 * (t >> 2))); s_ -= n_ti * col[i]; }
            col[t] = s_; TT[t * 16 + fr] = (bf16)f2bf(s_); }
    }
    LDS_WAIT(); asm volatile("" ::: "memory");
    f32x4 WTc[4], RqT[4], U0c[4], Y0c[4];
    {   const bf16x8 aT = frag_lo(*(const LAS u32x2*)(TT + fr * 16 + 4 * fq)), aKK = frag_lo(*(const LAS u32x2*)(AKK + fr * 16 + 4 * fq)), aRK = frag_lo(*(const LAS u32x2*)(ARK + fr * 16 + 4 * fq));
        u32x2 nb = *(const LAS u32x2*)(ARB + fr * 16 + 4 * fq); nb.x ^= 0x80008000u; nb.y ^= 0x80008000u; const bf16x8 aRBn = frag_lo(nb);
        const f32x4 z4 = {0.f, 0.f, 0.f, 0.f};
#pragma unroll
        for (int nt = 0; nt < 4; ++nt) { const int o = (16 * nt + fr) * 16 + 4 * fq;
            const bf16x8 bK = frag_lo(*(const LAS u32x2*)(KTt + o)), bV = frag_lo(*(const LAS u32x2*)(Vt + o));
            float ri[4]; unpack4(*(const LAS u32x2*)(TR + fr * 64 + 16 * nt + 4 * fq), ri);
            const f32x4 Wn = MFMA16(aT, bK, z4); WTc[nt] = MFMA16(bK, aT, z4);
            const f32x4 Zn = MFMA16(aKK, bV, z4);
            U0c[nt] = MFMA16(aT, frag_c(Zn), z4);
            RqT[nt] = MFMA16(frag_c(Wn), aRBn, ((f32x4){ri[0], ri[1], ri[2], ri[3]}));
            Y0c[nt] = MFMA16(aRK, bV, z4); Y0c[nt] = MFMA16(aRBn, frag_c(U0c[nt]), Y0c[nt]); }
    }
    LDS_WAIT(); asm volatile("" ::: "memory");
#pragma unroll
    for (int nt = 0; nt < 4; ++nt) { const u32x2 vv = *(const LAS u32x2*)(Vt + (16 * nt + fr) * 16 + 4 * fq);
        *(u32x2*)(blob + 8192 + nt * 2048 + 1024 + lane * 8) = vv;
        u32x2 u0 = {pk2(U0c[nt][0], U0c[nt][1]), pk2(U0c[nt][2], U0c[nt][3])}, y0 = {pk2(Y0c[nt][0], Y0c[nt][1]), pk2(Y0c[nt][2], Y0c[nt][3])};
        *(u32x2*)(blob + 8192 + nt * 2048 + lane * 8) = u0; *(u32x2*)(blob + 8192 + nt * 2048 + 512 + lane * 8) = y0;
        *(float*)(blob + 8192 + nt * 2048 + 1536 + lane * 4) = pc; }
#pragma unroll
    for (int s = 0; s < 2; ++s) {
        *(u32x4*)(blob + (0 * 2 + s) * 1024 + lane * 16) = (u32x4){pk2(WTc[2 * s][0], WTc[2 * s][1]), pk2(WTc[2 * s][2], WTc[2 * s][3]), pk2(WTc[2 * s + 1][0], WTc[2 * s + 1][1]), pk2(WTc[2 * s + 1][2], WTc[2 * s + 1][3])};
        *(u32x4*)(blob + (1 * 2 + s) * 1024 + lane * 16) = (u32x4){pk2(RqT[2 * s][0], RqT[2 * s][1]), pk2(RqT[2 * s][2], RqT[2 * s][3]), pk2(RqT[2 * s + 1][0], RqT[2 * s + 1][1]), pk2(RqT[2 * s + 1][2], RqT[2 * s + 1][3])}; }
    LAS bf16* BHt = TKt; LAS bf16* KHt = TB;
    {   u32x4 a, c, d, e;
        a = (u32x4){pk2(bh[0], bh[1]), pk2(bh[2], bh[3]), pk2(bh[4], bh[5]), pk2(bh[6], bh[7])}; c = (u32x4){pk2(bh[8], bh[9]), pk2(bh[10], bh[11]), pk2(bh[12], bh[13]), pk2(bh[14], bh[15])};
        d = (u32x4){pk2(kh[0], kh[1]), pk2(kh[2], kh[3]), pk2(kh[4], kh[5]), pk2(kh[6], kh[7])}; e = (u32x4){pk2(kh[8], kh[9]), pk2(kh[10], kh[11]), pk2(kh[12], kh[13]), pk2(kh[14], kh[15])};
        *(LAS u32x4*)(BHt + lane * 16) = a; *(LAS u32x4*)(BHt + lane * 16 + 8) = c; *(LAS u32x4*)(KHt + lane * 16) = d; *(LAS u32x4*)(KHt + lane * 16 + 8) = e; }
    LDS_WAIT(); asm volatile("" ::: "memory");
#pragma unroll
    for (int mt = 0; mt < 4; ++mt) { const int o = (16 * mt + fr) * 16 + 4 * fq; const u32x2 bb = *(const LAS u32x2*)(BHt + o), kk = *(const LAS u32x2*)(KHt + o);
        *(u32x4*)(blob + 4096 + mt * 1024 + lane * 16) = (u32x4){bb.x ^ 0x80008000u, bb.y ^ 0x80008000u, kk.x, kk.y}; }
    LDS_WAIT(); asm volatile("" ::: "memory");
}

__device__ __forceinline__ void pre_phase(const Frame& F0, int seg, int b_lo) {
    const Frame F = phase_frame(F0); unsigned char* const ws = F.ws;
    if ((int)blockIdx.x < b_lo) return;
    const int nwv = (F.G - b_lo) * NWAVES;
    PreRegs R;
    int it = ((int)blockIdx.x - b_lo) * NWAVES + F.wave; if (it >= 32 * SEGCH) return;
    pre_load(R, ws, it & 31, seg * SEGCH + (it >> 5), F.lane);
    for (; it < 32 * SEGCH; it += nwv) { const int nx = it + nwv; const bool hn = nx < 32 * SEGCH;
        pre_item<0>(F, ws, it & 31, seg * SEGCH + (it >> 5), blob_ptr(ws, seg, it & 31, it >> 5), R, hn ? (nx & 31) : -1, seg * SEGCH + (nx >> 5)); }
}

constexpr int SQ_SLOT = 10240, SQ_R = 12, SQ_D = 8;
template <int MODE>
__device__ __forceinline__ void seq_item(const Frame& F0, int item, int seg, bool need_ctx) {
    const Frame F = phase_frame(F0); unsigned char* const ws = F.ws;
    const int scan = item >> 2, vb = item & 3, dir = scan & 1, h = (scan >> 1) & 7, b = scan >> 4; const int lane = F.lane, fr = lane & 15, fq = lane >> 4, w = F.wave;
    const unsigned char* blob = blob_ptr(ws, seg, scan, 0);
    LAS unsigned char* ring = F.lds;
    __syncthreads();
    const int p0 = 2 * (w - 1);
    const unsigned goff0 = (p0 < 8 ? p0 * 1024 : 8192 + vb * 2048 + (p0 - 8) * 1024) + lane * 16, goff1 = (p0 + 1 < 8 ? (p0 + 1) * 1024 : 8192 + vb * 2048 + (p0 + 1 - 8) * 1024) + lane * 16;
#define SQ_ISSUE(c) do { const unsigned char* g_ = blob + (size_t)(c) * BLOB; LAS unsigned char* s_ = ring + ((c) % SQ_R) * SQ_SLOT + p0 * 1024; \
        __builtin_amdgcn_global_load_lds((const unsigned*)(g_ + goff0), (LAS unsigned*)(s_), 16, 0, 0); \
        __builtin_amdgcn_global_load_lds((const unsigned*)(g_ + goff1), (LAS unsigned*)(s_ + 1024), 16, 0, 0); } while (0)
    const bool loader = (w >= 1 && w <= 5) && MODE != 2;
    if (loader) { for (int c = 0; c < SQ_D; ++c) SQ_ISSUE(c); }
    bf16* Y = (bf16*)(ws + WS_Y) + (size_t)dir * NROW * DR + h * 64 + 16 * vb + fr;
    float* st = (float*)(ws + WS_SCANST) + (size_t)item * 1024 + lane * 4;
    f32x4 M[4];
#pragma unroll
    for (int mt = 0; mt < 4; ++mt) M[mt] = (seg == 0 || w != 0) ? (f32x4){0.f, 0.f, 0.f, 0.f} : *(const f32x4*)(st + mt * 256);
    const f32x4 z4 = {0.f, 0.f, 0.f, 0.f};
    LAS unsigned char* mb = ring + SQ_R * SQ_SLOT;
    struct SQ { bf16x8 a1[2], a2[4]; f32x4 pc[4]; u32x2 u0, vv; };
#define SQ_READ(R, c) do { const LAS unsigned char* sl_ = ring + ((c) % SQ_R) * SQ_SLOT; _Pragma("unroll") for (int i = 0; i < 4; ++i) { \
        R.a2[i] = *(const LAS bf16x8*)(sl_ + 4096 + i * 1024 + lane * 16); R.pc[i] = *(const LAS f32x4*)(sl_ + 8192 + 1536 + (16 * i + 4 * fq) * 4); } \
        R.a1[0] = *(const LAS bf16x8*)(sl_ + lane * 16); R.a1[1] = *(const LAS bf16x8*)(sl_ + 1024 + lane * 16); \
        R.u0 = *(const LAS u32x2*)(sl_ + 8192 + lane * 8); R.vv = *(const LAS u32x2*)(sl_ + 8192 + 1024 + lane * 8); } while (0)
#define SQ_STEP(R, c, RN, cn) do { \
        if ((cn) < SEGCH) SQ_READ(RN, cn); \
        const u32x4 t0 = {pk2(M[0][0], M[0][1]), pk2(M[0][2], M[0][3]), pk2(M[1][0], M[1][1]), pk2(M[1][2], M[1][3])}; \
        const u32x4 t1 = {pk2(M[2][0], M[2][1]), pk2(M[2][2], M[2][3]), pk2(M[3][0], M[3][1]), pk2(M[3][2], M[3][3])}; \
        *(LAS u32x4*)(mb + ((c) & 1) * 2048 + lane * 16) = t0; *(LAS u32x4*)(mb + ((c) & 1) * 2048 + 1024 + lane * 16) = t1; \
        const bf16x8 b0 = __builtin_bit_cast(bf16x8, t0), b1 = __builtin_bit_cast(bf16x8, t1); \
        f32x4 X0 = MFMA16(R.a1[0], b0, z4); X0 = MFMA16(R.a1[1], b1, X0); \
        float u0[4]; unpack4(R.u0, u0); \
        const u32x4 tb = {pk2(X0[0] + u0[0], X0[1] + u0[1]), pk2(X0[2] + u0[2], X0[3] + u0[3]), R.vv.x, R.vv.y}; const bf16x8 bB = __builtin_bit_cast(bf16x8, tb); \
        _Pragma("unroll") for (int mt = 0; mt < 4; ++mt) M[mt] = MFMA16(R.a2[mt], bB, R.pc[mt] * M[mt]); \
        asm volatile("s_waitcnt lgkmcnt(0)" ::: "memory"); } while (0)
    const long ystep = dir ? -(long)DR : (long)DR;
#define SQ_YSTEP(c) do { const int cs_ = seg * SEGCH + (c); if (MODE == 0 && (need_ctx || cs_ >= 16)) { const LAS unsigned char* sl_ = ring + ((c) % SQ_R) * SQ_SLOT; \
        const bf16x8 q0 = *(const LAS bf16x8*)(sl_ + 2048 + lane * 16), q1 = *(const LAS bf16x8*)(sl_ + 3072 + lane * 16); \
        const bf16x8 b0 = *(const LAS bf16x8*)(mb + ((c) & 1) * 2048 + lane * 16), b1 = *(const LAS bf16x8*)(mb + ((c) & 1) * 2048 + 1024 + lane * 16); \
        float y0[4]; unpack4(*(const LAS u32x2*)(sl_ + 8192 + 512 + lane * 8), y0); \
        f32x4 X1 = MFMA16(q0, b0, z4); X1 = MFMA16(q1, b1, X1); \
        bf16* yp = Y + (size_t)scan_rowof(16 * cs_ + 4 * fq, dir, b) * DR; \
        yp[0] = (bf16)f2bf(X1[0] + y0[0]); yp[ystep] = (bf16)f2bf(X1[1] + y0[1]); yp[2 * ystep] = (bf16)f2bf(X1[2] + y0[2]); yp[3 * ystep] = (bf16)f2bf(X1[3] + y0[3]); \
        asm volatile("s_waitcnt lgkmcnt(0)" ::: "memory"); } } while (0)
#define SQ_LOADER(c) do { if (loader) { if ((c) + SQ_D < SEGCH) { SQ_ISSUE((c) + SQ_D); asm volatile("s_waitcnt vmcnt(12)" ::: "memory"); } else asm volatile("s_waitcnt vmcnt(0)" ::: "memory"); } \
        __builtin_amdgcn_s_barrier(); asm volatile("" ::: "memory"); } while (0)
    const bool stw = (w == 0 && MODE != 1), yw = (w == 6 && MODE != 1);
    SQ Ra, Rb, Rc;
    SQ_LOADER(0);
    if (stw) { SQ_READ(Ra, 0); SQ_READ(Rb, 1); }
    for (int c = 0; c < SEGCH; c += 3) {
        SQ_LOADER(c + 1);
        if (stw) SQ_STEP(Ra, c, Rc, c + 2);
        if (yw && c > 0) SQ_YSTEP(c - 1);
        SQ_LOADER(c + 2);
        if (stw) SQ_STEP(Rb, c + 1, Ra, c + 3);
        if (yw) SQ_YSTEP(c);
        SQ_LOADER(c + 3);
        if (stw) SQ_STEP(Rc, c + 2, Rb, c + 4);
        if (yw) SQ_YSTEP(c + 1);
    }
    __builtin_amdgcn_s_barrier(); asm volatile("" ::: "memory");
    if (yw) SQ_YSTEP(SEGCH - 1);
#undef SQ_READ
#undef SQ_STEP
#undef SQ_YSTEP
#undef SQ_LOADER
#undef SQ_ISSUE
    if (MODE >= 2 && w == 0 && M[0][0] + M[1][1] + M[2][2] + M[3][3] == 12345.678f) st[0] = M[0][0];
    if (MODE == 0 && w == 0 && seg + 1 < NSEG) {
#pragma unroll
        for (int mt = 0; mt < 4; ++mt) *(f32x4*)(st + mt * 256) = M[mt]; }
    __syncthreads();
}

namespace pg8 {
struct EpiStoreBf16 {
    static constexpr bool PERM = true, AFTER_DRAIN = false;
    bf16_t* O; int ldc; int pn_mask;
    __device__ __forceinline__ void operator()(const f32x4 (&acc)[2][2][4][2], const Unit& u, int wr, int wc, int fr, int fq) const {
        const int row0 = u.pm * BM + wr * 64 + fr; const int col0 = (u.pn & pn_mask) * BM + wc * 32 + 8 * fq;
#pragma unroll
        for (int ai = 0; ai < 2; ++ai)
#pragma unroll
            for (int m = 0; m < 4; ++m) { bf16_t* rowp = O + (size_t)(row0 + ai * HALF + m * 16) * ldc + col0;
#pragma unroll
                for (int bj = 0; bj < 2; ++bj) { const f32x4 v0 = acc[ai][bj][m][0], v1 = acc[ai][bj][m][1];
                    u32x4 w; w.x = cvt_pk_bf16(v0[0], v0[1]); w.y = cvt_pk_bf16(v0[2], v0[3]); w.z = cvt_pk_bf16(v1[0], v1[1]); w.w = cvt_pk_bf16(v1[2], v1[3]);
                    *(u32x4*)(rowp + bj * HALF) = w; } }
    }
};
struct EpiSwiGLU {
    static constexpr bool PERM = true, AFTER_DRAIN = false;
    bf16_t* O;
    __device__ __forceinline__ void operator()(const f32x4 (&acc)[2][2][4][2], const Unit& u, int wr, int wc, int fr, int fq) const {
        const int row0 = u.pm * BM + wr * 64 + fr; const int col0 = ((u.pn & 3) * BM + wc * 32 + 8 * fq) >> 1;
#pragma unroll
        for (int ai = 0; ai < 2; ++ai)
#pragma unroll
            for (int m = 0; m < 4; ++m) { bf16_t* rowp = O + (size_t)(row0 + ai * HALF + m * 16) * 512 + col0;
#pragma unroll
                for (int bj = 0; bj < 2; ++bj) { const f32x4 g = acc[ai][bj][m][0], up = acc[ai][bj][m][1]; float a[4];
#pragma unroll
                    for (int i = 0; i < 4; ++i) a[i] = g[i] / (1.f + __expf(-g[i])) * up[i];
                    unsigned long long w = (unsigned long long)cvt_pk_bf16(a[0], a[1]) | ((unsigned long long)cvt_pk_bf16(a[2], a[3]) << 32);
                    *(unsigned long long*)(rowp + bj * (HALF / 2)) = w; } }
    }
};
template <bool XF32> struct EpiResidual {
    static constexpr bool PERM = false, AFTER_DRAIN = false;
    const void* xlat; const void* xctx;
    bf16_t* out; const float* g1;
    __device__ __forceinline__ void operator()(const f32x4 (&acc)[2][2][4][2], const Unit& u, int wr, int wc, int fr, int fq) const {
        const int rowt = u.pm * BM; const int mr = rowt < 16384 ? (rowt >> 13) : 2;
        const size_t boff = rowt < 16384 ? (size_t)rowt * 1024 : (size_t)(rowt - 16384) * 1024; const void* bp = rowt < 16384 ? xlat : xctx;
        const int col0 = u.pn * BM + wc * 32 + 4 * fq;
        f32x4 gv[2][2];
#pragma unroll
        for (int bj = 0; bj < 2; ++bj)
#pragma unroll
            for (int n = 0; n < 2; ++n) gv[bj][n] = *(const f32x4*)(g1 + (size_t)mr * 6144 + col0 + bj * HALF + n * 16);
#pragma unroll
        for (int ai = 0; ai < 2; ++ai)
#pragma unroll
            for (int m = 0; m < 4; ++m) { const int rl = ai * HALF + wr * 64 + m * 16 + fr;
#pragma unroll
                for (int bj = 0; bj < 2; ++bj)
#pragma unroll
                    for (int n = 0; n < 2; ++n) { const size_t off = (size_t)rl * 1024 + col0 + bj * HALF + n * 16;
                        f32x4 xo;
                        if (XF32) xo = *(const f32x4*)((const float*)bp + boff + off);
                        else { const unsigned long long w_ = *(const unsigned long long*)((const bf16_t*)bp + boff + off); const unsigned lo = (unsigned)w_, hi = (unsigned)(w_ >> 32);
                            xo = (f32x4){__uint_as_float(lo << 16), __uint_as_float(lo & 0xffff0000u), __uint_as_float(hi << 16), __uint_as_float(hi & 0xffff0000u)}; }
                        const f32x4 r = xo + gv[bj][n] * acc[ai][bj][m][n];
                        *(unsigned long long*)(out + (size_t)rowt * 1024 + off) = (unsigned long long)cvt_pk_bf16(r[0], r[1]) | ((unsigned long long)cvt_pk_bf16(r[2], r[3]) << 32); } }
    }
};
struct MoeOrder {
    const PG8_LAS int* tile_e; const PG8_LAS int* tile_t; int ntiles, G, c;
    __device__ bool next(int i, Unit& u) const { const long L = (long)i * G + c; if (L >= 4L * ntiles) return false; const int pm = (int)(L >> 2); const int e = tile_e[pm];
        u.pm = pm; u.pn = e * 4 + (int)(L & 3); u.ga = e * 16896 + tile_t[pm] * 256; return true; }
    __device__ __forceinline__ void a_ready(const Unit&) const {}
    __device__ __forceinline__ void done(const Unit&) const {}
};
}

__device__ __forceinline__ void expert_convert(const Frame& F0, int l, int b_lo) {
    const Frame F = phase_frame(F0); unsigned char* const ws = F.ws;
    if ((int)blockIdx.x < b_lo) return;
    const int nwv = (F.G - b_lo) * NWAVES, myw = ((int)blockIdx.x - b_lo) * NWAVES + F.wave;
    LAS float* scr = (LAS float*)(F.lds + F.wave * 16384);
    bf16* wgu = (bf16*)(ws + WS_WGU_T); bf16* wd = (bf16*)(ws + WS_WD_T);
    constexpr int I_G = 16 * 16, I_D = 8 * 32;
    constexpr int NIT = NEXP * (2 * I_G + I_D);
    const float* p_eg = inptr(I_EG); const float* p_eu = inptr(I_EU); const float* p_ed = inptr(I_ED);
    for (int it = myw; it < NIT; it += nwv) { const int e = it / (2 * I_G + I_D); int r = it % (2 * I_G + I_D);
        if (r < I_G) { transpose_item(p_eg + ((size_t)l * NEXP + e) * D * DEXP, DEXP, (r >> 4) * 64, (r & 15) * 32, wgu, D, RmGU{e * 1024}, scr, F.lane); continue; } r -= I_G;
        if (r < I_G) { transpose_item(p_eu + ((size_t)l * NEXP + e) * D * DEXP, DEXP, (r >> 4) * 64, (r & 15) * 32, wgu, D, RmGU{e * 1024 + 4}, scr, F.lane); continue; } r -= I_G;
        transpose_item(p_ed + ((size_t)l * NEXP + e) * DEXP * D, D, (r >> 5) * 64, (r & 31) * 32, wd, DEXP, RmId{e * 1024}, scr, F.lane);
    }
}

__device__ __forceinline__ void router_pass(const Frame& F0, int l, int nrows, int cnt_off = 0) {
    const Frame F = phase_frame(F0); unsigned char* const ws = F.ws;
    constexpr int HP = 1028;
    LAS float* msh = (LAS float*)F.lds; LAS float* msc = msh + 3072; LAS float* hrow = msc + 3072;
    LAS float* part = hrow + 16 * HP;
    LAS float* lgs = part + 8 * 16 * 48;
    LAS unsigned* lcnt = (LAS unsigned*)(lgs + 16 * 40);
    if (F0.tid < 64) lcnt[F0.tid] = 0u;
    __syncthreads();
    mod_to_lds(F, l, 3, msh, false); mod_to_lds(F, l, 4, msc, false); __syncthreads();
    const bf16* X = (const bf16*)(ws + WS_X); bf16* H = (bf16*)(ws + WS_H);
    const float* rgw = inptr(I_RGW) + (size_t)l * D * 4; const float* rew = inptr(I_REW) + (size_t)l * D * NEXP;
    const float* rgb = inptr(I_RGB) + l * 4; const float* reb = inptr(I_REB) + l * NEXP;
    int* rt_e = (int*)(ws + WS_ROUTE + RT_E); int* rt_pos = (int*)(ws + WS_ROUTE + RT_POS); float* rt_gate = (float*)(ws + WS_ROUTE + RT_GATE);
    unsigned* cnt = (unsigned*)(ws + WS_CTL) + CW_CNT + 64 * l + cnt_off;
    const int lane = F.lane, w = F.wave, fr = lane & 15, fq = lane >> 4; const float* n2g = inptr(I_N2G) + l * D;
    float bw[32][3];
#pragma unroll
    for (int ks = 0; ks < 32; ++ks) { const int k = 128 * w + 4 * ks + fq;
        bw[ks][0] = rew[(size_t)k * 32 + fr]; bw[ks][1] = rew[(size_t)k * 32 + 16 + fr]; bw[ks][2] = fr < 4 ? rgw[(size_t)k * 4 + fr] : 0.f; }
    const int ntiles = nrows >> 4;
    u32x2 pv[2][4];
    if (F.vcu < ntiles) {
#pragma unroll
        for (int rr = 0; rr < 2; ++rr)
#pragma unroll
            for (int j = 0; j < 4; ++j) pv[rr][j] = *(const u32x2*)(X + (size_t)(F.vcu * 16 + 2 * w + rr) * D + 4 * lane + 256 * j); }
    for (int gi = F.vcu; gi < ntiles; gi += F.G) {
#pragma unroll
        for (int rr = 0; rr < 2; ++rr) { const int r = 2 * w + rr, row = gi * 16 + r; f32x4 v[4];
#pragma unroll
            for (int j = 0; j < 4; ++j) { float t_[4]; unpack4(pv[rr][j], t_); v[j] = (f32x4){t_[0], t_[1], t_[2], t_[3]}; }
            const int mr = modrow(row);
            norm_mod_row(v, n2g, msc + mr * 1024, msh + mr * 1024, H + (size_t)row * D, lane);
#pragma unroll
            for (int j = 0; j < 4; ++j) *(LAS f32x4*)(hrow + r * HP + 4 * lane + 256 * j) = v[j]; }
        if (gi + F.G < ntiles) {
#pragma unroll
            for (int rr = 0; rr < 2; ++rr)
#pragma unroll
                for (int j = 0; j < 4; ++j) pv[rr][j] = *(const u32x2*)(X + (size_t)((gi + F.G) * 16 + 2 * w + rr) * D + 4 * lane + 256 * j); }
        __syncthreads();
        {   f32x4 acc[3] = {{0.f, 0.f, 0.f, 0.f}, {0.f, 0.f, 0.f, 0.f}, {0.f, 0.f, 0.f, 0.f}};
#pragma unroll
            for (int ks = 0; ks < 32; ++ks) { const float a = hrow[fr * HP + 128 * w + 4 * ks + fq];
#pragma unroll
                for (int nt = 0; nt < 3; ++nt) acc[nt] = __builtin_amdgcn_mfma_f32_16x16x4f32(a, bw[ks][nt], acc[nt], 0, 0, 0); }
#pragma unroll
            for (int nt = 0; nt < 3; ++nt)
#pragma unroll
                for (int reg = 0; reg < 4; ++reg) part[(w * 16 + 4 * fq + reg) * 48 + 16 * nt + fr] = acc[nt][reg]; }
        __syncthreads();
        for (int idx = F.tid; idx < 16 * 36; idx += NTHR) { const int r = idx / 36, n = idx % 36; float s_ = 0.f;
#pragma unroll
            for (int ww = 0; ww < 8; ++ww) s_ += part[(ww * 16 + r) * 48 + n];
            if (n < 32) lgs[r * 40 + 4 + n] = s_ + reb[n]; else lgs[r * 40 + n - 32] = s_ + rgb[n - 32]; }
        __syncthreads();
        if (F.tid < 16) { const int rr = gi * 16 + F.tid; const LAS float* lp = lgs + F.tid * 40;
            int grp = 0; float mx = lp[0];
#pragma unroll
            for (int g = 1; g < 4; ++g) if (lp[g] > mx) { mx = lp[g]; grp = g; }
            float den = 0.f;
#pragma unroll
            for (int g = 0; g < 4; ++g) den += __expf(lp[g] - mx);
            const float pg_top = 1.f / den; const LAS float* sel = lp + 4 + grp * 8;
            int i0 = 0; float l0 = sel[0];
#pragma unroll
            for (int q = 1; q < 8; ++q) if (sel[q] > l0) { l0 = sel[q]; i0 = q; }
            int i1 = -1; float l1 = -3.0e38f;
#pragma unroll
            for (int q = 0; q < 8; ++q) if (q != i0 && sel[q] > l1) { l1 = sel[q]; i1 = q; }
            const float e1 = __expf(l1 - l0); const float w0 = pg_top / (1.f + e1), w1 = pg_top * e1 / (1.f + e1);
            const int ea = grp * 8 + i0, eb = grp * 8 + i1;
            const unsigned pa = atomicAdd((unsigned*)(lcnt + ea), 1u), pb = atomicAdd((unsigned*)(lcnt + eb), 1u);
            rt_e[2 * rr] = ea; rt_e[2 * rr + 1] = eb; rt_pos[2 * rr] = (int)pa; rt_pos[2 * rr + 1] = (int)pb; rt_gate[2 * rr] = w0; rt_gate[2 * rr + 1] = w1; }
    }
    __syncthreads();
    if (F.tid < 32) lcnt[32 + F.tid] = lcnt[F.tid] ? atomicAdd(cnt + F.tid, lcnt[F.tid]) : 0u;
    __syncthreads();
    int* elist = (int*)(ws + WS_ELIST);
    if (F.tid < 16) for (int gi = F.vcu; gi < ntiles; gi += F.G) { const int rr = gi * 16 + F.tid;
        const int ea = rt_e[2 * rr], eb = rt_e[2 * rr + 1]; const int pa = rt_pos[2 * rr] + (int)lcnt[32 + ea], pb = rt_pos[2 * rr + 1] + (int)lcnt[32 + eb];
        rt_pos[2 * rr] = pa; rt_pos[2 * rr + 1] = pb; elist[(size_t)ea * NROW + pa] = rr; elist[(size_t)eb * NROW + pb] = rr; }
}

constexpr int MOE_MAP_OFF = 131072;
__device__ __forceinline__ void moe_map(const Frame& F0, int l) {
    const Frame F = phase_frame(F0); unsigned char* const ws = F.ws;
    LAS int* mp = (LAS int*)(F.lds + MOE_MAP_OFF);
    const unsigned* cnt = (const unsigned*)(ws + WS_CTL) + CW_CNT + 64 * l;
    __syncthreads();
    if (F.tid < NEXP) mp[32 + F.tid] = (int)__hip_atomic_load(cnt + F.tid, __ATOMIC_RELAXED, __HIP_MEMORY_SCOPE_AGENT);
    __syncthreads();
    if (F.tid == 0) { int o = 0;
#pragma nounroll
        for (int e = 0; e < NEXP; ++e) { const int c = mp[32 + e]; const int nt = (c + 255) >> 8; mp[e] = o;
#pragma nounroll
            for (int t = 0; t < nt; ++t) { mp[128 + (o >> 8) + t] = e; mp[320 + (o >> 8) + t] = t; }
            o += nt << 8; }
        mp[64] = o >> 8; }
    __syncthreads();
}

template <bool DRY>
__device__ __forceinline__ void combine_pass(const Frame& F0, int l, int nrows) {
    const Frame F = phase_frame(F0); unsigned char* const ws = F.ws;
    LAS float* mg2 = (LAS float*)F.lds; LAS float* msh = mg2 + 3072; LAS float* msc = msh + 3072;
    const bool last = (l == DEPTH - 1);
    __syncthreads();
    mod_to_lds(F, l, 5, mg2, false); if (!last) { mod_to_lds(F, l + 1, 0, msh, false); mod_to_lds(F, l + 1, 1, msc, false); }
    __syncthreads();
    bf16* X = (bf16*)(ws + WS_X); bf16* H = (bf16*)(ws + WS_H); const bf16* Ys = (const bf16*)(ws + WS_XS);
    const int* rt_e = (const int*)(ws + WS_ROUTE + RT_E); const int* rt_pos = (const int*)(ws + WS_ROUTE + RT_POS); const float* rt_gate = (const float*)(ws + WS_ROUTE + RT_GATE);
    const LAS int* moff = (const LAS int*)(F.lds + MOE_MAP_OFF);
    const int lane = F.lane; const float* n1g = inptr(I_N1G) + (last ? 0 : (l + 1) * D); const float* fgp = inptr(I_FG);
    for (int row0 = F.gw; row0 < nrows; row0 += 2 * F.NGW) {
        int s0[2], s1[2]; float w0[2], w1[2]; bool ok[2]; u32x2 ya[2][4], yb[2][4], xo[2][4];
#pragma unroll
        for (int u = 0; u < 2; ++u) { const int row = row0 + u * F.NGW; ok[u] = row < nrows; if (ok[u]) { s0[u] = moff[rt_e[2 * row]] + rt_pos[2 * row]; s1[u] = moff[rt_e[2 * row + 1]] + rt_pos[2 * row + 1]; w0[u] = rt_gate[2 * row]; w1[u] = rt_gate[2 * row + 1]; } }
#pragma unroll
        for (int u = 0; u < 2; ++u) if (ok[u]) { const int row = row0 + u * F.NGW;
#pragma unroll
            for (int j = 0; j < 4; ++j) { const int c = 4 * lane + 256 * j; ya[u][j] = *(const u32x2*)(Ys + (size_t)s0[u] * D + c); yb[u][j] = *(const u32x2*)(Ys + (size_t)s1[u] * D + c); xo[u][j] = *(const u32x2*)(X + (size_t)row * D + c); } }
#pragma unroll
        for (int u = 0; u < 2; ++u) if (ok[u]) { const int row = row0 + u * F.NGW; const int mr = modrow(row); f32x4 v[4];
#pragma unroll
            for (int j = 0; j < 4; ++j) { const int c = 4 * lane + 256 * j; float a[4], b[4]; unpack4(ya[u][j], a); unpack4(yb[u][j], b);
                const f32x4 g2 = *(const LAS f32x4*)(mg2 + mr * 1024 + c);
                f32x4 y; y.x = w0[u] * a[0] + w1[u] * b[0]; y.y = w0[u] * a[1] + w1[u] * b[1]; y.z = w0[u] * a[2] + w1[u] * b[2]; y.w = w0[u] * a[3] + w1[u] * b[3];
                float x_[4]; unpack4(xo[u][j], x_); v[j] = (f32x4){x_[0], x_[1], x_[2], x_[3]} + g2 * y; }
            if (DRY) { asm volatile("" :: "v"(v[0].x + v[1].y + v[2].z + v[3].w)); }
            else if (!last) {
#pragma unroll
                for (int j = 0; j < 4; ++j) *(u32x2*)(X + (size_t)row * D + 4 * lane + 256 * j) = (u32x2){pk2(v[j].x, v[j].y), pk2(v[j].z, v[j].w)};
                norm_mod_row(v, n1g, msc + mr * 1024, msh + mr * 1024, H + (size_t)row * D, lane);
            } else { float s = 0.f;
#pragma unroll
                for (int j = 0; j < 4; ++j) s += (v[j].x * v[j].x + v[j].y * v[j].y) + (v[j].z * v[j].z + v[j].w * v[j].w);
                const float rs = rsqrtf(wave_sum(s) * (1.f / D) + RMS_EPS);
#pragma unroll
                for (int j = 0; j < 4; ++j) { const int c = 4 * lane + 256 * j; const f32x4 g = *(const f32x4*)(fgp + c); *(f32x4*)(F.out + (size_t)row * D + c) = v[j] * rs * g; } } }
    }
}
__global__ void __launch_bounds__(NTHR, 2) fwd_megakernel(Params prm) {
    extern __shared__ __attribute__((aligned(16))) unsigned char lds_raw[];
    Frame F;
    F.lds = (LAS unsigned char*)lds_raw;
    F.tid = threadIdx.x; F.lane = F.tid & 63; F.wave = __builtin_amdgcn_readfirstlane(F.tid >> 6);
    F.G = gridDim.x; { const int bx = blockIdx.x; F.vcu = (F.G % 8 == 0) ? (bx % 8) * (F.G / 8) + bx / 8 : bx; }
    F.gw = F.vcu * NWAVES + F.wave; F.NGW = F.G * NWAVES;
    F.out = prm.out; F.ws = prm.ws;
    for (int u = F.tid; u < (LDS_BYTES - LDSCTL_OFF) / 4; u += NTHR) ((LAS unsigned*)(F.lds + LDSCTL_OFF))[u] = 0u;
    __syncthreads();
    (void)xcd_barrier_post((unsigned*)(F.ws + WS_CTL) + CW_BAR, (volatile LAS unsigned*)(F.lds + MISC_OFF) + 8);
#define GRID_BAR() do { XcdBarrier bar_; bar_.bar = (unsigned*)(opaque(F.ws) + WS_CTL) + CW_BAR; bar_.x = xb_xcc_id(); bar_.st = (volatile LAS unsigned*)(F.lds + MISC_OFF) + 8; xcd_barrier(bar_); } while (0)

    p0_prologue(F);
#if USE_CG_SYNC
    cg::this_grid().sync();
#else
    GRID_BAR();
#endif
    p0b_norm1(F);
    GRID_BAR();

    for (int l = 0; l < DEPTH; ++l) {
        const bool need_ctx = (l == 0); const int nrows = need_ctx ? NROW : NLAT;
#define WSO Fp.ws
        {
            const Frame Fp = phase_frame(F); unsigned char* const ws = WSO; bf16* Hb = (bf16*)(ws + WS_H); bf16* Pb = (bf16*)(ws + WS_P);
            pg8::Gemm g{Hb, (const bf16*)(ws + WS_WIN_T) + (size_t)l * NP * D, NROW, NP, D}; pg8::StaticOrder S; S.init(NROW, NP, Fp.G, (int)blockIdx.x);
            pg8::EpiStoreBf16 E{Pb, NP, 0xffff};
            pg8::gemm_phase<pg8::EpiStoreBf16, pg8::StaticOrder, true, true>(F.lds, g, S, E);
        }
        GRID_BAR();
        {
            const Frame Fp = phase_frame(F); unsigned char* const ws = WSO; bf16* Pb = (bf16*)(ws + WS_P);
            for (int it = blockIdx.x; it < 256; it += F.G) fftA_item(F, it);
            if (need_ctx) for (int it = (int)blockIdx.x - (F.G >= 64 ? F.G - 32 : 0); it >= 0 && it < 32; it += F.G) { const int b = it >> 4, m0 = (it & 15) * 16;
                const bf16* src0 = Pb + (size_t)(NLAT + b * CTXL) * NP + COL_FC;
                dft64_item<4, 256, 1>(F, l, m0, -1.f, 1.f / 128.f, [=](int t, int ri) { return src0 + (size_t)t * NP + ri * 256; }, [=](int m) { return NLAT + b * CTXL + m; }); }
            shift_pass(F, l);
            conv_pass(F, l, nrows);
        }
        GRID_BAR();
        {
            const Frame Fp = phase_frame(F); unsigned char* const ws = WSO;
            prep_phase(F, l);
        }
        GRID_BAR();
        for (int seg = -1; seg < NSEG; ++seg) {
            const bool split = (F.G == 256);
            if (seg + 1 < NSEG) pre_phase(F, seg + 1, (seg >= 0 && split) ? 128 : 0);
            if (seg + 1 == NSEG && (!split || blockIdx.x >= 128)) { unsigned char* const ws = opaque(F.ws); int bx_ = (int)blockIdx.x; asm volatile("" : "+s"(bx_));
                const int first_ = split ? bx_ - 128 : bx_, stride_ = split ? 128 : F.G;
                for (int it = first_; it < 256; it += stride_) { const int b = it >> 7, t1p = it & 127;
                    const bf16* src0 = (const bf16*)(ws + WS_GT) + (size_t)(b * 128 + t1p) * 64 * 512;
                    dft64_item<1, 64, 4>(F, l, 0, 1.f, 0.0013810679320049757f, [=](int t, int ri) { return src0 + (size_t)t * 512 + ri * 256; }, [=](int m) { return b * SEQ + t1p + 128 * m; }); } }
            if (seg >= 0) for (int it = blockIdx.x; it < 128; it += F.G) { const int x_ = it & 7, j_ = it >> 3;
                seq_item<0>(F, ((x_ + 8 * (j_ >> 2)) << 2) | (j_ & 3), seg, need_ctx); }
            GRID_BAR();
        }
        readout_pass(F, l, nrows);
        GRID_BAR();
        const int cv_lo = (nrows / 256) * 4 > F.G ? (nrows / 256) * 4 - F.G : 0;
        if (blockIdx.x & 1) expert_convert(F, l, cv_lo);
        {
            const Frame Fp = phase_frame(F); unsigned char* const ws = WSO; bf16* Hb = (bf16*)(ws + WS_H);
            pg8::Gemm g{Hb, (const bf16*)(ws + WS_WOUT_T) + (size_t)l * D * D, nrows, D, D}; pg8::StaticOrder S; S.init(nrows, D, Fp.G, (int)blockIdx.x);
            bf16* X = (bf16*)(ws + WS_X); const float* g1p = (const float*)(ws + WS_MODF) + (size_t)l * 3 * 6144 + 2 * 1024;
            if (l == 0) { pg8::EpiResidual<true> E{inptr(I_X), inptr(I_CTX), X, g1p}; pg8::gemm_phase<pg8::EpiResidual<true>, pg8::StaticOrder, true, true>(F.lds, g, S, E); }
            else { pg8::EpiResidual<false> E{X, X + (size_t)NLAT * D, X, g1p}; pg8::gemm_phase<pg8::EpiResidual<false>, pg8::StaticOrder, true, true>(F.lds, g, S, E); }
        }
        if (!(blockIdx.x & 1)) expert_convert(F, l, cv_lo);
        GRID_BAR();
        router_pass(F, l, nrows);
        GRID_BAR();
        {
            const Frame Fp = phase_frame(F); unsigned char* const ws = WSO;
            moe_map(F, l);
            const LAS int* mp = (const LAS int*)(F.lds + MOE_MAP_OFF);
            pg8::MoeOrder S{mp + 128, mp + 320, mp[64], Fp.G, (int)blockIdx.x};
            {   pg8::Gemm g{(const bf16*)(ws + WS_H), (const bf16*)(ws + WS_WGU_T), 0, 0, D, (const int*)(ws + WS_ELIST), NROW - 1};
                pg8::EpiSwiGLU E{(bf16*)(ws + WS_ACT)};
                pg8::gemm_phase<pg8::EpiSwiGLU, pg8::MoeOrder, true, true, true>(F.lds, g, S, E); }
            GRID_BAR();
            {   pg8::Gemm g{(const bf16*)(ws + WS_ACT), (const bf16*)(ws + WS_WD_T), 0, 0, DEXP};
                pg8::EpiStoreBf16 E{(bf16*)(ws + WS_XS), D, 3};
                pg8::gemm_phase<pg8::EpiStoreBf16, pg8::MoeOrder, true, true>(F.lds, g, S, E); }
        }
        GRID_BAR();
        combine_pass<false>(F, l, nrows);
        if (l + 1 < DEPTH) GRID_BAR();
    }
}

extern "C" void kernel_launch(void* const* d_in, const int* in_sizes, int n_in, void* d_out, int out_size, void* d_ws, size_t ws_size, hipStream_t stream) {
    static int grid = 0;
    if (grid == 0) {
        if (n_in != N_IN || in_sizes[0] != NLAT * D || out_size != NLAT * D || ws_size < WS_END) {
            fprintf(stderr, "kernel_launch: unexpected shapes (n_in %d in0 %d out %d ws %zu)\n", n_in, n_in > 0 ? in_sizes[0] : -1, out_size, ws_size); grid = -1; return; }
        int dev = 0, cus = 0, per_cu = 0;
        hipGetDevice(&dev); hipDeviceGetAttribute(&cus, hipDeviceAttributeMultiprocessorCount, dev);
        hipFuncSetAttribute((const void*)fwd_megakernel, hipFuncAttributeMaxDynamicSharedMemorySize, LDS_BYTES);
        hipOccupancyMaxActiveBlocksPerMultiprocessor(&per_cu, (const void*)fwd_megakernel, NTHR, LDS_BYTES);
        if (per_cu < 1) { fprintf(stderr, "kernel_launch: occupancy query says %d blocks per CU\n", per_cu); per_cu = 1; }
        (void)hipGetLastError();
        grid = cus * per_cu;
    }
    if (grid < 0) return;
    hipMemsetAsync((char*)d_ws + WS_CTL, 0, CTL_ZERO_BYTES, stream);
    Params p{};
    for (int i = 0; i < N_IN; ++i) p.in[i] = (const float*)d_in[i];
    p.out = (float*)d_out; p.ws = (unsigned char*)d_ws;
    void* args[] = {&p};
    hipError_t e = hipLaunchCooperativeKernel((const void*)fwd_megakernel, dim3(grid), dim3(NTHR), args, LDS_BYTES, stream);
    if (e != hipSuccess) fprintf(stderr, "kernel_launch: cooperative launch failed: %s (grid %d)\n", hipGetErrorString(e), grid);
}
```

```cpp
#include <hip/hip_runtime.h>
#include <hip/hip_cooperative_groups.h>
#include <cstdio>
#include <cstdint>
namespace cg = cooperative_groups;
#define USE_CG_SYNC 0
#define SEQ_PROBE 0
#define SEQ_PROBE_PRE 0
namespace pg8 {
#define PG8_LAS __attribute__((address_space(3)))
typedef unsigned short bf16_t;
typedef short bf16x8 __attribute__((ext_vector_type(8)));
typedef float f32x4 __attribute__((ext_vector_type(4)));
typedef unsigned u32x4 __attribute__((ext_vector_type(4)));
constexpr int BM = 256, BK = 64, HALF = 128, HTB = HALF * BK * 2  , STAGE_BYTES = 8 * HTB, NXCD = 8, WGM = 8;

__host__ __device__ __forceinline__ int lds_byte(int r, int c) { const int st = (r >> 4) * 2 + (c >> 5), rr = r & 15, cc = c & 31, ob = rr * 64 + cc * 2; return st * 1024 + (ob ^ (((ob >> 9) & 1) << 5)); }
__host__ __device__ __forceinline__ void stage_rc(int b, int& R, int& C) { const int st = b / 1024, sb = b % 1024, swz = sb ^ (((sb >> 9) & 1) << 5); R = (st >> 1) * 16 + swz / 64; C = (st & 1) * 32 + (swz % 64) / 2; }
__host__ __device__ __forceinline__ int perm32(int rho) { const int n = rho >> 4, i = rho & 15; return 8 * (i >> 2) + 4 * n + (i & 3); }

struct Unit { int pm, pn, ga; };
struct Gemm { const bf16_t* A; const bf16_t* Bt; int M, N, K; const int* gidx; int gmax; };

struct StaticOrder {
    int nM, nN, nwg, G, c;
    __host__ __device__ void init(int M, int N, int G_, int c_) { nM = M / BM; nN = N / BM; nwg = nM * nN; G = G_; c = c_; }
    __host__ __device__ bool next(int i, Unit& u) const {
        const long L = (long)i * G + c; if (L >= nwg) return false;
        int wgid = (int)L; { const int q = nwg / NXCD, r = nwg % NXCD, xcd = wgid % NXCD, off = wgid / NXCD; wgid = (xcd < r ? xcd * (q + 1) : r * (q + 1) + (xcd - r) * q) + off; }
        const int nig = WGM * nN, gid = wgid / nig, fm = gid * WGM, gsz = (nM - fm) < WGM ? (nM - fm) : WGM;
        u.pm = fm + ((wgid % nig) % gsz); u.pn = (wgid % nig) / gsz; return true;
    }
    __device__ __forceinline__ void a_ready(const Unit&) const {}
    __device__ __forceinline__ void done(const Unit&) const {}
};

__device__ __forceinline__ unsigned cvt_pk_bf16(float lo, float hi) { unsigned r; asm volatile("v_cvt_pk_bf16_f32 %0, %1, %2" : "=v"(r) : "v"(lo), "v"(hi)); return r; }
typedef float f32x2 __attribute__((ext_vector_type(2)));
template <class Epi, class Sched, bool ALIGN_EPI = false, bool SP2 = false, bool GATHER = false>
__device__ __forceinline__ void gemm_phase(PG8_LAS unsigned char* lds, const Gemm g, const Sched& S, const Epi& E) {
    int tid = threadIdx.x; asm volatile("" : "+v"(tid));
    const int wid = __builtin_amdgcn_readfirstlane(tid >> 6), lane = tid & 63, wr = wid >> 2, wc = wid & 3, fr = lane & 15, fq = lane >> 4;
    const int K = g.K, nt = K / BK;
    unsigned voffA[2], voffB[2];
#pragma unroll
    for (int i = 0; i < 2; ++i) { int R, C; stage_rc(tid * 16 + i * 8192, R, C); const int Rb = Epi::PERM ? ((R & ~31) + perm32(R & 31)) : R;
        voffA[i] = (unsigned)(R * K + C) * 2u; voffB[i] = (unsigned)(Rb * K + C) * 2u; }
    static_assert(!GATHER || SP2, "GATHER is implemented for the SP2 loop");
    unsigned gcur[2][2], gnx[2][2];
#define PG8_GOFF(go, u_) do { _Pragma("unroll") for (int h_ = 0; h_ < 2; ++h_) _Pragma("unroll") for (int i_ = 0; i_ < 2; ++i_) { int R_, C_; stage_rc(tid * 16 + i_ * 8192, R_, C_); \
        int ri_ = g.gidx[(u_).ga + h_ * HALF + R_]; ri_ = ri_ < 0 ? 0 : (ri_ > g.gmax ? g.gmax : ri_); go[h_][i_] = (unsigned)ri_ * (unsigned)(K * 2) + (unsigned)C_ * 2u; } } while (0)
    const size_t kstep = (size_t)(BK * 2);
    const size_t hstep = (size_t)HALF * K * 2;
    const size_t tstep = 2 * hstep;
    const unsigned ldsw = (unsigned)wid * 1024u;
    const int aoff = lds_byte(wr * 64 + fr, fq * 8), boff = lds_byte(wc * 32 + fr, fq * 8);
#define PG8_SA(b, h) (((b) * 2 + (h)) * HTB)
#define PG8_SB(b, h) ((4 + (b) * 2 + (h)) * HTB)
#define PG8_STAGE(bufoff, gbase, voff) do { _Pragma("unroll") for (int _i = 0; _i < 2; ++_i) \
        __builtin_amdgcn_global_load_lds((const unsigned*)((const char*)(gbase) + (voff)[_i]), (PG8_LAS unsigned*)(lds + (bufoff) + ldsw + _i * 8192), 16, 0, 0); } while (0)
#define PG8_LDA(dst, b, h) do { _Pragma("unroll") for (int m = 0; m < 4; ++m) _Pragma("unroll") for (int k = 0; k < 2; ++k) dst[m][k] = *(const PG8_LAS bf16x8*)(lds + PG8_SA(b, h) + aoff + m * 2048 + k * 1024); } while (0)
#define PG8_LDB(dst, b, h) do { _Pragma("unroll") for (int n = 0; n < 2; ++n) _Pragma("unroll") for (int k = 0; k < 2; ++k) dst[n][k] = *(const PG8_LAS bf16x8*)(lds + PG8_SB(b, h) + boff + n * 2048 + k * 1024); } while (0)
#define PG8_MMA(ai, bj, At, Bt) do { __builtin_amdgcn_s_setprio(1); _Pragma("unroll") for (int m = 0; m < 4; ++m) _Pragma("unroll") for (int n = 0; n < 2; ++n) _Pragma("unroll") for (int k = 0; k < 2; ++k) \
        acc[ai][bj][m][n] = __builtin_amdgcn_mfma_f32_16x16x32_bf16(Bt[n][k], At[m][k], acc[ai][bj][m][n], 0, 0, 0); __builtin_amdgcn_s_setprio(0); } while (0)
#define PG8_WAIT_V(n) asm volatile("s_waitcnt vmcnt(" #n ")" ::: "memory")
#define PG8_WAIT_L(n) asm volatile("s_waitcnt lgkmcnt(" #n ")" ::: "memory")
#define PG8_BAR __builtin_amdgcn_s_barrier()
#define PG8_SCHED __builtin_amdgcn_sched_barrier(0)
    Unit cur, nxt; int ui = 0;
    if (!S.next(0, cur)) return;
    f32x4 acc[2][2][4][2];
#pragma unroll
    for (int a = 0; a < 2; ++a)
#pragma unroll
        for (int b = 0; b < 2; ++b)
#pragma unroll
            for (int m = 0; m < 4; ++m)
#pragma unroll
                for (int n = 0; n < 2; ++n) acc[a][b][m][n] = (f32x4){0.f, 0.f, 0.f, 0.f};
    bf16x8 At[4][2], B0[2][2], B1[2][2];
    const char* cA = (const char*)g.A + (size_t)cur.pm * tstep; const char* cB = (const char*)g.Bt + (size_t)cur.pn * tstep;
    S.a_ready(cur);
    const char* gA = (const char*)g.A;
    if constexpr (GATHER) PG8_GOFF(gcur, cur);
    if constexpr (SP2) {
        PG8_STAGE(PG8_SB(0, 0), cB, voffB); PG8_STAGE(PG8_SB(0, 1), cB + hstep, voffB);
        if constexpr (GATHER) { PG8_STAGE(PG8_SA(0, 0), gA, gcur[0]); PG8_STAGE(PG8_SA(0, 1), gA, gcur[1]); } else { PG8_STAGE(PG8_SA(0, 0), cA, voffA); PG8_STAGE(PG8_SA(0, 1), cA + hstep, voffA); }
        if (wr == 1) PG8_BAR;
        PG8_WAIT_V(2); PG8_BAR;
        PG8_STAGE(PG8_SB(1, 0), cB + kstep, voffB); if constexpr (GATHER) PG8_STAGE(PG8_SA(1, 0), gA + kstep, gcur[0]); else PG8_STAGE(PG8_SA(1, 0), cA + kstep, voffA); PG8_STAGE(PG8_SB(1, 1), cB + hstep + kstep, voffB);
        PG8_WAIT_V(6); PG8_BAR;
    } else {
        PG8_STAGE(PG8_SB(0, 0), cB, voffB); PG8_STAGE(PG8_SA(0, 0), cA, voffA); PG8_STAGE(PG8_SB(0, 1), cB + hstep, voffB); PG8_STAGE(PG8_SA(0, 1), cA + hstep, voffA);
        if (wr == 1) PG8_BAR;
        PG8_WAIT_V(4); PG8_BAR;
        PG8_STAGE(PG8_SB(1, 0), cB + kstep, voffB); PG8_STAGE(PG8_SA(1, 0), cA + kstep, voffA); PG8_STAGE(PG8_SB(1, 1), cB + hstep + kstep, voffB);
        PG8_WAIT_V(6); PG8_BAR;
    }
    for (;;) {
        const bool has_next = S.next(ui + 1, nxt);
        if constexpr (GATHER) { if (has_next) PG8_GOFF(gnx, nxt); else { gnx[0][0] = gcur[0][0]; gnx[0][1] = gcur[0][1]; gnx[1][0] = gcur[1][0]; gnx[1][1] = gcur[1][1]; } }
        const char* nA = has_next ? (const char*)g.A + (size_t)nxt.pm * tstep : cA; const char* nB = has_next ? (const char*)g.Bt + (size_t)nxt.pn * tstep : cB;
        for (int t = 0; t < nt; t += 2) {
            const bool last = (t == nt - 2);
            const char* a1 = cA + (size_t)(t + 1) * kstep;
            const char* a2 = last ? nA : cA + (size_t)(t + 2) * kstep; const char* b2 = last ? nB : cB + (size_t)(t + 2) * kstep;
            const char* a3 = a2 + kstep; const char* b3 = b2 + kstep;
            if (last && has_next) S.a_ready(nxt);
            unsigned ga0[2], ga1[2]; const char* g1 = gA; const char* g2 = gA; const char* g3 = gA;
            if constexpr (GATHER) { g1 = gA + (size_t)(t + 1) * kstep; g2 = last ? gA : gA + (size_t)(t + 2) * kstep; g3 = g2 + kstep;
                ga0[0] = last ? gnx[0][0] : gcur[0][0]; ga0[1] = last ? gnx[0][1] : gcur[0][1]; ga1[0] = last ? gnx[1][0] : gcur[1][0]; ga1[1] = last ? gnx[1][1] : gcur[1][1]; }
            if constexpr (SP2) {
            PG8_LDB(B0, 0, 0); PG8_LDB(B1, 0, 1); PG8_SCHED; PG8_LDA(At, 0, 0); if constexpr (GATHER) PG8_STAGE(PG8_SA(1, 1), g1, gcur[1]); else PG8_STAGE(PG8_SA(1, 1), a1 + hstep, voffA);
            PG8_WAIT_V(8); PG8_WAIT_L(0); PG8_BAR; PG8_MMA(0, 0, At, B0); PG8_MMA(0, 1, At, B1); PG8_BAR; PG8_SCHED;
            PG8_LDA(At, 0, 1); PG8_STAGE(PG8_SB(0, 0), b2, voffB); PG8_STAGE(PG8_SB(0, 1), b2 + hstep, voffB); if constexpr (GATHER) PG8_STAGE(PG8_SA(0, 0), g2, ga0); else PG8_STAGE(PG8_SA(0, 0), a2, voffA);
            PG8_WAIT_V(8); PG8_WAIT_L(0); PG8_BAR; PG8_MMA(1, 0, At, B0); PG8_MMA(1, 1, At, B1); PG8_BAR; PG8_SCHED;
            PG8_LDB(B0, 1, 0); PG8_LDB(B1, 1, 1); PG8_SCHED; PG8_LDA(At, 1, 0); if constexpr (GATHER) PG8_STAGE(PG8_SA(0, 1), g2, ga1); else PG8_STAGE(PG8_SA(0, 1), a2 + hstep, voffA);
            PG8_WAIT_V(8); PG8_WAIT_L(0); PG8_BAR; PG8_MMA(0, 0, At, B0); PG8_MMA(0, 1, At, B1); PG8_BAR; PG8_SCHED;
            PG8_LDA(At, 1, 1); PG8_STAGE(PG8_SB(1, 0), b3, voffB); PG8_STAGE(PG8_SB(1, 1), b3 + hstep, voffB); if constexpr (GATHER) PG8_STAGE(PG8_SA(1, 0), g3, ga0); else PG8_STAGE(PG8_SA(1, 0), a3, voffA);
            PG8_WAIT_V(8); PG8_WAIT_L(0); PG8_BAR; PG8_MMA(1, 0, At, B0); PG8_MMA(1, 1, At, B1); PG8_BAR; PG8_SCHED;
            } else {
            PG8_LDB(B0, 0, 0); PG8_SCHED; PG8_LDA(At, 0, 0); PG8_STAGE(PG8_SA(1, 1), a1 + hstep, voffA);
            PG8_WAIT_L(8); PG8_BAR; PG8_WAIT_L(0); PG8_MMA(0, 0, At, B0); PG8_BAR; PG8_SCHED;
            PG8_LDB(B1, 0, 1); PG8_STAGE(PG8_SB(0, 0), b2, voffB);
            PG8_BAR; PG8_WAIT_L(0); PG8_MMA(0, 1, At, B1); PG8_BAR;
            PG8_LDA(At, 0, 1); PG8_STAGE(PG8_SA(0, 0), a2, voffA);
            PG8_BAR; PG8_WAIT_L(0); PG8_MMA(1, 0, At, B0); PG8_BAR; PG8_SCHED;
            PG8_STAGE(PG8_SB(0, 1), b2 + hstep, voffB);
            PG8_WAIT_V(6); PG8_BAR; PG8_MMA(1, 1, At, B1); PG8_BAR;
            PG8_LDB(B0, 1, 0); PG8_SCHED; PG8_LDA(At, 1, 0); PG8_STAGE(PG8_SA(0, 1), a2 + hstep, voffA);
            PG8_WAIT_L(8); PG8_BAR; PG8_WAIT_L(0); PG8_MMA(0, 0, At, B0); PG8_BAR; PG8_SCHED;
            PG8_LDB(B1, 1, 1); PG8_STAGE(PG8_SB(1, 0), b3, voffB);
            PG8_BAR; PG8_WAIT_L(0); PG8_MMA(0, 1, At, B1); PG8_BAR;
            PG8_LDA(At, 1, 1); PG8_STAGE(PG8_SA(1, 0), a3, voffA);
            PG8_BAR; PG8_WAIT_L(0); PG8_MMA(1, 0, At, B0); PG8_BAR; PG8_SCHED;
            PG8_STAGE(PG8_SB(1, 1), b3 + hstep, voffB);
            PG8_WAIT_V(6); PG8_BAR; PG8_MMA(1, 1, At, B1); PG8_BAR;
            }
        }
        if constexpr (ALIGN_EPI) { if (wr == 0) PG8_BAR; }
        if constexpr (!Epi::AFTER_DRAIN) { E(acc, cur, wr, wc, fr, fq); S.done(cur); }
        if (!has_next) break;
#pragma unroll
        for (int a = 0; a < 2; ++a)
#pragma unroll
            for (int b = 0; b < 2; ++b)
#pragma unroll
                for (int m = 0; m < 4; ++m)
#pragma unroll
                    for (int n = 0; n < 2; ++n) acc[a][b][m][n] = (f32x4){0.f, 0.f, 0.f, 0.f};
        cur = nxt; cA = nA; cB = nB; ++ui;
        if constexpr (GATHER) { gcur[0][0] = gnx[0][0]; gcur[0][1] = gnx[0][1]; gcur[1][0] = gnx[1][0]; gcur[1][1] = gnx[1][1]; }
        if constexpr (ALIGN_EPI) { if (wr == 1) PG8_BAR; }
    }
    PG8_WAIT_V(0);
    if constexpr (!ALIGN_EPI) { if (wr == 0) PG8_BAR; }
    PG8_BAR;
    if constexpr (Epi::AFTER_DRAIN) { E.fused(acc, cur, wr, wc, fr, fq, lds, wid, lane); S.done(cur); }
#undef PG8_GOFF
#undef PG8_SA
#undef PG8_SB
#undef PG8_STAGE
#undef PG8_LDA
#undef PG8_LDB
#undef PG8_MMA
#undef PG8_WAIT_V
#undef PG8_WAIT_L
#undef PG8_BAR
#undef PG8_SCHED
}
}
#define LAS __attribute__((address_space(3)))
typedef unsigned short bf16;
typedef float f32x4 __attribute__((ext_vector_type(4)));
typedef short bf16x8 __attribute__((ext_vector_type(8)));
typedef unsigned u32x4 __attribute__((ext_vector_type(4)));
typedef unsigned u32x2 __attribute__((ext_vector_type(2)));

constexpr int D = 1024, NBATCH = 2, SEQ = 8192, CTXL = 256, DEPTH = 2;
constexpr int NLAT = NBATCH * SEQ, NCTX = NBATCH * CTXL, NROW = NLAT + NCTX;
constexpr int DR = 512, DIN = 2944, NP = 3328, ZW = 1920, NHEAD = 8;
constexpr int COL_CONV = 1920, COL_FC = 2688, COL_FS = 2944;
constexpr int STRW = 5120;
constexpr int NEXP = 32, DEXP = 512;
constexpr int MOE_MAXTILES = 168;
constexpr float RMS_EPS = 1e-6f, GN_EPS = 64e-5f;

enum { I_X = 0, I_C, I_CTX, I_CCTX, I_ADAW, I_ADAB, I_N1G, I_N2G, I_WIN, I_MU, I_DW0, I_DW2, I_IA0, I_IA2, I_GG2, I_KK, I_KA, I_RK, I_GNW, I_GNB,
       I_CONVW, I_CONVG, I_FOURG, I_WOUT, I_RGW, I_RGB, I_REW, I_REB, I_EG, I_EU, I_ED, I_FG, N_IN };

constexpr size_t MiB = 1u << 20;
constexpr size_t WS_CTL = 0, CTL_ZERO_BYTES = 64 * 1024;
constexpr size_t WS_MODP = 1 * MiB;
constexpr size_t WS_MODF = 1 * MiB + 1280 * 1024;
constexpr size_t WS_WIN_T = 3 * MiB;
constexpr size_t WS_WOUT_T = 16 * MiB;
constexpr size_t WS_WGU_T = 20 * MiB;
constexpr size_t WS_WD_T = 84 * MiB;
constexpr size_t WS_X = 116 * MiB;
constexpr size_t WS_H = 182 * MiB;
constexpr size_t WS_ZS = 215 * MiB;
constexpr size_t WS_P = 277 * MiB;
constexpr size_t WS_STR = 277 * MiB;
constexpr size_t WS_Y = 442 * MiB;
constexpr size_t WS_GT = 475 * MiB;
constexpr size_t WS_ROUTE = 491 * MiB;
constexpr size_t WS_XS = 215 * MiB;
constexpr size_t WS_ACT = 299 * MiB;
constexpr size_t WS_ELIST = 340 * MiB;
constexpr size_t WS_END = 530 * MiB;
constexpr size_t RT_E = 0, RT_POS = 1 * 33792 * 4, RT_GATE = 2 * 33792 * 4, RT_SLOT = 3 * 33792 * 4, RT_TILE = 4 * 33792 * 4, RT_NT = RT_TILE + 1024;

constexpr int CW_BAR = 4096;
constexpr int CW_CNT = 8192;

constexpr int NWAVES = 8, NTHR = 512;
constexpr int RING_BYTES = 131072, LDSCTL_OFF = 143360, MISC_OFF = LDSCTL_OFF + 320, LDS_BYTES = 147456;

struct Params { const float* in[N_IN]; float* out; unsigned char* ws; };

__device__ __forceinline__ float bf2f(unsigned h) { return __uint_as_float(h << 16); }
typedef __bf16 hwbf2 __attribute__((ext_vector_type(2)));
typedef float f32x2 __attribute__((ext_vector_type(2)));
__device__ __forceinline__ unsigned pk2(float lo, float hi) { const f32x2 x = {lo, hi}; const hwbf2 r = __builtin_convertvector(x, hwbf2); return __builtin_bit_cast(unsigned, r); }
__device__ __forceinline__ unsigned f2bf(float f) { return pk2(f, 0.f) & 0xffffu; }
__device__ __forceinline__ float wave_sum(float v) {
#pragma unroll
    for (int o = 1; o < 64; o <<= 1) v += __shfl_xor(v, o);
    return v;
}
__device__ __forceinline__ float sigmoidf_(float x) { return 1.f / (1.f + __expf(-x)); }
#define LDS_WAIT() asm volatile("s_waitcnt lgkmcnt(0)" ::: "memory")
#define VM_WAIT() asm volatile("s_waitcnt vmcnt(0)" ::: "memory")

struct Frame {
    LAS unsigned char* lds;
    int tid, lane, wave, vcu, G, gw, NGW;
    float* out; unsigned char* ws;
};
#if defined(__HIP_DEVICE_COMPILE__)
#define ASSUME_GLOBAL(p) do { __builtin_assume(!__builtin_amdgcn_is_shared(p)); __builtin_assume(!__builtin_amdgcn_is_private(p)); } while (0)
#else
#define ASSUME_GLOBAL(p) do { } while (0)
#endif
__device__ __forceinline__ const float* inptr(int i) {
    const volatile unsigned long long __attribute__((address_space(4)))* ka = (const volatile unsigned long long __attribute__((address_space(4)))*)__builtin_amdgcn_kernarg_segment_ptr();
    return (const float*)(const __attribute__((address_space(1))) float*)ka[i];
}
__device__ __forceinline__ unsigned char* opaque(unsigned char* p) { unsigned long z = 0; asm volatile("" : "+s"(z)); return p + z; }
__device__ __forceinline__ Frame phase_frame(const Frame& F0) { Frame F = F0; asm volatile("" : "+v"(F.tid)); F.lane = F.tid & 63; F.ws = opaque(F0.ws);
    asm volatile("" : "+s"(F.G), "+s"(F.vcu)); F.gw = F.vcu * NWAVES + F.wave; F.NGW = F.G * NWAVES; return F; }
__device__ __forceinline__ int modrow(int row) { return row < NLAT ? (row >> 13) : 2; }
#define XB_TMO      128
#define XB_XCNT(j)  (256  + 64 * (j))
#define XB_XSUB(j)  (1280 + 64 * (j))
#define XB_XGEN(j)  (2304 + 64 * (j))
#define XB_TOP      3328
#define XB_TOPGEN   3392
#define XCD_BAR_WORDS 3456
#define XB_SPIN_CAP (1u << 18)

__device__ __forceinline__ unsigned xb_ld(unsigned* p)              { return __hip_atomic_load(p, __ATOMIC_RELAXED, __HIP_MEMORY_SCOPE_AGENT); }
__device__ __forceinline__ unsigned xb_add(unsigned* p, unsigned v) { return __hip_atomic_fetch_add(p, v, __ATOMIC_RELAXED, __HIP_MEMORY_SCOPE_AGENT); }
__device__ __forceinline__ unsigned xb_xcc_id() { return (unsigned)__builtin_amdgcn_s_getreg((3 << 11) | 20) & 0xFu; }
#define XB_SPIN(cond, bar) do { unsigned _sp = 0; while (cond) { __builtin_amdgcn_s_sleep(1); \
    if ((++_sp & 255u) == 0u) { if (xb_ld(&(bar)[XB_TMO])) break; if (_sp > XB_SPIN_CAP) { atomicAdd(&(bar)[XB_TMO], 1u); break; } } } } while (0)

struct XcdBarrier {
    unsigned* bar; unsigned x;
    volatile LAS unsigned* st;
};

__device__ __forceinline__ XcdBarrier xcd_barrier_post(unsigned* bar, volatile LAS unsigned* st) {
    XcdBarrier b; b.bar = bar; b.x = xb_xcc_id(); b.st = st;
    if (threadIdx.x == 0) (void)xb_add(&bar[XB_XCNT(b.x)], 1u);
    return b;
}
__device__ __forceinline__ void xcd_barrier_complete(unsigned* bar, unsigned x, unsigned& nloc, unsigned& nx) {
    const unsigned G = gridDim.x * gridDim.y * gridDim.z;
    unsigned sum, cnt, mine, sp = 0u;
    for (;;) {
        sum = 0u; cnt = 0u; mine = 0u;
#pragma nounroll
        for (unsigned j = 0; j < 16; ++j) { const unsigned c = xb_ld(&bar[XB_XCNT(j)]); sum += c; cnt += (c > 0u) ? 1u : 0u; mine = (j == x) ? c : mine; }
        if (sum == G) break;
        __builtin_amdgcn_s_sleep(1);
        if ((++sp & 255u) == 0u) { if (xb_ld(&bar[XB_TMO])) break; if (sp > XB_SPIN_CAP) { atomicAdd(&bar[XB_TMO], 1u); break; } }
    }
    nloc = mine > 0u ? mine : 1u; nx = cnt > 0u ? cnt : 1u;
}

__device__ __forceinline__ void xcd_barrier(const XcdBarrier& b) {
    asm volatile("s_waitcnt vmcnt(0)" ::: "memory");
    __syncthreads();
    if (threadIdx.x == 0) {
        unsigned* bar = b.bar;
        asm volatile("" : "+s"(bar));
        __builtin_amdgcn_s_waitcnt(0);
        unsigned nloc = b.st[0], nx = b.st[1];
        if (nloc == 0u) { xcd_barrier_complete(bar, b.x, nloc, nx); b.st[0] = nloc; b.st[1] = nx; }
        const unsigned old = xb_add(&bar[XB_XSUB(b.x)], 1u);
        const unsigned gen = old / nloc;
        if (old + 1u == (gen + 1u) * nloc) {
            __builtin_amdgcn_fence(__ATOMIC_RELEASE, "agent");
            asm volatile("s_waitcnt vmcnt(0)" ::: "memory");
            const unsigned og = xb_add(&bar[XB_TOP], 1u);
            const unsigned tg = og / nx;
            if (og + 1u == (tg + 1u) * nx) xb_add(&bar[XB_TOPGEN], 1u);
            else XB_SPIN(xb_ld(&bar[XB_TOPGEN]) == tg, bar);
            __builtin_amdgcn_fence(__ATOMIC_ACQUIRE, "agent");
            xb_add(&bar[XB_XGEN(b.x)], 1u);
            asm volatile("s_waitcnt vmcnt(0)" ::: "memory");
        } else {
            XB_SPIN(xb_ld(&bar[XB_XGEN(b.x)]) == gen, bar);
            __builtin_amdgcn_fence(__ATOMIC_ACQUIRE, "agent");
            asm volatile("s_waitcnt vmcnt(0)" ::: "memory");
        }
    }
    __syncthreads();
}
template <class RowMap>
__device__ __forceinline__ void transpose_item(const float* W, int ldw, int k0, int n0, bf16* WT, int ldt, RowMap rm, LAS float* scr, int lane) {
    (void)scr;
    const int nq = lane & 7, kg = lane >> 3; const float* src = W + (size_t)(k0 + 8 * kg) * ldw + n0 + 4 * nq;
    f32x4 v[8];
#pragma unroll
    for (int i = 0; i < 8; ++i) v[i] = *(const f32x4*)(src + (size_t)i * ldw);
#pragma unroll
    for (int j = 0; j < 4; ++j) { u32x4 o = {pk2(v[0][j], v[1][j]), pk2(v[2][j], v[3][j]), pk2(v[4][j], v[5][j]), pk2(v[6][j], v[7][j])};
        *(u32x4*)(WT + (size_t)rm(n0 + 4 * nq + j) * ldt + k0 + 8 * kg) = o; }
}
struct RmId { int off; __device__ __forceinline__ int operator()(int n) const { return off + n; } };
struct RmGU { int off; __device__ __forceinline__ int operator()(int n) const { return off + ((n >> 2) << 3) + (n & 3); } };

__device__ __forceinline__ void p0_prologue(const Frame& F0) {
    const Frame F = phase_frame(F0); unsigned char* const ws = F.ws;
    LAS float* scr = (LAS float*)(F.lds + F.wave * 16384);
    LAS float* ctab = (LAS float*)(F.lds + 8 * 16384);
    if (F.tid < 64) ctab[F.tid] = cosf((float)F.tid * (6.283185307179586f / 64.f));
    __syncthreads();
    bf16* win_t = (bf16*)(ws + WS_WIN_T); bf16* wout_t = (bf16*)(ws + WS_WOUT_T);
    constexpr int I_WIN_L = 16 * 84, I_WOUT_L = 16 * 32, I_FOLD_L = 4 * 64, I_MOD_L = 96 * 8;
    constexpr int NIT = 2 * (I_WIN_L + I_WOUT_L + I_FOLD_L + I_MOD_L);
    const float* p_win = inptr(I_WIN); const float* p_wout = inptr(I_WOUT); const float* p_c = inptr(I_C); const float* p_cctx = inptr(I_CCTX); const float* p_adaw = inptr(I_ADAW);
    {
        bf16* wl = (bf16*)(ws + 64 * 1024); const float* dw2 = inptr(I_DW2); const float* ia2 = inptr(I_IA2); const float* gg2 = inptr(I_GG2);
        for (int idx = F.vcu * NTHR + F.tid; idx < 2 * 384 * 512; idx += F.G * NTHR) { const int c = idx & 511, k = (idx >> 9) % 384, l = idx / (384 * 512);
            float v;
            if (k < 128) v = dw2[((size_t)(l * 2 + (k >> 6)) * 64 + (k & 63)) * DR + c];
            else if (k < 256) v = ia2[((size_t)(l * 2 + ((k - 128) >> 6)) * 64 + (k & 63)) * DR + c];
            else v = gg2[((size_t)l * 128 + (k - 256)) * DR + c];
            wl[((size_t)l * 512 + c) * 384 + k] = (bf16)f2bf(v); } }
    for (int it = F.gw; it < NIT; it += F.NGW) {
        int r = it; const int l = r & 1; r >>= 1;
        if (r < I_WIN_L) { const int kb = r / 84, nb = r % 84;
            transpose_item(p_win + (size_t)l * D * DIN, DIN, kb * 64, nb * 32, win_t + (size_t)l * NP * D, D, RmId{0}, scr, F.lane); continue; }
        r -= I_WIN_L;
        if (r < I_WOUT_L) { const int kb = r / 32, nb = r % 32;
            transpose_item(p_wout + (size_t)l * D * D, D, kb * 64, nb * 32, wout_t + (size_t)l * D * D, D, RmId{0}, scr, F.lane); continue; }
        r -= I_WOUT_L;
        if (r < I_FOLD_L) {
            const int g = r >> 6, k0 = (r & 63) * 16; const float* W = p_win + (size_t)l * D * DIN;
#pragma unroll
            for (int kk = 0; kk < 16; ++kk) scr[kk * 64 + F.lane] = W[(size_t)(k0 + kk) * DIN + 2688 + g * 64 + F.lane];
            LDS_WAIT(); asm volatile("" ::: "memory");
            float ac[16], as[16];
#pragma unroll
            for (int kk = 0; kk < 16; ++kk) { ac[kk] = 0.f; as[kk] = 0.f; }
            for (int c = 0; c < 64; ++c) { const int idx = (c * F.lane) & 63; const float cc = ctab[idx], ss = ctab[(idx - 16) & 63];
#pragma unroll
                for (int kk = 0; kk < 16; ++kk) { const float w = scr[kk * 64 + c]; ac[kk] += w * cc; as[kk] += w * ss; } }
            bf16* oc = win_t + (size_t)l * NP * D + (size_t)(COL_FC + g * 64 + F.lane) * D + k0;
            bf16* os = win_t + (size_t)l * NP * D + (size_t)(COL_FS + g * 64 + F.lane) * D + k0;
            u32x4 a, b;
            a.x = pk2(ac[0], ac[1]); a.y = pk2(ac[2], ac[3]); a.z = pk2(ac[4], ac[5]); a.w = pk2(ac[6], ac[7]);
            b.x = pk2(ac[8], ac[9]); b.y = pk2(ac[10], ac[11]); b.z = pk2(ac[12], ac[13]); b.w = pk2(ac[14], ac[15]);
            *(u32x4*)oc = a; *(u32x4*)(oc + 8) = b;
            a.x = pk2(as[0], as[1]); a.y = pk2(as[2], as[3]); a.z = pk2(as[4], as[5]); a.w = pk2(as[6], as[7]);
            b.x = pk2(as[8], as[9]); b.y = pk2(as[10], as[11]); b.z = pk2(as[12], as[13]); b.w = pk2(as[14], as[15]);
            *(u32x4*)os = a; *(u32x4*)(os + 8) = b;
            LDS_WAIT(); asm volatile("" ::: "memory");
            continue; }
        r -= I_FOLD_L;
        {
            const int cb = r >> 3, ks = r & 7;
#pragma unroll
            for (int q = 0; q < 2; ++q) { const int k = ks * 128 + q * 64 + F.lane;
                const float c0 = p_c[k], c1 = p_c[D + k], c2 = p_cctx[k];
                scr[0 * 128 + q * 64 + F.lane] = c0 * sigmoidf_(c0); scr[1 * 128 + q * 64 + F.lane] = c1 * sigmoidf_(c1); scr[2 * 128 + q * 64 + F.lane] = c2 * sigmoidf_(c2); }
            LDS_WAIT(); asm volatile("" ::: "memory");
            const float* W = p_adaw + (size_t)l * D * 6144 + (size_t)(ks * 128) * 6144 + cb * 64 + F.lane;
            float a0 = 0.f, a1 = 0.f, a2 = 0.f;
#pragma unroll 8
            for (int kk = 0; kk < 128; ++kk) { const float w = W[(size_t)kk * 6144]; a0 += scr[kk] * w; a1 += scr[128 + kk] * w; a2 += scr[256 + kk] * w; }
            float* mp = (float*)(ws + WS_MODP) + (size_t)((l * 8 + ks) * 3) * 6144 + cb * 64 + F.lane;
            mp[0] = a0; mp[6144] = a1; mp[2 * 6144] = a2;
            LDS_WAIT(); asm volatile("" ::: "memory");
        }
    }
}

__device__ __forceinline__ void mod_to_lds(const Frame& F0, int l, int p, LAS float* dst, bool from_partials) {
    const Frame F = phase_frame(F0); unsigned char* const ws = F.ws;
    const float* adab = inptr(I_ADAB);
    for (int idx = F.tid; idx < 3 * 1024; idx += NTHR) { const int r = idx >> 10, n = idx & 1023;
        float v;
        if (from_partials) { v = adab[l * 6144 + p * 1024 + n]; const float* mp = (const float*)(ws + WS_MODP) + (size_t)(l * 8 * 3 + r) * 6144 + p * 1024 + n;
#pragma unroll
            for (int ks = 0; ks < 8; ++ks) v += mp[(size_t)ks * 3 * 6144]; }
        else v = ((const float*)(ws + WS_MODF))[(size_t)(l * 3 + r) * 6144 + p * 1024 + n];
        dst[idx] = v; }
}
__device__ __forceinline__ void mod_finalize(const Frame& F0) {
    const Frame F = phase_frame(F0); unsigned char* const ws = F.ws;
    const float* adab = inptr(I_ADAB);
    for (int idx = F.vcu * NTHR + F.tid; idx < 2 * 3 * 6144; idx += F.G * NTHR) { const int l = idx / (3 * 6144), rem = idx % (3 * 6144), r = rem / 6144, n = rem % 6144;
        float v = adab[l * 6144 + n]; const float* mp = (const float*)(ws + WS_MODP) + (size_t)(l * 8 * 3 + r) * 6144 + n;
#pragma unroll
        for (int ks = 0; ks < 8; ++ks) v += mp[(size_t)ks * 3 * 6144];
        ((float*)(ws + WS_MODF))[idx] = v; }
}


__device__ __forceinline__ void norm_mod_row(f32x4 (&v)[4], const float* gain, const LAS float* sc, const LAS float* sh, bf16* orow, int lane) {
    float s = 0.f;
#pragma unroll
    for (int j = 0; j < 4; ++j) s += (v[j].x * v[j].x + v[j].y * v[j].y) + (v[j].z * v[j].z + v[j].w * v[j].w);
    const float rs = rsqrtf(wave_sum(s) * (1.f / D) + RMS_EPS);
#pragma unroll
    for (int j = 0; j < 4; ++j) { const int c = 4 * lane + 256 * j; const f32x4 g = *(const f32x4*)(gain + c); const f32x4 a = *(const LAS f32x4*)(sc + c), b = *(const LAS f32x4*)(sh + c);
        v[j] = (v[j] * rs) * g * (a + 1.f) + b;
        u32x2 w; w.x = pk2(v[j].x, v[j].y); w.y = pk2(v[j].z, v[j].w); *(u32x2*)(orow + c) = w; }
}

__device__ __forceinline__ void p0b_norm1(const Frame& F0) {
    const Frame F = phase_frame(F0); unsigned char* const ws = F.ws;
    LAS float* msh = (LAS float*)F.lds; LAS float* msc = msh + 3072;
    mod_to_lds(F, 0, 0, msh, true); mod_to_lds(F, 0, 1, msc, true); __syncthreads();
    mod_finalize(F);
    bf16* H = (bf16*)(ws + WS_H); const float* xin = inptr(I_X); const float* cin = inptr(I_CTX); const float* n1g = inptr(I_N1G);
    for (int row0 = F.gw; row0 < NROW; row0 += 2 * F.NGW) { f32x4 v[2][4]; bool ok[2];
#pragma unroll
        for (int u = 0; u < 2; ++u) { const int row = row0 + u * F.NGW; ok[u] = row < NROW; if (ok[u]) { const float* xr = row < NLAT ? xin + (size_t)row * D : cin + (size_t)(row - NLAT) * D;
#pragma unroll
            for (int j = 0; j < 4; ++j) v[u][j] = *(const f32x4*)(xr + 4 * F.lane + 256 * j); } }
#pragma unroll
        for (int u = 0; u < 2; ++u) if (ok[u]) { const int row = row0 + u * F.NGW; const int mr = modrow(row);
            norm_mod_row(v[u], n1g, msc + mr * 1024, msh + mr * 1024, H + (size_t)row * D, F.lane); } }
}
__device__ __forceinline__ void unpack8(const u32x4 w, float (&o)[8]) {
    o[0] = bf2f(w.x & 0xffffu); o[1] = bf2f(w.x >> 16); o[2] = bf2f(w.y & 0xffffu); o[3] = bf2f(w.y >> 16);
    o[4] = bf2f(w.z & 0xffffu); o[5] = bf2f(w.z >> 16); o[6] = bf2f(w.w & 0xffffu); o[7] = bf2f(w.w >> 16);
}
__device__ __forceinline__ void unpack4(const u32x2 w, float (&o)[4]) { o[0] = bf2f(w.x & 0xffffu); o[1] = bf2f(w.x >> 16); o[2] = bf2f(w.y & 0xffffu); o[3] = bf2f(w.y >> 16); }

__device__ __forceinline__ void shift_pass(const Frame& F0, int l) {
    const Frame F = phase_frame(F0); unsigned char* const ws = F.ws;
    const bf16* P = (const bf16*)(ws + WS_P); bf16* Zs = (bf16*)(ws + WS_ZS); const float* mu = inptr(I_MU) + l * ZW;
    const int total = NROW * 240;
    for (int idx = F.vcu * NTHR + F.tid; idx < total; idx += F.G * NTHR) {
        const int row = idx / 240, ck = idx % 240; const bf16* pr = P + (size_t)row * NP + ck * 8;
        const u32x4 zero = {0u, 0u, 0u, 0u};
        float z[8], n0[8], n1[8], n2[8], n3[8], o[8];
        unpack8(*(const u32x4*)pr, z);
        if (row < NLAT) { const int t = row & (SEQ - 1), gr = t >> 6, gc = t & 63;
            unpack8(gc > 0 ? *(const u32x4*)(pr - NP) : zero, n0); unpack8(gc < 63 ? *(const u32x4*)(pr + NP) : zero, n1);
            unpack8(gr > 0 ? *(const u32x4*)(pr - 64 * NP) : zero, n2); unpack8(gr < 127 ? *(const u32x4*)(pr + 64 * NP) : zero, n3);
        } else { const int tc = (row - NLAT) & (CTXL - 1);
            unpack8(tc > 0 ? *(const u32x4*)(pr - NP) : zero, n0); unpack8(tc < CTXL - 1 ? *(const u32x4*)(pr + NP) : zero, n1);
#pragma unroll
            for (int j = 0; j < 8; ++j) { n2[j] = n0[j]; n3[j] = n1[j]; }
        }
        const f32x4 m0 = *(const f32x4*)(mu + ck * 8), m1 = *(const f32x4*)(mu + ck * 8 + 4);
        const float m[8] = {m0.x, m0.y, m0.z, m0.w, m1.x, m1.y, m1.z, m1.w};
#pragma unroll
        for (int j = 0; j < 8; ++j) { const float nb = (j & 3) == 0 ? n0[j] : (j & 3) == 1 ? n1[j] : (j & 3) == 2 ? n2[j] : n3[j]; o[j] = z[j] + (nb - z[j]) * m[j]; }
        u32x4 w; w.x = pk2(o[0], o[1]); w.y = pk2(o[2], o[3]); w.z = pk2(o[4], o[5]); w.w = pk2(o[6], o[7]);
        *(u32x4*)(Zs + (size_t)row * ZW + ck * 8) = w;
    }
}

__device__ __forceinline__ void conv_pass(const Frame& F0, int l, int nrows) {
    const Frame F = phase_frame(F0); unsigned char* const ws = F.ws;
    const bf16* P = (const bf16*)(ws + WS_P); bf16* MA = (bf16*)(ws + WS_H);
    const float* cw = inptr(I_CONVW) + l * 3 * 256; const int c = 4 * F.lane;
    const f32x4 w0 = *(const f32x4*)(cw + c), w1 = *(const f32x4*)(cw + 256 + c), w2 = *(const f32x4*)(cw + 512 + c), gn = *(const f32x4*)(inptr(I_CONVG) + l * 256 + c);
    for (int row0 = F.gw; row0 < nrows; row0 += 2 * F.NGW) {
        u32x2 q[2][7]; bool ok[2]; const u32x2 zero = {0u, 0u};
#pragma unroll
        for (int u = 0; u < 2; ++u) { const int row = row0 + u * F.NGW; ok[u] = row < nrows; if (ok[u]) {
            int t, L; if (row < NLAT) { t = row & (SEQ - 1); L = SEQ; } else { t = (row - NLAT) & (CTXL - 1); L = CTXL; }
            const bf16* pr = P + (size_t)row * NP + COL_CONV + c;
            q[u][0] = *(const u32x2*)pr; q[u][1] = *(const u32x2*)(pr + 256); q[u][2] = *(const u32x2*)(pr + 512);
            q[u][3] = t > 0 ? *(const u32x2*)(pr - NP + 256) : zero; q[u][4] = t > 0 ? *(const u32x2*)(pr - NP + 512) : zero;
            q[u][5] = t < L - 1 ? *(const u32x2*)(pr + NP + 256) : zero; q[u][6] = t < L - 1 ? *(const u32x2*)(pr + NP + 512) : zero; } }
#pragma unroll
        for (int u = 0; u < 2; ++u) if (ok[u]) { const int row = row0 + u * F.NGW;
            float bg[4], cg[4], hh[4], cp[4], hp[4], cn[4], hn[4];
            unpack4(q[u][0], bg); unpack4(q[u][1], cg); unpack4(q[u][2], hh); unpack4(q[u][3], cp); unpack4(q[u][4], hp); unpack4(q[u][5], cn); unpack4(q[u][6], hn);
            const float W0[4] = {w0.x, w0.y, w0.z, w0.w}, W1[4] = {w1.x, w1.y, w1.z, w1.w}, W2[4] = {w2.x, w2.y, w2.z, w2.w}, GN[4] = {gn.x, gn.y, gn.z, gn.w};
            float y[4], s = 0.f;
#pragma unroll
            for (int j = 0; j < 4; ++j) { y[j] = bg[j] * (W0[j] * (cp[j] * hp[j]) + W1[j] * (cg[j] * hh[j]) + W2[j] * (cn[j] * hn[j])); s += y[j] * y[j]; }
            const float rs = rsqrtf(wave_sum(s) * (1.f / 256.f) + RMS_EPS);
            u32x2 o; o.x = pk2(y[0] * rs * GN[0], y[1] * rs * GN[1]); o.y = pk2(y[2] * rs * GN[2], y[3] * rs * GN[3]);
            *(u32x2*)(MA + (size_t)row * D + 512 + c) = o; }
    }
}

__device__ __forceinline__ void sincos_turns(float x, float& s, float& c) { s = __builtin_amdgcn_sinf(x); c = __builtin_amdgcn_cosf(x); }
#define MFMA16(a, b, c) __builtin_amdgcn_mfma_f32_16x16x32_bf16((a), (b), (c), 0, 0, 0)

__device__ __forceinline__ void fftA_item(const Frame& F0, int item) {
    const Frame F = phase_frame(F0); unsigned char* const ws = F.ws;
    const int half = item & 1, t2 = (item >> 1) & 63, b = item >> 7;
    const bf16* P = (const bf16*)(ws + WS_P); bf16* GT = (bf16*)(ws + WS_GT);
    LAS bf16* Bs = (LAS bf16*)F.lds;
    const int lane = F.lane, w = F.wave, fr = lane & 15, fq = lane >> 4;
    __syncthreads();
#pragma unroll
    for (int i = 0; i < 8; ++i) { const int cidx = F.tid + NTHR * i, krow = cidx >> 4, ch8 = cidx & 15, ri = krow >> 7, t1 = krow & 127;
        const u32x4 v = *(const u32x4*)(P + (size_t)(b * SEQ + t1 * 64 + t2) * NP + COL_FC + ri * 256 + half * 128 + ch8 * 8);
        LAS bf16* d = Bs + (ch8 * 8) * 264 + krow;
        d[0 * 264] = (bf16)(v.x & 0xffffu); d[1 * 264] = (bf16)(v.x >> 16); d[2 * 264] = (bf16)(v.y & 0xffffu); d[3 * 264] = (bf16)(v.y >> 16);
        d[4 * 264] = (bf16)(v.z & 0xffffu); d[5 * 264] = (bf16)(v.z >> 16); d[6 * 264] = (bf16)(v.w & 0xffffu); d[7 * 264] = (bf16)(v.w >> 16); }
    __syncthreads();
    f32x4 acc[2][8];
#pragma unroll
    for (int a = 0; a < 2; ++a)
#pragma unroll
        for (int n = 0; n < 8; ++n) acc[a][n] = (f32x4){0.f, 0.f, 0.f, 0.f};
    int t1p_a = 16 * w + fr;
    asm volatile("" : "+v"(t1p_a));
#pragma unroll
    for (int ks = 0; ks < 8; ++ks) {
        bf16x8 ar, ai;
#pragma unroll
        for (int j = 0; j < 8; ++j) { const int k = ks * 32 + 8 * fq + j, ri = k >> 7, t1 = k & 127; const int idx = (t1 * t1p_a) & 127;
            float sn, cs; sincos_turns((float)idx * (1.f / 128.f), sn, cs);
            const float vr = ri == 0 ? cs : -sn, vi = ri == 0 ? -sn : -cs;
            ar[j] = (short)f2bf(vr); ai[j] = (short)f2bf(vi); }
#pragma unroll
        for (int nt = 0; nt < 8; ++nt) { const bf16x8 bfr = *(const LAS bf16x8*)(Bs + (nt * 16 + fr) * 264 + ks * 32 + 8 * fq);
            acc[0][nt] = MFMA16(ar, bfr, acc[0][nt]); acc[1][nt] = MFMA16(ai, bfr, acc[1][nt]); }
    }
#pragma unroll
    for (int reg = 0; reg < 4; ++reg) { const int t1p = 16 * w + 4 * fq + reg; float st, ct; sincos_turns((float)(t2 * t1p) * (1.f / 8192.f), st, ct);
        bf16* g = GT + ((size_t)((b * 128 + t1p) * 64 + t2) * 2) * 256 + half * 128 + fr;
#pragma unroll
        for (int nt = 0; nt < 8; ++nt) { const float gr = acc[0][nt][reg], gi = acc[1][nt][reg];
            g[nt * 16] = (bf16)f2bf(gr * ct + gi * st); g[256 + nt * 16] = (bf16)f2bf(gi * ct - gr * st); } }
}

template <int NKC, int NDIV, int MT, class SrcRow, class OutRow>
__device__ __forceinline__ void dft64_item(const Frame& F0, int l, int m0, float sgn, float scale, SrcRow src, OutRow orow) {
    const Frame F = phase_frame(F0); unsigned char* const ws = F.ws;
    LAS bf16* Bs = (LAS bf16*)F.lds;
    LAS float* red = (LAS float*)(F.lds + 256 * 136 * 2);
    const int lane = F.lane, w = F.wave, fr = lane & 15, fq = lane >> 4;
    int fr_a = fr; asm volatile("" : "+v"(fr_a));
    f32x4 acc[MT][2];
#pragma unroll
    for (int a = 0; a < MT; ++a) { acc[a][0] = (f32x4){0.f, 0.f, 0.f, 0.f}; acc[a][1] = (f32x4){0.f, 0.f, 0.f, 0.f}; }
    for (int kc = 0; kc < NKC; ++kc) {
        __syncthreads();
#pragma unroll
        for (int i = 0; i < 8; ++i) { const int cidx = F.tid + NTHR * i, krow = cidx >> 5, ch8 = cidx & 31;
            const u32x4 v = *(const u32x4*)(src(kc * 64 + (krow >> 1), krow & 1) + ch8 * 8);
            LAS bf16* d = Bs + (ch8 * 8) * 136 + krow;
            d[0 * 136] = (bf16)(v.x & 0xffffu); d[1 * 136] = (bf16)(v.x >> 16); d[2 * 136] = (bf16)(v.y & 0xffffu); d[3 * 136] = (bf16)(v.y >> 16);
            d[4 * 136] = (bf16)(v.z & 0xffffu); d[5 * 136] = (bf16)(v.z >> 16); d[6 * 136] = (bf16)(v.w & 0xffffu); d[7 * 136] = (bf16)(v.w >> 16); }
        __syncthreads();
#pragma unroll
        for (int ks = 0; ks < 4; ++ks) {
            const bf16x8 b0 = *(const LAS bf16x8*)(Bs + ((2 * w) * 16 + fr) * 136 + ks * 32 + 8 * fq);
            const bf16x8 b1 = *(const LAS bf16x8*)(Bs + ((2 * w + 1) * 16 + fr) * 136 + ks * 32 + 8 * fq);
#pragma unroll
            for (int mt = 0; mt < MT; ++mt) { const int mrow = m0 + mt * 16 + fr_a; bf16x8 a;
#pragma unroll
                for (int j = 0; j < 8; ++j) { const int k = ks * 32 + 8 * fq + j, tl = k >> 1, ri = k & 1; const int idx = ((kc * 64 + tl) * mrow) & (NDIV - 1);
                    float sn, cs; sincos_turns((float)idx * (1.f / (float)NDIV), sn, cs);
                    a[j] = (short)f2bf(ri == 0 ? cs : sgn * sn); }
                acc[mt][0] = MFMA16(a, b0, acc[mt][0]); acc[mt][1] = MFMA16(a, b1, acc[mt][1]); }
        }
    }
#pragma unroll
    for (int mt = 0; mt < MT; ++mt)
#pragma unroll
        for (int reg = 0; reg < 4; ++reg) { const float a = acc[mt][0][reg] * scale, b = acc[mt][1][reg] * scale; acc[mt][0][reg] = a; acc[mt][1][reg] = b;
            float s = a * a + b * b; s += __shfl_xor(s, 1); s += __shfl_xor(s, 2); s += __shfl_xor(s, 4); s += __shfl_xor(s, 8);
            if (fr == 0) red[w * 64 + mt * 16 + 4 * fq + reg] = s; }
    __syncthreads();
    bf16* MA = (bf16*)(ws + WS_H); const float* fg = inptr(I_FOURG) + l * 256;
    const float g0 = fg[(2 * w) * 16 + fr], g1 = fg[(2 * w + 1) * 16 + fr];
#pragma unroll
    for (int mt = 0; mt < MT; ++mt)
#pragma unroll
        for (int reg = 0; reg < 4; ++reg) { const int ml = mt * 16 + 4 * fq + reg; float tot = 0.f;
#pragma unroll
            for (int ww = 0; ww < 8; ++ww) tot += red[ww * 64 + ml];
            const float rs = rsqrtf(tot * (1.f / 256.f) + RMS_EPS);
            bf16* o = MA + (size_t)orow(m0 + ml) * D + 768 + fr;
            o[(2 * w) * 16] = (bf16)f2bf(acc[mt][0][reg] * rs * g0); o[(2 * w + 1) * 16] = (bf16)f2bf(acc[mt][1][reg] * rs * g1); }
    __syncthreads();
}

constexpr size_t WS_LORA = 64 * 1024;
constexpr int LINP = 392;
__device__ __forceinline__ float fast_sigmoid(float x) { return __builtin_amdgcn_rcpf(1.f + __expf(-x)); }
__device__ __forceinline__ float fast_tanh(float x) { return 1.f - 2.f * __builtin_amdgcn_rcpf(1.f + __expf(2.f * x)); }
__device__ __forceinline__ void prep_phase(const Frame& F0, int l) {
    const Frame F = phase_frame(F0); unsigned char* const ws = F.ws;
    const bf16* Zs = (const bf16*)(ws + WS_ZS); bf16* STR = (bf16*)(ws + WS_STR);
    LAS bf16* lin = (LAS bf16*)F.lds;
    LAS float* ssum = (LAS float*)(F.lds + 12544);
    constexpr int TP = 72, TSZ = 16 * TP;
    LAS bf16* tiles = (LAS bf16*)(F.lds + 13312);
    const int lane = F.lane, fr = lane & 15, fq = lane >> 4, w = F.wave, tid = F.tid;
    const int nitems = (NROW / 16) * 2;
    int it = blockIdx.x; if (it >= nitems) return;
    int hh = -1, head = 0, cb = 0;
    bf16x8 wf[12][2];
    const float* kkp = inptr(I_KK) + l * DR; const float* kap = inptr(I_KA) + l * DR; const float* dw0 = inptr(I_DW0) + l * 2 * DR; const float* ia0 = inptr(I_IA0) + l * 2 * DR;
    u32x4 pz[2];
#define PREP_LOAD(item_) do { const int row0_ = ((item_) >> 1) * 16; \
        pz[0] = *(const u32x4*)(Zs + (size_t)(row0_ + tid / 48) * ZW + 1536 + (tid % 48) * 8); \
        if (tid < 256) pz[1] = *(const u32x4*)(Zs + (size_t)(row0_ + (tid + 512) / 48) * ZW + 1536 + ((tid + 512) % 48) * 8); } while (0)
    PREP_LOAD(it);
    for (; it < nitems; it += F.G) {
        const int tile = it >> 1;
        if ((it & 1) != hh) {
            hh = it & 1; head = 4 * hh + (w >> 1); cb = 64 * head + 32 * (w & 1);
            const bf16* WL = (const bf16*)(ws + WS_LORA) + (size_t)l * 512 * 384 + (size_t)(cb + fr) * 384 + 8 * fq;
#pragma unroll
            for (int ks = 0; ks < 12; ++ks)
#pragma unroll
                for (int nt = 0; nt < 2; ++nt) wf[ks][nt] = *(const bf16x8*)(WL + (size_t)nt * 16 * 384 + ks * 32);
        }
        __syncthreads();
        {   float v[8]; unpack8(pz[0], v); const int c8 = tid % 48;
            if (c8 < 16) {
#pragma unroll
                for (int j = 0; j < 8; ++j) v[j] = fast_tanh(v[j]); }
            else if (c8 >= 32) {
#pragma unroll
                for (int j = 0; j < 8; ++j) v[j] = fast_sigmoid(v[j]); }
            *(LAS u32x4*)(lin + (tid / 48) * LINP + c8 * 8) = (u32x4){pk2(v[0], v[1]), pk2(v[2], v[3]), pk2(v[4], v[5]), pk2(v[6], v[7])};
            if (tid < 256) { unpack8(pz[1], v); const int c9 = (tid + 512) % 48;
                if (c9 < 16) {
#pragma unroll
                    for (int j = 0; j < 8; ++j) v[j] = fast_tanh(v[j]); }
                else if (c9 >= 32) {
#pragma unroll
                    for (int j = 0; j < 8; ++j) v[j] = fast_sigmoid(v[j]); }
                *(LAS u32x4*)(lin + ((tid + 512) / 48) * LINP + c9 * 8) = (u32x4){pk2(v[0], v[1]), pk2(v[2], v[3]), pk2(v[4], v[5]), pk2(v[6], v[7])}; } }
        u32x2 zr2[2], zk2[2], zv2[2];
        {   const bf16* zr_ = Zs + (size_t)(tile * 16 + fr) * ZW + cb + 4 * fq;
#pragma unroll
            for (int nt = 0; nt < 2; ++nt) { zr2[nt] = *(const u32x2*)(zr_ + 16 * nt); zk2[nt] = *(const u32x2*)(zr_ + 512 + 16 * nt); zv2[nt] = *(const u32x2*)(zr_ + 1024 + 16 * nt); } }
        if (it + F.G < nitems) PREP_LOAD(it + F.G);
        __syncthreads();
        f32x4 kkw[2], kaw[2], d0w[2][2], i0w[2][2];
#pragma unroll
        for (int nt = 0; nt < 2; ++nt) { const int c0 = cb + 16 * nt + 4 * fq; kkw[nt] = *(const f32x4*)(kkp + c0); kaw[nt] = *(const f32x4*)(kap + c0);
#pragma unroll
            for (int dn = 0; dn < 2; ++dn) { d0w[dn][nt] = *(const f32x4*)(dw0 + dn * DR + c0); i0w[dn][nt] = *(const f32x4*)(ia0 + dn * DR + c0); } }
        f32x4 acc[5][2];
#pragma unroll
        for (int q = 0; q < 5; ++q) { acc[q][0] = (f32x4){0.f, 0.f, 0.f, 0.f}; acc[q][1] = (f32x4){0.f, 0.f, 0.f, 0.f}; }
#pragma unroll
        for (int ks = 0; ks < 12; ++ks) { const int q = ks < 8 ? (ks >> 1) : 4; const bf16x8 xf = *(const LAS bf16x8*)(lin + fr * LINP + ks * 32 + 8 * fq);
            acc[q][0] = MFMA16(wf[ks][0], xf, acc[q][0]); acc[q][1] = MFMA16(wf[ks][1], xf, acc[q][1]); }
        float zk[2][4], kv[2][4]; float ss = 0.f;
#pragma unroll
        for (int nt = 0; nt < 2; ++nt) { unpack4(zk2[nt], zk[nt]);
#pragma unroll
            for (int i = 0; i < 4; ++i) { kv[nt][i] = zk[nt][i] * kkw[nt][i]; ss += kv[nt][i] * kv[nt][i]; } }
        ss += __shfl_xor(ss, 16); ss += __shfl_xor(ss, 32);
        if (fq == 0) ssum[w * 16 + fr] = ss;
        __syncthreads();
        const float inv = __builtin_amdgcn_rcpf(fmaxf(sqrtf(ssum[w * 16 + fr] + ssum[(w ^ 1) * 16 + fr]), 1e-12f));
        LAS bf16* th = tiles + (w >> 1) * 10 * TSZ + fr * TP + 32 * (w & 1) + 4 * fq;
#pragma unroll
        for (int nt = 0; nt < 2; ++nt) { LAS bf16* t0 = th + 16 * nt;
            *(LAS u32x2*)(t0) = zr2[nt]; *(LAS u32x2*)(t0 + TSZ) = zv2[nt];
            float kk[4];
#pragma unroll
            for (int i = 0; i < 4; ++i) kk[i] = kv[nt][i] * inv;
            *(LAS u32x2*)(t0 + 2 * TSZ) = (u32x2){pk2(kk[0], kk[1]), pk2(kk[2], kk[3])};
            *(LAS u32x2*)(t0 + 3 * TSZ) = (u32x2){pk2(acc[4][nt][0], acc[4][nt][1]), pk2(acc[4][nt][2], acc[4][nt][3])};
#pragma unroll
            for (int dn = 0; dn < 2; ++dn) { float ep[4], kd[4], bb[4];
#pragma unroll
                for (int i = 0; i < 4; ++i) { const float ew = fast_sigmoid(d0w[dn][nt][i] + acc[dn][nt][i]) * 0.6065306597126334f;
                    ep[i] = ew * (1.f + ew * (-0.5f + ew * (0.16666667f + ew * (-0.041666668f + ew * 0.0083333338f))));
                    const float a = fast_sigmoid(i0w[dn][nt][i] + acc[2 + dn][nt][i]); kd[i] = zk[nt][i] * (1.f + (a - 1.f) * kaw[nt][i]); bb[i] = kk[i] * a; }
                *(LAS u32x2*)(t0 + (4 + 3 * dn) * TSZ) = (u32x2){pk2(ep[0], ep[1]), pk2(ep[2], ep[3])};
                *(LAS u32x2*)(t0 + (5 + 3 * dn) * TSZ) = (u32x2){pk2(kd[0], kd[1]), pk2(kd[2], kd[3])};
                *(LAS u32x2*)(t0 + (6 + 3 * dn) * TSZ) = (u32x2){pk2(bb[0], bb[1]), pk2(bb[2], bb[3])}; } }
        __syncthreads();
        {   const LAS bf16* src = tiles + (w >> 1) * 10 * TSZ + (8 * (w & 1) + (lane >> 3)) * TP + (lane & 7) * 8; bf16* dst = STR + ((size_t)tile * 8 + head) * 10240 + 8 * (w & 1) * 64 + lane * 8;
#pragma unroll
            for (int s = 0; s < 10; ++s) *(u32x4*)(dst + s * 1024) = *(const LAS u32x4*)(src + s * TSZ); }
    }
#undef PREP_LOAD
}

__device__ __forceinline__ int scan_rowof(int s, int dir, int b) { if (s < CTXL) { const int tc = dir ? (CTXL - 1 - s) : s; return NLAT + b * CTXL + tc; } const int tt = s - CTXL; const int t = dir ? (SEQ - 1 - tt) : tt; return b * SEQ + t; }
__device__ __forceinline__ void readout_pass(const Frame& F0, int l, int nrows) {
    const Frame F = phase_frame(F0); unsigned char* const ws = F.ws;
    const bf16* STR = (const bf16*)(ws + WS_STR); const bf16* Y0 = (const bf16*)(ws + WS_Y); const bf16* Y1 = Y0 + (size_t)NROW * DR; bf16* MA = (bf16*)(ws + WS_H);
    const int lane = F.lane, c = 8 * lane;
    float gw[8], gb[8], rk[8];
    {   const float* gnw = inptr(I_GNW) + l * DR + c; const float* gnb = inptr(I_GNB) + l * DR + c; const float* rkp = inptr(I_RK) + l * DR + c;
        const f32x4 a0 = *(const f32x4*)gnw, a1 = *(const f32x4*)(gnw + 4), b0 = *(const f32x4*)gnb, b1 = *(const f32x4*)(gnb + 4), r0 = *(const f32x4*)rkp, r1 = *(const f32x4*)(rkp + 4);
#pragma unroll
        for (int i = 0; i < 4; ++i) { gw[i] = a0[i]; gw[4 + i] = a1[i]; gb[i] = b0[i]; gb[4 + i] = b1[i]; rk[i] = r0[i]; rk[4 + i] = r1[i]; } }
    for (int row0 = F.gw; row0 < nrows; row0 += 2 * F.NGW) {
        u32x4 q[2][7]; bool ok[2];
#pragma unroll
        for (int u = 0; u < 2; ++u) { const int row = row0 + u * F.NGW; ok[u] = row < nrows; if (ok[u]) {
            const bf16* sr = STR + ((size_t)(row >> 4) * 8 + (lane >> 3)) * 10240 + (row & 15) * 64 + (lane & 7) * 8;
            q[u][0] = *(const u32x4*)(Y0 + (size_t)row * DR + c); q[u][1] = *(const u32x4*)(Y1 + (size_t)row * DR + c);
            q[u][2] = *(const u32x4*)sr; q[u][3] = *(const u32x4*)(sr + 1024); q[u][4] = *(const u32x4*)(sr + 3072); q[u][5] = *(const u32x4*)(sr + 5 * 1024); q[u][6] = *(const u32x4*)(sr + 8 * 1024); } }
#pragma unroll
        for (int u = 0; u < 2; ++u) if (ok[u]) { const int row = row0 + u * F.NGW;
            float ya[8], yb[8], r[8], v[8], g[8], k0[8], k1[8];
            unpack8(q[u][0], ya); unpack8(q[u][1], yb); unpack8(q[u][2], r); unpack8(q[u][3], v); unpack8(q[u][4], g); unpack8(q[u][5], k0); unpack8(q[u][6], k1);
            float s1 = 0.f, s2 = 0.f, sb = 0.f;
#pragma unroll
            for (int i = 0; i < 8; ++i) { ya[i] += yb[i]; s1 += ya[i]; s2 += ya[i] * ya[i]; sb += r[i] * (k0[i] + k1[i]) * rk[i]; }
#pragma unroll
            for (int o = 1; o < 8; o <<= 1) { s1 += __shfl_xor(s1, o); s2 += __shfl_xor(s2, o); sb += __shfl_xor(sb, o); }
            const float mu = s1 * (1.f / 64.f); const float var = fmaxf(s2 * (1.f / 64.f) - mu * mu, 0.f); const float rs = rsqrtf(var + GN_EPS);
            float o8[8];
#pragma unroll
            for (int i = 0; i < 8; ++i) o8[i] = ((ya[i] - mu) * rs * gw[i] + gb[i] + sb * v[i]) * g[i];
            *(u32x4*)(MA + (size_t)row * D + c) = (u32x4){pk2(o8[0], o8[1]), pk2(o8[2], o8[3]), pk2(o8[4], o8[5]), pk2(o8[6], o8[7])}; }
    }
}
constexpr int BLOB = 16384, SEGCH = 132, NSEG = 4, BLOB_B1_SCANS = 14;
constexpr size_t WS_BLOBA = 20 * MiB, WS_BLOBB1 = 86 * MiB, WS_BLOBB2 = 492 * MiB;
constexpr size_t WS_SCANST = 2 * MiB + 512 * 1024;
__device__ __forceinline__ unsigned char* blob_ptr(unsigned char* ws, int seg, int scan, int ci) {
    if ((seg & 1) == 0) return ws + WS_BLOBA + ((size_t)scan * SEGCH + ci) * BLOB;
    return scan < BLOB_B1_SCANS ? ws + WS_BLOBB1 + ((size_t)scan * SEGCH + ci) * BLOB : ws + WS_BLOBB2 + ((size_t)(scan - BLOB_B1_SCANS) * SEGCH + ci) * BLOB;
}
typedef short s16x4 __attribute__((ext_vector_type(4)));
__device__ __forceinline__ bf16x8 frag_lo(u32x2 x) { u32x4 t = {x.x, x.y, 0u, 0u}; return __builtin_bit_cast(bf16x8, t); }
__device__ __forceinline__ bf16x8 frag_c(const f32x4& a) { u32x4 t = {pk2(a[0], a[1]), pk2(a[2], a[3]), 0u, 0u}; return __builtin_bit_cast(bf16x8, t); }

struct PreRegs { u32x4 q[12]; };
__device__ __forceinline__ void pre_load(PreRegs& R, unsigned char* ws, int scan, int cs, int lane) {
    const int dir = scan & 1, h = (scan >> 1) & 7, b = scan >> 4; const int rfirst = scan_rowof(16 * cs, dir, b);
    const bf16* blk = (const bf16*)(ws + WS_STR) + ((size_t)(rfirst >> 4) * 8 + h) * 10240 + lane * 8;
    const int so[6] = {0, 1, 2, 4 + 3 * dir, 5 + 3 * dir, 6 + 3 * dir};
#pragma unroll
    for (int i = 0; i < 6; ++i) { R.q[2 * i] = *(const u32x4*)(blk + so[i] * 1024); R.q[2 * i + 1] = *(const u32x4*)(blk + so[i] * 1024 + 512); }
}
template <int PM>
__device__ __forceinline__ void pre_item(const Frame& F, unsigned char* ws, int scan, int cs, unsigned char* blob, PreRegs& PR, int nscan, int ncs) {
    const int dir = scan & 1, h = (scan >> 1) & 7, b = scan >> 4; const int lane = F.lane, fr = lane & 15, fq = lane >> 4;
    LAS unsigned char* L = F.lds + F.wave * 17408;
    LAS bf16* TK = (LAS bf16*)L; LAS bf16* TR = TK + 1024; LAS bf16* TKt = TR + 1024; LAS bf16* TB = TKt + 1024;
    LAS bf16* KTt = TB + 1024; LAS bf16* RTt = KTt + 1024; LAS bf16* Vt = RTt + 1024;
    LAS float* AKB = (LAS float*)(Vt + 1024);
    LAS bf16* AKK = (LAS bf16*)(AKB + 256); LAS bf16* ARK = AKK + 256; LAS bf16* ARB = ARK + 256; LAS bf16* TT = ARB + 256;
    float kh[16], bh[16];
    float pc;
    {   float r_[16], v_[16], kk_[16], lp_[16], kd_[16], bb_[16];
        LAS bf16* stg = TK;
#pragma unroll
        for (int i = 0; i < 6; ++i) { *(LAS u32x4*)(stg + i * 1024 + lane * 8) = PR.q[2 * i]; *(LAS u32x4*)(stg + i * 1024 + 512 + lane * 8) = PR.q[2 * i + 1]; }
        LDS_WAIT(); asm volatile("" ::: "memory");
        if (nscan >= 0) pre_load(PR, ws, nscan, ncs, lane);
#pragma unroll
        for (int t = 0; t < 16; ++t) { const int tm = (dir ? 15 - t : t) * 64 + lane;
            r_[t] = bf2f(stg[tm]); v_[t] = bf2f(stg[1024 + tm]); kk_[t] = bf2f(stg[2048 + tm]); lp_[t] = bf2f(stg[3072 + tm]); kd_[t] = bf2f(stg[4096 + tm]); bb_[t] = bf2f(stg[5120 + tm]); }
        LDS_WAIT(); asm volatile("" ::: "memory");
        float pp = 1.f; u32x4 kt4[2], rt4[2], v4[2];
        unsigned ktp[8], rtp[8], vp[8];
#pragma unroll
        for (int t = 0; t < 16; ++t) { const float pm1 = pp; pp *= 1.f - lp_[t]; const float p = pp, ip = __builtin_amdgcn_rcpf(pp); lp_[t] = ip;
            const float kt = kk_[t] * pm1, ktl = kd_[t] * ip, btl = bb_[t] * ip, rt = r_[t] * p;
            const unsigned hk = pk2(kt, rt), hb = pk2(ktl, btl);
            TK[t * 64 + lane] = (bf16)(hk & 0xffffu); TR[t * 64 + lane] = (bf16)(hk >> 16); TKt[t * 64 + lane] = (bf16)(hb & 0xffffu); TB[t * 64 + lane] = (bf16)(hb >> 16);
            const unsigned hv = f2bf(v_[t]);
            if (t & 1) { ktp[t >> 1] |= hk << 16; rtp[t >> 1] |= hk & 0xffff0000u; vp[t >> 1] |= hv << 16; }
            else { ktp[t >> 1] = hk & 0xffffu; rtp[t >> 1] = hk >> 16; vp[t >> 1] = hv; } }
        kt4[0] = (u32x4){ktp[0], ktp[1], ktp[2], ktp[3]}; kt4[1] = (u32x4){ktp[4], ktp[5], ktp[6], ktp[7]};
        rt4[0] = (u32x4){rtp[0], rtp[1], rtp[2], rtp[3]}; rt4[1] = (u32x4){rtp[4], rtp[5], rtp[6], rtp[7]};
        v4[0] = (u32x4){vp[0], vp[1], vp[2], vp[3]}; v4[1] = (u32x4){vp[4], vp[5], vp[6], vp[7]};
        *(LAS u32x4*)(KTt + lane * 16) = kt4[0]; *(LAS u32x4*)(KTt + lane * 16 + 8) = kt4[1];
        *(LAS u32x4*)(RTt + lane * 16) = rt4[0]; *(LAS u32x4*)(RTt + lane * 16 + 8) = rt4[1];
        *(LAS u32x4*)(Vt + lane * 16) = v4[0]; *(LAS u32x4*)(Vt + lane * 16 + 8) = v4[1];
        pc = pp;
#pragma unroll
        for (int t = 0; t < 16; ++t) { const float e = pp * lp_[t]; kh[t] = kd_[t] * e; bh[t] = bb_[t] * e; }
    }
    LDS_WAIT(); asm volatile("" ::: "memory");
    {   f32x4 akb = {0.f, 0.f, 0.f, 0.f}, akk = akb, ark = akb, arb = akb;
#pragma unroll
        for (int s = 0; s < 2; ++s) { const int o = fr * 64 + 32 * s + 8 * fq;
            const bf16x8 fk = *(const LAS bf16x8*)(TK + o), frr = *(const LAS bf16x8*)(TR + o), fkt = *(const LAS bf16x8*)(TKt + o), fb = *(const LAS bf16x8*)(TB + o);
            akb = MFMA16(fk, fb, akb); akk = MFMA16(fk, fkt, akk); ark = MFMA16(frr, fkt, ark); arb = MFMA16(frr, fb, arb); }
        float nm[4];
#pragma unroll
        for (int reg = 0; reg < 4; ++reg) { const int t = 4 * fq + reg; const bool lo = fr < t, le = fr <= t;
            nm[reg] = lo ? akb[reg] : 0.f; AKK[t * 16 + fr] = (bf16)f2bf(lo ? akk[reg] : 0.f);
            ARK[t * 16 + fr] = (bf16)f2bf(le ? ark[reg] : 0.f); ARB[t * 16 + fr] = (bf16)f2bf(le ? arb[reg] : 0.f); }
        float col[16];
#pragma unroll
        for (int t = 0; t < 16; ++t) { float s_ = (t == fr) ? 1.f : 0.f;
#pragma unroll
            for (int i = 0; i < 16; ++i) if (i < t) { const float n_ti = __builtin_bit_cast(float, __builtin_amdgcn_readlane(__builtin_bit_cast(int, nm[t & 3]), i + 16 * (t >> 2))); s_ -= n_ti * col[i]; }
            col[t] = s_; TT[t * 16 + fr] = (bf16)f2bf(s_); }
    }
    LDS_WAIT(); asm volatile("" ::: "memory");
    f32x4 WTc[4], RqT[4], U0c[4], Y0c[4];
    {   const bf16x8 aT = frag_lo(*(const LAS u32x2*)(TT + fr * 16 + 4 * fq)), aKK = frag_lo(*(const LAS u32x2*)(AKK + fr * 16 + 4 * fq)), aRK = frag_lo(*(const LAS u32x2*)(ARK + fr * 16 + 4 * fq));
        u32x2 nb = *(const LAS u32x2*)(ARB + fr * 16 + 4 * fq); nb.x ^= 0x80008000u; nb.y ^= 0x80008000u; const bf16x8 aRBn = frag_lo(nb);
        const f32x4 z4 = {0.f, 0.f, 0.f, 0.f};
#pragma unroll
        for (int nt = 0; nt < 4; ++nt) { const int o = (16 * nt + fr) * 16 + 4 * fq;
            const bf16x8 bK = frag_lo(*(const LAS u32x2*)(KTt + o)), bV = frag_lo(*(const LAS u32x2*)(Vt + o));
            float ri[4]; unpack4(*(const LAS u32x2*)(TR + fr * 64 + 16 * nt + 4 * fq), ri);
            const f32x4 Wn = MFMA16(aT, bK, z4); WTc[nt] = MFMA16(bK, aT, z4);
            const f32x4 Zn = MFMA16(aKK, bV, z4);
            U0c[nt] = MFMA16(aT, frag_c(Zn), z4);
            RqT[nt] = MFMA16(frag_c(Wn), aRBn, ((f32x4){ri[0], ri[1], ri[2], ri[3]}));
            Y0c[nt] = MFMA16(aRK, bV, z4); Y0c[nt] = MFMA16(aRBn, frag_c(U0c[nt]), Y0c[nt]); }
    }
    LDS_WAIT(); asm volatile("" ::: "memory");
#pragma unroll
    for (int nt = 0; nt < 4; ++nt) { const u32x2 vv = *(const LAS u32x2*)(Vt + (16 * nt + fr) * 16 + 4 * fq);
        *(u32x2*)(blob + 8192 + nt * 2048 + 1024 + lane * 8) = vv;
        u32x2 u0 = {pk2(U0c[nt][0], U0c[nt][1]), pk2(U0c[nt][2], U0c[nt][3])}, y0 = {pk2(Y0c[nt][0], Y0c[nt][1]), pk2(Y0c[nt][2], Y0c[nt][3])};
        *(u32x2*)(blob + 8192 + nt * 2048 + lane * 8) = u0; *(u32x2*)(blob + 8192 + nt * 2048 + 512 + lane * 8) = y0;
        *(float*)(blob + 8192 + nt * 2048 + 1536 + lane * 4) = pc; }
#pragma unroll
    for (int s = 0; s < 2; ++s) {
        *(u32x4*)(blob + (0 * 2 + s) * 1024 + lane * 16) = (u32x4){pk2(WTc[2 * s][0], WTc[2 * s][1]), pk2(WTc[2 * s][2], WTc[2 * s][3]), pk2(WTc[2 * s + 1][0], WTc[2 * s + 1][1]), pk2(WTc[2 * s + 1][2], WTc[2 * s + 1][3])};
        *(u32x4*)(blob + (1 * 2 + s) * 1024 + lane * 16) = (u32x4){pk2(RqT[2 * s][0], RqT[2 * s][1]), pk2(RqT[2 * s][2], RqT[2 * s][3]), pk2(RqT[2 * s + 1][0], RqT[2 * s + 1][1]), pk2(RqT[2 * s + 1][2], RqT[2 * s + 1][3])}; }
    LAS bf16* BHt = TKt; LAS bf16* KHt = TB;
    {   u32x4 a, c, d, e;
        a = (u32x4){pk2(bh[0], bh[1]), pk2(bh[2], bh[3]), pk2(bh[4], bh[5]), pk2(bh[6], bh[7])}; c = (u32x4){pk2(bh[8], bh[9]), pk2(bh[10], bh[11]), pk2(bh[12], bh[13]), pk2(bh[14], bh[15])};
        d = (u32x4){pk2(kh[0], kh[1]), pk2(kh[2], kh[3]), pk2(kh[4], kh[5]), pk2(kh[6], kh[7])}; e = (u32x4){pk2(kh[8], kh[9]), pk2(kh[10], kh[11]), pk2(kh[12], kh[13]), pk2(kh[14], kh[15])};
        *(LAS u32x4*)(BHt + lane * 16) = a; *(LAS u32x4*)(BHt + lane * 16 + 8) = c; *(LAS u32x4*)(KHt + lane * 16) = d; *(LAS u32x4*)(KHt + lane * 16 + 8) = e; }
    LDS_WAIT(); asm volatile("" ::: "memory");
#pragma unroll
    for (int mt = 0; mt < 4; ++mt) { const int o = (16 * mt + fr) * 16 + 4 * fq; const u32x2 bb = *(const LAS u32x2*)(BHt + o), kk = *(const LAS u32x2*)(KHt + o);
        *(u32x4*)(blob + 4096 + mt * 1024 + lane * 16) = (u32x4){bb.x ^ 0x80008000u, bb.y ^ 0x80008000u, kk.x, kk.y}; }
    LDS_WAIT(); asm volatile("" ::: "memory");
}

__device__ __forceinline__ void pre_phase(const Frame& F0, int seg, int b_lo) {
    const Frame F = phase_frame(F0); unsigned char* const ws = F.ws;
    if ((int)blockIdx.x < b_lo) return;
    const int nwv = (F.G - b_lo) * NWAVES;
    PreRegs R;
    int it = ((int)blockIdx.x - b_lo) * NWAVES + F.wave; if (it >= 32 * SEGCH) return;
    pre_load(R, ws, it & 31, seg * SEGCH + (it >> 5), F.lane);
    for (; it < 32 * SEGCH; it += nwv) { const int nx = it + nwv; const bool hn = nx < 32 * SEGCH;
        pre_item<0>(F, ws, it & 31, seg * SEGCH + (it >> 5), blob_ptr(ws, seg, it & 31, it >> 5), R, hn ? (nx & 31) : -1, seg * SEGCH + (nx >> 5)); }
}

constexpr int SQ_SLOT = 10240, SQ_R = 12, SQ_D = 8;
template <int MODE>
__device__ __forceinline__ void seq_item(const Frame& F0, int item, int seg, bool need_ctx) {
    const Frame F = phase_frame(F0); unsigned char* const ws = F.ws;
    const int scan = item >> 2, vb = item & 3, dir = scan & 1, h = (scan >> 1) & 7, b = scan >> 4; const int lane = F.lane, fr = lane & 15, fq = lane >> 4, w = F.wave;
    const unsigned char* blob = blob_ptr(ws, seg, scan, 0);
    LAS unsigned char* ring = F.lds;
    __syncthreads();
    const int p0 = 2 * (w - 1);
    const unsigned goff0 = (p0 < 8 ? p0 * 1024 : 8192 + vb * 2048 + (p0 - 8) * 1024) + lane * 16, goff1 = (p0 + 1 < 8 ? (p0 + 1) * 1024 : 8192 + vb * 2048 + (p0 + 1 - 8) * 1024) + lane * 16;
#define SQ_ISSUE(c) do { const unsigned char* g_ = blob + (size_t)(c) * BLOB; LAS unsigned char* s_ = ring + ((c) % SQ_R) * SQ_SLOT + p0 * 1024; \
        __builtin_amdgcn_global_load_lds((const unsigned*)(g_ + goff0), (LAS unsigned*)(s_), 16, 0, 0); \
        __builtin_amdgcn_global_load_lds((const unsigned*)(g_ + goff1), (LAS unsigned*)(s_ + 1024), 16, 0, 0); } while (0)
    const bool loader = (w >= 1 && w <= 5) && MODE != 2;
    if (loader) { for (int c = 0; c < SQ_D; ++c) SQ_ISSUE(c); }
    bf16* Y = (bf16*)(ws + WS_Y) + (size_t)dir * NROW * DR + h * 64 + 16 * vb + fr;
    float* st = (float*)(ws + WS_SCANST) + (size_t)item * 1024 + lane * 4;
    f32x4 M[4];
#pragma unroll
    for (int mt = 0; mt < 4; ++mt) M[mt] = (seg == 0 || w != 0) ? (f32x4){0.f, 0.f, 0.f, 0.f} : *(const f32x4*)(st + mt * 256);
    const f32x4 z4 = {0.f, 0.f, 0.f, 0.f};
    LAS unsigned char* mb = ring + SQ_R * SQ_SLOT;
    struct SQ { bf16x8 a1[2], a2[4]; f32x4 pc[4]; u32x2 u0, vv; };
#define SQ_READ(R, c) do { const LAS unsigned char* sl_ = ring + ((c) % SQ_R) * SQ_SLOT; _Pragma("unroll") for (int i = 0; i < 4; ++i) { \
        R.a2[i] = *(const LAS bf16x8*)(sl_ + 4096 + i * 1024 + lane * 16); R.pc[i] = *(const LAS f32x4*)(sl_ + 8192 + 1536 + (16 * i + 4 * fq) * 4); } \
        R.a1[0] = *(const LAS bf16x8*)(sl_ + lane * 16); R.a1[1] = *(const LAS bf16x8*)(sl_ + 1024 + lane * 16); \
        R.u0 = *(const LAS u32x2*)(sl_ + 8192 + lane * 8); R.vv = *(const LAS u32x2*)(sl_ + 8192 + 1024 + lane * 8); } while (0)
#define SQ_STEP(R, c, RN, cn) do { \
        if ((cn) < SEGCH) SQ_READ(RN, cn); \
        const u32x4 t0 = {pk2(M[0][0], M[0][1]), pk2(M[0][2], M[0][3]), pk2(M[1][0], M[1][1]), pk2(M[1][2], M[1][3])}; \
        const u32x4 t1 = {pk2(M[2][0], M[2][1]), pk2(M[2][2], M[2][3]), pk2(M[3][0], M[3][1]), pk2(M[3][2], M[3][3])}; \
        *(LAS u32x4*)(mb + ((c) & 1) * 2048 + lane * 16) = t0; *(LAS u32x4*)(mb + ((c) & 1) * 2048 + 1024 + lane * 16) = t1; \
        const bf16x8 b0 = __builtin_bit_cast(bf16x8, t0), b1 = __builtin_bit_cast(bf16x8, t1); \
        f32x4 X0 = MFMA16(R.a1[0], b0, z4); X0 = MFMA16(R.a1[1], b1, X0); \
        float u0[4]; unpack4(R.u0, u0); \
        const u32x4 tb = {pk2(X0[0] + u0[0], X0[1] + u0[1]), pk2(X0[2] + u0[2], X0[3] + u0[3]), R.vv.x, R.vv.y}; const bf16x8 bB = __builtin_bit_cast(bf16x8, tb); \
        _Pragma("unroll") for (int mt = 0; mt < 4; ++mt) M[mt] = MFMA16(R.a2[mt], bB, R.pc[mt] * M[mt]); \
        asm volatile("s_waitcnt lgkmcnt(0)" ::: "memory"); } while (0)
    const long ystep = dir ? -(long)DR : (long)DR;
#define SQ_YSTEP(c) do { const int cs_ = seg * SEGCH + (c); if (MODE == 0 && (need_ctx || cs_ >= 16)) { const LAS unsigned char* sl_ = ring + ((c) % SQ_R) * SQ_SLOT; \
        const bf16x8 q0 = *(const LAS bf16x8*)(sl_ + 2048 + lane * 16), q1 = *(const LAS bf16x8*)(sl_ + 3072 + lane * 16); \
        const bf16x8 b0 = *(const LAS bf16x8*)(mb + ((c) & 1) * 2048 + lane * 16), b1 = *(const LAS bf16x8*)(mb + ((c) & 1) * 2048 + 1024 + lane * 16); \
        float y0[4]; unpack4(*(const LAS u32x2*)(sl_ + 8192 + 512 + lane * 8), y0); \
        f32x4 X1 = MFMA16(q0, b0, z4); X1 = MFMA16(q1, b1, X1); \
        bf16* yp = Y + (size_t)scan_rowof(16 * cs_ + 4 * fq, dir, b) * DR; \
        yp[0] = (bf16)f2bf(X1[0] + y0[0]); yp[ystep] = (bf16)f2bf(X1[1] + y0[1]); yp[2 * ystep] = (bf16)f2bf(X1[2] + y0[2]); yp[3 * ystep] = (bf16)f2bf(X1[3] + y0[3]); \
        asm volatile("s_waitcnt lgkmcnt(0)" ::: "memory"); } } while (0)
#define SQ_LOADER(c) do { if (loader) { if ((c) + SQ_D < SEGCH) { SQ_ISSUE((c) + SQ_D); asm volatile("s_waitcnt vmcnt(12)" ::: "memory"); } else asm volatile("s_waitcnt vmcnt(0)" ::: "memory"); } \
        __builtin_amdgcn_s_barrier(); asm volatile("" ::: "memory"); } while (0)
    const bool stw = (w == 0 && MODE != 1), yw = (w == 6 && MODE != 1);
    SQ Ra, Rb, Rc;
    SQ_LOADER(0);
    if (stw) { SQ_READ(Ra, 0); SQ_READ(Rb, 1); }
    for (int c = 0; c < SEGCH; c += 3) {
        SQ_LOADER(c + 1);
        if (stw) SQ_STEP(Ra, c, Rc, c + 2);
        if (yw && c > 0) SQ_YSTEP(c - 1);
        SQ_LOADER(c + 2);
        if (stw) SQ_STEP(Rb, c + 1, Ra, c + 3);
        if (yw) SQ_YSTEP(c);
        SQ_LOADER(c + 3);
        if (stw) SQ_STEP(Rc, c + 2, Rb, c + 4);
        if (yw) SQ_YSTEP(c + 1);
    }
    __builtin_amdgcn_s_barrier(); asm volatile("" ::: "memory");
    if (yw) SQ_YSTEP(SEGCH - 1);
#undef SQ_READ
#undef SQ_STEP
#undef SQ_YSTEP
#undef SQ_LOADER
#undef SQ_ISSUE
    if (MODE >= 2 && w == 0 && M[0][0] + M[1][1] + M[2][2] + M[3][3] == 12345.678f) st[0] = M[0][0];
    if (MODE == 0 && w == 0 && seg + 1 < NSEG) {
#pragma unroll
        for (int mt = 0; mt < 4; ++mt) *(f32x4*)(st + mt * 256) = M[mt]; }
    __syncthreads();
}

namespace pg8 {
struct EpiStoreBf16 {
    static constexpr bool PERM = true, AFTER_DRAIN = false;
    bf16_t* O; int ldc; int pn_mask;
    __device__ __forceinline__ void operator()(const f32x4 (&acc)[2][2][4][2], const Unit& u, int wr, int wc, int fr, int fq) const {
        const int row0 = u.pm * BM + wr * 64 + fr; const int col0 = (u.pn & pn_mask) * BM + wc * 32 + 8 * fq;
#pragma unroll
        for (int ai = 0; ai < 2; ++ai)
#pragma unroll
            for (int m = 0; m < 4; ++m) { bf16_t* rowp = O + (size_t)(row0 + ai * HALF + m * 16) * ldc + col0;
#pragma unroll
                for (int bj = 0; bj < 2; ++bj) { const f32x4 v0 = acc[ai][bj][m][0], v1 = acc[ai][bj][m][1];
                    u32x4 w; w.x = cvt_pk_bf16(v0[0], v0[1]); w.y = cvt_pk_bf16(v0[2], v0[3]); w.z = cvt_pk_bf16(v1[0], v1[1]); w.w = cvt_pk_bf16(v1[2], v1[3]);
                    *(u32x4*)(rowp + bj * HALF) = w; } }
    }
};
struct EpiSwiGLU {
    static constexpr bool PERM = true, AFTER_DRAIN = false;
    bf16_t* O;
    __device__ __forceinline__ void operator()(const f32x4 (&acc)[2][2][4][2], const Unit& u, int wr, int wc, int fr, int fq) const {
        const int row0 = u.pm * BM + wr * 64 + fr; const int col0 = ((u.pn & 3) * BM + wc * 32 + 8 * fq) >> 1;
#pragma unroll
        for (int ai = 0; ai < 2; ++ai)
#pragma unroll
            for (int m = 0; m < 4; ++m) { bf16_t* rowp = O + (size_t)(row0 + ai * HALF + m * 16) * 512 + col0;
#pragma unroll
                for (int bj = 0; bj < 2; ++bj) { const f32x4 g = acc[ai][bj][m][0], up = acc[ai][bj][m][1]; float a[4];
#pragma unroll
                    for (int i = 0; i < 4; ++i) a[i] = g[i] / (1.f + __expf(-g[i])) * up[i];
                    unsigned long long w = (unsigned long long)cvt_pk_bf16(a[0], a[1]) | ((unsigned long long)cvt_pk_bf16(a[2], a[3]) << 32);
                    *(unsigned long long*)(rowp + bj * (HALF / 2)) = w; } }
    }
};
template <bool XF32> struct EpiResidual {
    static constexpr bool PERM = false, AFTER_DRAIN = false;
    const void* xlat; const void* xctx;
    bf16_t* out; const float* g1;
    __device__ __forceinline__ void operator()(const f32x4 (&acc)[2][2][4][2], const Unit& u, int wr, int wc, int fr, int fq) const {
        const int rowt = u.pm * BM; const int mr = rowt < 16384 ? (rowt >> 13) : 2;
        const size_t boff = rowt < 16384 ? (size_t)rowt * 1024 : (size_t)(rowt - 16384) * 1024; const void* bp = rowt < 16384 ? xlat : xctx;
        const int col0 = u.pn * BM + wc * 32 + 4 * fq;
        f32x4 gv[2][2];
#pragma unroll
        for (int bj = 0; bj < 2; ++bj)
#pragma unroll
            for (int n = 0; n < 2; ++n) gv[bj][n] = *(const f32x4*)(g1 + (size_t)mr * 6144 + col0 + bj * HALF + n * 16);
#pragma unroll
        for (int ai = 0; ai < 2; ++ai)
#pragma unroll
            for (int m = 0; m < 4; ++m) { const int rl = ai * HALF + wr * 64 + m * 16 + fr;
#pragma unroll
                for (int bj = 0; bj < 2; ++bj)
#pragma unroll
                    for (int n = 0; n < 2; ++n) { const size_t off = (size_t)rl * 1024 + col0 + bj * HALF + n * 16;
                        f32x4 xo;
                        if (XF32) xo = *(const f32x4*)((const float*)bp + boff + off);
                        else { const unsigned long long w_ = *(const unsigned long long*)((const bf16_t*)bp + boff + off); const unsigned lo = (unsigned)w_, hi = (unsigned)(w_ >> 32);
                            xo = (f32x4){__uint_as_float(lo << 16), __uint_as_float(lo & 0xffff0000u), __uint_as_float(hi << 16), __uint_as_float(hi & 0xffff0000u)}; }
                        const f32x4 r = xo + gv[bj][n] * acc[ai][bj][m][n];
                        *(unsigned long long*)(out + (size_t)rowt * 1024 + off) = (unsigned long long)cvt_pk_bf16(r[0], r[1]) | ((unsigned long long)cvt_pk_bf16(r[2], r[3]) << 32); } }
    }
};
struct MoeOrder {
    const PG8_LAS int* tile_e; const PG8_LAS int* tile_t; int ntiles, G, c;
    __device__ bool next(int i, Unit& u) const { const long L = (long)i * G + c; if (L >= 4L * ntiles) return false; const int pm = (int)(L >> 2); const int e = tile_e[pm];
        u.pm = pm; u.pn = e * 4 + (int)(L & 3); u.ga = e * 16896 + tile_t[pm] * 256; return true; }
    __device__ __forceinline__ void a_ready(const Unit&) const {}
    __device__ __forceinline__ void done(const Unit&) const {}
};
}

__device__ __forceinline__ void expert_convert(const Frame& F0, int l, int b_lo) {
    const Frame F = phase_frame(F0); unsigned char* const ws = F.ws;
    if ((int)blockIdx.x < b_lo) return;
    const int nwv = (F.G - b_lo) * NWAVES, myw = ((int)blockIdx.x - b_lo) * NWAVES + F.wave;
    LAS float* scr = (LAS float*)(F.lds + F.wave * 16384);
    bf16* wgu = (bf16*)(ws + WS_WGU_T); bf16* wd = (bf16*)(ws + WS_WD_T);
    constexpr int I_G = 16 * 16, I_D = 8 * 32;
    constexpr int NIT = NEXP * (2 * I_G + I_D);
    const float* p_eg = inptr(I_EG); const float* p_eu = inptr(I_EU); const float* p_ed = inptr(I_ED);
    for (int it = myw; it < NIT; it += nwv) { const int e = it / (2 * I_G + I_D); int r = it % (2 * I_G + I_D);
        if (r < I_G) { transpose_item(p_eg + ((size_t)l * NEXP + e) * D * DEXP, DEXP, (r >> 4) * 64, (r & 15) * 32, wgu, D, RmGU{e * 1024}, scr, F.lane); continue; } r -= I_G;
        if (r < I_G) { transpose_item(p_eu + ((size_t)l * NEXP + e) * D * DEXP, DEXP, (r >> 4) * 64, (r & 15) * 32, wgu, D, RmGU{e * 1024 + 4}, scr, F.lane); continue; } r -= I_G;
        transpose_item(p_ed + ((size_t)l * NEXP + e) * DEXP * D, D, (r >> 5) * 64, (r & 31) * 32, wd, DEXP, RmId{e * 1024}, scr, F.lane);
    }
}

__device__ __forceinline__ void router_pass(const Frame& F0, int l, int nrows, int cnt_off = 0) {
    const Frame F = phase_frame(F0); unsigned char* const ws = F.ws;
    constexpr int HP = 1028;
    LAS float* msh = (LAS float*)F.lds; LAS float* msc = msh + 3072; LAS float* hrow = msc + 3072;
    LAS float* part = hrow + 16 * HP;
    LAS float* lgs = part + 8 * 16 * 48;
    LAS unsigned* lcnt = (LAS unsigned*)(lgs + 16 * 40);
    if (F0.tid < 64) lcnt[F0.tid] = 0u;
    __syncthreads();
    mod_to_lds(F, l, 3, msh, false); mod_to_lds(F, l, 4, msc, false); __syncthreads();
    const bf16* X = (const bf16*)(ws + WS_X); bf16* H = (bf16*)(ws + WS_H);
    const float* rgw = inptr(I_RGW) + (size_t)l * D * 4; const float* rew = inptr(I_REW) + (size_t)l * D * NEXP;
    const float* rgb = inptr(I_RGB) + l * 4; const float* reb = inptr(I_REB) + l * NEXP;
    int* rt_e = (int*)(ws + WS_ROUTE + RT_E); int* rt_pos = (int*)(ws + WS_ROUTE + RT_POS); float* rt_gate = (float*)(ws + WS_ROUTE + RT_GATE);
    unsigned* cnt = (unsigned*)(ws + WS_CTL) + CW_CNT + 64 * l + cnt_off;
    const int lane = F.lane, w = F.wave, fr = lane & 15, fq = lane >> 4; const float* n2g = inptr(I_N2G) + l * D;
    float bw[32][3];
#pragma unroll
    for (int ks = 0; ks < 32; ++ks) { const int k = 128 * w + 4 * ks + fq;
        bw[ks][0] = rew[(size_t)k * 32 + fr]; bw[ks][1] = rew[(size_t)k * 32 + 16 + fr]; bw[ks][2] = fr < 4 ? rgw[(size_t)k * 4 + fr] : 0.f; }
    const int ntiles = nrows >> 4;
    u32x2 pv[2][4];
    if (F.vcu < ntiles) {
#pragma unroll
        for (int rr = 0; rr < 2; ++rr)
#pragma unroll
            for (int j = 0; j < 4; ++j) pv[rr][j] = *(const u32x2*)(X + (size_t)(F.vcu * 16 + 2 * w + rr) * D + 4 * lane + 256 * j); }
    for (int gi = F.vcu; gi < ntiles; gi += F.G) {
#pragma unroll
        for (int rr = 0; rr < 2; ++rr) { const int r = 2 * w + rr, row = gi * 16 + r; f32x4 v[4];
#pragma unroll
            for (int j = 0; j < 4; ++j) { float t_[4]; unpack4(pv[rr][j], t_); v[j] = (f32x4){t_[0], t_[1], t_[2], t_[3]}; }
            const int mr = modrow(row);
            norm_mod_row(v, n2g, msc + mr * 1024, msh + mr * 1024, H + (size_t)row * D, lane);
#pragma unroll
            for (int j = 0; j < 4; ++j) *(LAS f32x4*)(hrow + r * HP + 4 * lane + 256 * j) = v[j]; }
        if (gi + F.G < ntiles) {
#pragma unroll
            for (int rr = 0; rr < 2; ++rr)
#pragma unroll
                for (int j = 0; j < 4; ++j) pv[rr][j] = *(const u32x2*)(X + (size_t)((gi + F.G) * 16 + 2 * w + rr) * D + 4 * lane + 256 * j); }
        __syncthreads();
        {   f32x4 acc[3] = {{0.f, 0.f, 0.f, 0.f}, {0.f, 0.f, 0.f, 0.f}, {0.f, 0.f, 0.f, 0.f}};
#pragma unroll
            for (int ks = 0; ks < 32; ++ks) { const float a = hrow[fr * HP + 128 * w + 4 * ks + fq];
#pragma unroll
                for (int nt = 0; nt < 3; ++nt) acc[nt] = __builtin_amdgcn_mfma_f32_16x16x4f32(a, bw[ks][nt], acc[nt], 0, 0, 0); }
#pragma unroll
            for (int nt = 0; nt < 3; ++nt)
#pragma unroll
                for (int reg = 0; reg < 4; ++reg) part[(w * 16 + 4 * fq + reg) * 48 + 16 * nt + fr] = acc[nt][reg]; }
        __syncthreads();
        for (int idx = F.tid; idx < 16 * 36; idx += NTHR) { const int r = idx / 36, n = idx % 36; float s_ = 0.f;
#pragma unroll
            for (int ww = 0; ww < 8; ++ww) s_ += part[(ww * 16 + r) * 48 + n];
            if (n < 32) lgs[r * 40 + 4 + n] = s_ + reb[n]; else lgs[r * 40 + n - 32] = s_ + rgb[n - 32]; }
        __syncthreads();
        if (F.tid < 16) { const int rr = gi * 16 + F.tid; const LAS float* lp = lgs + F.tid * 40;
            int grp = 0; float mx = lp[0];
#pragma unroll
            for (int g = 1; g < 4; ++g) if (lp[g] > mx) { mx = lp[g]; grp = g; }
            float den = 0.f;
#pragma unroll
            for (int g = 0; g < 4; ++g) den += __expf(lp[g] - mx);
            const float pg_top = 1.f / den; const LAS float* sel = lp + 4 + grp * 8;
            int i0 = 0; float l0 = sel[0];
#pragma unroll
            for (int q = 1; q < 8; ++q) if (sel[q] > l0) { l0 = sel[q]; i0 = q; }
            int i1 = -1; float l1 = -3.0e38f;
#pragma unroll
            for (int q = 0; q < 8; ++q) if (q != i0 && sel[q] > l1) { l1 = sel[q]; i1 = q; }
            const float e1 = __expf(l1 - l0); const float w0 = pg_top / (1.f + e1), w1 = pg_top * e1 / (1.f + e1);
            const int ea = grp * 8 + i0, eb = grp * 8 + i1;
            const unsigned pa = atomicAdd((unsigned*)(lcnt + ea), 1u), pb = atomicAdd((unsigned*)(lcnt + eb), 1u);
            rt_e[2 * rr] = ea; rt_e[2 * rr + 1] = eb; rt_pos[2 * rr] = (int)pa; rt_pos[2 * rr + 1] = (int)pb; rt_gate[2 * rr] = w0; rt_gate[2 * rr + 1] = w1; }
    }
    __syncthreads();
    if (F.tid < 32) lcnt[32 + F.tid] = lcnt[F.tid] ? atomicAdd(cnt + F.tid, lcnt[F.tid]) : 0u;
    __syncthreads();
    int* elist = (int*)(ws + WS_ELIST);
    if (F.tid < 16) for (int gi = F.vcu; gi < ntiles; gi += F.G) { const int rr = gi * 16 + F.tid;
        const int ea = rt_e[2 * rr], eb = rt_e[2 * rr + 1]; const int pa = rt_pos[2 * rr] + (int)lcnt[32 + ea], pb = rt_pos[2 * rr + 1] + (int)lcnt[32 + eb];
        rt_pos[2 * rr] = pa; rt_pos[2 * rr + 1] = pb; elist[(size_t)ea * NROW + pa] = rr; elist[(size_t)eb * NROW + pb] = rr; }
}

constexpr int MOE_MAP_OFF = 131072;
__device__ __forceinline__ void moe_map(const Frame& F0, int l) {
    const Frame F = phase_frame(F0); unsigned char* const ws = F.ws;
    LAS int* mp = (LAS int*)(F.lds + MOE_MAP_OFF);
    const unsigned* cnt = (const unsigned*)(ws + WS_CTL) + CW_CNT + 64 * l;
    __syncthreads();
    if (F.tid < NEXP) mp[32 + F.tid] = (int)__hip_atomic_load(cnt + F.tid, __ATOMIC_RELAXED, __HIP_MEMORY_SCOPE_AGENT);
    __syncthreads();
    if (F.tid == 0) { int o = 0;
#pragma nounroll
        for (int e = 0; e < NEXP; ++e) { const int c = mp[32 + e]; const int nt = (c + 255) >> 8; mp[e] = o;
#pragma nounroll
            for (int t = 0; t < nt; ++t) { mp[128 + (o >> 8) + t] = e; mp[320 + (o >> 8) + t] = t; }
            o += nt << 8; }
        mp[64] = o >> 8; }
    __syncthreads();
}

template <bool DRY>
__device__ __forceinline__ void combine_pass(const Frame& F0, int l, int nrows) {
    const Frame F = phase_frame(F0); unsigned char* const ws = F.ws;
    LAS float* mg2 = (LAS float*)F.lds; LAS float* msh = mg2 + 3072; LAS float* msc = msh + 3072;
    const bool last = (l == DEPTH - 1);
    __syncthreads();
    mod_to_lds(F, l, 5, mg2, false); if (!last) { mod_to_lds(F, l + 1, 0, msh, false); mod_to_lds(F, l + 1, 1, msc, false); }
    __syncthreads();
    bf16* X = (bf16*)(ws + WS_X); bf16* H = (bf16*)(ws + WS_H); const bf16* Ys = (const bf16*)(ws + WS_XS);
    const int* rt_e = (const int*)(ws + WS_ROUTE + RT_E); const int* rt_pos = (const int*)(ws + WS_ROUTE + RT_POS); const float* rt_gate = (const float*)(ws + WS_ROUTE + RT_GATE);
    const LAS int* moff = (const LAS int*)(F.lds + MOE_MAP_OFF);
    const int lane = F.lane; const float* n1g = inptr(I_N1G) + (last ? 0 : (l + 1) * D); const float* fgp = inptr(I_FG);
    for (int row0 = F.gw; row0 < nrows; row0 += 2 * F.NGW) {
        int s0[2], s1[2]; float w0[2], w1[2]; bool ok[2]; u32x2 ya[2][4], yb[2][4], xo[2][4];
#pragma unroll
        for (int u = 0; u < 2; ++u) { const int row = row0 + u * F.NGW; ok[u] = row < nrows; if (ok[u]) { s0[u] = moff[rt_e[2 * row]] + rt_pos[2 * row]; s1[u] = moff[rt_e[2 * row + 1]] + rt_pos[2 * row + 1]; w0[u] = rt_gate[2 * row]; w1[u] = rt_gate[2 * row + 1]; } }
#pragma unroll
        for (int u = 0; u < 2; ++u) if (ok[u]) { const int row = row0 + u * F.NGW;
#pragma unroll
            for (int j = 0; j < 4; ++j) { const int c = 4 * lane + 256 * j; ya[u][j] = *(const u32x2*)(Ys + (size_t)s0[u] * D + c); yb[u][j] = *(const u32x2*)(Ys + (size_t)s1[u] * D + c); xo[u][j] = *(const u32x2*)(X + (size_t)row * D + c); } }
#pragma unroll
        for (int u = 0; u < 2; ++u) if (ok[u]) { const int row = row0 + u * F.NGW; const int mr = modrow(row); f32x4 v[4];
#pragma unroll
            for (int j = 0; j < 4; ++j) { const int c = 4 * lane + 256 * j; float a[4], b[4]; unpack4(ya[u][j], a); unpack4(yb[u][j], b);
                const f32x4 g2 = *(const LAS f32x4*)(mg2 + mr * 1024 + c);
                f32x4 y; y.x = w0[u] * a[0] + w1[u] * b[0]; y.y = w0[u] * a[1] + w1[u] * b[1]; y.z = w0[u] * a[2] + w1[u] * b[2]; y.w = w0[u] * a[3] + w1[u] * b[3];
                float x_[4]; unpack4(xo[u][j], x_); v[j] = (f32x4){x_[0], x_[1], x_[2], x_[3]} + g2 * y; }
            if (DRY) { asm volatile("" :: "v"(v[0].x + v[1].y + v[2].z + v[3].w)); }
            else if (!last) {
#pragma unroll
                for (int j = 0; j < 4; ++j) *(u32x2*)(X + (size_t)row * D + 4 * lane + 256 * j) = (u32x2){pk2(v[j].x, v[j].y), pk2(v[j].z, v[j].w)};
                norm_mod_row(v, n1g, msc + mr * 1024, msh + mr * 1024, H + (size_t)row * D, lane);
            } else { float s = 0.f;
#pragma unroll
                for (int j = 0; j < 4; ++j) s += (v[j].x * v[j].x + v[j].y * v[j].y) + (v[j].z * v[j].z + v[j].w * v[j].w);
                const float rs = rsqrtf(wave_sum(s) * (1.f / D) + RMS_EPS);
#pragma unroll
                for (int j = 0; j < 4; ++j) { const int c = 4 * lane + 256 * j; const f32x4 g = *(const f32x4*)(fgp + c); *(f32x4*)(F.out + (size_t)row * D + c) = v[j] * rs * g; } } }
    }
}
__global__ void __launch_bounds__(NTHR, 2) fwd_megakernel(Params prm) {
    extern __shared__ __attribute__((aligned(16))) unsigned char lds_raw[];
    Frame F;
    F.lds = (LAS unsigned char*)lds_raw;
    F.tid = threadIdx.x; F.lane = F.tid & 63; F.wave = __builtin_amdgcn_readfirstlane(F.tid >> 6);
    F.G = gridDim.x; { const int bx = blockIdx.x; F.vcu = (F.G % 8 == 0) ? (bx % 8) * (F.G / 8) + bx / 8 : bx; }
    F.gw = F.vcu * NWAVES + F.wave; F.NGW = F.G * NWAVES;
    F.out = prm.out; F.ws = prm.ws;
    for (int u = F.tid; u < (LDS_BYTES - LDSCTL_OFF) / 4; u += NTHR) ((LAS unsigned*)(F.lds + LDSCTL_OFF))[u] = 0u;
    __syncthreads();
    (void)xcd_barrier_post((unsigned*)(F.ws + WS_CTL) + CW_BAR, (volatile LAS unsigned*)(F.lds + MISC_OFF) + 8);
#define GRID_BAR() do { XcdBarrier bar_; bar_.bar = (unsigned*)(opaque(F.ws) + WS_CTL) + CW_BAR; bar_.x = xb_xcc_id(); bar_.st = (volatile LAS unsigned*)(F.lds + MISC_OFF) + 8; xcd_barrier(bar_); } while (0)

    p0_prologue(F);
#if USE_CG_SYNC
    cg::this_grid().sync();
#else
    GRID_BAR();
#endif
    p0b_norm1(F);
    GRID_BAR();

    for (int l = 0; l < DEPTH; ++l) {
        const bool need_ctx = (l == 0); const int nrows = need_ctx ? NROW : NLAT;
#define WSO Fp.ws
        {
            const Frame Fp = phase_frame(F); unsigned char* const ws = WSO; bf16* Hb = (bf16*)(ws + WS_H); bf16* Pb = (bf16*)(ws + WS_P);
            pg8::Gemm g{Hb, (const bf16*)(ws + WS_WIN_T) + (size_t)l * NP * D, NROW, NP, D}; pg8::StaticOrder S; S.init(NROW, NP, Fp.G, (int)blockIdx.x);
            pg8::EpiStoreBf16 E{Pb, NP, 0xffff};
            pg8::gemm_phase<pg8::EpiStoreBf16, pg8::StaticOrder, true, true>(F.lds, g, S, E);
        }
        GRID_BAR();
        {
            const Frame Fp = phase_frame(F); unsigned char* const ws = WSO; bf16* Pb = (bf16*)(ws + WS_P);
            for (int it = blockIdx.x; it < 256; it += F.G) fftA_item(F, it);
            if (need_ctx) for (int it = (int)blockIdx.x - (F.G >= 64 ? F.G - 32 : 0); it >= 0 && it < 32; it += F.G) { const int b = it >> 4, m0 = (it & 15) * 16;
                const bf16* src0 = Pb + (size_t)(NLAT + b * CTXL) * NP + COL_FC;
                dft64_item<4, 256, 1>(F, l, m0, -1.f, 1.f / 128.f, [=](int t, int ri) { return src0 + (size_t)t * NP + ri * 256; }, [=](int m) { return NLAT + b * CTXL + m; }); }
            shift_pass(F, l);
            conv_pass(F, l, nrows);
        }
        GRID_BAR();
        {
            const Frame Fp = phase_frame(F); unsigned char* const ws = WSO;
            prep_phase(F, l);
        }
        GRID_BAR();
        for (int seg = -1; seg < NSEG; ++seg) {
            const bool split = (F.G == 256);
            if (seg + 1 < NSEG) pre_phase(F, seg + 1, (seg >= 0 && split) ? 128 : 0);
            if (seg + 1 == NSEG && (!split || blockIdx.x >= 128)) { unsigned char* const ws = opaque(F.ws); int bx_ = (int)blockIdx.x; asm volatile("" : "+s"(bx_));
                const int first_ = split ? bx_ - 128 : bx_, stride_ = split ? 128 : F.G;
                for (int it = first_; it < 256; it += stride_) { const int b = it >> 7, t1p = it & 127;
                    const bf16* src0 = (const bf16*)(ws + WS_GT) + (size_t)(b * 128 + t1p) * 64 * 512;
                    dft64_item<1, 64, 4>(F, l, 0, 1.f, 0.0013810679320049757f, [=](int t, int ri) { return src0 + (size_t)t * 512 + ri * 256; }, [=](int m) { return b * SEQ + t1p + 128 * m; }); } }
            if (seg >= 0) for (int it = blockIdx.x; it < 128; it += F.G) { const int x_ = it & 7, j_ = it >> 3;
                seq_item<0>(F, ((x_ + 8 * (j_ >> 2)) << 2) | (j_ & 3), seg, need_ctx); }
            GRID_BAR();
        }
        readout_pass(F, l, nrows);
        GRID_BAR();
        const int cv_lo = (nrows / 256) * 4 > F.G ? (nrows / 256) * 4 - F.G : 0;
        if (blockIdx.x & 1) expert_convert(F, l, cv_lo);
        {
            const Frame Fp = phase_frame(F); unsigned char* const ws = WSO; bf16* Hb = (bf16*)(ws + WS_H);
            pg8::Gemm g{Hb, (const bf16*)(ws + WS_WOUT_T) + (size_t)l * D * D, nrows, D, D}; pg8::StaticOrder S; S.init(nrows, D, Fp.G, (int)blockIdx.x);
            bf16* X = (bf16*)(ws + WS_X); const float* g1p = (const float*)(ws + WS_MODF) + (size_t)l * 3 * 6144 + 2 * 1024;
            if (l == 0) { pg8::EpiResidual<true> E{inptr(I_X), inptr(I_CTX), X, g1p}; pg8::gemm_phase<pg8::EpiResidual<true>, pg8::StaticOrder, true, true>(F.lds, g, S, E); }
            else { pg8::EpiResidual<false> E{X, X + (size_t)NLAT * D, X, g1p}; pg8::gemm_phase<pg8::EpiResidual<false>, pg8::StaticOrder, true, true>(F.lds, g, S, E); }
        }
        if (!(blockIdx.x & 1)) expert_convert(F, l, cv_lo);
        GRID_BAR();
        router_pass(F, l, nrows);
        GRID_BAR();
        {
            const Frame Fp = phase_frame(F); unsigned char* const ws = WSO;
            moe_map(F, l);
            const LAS int* mp = (const LAS int*)(F.lds + MOE_MAP_OFF);
            pg8::MoeOrder S{mp + 128, mp + 320, mp[64], Fp.G, (int)blockIdx.x};
            {   pg8::Gemm g{(const bf16*)(ws + WS_H), (const bf16*)(ws + WS_WGU_T), 0, 0, D, (const int*)(ws + WS_ELIST), NROW - 1};
                pg8::EpiSwiGLU E{(bf16*)(ws + WS_ACT)};
                pg8::gemm_phase<pg8::EpiSwiGLU, pg8::MoeOrder, true, true, true>(F.lds, g, S, E); }
            GRID_BAR();
            {   pg8::Gemm g{(const bf16*)(ws + WS_ACT), (const bf16*)(ws + WS_WD_T), 0, 0, DEXP};
                pg8::EpiStoreBf16 E{(bf16*)(ws + WS_XS), D, 3};
                pg8::gemm_phase<pg8::EpiStoreBf16, pg8::MoeOrder, true, true>(F.lds, g, S, E); }
        }
        GRID_BAR();
        combine_pass<false>(F, l, nrows);
        if (l + 1 < DEPTH) GRID_BAR();
    }
}

extern "C" void kernel_launch(void* const* d_in, const int* in_sizes, int n_in, void* d_out, int out_size, void* d_ws, size_t ws_size, hipStream_t stream) {
    static int grid = 0;
    if (grid == 0) {
        if (n_in != N_IN || in_sizes[0] != NLAT * D || out_size != NLAT * D || ws_size < WS_END) {
            fprintf(stderr, "kernel_launch: unexpected shapes (n_in %d in0 %d out %d ws %zu)\n", n_in, n_in > 0 ? in_sizes[0] : -1, out_size, ws_size); grid = -1; return; }
        int dev = 0, cus = 0, per_cu = 0;
        hipGetDevice(&dev); hipDeviceGetAttribute(&cus, hipDeviceAttributeMultiprocessorCount, dev);
        hipFuncSetAttribute((const void*)fwd_megakernel, hipFuncAttributeMaxDynamicSharedMemorySize, LDS_BYTES);
        hipOccupancyMaxActiveBlocksPerMultiprocessor(&per_cu, (const void*)fwd_megakernel, NTHR, LDS_BYTES);
        if (per_cu < 1) { fprintf(stderr, "kernel_launch: occupancy query says %d blocks per CU\n", per_cu); per_cu = 1; }
        (void)hipGetLastError();
        grid = cus * per_cu;
    }
    if (grid < 0) return;
    hipMemsetAsync((char*)d_ws + WS_CTL, 0, CTL_ZERO_BYTES, stream);
    Params p{};
    for (int i = 0; i < N_IN; ++i) p.in[i] = (const float*)d_in[i];
    p.out = (float*)d_out; p.ws = (unsigned char*)d_ws;
    void* args[] = {&p};
    hipError_t e = hipLaunchCooperativeKernel((const void*)fwd_megakernel, dim3(grid), dim3(NTHR), args, LDS_BYTES, stream);
    if (e != hipSuccess) fprintf(stderr, "kernel_launch: cooperative launch failed: %s (grid %d)\n", hipGetErrorString(e), grid);
}
```

```cpp
#include <hip/hip_runtime.h>
#include <hip/hip_cooperative_groups.h>
#include <cstdio>
#include <cstdint>
namespace cg = cooperative_groups;
#define USE_CG_SYNC 0
#define SEQ_PROBE 0
#define SEQ_PROBE_PRE 0
namespace pg8 {
#define PG8_LAS __attribute__((address_space(3)))
typedef unsigned short bf16_t;
typedef short bf16x8 __attribute__((ext_vector_type(8)));
typedef float f32x4 __attribute__((ext_vector_type(4)));
typedef unsigned u32x4 __attribute__((ext_vector_type(4)));
constexpr int BM = 256, BK = 64, HALF = 128, HTB = HALF * BK * 2  , STAGE_BYTES = 8 * HTB, NXCD = 8, WGM = 8;

__host__ __device__ __forceinline__ int lds_byte(int r, int c) { const int st = (r >> 4) * 2 + (c >> 5), rr = r & 15, cc = c & 31, ob = rr * 64 + cc * 2; return st * 1024 + (ob ^ (((ob >> 9) & 1) << 5)); }
__host__ __device__ __forceinline__ void stage_rc(int b, int& R, int& C) { const int st = b / 1024, sb = b % 1024, swz = sb ^ (((sb >> 9) & 1) << 5); R = (st >> 1) * 16 + swz / 64; C = (st & 1) * 32 + (swz % 64) / 2; }
__host__ __device__ __forceinline__ int perm32(int rho) { const int n = rho >> 4, i = rho & 15; return 8 * (i >> 2) + 4 * n + (i & 3); }

struct Unit { int pm, pn, ga; };
struct Gemm { const bf16_t* A; const bf16_t* Bt; int M, N, K; const int* gidx; int gmax; };

struct StaticOrder {
    int nM, nN, nwg, G, c;
    __host__ __device__ void init(int M, int N, int G_, int c_) { nM = M / BM; nN = N / BM; nwg = nM * nN; G = G_; c = c_; }
    __host__ __device__ bool next(int i, Unit& u) const {
        const long L = (long)i * G + c; if (L >= nwg) return false;
        int wgid = (int)L; { const int q = nwg / NXCD, r = nwg % NXCD, xcd = wgid % NXCD, off = wgid / NXCD; wgid = (xcd < r ? xcd * (q + 1) : r * (q + 1) + (xcd - r) * q) + off; }
        const int nig = WGM * nN, gid = wgid / nig, fm = gid * WGM, gsz = (nM - fm) < WGM ? (nM - fm) : WGM;
        u.pm = fm + ((wgid % nig) % gsz); u.pn = (wgid % nig) / gsz; return true;
    }
    __device__ __forceinline__ void a_ready(const Unit&) const {}
    __device__ __forceinline__ void done(const Unit&) const {}
};

__device__ __forceinline__ unsigned cvt_pk_bf16(float lo, float hi) { unsigned r; asm volatile("v_cvt_pk_bf16_f32 %0, %1, %2" : "=v"(r) : "v"(lo), "v"(hi)); return r; }
typedef float f32x2 __attribute__((ext_vector_type(2)));
template <class Epi, class Sched, bool ALIGN_EPI = false, bool SP2 = false, bool GATHER = false>
__device__ __forceinline__ void gemm_phase(PG8_LAS unsigned char* lds, const Gemm g, const Sched& S, const Epi& E) {
    int tid = threadIdx.x; asm volatile("" : "+v"(tid));
    const int wid = __builtin_amdgcn_readfirstlane(tid >> 6), lane = tid & 63, wr = wid >> 2, wc = wid & 3, fr = lane & 15, fq = lane >> 4;
    const int K = g.K, nt = K / BK;
    unsigned voffA[2], voffB[2];
#pragma unroll
    for (int i = 0; i < 2; ++i) { int R, C; stage_rc(tid * 16 + i * 8192, R, C); const int Rb = Epi::PERM ? ((R & ~31) + perm32(R & 31)) : R;
        voffA[i] = (unsigned)(R * K + C) * 2u; voffB[i] = (unsigned)(Rb * K + C) * 2u; }
    static_assert(!GATHER || SP2, "GATHER is implemented for the SP2 loop");
    unsigned gcur[2][2], gnx[2][2];
#define PG8_GOFF(go, u_) do { _Pragma("unroll") for (int h_ = 0; h_ < 2; ++h_) _Pragma("unroll") for (int i_ = 0; i_ < 2; ++i_) { int R_, C_; stage_rc(tid * 16 + i_ * 8192, R_, C_); \
        int ri_ = g.gidx[(u_).ga + h_ * HALF + R_]; ri_ = ri_ < 0 ? 0 : (ri_ > g.gmax ? g.gmax : ri_); go[h_][i_] = (unsigned)ri_ * (unsigned)(K * 2) + (unsigned)C_ * 2u; } } while (0)
    const size_t kstep = (size_t)(BK * 2);
    const size_t hstep = (size_t)HALF * K * 2;
    const size_t tstep = 2 * hstep;
    const unsigned ldsw = (unsigned)wid * 1024u;
    const int aoff = lds_byte(wr * 64 + fr, fq * 8), boff = lds_byte(wc * 32 + fr, fq * 8);
#define PG8_SA(b, h) (((b) * 2 + (h)) * HTB)
#define PG8_SB(b, h) ((4 + (b) * 2 + (h)) * HTB)
#define PG8_STAGE(bufoff, gbase, voff) do { _Pragma("unroll") for (int _i = 0; _i < 2; ++_i) \
        __builtin_amdgcn_global_load_lds((const unsigned*)((const char*)(gbase) + (voff)[_i]), (PG8_LAS unsigned*)(lds + (bufoff) + ldsw + _i * 8192), 16, 0, 0); } while (0)
#define PG8_LDA(dst, b, h) do { _Pragma("unroll") for (int m = 0; m < 4; ++m) _Pragma("unroll") for (int k = 0; k < 2; ++k) dst[m][k] = *(const PG8_LAS bf16x8*)(lds + PG8_SA(b, h) + aoff + m * 2048 + k * 1024); } while (0)
#define PG8_LDB(dst, b, h) do { _Pragma("unroll") for (int n = 0; n < 2; ++n) _Pragma("unroll") for (int k = 0; k < 2; ++k) dst[n][k] = *(const PG8_LAS bf16x8*)(lds + PG8_SB(b, h) + boff + n * 2048 + k * 1024); } while (0)
#define PG8_MMA(ai, bj, At, Bt) do { __builtin_amdgcn_s_setprio(1); _Pragma("unroll") for (int m = 0; m < 4; ++m) _Pragma("unroll") for (int n = 0; n < 2; ++n) _Pragma("unroll") for (int k = 0; k < 2; ++k) \
        acc[ai][bj][m][n] = __builtin_amdgcn_mfma_f32_16x16x32_bf16(Bt[n][k], At[m][k], acc[ai][bj][m][n], 0, 0, 0); __builtin_amdgcn_s_setprio(0); } while (0)
#define PG8_WAIT_V(n) asm volatile("s_waitcnt vmcnt(" #n ")" ::: "memory")
#define PG8_WAIT_L(n) asm volatile("s_waitcnt lgkmcnt(" #n ")" ::: "memory")
#define PG8_BAR __builtin_amdgcn_s_barrier()
#define PG8_SCHED __builtin_amdgcn_sched_barrier(0)
    Unit cur, nxt; int ui = 0;
    if (!S.next(0, cur)) return;
    f32x4 acc[2][2][4][2];
#pragma unroll
    for (int a = 0; a < 2; ++a)
#pragma unroll
        for (int b = 0; b < 2; ++b)
#pragma unroll
            for (int m = 0; m < 4; ++m)
#pragma unroll
                for (int n = 0; n < 2; ++n) acc[a][b][m][n] = (f32x4){0.f, 0.f, 0.f, 0.f};
    bf16x8 At[4][2], B0[2][2], B1[2][2];
    const char* cA = (const char*)g.A + (size_t)cur.pm * tstep; const char* cB = (const char*)g.Bt + (size_t)cur.pn * tstep;
    S.a_ready(cur);
    const char* gA = (const char*)g.A;
    if constexpr (GATHER) PG8_GOFF(gcur, cur);
    if constexpr (SP2) {
        PG8_STAGE(PG8_SB(0, 0), cB, voffB); PG8_STAGE(PG8_SB(0, 1), cB + hstep, voffB);
        if constexpr (GATHER) { PG8_STAGE(PG8_SA(0, 0), gA, gcur[0]); PG8_STAGE(PG8_SA(0, 1), gA, gcur[1]); } else { PG8_STAGE(PG8_SA(0, 0), cA, voffA); PG8_STAGE(PG8_SA(0, 1), cA + hstep, voffA); }
        if (wr == 1) PG8_BAR;
        PG8_WAIT_V(2); PG8_BAR;
        PG8_STAGE(PG8_SB(1, 0), cB + kstep, voffB); if constexpr (GATHER) PG8_STAGE(PG8_SA(1, 0), gA + kstep, gcur[0]); else PG8_STAGE(PG8_SA(1, 0), cA + kstep, voffA); PG8_STAGE(PG8_SB(1, 1), cB + hstep + kstep, voffB);
        PG8_WAIT_V(6); PG8_BAR;
    } else {
        PG8_STAGE(PG8_SB(0, 0), cB, voffB); PG8_STAGE(PG8_SA(0, 0), cA, voffA); PG8_STAGE(PG8_SB(0, 1), cB + hstep, voffB); PG8_STAGE(PG8_SA(0, 1), cA + hstep, voffA);
        if (wr == 1) PG8_BAR;
        PG8_WAIT_V(4); PG8_BAR;
        PG8_STAGE(PG8_SB(1, 0), cB + kstep, voffB); PG8_STAGE(PG8_SA(1, 0), cA + kstep, voffA); PG8_STAGE(PG8_SB(1, 1), cB + hstep + kstep, voffB);
        PG8_WAIT_V(6); PG8_BAR;
    }
    for (;;) {
        const bool has_next = S.next(ui + 1, nxt);
        if constexpr (GATHER) { if (has_next) PG8_GOFF(gnx, nxt); else { gnx[0][0] = gcur[0][0]; gnx[0][1] = gcur[0][1]; gnx[1][0] = gcur[1][0]; gnx[1][1] = gcur[1][1]; } }
        const char* nA = has_next ? (const char*)g.A + (size_t)nxt.pm * tstep : cA; const char* nB = has_next ? (const char*)g.Bt + (size_t)nxt.pn * tstep : cB;
        for (int t = 0; t < nt; t += 2) {
            const bool last = (t == nt - 2);
            const char* a1 = cA + (size_t)(t + 1) * kstep;
            const char* a2 = last ? nA : cA + (size_t)(t + 2) * kstep; const char* b2 = last ? nB : cB + (size_t)(t + 2) * kstep;
            const char* a3 = a2 + kstep; const char* b3 = b2 + kstep;
            if (last && has_next) S.a_ready(nxt);
            unsigned ga0[2], ga1[2]; const char* g1 = gA; const char* g2 = gA; const char* g3 = gA;
            if constexpr (GATHER) { g1 = gA + (size_t)(t + 1) * kstep; g2 = last ? gA : gA + (size_t)(t + 2) * kstep; g3 = g2 + kstep;
                ga0[0] = last ? gnx[0][0] : gcur[0][0]; ga0[1] = last ? gnx[0][1] : gcur[0][1]; ga1[0] = last ? gnx[1][0] : gcur[1][0]; ga1[1] = last ? gnx[1][1] : gcur[1][1]; }
            if constexpr (SP2) {
            PG8_LDB(B0, 0, 0); PG8_LDB(B1, 0, 1); PG8_SCHED; PG8_LDA(At, 0, 0); if constexpr (GATHER) PG8_STAGE(PG8_SA(1, 1), g1, gcur[1]); else PG8_STAGE(PG8_SA(1, 1), a1 + hstep, voffA);
            PG8_WAIT_V(8); PG8_WAIT_L(0); PG8_BAR; PG8_MMA(0, 0, At, B0); PG8_MMA(0, 1, At, B1); PG8_BAR; PG8_SCHED;
            PG8_LDA(At, 0, 1); PG8_STAGE(PG8_SB(0, 0), b2, voffB); PG8_STAGE(PG8_SB(0, 1), b2 + hstep, voffB); if constexpr (GATHER) PG8_STAGE(PG8_SA(0, 0), g2, ga0); else PG8_STAGE(PG8_SA(0, 0), a2, voffA);
            PG8_WAIT_V(8); PG8_WAIT_L(0); PG8_BAR; PG8_MMA(1, 0, At, B0); PG8_MMA(1, 1, At, B1); PG8_BAR; PG8_SCHED;
            PG8_LDB(B0, 1, 0); PG8_LDB(B1, 1, 1); PG8_SCHED; PG8_LDA(At, 1, 0); if constexpr (GATHER) PG8_STAGE(PG8_SA(0, 1), g2, ga1); else PG8_STAGE(PG8_SA(0, 1), a2 + hstep, voffA);
            PG8_WAIT_V(8); PG8_WAIT_L(0); PG8_BAR; PG8_MMA(0, 0, At, B0); PG8_MMA(0, 1, At, B1); PG8_BAR; PG8_SCHED;
            PG8_LDA(At, 1, 1); PG8_STAGE(PG8_SB(1, 0), b3, voffB); PG8_STAGE(PG8_SB(1, 1), b3 + hstep, voffB); if constexpr (GATHER) PG8_STAGE(PG8_SA(1, 0), g3, ga0); else PG8_STAGE(PG8_SA(1, 0), a3, voffA);
            PG8_WAIT_V(8); PG8_WAIT_L(0); PG8_BAR; PG8_MMA(1, 0, At, B0); PG8_MMA(1, 1, At, B1); PG8_BAR; PG8_SCHED;
            } else {
            PG8_LDB(B0, 0, 0); PG8_SCHED; PG8_LDA(At, 0, 0); PG8_STAGE(PG8_SA(1, 1), a1 + hstep, voffA);
            PG8_WAIT_L(8); PG8_BAR; PG8_WAIT_L(0); PG8_MMA(0, 0, At, B0); PG8_BAR; PG8_SCHED;
            PG8_LDB(B1, 0, 1); PG8_STAGE(PG8_SB(0, 0), b2, voffB);
            PG8_BAR; PG8_WAIT_L(0); PG8_MMA(0, 1, At, B1); PG8_BAR;
            PG8_LDA(At, 0, 1); PG8_STAGE(PG8_SA(0, 0), a2, voffA);
            PG8_BAR; PG8_WAIT_L(0); PG8_MMA(1, 0, At, B0); PG8_BAR; PG8_SCHED;
            PG8_STAGE(PG8_SB(0, 1), b2 + hstep, voffB);
            PG8_WAIT_V(6); PG8_BAR; PG8_MMA(1, 1, At, B1); PG8_BAR;
            PG8_LDB(B0, 1, 0); PG8_SCHED; PG8_LDA(At, 1, 0); PG8_STAGE(PG8_SA(0, 1), a2 + hstep, voffA);
            PG8_WAIT_L(8); PG8_BAR; PG8_WAIT_L(0); PG8_MMA(0, 0, At, B0); PG8_BAR; PG8_SCHED;
            PG8_LDB(B1, 1, 1); PG8_STAGE(PG8_SB(1, 0), b3, voffB);
            PG8_BAR; PG8_WAIT_L(0); PG8_MMA(0, 1, At, B1); PG8_BAR;
            PG8_LDA(At, 1, 1); PG8_STAGE(PG8_SA(1, 0), a3, voffA);
            PG8_BAR; PG8_WAIT_L(0); PG8_MMA(1, 0, At, B0); PG8_BAR; PG8_SCHED;
            PG8_STAGE(PG8_SB(1, 1), b3 + hstep, voffB);
            PG8_WAIT_V(6); PG8_BAR; PG8_MMA(1, 1, At, B1); PG8_BAR;
            }
        }
        if constexpr (ALIGN_EPI) { if (wr == 0) PG8_BAR; }
        if constexpr (!Epi::AFTER_DRAIN) { E(acc, cur, wr, wc, fr, fq); S.done(cur); }
        if (!has_next) break;
#pragma unroll
        for (int a = 0; a < 2; ++a)
#pragma unroll
            for (int b = 0; b < 2; ++b)
#pragma unroll
                for (int m = 0; m < 4; ++m)
#pragma unroll
                    for (int n = 0; n < 2; ++n) acc[a][b][m][n] = (f32x4){0.f, 0.f, 0.f, 0.f};
        cur = nxt; cA = nA; cB = nB; ++ui;
        if constexpr (GATHER) { gcur[0][0] = gnx[0][0]; gcur[0][1] = gnx[0][1]; gcur[1][0] = gnx[1][0]; gcur[1][1] = gnx[1][1]; }
        if constexpr (ALIGN_EPI) { if (wr == 1) PG8_BAR; }
    }
    PG8_WAIT_V(0);
    if constexpr (!ALIGN_EPI) { if (wr == 0) PG8_BAR; }
    PG8_BAR;
    if constexpr (Epi::AFTER_DRAIN) { E.fused(acc, cur, wr, wc, fr, fq, lds, wid, lane); S.done(cur); }
#undef PG8_GOFF
#undef PG8_SA
#undef PG8_SB
#undef PG8_STAGE
#undef PG8_LDA
#undef PG8_LDB
#undef PG8_MMA
#undef PG8_WAIT_V
#undef PG8_WAIT_L
#undef PG8_BAR
#undef PG8_SCHED
}
}
#define LAS __attribute__((address_space(3)))
typedef unsigned short bf16;
typedef float f32x4 __attribute__((ext_vector_type(4)));
typedef short bf16x8 __attribute__((ext_vector_type(8)));
typedef unsigned u32x4 __attribute__((ext_vector_type(4)));
typedef unsigned u32x2 __attribute__((ext_vector_type(2)));

constexpr int D = 1024, NBATCH = 2, SEQ = 8192, CTXL = 256, DEPTH = 2;
constexpr int NLAT = NBATCH * SEQ, NCTX = NBATCH * CTXL, NROW = NLAT + NCTX;
constexpr int DR = 512, DIN = 2944, NP = 3328, ZW = 1920, NHEAD = 8;
constexpr int COL_CONV = 1920, COL_FC = 2688, COL_FS = 2944;
constexpr int STRW = 5120;
constexpr int NEXP = 32, DEXP = 512;
constexpr int MOE_MAXTILES = 168;
constexpr float RMS_EPS = 1e-6f, GN_EPS = 64e-5f;

enum { I_X = 0, I_C, I_CTX, I_CCTX, I_ADAW, I_ADAB, I_N1G, I_N2G, I_WIN, I_MU, I_DW0, I_DW2, I_IA0, I_IA2, I_GG2, I_KK, I_KA, I_RK, I_GNW, I_GNB,
       I_CONVW, I_CONVG, I_FOURG, I_WOUT, I_RGW, I_RGB, I_REW, I_REB, I_EG, I_EU, I_ED, I_FG, N_IN };

constexpr size_t MiB = 1u << 20;
constexpr size_t WS_CTL = 0, CTL_ZERO_BYTES = 64 * 1024;
constexpr size_t WS_MODP = 1 * MiB;
constexpr size_t WS_MODF = 1 * MiB + 1280 * 1024;
constexpr size_t WS_WIN_T = 3 * MiB;
constexpr size_t WS_WOUT_T = 16 * MiB;
constexpr size_t WS_WGU_T = 20 * MiB;
constexpr size_t WS_WD_T = 84 * MiB;
constexpr size_t WS_X = 116 * MiB;
constexpr size_t WS_H = 182 * MiB;
constexpr size_t WS_ZS = 215 * MiB;
constexpr size_t WS_P = 277 * MiB;
constexpr size_t WS_STR = 277 * MiB;
constexpr size_t WS_Y = 442 * MiB;
constexpr size_t WS_GT = 475 * MiB;
constexpr size_t WS_ROUTE = 491 * MiB;
constexpr size_t WS_XS = 215 * MiB;
constexpr size_t WS_ACT = 299 * MiB;
constexpr size_t WS_ELIST = 340 * MiB;
constexpr size_t WS_END = 530 * MiB;
constexpr size_t RT_E = 0, RT_POS = 1 * 33792 * 4, RT_GATE = 2 * 33792 * 4, RT_SLOT = 3 * 33792 * 4, RT_TILE = 4 * 33792 * 4, RT_NT = RT_TILE + 1024;

constexpr int CW_BAR = 4096;
constexpr int CW_CNT = 8192;

constexpr int NWAVES = 8, NTHR = 512;
constexpr int RING_BYTES = 131072, LDSCTL_OFF = 143360, MISC_OFF = LDSCTL_OFF + 320, LDS_BYTES = 147456;

struct Params { const float* in[N_IN]; float* out; unsigned char* ws; };

__device__ __forceinline__ float bf2f(unsigned h) { return __uint_as_float(h << 16); }
typedef __bf16 hwbf2 __attribute__((ext_vector_type(2)));
typedef float f32x2 __attribute__((ext_vector_type(2)));
__device__ __forceinline__ unsigned pk2(float lo, float hi) { const f32x2 x = {lo, hi}; const hwbf2 r = __builtin_convertvector(x, hwbf2); return __builtin_bit_cast(unsigned, r); }
__device__ __forceinline__ unsigned f2bf(float f) { return pk2(f, 0.f) & 0xffffu; }
__device__ __forceinline__ float wave_sum(float v) {
#pragma unroll
    for (int o = 1; o < 64; o <<= 1) v += __shfl_xor(v, o);
    return v;
}
__device__ __forceinline__ float sigmoidf_(float x) { return 1.f / (1.f + __expf(-x)); }
#define LDS_WAIT() asm volatile("s_waitcnt lgkmcnt(0)" ::: "memory")
#define VM_WAIT() asm volatile("s_waitcnt vmcnt(0)" ::: "memory")

struct Frame {
    LAS unsigned char* lds;
    int tid, lane, wave, vcu, G, gw, NGW;
    float* out; unsigned char* ws;
};
#if defined(__HIP_DEVICE_COMPILE__)
#define ASSUME_GLOBAL(p) do { __builtin_assume(!__builtin_amdgcn_is_shared(p)); __builtin_assume(!__builtin_amdgcn_is_private(p)); } while (0)
#else
#define ASSUME_GLOBAL(p) do { } while (0)
#endif
__device__ __forceinline__ const float* inptr(int i) {
    const volatile unsigned long long __attribute__((address_space(4)))* ka = (const volatile unsigned long long __attribute__((address_space(4)))*)__builtin_amdgcn_kernarg_segment_ptr();
    return (const float*)(const __attribute__((address_space(1))) float*)ka[i];
}
__device__ __forceinline__ unsigned char* opaque(unsigned char* p) { unsigned long z = 0; asm volatile("" : "+s"(z)); return p + z; }
__device__ __forceinline__ Frame phase_frame(const Frame& F0) { Frame F = F0; asm volatile("" : "+v"(F.tid)); F.lane = F.tid & 63; F.ws = opaque(F0.ws);
    asm volatile("" : "+s"(F.G), "+s"(F.vcu)); F.gw = F.vcu * NWAVES + F.wave; F.NGW = F.G * NWAVES; return F; }
__device__ __forceinline__ int modrow(int row) { return row < NLAT ? (row >> 13) : 2; }
#define XB_TMO      128
#define XB_XCNT(j)  (256  + 64 * (j))
#define XB_XSUB(j)  (1280 + 64 * (j))
#define XB_XGEN(j)  (2304 + 64 * (j))
#define XB_TOP      3328
#define XB_TOPGEN   3392
#define XCD_BAR_WORDS 3456
#define XB_SPIN_CAP (1u << 18)

__device__ __forceinline__ unsigned xb_ld(unsigned* p)              { return __hip_atomic_load(p, __ATOMIC_RELAXED, __HIP_MEMORY_SCOPE_AGENT); }
__device__ __forceinline__ unsigned xb_add(unsigned* p, unsigned v) { return __hip_atomic_fetch_add(p, v, __ATOMIC_RELAXED, __HIP_MEMORY_SCOPE_AGENT); }
__device__ __forceinline__ unsigned xb_xcc_id() { return (unsigned)__builtin_amdgcn_s_getreg((3 << 11) | 20) & 0xFu; }
#define XB_SPIN(cond, bar) do { unsigned _sp = 0; while (cond) { __builtin_amdgcn_s_sleep(1); \
    if ((++_sp & 255u) == 0u) { if (xb_ld(&(bar)[XB_TMO])) break; if (_sp > XB_SPIN_CAP) { atomicAdd(&(bar)[XB_TMO], 1u); break; } } } } while (0)

struct XcdBarrier {
    unsigned* bar; unsigned x;
    volatile LAS unsigned* st;
};

__device__ __forceinline__ XcdBarrier xcd_barrier_post(unsigned* bar, volatile LAS unsigned* st) {
    XcdBarrier b; b.bar = bar; b.x = xb_xcc_id(); b.st = st;
    if (threadIdx.x == 0) (void)xb_add(&bar[XB_XCNT(b.x)], 1u);
    return b;
}
__device__ __forceinline__ void xcd_barrier_complete(unsigned* bar, unsigned x, unsigned& nloc, unsigned& nx) {
    const unsigned G = gridDim.x * gridDim.y * gridDim.z;
    unsigned sum, cnt, mine, sp = 0u;
    for (;;) {
        sum = 0u; cnt = 0u; mine = 0u;
#pragma nounroll
        for (unsigned j = 0; j < 16; ++j) { const unsigned c = xb_ld(&bar[XB_XCNT(j)]); sum += c; cnt += (c > 0u) ? 1u : 0u; mine = (j == x) ? c : mine; }
        if (sum == G) break;
        __builtin_amdgcn_s_sleep(1);
        if ((++sp & 255u) == 0u) { if (xb_ld(&bar[XB_TMO])) break; if (sp > XB_SPIN_CAP) { atomicAdd(&bar[XB_TMO], 1u); break; } }
    }
    nloc = mine > 0u ? mine : 1u; nx = cnt > 0u ? cnt : 1u;
}

__device__ __forceinline__ void xcd_barrier(const XcdBarrier& b) {
    asm volatile("s_waitcnt vmcnt(0)" ::: "memory");
    __syncthreads();
    if (threadIdx.x == 0) {
        unsigned* bar = b.bar;
        asm volatile("" : "+s"(bar));
        __builtin_amdgcn_s_waitcnt(0);
        unsigned nloc = b.st[0], nx = b.st[1];
        if (nloc == 0u) { xcd_barrier_complete(bar, b.x, nloc, nx); b.st[0] = nloc; b.st[1] = nx; }
        const unsigned old = xb_add(&bar[XB_XSUB(b.x)], 1u);
        const unsigned gen = old / nloc;
        if (old + 1u == (gen + 1u) * nloc) {
            __builtin_amdgcn_fence(__ATOMIC_RELEASE, "agent");
            asm volatile("s_waitcnt vmcnt(0)" ::: "memory");
            const unsigned og = xb_add(&bar[XB_TOP], 1u);
            const unsigned tg = og / nx;
            if (og + 1u == (tg + 1u) * nx) xb_add(&bar[XB_TOPGEN], 1u);
            else XB_SPIN(xb_ld(&bar[XB_TOPGEN]) == tg, bar);
            __builtin_amdgcn_fence(__ATOMIC_ACQUIRE, "agent");
            xb_add(&bar[XB_XGEN(b.x)], 1u);
            asm volatile("s_waitcnt vmcnt(0)" ::: "memory");
        } else {
            XB_SPIN(xb_ld(&bar[XB_XGEN(b.x)]) == gen, bar);
            __builtin_amdgcn_fence(__ATOMIC_ACQUIRE, "agent");
            asm volatile("s_waitcnt vmcnt(0)" ::: "memory");
        }
    }
    __syncthreads();
}
template <class RowMap>
__device__ __forceinline__ void transpose_item(const float* W, int ldw, int k0, int n0, bf16* WT, int ldt, RowMap rm, LAS float* scr, int lane) {
    (void)scr;
    const int nq = lane & 7, kg = lane >> 3; const float* src = W + (size_t)(k0 + 8 * kg) * ldw + n0 + 4 * nq;
    f32x4 v[8];
#pragma unroll
    for (int i = 0; i < 8; ++i) v[i] = *(const f32x4*)(src + (size_t)i * ldw);
#pragma unroll
    for (int j = 0; j < 4; ++j) { u32x4 o = {pk2(v[0][j], v[1][j]), pk2(v[2][j], v[3][j]), pk2(v[4][j], v[5][j]), pk2(v[6][j], v[7][j])};
        *(u32x4*)(WT + (size_t)rm(n0 + 4 * nq + j) * ldt + k0 + 8 * kg) = o; }
}
struct RmId { int off; __device__ __forceinline__ int operator()(int n) const { return off + n; } };
struct RmGU { int off; __device__ __forceinline__ int operator()(int n) const { return off + ((n >> 2) << 3) + (n & 3); } };

__device__ __forceinline__ void p0_prologue(const Frame& F0) {
    const Frame F = phase_frame(F0); unsigned char* const ws = F.ws;
    LAS float* scr = (LAS float*)(F.lds + F.wave * 16384);
    LAS float* ctab = (LAS float*)(F.lds + 8 * 16384);
    if (F.tid < 64) ctab[F.tid] = cosf((float)F.tid * (6.283185307179586f / 64.f));
    __syncthreads();
    bf16* win_t = (bf16*)(ws + WS_WIN_T); bf16* wout_t = (bf16*)(ws + WS_WOUT_T);
    constexpr int I_WIN_L = 16 * 84, I_WOUT_L = 16 * 32, I_FOLD_L = 4 * 64, I_MOD_L = 96 * 8;
    constexpr int NIT = 2 * (I_WIN_L + I_WOUT_L + I_FOLD_L + I_MOD_L);
    const float* p_win = inptr(I_WIN); const float* p_wout = inptr(I_WOUT); const float* p_c = inptr(I_C); const float* p_cctx = inptr(I_CCTX); const float* p_adaw = inptr(I_ADAW);
    {
        bf16* wl = (bf16*)(ws + 64 * 1024); const float* dw2 = inptr(I_DW2); const float* ia2 = inptr(I_IA2); const float* gg2 = inptr(I_GG2);
        for (int idx = F.vcu * NTHR + F.tid; idx < 2 * 384 * 512; idx += F.G * NTHR) { const int c = idx & 511, k = (idx >> 9) % 384, l = idx / (384 * 512);
            float v;
            if (k < 128) v = dw2[((size_t)(l * 2 + (k >> 6)) * 64 + (k & 63)) * DR + c];
            else if (k < 256) v = ia2[((size_t)(l * 2 + ((k - 128) >> 6)) * 64 + (k & 63)) * DR + c];
            else v = gg2[((size_t)l * 128 + (k - 256)) * DR + c];
            wl[((size_t)l * 512 + c) * 384 + k] = (bf16)f2bf(v); } }
    for (int it = F.gw; it < NIT; it += F.NGW) {
        int r = it; const int l = r & 1; r >>= 1;
        if (r < I_WIN_L) { const int kb = r / 84, nb = r % 84;
            transpose_item(p_win + (size_t)l * D * DIN, DIN, kb * 64, nb * 32, win_t + (size_t)l * NP * D, D, RmId{0}, scr, F.lane); continue; }
        r -= I_WIN_L;
        if (r < I_WOUT_L) { const int kb = r / 32, nb = r % 32;
            transpose_item(p_wout + (size_t)l * D * D, D, kb * 64, nb * 32, wout_t + (size_t)l * D * D, D, RmId{0}, scr, F.lane); continue; }
        r -= I_WOUT_L;
        if (r < I_FOLD_L) {
            const int g = r >> 6, k0 = (r & 63) * 16; const float* W = p_win + (size_t)l * D * DIN;
#pragma unroll
            for (int kk = 0; kk < 16; ++kk) scr[kk * 64 + F.lane] = W[(size_t)(k0 + kk) * DIN + 2688 + g * 64 + F.lane];
            LDS_WAIT(); asm volatile("" ::: "memory");
            float ac[16], as[16];
#pragma unroll
            for (int kk = 0; kk < 16; ++kk) { ac[kk] = 0.f; as[kk] = 0.f; }
            for (int c = 0; c < 64; ++c) { const int idx = (c * F.lane) & 63; const float cc = ctab[idx], ss = ctab[(idx - 16) & 63];
#pragma unroll
                for (int kk = 0; kk < 16; ++kk) { const float w = scr[kk * 64 + c]; ac[kk] += w * cc; as[kk] += w * ss; } }
            bf16* oc = win_t + (size_t)l * NP * D + (size_t)(COL_FC + g * 64 + F.lane) * D + k0;
            bf16* os = win_t + (size_t)l * NP * D + (size_t)(COL_FS + g * 64 + F.lane) * D + k0;
            u32x4 a, b;
            a.x = pk2(ac[0], ac[1]); a.y = pk2(ac[2], ac[3]); a.z = pk2(ac[4], ac[5]); a.w = pk2(ac[6], ac[7]);
            b.x = pk2(ac[8], ac[9]); b.y = pk2(ac[10], ac[11]); b.z = pk2(ac[12], ac[13]); b.w = pk2(ac[14], ac[15]);
            *(u32x4*)oc = a; *(u32x4*)(oc + 8) = b;
            a.x = pk2(as[0], as[1]); a.y = pk2(as[2], as[3]); a.z = pk2(as[4], as[5]); a.w = pk2(as[6], as[7]);
            b.x = pk2(as[8], as[9]); b.y = pk2(as[10], as[11]); b.z = pk2(as[12], as[13]); b.w = pk2(as[14], as[15]);
            *(u32x4*)os = a; *(u32x4*)(os + 8) = b;
            LDS_WAIT(); asm volatile("" ::: "memory");
            continue; }
        r -= I_FOLD_L;
        {
            const int cb = r >> 3, ks = r & 7;
#pragma unroll
            for (int q = 0; q < 2; ++q) { const int k = ks * 128 + q * 64 + F.lane;
                const float c0 = p_c[k], c1 = p_c[D + k], c2 = p_cctx[k];
                scr[0 * 128 + q * 64 + F.lane] = c0 * sigmoidf_(c0); scr[1 * 128 + q * 64 + F.lane] = c1 * sigmoidf_(c1); scr[2 * 128 + q * 64 + F.lane] = c2 * sigmoidf_(c2); }
            LDS_WAIT(); asm volatile("" ::: "memory");
            const float* W = p_adaw + (size_t)l * D * 6144 + (size_t)(ks * 128) * 6144 + cb * 64 + F.lane;
            float a0 = 0.f, a1 = 0.f, a2 = 0.f;
#pragma unroll 8
            for (int kk = 0; kk < 128; ++kk) { const float w = W[(size_t)kk * 6144]; a0 += scr[kk] * w; a1 += scr[128 + kk] * w; a2 += scr[256 + kk] * w; }
            float* mp = (float*)(ws + WS_MODP) + (size_t)((l * 8 + ks) * 3) * 6144 + cb * 64 + F.lane;
            mp[0] = a0; mp[6144] = a1; mp[2 * 6144] = a2;
            LDS_WAIT(); asm volatile("" ::: "memory");
        }
    }
}

__device__ __forceinline__ void mod_to_lds(const Frame& F0, int l, int p, LAS float* dst, bool from_partials) {
    const Frame F = phase_frame(F0); unsigned char* const ws = F.ws;
    const float* adab = inptr(I_ADAB);
    for (int idx = F.tid; idx < 3 * 1024; idx += NTHR) { const int r = idx >> 10, n = idx & 1023;
        float v;
        if (from_partials) { v = adab[l * 6144 + p * 1024 + n]; const float* mp = (const float*)(ws + WS_MODP) + (size_t)(l * 8 * 3 + r) * 6144 + p * 1024 + n;
#pragma unroll
            for (int ks = 0; ks < 8; ++ks) v += mp[(size_t)ks * 3 * 6144]; }
        else v = ((const float*)(ws + WS_MODF))[(size_t)(l * 3 + r) * 6144 + p * 1024 + n];
        dst[idx] = v; }
}
__device__ __forceinline__ void mod_finalize(const Frame& F0) {
    const Frame F = phase_frame(F0); unsigned char* const ws = F.ws;
    const float* adab = inptr(I_ADAB);
    for (int idx = F.vcu * NTHR + F.tid; idx < 2 * 3 * 6144; idx += F.G * NTHR) { const int l = idx / (3 * 6144), rem = idx % (3 * 6144), r = rem / 6144, n = rem % 6144;
        float v = adab[l * 6144 + n]; const float* mp = (const float*)(ws + WS_MODP) + (size_t)(l * 8 * 3 + r) * 6144 + n;
#pragma unroll
        for (int ks = 0; ks < 8; ++ks) v += mp[(size_t)ks * 3 * 6144];
        ((float*)(ws + WS_MODF))[idx] = v; }
}


__device__ __forceinline__ void norm_mod_row(f32x4 (&v)[4], const float* gain, const LAS float* sc, const LAS float* sh, bf16* orow, int lane) {
    float s = 0.f;
#pragma unroll
    for (int j = 0; j < 4; ++j) s += (v[j].x * v[j].x + v[j].y * v[j].y) + (v[j].z * v[j].z + v[j].w * v[j].w);
    const float rs = rsqrtf(wave_sum(s) * (1.f / D) + RMS_EPS);
#pragma unroll
    for (int j = 0; j < 4; ++j) { const int c = 4 * lane + 256 * j; const f32x4 g = *(const f32x4*)(gain + c); const f32x4 a = *(const LAS f32x4*)(sc + c), b = *(const LAS f32x4*)(sh + c);
        v[j] = (v[j] * rs) * g * (a + 1.f) + b;
        u32x2 w; w.x = pk2(v[j].x, v[j].y); w.y = pk2(v[j].z, v[j].w); *(u32x2*)(orow + c) = w; }
}

__device__ __forceinline__ void p0b_norm1(const Frame& F0) {
    const Frame F = phase_frame(F0); unsigned char* const ws = F.ws;
    LAS float* msh = (LAS float*)F.lds; LAS float* msc = msh + 3072;
    mod_to_lds(F, 0, 0, msh, true); mod_to_lds(F, 0, 1, msc, true); __syncthreads();
    mod_finalize(F);
    bf16* H = (bf16*)(ws + WS_H); const float* xin = inptr(I_X); const float* cin = inptr(I_CTX); const float* n1g = inptr(I_N1G);
    for (int row0 = F.gw; row0 < NROW; row0 += 2 * F.NGW) { f32x4 v[2][4]; bool ok[2];
#pragma unroll
        for (int u = 0; u < 2; ++u) { const int row = row0 + u * F.NGW; ok[u] = row < NROW; if (ok[u]) { const float* xr = row < NLAT ? xin + (size_t)row * D : cin + (size_t)(row - NLAT) * D;
#pragma unroll
            for (int j = 0; j < 4; ++j) v[u][j] = *(const f32x4*)(xr + 4 * F.lane + 256 * j); } }
#pragma unroll
        for (int u = 0; u < 2; ++u) if (ok[u]) { const int row = row0 + u * F.NGW; const int mr = modrow(row);
            norm_mod_row(v[u], n1g, msc + mr * 1024, msh + mr * 1024, H + (size_t)row * D, F.lane); } }
}
__device__ __forceinline__ void unpack8(const u32x4 w, float (&o)[8]) {
    o[0] = bf2f(w.x & 0xffffu); o[1] = bf2f(w.x >> 16); o[2] = bf2f(w.y & 0xffffu); o[3] = bf2f(w.y >> 16);
    o[4] = bf2f(w.z & 0xffffu); o[5] = bf2f(w.z >> 16); o[6] = bf2f(w.w & 0xffffu); o[7] = bf2f(w.w >> 16);
}
__device__ __forceinline__ void unpack4(const u32x2 w, float (&o)[4]) { o[0] = bf2f(w.x & 0xffffu); o[1] = bf2f(w.x >> 16); o[2] = bf2f(w.y & 0xffffu); o[3] = bf2f(w.y >> 16); }

__device__ __forceinline__ void shift_pass(const Frame& F0, int l) {
    const Frame F = phase_frame(F0); unsigned char* const ws = F.ws;
    const bf16* P = (const bf16*)(ws + WS_P); bf16* Zs = (bf16*)(ws + WS_ZS); const float* mu = inptr(I_MU) + l * ZW;
    const int total = NROW * 240;
    for (int idx = F.vcu * NTHR + F.tid; idx < total; idx += F.G * NTHR) {
        const int row = idx / 240, ck = idx % 240; const bf16* pr = P + (size_t)row * NP + ck * 8;
        const u32x4 zero = {0u, 0u, 0u, 0u};
        float z[8], n0[8], n1[8], n2[8], n3[8], o[8];
        unpack8(*(const u32x4*)pr, z);
        if (row < NLAT) { const int t = row & (SEQ - 1), gr = t >> 6, gc = t & 63;
            unpack8(gc > 0 ? *(const u32x4*)(pr - NP) : zero, n0); unpack8(gc < 63 ? *(const u32x4*)(pr + NP) : zero, n1);
            unpack8(gr > 0 ? *(const u32x4*)(pr - 64 * NP) : zero, n2); unpack8(gr < 127 ? *(const u32x4*)(pr + 64 * NP) : zero, n3);
        } else { const int tc = (row - NLAT) & (CTXL - 1);
            unpack8(tc > 0 ? *(const u32x4*)(pr - NP) : zero, n0); unpack8(tc < CTXL - 1 ? *(const u32x4*)(pr + NP) : zero, n1);
#pragma unroll
            for (int j = 0; j < 8; ++j) { n2[j] = n0[j]; n3[j] = n1[j]; }
        }
        const f32x4 m0 = *(const f32x4*)(mu + ck * 8), m1 = *(const f32x4*)(mu + ck * 8 + 4);
        const float m[8] = {m0.x, m0.y, m0.z, m0.w, m1.x, m1.y, m1.z, m1.w};
#pragma unroll
        for (int j = 0; j < 8; ++j) { const float nb = (j & 3) == 0 ? n0[j] : (j & 3) == 1 ? n1[j] : (j & 3) == 2 ? n2[j] : n3[j]; o[j] = z[j] + (nb - z[j]) * m[j]; }
        u32x4 w; w.x = pk2(o[0], o[1]); w.y = pk2(o[2], o[3]); w.z = pk2(o[4], o[5]); w.w = pk2(o[6], o[7]);
        *(u32x4*)(Zs + (size_t)row * ZW + ck * 8) = w;
    }
}

__device__ __forceinline__ void conv_pass(const Frame& F0, int l, int nrows) {
    const Frame F = phase_frame(F0); unsigned char* const ws = F.ws;
    const bf16* P = (const bf16*)(ws + WS_P); bf16* MA = (bf16*)(ws + WS_H);
    const float* cw = inptr(I_CONVW) + l * 3 * 256; const int c = 4 * F.lane;
    const f32x4 w0 = *(const f32x4*)(cw + c), w1 = *(const f32x4*)(cw + 256 + c), w2 = *(const f32x4*)(cw + 512 + c), gn = *(const f32x4*)(inptr(I_CONVG) + l * 256 + c);
    for (int row0 = F.gw; row0 < nrows; row0 += 2 * F.NGW) {
        u32x2 q[2][7]; bool ok[2]; const u32x2 zero = {0u, 0u};
#pragma unroll
        for (int u = 0; u < 2; ++u) { const int row = row0 + u * F.NGW; ok[u] = row < nrows; if (ok[u]) {
            int t, L; if (row < NLAT) { t = row & (SEQ - 1); L = SEQ; } else { t = (row - NLAT) & (CTXL - 1); L = CTXL; }
            const bf16* pr = P + (size_t)row * NP + COL_CONV + c;
            q[u][0] = *(const u32x2*)pr; q[u][1] = *(const u32x2*)(pr + 256); q[u][2] = *(const u32x2*)(pr + 512);
            q[u][3] = t > 0 ? *(const u32x2*)(pr - NP + 256) : zero; q[u][4] = t > 0 ? *(const u32x2*)(pr - NP + 512) : zero;
            q[u][5] = t < L - 1 ? *(const u32x2*)(pr + NP + 256) : zero; q[u][6] = t < L - 1 ? *(const u32x2*)(pr + NP + 512) : zero; } }
#pragma unroll
        for (int u = 0; u < 2; ++u) if (ok[u]) { const int row = row0 + u * F.NGW;
            float bg[4], cg[4], hh[4], cp[4], hp[4], cn[4], hn[4];
            unpack4(q[u][0], bg); unpack4(q[u][1], cg); unpack4(q[u][2], hh); unpack4(q[u][3], cp); unpack4(q[u][4], hp); unpack4(q[u][5], cn); unpack4(q[u][6], hn);
            const float W0[4] = {w0.x, w0.y, w0.z, w0.w}, W1[4] = {w1.x, w1.y, w1.z, w1.w}, W2[4] = {w2.x, w2.y, w2.z, w2.w}, GN[4] = {gn.x, gn.y, gn.z, gn.w};
            float y[4], s = 0.f;
#pragma unroll
            for (int j = 0; j < 4; ++j) { y[j] = bg[j] * (W0[j] * (cp[j] * hp[j]) + W1[j] * (cg[j] * hh[j]) + W2[j] * (cn[j] * hn[j])); s += y[j] * y[j]; }
            const float rs = rsqrtf(wave_sum(s) * (1.f / 256.f) + RMS_EPS);
            u32x2 o; o.x = pk2(y[0] * rs * GN[0], y[1] * rs * GN[1]); o.y = pk2(y[2] * rs * GN[2], y[3] * rs * GN[3]);
            *(u32x2*)(MA + (size_t)row * D + 512 + c) = o; }
    }
}

__device__ __forceinline__ void sincos_turns(float x, float& s, float& c) { s = __builtin_amdgcn_sinf(x); c = __builtin_amdgcn_cosf(x); }
#define MFMA16(a, b, c) __builtin_amdgcn_mfma_f32_16x16x32_bf16((a), (b), (c), 0, 0, 0)

__device__ __forceinline__ void fftA_item(const Frame& F0, int item) {
    const Frame F = phase_frame(F0); unsigned char* const ws = F.ws;
    const int half = item & 1, t2 = (item >> 1) & 63, b = item >> 7;
    const bf16* P = (const bf16*)(ws + WS_P); bf16* GT = (bf16*)(ws + WS_GT);
    LAS bf16* Bs = (LAS bf16*)F.lds;
    const int lane = F.lane, w = F.wave, fr = lane & 15, fq = lane >> 4;
    __syncthreads();
#pragma unroll
    for (int i = 0; i < 8; ++i) { const int cidx = F.tid + NTHR * i, krow = cidx >> 4, ch8 = cidx & 15, ri = krow >> 7, t1 = krow & 127;
        const u32x4 v = *(const u32x4*)(P + (size_t)(b * SEQ + t1 * 64 + t2) * NP + COL_FC + ri * 256 + half * 128 + ch8 * 8);
        LAS bf16* d = Bs + (ch8 * 8) * 264 + (krow ^ (ch8 << 3));
        d[0 * 264] = (bf16)(v.x & 0xffffu); d[1 * 264] = (bf16)(v.x >> 16); d[2 * 264] = (bf16)(v.y & 0xffffu); d[3 * 264] = (bf16)(v.y >> 16);
        d[4 * 264] = (bf16)(v.z & 0xffffu); d[5 * 264] = (bf16)(v.z >> 16); d[6 * 264] = (bf16)(v.w & 0xffffu); d[7 * 264] = (bf16)(v.w >> 16); }
    __syncthreads();
    f32x4 acc[2][8];
#pragma unroll
    for (int a = 0; a < 2; ++a)
#pragma unroll
        for (int n = 0; n < 8; ++n) acc[a][n] = (f32x4){0.f, 0.f, 0.f, 0.f};
    int t1p_a = 16 * w + fr;
    asm volatile("" : "+v"(t1p_a));
#pragma unroll
    for (int ks = 0; ks < 8; ++ks) {
        bf16x8 ar, ai;
#pragma unroll
        for (int j = 0; j < 8; ++j) { const int k = ks * 32 + 8 * fq + j, ri = k >> 7, t1 = k & 127; const int idx = (t1 * t1p_a) & 127;
            float sn, cs; sincos_turns((float)idx * (1.f / 128.f), sn, cs);
            const float vr = ri == 0 ? cs : -sn, vi = ri == 0 ? -sn : -cs;
            ar[j] = (short)f2bf(vr); ai[j] = (short)f2bf(vi); }
#pragma unroll
        for (int nt = 0; nt < 8; ++nt) { const bf16x8 bfr = *(const LAS bf16x8*)(Bs + (nt * 16 + fr) * 264 + ((ks * 32 + 8 * fq) ^ ((nt * 2 + (fr >> 3)) << 3)));
            acc[0][nt] = MFMA16(ar, bfr, acc[0][nt]); acc[1][nt] = MFMA16(ai, bfr, acc[1][nt]); }
    }
#pragma unroll
    for (int reg = 0; reg < 4; ++reg) { const int t1p = 16 * w + 4 * fq + reg; float st, ct; sincos_turns((float)(t2 * t1p) * (1.f / 8192.f), st, ct);
        bf16* g = GT + ((size_t)((b * 128 + t1p) * 64 + t2) * 2) * 256 + half * 128 + fr;
#pragma unroll
        for (int nt = 0; nt < 8; ++nt) { const float gr = acc[0][nt][reg], gi = acc[1][nt][reg];
            g[nt * 16] = (bf16)f2bf(gr * ct + gi * st); g[256 + nt * 16] = (bf16)f2bf(gi * ct - gr * st); } }
}

template <int NKC, int NDIV, int MT, class SrcRow, class OutRow>
__device__ __forceinline__ void dft64_item(const Frame& F0, int l, int m0, float sgn, float scale, SrcRow src, OutRow orow) {
    const Frame F = phase_frame(F0); unsigned char* const ws = F.ws;
    LAS bf16* Bs = (LAS bf16*)F.lds;
    LAS float* red = (LAS float*)(F.lds + 256 * 136 * 2);
    const int lane = F.lane, w = F.wave, fr = lane & 15, fq = lane >> 4;
    int fr_a = fr; asm volatile("" : "+v"(fr_a));
    f32x4 acc[MT][2];
#pragma unroll
    for (int a = 0; a < MT; ++a) { acc[a][0] = (f32x4){0.f, 0.f, 0.f, 0.f}; acc[a][1] = (f32x4){0.f, 0.f, 0.f, 0.f}; }
    for (int kc = 0; kc < NKC; ++kc) {
        __syncthreads();
#pragma unroll
        for (int i = 0; i < 8; ++i) { const int cidx = F.tid + NTHR * i, krow = cidx >> 5, ch8 = cidx & 31;
            const u32x4 v = *(const u32x4*)(src(kc * 64 + (krow >> 1), krow & 1) + ch8 * 8);
            LAS bf16* d = Bs + (ch8 * 8) * 136 + (krow ^ ((ch8 & 15) << 3));
            d[0 * 136] = (bf16)(v.x & 0xffffu); d[1 * 136] = (bf16)(v.x >> 16); d[2 * 136] = (bf16)(v.y & 0xffffu); d[3 * 136] = (bf16)(v.y >> 16);
            d[4 * 136] = (bf16)(v.z & 0xffffu); d[5 * 136] = (bf16)(v.z >> 16); d[6 * 136] = (bf16)(v.w & 0xffffu); d[7 * 136] = (bf16)(v.w >> 16); }
        __syncthreads();
#pragma unroll
        for (int ks = 0; ks < 4; ++ks) {
            const bf16x8 b0 = *(const LAS bf16x8*)(Bs + ((2 * w) * 16 + fr) * 136 + ((ks * 32 + 8 * fq) ^ ((((2 * w) * 2 + (fr >> 3)) & 15) << 3)));
            const bf16x8 b1 = *(const LAS bf16x8*)(Bs + ((2 * w + 1) * 16 + fr) * 136 + ((ks * 32 + 8 * fq) ^ ((((2 * w + 1) * 2 + (fr >> 3)) & 15) << 3)));
#pragma unroll
            for (int mt = 0; mt < MT; ++mt) { const int mrow = m0 + mt * 16 + fr_a; bf16x8 a;
#pragma unroll
                for (int j = 0; j < 8; ++j) { const int k = ks * 32 + 8 * fq + j, tl = k >> 1, ri = k & 1; const int idx = ((kc * 64 + tl) * mrow) & (NDIV - 1);
                    float sn, cs; sincos_turns((float)idx * (1.f / (float)NDIV), sn, cs);
                    a[j] = (short)f2bf(ri == 0 ? cs : sgn * sn); }
                acc[mt][0] = MFMA16(a, b0, acc[mt][0]); acc[mt][1] = MFMA16(a, b1, acc[mt][1]); }
        }
    }
#pragma unroll
    for (int mt = 0; mt < MT; ++mt)
#pragma unroll
        for (int reg = 0; reg < 4; ++reg) { const float a = acc[mt][0][reg] * scale, b = acc[mt][1][reg] * scale; acc[mt][0][reg] = a; acc[mt][1][reg] = b;
            float s = a * a + b * b; s += __shfl_xor(s, 1); s += __shfl_xor(s, 2); s += __shfl_xor(s, 4); s += __shfl_xor(s, 8);
            if (fr == 0) red[w * 64 + mt * 16 + 4 * fq + reg] = s; }
    __syncthreads();
    bf16* MA = (bf16*)(ws + WS_H); const float* fg = inptr(I_FOURG) + l * 256;
    const float g0 = fg[(2 * w) * 16 + fr], g1 = fg[(2 * w + 1) * 16 + fr];
#pragma unroll
    for (int mt = 0; mt < MT; ++mt)
#pragma unroll
        for (int reg = 0; reg < 4; ++reg) { const int ml = mt * 16 + 4 * fq + reg; float tot = 0.f;
#pragma unroll
            for (int ww = 0; ww < 8; ++ww) tot += red[ww * 64 + ml];
            const float rs = rsqrtf(tot * (1.f / 256.f) + RMS_EPS);
            bf16* o = MA + (size_t)orow(m0 + ml) * D + 768 + fr;
            o[(2 * w) * 16] = (bf16)f2bf(acc[mt][0][reg] * rs * g0); o[(2 * w + 1) * 16] = (bf16)f2bf(acc[mt][1][reg] * rs * g1); }
    __syncthreads();
}

constexpr size_t WS_LORA = 64 * 1024;
constexpr int LINP = 392;
__device__ __forceinline__ float fast_sigmoid(float x) { return __builtin_amdgcn_rcpf(1.f + __expf(-x)); }
__device__ __forceinline__ float fast_tanh(float x) { return 1.f - 2.f * __builtin_amdgcn_rcpf(1.f + __expf(2.f * x)); }
__device__ __forceinline__ void prep_phase(const Frame& F0, int l) {
    const Frame F = phase_frame(F0); unsigned char* const ws = F.ws;
    const bf16* Zs = (const bf16*)(ws + WS_ZS); bf16* STR = (bf16*)(ws + WS_STR);
    LAS bf16* lin = (LAS bf16*)F.lds;
    LAS float* ssum = (LAS float*)(F.lds + 12544);
    constexpr int TP = 72, TSZ = 16 * TP;
    LAS bf16* tiles = (LAS bf16*)(F.lds + 13312);
    const int lane = F.lane, fr = lane & 15, fq = lane >> 4, w = F.wave, tid = F.tid;
    const int nitems = (NROW / 16) * 2;
    int it = blockIdx.x; if (it >= nitems) return;
    int hh = -1, head = 0, cb = 0;
    bf16x8 wf[12][2];
    const float* kkp = inptr(I_KK) + l * DR; const float* kap = inptr(I_KA) + l * DR; const float* dw0 = inptr(I_DW0) + l * 2 * DR; const float* ia0 = inptr(I_IA0) + l * 2 * DR;
    u32x4 pz[2];
#define PREP_LOAD(item_) do { const int row0_ = ((item_) >> 1) * 16; \
        pz[0] = *(const u32x4*)(Zs + (size_t)(row0_ + tid / 48) * ZW + 1536 + (tid % 48) * 8); \
        if (tid < 256) pz[1] = *(const u32x4*)(Zs + (size_t)(row0_ + (tid + 512) / 48) * ZW + 1536 + ((tid + 512) % 48) * 8); } while (0)
    PREP_LOAD(it);
    for (; it < nitems; it += F.G) {
        const int tile = it >> 1;
        if ((it & 1) != hh) {
            hh = it & 1; head = 4 * hh + (w >> 1); cb = 64 * head + 32 * (w & 1);
            const bf16* WL = (const bf16*)(ws + WS_LORA) + (size_t)l * 512 * 384 + (size_t)(cb + fr) * 384 + 8 * fq;
#pragma unroll
            for (int ks = 0; ks < 12; ++ks)
#pragma unroll
                for (int nt = 0; nt < 2; ++nt) wf[ks][nt] = *(const bf16x8*)(WL + (size_t)nt * 16 * 384 + ks * 32);
        }
        __syncthreads();
        {   float v[8]; unpack8(pz[0], v); const int c8 = tid % 48;
            if (c8 < 16) {
#pragma unroll
                for (int j = 0; j < 8; ++j) v[j] = fast_tanh(v[j]); }
            else if (c8 >= 32) {
#pragma unroll
                for (int j = 0; j < 8; ++j) v[j] = fast_sigmoid(v[j]); }
            *(LAS u32x4*)(lin + (tid / 48) * LINP + c8 * 8) = (u32x4){pk2(v[0], v[1]), pk2(v[2], v[3]), pk2(v[4], v[5]), pk2(v[6], v[7])};
            if (tid < 256) { unpack8(pz[1], v); const int c9 = (tid + 512) % 48;
                if (c9 < 16) {
#pragma unroll
                    for (int j = 0; j < 8; ++j) v[j] = fast_tanh(v[j]); }
                else if (c9 >= 32) {
#pragma unroll
                    for (int j = 0; j < 8; ++j) v[j] = fast_sigmoid(v[j]); }
                *(LAS u32x4*)(lin + ((tid + 512) / 48) * LINP + c9 * 8) = (u32x4){pk2(v[0], v[1]), pk2(v[2], v[3]), pk2(v[4], v[5]), pk2(v[6], v[7])}; } }
        u32x2 zr2[2], zk2[2], zv2[2];
        {   const bf16* zr_ = Zs + (size_t)(tile * 16 + fr) * ZW + cb + 4 * fq;
#pragma unroll
            for (int nt = 0; nt < 2; ++nt) { zr2[nt] = *(const u32x2*)(zr_ + 16 * nt); zk2[nt] = *(const u32x2*)(zr_ + 512 + 16 * nt); zv2[nt] = *(const u32x2*)(zr_ + 1024 + 16 * nt); } }
        if (it + F.G < nitems) PREP_LOAD(it + F.G);
        __syncthreads();
        f32x4 kkw[2], kaw[2], d0w[2][2], i0w[2][2];
#pragma unroll
        for (int nt = 0; nt < 2; ++nt) { const int c0 = cb + 16 * nt + 4 * fq; kkw[nt] = *(const f32x4*)(kkp + c0); kaw[nt] = *(const f32x4*)(kap + c0);
#pragma unroll
            for (int dn = 0; dn < 2; ++dn) { d0w[dn][nt] = *(const f32x4*)(dw0 + dn * DR + c0); i0w[dn][nt] = *(const f32x4*)(ia0 + dn * DR + c0); } }
        f32x4 acc[5][2];
#pragma unroll
        for (int q = 0; q < 5; ++q) { acc[q][0] = (f32x4){0.f, 0.f, 0.f, 0.f}; acc[q][1] = (f32x4){0.f, 0.f, 0.f, 0.f}; }
#pragma unroll
        for (int ks = 0; ks < 12; ++ks) { const int q = ks < 8 ? (ks >> 1) : 4; const bf16x8 xf = *(const LAS bf16x8*)(lin + fr * LINP + ks * 32 + 8 * fq);
            acc[q][0] = MFMA16(wf[ks][0], xf, acc[q][0]); acc[q][1] = MFMA16(wf[ks][1], xf, acc[q][1]); }
        float zk[2][4], kv[2][4]; float ss = 0.f;
#pragma unroll
        for (int nt = 0; nt < 2; ++nt) { unpack4(zk2[nt], zk[nt]);
#pragma unroll
            for (int i = 0; i < 4; ++i) { kv[nt][i] = zk[nt][i] * kkw[nt][i]; ss += kv[nt][i] * kv[nt][i]; } }
        ss += __shfl_xor(ss, 16); ss += __shfl_xor(ss, 32);
        if (fq == 0) ssum[w * 16 + fr] = ss;
        __syncthreads();
        const float inv = __builtin_amdgcn_rcpf(fmaxf(sqrtf(ssum[w * 16 + fr] + ssum[(w ^ 1) * 16 + fr]), 1e-12f));
        LAS bf16* th = tiles + (w >> 1) * 10 * TSZ + fr * TP + 32 * (w & 1) + 4 * fq;
#pragma unroll
        for (int nt = 0; nt < 2; ++nt) { LAS bf16* t0 = th + 16 * nt;
            *(LAS u32x2*)(t0) = zr2[nt]; *(LAS u32x2*)(t0 + TSZ) = zv2[nt];
            float kk[4];
#pragma unroll
            for (int i = 0; i < 4; ++i) kk[i] = kv[nt][i] * inv;
            *(LAS u32x2*)(t0 + 2 * TSZ) = (u32x2){pk2(kk[0], kk[1]), pk2(kk[2], kk[3])};
            *(LAS u32x2*)(t0 + 3 * TSZ) = (u32x2){pk2(acc[4][nt][0], acc[4][nt][1]), pk2(acc[4][nt][2], acc[4][nt][3])};
#pragma unroll
            for (int dn = 0; dn < 2; ++dn) { float ep[4], kd[4], bb[4];
#pragma unroll
                for (int i = 0; i < 4; ++i) { const float ew = fast_sigmoid(d0w[dn][nt][i] + acc[dn][nt][i]) * 0.6065306597126334f;
                    ep[i] = ew * (1.f + ew * (-0.5f + ew * (0.16666667f + ew * (-0.041666668f + ew * 0.0083333338f))));
                    const float a = fast_sigmoid(i0w[dn][nt][i] + acc[2 + dn][nt][i]); kd[i] = zk[nt][i] * (1.f + (a - 1.f) * kaw[nt][i]); bb[i] = kk[i] * a; }
                *(LAS u32x2*)(t0 + (4 + 3 * dn) * TSZ) = (u32x2){pk2(ep[0], ep[1]), pk2(ep[2], ep[3])};
                *(LAS u32x2*)(t0 + (5 + 3 * dn) * TSZ) = (u32x2){pk2(kd[0], kd[1]), pk2(kd[2], kd[3])};
                *(LAS u32x2*)(t0 + (6 + 3 * dn) * TSZ) = (u32x2){pk2(bb[0], bb[1]), pk2(bb[2], bb[3])}; } }
        __syncthreads();
        {   const LAS bf16* src = tiles + (w >> 1) * 10 * TSZ + (8 * (w & 1) + (lane >> 3)) * TP + (lane & 7) * 8; bf16* dst = STR + ((size_t)tile * 8 + head) * 10240 + 8 * (w & 1) * 64 + lane * 8;
#pragma unroll
            for (int s = 0; s < 10; ++s) *(u32x4*)(dst + s * 1024) = *(const LAS u32x4*)(src + s * TSZ); }
    }
#undef PREP_LOAD
}

__device__ __forceinline__ int scan_rowof(int s, int dir, int b) { if (s < CTXL) { const int tc = dir ? (CTXL - 1 - s) : s; return NLAT + b * CTXL + tc; } const int tt = s - CTXL; const int t = dir ? (SEQ - 1 - tt) : tt; return b * SEQ + t; }
__device__ __forceinline__ void readout_pass(const Frame& F0, int l, int nrows) {
    const Frame F = phase_frame(F0); unsigned char* const ws = F.ws;
    const bf16* STR = (const bf16*)(ws + WS_STR); const bf16* Y0 = (const bf16*)(ws + WS_Y); const bf16* Y1 = Y0 + (size_t)NROW * DR; bf16* MA = (bf16*)(ws + WS_H);
    const int lane = F.lane, c = 8 * lane;
    float gw[8], gb[8], rk[8];
    {   const float* gnw = inptr(I_GNW) + l * DR + c; const float* gnb = inptr(I_GNB) + l * DR + c; const float* rkp = inptr(I_RK) + l * DR + c;
        const f32x4 a0 = *(const f32x4*)gnw, a1 = *(const f32x4*)(gnw + 4), b0 = *(const f32x4*)gnb, b1 = *(const f32x4*)(gnb + 4), r0 = *(const f32x4*)rkp, r1 = *(const f32x4*)(rkp + 4);
#pragma unroll
        for (int i = 0; i < 4; ++i) { gw[i] = a0[i]; gw[4 + i] = a1[i]; gb[i] = b0[i]; gb[4 + i] = b1[i]; rk[i] = r0[i]; rk[4 + i] = r1[i]; } }
    for (int row0 = F.gw; row0 < nrows; row0 += 2 * F.NGW) {
        u32x4 q[2][7]; bool ok[2];
#pragma unroll
        for (int u = 0; u < 2; ++u) { const int row = row0 + u * F.NGW; ok[u] = row < nrows; if (ok[u]) {
            const bf16* sr = STR + ((size_t)(row >> 4) * 8 + (lane >> 3)) * 10240 + (row & 15) * 64 + (lane & 7) * 8;
            q[u][0] = *(const u32x4*)(Y0 + (size_t)row * DR + c); q[u][1] = *(const u32x4*)(Y1 + (size_t)row * DR + c);
            q[u][2] = *(const u32x4*)sr; q[u][3] = *(const u32x4*)(sr + 1024); q[u][4] = *(const u32x4*)(sr + 3072); q[u][5] = *(const u32x4*)(sr + 5 * 1024); q[u][6] = *(const u32x4*)(sr + 8 * 1024); } }
#pragma unroll
        for (int u = 0; u < 2; ++u) if (ok[u]) { const int row = row0 + u * F.NGW;
            float ya[8], yb[8], r[8], v[8], g[8], k0[8], k1[8];
            unpack8(q[u][0], ya); unpack8(q[u][1], yb); unpack8(q[u][2], r); unpack8(q[u][3], v); unpack8(q[u][4], g); unpack8(q[u][5], k0); unpack8(q[u][6], k1);
            float s1 = 0.f, s2 = 0.f, sb = 0.f;
#pragma unroll
            for (int i = 0; i < 8; ++i) { ya[i] += yb[i]; s1 += ya[i]; s2 += ya[i] * ya[i]; sb += r[i] * (k0[i] + k1[i]) * rk[i]; }
#pragma unroll
            for (int o = 1; o < 8; o <<= 1) { s1 += __shfl_xor(s1, o); s2 += __shfl_xor(s2, o); sb += __shfl_xor(sb, o); }
            const float mu = s1 * (1.f / 64.f); const float var = fmaxf(s2 * (1.f / 64.f) - mu * mu, 0.f); const float rs = rsqrtf(var + GN_EPS);
            float o8[8];
#pragma unroll
            for (int i = 0; i < 8; ++i) o8[i] = ((ya[i] - mu) * rs * gw[i] + gb[i] + sb * v[i]) * g[i];
            *(u32x4*)(MA + (size_t)row * D + c) = (u32x4){pk2(o8[0], o8[1]), pk2(o8[2], o8[3]), pk2(o8[4], o8[5]), pk2(o8[6], o8[7])}; }
    }
}
constexpr int BLOB = 16384, SEGCH = 132, NSEG = 4, BLOB_B1_SCANS = 14;
constexpr size_t WS_BLOBA = 20 * MiB, WS_BLOBB1 = 86 * MiB, WS_BLOBB2 = 492 * MiB;
constexpr size_t WS_SCANST = 2 * MiB + 512 * 1024;
__device__ __forceinline__ unsigned char* blob_ptr(unsigned char* ws, int seg, int scan, int ci) {
    if ((seg & 1) == 0) return ws + WS_BLOBA + ((size_t)scan * SEGCH + ci) * BLOB;
    return scan < BLOB_B1_SCANS ? ws + WS_BLOBB1 + ((size_t)scan * SEGCH + ci) * BLOB : ws + WS_BLOBB2 + ((size_t)(scan - BLOB_B1_SCANS) * SEGCH + ci) * BLOB;
}
typedef short s16x4 __attribute__((ext_vector_type(4)));
__device__ __forceinline__ bf16x8 frag_lo(u32x2 x) { u32x4 t = {x.x, x.y, 0u, 0u}; return __builtin_bit_cast(bf16x8, t); }
__device__ __forceinline__ bf16x8 frag_c(const f32x4& a) { u32x4 t = {pk2(a[0], a[1]), pk2(a[2], a[3]), 0u, 0u}; return __builtin_bit_cast(bf16x8, t); }

struct PreRegs { u32x4 q[12]; };
__device__ __forceinline__ void pre_load(PreRegs& R, unsigned char* ws, int scan, int cs, int lane) {
    const int dir = scan & 1, h = (scan >> 1) & 7, b = scan >> 4; const int rfirst = scan_rowof(16 * cs, dir, b);
    const bf16* blk = (const bf16*)(ws + WS_STR) + ((size_t)(rfirst >> 4) * 8 + h) * 10240 + lane * 8;
    const int so[6] = {0, 1, 2, 4 + 3 * dir, 5 + 3 * dir, 6 + 3 * dir};
#pragma unroll
    for (int i = 0; i < 6; ++i) { R.q[2 * i] = *(const u32x4*)(blk + so[i] * 1024); R.q[2 * i + 1] = *(const u32x4*)(blk + so[i] * 1024 + 512); }
}
template <int PM>
__device__ __forceinline__ void pre_item(const Frame& F, unsigned char* ws, int scan, int cs, unsigned char* blob, PreRegs& PR, int nscan, int ncs) {
    const int dir = scan & 1, h = (scan >> 1) & 7, b = scan >> 4; const int lane = F.lane, fr = lane & 15, fq = lane >> 4;
    LAS unsigned char* L = F.lds + F.wave * 17408;
    LAS bf16* TK = (LAS bf16*)L; LAS bf16* TR = TK + 1024; LAS bf16* TKt = TR + 1024; LAS bf16* TB = TKt + 1024;
    LAS bf16* KTt = TB + 1024; LAS bf16* RTt = KTt + 1024; LAS bf16* Vt = RTt + 1024;
    LAS float* AKB = (LAS float*)(Vt + 1024);
    LAS bf16* AKK = (LAS bf16*)(AKB + 256); LAS bf16* ARK = AKK + 256; LAS bf16* ARB = ARK + 256; LAS bf16* TT = ARB + 256;
    float kh[16], bh[16];
    float pc;
    {   float r_[16], v_[16], kk_[16], lp_[16], kd_[16], bb_[16];
        LAS bf16* stg = TK;
#pragma unroll
        for (int i = 0; i < 6; ++i) { *(LAS u32x4*)(stg + i * 1024 + lane * 8) = PR.q[2 * i]; *(LAS u32x4*)(stg + i * 1024 + 512 + lane * 8) = PR.q[2 * i + 1]; }
        LDS_WAIT(); asm volatile("" ::: "memory");
        if (nscan >= 0) pre_load(PR, ws, nscan, ncs, lane);
#pragma unroll
        for (int t = 0; t < 16; ++t) { const int tm = (dir ? 15 - t : t) * 64 + lane;
            r_[t] = bf2f(stg[tm]); v_[t] = bf2f(stg[1024 + tm]); kk_[t] = bf2f(stg[2048 + tm]); lp_[t] = bf2f(stg[3072 + tm]); kd_[t] = bf2f(stg[4096 + tm]); bb_[t] = bf2f(stg[5120 + tm]); }
        LDS_WAIT(); asm volatile("" ::: "memory");
        float pp = 1.f; u32x4 kt4[2], rt4[2], v4[2];
        unsigned ktp[8], rtp[8], vp[8];
#pragma unroll
        for (int t = 0; t < 16; ++t) { const float pm1 = pp; pp *= 1.f - lp_[t]; const float p = pp, ip = __builtin_amdgcn_rcpf(pp); lp_[t] = ip;
            const float kt = kk_[t] * pm1, ktl = kd_[t] * ip, btl = bb_[t] * ip, rt = r_[t] * p;
            const unsigned hk = pk2(kt, rt), hb = pk2(ktl, btl);
            TK[t * 64 + lane] = (bf16)(hk & 0xffffu); TR[t * 64 + lane] = (bf16)(hk >> 16); TKt[t * 64 + lane] = (bf16)(hb & 0xffffu); TB[t * 64 + lane] = (bf16)(hb >> 16);
            const unsigned hv = f2bf(v_[t]);
            if (t & 1) { ktp[t >> 1] |= hk << 16; rtp[t >> 1] |= hk & 0xffff0000u; vp[t >> 1] |= hv << 16; }
            else { ktp[t >> 1] = hk & 0xffffu; rtp[t >> 1] = hk >> 16; vp[t >> 1] = hv; } }
        kt4[0] = (u32x4){ktp[0], ktp[1], ktp[2], ktp[3]}; kt4[1] = (u32x4){ktp[4], ktp[5], ktp[6], ktp[7]};
        rt4[0] = (u32x4){rtp[0], rtp[1], rtp[2], rtp[3]}; rt4[1] = (u32x4){rtp[4], rtp[5], rtp[6], rtp[7]};
        v4[0] = (u32x4){vp[0], vp[1], vp[2], vp[3]}; v4[1] = (u32x4){vp[4], vp[5], vp[6], vp[7]};
        *(LAS u32x4*)(KTt + lane * 16) = kt4[0]; *(LAS u32x4*)(KTt + lane * 16 + 8) = kt4[1];
        *(LAS u32x4*)(RTt + lane * 16) = rt4[0]; *(LAS u32x4*)(RTt + lane * 16 + 8) = rt4[1];
        *(LAS u32x4*)(Vt + lane * 16) = v4[0]; *(LAS u32x4*)(Vt + lane * 16 + 8) = v4[1];
        pc = pp;
#pragma unroll
        for (int t = 0; t < 16; ++t) { const float e = pp * lp_[t]; kh[t] = kd_[t] * e; bh[t] = bb_[t] * e; }
    }
    LDS_WAIT(); asm volatile("" ::: "memory");
    {   f32x4 akb = {0.f, 0.f, 0.f, 0.f}, akk = akb, ark = akb, arb = akb;
#pragma unroll
        for (int s = 0; s < 2; ++s) { const int o = fr * 64 + 32 * s + 8 * fq;
            const bf16x8 fk = *(const LAS bf16x8*)(TK + o), frr = *(const LAS bf16x8*)(TR + o), fkt = *(const LAS bf16x8*)(TKt + o), fb = *(const LAS bf16x8*)(TB + o);
            akb = MFMA16(fk, fb, akb); akk = MFMA16(fk, fkt, akk); ark = MFMA16(frr, fkt, ark); arb = MFMA16(frr, fb, arb); }
        float nm[4];
#pragma unroll
        for (int reg = 0; reg < 4; ++reg) { const int t = 4 * fq + reg; const bool lo = fr < t, le = fr <= t;
            nm[reg] = lo ? akb[reg] : 0.f; AKK[t * 16 + fr] = (bf16)f2bf(lo ? akk[reg] : 0.f);
            ARK[t * 16 + fr] = (bf16)f2bf(le ? ark[reg] : 0.f); ARB[t * 16 + fr] = (bf16)f2bf(le ? arb[reg] : 0.f); }
        float col[16];
#pragma unroll
        for (int t = 0; t < 16; ++t) { float s_ = (t == fr) ? 1.f : 0.f;
#pragma unroll
            for (int i = 0; i < 16; ++i) if (i < t) { const float n_ti = __builtin_bit_cast(float, __builtin_amdgcn_readlane(__builtin_bit_cast(int, nm[t & 3]), i + 16 * (t >> 2))); s_ -= n_ti * col[i]; }
            col[t] = s_; TT[t * 16 + fr] = (bf16)f2bf(s_); }
    }
    LDS_WAIT(); asm volatile("" ::: "memory");
    f32x4 WTc[4], RqT[4], U0c[4], Y0c[4];
    {   const bf16x8 aT = frag_lo(*(const LAS u32x2*)(TT + fr * 16 + 4 * fq)), aKK = frag_lo(*(const LAS u32x2*)(AKK + fr * 16 + 4 * fq)), aRK = frag_lo(*(const LAS u32x2*)(ARK + fr * 16 + 4 * fq));
        u32x2 nb = *(const LAS u32x2*)(ARB + fr * 16 + 4 * fq); nb.x ^= 0x80008000u; nb.y ^= 0x80008000u; const bf16x8 aRBn = frag_lo(nb);
        const f32x4 z4 = {0.f, 0.f, 0.f, 0.f};
#pragma unroll
        for (int nt = 0; nt < 4; ++nt) { const int o = (16 * nt + fr) * 16 + 4 * fq;
            const bf16x8 bK = frag_lo(*(const LAS u32x2*)(KTt + o)), bV = frag_lo(*(const LAS u32x2*)(Vt + o));
            float ri[4]; unpack4(*(const LAS u32x2*)(TR + fr * 64 + 16 * nt + 4 * fq), ri);
            const f32x4 Wn = MFMA16(aT, bK, z4); WTc[nt] = MFMA16(bK, aT, z4);
            const f32x4 Zn = MFMA16(aKK, bV, z4);
            U0c[nt] = MFMA16(aT, frag_c(Zn), z4);
            RqT[nt] = MFMA16(frag_c(Wn), aRBn, ((f32x4){ri[0], ri[1], ri[2], ri[3]}));
            Y0c[nt] = MFMA16(aRK, bV, z4); Y0c[nt] = MFMA16(aRBn, frag_c(U0c[nt]), Y0c[nt]); }
    }
    LDS_WAIT(); asm volatile("" ::: "memory");
#pragma unroll
    for (int nt = 0; nt < 4; ++nt) { const u32x2 vv = *(const LAS u32x2*)(Vt + (16 * nt + fr) * 16 + 4 * fq);
        *(u32x2*)(blob + 8192 + nt * 2048 + 1024 + lane * 8) = vv;
        u32x2 u0 = {pk2(U0c[nt][0], U0c[nt][1]), pk2(U0c[nt][2], U0c[nt][3])}, y0 = {pk2(Y0c[nt][0], Y0c[nt][1]), pk2(Y0c[nt][2], Y0c[nt][3])};
        *(u32x2*)(blob + 8192 + nt * 2048 + lane * 8) = u0; *(u32x2*)(blob + 8192 + nt * 2048 + 512 + lane * 8) = y0;
        *(float*)(blob + 8192 + nt * 2048 + 1536 + lane * 4) = pc; }
#pragma unroll
    for (int s = 0; s < 2; ++s) {
        *(u32x4*)(blob + (0 * 2 + s) * 1024 + lane * 16) = (u32x4){pk2(WTc[2 * s][0], WTc[2 * s][1]), pk2(WTc[2 * s][2], WTc[2 * s][3]), pk2(WTc[2 * s + 1][0], WTc[2 * s + 1][1]), pk2(WTc[2 * s + 1][2], WTc[2 * s + 1][3])};
        *(u32x4*)(blob + (1 * 2 + s) * 1024 + lane * 16) = (u32x4){pk2(RqT[2 * s][0], RqT[2 * s][1]), pk2(RqT[2 * s][2], RqT[2 * s][3]), pk2(RqT[2 * s + 1][0], RqT[2 * s + 1][1]), pk2(RqT[2 * s + 1][2], RqT[2 * s + 1][3])}; }
    LAS bf16* BHt = TKt; LAS bf16* KHt = TB;
    {   u32x4 a, c, d, e;
        a = (u32x4){pk2(bh[0], bh[1]), pk2(bh[2], bh[3]), pk2(bh[4], bh[5]), pk2(bh[6], bh[7])}; c = (u32x4){pk2(bh[8], bh[9]), pk2(bh[10], bh[11]), pk2(bh[12], bh[13]), pk2(bh[14], bh[15])};
        d = (u32x4){pk2(kh[0], kh[1]), pk2(kh[2], kh[3]), pk2(kh[4], kh[5]), pk2(kh[6], kh[7])}; e = (u32x4){pk2(kh[8], kh[9]), pk2(kh[10], kh[11]), pk2(kh[12], kh[13]), pk2(kh[14], kh[15])};
        *(LAS u32x4*)(BHt + lane * 16) = a; *(LAS u32x4*)(BHt + lane * 16 + 8) = c; *(LAS u32x4*)(KHt + lane * 16) = d; *(LAS u32x4*)(KHt + lane * 16 + 8) = e; }
    LDS_WAIT(); asm volatile("" ::: "memory");
#pragma unroll
    for (int mt = 0; mt < 4; ++mt) { const int o = (16 * mt + fr) * 16 + 4 * fq; const u32x2 bb = *(const LAS u32x2*)(BHt + o), kk = *(const LAS u32x2*)(KHt + o);
        *(u32x4*)(blob + 4096 + mt * 1024 + lane * 16) = (u32x4){bb.x ^ 0x80008000u, bb.y ^ 0x80008000u, kk.x, kk.y}; }
    LDS_WAIT(); asm volatile("" ::: "memory");
}

__device__ __forceinline__ void pre_phase(const Frame& F0, int seg, int b_lo) {
    const Frame F = phase_frame(F0); unsigned char* const ws = F.ws;
    if ((int)blockIdx.x < b_lo) return;
    const int nwv = (F.G - b_lo) * NWAVES;
    PreRegs R;
    int it = ((int)blockIdx.x - b_lo) * NWAVES + F.wave; if (it >= 32 * SEGCH) return;
    pre_load(R, ws, it & 31, seg * SEGCH + (it >> 5), F.lane);
    for (; it < 32 * SEGCH; it += nwv) { const int nx = it + nwv; const bool hn = nx < 32 * SEGCH;
        pre_item<0>(F, ws, it & 31, seg * SEGCH + (it >> 5), blob_ptr(ws, seg, it & 31, it >> 5), R, hn ? (nx & 31) : -1, seg * SEGCH + (nx >> 5)); }
}

constexpr int SQ_SLOT = 10240, SQ_R = 12, SQ_D = 8;
template <int MODE>
__device__ __forceinline__ void seq_item(const Frame& F0, int item, int seg, bool need_ctx) {
    const Frame F = phase_frame(F0); unsigned char* const ws = F.ws;
    const int scan = item >> 2, vb = item & 3, dir = scan & 1, h = (scan >> 1) & 7, b = scan >> 4; const int lane = F.lane, fr = lane & 15, fq = lane >> 4, w = F.wave;
    const unsigned char* blob = blob_ptr(ws, seg, scan, 0);
    LAS unsigned char* ring = F.lds;
    __syncthreads();
    const int p0 = 2 * (w - 1);
    const unsigned goff0 = (p0 < 8 ? p0 * 1024 : 8192 + vb * 2048 + (p0 - 8) * 1024) + lane * 16, goff1 = (p0 + 1 < 8 ? (p0 + 1) * 1024 : 8192 + vb * 2048 + (p0 + 1 - 8) * 1024) + lane * 16;
#define SQ_ISSUE(c) do { const unsigned char* g_ = blob + (size_t)(c) * BLOB; LAS unsigned char* s_ = ring + ((c) % SQ_R) * SQ_SLOT + p0 * 1024; \
        __builtin_amdgcn_global_load_lds((const unsigned*)(g_ + goff0), (LAS unsigned*)(s_), 16, 0, 0); \
        __builtin_amdgcn_global_load_lds((const unsigned*)(g_ + goff1), (LAS unsigned*)(s_ + 1024), 16, 0, 0); } while (0)
    const bool loader = (w >= 1 && w <= 5) && MODE != 2;
    if (loader) { for (int c = 0; c < SQ_D; ++c) SQ_ISSUE(c); }
    bf16* Y = (bf16*)(ws + WS_Y) + (size_t)dir * NROW * DR + h * 64 + 16 * vb + fr;
    float* st = (float*)(ws + WS_SCANST) + (size_t)item * 1024 + lane * 4;
    f32x4 M[4];
#pragma unroll
    for (int mt = 0; mt < 4; ++mt) M[mt] = (seg == 0 || w != 0) ? (f32x4){0.f, 0.f, 0.f, 0.f} : *(const f32x4*)(st + mt * 256);
    const f32x4 z4 = {0.f, 0.f, 0.f, 0.f};
    LAS unsigned char* mb = ring + SQ_R * SQ_SLOT;
    struct SQ { bf16x8 a1[2], a2[4]; f32x4 pc[4]; u32x2 u0, vv; };
#define SQ_READ(R, c) do { const LAS unsigned char* sl_ = ring + ((c) % SQ_R) * SQ_SLOT; _Pragma("unroll") for (int i = 0; i < 4; ++i) { \
        R.a2[i] = *(const LAS bf16x8*)(sl_ + 4096 + i * 1024 + lane * 16); R.pc[i] = *(const LAS f32x4*)(sl_ + 8192 + 1536 + (16 * i + 4 * fq) * 4); } \
        R.a1[0] = *(const LAS bf16x8*)(sl_ + lane * 16); R.a1[1] = *(const LAS bf16x8*)(sl_ + 1024 + lane * 16); \
        R.u0 = *(const LAS u32x2*)(sl_ + 8192 + lane * 8); R.vv = *(const LAS u32x2*)(sl_ + 8192 + 1024 + lane * 8); } while (0)
#define SQ_STEP(R, c, RN, cn) do { \
        if ((cn) < SEGCH) SQ_READ(RN, cn); \
        const u32x4 t0 = {pk2(M[0][0], M[0][1]), pk2(M[0][2], M[0][3]), pk2(M[1][0], M[1][1]), pk2(M[1][2], M[1][3])}; \
        const u32x4 t1 = {pk2(M[2][0], M[2][1]), pk2(M[2][2], M[2][3]), pk2(M[3][0], M[3][1]), pk2(M[3][2], M[3][3])}; \
        *(LAS u32x4*)(mb + ((c) & 1) * 2048 + lane * 16) = t0; *(LAS u32x4*)(mb + ((c) & 1) * 2048 + 1024 + lane * 16) = t1; \
        const bf16x8 b0 = __builtin_bit_cast(bf16x8, t0), b1 = __builtin_bit_cast(bf16x8, t1); \
        f32x4 X0 = MFMA16(R.a1[0], b0, z4); X0 = MFMA16(R.a1[1], b1, X0); \
        float u0[4]; unpack4(R.u0, u0); \
        const u32x4 tb = {pk2(X0[0] + u0[0], X0[1] + u0[1]), pk2(X0[2] + u0[2], X0[3] + u0[3]), R.vv.x, R.vv.y}; const bf16x8 bB = __builtin_bit_cast(bf16x8, tb); \
        _Pragma("unroll") for (int mt = 0; mt < 4; ++mt) M[mt] = MFMA16(R.a2[mt], bB, R.pc[mt] * M[mt]); \
        asm volatile("s_waitcnt lgkmcnt(0)" ::: "memory"); } while (0)
    const long ystep = dir ? -(long)DR : (long)DR;
#define SQ_YSTEP(c) do { const int cs_ = seg * SEGCH + (c); if (MODE == 0 && (need_ctx || cs_ >= 16)) { const LAS unsigned char* sl_ = ring + ((c) % SQ_R) * SQ_SLOT; \
        const bf16x8 q0 = *(const LAS bf16x8*)(sl_ + 2048 + lane * 16), q1 = *(const LAS bf16x8*)(sl_ + 3072 + lane * 16); \
        const bf16x8 b0 = *(const LAS bf16x8*)(mb + ((c) & 1) * 2048 + lane * 16), b1 = *(const LAS bf16x8*)(mb + ((c) & 1) * 2048 + 1024 + lane * 16); \
        float y0[4]; unpack4(*(const LAS u32x2*)(sl_ + 8192 + 512 + lane * 8), y0); \
        f32x4 X1 = MFMA16(q0, b0, z4); X1 = MFMA16(q1, b1, X1); \
        bf16* yp = Y + (size_t)scan_rowof(16 * cs_ + 4 * fq, dir, b) * DR; \
        yp[0] = (bf16)f2bf(X1[0] + y0[0]); yp[ystep] = (bf16)f2bf(X1[1] + y0[1]); yp[2 * ystep] = (bf16)f2bf(X1[2] + y0[2]); yp[3 * ystep] = (bf16)f2bf(X1[3] + y0[3]); \
        asm volatile("s_waitcnt lgkmcnt(0)" ::: "memory"); } } while (0)
#define SQ_LOADER(c) do { if (loader) { if ((c) + SQ_D < SEGCH) { SQ_ISSUE((c) + SQ_D); asm volatile("s_waitcnt vmcnt(12)" ::: "memory"); } else asm volatile("s_waitcnt vmcnt(0)" ::: "memory"); } \
        __builtin_amdgcn_s_barrier(); asm volatile("" ::: "memory"); } while (0)
    const bool stw = (w == 0 && MODE != 1), yw = (w == 6 && MODE != 1);
    SQ Ra, Rb, Rc;
    SQ_LOADER(0);
    if (stw) { SQ_READ(Ra, 0); SQ_READ(Rb, 1); }
    for (int c = 0; c < SEGCH; c += 3) {
        SQ_LOADER(c + 1);
        if (stw) SQ_STEP(Ra, c, Rc, c + 2);
        if (yw && c > 0) SQ_YSTEP(c - 1);
        SQ_LOADER(c + 2);
        if (stw) SQ_STEP(Rb, c + 1, Ra, c + 3);
        if (yw) SQ_YSTEP(c);
        SQ_LOADER(c + 3);
        if (stw) SQ_STEP(Rc, c + 2, Rb, c + 4);
        if (yw) SQ_YSTEP(c + 1);
    }
    __builtin_amdgcn_s_barrier(); asm volatile("" ::: "memory");
    if (yw) SQ_YSTEP(SEGCH - 1);
#undef SQ_READ
#undef SQ_STEP
#undef SQ_YSTEP
#undef SQ_LOADER
#undef SQ_ISSUE
    if (MODE >= 2 && w == 0 && M[0][0] + M[1][1] + M[2][2] + M[3][3] == 12345.678f) st[0] = M[0][0];
    if (MODE == 0 && w == 0 && seg + 1 < NSEG) {
#pragma unroll
        for (int mt = 0; mt < 4; ++mt) *(f32x4*)(st + mt * 256) = M[mt]; }
    __syncthreads();
}

namespace pg8 {
struct EpiStoreBf16 {
    static constexpr bool PERM = true, AFTER_DRAIN = false;
    bf16_t* O; int ldc; int pn_mask;
    __device__ __forceinline__ void operator()(const f32x4 (&acc)[2][2][4][2], const Unit& u, int wr, int wc, int fr, int fq) const {
        const int row0 = u.pm * BM + wr * 64 + fr; const int col0 = (u.pn & pn_mask) * BM + wc * 32 + 8 * fq;
#pragma unroll
        for (int ai = 0; ai < 2; ++ai)
#pragma unroll
            for (int m = 0; m < 4; ++m) { bf16_t* rowp = O + (size_t)(row0 + ai * HALF + m * 16) * ldc + col0;
#pragma unroll
                for (int bj = 0; bj < 2; ++bj) { const f32x4 v0 = acc[ai][bj][m][0], v1 = acc[ai][bj][m][1];
                    u32x4 w; w.x = cvt_pk_bf16(v0[0], v0[1]); w.y = cvt_pk_bf16(v0[2], v0[3]); w.z = cvt_pk_bf16(v1[0], v1[1]); w.w = cvt_pk_bf16(v1[2], v1[3]);
                    *(u32x4*)(rowp + bj * HALF) = w; } }
    }
};
struct EpiSwiGLU {
    static constexpr bool PERM = true, AFTER_DRAIN = false;
    bf16_t* O;
    __device__ __forceinline__ void operator()(const f32x4 (&acc)[2][2][4][2], const Unit& u, int wr, int wc, int fr, int fq) const {
        const int row0 = u.pm * BM + wr * 64 + fr; const int col0 = ((u.pn & 3) * BM + wc * 32 + 8 * fq) >> 1;
#pragma unroll
        for (int ai = 0; ai < 2; ++ai)
#pragma unroll
            for (int m = 0; m < 4; ++m) { bf16_t* rowp = O + (size_t)(row0 + ai * HALF + m * 16) * 512 + col0;
#pragma unroll
                for (int bj = 0; bj < 2; ++bj) { const f32x4 g = acc[ai][bj][m][0], up = acc[ai][bj][m][1]; float a[4];
#pragma unroll
                    for (int i = 0; i < 4; ++i) a[i] = g[i] / (1.f + __expf(-g[i])) * up[i];
                    unsigned long long w = (unsigned long long)cvt_pk_bf16(a[0], a[1]) | ((unsigned long long)cvt_pk_bf16(a[2], a[3]) << 32);
                    *(unsigned long long*)(rowp + bj * (HALF / 2)) = w; } }
    }
};
template <bool XF32> struct EpiResidual {
    static constexpr bool PERM = false, AFTER_DRAIN = false;
    const void* xlat; const void* xctx;
    bf16_t* out; const float* g1;
    __device__ __forceinline__ void operator()(const f32x4 (&acc)[2][2][4][2], const Unit& u, int wr, int wc, int fr, int fq) const {
        const int rowt = u.pm * BM; const int mr = rowt < 16384 ? (rowt >> 13) : 2;
        const size_t boff = rowt < 16384 ? (size_t)rowt * 1024 : (size_t)(rowt - 16384) * 1024; const void* bp = rowt < 16384 ? xlat : xctx;
        const int col0 = u.pn * BM + wc * 32 + 4 * fq;
        f32x4 gv[2][2];
#pragma unroll
        for (int bj = 0; bj < 2; ++bj)
#pragma unroll
            for (int n = 0; n < 2; ++n) gv[bj][n] = *(const f32x4*)(g1 + (size_t)mr * 6144 + col0 + bj * HALF + n * 16);
#pragma unroll
        for (int ai = 0; ai < 2; ++ai)
#pragma unroll
            for (int m = 0; m < 4; ++m) { const int rl = ai * HALF + wr * 64 + m * 16 + fr;
#pragma unroll
                for (int bj = 0; bj < 2; ++bj)
#pragma unroll
                    for (int n = 0; n < 2; ++n) { const size_t off = (size_t)rl * 1024 + col0 + bj * HALF + n * 16;
                        f32x4 xo;
                        if (XF32) xo = *(const f32x4*)((const float*)bp + boff + off);
                        else { const unsigned long long w_ = *(const unsigned long long*)((const bf16_t*)bp + boff + off); const unsigned lo = (unsigned)w_, hi = (unsigned)(w_ >> 32);
                            xo = (f32x4){__uint_as_float(lo << 16), __uint_as_float(lo & 0xffff0000u), __uint_as_float(hi << 16), __uint_as_float(hi & 0xffff0000u)}; }
                        const f32x4 r = xo + gv[bj][n] * acc[ai][bj][m][n];
                        *(unsigned long long*)(out + (size_t)rowt * 1024 + off) = (unsigned long long)cvt_pk_bf16(r[0], r[1]) | ((unsigned long long)cvt_pk_bf16(r[2], r[3]) << 32); } }
    }
};
struct MoeOrder {
    const PG8_LAS int* tile_e; const PG8_LAS int* tile_t; int ntiles, G, c;
    __device__ bool next(int i, Unit& u) const { const long L = (long)i * G + c; if (L >= 4L * ntiles) return false; const int pm = (int)(L >> 2); const int e = tile_e[pm];
        u.pm = pm; u.pn = e * 4 + (int)(L & 3); u.ga = e * 16896 + tile_t[pm] * 256; return true; }
    __device__ __forceinline__ void a_ready(const Unit&) const {}
    __device__ __forceinline__ void done(const Unit&) const {}
};
}

__device__ __forceinline__ void expert_convert(const Frame& F0, int l, int b_lo) {
    const Frame F = phase_frame(F0); unsigned char* const ws = F.ws;
    if ((int)blockIdx.x < b_lo) return;
    const int nwv = (F.G - b_lo) * NWAVES, myw = ((int)blockIdx.x - b_lo) * NWAVES + F.wave;
    LAS float* scr = (LAS float*)(F.lds + F.wave * 16384);
    bf16* wgu = (bf16*)(ws + WS_WGU_T); bf16* wd = (bf16*)(ws + WS_WD_T);
    constexpr int I_G = 16 * 16, I_D = 8 * 32;
    constexpr int NIT = NEXP * (2 * I_G + I_D);
    const float* p_eg = inptr(I_EG); const float* p_eu = inptr(I_EU); const float* p_ed = inptr(I_ED);
    for (int it = myw; it < NIT; it += nwv) { const int e = it / (2 * I_G + I_D); int r = it % (2 * I_G + I_D);
        if (r < I_G) { transpose_item(p_eg + ((size_t)l * NEXP + e) * D * DEXP, DEXP, (r >> 4) * 64, (r & 15) * 32, wgu, D, RmGU{e * 1024}, scr, F.lane); continue; } r -= I_G;
        if (r < I_G) { transpose_item(p_eu + ((size_t)l * NEXP + e) * D * DEXP, DEXP, (r >> 4) * 64, (r & 15) * 32, wgu, D, RmGU{e * 1024 + 4}, scr, F.lane); continue; } r -= I_G;
        transpose_item(p_ed + ((size_t)l * NEXP + e) * DEXP * D, D, (r >> 5) * 64, (r & 31) * 32, wd, DEXP, RmId{e * 1024}, scr, F.lane);
    }
}

__device__ __forceinline__ void router_pass(const Frame& F0, int l, int nrows, int cnt_off = 0) {
    const Frame F = phase_frame(F0); unsigned char* const ws = F.ws;
    constexpr int HP = 1028;
    LAS float* msh = (LAS float*)F.lds; LAS float* msc = msh + 3072; LAS float* hrow = msc + 3072;
    LAS float* part = hrow + 16 * HP;
    LAS float* lgs = part + 8 * 16 * 48;
    LAS unsigned* lcnt = (LAS unsigned*)(lgs + 16 * 40);
    if (F0.tid < 64) lcnt[F0.tid] = 0u;
    __syncthreads();
    mod_to_lds(F, l, 3, msh, false); mod_to_lds(F, l, 4, msc, false); __syncthreads();
    const bf16* X = (const bf16*)(ws + WS_X); bf16* H = (bf16*)(ws + WS_H);
    const float* rgw = inptr(I_RGW) + (size_t)l * D * 4; const float* rew = inptr(I_REW) + (size_t)l * D * NEXP;
    const float* rgb = inptr(I_RGB) + l * 4; const float* reb = inptr(I_REB) + l * NEXP;
    int* rt_e = (int*)(ws + WS_ROUTE + RT_E); int* rt_pos = (int*)(ws + WS_ROUTE + RT_POS); float* rt_gate = (float*)(ws + WS_ROUTE + RT_GATE);
    unsigned* cnt = (unsigned*)(ws + WS_CTL) + CW_CNT + 64 * l + cnt_off;
    const int lane = F.lane, w = F.wave, fr = lane & 15, fq = lane >> 4; const float* n2g = inptr(I_N2G) + l * D;
    float bw[32][3];
#pragma unroll
    for (int ks = 0; ks < 32; ++ks) { const int k = 128 * w + 4 * ks + fq;
        bw[ks][0] = rew[(size_t)k * 32 + fr]; bw[ks][1] = rew[(size_t)k * 32 + 16 + fr]; bw[ks][2] = fr < 4 ? rgw[(size_t)k * 4 + fr] : 0.f; }
    const int ntiles = nrows >> 4;
    u32x2 pv[2][4];
    if (F.vcu < ntiles) {
#pragma unroll
        for (int rr = 0; rr < 2; ++rr)
#pragma unroll
            for (int j = 0; j < 4; ++j) pv[rr][j] = *(const u32x2*)(X + (size_t)(F.vcu * 16 + 2 * w + rr) * D + 4 * lane + 256 * j); }
    for (int gi = F.vcu; gi < ntiles; gi += F.G) {
#pragma unroll
        for (int rr = 0; rr < 2; ++rr) { const int r = 2 * w + rr, row = gi * 16 + r; f32x4 v[4];
#pragma unroll
            for (int j = 0; j < 4; ++j) { float t_[4]; unpack4(pv[rr][j], t_); v[j] = (f32x4){t_[0], t_[1], t_[2], t_[3]}; }
            const int mr = modrow(row);
            norm_mod_row(v, n2g, msc + mr * 1024, msh + mr * 1024, H + (size_t)row * D, lane);
#pragma unroll
            for (int j = 0; j < 4; ++j) *(LAS f32x4*)(hrow + r * HP + 4 * lane + 256 * j) = v[j]; }
        if (gi + F.G < ntiles) {
#pragma unroll
            for (int rr = 0; rr < 2; ++rr)
#pragma unroll
                for (int j = 0; j < 4; ++j) pv[rr][j] = *(const u32x2*)(X + (size_t)((gi + F.G) * 16 + 2 * w + rr) * D + 4 * lane + 256 * j); }
        __syncthreads();
        {   f32x4 acc[3] = {{0.f, 0.f, 0.f, 0.f}, {0.f, 0.f, 0.f, 0.f}, {0.f, 0.f, 0.f, 0.f}};
#pragma unroll
            for (int ks = 0; ks < 32; ++ks) { const float a = hrow[fr * HP + 128 * w + 4 * ks + fq];
#pragma unroll
                for (int nt = 0; nt < 3; ++nt) acc[nt] = __builtin_amdgcn_mfma_f32_16x16x4f32(a, bw[ks][nt], acc[nt], 0, 0, 0); }
#pragma unroll
            for (int nt = 0; nt < 3; ++nt)
#pragma unroll
                for (int reg = 0; reg < 4; ++reg) part[(w * 16 + 4 * fq + reg) * 48 + 16 * nt + fr] = acc[nt][reg]; }
        __syncthreads();
        for (int idx = F.tid; idx < 16 * 36; idx += NTHR) { const int r = idx / 36, n = idx % 36; float s_ = 0.f;
#pragma unroll
            for (int ww = 0; ww < 8; ++ww) s_ += part[(ww * 16 + r) * 48 + n];
            if (n < 32) lgs[r * 40 + 4 + n] = s_ + reb[n]; else lgs[r * 40 + n - 32] = s_ + rgb[n - 32]; }
        __syncthreads();
        if (F.tid < 16) { const int rr = gi * 16 + F.tid; const LAS float* lp = lgs + F.tid * 40;
            int grp = 0; float mx = lp[0];
#pragma unroll
            for (int g = 1; g < 4; ++g) if (lp[g] > mx) { mx = lp[g]; grp = g; }
            float den = 0.f;
#pragma unroll
            for (int g = 0; g < 4; ++g) den += __expf(lp[g] - mx);
            const float pg_top = 1.f / den; const LAS float* sel = lp + 4 + grp * 8;
            int i0 = 0; float l0 = sel[0];
#pragma unroll
            for (int q = 1; q < 8; ++q) if (sel[q] > l0) { l0 = sel[q]; i0 = q; }
            int i1 = -1; float l1 = -3.0e38f;
#pragma unroll
            for (int q = 0; q < 8; ++q) if (q != i0 && sel[q] > l1) { l1 = sel[q]; i1 = q; }
            const float e1 = __expf(l1 - l0); const float w0 = pg_top / (1.f + e1), w1 = pg_top * e1 / (1.f + e1);
            const int ea = grp * 8 + i0, eb = grp * 8 + i1;
            const unsigned pa = atomicAdd((unsigned*)(lcnt + ea), 1u), pb = atomicAdd((unsigned*)(lcnt + eb), 1u);
            rt_e[2 * rr] = ea; rt_e[2 * rr + 1] = eb; rt_pos[2 * rr] = (int)pa; rt_pos[2 * rr + 1] = (int)pb; rt_gate[2 * rr] = w0; rt_gate[2 * rr + 1] = w1; }
    }
    __syncthreads();
    if (F.tid < 32) lcnt[32 + F.tid] = lcnt[F.tid] ? atomicAdd(cnt + F.tid, lcnt[F.tid]) : 0u;
    __syncthreads();
    int* elist = (int*)(ws + WS_ELIST);
    if (F.tid < 16) for (int gi = F.vcu; gi < ntiles; gi += F.G) { const int rr = gi * 16 + F.tid;
        const int ea = rt_e[2 * rr], eb = rt_e[2 * rr + 1]; const int pa = rt_pos[2 * rr] + (int)lcnt[32 + ea], pb = rt_pos[2 * rr + 1] + (int)lcnt[32 + eb];
        rt_pos[2 * rr] = pa; rt_pos[2 * rr + 1] = pb; elist[(size_t)ea * NROW + pa] = rr; elist[(size_t)eb * NROW + pb] = rr; }
}

constexpr int MOE_MAP_OFF = 131072;
__device__ __forceinline__ void moe_map(const Frame& F0, int l) {
    const Frame F = phase_frame(F0); unsigned char* const ws = F.ws;
    LAS int* mp = (LAS int*)(F.lds + MOE_MAP_OFF);
    const unsigned* cnt = (const unsigned*)(ws + WS_CTL) + CW_CNT + 64 * l;
    __syncthreads();
    if (F.tid < NEXP) mp[32 + F.tid] = (int)__hip_atomic_load(cnt + F.tid, __ATOMIC_RELAXED, __HIP_MEMORY_SCOPE_AGENT);
    __syncthreads();
    if (F.tid == 0) { int o = 0;
#pragma nounroll
        for (int e = 0; e < NEXP; ++e) { const int c = mp[32 + e]; const int nt = (c + 255) >> 8; mp[e] = o;
#pragma nounroll
            for (int t = 0; t < nt; ++t) { mp[128 + (o >> 8) + t] = e; mp[320 + (o >> 8) + t] = t; }
            o += nt << 8; }
        mp[64] = o >> 8; }
    __syncthreads();
}

template <bool DRY>
__device__ __forceinline__ void combine_pass(const Frame& F0, int l, int nrows) {
    const Frame F = phase_frame(F0); unsigned char* const ws = F.ws;
    LAS float* mg2 = (LAS float*)F.lds; LAS float* msh = mg2 + 3072; LAS float* msc = msh + 3072;
    const bool last = (l == DEPTH - 1);
    __syncthreads();
    mod_to_lds(F, l, 5, mg2, false); if (!last) { mod_to_lds(F, l + 1, 0, msh, false); mod_to_lds(F, l + 1, 1, msc, false); }
    __syncthreads();
    bf16* X = (bf16*)(ws + WS_X); bf16* H = (bf16*)(ws + WS_H); const bf16* Ys = (const bf16*)(ws + WS_XS);
    const int* rt_e = (const int*)(ws + WS_ROUTE + RT_E); const int* rt_pos = (const int*)(ws + WS_ROUTE + RT_POS); const float* rt_gate = (const float*)(ws + WS_ROUTE + RT_GATE);
    const LAS int* moff = (const LAS int*)(F.lds + MOE_MAP_OFF);
    const int lane = F.lane; const float* n1g = inptr(I_N1G) + (last ? 0 : (l + 1) * D); const float* fgp = inptr(I_FG);
    for (int row0 = F.gw; row0 < nrows; row0 += 2 * F.NGW) {
        int s0[2], s1[2]; float w0[2], w1[2]; bool ok[2]; u32x2 ya[2][4], yb[2][4], xo[2][4];
#pragma unroll
        for (int u = 0; u < 2; ++u) { const int row = row0 + u * F.NGW; ok[u] = row < nrows; if (ok[u]) { s0[u] = moff[rt_e[2 * row]] + rt_pos[2 * row]; s1[u] = moff[rt_e[2 * row + 1]] + rt_pos[2 * row + 1]; w0[u] = rt_gate[2 * row]; w1[u] = rt_gate[2 * row + 1]; } }
#pragma unroll
        for (int u = 0; u < 2; ++u) if (ok[u]) { const int row = row0 + u * F.NGW;
#pragma unroll
            for (int j = 0; j < 4; ++j) { const int c = 4 * lane + 256 * j; ya[u][j] = *(const u32x2*)(Ys + (size_t)s0[u] * D + c); yb[u][j] = *(const u32x2*)(Ys + (size_t)s1[u] * D + c); xo[u][j] = *(const u32x2*)(X + (size_t)row * D + c); } }
#pragma unroll
        for (int u = 0; u < 2; ++u) if (ok[u]) { const int row = row0 + u * F.NGW; const int mr = modrow(row); f32x4 v[4];
#pragma unroll
            for (int j = 0; j < 4; ++j) { const int c = 4 * lane + 256 * j; float a[4], b[4]; unpack4(ya[u][j], a); unpack4(yb[u][j], b);
                const f32x4 g2 = *(const LAS f32x4*)(mg2 + mr * 1024 + c);
                f32x4 y; y.x = w0[u] * a[0] + w1[u] * b[0]; y.y = w0[u] * a[1] + w1[u] * b[1]; y.z = w0[u] * a[2] + w1[u] * b[2]; y.w = w0[u] * a[3] + w1[u] * b[3];
                float x_[4]; unpack4(xo[u][j], x_); v[j] = (f32x4){x_[0], x_[1], x_[2], x_[3]} + g2 * y; }
            if (DRY) { asm volatile("" :: "v"(v[0].x + v[1].y + v[2].z + v[3].w)); }
            else if (!last) {
#pragma unroll
                for (int j = 0; j < 4; ++j) *(u32x2*)(X + (size_t)row * D + 4 * lane + 256 * j) = (u32x2){pk2(v[j].x, v[j].y), pk2(v[j].z, v[j].w)};
                norm_mod_row(v, n1g, msc + mr * 1024, msh + mr * 1024, H + (size_t)row * D, lane);
            } else { float s = 0.f;
#pragma unroll
                for (int j = 0; j < 4; ++j) s += (v[j].x * v[j].x + v[j].y * v[j].y) + (v[j].z * v[j].z + v[j].w * v[j].w);
                const float rs = rsqrtf(wave_sum(s) * (1.f / D) + RMS_EPS);
#pragma unroll
                for (int j = 0; j < 4; ++j) { const int c = 4 * lane + 256 * j; const f32x4 g = *(const f32x4*)(fgp + c); *(f32x4*)(F.out + (size_t)row * D + c) = v[j] * rs * g; } } }
    }
}
__global__ void __launch_bounds__(NTHR, 2) fwd_megakernel(Params prm) {
    extern __shared__ __attribute__((aligned(16))) unsigned char lds_raw[];
    Frame F;
    F.lds = (LAS unsigned char*)lds_raw;
    F.tid = threadIdx.x; F.lane = F.tid & 63; F.wave = __builtin_amdgcn_readfirstlane(F.tid >> 6);
    F.G = gridDim.x; { const int bx = blockIdx.x; F.vcu = (F.G % 8 == 0) ? (bx % 8) * (F.G / 8) + bx / 8 : bx; }
    F.gw = F.vcu * NWAVES + F.wave; F.NGW = F.G * NWAVES;
    F.out = prm.out; F.ws = prm.ws;
    for (int u = F.tid; u < (LDS_BYTES - LDSCTL_OFF) / 4; u += NTHR) ((LAS unsigned*)(F.lds + LDSCTL_OFF))[u] = 0u;
    __syncthreads();
    (void)xcd_barrier_post((unsigned*)(F.ws + WS_CTL) + CW_BAR, (volatile LAS unsigned*)(F.lds + MISC_OFF) + 8);
#define GRID_BAR() do { XcdBarrier bar_; bar_.bar = (unsigned*)(opaque(F.ws) + WS_CTL) + CW_BAR; bar_.x = xb_xcc_id(); bar_.st = (volatile LAS unsigned*)(F.lds + MISC_OFF) + 8; xcd_barrier(bar_); } while (0)

    p0_prologue(F);
#if USE_CG_SYNC
    cg::this_grid().sync();
#else
    GRID_BAR();
#endif
    p0b_norm1(F);
    GRID_BAR();

    for (int l = 0; l < DEPTH; ++l) {
        const bool need_ctx = (l == 0); const int nrows = need_ctx ? NROW : NLAT;
#define WSO Fp.ws
        {
            const Frame Fp = phase_frame(F); unsigned char* const ws = WSO; bf16* Hb = (bf16*)(ws + WS_H); bf16* Pb = (bf16*)(ws + WS_P);
            pg8::Gemm g{Hb, (const bf16*)(ws + WS_WIN_T) + (size_t)l * NP * D, NROW, NP, D}; pg8::StaticOrder S; S.init(NROW, NP, Fp.G, (int)blockIdx.x);
            pg8::EpiStoreBf16 E{Pb, NP, 0xffff};
            pg8::gemm_phase<pg8::EpiStoreBf16, pg8::StaticOrder, true, true>(F.lds, g, S, E);
        }
        GRID_BAR();
        {
            const Frame Fp = phase_frame(F); unsigned char* const ws = WSO; bf16* Pb = (bf16*)(ws + WS_P);
            for (int it = blockIdx.x; it < 256; it += F.G) fftA_item(F, it);
            if (need_ctx) for (int it = (int)blockIdx.x - (F.G >= 64 ? F.G - 32 : 0); it >= 0 && it < 32; it += F.G) { const int b = it >> 4, m0 = (it & 15) * 16;
                const bf16* src0 = Pb + (size_t)(NLAT + b * CTXL) * NP + COL_FC;
                dft64_item<4, 256, 1>(F, l, m0, -1.f, 1.f / 128.f, [=](int t, int ri) { return src0 + (size_t)t * NP + ri * 256; }, [=](int m) { return NLAT + b * CTXL + m; }); }
            shift_pass(F, l);
            conv_pass(F, l, nrows);
        }
        GRID_BAR();
        {
            const Frame Fp = phase_frame(F); unsigned char* const ws = WSO;
            prep_phase(F, l);
        }
        GRID_BAR();
        for (int seg = -1; seg < NSEG; ++seg) {
            const bool split = (F.G == 256);
            if (seg + 1 < NSEG) pre_phase(F, seg + 1, (seg >= 0 && split) ? 128 : 0);
            if (seg + 1 == NSEG && (!split || blockIdx.x >= 128)) { unsigned char* const ws = opaque(F.ws); int bx_ = (int)blockIdx.x; asm volatile("" : "+s"(bx_));
                const int first_ = split ? bx_ - 128 : bx_, stride_ = split ? 128 : F.G;
                for (int it = first_; it < 256; it += stride_) { const int b = it >> 7, t1p = it & 127;
                    const bf16* src0 = (const bf16*)(ws + WS_GT) + (size_t)(b * 128 + t1p) * 64 * 512;
                    dft64_item<1, 64, 4>(F, l, 0, 1.f, 0.0013810679320049757f, [=](int t, int ri) { return src0 + (size_t)t * 512 + ri * 256; }, [=](int m) { return b * SEQ + t1p + 128 * m; }); } }
            if (seg >= 0) for (int it = blockIdx.x; it < 128; it += F.G) { const int x_ = it & 7, j_ = it >> 3;
                seq_item<0>(F, ((x_ + 8 * (j_ >> 2)) << 2) | (j_ & 3), seg, need_ctx); }
            GRID_BAR();
        }
        readout_pass(F, l, nrows);
        GRID_BAR();
        const int cv_lo = (nrows / 256) * 4 > F.G ? (nrows / 256) * 4 - F.G : 0;
        if (blockIdx.x & 1) expert_convert(F, l, cv_lo);
        {
            const Frame Fp = phase_frame(F); unsigned char* const ws = WSO; bf16* Hb = (bf16*)(ws + WS_H);
            pg8::Gemm g{Hb, (const bf16*)(ws + WS_WOUT_T) + (size_t)l * D * D, nrows, D, D}; pg8::StaticOrder S; S.init(nrows, D, Fp.G, (int)blockIdx.x);
            bf16* X = (bf16*)(ws + WS_X); const float* g1p = (const float*)(ws + WS_MODF) + (size_t)l * 3 * 6144 + 2 * 1024;
            if (l == 0) { pg8::EpiResidual<true> E{inptr(I_X), inptr(I_CTX), X, g1p}; pg8::gemm_phase<pg8::EpiResidual<true>, pg8::StaticOrder, true, true>(F.lds, g, S, E); }
            else { pg8::EpiResidual<false> E{X, X + (size_t)NLAT * D, X, g1p}; pg8::gemm_phase<pg8::EpiResidual<false>, pg8::StaticOrder, true, true>(F.lds, g, S, E); }
        }
        if (!(blockIdx.x & 1)) expert_convert(F, l, cv_lo);
        GRID_BAR();
        router_pass(F, l, nrows);
        GRID_BAR();
        {
            const Frame Fp = phase_frame(F); unsigned char* const ws = WSO;
            moe_map(F, l);
            const LAS int* mp = (const LAS int*)(F.lds + MOE_MAP_OFF);
            pg8::MoeOrder S{mp + 128, mp + 320, mp[64], Fp.G, (int)blockIdx.x};
            {   pg8::Gemm g{(const bf16*)(ws + WS_H), (const bf16*)(ws + WS_WGU_T), 0, 0, D, (const int*)(ws + WS_ELIST), NROW - 1};
                pg8::EpiSwiGLU E{(bf16*)(ws + WS_ACT)};
                pg8::gemm_phase<pg8::EpiSwiGLU, pg8::MoeOrder, true, true, true>(F.lds, g, S, E); }
            GRID_BAR();
            {   pg8::Gemm g{(const bf16*)(ws + WS_ACT), (const bf16*)(ws + WS_WD_T), 0, 0, DEXP};
                pg8::EpiStoreBf16 E{(bf16*)(ws + WS_XS), D, 3};
                pg8::gemm_phase<pg8::EpiStoreBf16, pg8::MoeOrder, true, true>(F.lds, g, S, E); }
        }
        GRID_BAR();
        combine_pass<false>(F, l, nrows);
        if (l + 1 < DEPTH) GRID_BAR();
    }
}

extern "C" void kernel_launch(void* const* d_in, const int* in_sizes, int n_in, void* d_out, int out_size, void* d_ws, size_t ws_size, hipStream_t stream) {
    static int grid = 0;
    if (grid == 0) {
        if (n_in != N_IN || in_sizes[0] != NLAT * D || out_size != NLAT * D || ws_size < WS_END) {
            fprintf(stderr, "kernel_launch: unexpected shapes (n_in %d in0 %d out %d ws %zu)\n", n_in, n_in > 0 ? in_sizes[0] : -1, out_size, ws_size); grid = -1; return; }
        int dev = 0, cus = 0, per_cu = 0;
        hipGetDevice(&dev); hipDeviceGetAttribute(&cus, hipDeviceAttributeMultiprocessorCount, dev);
        hipFuncSetAttribute((const void*)fwd_megakernel, hipFuncAttributeMaxDynamicSharedMemorySize, LDS_BYTES);
        hipOccupancyMaxActiveBlocksPerMultiprocessor(&per_cu, (const void*)fwd_megakernel, NTHR, LDS_BYTES);
        if (per_cu < 1) { fprintf(stderr, "kernel_launch: occupancy query says %d blocks per CU\n", per_cu); per_cu = 1; }
        (void)hipGetLastError();
        grid = cus * per_cu;
    }
    if (grid < 0) return;
    hipMemsetAsync((char*)d_ws + WS_CTL, 0, CTL_ZERO_BYTES, stream);
    Params p{};
    for (int i = 0; i < N_IN; ++i) p.in[i] = (const float*)d_in[i];
    p.out = (float*)d_out; p.ws = (unsigned char*)d_ws;
    void* args[] = {&p};
    hipError_t e = hipLaunchCooperativeKernel((const void*)fwd_megakernel, dim3(grid), dim3(NTHR), args, LDS_BYTES, stream);
    if (e != hipSuccess) fprintf(stderr, "kernel_launch: cooperative launch failed: %s (grid %d)\n", hipGetErrorString(e), grid);
}
```

```cpp
#include <hip/hip_runtime.h>
#include <hip/hip_cooperative_groups.h>
#include <cstdio>
#include <cstdint>
namespace cg = cooperative_groups;
#define USE_CG_SYNC 0
#define SEQ_PROBE 0
#define SEQ_PROBE_PRE 0
namespace pg8 {
#define PG8_LAS __attribute__((address_space(3)))
typedef unsigned short bf16_t;
typedef short bf16x8 __attribute__((ext_vector_type(8)));
typedef float f32x4 __attribute__((ext_vector_type(4)));
typedef unsigned u32x4 __attribute__((ext_vector_type(4)));
constexpr int BM = 256, BK = 64, HALF = 128, HTB = HALF * BK * 2  , STAGE_BYTES = 8 * HTB, NXCD = 8, WGM = 8;

__host__ __device__ __forceinline__ int lds_byte(int r, int c) { const int st = (r >> 4) * 2 + (c >> 5), rr = r & 15, cc = c & 31, ob = rr * 64 + cc * 2; return st * 1024 + (ob ^ (((ob >> 9) & 1) << 5)); }
__host__ __device__ __forceinline__ void stage_rc(int b, int& R, int& C) { const int st = b / 1024, sb = b % 1024, swz = sb ^ (((sb >> 9) & 1) << 5); R = (st >> 1) * 16 + swz / 64; C = (st & 1) * 32 + (swz % 64) / 2; }
__host__ __device__ __forceinline__ int perm32(int rho) { const int n = rho >> 4, i = rho & 15; return 8 * (i >> 2) + 4 * n + (i & 3); }

struct Unit { int pm, pn, ga; };
struct Gemm { const bf16_t* A; const bf16_t* Bt; int M, N, K; const int* gidx; int gmax; };

struct StaticOrder {
    int nM, nN, nwg, G, c;
    __host__ __device__ void init(int M, int N, int G_, int c_) { nM = M / BM; nN = N / BM; nwg = nM * nN; G = G_; c = c_; }
    __host__ __device__ bool next(int i, Unit& u) const {
        const long L = (long)i * G + c; if (L >= nwg) return false;
        int wgid = (int)L; { const int q = nwg / NXCD, r = nwg % NXCD, xcd = wgid % NXCD, off = wgid / NXCD; wgid = (xcd < r ? xcd * (q + 1) : r * (q + 1) + (xcd - r) * q) + off; }
        const int nig = WGM * nN, gid = wgid / nig, fm = gid * WGM, gsz = (nM - fm) < WGM ? (nM - fm) : WGM;
        u.pm = fm + ((wgid % nig) % gsz); u.pn = (wgid % nig) / gsz; return true;
    }
    __device__ __forceinline__ void a_ready(const Unit&) const {}
    __device__ __forceinline__ void done(const Unit&) const {}
};

__device__ __forceinline__ unsigned cvt_pk_bf16(float lo, float hi) { unsigned r; asm volatile("v_cvt_pk_bf16_f32 %0, %1, %2" : "=v"(r) : "v"(lo), "v"(hi)); return r; }
typedef float f32x2 __attribute__((ext_vector_type(2)));
template <class Epi, class Sched, bool ALIGN_EPI = false, bool SP2 = false, bool GATHER = false>
__device__ __forceinline__ void gemm_phase(PG8_LAS unsigned char* lds, const Gemm g, const Sched& S, const Epi& E) {
    int tid = threadIdx.x; asm volatile("" : "+v"(tid));
    const int wid = __builtin_amdgcn_readfirstlane(tid >> 6), lane = tid & 63, wr = wid >> 2, wc = wid & 3, fr = lane & 15, fq = lane >> 4;
    const int K = g.K, nt = K / BK;
    unsigned voffA[2], voffB[2];
#pragma unroll
    for (int i = 0; i < 2; ++i) { int R, C; stage_rc(tid * 16 + i * 8192, R, C); const int Rb = Epi::PERM ? ((R & ~31) + perm32(R & 31)) : R;
        voffA[i] = (unsigned)(R * K + C) * 2u; voffB[i] = (unsigned)(Rb * K + C) * 2u; }
    static_assert(!GATHER || SP2, "GATHER is implemented for the SP2 loop");
    unsigned gcur[2][2], gnx[2][2];
#define PG8_GOFF(go, u_) do { _Pragma("unroll") for (int h_ = 0; h_ < 2; ++h_) _Pragma("unroll") for (int i_ = 0; i_ < 2; ++i_) { int R_, C_; stage_rc(tid * 16 + i_ * 8192, R_, C_); \
        int ri_ = g.gidx[(u_).ga + h_ * HALF + R_]; ri_ = ri_ < 0 ? 0 : (ri_ > g.gmax ? g.gmax : ri_); go[h_][i_] = (unsigned)ri_ * (unsigned)(K * 2) + (unsigned)C_ * 2u; } } while (0)
    const size_t kstep = (size_t)(BK * 2);
    const size_t hstep = (size_t)HALF * K * 2;
    const size_t tstep = 2 * hstep;
    const unsigned ldsw = (unsigned)wid * 1024u;
    const int aoff = lds_byte(wr * 64 + fr, fq * 8), boff = lds_byte(wc * 32 + fr, fq * 8);
#define PG8_SA(b, h) (((b) * 2 + (h)) * HTB)
#define PG8_SB(b, h) ((4 + (b) * 2 + (h)) * HTB)
#define PG8_STAGE(bufoff, gbase, voff) do { _Pragma("unroll") for (int _i = 0; _i < 2; ++_i) \
        __builtin_amdgcn_global_load_lds((const unsigned*)((const char*)(gbase) + (voff)[_i]), (PG8_LAS unsigned*)(lds + (bufoff) + ldsw + _i * 8192), 16, 0, 0); } while (0)
#define PG8_LDA(dst, b, h) do { _Pragma("unroll") for (int m = 0; m < 4; ++m) _Pragma("unroll") for (int k = 0; k < 2; ++k) dst[m][k] = *(const PG8_LAS bf16x8*)(lds + PG8_SA(b, h) + aoff + m * 2048 + k * 1024); } while (0)
#define PG8_LDB(dst, b, h) do { _Pragma("unroll") for (int n = 0; n < 2; ++n) _Pragma("unroll") for (int k = 0; k < 2; ++k) dst[n][k] = *(const PG8_LAS bf16x8*)(lds + PG8_SB(b, h) + boff + n * 2048 + k * 1024); } while (0)
#define PG8_MMA(ai, bj, At, Bt) do { __builtin_amdgcn_s_setprio(1); _Pragma("unroll") for (int m = 0; m < 4; ++m) _Pragma("unroll") for (int n = 0; n < 2; ++n) _Pragma("unroll") for (int k = 0; k < 2; ++k) \
        acc[ai][bj][m][n] = __builtin_amdgcn_mfma_f32_16x16x32_bf16(Bt[n][k], At[m][k], acc[ai][bj][m][n], 0, 0, 0); __builtin_amdgcn_s_setprio(0); } while (0)
#define PG8_WAIT_V(n) asm volatile("s_waitcnt vmcnt(" #n ")" ::: "memory")
#define PG8_WAIT_L(n) asm volatile("s_waitcnt lgkmcnt(" #n ")" ::: "memory")
#define PG8_BAR __builtin_amdgcn_s_barrier()
#define PG8_SCHED __builtin_amdgcn_sched_barrier(0)
    Unit cur, nxt; int ui = 0;
    if (!S.next(0, cur)) return;
    f32x4 acc[2][2][4][2];
#pragma unroll
    for (int a = 0; a < 2; ++a)
#pragma unroll
        for (int b = 0; b < 2; ++b)
#pragma unroll
            for (int m = 0; m < 4; ++m)
#pragma unroll
                for (int n = 0; n < 2; ++n) acc[a][b][m][n] = (f32x4){0.f, 0.f, 0.f, 0.f};
    bf16x8 At[4][2], B0[2][2], B1[2][2];
    const char* cA = (const char*)g.A + (size_t)cur.pm * tstep; const char* cB = (const char*)g.Bt + (size_t)cur.pn * tstep;
    S.a_ready(cur);
    const char* gA = (const char*)g.A;
    if constexpr (GATHER) PG8_GOFF(gcur, cur);
    if constexpr (SP2) {
        PG8_STAGE(PG8_SB(0, 0), cB, voffB); PG8_STAGE(PG8_SB(0, 1), cB + hstep, voffB);
        if constexpr (GATHER) { PG8_STAGE(PG8_SA(0, 0), gA, gcur[0]); PG8_STAGE(PG8_SA(0, 1), gA, gcur[1]); } else { PG8_STAGE(PG8_SA(0, 0), cA, voffA); PG8_STAGE(PG8_SA(0, 1), cA + hstep, voffA); }
        if (wr == 1) PG8_BAR;
        PG8_WAIT_V(2); PG8_BAR;
        PG8_STAGE(PG8_SB(1, 0), cB + kstep, voffB); if constexpr (GATHER) PG8_STAGE(PG8_SA(1, 0), gA + kstep, gcur[0]); else PG8_STAGE(PG8_SA(1, 0), cA + kstep, voffA); PG8_STAGE(PG8_SB(1, 1), cB + hstep + kstep, voffB);
        PG8_WAIT_V(6); PG8_BAR;
    } else {
        PG8_STAGE(PG8_SB(0, 0), cB, voffB); PG8_STAGE(PG8_SA(0, 0), cA, voffA); PG8_STAGE(PG8_SB(0, 1), cB + hstep, voffB); PG8_STAGE(PG8_SA(0, 1), cA + hstep, voffA);
        if (wr == 1) PG8_BAR;
        PG8_WAIT_V(4); PG8_BAR;
        PG8_STAGE(PG8_SB(1, 0), cB + kstep, voffB); PG8_STAGE(PG8_SA(1, 0), cA + kstep, voffA); PG8_STAGE(PG8_SB(1, 1), cB + hstep + kstep, voffB);
        PG8_WAIT_V(6); PG8_BAR;
    }
    for (;;) {
        const bool has_next = S.next(ui + 1, nxt);
        if constexpr (GATHER) { if (has_next) PG8_GOFF(gnx, nxt); else { gnx[0][0] = gcur[0][0]; gnx[0][1] = gcur[0][1]; gnx[1][0] = gcur[1][0]; gnx[1][1] = gcur[1][1]; } }
        const char* nA = has_next ? (const char*)g.A + (size_t)nxt.pm * tstep : cA; const char* nB = has_next ? (const char*)g.Bt + (size_t)nxt.pn * tstep : cB;
        for (int t = 0; t < nt; t += 2) {
            const bool last = (t == nt - 2);
            const char* a1 = cA + (size_t)(t + 1) * kstep;
            const char* a2 = last ? nA : cA + (size_t)(t + 2) * kstep; const char* b2 = last ? nB : cB + (size_t)(t + 2) * kstep;
            const char* a3 = a2 + kstep; const char* b3 = b2 + kstep;
            if (last && has_next) S.a_ready(nxt);
            unsigned ga0[2], ga1[2]; const char* g1 = gA; const char* g2 = gA; const char* g3 = gA;
            if constexpr (GATHER) { g1 = gA + (size_t)(t + 1) * kstep; g2 = last ? gA : gA + (size_t)(t + 2) * kstep; g3 = g2 + kstep;
                ga0[0] = last ? gnx[0][0] : gcur[0][0]; ga0[1] = last ? gnx[0][1] : gcur[0][1]; ga1[0] = last ? gnx[1][0] : gcur[1][0]; ga1[1] = last ? gnx[1][1] : gcur[1][1]; }
            if constexpr (SP2) {
            PG8_LDB(B0, 0, 0); PG8_LDB(B1, 0, 1); PG8_SCHED; PG8_LDA(At, 0, 0); if constexpr (GATHER) PG8_STAGE(PG8_SA(1, 1), g1, gcur[1]); else PG8_STAGE(PG8_SA(1, 1), a1 + hstep, voffA);
            PG8_WAIT_V(8); PG8_WAIT_L(0); PG8_BAR; PG8_MMA(0, 0, At, B0); PG8_MMA(0, 1, At, B1); PG8_BAR; PG8_SCHED;
            PG8_LDA(At, 0, 1); PG8_STAGE(PG8_SB(0, 0), b2, voffB); PG8_STAGE(PG8_SB(0, 1), b2 + hstep, voffB); if constexpr (GATHER) PG8_STAGE(PG8_SA(0, 0), g2, ga0); else PG8_STAGE(PG8_SA(0, 0), a2, voffA);
            PG8_WAIT_V(8); PG8_WAIT_L(0); PG8_BAR; PG8_MMA(1, 0, At, B0); PG8_MMA(1, 1, At, B1); PG8_BAR; PG8_SCHED;
            PG8_LDB(B0, 1, 0); PG8_LDB(B1, 1, 1); PG8_SCHED; PG8_LDA(At, 1, 0); if constexpr (GATHER) PG8_STAGE(PG8_SA(0, 1), g2, ga1); else PG8_STAGE(PG8_SA(0, 1), a2 + hstep, voffA);
            PG8_WAIT_V(8); PG8_WAIT_L(0); PG8_BAR; PG8_MMA(0, 0, At, B0); PG8_MMA(0, 1, At, B1); PG8_BAR; PG8_SCHED;
            PG8_LDA(At, 1, 1); PG8_STAGE(PG8_SB(1, 0), b3, voffB); PG8_STAGE(PG8_SB(1, 1), b3 + hstep, voffB); if constexpr (GATHER) PG8_STAGE(PG8_SA(1, 0), g3, ga0); else PG8_STAGE(PG8_SA(1, 0), a3, voffA);
            PG8_WAIT_V(8); PG8_WAIT_L(0); PG8_BAR; PG8_MMA(1, 0, At, B0); PG8_MMA(1, 1, At, B1); PG8_BAR; PG8_SCHED;
            } else {
            PG8_LDB(B0, 0, 0); PG8_SCHED; PG8_LDA(At, 0, 0); PG8_STAGE(PG8_SA(1, 1), a1 + hstep, voffA);
            PG8_WAIT_L(8); PG8_BAR; PG8_WAIT_L(0); PG8_MMA(0, 0, At, B0); PG8_BAR; PG8_SCHED;
            PG8_LDB(B1, 0, 1); PG8_STAGE(PG8_SB(0, 0), b2, voffB);
            PG8_BAR; PG8_WAIT_L(0); PG8_MMA(0, 1, At, B1); PG8_BAR;
            PG8_LDA(At, 0, 1); PG8_STAGE(PG8_SA(0, 0), a2, voffA);
            PG8_BAR; PG8_WAIT_L(0); PG8_MMA(1, 0, At, B0); PG8_BAR; PG8_SCHED;
            PG8_STAGE(PG8_SB(0, 1), b2 + hstep, voffB);
            PG8_WAIT_V(6); PG8_BAR; PG8_MMA(1, 1, At, B1); PG8_BAR;
            PG8_LDB(B0, 1, 0); PG8_SCHED; PG8_LDA(At, 1, 0); PG8_STAGE(PG8_SA(0, 1), a2 + hstep, voffA);
            PG8_WAIT_L(8); PG8_BAR; PG8_WAIT_L(0); PG8_MMA(0, 0, At, B0); PG8_BAR; PG8_SCHED;
            PG8_LDB(B1, 1, 1); PG8_STAGE(PG8_SB(1, 0), b3, voffB);
            PG8_BAR; PG8_WAIT_L(0); PG8_MMA(0, 1, At, B1); PG8_BAR;
            PG8_LDA(At, 1, 1); PG8_STAGE(PG8_SA(1, 0), a3, voffA);
            PG8_BAR; PG8_WAIT_L(0); PG8_MMA(1, 0, At, B0); PG8_BAR; PG8_SCHED;
            PG8_STAGE(PG8_SB(1, 1), b3 + hstep, voffB);
            PG8_WAIT_V(6); PG8_BAR; PG8_MMA(1, 1, At, B1); PG8_BAR;
            }
        }
        if constexpr (ALIGN_EPI) { if (wr == 0) PG8_BAR; }
        if constexpr (!Epi::AFTER_DRAIN) { E(acc, cur, wr, wc, fr, fq); S.done(cur); }
        if (!has_next) break;
#pragma unroll
        for (int a = 0; a < 2; ++a)
#pragma unroll
            for (int b = 0; b < 2; ++b)
#pragma unroll
                for (int m = 0; m < 4; ++m)
#pragma unroll
                    for (int n = 0; n < 2; ++n) acc[a][b][m][n] = (f32x4){0.f, 0.f, 0.f, 0.f};
        cur = nxt; cA = nA; cB = nB; ++ui;
        if constexpr (GATHER) { gcur[0][0] = gnx[0][0]; gcur[0][1] = gnx[0][1]; gcur[1][0] = gnx[1][0]; gcur[1][1] = gnx[1][1]; }
        if constexpr (ALIGN_EPI) { if (wr == 1) PG8_BAR; }
    }
    PG8_WAIT_V(0);
    if constexpr (!ALIGN_EPI) { if (wr == 0) PG8_BAR; }
    PG8_BAR;
    if constexpr (Epi::AFTER_DRAIN) { E.fused(acc, cur, wr, wc, fr, fq, lds, wid, lane); S.done(cur); }
#undef PG8_GOFF
#undef PG8_SA
#undef PG8_SB
#undef PG8_STAGE
#undef PG8_LDA
#undef PG8_LDB
#undef PG8_MMA
#undef PG8_WAIT_V
#undef PG8_WAIT_L
#undef PG8_BAR
#undef PG8_SCHED
}
}
#define LAS __attribute__((address_space(3)))
typedef unsigned short bf16;
typedef float f32x4 __attribute__((ext_vector_type(4)));
typedef short bf16x8 __attribute__((ext_vector_type(8)));
typedef unsigned u32x4 __attribute__((ext_vector_type(4)));
typedef unsigned u32x2 __attribute__((ext_vector_type(2)));

constexpr int D = 1024, NBATCH = 2, SEQ = 8192, CTXL = 256, DEPTH = 2;
constexpr int NLAT = NBATCH * SEQ, NCTX = NBATCH * CTXL, NROW = NLAT + NCTX;
constexpr int DR = 512, DIN = 2944, NP = 3328, ZW = 1920, NHEAD = 8;
constexpr int COL_CONV = 1920, COL_FC = 2688, COL_FS = 2944;
constexpr int STRW = 5120;
constexpr int NEXP = 32, DEXP = 512;
constexpr int MOE_MAXTILES = 168;
constexpr float RMS_EPS = 1e-6f, GN_EPS = 64e-5f;

enum { I_X = 0, I_C, I_CTX, I_CCTX, I_ADAW, I_ADAB, I_N1G, I_N2G, I_WIN, I_MU, I_DW0, I_DW2, I_IA0, I_IA2, I_GG2, I_KK, I_KA, I_RK, I_GNW, I_GNB,
       I_CONVW, I_CONVG, I_FOURG, I_WOUT, I_RGW, I_RGB, I_REW, I_REB, I_EG, I_EU, I_ED, I_FG, N_IN };

constexpr size_t MiB = 1u << 20;
constexpr size_t WS_CTL = 0, CTL_ZERO_BYTES = 64 * 1024;
constexpr size_t WS_MODP = 1 * MiB;
constexpr size_t WS_MODF = 1 * MiB + 1280 * 1024;
constexpr size_t WS_WIN_T = 3 * MiB;
constexpr size_t WS_WOUT_T = 16 * MiB;
constexpr size_t WS_WGU_T = 20 * MiB;
constexpr size_t WS_WD_T = 84 * MiB;
constexpr size_t WS_X = 116 * MiB;
constexpr size_t WS_H = 182 * MiB;
constexpr size_t WS_ZS = 215 * MiB;
constexpr size_t WS_P = 277 * MiB;
constexpr size_t WS_STR = 277 * MiB;
constexpr size_t WS_Y = 442 * MiB;
constexpr size_t WS_GT = 475 * MiB;
constexpr size_t WS_ROUTE = 491 * MiB;
constexpr size_t WS_XS = 215 * MiB;
constexpr size_t WS_ACT = 299 * MiB;
constexpr size_t WS_ELIST = 340 * MiB;
constexpr size_t WS_END = 530 * MiB;
constexpr size_t RT_E = 0, RT_POS = 1 * 33792 * 4, RT_GATE = 2 * 33792 * 4, RT_SLOT = 3 * 33792 * 4, RT_TILE = 4 * 33792 * 4, RT_NT = RT_TILE + 1024;

constexpr int CW_BAR = 4096;
constexpr int CW_CNT = 8192;

constexpr int NWAVES = 8, NTHR = 512;
constexpr int RING_BYTES = 131072, LDSCTL_OFF = 143360, MISC_OFF = LDSCTL_OFF + 320, LDS_BYTES = 147456;

struct Params { const float* in[N_IN]; float* out; unsigned char* ws; };

__device__ __forceinline__ float bf2f(unsigned h) { return __uint_as_float(h << 16); }
typedef __bf16 hwbf2 __attribute__((ext_vector_type(2)));
typedef float f32x2 __attribute__((ext_vector_type(2)));
__device__ __forceinline__ unsigned pk2(float lo, float hi) { const f32x2 x = {lo, hi}; const hwbf2 r = __builtin_convertvector(x, hwbf2); return __builtin_bit_cast(unsigned, r); }
__device__ __forceinline__ unsigned f2bf(float f) { return pk2(f, 0.f) & 0xffffu; }
__device__ __forceinline__ float wave_sum(float v) {
#pragma unroll
    for (int o = 1; o < 64; o <<= 1) v += __shfl_xor(v, o);
    return v;
}
__device__ __forceinline__ float sigmoidf_(float x) { return 1.f / (1.f + __expf(-x)); }
#define LDS_WAIT() asm volatile("s_waitcnt lgkmcnt(0)" ::: "memory")
#define VM_WAIT() asm volatile("s_waitcnt vmcnt(0)" ::: "memory")

struct Frame {
    LAS unsigned char* lds;
    int tid, lane, wave, vcu, G, gw, NGW;
    float* out; unsigned char* ws;
};
#if defined(__HIP_DEVICE_COMPILE__)
#define ASSUME_GLOBAL(p) do { __builtin_assume(!__builtin_amdgcn_is_shared(p)); __builtin_assume(!__builtin_amdgcn_is_private(p)); } while (0)
#else
#define ASSUME_GLOBAL(p) do { } while (0)
#endif
__device__ __forceinline__ const float* inptr(int i) {
    const volatile unsigned long long __attribute__((address_space(4)))* ka = (const volatile unsigned long long __attribute__((address_space(4)))*)__builtin_amdgcn_kernarg_segment_ptr();
    return (const float*)(const __attribute__((address_space(1))) float*)ka[i];
}
__device__ __forceinline__ unsigned char* opaque(unsigned char* p) { unsigned long z = 0; asm volatile("" : "+s"(z)); return p + z; }
__device__ __forceinline__ Frame phase_frame(const Frame& F0) { Frame F = F0; asm volatile("" : "+v"(F.tid)); F.lane = F.tid & 63; F.ws = opaque(F0.ws);
    asm volatile("" : "+s"(F.G), "+s"(F.vcu)); F.gw = F.vcu * NWAVES + F.wave; F.NGW = F.G * NWAVES; return F; }
__device__ __forceinline__ int modrow(int row) { return row < NLAT ? (row >> 13) : 2; }
#define XB_TMO      128
#define XB_XCNT(j)  (256  + 64 * (j))
#define XB_XSUB(j)  (1280 + 64 * (j))
#define XB_XGEN(j)  (2304 + 64 * (j))
#define XB_TOP      3328
#define XB_TOPGEN   3392
#define XCD_BAR_WORDS 3456
#define XB_SPIN_CAP (1u << 18)

__device__ __forceinline__ unsigned xb_ld(unsigned* p)              { return __hip_atomic_load(p, __ATOMIC_RELAXED, __HIP_MEMORY_SCOPE_AGENT); }
__device__ __forceinline__ unsigned xb_add(unsigned* p, unsigned v) { return __hip_atomic_fetch_add(p, v, __ATOMIC_RELAXED, __HIP_MEMORY_SCOPE_AGENT); }
__device__ __forceinline__ unsigned xb_xcc_id() { return (unsigned)__builtin_amdgcn_s_getreg((3 << 11) | 20) & 0xFu; }
#define XB_SPIN(cond, bar) do { unsigned _sp = 0; while (cond) { __builtin_amdgcn_s_sleep(1); \
    if ((++_sp & 255u) == 0u) { if (xb_ld(&(bar)[XB_TMO])) break; if (_sp > XB_SPIN_CAP) { atomicAdd(&(bar)[XB_TMO], 1u); break; } } } } while (0)

struct XcdBarrier {
    unsigned* bar; unsigned x;
    volatile LAS unsigned* st;
};

__device__ __forceinline__ XcdBarrier xcd_barrier_post(unsigned* bar, volatile LAS unsigned* st) {
    XcdBarrier b; b.bar = bar; b.x = xb_xcc_id(); b.st = st;
    if (threadIdx.x == 0) (void)xb_add(&bar[XB_XCNT(b.x)], 1u);
    return b;
}
__device__ __forceinline__ void xcd_barrier_complete(unsigned* bar, unsigned x, unsigned& nloc, unsigned& nx) {
    const unsigned G = gridDim.x * gridDim.y * gridDim.z;
    unsigned sum, cnt, mine, sp = 0u;
    for (;;) {
        sum = 0u; cnt = 0u; mine = 0u;
#pragma nounroll
        for (unsigned j = 0; j < 16; ++j) { const unsigned c = xb_ld(&bar[XB_XCNT(j)]); sum += c; cnt += (c > 0u) ? 1u : 0u; mine = (j == x) ? c : mine; }
        if (sum == G) break;
        __builtin_amdgcn_s_sleep(1);
        if ((++sp & 255u) == 0u) { if (xb_ld(&bar[XB_TMO])) break; if (sp > XB_SPIN_CAP) { atomicAdd(&bar[XB_TMO], 1u); break; } }
    }
    nloc = mine > 0u ? mine : 1u; nx = cnt > 0u ? cnt : 1u;
}

__device__ __forceinline__ void xcd_barrier(const XcdBarrier& b) {
    asm volatile("s_waitcnt vmcnt(0)" ::: "memory");
    __syncthreads();
    if (threadIdx.x == 0) {
        unsigned* bar = b.bar;
        asm volatile("" : "+s"(bar));
        __builtin_amdgcn_s_waitcnt(0);
        unsigned nloc = b.st[0], nx = b.st[1];
        if (nloc == 0u) { xcd_barrier_complete(bar, b.x, nloc, nx); b.st[0] = nloc; b.st[1] = nx; }
        const unsigned old = xb_add(&bar[XB_XSUB(b.x)], 1u);
        const unsigned gen = old / nloc;
        if (old + 1u == (gen + 1u) * nloc) {
            __builtin_amdgcn_fence(__ATOMIC_RELEASE, "agent");
            asm volatile("s_waitcnt vmcnt(0)" ::: "memory");
            const unsigned og = xb_add(&bar[XB_TOP], 1u);
            const unsigned tg = og / nx;
            if (og + 1u == (tg + 1u) * nx) xb_add(&bar[XB_TOPGEN], 1u);
            else XB_SPIN(xb_ld(&bar[XB_TOPGEN]) == tg, bar);
            __builtin_amdgcn_fence(__ATOMIC_ACQUIRE, "agent");
            xb_add(&bar[XB_XGEN(b.x)], 1u);
            asm volatile("s_waitcnt vmcnt(0)" ::: "memory");
        } else {
            XB_SPIN(xb_ld(&bar[XB_XGEN(b.x)]) == gen, bar);
            __builtin_amdgcn_fence(__ATOMIC_ACQUIRE, "agent");
            asm volatile("s_waitcnt vmcnt(0)" ::: "memory");
        }
    }
    __syncthreads();
}
template <class RowMap>
__device__ __forceinline__ void transpose_item(const float* W, int ldw, int k0, int n0, bf16* WT, int ldt, RowMap rm, LAS float* scr, int lane) {
    (void)scr;
    const int nq = lane & 7, kg = lane >> 3; const float* src = W + (size_t)(k0 + 8 * kg) * ldw + n0 + 4 * nq;
    f32x4 v[8];
#pragma unroll
    for (int i = 0; i < 8; ++i) v[i] = *(const f32x4*)(src + (size_t)i * ldw);
#pragma unroll
    for (int j = 0; j < 4; ++j) { u32x4 o = {pk2(v[0][j], v[1][j]), pk2(v[2][j], v[3][j]), pk2(v[4][j], v[5][j]), pk2(v[6][j], v[7][j])};
        *(u32x4*)(WT + (size_t)rm(n0 + 4 * nq + j) * ldt + k0 + 8 * kg) = o; }
}
struct RmId { int off; __device__ __forceinline__ int operator()(int n) const { return off + n; } };
struct RmGU { int off; __device__ __forceinline__ int operator()(int n) const { return off + ((n >> 2) << 3) + (n & 3); } };

__device__ __forceinline__ void p0_prologue(const Frame& F0) {
    const Frame F = phase_frame(F0); unsigned char* const ws = F.ws;
    LAS float* scr = (LAS float*)(F.lds + F.wave * 16384);
    LAS float* ctab = (LAS float*)(F.lds + 8 * 16384);
    if (F.tid < 64) ctab[F.tid] = cosf((float)F.tid * (6.283185307179586f / 64.f));
    __syncthreads();
    bf16* win_t = (bf16*)(ws + WS_WIN_T); bf16* wout_t = (bf16*)(ws + WS_WOUT_T);
    constexpr int I_WIN_L = 16 * 84, I_WOUT_L = 16 * 32, I_FOLD_L = 4 * 64, I_MOD_L = 96 * 8;
    constexpr int NIT = 2 * (I_WIN_L + I_WOUT_L + I_FOLD_L + I_MOD_L);
    const float* p_win = inptr(I_WIN); const float* p_wout = inptr(I_WOUT); const float* p_c = inptr(I_C); const float* p_cctx = inptr(I_CCTX); const float* p_adaw = inptr(I_ADAW);
    {
        bf16* wl = (bf16*)(ws + 64 * 1024); const float* dw2 = inptr(I_DW2); const float* ia2 = inptr(I_IA2); const float* gg2 = inptr(I_GG2);
        for (int idx = F.vcu * NTHR + F.tid; idx < 2 * 384 * 512; idx += F.G * NTHR) { const int c = idx & 511, k = (idx >> 9) % 384, l = idx / (384 * 512);
            float v;
            if (k < 128) v = dw2[((size_t)(l * 2 + (k >> 6)) * 64 + (k & 63)) * DR + c];
            else if (k < 256) v = ia2[((size_t)(l * 2 + ((k - 128) >> 6)) * 64 + (k & 63)) * DR + c];
            else v = gg2[((size_t)l * 128 + (k - 256)) * DR + c];
            wl[((size_t)l * 512 + c) * 384 + k] = (bf16)f2bf(v); } }
    for (int it = F.gw; it < NIT; it += F.NGW) {
        int r = it; const int l = r & 1; r >>= 1;
        if (r < I_WIN_L) { const int kb = r / 84, nb = r % 84;
            transpose_item(p_win + (size_t)l * D * DIN, DIN, kb * 64, nb * 32, win_t + (size_t)l * NP * D, D, RmId{0}, scr, F.lane); continue; }
        r -= I_WIN_L;
        if (r < I_WOUT_L) { const int kb = r / 32, nb = r % 32;
            transpose_item(p_wout + (size_t)l * D * D, D, kb * 64, nb * 32, wout_t + (size_t)l * D * D, D, RmId{0}, scr, F.lane); continue; }
        r -= I_WOUT_L;
        if (r < I_FOLD_L) {
            const int g = r >> 6, k0 = (r & 63) * 16; const float* W = p_win + (size_t)l * D * DIN;
#pragma unroll
            for (int kk = 0; kk < 16; ++kk) scr[kk * 64 + F.lane] = W[(size_t)(k0 + kk) * DIN + 2688 + g * 64 + F.lane];
            LDS_WAIT(); asm volatile("" ::: "memory");
            float ac[16], as[16];
#pragma unroll
            for (int kk = 0; kk < 16; ++kk) { ac[kk] = 0.f; as[kk] = 0.f; }
            for (int c = 0; c < 64; ++c) { const int idx = (c * F.lane) & 63; const float cc = ctab[idx], ss = ctab[(idx - 16) & 63];
#pragma unroll
                for (int kk = 0; kk < 16; ++kk) { const float w = scr[kk * 64 + c]; ac[kk] += w * cc; as[kk] += w * ss; } }
            bf16* oc = win_t + (size_t)l * NP * D + (size_t)(COL_FC + g * 64 + F.lane) * D + k0;
            bf16* os = win_t + (size_t)l * NP * D + (size_t)(COL_FS + g * 64 + F.lane) * D + k0;
            u32x4 a, b;
            a.x = pk2(ac[0], ac[1]); a.y = pk2(ac[2], ac[3]); a.z = pk2(ac[4], ac[5]); a.w = pk2(ac[6], ac[7]);
            b.x = pk2(ac[8], ac[9]); b.y = pk2(ac[10], ac[11]); b.z = pk2(ac[12], ac[13]); b.w = pk2(ac[14], ac[15]);
            *(u32x4*)oc = a; *(u32x4*)(oc + 8) = b;
            a.x = pk2(as[0], as[1]); a.y = pk2(as[2], as[3]); a.z = pk2(as[4], as[5]); a.w = pk2(as[6], as[7]);
            b.x = pk2(as[8], as[9]); b.y = pk2(as[10], as[11]); b.z = pk2(as[12], as[13]); b.w = pk2(as[14], as[15]);
            *(u32x4*)os = a; *(u32x4*)(os + 8) = b;
            LDS_WAIT(); asm volatile("" ::: "memory");
            continue; }
        r -= I_FOLD_L;
        {
            const int cb = r >> 3, ks = r & 7;
#pragma unroll
            for (int q = 0; q < 2; ++q) { const int k = ks * 128 + q * 64 + F.lane;
                const float c0 = p_c[k], c1 = p_c[D + k], c2 = p_cctx[k];
                scr[0 * 128 + q * 64 + F.lane] = c0 * sigmoidf_(c0); scr[1 * 128 + q * 64 + F.lane] = c1 * sigmoidf_(c1); scr[2 * 128 + q * 64 + F.lane] = c2 * sigmoidf_(c2); }
            LDS_WAIT(); asm volatile("" ::: "memory");
            const float* W = p_adaw + (size_t)l * D * 6144 + (size_t)(ks * 128) * 6144 + cb * 64 + F.lane;
            float a0 = 0.f, a1 = 0.f, a2 = 0.f;
#pragma unroll 8
            for (int kk = 0; kk < 128; ++kk) { const float w = W[(size_t)kk * 6144]; a0 += scr[kk] * w; a1 += scr[128 + kk] * w; a2 += scr[256 + kk] * w; }
            float* mp = (float*)(ws + WS_MODP) + (size_t)((l * 8 + ks) * 3) * 6144 + cb * 64 + F.lane;
            mp[0] = a0; mp[6144] = a1; mp[2 * 6144] = a2;
            LDS_WAIT(); asm volatile("" ::: "memory");
        }
    }
}

__device__ __forceinline__ void mod_to_lds(const Frame& F0, int l, int p, LAS float* dst, bool from_partials) {
    const Frame F = phase_frame(F0); unsigned char* const ws = F.ws;
    const float* adab = inptr(I_ADAB);
    for (int idx = F.tid; idx < 3 * 1024; idx += NTHR) { const int r = idx >> 10, n = idx & 1023;
        float v;
        if (from_partials) { v = adab[l * 6144 + p * 1024 + n]; const float* mp = (const float*)(ws + WS_MODP) + (size_t)(l * 8 * 3 + r) * 6144 + p * 1024 + n;
#pragma unroll
            for (int ks = 0; ks < 8; ++ks) v += mp[(size_t)ks * 3 * 6144]; }
        else v = ((const float*)(ws + WS_MODF))[(size_t)(l * 3 + r) * 6144 + p * 1024 + n];
        dst[idx] = v; }
}
__device__ __forceinline__ void mod_finalize(const Frame& F0) {
    const Frame F = phase_frame(F0); unsigned char* const ws = F.ws;
    const float* adab = inptr(I_ADAB);
    for (int idx = F.vcu * NTHR + F.tid; idx < 2 * 3 * 6144; idx += F.G * NTHR) { const int l = idx / (3 * 6144), rem = idx % (3 * 6144), r = rem / 6144, n = rem % 6144;
        float v = adab[l * 6144 + n]; const float* mp = (const float*)(ws + WS_MODP) + (size_t)(l * 8 * 3 + r) * 6144 + n;
#pragma unroll
        for (int ks = 0; ks < 8; ++ks) v += mp[(size_t)ks * 3 * 6144];
        ((float*)(ws + WS_MODF))[idx] = v; }
}


__device__ __forceinline__ void norm_mod_row(f32x4 (&v)[4], const float* gain, const LAS float* sc, const LAS float* sh, bf16* orow, int lane) {
    float s = 0.f;
#pragma unroll
    for (int j = 0; j < 4; ++j) s += (v[j].x * v[j].x + v[j].y * v[j].y) + (v[j].z * v[j].z + v[j].w * v[j].w);
    const float rs = rsqrtf(wave_sum(s) * (1.f / D) + RMS_EPS);
#pragma unroll
    for (int j = 0; j < 4; ++j) { const int c = 4 * lane + 256 * j; const f32x4 g = *(const f32x4*)(gain + c); const f32x4 a = *(const LAS f32x4*)(sc + c), b = *(const LAS f32x4*)(sh + c);
        v[j] = (v[j] * rs) * g * (a + 1.f) + b;
        u32x2 w; w.x = pk2(v[j].x, v[j].y); w.y = pk2(v[j].z, v[j].w); *(u32x2*)(orow + c) = w; }
}

__device__ __forceinline__ void p0b_norm1(const Frame& F0) {
    const Frame F = phase_frame(F0); unsigned char* const ws = F.ws;
    LAS float* msh = (LAS float*)F.lds; LAS float* msc = msh + 3072;
    mod_to_lds(F, 0, 0, msh, true); mod_to_lds(F, 0, 1, msc, true); __syncthreads();
    mod_finalize(F);
    bf16* H = (bf16*)(ws + WS_H); const float* xin = inptr(I_X); const float* cin = inptr(I_CTX); const float* n1g = inptr(I_N1G);
    for (int row0 = F.gw; row0 < NROW; row0 += 2 * F.NGW) { f32x4 v[2][4]; bool ok[2];
#pragma unroll
        for (int u = 0; u < 2; ++u) { const int row = row0 + u * F.NGW; ok[u] = row < NROW; if (ok[u]) { const float* xr = row < NLAT ? xin + (size_t)row * D : cin + (size_t)(row - NLAT) * D;
#pragma unroll
            for (int j = 0; j < 4; ++j) v[u][j] = *(const f32x4*)(xr + 4 * F.lane + 256 * j); } }
#pragma unroll
        for (int u = 0; u < 2; ++u) if (ok[u]) { const int row = row0 + u * F.NGW; const int mr = modrow(row);
            norm_mod_row(v[u], n1g, msc + mr * 1024, msh + mr * 1024, H + (size_t)row * D, F.lane); } }
}
__device__ __forceinline__ void unpack8(const u32x4 w, float (&o)[8]) {
    o[0] = bf2f(w.x & 0xffffu); o[1] = bf2f(w.x >> 16); o[2] = bf2f(w.y & 0xffffu); o[3] = bf2f(w.y >> 16);
    o[4] = bf2f(w.z & 0xffffu); o[5] = bf2f(w.z >> 16); o[6] = bf2f(w.w & 0xffffu); o[7] = bf2f(w.w >> 16);
}
__device__ __forceinline__ void unpack4(const u32x2 w, float (&o)[4]) { o[0] = bf2f(w.x & 0xffffu); o[1] = bf2f(w.x >> 16); o[2] = bf2f(w.y & 0xffffu); o[3] = bf2f(w.y >> 16); }

__device__ __forceinline__ void shift_pass(const Frame& F0, int l) {
    const Frame F = phase_frame(F0); unsigned char* const ws = F.ws;
    const bf16* P = (const bf16*)(ws + WS_P); bf16* Zs = (bf16*)(ws + WS_ZS); const float* mu = inptr(I_MU) + l * ZW;
    const int total = NROW * 240;
    for (int idx = F.vcu * NTHR + F.tid; idx < total; idx += F.G * NTHR) {
        const int row = idx / 240, ck = idx % 240; const bf16* pr = P + (size_t)row * NP + ck * 8;
        const u32x4 zero = {0u, 0u, 0u, 0u};
        float z[8], n0[8], n1[8], n2[8], n3[8], o[8];
        unpack8(*(const u32x4*)pr, z);
        if (row < NLAT) { const int t = row & (SEQ - 1), gr = t >> 6, gc = t & 63;
            unpack8(gc > 0 ? *(const u32x4*)(pr - NP) : zero, n0); unpack8(gc < 63 ? *(const u32x4*)(pr + NP) : zero, n1);
            unpack8(gr > 0 ? *(const u32x4*)(pr - 64 * NP) : zero, n2); unpack8(gr < 127 ? *(const u32x4*)(pr + 64 * NP) : zero, n3);
        } else { const int tc = (row - NLAT) & (CTXL - 1);
            unpack8(tc > 0 ? *(const u32x4*)(pr - NP) : zero, n0); unpack8(tc < CTXL - 1 ? *(const u32x4*)(pr + NP) : zero, n1);
#pragma unroll
            for (int j = 0; j < 8; ++j) { n2[j] = n0[j]; n3[j] = n1[j]; }
        }
        const f32x4 m0 = *(const f32x4*)(mu + ck * 8), m1 = *(const f32x4*)(mu + ck * 8 + 4);
        const float m[8] = {m0.x, m0.y, m0.z, m0.w, m1.x, m1.y, m1.z, m1.w};
#pragma unroll
        for (int j = 0; j < 8; ++j) { const float nb = (j & 3) == 0 ? n0[j] : (j & 3) == 1 ? n1[j] : (j & 3) == 2 ? n2[j] : n3[j]; o[j] = z[j] + (nb - z[j]) * m[j]; }
        u32x4 w; w.x = pk2(o[0], o[1]); w.y = pk2(o[2], o[3]); w.z = pk2(o[4], o[5]); w.w = pk2(o[6], o[7]);
        *(u32x4*)(Zs + (size_t)row * ZW + ck * 8) = w;
    }
}

__device__ __forceinline__ void conv_pass(const Frame& F0, int l, int nrows) {
    const Frame F = phase_frame(F0); unsigned char* const ws = F.ws;
    const bf16* P = (const bf16*)(ws + WS_P); bf16* MA = (bf16*)(ws + WS_H);
    const float* cw = inptr(I_CONVW) + l * 3 * 256; const int c = 4 * F.lane;
    const f32x4 w0 = *(const f32x4*)(cw + c), w1 = *(const f32x4*)(cw + 256 + c), w2 = *(const f32x4*)(cw + 512 + c), gn = *(const f32x4*)(inptr(I_CONVG) + l * 256 + c);
    for (int row0 = F.gw; row0 < nrows; row0 += 2 * F.NGW) {
        u32x2 q[2][7]; bool ok[2]; const u32x2 zero = {0u, 0u};
#pragma unroll
        for (int u = 0; u < 2; ++u) { const int row = row0 + u * F.NGW; ok[u] = row < nrows; if (ok[u]) {
            int t, L; if (row < NLAT) { t = row & (SEQ - 1); L = SEQ; } else { t = (row - NLAT) & (CTXL - 1); L = CTXL; }
            const bf16* pr = P + (size_t)row * NP + COL_CONV + c;
            q[u][0] = *(const u32x2*)pr; q[u][1] = *(const u32x2*)(pr + 256); q[u][2] = *(const u32x2*)(pr + 512);
            q[u][3] = t > 0 ? *(const u32x2*)(pr - NP + 256) : zero; q[u][4] = t > 0 ? *(const u32x2*)(pr - NP + 512) : zero;
            q[u][5] = t < L - 1 ? *(const u32x2*)(pr + NP + 256) : zero; q[u][6] = t < L - 1 ? *(const u32x2*)(pr + NP + 512) : zero; } }
#pragma unroll
        for (int u = 0; u < 2; ++u) if (ok[u]) { const int row = row0 + u * F.NGW;
            float bg[4], cg[4], hh[4], cp[4], hp[4], cn[4], hn[4];
            unpack4(q[u][0], bg); unpack4(q[u][1], cg); unpack4(q[u][2], hh); unpack4(q[u][3], cp); unpack4(q[u][4], hp); unpack4(q[u][5], cn); unpack4(q[u][6], hn);
            const float W0[4] = {w0.x, w0.y, w0.z, w0.w}, W1[4] = {w1.x, w1.y, w1.z, w1.w}, W2[4] = {w2.x, w2.y, w2.z, w2.w}, GN[4] = {gn.x, gn.y, gn.z, gn.w};
            float y[4], s = 0.f;
#pragma unroll
            for (int j = 0; j < 4; ++j) { y[j] = bg[j] * (W0[j] * (cp[j] * hp[j]) + W1[j] * (cg[j] * hh[j]) + W2[j] * (cn[j] * hn[j])); s += y[j] * y[j]; }
            const float rs = rsqrtf(wave_sum(s) * (1.f / 256.f) + RMS_EPS);
            u32x2 o; o.x = pk2(y[0] * rs * GN[0], y[1] * rs * GN[1]); o.y = pk2(y[2] * rs * GN[2], y[3] * rs * GN[3]);
            *(u32x2*)(MA + (size_t)row * D + 512 + c) = o; }
    }
}

__device__ __forceinline__ void sincos_turns(float x, float& s, float& c) { s = __builtin_amdgcn_sinf(x); c = __builtin_amdgcn_cosf(x); }
#define MFMA16(a, b, c) __builtin_amdgcn_mfma_f32_16x16x32_bf16((a), (b), (c), 0, 0, 0)

__device__ __forceinline__ void fftA_item(const Frame& F0, int item) {
    const Frame F = phase_frame(F0); unsigned char* const ws = F.ws;
    const int half = item & 1, t2 = (item >> 1) & 63, b = item >> 7;
    const bf16* P = (const bf16*)(ws + WS_P); bf16* GT = (bf16*)(ws + WS_GT);
    LAS bf16* Bs = (LAS bf16*)F.lds;
    const int lane = F.lane, w = F.wave, fr = lane & 15, fq = lane >> 4;
    __syncthreads();
#pragma unroll
    for (int i = 0; i < 8; ++i) { const int cidx = F.tid + NTHR * i, krow = cidx >> 4, ch8 = cidx & 15, ri = krow >> 7, t1 = krow & 127;
        const u32x4 v = *(const u32x4*)(P + (size_t)(b * SEQ + t1 * 64 + t2) * NP + COL_FC + ri * 256 + half * 128 + ch8 * 8);
        LAS bf16* d = Bs + (ch8 * 8) * 264 + (krow ^ (ch8 << 3));
        d[0 * 264] = (bf16)(v.x & 0xffffu); d[1 * 264] = (bf16)(v.x >> 16); d[2 * 264] = (bf16)(v.y & 0xffffu); d[3 * 264] = (bf16)(v.y >> 16);
        d[4 * 264] = (bf16)(v.z & 0xffffu); d[5 * 264] = (bf16)(v.z >> 16); d[6 * 264] = (bf16)(v.w & 0xffffu); d[7 * 264] = (bf16)(v.w >> 16); }
    __syncthreads();
    f32x4 acc[2][8];
#pragma unroll
    for (int a = 0; a < 2; ++a)
#pragma unroll
        for (int n = 0; n < 8; ++n) acc[a][n] = (f32x4){0.f, 0.f, 0.f, 0.f};
    int t1p_a = 16 * w + fr;
    asm volatile("" : "+v"(t1p_a));
#pragma unroll
    for (int ks = 0; ks < 8; ++ks) {
        bf16x8 ar, ai;
#pragma unroll
        for (int j = 0; j < 8; ++j) { const int k = ks * 32 + 8 * fq + j, ri = k >> 7, t1 = k & 127; const int idx = (t1 * t1p_a) & 127;
            float sn, cs; sincos_turns((float)idx * (1.f / 128.f), sn, cs);
            const float vr = ri == 0 ? cs : -sn, vi = ri == 0 ? -sn : -cs;
            ar[j] = (short)f2bf(vr); ai[j] = (short)f2bf(vi); }
#pragma unroll
        for (int nt = 0; nt < 8; ++nt) { const bf16x8 bfr = *(const LAS bf16x8*)(Bs + (nt * 16 + fr) * 264 + ((ks * 32 + 8 * fq) ^ ((nt * 2 + (fr >> 3)) << 3)));
            acc[0][nt] = MFMA16(ar, bfr, acc[0][nt]); acc[1][nt] = MFMA16(ai, bfr, acc[1][nt]); }
    }
#pragma unroll
    for (int reg = 0; reg < 4; ++reg) { const int t1p = 16 * w + 4 * fq + reg; float st, ct; sincos_turns((float)(t2 * t1p) * (1.f / 8192.f), st, ct);
        bf16* g = GT + ((size_t)((b * 128 + t1p) * 64 + t2) * 2) * 256 + half * 128 + fr;
#pragma unroll
        for (int nt = 0; nt < 8; ++nt) { const float gr = acc[0][nt][reg], gi = acc[1][nt][reg];
            g[nt * 16] = (bf16)f2bf(gr * ct + gi * st); g[256 + nt * 16] = (bf16)f2bf(gi * ct - gr * st); } }
}

template <int NKC, int NDIV, int MT, class SrcRow, class OutRow>
__device__ __forceinline__ void dft64_item(const Frame& F0, int l, int m0, float sgn, float scale, SrcRow src, OutRow orow) {
    const Frame F = phase_frame(F0); unsigned char* const ws = F.ws;
    LAS bf16* Bs = (LAS bf16*)F.lds;
    LAS float* red = (LAS float*)(F.lds + 256 * 136 * 2);
    const int lane = F.lane, w = F.wave, fr = lane & 15, fq = lane >> 4;
    int fr_a = fr; asm volatile("" : "+v"(fr_a));
    f32x4 acc[MT][2];
#pragma unroll
    for (int a = 0; a < MT; ++a) { acc[a][0] = (f32x4){0.f, 0.f, 0.f, 0.f}; acc[a][1] = (f32x4){0.f, 0.f, 0.f, 0.f}; }
    for (int kc = 0; kc < NKC; ++kc) {
        __syncthreads();
#pragma unroll
        for (int i = 0; i < 8; ++i) { const int cidx = F.tid + NTHR * i, krow = cidx >> 5, ch8 = cidx & 31;
            const u32x4 v = *(const u32x4*)(src(kc * 64 + (krow >> 1), krow & 1) + ch8 * 8);
            LAS bf16* d = Bs + (ch8 * 8) * 136 + (krow ^ ((ch8 & 15) << 3));
            d[0 * 136] = (bf16)(v.x & 0xffffu); d[1 * 136] = (bf16)(v.x >> 16); d[2 * 136] = (bf16)(v.y & 0xffffu); d[3 * 136] = (bf16)(v.y >> 16);
            d[4 * 136] = (bf16)(v.z & 0xffffu); d[5 * 136] = (bf16)(v.z >> 16); d[6 * 136] = (bf16)(v.w & 0xffffu); d[7 * 136] = (bf16)(v.w >> 16); }
        __syncthreads();
#pragma unroll
        for (int ks = 0; ks < 4; ++ks) {
            const bf16x8 b0 = *(const LAS bf16x8*)(Bs + ((2 * w) * 16 + fr) * 136 + ((ks * 32 + 8 * fq) ^ ((((2 * w) * 2 + (fr >> 3)) & 15) << 3)));
            const bf16x8 b1 = *(const LAS bf16x8*)(Bs + ((2 * w + 1) * 16 + fr) * 136 + ((ks * 32 + 8 * fq) ^ ((((2 * w + 1) * 2 + (fr >> 3)) & 15) << 3)));
#pragma unroll
            for (int mt = 0; mt < MT; ++mt) { const int mrow = m0 + mt * 16 + fr_a; bf16x8 a;
#pragma unroll
                for (int j = 0; j < 8; ++j) { const int k = ks * 32 + 8 * fq + j, tl = k >> 1, ri = k & 1; const int idx = ((kc * 64 + tl) * mrow) & (NDIV - 1);
                    float sn, cs; sincos_turns((float)idx * (1.f / (float)NDIV), sn, cs);
                    a[j] = (short)f2bf(ri == 0 ? cs : sgn * sn); }
                acc[mt][0] = MFMA16(a, b0, acc[mt][0]); acc[mt][1] = MFMA16(a, b1, acc[mt][1]); }
        }
    }
#pragma unroll
    for (int mt = 0; mt < MT; ++mt)
#pragma unroll
        for (int reg = 0; reg < 4; ++reg) { const float a = acc[mt][0][reg] * scale, b = acc[mt][1][reg] * scale; acc[mt][0][reg] = a; acc[mt][1][reg] = b;
            float s = a * a + b * b; s += __shfl_xor(s, 1); s += __shfl_xor(s, 2); s += __shfl_xor(s, 4); s += __shfl_xor(s, 8);
            if (fr == 0) red[w * 64 + mt * 16 + 4 * fq + reg] = s; }
    __syncthreads();
    bf16* MA = (bf16*)(ws + WS_H); const float* fg = inptr(I_FOURG) + l * 256;
    const float g0 = fg[(2 * w) * 16 + fr], g1 = fg[(2 * w + 1) * 16 + fr];
#pragma unroll
    for (int mt = 0; mt < MT; ++mt)
#pragma unroll
        for (int reg = 0; reg < 4; ++reg) { const int ml = mt * 16 + 4 * fq + reg; float tot = 0.f;
#pragma unroll
            for (int ww = 0; ww < 8; ++ww) tot += red[ww * 64 + ml];
            const float rs = rsqrtf(tot * (1.f / 256.f) + RMS_EPS);
            bf16* o = MA + (size_t)orow(m0 + ml) * D + 768 + fr;
            o[(2 * w) * 16] = (bf16)f2bf(acc[mt][0][reg] * rs * g0); o[(2 * w + 1) * 16] = (bf16)f2bf(acc[mt][1][reg] * rs * g1); }
    __syncthreads();
}

constexpr size_t WS_LORA = 64 * 1024;
constexpr int LINP = 392;
__device__ __forceinline__ float fast_sigmoid(float x) { return __builtin_amdgcn_rcpf(1.f + __expf(-x)); }
__device__ __forceinline__ float fast_tanh(float x) { return 1.f - 2.f * __builtin_amdgcn_rcpf(1.f + __expf(2.f * x)); }
__device__ __forceinline__ void prep_phase(const Frame& F0, int l) {
    const Frame F = phase_frame(F0); unsigned char* const ws = F.ws;
    const bf16* Zs = (const bf16*)(ws + WS_ZS); bf16* STR = (bf16*)(ws + WS_STR);
    LAS bf16* lin = (LAS bf16*)F.lds;
    LAS float* ssum = (LAS float*)(F.lds + 12544);
    constexpr int TP = 72, TSZ = 16 * TP;
    LAS bf16* tiles = (LAS bf16*)(F.lds + 13312);
    const int lane = F.lane, fr = lane & 15, fq = lane >> 4, w = F.wave, tid = F.tid;
    const int nitems = (NROW / 16) * 2;
    int it = blockIdx.x; if (it >= nitems) return;
    int hh = -1, head = 0, cb = 0;
    bf16x8 wf[12][2];
    const float* kkp = inptr(I_KK) + l * DR; const float* kap = inptr(I_KA) + l * DR; const float* dw0 = inptr(I_DW0) + l * 2 * DR; const float* ia0 = inptr(I_IA0) + l * 2 * DR;
    u32x4 pz[2];
#define PREP_LOAD(item_) do { const int row0_ = ((item_) >> 1) * 16; \
        pz[0] = *(const u32x4*)(Zs + (size_t)(row0_ + tid / 48) * ZW + 1536 + (tid % 48) * 8); \
        if (tid < 256) pz[1] = *(const u32x4*)(Zs + (size_t)(row0_ + (tid + 512) / 48) * ZW + 1536 + ((tid + 512) % 48) * 8); } while (0)
    PREP_LOAD(it);
    for (; it < nitems; it += F.G) {
        const int tile = it >> 1;
        if ((it & 1) != hh) {
            hh = it & 1; head = 4 * hh + (w >> 1); cb = 64 * head + 32 * (w & 1);
            const bf16* WL = (const bf16*)(ws + WS_LORA) + (size_t)l * 512 * 384 + (size_t)(cb + fr) * 384 + 8 * fq;
#pragma unroll
            for (int ks = 0; ks < 12; ++ks)
#pragma unroll
                for (int nt = 0; nt < 2; ++nt) wf[ks][nt] = *(const bf16x8*)(WL + (size_t)nt * 16 * 384 + ks * 32);
        }
        __syncthreads();
        {   float v[8]; unpack8(pz[0], v); const int c8 = tid % 48;
            if (c8 < 16) {
#pragma unroll
                for (int j = 0; j < 8; ++j) v[j] = fast_tanh(v[j]); }
            else if (c8 >= 32) {
#pragma unroll
                for (int j = 0; j < 8; ++j) v[j] = fast_sigmoid(v[j]); }
            *(LAS u32x4*)(lin + (tid / 48) * LINP + c8 * 8) = (u32x4){pk2(v[0], v[1]), pk2(v[2], v[3]), pk2(v[4], v[5]), pk2(v[6], v[7])};
            if (tid < 256) { unpack8(pz[1], v); const int c9 = (tid + 512) % 48;
                if (c9 < 16) {
#pragma unroll
                    for (int j = 0; j < 8; ++j) v[j] = fast_tanh(v[j]); }
                else if (c9 >= 32) {
#pragma unroll
                    for (int j = 0; j < 8; ++j) v[j] = fast_sigmoid(v[j]); }
                *(LAS u32x4*)(lin + ((tid + 512) / 48) * LINP + c9 * 8) = (u32x4){pk2(v[0], v[1]), pk2(v[2], v[3]), pk2(v[4], v[5]), pk2(v[6], v[7])}; } }
        u32x2 zr2[2], zk2[2], zv2[2];
        {   const bf16* zr_ = Zs + (size_t)(tile * 16 + fr) * ZW + cb + 4 * fq;
#pragma unroll
            for (int nt = 0; nt < 2; ++nt) { zr2[nt] = *(const u32x2*)(zr_ + 16 * nt); zk2[nt] = *(const u32x2*)(zr_ + 512 + 16 * nt); zv2[nt] = *(const u32x2*)(zr_ + 1024 + 16 * nt); } }
        if (it + F.G < nitems) PREP_LOAD(it + F.G);
        __syncthreads();
        f32x4 kkw[2], kaw[2], d0w[2][2], i0w[2][2];
#pragma unroll
        for (int nt = 0; nt < 2; ++nt) { const int c0 = cb + 16 * nt + 4 * fq; kkw[nt] = *(const f32x4*)(kkp + c0); kaw[nt] = *(const f32x4*)(kap + c0);
#pragma unroll
            for (int dn = 0; dn < 2; ++dn) { d0w[dn][nt] = *(const f32x4*)(dw0 + dn * DR + c0); i0w[dn][nt] = *(const f32x4*)(ia0 + dn * DR + c0); } }
        f32x4 acc[5][2];
#pragma unroll
        for (int q = 0; q < 5; ++q) { acc[q][0] = (f32x4){0.f, 0.f, 0.f, 0.f}; acc[q][1] = (f32x4){0.f, 0.f, 0.f, 0.f}; }
#pragma unroll
        for (int ks = 0; ks < 12; ++ks) { const int q = ks < 8 ? (ks >> 1) : 4; const bf16x8 xf = *(const LAS bf16x8*)(lin + fr * LINP + ks * 32 + 8 * fq);
            acc[q][0] = MFMA16(wf[ks][0], xf, acc[q][0]); acc[q][1] = MFMA16(wf[ks][1], xf, acc[q][1]); }
        float zk[2][4], kv[2][4]; float ss = 0.f;
#pragma unroll
        for (int nt = 0; nt < 2; ++nt) { unpack4(zk2[nt], zk[nt]);
#pragma unroll
            for (int i = 0; i < 4; ++i) { kv[nt][i] = zk[nt][i] * kkw[nt][i]; ss += kv[nt][i] * kv[nt][i]; } }
        ss += __shfl_xor(ss, 16); ss += __shfl_xor(ss, 32);
        if (fq == 0) ssum[w * 16 + fr] = ss;
        __syncthreads();
        const float inv = __builtin_amdgcn_rcpf(fmaxf(sqrtf(ssum[w * 16 + fr] + ssum[(w ^ 1) * 16 + fr]), 1e-12f));
        LAS bf16* th = tiles + (w >> 1) * 10 * TSZ + fr * TP + 32 * (w & 1) + 4 * fq;
#pragma unroll
        for (int nt = 0; nt < 2; ++nt) { LAS bf16* t0 = th + 16 * nt;
            *(LAS u32x2*)(t0) = zr2[nt]; *(LAS u32x2*)(t0 + TSZ) = zv2[nt];
            float kk[4];
#pragma unroll
            for (int i = 0; i < 4; ++i) kk[i] = kv[nt][i] * inv;
            *(LAS u32x2*)(t0 + 2 * TSZ) = (u32x2){pk2(kk[0], kk[1]), pk2(kk[2], kk[3])};
            *(LAS u32x2*)(t0 + 3 * TSZ) = (u32x2){pk2(acc[4][nt][0], acc[4][nt][1]), pk2(acc[4][nt][2], acc[4][nt][3])};
#pragma unroll
            for (int dn = 0; dn < 2; ++dn) { float ep[4], kd[4], bb[4];
#pragma unroll
                for (int i = 0; i < 4; ++i) { const float ew = fast_sigmoid(d0w[dn][nt][i] + acc[dn][nt][i]) * 0.6065306597126334f;
                    ep[i] = ew * (1.f + ew * (-0.5f + ew * (0.16666667f + ew * (-0.041666668f + ew * 0.0083333338f))));
                    const float a = fast_sigmoid(i0w[dn][nt][i] + acc[2 + dn][nt][i]); kd[i] = zk[nt][i] * (1.f + (a - 1.f) * kaw[nt][i]); bb[i] = kk[i] * a; }
                *(LAS u32x2*)(t0 + (4 + 3 * dn) * TSZ) = (u32x2){pk2(ep[0], ep[1]), pk2(ep[2], ep[3])};
                *(LAS u32x2*)(t0 + (5 + 3 * dn) * TSZ) = (u32x2){pk2(kd[0], kd[1]), pk2(kd[2], kd[3])};
                *(LAS u32x2*)(t0 + (6 + 3 * dn) * TSZ) = (u32x2){pk2(bb[0], bb[1]), pk2(bb[2], bb[3])}; } }
        __syncthreads();
        {   const LAS bf16* src = tiles + (w >> 1) * 10 * TSZ + (8 * (w & 1) + (lane >> 3)) * TP + (lane & 7) * 8; bf16* dst = STR + ((size_t)tile * 8 + head) * 10240 + 8 * (w & 1) * 64 + lane * 8;
#pragma unroll
            for (int s = 0; s < 10; ++s) *(u32x4*)(dst + s * 1024) = *(const LAS u32x4*)(src + s * TSZ); }
    }
#undef PREP_LOAD
}

__device__ __forceinline__ int scan_rowof(int s, int dir, int b) { if (s < CTXL) { const int tc = dir ? (CTXL - 1 - s) : s; return NLAT + b * CTXL + tc; } const int tt = s - CTXL; const int t = dir ? (SEQ - 1 - tt) : tt; return b * SEQ + t; }
__device__ __forceinline__ void readout_pass(const Frame& F0, int l, int nrows) {
    const Frame F = phase_frame(F0); unsigned char* const ws = F.ws;
    const bf16* STR = (const bf16*)(ws + WS_STR); const bf16* Y0 = (const bf16*)(ws + WS_Y); const bf16* Y1 = Y0 + (size_t)NROW * DR; bf16* MA = (bf16*)(ws + WS_H);
    const int lane = F.lane, c = 8 * lane;
    float gw[8], gb[8], rk[8];
    {   const float* gnw = inptr(I_GNW) + l * DR + c; const float* gnb = inptr(I_GNB) + l * DR + c; const float* rkp = inptr(I_RK) + l * DR + c;
        const f32x4 a0 = *(const f32x4*)gnw, a1 = *(const f32x4*)(gnw + 4), b0 = *(const f32x4*)gnb, b1 = *(const f32x4*)(gnb + 4), r0 = *(const f32x4*)rkp, r1 = *(const f32x4*)(rkp + 4);
#pragma unroll
        for (int i = 0; i < 4; ++i) { gw[i] = a0[i]; gw[4 + i] = a1[i]; gb[i] = b0[i]; gb[4 + i] = b1[i]; rk[i] = r0[i]; rk[4 + i] = r1[i]; } }
    for (int row0 = F.gw; row0 < nrows; row0 += 2 * F.NGW) {
        u32x4 q[2][7]; bool ok[2];
#pragma unroll
        for (int u = 0; u < 2; ++u) { const int row = row0 + u * F.NGW; ok[u] = row < nrows; if (ok[u]) {
            const bf16* sr = STR + ((size_t)(row >> 4) * 8 + (lane >> 3)) * 10240 + (row & 15) * 64 + (lane & 7) * 8;
            q[u][0] = *(const u32x4*)(Y0 + (size_t)row * DR + c); q[u][1] = *(const u32x4*)(Y1 + (size_t)row * DR + c);
            q[u][2] = *(const u32x4*)sr; q[u][3] = *(const u32x4*)(sr + 1024); q[u][4] = *(const u32x4*)(sr + 3072); q[u][5] = *(const u32x4*)(sr + 5 * 1024); q[u][6] = *(const u32x4*)(sr + 8 * 1024); } }
#pragma unroll
        for (int u = 0; u < 2; ++u) if (ok[u]) { const int row = row0 + u * F.NGW;
            float ya[8], yb[8], r[8], v[8], g[8], k0[8], k1[8];
            unpack8(q[u][0], ya); unpack8(q[u][1], yb); unpack8(q[u][2], r); unpack8(q[u][3], v); unpack8(q[u][4], g); unpack8(q[u][5], k0); unpack8(q[u][6], k1);
            float s1 = 0.f, s2 = 0.f, sb = 0.f;
#pragma unroll
            for (int i = 0; i < 8; ++i) { ya[i] += yb[i]; s1 += ya[i]; s2 += ya[i] * ya[i]; sb += r[i] * (k0[i] + k1[i]) * rk[i]; }
#pragma unroll
            for (int o = 1; o < 8; o <<= 1) { s1 += __shfl_xor(s1, o); s2 += __shfl_xor(s2, o); sb += __shfl_xor(sb, o); }
            const float mu = s1 * (1.f / 64.f); const float var = fmaxf(s2 * (1.f / 64.f) - mu * mu, 0.f); const float rs = rsqrtf(var + GN_EPS);
            float o8[8];
#pragma unroll
            for (int i = 0; i < 8; ++i) o8[i] = ((ya[i] - mu) * rs * gw[i] + gb[i] + sb * v[i]) * g[i];
            *(u32x4*)(MA + (size_t)row * D + c) = (u32x4){pk2(o8[0], o8[1]), pk2(o8[2], o8[3]), pk2(o8[4], o8[5]), pk2(o8[6], o8[7])}; }
    }
}
constexpr int BLOB = 16384, SEGCH = 132, NSEG = 4, BLOB_B1_SCANS = 14;
constexpr size_t WS_BLOBA = 20 * MiB, WS_BLOBB1 = 86 * MiB, WS_BLOBB2 = 492 * MiB;
constexpr size_t WS_SCANST = 2 * MiB + 512 * 1024;
__device__ __forceinline__ unsigned char* blob_ptr(unsigned char* ws, int seg, int scan, int ci) {
    if ((seg & 1) == 0) return ws + WS_BLOBA + ((size_t)scan * SEGCH + ci) * BLOB;
    return scan < BLOB_B1_SCANS ? ws + WS_BLOBB1 + ((size_t)scan * SEGCH + ci) * BLOB : ws + WS_BLOBB2 + ((size_t)(scan - BLOB_B1_SCANS) * SEGCH + ci) * BLOB;
}
typedef short s16x4 __attribute__((ext_vector_type(4)));
__device__ __forceinline__ bf16x8 frag_lo(u32x2 x) { u32x4 t = {x.x, x.y, 0u, 0u}; return __builtin_bit_cast(bf16x8, t); }
__device__ __forceinline__ bf16x8 frag_c(const f32x4& a) { u32x4 t = {pk2(a[0], a[1]), pk2(a[2], a[3]), 0u, 0u}; return __builtin_bit_cast(bf16x8, t); }

struct PreRegs { u32x4 q[12]; };
__device__ __forceinline__ void pre_load(PreRegs& R, unsigned char* ws, int scan, int cs, int lane) {
    const int dir = scan & 1, h = (scan >> 1) & 7, b = scan >> 4; const int rfirst = scan_rowof(16 * cs, dir, b);
    const bf16* blk = (const bf16*)(ws + WS_STR) + ((size_t)(rfirst >> 4) * 8 + h) * 10240 + lane * 8;
    const int so[6] = {0, 1, 2, 4 + 3 * dir, 5 + 3 * dir, 6 + 3 * dir};
#pragma unroll
    for (int i = 0; i < 6; ++i) { R.q[2 * i] = *(const u32x4*)(blk + so[i] * 1024); R.q[2 * i + 1] = *(const u32x4*)(blk + so[i] * 1024 + 512); }
}
template <int PM>
__device__ __forceinline__ void pre_item(const Frame& F, unsigned char* ws, int scan, int cs, unsigned char* blob, PreRegs& PR, int nscan, int ncs) {
    const int dir = scan & 1, h = (scan >> 1) & 7, b = scan >> 4; const int lane = F.lane, fr = lane & 15, fq = lane >> 4;
    LAS unsigned char* L = F.lds + F.wave * 17408;
    constexpr int TKP = 72, TKS = 16 * TKP;
    LAS bf16* TK = (LAS bf16*)L; LAS bf16* TR = TK + TKS; LAS bf16* TKt = TR + TKS; LAS bf16* TB = TKt + TKS;
    LAS bf16* KTt = TB + TKS; LAS bf16* RTt = KTt + 1024; LAS bf16* Vt = RTt + 1024;
    LAS bf16* AKK = Vt + 1024; LAS bf16* ARK = AKK + 256; LAS bf16* ARB = ARK + 256; LAS bf16* TT = ARB + 256;
    float kh[16], bh[16];
    float pc;
    {   float r_[16], v_[16], kk_[16], lp_[16], kd_[16], bb_[16];
        LAS bf16* stg = TK;
#pragma unroll
        for (int i = 0; i < 6; ++i) { *(LAS u32x4*)(stg + i * 1024 + lane * 8) = PR.q[2 * i]; *(LAS u32x4*)(stg + i * 1024 + 512 + lane * 8) = PR.q[2 * i + 1]; }
        LDS_WAIT(); asm volatile("" ::: "memory");
        if (nscan >= 0) pre_load(PR, ws, nscan, ncs, lane);
#pragma unroll
        for (int t = 0; t < 16; ++t) { const int tm = (dir ? 15 - t : t) * 64 + lane;
            r_[t] = bf2f(stg[tm]); v_[t] = bf2f(stg[1024 + tm]); kk_[t] = bf2f(stg[2048 + tm]); lp_[t] = bf2f(stg[3072 + tm]); kd_[t] = bf2f(stg[4096 + tm]); bb_[t] = bf2f(stg[5120 + tm]); }
        LDS_WAIT(); asm volatile("" ::: "memory");
        float pp = 1.f; u32x4 kt4[2], rt4[2], v4[2];
        unsigned ktp[8], rtp[8], vp[8];
#pragma unroll
        for (int t = 0; t < 16; ++t) { const float pm1 = pp; pp *= 1.f - lp_[t]; const float p = pp, ip = __builtin_amdgcn_rcpf(pp); lp_[t] = ip;
            const float kt = kk_[t] * pm1, ktl = kd_[t] * ip, btl = bb_[t] * ip, rt = r_[t] * p;
            const unsigned hk = pk2(kt, rt), hb = pk2(ktl, btl);
            TK[t * TKP + lane] = (bf16)(hk & 0xffffu); TR[t * TKP + lane] = (bf16)(hk >> 16); TKt[t * TKP + lane] = (bf16)(hb & 0xffffu); TB[t * TKP + lane] = (bf16)(hb >> 16);
            const unsigned hv = f2bf(v_[t]);
            if (t & 1) { ktp[t >> 1] |= hk << 16; rtp[t >> 1] |= hk & 0xffff0000u; vp[t >> 1] |= hv << 16; }
            else { ktp[t >> 1] = hk & 0xffffu; rtp[t >> 1] = hk >> 16; vp[t >> 1] = hv; } }
        kt4[0] = (u32x4){ktp[0], ktp[1], ktp[2], ktp[3]}; kt4[1] = (u32x4){ktp[4], ktp[5], ktp[6], ktp[7]};
        rt4[0] = (u32x4){rtp[0], rtp[1], rtp[2], rtp[3]}; rt4[1] = (u32x4){rtp[4], rtp[5], rtp[6], rtp[7]};
        v4[0] = (u32x4){vp[0], vp[1], vp[2], vp[3]}; v4[1] = (u32x4){vp[4], vp[5], vp[6], vp[7]};
        *(LAS u32x4*)(KTt + lane * 16) = kt4[0]; *(LAS u32x4*)(KTt + lane * 16 + 8) = kt4[1];
        *(LAS u32x4*)(RTt + lane * 16) = rt4[0]; *(LAS u32x4*)(RTt + lane * 16 + 8) = rt4[1];
        *(LAS u32x4*)(Vt + lane * 16) = v4[0]; *(LAS u32x4*)(Vt + lane * 16 + 8) = v4[1];
        pc = pp;
#pragma unroll
        for (int t = 0; t < 16; ++t) { const float e = pp * lp_[t]; kh[t] = kd_[t] * e; bh[t] = bb_[t] * e; }
    }
    LDS_WAIT(); asm volatile("" ::: "memory");
    {   f32x4 akb = {0.f, 0.f, 0.f, 0.f}, akk = akb, ark = akb, arb = akb;
#pragma unroll
        for (int s = 0; s < 2; ++s) { const int o = fr * TKP + 32 * s + 8 * fq;
            const bf16x8 fk = *(const LAS bf16x8*)(TK + o), frr = *(const LAS bf16x8*)(TR + o), fkt = *(const LAS bf16x8*)(TKt + o), fb = *(const LAS bf16x8*)(TB + o);
            akb = MFMA16(fk, fb, akb); akk = MFMA16(fk, fkt, akk); ark = MFMA16(frr, fkt, ark); arb = MFMA16(frr, fb, arb); }
        float nm[4];
#pragma unroll
        for (int reg = 0; reg < 4; ++reg) { const int t = 4 * fq + reg; const bool lo = fr < t, le = fr <= t;
            nm[reg] = lo ? akb[reg] : 0.f; AKK[t * 16 + fr] = (bf16)f2bf(lo ? akk[reg] : 0.f);
            ARK[t * 16 + fr] = (bf16)f2bf(le ? ark[reg] : 0.f); ARB[t * 16 + fr] = (bf16)f2bf(le ? arb[reg] : 0.f); }
        float col[16];
#pragma unroll
        for (int t = 0; t < 16; ++t) { float s_ = (t == fr) ? 1.f : 0.f;
#pragma unroll
            for (int i = 0; i < 16; ++i) if (i < t) { const float n_ti = __builtin_bit_cast(float, __builtin_amdgcn_readlane(__builtin_bit_cast(int, nm[t & 3]), i + 16 * (t >> 2))); s_ -= n_ti * col[i]; }
            col[t] = s_; TT[t * 16 + fr] = (bf16)f2bf(s_); }
    }
    LDS_WAIT(); asm volatile("" ::: "memory");
    f32x4 WTc[4], RqT[4], U0c[4], Y0c[4];
    {   const bf16x8 aT = frag_lo(*(const LAS u32x2*)(TT + fr * 16 + 4 * fq)), aKK = frag_lo(*(const LAS u32x2*)(AKK + fr * 16 + 4 * fq)), aRK = frag_lo(*(const LAS u32x2*)(ARK + fr * 16 + 4 * fq));
        u32x2 nb = *(const LAS u32x2*)(ARB + fr * 16 + 4 * fq); nb.x ^= 0x80008000u; nb.y ^= 0x80008000u; const bf16x8 aRBn = frag_lo(nb);
        const f32x4 z4 = {0.f, 0.f, 0.f, 0.f};
#pragma unroll
        for (int nt = 0; nt < 4; ++nt) { const int o = (16 * nt + fr) * 16 + 4 * fq;
            const bf16x8 bK = frag_lo(*(const LAS u32x2*)(KTt + o)), bV = frag_lo(*(const LAS u32x2*)(Vt + o));
            float ri[4]; unpack4(*(const LAS u32x2*)(TR + fr * TKP + 16 * nt + 4 * fq), ri);
            const f32x4 Wn = MFMA16(aT, bK, z4); WTc[nt] = MFMA16(bK, aT, z4);
            const f32x4 Zn = MFMA16(aKK, bV, z4);
            U0c[nt] = MFMA16(aT, frag_c(Zn), z4);
            RqT[nt] = MFMA16(frag_c(Wn), aRBn, ((f32x4){ri[0], ri[1], ri[2], ri[3]}));
            Y0c[nt] = MFMA16(aRK, bV, z4); Y0c[nt] = MFMA16(aRBn, frag_c(U0c[nt]), Y0c[nt]); }
    }
    LDS_WAIT(); asm volatile("" ::: "memory");
#pragma unroll
    for (int nt = 0; nt < 4; ++nt) { const u32x2 vv = *(const LAS u32x2*)(Vt + (16 * nt + fr) * 16 + 4 * fq);
        *(u32x2*)(blob + 8192 + nt * 2048 + 1024 + lane * 8) = vv;
        u32x2 u0 = {pk2(U0c[nt][0], U0c[nt][1]), pk2(U0c[nt][2], U0c[nt][3])}, y0 = {pk2(Y0c[nt][0], Y0c[nt][1]), pk2(Y0c[nt][2], Y0c[nt][3])};
        *(u32x2*)(blob + 8192 + nt * 2048 + lane * 8) = u0; *(u32x2*)(blob + 8192 + nt * 2048 + 512 + lane * 8) = y0;
        *(float*)(blob + 8192 + nt * 2048 + 1536 + lane * 4) = pc; }
#pragma unroll
    for (int s = 0; s < 2; ++s) {
        *(u32x4*)(blob + (0 * 2 + s) * 1024 + lane * 16) = (u32x4){pk2(WTc[2 * s][0], WTc[2 * s][1]), pk2(WTc[2 * s][2], WTc[2 * s][3]), pk2(WTc[2 * s + 1][0], WTc[2 * s + 1][1]), pk2(WTc[2 * s + 1][2], WTc[2 * s + 1][3])};
        *(u32x4*)(blob + (1 * 2 + s) * 1024 + lane * 16) = (u32x4){pk2(RqT[2 * s][0], RqT[2 * s][1]), pk2(RqT[2 * s][2], RqT[2 * s][3]), pk2(RqT[2 * s + 1][0], RqT[2 * s + 1][1]), pk2(RqT[2 * s + 1][2], RqT[2 * s + 1][3])}; }
    LAS bf16* BHt = TKt; LAS bf16* KHt = TB;
    {   u32x4 a, c, d, e;
        a = (u32x4){pk2(bh[0], bh[1]), pk2(bh[2], bh[3]), pk2(bh[4], bh[5]), pk2(bh[6], bh[7])}; c = (u32x4){pk2(bh[8], bh[9]), pk2(bh[10], bh[11]), pk2(bh[12], bh[13]), pk2(bh[14], bh[15])};
        d = (u32x4){pk2(kh[0], kh[1]), pk2(kh[2], kh[3]), pk2(kh[4], kh[5]), pk2(kh[6], kh[7])}; e = (u32x4){pk2(kh[8], kh[9]), pk2(kh[10], kh[11]), pk2(kh[12], kh[13]), pk2(kh[14], kh[15])};
        *(LAS u32x4*)(BHt + lane * 16) = a; *(LAS u32x4*)(BHt + lane * 16 + 8) = c; *(LAS u32x4*)(KHt + lane * 16) = d; *(LAS u32x4*)(KHt + lane * 16 + 8) = e; }
    LDS_WAIT(); asm volatile("" ::: "memory");
#pragma unroll
    for (int mt = 0; mt < 4; ++mt) { const int o = (16 * mt + fr) * 16 + 4 * fq; const u32x2 bb = *(const LAS u32x2*)(BHt + o), kk = *(const LAS u32x2*)(KHt + o);
        *(u32x4*)(blob + 4096 + mt * 1024 + lane * 16) = (u32x4){bb.x ^ 0x80008000u, bb.y ^ 0x80008000u, kk.x, kk.y}; }
    LDS_WAIT(); asm volatile("" ::: "memory");
}

__device__ __forceinline__ void pre_phase(const Frame& F0, int seg, int b_lo) {
    const Frame F = phase_frame(F0); unsigned char* const ws = F.ws;
    if ((int)blockIdx.x < b_lo) return;
    const int nwv = (F.G - b_lo) * NWAVES;
    PreRegs R;
    int it = ((int)blockIdx.x - b_lo) * NWAVES + F.wave; if (it >= 32 * SEGCH) return;
    pre_load(R, ws, it & 31, seg * SEGCH + (it >> 5), F.lane);
    for (; it < 32 * SEGCH; it += nwv) { const int nx = it + nwv; const bool hn = nx < 32 * SEGCH;
        pre_item<0>(F, ws, it & 31, seg * SEGCH + (it >> 5), blob_ptr(ws, seg, it & 31, it >> 5), R, hn ? (nx & 31) : -1, seg * SEGCH + (nx >> 5)); }
}

constexpr int SQ_SLOT = 10240, SQ_R = 12, SQ_D = 8;
template <int MODE>
__device__ __forceinline__ void seq_item(const Frame& F0, int item, int seg, bool need_ctx) {
    const Frame F = phase_frame(F0); unsigned char* const ws = F.ws;
    const int scan = item >> 2, vb = item & 3, dir = scan & 1, h = (scan >> 1) & 7, b = scan >> 4; const int lane = F.lane, fr = lane & 15, fq = lane >> 4, w = F.wave;
    const unsigned char* blob = blob_ptr(ws, seg, scan, 0);
    LAS unsigned char* ring = F.lds;
    __syncthreads();
    const int p0 = 2 * (w - 1);
    const unsigned goff0 = (p0 < 8 ? p0 * 1024 : 8192 + vb * 2048 + (p0 - 8) * 1024) + lane * 16, goff1 = (p0 + 1 < 8 ? (p0 + 1) * 1024 : 8192 + vb * 2048 + (p0 + 1 - 8) * 1024) + lane * 16;
#define SQ_ISSUE(c) do { const unsigned char* g_ = blob + (size_t)(c) * BLOB; LAS unsigned char* s_ = ring + ((c) % SQ_R) * SQ_SLOT + p0 * 1024; \
        __builtin_amdgcn_global_load_lds((const unsigned*)(g_ + goff0), (LAS unsigned*)(s_), 16, 0, 0); \
        __builtin_amdgcn_global_load_lds((const unsigned*)(g_ + goff1), (LAS unsigned*)(s_ + 1024), 16, 0, 0); } while (0)
    const bool loader = (w >= 1 && w <= 5) && MODE != 2;
    if (loader) { for (int c = 0; c < SQ_D; ++c) SQ_ISSUE(c); }
    bf16* Y = (bf16*)(ws + WS_Y) + (size_t)dir * NROW * DR + h * 64 + 16 * vb + fr;
    float* st = (float*)(ws + WS_SCANST) + (size_t)item * 1024 + lane * 4;
    f32x4 M[4];
#pragma unroll
    for (int mt = 0; mt < 4; ++mt) M[mt] = (seg == 0 || w != 0) ? (f32x4){0.f, 0.f, 0.f, 0.f} : *(const f32x4*)(st + mt * 256);
    const f32x4 z4 = {0.f, 0.f, 0.f, 0.f};
    LAS unsigned char* mb = ring + SQ_R * SQ_SLOT;
    struct SQ { bf16x8 a1[2], a2[4]; f32x4 pc[4]; u32x2 u0, vv; };
#define SQ_READ(R, c) do { const LAS unsigned char* sl_ = ring + ((c) % SQ_R) * SQ_SLOT; _Pragma("unroll") for (int i = 0; i < 4; ++i) { \
        R.a2[i] = *(const LAS bf16x8*)(sl_ + 4096 + i * 1024 + lane * 16); R.pc[i] = *(const LAS f32x4*)(sl_ + 8192 + 1536 + (16 * i + 4 * fq) * 4); } \
        R.a1[0] = *(const LAS bf16x8*)(sl_ + lane * 16); R.a1[1] = *(const LAS bf16x8*)(sl_ + 1024 + lane * 16); \
        R.u0 = *(const LAS u32x2*)(sl_ + 8192 + lane * 8); R.vv = *(const LAS u32x2*)(sl_ + 8192 + 1024 + lane * 8); } while (0)
#define SQ_STEP(R, c, RN, cn) do { \
        if ((cn) < SEGCH) SQ_READ(RN, cn); \
        const u32x4 t0 = {pk2(M[0][0], M[0][1]), pk2(M[0][2], M[0][3]), pk2(M[1][0], M[1][1]), pk2(M[1][2], M[1][3])}; \
        const u32x4 t1 = {pk2(M[2][0], M[2][1]), pk2(M[2][2], M[2][3]), pk2(M[3][0], M[3][1]), pk2(M[3][2], M[3][3])}; \
        *(LAS u32x4*)(mb + ((c) & 1) * 2048 + lane * 16) = t0; *(LAS u32x4*)(mb + ((c) & 1) * 2048 + 1024 + lane * 16) = t1; \
        const bf16x8 b0 = __builtin_bit_cast(bf16x8, t0), b1 = __builtin_bit_cast(bf16x8, t1); \
        f32x4 X0 = MFMA16(R.a1[0], b0, z4); X0 = MFMA16(R.a1[1], b1, X0); \
        float u0[4]; unpack4(R.u0, u0); \
        const u32x4 tb = {pk2(X0[0] + u0[0], X0[1] + u0[1]), pk2(X0[2] + u0[2], X0[3] + u0[3]), R.vv.x, R.vv.y}; const bf16x8 bB = __builtin_bit_cast(bf16x8, tb); \
        _Pragma("unroll") for (int mt = 0; mt < 4; ++mt) M[mt] = MFMA16(R.a2[mt], bB, R.pc[mt] * M[mt]); \
        asm volatile("s_waitcnt lgkmcnt(0)" ::: "memory"); } while (0)
    const long ystep = dir ? -(long)DR : (long)DR;
#define SQ_YSTEP(c) do { const int cs_ = seg * SEGCH + (c); if (MODE == 0 && (need_ctx || cs_ >= 16)) { const LAS unsigned char* sl_ = ring + ((c) % SQ_R) * SQ_SLOT; \
        const bf16x8 q0 = *(const LAS bf16x8*)(sl_ + 2048 + lane * 16), q1 = *(const LAS bf16x8*)(sl_ + 3072 + lane * 16); \
        const bf16x8 b0 = *(const LAS bf16x8*)(mb + ((c) & 1) * 2048 + lane * 16), b1 = *(const LAS bf16x8*)(mb + ((c) & 1) * 2048 + 1024 + lane * 16); \
        float y0[4]; unpack4(*(const LAS u32x2*)(sl_ + 8192 + 512 + lane * 8), y0); \
        f32x4 X1 = MFMA16(q0, b0, z4); X1 = MFMA16(q1, b1, X1); \
        bf16* yp = Y + (size_t)scan_rowof(16 * cs_ + 4 * fq, dir, b) * DR; \
        yp[0] = (bf16)f2bf(X1[0] + y0[0]); yp[ystep] = (bf16)f2bf(X1[1] + y0[1]); yp[2 * ystep] = (bf16)f2bf(X1[2] + y0[2]); yp[3 * ystep] = (bf16)f2bf(X1[3] + y0[3]); \
        asm volatile("s_waitcnt lgkmcnt(0)" ::: "memory"); } } while (0)
#define SQ_LOADER(c) do { if (loader) { if ((c) + SQ_D < SEGCH) { SQ_ISSUE((c) + SQ_D); asm volatile("s_waitcnt vmcnt(12)" ::: "memory"); } else asm volatile("s_waitcnt vmcnt(0)" ::: "memory"); } \
        __builtin_amdgcn_s_barrier(); asm volatile("" ::: "memory"); } while (0)
    const bool stw = (w == 0 && MODE != 1), yw = (w == 6 && MODE != 1);
    SQ Ra, Rb, Rc;
    SQ_LOADER(0);
    if (stw) { SQ_READ(Ra, 0); SQ_READ(Rb, 1); }
    for (int c = 0; c < SEGCH; c += 3) {
        SQ_LOADER(c + 1);
        if (stw) SQ_STEP(Ra, c, Rc, c + 2);
        if (yw && c > 0) SQ_YSTEP(c - 1);
        SQ_LOADER(c + 2);
        if (stw) SQ_STEP(Rb, c + 1, Ra, c + 3);
        if (yw) SQ_YSTEP(c);
        SQ_LOADER(c + 3);
        if (stw) SQ_STEP(Rc, c + 2, Rb, c + 4);
        if (yw) SQ_YSTEP(c + 1);
    }
    __builtin_amdgcn_s_barrier(); asm volatile("" ::: "memory");
    if (yw) SQ_YSTEP(SEGCH - 1);
#undef SQ_READ
#undef SQ_STEP
#undef SQ_YSTEP
#undef SQ_LOADER
#undef SQ_ISSUE
    if (MODE >= 2 && w == 0 && M[0][0] + M[1][1] + M[2][2] + M[3][3] == 12345.678f) st[0] = M[0][0];
    if (MODE == 0 && w == 0 && seg + 1 < NSEG) {
#pragma unroll
        for (int mt = 0; mt < 4; ++mt) *(f32x4*)(st + mt * 256) = M[mt]; }
    __syncthreads();
}

namespace pg8 {
struct EpiStoreBf16 {
    static constexpr bool PERM = true, AFTER_DRAIN = false;
    bf16_t* O; int ldc; int pn_mask;
    __device__ __forceinline__ void operator()(const f32x4 (&acc)[2][2][4][2], const Unit& u, int wr, int wc, int fr, int fq) const {
        const int row0 = u.pm * BM + wr * 64 + fr; const int col0 = (u.pn & pn_mask) * BM + wc * 32 + 8 * fq;
#pragma unroll
        for (int ai = 0; ai < 2; ++ai)
#pragma unroll
            for (int m = 0; m < 4; ++m) { bf16_t* rowp = O + (size_t)(row0 + ai * HALF + m * 16) * ldc + col0;
#pragma unroll
                for (int bj = 0; bj < 2; ++bj) { const f32x4 v0 = acc[ai][bj][m][0], v1 = acc[ai][bj][m][1];
                    u32x4 w; w.x = cvt_pk_bf16(v0[0], v0[1]); w.y = cvt_pk_bf16(v0[2], v0[3]); w.z = cvt_pk_bf16(v1[0], v1[1]); w.w = cvt_pk_bf16(v1[2], v1[3]);
                    *(u32x4*)(rowp + bj * HALF) = w; } }
    }
};
struct EpiSwiGLU {
    static constexpr bool PERM = true, AFTER_DRAIN = false;
    bf16_t* O;
    __device__ __forceinline__ void operator()(const f32x4 (&acc)[2][2][4][2], const Unit& u, int wr, int wc, int fr, int fq) const {
        const int row0 = u.pm * BM + wr * 64 + fr; const int col0 = ((u.pn & 3) * BM + wc * 32 + 8 * fq) >> 1;
#pragma unroll
        for (int ai = 0; ai < 2; ++ai)
#pragma unroll
            for (int m = 0; m < 4; ++m) { bf16_t* rowp = O + (size_t)(row0 + ai * HALF + m * 16) * 512 + col0;
#pragma unroll
                for (int bj = 0; bj < 2; ++bj) { const f32x4 g = acc[ai][bj][m][0], up = acc[ai][bj][m][1]; float a[4];
#pragma unroll
                    for (int i = 0; i < 4; ++i) a[i] = g[i] / (1.f + __expf(-g[i])) * up[i];
                    unsigned long long w = (unsigned long long)cvt_pk_bf16(a[0], a[1]) | ((unsigned long long)cvt_pk_bf16(a[2], a[3]) << 32);
                    *(unsigned long long*)(rowp + bj * (HALF / 2)) = w; } }
    }
};
template <bool XF32> struct EpiResidual {
    static constexpr bool PERM = false, AFTER_DRAIN = false;
    const void* xlat; const void* xctx;
    bf16_t* out; const float* g1;
    __device__ __forceinline__ void operator()(const f32x4 (&acc)[2][2][4][2], const Unit& u, int wr, int wc, int fr, int fq) const {
        const int rowt = u.pm * BM; const int mr = rowt < 16384 ? (rowt >> 13) : 2;
        const size_t boff = rowt < 16384 ? (size_t)rowt * 1024 : (size_t)(rowt - 16384) * 1024; const void* bp = rowt < 16384 ? xlat : xctx;
        const int col0 = u.pn * BM + wc * 32 + 4 * fq;
        f32x4 gv[2][2];
#pragma unroll
        for (int bj = 0; bj < 2; ++bj)
#pragma unroll
            for (int n = 0; n < 2; ++n) gv[bj][n] = *(const f32x4*)(g1 + (size_t)mr * 6144 + col0 + bj * HALF + n * 16);
#pragma unroll
        for (int ai = 0; ai < 2; ++ai)
#pragma unroll
            for (int m = 0; m < 4; ++m) { const int rl = ai * HALF + wr * 64 + m * 16 + fr;
#pragma unroll
                for (int bj = 0; bj < 2; ++bj)
#pragma unroll
                    for (int n = 0; n < 2; ++n) { const size_t off = (size_t)rl * 1024 + col0 + bj * HALF + n * 16;
                        f32x4 xo;
                        if (XF32) xo = *(const f32x4*)((const float*)bp + boff + off);
                        else { const unsigned long long w_ = *(const unsigned long long*)((const bf16_t*)bp + boff + off); const unsigned lo = (unsigned)w_, hi = (unsigned)(w_ >> 32);
                            xo = (f32x4){__uint_as_float(lo << 16), __uint_as_float(lo & 0xffff0000u), __uint_as_float(hi << 16), __uint_as_float(hi & 0xffff0000u)}; }
                        const f32x4 r = xo + gv[bj][n] * acc[ai][bj][m][n];
                        *(unsigned long long*)(out + (size_t)rowt * 1024 + off) = (unsigned long long)cvt_pk_bf16(r[0], r[1]) | ((unsigned long long)cvt_pk_bf16(r[2], r[3]) << 32); } }
    }
};
struct MoeOrder {
    const PG8_LAS int* tile_e; const PG8_LAS int* tile_t; int ntiles, G, c;
    __device__ bool next(int i, Unit& u) const { const long L = (long)i * G + c; if (L >= 4L * ntiles) return false; const int pm = (int)(L >> 2); const int e = tile_e[pm];
        u.pm = pm; u.pn = e * 4 + (int)(L & 3); u.ga = e * 16896 + tile_t[pm] * 256; return true; }
    __device__ __forceinline__ void a_ready(const Unit&) const {}
    __device__ __forceinline__ void done(const Unit&) const {}
};
}

__device__ __forceinline__ void expert_convert(const Frame& F0, int l, int b_lo) {
    const Frame F = phase_frame(F0); unsigned char* const ws = F.ws;
    if ((int)blockIdx.x < b_lo) return;
    const int nwv = (F.G - b_lo) * NWAVES, myw = ((int)blockIdx.x - b_lo) * NWAVES + F.wave;
    LAS float* scr = (LAS float*)(F.lds + F.wave * 16384);
    bf16* wgu = (bf16*)(ws + WS_WGU_T); bf16* wd = (bf16*)(ws + WS_WD_T);
    constexpr int I_G = 16 * 16, I_D = 8 * 32;
    constexpr int NIT = NEXP * (2 * I_G + I_D);
    const float* p_eg = inptr(I_EG); const float* p_eu = inptr(I_EU); const float* p_ed = inptr(I_ED);
    for (int it = myw; it < NIT; it += nwv) { const int e = it / (2 * I_G + I_D); int r = it % (2 * I_G + I_D);
        if (r < I_G) { transpose_item(p_eg + ((size_t)l * NEXP + e) * D * DEXP, DEXP, (r >> 4) * 64, (r & 15) * 32, wgu, D, RmGU{e * 1024}, scr, F.lane); continue; } r -= I_G;
        if (r < I_G) { transpose_item(p_eu + ((size_t)l * NEXP + e) * D * DEXP, DEXP, (r >> 4) * 64, (r & 15) * 32, wgu, D, RmGU{e * 1024 + 4}, scr, F.lane); continue; } r -= I_G;
        transpose_item(p_ed + ((size_t)l * NEXP + e) * DEXP * D, D, (r >> 5) * 64, (r & 31) * 32, wd, DEXP, RmId{e * 1024}, scr, F.lane);
    }
}

__device__ __forceinline__ void router_pass(const Frame& F0, int l, int nrows, int cnt_off = 0) {
    const Frame F = phase_frame(F0); unsigned char* const ws = F.ws;
    constexpr int HP = 1028;
    LAS float* msh = (LAS float*)F.lds; LAS float* msc = msh + 3072; LAS float* hrow = msc + 3072;
    LAS float* part = hrow + 16 * HP;
    LAS float* lgs = part + 8 * 16 * 48;
    LAS unsigned* lcnt = (LAS unsigned*)(lgs + 16 * 40);
    if (F0.tid < 64) lcnt[F0.tid] = 0u;
    __syncthreads();
    mod_to_lds(F, l, 3, msh, false); mod_to_lds(F, l, 4, msc, false); __syncthreads();
    const bf16* X = (const bf16*)(ws + WS_X); bf16* H = (bf16*)(ws + WS_H);
    const float* rgw = inptr(I_RGW) + (size_t)l * D * 4; const float* rew = inptr(I_REW) + (size_t)l * D * NEXP;
    const float* rgb = inptr(I_RGB) + l * 4; const float* reb = inptr(I_REB) + l * NEXP;
    int* rt_e = (int*)(ws + WS_ROUTE + RT_E); int* rt_pos = (int*)(ws + WS_ROUTE + RT_POS); float* rt_gate = (float*)(ws + WS_ROUTE + RT_GATE);
    unsigned* cnt = (unsigned*)(ws + WS_CTL) + CW_CNT + 64 * l + cnt_off;
    const int lane = F.lane, w = F.wave, fr = lane & 15, fq = lane >> 4; const float* n2g = inptr(I_N2G) + l * D;
    float bw[32][3];
#pragma unroll
    for (int ks = 0; ks < 32; ++ks) { const int k = 128 * w + 4 * ks + fq;
        bw[ks][0] = rew[(size_t)k * 32 + fr]; bw[ks][1] = rew[(size_t)k * 32 + 16 + fr]; bw[ks][2] = fr < 4 ? rgw[(size_t)k * 4 + fr] : 0.f; }
    const int ntiles = nrows >> 4;
    u32x2 pv[2][4];
    if (F.vcu < ntiles) {
#pragma unroll
        for (int rr = 0; rr < 2; ++rr)
#pragma unroll
            for (int j = 0; j < 4; ++j) pv[rr][j] = *(const u32x2*)(X + (size_t)(F.vcu * 16 + 2 * w + rr) * D + 4 * lane + 256 * j); }
    for (int gi = F.vcu; gi < ntiles; gi += F.G) {
#pragma unroll
        for (int rr = 0; rr < 2; ++rr) { const int r = 2 * w + rr, row = gi * 16 + r; f32x4 v[4];
#pragma unroll
            for (int j = 0; j < 4; ++j) { float t_[4]; unpack4(pv[rr][j], t_); v[j] = (f32x4){t_[0], t_[1], t_[2], t_[3]}; }
            const int mr = modrow(row);
            norm_mod_row(v, n2g, msc + mr * 1024, msh + mr * 1024, H + (size_t)row * D, lane);
#pragma unroll
            for (int j = 0; j < 4; ++j) *(LAS f32x4*)(hrow + r * HP + 4 * lane + 256 * j) = v[j]; }
        if (gi + F.G < ntiles) {
#pragma unroll
            for (int rr = 0; rr < 2; ++rr)
#pragma unroll
                for (int j = 0; j < 4; ++j) pv[rr][j] = *(const u32x2*)(X + (size_t)((gi + F.G) * 16 + 2 * w + rr) * D + 4 * lane + 256 * j); }
        __syncthreads();
        {   f32x4 acc[3] = {{0.f, 0.f, 0.f, 0.f}, {0.f, 0.f, 0.f, 0.f}, {0.f, 0.f, 0.f, 0.f}};
#pragma unroll
            for (int ks = 0; ks < 32; ++ks) { const float a = hrow[fr * HP + 128 * w + 4 * ks + fq];
#pragma unroll
                for (int nt = 0; nt < 3; ++nt) acc[nt] = __builtin_amdgcn_mfma_f32_16x16x4f32(a, bw[ks][nt], acc[nt], 0, 0, 0); }
#pragma unroll
            for (int nt = 0; nt < 3; ++nt)
#pragma unroll
                for (int reg = 0; reg < 4; ++reg) part[(w * 16 + 4 * fq + reg) * 48 + 16 * nt + fr] = acc[nt][reg]; }
        __syncthreads();
        for (int idx = F.tid; idx < 16 * 36; idx += NTHR) { const int r = idx / 36, n = idx % 36; float s_ = 0.f;
#pragma unroll
            for (int ww = 0; ww < 8; ++ww) s_ += part[(ww * 16 + r) * 48 + n];
            if (n < 32) lgs[r * 40 + 4 + n] = s_ + reb[n]; else lgs[r * 40 + n - 32] = s_ + rgb[n - 32]; }
        __syncthreads();
        if (F.tid < 16) { const int rr = gi * 16 + F.tid; const LAS float* lp = lgs + F.tid * 40;
            int grp = 0; float mx = lp[0];
#pragma unroll
            for (int g = 1; g < 4; ++g) if (lp[g] > mx) { mx = lp[g]; grp = g; }
            float den = 0.f;
#pragma unroll
            for (int g = 0; g < 4; ++g) den += __expf(lp[g] - mx);
            const float pg_top = 1.f / den; const LAS float* sel = lp + 4 + grp * 8;
            int i0 = 0; float l0 = sel[0];
#pragma unroll
            for (int q = 1; q < 8; ++q) if (sel[q] > l0) { l0 = sel[q]; i0 = q; }
            int i1 = -1; float l1 = -3.0e38f;
#pragma unroll
            for (int q = 0; q < 8; ++q) if (q != i0 && sel[q] > l1) { l1 = sel[q]; i1 = q; }
            const float e1 = __expf(l1 - l0); const float w0 = pg_top / (1.f + e1), w1 = pg_top * e1 / (1.f + e1);
            const int ea = grp * 8 + i0, eb = grp * 8 + i1;
            const unsigned pa = atomicAdd((unsigned*)(lcnt + ea), 1u), pb = atomicAdd((unsigned*)(lcnt + eb), 1u);
            rt_e[2 * rr] = ea; rt_e[2 * rr + 1] = eb; rt_pos[2 * rr] = (int)pa; rt_pos[2 * rr + 1] = (int)pb; rt_gate[2 * rr] = w0; rt_gate[2 * rr + 1] = w1; }
    }
    __syncthreads();
    if (F.tid < 32) lcnt[32 + F.tid] = lcnt[F.tid] ? atomicAdd(cnt + F.tid, lcnt[F.tid]) : 0u;
    __syncthreads();
    int* elist = (int*)(ws + WS_ELIST);
    if (F.tid < 16) for (int gi = F.vcu; gi < ntiles; gi += F.G) { const int rr = gi * 16 + F.tid;
        const int ea = rt_e[2 * rr], eb = rt_e[2 * rr + 1]; const int pa = rt_pos[2 * rr] + (int)lcnt[32 + ea], pb = rt_pos[2 * rr + 1] + (int)lcnt[32 + eb];
        rt_pos[2 * rr] = pa; rt_pos[2 * rr + 1] = pb; elist[(size_t)ea * NROW + pa] = rr; elist[(size_t)eb * NROW + pb] = rr; }
}

constexpr int MOE_MAP_OFF = 131072;
__device__ __forceinline__ void moe_map(const Frame& F0, int l) {
    const Frame F = phase_frame(F0); unsigned char* const ws = F.ws;
    LAS int* mp = (LAS int*)(F.lds + MOE_MAP_OFF);
    const unsigned* cnt = (const unsigned*)(ws + WS_CTL) + CW_CNT + 64 * l;
    __syncthreads();
    if (F.tid < NEXP) mp[32 + F.tid] = (int)__hip_atomic_load(cnt + F.tid, __ATOMIC_RELAXED, __HIP_MEMORY_SCOPE_AGENT);
    __syncthreads();
    if (F.tid == 0) { int o = 0;
#pragma nounroll
        for (int e = 0; e < NEXP; ++e) { const int c = mp[32 + e]; const int nt = (c + 255) >> 8; mp[e] = o;
#pragma nounroll
            for (int t = 0; t < nt; ++t) { mp[128 + (o >> 8) + t] = e; mp[320 + (o >> 8) + t] = t; }
            o += nt << 8; }
        mp[64] = o >> 8; }
    __syncthreads();
}

template <bool DRY>
__device__ __forceinline__ void combine_pass(const Frame& F0, int l, int nrows) {
    const Frame F = phase_frame(F0); unsigned char* const ws = F.ws;
    LAS float* mg2 = (LAS float*)F.lds; LAS float* msh = mg2 + 3072; LAS float* msc = msh + 3072;
    const bool last = (l == DEPTH - 1);
    __syncthreads();
    mod_to_lds(F, l, 5, mg2, false); if (!last) { mod_to_lds(F, l + 1, 0, msh, false); mod_to_lds(F, l + 1, 1, msc, false); }
    __syncthreads();
    bf16* X = (bf16*)(ws + WS_X); bf16* H = (bf16*)(ws + WS_H); const bf16* Ys = (const bf16*)(ws + WS_XS);
    const int* rt_e = (const int*)(ws + WS_ROUTE + RT_E); const int* rt_pos = (const int*)(ws + WS_ROUTE + RT_POS); const float* rt_gate = (const float*)(ws + WS_ROUTE + RT_GATE);
    const LAS int* moff = (const LAS int*)(F.lds + MOE_MAP_OFF);
    const int lane = F.lane; const float* n1g = inptr(I_N1G) + (last ? 0 : (l + 1) * D); const float* fgp = inptr(I_FG);
    for (int row0 = F.gw; row0 < nrows; row0 += 2 * F.NGW) {
        int s0[2], s1[2]; float w0[2], w1[2]; bool ok[2]; u32x2 ya[2][4], yb[2][4], xo[2][4];
#pragma unroll
        for (int u = 0; u < 2; ++u) { const int row = row0 + u * F.NGW; ok[u] = row < nrows; if (ok[u]) { s0[u] = moff[rt_e[2 * row]] + rt_pos[2 * row]; s1[u] = moff[rt_e[2 * row + 1]] + rt_pos[2 * row + 1]; w0[u] = rt_gate[2 * row]; w1[u] = rt_gate[2 * row + 1]; } }
#pragma unroll
        for (int u = 0; u < 2; ++u) if (ok[u]) { const int row = row0 + u * F.NGW;
#pragma unroll
            for (int j = 0; j < 4; ++j) { const int c = 4 * lane + 256 * j; ya[u][j] = *(const u32x2*)(Ys + (size_t)s0[u] * D + c); yb[u][j] = *(const u32x2*)(Ys + (size_t)s1[u] * D + c); xo[u][j] = *(const u32x2*)(X + (size_t)row * D + c); } }
#pragma unroll
        for (int u = 0; u < 2; ++u) if (ok[u]) { const int row = row0 + u * F.NGW; const int mr = modrow(row); f32x4 v[4];
#pragma unroll
            for (int j = 0; j < 4; ++j) { const int c = 4 * lane + 256 * j; float a[4], b[4]; unpack4(ya[u][j], a); unpack4(yb[u][j], b);
                const f32x4 g2 = *(const LAS f32x4*)(mg2 + mr * 1024 + c);
                f32x4 y; y.x = w0[u] * a[0] + w1[u] * b[0]; y.y = w0[u] * a[1] + w1[u] * b[1]; y.z = w0[u] * a[2] + w1[u] * b[2]; y.w = w0[u] * a[3] + w1[u] * b[3];
                float x_[4]; unpack4(xo[u][j], x_); v[j] = (f32x4){x_[0], x_[1], x_[2], x_[3]} + g2 * y; }
            if (DRY) { asm volatile("" :: "v"(v[0].x + v[1].y + v[2].z + v[3].w)); }
            else if (!last) {
#pragma unroll
                for (int j = 0; j < 4; ++j) *(u32x2*)(X + (size_t)row * D + 4 * lane + 256 * j) = (u32x2){pk2(v[j].x, v[j].y), pk2(v[j].z, v[j].w)};
                norm_mod_row(v, n1g, msc + mr * 1024, msh + mr * 1024, H + (size_t)row * D, lane);
            } else { float s = 0.f;
#pragma unroll
                for (int j = 0; j < 4; ++j) s += (v[j].x * v[j].x + v[j].y * v[j].y) + (v[j].z * v[j].z + v[j].w * v[j].w);
                const float rs = rsqrtf(wave_sum(s) * (1.f / D) + RMS_EPS);
#pragma unroll
                for (int j = 0; j < 4; ++j) { const int c = 4 * lane + 256 * j; const f32x4 g = *(const f32x4*)(fgp + c); *(f32x4*)(F.out + (size_t)row * D + c) = v[j] * rs * g; } } }
    }
}
__global__ void __launch_bounds__(NTHR, 2) fwd_megakernel(Params prm) {
    extern __shared__ __attribute__((aligned(16))) unsigned char lds_raw[];
    Frame F;
    F.lds = (LAS unsigned char*)lds_raw;
    F.tid = threadIdx.x; F.lane = F.tid & 63; F.wave = __builtin_amdgcn_readfirstlane(F.tid >> 6);
    F.G = gridDim.x; { const int bx = blockIdx.x; F.vcu = (F.G % 8 == 0) ? (bx % 8) * (F.G / 8) + bx / 8 : bx; }
    F.gw = F.vcu * NWAVES + F.wave; F.NGW = F.G * NWAVES;
    F.out = prm.out; F.ws = prm.ws;
    for (int u = F.tid; u < (LDS_BYTES - LDSCTL_OFF) / 4; u += NTHR) ((LAS unsigned*)(F.lds + LDSCTL_OFF))[u] = 0u;
    __syncthreads();
    (void)xcd_barrier_post((unsigned*)(F.ws + WS_CTL) + CW_BAR, (volatile LAS unsigned*)(F.lds + MISC_OFF) + 8);
#define GRID_BAR() do { XcdBarrier bar_; bar_.bar = (unsigned*)(opaque(F.ws) + WS_CTL) + CW_BAR; bar_.x = xb_xcc_id(); bar_.st = (volatile LAS unsigned*)(F.lds + MISC_OFF) + 8; xcd_barrier(bar_); } while (0)

    p0_prologue(F);
#if USE_CG_SYNC
    cg::this_grid().sync();
#else
    GRID_BAR();
#endif
    p0b_norm1(F);
    GRID_BAR();

    for (int l = 0; l < DEPTH; ++l) {
        const bool need_ctx = (l == 0); const int nrows = need_ctx ? NROW : NLAT;
#define WSO Fp.ws
        {
            const Frame Fp = phase_frame(F); unsigned char* const ws = WSO; bf16* Hb = (bf16*)(ws + WS_H); bf16* Pb = (bf16*)(ws + WS_P);
            pg8::Gemm g{Hb, (const bf16*)(ws + WS_WIN_T) + (size_t)l * NP * D, NROW, NP, D}; pg8::StaticOrder S; S.init(NROW, NP, Fp.G, (int)blockIdx.x);
            pg8::EpiStoreBf16 E{Pb, NP, 0xffff};
            pg8::gemm_phase<pg8::EpiStoreBf16, pg8::StaticOrder, true, true>(F.lds, g, S, E);
        }
        GRID_BAR();
        {
            const Frame Fp = phase_frame(F); unsigned char* const ws = WSO; bf16* Pb = (bf16*)(ws + WS_P);
            for (int it = blockIdx.x; it < 256; it += F.G) fftA_item(F, it);
            if (need_ctx) for (int it = (int)blockIdx.x - (F.G >= 64 ? F.G - 32 : 0); it >= 0 && it < 32; it += F.G) { const int b = it >> 4, m0 = (it & 15) * 16;
                const bf16* src0 = Pb + (size_t)(NLAT + b * CTXL) * NP + COL_FC;
                dft64_item<4, 256, 1>(F, l, m0, -1.f, 1.f / 128.f, [=](int t, int ri) { return src0 + (size_t)t * NP + ri * 256; }, [=](int m) { return NLAT + b * CTXL + m; }); }
            shift_pass(F, l);
            conv_pass(F, l, nrows);
        }
        GRID_BAR();
        {
            const Frame Fp = phase_frame(F); unsigned char* const ws = WSO;
            prep_phase(F, l);
        }
        GRID_BAR();
        for (int seg = -1; seg < NSEG; ++seg) {
            const bool split = (F.G == 256);
            if (seg + 1 < NSEG) pre_phase(F, seg + 1, (seg >= 0 && split) ? 128 : 0);
            if (seg + 1 == NSEG && (!split || blockIdx.x >= 128)) { unsigned char* const ws = opaque(F.ws); int bx_ = (int)blockIdx.x; asm volatile("" : "+s"(bx_));
                const int first_ = split ? bx_ - 128 : bx_, stride_ = split ? 128 : F.G;
                for (int it = first_; it < 256; it += stride_) { const int b = it >> 7, t1p = it & 127;
                    const bf16* src0 = (const bf16*)(ws + WS_GT) + (size_t)(b * 128 + t1p) * 64 * 512;
                    dft64_item<1, 64, 4>(F, l, 0, 1.f, 0.0013810679320049757f, [=](int t, int ri) { return src0 + (size_t)t * 512 + ri * 256; }, [=](int m) { return b * SEQ + t1p + 128 * m; }); } }
            if (seg >= 0) for (int it = blockIdx.x; it < 128; it += F.G) { const int x_ = it & 7, j_ = it >> 3;
                seq_item<0>(F, ((x_ + 8 * (j_ >> 2)) << 2) | (j_ & 3), seg, need_ctx); }
            GRID_BAR();
        }
        readout_pass(F, l, nrows);
        GRID_BAR();
        const int cv_lo = (nrows / 256) * 4 > F.G ? (nrows / 256) * 4 - F.G : 0;
        if (blockIdx.x & 1) expert_convert(F, l, cv_lo);
        {
            const Frame Fp = phase_frame(F); unsigned char* const ws = WSO; bf16* Hb = (bf16*)(ws + WS_H);
            pg8::Gemm g{Hb, (const bf16*)(ws + WS_WOUT_T) + (size_t)l * D * D, nrows, D, D}; pg8::StaticOrder S; S.init(nrows, D, Fp.G, (int)blockIdx.x);
            bf16* X = (bf16*)(ws + WS_X); const float* g1p = (const float*)(ws + WS_MODF) + (size_t)l * 3 * 6144 + 2 * 1024;
            if (l == 0) { pg8::EpiResidual<true> E{inptr(I_X), inptr(I_CTX), X, g1p}; pg8::gemm_phase<pg8::EpiResidual<true>, pg8::StaticOrder, true, true>(F.lds, g, S, E); }
            else { pg8::EpiResidual<false> E{X, X + (size_t)NLAT * D, X, g1p}; pg8::gemm_phase<pg8::EpiResidual<false>, pg8::StaticOrder, true, true>(F.lds, g, S, E); }
        }
        if (!(blockIdx.x & 1)) expert_convert(F, l, cv_lo);
        GRID_BAR();
        router_pass(F, l, nrows);
        GRID_BAR();
        {
            const Frame Fp = phase_frame(F); unsigned char* const ws = WSO;
            moe_map(F, l);
            const LAS int* mp = (const LAS int*)(F.lds + MOE_MAP_OFF);
            pg8::MoeOrder S{mp + 128, mp + 320, mp[64], Fp.G, (int)blockIdx.x};
            {   pg8::Gemm g{(const bf16*)(ws + WS_H), (const bf16*)(ws + WS_WGU_T), 0, 0, D, (const int*)(ws + WS_ELIST), NROW - 1};
                pg8::EpiSwiGLU E{(bf16*)(ws + WS_ACT)};
                pg8::gemm_phase<pg8::EpiSwiGLU, pg8::MoeOrder, true, true, true>(F.lds, g, S, E); }
            GRID_BAR();
            {   pg8::Gemm g{(const bf16*)(ws + WS_ACT), (const bf16*)(ws + WS_WD_T), 0, 0, DEXP};
                pg8::EpiStoreBf16 E{(bf16*)(ws + WS_XS), D, 3};
                pg8::gemm_phase<pg8::EpiStoreBf16, pg8::MoeOrder, true, true>(F.lds, g, S, E); }
        }
        GRID_BAR();
        combine_pass<false>(F, l, nrows);
        if (l + 1 < DEPTH) GRID_BAR();
    }
}

extern "C" void kernel_launch(void* const* d_in, const int* in_sizes, int n_in, void* d_out, int out_size, void* d_ws, size_t ws_size, hipStream_t stream) {
    static int grid = 0;
    if (grid == 0) {
        if (n_in != N_IN || in_sizes[0] != NLAT * D || out_size != NLAT * D || ws_size < WS_END) {
            fprintf(stderr, "kernel_launch: unexpected shapes (n_in %d in0 %d out %d ws %zu)\n", n_in, n_in > 0 ? in_sizes[0] : -1, out_size, ws_size); grid = -1; return; }
        int dev = 0, cus = 0, per_cu = 0;
        hipGetDevice(&dev); hipDeviceGetAttribute(&cus, hipDeviceAttributeMultiprocessorCount, dev);
        hipFuncSetAttribute((const void*)fwd_megakernel, hipFuncAttributeMaxDynamicSharedMemorySize, LDS_BYTES);
        hipOccupancyMaxActiveBlocksPerMultiprocessor(&per_cu, (const void*)fwd_megakernel, NTHR, LDS_BYTES);
        if (per_cu < 1) { fprintf(stderr, "kernel_launch: occupancy query says %d blocks per CU\n", per_cu); per_cu = 1; }
        (void)hipGetLastError();
        grid = cus * per_cu;
    }
    if (grid < 0) return;
    hipMemsetAsync((char*)d_ws + WS_CTL, 0, CTL_ZERO_BYTES, stream);
    Params p{};
    for (int i = 0; i < N_IN; ++i) p.in[i] = (const float*)d_in[i];
    p.out = (float*)d_out; p.ws = (unsigned char*)d_ws;
    void* args[] = {&p};
    hipError_t e = hipLaunchCooperativeKernel((const void*)fwd_megakernel, dim3(grid), dim3(NTHR), args, LDS_BYTES, stream);
    if (e != hipSuccess) fprintf(stderr, "kernel_launch: cooperative launch failed: %s (grid %d)\n", hipGetErrorString(e), grid);
}
```

```cpp
#include <hip/hip_runtime.h>
#include <hip/hip_cooperative_groups.h>
#include <cstdio>
#include <cstdint>
namespace cg = cooperative_groups;
#define USE_CG_SYNC 0
#define SEQ_PROBE 0
#define SEQ_PROBE_PRE 0
namespace pg8 {
#define PG8_LAS __attribute__((address_space(3)))
typedef unsigned short bf16_t;
typedef short bf16x8 __attribute__((ext_vector_type(8)));
typedef float f32x4 __attribute__((ext_vector_type(4)));
typedef unsigned u32x4 __attribute__((ext_vector_type(4)));
constexpr int BM = 256, BK = 64, HALF = 128, HTB = HALF * BK * 2  , STAGE_BYTES = 8 * HTB, NXCD = 8, WGM = 8;

__host__ __device__ __forceinline__ int lds_byte(int r, int c) { const int st = (r >> 4) * 2 + (c >> 5), rr = r & 15, cc = c & 31, ob = rr * 64 + cc * 2; return st * 1024 + (ob ^ (((ob >> 9) & 1) << 5)); }
__host__ __device__ __forceinline__ void stage_rc(int b, int& R, int& C) { const int st = b / 1024, sb = b % 1024, swz = sb ^ (((sb >> 9) & 1) << 5); R = (st >> 1) * 16 + swz / 64; C = (st & 1) * 32 + (swz % 64) / 2; }
__host__ __device__ __forceinline__ int perm32(int rho) { const int n = rho >> 4, i = rho & 15; return 8 * (i >> 2) + 4 * n + (i & 3); }

struct Unit { int pm, pn, ga; };
struct Gemm { const bf16_t* A; const bf16_t* Bt; int M, N, K; const int* gidx; int gmax; };

struct StaticOrder {
    int nM, nN, nwg, G, c;
    __host__ __device__ void init(int M, int N, int G_, int c_) { nM = M / BM; nN = N / BM; nwg = nM * nN; G = G_; c = c_; }
    __host__ __device__ bool next(int i, Unit& u) const {
        const long L = (long)i * G + c; if (L >= nwg) return false;
        int wgid = (int)L; { const int q = nwg / NXCD, r = nwg % NXCD, xcd = wgid % NXCD, off = wgid / NXCD; wgid = (xcd < r ? xcd * (q + 1) : r * (q + 1) + (xcd - r) * q) + off; }
        const int nig = WGM * nN, gid = wgid / nig, fm = gid * WGM, gsz = (nM - fm) < WGM ? (nM - fm) : WGM;
        u.pm = fm + ((wgid % nig) % gsz); u.pn = (wgid % nig) / gsz; return true;
    }
    __device__ __forceinline__ void a_ready(const Unit&) const {}
    __device__ __forceinline__ void done(const Unit&) const {}
};

__device__ __forceinline__ unsigned cvt_pk_bf16(float lo, float hi) { unsigned r; asm volatile("v_cvt_pk_bf16_f32 %0, %1, %2" : "=v"(r) : "v"(lo), "v"(hi)); return r; }
typedef float f32x2 __attribute__((ext_vector_type(2)));
template <class Epi, class Sched, bool ALIGN_EPI = false, bool SP2 = false, bool GATHER = false>
__device__ __forceinline__ void gemm_phase(PG8_LAS unsigned char* lds, const Gemm g, const Sched& S, const Epi& E) {
    int tid = threadIdx.x; asm volatile("" : "+v"(tid));
    const int wid = __builtin_amdgcn_readfirstlane(tid >> 6), lane = tid & 63, wr = wid >> 2, wc = wid & 3, fr = lane & 15, fq = lane >> 4;
    const int K = g.K, nt = K / BK;
    unsigned voffA[2], voffB[2];
#pragma unroll
    for (int i = 0; i < 2; ++i) { int R, C; stage_rc(tid * 16 + i * 8192, R, C); const int Rb = Epi::PERM ? ((R & ~31) + perm32(R & 31)) : R;
        voffA[i] = (unsigned)(R * K + C) * 2u; voffB[i] = (unsigned)(Rb * K + C) * 2u; }
    static_assert(!GATHER || SP2, "GATHER is implemented for the SP2 loop");
    unsigned gcur[2][2], gnx[2][2];
#define PG8_GOFF(go, u_) do { _Pragma("unroll") for (int h_ = 0; h_ < 2; ++h_) _Pragma("unroll") for (int i_ = 0; i_ < 2; ++i_) { int R_, C_; stage_rc(tid * 16 + i_ * 8192, R_, C_); \
        int ri_ = g.gidx[(u_).ga + h_ * HALF + R_]; ri_ = ri_ < 0 ? 0 : (ri_ > g.gmax ? g.gmax : ri_); go[h_][i_] = (unsigned)ri_ * (unsigned)(K * 2) + (unsigned)C_ * 2u; } } while (0)
    const size_t kstep = (size_t)(BK * 2);
    const size_t hstep = (size_t)HALF * K * 2;
    const size_t tstep = 2 * hstep;
    const unsigned ldsw = (unsigned)wid * 1024u;
    const int aoff = lds_byte(wr * 64 + fr, fq * 8), boff = lds_byte(wc * 32 + fr, fq * 8);
#define PG8_SA(b, h) (((b) * 2 + (h)) * HTB)
#define PG8_SB(b, h) ((4 + (b) * 2 + (h)) * HTB)
#define PG8_STAGE(bufoff, gbase, voff) do { _Pragma("unroll") for (int _i = 0; _i < 2; ++_i) \
        __builtin_amdgcn_global_load_lds((const unsigned*)((const char*)(gbase) + (voff)[_i]), (PG8_LAS unsigned*)(lds + (bufoff) + ldsw + _i * 8192), 16, 0, 0); } while (0)
#define PG8_LDA(dst, b, h) do { _Pragma("unroll") for (int m = 0; m < 4; ++m) _Pragma("unroll") for (int k = 0; k < 2; ++k) dst[m][k] = *(const PG8_LAS bf16x8*)(lds + PG8_SA(b, h) + aoff + m * 2048 + k * 1024); } while (0)
#define PG8_LDB(dst, b, h) do { _Pragma("unroll") for (int n = 0; n < 2; ++n) _Pragma("unroll") for (int k = 0; k < 2; ++k) dst[n][k] = *(const PG8_LAS bf16x8*)(lds + PG8_SB(b, h) + boff + n * 2048 + k * 1024); } while (0)
#define PG8_MMA(ai, bj, At, Bt) do { __builtin_amdgcn_s_setprio(1); _Pragma("unroll") for (int m = 0; m < 4; ++m) _Pragma("unroll") for (int n = 0; n < 2; ++n) _Pragma("unroll") for (int k = 0; k < 2; ++k) \
        acc[ai][bj][m][n] = __builtin_amdgcn_mfma_f32_16x16x32_bf16(Bt[n][k], At[m][k], acc[ai][bj][m][n], 0, 0, 0); __builtin_amdgcn_s_setprio(0); } while (0)
#define PG8_WAIT_V(n) asm volatile("s_waitcnt vmcnt(" #n ")" ::: "memory")
#define PG8_WAIT_L(n) asm volatile("s_waitcnt lgkmcnt(" #n ")" ::: "memory")
#define PG8_BAR __builtin_amdgcn_s_barrier()
#define PG8_SCHED __builtin_amdgcn_sched_barrier(0)
    Unit cur, nxt; int ui = 0;
    if (!S.next(0, cur)) return;
    f32x4 acc[2][2][4][2];
#pragma unroll
    for (int a = 0; a < 2; ++a)
#pragma unroll
        for (int b = 0; b < 2; ++b)
#pragma unroll
            for (int m = 0; m < 4; ++m)
#pragma unroll
                for (int n = 0; n < 2; ++n) acc[a][b][m][n] = (f32x4){0.f, 0.f, 0.f, 0.f};
    bf16x8 At[4][2], B0[2][2], B1[2][2];
    const char* cA = (const char*)g.A + (size_t)cur.pm * tstep; const char* cB = (const char*)g.Bt + (size_t)cur.pn * tstep;
    S.a_ready(cur);
    const char* gA = (const char*)g.A;
    if constexpr (GATHER) PG8_GOFF(gcur, cur);
    if constexpr (SP2) {
        PG8_STAGE(PG8_SB(0, 0), cB, voffB); PG8_STAGE(PG8_SB(0, 1), cB + hstep, voffB);
        if constexpr (GATHER) { PG8_STAGE(PG8_SA(0, 0), gA, gcur[0]); PG8_STAGE(PG8_SA(0, 1), gA, gcur[1]); } else { PG8_STAGE(PG8_SA(0, 0), cA, voffA); PG8_STAGE(PG8_SA(0, 1), cA + hstep, voffA); }
        if (wr == 1) PG8_BAR;
        PG8_WAIT_V(2); PG8_BAR;
        PG8_STAGE(PG8_SB(1, 0), cB + kstep, voffB); if constexpr (GATHER) PG8_STAGE(PG8_SA(1, 0), gA + kstep, gcur[0]); else PG8_STAGE(PG8_SA(1, 0), cA + kstep, voffA); PG8_STAGE(PG8_SB(1, 1), cB + hstep + kstep, voffB);
        PG8_WAIT_V(6); PG8_BAR;
    } else {
        PG8_STAGE(PG8_SB(0, 0), cB, voffB); PG8_STAGE(PG8_SA(0, 0), cA, voffA); PG8_STAGE(PG8_SB(0, 1), cB + hstep, voffB); PG8_STAGE(PG8_SA(0, 1), cA + hstep, voffA);
        if (wr == 1) PG8_BAR;
        PG8_WAIT_V(4); PG8_BAR;
        PG8_STAGE(PG8_SB(1, 0), cB + kstep, voffB); PG8_STAGE(PG8_SA(1, 0), cA + kstep, voffA); PG8_STAGE(PG8_SB(1, 1), cB + hstep + kstep, voffB);
        PG8_WAIT_V(6); PG8_BAR;
    }
    for (;;) {
        const bool has_next = S.next(ui + 1, nxt);
        if constexpr (GATHER) { if (has_next) PG8_GOFF(gnx, nxt); else { gnx[0][0] = gcur[0][0]; gnx[0][1] = gcur[0][1]; gnx[1][0] = gcur[1][0]; gnx[1][1] = gcur[1][1]; } }
        const char* nA = has_next ? (const char*)g.A + (size_t)nxt.pm * tstep : cA; const char* nB = has_next ? (const char*)g.Bt + (size_t)nxt.pn * tstep : cB;
        for (int t = 0; t < nt; t += 2) {
            const bool last = (t == nt - 2);
            const char* a1 = cA + (size_t)(t + 1) * kstep;
            const char* a2 = last ? nA : cA + (size_t)(t + 2) * kstep; const char* b2 = last ? nB : cB + (size_t)(t + 2) * kstep;
            const char* a3 = a2 + kstep; const char* b3 = b2 + kstep;
            if (last && has_next) S.a_ready(nxt);
            unsigned ga0[2], ga1[2]; const char* g1 = gA; const char* g2 = gA; const char* g3 = gA;
            if constexpr (GATHER) { g1 = gA + (size_t)(t + 1) * kstep; g2 = last ? gA : gA + (size_t)(t + 2) * kstep; g3 = g2 + kstep;
                ga0[0] = last ? gnx[0][0] : gcur[0][0]; ga0[1] = last ? gnx[0][1] : gcur[0][1]; ga1[0] = last ? gnx[1][0] : gcur[1][0]; ga1[1] = last ? gnx[1][1] : gcur[1][1]; }
            if constexpr (SP2) {
            PG8_LDB(B0, 0, 0); PG8_LDB(B1, 0, 1); PG8_SCHED; PG8_LDA(At, 0, 0); if constexpr (GATHER) PG8_STAGE(PG8_SA(1, 1), g1, gcur[1]); else PG8_STAGE(PG8_SA(1, 1), a1 + hstep, voffA);
            PG8_WAIT_V(8); PG8_WAIT_L(0); PG8_BAR; PG8_MMA(0, 0, At, B0); PG8_MMA(0, 1, At, B1); PG8_BAR; PG8_SCHED;
            PG8_LDA(At, 0, 1); PG8_STAGE(PG8_SB(0, 0), b2, voffB); PG8_STAGE(PG8_SB(0, 1), b2 + hstep, voffB); if constexpr (GATHER) PG8_STAGE(PG8_SA(0, 0), g2, ga0); else PG8_STAGE(PG8_SA(0, 0), a2, voffA);
            PG8_WAIT_V(8); PG8_WAIT_L(0); PG8_BAR; PG8_MMA(1, 0, At, B0); PG8_MMA(1, 1, At, B1); PG8_BAR; PG8_SCHED;
            PG8_LDB(B0, 1, 0); PG8_LDB(B1, 1, 1); PG8_SCHED; PG8_LDA(At, 1, 0); if constexpr (GATHER) PG8_STAGE(PG8_SA(0, 1), g2, ga1); else PG8_STAGE(PG8_SA(0, 1), a2 + hstep, voffA);
            PG8_WAIT_V(8); PG8_WAIT_L(0); PG8_BAR; PG8_MMA(0, 0, At, B0); PG8_MMA(0, 1, At, B1); PG8_BAR; PG8_SCHED;
            PG8_LDA(At, 1, 1); PG8_STAGE(PG8_SB(1, 0), b3, voffB); PG8_STAGE(PG8_SB(1, 1), b3 + hstep, voffB); if constexpr (GATHER) PG8_STAGE(PG8_SA(1, 0), g3, ga0); else PG8_STAGE(PG8_SA(1, 0), a3, voffA);
            PG8_WAIT_V(8); PG8_WAIT_L(0); PG8_BAR; PG8_MMA(1, 0, At, B0); PG8_MMA(1, 1, At, B1); PG8_BAR; PG8_SCHED;
            } else {
            PG8_LDB(B0, 0, 0); PG8_SCHED; PG8_LDA(At, 0, 0); PG8_STAGE(PG8_SA(1, 1), a1 + hstep, voffA);
            PG8_WAIT_L(8); PG8_BAR; PG8_WAIT_L(0); PG8_MMA(0, 0, At, B0); PG8_BAR; PG8_SCHED;
            PG8_LDB(B1, 0, 1); PG8_STAGE(PG8_SB(0, 0), b2, voffB);
            PG8_BAR; PG8_WAIT_L(0); PG8_MMA(0, 1, At, B1); PG8_BAR;
            PG8_LDA(At, 0, 1); PG8_STAGE(PG8_SA(0, 0), a2, voffA);
            PG8_BAR; PG8_WAIT_L(0); PG8_MMA(1, 0, At, B0); PG8_BAR; PG8_SCHED;
            PG8_STAGE(PG8_SB(0, 1), b2 + hstep, voffB);
            PG8_WAIT_V(6); PG8_BAR; PG8_MMA(1, 1, At, B1); PG8_BAR;
            PG8_LDB(B0, 1, 0); PG8_SCHED; PG8_LDA(At, 1, 0); PG8_STAGE(PG8_SA(0, 1), a2 + hstep, voffA);
            PG8_WAIT_L(8); PG8_BAR; PG8_WAIT_L(0); PG8_MMA(0, 0, At, B0); PG8_BAR; PG8_SCHED;
            PG8_LDB(B1, 1, 1); PG8_STAGE(PG8_SB(1, 0), b3, voffB);
            PG8_BAR; PG8_WAIT_L(0); PG8_MMA(0, 1, At, B1); PG8_BAR;
            PG8_LDA(At, 1, 1); PG8_STAGE(PG8_SA(1, 0), a3, voffA);
            PG8_BAR; PG8_WAIT_L(0); PG8_MMA(1, 0, At, B0); PG8_BAR; PG8_SCHED;
            PG8_STAGE(PG8_SB(1, 1), b3 + hstep, voffB);
            PG8_WAIT_V(6); PG8_BAR; PG8_MMA(1, 1, At, B1); PG8_BAR;
            }
        }
        if constexpr (ALIGN_EPI) { if (wr == 0) PG8_BAR; }
        if constexpr (!Epi::AFTER_DRAIN) { E(acc, cur, wr, wc, fr, fq); S.done(cur); }
        if (!has_next) break;
#pragma unroll
        for (int a = 0; a < 2; ++a)
#pragma unroll
            for (int b = 0; b < 2; ++b)
#pragma unroll
                for (int m = 0; m < 4; ++m)
#pragma unroll
                    for (int n = 0; n < 2; ++n) acc[a][b][m][n] = (f32x4){0.f, 0.f, 0.f, 0.f};
        cur = nxt; cA = nA; cB = nB; ++ui;
        if constexpr (GATHER) { gcur[0][0] = gnx[0][0]; gcur[0][1] = gnx[0][1]; gcur[1][0] = gnx[1][0]; gcur[1][1] = gnx[1][1]; }
        if constexpr (ALIGN_EPI) { if (wr == 1) PG8_BAR; }
    }
    PG8_WAIT_V(0);
    if constexpr (!ALIGN_EPI) { if (wr == 0) PG8_BAR; }
    PG8_BAR;
    if constexpr (Epi::AFTER_DRAIN) { E.fused(acc, cur, wr, wc, fr, fq, lds, wid, lane); S.done(cur); }
#undef PG8_GOFF
#undef PG8_SA
#undef PG8_SB
#undef PG8_STAGE
#undef PG8_LDA
#undef PG8_LDB
#undef PG8_MMA
#undef PG8_WAIT_V
#undef PG8_WAIT_L
#undef PG8_BAR
#undef PG8_SCHED
}
}
#define LAS __attribute__((address_space(3)))
typedef unsigned short bf16;
typedef float f32x4 __attribute__((ext_vector_type(4)));
typedef short bf16x8 __attribute__((ext_vector_type(8)));
typedef unsigned u32x4 __attribute__((ext_vector_type(4)));
typedef unsigned u32x2 __attribute__((ext_vector_type(2)));

constexpr int D = 1024, NBATCH = 2, SEQ = 8192, CTXL = 256, DEPTH = 2;
constexpr int NLAT = NBATCH * SEQ, NCTX = NBATCH * CTXL, NROW = NLAT + NCTX;
constexpr int DR = 512, DIN = 2944, NP = 3328, ZW = 1920, NHEAD = 8;
constexpr int COL_CONV = 1920, COL_FC = 2688, COL_FS = 2944;
constexpr int STRW = 5120;
constexpr int NEXP = 32, DEXP = 512;
constexpr int MOE_MAXTILES = 168;
constexpr float RMS_EPS = 1e-6f, GN_EPS = 64e-5f;

enum { I_X = 0, I_C, I_CTX, I_CCTX, I_ADAW, I_ADAB, I_N1G, I_N2G, I_WIN, I_MU, I_DW0, I_DW2, I_IA0, I_IA2, I_GG2, I_KK, I_KA, I_RK, I_GNW, I_GNB,
       I_CONVW, I_CONVG, I_FOURG, I_WOUT, I_RGW, I_RGB, I_REW, I_REB, I_EG, I_EU, I_ED, I_FG, N_IN };

constexpr size_t MiB = 1u << 20;
constexpr size_t WS_CTL = 0, CTL_ZERO_BYTES = 64 * 1024;
constexpr size_t WS_MODP = 1 * MiB;
constexpr size_t WS_MODF = 1 * MiB + 1280 * 1024;
constexpr size_t WS_WIN_T = 3 * MiB;
constexpr size_t WS_WOUT_T = 16 * MiB;
constexpr size_t WS_WGU_T = 20 * MiB;
constexpr size_t WS_WD_T = 84 * MiB;
constexpr size_t WS_X = 116 * MiB;
constexpr size_t WS_H = 182 * MiB;
constexpr size_t WS_ZS = 215 * MiB;
constexpr size_t WS_P = 277 * MiB;
constexpr size_t WS_STR = 277 * MiB;
constexpr size_t WS_Y = 442 * MiB;
constexpr size_t WS_GT = 475 * MiB;
constexpr size_t WS_ROUTE = 491 * MiB;
constexpr size_t WS_XS = 215 * MiB;
constexpr size_t WS_ACT = 299 * MiB;
constexpr size_t WS_ELIST = 340 * MiB;
constexpr size_t WS_END = 530 * MiB;
constexpr size_t RT_E = 0, RT_POS = 1 * 33792 * 4, RT_GATE = 2 * 33792 * 4, RT_SLOT = 3 * 33792 * 4, RT_TILE = 4 * 33792 * 4, RT_NT = RT_TILE + 1024;

constexpr int CW_BAR = 4096;
constexpr int CW_CNT = 8192;

constexpr int NWAVES = 8, NTHR = 512;
constexpr int RING_BYTES = 131072, LDSCTL_OFF = 143360, MISC_OFF = LDSCTL_OFF + 320, LDS_BYTES = 147456;

struct Params { const float* in[N_IN]; float* out; unsigned char* ws; };

__device__ __forceinline__ float bf2f(unsigned h) { return __uint_as_float(h << 16); }
typedef __bf16 hwbf2 __attribute__((ext_vector_type(2)));
typedef float f32x2 __attribute__((ext_vector_type(2)));
__device__ __forceinline__ unsigned pk2(float lo, float hi) { const f32x2 x = {lo, hi}; const hwbf2 r = __builtin_convertvector(x, hwbf2); return __builtin_bit_cast(unsigned, r); }
__device__ __forceinline__ unsigned f2bf(float f) { return pk2(f, 0.f) & 0xffffu; }
__device__ __forceinline__ float wave_sum(float v) {
#pragma unroll
    for (int o = 1; o < 64; o <<= 1) v += __shfl_xor(v, o);
    return v;
}
__device__ __forceinline__ float sigmoidf_(float x) { return 1.f / (1.f + __expf(-x)); }
#define LDS_WAIT() asm volatile("s_waitcnt lgkmcnt(0)" ::: "memory")
#define VM_WAIT() asm volatile("s_waitcnt vmcnt(0)" ::: "memory")

struct Frame {
    LAS unsigned char* lds;
    int tid, lane, wave, vcu, G, gw, NGW;
    float* out; unsigned char* ws;
};
#if defined(__HIP_DEVICE_COMPILE__)
#define ASSUME_GLOBAL(p) do { __builtin_assume(!__builtin_amdgcn_is_shared(p)); __builtin_assume(!__builtin_amdgcn_is_private(p)); } while (0)
#else
#define ASSUME_GLOBAL(p) do { } while (0)
#endif
__device__ __forceinline__ const float* inptr(int i) {
    const volatile unsigned long long __attribute__((address_space(4)))* ka = (const volatile unsigned long long __attribute__((address_space(4)))*)__builtin_amdgcn_kernarg_segment_ptr();
    return (const float*)(const __attribute__((address_space(1))) float*)ka[i];
}
__device__ __forceinline__ unsigned char* opaque(unsigned char* p) { unsigned long z = 0; asm volatile("" : "+s"(z)); return p + z; }
__device__ __forceinline__ Frame phase_frame(const Frame& F0) { Frame F = F0; asm volatile("" : "+v"(F.tid)); F.lane = F.tid & 63; F.ws = opaque(F0.ws);
    asm volatile("" : "+s"(F.G), "+s"(F.vcu)); F.gw = F.vcu * NWAVES + F.wave; F.NGW = F.G * NWAVES; return F; }
__device__ __forceinline__ int modrow(int row) { return row < NLAT ? (row >> 13) : 2; }
#define XB_TMO      128
#define XB_XCNT(j)  (256  + 64 * (j))
#define XB_XSUB(j)  (1280 + 64 * (j))
#define XB_XGEN(j)  (2304 + 64 * (j))
#define XB_TOP      3328
#define XB_TOPGEN   3392
#define XCD_BAR_WORDS 3456
#define XB_SPIN_CAP (1u << 18)

__device__ __forceinline__ unsigned xb_ld(unsigned* p)              { return __hip_atomic_load(p, __ATOMIC_RELAXED, __HIP_MEMORY_SCOPE_AGENT); }
__device__ __forceinline__ unsigned xb_add(unsigned* p, unsigned v) { return __hip_atomic_fetch_add(p, v, __ATOMIC_RELAXED, __HIP_MEMORY_SCOPE_AGENT); }
__device__ __forceinline__ unsigned xb_xcc_id() { return (unsigned)__builtin_amdgcn_s_getreg((3 << 11) | 20) & 0xFu; }
#define XB_SPIN(cond, bar) do { unsigned _sp = 0; while (cond) { __builtin_amdgcn_s_sleep(1); \
    if ((++_sp & 255u) == 0u) { if (xb_ld(&(bar)[XB_TMO])) break; if (_sp > XB_SPIN_CAP) { atomicAdd(&(bar)[XB_TMO], 1u); break; } } } } while (0)

struct XcdBarrier {
    unsigned* bar; unsigned x;
    volatile LAS unsigned* st;
};

__device__ __forceinline__ XcdBarrier xcd_barrier_post(unsigned* bar, volatile LAS unsigned* st) {
    XcdBarrier b; b.bar = bar; b.x = xb_xcc_id(); b.st = st;
    if (threadIdx.x == 0) (void)xb_add(&bar[XB_XCNT(b.x)], 1u);
    return b;
}
__device__ __forceinline__ void xcd_barrier_complete(unsigned* bar, unsigned x, unsigned& nloc, unsigned& nx) {
    const unsigned G = gridDim.x * gridDim.y * gridDim.z;
    unsigned sum, cnt, mine, sp = 0u;
    for (;;) {
        sum = 0u; cnt = 0u; mine = 0u;
#pragma nounroll
        for (unsigned j = 0; j < 16; ++j) { const unsigned c = xb_ld(&bar[XB_XCNT(j)]); sum += c; cnt += (c > 0u) ? 1u : 0u; mine = (j == x) ? c : mine; }
        if (sum == G) break;
        __builtin_amdgcn_s_sleep(1);
        if ((++sp & 255u) == 0u) { if (xb_ld(&bar[XB_TMO])) break; if (sp > XB_SPIN_CAP) { atomicAdd(&bar[XB_TMO], 1u); break; } }
    }
    nloc = mine > 0u ? mine : 1u; nx = cnt > 0u ? cnt : 1u;
}

__device__ __forceinline__ void xcd_barrier(const XcdBarrier& b) {
    asm volatile("s_waitcnt vmcnt(0)" ::: "memory");
    __syncthreads();
    if (threadIdx.x == 0) {
        unsigned* bar = b.bar;
        asm volatile("" : "+s"(bar));
        __builtin_amdgcn_s_waitcnt(0);
        unsigned nloc = b.st[0], nx = b.st[1];
        if (nloc == 0u) { xcd_barrier_complete(bar, b.x, nloc, nx); b.st[0] = nloc; b.st[1] = nx; }
        const unsigned old = xb_add(&bar[XB_XSUB(b.x)], 1u);
        const unsigned gen = old / nloc;
        if (old + 1u == (gen + 1u) * nloc) {
            __builtin_amdgcn_fence(__ATOMIC_RELEASE, "agent");
            asm volatile("s_waitcnt vmcnt(0)" ::: "memory");
            const unsigned og = xb_add(&bar[XB_TOP], 1u);
            const unsigned tg = og / nx;
            if (og + 1u == (tg + 1u) * nx) xb_add(&bar[XB_TOPGEN], 1u);
            else XB_SPIN(xb_ld(&bar[XB_TOPGEN]) == tg, bar);
            __builtin_amdgcn_fence(__ATOMIC_ACQUIRE, "agent");
            xb_add(&bar[XB_XGEN(b.x)], 1u);
            asm volatile("s_waitcnt vmcnt(0)" ::: "memory");
        } else {
            XB_SPIN(xb_ld(&bar[XB_XGEN(b.x)]) == gen, bar);
            __builtin_amdgcn_fence(__ATOMIC_ACQUIRE, "agent");
            asm volatile("s_waitcnt vmcnt(0)" ::: "memory");
        }
    }
    __syncthreads();
}
template <class RowMap>
__device__ __forceinline__ void transpose_item(const float* W, int ldw, int k0, int n0, bf16* WT, int ldt, RowMap rm, LAS float* scr, int lane) {
    (void)scr;
    const int nq = lane & 7, kg = lane >> 3; const float* src = W + (size_t)(k0 + 8 * kg) * ldw + n0 + 4 * nq;
    f32x4 v[8];
#pragma unroll
    for (int i = 0; i < 8; ++i) v[i] = *(const f32x4*)(src + (size_t)i * ldw);
#pragma unroll
    for (int j = 0; j < 4; ++j) { u32x4 o = {pk2(v[0][j], v[1][j]), pk2(v[2][j], v[3][j]), pk2(v[4][j], v[5][j]), pk2(v[6][j], v[7][j])};
        *(u32x4*)(WT + (size_t)rm(n0 + 4 * nq + j) * ldt + k0 + 8 * kg) = o; }
}
struct RmId { int off; __device__ __forceinline__ int operator()(int n) const { return off + n; } };
struct RmGU { int off; __device__ __forceinline__ int operator()(int n) const { return off + ((n >> 2) << 3) + (n & 3); } };

__device__ __forceinline__ void p0_prologue(const Frame& F0) {
    const Frame F = phase_frame(F0); unsigned char* const ws = F.ws;
    LAS float* scr = (LAS float*)(F.lds + F.wave * 16384);
    LAS float* ctab = (LAS float*)(F.lds + 8 * 16384);
    if (F.tid < 64) ctab[F.tid] = cosf((float)F.tid * (6.283185307179586f / 64.f));
    __syncthreads();
    bf16* win_t = (bf16*)(ws + WS_WIN_T); bf16* wout_t = (bf16*)(ws + WS_WOUT_T);
    constexpr int I_WIN_L = 16 * 84, I_WOUT_L = 16 * 32, I_FOLD_L = 4 * 64, I_MOD_L = 96 * 8;
    constexpr int NIT = 2 * (I_WIN_L + I_WOUT_L + I_FOLD_L + I_MOD_L);
    const float* p_win = inptr(I_WIN); const float* p_wout = inptr(I_WOUT); const float* p_c = inptr(I_C); const float* p_cctx = inptr(I_CCTX); const float* p_adaw = inptr(I_ADAW);
    {
        bf16* wl = (bf16*)(ws + 64 * 1024); const float* dw2 = inptr(I_DW2); const float* ia2 = inptr(I_IA2); const float* gg2 = inptr(I_GG2);
        for (int idx = F.vcu * NTHR + F.tid; idx < 2 * 384 * 512; idx += F.G * NTHR) { const int c = idx & 511, k = (idx >> 9) % 384, l = idx / (384 * 512);
            float v;
            if (k < 128) v = dw2[((size_t)(l * 2 + (k >> 6)) * 64 + (k & 63)) * DR + c];
            else if (k < 256) v = ia2[((size_t)(l * 2 + ((k - 128) >> 6)) * 64 + (k & 63)) * DR + c];
            else v = gg2[((size_t)l * 128 + (k - 256)) * DR + c];
            wl[((size_t)l * 512 + c) * 384 + k] = (bf16)f2bf(v); } }
    for (int it = F.gw; it < NIT; it += F.NGW) {
        int r = it; const int l = r & 1; r >>= 1;
        if (r < I_WIN_L) { const int kb = r / 84, nb = r % 84;
            transpose_item(p_win + (size_t)l * D * DIN, DIN, kb * 64, nb * 32, win_t + (size_t)l * NP * D, D, RmId{0}, scr, F.lane); continue; }
        r -= I_WIN_L;
        if (r < I_WOUT_L) { const int kb = r / 32, nb = r % 32;
            transpose_item(p_wout + (size_t)l * D * D, D, kb * 64, nb * 32, wout_t + (size_t)l * D * D, D, RmId{0}, scr, F.lane); continue; }
        r -= I_WOUT_L;
        if (r < I_FOLD_L) {
            const int g = r >> 6, k0 = (r & 63) * 16; const float* W = p_win + (size_t)l * D * DIN;
#pragma unroll
            for (int kk = 0; kk < 16; ++kk) scr[kk * 64 + F.lane] = W[(size_t)(k0 + kk) * DIN + 2688 + g * 64 + F.lane];
            LDS_WAIT(); asm volatile("" ::: "memory");
            float ac[16], as[16];
#pragma unroll
            for (int kk = 0; kk < 16; ++kk) { ac[kk] = 0.f; as[kk] = 0.f; }
            for (int c = 0; c < 64; ++c) { const int idx = (c * F.lane) & 63; const float cc = ctab[idx], ss = ctab[(idx - 16) & 63];
#pragma unroll
                for (int kk = 0; kk < 16; ++kk) { const float w = scr[kk * 64 + c]; ac[kk] += w * cc; as[kk] += w * ss; } }
            bf16* oc = win_t + (size_t)l * NP * D + (size_t)(COL_FC + g * 64 + F.lane) * D + k0;
            bf16* os = win_t + (size_t)l * NP * D + (size_t)(COL_FS + g * 64 + F.lane) * D + k0;
            u32x4 a, b;
            a.x = pk2(ac[0], ac[1]); a.y = pk2(ac[2], ac[3]); a.z = pk2(ac[4], ac[5]); a.w = pk2(ac[6], ac[7]);
            b.x = pk2(ac[8], ac[9]); b.y = pk2(ac[10], ac[11]); b.z = pk2(ac[12], ac[13]); b.w = pk2(ac[14], ac[15]);
            *(u32x4*)oc = a; *(u32x4*)(oc + 8) = b;
            a.x = pk2(as[0], as[1]); a.y = pk2(as[2], as[3]); a.z = pk2(as[4], as[5]); a.w = pk2(as[6], as[7]);
            b.x = pk2(as[8], as[9]); b.y = pk2(as[10], as[11]); b.z = pk2(as[12], as[13]); b.w = pk2(as[14], as[15]);
            *(u32x4*)os = a; *(u32x4*)(os + 8) = b;
            LDS_WAIT(); asm volatile("" ::: "memory");
            continue; }
        r -= I_FOLD_L;
        {
            const int cb = r >> 3, ks = r & 7;
#pragma unroll
            for (int q = 0; q < 2; ++q) { const int k = ks * 128 + q * 64 + F.lane;
                const float c0 = p_c[k], c1 = p_c[D + k], c2 = p_cctx[k];
                scr[0 * 128 + q * 64 + F.lane] = c0 * sigmoidf_(c0); scr[1 * 128 + q * 64 + F.lane] = c1 * sigmoidf_(c1); scr[2 * 128 + q * 64 + F.lane] = c2 * sigmoidf_(c2); }
            LDS_WAIT(); asm volatile("" ::: "memory");
            const float* W = p_adaw + (size_t)l * D * 6144 + (size_t)(ks * 128) * 6144 + cb * 64 + F.lane;
            float a0 = 0.f, a1 = 0.f, a2 = 0.f;
#pragma unroll 8
            for (int kk = 0; kk < 128; ++kk) { const float w = W[(size_t)kk * 6144]; a0 += scr[kk] * w; a1 += scr[128 + kk] * w; a2 += scr[256 + kk] * w; }
            float* mp = (float*)(ws + WS_MODP) + (size_t)((l * 8 + ks) * 3) * 6144 + cb * 64 + F.lane;
            mp[0] = a0; mp[6144] = a1; mp[2 * 6144] = a2;
            LDS_WAIT(); asm volatile("" ::: "memory");
        }
    }
}

__device__ __forceinline__ void mod_to_lds(const Frame& F0, int l, int p, LAS float* dst, bool from_partials) {
    const Frame F = phase_frame(F0); unsigned char* const ws = F.ws;
    const float* adab = inptr(I_ADAB);
    for (int idx = F.tid; idx < 3 * 1024; idx += NTHR) { const int r = idx >> 10, n = idx & 1023;
        float v;
        if (from_partials) { v = adab[l * 6144 + p * 1024 + n]; const float* mp = (const float*)(ws + WS_MODP) + (size_t)(l * 8 * 3 + r) * 6144 + p * 1024 + n;
#pragma unroll
            for (int ks = 0; ks < 8; ++ks) v += mp[(size_t)ks * 3 * 6144]; }
        else v = ((const float*)(ws + WS_MODF))[(size_t)(l * 3 + r) * 6144 + p * 1024 + n];
        dst[idx] = v; }
}
__device__ __forceinline__ void mod_finalize(const Frame& F0) {
    const Frame F = phase_frame(F0); unsigned char* const ws = F.ws;
    const float* adab = inptr(I_ADAB);
    for (int idx = F.vcu * NTHR + F.tid; idx < 2 * 3 * 6144; idx += F.G * NTHR) { const int l = idx / (3 * 6144), rem = idx % (3 * 6144), r = rem / 6144, n = rem % 6144;
        float v = adab[l * 6144 + n]; const float* mp = (const float*)(ws + WS_MODP) + (size_t)(l * 8 * 3 + r) * 6144 + n;
#pragma unroll
        for (int ks = 0; ks < 8; ++ks) v += mp[(size_t)ks * 3 * 6144];
        ((float*)(ws + WS_MODF))[idx] = v; }
}


__device__ __forceinline__ void norm_mod_row(f32x4 (&v)[4], const float* gain, const LAS float* sc, const LAS float* sh, bf16* orow, int lane) {
    float s = 0.f;
#pragma unroll
    for (int j = 0; j < 4; ++j) s += (v[j].x * v[j].x + v[j].y * v[j].y) + (v[j].z * v[j].z + v[j].w * v[j].w);
    const float rs = rsqrtf(wave_sum(s) * (1.f / D) + RMS_EPS);
#pragma unroll
    for (int j = 0; j < 4; ++j) { const int c = 4 * lane + 256 * j; const f32x4 g = *(const f32x4*)(gain + c); const f32x4 a = *(const LAS f32x4*)(sc + c), b = *(const LAS f32x4*)(sh + c);
        v[j] = (v[j] * rs) * g * (a + 1.f) + b;
        u32x2 w; w.x = pk2(v[j].x, v[j].y); w.y = pk2(v[j].z, v[j].w); *(u32x2*)(orow + c) = w; }
}

__device__ __forceinline__ void p0b_norm1(const Frame& F0) {
    const Frame F = phase_frame(F0); unsigned char* const ws = F.ws;
    LAS float* msh = (LAS float*)F.lds; LAS float* msc = msh + 3072;
    mod_to_lds(F, 0, 0, msh, true); mod_to_lds(F, 0, 1, msc, true); __syncthreads();
    mod_finalize(F);
    bf16* H = (bf16*)(ws + WS_H); const float* xin = inptr(I_X); const float* cin = inptr(I_CTX); const float* n1g = inptr(I_N1G);
    for (int row0 = F.gw; row0 < NROW; row0 += 2 * F.NGW) { f32x4 v[2][4]; bool ok[2];
#pragma unroll
        for (int u = 0; u < 2; ++u) { const int row = row0 + u * F.NGW; ok[u] = row < NROW; if (ok[u]) { const float* xr = row < NLAT ? xin + (size_t)row * D : cin + (size_t)(row - NLAT) * D;
#pragma unroll
            for (int j = 0; j < 4; ++j) v[u][j] = *(const f32x4*)(xr + 4 * F.lane + 256 * j); } }
#pragma unroll
        for (int u = 0; u < 2; ++u) if (ok[u]) { const int row = row0 + u * F.NGW; const int mr = modrow(row);
            norm_mod_row(v[u], n1g, msc + mr * 1024, msh + mr * 1024, H + (size_t)row * D, F.lane); } }
}
__device__ __forceinline__ void unpack8(const u32x4 w, float (&o)[8]) {
    o[0] = bf2f(w.x & 0xffffu); o[1] = bf2f(w.x >> 16); o[2] = bf2f(w.y & 0xffffu); o[3] = bf2f(w.y >> 16);
    o[4] = bf2f(w.z & 0xffffu); o[5] = bf2f(w.z >> 16); o[6] = bf2f(w.w & 0xffffu); o[7] = bf2f(w.w >> 16);
}
__device__ __forceinline__ void unpack4(const u32x2 w, float (&o)[4]) { o[0] = bf2f(w.x & 0xffffu); o[1] = bf2f(w.x >> 16); o[2] = bf2f(w.y & 0xffffu); o[3] = bf2f(w.y >> 16); }

__device__ __forceinline__ void shift_pass(const Frame& F0, int l) {
    const Frame F = phase_frame(F0); unsigned char* const ws = F.ws;
    const bf16* P = (const bf16*)(ws + WS_P); bf16* Zs = (bf16*)(ws + WS_ZS); const float* mu = inptr(I_MU) + l * ZW;
    const int total = NROW * 240;
    for (int idx = F.vcu * NTHR + F.tid; idx < total; idx += F.G * NTHR) {
        const int row = idx / 240, ck = idx % 240; const bf16* pr = P + (size_t)row * NP + ck * 8;
        const u32x4 zero = {0u, 0u, 0u, 0u};
        float z[8], n0[8], n1[8], n2[8], n3[8], o[8];
        unpack8(*(const u32x4*)pr, z);
        if (row < NLAT) { const int t = row & (SEQ - 1), gr = t >> 6, gc = t & 63;
            unpack8(gc > 0 ? *(const u32x4*)(pr - NP) : zero, n0); unpack8(gc < 63 ? *(const u32x4*)(pr + NP) : zero, n1);
            unpack8(gr > 0 ? *(const u32x4*)(pr - 64 * NP) : zero, n2); unpack8(gr < 127 ? *(const u32x4*)(pr + 64 * NP) : zero, n3);
        } else { const int tc = (row - NLAT) & (CTXL - 1);
            unpack8(tc > 0 ? *(const u32x4*)(pr - NP) : zero, n0); unpack8(tc < CTXL - 1 ? *(const u32x4*)(pr + NP) : zero, n1);
#pragma unroll
            for (int j = 0; j < 8; ++j) { n2[j] = n0[j]; n3[j] = n1[j]; }
        }
        const f32x4 m0 = *(const f32x4*)(mu + ck * 8), m1 = *(const f32x4*)(mu + ck * 8 + 4);
        const float m[8] = {m0.x, m0.y, m0.z, m0.w, m1.x, m1.y, m1.z, m1.w};
#pragma unroll
        for (int j = 0; j < 8; ++j) { const float nb = (j & 3) == 0 ? n0[j] : (j & 3) == 1 ? n1[j] : (j & 3) == 2 ? n2[j] : n3[j]; o[j] = z[j] + (nb - z[j]) * m[j]; }
        u32x4 w; w.x = pk2(o[0], o[1]); w.y = pk2(o[2], o[3]); w.z = pk2(o[4], o[5]); w.w = pk2(o[6], o[7]);
        *(u32x4*)(Zs + (size_t)row * ZW + ck * 8) = w;
    }
}

__device__ __forceinline__ void conv_pass(const Frame& F0, int l, int nrows) {
    const Frame F = phase_frame(F0); unsigned char* const ws = F.ws;
    const bf16* P = (const bf16*)(ws + WS_P); bf16* MA = (bf16*)(ws + WS_H);
    const float* cw = inptr(I_CONVW) + l * 3 * 256; const int c = 4 * F.lane;
    const f32x4 w0 = *(const f32x4*)(cw + c), w1 = *(const f32x4*)(cw + 256 + c), w2 = *(const f32x4*)(cw + 512 + c), gn = *(const f32x4*)(inptr(I_CONVG) + l * 256 + c);
    for (int row0 = F.gw; row0 < nrows; row0 += 2 * F.NGW) {
        u32x2 q[2][7]; bool ok[2]; const u32x2 zero = {0u, 0u};
#pragma unroll
        for (int u = 0; u < 2; ++u) { const int row = row0 + u * F.NGW; ok[u] = row < nrows; if (ok[u]) {
            int t, L; if (row < NLAT) { t = row & (SEQ - 1); L = SEQ; } else { t = (row - NLAT) & (CTXL - 1); L = CTXL; }
            const bf16* pr = P + (size_t)row * NP + COL_CONV + c;
            q[u][0] = *(const u32x2*)pr; q[u][1] = *(const u32x2*)(pr + 256); q[u][2] = *(const u32x2*)(pr + 512);
            q[u][3] = t > 0 ? *(const u32x2*)(pr - NP + 256) : zero; q[u][4] = t > 0 ? *(const u32x2*)(pr - NP + 512) : zero;
            q[u][5] = t < L - 1 ? *(const u32x2*)(pr + NP + 256) : zero; q[u][6] = t < L - 1 ? *(const u32x2*)(pr + NP + 512) : zero; } }
#pragma unroll
        for (int u = 0; u < 2; ++u) if (ok[u]) { const int row = row0 + u * F.NGW;
            float bg[4], cg[4], hh[4], cp[4], hp[4], cn[4], hn[4];
            unpack4(q[u][0], bg); unpack4(q[u][1], cg); unpack4(q[u][2], hh); unpack4(q[u][3], cp); unpack4(q[u][4], hp); unpack4(q[u][5], cn); unpack4(q[u][6], hn);
            const float W0[4] = {w0.x, w0.y, w0.z, w0.w}, W1[4] = {w1.x, w1.y, w1.z, w1.w}, W2[4] = {w2.x, w2.y, w2.z, w2.w}, GN[4] = {gn.x, gn.y, gn.z, gn.w};
            float y[4], s = 0.f;
#pragma unroll
            for (int j = 0; j < 4; ++j) { y[j] = bg[j] * (W0[j] * (cp[j] * hp[j]) + W1[j] * (cg[j] * hh[j]) + W2[j] * (cn[j] * hn[j])); s += y[j] * y[j]; }
            const float rs = rsqrtf(wave_sum(s) * (1.f / 256.f) + RMS_EPS);
            u32x2 o; o.x = pk2(y[0] * rs * GN[0], y[1] * rs * GN[1]); o.y = pk2(y[2] * rs * GN[2], y[3] * rs * GN[3]);
            *(u32x2*)(MA + (size_t)row * D + 512 + c) = o; }
    }
}

__device__ __forceinline__ void sincos_turns(float x, float& s, float& c) { s = __builtin_amdgcn_sinf(x); c = __builtin_amdgcn_cosf(x); }
#define MFMA16(a, b, c) __builtin_amdgcn_mfma_f32_16x16x32_bf16((a), (b), (c), 0, 0, 0)

__device__ __forceinline__ void fftA_item(const Frame& F0, int item) {
    const Frame F = phase_frame(F0); unsigned char* const ws = F.ws;
    const int half = item & 1, t2 = (item >> 1) & 63, b = item >> 7;
    const bf16* P = (const bf16*)(ws + WS_P); bf16* GT = (bf16*)(ws + WS_GT);
    LAS bf16* Bs = (LAS bf16*)F.lds;
    const int lane = F.lane, w = F.wave, fr = lane & 15, fq = lane >> 4;
    __syncthreads();
#pragma unroll
    for (int i = 0; i < 8; ++i) { const int cidx = F.tid + NTHR * i, krow = cidx >> 4, ch8 = cidx & 15, ri = krow >> 7, t1 = krow & 127;
        const u32x4 v = *(const u32x4*)(P + (size_t)(b * SEQ + t1 * 64 + t2) * NP + COL_FC + ri * 256 + half * 128 + ch8 * 8);
        LAS bf16* d = Bs + (ch8 * 8) * 264 + (krow ^ (ch8 << 3));
        d[0 * 264] = (bf16)(v.x & 0xffffu); d[1 * 264] = (bf16)(v.x >> 16); d[2 * 264] = (bf16)(v.y & 0xffffu); d[3 * 264] = (bf16)(v.y >> 16);
        d[4 * 264] = (bf16)(v.z & 0xffffu); d[5 * 264] = (bf16)(v.z >> 16); d[6 * 264] = (bf16)(v.w & 0xffffu); d[7 * 264] = (bf16)(v.w >> 16); }
    __syncthreads();
    f32x4 acc[2][8];
#pragma unroll
    for (int a = 0; a < 2; ++a)
#pragma unroll
        for (int n = 0; n < 8; ++n) acc[a][n] = (f32x4){0.f, 0.f, 0.f, 0.f};
    int t1p_a = 16 * w + fr;
    asm volatile("" : "+v"(t1p_a));
#pragma unroll
    for (int ks = 0; ks < 8; ++ks) {
        bf16x8 ar, ai;
#pragma unroll
        for (int j = 0; j < 8; ++j) { const int k = ks * 32 + 8 * fq + j, ri = k >> 7, t1 = k & 127; const int idx = (t1 * t1p_a) & 127;
            float sn, cs; sincos_turns((float)idx * (1.f / 128.f), sn, cs);
            const float vr = ri == 0 ? cs : -sn, vi = ri == 0 ? -sn : -cs;
            ar[j] = (short)f2bf(vr); ai[j] = (short)f2bf(vi); }
#pragma unroll
        for (int nt = 0; nt < 8; ++nt) { const bf16x8 bfr = *(const LAS bf16x8*)(Bs + (nt * 16 + fr) * 264 + ((ks * 32 + 8 * fq) ^ ((nt * 2 + (fr >> 3)) << 3)));
            acc[0][nt] = MFMA16(ar, bfr, acc[0][nt]); acc[1][nt] = MFMA16(ai, bfr, acc[1][nt]); }
    }
#pragma unroll
    for (int reg = 0; reg < 4; ++reg) { const int t1p = 16 * w + 4 * fq + reg; float st, ct; sincos_turns((float)(t2 * t1p) * (1.f / 8192.f), st, ct);
        bf16* g = GT + ((size_t)((b * 128 + t1p) * 64 + t2) * 2) * 256 + half * 128 + fr;
#pragma unroll
        for (int nt = 0; nt < 8; ++nt) { const float gr = acc[0][nt][reg], gi = acc[1][nt][reg];
            g[nt * 16] = (bf16)f2bf(gr * ct + gi * st); g[256 + nt * 16] = (bf16)f2bf(gi * ct - gr * st); } }
}

template <int NKC, int NDIV, int MT, class SrcRow, class OutRow>
__device__ __forceinline__ void dft64_item(const Frame& F0, int l, int m0, float sgn, float scale, SrcRow src, OutRow orow) {
    const Frame F = phase_frame(F0); unsigned char* const ws = F.ws;
    LAS bf16* Bs = (LAS bf16*)F.lds;
    LAS float* red = (LAS float*)(F.lds + 256 * 136 * 2);
    const int lane = F.lane, w = F.wave, fr = lane & 15, fq = lane >> 4;
    int fr_a = fr; asm volatile("" : "+v"(fr_a));
    f32x4 acc[MT][2];
#pragma unroll
    for (int a = 0; a < MT; ++a) { acc[a][0] = (f32x4){0.f, 0.f, 0.f, 0.f}; acc[a][1] = (f32x4){0.f, 0.f, 0.f, 0.f}; }
    for (int kc = 0; kc < NKC; ++kc) {
        __syncthreads();
#pragma unroll
        for (int i = 0; i < 8; ++i) { const int cidx = F.tid + NTHR * i, krow = cidx >> 5, ch8 = cidx & 31;
            const u32x4 v = *(const u32x4*)(src(kc * 64 + (krow >> 1), krow & 1) + ch8 * 8);
            LAS bf16* d = Bs + (ch8 * 8) * 136 + (krow ^ ((ch8 & 15) << 3));
            d[0 * 136] = (bf16)(v.x & 0xffffu); d[1 * 136] = (bf16)(v.x >> 16); d[2 * 136] = (bf16)(v.y & 0xffffu); d[3 * 136] = (bf16)(v.y >> 16);
            d[4 * 136] = (bf16)(v.z & 0xffffu); d[5 * 136] = (bf16)(v.z >> 16); d[6 * 136] = (bf16)(v.w & 0xffffu); d[7 * 136] = (bf16)(v.w >> 16); }
        __syncthreads();
#pragma unroll
        for (int ks = 0; ks < 4; ++ks) {
            const bf16x8 b0 = *(const LAS bf16x8*)(Bs + ((2 * w) * 16 + fr) * 136 + ((ks * 32 + 8 * fq) ^ ((((2 * w) * 2 + (fr >> 3)) & 15) << 3)));
            const bf16x8 b1 = *(const LAS bf16x8*)(Bs + ((2 * w + 1) * 16 + fr) * 136 + ((ks * 32 + 8 * fq) ^ ((((2 * w + 1) * 2 + (fr >> 3)) & 15) << 3)));
#pragma unroll
            for (int mt = 0; mt < MT; ++mt) { const int mrow = m0 + mt * 16 + fr_a; bf16x8 a;
#pragma unroll
                for (int j = 0; j < 8; ++j) { const int k = ks * 32 + 8 * fq + j, tl = k >> 1, ri = k & 1; const int idx = ((kc * 64 + tl) * mrow) & (NDIV - 1);
                    float sn, cs; sincos_turns((float)idx * (1.f / (float)NDIV), sn, cs);
                    a[j] = (short)f2bf(ri == 0 ? cs : sgn * sn); }
                acc[mt][0] = MFMA16(a, b0, acc[mt][0]); acc[mt][1] = MFMA16(a, b1, acc[mt][1]); }
        }
    }
#pragma unroll
    for (int mt = 0; mt < MT; ++mt)
#pragma unroll
        for (int reg = 0; reg < 4; ++reg) { const float a = acc[mt][0][reg] * scale, b = acc[mt][1][reg] * scale; acc[mt][0][reg] = a; acc[mt][1][reg] = b;
            float s = a * a + b * b; s += __shfl_xor(s, 1); s += __shfl_xor(s, 2); s += __shfl_xor(s, 4); s += __shfl_xor(s, 8);
            if (fr == 0) red[w * 64 + mt * 16 + 4 * fq + reg] = s; }
    __syncthreads();
    bf16* MA = (bf16*)(ws + WS_H); const float* fg = inptr(I_FOURG) + l * 256;
    const float g0 = fg[(2 * w) * 16 + fr], g1 = fg[(2 * w + 1) * 16 + fr];
#pragma unroll
    for (int mt = 0; mt < MT; ++mt)
#pragma unroll
        for (int reg = 0; reg < 4; ++reg) { const int ml = mt * 16 + 4 * fq + reg; float tot = 0.f;
#pragma unroll
            for (int ww = 0; ww < 8; ++ww) tot += red[ww * 64 + ml];
            const float rs = rsqrtf(tot * (1.f / 256.f) + RMS_EPS);
            bf16* o = MA + (size_t)orow(m0 + ml) * D + 768 + fr;
            o[(2 * w) * 16] = (bf16)f2bf(acc[mt][0][reg] * rs * g0); o[(2 * w + 1) * 16] = (bf16)f2bf(acc[mt][1][reg] * rs * g1); }
    __syncthreads();
}

constexpr size_t WS_LORA = 64 * 1024;
constexpr int LINP = 392;
__device__ __forceinline__ float fast_sigmoid(float x) { return __builtin_amdgcn_rcpf(1.f + __expf(-x)); }
__device__ __forceinline__ float fast_tanh(float x) { return 1.f - 2.f * __builtin_amdgcn_rcpf(1.f + __expf(2.f * x)); }
__device__ __forceinline__ void prep_phase(const Frame& F0, int l) {
    const Frame F = phase_frame(F0); unsigned char* const ws = F.ws;
    const bf16* Zs = (const bf16*)(ws + WS_ZS); bf16* STR = (bf16*)(ws + WS_STR);
    LAS bf16* lin = (LAS bf16*)F.lds;
    LAS float* ssum = (LAS float*)(F.lds + 12544);
    constexpr int TP = 72, TSZ = 16 * TP;
    LAS bf16* tiles = (LAS bf16*)(F.lds + 13312);
    const int lane = F.lane, fr = lane & 15, fq = lane >> 4, w = F.wave, tid = F.tid;
    const int nitems = (NROW / 16) * 2;
    int it = blockIdx.x; if (it >= nitems) return;
    int hh = -1, head = 0, cb = 0;
    bf16x8 wf[12][2];
    const float* kkp = inptr(I_KK) + l * DR; const float* kap = inptr(I_KA) + l * DR; const float* dw0 = inptr(I_DW0) + l * 2 * DR; const float* ia0 = inptr(I_IA0) + l * 2 * DR;
    u32x4 pz[2];
#define PREP_LOAD(item_) do { const int row0_ = ((item_) >> 1) * 16; \
        pz[0] = *(const u32x4*)(Zs + (size_t)(row0_ + tid / 48) * ZW + 1536 + (tid % 48) * 8); \
        if (tid < 256) pz[1] = *(const u32x4*)(Zs + (size_t)(row0_ + (tid + 512) / 48) * ZW + 1536 + ((tid + 512) % 48) * 8); } while (0)
    PREP_LOAD(it);
    for (; it < nitems; it += F.G) {
        const int tile = it >> 1;
        if ((it & 1) != hh) {
            hh = it & 1; head = 4 * hh + (w >> 1); cb = 64 * head + 32 * (w & 1);
            const bf16* WL = (const bf16*)(ws + WS_LORA) + (size_t)l * 512 * 384 + (size_t)(cb + fr) * 384 + 8 * fq;
#pragma unroll
            for (int ks = 0; ks < 12; ++ks)
#pragma unroll
                for (int nt = 0; nt < 2; ++nt) wf[ks][nt] = *(const bf16x8*)(WL + (size_t)nt * 16 * 384 + ks * 32);
        }
        __syncthreads();
        {   float v[8]; unpack8(pz[0], v); const int c8 = tid % 48;
            if (c8 < 16) {
#pragma unroll
                for (int j = 0; j < 8; ++j) v[j] = fast_tanh(v[j]); }
            else if (c8 >= 32) {
#pragma unroll
                for (int j = 0; j < 8; ++j) v[j] = fast_sigmoid(v[j]); }
            *(LAS u32x4*)(lin + (tid / 48) * LINP + c8 * 8) = (u32x4){pk2(v[0], v[1]), pk2(v[2], v[3]), pk2(v[4], v[5]), pk2(v[6], v[7])};
            if (tid < 256) { unpack8(pz[1], v); const int c9 = (tid + 512) % 48;
                if (c9 < 16) {
#pragma unroll
                    for (int j = 0; j < 8; ++j) v[j] = fast_tanh(v[j]); }
                else if (c9 >= 32) {
#pragma unroll
                    for (int j = 0; j < 8; ++j) v[j] = fast_sigmoid(v[j]); }
                *(LAS u32x4*)(lin + ((tid + 512) / 48) * LINP + c9 * 8) = (u32x4){pk2(v[0], v[1]), pk2(v[2], v[3]), pk2(v[4], v[5]), pk2(v[6], v[7])}; } }
        u32x2 zr2[2], zk2[2], zv2[2];
        {   const bf16* zr_ = Zs + (size_t)(tile * 16 + fr) * ZW + cb + 4 * fq;
#pragma unroll
            for (int nt = 0; nt < 2; ++nt) { zr2[nt] = *(const u32x2*)(zr_ + 16 * nt); zk2[nt] = *(const u32x2*)(zr_ + 512 + 16 * nt); zv2[nt] = *(const u32x2*)(zr_ + 1024 + 16 * nt); } }
        if (it + F.G < nitems) PREP_LOAD(it + F.G);
        __syncthreads();
        f32x4 kkw[2], kaw[2], d0w[2][2], i0w[2][2];
#pragma unroll
        for (int nt = 0; nt < 2; ++nt) { const int c0 = cb + 16 * nt + 4 * fq; kkw[nt] = *(const f32x4*)(kkp + c0); kaw[nt] = *(const f32x4*)(kap + c0);
#pragma unroll
            for (int dn = 0; dn < 2; ++dn) { d0w[dn][nt] = *(const f32x4*)(dw0 + dn * DR + c0); i0w[dn][nt] = *(const f32x4*)(ia0 + dn * DR + c0); } }
        f32x4 acc[5][2];
#pragma unroll
        for (int q = 0; q < 5; ++q) { acc[q][0] = (f32x4){0.f, 0.f, 0.f, 0.f}; acc[q][1] = (f32x4){0.f, 0.f, 0.f, 0.f}; }
#pragma unroll
        for (int ks = 0; ks < 12; ++ks) { const int q = ks < 8 ? (ks >> 1) : 4; const bf16x8 xf = *(const LAS bf16x8*)(lin + fr * LINP + ks * 32 + 8 * fq);
            acc[q][0] = MFMA16(wf[ks][0], xf, acc[q][0]); acc[q][1] = MFMA16(wf[ks][1], xf, acc[q][1]); }
        float zk[2][4], kv[2][4]; float ss = 0.f;
#pragma unroll
        for (int nt = 0; nt < 2; ++nt) { unpack4(zk2[nt], zk[nt]);
#pragma unroll
            for (int i = 0; i < 4; ++i) { kv[nt][i] = zk[nt][i] * kkw[nt][i]; ss += kv[nt][i] * kv[nt][i]; } }
        ss += __shfl_xor(ss, 16); ss += __shfl_xor(ss, 32);
        if (fq == 0) ssum[w * 16 + fr] = ss;
        __syncthreads();
        const float inv = __builtin_amdgcn_rcpf(fmaxf(sqrtf(ssum[w * 16 + fr] + ssum[(w ^ 1) * 16 + fr]), 1e-12f));
        LAS bf16* th = tiles + (w >> 1) * 10 * TSZ + fr * TP + 32 * (w & 1) + 4 * fq;
#pragma unroll
        for (int nt = 0; nt < 2; ++nt) { LAS bf16* t0 = th + 16 * nt;
            *(LAS u32x2*)(t0) = zr2[nt]; *(LAS u32x2*)(t0 + TSZ) = zv2[nt];
            float kk[4];
#pragma unroll
            for (int i = 0; i < 4; ++i) kk[i] = kv[nt][i] * inv;
            *(LAS u32x2*)(t0 + 2 * TSZ) = (u32x2){pk2(kk[0], kk[1]), pk2(kk[2], kk[3])};
            *(LAS u32x2*)(t0 + 3 * TSZ) = (u32x2){pk2(acc[4][nt][0], acc[4][nt][1]), pk2(acc[4][nt][2], acc[4][nt][3])};
#pragma unroll
            for (int dn = 0; dn < 2; ++dn) { float ep[4], kd[4], bb[4];
#pragma unroll
                for (int i = 0; i < 4; ++i) { const float ew = fast_sigmoid(d0w[dn][nt][i] + acc[dn][nt][i]) * 0.6065306597126334f;
                    ep[i] = ew * (1.f + ew * (-0.5f + ew * (0.16666667f + ew * (-0.041666668f + ew * 0.0083333338f))));
                    const float a = fast_sigmoid(i0w[dn][nt][i] + acc[2 + dn][nt][i]); kd[i] = zk[nt][i] * (1.f + (a - 1.f) * kaw[nt][i]); bb[i] = kk[i] * a; }
                *(LAS u32x2*)(t0 + (4 + 3 * dn) * TSZ) = (u32x2){pk2(ep[0], ep[1]), pk2(ep[2], ep[3])};
                *(LAS u32x2*)(t0 + (5 + 3 * dn) * TSZ) = (u32x2){pk2(kd[0], kd[1]), pk2(kd[2], kd[3])};
                *(LAS u32x2*)(t0 + (6 + 3 * dn) * TSZ) = (u32x2){pk2(bb[0], bb[1]), pk2(bb[2], bb[3])}; } }
        __syncthreads();
        {   const LAS bf16* src = tiles + (w >> 1) * 10 * TSZ + (8 * (w & 1) + (lane >> 3)) * TP + (lane & 7) * 8; bf16* dst = STR + ((size_t)tile * 8 + head) * 10240 + 8 * (w & 1) * 64 + lane * 8;
#pragma unroll
            for (int s = 0; s < 10; ++s) *(u32x4*)(dst + s * 1024) = *(const LAS u32x4*)(src + s * TSZ); }
    }
#undef PREP_LOAD
}

__device__ __forceinline__ int scan_rowof(int s, int dir, int b) { if (s < CTXL) { const int tc = dir ? (CTXL - 1 - s) : s; return NLAT + b * CTXL + tc; } const int tt = s - CTXL; const int t = dir ? (SEQ - 1 - tt) : tt; return b * SEQ + t; }
__device__ __forceinline__ void readout_pass(const Frame& F0, int l, int nrows) {
    const Frame F = phase_frame(F0); unsigned char* const ws = F.ws;
    const bf16* STR = (const bf16*)(ws + WS_STR); const bf16* Y0 = (const bf16*)(ws + WS_Y); const bf16* Y1 = Y0 + (size_t)NROW * DR; bf16* MA = (bf16*)(ws + WS_H);
    const int lane = F.lane, c = 8 * lane;
    float gw[8], gb[8], rk[8];
    {   const float* gnw = inptr(I_GNW) + l * DR + c; const float* gnb = inptr(I_GNB) + l * DR + c; const float* rkp = inptr(I_RK) + l * DR + c;
        const f32x4 a0 = *(const f32x4*)gnw, a1 = *(const f32x4*)(gnw + 4), b0 = *(const f32x4*)gnb, b1 = *(const f32x4*)(gnb + 4), r0 = *(const f32x4*)rkp, r1 = *(const f32x4*)(rkp + 4);
#pragma unroll
        for (int i = 0; i < 4; ++i) { gw[i] = a0[i]; gw[4 + i] = a1[i]; gb[i] = b0[i]; gb[4 + i] = b1[i]; rk[i] = r0[i]; rk[4 + i] = r1[i]; } }
    for (int row0 = F.gw; row0 < nrows; row0 += 2 * F.NGW) {
        u32x4 q[2][7]; bool ok[2];
#pragma unroll
        for (int u = 0; u < 2; ++u) { const int row = row0 + u * F.NGW; ok[u] = row < nrows; if (ok[u]) {
            const bf16* sr = STR + ((size_t)(row >> 4) * 8 + (lane >> 3)) * 10240 + (row & 15) * 64 + (lane & 7) * 8;
            q[u][0] = *(const u32x4*)(Y0 + (size_t)row * DR + c); q[u][1] = *(const u32x4*)(Y1 + (size_t)row * DR + c);
            q[u][2] = *(const u32x4*)sr; q[u][3] = *(const u32x4*)(sr + 1024); q[u][4] = *(const u32x4*)(sr + 3072); q[u][5] = *(const u32x4*)(sr + 5 * 1024); q[u][6] = *(const u32x4*)(sr + 8 * 1024); } }
#pragma unroll
        for (int u = 0; u < 2; ++u) if (ok[u]) { const int row = row0 + u * F.NGW;
            float ya[8], yb[8], r[8], v[8], g[8], k0[8], k1[8];
            unpack8(q[u][0], ya); unpack8(q[u][1], yb); unpack8(q[u][2], r); unpack8(q[u][3], v); unpack8(q[u][4], g); unpack8(q[u][5], k0); unpack8(q[u][6], k1);
            float s1 = 0.f, s2 = 0.f, sb = 0.f;
#pragma unroll
            for (int i = 0; i < 8; ++i) { ya[i] += yb[i]; s1 += ya[i]; s2 += ya[i] * ya[i]; sb += r[i] * (k0[i] + k1[i]) * rk[i]; }
#pragma unroll
            for (int o = 1; o < 8; o <<= 1) { s1 += __shfl_xor(s1, o); s2 += __shfl_xor(s2, o); sb += __shfl_xor(sb, o); }
            const float mu = s1 * (1.f / 64.f); const float var = fmaxf(s2 * (1.f / 64.f) - mu * mu, 0.f); const float rs = rsqrtf(var + GN_EPS);
            float o8[8];
#pragma unroll
            for (int i = 0; i < 8; ++i) o8[i] = ((ya[i] - mu) * rs * gw[i] + gb[i] + sb * v[i]) * g[i];
            *(u32x4*)(MA + (size_t)row * D + c) = (u32x4){pk2(o8[0], o8[1]), pk2(o8[2], o8[3]), pk2(o8[4], o8[5]), pk2(o8[6], o8[7])}; }
    }
}
constexpr int BLOB = 16384, SEGCH = 132, NSEG = 4, BLOB_B1_SCANS = 14;
constexpr size_t WS_BLOBA = 20 * MiB, WS_BLOBB1 = 86 * MiB, WS_BLOBB2 = 492 * MiB;
constexpr size_t WS_SCANST = 2 * MiB + 512 * 1024;
__device__ __forceinline__ unsigned char* blob_ptr(unsigned char* ws, int seg, int scan, int ci) {
    if ((seg & 1) == 0) return ws + WS_BLOBA + ((size_t)scan * SEGCH + ci) * BLOB;
    return scan < BLOB_B1_SCANS ? ws + WS_BLOBB1 + ((size_t)scan * SEGCH + ci) * BLOB : ws + WS_BLOBB2 + ((size_t)(scan - BLOB_B1_SCANS) * SEGCH + ci) * BLOB;
}
typedef short s16x4 __attribute__((ext_vector_type(4)));
__device__ __forceinline__ bf16x8 frag_lo(u32x2 x) { u32x4 t = {x.x, x.y, 0u, 0u}; return __builtin_bit_cast(bf16x8, t); }
__device__ __forceinline__ bf16x8 frag_c(const f32x4& a) { u32x4 t = {pk2(a[0], a[1]), pk2(a[2], a[3]), 0u, 0u}; return __builtin_bit_cast(bf16x8, t); }

struct PreRegs { u32x4 q[12]; };
__device__ __forceinline__ void pre_load(PreRegs& R, unsigned char* ws, int scan, int cs, int lane) {
    const int dir = scan & 1, h = (scan >> 1) & 7, b = scan >> 4; const int rfirst = scan_rowof(16 * cs, dir, b);
    const bf16* blk = (const bf16*)(ws + WS_STR) + ((size_t)(rfirst >> 4) * 8 + h) * 10240 + lane * 8;
    const int so[6] = {0, 1, 2, 4 + 3 * dir, 5 + 3 * dir, 6 + 3 * dir};
#pragma unroll
    for (int i = 0; i < 6; ++i) { R.q[2 * i] = *(const u32x4*)(blk + so[i] * 1024); R.q[2 * i + 1] = *(const u32x4*)(blk + so[i] * 1024 + 512); }
}
template <int PM>
__device__ __forceinline__ void pre_item(const Frame& F, unsigned char* ws, int scan, int cs, unsigned char* blob, PreRegs& PR, int nscan, int ncs) {
    const int dir = scan & 1, h = (scan >> 1) & 7, b = scan >> 4; const int lane = F.lane, fr = lane & 15, fq = lane >> 4;
    LAS unsigned char* L = F.lds + F.wave * 17408;
    constexpr int TKP = 72, TKS = 16 * TKP;
    LAS bf16* TK = (LAS bf16*)L; LAS bf16* TR = TK + TKS; LAS bf16* TKt = TR + TKS; LAS bf16* TB = TKt + TKS;
    LAS bf16* KTt = TB + TKS; LAS bf16* RTt = KTt + 1024; LAS bf16* Vt = RTt + 1024;
    LAS bf16* AKK = Vt + 1024; LAS bf16* ARK = AKK + 256; LAS bf16* ARB = ARK + 256; LAS bf16* TT = ARB + 256;
    float kh[16], bh[16];
    float pc;
    {   float r_[16], v_[16], kk_[16], lp_[16], kd_[16], bb_[16];
        LAS bf16* stg = TK;
#pragma unroll
        for (int i = 0; i < 6; ++i) { *(LAS u32x4*)(stg + i * 1024 + lane * 8) = PR.q[2 * i]; *(LAS u32x4*)(stg + i * 1024 + 512 + lane * 8) = PR.q[2 * i + 1]; }
        LDS_WAIT(); asm volatile("" ::: "memory");
        if (nscan >= 0) pre_load(PR, ws, nscan, ncs, lane);
#pragma unroll
        for (int t = 0; t < 16; ++t) { const int tm = (dir ? 15 - t : t) * 64 + lane;
            r_[t] = bf2f(stg[tm]); v_[t] = bf2f(stg[1024 + tm]); kk_[t] = bf2f(stg[2048 + tm]); lp_[t] = bf2f(stg[3072 + tm]); kd_[t] = bf2f(stg[4096 + tm]); bb_[t] = bf2f(stg[5120 + tm]); }
        LDS_WAIT(); asm volatile("" ::: "memory");
        float pp = 1.f; u32x4 kt4[2], rt4[2], v4[2];
        unsigned ktp[8], rtp[8], vp[8];
#pragma unroll
        for (int t = 0; t < 16; ++t) { const float pm1 = pp; pp *= 1.f - lp_[t]; const float p = pp, ip = __builtin_amdgcn_rcpf(pp); lp_[t] = ip;
            const float kt = kk_[t] * pm1, ktl = kd_[t] * ip, btl = bb_[t] * ip, rt = r_[t] * p;
            const unsigned hk = pk2(kt, rt), hb = pk2(ktl, btl);
            TK[t * TKP + lane] = (bf16)(hk & 0xffffu); TR[t * TKP + lane] = (bf16)(hk >> 16); TKt[t * TKP + lane] = (bf16)(hb & 0xffffu); TB[t * TKP + lane] = (bf16)(hb >> 16);
            const unsigned hv = f2bf(v_[t]);
            if (t & 1) { ktp[t >> 1] |= hk << 16; rtp[t >> 1] |= hk & 0xffff0000u; vp[t >> 1] |= hv << 16; }
            else { ktp[t >> 1] = hk & 0xffffu; rtp[t >> 1] = hk >> 16; vp[t >> 1] = hv; } }
        kt4[0] = (u32x4){ktp[0], ktp[1], ktp[2], ktp[3]}; kt4[1] = (u32x4){ktp[4], ktp[5], ktp[6], ktp[7]};
        rt4[0] = (u32x4){rtp[0], rtp[1], rtp[2], rtp[3]}; rt4[1] = (u32x4){rtp[4], rtp[5], rtp[6], rtp[7]};
        v4[0] = (u32x4){vp[0], vp[1], vp[2], vp[3]}; v4[1] = (u32x4){vp[4], vp[5], vp[6], vp[7]};
        *(LAS u32x4*)(KTt + lane * 16) = kt4[0]; *(LAS u32x4*)(KTt + lane * 16 + 8) = kt4[1];
        *(LAS u32x4*)(RTt + lane * 16) = rt4[0]; *(LAS u32x4*)(RTt + lane * 16 + 8) = rt4[1];
        *(LAS u32x4*)(Vt + lane * 16) = v4[0]; *(LAS u32x4*)(Vt + lane * 16 + 8) = v4[1];
        pc = pp;
#pragma unroll
        for (int t = 0; t < 16; ++t) { const float e = pp * lp_[t]; kh[t] = kd_[t] * e; bh[t] = bb_[t] * e; }
    }
    LDS_WAIT(); asm volatile("" ::: "memory");
    {   f32x4 akb = {0.f, 0.f, 0.f, 0.f}, akk = akb, ark = akb, arb = akb;
#pragma unroll
        for (int s = 0; s < 2; ++s) { const int o = fr * TKP + 32 * s + 8 * fq;
            const bf16x8 fk = *(const LAS bf16x8*)(TK + o), frr = *(const LAS bf16x8*)(TR + o), fkt = *(const LAS bf16x8*)(TKt + o), fb = *(const LAS bf16x8*)(TB + o);
            akb = MFMA16(fk, fb, akb); akk = MFMA16(fk, fkt, akk); ark = MFMA16(frr, fkt, ark); arb = MFMA16(frr, fb, arb); }
        float nm[4];
#pragma unroll
        for (int reg = 0; reg < 4; ++reg) { const int t = 4 * fq + reg; const bool lo = fr < t, le = fr <= t;
            nm[reg] = lo ? akb[reg] : 0.f; AKK[t * 16 + fr] = (bf16)f2bf(lo ? akk[reg] : 0.f);
            ARK[t * 16 + fr] = (bf16)f2bf(le ? ark[reg] : 0.f); ARB[t * 16 + fr] = (bf16)f2bf(le ? arb[reg] : 0.f); }
        float col[16];
#pragma unroll
        for (int t = 0; t < 16; ++t) { float s_ = (t == fr) ? 1.f : 0.f;
#pragma unroll
            for (int i = 0; i < 16; ++i) if (i < t) { const float n_ti = __builtin_bit_cast(float, __builtin_amdgcn_readlane(__builtin_bit_cast(int, nm[t & 3]), i + 16 * (t >> 2))); s_ -= n_ti * col[i]; }
            col[t] = s_; TT[t * 16 + fr] = (bf16)f2bf(s_); }
    }
    LDS_WAIT(); asm volatile("" ::: "memory");
    f32x4 WTc[4], RqT[4], U0c[4], Y0c[4];
    {   const bf16x8 aT = frag_lo(*(const LAS u32x2*)(TT + fr * 16 + 4 * fq)), aKK = frag_lo(*(const LAS u32x2*)(AKK + fr * 16 + 4 * fq)), aRK = frag_lo(*(const LAS u32x2*)(ARK + fr * 16 + 4 * fq));
        u32x2 nb = *(const LAS u32x2*)(ARB + fr * 16 + 4 * fq); nb.x ^= 0x80008000u; nb.y ^= 0x80008000u; const bf16x8 aRBn = frag_lo(nb);
        const f32x4 z4 = {0.f, 0.f, 0.f, 0.f};
#pragma unroll
        for (int nt = 0; nt < 4; ++nt) { const int o = (16 * nt + fr) * 16 + 4 * fq;
            const bf16x8 bK = frag_lo(*(const LAS u32x2*)(KTt + o)), bV = frag_lo(*(const LAS u32x2*)(Vt + o));
            float ri[4]; unpack4(*(const LAS u32x2*)(TR + fr * TKP + 16 * nt + 4 * fq), ri);
            const f32x4 Wn = MFMA16(aT, bK, z4); WTc[nt] = MFMA16(bK, aT, z4);
            const f32x4 Zn = MFMA16(aKK, bV, z4);
            U0c[nt] = MFMA16(aT, frag_c(Zn), z4);
            RqT[nt] = MFMA16(frag_c(Wn), aRBn, ((f32x4){ri[0], ri[1], ri[2], ri[3]}));
            Y0c[nt] = MFMA16(aRK, bV, z4); Y0c[nt] = MFMA16(aRBn, frag_c(U0c[nt]), Y0c[nt]); }
    }
    LDS_WAIT(); asm volatile("" ::: "memory");
#pragma unroll
    for (int nt = 0; nt < 4; ++nt) { const u32x2 vv = *(const LAS u32x2*)(Vt + (16 * nt + fr) * 16 + 4 * fq);
        *(u32x2*)(blob + 8192 + nt * 2048 + 1024 + lane * 8) = vv;
        u32x2 u0 = {pk2(U0c[nt][0], U0c[nt][1]), pk2(U0c[nt][2], U0c[nt][3])}, y0 = {pk2(Y0c[nt][0], Y0c[nt][1]), pk2(Y0c[nt][2], Y0c[nt][3])};
        *(u32x2*)(blob + 8192 + nt * 2048 + lane * 8) = u0; *(u32x2*)(blob + 8192 + nt * 2048 + 512 + lane * 8) = y0;
        *(float*)(blob + 8192 + nt * 2048 + 1536 + lane * 4) = pc; }
#pragma unroll
    for (int s = 0; s < 2; ++s) {
        *(u32x4*)(blob + (0 * 2 + s) * 1024 + lane * 16) = (u32x4){pk2(WTc[2 * s][0], WTc[2 * s][1]), pk2(WTc[2 * s][2], WTc[2 * s][3]), pk2(WTc[2 * s + 1][0], WTc[2 * s + 1][1]), pk2(WTc[2 * s + 1][2], WTc[2 * s + 1][3])};
        *(u32x4*)(blob + (1 * 2 + s) * 1024 + lane * 16) = (u32x4){pk2(RqT[2 * s][0], RqT[2 * s][1]), pk2(RqT[2 * s][2], RqT[2 * s][3]), pk2(RqT[2 * s + 1][0], RqT[2 * s + 1][1]), pk2(RqT[2 * s + 1][2], RqT[2 * s + 1][3])}; }
    LAS bf16* BHt = TKt; LAS bf16* KHt = TB;
    {   u32x4 a, c, d, e;
        a = (u32x4){pk2(bh[0], bh[1]), pk2(bh[2], bh[3]), pk2(bh[4], bh[5]), pk2(bh[6], bh[7])}; c = (u32x4){pk2(bh[8], bh[9]), pk2(bh[10], bh[11]), pk2(bh[12], bh[13]), pk2(bh[14], bh[15])};
        d = (u32x4){pk2(kh[0], kh[1]), pk2(kh[2], kh[3]), pk2(kh[4], kh[5]), pk2(kh[6], kh[7])}; e = (u32x4){pk2(kh[8], kh[9]), pk2(kh[10], kh[11]), pk2(kh[12], kh[13]), pk2(kh[14], kh[15])};
        *(LAS u32x4*)(BHt + lane * 16) = a; *(LAS u32x4*)(BHt + lane * 16 + 8) = c; *(LAS u32x4*)(KHt + lane * 16) = d; *(LAS u32x4*)(KHt + lane * 16 + 8) = e; }
    LDS_WAIT(); asm volatile("" ::: "memory");
#pragma unroll
    for (int mt = 0; mt < 4; ++mt) { const int o = (16 * mt + fr) * 16 + 4 * fq; const u32x2 bb = *(const LAS u32x2*)(BHt + o), kk = *(const LAS u32x2*)(KHt + o);
        *(u32x4*)(blob + 4096 + mt * 1024 + lane * 16) = (u32x4){bb.x ^ 0x80008000u, bb.y ^ 0x80008000u, kk.x, kk.y}; }
    LDS_WAIT(); asm volatile("" ::: "memory");
}

__device__ __forceinline__ void pre_phase(const Frame& F0, int seg, int b_lo) {
    const Frame F = phase_frame(F0); unsigned char* const ws = F.ws;
    if ((int)blockIdx.x < b_lo) return;
    const int nwv = (F.G - b_lo) * NWAVES;
    PreRegs R;
    int it = ((int)blockIdx.x - b_lo) * NWAVES + F.wave; if (it >= 32 * SEGCH) return;
    pre_load(R, ws, it & 31, seg * SEGCH + (it >> 5), F.lane);
    for (; it < 32 * SEGCH; it += nwv) { const int nx = it + nwv; const bool hn = nx < 32 * SEGCH;
        pre_item<0>(F, ws, it & 31, seg * SEGCH + (it >> 5), blob_ptr(ws, seg, it & 31, it >> 5), R, hn ? (nx & 31) : -1, seg * SEGCH + (nx >> 5)); }
}

constexpr int SQ_SLOT = 10240, SQ_R = 12, SQ_D = 8;
template <int MODE>
__device__ __forceinline__ void seq_item(const Frame& F0, int item, int seg, bool need_ctx) {
    const Frame F = phase_frame(F0); unsigned char* const ws = F.ws;
    const int scan = item >> 2, vb = item & 3, dir = scan & 1, h = (scan >> 1) & 7, b = scan >> 4; const int lane = F.lane, fr = lane & 15, fq = lane >> 4, w = F.wave;
    const unsigned char* blob = blob_ptr(ws, seg, scan, 0);
    LAS unsigned char* ring = F.lds;
    __syncthreads();
    const int p0 = 2 * (w - 1);
    const unsigned goff0 = (p0 < 8 ? p0 * 1024 : 8192 + vb * 2048 + (p0 - 8) * 1024) + lane * 16, goff1 = (p0 + 1 < 8 ? (p0 + 1) * 1024 : 8192 + vb * 2048 + (p0 + 1 - 8) * 1024) + lane * 16;
#define SQ_ISSUE(c) do { const unsigned char* g_ = blob + (size_t)(c) * BLOB; LAS unsigned char* s_ = ring + ((c) % SQ_R) * SQ_SLOT + p0 * 1024; \
        __builtin_amdgcn_global_load_lds((const unsigned*)(g_ + goff0), (LAS unsigned*)(s_), 16, 0, 0); \
        __builtin_amdgcn_global_load_lds((const unsigned*)(g_ + goff1), (LAS unsigned*)(s_ + 1024), 16, 0, 0); } while (0)
    const bool loader = (w >= 1 && w <= 5) && MODE != 2;
    if (loader) { for (int c = 0; c < SQ_D; ++c) SQ_ISSUE(c); }
    bf16* Y = (bf16*)(ws + WS_Y) + (size_t)dir * NROW * DR + h * 64 + 16 * vb + fr;
    float* st = (float*)(ws + WS_SCANST) + (size_t)item * 1024 + lane * 4;
    f32x4 M[4];
#pragma unroll
    for (int mt = 0; mt < 4; ++mt) M[mt] = (seg == 0 || w != 0) ? (f32x4){0.f, 0.f, 0.f, 0.f} : *(const f32x4*)(st + mt * 256);
    const f32x4 z4 = {0.f, 0.f, 0.f, 0.f};
    LAS unsigned char* mb = ring + SQ_R * SQ_SLOT;
    struct SQ { bf16x8 a1[2], a2[4]; f32x4 pc[4]; u32x2 u0, vv; };
#define SQ_READ(R, c) do { const LAS unsigned char* sl_ = ring + ((c) % SQ_R) * SQ_SLOT; _Pragma("unroll") for (int i = 0; i < 4; ++i) { \
        R.a2[i] = *(const LAS bf16x8*)(sl_ + 4096 + i * 1024 + lane * 16); R.pc[i] = *(const LAS f32x4*)(sl_ + 8192 + 1536 + (16 * i + 4 * fq) * 4); } \
        R.a1[0] = *(const LAS bf16x8*)(sl_ + lane * 16); R.a1[1] = *(const LAS bf16x8*)(sl_ + 1024 + lane * 16); \
        R.u0 = *(const LAS u32x2*)(sl_ + 8192 + lane * 8); R.vv = *(const LAS u32x2*)(sl_ + 8192 + 1024 + lane * 8); } while (0)
#define SQ_STEP(R, c, RN, cn) do { \
        if ((cn) < SEGCH) SQ_READ(RN, cn); \
        const u32x4 t0 = {pk2(M[0][0], M[0][1]), pk2(M[0][2], M[0][3]), pk2(M[1][0], M[1][1]), pk2(M[1][2], M[1][3])}; \
        const u32x4 t1 = {pk2(M[2][0], M[2][1]), pk2(M[2][2], M[2][3]), pk2(M[3][0], M[3][1]), pk2(M[3][2], M[3][3])}; \
        *(LAS u32x4*)(mb + ((c) & 1) * 2048 + lane * 16) = t0; *(LAS u32x4*)(mb + ((c) & 1) * 2048 + 1024 + lane * 16) = t1; \
        const bf16x8 b0 = __builtin_bit_cast(bf16x8, t0), b1 = __builtin_bit_cast(bf16x8, t1); \
        f32x4 X0 = MFMA16(R.a1[0], b0, z4); X0 = MFMA16(R.a1[1], b1, X0); \
        float u0[4]; unpack4(R.u0, u0); \
        const u32x4 tb = {pk2(X0[0] + u0[0], X0[1] + u0[1]), pk2(X0[2] + u0[2], X0[3] + u0[3]), R.vv.x, R.vv.y}; const bf16x8 bB = __builtin_bit_cast(bf16x8, tb); \
        _Pragma("unroll") for (int mt = 0; mt < 4; ++mt) M[mt] = MFMA16(R.a2[mt], bB, R.pc[mt] * M[mt]); \
        asm volatile("s_waitcnt lgkmcnt(0)" ::: "memory"); } while (0)
    const long ystep = dir ? -(long)DR : (long)DR;
    bf16* const yctx = Y + (size_t)scan_rowof(4 * fq, dir, b) * DR; bf16* const ylat = Y + (size_t)scan_rowof(CTXL + 4 * fq, dir, b) * DR;
#define SQ_YSTEP(c) do { const int cs_ = seg * SEGCH + (c); if (MODE == 0 && (need_ctx || cs_ >= 16)) { const LAS unsigned char* sl_ = ring + ((c) % SQ_R) * SQ_SLOT; \
        const bf16x8 q0 = *(const LAS bf16x8*)(sl_ + 2048 + lane * 16), q1 = *(const LAS bf16x8*)(sl_ + 3072 + lane * 16); \
        const bf16x8 b0 = *(const LAS bf16x8*)(mb + ((c) & 1) * 2048 + lane * 16), b1 = *(const LAS bf16x8*)(mb + ((c) & 1) * 2048 + 1024 + lane * 16); \
        float y0[4]; unpack4(*(const LAS u32x2*)(sl_ + 8192 + 512 + lane * 8), y0); \
        f32x4 X1 = MFMA16(q0, b0, z4); X1 = MFMA16(q1, b1, X1); \
        bf16* yp = cs_ < 16 ? yctx + (long)cs_ * 16 * ystep : ylat + (long)(cs_ - 16) * 16 * ystep; \
        yp[0] = (bf16)f2bf(X1[0] + y0[0]); yp[ystep] = (bf16)f2bf(X1[1] + y0[1]); yp[2 * ystep] = (bf16)f2bf(X1[2] + y0[2]); yp[3 * ystep] = (bf16)f2bf(X1[3] + y0[3]); \
        asm volatile("s_waitcnt lgkmcnt(0)" ::: "memory"); } } while (0)
#define SQ_LOADER(c) do { if (loader) { if ((c) + SQ_D < SEGCH) { SQ_ISSUE((c) + SQ_D); asm volatile("s_waitcnt vmcnt(12)" ::: "memory"); } else asm volatile("s_waitcnt vmcnt(0)" ::: "memory"); } \
        __builtin_amdgcn_s_barrier(); asm volatile("" ::: "memory"); } while (0)
    const bool stw = (w == 0 && MODE != 1), yw = (w == 6 && MODE != 1);
    SQ Ra, Rb, Rc;
    SQ_LOADER(0);
    if (stw) { SQ_READ(Ra, 0); SQ_READ(Rb, 1); }
    for (int c = 0; c < SEGCH; c += 3) {
        SQ_LOADER(c + 1);
        if (stw) SQ_STEP(Ra, c, Rc, c + 2);
        if (yw && c > 0) SQ_YSTEP(c - 1);
        SQ_LOADER(c + 2);
        if (stw) SQ_STEP(Rb, c + 1, Ra, c + 3);
        if (yw) SQ_YSTEP(c);
        SQ_LOADER(c + 3);
        if (stw) SQ_STEP(Rc, c + 2, Rb, c + 4);
        if (yw) SQ_YSTEP(c + 1);
    }
    __builtin_amdgcn_s_barrier(); asm volatile("" ::: "memory");
    if (yw) SQ_YSTEP(SEGCH - 1);
#undef SQ_READ
#undef SQ_STEP
#undef SQ_YSTEP
#undef SQ_LOADER
#undef SQ_ISSUE
    if (MODE >= 2 && w == 0 && M[0][0] + M[1][1] + M[2][2] + M[3][3] == 12345.678f) st[0] = M[0][0];
    if (MODE == 0 && w == 0 && seg + 1 < NSEG) {
#pragma unroll
        for (int mt = 0; mt < 4; ++mt) *(f32x4*)(st + mt * 256) = M[mt]; }
    __syncthreads();
}

namespace pg8 {
struct EpiStoreBf16 {
    static constexpr bool PERM = true, AFTER_DRAIN = false;
    bf16_t* O; int ldc; int pn_mask;
    __device__ __forceinline__ void operator()(const f32x4 (&acc)[2][2][4][2], const Unit& u, int wr, int wc, int fr, int fq) const {
        const int row0 = u.pm * BM + wr * 64 + fr; const int col0 = (u.pn & pn_mask) * BM + wc * 32 + 8 * fq;
#pragma unroll
        for (int ai = 0; ai < 2; ++ai)
#pragma unroll
            for (int m = 0; m < 4; ++m) { bf16_t* rowp = O + (size_t)(row0 + ai * HALF + m * 16) * ldc + col0;
#pragma unroll
                for (int bj = 0; bj < 2; ++bj) { const f32x4 v0 = acc[ai][bj][m][0], v1 = acc[ai][bj][m][1];
                    u32x4 w; w.x = cvt_pk_bf16(v0[0], v0[1]); w.y = cvt_pk_bf16(v0[2], v0[3]); w.z = cvt_pk_bf16(v1[0], v1[1]); w.w = cvt_pk_bf16(v1[2], v1[3]);
                    *(u32x4*)(rowp + bj * HALF) = w; } }
    }
};
struct EpiSwiGLU {
    static constexpr bool PERM = true, AFTER_DRAIN = false;
    bf16_t* O;
    __device__ __forceinline__ void operator()(const f32x4 (&acc)[2][2][4][2], const Unit& u, int wr, int wc, int fr, int fq) const {
        const int row0 = u.pm * BM + wr * 64 + fr; const int col0 = ((u.pn & 3) * BM + wc * 32 + 8 * fq) >> 1;
#pragma unroll
        for (int ai = 0; ai < 2; ++ai)
#pragma unroll
            for (int m = 0; m < 4; ++m) { bf16_t* rowp = O + (size_t)(row0 + ai * HALF + m * 16) * 512 + col0;
#pragma unroll
                for (int bj = 0; bj < 2; ++bj) { const f32x4 g = acc[ai][bj][m][0], up = acc[ai][bj][m][1]; float a[4];
#pragma unroll
                    for (int i = 0; i < 4; ++i) a[i] = g[i] / (1.f + __expf(-g[i])) * up[i];
                    unsigned long long w = (unsigned long long)cvt_pk_bf16(a[0], a[1]) | ((unsigned long long)cvt_pk_bf16(a[2], a[3]) << 32);
                    *(unsigned long long*)(rowp + bj * (HALF / 2)) = w; } }
    }
};
template <bool XF32> struct EpiResidual {
    static constexpr bool PERM = false, AFTER_DRAIN = false;
    const void* xlat; const void* xctx;
    bf16_t* out; const float* g1;
    __device__ __forceinline__ void operator()(const f32x4 (&acc)[2][2][4][2], const Unit& u, int wr, int wc, int fr, int fq) const {
        const int rowt = u.pm * BM; const int mr = rowt < 16384 ? (rowt >> 13) : 2;
        const size_t boff = rowt < 16384 ? (size_t)rowt * 1024 : (size_t)(rowt - 16384) * 1024; const void* bp = rowt < 16384 ? xlat : xctx;
        const int col0 = u.pn * BM + wc * 32 + 4 * fq;
        f32x4 gv[2][2];
#pragma unroll
        for (int bj = 0; bj < 2; ++bj)
#pragma unroll
            for (int n = 0; n < 2; ++n) gv[bj][n] = *(const f32x4*)(g1 + (size_t)mr * 6144 + col0 + bj * HALF + n * 16);
#pragma unroll
        for (int ai = 0; ai < 2; ++ai)
#pragma unroll
            for (int m = 0; m < 4; ++m) { const int rl = ai * HALF + wr * 64 + m * 16 + fr;
#pragma unroll
                for (int bj = 0; bj < 2; ++bj)
#pragma unroll
                    for (int n = 0; n < 2; ++n) { const size_t off = (size_t)rl * 1024 + col0 + bj * HALF + n * 16;
                        f32x4 xo;
                        if (XF32) xo = *(const f32x4*)((const float*)bp + boff + off);
                        else { const unsigned long long w_ = *(const unsigned long long*)((const bf16_t*)bp + boff + off); const unsigned lo = (unsigned)w_, hi = (unsigned)(w_ >> 32);
                            xo = (f32x4){__uint_as_float(lo << 16), __uint_as_float(lo & 0xffff0000u), __uint_as_float(hi << 16), __uint_as_float(hi & 0xffff0000u)}; }
                        const f32x4 r = xo + gv[bj][n] * acc[ai][bj][m][n];
                        *(unsigned long long*)(out + (size_t)rowt * 1024 + off) = (unsigned long long)cvt_pk_bf16(r[0], r[1]) | ((unsigned long long)cvt_pk_bf16(r[2], r[3]) << 32); } }
    }
};
struct MoeOrder {
    const PG8_LAS int* tile_e; const PG8_LAS int* tile_t; int ntiles, G, c;
    __device__ bool next(int i, Unit& u) const { const long L = (long)i * G + c; if (L >= 4L * ntiles) return false; const int pm = (int)(L >> 2); const int e = tile_e[pm];
        u.pm = pm; u.pn = e * 4 + (int)(L & 3); u.ga = e * 16896 + tile_t[pm] * 256; return true; }
    __device__ __forceinline__ void a_ready(const Unit&) const {}
    __device__ __forceinline__ void done(const Unit&) const {}
};
}

__device__ __forceinline__ void expert_convert(const Frame& F0, int l, int b_lo) {
    const Frame F = phase_frame(F0); unsigned char* const ws = F.ws;
    if ((int)blockIdx.x < b_lo) return;
    const int nwv = (F.G - b_lo) * NWAVES, myw = ((int)blockIdx.x - b_lo) * NWAVES + F.wave;
    LAS float* scr = (LAS float*)(F.lds + F.wave * 16384);
    bf16* wgu = (bf16*)(ws + WS_WGU_T); bf16* wd = (bf16*)(ws + WS_WD_T);
    constexpr int I_G = 16 * 16, I_D = 8 * 32;
    constexpr int NIT = NEXP * (2 * I_G + I_D);
    const float* p_eg = inptr(I_EG); const float* p_eu = inptr(I_EU); const float* p_ed = inptr(I_ED);
    for (int it = myw; it < NIT; it += nwv) { const int e = it / (2 * I_G + I_D); int r = it % (2 * I_G + I_D);
        if (r < I_G) { transpose_item(p_eg + ((size_t)l * NEXP + e) * D * DEXP, DEXP, (r >> 4) * 64, (r & 15) * 32, wgu, D, RmGU{e * 1024}, scr, F.lane); continue; } r -= I_G;
        if (r < I_G) { transpose_item(p_eu + ((size_t)l * NEXP + e) * D * DEXP, DEXP, (r >> 4) * 64, (r & 15) * 32, wgu, D, RmGU{e * 1024 + 4}, scr, F.lane); continue; } r -= I_G;
        transpose_item(p_ed + ((size_t)l * NEXP + e) * DEXP * D, D, (r >> 5) * 64, (r & 31) * 32, wd, DEXP, RmId{e * 1024}, scr, F.lane);
    }
}

__device__ __forceinline__ void router_pass(const Frame& F0, int l, int nrows, int cnt_off = 0) {
    const Frame F = phase_frame(F0); unsigned char* const ws = F.ws;
    constexpr int HP = 1028;
    LAS float* msh = (LAS float*)F.lds; LAS float* msc = msh + 3072; LAS float* hrow = msc + 3072;
    LAS float* part = hrow + 16 * HP;
    LAS float* lgs = part + 8 * 16 * 48;
    LAS unsigned* lcnt = (LAS unsigned*)(lgs + 16 * 40);
    if (F0.tid < 64) lcnt[F0.tid] = 0u;
    __syncthreads();
    mod_to_lds(F, l, 3, msh, false); mod_to_lds(F, l, 4, msc, false); __syncthreads();
    const bf16* X = (const bf16*)(ws + WS_X); bf16* H = (bf16*)(ws + WS_H);
    const float* rgw = inptr(I_RGW) + (size_t)l * D * 4; const float* rew = inptr(I_REW) + (size_t)l * D * NEXP;
    const float* rgb = inptr(I_RGB) + l * 4; const float* reb = inptr(I_REB) + l * NEXP;
    int* rt_e = (int*)(ws + WS_ROUTE + RT_E); int* rt_pos = (int*)(ws + WS_ROUTE + RT_POS); float* rt_gate = (float*)(ws + WS_ROUTE + RT_GATE);
    unsigned* cnt = (unsigned*)(ws + WS_CTL) + CW_CNT + 64 * l + cnt_off;
    const int lane = F.lane, w = F.wave, fr = lane & 15, fq = lane >> 4; const float* n2g = inptr(I_N2G) + l * D;
    float bw[32][3];
#pragma unroll
    for (int ks = 0; ks < 32; ++ks) { const int k = 128 * w + 4 * ks + fq;
        bw[ks][0] = rew[(size_t)k * 32 + fr]; bw[ks][1] = rew[(size_t)k * 32 + 16 + fr]; bw[ks][2] = fr < 4 ? rgw[(size_t)k * 4 + fr] : 0.f; }
    const int ntiles = nrows >> 4;
    u32x2 pv[2][4];
    if (F.vcu < ntiles) {
#pragma unroll
        for (int rr = 0; rr < 2; ++rr)
#pragma unroll
            for (int j = 0; j < 4; ++j) pv[rr][j] = *(const u32x2*)(X + (size_t)(F.vcu * 16 + 2 * w + rr) * D + 4 * lane + 256 * j); }
    for (int gi = F.vcu; gi < ntiles; gi += F.G) {
#pragma unroll
        for (int rr = 0; rr < 2; ++rr) { const int r = 2 * w + rr, row = gi * 16 + r; f32x4 v[4];
#pragma unroll
            for (int j = 0; j < 4; ++j) { float t_[4]; unpack4(pv[rr][j], t_); v[j] = (f32x4){t_[0], t_[1], t_[2], t_[3]}; }
            const int mr = modrow(row);
            norm_mod_row(v, n2g, msc + mr * 1024, msh + mr * 1024, H + (size_t)row * D, lane);
#pragma unroll
            for (int j = 0; j < 4; ++j) *(LAS f32x4*)(hrow + r * HP + 4 * lane + 256 * j) = v[j]; }
        if (gi + F.G < ntiles) {
#pragma unroll
            for (int rr = 0; rr < 2; ++rr)
#pragma unroll
                for (int j = 0; j < 4; ++j) pv[rr][j] = *(const u32x2*)(X + (size_t)((gi + F.G) * 16 + 2 * w + rr) * D + 4 * lane + 256 * j); }
        __syncthreads();
        {   f32x4 acc[3] = {{0.f, 0.f, 0.f, 0.f}, {0.f, 0.f, 0.f, 0.f}, {0.f, 0.f, 0.f, 0.f}};
#pragma unroll
            for (int ks = 0; ks < 32; ++ks) { const float a = hrow[fr * HP + 128 * w + 4 * ks + fq];
#pragma unroll
                for (int nt = 0; nt < 3; ++nt) acc[nt] = __builtin_amdgcn_mfma_f32_16x16x4f32(a, bw[ks][nt], acc[nt], 0, 0, 0); }
#pragma unroll
            for (int nt = 0; nt < 3; ++nt)
#pragma unroll
                for (int reg = 0; reg < 4; ++reg) part[(w * 16 + 4 * fq + reg) * 48 + 16 * nt + fr] = acc[nt][reg]; }
        __syncthreads();
        for (int idx = F.tid; idx < 16 * 36; idx += NTHR) { const int r = idx / 36, n = idx % 36; float s_ = 0.f;
#pragma unroll
            for (int ww = 0; ww < 8; ++ww) s_ += part[(ww * 16 + r) * 48 + n];
            if (n < 32) lgs[r * 40 + 4 + n] = s_ + reb[n]; else lgs[r * 40 + n - 32] = s_ + rgb[n - 32]; }
        __syncthreads();
        if (F.tid < 16) { const int rr = gi * 16 + F.tid; const LAS float* lp = lgs + F.tid * 40;
            int grp = 0; float mx = lp[0];
#pragma unroll
            for (int g = 1; g < 4; ++g) if (lp[g] > mx) { mx = lp[g]; grp = g; }
            float den = 0.f;
#pragma unroll
            for (int g = 0; g < 4; ++g) den += __expf(lp[g] - mx);
            const float pg_top = 1.f / den; const LAS float* sel = lp + 4 + grp * 8;
            int i0 = 0; float l0 = sel[0];
#pragma unroll
            for (int q = 1; q < 8; ++q) if (sel[q] > l0) { l0 = sel[q]; i0 = q; }
            int i1 = -1; float l1 = -3.0e38f;
#pragma unroll
            for (int q = 0; q < 8; ++q) if (q != i0 && sel[q] > l1) { l1 = sel[q]; i1 = q; }
            const float e1 = __expf(l1 - l0); const float w0 = pg_top / (1.f + e1), w1 = pg_top * e1 / (1.f + e1);
            const int ea = grp * 8 + i0, eb = grp * 8 + i1;
            const unsigned pa = atomicAdd((unsigned*)(lcnt + ea), 1u), pb = atomicAdd((unsigned*)(lcnt + eb), 1u);
            rt_e[2 * rr] = ea; rt_e[2 * rr + 1] = eb; rt_pos[2 * rr] = (int)pa; rt_pos[2 * rr + 1] = (int)pb; rt_gate[2 * rr] = w0; rt_gate[2 * rr + 1] = w1; }
    }
    __syncthreads();
    if (F.tid < 32) lcnt[32 + F.tid] = lcnt[F.tid] ? atomicAdd(cnt + F.tid, lcnt[F.tid]) : 0u;
    __syncthreads();
    int* elist = (int*)(ws + WS_ELIST);
    if (F.tid < 16) for (int gi = F.vcu; gi < ntiles; gi += F.G) { const int rr = gi * 16 + F.tid;
        const int ea = rt_e[2 * rr], eb = rt_e[2 * rr + 1]; const int pa = rt_pos[2 * rr] + (int)lcnt[32 + ea], pb = rt_pos[2 * rr + 1] + (int)lcnt[32 + eb];
        rt_pos[2 * rr] = pa; rt_pos[2 * rr + 1] = pb; elist[(size_t)ea * NROW + pa] = rr; elist[(size_t)eb * NROW + pb] = rr; }
}

constexpr int MOE_MAP_OFF = 131072;
__device__ __forceinline__ void moe_map(const Frame& F0, int l) {
    const Frame F = phase_frame(F0); unsigned char* const ws = F.ws;
    LAS int* mp = (LAS int*)(F.lds + MOE_MAP_OFF);
    const unsigned* cnt = (const unsigned*)(ws + WS_CTL) + CW_CNT + 64 * l;
    __syncthreads();
    if (F.tid < NEXP) mp[32 + F.tid] = (int)__hip_atomic_load(cnt + F.tid, __ATOMIC_RELAXED, __HIP_MEMORY_SCOPE_AGENT);
    __syncthreads();
    if (F.tid == 0) { int o = 0;
#pragma nounroll
        for (int e = 0; e < NEXP; ++e) { const int c = mp[32 + e]; const int nt = (c + 255) >> 8; mp[e] = o;
#pragma nounroll
            for (int t = 0; t < nt; ++t) { mp[128 + (o >> 8) + t] = e; mp[320 + (o >> 8) + t] = t; }
            o += nt << 8; }
        mp[64] = o >> 8; }
    __syncthreads();
}

template <bool DRY>
__device__ __forceinline__ void combine_pass(const Frame& F0, int l, int nrows) {
    const Frame F = phase_frame(F0); unsigned char* const ws = F.ws;
    LAS float* mg2 = (LAS float*)F.lds; LAS float* msh = mg2 + 3072; LAS float* msc = msh + 3072;
    const bool last = (l == DEPTH - 1);
    __syncthreads();
    mod_to_lds(F, l, 5, mg2, false); if (!last) { mod_to_lds(F, l + 1, 0, msh, false); mod_to_lds(F, l + 1, 1, msc, false); }
    __syncthreads();
    bf16* X = (bf16*)(ws + WS_X); bf16* H = (bf16*)(ws + WS_H); const bf16* Ys = (const bf16*)(ws + WS_XS);
    const int* rt_e = (const int*)(ws + WS_ROUTE + RT_E); const int* rt_pos = (const int*)(ws + WS_ROUTE + RT_POS); const float* rt_gate = (const float*)(ws + WS_ROUTE + RT_GATE);
    const LAS int* moff = (const LAS int*)(F.lds + MOE_MAP_OFF);
    const int lane = F.lane; const float* n1g = inptr(I_N1G) + (last ? 0 : (l + 1) * D); const float* fgp = inptr(I_FG);
    for (int row0 = F.gw; row0 < nrows; row0 += 2 * F.NGW) {
        int s0[2], s1[2]; float w0[2], w1[2]; bool ok[2]; u32x2 ya[2][4], yb[2][4], xo[2][4];
#pragma unroll
        for (int u = 0; u < 2; ++u) { const int row = row0 + u * F.NGW; ok[u] = row < nrows; if (ok[u]) { s0[u] = moff[rt_e[2 * row]] + rt_pos[2 * row]; s1[u] = moff[rt_e[2 * row + 1]] + rt_pos[2 * row + 1]; w0[u] = rt_gate[2 * row]; w1[u] = rt_gate[2 * row + 1]; } }
#pragma unroll
        for (int u = 0; u < 2; ++u) if (ok[u]) { const int row = row0 + u * F.NGW;
#pragma unroll
            for (int j = 0; j < 4; ++j) { const int c = 4 * lane + 256 * j; ya[u][j] = *(const u32x2*)(Ys + (size_t)s0[u] * D + c); yb[u][j] = *(const u32x2*)(Ys + (size_t)s1[u] * D + c); xo[u][j] = *(const u32x2*)(X + (size_t)row * D + c); } }
#pragma unroll
        for (int u = 0; u < 2; ++u) if (ok[u]) { const int row = row0 + u * F.NGW; const int mr = modrow(row); f32x4 v[4];
#pragma unroll
            for (int j = 0; j < 4; ++j) { const int c = 4 * lane + 256 * j; float a[4], b[4]; unpack4(ya[u][j], a); unpack4(yb[u][j], b);
                const f32x4 g2 = *(const LAS f32x4*)(mg2 + mr * 1024 + c);
                f32x4 y; y.x = w0[u] * a[0] + w1[u] * b[0]; y.y = w0[u] * a[1] + w1[u] * b[1]; y.z = w0[u] * a[2] + w1[u] * b[2]; y.w = w0[u] * a[3] + w1[u] * b[3];
                float x_[4]; unpack4(xo[u][j], x_); v[j] = (f32x4){x_[0], x_[1], x_[2], x_[3]} + g2 * y; }
            if (DRY) { asm volatile("" :: "v"(v[0].x + v[1].y + v[2].z + v[3].w)); }
            else if (!last) {
#pragma unroll
                for (int j = 0; j < 4; ++j) *(u32x2*)(X + (size_t)row * D + 4 * lane + 256 * j) = (u32x2){pk2(v[j].x, v[j].y), pk2(v[j].z, v[j].w)};
                norm_mod_row(v, n1g, msc + mr * 1024, msh + mr * 1024, H + (size_t)row * D, lane);
            } else { float s = 0.f;
#pragma unroll
                for (int j = 0; j < 4; ++j) s += (v[j].x * v[j].x + v[j].y * v[j].y) + (v[j].z * v[j].z + v[j].w * v[j].w);
                const float rs = rsqrtf(wave_sum(s) * (1.f / D) + RMS_EPS);
#pragma unroll
                for (int j = 0; j < 4; ++j) { const int c = 4 * lane + 256 * j; const f32x4 g = *(const f32x4*)(fgp + c); *(f32x4*)(F.out + (size_t)row * D + c) = v[j] * rs * g; } } }
    }
}
__global__ void __launch_bounds__(NTHR, 2) fwd_megakernel(Params prm) {
    extern __shared__ __attribute__((aligned(16))) unsigned char lds_raw[];
    Frame F;
    F.lds = (LAS unsigned char*)lds_raw;
    F.tid = threadIdx.x; F.lane = F.tid & 63; F.wave = __builtin_amdgcn_readfirstlane(F.tid >> 6);
    F.G = gridDim.x; { const int bx = blockIdx.x; F.vcu = (F.G % 8 == 0) ? (bx % 8) * (F.G / 8) + bx / 8 : bx; }
    F.gw = F.vcu * NWAVES + F.wave; F.NGW = F.G * NWAVES;
    F.out = prm.out; F.ws = prm.ws;
    for (int u = F.tid; u < (LDS_BYTES - LDSCTL_OFF) / 4; u += NTHR) ((LAS unsigned*)(F.lds + LDSCTL_OFF))[u] = 0u;
    __syncthreads();
    (void)xcd_barrier_post((unsigned*)(F.ws + WS_CTL) + CW_BAR, (volatile LAS unsigned*)(F.lds + MISC_OFF) + 8);
#define GRID_BAR() do { XcdBarrier bar_; bar_.bar = (unsigned*)(opaque(F.ws) + WS_CTL) + CW_BAR; bar_.x = xb_xcc_id(); bar_.st = (volatile LAS unsigned*)(F.lds + MISC_OFF) + 8; xcd_barrier(bar_); } while (0)

    p0_prologue(F);
#if USE_CG_SYNC
    cg::this_grid().sync();
#else
    GRID_BAR();
#endif
    p0b_norm1(F);
    GRID_BAR();

    for (int l = 0; l < DEPTH; ++l) {
        const bool need_ctx = (l == 0); const int nrows = need_ctx ? NROW : NLAT;
#define WSO Fp.ws
        {
            const Frame Fp = phase_frame(F); unsigned char* const ws = WSO; bf16* Hb = (bf16*)(ws + WS_H); bf16* Pb = (bf16*)(ws + WS_P);
            pg8::Gemm g{Hb, (const bf16*)(ws + WS_WIN_T) + (size_t)l * NP * D, NROW, NP, D}; pg8::StaticOrder S; S.init(NROW, NP, Fp.G, (int)blockIdx.x);
            pg8::EpiStoreBf16 E{Pb, NP, 0xffff};
            pg8::gemm_phase<pg8::EpiStoreBf16, pg8::StaticOrder, true, true>(F.lds, g, S, E);
        }
        GRID_BAR();
        {
            const Frame Fp = phase_frame(F); unsigned char* const ws = WSO; bf16* Pb = (bf16*)(ws + WS_P);
            for (int it = blockIdx.x; it < 256; it += F.G) fftA_item(F, it);
            if (need_ctx) for (int it = (int)blockIdx.x - (F.G >= 64 ? F.G - 32 : 0); it >= 0 && it < 32; it += F.G) { const int b = it >> 4, m0 = (it & 15) * 16;
                const bf16* src0 = Pb + (size_t)(NLAT + b * CTXL) * NP + COL_FC;
                dft64_item<4, 256, 1>(F, l, m0, -1.f, 1.f / 128.f, [=](int t, int ri) { return src0 + (size_t)t * NP + ri * 256; }, [=](int m) { return NLAT + b * CTXL + m; }); }
            shift_pass(F, l);
            conv_pass(F, l, nrows);
        }
        GRID_BAR();
        {
            const Frame Fp = phase_frame(F); unsigned char* const ws = WSO;
            prep_phase(F, l);
        }
        GRID_BAR();
        for (int seg = -1; seg < NSEG; ++seg) {
            const bool split = (F.G == 256);
            if (seg + 1 < NSEG) pre_phase(F, seg + 1, (seg >= 0 && split) ? 128 : 0);
            if (seg + 1 == NSEG && (!split || blockIdx.x >= 128)) { unsigned char* const ws = opaque(F.ws); int bx_ = (int)blockIdx.x; asm volatile("" : "+s"(bx_));
                const int first_ = split ? bx_ - 128 : bx_, stride_ = split ? 128 : F.G;
                for (int it = first_; it < 256; it += stride_) { const int b = it >> 7, t1p = it & 127;
                    const bf16* src0 = (const bf16*)(ws + WS_GT) + (size_t)(b * 128 + t1p) * 64 * 512;
                    dft64_item<1, 64, 4>(F, l, 0, 1.f, 0.0013810679320049757f, [=](int t, int ri) { return src0 + (size_t)t * 512 + ri * 256; }, [=](int m) { return b * SEQ + t1p + 128 * m; }); } }
            if (seg >= 0) for (int it = blockIdx.x; it < 128; it += F.G) { const int x_ = it & 7, j_ = it >> 3;
                seq_item<0>(F, ((x_ + 8 * (j_ >> 2)) << 2) | (j_ & 3), seg, need_ctx); }
            GRID_BAR();
        }
        readout_pass(F, l, nrows);
        GRID_BAR();
        const int cv_lo = (nrows / 256) * 4 > F.G ? (nrows / 256) * 4 - F.G : 0;
        if (blockIdx.x & 1) expert_convert(F, l, cv_lo);
        {
            const Frame Fp = phase_frame(F); unsigned char* const ws = WSO; bf16* Hb = (bf16*)(ws + WS_H);
            pg8::Gemm g{Hb, (const bf16*)(ws + WS_WOUT_T) + (size_t)l * D * D, nrows, D, D}; pg8::StaticOrder S; S.init(nrows, D, Fp.G, (int)blockIdx.x);
            bf16* X = (bf16*)(ws + WS_X); const float* g1p = (const float*)(ws + WS_MODF) + (size_t)l * 3 * 6144 + 2 * 1024;
            if (l == 0) { pg8::EpiResidual<true> E{inptr(I_X), inptr(I_CTX), X, g1p}; pg8::gemm_phase<pg8::EpiResidual<true>, pg8::StaticOrder, true, true>(F.lds, g, S, E); }
            else { pg8::EpiResidual<false> E{X, X + (size_t)NLAT * D, X, g1p}; pg8::gemm_phase<pg8::EpiResidual<false>, pg8::StaticOrder, true, true>(F.lds, g, S, E); }
        }
        if (!(blockIdx.x & 1)) expert_convert(F, l, cv_lo);
        GRID_BAR();
        router_pass(F, l, nrows);
        GRID_BAR();
        {
            const Frame Fp = phase_frame(F); unsigned char* const ws = WSO;
            moe_map(F, l);
            const LAS int* mp = (const LAS int*)(F.lds + MOE_MAP_OFF);
            pg8::MoeOrder S{mp + 128, mp + 320, mp[64], Fp.G, (int)blockIdx.x};
            {   pg8::Gemm g{(const bf16*)(ws + WS_H), (const bf16*)(ws + WS_WGU_T), 0, 0, D, (const int*)(ws + WS_ELIST), NROW - 1};
                pg8::EpiSwiGLU E{(bf16*)(ws + WS_ACT)};
                pg8::gemm_phase<pg8::EpiSwiGLU, pg8::MoeOrder, true, true, true>(F.lds, g, S, E); }
            GRID_BAR();
            {   pg8::Gemm g{(const bf16*)(ws + WS_ACT), (const bf16*)(ws + WS_WD_T), 0, 0, DEXP};
                pg8::EpiStoreBf16 E{(bf16*)(ws + WS_XS), D, 3};
                pg8::gemm_phase<pg8::EpiStoreBf16, pg8::MoeOrder, true, true>(F.lds, g, S, E); }
        }
        GRID_BAR();
        combine_pass<false>(F, l, nrows);
        if (l + 1 < DEPTH) GRID_BAR();
    }
}

extern "C" void kernel_launch(void* const* d_in, const int* in_sizes, int n_in, void* d_out, int out_size, void* d_ws, size_t ws_size, hipStream_t stream) {
    static int grid = 0;
    if (grid == 0) {
        if (n_in != N_IN || in_sizes[0] != NLAT * D || out_size != NLAT * D || ws_size < WS_END) {
            fprintf(stderr, "kernel_launch: unexpected shapes (n_in %d in0 %d out %d ws %zu)\n", n_in, n_in > 0 ? in_sizes[0] : -1, out_size, ws_size); grid = -1; return; }
        int dev = 0, cus = 0, per_cu = 0;
        hipGetDevice(&dev); hipDeviceGetAttribute(&cus, hipDeviceAttributeMultiprocessorCount, dev);
        hipFuncSetAttribute((const void*)fwd_megakernel, hipFuncAttributeMaxDynamicSharedMemorySize, LDS_BYTES);
        hipOccupancyMaxActiveBlocksPerMultiprocessor(&per_cu, (const void*)fwd_megakernel, NTHR, LDS_BYTES);
        if (per_cu < 1) { fprintf(stderr, "kernel_launch: occupancy query says %d blocks per CU\n", per_cu); per_cu = 1; }
        (void)hipGetLastError();
        grid = cus * per_cu;
    }
    if (grid < 0) return;
    hipMemsetAsync((char*)d_ws + WS_CTL, 0, CTL_ZERO_BYTES, stream);
    Params p{};
    for (int i = 0; i < N_IN; ++i) p.in[i] = (const float*)d_in[i];
    p.out = (float*)d_out; p.ws = (unsigned char*)d_ws;
    void* args[] = {&p};
    hipError_t e = hipLaunchCooperativeKernel((const void*)fwd_megakernel, dim3(grid), dim3(NTHR), args, LDS_BYTES, stream);
    if (e != hipSuccess) fprintf(stderr, "kernel_launch: cooperative launch failed: %s (grid %d)\n", hipGetErrorString(e), grid);
}
```

```cpp
#include <hip/hip_runtime.h>
#include <hip/hip_cooperative_groups.h>
#include <cstdio>
#include <cstdint>
namespace cg = cooperative_groups;
#define USE_CG_SYNC 0
#define SEQ_PROBE 0
#define SEQ_PROBE_PRE 0
namespace pg8 {
#define PG8_LAS __attribute__((address_space(3)))
typedef unsigned short bf16_t;
typedef short bf16x8 __attribute__((ext_vector_type(8)));
typedef float f32x4 __attribute__((ext_vector_type(4)));
typedef unsigned u32x4 __attribute__((ext_vector_type(4)));
constexpr int BM = 256, BK = 64, HALF = 128, HTB = HALF * BK * 2  , STAGE_BYTES = 8 * HTB, NXCD = 8, WGM = 8;

__host__ __device__ __forceinline__ int lds_byte(int r, int c) { const int st = (r >> 4) * 2 + (c >> 5), rr = r & 15, cc = c & 31, ob = rr * 64 + cc * 2; return st * 1024 + (ob ^ (((ob >> 9) & 1) << 5)); }
__host__ __device__ __forceinline__ void stage_rc(int b, int& R, int& C) { const int st = b / 1024, sb = b % 1024, swz = sb ^ (((sb >> 9) & 1) << 5); R = (st >> 1) * 16 + swz / 64; C = (st & 1) * 32 + (swz % 64) / 2; }
__host__ __device__ __forceinline__ int perm32(int rho) { const int n = rho >> 4, i = rho & 15; return 8 * (i >> 2) + 4 * n + (i & 3); }

struct Unit { int pm, pn, ga; };
struct Gemm { const bf16_t* A; const bf16_t* Bt; int M, N, K; const int* gidx; int gmax; };

struct StaticOrder {
    int nM, nN, nwg, G, c;
    __host__ __device__ void init(int M, int N, int G_, int c_) { nM = M / BM; nN = N / BM; nwg = nM * nN; G = G_; c = c_; }
    __host__ __device__ bool next(int i, Unit& u) const {
        const long L = (long)i * G + c; if (L >= nwg) return false;
        int wgid = (int)L; { const int q = nwg / NXCD, r = nwg % NXCD, xcd = wgid % NXCD, off = wgid / NXCD; wgid = (xcd < r ? xcd * (q + 1) : r * (q + 1) + (xcd - r) * q) + off; }
        const int nig = WGM * nN, gid = wgid / nig, fm = gid * WGM, gsz = (nM - fm) < WGM ? (nM - fm) : WGM;
        u.pm = fm + ((wgid % nig) % gsz); u.pn = (wgid % nig) / gsz; return true;
    }
    __device__ __forceinline__ void a_ready(const Unit&) const {}
    __device__ __forceinline__ void done(const Unit&) const {}
};

__device__ __forceinline__ unsigned cvt_pk_bf16(float lo, float hi) { unsigned r; asm volatile("v_cvt_pk_bf16_f32 %0, %1, %2" : "=v"(r) : "v"(lo), "v"(hi)); return r; }
typedef float f32x2 __attribute__((ext_vector_type(2)));
template <class Epi, class Sched, bool ALIGN_EPI = false, bool SP2 = false, bool GATHER = false>
__device__ __forceinline__ void gemm_phase(PG8_LAS unsigned char* lds, const Gemm g, const Sched& S, const Epi& E) {
    int tid = threadIdx.x; asm volatile("" : "+v"(tid));
    const int wid = __builtin_amdgcn_readfirstlane(tid >> 6), lane = tid & 63, wr = wid >> 2, wc = wid & 3, fr = lane & 15, fq = lane >> 4;
    const int K = g.K, nt = K / BK;
    unsigned voffA[2], voffB[2];
#pragma unroll
    for (int i = 0; i < 2; ++i) { int R, C; stage_rc(tid * 16 + i * 8192, R, C); const int Rb = Epi::PERM ? ((R & ~31) + perm32(R & 31)) : R;
        voffA[i] = (unsigned)(R * K + C) * 2u; voffB[i] = (unsigned)(Rb * K + C) * 2u; }
    static_assert(!GATHER || SP2, "GATHER is implemented for the SP2 loop");
    unsigned gcur[2][2], gnx[2][2];
#define PG8_GOFF(go, u_) do { _Pragma("unroll") for (int h_ = 0; h_ < 2; ++h_) _Pragma("unroll") for (int i_ = 0; i_ < 2; ++i_) { int R_, C_; stage_rc(tid * 16 + i_ * 8192, R_, C_); \
        int ri_ = g.gidx[(u_).ga + h_ * HALF + R_]; ri_ = ri_ < 0 ? 0 : (ri_ > g.gmax ? g.gmax : ri_); go[h_][i_] = (unsigned)ri_ * (unsigned)(K * 2) + (unsigned)C_ * 2u; } } while (0)
    const size_t kstep = (size_t)(BK * 2);
    const size_t hstep = (size_t)HALF * K * 2;
    const size_t tstep = 2 * hstep;
    const unsigned ldsw = (unsigned)wid * 1024u;
    const int aoff = lds_byte(wr * 64 + fr, fq * 8), boff = lds_byte(wc * 32 + fr, fq * 8);
#define PG8_SA(b, h) (((b) * 2 + (h)) * HTB)
#define PG8_SB(b, h) ((4 + (b) * 2 + (h)) * HTB)
#define PG8_STAGE(bufoff, gbase, voff) do { _Pragma("unroll") for (int _i = 0; _i < 2; ++_i) \
        __builtin_amdgcn_global_load_lds((const unsigned*)((const char*)(gbase) + (voff)[_i]), (PG8_LAS unsigned*)(lds + (bufoff) + ldsw + _i * 8192), 16, 0, 0); } while (0)
#define PG8_LDA(dst, b, h) do { _Pragma("unroll") for (int m = 0; m < 4; ++m) _Pragma("unroll") for (int k = 0; k < 2; ++k) dst[m][k] = *(const PG8_LAS bf16x8*)(lds + PG8_SA(b, h) + aoff + m * 2048 + k * 1024); } while (0)
#define PG8_LDB(dst, b, h) do { _Pragma("unroll") for (int n = 0; n < 2; ++n) _Pragma("unroll") for (int k = 0; k < 2; ++k) dst[n][k] = *(const PG8_LAS bf16x8*)(lds + PG8_SB(b, h) + boff + n * 2048 + k * 1024); } while (0)
#define PG8_MMA(ai, bj, At, Bt) do { __builtin_amdgcn_s_setprio(1); _Pragma("unroll") for (int m = 0; m < 4; ++m) _Pragma("unroll") for (int n = 0; n < 2; ++n) _Pragma("unroll") for (int k = 0; k < 2; ++k) \
        acc[ai][bj][m][n] = __builtin_amdgcn_mfma_f32_16x16x32_bf16(Bt[n][k], At[m][k], acc[ai][bj][m][n], 0, 0, 0); __builtin_amdgcn_s_setprio(0); } while (0)
#define PG8_WAIT_V(n) asm volatile("s_waitcnt vmcnt(" #n ")" ::: "memory")
#define PG8_WAIT_L(n) asm volatile("s_waitcnt lgkmcnt(" #n ")" ::: "memory")
#define PG8_BAR __builtin_amdgcn_s_barrier()
#define PG8_SCHED __builtin_amdgcn_sched_barrier(0)
    Unit cur, nxt; int ui = 0;
    if (!S.next(0, cur)) return;
    f32x4 acc[2][2][4][2];
#pragma unroll
    for (int a = 0; a < 2; ++a)
#pragma unroll
        for (int b = 0; b < 2; ++b)
#pragma unroll
            for (int m = 0; m < 4; ++m)
#pragma unroll
                for (int n = 0; n < 2; ++n) acc[a][b][m][n] = (f32x4){0.f, 0.f, 0.f, 0.f};
    bf16x8 At[4][2], B0[2][2], B1[2][2];
    const char* cA = (const char*)g.A + (size_t)cur.pm * tstep; const char* cB = (const char*)g.Bt + (size_t)cur.pn * tstep;
    S.a_ready(cur);
    const char* gA = (const char*)g.A;
    if constexpr (GATHER) PG8_GOFF(gcur, cur);
    if constexpr (SP2) {
        PG8_STAGE(PG8_SB(0, 0), cB, voffB); PG8_STAGE(PG8_SB(0, 1), cB + hstep, voffB);
        if constexpr (GATHER) { PG8_STAGE(PG8_SA(0, 0), gA, gcur[0]); PG8_STAGE(PG8_SA(0, 1), gA, gcur[1]); } else { PG8_STAGE(PG8_SA(0, 0), cA, voffA); PG8_STAGE(PG8_SA(0, 1), cA + hstep, voffA); }
        if (wr == 1) PG8_BAR;
        PG8_WAIT_V(2); PG8_BAR;
        PG8_STAGE(PG8_SB(1, 0), cB + kstep, voffB); if constexpr (GATHER) PG8_STAGE(PG8_SA(1, 0), gA + kstep, gcur[0]); else PG8_STAGE(PG8_SA(1, 0), cA + kstep, voffA); PG8_STAGE(PG8_SB(1, 1), cB + hstep + kstep, voffB);
        PG8_WAIT_V(6); PG8_BAR;
    } else {
        PG8_STAGE(PG8_SB(0, 0), cB, voffB); PG8_STAGE(PG8_SA(0, 0), cA, voffA); PG8_STAGE(PG8_SB(0, 1), cB + hstep, voffB); PG8_STAGE(PG8_SA(0, 1), cA + hstep, voffA);
        if (wr == 1) PG8_BAR;
        PG8_WAIT_V(4); PG8_BAR;
        PG8_STAGE(PG8_SB(1, 0), cB + kstep, voffB); PG8_STAGE(PG8_SA(1, 0), cA + kstep, voffA); PG8_STAGE(PG8_SB(1, 1), cB + hstep + kstep, voffB);
        PG8_WAIT_V(6); PG8_BAR;
    }
    for (;;) {
        const bool has_next = S.next(ui + 1, nxt);
        if constexpr (GATHER) { if (has_next) PG8_GOFF(gnx, nxt); else { gnx[0][0] = gcur[0][0]; gnx[0][1] = gcur[0][1]; gnx[1][0] = gcur[1][0]; gnx[1][1] = gcur[1][1]; } }
        const char* nA = has_next ? (const char*)g.A + (size_t)nxt.pm * tstep : cA; const char* nB = has_next ? (const char*)g.Bt + (size_t)nxt.pn * tstep : cB;
        for (int t = 0; t < nt; t += 2) {
            const bool last = (t == nt - 2);
            const char* a1 = cA + (size_t)(t + 1) * kstep;
            const char* a2 = last ? nA : cA + (size_t)(t + 2) * kstep; const char* b2 = last ? nB : cB + (size_t)(t + 2) * kstep;
            const char* a3 = a2 + kstep; const char* b3 = b2 + kstep;
            if (last && has_next) S.a_ready(nxt);
            unsigned ga0[2], ga1[2]; const char* g1 = gA; const char* g2 = gA; const char* g3 = gA;
            if constexpr (GATHER) { g1 = gA + (size_t)(t + 1) * kstep; g2 = last ? gA : gA + (size_t)(t + 2) * kstep; g3 = g2 + kstep;
                ga0[0] = last ? gnx[0][0] : gcur[0][0]; ga0[1] = last ? gnx[0][1] : gcur[0][1]; ga1[0] = last ? gnx[1][0] : gcur[1][0]; ga1[1] = last ? gnx[1][1] : gcur[1][1]; }
            if constexpr (SP2) {
            PG8_LDB(B0, 0, 0); PG8_LDB(B1, 0, 1); PG8_SCHED; PG8_LDA(At, 0, 0); if constexpr (GATHER) PG8_STAGE(PG8_SA(1, 1), g1, gcur[1]); else PG8_STAGE(PG8_SA(1, 1), a1 + hstep, voffA);
            PG8_WAIT_V(8); PG8_WAIT_L(0); PG8_BAR; PG8_MMA(0, 0, At, B0); PG8_MMA(0, 1, At, B1); PG8_BAR; PG8_SCHED;
            PG8_LDA(At, 0, 1); PG8_STAGE(PG8_SB(0, 0), b2, voffB); PG8_STAGE(PG8_SB(0, 1), b2 + hstep, voffB); if constexpr (GATHER) PG8_STAGE(PG8_SA(0, 0), g2, ga0); else PG8_STAGE(PG8_SA(0, 0), a2, voffA);
            PG8_WAIT_V(8); PG8_WAIT_L(0); PG8_BAR; PG8_MMA(1, 0, At, B0); PG8_MMA(1, 1, At, B1); PG8_BAR; PG8_SCHED;
            PG8_LDB(B0, 1, 0); PG8_LDB(B1, 1, 1); PG8_SCHED; PG8_LDA(At, 1, 0); if constexpr (GATHER) PG8_STAGE(PG8_SA(0, 1), g2, ga1); else PG8_STAGE(PG8_SA(0, 1), a2 + hstep, voffA);
            PG8_WAIT_V(8); PG8_WAIT_L(0); PG8_BAR; PG8_MMA(0, 0, At, B0); PG8_MMA(0, 1, At, B1); PG8_BAR; PG8_SCHED;
            PG8_LDA(At, 1, 1); PG8_STAGE(PG8_SB(1, 0), b3, voffB); PG8_STAGE(PG8_SB(1, 1), b3 + hstep, voffB); if constexpr (GATHER) PG8_STAGE(PG8_SA(1, 0), g3, ga0); else PG8_STAGE(PG8_SA(1, 0), a3, voffA);
            PG8_WAIT_V(8); PG8_WAIT_L(0); PG8_BAR; PG8_MMA(1, 0, At, B0); PG8_MMA(1, 1, At, B1); PG8_BAR; PG8_SCHED;
            } else {
            PG8_LDB(B0, 0, 0); PG8_SCHED; PG8_LDA(At, 0, 0); PG8_STAGE(PG8_SA(1, 1), a1 + hstep, voffA);
            PG8_WAIT_L(8); PG8_BAR; PG8_WAIT_L(0); PG8_MMA(0, 0, At, B0); PG8_BAR; PG8_SCHED;
            PG8_LDB(B1, 0, 1); PG8_STAGE(PG8_SB(0, 0), b2, voffB);
            PG8_BAR; PG8_WAIT_L(0); PG8_MMA(0, 1, At, B1); PG8_BAR;
            PG8_LDA(At, 0, 1); PG8_STAGE(PG8_SA(0, 0), a2, voffA);
            PG8_BAR; PG8_WAIT_L(0); PG8_MMA(1, 0, At, B0); PG8_BAR; PG8_SCHED;
            PG8_STAGE(PG8_SB(0, 1), b2 + hstep, voffB);
            PG8_WAIT_V(6); PG8_BAR; PG8_MMA(1, 1, At, B1); PG8_BAR;
            PG8_LDB(B0, 1, 0); PG8_SCHED; PG8_LDA(At, 1, 0); PG8_STAGE(PG8_SA(0, 1), a2 + hstep, voffA);
            PG8_WAIT_L(8); PG8_BAR; PG8_WAIT_L(0); PG8_MMA(0, 0, At, B0); PG8_BAR; PG8_SCHED;
            PG8_LDB(B1, 1, 1); PG8_STAGE(PG8_SB(1, 0), b3, voffB);
            PG8_BAR; PG8_WAIT_L(0); PG8_MMA(0, 1, At, B1); PG8_BAR;
            PG8_LDA(At, 1, 1); PG8_STAGE(PG8_SA(1, 0), a3, voffA);
            PG8_BAR; PG8_WAIT_L(0); PG8_MMA(1, 0, At, B0); PG8_BAR; PG8_SCHED;
            PG8_STAGE(PG8_SB(1, 1), b3 + hstep, voffB);
            PG8_WAIT_V(6); PG8_BAR; PG8_MMA(1, 1, At, B1); PG8_BAR;
            }
        }
        if constexpr (ALIGN_EPI) { if (wr == 0) PG8_BAR; }
        if constexpr (!Epi::AFTER_DRAIN) { E(acc, cur, wr, wc, fr, fq); S.done(cur); }
        if (!has_next) break;
#pragma unroll
        for (int a = 0; a < 2; ++a)
#pragma unroll
            for (int b = 0; b < 2; ++b)
#pragma unroll
                for (int m = 0; m < 4; ++m)
#pragma unroll
                    for (int n = 0; n < 2; ++n) acc[a][b][m][n] = (f32x4){0.f, 0.f, 0.f, 0.f};
        cur = nxt; cA = nA; cB = nB; ++ui;
        if constexpr (GATHER) { gcur[0][0] = gnx[0][0]; gcur[0][1] = gnx[0][1]; gcur[1][0] = gnx[1][0]; gcur[1][1] = gnx[1][1]; }
        if constexpr (ALIGN_EPI) { if (wr == 1) PG8_BAR; }
    }
    PG8_WAIT_V(0);
    if constexpr (!ALIGN_EPI) { if (wr == 0) PG8_BAR; }
    PG8_BAR;
    if constexpr (Epi::AFTER_DRAIN) { E.fused(acc, cur, wr, wc, fr, fq, lds, wid, lane); S.done(cur); }
#undef PG8_GOFF
#undef PG8_SA
#undef PG8_SB
#undef PG8_STAGE
#undef PG8_LDA
#undef PG8_LDB
#undef PG8_MMA
#undef PG8_WAIT_V
#undef PG8_WAIT_L
#undef PG8_BAR
#undef PG8_SCHED
}
}
#define LAS __attribute__((address_space(3)))
typedef unsigned short bf16;
typedef float f32x4 __attribute__((ext_vector_type(4)));
typedef short bf16x8 __attribute__((ext_vector_type(8)));
typedef unsigned u32x4 __attribute__((ext_vector_type(4)));
typedef unsigned u32x2 __attribute__((ext_vector_type(2)));

__device__ __forceinline__ void stg16(void* p, u32x4 v) { asm volatile("global_store_dwordx4 %0, %1, off sc1\n\ts_nop 0" :: "v"(p), "v"(v)); }
__device__ __forceinline__ void stg8(void* p, u32x2 v) { asm volatile("global_store_dwordx2 %0, %1, off sc1\n\ts_nop 0" :: "v"(p), "v"(v)); }
__device__ __forceinline__ void stg4(void* p, float v) { asm volatile("global_store_dword %0, %1, off sc1\n\ts_nop 0" :: "v"(p), "v"(v)); }

constexpr int D = 1024, NBATCH = 2, SEQ = 8192, CTXL = 256, DEPTH = 2;
constexpr int NLAT = NBATCH * SEQ, NCTX = NBATCH * CTXL, NROW = NLAT + NCTX;
constexpr int DR = 512, DIN = 2944, NP = 3328, ZW = 1920, NHEAD = 8;
constexpr int COL_CONV = 1920, COL_FC = 2688, COL_FS = 2944;
constexpr int STRW = 5120;
constexpr int NEXP = 32, DEXP = 512;
constexpr int MOE_MAXTILES = 168;
constexpr float RMS_EPS = 1e-6f, GN_EPS = 64e-5f;

enum { I_X = 0, I_C, I_CTX, I_CCTX, I_ADAW, I_ADAB, I_N1G, I_N2G, I_WIN, I_MU, I_DW0, I_DW2, I_IA0, I_IA2, I_GG2, I_KK, I_KA, I_RK, I_GNW, I_GNB,
       I_CONVW, I_CONVG, I_FOURG, I_WOUT, I_RGW, I_RGB, I_REW, I_REB, I_EG, I_EU, I_ED, I_FG, N_IN };

constexpr size_t MiB = 1u << 20;
constexpr size_t WS_CTL = 0, CTL_ZERO_BYTES = 64 * 1024;
constexpr size_t WS_MODP = 1 * MiB;
constexpr size_t WS_MODF = 1 * MiB + 1280 * 1024;
constexpr size_t WS_WIN_T = 3 * MiB;
constexpr size_t WS_WOUT_T = 16 * MiB;
constexpr size_t WS_WGU_T = 20 * MiB;
constexpr size_t WS_WD_T = 84 * MiB;
constexpr size_t WS_X = 116 * MiB;
constexpr size_t WS_H = 182 * MiB;
constexpr size_t WS_ZS = 215 * MiB;
constexpr size_t WS_P = 277 * MiB;
constexpr size_t WS_STR = 277 * MiB;
constexpr size_t WS_Y = 442 * MiB;
constexpr size_t WS_GT = 475 * MiB;
constexpr size_t WS_ROUTE = 491 * MiB;
constexpr size_t WS_XS = 215 * MiB;
constexpr size_t WS_ACT = 299 * MiB;
constexpr size_t WS_ELIST = 340 * MiB;
constexpr size_t WS_END = 530 * MiB;
constexpr size_t RT_E = 0, RT_POS = 1 * 33792 * 4, RT_GATE = 2 * 33792 * 4, RT_SLOT = 3 * 33792 * 4, RT_TILE = 4 * 33792 * 4, RT_NT = RT_TILE + 1024;

constexpr int CW_BAR = 4096;
constexpr int CW_CNT = 8192;
constexpr int CW_TRDY = 9216;
constexpr int CW_TMO2 = 15360;
constexpr int CW_SCANF = 15872;

constexpr int NWAVES = 8, NTHR = 512;
#ifndef CONV_P_PER_WAVE
#define CONV_P_PER_WAVE 1
#endif
#ifndef CONV_A_ITEMS
#define CONV_A_ITEMS 2048
#endif
constexpr int RING_BYTES = 131072, LDSCTL_OFF = 143360, MISC_OFF = LDSCTL_OFF + 320, LDS_BYTES = 147456;

struct Params { const float* in[N_IN]; float* out; unsigned char* ws; };

__device__ __forceinline__ float bf2f(unsigned h) { return __uint_as_float(h << 16); }
typedef __bf16 hwbf2 __attribute__((ext_vector_type(2)));
typedef float f32x2 __attribute__((ext_vector_type(2)));
__device__ __forceinline__ unsigned pk2(float lo, float hi) { const f32x2 x = {lo, hi}; const hwbf2 r = __builtin_convertvector(x, hwbf2); return __builtin_bit_cast(unsigned, r); }
__device__ __forceinline__ unsigned f2bf(float f) { return pk2(f, 0.f) & 0xffffu; }
__device__ __forceinline__ float wave_sum(float v) {
#pragma unroll
    for (int o = 1; o < 64; o <<= 1) v += __shfl_xor(v, o);
    return v;
}
__device__ __forceinline__ float sigmoidf_(float x) { return 1.f / (1.f + __expf(-x)); }
#define LDS_WAIT() asm volatile("s_waitcnt lgkmcnt(0)" ::: "memory")
#define VM_WAIT() asm volatile("s_waitcnt vmcnt(0)" ::: "memory")

struct Frame {
    LAS unsigned char* lds;
    int tid, lane, wave, vcu, G, gw, NGW;
    float* out; unsigned char* ws;
};
#if defined(__HIP_DEVICE_COMPILE__)
#define ASSUME_GLOBAL(p) do { __builtin_assume(!__builtin_amdgcn_is_shared(p)); __builtin_assume(!__builtin_amdgcn_is_private(p)); } while (0)
#else
#define ASSUME_GLOBAL(p) do { } while (0)
#endif
__device__ __forceinline__ const float* inptr(int i) {
    const volatile unsigned long long __attribute__((address_space(4)))* ka = (const volatile unsigned long long __attribute__((address_space(4)))*)__builtin_amdgcn_kernarg_segment_ptr();
    return (const float*)(const __attribute__((address_space(1))) float*)ka[i];
}
__device__ __forceinline__ unsigned char* opaque(unsigned char* p) { unsigned long z = 0; asm volatile("" : "+s"(z)); return p + z; }
__device__ __forceinline__ Frame phase_frame(const Frame& F0) { Frame F = F0; asm volatile("" : "+v"(F.tid)); F.lane = F.tid & 63; F.ws = opaque(F0.ws);
    asm volatile("" : "+s"(F.G), "+s"(F.vcu)); F.gw = F.vcu * NWAVES + F.wave; F.NGW = F.G * NWAVES; return F; }
__device__ __forceinline__ int modrow(int row) { return row < NLAT ? (row >> 13) : 2; }
#define XB_TMO      128
#define XB_XCNT(j)  (256  + 64 * (j))
#define XB_XSUB(j)  (1280 + 64 * (j))
#define XB_XGEN(j)  (2304 + 64 * (j))
#define XB_TOP      3328
#define XB_TOPGEN   3392
#define XCD_BAR_WORDS 3456
#define XB_SPIN_CAP (1u << 18)

__device__ __forceinline__ unsigned xb_ld(unsigned* p)              { return __hip_atomic_load(p, __ATOMIC_RELAXED, __HIP_MEMORY_SCOPE_AGENT); }
__device__ __forceinline__ unsigned xb_add(unsigned* p, unsigned v) { return __hip_atomic_fetch_add(p, v, __ATOMIC_RELAXED, __HIP_MEMORY_SCOPE_AGENT); }
__device__ __forceinline__ unsigned xb_xcc_id() { return (unsigned)__builtin_amdgcn_s_getreg((3 << 11) | 20) & 0xFu; }
#define XB_SPIN(cond, bar) do { unsigned _sp = 0; while (cond) { __builtin_amdgcn_s_sleep(1); \
    if ((++_sp & 255u) == 0u) { if (xb_ld(&(bar)[XB_TMO])) break; if (_sp > XB_SPIN_CAP) { atomicAdd(&(bar)[XB_TMO], 1u); break; } } } } while (0)

struct XcdBarrier {
    unsigned* bar; unsigned x;
    volatile LAS unsigned* st;
};

__device__ __forceinline__ XcdBarrier xcd_barrier_post(unsigned* bar, volatile LAS unsigned* st) {
    XcdBarrier b; b.bar = bar; b.x = xb_xcc_id(); b.st = st;
    if (threadIdx.x == 0) (void)xb_add(&bar[XB_XCNT(b.x)], 1u);
    return b;
}
__device__ __forceinline__ void xcd_barrier_complete(unsigned* bar, unsigned x, unsigned& nloc, unsigned& nx) {
    const unsigned G = gridDim.x * gridDim.y * gridDim.z;
    unsigned sum, cnt, mine, sp = 0u;
    for (;;) {
        sum = 0u; cnt = 0u; mine = 0u;
#pragma nounroll
        for (unsigned j = 0; j < 16; ++j) { const unsigned c = xb_ld(&bar[XB_XCNT(j)]); sum += c; cnt += (c > 0u) ? 1u : 0u; mine = (j == x) ? c : mine; }
        if (sum == G) break;
        __builtin_amdgcn_s_sleep(1);
        if ((++sp & 255u) == 0u) { if (xb_ld(&bar[XB_TMO])) break; if (sp > XB_SPIN_CAP) { atomicAdd(&bar[XB_TMO], 1u); break; } }
    }
    nloc = mine > 0u ? mine : 1u; nx = cnt > 0u ? cnt : 1u;
}

__device__ __forceinline__ void xcd_barrier(const XcdBarrier& b) {
    asm volatile("s_waitcnt vmcnt(0)" ::: "memory");
    __syncthreads();
    if (threadIdx.x == 0) {
        unsigned* bar = b.bar;
        asm volatile("" : "+s"(bar));
        __builtin_amdgcn_s_waitcnt(0);
        unsigned nloc = b.st[0], nx = b.st[1];
        if (nloc == 0u) { xcd_barrier_complete(bar, b.x, nloc, nx); b.st[0] = nloc; b.st[1] = nx; }
        const unsigned old = xb_add(&bar[XB_XSUB(b.x)], 1u);
        const unsigned gen = old / nloc;
        if (old + 1u == (gen + 1u) * nloc) {
            __builtin_amdgcn_fence(__ATOMIC_RELEASE, "agent");
            asm volatile("s_waitcnt vmcnt(0)" ::: "memory");
            const unsigned og = xb_add(&bar[XB_TOP], 1u);
            const unsigned tg = og / nx;
            if (og + 1u == (tg + 1u) * nx) xb_add(&bar[XB_TOPGEN], 1u);
            else XB_SPIN(xb_ld(&bar[XB_TOPGEN]) == tg, bar);
            __builtin_amdgcn_fence(__ATOMIC_ACQUIRE, "agent");
            xb_add(&bar[XB_XGEN(b.x)], 1u);
            asm volatile("s_waitcnt vmcnt(0)" ::: "memory");
        } else {
            XB_SPIN(xb_ld(&bar[XB_XGEN(b.x)]) == gen, bar);
            __builtin_amdgcn_fence(__ATOMIC_ACQUIRE, "agent");
            asm volatile("s_waitcnt vmcnt(0)" ::: "memory");
        }
    }
    __syncthreads();
}

__device__ __forceinline__ void flag_wait(unsigned* p, unsigned need, unsigned* tmo) {
    if (threadIdx.x < 64) { unsigned polls = 0;
        while ((unsigned)__builtin_amdgcn_readfirstlane(xb_ld(p)) < need) {
            if ((++polls & 255u) == 0u) { if (__builtin_amdgcn_readfirstlane(xb_ld(tmo)) != 0u) break; if (polls > XB_SPIN_CAP) { if (threadIdx.x == 0) atomicAdd(tmo, 1u); break; } }
            __builtin_amdgcn_s_sleep(24); }
        __builtin_amdgcn_fence(__ATOMIC_ACQUIRE, "agent");
        asm volatile("s_waitcnt vmcnt(0)" ::: "memory"); }
    __syncthreads();
}
__device__ __forceinline__ void flag_publish(unsigned* p) {
    asm volatile("s_waitcnt vmcnt(0)" ::: "memory");
    __syncthreads();
    if (threadIdx.x == 0) (void)xb_add(p, 1u);
}
__device__ __forceinline__ void flag_signal(unsigned* p) {
    asm volatile("s_waitcnt vmcnt(0)" ::: "memory");
    __syncthreads();
    if (threadIdx.x == 0) (void)xb_add(p, 1u);
}
template <class RowMap>
__device__ __forceinline__ void transpose_item(const float* W, int ldw, int k0, int n0, bf16* WT, int ldt, RowMap rm, LAS float* scr, int lane) {
    (void)scr;
    const int nq = lane & 7, kg = lane >> 3; const float* src = W + (size_t)(k0 + 8 * kg) * ldw + n0 + 4 * nq;
    f32x4 v[8];
#pragma unroll
    for (int i = 0; i < 8; ++i) v[i] = *(const f32x4*)(src + (size_t)i * ldw);
#pragma unroll
    for (int j = 0; j < 4; ++j) { u32x4 o = {pk2(v[0][j], v[1][j]), pk2(v[2][j], v[3][j]), pk2(v[4][j], v[5][j]), pk2(v[6][j], v[7][j])};
        *(u32x4*)(WT + (size_t)rm(n0 + 4 * nq + j) * ldt + k0 + 8 * kg) = o; }
}
template <int U, class RowMap>
__device__ __forceinline__ void transpose_item_u(const float* W, int ldw, int k0, int n0, bf16* WT, int ldt, RowMap rm, int lane) {
    const int nq = lane & 7, kg = lane >> 3; const float* src = W + (size_t)(k0 + 8 * kg) * ldw + n0 + 4 * nq;
    f32x4 v[U][8];
#pragma unroll
    for (int u = 0; u < U; ++u)
#pragma unroll
        for (int i = 0; i < 8; ++i) v[u][i] = __builtin_nontemporal_load((const f32x4*)(src + (size_t)i * ldw + 32 * u));
#pragma unroll
    for (int u = 0; u < U; ++u)
#pragma unroll
        for (int j = 0; j < 4; ++j) { u32x4 o = {pk2(v[u][0][j], v[u][1][j]), pk2(v[u][2][j], v[u][3][j]), pk2(v[u][4][j], v[u][5][j]), pk2(v[u][6][j], v[u][7][j])};
            *(u32x4*)(WT + (size_t)rm(n0 + 32 * u + 4 * nq + j) * ldt + k0 + 8 * kg) = o; }
}
struct RmId { int off; __device__ __forceinline__ int operator()(int n) const { return off + n; } };
struct RmGU { int off; __device__ __forceinline__ int operator()(int n) const { return off + ((n >> 2) << 3) + (n & 3); } };

__device__ __forceinline__ void p0_prologue(const Frame& F0) {
    const Frame F = phase_frame(F0); unsigned char* const ws = F.ws;
    LAS float* scr = (LAS float*)(F.lds + F.wave * 16384);
    LAS float* ctab = (LAS float*)(F.lds + 8 * 16384);
    if (F.tid < 64) ctab[F.tid] = cosf((float)F.tid * (6.283185307179586f / 64.f));
    __syncthreads();
    bf16* win_t = (bf16*)(ws + WS_WIN_T); bf16* wout_t = (bf16*)(ws + WS_WOUT_T);
    constexpr int I_WIN_L = 16 * 21, I_WOUT_L = 16 * 8, I_FOLD_L = 4 * 64, I_MOD_L = 96 * 8;
    constexpr int NIT = 2 * (I_WIN_L + I_WOUT_L + I_FOLD_L + I_MOD_L);
    const float* p_win = inptr(I_WIN); const float* p_wout = inptr(I_WOUT); const float* p_c = inptr(I_C); const float* p_cctx = inptr(I_CCTX); const float* p_adaw = inptr(I_ADAW);
    {
        bf16* wl = (bf16*)(ws + 64 * 1024); const float* dw2 = inptr(I_DW2); const float* ia2 = inptr(I_IA2); const float* gg2 = inptr(I_GG2);
        for (int idx = F.vcu * NTHR + F.tid; idx < 2 * 384 * 512; idx += F.G * NTHR) { const int c = idx & 511, k = (idx >> 9) % 384, l = idx / (384 * 512);
            float v;
            if (k < 128) v = dw2[((size_t)(l * 2 + (k >> 6)) * 64 + (k & 63)) * DR + c];
            else if (k < 256) v = ia2[((size_t)(l * 2 + ((k - 128) >> 6)) * 64 + (k & 63)) * DR + c];
            else v = gg2[((size_t)l * 128 + (k - 256)) * DR + c];
            wl[((size_t)l * 512 + c) * 384 + k] = (bf16)f2bf(v); } }
    for (int it = F.gw; it < NIT; it += F.NGW) {
        int r = it; const int l = r & 1; r >>= 1;
        r = r < I_MOD_L + I_FOLD_L ? r + I_WIN_L + I_WOUT_L : r - (I_MOD_L + I_FOLD_L);
        if (r < I_WIN_L) { const int kb = r / 21, nb = r % 21;
            transpose_item_u<4>(p_win + (size_t)l * D * DIN, DIN, kb * 64, nb * 128, win_t + (size_t)l * NP * D, D, RmId{0}, F.lane); continue; }
        r -= I_WIN_L;
        if (r < I_WOUT_L) { const int kb = r / 8, nb = r % 8;
            transpose_item_u<4>(p_wout + (size_t)l * D * D, D, kb * 64, nb * 128, wout_t + (size_t)l * D * D, D, RmId{0}, F.lane); continue; }
        r -= I_WOUT_L;
        if (r < I_FOLD_L) {
            const int g = r >> 6, k0 = (r & 63) * 16; const float* W = p_win + (size_t)l * D * DIN;
#pragma unroll
            for (int kk = 0; kk < 16; ++kk) scr[kk * 64 + F.lane] = W[(size_t)(k0 + kk) * DIN + 2688 + g * 64 + F.lane];
            LDS_WAIT(); asm volatile("" ::: "memory");
            float ac[16], as[16];
#pragma unroll
            for (int kk = 0; kk < 16; ++kk) { ac[kk] = 0.f; as[kk] = 0.f; }
            for (int c = 0; c < 64; ++c) { const int idx = (c * F.lane) & 63; const float cc = ctab[idx], ss = ctab[(idx - 16) & 63];
#pragma unroll
                for (int kk = 0; kk < 16; ++kk) { const float w = scr[kk * 64 + c]; ac[kk] += w * cc; as[kk] += w * ss; } }
            bf16* oc = win_t + (size_t)l * NP * D + (size_t)(COL_FC + g * 64 + F.lane) * D + k0;
            bf16* os = win_t + (size_t)l * NP * D + (size_t)(COL_FS + g * 64 + F.lane) * D + k0;
            u32x4 a, b;
            a.x = pk2(ac[0], ac[1]); a.y = pk2(ac[2], ac[3]); a.z = pk2(ac[4], ac[5]); a.w = pk2(ac[6], ac[7]);
            b.x = pk2(ac[8], ac[9]); b.y = pk2(ac[10], ac[11]); b.z = pk2(ac[12], ac[13]); b.w = pk2(ac[14], ac[15]);
            *(u32x4*)oc = a; *(u32x4*)(oc + 8) = b;
            a.x = pk2(as[0], as[1]); a.y = pk2(as[2], as[3]); a.z = pk2(as[4], as[5]); a.w = pk2(as[6], as[7]);
            b.x = pk2(as[8], as[9]); b.y = pk2(as[10], as[11]); b.z = pk2(as[12], as[13]); b.w = pk2(as[14], as[15]);
            *(u32x4*)os = a; *(u32x4*)(os + 8) = b;
            LDS_WAIT(); asm volatile("" ::: "memory");
            continue; }
        r -= I_FOLD_L;
        {
            const int cb = r >> 3, ks = r & 7;
#pragma unroll
            for (int q = 0; q < 2; ++q) { const int k = ks * 128 + q * 64 + F.lane;
                const float c0 = p_c[k], c1 = p_c[D + k], c2 = p_cctx[k];
                scr[0 * 128 + q * 64 + F.lane] = c0 * sigmoidf_(c0); scr[1 * 128 + q * 64 + F.lane] = c1 * sigmoidf_(c1); scr[2 * 128 + q * 64 + F.lane] = c2 * sigmoidf_(c2); }
            LDS_WAIT(); asm volatile("" ::: "memory");
            const float* W = p_adaw + (size_t)l * D * 6144 + (size_t)(ks * 128) * 6144 + cb * 64 + F.lane;
            float a0 = 0.f, a1 = 0.f, a2 = 0.f;
#pragma unroll 32
            for (int kk = 0; kk < 128; ++kk) { const float w = __builtin_nontemporal_load(W + (size_t)kk * 6144); a0 += scr[kk] * w; a1 += scr[128 + kk] * w; a2 += scr[256 + kk] * w; }
            float* mp = (float*)(ws + WS_MODP) + (size_t)((l * 8 + ks) * 3) * 6144 + cb * 64 + F.lane;
            mp[0] = a0; mp[6144] = a1; mp[2 * 6144] = a2;
            LDS_WAIT(); asm volatile("" ::: "memory");
        }
    }
}

__device__ __forceinline__ void mod_to_lds(const Frame& F0, int l, int p, LAS float* dst, bool from_partials) {
    const Frame F = phase_frame(F0); unsigned char* const ws = F.ws;
    const float* adab = inptr(I_ADAB);
    for (int idx = F.tid; idx < 3 * 1024; idx += NTHR) { const int r = idx >> 10, n = idx & 1023;
        float v;
        if (from_partials) { v = adab[l * 6144 + p * 1024 + n]; const float* mp = (const float*)(ws + WS_MODP) + (size_t)(l * 8 * 3 + r) * 6144 + p * 1024 + n;
#pragma unroll
            for (int ks = 0; ks < 8; ++ks) v += mp[(size_t)ks * 3 * 6144]; }
        else v = ((const float*)(ws + WS_MODF))[(size_t)(l * 3 + r) * 6144 + p * 1024 + n];
        dst[idx] = v; }
}
__device__ __forceinline__ void mod_finalize(const Frame& F0) {
    const Frame F = phase_frame(F0); unsigned char* const ws = F.ws;
    const float* adab = inptr(I_ADAB);
    for (int idx = F.vcu * NTHR + F.tid; idx < 2 * 3 * 6144; idx += F.G * NTHR) { const int l = idx / (3 * 6144), rem = idx % (3 * 6144), r = rem / 6144, n = rem % 6144;
        float v = adab[l * 6144 + n]; const float* mp = (const float*)(ws + WS_MODP) + (size_t)(l * 8 * 3 + r) * 6144 + n;
#pragma unroll
        for (int ks = 0; ks < 8; ++ks) v += mp[(size_t)ks * 3 * 6144];
        ((float*)(ws + WS_MODF))[idx] = v; }
}


__device__ __forceinline__ void norm_mod_row(f32x4 (&v)[4], const float* gain, const LAS float* sc, const LAS float* sh, bf16* orow, int lane) {
    float s = 0.f;
#pragma unroll
    for (int j = 0; j < 4; ++j) s += (v[j].x * v[j].x + v[j].y * v[j].y) + (v[j].z * v[j].z + v[j].w * v[j].w);
    const float rs = rsqrtf(wave_sum(s) * (1.f / D) + RMS_EPS);
#pragma unroll
    for (int j = 0; j < 4; ++j) { const int c = 4 * lane + 256 * j; const f32x4 g = *(const f32x4*)(gain + c); const f32x4 a = *(const LAS f32x4*)(sc + c), b = *(const LAS f32x4*)(sh + c);
        v[j] = (v[j] * rs) * g * (a + 1.f) + b;
        u32x2 w; w.x = pk2(v[j].x, v[j].y); w.y = pk2(v[j].z, v[j].w); *(u32x2*)(orow + c) = w; }
}

__device__ __forceinline__ void p0b_norm1(const Frame& F0) {
    const Frame F = phase_frame(F0); unsigned char* const ws = F.ws;
    LAS float* msh = (LAS float*)F.lds; LAS float* msc = msh + 3072;
    mod_to_lds(F, 0, 0, msh, true); mod_to_lds(F, 0, 1, msc, true); __syncthreads();
    mod_finalize(F);
    bf16* H = (bf16*)(ws + WS_H); const float* xin = inptr(I_X); const float* cin = inptr(I_CTX); const float* n1g = inptr(I_N1G);
    for (int row0 = F.gw; row0 < NROW; row0 += 2 * F.NGW) { f32x4 v[2][4]; bool ok[2];
#pragma unroll
        for (int u = 0; u < 2; ++u) { const int row = row0 + u * F.NGW; ok[u] = row < NROW; if (ok[u]) { const float* xr = row < NLAT ? xin + (size_t)row * D : cin + (size_t)(row - NLAT) * D;
#pragma unroll
            for (int j = 0; j < 4; ++j) v[u][j] = __builtin_nontemporal_load((const f32x4*)(xr + 4 * F.lane + 256 * j)); } }
#pragma unroll
        for (int u = 0; u < 2; ++u) if (ok[u]) { const int row = row0 + u * F.NGW; const int mr = modrow(row);
            norm_mod_row(v[u], n1g, msc + mr * 1024, msh + mr * 1024, H + (size_t)row * D, F.lane); } }
}
__device__ __forceinline__ void unpack8(const u32x4 w, float (&o)[8]) {
    o[0] = bf2f(w.x & 0xffffu); o[1] = bf2f(w.x >> 16); o[2] = bf2f(w.y & 0xffffu); o[3] = bf2f(w.y >> 16);
    o[4] = bf2f(w.z & 0xffffu); o[5] = bf2f(w.z >> 16); o[6] = bf2f(w.w & 0xffffu); o[7] = bf2f(w.w >> 16);
}
__device__ __forceinline__ void unpack4(const u32x2 w, float (&o)[4]) { o[0] = bf2f(w.x & 0xffffu); o[1] = bf2f(w.x >> 16); o[2] = bf2f(w.y & 0xffffu); o[3] = bf2f(w.y >> 16); }

__device__ __forceinline__ void shift_pass(const Frame& F0, int l) {
    const Frame F = phase_frame(F0); unsigned char* const ws = F.ws;
    const bf16* P = (const bf16*)(ws + WS_P); bf16* Zs = (bf16*)(ws + WS_ZS); const float* mu = inptr(I_MU) + l * ZW;
    const int total = NROW * 240;
    for (int idx = F.vcu * NTHR + F.tid; idx < total; idx += F.G * NTHR) {
        const int row = idx / 240, ck = idx % 240; const bf16* pr = P + (size_t)row * NP + ck * 8;
        const u32x4 zero = {0u, 0u, 0u, 0u};
        float z[8], n0[8], n1[8], n2[8], n3[8], o[8];
        unpack8(*(const u32x4*)pr, z);
        if (row < NLAT) { const int t = row & (SEQ - 1), gr = t >> 6, gc = t & 63;
            unpack8(gc > 0 ? *(const u32x4*)(pr - NP) : zero, n0); unpack8(gc < 63 ? *(const u32x4*)(pr + NP) : zero, n1);
            unpack8(gr > 0 ? *(const u32x4*)(pr - 64 * NP) : zero, n2); unpack8(gr < 127 ? *(const u32x4*)(pr + 64 * NP) : zero, n3);
        } else { const int tc = (row - NLAT) & (CTXL - 1);
            unpack8(tc > 0 ? *(const u32x4*)(pr - NP) : zero, n0); unpack8(tc < CTXL - 1 ? *(const u32x4*)(pr + NP) : zero, n1);
#pragma unroll
            for (int j = 0; j < 8; ++j) { n2[j] = n0[j]; n3[j] = n1[j]; }
        }
        const f32x4 m0 = *(const f32x4*)(mu + ck * 8), m1 = *(const f32x4*)(mu + ck * 8 + 4);
        const float m[8] = {m0.x, m0.y, m0.z, m0.w, m1.x, m1.y, m1.z, m1.w};
#pragma unroll
        for (int j = 0; j < 8; ++j) { const float nb = (j & 3) == 0 ? n0[j] : (j & 3) == 1 ? n1[j] : (j & 3) == 2 ? n2[j] : n3[j]; o[j] = z[j] + (nb - z[j]) * m[j]; }
        u32x4 w; w.x = pk2(o[0], o[1]); w.y = pk2(o[2], o[3]); w.z = pk2(o[4], o[5]); w.w = pk2(o[6], o[7]);
        *(u32x4*)(Zs + (size_t)row * ZW + ck * 8) = w;
    }
}

__device__ __forceinline__ void conv_pass(const Frame& F0, int l, int nrows) {
    const Frame F = phase_frame(F0); unsigned char* const ws = F.ws;
    const bf16* P = (const bf16*)(ws + WS_P); bf16* MA = (bf16*)(ws + WS_H);
    const float* cw = inptr(I_CONVW) + l * 3 * 256; const int c = 4 * F.lane;
    const f32x4 w0 = *(const f32x4*)(cw + c), w1 = *(const f32x4*)(cw + 256 + c), w2 = *(const f32x4*)(cw + 512 + c), gn = *(const f32x4*)(inptr(I_CONVG) + l * 256 + c);
    for (int row0 = F.gw; row0 < nrows; row0 += 2 * F.NGW) {
        u32x2 q[2][7]; bool ok[2]; const u32x2 zero = {0u, 0u};
#pragma unroll
        for (int u = 0; u < 2; ++u) { const int row = row0 + u * F.NGW; ok[u] = row < nrows; if (ok[u]) {
            int t, L; if (row < NLAT) { t = row & (SEQ - 1); L = SEQ; } else { t = (row - NLAT) & (CTXL - 1); L = CTXL; }
            const bf16* pr = P + (size_t)row * NP + COL_CONV + c;
            q[u][0] = *(const u32x2*)pr; q[u][1] = *(const u32x2*)(pr + 256); q[u][2] = *(const u32x2*)(pr + 512);
            q[u][3] = t > 0 ? *(const u32x2*)(pr - NP + 256) : zero; q[u][4] = t > 0 ? *(const u32x2*)(pr - NP + 512) : zero;
            q[u][5] = t < L - 1 ? *(const u32x2*)(pr + NP + 256) : zero; q[u][6] = t < L - 1 ? *(const u32x2*)(pr + NP + 512) : zero; } }
#pragma unroll
        for (int u = 0; u < 2; ++u) if (ok[u]) { const int row = row0 + u * F.NGW;
            float bg[4], cg[4], hh[4], cp[4], hp[4], cn[4], hn[4];
            unpack4(q[u][0], bg); unpack4(q[u][1], cg); unpack4(q[u][2], hh); unpack4(q[u][3], cp); unpack4(q[u][4], hp); unpack4(q[u][5], cn); unpack4(q[u][6], hn);
            const float W0[4] = {w0.x, w0.y, w0.z, w0.w}, W1[4] = {w1.x, w1.y, w1.z, w1.w}, W2[4] = {w2.x, w2.y, w2.z, w2.w}, GN[4] = {gn.x, gn.y, gn.z, gn.w};
            float y[4], s = 0.f;
#pragma unroll
            for (int j = 0; j < 4; ++j) { y[j] = bg[j] * (W0[j] * (cp[j] * hp[j]) + W1[j] * (cg[j] * hh[j]) + W2[j] * (cn[j] * hn[j])); s += y[j] * y[j]; }
            const float rs = rsqrtf(wave_sum(s) * (1.f / 256.f) + RMS_EPS);
            u32x2 o; o.x = pk2(y[0] * rs * GN[0], y[1] * rs * GN[1]); o.y = pk2(y[2] * rs * GN[2], y[3] * rs * GN[3]);
            __builtin_nontemporal_store(o, (u32x2*)(MA + (size_t)row * D + 512 + c)); }
    }
}

__device__ __forceinline__ void sincos_turns(float x, float& s, float& c) { s = __builtin_amdgcn_sinf(x); c = __builtin_amdgcn_cosf(x); }
#define MFMA16(a, b, c) __builtin_amdgcn_mfma_f32_16x16x32_bf16((a), (b), (c), 0, 0, 0)

__device__ __forceinline__ void fftA_item(const Frame& F0, int item) {
    const Frame F = phase_frame(F0); unsigned char* const ws = F.ws;
    const int half = item & 1, t2 = (item >> 1) & 63, b = item >> 7;
    const bf16* P = (const bf16*)(ws + WS_P); bf16* GT = (bf16*)(ws + WS_GT);
    LAS bf16* Bs = (LAS bf16*)F.lds;
    const int lane = F.lane, w = F.wave, fr = lane & 15, fq = lane >> 4;
    __syncthreads();
#pragma unroll
    for (int i = 0; i < 8; ++i) { const int cidx = F.tid + NTHR * i, krow = cidx >> 4, ch8 = cidx & 15, ri = krow >> 7, t1 = krow & 127;
        const u32x4 v = *(const u32x4*)(P + (size_t)(b * SEQ + t1 * 64 + t2) * NP + COL_FC + ri * 256 + half * 128 + ch8 * 8);
        LAS bf16* d = Bs + (ch8 * 8) * 264 + (krow ^ (ch8 << 3));
        d[0 * 264] = (bf16)(v.x & 0xffffu); d[1 * 264] = (bf16)(v.x >> 16); d[2 * 264] = (bf16)(v.y & 0xffffu); d[3 * 264] = (bf16)(v.y >> 16);
        d[4 * 264] = (bf16)(v.z & 0xffffu); d[5 * 264] = (bf16)(v.z >> 16); d[6 * 264] = (bf16)(v.w & 0xffffu); d[7 * 264] = (bf16)(v.w >> 16); }
    __syncthreads();
    f32x4 acc[2][8];
#pragma unroll
    for (int a = 0; a < 2; ++a)
#pragma unroll
        for (int n = 0; n < 8; ++n) acc[a][n] = (f32x4){0.f, 0.f, 0.f, 0.f};
    int t1p_a = 16 * w + fr;
    asm volatile("" : "+v"(t1p_a));
#pragma unroll
    for (int ks = 0; ks < 8; ++ks) {
        bf16x8 ar, ai;
#pragma unroll
        for (int j = 0; j < 8; ++j) { const int k = ks * 32 + 8 * fq + j, ri = k >> 7, t1 = k & 127; const int idx = (t1 * t1p_a) & 127;
            float sn, cs; sincos_turns((float)idx * (1.f / 128.f), sn, cs);
            const float vr = ri == 0 ? cs : -sn, vi = ri == 0 ? -sn : -cs;
            ar[j] = (short)f2bf(vr); ai[j] = (short)f2bf(vi); }
#pragma unroll
        for (int nt = 0; nt < 8; ++nt) { const bf16x8 bfr = *(const LAS bf16x8*)(Bs + (nt * 16 + fr) * 264 + ((ks * 32 + 8 * fq) ^ ((nt * 2 + (fr >> 3)) << 3)));
            acc[0][nt] = MFMA16(ar, bfr, acc[0][nt]); acc[1][nt] = MFMA16(ai, bfr, acc[1][nt]); }
    }
#pragma unroll
    for (int reg = 0; reg < 4; ++reg) { const int t1p = 16 * w + 4 * fq + reg; float st, ct; sincos_turns((float)(t2 * t1p) * (1.f / 8192.f), st, ct);
        bf16* g = GT + ((size_t)((b * 128 + t1p) * 64 + t2) * 2) * 256 + half * 128 + fr;
#pragma unroll
        for (int nt = 0; nt < 8; ++nt) { const float gr = acc[0][nt][reg], gi = acc[1][nt][reg];
            __builtin_nontemporal_store((bf16)f2bf(gr * ct + gi * st), g + nt * 16); __builtin_nontemporal_store((bf16)f2bf(gi * ct - gr * st), g + 256 + nt * 16); } }
}

template <int NKC, int NDIV, int MT, class SrcRow, class OutRow>
__device__ __forceinline__ void dft64_item(const Frame& F0, int l, int m0, float sgn, float scale, SrcRow src, OutRow orow) {
    const Frame F = phase_frame(F0); unsigned char* const ws = F.ws;
    LAS bf16* Bs = (LAS bf16*)F.lds;
    LAS float* red = (LAS float*)(F.lds + 256 * 136 * 2);
    const int lane = F.lane, w = F.wave, fr = lane & 15, fq = lane >> 4;
    int fr_a = fr; asm volatile("" : "+v"(fr_a));
    f32x4 acc[MT][2];
#pragma unroll
    for (int a = 0; a < MT; ++a) { acc[a][0] = (f32x4){0.f, 0.f, 0.f, 0.f}; acc[a][1] = (f32x4){0.f, 0.f, 0.f, 0.f}; }
    for (int kc = 0; kc < NKC; ++kc) {
        __syncthreads();
#pragma unroll
        for (int i = 0; i < 8; ++i) { const int cidx = F.tid + NTHR * i, krow = cidx >> 5, ch8 = cidx & 31;
            const u32x4 v = *(const u32x4*)(src(kc * 64 + (krow >> 1), krow & 1) + ch8 * 8);
            LAS bf16* d = Bs + (ch8 * 8) * 136 + (krow ^ ((ch8 & 15) << 3));
            d[0 * 136] = (bf16)(v.x & 0xffffu); d[1 * 136] = (bf16)(v.x >> 16); d[2 * 136] = (bf16)(v.y & 0xffffu); d[3 * 136] = (bf16)(v.y >> 16);
            d[4 * 136] = (bf16)(v.z & 0xffffu); d[5 * 136] = (bf16)(v.z >> 16); d[6 * 136] = (bf16)(v.w & 0xffffu); d[7 * 136] = (bf16)(v.w >> 16); }
        __syncthreads();
#pragma unroll
        for (int ks = 0; ks < 4; ++ks) {
            const bf16x8 b0 = *(const LAS bf16x8*)(Bs + ((2 * w) * 16 + fr) * 136 + ((ks * 32 + 8 * fq) ^ ((((2 * w) * 2 + (fr >> 3)) & 15) << 3)));
            const bf16x8 b1 = *(const LAS bf16x8*)(Bs + ((2 * w + 1) * 16 + fr) * 136 + ((ks * 32 + 8 * fq) ^ ((((2 * w + 1) * 2 + (fr >> 3)) & 15) << 3)));
#pragma unroll
            for (int mt = 0; mt < MT; ++mt) { const int mrow = m0 + mt * 16 + fr_a; bf16x8 a;
#pragma unroll
                for (int j = 0; j < 8; ++j) { const int k = ks * 32 + 8 * fq + j, tl = k >> 1, ri = k & 1; const int idx = ((kc * 64 + tl) * mrow) & (NDIV - 1);
                    float sn, cs; sincos_turns((float)idx * (1.f / (float)NDIV), sn, cs);
                    a[j] = (short)f2bf(ri == 0 ? cs : sgn * sn); }
                acc[mt][0] = MFMA16(a, b0, acc[mt][0]); acc[mt][1] = MFMA16(a, b1, acc[mt][1]); }
        }
    }
#pragma unroll
    for (int mt = 0; mt < MT; ++mt)
#pragma unroll
        for (int reg = 0; reg < 4; ++reg) { const float a = acc[mt][0][reg] * scale, b = acc[mt][1][reg] * scale; acc[mt][0][reg] = a; acc[mt][1][reg] = b;
            float s = a * a + b * b; s += __shfl_xor(s, 1); s += __shfl_xor(s, 2); s += __shfl_xor(s, 4); s += __shfl_xor(s, 8);
            if (fr == 0) red[w * 64 + mt * 16 + 4 * fq + reg] = s; }
    __syncthreads();
    bf16* MA = (bf16*)(ws + WS_H); const float* fg = inptr(I_FOURG) + l * 256;
    const float g0 = fg[(2 * w) * 16 + fr], g1 = fg[(2 * w + 1) * 16 + fr];
#pragma unroll
    for (int mt = 0; mt < MT; ++mt)
#pragma unroll
        for (int reg = 0; reg < 4; ++reg) { const int ml = mt * 16 + 4 * fq + reg; float tot = 0.f;
#pragma unroll
            for (int ww = 0; ww < 8; ++ww) tot += red[ww * 64 + ml];
            const float rs = rsqrtf(tot * (1.f / 256.f) + RMS_EPS);
            bf16* o = MA + (size_t)orow(m0 + ml) * D + 768 + fr;
            o[(2 * w) * 16] = (bf16)f2bf(acc[mt][0][reg] * rs * g0); o[(2 * w + 1) * 16] = (bf16)f2bf(acc[mt][1][reg] * rs * g1); }
    __syncthreads();
}

constexpr size_t WS_LORA = 64 * 1024;
constexpr int LINP = 392;
__device__ __forceinline__ float fast_sigmoid(float x) { return __builtin_amdgcn_rcpf(1.f + __expf(-x)); }
__device__ __forceinline__ float fast_tanh(float x) { return 1.f - 2.f * __builtin_amdgcn_rcpf(1.f + __expf(2.f * x)); }
__device__ __forceinline__ void prep_phase(const Frame& F0, int l) {
    const Frame F = phase_frame(F0); unsigned char* const ws = F.ws;
    const bf16* Zs = (const bf16*)(ws + WS_ZS); bf16* STR = (bf16*)(ws + WS_STR);
    LAS bf16* lin = (LAS bf16*)F.lds;
    LAS float* ssum = (LAS float*)(F.lds + 12544);
    constexpr int TP = 72, TSZ = 16 * TP;
    LAS bf16* tiles = (LAS bf16*)(F.lds + 13312);
    const int lane = F.lane, fr = lane & 15, fq = lane >> 4, w = F.wave, tid = F.tid;
    const int nitems = (NROW / 16) * 2;
    int it = blockIdx.x; if (it >= nitems) return;
    int hh = -1, head = 0, cb = 0;
    bf16x8 wf[12][2];
    const float* kkp = inptr(I_KK) + l * DR; const float* kap = inptr(I_KA) + l * DR; const float* dw0 = inptr(I_DW0) + l * 2 * DR; const float* ia0 = inptr(I_IA0) + l * 2 * DR;
    u32x4 pz[2];
#define PREP_LOAD(item_) do { const int row0_ = ((item_) >> 1) * 16; \
        pz[0] = *(const u32x4*)(Zs + (size_t)(row0_ + tid / 48) * ZW + 1536 + (tid % 48) * 8); \
        if (tid < 256) pz[1] = *(const u32x4*)(Zs + (size_t)(row0_ + (tid + 512) / 48) * ZW + 1536 + ((tid + 512) % 48) * 8); } while (0)
    PREP_LOAD(it);
    for (; it < nitems; it += F.G) {
        const int tile = it >> 1;
        if ((it & 1) != hh) {
            hh = it & 1; head = 4 * hh + (w >> 1); cb = 64 * head + 32 * (w & 1);
            const bf16* WL = (const bf16*)(ws + WS_LORA) + (size_t)l * 512 * 384 + (size_t)(cb + fr) * 384 + 8 * fq;
#pragma unroll
            for (int ks = 0; ks < 12; ++ks)
#pragma unroll
                for (int nt = 0; nt < 2; ++nt) wf[ks][nt] = *(const bf16x8*)(WL + (size_t)nt * 16 * 384 + ks * 32);
        }
        __syncthreads();
        {   float v[8]; unpack8(pz[0], v); const int c8 = tid % 48;
            if (c8 < 16) {
#pragma unroll
                for (int j = 0; j < 8; ++j) v[j] = fast_tanh(v[j]); }
            else if (c8 >= 32) {
#pragma unroll
                for (int j = 0; j < 8; ++j) v[j] = fast_sigmoid(v[j]); }
            *(LAS u32x4*)(lin + (tid / 48) * LINP + c8 * 8) = (u32x4){pk2(v[0], v[1]), pk2(v[2], v[3]), pk2(v[4], v[5]), pk2(v[6], v[7])};
            if (tid < 256) { unpack8(pz[1], v); const int c9 = (tid + 512) % 48;
                if (c9 < 16) {
#pragma unroll
                    for (int j = 0; j < 8; ++j) v[j] = fast_tanh(v[j]); }
                else if (c9 >= 32) {
#pragma unroll
                    for (int j = 0; j < 8; ++j) v[j] = fast_sigmoid(v[j]); }
                *(LAS u32x4*)(lin + ((tid + 512) / 48) * LINP + c9 * 8) = (u32x4){pk2(v[0], v[1]), pk2(v[2], v[3]), pk2(v[4], v[5]), pk2(v[6], v[7])}; } }
        u32x2 zr2[2], zk2[2], zv2[2];
        {   const bf16* zr_ = Zs + (size_t)(tile * 16 + fr) * ZW + cb + 4 * fq;
#pragma unroll
            for (int nt = 0; nt < 2; ++nt) { zr2[nt] = *(const u32x2*)(zr_ + 16 * nt); zk2[nt] = *(const u32x2*)(zr_ + 512 + 16 * nt); zv2[nt] = *(const u32x2*)(zr_ + 1024 + 16 * nt); } }
        if (it + F.G < nitems) PREP_LOAD(it + F.G);
        __syncthreads();
        f32x4 kkw[2], kaw[2], d0w[2][2], i0w[2][2];
#pragma unroll
        for (int nt = 0; nt < 2; ++nt) { const int c0 = cb + 16 * nt + 4 * fq; kkw[nt] = *(const f32x4*)(kkp + c0); kaw[nt] = *(const f32x4*)(kap + c0);
#pragma unroll
            for (int dn = 0; dn < 2; ++dn) { d0w[dn][nt] = *(const f32x4*)(dw0 + dn * DR + c0); i0w[dn][nt] = *(const f32x4*)(ia0 + dn * DR + c0); } }
        f32x4 acc[5][2];
#pragma unroll
        for (int q = 0; q < 5; ++q) { acc[q][0] = (f32x4){0.f, 0.f, 0.f, 0.f}; acc[q][1] = (f32x4){0.f, 0.f, 0.f, 0.f}; }
#pragma unroll
        for (int ks = 0; ks < 12; ++ks) { const int q = ks < 8 ? (ks >> 1) : 4; const bf16x8 xf = *(const LAS bf16x8*)(lin + fr * LINP + ks * 32 + 8 * fq);
            acc[q][0] = MFMA16(wf[ks][0], xf, acc[q][0]); acc[q][1] = MFMA16(wf[ks][1], xf, acc[q][1]); }
        float zk[2][4], kv[2][4]; float ss = 0.f;
#pragma unroll
        for (int nt = 0; nt < 2; ++nt) { unpack4(zk2[nt], zk[nt]);
#pragma unroll
            for (int i = 0; i < 4; ++i) { kv[nt][i] = zk[nt][i] * kkw[nt][i]; ss += kv[nt][i] * kv[nt][i]; } }
        ss += __shfl_xor(ss, 16); ss += __shfl_xor(ss, 32);
        if (fq == 0) ssum[w * 16 + fr] = ss;
        __syncthreads();
        const float inv = __builtin_amdgcn_rcpf(fmaxf(sqrtf(ssum[w * 16 + fr] + ssum[(w ^ 1) * 16 + fr]), 1e-12f));
        LAS bf16* th = tiles + (w >> 1) * 10 * TSZ + fr * TP + 32 * (w & 1) + 4 * fq;
#pragma unroll
        for (int nt = 0; nt < 2; ++nt) { LAS bf16* t0 = th + 16 * nt;
            *(LAS u32x2*)(t0) = zr2[nt]; *(LAS u32x2*)(t0 + TSZ) = zv2[nt];
            float kk[4];
#pragma unroll
            for (int i = 0; i < 4; ++i) kk[i] = kv[nt][i] * inv;
            *(LAS u32x2*)(t0 + 2 * TSZ) = (u32x2){pk2(kk[0], kk[1]), pk2(kk[2], kk[3])};
            *(LAS u32x2*)(t0 + 3 * TSZ) = (u32x2){pk2(acc[4][nt][0], acc[4][nt][1]), pk2(acc[4][nt][2], acc[4][nt][3])};
#pragma unroll
            for (int dn = 0; dn < 2; ++dn) { float ep[4], kd[4], bb[4];
#pragma unroll
                for (int i = 0; i < 4; ++i) { const float ew = fast_sigmoid(d0w[dn][nt][i] + acc[dn][nt][i]) * 0.6065306597126334f;
                    ep[i] = ew * (1.f + ew * (-0.5f + ew * (0.16666667f + ew * (-0.041666668f + ew * 0.0083333338f))));
                    const float a = fast_sigmoid(i0w[dn][nt][i] + acc[2 + dn][nt][i]); kd[i] = zk[nt][i] * (1.f + (a - 1.f) * kaw[nt][i]); bb[i] = kk[i] * a; }
                *(LAS u32x2*)(t0 + (4 + 3 * dn) * TSZ) = (u32x2){pk2(ep[0], ep[1]), pk2(ep[2], ep[3])};
                *(LAS u32x2*)(t0 + (5 + 3 * dn) * TSZ) = (u32x2){pk2(kd[0], kd[1]), pk2(kd[2], kd[3])};
                *(LAS u32x2*)(t0 + (6 + 3 * dn) * TSZ) = (u32x2){pk2(bb[0], bb[1]), pk2(bb[2], bb[3])}; } }
        __syncthreads();
        {   const LAS bf16* src = tiles + (w >> 1) * 10 * TSZ + (8 * (w & 1) + (lane >> 3)) * TP + (lane & 7) * 8; bf16* dst = STR + ((size_t)tile * 8 + head) * 10240 + 8 * (w & 1) * 64 + lane * 8;
#pragma unroll
            for (int s = 0; s < 10; ++s) __builtin_nontemporal_store(*(const LAS u32x4*)(src + s * TSZ), (u32x4*)(dst + s * 1024)); }
    }
#undef PREP_LOAD
}

__device__ __forceinline__ int scan_rowof(int s, int dir, int b) { if (s < CTXL) { const int tc = dir ? (CTXL - 1 - s) : s; return NLAT + b * CTXL + tc; } const int tt = s - CTXL; const int t = dir ? (SEQ - 1 - tt) : tt; return b * SEQ + t; }
__device__ __forceinline__ void readout_pass(const Frame& F0, int l, int nrows) {
    const Frame F = phase_frame(F0); unsigned char* const ws = F.ws;
    const bf16* STR = (const bf16*)(ws + WS_STR); const bf16* Y0 = (const bf16*)(ws + WS_Y); const bf16* Y1 = Y0 + (size_t)NROW * DR; bf16* MA = (bf16*)(ws + WS_H);
    const int lane = F.lane, c = 8 * lane;
    float gw[8], gb[8], rk[8];
    {   const float* gnw = inptr(I_GNW) + l * DR + c; const float* gnb = inptr(I_GNB) + l * DR + c; const float* rkp = inptr(I_RK) + l * DR + c;
        const f32x4 a0 = *(const f32x4*)gnw, a1 = *(const f32x4*)(gnw + 4), b0 = *(const f32x4*)gnb, b1 = *(const f32x4*)(gnb + 4), r0 = *(const f32x4*)rkp, r1 = *(const f32x4*)(rkp + 4);
#pragma unroll
        for (int i = 0; i < 4; ++i) { gw[i] = a0[i]; gw[4 + i] = a1[i]; gb[i] = b0[i]; gb[4 + i] = b1[i]; rk[i] = r0[i]; rk[4 + i] = r1[i]; } }
    for (int row0 = F.gw; row0 < nrows; row0 += 2 * F.NGW) {
        u32x4 q[2][7]; bool ok[2];
#pragma unroll
        for (int u = 0; u < 2; ++u) { const int row = row0 + u * F.NGW; ok[u] = row < nrows; if (ok[u]) {
            const bf16* sr = STR + ((size_t)(row >> 4) * 8 + (lane >> 3)) * 10240 + (row & 15) * 64 + (lane & 7) * 8;
            q[u][0] = *(const u32x4*)(Y0 + (size_t)row * DR + c); q[u][1] = *(const u32x4*)(Y1 + (size_t)row * DR + c);
            q[u][2] = *(const u32x4*)sr; q[u][3] = *(const u32x4*)(sr + 1024); q[u][4] = *(const u32x4*)(sr + 3072); q[u][5] = *(const u32x4*)(sr + 5 * 1024); q[u][6] = *(const u32x4*)(sr + 8 * 1024); } }
#pragma unroll
        for (int u = 0; u < 2; ++u) if (ok[u]) { const int row = row0 + u * F.NGW;
            float ya[8], yb[8], r[8], v[8], g[8], k0[8], k1[8];
            unpack8(q[u][0], ya); unpack8(q[u][1], yb); unpack8(q[u][2], r); unpack8(q[u][3], v); unpack8(q[u][4], g); unpack8(q[u][5], k0); unpack8(q[u][6], k1);
            float s1 = 0.f, s2 = 0.f, sb = 0.f;
#pragma unroll
            for (int i = 0; i < 8; ++i) { ya[i] += yb[i]; s1 += ya[i]; s2 += ya[i] * ya[i]; sb += r[i] * (k0[i] + k1[i]) * rk[i]; }
#pragma unroll
            for (int o = 1; o < 8; o <<= 1) { s1 += __shfl_xor(s1, o); s2 += __shfl_xor(s2, o); sb += __shfl_xor(sb, o); }
            const float mu = s1 * (1.f / 64.f); const float var = fmaxf(s2 * (1.f / 64.f) - mu * mu, 0.f); const float rs = rsqrtf(var + GN_EPS);
            float o8[8];
#pragma unroll
            for (int i = 0; i < 8; ++i) o8[i] = ((ya[i] - mu) * rs * gw[i] + gb[i] + sb * v[i]) * g[i];
            *(u32x4*)(MA + (size_t)row * D + c) = (u32x4){pk2(o8[0], o8[1]), pk2(o8[2], o8[3]), pk2(o8[4], o8[5]), pk2(o8[6], o8[7])}; }
    }
}
constexpr int BLOB = 16384, SEGCH = 132, NSEG = 4;
constexpr size_t WS_BLOBA0 = 149 * MiB, WS_BLOBA1 = 215 * MiB, WS_BLOBB1 = 248 * MiB, WS_BLOBB2 = 492 * MiB;
constexpr int BLOB_B1_SCANS = 14;
constexpr size_t WS_SCANST = 2 * MiB + 512 * 1024;
__device__ __forceinline__ unsigned char* blob_ptr(unsigned char* ws, int seg, int scan, int ci) {
    if ((seg & 1) == 0) return scan < 16 ? ws + WS_BLOBA0 + ((size_t)scan * SEGCH + ci) * BLOB : ws + WS_BLOBA1 + ((size_t)(scan - 16) * SEGCH + ci) * BLOB;
    return scan < BLOB_B1_SCANS ? ws + WS_BLOBB1 + ((size_t)scan * SEGCH + ci) * BLOB : ws + WS_BLOBB2 + ((size_t)(scan - BLOB_B1_SCANS) * SEGCH + ci) * BLOB;
}
typedef short s16x4 __attribute__((ext_vector_type(4)));
__device__ __forceinline__ bf16x8 frag_lo(u32x2 x) { u32x4 t = {x.x, x.y, 0u, 0u}; return __builtin_bit_cast(bf16x8, t); }
__device__ __forceinline__ bf16x8 frag_c(const f32x4& a) { u32x4 t = {pk2(a[0], a[1]), pk2(a[2], a[3]), 0u, 0u}; return __builtin_bit_cast(bf16x8, t); }

struct PreRegs { u32x4 q[12]; };
__device__ __forceinline__ void pre_load(PreRegs& R, unsigned char* ws, int scan, int cs, int lane) {
    const int dir = scan & 1, h = (scan >> 1) & 7, b = scan >> 4; const int rfirst = scan_rowof(16 * cs, dir, b);
    const bf16* blk = (const bf16*)(ws + WS_STR) + ((size_t)(rfirst >> 4) * 8 + h) * 10240 + lane * 8;
    const int so[6] = {0, 1, 2, 4 + 3 * dir, 5 + 3 * dir, 6 + 3 * dir};
#pragma unroll
    for (int i = 0; i < 6; ++i) { R.q[2 * i] = *(const u32x4*)(blk + so[i] * 1024); R.q[2 * i + 1] = *(const u32x4*)(blk + so[i] * 1024 + 512); }
}
template <int PM>
__device__ __forceinline__ void pre_item(const Frame& F, unsigned char* ws, int scan, int cs, unsigned char* blob, PreRegs& PR, int nscan, int ncs) {
    const int dir = scan & 1, h = (scan >> 1) & 7, b = scan >> 4; const int lane = F.lane, fr = lane & 15, fq = lane >> 4;
    LAS unsigned char* L = F.lds + F.wave * 17408;
    constexpr int TKP = 72, TKS = 16 * TKP;
    LAS bf16* TK = (LAS bf16*)L; LAS bf16* TR = TK + TKS; LAS bf16* TKt = TR + TKS; LAS bf16* TB = TKt + TKS;
    LAS bf16* KTt = TB + TKS; LAS bf16* RTt = KTt + 1024; LAS bf16* Vt = RTt + 1024;
    LAS bf16* AKK = Vt + 1024; LAS bf16* ARK = AKK + 256; LAS bf16* ARB = ARK + 256; LAS bf16* TT = ARB + 256;
    float kh[16], bh[16];
    float pc;
    {   float r_[16], v_[16], kk_[16], lp_[16], kd_[16], bb_[16];
        LAS bf16* stg = TK;
#pragma unroll
        for (int i = 0; i < 6; ++i) { *(LAS u32x4*)(stg + i * 1024 + lane * 8) = PR.q[2 * i]; *(LAS u32x4*)(stg + i * 1024 + 512 + lane * 8) = PR.q[2 * i + 1]; }
        LDS_WAIT(); asm volatile("" ::: "memory");
        if (nscan >= 0) pre_load(PR, ws, nscan, ncs, lane);
#pragma unroll
        for (int t = 0; t < 16; ++t) { const int tm = (dir ? 15 - t : t) * 64 + lane;
            r_[t] = bf2f(stg[tm]); v_[t] = bf2f(stg[1024 + tm]); kk_[t] = bf2f(stg[2048 + tm]); lp_[t] = bf2f(stg[3072 + tm]); kd_[t] = bf2f(stg[4096 + tm]); bb_[t] = bf2f(stg[5120 + tm]); }
        LDS_WAIT(); asm volatile("" ::: "memory");
        float pp = 1.f; u32x4 kt4[2], rt4[2], v4[2];
        unsigned ktp[8], rtp[8], vp[8];
#pragma unroll
        for (int t = 0; t < 16; ++t) { const float pm1 = pp; pp *= 1.f - lp_[t]; const float p = pp, ip = __builtin_amdgcn_rcpf(pp); lp_[t] = ip;
            const float kt = kk_[t] * pm1, ktl = kd_[t] * ip, btl = bb_[t] * ip, rt = r_[t] * p;
            const unsigned hk = pk2(kt, rt), hb = pk2(ktl, btl);
            TK[t * TKP + lane] = (bf16)(hk & 0xffffu); TR[t * TKP + lane] = (bf16)(hk >> 16); TKt[t * TKP + lane] = (bf16)(hb & 0xffffu); TB[t * TKP + lane] = (bf16)(hb >> 16);
            const unsigned hv = f2bf(v_[t]);
            if (t & 1) { ktp[t >> 1] |= hk << 16; rtp[t >> 1] |= hk & 0xffff0000u; vp[t >> 1] |= hv << 16; }
            else { ktp[t >> 1] = hk & 0xffffu; rtp[t >> 1] = hk >> 16; vp[t >> 1] = hv; } }
        kt4[0] = (u32x4){ktp[0], ktp[1], ktp[2], ktp[3]}; kt4[1] = (u32x4){ktp[4], ktp[5], ktp[6], ktp[7]};
        rt4[0] = (u32x4){rtp[0], rtp[1], rtp[2], rtp[3]}; rt4[1] = (u32x4){rtp[4], rtp[5], rtp[6], rtp[7]};
        v4[0] = (u32x4){vp[0], vp[1], vp[2], vp[3]}; v4[1] = (u32x4){vp[4], vp[5], vp[6], vp[7]};
        *(LAS u32x4*)(KTt + lane * 16) = kt4[0]; *(LAS u32x4*)(KTt + lane * 16 + 8) = kt4[1];
        *(LAS u32x4*)(RTt + lane * 16) = rt4[0]; *(LAS u32x4*)(RTt + lane * 16 + 8) = rt4[1];
        *(LAS u32x4*)(Vt + lane * 16) = v4[0]; *(LAS u32x4*)(Vt + lane * 16 + 8) = v4[1];
        pc = pp;
#pragma unroll
        for (int t = 0; t < 16; ++t) { const float e = pp * lp_[t]; kh[t] = kd_[t] * e; bh[t] = bb_[t] * e; }
    }
    LDS_WAIT(); asm volatile("" ::: "memory");
    {   f32x4 akb = {0.f, 0.f, 0.f, 0.f}, akk = akb, ark = akb, arb = akb;
#pragma unroll
        for (int s = 0; s < 2; ++s) { const int o = fr * TKP + 32 * s + 8 * fq;
            const bf16x8 fk = *(const LAS bf16x8*)(TK + o), frr = *(const LAS bf16x8*)(TR + o), fkt = *(const LAS bf16x8*)(TKt + o), fb = *(const LAS bf16x8*)(TB + o);
            akb = MFMA16(fk, fb, akb); akk = MFMA16(fk, fkt, akk); ark = MFMA16(frr, fkt, ark); arb = MFMA16(frr, fb, arb); }
        float nm[4];
#pragma unroll
        for (int reg = 0; reg < 4; ++reg) { const int t = 4 * fq + reg; const bool lo = fr < t, le = fr <= t;
            nm[reg] = lo ? akb[reg] : 0.f; AKK[t * 16 + fr] = (bf16)f2bf(lo ? akk[reg] : 0.f);
            ARK[t * 16 + fr] = (bf16)f2bf(le ? ark[reg] : 0.f); ARB[t * 16 + fr] = (bf16)f2bf(le ? arb[reg] : 0.f); }
        float col[16];
#pragma unroll
        for (int t = 0; t < 16; ++t) { float s_ = (t == fr) ? 1.f : 0.f;
#pragma unroll
            for (int i = 0; i < 16; ++i) if (i < t) { const float n_ti = __builtin_bit_cast(float, __builtin_amdgcn_readlane(__builtin_bit_cast(int, nm[t & 3]), i + 16 * (t >> 2))); s_ -= n_ti * col[i]; }
            col[t] = s_; TT[t * 16 + fr] = (bf16)f2bf(s_); }
    }
    LDS_WAIT(); asm volatile("" ::: "memory");
    f32x4 WTc[4], RqT[4], U0c[4], Y0c[4];
    {   const bf16x8 aT = frag_lo(*(const LAS u32x2*)(TT + fr * 16 + 4 * fq)), aKK = frag_lo(*(const LAS u32x2*)(AKK + fr * 16 + 4 * fq)), aRK = frag_lo(*(const LAS u32x2*)(ARK + fr * 16 + 4 * fq));
        u32x2 nb = *(const LAS u32x2*)(ARB + fr * 16 + 4 * fq); nb.x ^= 0x80008000u; nb.y ^= 0x80008000u; const bf16x8 aRBn = frag_lo(nb);
        const f32x4 z4 = {0.f, 0.f, 0.f, 0.f};
#pragma unroll
        for (int nt = 0; nt < 4; ++nt) { const int o = (16 * nt + fr) * 16 + 4 * fq;
            const bf16x8 bK = frag_lo(*(const LAS u32x2*)(KTt + o)), bV = frag_lo(*(const LAS u32x2*)(Vt + o));
            float ri[4]; unpack4(*(const LAS u32x2*)(TR + fr * TKP + 16 * nt + 4 * fq), ri);
            const f32x4 Wn = MFMA16(aT, bK, z4); WTc[nt] = MFMA16(bK, aT, z4);
            const f32x4 Zn = MFMA16(aKK, bV, z4);
            U0c[nt] = MFMA16(aT, frag_c(Zn), z4);
            RqT[nt] = MFMA16(frag_c(Wn), aRBn, ((f32x4){ri[0], ri[1], ri[2], ri[3]}));
            Y0c[nt] = MFMA16(aRK, bV, z4); Y0c[nt] = MFMA16(aRBn, frag_c(U0c[nt]), Y0c[nt]); }
    }
    LDS_WAIT(); asm volatile("" ::: "memory");
#pragma unroll
    for (int nt = 0; nt < 4; ++nt) { const u32x2 vv = *(const LAS u32x2*)(Vt + (16 * nt + fr) * 16 + 4 * fq);
        stg8(blob + 8192 + nt * 2048 + 1024 + lane * 8, vv);
        u32x2 u0 = {pk2(U0c[nt][0], U0c[nt][1]), pk2(U0c[nt][2], U0c[nt][3])}, y0 = {pk2(Y0c[nt][0], Y0c[nt][1]), pk2(Y0c[nt][2], Y0c[nt][3])};
        stg8(blob + 8192 + nt * 2048 + lane * 8, u0); stg8(blob + 8192 + nt * 2048 + 512 + lane * 8, y0);
        stg4(blob + 8192 + nt * 2048 + 1536 + lane * 4, pc); }
#pragma unroll
    for (int s = 0; s < 2; ++s) {
        stg16(blob + (0 * 2 + s) * 1024 + lane * 16, (u32x4){pk2(WTc[2 * s][0], WTc[2 * s][1]), pk2(WTc[2 * s][2], WTc[2 * s][3]), pk2(WTc[2 * s + 1][0], WTc[2 * s + 1][1]), pk2(WTc[2 * s + 1][2], WTc[2 * s + 1][3])});
        stg16(blob + (1 * 2 + s) * 1024 + lane * 16, (u32x4){pk2(RqT[2 * s][0], RqT[2 * s][1]), pk2(RqT[2 * s][2], RqT[2 * s][3]), pk2(RqT[2 * s + 1][0], RqT[2 * s + 1][1]), pk2(RqT[2 * s + 1][2], RqT[2 * s + 1][3])}); }
    LAS bf16* BHt = TKt; LAS bf16* KHt = TB;
    {   u32x4 a, c, d, e;
        a = (u32x4){pk2(bh[0], bh[1]), pk2(bh[2], bh[3]), pk2(bh[4], bh[5]), pk2(bh[6], bh[7])}; c = (u32x4){pk2(bh[8], bh[9]), pk2(bh[10], bh[11]), pk2(bh[12], bh[13]), pk2(bh[14], bh[15])};
        d = (u32x4){pk2(kh[0], kh[1]), pk2(kh[2], kh[3]), pk2(kh[4], kh[5]), pk2(kh[6], kh[7])}; e = (u32x4){pk2(kh[8], kh[9]), pk2(kh[10], kh[11]), pk2(kh[12], kh[13]), pk2(kh[14], kh[15])};
        *(LAS u32x4*)(BHt + lane * 16) = a; *(LAS u32x4*)(BHt + lane * 16 + 8) = c; *(LAS u32x4*)(KHt + lane * 16) = d; *(LAS u32x4*)(KHt + lane * 16 + 8) = e; }
    LDS_WAIT(); asm volatile("" ::: "memory");
#pragma unroll
    for (int mt = 0; mt < 4; ++mt) { const int o = (16 * mt + fr) * 16 + 4 * fq; const u32x2 bb = *(const LAS u32x2*)(BHt + o), kk = *(const LAS u32x2*)(KHt + o);
        stg16(blob + 4096 + mt * 1024 + lane * 16, (u32x4){bb.x ^ 0x80008000u, bb.y ^ 0x80008000u, kk.x, kk.y}); }
    LDS_WAIT(); asm volatile("" ::: "memory");
}

__device__ __forceinline__ void pre_phase(const Frame& F0, int seg, int b_lo) {
    const Frame F = phase_frame(F0); unsigned char* const ws = F.ws;
    if ((int)blockIdx.x < b_lo) return;
    const int nwv = (F.G - b_lo) * NWAVES;
    PreRegs R;
    int it = ((int)blockIdx.x - b_lo) * NWAVES + F.wave; if (it >= 32 * SEGCH) return;
    pre_load(R, ws, it & 31, seg * SEGCH + (it >> 5), F.lane);
    for (; it < 32 * SEGCH; it += nwv) { const int nx = it + nwv; const bool hn = nx < 32 * SEGCH;
        pre_item<0>(F, ws, it & 31, seg * SEGCH + (it >> 5), blob_ptr(ws, seg, it & 31, it >> 5), R, hn ? (nx & 31) : -1, seg * SEGCH + (nx >> 5)); }
}

constexpr int SQ_SLOT = 10240, SQ_R = 12, SQ_D = 8;
template <int MODE>
__device__ __forceinline__ void seq_item(const Frame& F0, int item, int seg, bool need_ctx) {
    const Frame F = phase_frame(F0); unsigned char* const ws = F.ws;
    const int scan = item >> 2, vb = item & 3, dir = scan & 1, h = (scan >> 1) & 7, b = scan >> 4; const int lane = F.lane, fr = lane & 15, fq = lane >> 4, w = F.wave;
    const unsigned char* blob = blob_ptr(ws, seg, scan, 0);
    LAS unsigned char* ring = F.lds;
    __syncthreads();
    const int p0 = 2 * (w - 1);
    const unsigned goff0 = (p0 < 8 ? p0 * 1024 : 8192 + vb * 2048 + (p0 - 8) * 1024) + lane * 16, goff1 = (p0 + 1 < 8 ? (p0 + 1) * 1024 : 8192 + vb * 2048 + (p0 + 1 - 8) * 1024) + lane * 16;
#define SQ_ISSUE(c) do { const unsigned char* g_ = blob + (size_t)(c) * BLOB; LAS unsigned char* s_ = ring + ((c) % SQ_R) * SQ_SLOT + p0 * 1024; \
        __builtin_amdgcn_global_load_lds((const unsigned*)(g_ + goff0), (LAS unsigned*)(s_), 16, 0, 0); \
        __builtin_amdgcn_global_load_lds((const unsigned*)(g_ + goff1), (LAS unsigned*)(s_ + 1024), 16, 0, 0); } while (0)
    const bool loader = (w >= 1 && w <= 5) && MODE != 2;
    if (loader) { for (int c = 0; c < SQ_D; ++c) SQ_ISSUE(c); }
    bf16* Y = (bf16*)(ws + WS_Y) + (size_t)dir * NROW * DR + h * 64 + 16 * vb + fr;
    float* st = (float*)(ws + WS_SCANST) + (size_t)item * 1024 + lane * 4;
    f32x4 M[4];
#pragma unroll
    for (int mt = 0; mt < 4; ++mt) M[mt] = (seg == 0 || w != 0) ? (f32x4){0.f, 0.f, 0.f, 0.f} : *(const f32x4*)(st + mt * 256);
    const f32x4 z4 = {0.f, 0.f, 0.f, 0.f};
    LAS unsigned char* mb = ring + SQ_R * SQ_SLOT;
    struct SQ { bf16x8 a1[2], a2[4]; f32x4 pc[4]; u32x2 u0, vv; };
#define SQ_READ(R, c) do { const LAS unsigned char* sl_ = ring + ((c) % SQ_R) * SQ_SLOT; _Pragma("unroll") for (int i = 0; i < 4; ++i) { \
        R.a2[i] = *(const LAS bf16x8*)(sl_ + 4096 + i * 1024 + lane * 16); R.pc[i] = *(const LAS f32x4*)(sl_ + 8192 + 1536 + (16 * i + 4 * fq) * 4); } \
        R.a1[0] = *(const LAS bf16x8*)(sl_ + lane * 16); R.a1[1] = *(const LAS bf16x8*)(sl_ + 1024 + lane * 16); \
        R.u0 = *(const LAS u32x2*)(sl_ + 8192 + lane * 8); R.vv = *(const LAS u32x2*)(sl_ + 8192 + 1024 + lane * 8); } while (0)
#define SQ_STEP(R, c, RN, cn) do { \
        if ((cn) < SEGCH) SQ_READ(RN, cn); \
        const u32x4 t0 = {pk2(M[0][0], M[0][1]), pk2(M[0][2], M[0][3]), pk2(M[1][0], M[1][1]), pk2(M[1][2], M[1][3])}; \
        const u32x4 t1 = {pk2(M[2][0], M[2][1]), pk2(M[2][2], M[2][3]), pk2(M[3][0], M[3][1]), pk2(M[3][2], M[3][3])}; \
        *(LAS u32x4*)(mb + ((c) & 1) * 2048 + lane * 16) = t0; *(LAS u32x4*)(mb + ((c) & 1) * 2048 + 1024 + lane * 16) = t1; \
        const bf16x8 b0 = __builtin_bit_cast(bf16x8, t0), b1 = __builtin_bit_cast(bf16x8, t1); \
        f32x4 X0 = MFMA16(R.a1[0], b0, z4); X0 = MFMA16(R.a1[1], b1, X0); \
        float u0[4]; unpack4(R.u0, u0); \
        const u32x4 tb = {pk2(X0[0] + u0[0], X0[1] + u0[1]), pk2(X0[2] + u0[2], X0[3] + u0[3]), R.vv.x, R.vv.y}; const bf16x8 bB = __builtin_bit_cast(bf16x8, tb); \
        _Pragma("unroll") for (int mt = 0; mt < 4; ++mt) M[mt] = MFMA16(R.a2[mt], bB, R.pc[mt] * M[mt]); \
        asm volatile("s_waitcnt lgkmcnt(0)" ::: "memory"); } while (0)
    const long ystep = dir ? -(long)DR : (long)DR;
    bf16* const yctx = Y + (size_t)scan_rowof(4 * fq, dir, b) * DR; bf16* const ylat = Y + (size_t)scan_rowof(CTXL + 4 * fq, dir, b) * DR;
#define SQ_YSTEP(c) do { const int cs_ = seg * SEGCH + (c); if (MODE == 0 && (need_ctx || cs_ >= 16)) { const LAS unsigned char* sl_ = ring + ((c) % SQ_R) * SQ_SLOT; \
        const bf16x8 q0 = *(const LAS bf16x8*)(sl_ + 2048 + lane * 16), q1 = *(const LAS bf16x8*)(sl_ + 3072 + lane * 16); \
        const bf16x8 b0 = *(const LAS bf16x8*)(mb + ((c) & 1) * 2048 + lane * 16), b1 = *(const LAS bf16x8*)(mb + ((c) & 1) * 2048 + 1024 + lane * 16); \
        float y0[4]; unpack4(*(const LAS u32x2*)(sl_ + 8192 + 512 + lane * 8), y0); \
        f32x4 X1 = MFMA16(q0, b0, z4); X1 = MFMA16(q1, b1, X1); \
        bf16* yp = cs_ < 16 ? yctx + (long)cs_ * 16 * ystep : ylat + (long)(cs_ - 16) * 16 * ystep; \
        yp[0] = (bf16)f2bf(X1[0] + y0[0]); yp[ystep] = (bf16)f2bf(X1[1] + y0[1]); yp[2 * ystep] = (bf16)f2bf(X1[2] + y0[2]); yp[3 * ystep] = (bf16)f2bf(X1[3] + y0[3]); \
        asm volatile("s_waitcnt lgkmcnt(0)" ::: "memory"); } } while (0)
#define SQ_LOADER(c) do { if (loader) { if ((c) + SQ_D < SEGCH) { SQ_ISSUE((c) + SQ_D); asm volatile("s_waitcnt vmcnt(12)" ::: "memory"); } else asm volatile("s_waitcnt vmcnt(0)" ::: "memory"); } \
        __builtin_amdgcn_s_barrier(); asm volatile("" ::: "memory"); } while (0)
    const bool stw = (w == 0 && MODE != 1), yw = (w == 6 && MODE != 1);
    SQ Ra, Rb, Rc;
    SQ_LOADER(0);
    if (stw) { SQ_READ(Ra, 0); SQ_READ(Rb, 1); }
    for (int c = 0; c < SEGCH; c += 3) {
        SQ_LOADER(c + 1);
        if (stw) SQ_STEP(Ra, c, Rc, c + 2);
        if (yw && c > 0) SQ_YSTEP(c - 1);
        SQ_LOADER(c + 2);
        if (stw) SQ_STEP(Rb, c + 1, Ra, c + 3);
        if (yw) SQ_YSTEP(c);
        SQ_LOADER(c + 3);
        if (stw) SQ_STEP(Rc, c + 2, Rb, c + 4);
        if (yw) SQ_YSTEP(c + 1);
    }
    __builtin_amdgcn_s_barrier(); asm volatile("" ::: "memory");
    if (yw) SQ_YSTEP(SEGCH - 1);
#undef SQ_READ
#undef SQ_STEP
#undef SQ_YSTEP
#undef SQ_LOADER
#undef SQ_ISSUE
    if (MODE >= 2 && w == 0 && M[0][0] + M[1][1] + M[2][2] + M[3][3] == 12345.678f) st[0] = M[0][0];
    if (MODE == 0 && w == 0 && seg + 1 < NSEG) {
#pragma unroll
        for (int mt = 0; mt < 4; ++mt) *(f32x4*)(st + mt * 256) = M[mt]; }
    __syncthreads();
}

namespace pg8 {
struct EpiStoreBf16 {
    static constexpr bool PERM = true, AFTER_DRAIN = false;
    bf16_t* O; int ldc; int pn_mask;
    __device__ __forceinline__ void operator()(const f32x4 (&acc)[2][2][4][2], const Unit& u, int wr, int wc, int fr, int fq) const {
        const int row0 = u.pm * BM + wr * 64 + fr; const int col0 = (u.pn & pn_mask) * BM + wc * 32 + 8 * fq;
#pragma unroll
        for (int ai = 0; ai < 2; ++ai)
#pragma unroll
            for (int m = 0; m < 4; ++m) { bf16_t* rowp = O + (size_t)(row0 + ai * HALF + m * 16) * ldc + col0;
#pragma unroll
                for (int bj = 0; bj < 2; ++bj) { const f32x4 v0 = acc[ai][bj][m][0], v1 = acc[ai][bj][m][1];
                    u32x4 w; w.x = cvt_pk_bf16(v0[0], v0[1]); w.y = cvt_pk_bf16(v0[2], v0[3]); w.z = cvt_pk_bf16(v1[0], v1[1]); w.w = cvt_pk_bf16(v1[2], v1[3]);
                    *(u32x4*)(rowp + bj * HALF) = w; } }
    }
};
typedef __attribute__((address_space(1))) unsigned long long gu64_t;
typedef __attribute__((address_space(1))) unsigned gu32_t;
struct EpiSwiGLU {
    static constexpr bool PERM = true, AFTER_DRAIN = false;
    bf16_t* O;
    __device__ __forceinline__ void operator()(const f32x4 (&acc)[2][2][4][2], const Unit& u, int wr, int wc, int fr, int fq) const {
        const int row0 = u.pm * BM + wr * 64 + fr; const int col0 = ((u.pn & 3) * BM + wc * 32 + 8 * fq) >> 1;
#pragma unroll
        for (int ai = 0; ai < 2; ++ai)
#pragma unroll
            for (int m = 0; m < 4; ++m) { bf16_t* rowp = O + (size_t)(row0 + ai * HALF + m * 16) * 512 + col0;
#pragma unroll
                for (int bj = 0; bj < 2; ++bj) { const f32x4 g = acc[ai][bj][m][0], up = acc[ai][bj][m][1]; float a[4];
#pragma unroll
                    for (int i = 0; i < 4; ++i) a[i] = g[i] / (1.f + __expf(-g[i])) * up[i];
                    unsigned long long w = (unsigned long long)cvt_pk_bf16(a[0], a[1]) | ((unsigned long long)cvt_pk_bf16(a[2], a[3]) << 32);
                    __hip_atomic_store((gu64_t*)(rowp + bj * (HALF / 2)), w, __ATOMIC_RELAXED, __HIP_MEMORY_SCOPE_AGENT); } }
    }
};
template <bool XF32> struct EpiResidual {
    static constexpr bool PERM = false, AFTER_DRAIN = false;
    const void* xlat; const void* xctx;
    bf16_t* out; const float* g1;
    __device__ __forceinline__ void operator()(const f32x4 (&acc)[2][2][4][2], const Unit& u, int wr, int wc, int fr, int fq) const {
        const int rowt = u.pm * BM; const int mr = rowt < 16384 ? (rowt >> 13) : 2;
        const size_t boff = rowt < 16384 ? (size_t)rowt * 1024 : (size_t)(rowt - 16384) * 1024; const void* bp = rowt < 16384 ? xlat : xctx;
        const int col0 = u.pn * BM + wc * 32 + 4 * fq;
        f32x4 gv[2][2];
#pragma unroll
        for (int bj = 0; bj < 2; ++bj)
#pragma unroll
            for (int n = 0; n < 2; ++n) gv[bj][n] = *(const f32x4*)(g1 + (size_t)mr * 6144 + col0 + bj * HALF + n * 16);
#pragma unroll
        for (int ai = 0; ai < 2; ++ai)
#pragma unroll
            for (int m = 0; m < 4; ++m) { const int rl = ai * HALF + wr * 64 + m * 16 + fr;
#pragma unroll
                for (int bj = 0; bj < 2; ++bj)
#pragma unroll
                    for (int n = 0; n < 2; ++n) { const size_t off = (size_t)rl * 1024 + col0 + bj * HALF + n * 16;
                        f32x4 xo;
                        if (XF32) xo = __builtin_nontemporal_load((const f32x4*)((const float*)bp + boff + off));
                        else { const unsigned long long w_ = *(const unsigned long long*)((const bf16_t*)bp + boff + off); const unsigned lo = (unsigned)w_, hi = (unsigned)(w_ >> 32);
                            xo = (f32x4){__uint_as_float(lo << 16), __uint_as_float(lo & 0xffff0000u), __uint_as_float(hi << 16), __uint_as_float(hi & 0xffff0000u)}; }
                        const f32x4 r = xo + gv[bj][n] * acc[ai][bj][m][n];
                        *(unsigned long long*)(out + (size_t)rowt * 1024 + off) = (unsigned long long)cvt_pk_bf16(r[0], r[1]) | ((unsigned long long)cvt_pk_bf16(r[2], r[3]) << 32); } }
    }
};
struct MoeOrder {
    const PG8_LAS int* tile_e; const PG8_LAS int* tile_t; int ntiles, G, c;
    __device__ bool next(int i, Unit& u) const { const long L = (long)i * G + c; if (L >= 4L * ntiles) return false; const int pm = (int)(L >> 2); const int e = tile_e[pm];
        u.pm = pm; u.pn = e * 4 + (int)(L & 3); u.ga = e * 16896 + tile_t[pm] * 256; return true; }
    __device__ __forceinline__ void a_ready(const Unit&) const {}
    __device__ __forceinline__ void done(const Unit&) const {}
};
struct MoeOrderPub : MoeOrder {
    unsigned* ready;
    __device__ __forceinline__ void done(const Unit& u) const {
        asm volatile("s_waitcnt vmcnt(0)" ::: "memory");
        if ((threadIdx.x & 63) == 0) (void)__hip_atomic_fetch_add((gu32_t*)(ready + 16 * u.pm), 1u, __ATOMIC_RELAXED, __HIP_MEMORY_SCOPE_AGENT);
    }
};
struct MoeOrder2 {
    const PG8_LAS int* tile_e; int n, G, c, rem, nl, nA; const unsigned* ready; unsigned* tmo;
    __device__ __forceinline__ void init(const PG8_LAS int* te, int ntiles, int G_, int c_, const unsigned* rdy, unsigned* t) {
        tile_e = te; n = 4 * ntiles; G = G_; c = c_; rem = n % G; nl = rem ? G - rem : 0; nA = 2 * nl < n ? 2 * nl : n; ready = rdy; tmo = t; }
    __device__ bool next(int i, Unit& u) const {
        long L;
        if (rem && c >= rem && i < 2) { L = (long)(c - rem) + (long)i * nl; if (L >= nA) return false; }
        else { const int k = (rem && c >= rem) ? i - 2 : i; L = (long)nA + c + (long)G * k; if (L >= n) return false; }
        const int pm = (int)(L >> 2); u.pm = pm; u.pn = tile_e[pm] * 4 + (int)(L & 3); u.ga = 0; return true; }
    __device__ __forceinline__ void a_ready(const Unit& u) const {
        if (threadIdx.x < 64) {
            unsigned polls = 0;
            while ((unsigned)__builtin_amdgcn_readfirstlane(__hip_atomic_load((const gu32_t*)(ready + 16 * u.pm), __ATOMIC_RELAXED, __HIP_MEMORY_SCOPE_AGENT)) < 32u) {
                if ((++polls & 255u) == 0u) { if (__builtin_amdgcn_readfirstlane(__hip_atomic_load((const gu32_t*)tmo, __ATOMIC_RELAXED, __HIP_MEMORY_SCOPE_AGENT)) != 0u) break;
                    if (polls > (1u << 18)) { if (threadIdx.x == 0) __hip_atomic_store((gu32_t*)tmo, 1u, __ATOMIC_RELAXED, __HIP_MEMORY_SCOPE_AGENT); break; } }
                __builtin_amdgcn_s_sleep(2); }
            __builtin_amdgcn_fence(__ATOMIC_ACQUIRE, "agent");
            asm volatile("s_waitcnt vmcnt(0)" ::: "memory");
        }
        asm volatile("" ::: "memory"); __builtin_amdgcn_s_barrier(); asm volatile("" ::: "memory");
    }
    __device__ __forceinline__ void done(const Unit&) const {}
};
}

constexpr int EXPERT_NIT = 6144;
__device__ __forceinline__ void expert_convert(const Frame& F0, int l, int b_lo, int it_lo, int it_hi) {
    const Frame F = phase_frame(F0); unsigned char* const ws = F.ws;
    if ((int)blockIdx.x < b_lo) return;
    const int nwv = (F.G - b_lo) * NWAVES, myw = ((int)blockIdx.x - b_lo) * NWAVES + F.wave;
    LAS float* scr = (LAS float*)(F.lds + F.wave * 16384);
    bf16* wgu = (bf16*)(ws + WS_WGU_T); bf16* wd = (bf16*)(ws + WS_WD_T);
    constexpr int CU_ = 4;
    constexpr int I_G = 16 * (16 / CU_), I_D = 8 * (32 / CU_);
    constexpr int NIT = NEXP * (2 * I_G + I_D);
    const float* p_eg = inptr(I_EG); const float* p_eu = inptr(I_EU); const float* p_ed = inptr(I_ED);
    static_assert(NIT == EXPERT_NIT, "item count");
    for (int it = it_lo + myw; it < it_hi; it += nwv) { const int e = it / (2 * I_G + I_D); int r = it % (2 * I_G + I_D);
        if (r < I_G) { transpose_item_u<CU_>(p_eg + ((size_t)l * NEXP + e) * D * DEXP, DEXP, (r / (16 / CU_)) * 64, (r % (16 / CU_)) * 32 * CU_, wgu, D, RmGU{e * 1024}, F.lane); continue; } r -= I_G;
        if (r < I_G) { transpose_item_u<CU_>(p_eu + ((size_t)l * NEXP + e) * D * DEXP, DEXP, (r / (16 / CU_)) * 64, (r % (16 / CU_)) * 32 * CU_, wgu, D, RmGU{e * 1024 + 4}, F.lane); continue; } r -= I_G;
        transpose_item_u<CU_>(p_ed + ((size_t)l * NEXP + e) * DEXP * D, D, (r / (32 / CU_)) * 64, (r % (32 / CU_)) * 32 * CU_, wd, DEXP, RmId{e * 1024}, F.lane);
    }
}

__device__ __forceinline__ void router_pass(const Frame& F0, int l, int nrows, int cnt_off = 0) {
    const Frame F = phase_frame(F0); unsigned char* const ws = F.ws;
    constexpr int HP = 1028;
    LAS float* msh = (LAS float*)F.lds; LAS float* msc = msh + 3072; LAS float* hrow = msc + 3072;
    LAS float* part = hrow + 16 * HP;
    LAS float* lgs = part + 8 * 16 * 48;
    LAS unsigned* lcnt = (LAS unsigned*)(lgs + 16 * 40);
    if (F0.tid < 64) lcnt[F0.tid] = 0u;
    __syncthreads();
    mod_to_lds(F, l, 3, msh, false); mod_to_lds(F, l, 4, msc, false); __syncthreads();
    const bf16* X = (const bf16*)(ws + WS_X); bf16* H = (bf16*)(ws + WS_H);
    const float* rgw = inptr(I_RGW) + (size_t)l * D * 4; const float* rew = inptr(I_REW) + (size_t)l * D * NEXP;
    const float* rgb = inptr(I_RGB) + l * 4; const float* reb = inptr(I_REB) + l * NEXP;
    int* rt_e = (int*)(ws + WS_ROUTE + RT_E); int* rt_pos = (int*)(ws + WS_ROUTE + RT_POS); float* rt_gate = (float*)(ws + WS_ROUTE + RT_GATE);
    unsigned* cnt = (unsigned*)(ws + WS_CTL) + CW_CNT + 64 * l + cnt_off;
    const int lane = F.lane, w = F.wave, fr = lane & 15, fq = lane >> 4; const float* n2g = inptr(I_N2G) + l * D;
    float bw[32][3];
#pragma unroll
    for (int ks = 0; ks < 32; ++ks) { const int k = 128 * w + 4 * ks + fq;
        bw[ks][0] = rew[(size_t)k * 32 + fr]; bw[ks][1] = rew[(size_t)k * 32 + 16 + fr]; bw[ks][2] = fr < 4 ? rgw[(size_t)k * 4 + fr] : 0.f; }
    const int ntiles = nrows >> 4;
    u32x2 pv[2][4];
    if (F.vcu < ntiles) {
#pragma unroll
        for (int rr = 0; rr < 2; ++rr)
#pragma unroll
            for (int j = 0; j < 4; ++j) pv[rr][j] = *(const u32x2*)(X + (size_t)(F.vcu * 16 + 2 * w + rr) * D + 4 * lane + 256 * j); }
    for (int gi = F.vcu; gi < ntiles; gi += F.G) {
#pragma unroll
        for (int rr = 0; rr < 2; ++rr) { const int r = 2 * w + rr, row = gi * 16 + r; f32x4 v[4];
#pragma unroll
            for (int j = 0; j < 4; ++j) { float t_[4]; unpack4(pv[rr][j], t_); v[j] = (f32x4){t_[0], t_[1], t_[2], t_[3]}; }
            const int mr = modrow(row);
            norm_mod_row(v, n2g, msc + mr * 1024, msh + mr * 1024, H + (size_t)row * D, lane);
#pragma unroll
            for (int j = 0; j < 4; ++j) *(LAS f32x4*)(hrow + r * HP + 4 * lane + 256 * j) = v[j]; }
        if (gi + F.G < ntiles) {
#pragma unroll
            for (int rr = 0; rr < 2; ++rr)
#pragma unroll
                for (int j = 0; j < 4; ++j) pv[rr][j] = *(const u32x2*)(X + (size_t)((gi + F.G) * 16 + 2 * w + rr) * D + 4 * lane + 256 * j); }
        __syncthreads();
        {   f32x4 acc[3] = {{0.f, 0.f, 0.f, 0.f}, {0.f, 0.f, 0.f, 0.f}, {0.f, 0.f, 0.f, 0.f}};
#pragma unroll
            for (int ks = 0; ks < 32; ++ks) { const float a = hrow[fr * HP + 128 * w + 4 * ks + fq];
#pragma unroll
                for (int nt = 0; nt < 3; ++nt) acc[nt] = __builtin_amdgcn_mfma_f32_16x16x4f32(a, bw[ks][nt], acc[nt], 0, 0, 0); }
#pragma unroll
            for (int nt = 0; nt < 3; ++nt)
#pragma unroll
                for (int reg = 0; reg < 4; ++reg) part[(w * 16 + 4 * fq + reg) * 48 + 16 * nt + fr] = acc[nt][reg]; }
        __syncthreads();
        for (int idx = F.tid; idx < 16 * 36; idx += NTHR) { const int r = idx / 36, n = idx % 36; float s_ = 0.f;
#pragma unroll
            for (int ww = 0; ww < 8; ++ww) s_ += part[(ww * 16 + r) * 48 + n];
            if (n < 32) lgs[r * 40 + 4 + n] = s_ + reb[n]; else lgs[r * 40 + n - 32] = s_ + rgb[n - 32]; }
        __syncthreads();
        if (F.tid < 16) { const int rr = gi * 16 + F.tid; const LAS float* lp = lgs + F.tid * 40;
            int grp = 0; float mx = lp[0];
#pragma unroll
            for (int g = 1; g < 4; ++g) if (lp[g] > mx) { mx = lp[g]; grp = g; }
            float den = 0.f;
#pragma unroll
            for (int g = 0; g < 4; ++g) den += __expf(lp[g] - mx);
            const float pg_top = 1.f / den; const LAS float* sel = lp + 4 + grp * 8;
            int i0 = 0; float l0 = sel[0];
#pragma unroll
            for (int q = 1; q < 8; ++q) if (sel[q] > l0) { l0 = sel[q]; i0 = q; }
            int i1 = -1; float l1 = -3.0e38f;
#pragma unroll
            for (int q = 0; q < 8; ++q) if (q != i0 && sel[q] > l1) { l1 = sel[q]; i1 = q; }
            const float e1 = __expf(l1 - l0); const float w0 = pg_top / (1.f + e1), w1 = pg_top * e1 / (1.f + e1);
            const int ea = grp * 8 + i0, eb = grp * 8 + i1;
            const unsigned pa = atomicAdd((unsigned*)(lcnt + ea), 1u), pb = atomicAdd((unsigned*)(lcnt + eb), 1u);
            rt_e[2 * rr] = ea; rt_e[2 * rr + 1] = eb; rt_pos[2 * rr] = (int)pa; rt_pos[2 * rr + 1] = (int)pb; rt_gate[2 * rr] = w0; rt_gate[2 * rr + 1] = w1; }
    }
    __syncthreads();
    if (F.tid < 32) lcnt[32 + F.tid] = lcnt[F.tid] ? atomicAdd(cnt + F.tid, lcnt[F.tid]) : 0u;
    __syncthreads();
    int* elist = (int*)(ws + WS_ELIST);
    if (F.tid < 16) for (int gi = F.vcu; gi < ntiles; gi += F.G) { const int rr = gi * 16 + F.tid;
        const int ea = rt_e[2 * rr], eb = rt_e[2 * rr + 1]; const int pa = rt_pos[2 * rr] + (int)lcnt[32 + ea], pb = rt_pos[2 * rr + 1] + (int)lcnt[32 + eb];
        rt_pos[2 * rr] = pa; rt_pos[2 * rr + 1] = pb; elist[(size_t)ea * NROW + pa] = rr; elist[(size_t)eb * NROW + pb] = rr; }
}

constexpr int MOE_MAP_OFF = 131072;
__device__ __forceinline__ void moe_map(const Frame& F0, int l) {
    const Frame F = phase_frame(F0); unsigned char* const ws = F.ws;
    LAS int* mp = (LAS int*)(F.lds + MOE_MAP_OFF);
    const unsigned* cnt = (const unsigned*)(ws + WS_CTL) + CW_CNT + 64 * l;
    __syncthreads();
    if (F.tid < NEXP) mp[32 + F.tid] = (int)__hip_atomic_load(cnt + F.tid, __ATOMIC_RELAXED, __HIP_MEMORY_SCOPE_AGENT);
    __syncthreads();
    if (F.tid == 0) { int o = 0;
#pragma nounroll
        for (int e = 0; e < NEXP; ++e) { const int c = mp[32 + e]; const int nt = (c + 255) >> 8; mp[e] = o;
#pragma nounroll
            for (int t = 0; t < nt; ++t) { mp[128 + (o >> 8) + t] = e; mp[320 + (o >> 8) + t] = t; }
            o += nt << 8; }
        mp[64] = o >> 8; }
    __syncthreads();
}

template <bool DRY>
__device__ __forceinline__ void combine_pass(const Frame& F0, int l, int nrows) {
    const Frame F = phase_frame(F0); unsigned char* const ws = F.ws;
    LAS float* mg2 = (LAS float*)F.lds; LAS float* msh = mg2 + 3072; LAS float* msc = msh + 3072;
    const bool last = (l == DEPTH - 1);
    __syncthreads();
    mod_to_lds(F, l, 5, mg2, false); if (!last) { mod_to_lds(F, l + 1, 0, msh, false); mod_to_lds(F, l + 1, 1, msc, false); }
    __syncthreads();
    bf16* X = (bf16*)(ws + WS_X); bf16* H = (bf16*)(ws + WS_H); const bf16* Ys = (const bf16*)(ws + WS_XS);
    const int* rt_e = (const int*)(ws + WS_ROUTE + RT_E); const int* rt_pos = (const int*)(ws + WS_ROUTE + RT_POS); const float* rt_gate = (const float*)(ws + WS_ROUTE + RT_GATE);
    const LAS int* moff = (const LAS int*)(F.lds + MOE_MAP_OFF);
    const int lane = F.lane; const float* n1g = inptr(I_N1G) + (last ? 0 : (l + 1) * D); const float* fgp = inptr(I_FG);
    int ne0[2], ne1[2], np0[2], np1[2]; float ng0[2], ng1[2];
#define CMB_ROUTE(r0_) do { _Pragma("unroll") for (int u = 0; u < 2; ++u) { const int row = (r0_) + u * F.NGW; if (row < nrows) { \
        ne0[u] = rt_e[2 * row]; ne1[u] = rt_e[2 * row + 1]; np0[u] = rt_pos[2 * row]; np1[u] = rt_pos[2 * row + 1]; ng0[u] = rt_gate[2 * row]; ng1[u] = rt_gate[2 * row + 1]; } } } while (0)
    CMB_ROUTE(F.gw);
    for (int row0 = F.gw; row0 < nrows; row0 += 2 * F.NGW) {
        int s0[2], s1[2]; float w0[2], w1[2]; bool ok[2]; u32x2 ya[2][4], yb[2][4], xo[2][4];
#pragma unroll
        for (int u = 0; u < 2; ++u) { const int row = row0 + u * F.NGW; ok[u] = row < nrows; if (ok[u]) { s0[u] = moff[ne0[u]] + np0[u]; s1[u] = moff[ne1[u]] + np1[u]; w0[u] = ng0[u]; w1[u] = ng1[u]; } }
        CMB_ROUTE(row0 + 2 * F.NGW);
#pragma unroll
        for (int u = 0; u < 2; ++u) if (ok[u]) { const int row = row0 + u * F.NGW;
#pragma unroll
            for (int j = 0; j < 4; ++j) { const int c = 4 * lane + 256 * j; ya[u][j] = __builtin_nontemporal_load((const u32x2*)(Ys + (size_t)s0[u] * D + c)); yb[u][j] = __builtin_nontemporal_load((const u32x2*)(Ys + (size_t)s1[u] * D + c)); xo[u][j] = *(const u32x2*)(X + (size_t)row * D + c); } }
#pragma unroll
        for (int u = 0; u < 2; ++u) if (ok[u]) { const int row = row0 + u * F.NGW; const int mr = modrow(row); f32x4 v[4];
#pragma unroll
            for (int j = 0; j < 4; ++j) { const int c = 4 * lane + 256 * j; float a[4], b[4]; unpack4(ya[u][j], a); unpack4(yb[u][j], b);
                const f32x4 g2 = *(const LAS f32x4*)(mg2 + mr * 1024 + c);
                f32x4 y; y.x = w0[u] * a[0] + w1[u] * b[0]; y.y = w0[u] * a[1] + w1[u] * b[1]; y.z = w0[u] * a[2] + w1[u] * b[2]; y.w = w0[u] * a[3] + w1[u] * b[3];
                float x_[4]; unpack4(xo[u][j], x_); v[j] = (f32x4){x_[0], x_[1], x_[2], x_[3]} + g2 * y; }
            if (DRY) { asm volatile("" :: "v"(v[0].x + v[1].y + v[2].z + v[3].w)); }
            else if (!last) {
#pragma unroll
                for (int j = 0; j < 4; ++j) __builtin_nontemporal_store((u32x2){pk2(v[j].x, v[j].y), pk2(v[j].z, v[j].w)}, (u32x2*)(X + (size_t)row * D + 4 * lane + 256 * j));
                norm_mod_row(v, n1g, msc + mr * 1024, msh + mr * 1024, H + (size_t)row * D, lane);
            } else { float s = 0.f;
#pragma unroll
                for (int j = 0; j < 4; ++j) s += (v[j].x * v[j].x + v[j].y * v[j].y) + (v[j].z * v[j].z + v[j].w * v[j].w);
                const float rs = rsqrtf(wave_sum(s) * (1.f / D) + RMS_EPS);
#pragma unroll
                for (int j = 0; j < 4; ++j) { const int c = 4 * lane + 256 * j; const f32x4 g = *(const f32x4*)(fgp + c); __builtin_nontemporal_store(v[j] * rs * g, (f32x4*)(F.out + (size_t)row * D + c)); } } }
    }
#undef CMB_ROUTE
}
__global__ void __launch_bounds__(NTHR, 2) fwd_megakernel(Params prm) {
    extern __shared__ __attribute__((aligned(16))) unsigned char lds_raw[];
    Frame F;
    F.lds = (LAS unsigned char*)lds_raw;
    F.tid = threadIdx.x; F.lane = F.tid & 63; F.wave = __builtin_amdgcn_readfirstlane(F.tid >> 6);
    F.G = gridDim.x; { const int bx = blockIdx.x; F.vcu = (F.G % 8 == 0) ? (bx % 8) * (F.G / 8) + bx / 8 : bx; }
    F.gw = F.vcu * NWAVES + F.wave; F.NGW = F.G * NWAVES;
    F.out = prm.out; F.ws = prm.ws;
    for (int u = F.tid; u < (LDS_BYTES - LDSCTL_OFF) / 4; u += NTHR) ((LAS unsigned*)(F.lds + LDSCTL_OFF))[u] = 0u;
    __syncthreads();
    (void)xcd_barrier_post((unsigned*)(F.ws + WS_CTL) + CW_BAR, (volatile LAS unsigned*)(F.lds + MISC_OFF) + 8);
#define GRID_BAR() do { XcdBarrier bar_; bar_.bar = (unsigned*)(opaque(F.ws) + WS_CTL) + CW_BAR; bar_.x = xb_xcc_id(); bar_.st = (volatile LAS unsigned*)(F.lds + MISC_OFF) + 8; xcd_barrier(bar_); } while (0)

    p0_prologue(F);
#if USE_CG_SYNC
    cg::this_grid().sync();
#else
    GRID_BAR();
#endif
    p0b_norm1(F);
    GRID_BAR();

    for (int l = 0; l < DEPTH; ++l) {
        const bool need_ctx = (l == 0); const int nrows = need_ctx ? NROW : NLAT;
#define WSO Fp.ws
        {
            const Frame Fp = phase_frame(F); unsigned char* const ws = WSO; bf16* Hb = (bf16*)(ws + WS_H); bf16* Pb = (bf16*)(ws + WS_P);
            pg8::Gemm g{Hb, (const bf16*)(ws + WS_WIN_T) + (size_t)l * NP * D, NROW, NP, D}; pg8::StaticOrder S; S.init(NROW, NP, Fp.G, (int)blockIdx.x);
            pg8::EpiStoreBf16 E{Pb, NP, 0xffff};
            pg8::gemm_phase<pg8::EpiStoreBf16, pg8::StaticOrder, true, true>(F.lds, g, S, E);
        }
        GRID_BAR();
        {
            const Frame Fp = phase_frame(F); unsigned char* const ws = WSO; bf16* Pb = (bf16*)(ws + WS_P);
            for (int it = blockIdx.x; it < 256; it += F.G) fftA_item(F, it);
            if (need_ctx) for (int it = (int)blockIdx.x - (F.G >= 64 ? F.G - 32 : 0); it >= 0 && it < 32; it += F.G) { const int b = it >> 4, m0 = (it & 15) * 16;
                const bf16* src0 = Pb + (size_t)(NLAT + b * CTXL) * NP + COL_FC;
                dft64_item<4, 256, 1>(F, l, m0, -1.f, 1.f / 128.f, [=](int t, int ri) { return src0 + (size_t)t * NP + ri * 256; }, [=](int m) { return NLAT + b * CTXL + m; }); }
            shift_pass(F, l);
            conv_pass(F, l, nrows);
        }
        GRID_BAR();
        {
            const Frame Fp = phase_frame(F); unsigned char* const ws = WSO;
            prep_phase(F, l);
        }
        const int p_tail = (2 * (NROW / 16)) % F.G; const int cvP = (F.G == 256 && p_tail) ? (F.G - p_tail) * NWAVES * CONV_P_PER_WAVE : 0;
        if (cvP && (int)blockIdx.x >= p_tail) expert_convert(F, l, p_tail, CONV_A_ITEMS, CONV_A_ITEMS + cvP);
        GRID_BAR();
        {   const bool split = (F.G == 256);
            unsigned* const sflag = (unsigned*)(opaque(F.ws) + WS_CTL) + CW_SCANF + l * 256; unsigned* const stmo = (unsigned*)(opaque(F.ws) + WS_CTL) + CW_TMO2;
        for (int seg = -1; seg < NSEG; ++seg) {
            if (seg + 1 < NSEG && (seg < 0 || !split || blockIdx.x >= 128)) {
                if (split && seg >= 1) flag_wait(sflag + 16 * (4 + seg - 1), 128u, stmo);
                pre_phase(F, seg + 1, (seg >= 0 && split) ? 128 : 0);
                if (split) flag_publish(sflag + 16 * (seg + 1)); }
            if (seg + 1 == NSEG && (!split || blockIdx.x >= 128)) { unsigned char* const ws = opaque(F.ws); int bx_ = (int)blockIdx.x; asm volatile("" : "+s"(bx_));
                const int first_ = split ? bx_ - 128 : bx_, stride_ = split ? 128 : F.G;
                for (int it = first_; it < 256; it += stride_) { const int b = it >> 7, t1p = it & 127;
                    const bf16* src0 = (const bf16*)(ws + WS_GT) + (size_t)(b * 128 + t1p) * 64 * 512;
                    dft64_item<1, 64, 4>(F, l, 0, 1.f, 0.0013810679320049757f, [=](int t, int ri) { return src0 + (size_t)t * 512 + ri * 256; }, [=](int m) { return b * SEQ + t1p + 128 * m; }); }
                if (split) expert_convert(F, l, 128, 0, CONV_A_ITEMS); }
            if (seg >= 0 && (!split || blockIdx.x < 128)) {
                if (split) flag_wait(sflag + 16 * seg, seg == 0 ? 256u : 128u, stmo);
                for (int it = blockIdx.x; it < 128; it += F.G) { const int x_ = it & 7, j_ = it >> 3;
                    seq_item<0>(F, ((x_ + 8 * (j_ >> 2)) << 2) | (j_ & 3), seg, need_ctx); }
                if (split && seg + 2 < NSEG) flag_signal(sflag + 16 * (4 + seg)); }
            if (!split || seg == NSEG - 1) GRID_BAR();
        } }
        readout_pass(F, l, nrows);
        GRID_BAR();
        const int cv_lo = (nrows / 256) * 4 > F.G ? (nrows / 256) * 4 - F.G : 0; const int cvA = (F.G == 256) ? CONV_A_ITEMS + cvP : 0;
        if (blockIdx.x & 1) expert_convert(F, l, cv_lo, cvA, EXPERT_NIT);
        {
            const Frame Fp = phase_frame(F); unsigned char* const ws = WSO; bf16* Hb = (bf16*)(ws + WS_H);
            pg8::Gemm g{Hb, (const bf16*)(ws + WS_WOUT_T) + (size_t)l * D * D, nrows, D, D}; pg8::StaticOrder S; S.init(nrows, D, Fp.G, (int)blockIdx.x);
            bf16* X = (bf16*)(ws + WS_X); const float* g1p = (const float*)(ws + WS_MODF) + (size_t)l * 3 * 6144 + 2 * 1024;
            if (l == 0) { pg8::EpiResidual<true> E{inptr(I_X), inptr(I_CTX), X, g1p}; pg8::gemm_phase<pg8::EpiResidual<true>, pg8::StaticOrder, true, true>(F.lds, g, S, E); }
            else { pg8::EpiResidual<false> E{X, X + (size_t)NLAT * D, X, g1p}; pg8::gemm_phase<pg8::EpiResidual<false>, pg8::StaticOrder, true, true>(F.lds, g, S, E); }
        }
        if (!(blockIdx.x & 1)) expert_convert(F, l, cv_lo, cvA, EXPERT_NIT);
        GRID_BAR();
        router_pass(F, l, nrows);
        GRID_BAR();
        {
            const Frame Fp = phase_frame(F); unsigned char* const ws = WSO;
            moe_map(F, l);
            const LAS int* mp = (const LAS int*)(F.lds + MOE_MAP_OFF);
            unsigned* rdy = (unsigned*)(ws + WS_CTL) + CW_TRDY + l * 2688;
            {   pg8::MoeOrderPub S; S.tile_e = mp + 128; S.tile_t = mp + 320; S.ntiles = mp[64]; S.G = Fp.G; S.c = (int)blockIdx.x; S.ready = rdy;
                pg8::Gemm g{(const bf16*)(ws + WS_H), (const bf16*)(ws + WS_WGU_T), 0, 0, D, (const int*)(ws + WS_ELIST), NROW - 1};
                pg8::EpiSwiGLU E{(bf16*)(ws + WS_ACT)};
                pg8::gemm_phase<pg8::EpiSwiGLU, pg8::MoeOrderPub, true, true, true>(F.lds, g, S, E); }
            {   pg8::MoeOrder2 S; S.init(mp + 128, mp[64], Fp.G, (int)blockIdx.x, rdy, (unsigned*)(ws + WS_CTL) + CW_TMO2);
                pg8::Gemm g{(const bf16*)(ws + WS_ACT), (const bf16*)(ws + WS_WD_T), 0, 0, DEXP};
                pg8::EpiStoreBf16 E{(bf16*)(ws + WS_XS), D, 3};
                pg8::gemm_phase<pg8::EpiStoreBf16, pg8::MoeOrder2, true, true>(F.lds, g, S, E); }
        }
        GRID_BAR();
        combine_pass<false>(F, l, nrows);
        if (l + 1 < DEPTH) GRID_BAR();
    }
}

extern "C" void kernel_launch(void* const* d_in, const int* in_sizes, int n_in, void* d_out, int out_size, void* d_ws, size_t ws_size, hipStream_t stream) {
    static int grid = 0;
    if (grid == 0) {
        if (n_in != N_IN || in_sizes[0] != NLAT * D || out_size != NLAT * D || ws_size < WS_END) {
            fprintf(stderr, "kernel_launch: unexpected shapes (n_in %d in0 %d out %d ws %zu)\n", n_in, n_in > 0 ? in_sizes[0] : -1, out_size, ws_size); grid = -1; return; }
        int dev = 0, cus = 0, per_cu = 0;
        hipGetDevice(&dev); hipDeviceGetAttribute(&cus, hipDeviceAttributeMultiprocessorCount, dev);
        hipFuncSetAttribute((const void*)fwd_megakernel, hipFuncAttributeMaxDynamicSharedMemorySize, LDS_BYTES);
        hipOccupancyMaxActiveBlocksPerMultiprocessor(&per_cu, (const void*)fwd_megakernel, NTHR, LDS_BYTES);
        if (per_cu < 1) { fprintf(stderr, "kernel_launch: occupancy query says %d blocks per CU\n", per_cu); per_cu = 1; }
        (void)hipGetLastError();
        grid = cus * per_cu;
    }
    if (grid < 0) return;
    hipMemsetAsync((char*)d_ws + WS_CTL, 0, CTL_ZERO_BYTES, stream);
    Params p{};
    for (int i = 0; i < N_IN; ++i) p.in[i] = (const float*)d_in[i];
    p.out = (float*)d_out; p.ws = (unsigned char*)d_ws;
    void* args[] = {&p};
    hipError_t e = hipLaunchCooperativeKernel((const void*)fwd_megakernel, dim3(grid), dim3(NTHR), args, LDS_BYTES, stream);
    if (e != hipSuccess) fprintf(stderr, "kernel_launch: cooperative launch failed: %s (grid %d)\n", hipGetErrorString(e), grid);
}
```
